# Optimizing an MI355X kernel written in HIP

```python
import math
import jax, jax.numpy as jnp
from jax import lax
import numpy as np

D_MODEL = 1024
BATCH = 8
SEQ = 2048
DEPTH = 2

HEAD_DIM = 64
POOL_GROUPS = 4
POOL_WINDOWS = (2, 4, 8, 16)
POOL_GROUP_DIM = 128
POOL_WIDTH = POOL_GROUPS * POOL_GROUP_DIM
DIFF_HEADS = 4
DIFF_QK = DIFF_HEADS * 2 * HEAD_DIM
DIFF_V_DIM = 2 * HEAD_DIM
DIFF_V = DIFF_HEADS * DIFF_V_DIM
FOX_HEADS = 8
FOX_QK = FOX_HEADS * HEAD_DIM
FOX_V = FOX_HEADS * HEAD_DIM
N_BRANCH = 3
BRANCH_WIDTH = 512
ROT_DIM = HEAD_DIM // 4
ROPE_THETA = 500000.0
Q_BLOCK = 128
PLE_DIM = 256
N_GROUPS = 4
EXPERTS_PER_GROUP = 4
N_EXPERTS = N_GROUPS * EXPERTS_PER_GROUP
TOP_K = 2
D_EXPERT = 256
RMS_EPS = 1e-6
IN_SPLITS = (POOL_WIDTH, DIFF_QK, DIFF_QK, DIFF_V, FOX_QK, FOX_QK, FOX_V, FOX_HEADS, N_BRANCH * D_MODEL)
IN_WIDTH = sum(IN_SPLITS)

kernel_name = "hybrid_pool_diffattn_fox_hmoe_ple"


def rms_norm(x, g):
    x32 = x.astype(jnp.float32)
    y = x32 * lax.rsqrt(jnp.mean(x32 * x32, axis=-1, keepdims=True) + RMS_EPS)
    return (y * g.astype(jnp.float32)).astype(x.dtype)


def partial_rotary(x, cos, sin):
    half = ROT_DIM // 2
    x1 = x[..., :half]
    x2 = x[..., half:ROT_DIM]
    c = cos.astype(x.dtype)
    s = sin.astype(x.dtype)
    return jnp.concatenate([x1 * c - x2 * s, x2 * c + x1 * s, x[..., ROT_DIM:]], axis=-1)


def pool_mixer(u, w_grp, scale):
    B, S, _ = u.shape
    u = u.reshape(B, S, POOL_GROUPS, POOL_GROUP_DIM)
    u32 = u.astype(jnp.float32)
    csum = jnp.cumsum(u32, axis=1)
    t = jnp.arange(S)
    outs = []
    for g, w in enumerate(POOL_WINDOWS):
        c = csum[:, :, g]
        lag = jnp.pad(c, ((0, 0), (w, 0), (0, 0)))[:, :S]
        cnt = jnp.minimum(t + 1, w).astype(jnp.float32)[None, :, None]
        outs.append((c - lag) / cnt - u32[:, :, g])
    d = jnp.stack(outs, axis=2).astype(u.dtype)
    y = jnp.einsum('bsgc,gcd->bsgd', d, w_grp)
    return y.reshape(B, S, POOL_WIDTH) * scale


def _masked_softmax(s, mask):
    return jax.nn.softmax(jnp.where(mask, s, -jnp.inf), axis=-1)


def diff_attention(q1, q2, k1, k2, v, lam):
    S, dh = q1.shape[2], q1.shape[3]
    scale = dh ** -0.5
    outs = []
    for q0 in range(0, S, Q_BLOCK):
        kend = q0 + Q_BLOCK
        mask = jnp.arange(kend)[None, :] <= jnp.arange(q0, kend)[:, None]
        s1 = jnp.einsum('bhqd,bhkd->bhqk', q1[:, :, q0:kend], k1[:, :, :kend]).astype(jnp.float32) * scale
        s2 = jnp.einsum('bhqd,bhkd->bhqk', q2[:, :, q0:kend], k2[:, :, :kend]).astype(jnp.float32) * scale
        a = _masked_softmax(s1, mask) - lam * _masked_softmax(s2, mask)
        outs.append(jnp.einsum('bhqk,bhkd->bhqd', a.astype(v.dtype), v[:, :, :kend]))
    return jnp.concatenate(outs, axis=2)


def forgetting_attention(q, k, v, logf):
    S, dh = q.shape[2], q.shape[3]
    scale = dh ** -0.5
    F = jnp.cumsum(logf, axis=-1)
    outs = []
    for q0 in range(0, S, Q_BLOCK):
        kend = q0 + Q_BLOCK
        mask = jnp.arange(kend)[None, :] <= jnp.arange(q0, kend)[:, None]
        s = jnp.einsum('bhqd,bhkd->bhqk', q[:, :, q0:kend], k[:, :, :kend]).astype(jnp.float32) * scale
        s = s + (F[:, :, q0:kend, None] - F[:, :, None, :kend])
        a = _masked_softmax(s, mask)
        outs.append(jnp.einsum('bhqk,bhkd->bhqd', a.astype(v.dtype), v[:, :, :kend]))
    return jnp.concatenate(outs, axis=2)


def hierarchical_moe(h, w_rg, b_rg, w_re, b_re, w_gate, w_up, w_down):
    T = h.shape[0]
    g_prob = jax.nn.softmax((h @ w_rg).astype(jnp.float32) + b_rg.astype(jnp.float32), axis=-1)
    gp, gi = lax.top_k(g_prob, 1)
    e_logit = ((h @ w_re).astype(jnp.float32) + b_re.astype(jnp.float32)).reshape(T, N_GROUPS, EXPERTS_PER_GROUP)
    e_sel = jnp.take_along_axis(e_logit, gi[:, :, None], axis=1)[:, 0]
    ew, ei = lax.top_k(jax.nn.softmax(e_sel, axis=-1), TOP_K)
    weight = gp * ew / jnp.sum(ew, axis=-1, keepdims=True)
    eid = gi * EXPERTS_PER_GROUP + ei
    combine = jnp.sum(jax.nn.one_hot(eid, N_EXPERTS, dtype=jnp.float32) * weight[..., None], axis=1)
    act = jax.nn.silu(jnp.einsum('td,edf->tef', h, w_gate)) * jnp.einsum('td,edf->tef', h, w_up)
    return jnp.einsum('tef,efd->td', act * combine[:, :, None].astype(act.dtype), w_down)


def setup_inputs(seed: int = 0) -> dict:
    key = jax.random.key(seed)
    ks = jax.random.split(key, 32)
    f32 = jnp.float32
    L, D = DEPTH, D_MODEL

    def nrm(k, shape, scale):
        return jax.random.normal(k, shape, f32) * scale

    def gain(k, shape):
        return 1.0 + 0.05 * jax.random.normal(k, shape, f32)

    return {
        "x": nrm(ks[0], (BATCH, SEQ, D), 1.0),
        "p": nrm(ks[1], (L, BATCH, SEQ, PLE_DIM), 1.0),
        "positions": jnp.broadcast_to(jnp.arange(SEQ, dtype=jnp.int32), (BATCH, SEQ)),
        "attn_norm_g": gain(ks[2], (L, D)),
        "w_in": nrm(ks[3], (L, D, IN_WIDTH), D ** -0.5),
        "pool_w": nrm(ks[4], (L, POOL_GROUPS, POOL_GROUP_DIM, POOL_GROUP_DIM), POOL_GROUP_DIM ** -0.5),
        "pool_scale": gain(ks[5], (L, POOL_WIDTH)),
        "diff_qn_g": gain(ks[6], (L, HEAD_DIM)),
        "diff_kn_g": gain(ks[7], (L, HEAD_DIM)),
        "diff_lambda": nrm(ks[8], (L, 4, HEAD_DIM), 0.1),
        "diff_subln_g": gain(ks[9], (L, DIFF_V_DIM)),
        "fox_qn_g": gain(ks[10], (L, HEAD_DIM)),
        "fox_kn_g": gain(ks[11], (L, HEAD_DIM)),
        "fox_forget_b": 2.0 + 0.1 * jax.random.normal(ks[12], (L, FOX_HEADS), f32),
        "w_branch": nrm(ks[13], (L, N_BRANCH, BRANCH_WIDTH, D), BRANCH_WIDTH ** -0.5),
        "w_out": nrm(ks[14], (L, D, D), D ** -0.5),
        "ffn_norm_g": gain(ks[15], (L, D)),
        "w_route_group": nrm(ks[16], (L, D, N_GROUPS), D ** -0.5),
        "b_route_group": nrm(ks[17], (L, N_GROUPS), 0.01),
        "w_route_expert": nrm(ks[18], (L, D, N_EXPERTS), D ** -0.5),
        "b_route_expert": nrm(ks[19], (L, N_EXPERTS), 0.01),
        "moe_w_gate": nrm(ks[20], (L, N_EXPERTS, D, D_EXPERT), D ** -0.5),
        "moe_w_up": nrm(ks[21], (L, N_EXPERTS, D, D_EXPERT), D ** -0.5),
        "moe_w_down": nrm(ks[22], (L, N_EXPERTS, D_EXPERT, D), D_EXPERT ** -0.5),
        "ple_norm_g": gain(ks[23], (L, D)),
        "w_ple_gate": nrm(ks[24], (L, D, D), D ** -0.5),
        "w_ple": nrm(ks[25], (L, PLE_DIM, D), PLE_DIM ** -0.5),
    }


def reference(x, p, positions, attn_norm_g, w_in, pool_w, pool_scale, diff_qn_g, diff_kn_g, diff_lambda,
              diff_subln_g, fox_qn_g, fox_kn_g, fox_forget_b, w_branch, w_out, ffn_norm_g, w_route_group,
              b_route_group, w_route_expert, b_route_expert, moe_w_gate, moe_w_up, moe_w_down, ple_norm_g,
              w_ple_gate, w_ple):
    B, S, D = x.shape
    inv_freq = ROPE_THETA ** (-jnp.arange(0, ROT_DIM, 2, dtype=jnp.float32) / ROT_DIM)
    ang = positions.astype(jnp.float32)[:, None, :, None] * inv_freq
    cos, sin = jnp.cos(ang), jnp.sin(ang)
    split_idx = np.cumsum(IN_SPLITS)[:-1].tolist()

    for l in range(DEPTH):
        h = rms_norm(x, attn_norm_g[l])
        proj = h @ w_in[l]
        u_pool, dq, dk, dv, fq, fk, fv, fz, gz = jnp.split(proj, split_idx, axis=-1)

        y_pool = pool_mixer(u_pool, pool_w[l], pool_scale[l])

        dq = jnp.transpose(rms_norm(dq.reshape(B, S, DIFF_HEADS, 2, HEAD_DIM), diff_qn_g[l]), (0, 2, 3, 1, 4))
        dk = jnp.transpose(rms_norm(dk.reshape(B, S, DIFF_HEADS, 2, HEAD_DIM), diff_kn_g[l]), (0, 2, 3, 1, 4))
        q1, q2 = partial_rotary(dq[:, :, 0], cos, sin), partial_rotary(dq[:, :, 1], cos, sin)
        k1, k2 = partial_rotary(dk[:, :, 0], cos, sin), partial_rotary(dk[:, :, 1], cos, sin)
        dv = jnp.transpose(dv.reshape(B, S, DIFF_HEADS, DIFF_V_DIM), (0, 2, 1, 3))
        lam_init = 0.8 - 0.6 * math.exp(-0.3 * l)
        lp = diff_lambda[l].astype(jnp.float32)
        lam = jnp.exp(jnp.sum(lp[0] * lp[1])) - jnp.exp(jnp.sum(lp[2] * lp[3])) + lam_init
        o_diff = diff_attention(q1, q2, k1, k2, dv, lam)
        o_diff = rms_norm(o_diff, diff_subln_g[l]) * (1.0 - lam_init)
        y_diff = jnp.transpose(o_diff, (0, 2, 1, 3)).reshape(B, S, DIFF_V)

        fq = jnp.transpose(rms_norm(fq.reshape(B, S, FOX_HEADS, HEAD_DIM), fox_qn_g[l]), (0, 2, 1, 3))
        fk = jnp.transpose(rms_norm(fk.reshape(B, S, FOX_HEADS, HEAD_DIM), fox_kn_g[l]), (0, 2, 1, 3))
        fv = jnp.transpose(fv.reshape(B, S, FOX_HEADS, HEAD_DIM), (0, 2, 1, 3))
        logf = jnp.transpose(jax.nn.log_sigmoid(fz.astype(jnp.float32) + fox_forget_b[l].astype(jnp.float32)), (0, 2, 1))
        o_fox = forgetting_attention(fq, fk, fv, logf)
        y_fox = jnp.transpose(o_fox, (0, 2, 1, 3)).reshape(B, S, FOX_V)

        branches = jnp.stack([y_pool, y_diff, y_fox], axis=2)
        br = jnp.einsum('bsnc,ncd->bsnd', branches, w_branch[l])
        gates = jax.nn.sigmoid(gz.reshape(B, S, N_BRANCH, D))
        merged = jnp.sum(gates * br, axis=2)
        x = x + merged @ w_out[l]

        hf = rms_norm(x, ffn_norm_g[l]).reshape(B * S, D)
        y = hierarchical_moe(hf, w_route_group[l], b_route_group[l], w_route_expert[l], b_route_expert[l],
                             moe_w_gate[l], moe_w_up[l], moe_w_down[l])
        x = x + y.reshape(B, S, D)

        hp = rms_norm(x, ple_norm_g[l])
        x = x + jax.nn.sigmoid(hp @ w_ple_gate[l]) * (p[l] @ w_ple[l])
    return x
```

```cpp
#include <hip/hip_runtime.h>
#include <cstdio>
#include <cstdint>
#include <cmath>
typedef unsigned short bf16;
constexpr int T = 16384, DM = 1024, S = 2048, NB = 8, NL = 2, INW = 6664;
constexpr float RMS_EPS = 1e-6f;
constexpr float C2 = 0.125f * 1.4426950408889634f;
constexpr size_t MiB = 1u << 20;
constexpr size_t WS_CTL = 0, CTL_BYTES = 1 * MiB;
constexpr size_t WS_SS = 1 * MiB;
constexpr size_t WS_LOGF = 2 * MiB;
constexpr size_t WS_FCUM = 2 * MiB + 512 * 1024;
constexpr size_t WS_TOKW = 3 * MiB;
constexpr size_t WS_RSTD = 3 * MiB + 256 * 1024;
constexpr size_t WS_LIST = 3 * MiB + 512 * 1024;
constexpr size_t WS_COSSIN = 5 * MiB;
constexpr size_t WS_SSB = 49 * MiB;
constexpr size_t WS_W = 6 * MiB;
constexpr size_t WS_WPLE = 52 * MiB;
constexpr size_t WS_XY = 57 * MiB;
constexpr size_t WS_PROJ = 137 * MiB;
constexpr size_t WS_STASH = 249 * MiB;
constexpr size_t WS_MERGED = WS_PROJ + 96 * MiB;
constexpr size_t WS_PB = 265 * MiB;
constexpr size_t WS_END = 273 * MiB;
constexpr int XYP = 2560, PJP = 3584;
constexpr int CW_CLS = 64;
constexpr int CW_AQ = 256;
constexpr int CW_G4 = 16384;
constexpr int CW_SPLIT3 = 24576;
constexpr int CW_MOE2 = 32768;
constexpr int CW_XCC = 40960;
constexpr int CW_GT = 131072;
constexpr int CW_MOEG = 512;
constexpr int CW_SPLIT = 5632;
constexpr int CW_SPLITX = 5888;
constexpr int CW_FQ = 6144;
constexpr int CW_BAR = 8192;
#define MK_ONE_LAUNCH 1
namespace refp {

__device__ __forceinline__ float bf2f(bf16 v) { return __uint_as_float((unsigned)v << 16); }
__device__ __forceinline__ bf16 f2b(float f) { unsigned u = __float_as_uint(f); return (bf16)((u + 0x7fffu + ((u >> 16) & 1u)) >> 16); }
__device__ __forceinline__ float wsum(float v) {
#pragma unroll
    for (int o = 1; o < 64; o <<= 1) v += __shfl_xor(v, o);
    return v;
}
__device__ __forceinline__ float wmax(float v) {
#pragma unroll
    for (int o = 1; o < 64; o <<= 1) v = fmaxf(v, __shfl_xor(v, o));
    return v;
}
__device__ __forceinline__ float row_rstd(const float* SS, int t) {
    float s = 0.f;
#pragma unroll
    for (int i = 0; i < 16; ++i) s += SS[(size_t)t * 16 + i];
    return rsqrtf(s * (1.0f / 1024.0f) + RMS_EPS);
}

__global__ void __launch_bounds__(256) k_rowstats(const float* __restrict__ xsrc, bf16* XBdst, int ldxb, float* SS, float* RSTD, float* xcopy) {
    const int t = blockIdx.x * 4 + (threadIdx.x >> 6), lane = threadIdx.x & 63;
    const float* xr = xsrc + (size_t)t * 1024;
    float s = 0.f;
    for (int j = 0; j < 16; ++j) { const int k = lane + 64 * j; const float v = xr[k]; s += v * v; XBdst[(size_t)t * ldxb + k] = f2b(v); if (xcopy) xcopy[(size_t)t * 1024 + k] = v; }
    s = wsum(s);
    if (lane < 16) SS[(size_t)t * 16 + lane] = (lane == 0) ? s : 0.f;
    if (lane == 0) RSTD[t] = rsqrtf(s * (1.0f / 1024.0f) + RMS_EPS);
}
__global__ void k_ref_rstd(const float* __restrict__ SS, float* RSTD) { const int t = blockIdx.x * blockDim.x + threadIdx.x; if (t < T) RSTD[t] = row_rstd(SS, t); }

struct XnormLoader { const float* x; const float* RS; const float* g;
    __device__ __forceinline__ float operator()(int t, int k) const { return x[(size_t)t * 1024 + k] * RS[t] * g[k]; } };
struct Bf16Loader { const bf16* A; int lda; int pad;
    __device__ __forceinline__ float operator()(int t, int k) const { return bf2f(A[(size_t)t * lda + k]); } };
struct F32Loader { const float* A; int lda; int pad;
    __device__ __forceinline__ float operator()(int t, int k) const { return A[(size_t)t * lda + k]; } };

template <class AL, class EPI>
__global__ void __launch_bounds__(256) k_ref_gemm(AL al, const float* __restrict__ W, int ldw, int N, int K, EPI epi) {
    __shared__ float sA[16][65], sB[16][65];
    const int tx = threadIdx.x & 15, ty = threadIdx.x >> 4, t0 = blockIdx.y * 64, n0 = blockIdx.x * 64;
    float acc[4][4] = {};
    for (int k0 = 0; k0 < K; k0 += 16) {
        for (int e = threadIdx.x; e < 1024; e += 256) { const int r = e >> 4, kk = e & 15; sA[kk][r] = al(t0 + r, k0 + kk); }
        for (int e = threadIdx.x; e < 1024; e += 256) { const int kk = e >> 6, c = e & 63; sB[kk][c] = (n0 + c < N) ? W[(size_t)(k0 + kk) * ldw + n0 + c] : 0.f; }
        __syncthreads();
#pragma unroll
        for (int kk = 0; kk < 16; ++kk) {
            float a[4], b[4];
#pragma unroll
            for (int i = 0; i < 4; ++i) { a[i] = sA[kk][ty * 4 + i]; b[i] = sB[kk][tx * 4 + i]; }
#pragma unroll
            for (int i = 0; i < 4; ++i)
#pragma unroll
                for (int j = 0; j < 4; ++j) acc[i][j] += a[i] * b[j];
        }
        __syncthreads();
    }
#pragma unroll
    for (int i = 0; i < 4; ++i)
#pragma unroll
        for (int j = 0; j < 4; ++j) { const int n = n0 + tx * 4 + j; if (n < N) epi(t0 + ty * 4 + i, n, acc[i][j]); }
}
struct EpiStoreF32 { float* C; int ldc; int pad; __device__ __forceinline__ void operator()(int t, int n, float v) const { C[(size_t)t * ldc + n] = v; } };
struct EpiResid { const float* xs; float* xo; __device__ __forceinline__ void operator()(int t, int n, float v) const { xo[(size_t)t * 1024 + n] = xs[(size_t)t * 1024 + n] + v; } };

__global__ void __launch_bounds__(256) k_ref_epi1(const float* __restrict__ C, int cc, int kind, const float* pool_w, const float* pool_scale,
                                                  const float* gain, int rotary, float outscale, const int* positions, bf16* PROJ) {
    __shared__ float row[256];
    const int t = blockIdx.x, j = threadIdx.x;
    row[j] = C[(size_t)t * 256 + j];
    __syncthreads();
    float out;
    if (kind == 0) {
        const int g = 2 * cc + (j >> 7), d = j & 127; float s = 0.f;
        for (int c = 0; c < 128; ++c) s += row[(j & 128) + c] * pool_w[((size_t)g * 128 + c) * 128 + d];
        out = s * pool_scale[g * 128 + d];
    } else if (kind == 1) {
        const int dim = j & 63; float v = row[j];
        const float ss = wsum(v * v);
        v = v * rsqrtf(ss * (1.0f / 64.0f) + RMS_EPS) * gain[dim];
        if (rotary) {
            const float other = __shfl_xor(v, 8);
            if (dim < 16) {
                const int i = dim & 7; const float invf = powf(500000.0f, -(float)(2 * i) / 16.0f);
                const float ang = (float)positions[t] * invf; const float c = cosf(ang), s = sinf(ang);
                v = (dim < 8) ? (v * c - other * s) : (v * c + other * s);
            }
        }
        out = v * outscale;
    } else out = row[j];
    PROJ[(size_t)t * 3584 + 256 * cc + j] = f2b(out);
}
__global__ void k_ref_logf(const float* __restrict__ C8, const float* fb, float* LOGF) {
    const int i = blockIdx.x * blockDim.x + threadIdx.x; if (i >= T * 8) return;
    const float v = C8[i] + fb[i & 7];
    LOGF[i] = fminf(v, 0.f) - log1pf(expf(-fabsf(v)));
}
__global__ void k_ref_fscan(const float* __restrict__ LOGF, float* FCUM) {
    const int i = threadIdx.x; if (i >= 64) return; const int b = i >> 3, h = i & 7; float s = 0.f;
    for (int t = 0; t < S; ++t) { s += LOGF[((size_t)b * S + t) * 8 + h]; FCUM[((size_t)b * S + t) * 8 + h] = s; }
}
__global__ void __launch_bounds__(256) k_ref_fox(const bf16* __restrict__ PROJ, const float* __restrict__ FCUM, bf16* XY) {
    __shared__ float P[4][S];
    const int w = threadIdx.x >> 6, lane = threadIdx.x & 63; const int gw = blockIdx.x * 4 + w; const int t = gw >> 3, h = gw & 7; const int b = t / S, sq = t % S;
    float q[64];
#pragma unroll
    for (int d = 0; d < 64; ++d) q[d] = bf2f(PROJ[(size_t)t * 3584 + 2048 + h * 64 + d]);
    const float Ft = FCUM[(size_t)t * 8 + h];
    float m = -INFINITY;
    for (int j = lane; j <= sq; j += 64) { const bf16* kr = PROJ + ((size_t)b * S + j) * 3584 + 2560 + h * 64; float s = 0.f;
#pragma unroll
        for (int d = 0; d < 64; ++d) s += q[d] * bf2f(kr[d]);
        s += (Ft - FCUM[((size_t)b * S + j) * 8 + h]) * 1.4426950408889634f; P[w][j] = s; m = fmaxf(m, s); }
    m = wmax(m); float l = 0.f;
    for (int j = lane; j <= sq; j += 64) { const float p = exp2f(P[w][j] - m); P[w][j] = p; l += p; }
    l = wsum(l);
    __syncthreads();
    float o = 0.f;
    for (int j = 0; j <= sq; ++j) o += P[w][j] * bf2f(PROJ[((size_t)b * S + j) * 3584 + 3072 + h * 64 + lane]);
    XY[(size_t)t * 2560 + 1024 + h * 64 + lane] = f2b(o / l);
}
__global__ void __launch_bounds__(128) k_ref_diff(const bf16* __restrict__ PROJ, const float* __restrict__ lamp, const float* __restrict__ gsub, float lam_init, bf16* XY) {
    __shared__ float P[2][2][S];
    const int w = threadIdx.x >> 6, lane = threadIdx.x & 63; const int gw = blockIdx.x * 2 + w; const int t = gw >> 2, h = gw & 3; const int b = t / S, sq = t % S;
    float lam; { const float a = wsum(lamp[lane] * lamp[64 + lane]), c = wsum(lamp[128 + lane] * lamp[192 + lane]); lam = expf(a) - expf(c) + lam_init; }
    float linv[2];
    for (int c = 0; c < 2; ++c) {
        float q[64];
#pragma unroll
        for (int d = 0; d < 64; ++d) q[d] = bf2f(PROJ[(size_t)t * 3584 + 512 + (h * 2 + c) * 64 + d]);
        float m = -INFINITY;
        for (int j = lane; j <= sq; j += 64) { const bf16* kr = PROJ + ((size_t)b * S + j) * 3584 + 1024 + (h * 2 + c) * 64; float s = 0.f;
    #pragma unroll
        for (int d = 0; d < 64; ++d) s += q[d] * bf2f(kr[d]);
            P[w][c][j] = s; m = fmaxf(m, s); }
        m = wmax(m); float l = 0.f;
        for (int j = lane; j <= sq; j += 64) { const float p = exp2f(P[w][c][j] - m); P[w][c][j] = p; l += p; }
        linv[c] = 1.0f / wsum(l);
    }
    __syncthreads();
    float o0 = 0.f, o1 = 0.f;
    for (int j = 0; j <= sq; ++j) { const float a = P[w][0][j] * linv[0] - lam * P[w][1][j] * linv[1]; const bf16* vr = PROJ + ((size_t)b * S + j) * 3584 + 1536 + h * 128;
        o0 += a * bf2f(vr[lane]); o1 += a * bf2f(vr[64 + lane]); }
    const float ss = wsum(o0 * o0 + o1 * o1); const float r = rsqrtf(ss * (1.0f / 128.0f) + RMS_EPS) * (1.0f - lam_init);
    XY[(size_t)t * 2560 + 512 + h * 128 + lane] = f2b(o0 * r * gsub[lane]);
    XY[(size_t)t * 2560 + 512 + h * 128 + 64 + lane] = f2b(o1 * r * gsub[64 + lane]);
}
__global__ void k_ref_pool(const bf16* __restrict__ PROJ, bf16* XY) {
    const int i = blockIdx.x * blockDim.x + threadIdx.x; if (i >= T * 512) return; const int t = i >> 9, j = i & 511; const int g = j >> 7, w = 2 << g, s = t % S;
    const int cnt = min(s + 1, w); float a = 0.f;
    for (int k = 0; k < cnt; ++k) a += bf2f(PROJ[(size_t)(t - k) * 3584 + j]);
    XY[(size_t)t * 2560 + j] = f2b(a / (float)cnt - bf2f(PROJ[(size_t)t * 3584 + j]));
}
__global__ void __launch_bounds__(256) k_ref_gemm2(const float* __restrict__ x, const float* __restrict__ SS, const float* __restrict__ g, const float* __restrict__ w_in_l,
                                                   const float* __restrict__ w_branch_l, const bf16* __restrict__ XY, bf16* MERGED) {
    __shared__ float sA[16][65], sB[16][65];
    const int tx = threadIdx.x & 15, ty = threadIdx.x >> 4, t0 = blockIdx.y * 64, n0 = blockIdx.x * 64;
    float mg[4][4] = {};
    for (int n = 0; n < 3; ++n) {
        float ag[4][4] = {}, ab[4][4] = {};
        for (int pass = 0; pass < 2; ++pass) {
            const int K = pass == 0 ? 1024 : 512;
            for (int k0 = 0; k0 < K; k0 += 16) {
                for (int e = threadIdx.x; e < 1024; e += 256) { const int r = e >> 4, kk = e & 15; const int t = t0 + r, k = k0 + kk;
                    sA[kk][r] = pass == 0 ? x[(size_t)t * 1024 + k] * SS[t] * g[k] : bf2f(XY[(size_t)t * 2560 + 512 * n + k]); }
                for (int e = threadIdx.x; e < 1024; e += 256) { const int kk = e >> 6, c = e & 63; const int k = k0 + kk;
                    sB[kk][c] = pass == 0 ? w_in_l[(size_t)k * INW + 3592 + n * 1024 + n0 + c] : w_branch_l[((size_t)n * 512 + k) * 1024 + n0 + c]; }
                __syncthreads();
#pragma unroll
                for (int kk = 0; kk < 16; ++kk) {
                    float a[4], b[4];
#pragma unroll
                    for (int i = 0; i < 4; ++i) { a[i] = sA[kk][ty * 4 + i]; b[i] = sB[kk][tx * 4 + i]; }
#pragma unroll
                    for (int i = 0; i < 4; ++i)
#pragma unroll
                        for (int j = 0; j < 4; ++j) { if (pass == 0) ag[i][j] += a[i] * b[j]; else ab[i][j] += a[i] * b[j]; }
                }
                __syncthreads();
            }
        }
#pragma unroll
        for (int i = 0; i < 4; ++i)
#pragma unroll
            for (int j = 0; j < 4; ++j) mg[i][j] += ab[i][j] / (1.0f + expf(-ag[i][j]));
    }
#pragma unroll
    for (int i = 0; i < 4; ++i)
#pragma unroll
        for (int j = 0; j < 4; ++j) MERGED[(size_t)(t0 + ty * 4 + i) * 1024 + n0 + tx * 4 + j] = f2b(mg[i][j]);
}
__global__ void __launch_bounds__(256) k_ref_moe(float* X, const float* __restrict__ SS, const float* __restrict__ g, const int* __restrict__ cls_cnt, const int* __restrict__ LIST,
                                                 const float* __restrict__ TOKW, const float* __restrict__ wg_l, const float* __restrict__ wu_l, const float* __restrict__ wd_l) {
    __shared__ float h[8][1024]; __shared__ float act[8][512]; __shared__ int tok[8];
    const int cls = blockIdx.y, n_c = cls_cnt[cls], base = blockIdx.x * 8; if (base >= n_c) return;
    const int nt = min(8, n_c - base), tid = threadIdx.x;
    if (tid < 8) tok[tid] = tid < nt ? LIST[(size_t)cls * T + base + tid] : -1;
    __syncthreads();
    for (int e = tid; e < 8 * 1024; e += 256) { const int i = e >> 10, k = e & 1023; const int t = tok[i]; h[i][k] = t >= 0 ? X[(size_t)t * 1024 + k] * SS[t] * g[k] : 0.f; }
    __syncthreads();
    const int grp = cls / 6, pr = cls % 6; const int pa = pr < 3 ? 0 : (pr < 5 ? 1 : 2), pb = pr < 3 ? pr + 1 : (pr < 5 ? pr - 1 : 3); const int ea = grp * 4 + pa, eb = grp * 4 + pb;
    for (int s = 0; s < 2; ++s) { const int e = s ? eb : ea; float ga[8], ua[8];
#pragma unroll
        for (int i = 0; i < 8; ++i) { ga[i] = 0.f; ua[i] = 0.f; }
        const float* wg = wg_l + (size_t)e * 1024 * 256 + tid; const float* wu = wu_l + (size_t)e * 1024 * 256 + tid;
        for (int k = 0; k < 1024; ++k) { const float a = wg[(size_t)k * 256], u = wu[(size_t)k * 256];
#pragma unroll
            for (int i = 0; i < 8; ++i) { ga[i] += h[i][k] * a; ua[i] += h[i][k] * u; } }
#pragma unroll
        for (int i = 0; i < 8; ++i) { const int t = tok[i]; const float w = t >= 0 ? TOKW[(size_t)t * 4 + s] : 0.f; act[i][s * 256 + tid] = ga[i] / (1.0f + expf(-ga[i])) * ua[i] * w; } }
    __syncthreads();
    for (int j = 0; j < 4; ++j) { const int n = tid + 256 * j; float y[8];
#pragma unroll
        for (int i = 0; i < 8; ++i) y[i] = 0.f;
        for (int s = 0; s < 2; ++s) { const int e = s ? eb : ea; const float* wd = wd_l + (size_t)e * 256 * 1024 + n;
            for (int f = 0; f < 256; ++f) { const float w = wd[(size_t)f * 1024];
#pragma unroll
                for (int i = 0; i < 8; ++i) y[i] += act[i][s * 256 + f] * w; } }
#pragma unroll
        for (int i = 0; i < 8; ++i) { const int t = tok[i]; if (t >= 0) X[(size_t)t * 1024 + n] += y[i]; } }
}
__global__ void __launch_bounds__(256) k_ref_ple(const float* __restrict__ x, const float* __restrict__ SS, const float* __restrict__ g, const float* __restrict__ wgate_l,
                                                 const float* __restrict__ p_l, const float* __restrict__ wple_l, float* xo) {
    __shared__ float sA[16][65], sB[16][65];
    const int tx = threadIdx.x & 15, ty = threadIdx.x >> 4, t0 = blockIdx.y * 64, n0 = blockIdx.x * 64;
    float ag[4][4] = {}, ab[4][4] = {};
    for (int pass = 0; pass < 2; ++pass) {
        const int K = pass == 0 ? 1024 : 256;
        for (int k0 = 0; k0 < K; k0 += 16) {
            for (int e = threadIdx.x; e < 1024; e += 256) { const int r = e >> 4, kk = e & 15; const int t = t0 + r, k = k0 + kk;
                sA[kk][r] = pass == 0 ? x[(size_t)t * 1024 + k] * SS[t] * g[k] : p_l[(size_t)t * 256 + k]; }
            for (int e = threadIdx.x; e < 1024; e += 256) { const int kk = e >> 6, c = e & 63; const int k = k0 + kk;
                sB[kk][c] = pass == 0 ? wgate_l[(size_t)k * 1024 + n0 + c] : wple_l[(size_t)k * 1024 + n0 + c]; }
            __syncthreads();
#pragma unroll
            for (int kk = 0; kk < 16; ++kk) {
                float a[4], b[4];
#pragma unroll
                for (int i = 0; i < 4; ++i) { a[i] = sA[kk][ty * 4 + i]; b[i] = sB[kk][tx * 4 + i]; }
#pragma unroll
                for (int i = 0; i < 4; ++i)
#pragma unroll
                    for (int j = 0; j < 4; ++j) { if (pass == 0) ag[i][j] += a[i] * b[j]; else ab[i][j] += a[i] * b[j]; }
            }
            __syncthreads();
        }
    }
#pragma unroll
    for (int i = 0; i < 4; ++i)
#pragma unroll
        for (int j = 0; j < 4; ++j) { const size_t o = (size_t)(t0 + ty * 4 + i) * 1024 + n0 + tx * 4 + j; xo[o] = x[o] + ab[i][j] / (1.0f + expf(-ag[i][j])); }
}
}
__device__ __forceinline__ int route_decide(const float (&dg)[4], const float (&de)[16], const float rstd, const float* __restrict__ brg, const float* __restrict__ bre, float& wa, float& wb) {
    float lg[4]; int gi = 0; float lmax;
#pragma unroll
    for (int e = 0; e < 4; ++e) lg[e] = rstd * dg[e] + brg[e];
    lmax = lg[0];
#pragma unroll
    for (int e = 1; e < 4; ++e) if (lg[e] > lmax) { lmax = lg[e]; gi = e; }
    float den = 0.f;
#pragma unroll
    for (int e = 0; e < 4; ++e) den += expf(lg[e] - lmax);
    const float gp = 1.0f / den;
    float el[4] = {0.f, 0.f, 0.f, 0.f};
#pragma unroll
    for (int gg = 0; gg < 4; ++gg)
#pragma unroll
        for (int e = 0; e < 4; ++e) if (gg == gi) el[e] = rstd * de[gg * 4 + e] + bre[gg * 4 + e];
    int i1 = 0; float m1 = el[0];
#pragma unroll
    for (int e = 1; e < 4; ++e) if (el[e] > m1) { m1 = el[e]; i1 = e; }
    int i2 = -1; float m2 = -INFINITY;
#pragma unroll
    for (int e = 0; e < 4; ++e) if (e != i1 && el[e] > m2) { m2 = el[e]; i2 = e; }
    const float r2 = expf(m2 - m1); const float w1 = gp / (1.0f + r2), w2 = gp * r2 / (1.0f + r2);
    const int a = min(i1, i2), b = max(i1, i2); const int pr = (a == 0) ? (b - 1) : ((a == 1) ? (b + 1) : 5); const int cls = gi * 6 + pr;
    wa = i1 == a ? w1 : w2; wb = i1 == a ? w2 : w1;
    return cls;
}
__device__ __forceinline__ int route_core(int t, int lane, const float* __restrict__ X, const float* __restrict__ g, const float* __restrict__ wrg, const float* __restrict__ brg,
                                          const float* __restrict__ wre, const float* __restrict__ bre, float* TOKW) {
    float ss = 0.f, dg[4] = {0.f, 0.f, 0.f, 0.f}, de[16];
#pragma unroll
    for (int e = 0; e < 16; ++e) de[e] = 0.f;
#pragma unroll 4
    for (int i = 0; i < 16; ++i) { const int k = lane + 64 * i; const float xv = X[(size_t)t * 1024 + k]; ss += xv * xv; const float h = xv * g[k];
        const float4 a = *(const float4*)(wrg + (size_t)k * 4); dg[0] += h * a.x; dg[1] += h * a.y; dg[2] += h * a.z; dg[3] += h * a.w;
#pragma unroll
        for (int q = 0; q < 4; ++q) { const float4 b = *(const float4*)(wre + (size_t)k * 16 + 4 * q); de[4 * q] += h * b.x; de[4 * q + 1] += h * b.y; de[4 * q + 2] += h * b.z; de[4 * q + 3] += h * b.w; } }
    ss = refp::wsum(ss);
#pragma unroll
    for (int e = 0; e < 4; ++e) dg[e] = refp::wsum(dg[e]);
#pragma unroll
    for (int e = 0; e < 16; ++e) de[e] = refp::wsum(de[e]);
    const float rstd = rsqrtf(ss * (1.0f / 1024.0f) + RMS_EPS);
    float wa, wb; const int cls = route_decide(dg, de, rstd, brg, bre, wa, wb);
    if (lane == 0) *(float4*)(TOKW + (size_t)t * 4) = make_float4(wa, wb, rstd, 0.f);
    return cls;
}
__device__ __forceinline__ void route_token(int t, int lane, const float* __restrict__ X, const float* __restrict__ g, const float* __restrict__ wrg, const float* __restrict__ brg,
                                            const float* __restrict__ wre, const float* __restrict__ bre, unsigned* cls_cnt, int* LIST, float* TOKW) {
    const int cls = route_core(t, lane, X, g, wrg, brg, wre, bre, TOKW);
    if (lane == 0) { const unsigned pos = atomicAdd(cls_cnt + cls, 1u); LIST[(size_t)cls * T + pos] = t; }
}
__global__ void __launch_bounds__(256) k_route(const float* X, const float* g, const float* wrg, const float* brg, const float* wre, const float* bre, unsigned* cls_cnt, int* LIST, float* TOKW) {
    const int t = blockIdx.x * 4 + (threadIdx.x >> 6);
    route_token(t, threadIdx.x & 63, X, g, wrg, brg, wre, bre, cls_cnt, LIST, TOKW);
}

namespace pg8 {
#define PG8_LAS __attribute__((address_space(3)))
typedef short bf16x8 __attribute__((ext_vector_type(8)));
typedef float f32x4 __attribute__((ext_vector_type(4)));
typedef unsigned u32x4 __attribute__((ext_vector_type(4)));
typedef int i32x4 __attribute__((ext_vector_type(4)));
typedef int i32x8 __attribute__((ext_vector_type(8)));
__device__ __forceinline__ i32x8 cat8(bf16x8 lo, bf16x8 hi) { const i32x4 a = __builtin_bit_cast(i32x4, lo), b = __builtin_bit_cast(i32x4, hi); return __builtin_shufflevector(a, b, 0, 1, 2, 3, 4, 5, 6, 7); }
constexpr int BM = 256, BK = 64, HALF = 128, HTB = HALF * BK * 2, STAGE_BYTES = 8 * HTB;

__host__ __device__ __forceinline__ int lds_byte(int r, int c) { const int st = (r >> 4) * 2 + (c >> 5), rr = r & 15, cc = c & 31, ob = rr * 64 + cc * 2; return st * 1024 + (ob ^ (((ob >> 9) & 1) << 5)); }
__host__ __device__ __forceinline__ void stage_rc(int b, int& R, int& C) { const int st = b / 1024, sb = b % 1024, swz = sb ^ (((sb >> 9) & 1) << 5); R = (st >> 1) * 16 + swz / 64; C = (st & 1) * 32 + (swz % 64) / 2; }
__host__ __device__ __forceinline__ int perm32(int rho) { const int n = rho >> 4, i = rho & 15; return 8 * (i >> 2) + 4 * n + (i & 3); }

struct Step { const char* A; const char* B; const int* rows; int nt, pm, pn, aux, nvalid, zero_after; };
__device__ __forceinline__ int rfl(int v) { return __builtin_amdgcn_readfirstlane(v); }
template <class P> __device__ __forceinline__ P rflp(P p) { const unsigned long long u = (unsigned long long)p; const unsigned lo = (unsigned)__builtin_amdgcn_readfirstlane((int)(unsigned)u), hi = (unsigned)__builtin_amdgcn_readfirstlane((int)(unsigned)(u >> 32)); return (P)(((unsigned long long)hi << 32) | lo); }
__device__ __forceinline__ void step_uniform(Step& s, int& ok) {
    s.A = rflp(s.A); s.B = rflp(s.B); s.rows = rflp(s.rows); s.nt = rfl(s.nt); s.pm = rfl(s.pm); s.pn = rfl(s.pn); s.aux = rfl(s.aux); s.nvalid = rfl(s.nvalid); s.zero_after = rfl(s.zero_after); ok = rfl(ok);
    asm volatile("" : "+s"(ok), "+s"(s.A), "+s"(s.B), "+s"(s.nt), "+s"(s.aux));
}

template <class Sched, class Epi, bool GATHER, bool ALIGN_EPI, bool F8 = false>
__device__ __forceinline__ void gemm_phase(const int tid, PG8_LAS unsigned char* lds, const unsigned lda, const unsigned ldb, const Sched& S, const Epi& E) {
    const int wid = __builtin_amdgcn_readfirstlane(tid >> 6), lane = tid & 63, wr = wid >> 2, wc = wid & 3, fr = lane & 15, fq = lane >> 4;
    int Rr[2], Cc[2]; unsigned voffB[2], cOA[2][2], nOA[2][2];
#pragma unroll
    for (int i = 0; i < 2; ++i) { stage_rc(tid * 16 + i * 8192, Rr[i], Cc[i]); const int Rb = (Rr[i] & ~31) + perm32(Rr[i] & 31); voffB[i] = (unsigned)Rb * ldb + (unsigned)Cc[i] * 2u; }
    const size_t kstep = (size_t)(BK * 2);
    const size_t hstepB = (size_t)HALF * ldb;
    const unsigned ldsw = (unsigned)wid * 1024u;
    const int aoff = lds_byte(wr * 64 + fr, fq * 8), boff = lds_byte(wc * 32 + fr, fq * 8);
#define PG8_SA(b, h) (((b) * 2 + (h)) * HTB)
#define PG8_SB(b, h) ((4 + (b) * 2 + (h)) * HTB)
#define PG8_STAGE_B(bufoff, gbase) do { _Pragma("unroll") for (int _i = 0; _i < 2; ++_i) \
        __builtin_amdgcn_global_load_lds((const unsigned*)((const char*)(gbase) + voffB[_i]), (PG8_LAS unsigned*)(lds + (bufoff) + ldsw + _i * 8192), 16, 0, 0); } while (0)
#define PG8_STAGE_A(bufoff, gbase, o0, o1) do { \
        __builtin_amdgcn_global_load_lds((const unsigned*)((const char*)(gbase) + (o0)), (PG8_LAS unsigned*)(lds + (bufoff) + ldsw), 16, 0, 0); \
        __builtin_amdgcn_global_load_lds((const unsigned*)((const char*)(gbase) + (o1)), (PG8_LAS unsigned*)(lds + (bufoff) + ldsw + 8192), 16, 0, 0); } while (0)
#define PG8_LDA(dst, b, h) do { _Pragma("unroll") for (int m = 0; m < 4; ++m) _Pragma("unroll") for (int k = 0; k < 2; ++k) dst[m][k] = *(const PG8_LAS bf16x8*)(lds + PG8_SA(b, h) + aoff + m * 2048 + k * 1024); } while (0)
#define PG8_LDB(dst, b, h) do { _Pragma("unroll") for (int n = 0; n < 2; ++n) _Pragma("unroll") for (int k = 0; k < 2; ++k) dst[n][k] = *(const PG8_LAS bf16x8*)(lds + PG8_SB(b, h) + boff + n * 2048 + k * 1024); } while (0)
#define PG8_MMA(ai, bj, At, Bt) do { __builtin_amdgcn_s_setprio(1); \
        if constexpr (F8) { _Pragma("unroll") for (int m = 0; m < 4; ++m) _Pragma("unroll") for (int n = 0; n < 2; ++n) \
            asm volatile("v_mfma_scale_f32_16x16x128_f8f6f4 %0, %1, %2, %0, %3, %3 op_sel_hi:[0,0,0]" : "+v"(acc[ai][bj][m][n]) : "v"(cat8(Bt[n][0], Bt[n][1])), "v"(cat8(At[m][0], At[m][1])), "v"(f8scale)); } \
        else { _Pragma("unroll") for (int m = 0; m < 4; ++m) _Pragma("unroll") for (int n = 0; n < 2; ++n) _Pragma("unroll") for (int k = 0; k < 2; ++k) \
            acc[ai][bj][m][n] = __builtin_amdgcn_mfma_f32_16x16x32_bf16(Bt[n][k], At[m][k], acc[ai][bj][m][n], 0, 0, 0); } \
        __builtin_amdgcn_s_setprio(0); } while (0)
#define PG8_WAIT_V(n) asm volatile("s_waitcnt vmcnt(" #n ")" ::: "memory")
#define PG8_WAIT_L(n) asm volatile("s_waitcnt lgkmcnt(" #n ")" ::: "memory")
#define PG8_BAR __builtin_amdgcn_s_barrier()
#define PG8_SCHED __builtin_amdgcn_sched_barrier(0)
#define PG8_AOFFS(dst, st) do { _Pragma("unroll") for (int _h = 0; _h < 2; ++_h) _Pragma("unroll") for (int _i = 0; _i < 2; ++_i) { \
        int _row = Rr[_i] + 128 * _h; if (GATHER) { _row = (st).rows[_row]; _row = _row < 0 ? 0 : _row; } \
        dst[_h][_i] = (unsigned)_row * lda + (unsigned)Cc[_i] * 2u; } } while (0)
    int f8scale = 0x7F7F7F7F; if constexpr (F8) asm volatile("" : "+v"(f8scale));
    Step cur, nxt; int ui = 0;
    { int ok_ = S.next(0, cur) ? 1 : 0; step_uniform(cur, ok_); if (!ok_) return; }
    f32x4 acc[2][2][4][2];
#pragma unroll
    for (int a = 0; a < 2; ++a)
#pragma unroll
        for (int b = 0; b < 2; ++b)
#pragma unroll
            for (int m = 0; m < 4; ++m)
#pragma unroll
                for (int n = 0; n < 2; ++n) acc[a][b][m][n] = (f32x4){0.f, 0.f, 0.f, 0.f};
    bf16x8 At[4][2], B0[2][2], B1[2][2];
    PG8_AOFFS(cOA, cur);
    const char* cA = cur.A; const char* cB = cur.B;
    PG8_STAGE_B(PG8_SB(0, 0), cB); PG8_STAGE_B(PG8_SB(0, 1), cB + hstepB); PG8_STAGE_A(PG8_SA(0, 0), cA, cOA[0][0], cOA[0][1]); PG8_STAGE_A(PG8_SA(0, 1), cA, cOA[1][0], cOA[1][1]);
    if (wr == 1) PG8_BAR;
    PG8_WAIT_V(2); PG8_BAR;
    PG8_STAGE_B(PG8_SB(1, 0), cB + kstep); PG8_STAGE_A(PG8_SA(1, 0), cA + kstep, cOA[0][0], cOA[0][1]); PG8_STAGE_B(PG8_SB(1, 1), cB + hstepB + kstep);
    PG8_WAIT_V(6); PG8_BAR;
#pragma clang loop unroll(disable)
    for (;;) {
        bool has_next = S.next(ui + 1, nxt);
        { int hn_ = has_next ? 1 : 0; step_uniform(nxt, hn_); has_next = hn_ != 0; }
        asm volatile("" : "+v"(voffB[0]), "+v"(voffB[1]));
        const char* nA = has_next ? nxt.A : cA; const char* nB = has_next ? nxt.B : cB;
        if (GATHER) { if (has_next) { PG8_AOFFS(nOA, nxt); } else {
#pragma unroll
            for (int _h = 0; _h < 2; ++_h)
#pragma unroll
                for (int _i = 0; _i < 2; ++_i) nOA[_h][_i] = cOA[_h][_i]; } }
        const int nt = cur.nt;
#pragma clang loop unroll(disable)
        for (int t = 0; t < nt; t += 2) {
            const bool last = (t == nt - 2);
            const char* a1 = cA + (size_t)(t + 1) * kstep;
            const char* a2 = last ? nA : cA + (size_t)(t + 2) * kstep; const char* b2 = last ? nB : cB + (size_t)(t + 2) * kstep;
            const char* a3 = a2 + kstep; const char* b3 = b2 + kstep;
            unsigned o00, o01, o10, o11;
            if (GATHER) { o00 = last ? nOA[0][0] : cOA[0][0]; o01 = last ? nOA[0][1] : cOA[0][1]; o10 = last ? nOA[1][0] : cOA[1][0]; o11 = last ? nOA[1][1] : cOA[1][1]; }
            else { o00 = cOA[0][0]; o01 = cOA[0][1]; o10 = cOA[1][0]; o11 = cOA[1][1]; }
            PG8_LDB(B0, 0, 0); PG8_LDB(B1, 0, 1); PG8_SCHED; PG8_LDA(At, 0, 0); PG8_STAGE_A(PG8_SA(1, 1), a1, cOA[1][0], cOA[1][1]);
            PG8_WAIT_V(8); PG8_WAIT_L(0); PG8_BAR; PG8_MMA(0, 0, At, B0); PG8_MMA(0, 1, At, B1); PG8_BAR; PG8_SCHED;
            PG8_LDA(At, 0, 1); PG8_STAGE_B(PG8_SB(0, 0), b2); PG8_STAGE_B(PG8_SB(0, 1), b2 + hstepB); PG8_STAGE_A(PG8_SA(0, 0), a2, o00, o01);
            PG8_WAIT_V(8); PG8_WAIT_L(0); PG8_BAR; PG8_MMA(1, 0, At, B0); PG8_MMA(1, 1, At, B1); PG8_BAR; PG8_SCHED;
            PG8_LDB(B0, 1, 0); PG8_LDB(B1, 1, 1); PG8_SCHED; PG8_LDA(At, 1, 0); PG8_STAGE_A(PG8_SA(0, 1), a2, o10, o11);
            PG8_WAIT_V(8); PG8_WAIT_L(0); PG8_BAR; PG8_MMA(0, 0, At, B0); PG8_MMA(0, 1, At, B1); PG8_BAR; PG8_SCHED;
            PG8_LDA(At, 1, 1); PG8_STAGE_B(PG8_SB(1, 0), b3); PG8_STAGE_B(PG8_SB(1, 1), b3 + hstepB); PG8_STAGE_A(PG8_SA(1, 0), a3, o00, o01);
            PG8_WAIT_V(8); PG8_WAIT_L(0); PG8_BAR; PG8_MMA(1, 0, At, B0); PG8_MMA(1, 1, At, B1); PG8_BAR; PG8_SCHED;
        }
        if constexpr (F8) { asm volatile("s_nop 15\n\ts_nop 15" ::: "memory"); }
        if constexpr (ALIGN_EPI) { if (wr == 0) PG8_BAR; }
        { int ln_; asm volatile("v_mbcnt_lo_u32_b32 %0, -1, 0\n\tv_mbcnt_hi_u32_b32 %0, -1, %0" : "=v"(ln_));
          E(acc, cur, wr, wc, ln_ & 15, ln_ >> 4); }
        if (!has_next) break;
        if (cur.zero_after) {
#pragma unroll
            for (int a = 0; a < 2; ++a)
#pragma unroll
                for (int b = 0; b < 2; ++b)
#pragma unroll
                    for (int m = 0; m < 4; ++m)
#pragma unroll
                        for (int n = 0; n < 2; ++n) acc[a][b][m][n] = (f32x4){0.f, 0.f, 0.f, 0.f};
        }
        cur = nxt; cA = nA; cB = nB; ++ui;
        if (GATHER) {
#pragma unroll
            for (int _h = 0; _h < 2; ++_h)
#pragma unroll
                for (int _i = 0; _i < 2; ++_i) cOA[_h][_i] = nOA[_h][_i]; }
        if constexpr (ALIGN_EPI) { if (wr == 1) PG8_BAR; }
    }
    PG8_WAIT_V(0);
    if constexpr (!ALIGN_EPI) { if (wr == 0) PG8_BAR; }
    PG8_BAR;
#undef PG8_SA
#undef PG8_SB
#undef PG8_STAGE_A
#undef PG8_STAGE_B
#undef PG8_LDA
#undef PG8_LDB
#undef PG8_MMA
#undef PG8_WAIT_V
#undef PG8_WAIT_L
#undef PG8_BAR
#undef PG8_SCHED
#undef PG8_AOFFS
}
}
#include <hip/hip_bf16.h>
namespace attn_body {
using hbf16=__hip_bfloat16;
using bf16x8=__attribute__((ext_vector_type(8)))short;
using s16x4=__attribute__((ext_vector_type(4)))short;
using f32x16=__attribute__((ext_vector_type(16)))float;
using u32x4=__attribute__((ext_vector_type(4)))unsigned;
constexpr int SEQ=2048,D=64,DM=3584;
constexpr int NW=8,QBLK=32,QB=QBLK*NW,KVBLK=64,NQB=SEQ/QB;
__device__ __forceinline__ int crow(int r,int hi){return (r&3)+8*(r>>2)+4*hi;}
#define SBAR() __builtin_amdgcn_sched_barrier(0)
__device__ __forceinline__ void cmask(f32x16&p0,f32x16&p1,int jb,int qrel,int hi){
  const float NEG=-INFINITY; int kb=64*jb+4*hi;
  #pragma unroll
  for(int r=0;r<16;++r){int kv=kb+(r&3)+8*(r>>2); if(kv>qrel)p0[r]=NEG; if(kv+32>qrel)p1[r]=NEG;}
}

constexpr int NSLOT=3, SLOTB=8192;
constexpr int LDS_K=0, LDS_V=NSLOT*SLOTB, LDS_WS=2*NSLOT*SLOTB, LDS_OST=LDS_WS+NW*64*4, LDS_BIAS=LDS_OST+NW*4096, LDS_SSQ=LDS_BIAS+SEQ*4, LDS_BYTES=LDS_SSQ+NW*32*4;
constexpr float C2=0.125f*1.4426950408889634f;
__device__ __forceinline__ void glds16(const void*gsrc,unsigned lds_dst){unsigned keep;
  asm volatile("s_mov_b32 %0, m0\n\ts_mov_b32 m0, %2\n\ts_nop 0\n\tglobal_load_lds_dwordx4 %1, off\n\ts_mov_b32 m0, %0":"=&s"(keep):"v"(gsrc),"s"(lds_dst):"memory");}
__device__ __forceinline__ float max3f(float a,float b,float c){float r;asm("v_max3_f32 %0, %1, %2, %3":"=v"(r):"v"(a),"v"(b),"v"(c));return r;}
__device__ __forceinline__ float max2f(float a,float b){float r;asm("v_max_f32_e32 %0, %1, %2":"=v"(r):"v"(a),"v"(b));return r;}
__device__ __forceinline__ float fadd_s(float a,float b){float r;asm("v_add_f32_e32 %0, %1, %2":"=v"(r):"v"(a),"v"(b));return r;}
__device__ __forceinline__ float fsub_s(float a,float b){float r;asm("v_sub_f32_e32 %0, %1, %2":"=v"(r):"v"(a),"v"(b));return r;}
typedef float f32x2_t __attribute__((ext_vector_type(2))); typedef float f32x4_t __attribute__((ext_vector_type(4))); typedef __bf16 bf16x2_t __attribute__((ext_vector_type(2)));
__device__ __forceinline__ unsigned cvtpk_s(float lo,float hi){f32x2_t v={lo,hi};bf16x2_t b=__builtin_convertvector(v,bf16x2_t);return __builtin_bit_cast(unsigned,b);}
#define WAIT_BAR(N) asm volatile("s_waitcnt vmcnt(" #N ") lgkmcnt(0)\n\ts_barrier":::"memory")

__device__ __forceinline__ void qkt(f32x16&p0,f32x16&p1,const char*Kslot,const bf16x8*qr,const f32x16&negm,int r32,int hi){
  const char*kb=Kslot+hi*1024+r32*16;
  #pragma unroll
  for(int d0=0;d0<4;++d0){
    const bf16x8 b0=*reinterpret_cast<const bf16x8*>(kb+d0*2048);
    const bf16x8 b1=*reinterpret_cast<const bf16x8*>(kb+d0*2048+512);
    if(d0==0){p0=__builtin_amdgcn_mfma_f32_32x32x16_bf16(b0,qr[0],negm,0,0,0);p1=__builtin_amdgcn_mfma_f32_32x32x16_bf16(b1,qr[0],negm,0,0,0);}
    else{p0=__builtin_amdgcn_mfma_f32_32x32x16_bf16(b0,qr[d0],p0,0,0,0);p1=__builtin_amdgcn_mfma_f32_32x32x16_bf16(b1,qr[d0],p1,0,0,0);}}
}
typedef __attribute__((address_space(3))) const char* lds_cptr;
typedef short v4i16_t __attribute__((ext_vector_type(4)));
__device__ __forceinline__ void kload8(bf16x8*kf,lds_cptr kp){
  kf[0]=*(const __attribute__((address_space(3))) bf16x8*)(kp);      kf[1]=*(const __attribute__((address_space(3))) bf16x8*)(kp+512);
  kf[2]=*(const __attribute__((address_space(3))) bf16x8*)(kp+2048); kf[3]=*(const __attribute__((address_space(3))) bf16x8*)(kp+2560);
  kf[4]=*(const __attribute__((address_space(3))) bf16x8*)(kp+4096); kf[5]=*(const __attribute__((address_space(3))) bf16x8*)(kp+4608);
  kf[6]=*(const __attribute__((address_space(3))) bf16x8*)(kp+6144); kf[7]=*(const __attribute__((address_space(3))) bf16x8*)(kp+6656);
}
__device__ __forceinline__ void kload2(bf16x8*kf,lds_cptr kp,int j){ kf[2*j]=*(const __attribute__((address_space(3))) bf16x8*)(kp+j*2048); kf[2*j+1]=*(const __attribute__((address_space(3))) bf16x8*)(kp+j*2048+512); }
__device__ __forceinline__ s16x4 vtr(lds_cptr p){ return __builtin_bit_cast(s16x4,__builtin_amdgcn_ds_read_tr16_b64_v4i16((__attribute__((address_space(3))) v4i16_t*)p)); }
__device__ __forceinline__ float rowmax(const f32x16&p0,const f32x16&p1){
  float a=max3f(p0[0],p0[1],p1[0]),b=max3f(p0[2],p0[3],p1[1]);a=max3f(a,p1[2],p1[3]);
  #pragma unroll
  for(int r=4;r<16;r+=4){a=max3f(a,p0[r],p0[r+1]);b=max3f(b,p0[r+2],p0[r+3]);a=max3f(a,p1[r],p1[r+1]);b=max3f(b,p1[r+2],p1[r+3]);}
  const float m=max2f(a,b);
  auto rr=__builtin_amdgcn_permlane32_swap(__float_as_uint(m),__float_as_uint(m),false,false);
  return max2f(__uint_as_float(rr[0]),__uint_as_float(rr[1]));
}
__device__ __forceinline__ void pv(f32x16*o,int vb,bf16x8 pa0,bf16x8 pa1,bf16x8 pa2,bf16x8 pa3){
  #pragma unroll
  for(int d0=0;d0<2;++d0){s16x4 lo[4],hi[4];
    #pragma unroll
    for(int ks=0;ks<4;++ks){
      asm volatile("ds_read_b64_tr_b16 %0,%1 offset:%c2":"=&v"(lo[ks]):"v"(vb),"i"(d0*4096+ks*1024):"memory");
      asm volatile("ds_read_b64_tr_b16 %0,%1 offset:%c2":"=&v"(hi[ks]):"v"(vb),"i"(d0*4096+ks*1024+512):"memory");}
    asm volatile("s_waitcnt lgkmcnt(0)":::"memory");SBAR();
    #define PK(k) (bf16x8){lo[k][0],lo[k][1],lo[k][2],lo[k][3],hi[k][0],hi[k][1],hi[k][2],hi[k][3]}
    o[d0]=__builtin_amdgcn_mfma_f32_32x32x16_bf16(pa0,PK(0),o[d0],0,0,0);
    o[d0]=__builtin_amdgcn_mfma_f32_32x32x16_bf16(pa1,PK(1),o[d0],0,0,0);
    o[d0]=__builtin_amdgcn_mfma_f32_32x32x16_bf16(pa2,PK(2),o[d0],0,0,0);
    o[d0]=__builtin_amdgcn_mfma_f32_32x32x16_bf16(pa3,PK(3),o[d0],0,0,0);
    #undef PK
  }
}

#ifndef ATTN_STORE16
#define ATTN_STORE16(p,v) (*(u32x4*)(p)=(v))
#endif
struct AttnP { const bf16* Q; const bf16* K; const bf16* V; bf16* out; bf16* stash; const float* gsub; const float* logf; int opitch; float lam, nscale; };
template<int THRL,bool FOX> __device__ __forceinline__ void attn_unit(const int tid_in,int b,int qb,const int MODE,const AttnP&P,char*shm){
  int tid=tid_in; asm volatile("":"+v"(tid));
  const int lane=tid&63,r32=lane&31,hi=lane>>5; const int wid=__builtin_amdgcn_readfirstlane(tid>>6);
  const long rowbase=(long)b*SEQ; const int q0=qb*QB;
  const bf16*Qw=P.Q+(rowbase+q0+wid*QBLK)*DM;
  const bf16*Kh=P.K+rowbase*DM,*Vh=P.V+rowbase*DM;
  const unsigned lds0=(unsigned)(uintptr_t)shm;
  float*wsf=(float*)(shm+LDS_WS)+wid*64;
  const float*biasL=(const float*)(shm+LDS_BIAS);
  #define BIAS(P0,P1,t) do{ if(FOX){ const float*bb_=biasL+64*(t)+4*hi; _Pragma("unroll") for(int g_=0;g_<4;++g_){ const f32x4_t b0_=*(const f32x4_t*)(bb_+8*g_), b1_=*(const f32x4_t*)(bb_+32+8*g_); \
      _Pragma("unroll") for(int e_=0;e_<4;++e_){ P0[4*g_+e_]+=b0_[e_]; P1[4*g_+e_]+=b1_[e_]; } asm volatile("":::"memory"); } } }while(0)
  const bf16*ksrc=Kh+(long)lane*DM+wid*8;
  const bf16*vsrc=Vh+(long)(16*(wid&3)+(lane>>2))*DM+(wid>>2)*32+(lane&3)*8;
  const unsigned kdst=lds0+LDS_K+wid*1024, vdst=lds0+LDS_V+wid*1024;
  #define DMA_K(t,slot) glds16(ksrc+(long)(t)*KVBLK*DM,(unsigned)__builtin_amdgcn_readfirstlane(kdst+(slot)))
  #define DMA_V(t,slot) glds16(vsrc+(long)(t)*KVBLK*DM,(unsigned)__builtin_amdgcn_readfirstlane(vdst+(slot)))
  const int vb0=(int)(lds0+LDS_V)+((lane>>4)&1)*32+(lane&3)*8+(4*hi+((lane&15)>>2))*64;
  const char*Kbase=shm+LDS_K; bf16x8 kf[8];
  const lds_cptr shm3=(lds_cptr)shm; const lds_cptr kp0=shm3+LDS_K+hi*1024+r32*16; const lds_cptr vp0=shm3+LDS_V+((lane>>4)&1)*32+(lane&3)*8+(4*hi+((lane&15)>>2))*64;
  const int NT=(q0+QB)/KVBLK;
  DMA_K(0,0);DMA_V(0,0);DMA_K(1,SLOTB);
  bf16x8 qr[4];
  #pragma unroll
  for(int d0=0;d0<4;++d0)qr[d0]=*reinterpret_cast<const bf16x8*>(&Qw[(long)r32*DM+d0*16+hi*8]);
  float mhat=0.f,l_reg=0.f;f32x16 o[2];o[0]=f32x16{};o[1]=f32x16{};f32x16 negm=f32x16{};asm volatile("":"+v"(negm));
  const int qrel=wid*QBLK+r32;
  #define CMASK(P0,P1,t) do{int jb_=(t)-(NT-4); if(jb_>=0)cmask(P0,P1,jb_,qrel,hi);}while(0)
  bool resc=false;
  #define START(P0,P1) do{ const float rm=rowmax(P0,P1); resc=false; \
    { const float dl=rm; mhat=fadd_s(mhat,dl); \
      _Pragma("unroll") for(int r=0;r<16;++r){P0[r]=fsub_s(P0[r],dl);P1[r]=fsub_s(P1[r],dl);} \
      _Pragma("unroll") for(int r=0;r<16;++r)negm[r]=-mhat; asm volatile("":"+v"(negm)); } \
    _Pragma("unroll") for(int r=0;r<16;++r)P0[r]=__builtin_amdgcn_exp2f(P0[r]); }while(0)
  #define RESC() do{ if(resc){ asm volatile("s_waitcnt lgkmcnt(0)":::"memory"); \
      _Pragma("unroll") for(int d_=0;d_<2;++d_) _Pragma("unroll") for(int r=0;r<16;++r)o[d_][r]*=wsf[crow(r,hi)]; } }while(0)
  f32x16 pA0,pA1,pB0,pB1;
  int sl_prev=0,sl_cur=0,sl_next=SLOTB;
  #define ROT() do{sl_prev=sl_cur;sl_cur=sl_next;sl_next=(sl_next==(NSLOT-1)*SLOTB)?0:sl_next+SLOTB;}while(0)
  DMA_K(2,2*SLOTB);
  if(FOX){
    const int n=q0+QB; float v4[4]; float run=0.f;
    _Pragma("unroll") for(int i=0;i<4;++i){ const int sidx=4*tid+i; const float lv=(sidx<n)?P.logf[(rowbase+sidx)*8]:0.f; run+=lv; v4[i]=run; }
    float inc=run; _Pragma("unroll") for(int o_=1;o_<64;o_<<=1){ const float up=__int_as_float(__builtin_amdgcn_ds_bpermute((lane-o_)<<2,__float_as_int(inc))); if(lane>=o_)inc+=up; }
    float*wt=(float*)(shm+LDS_WS); if(lane==63)wt[wid]=inc; __syncthreads();
    float pre=inc-run; _Pragma("unroll") for(int w_=0;w_<NW;++w_){ if(w_<wid)pre+=wt[w_]; }
    float*bw=(float*)(shm+LDS_BIAS); _Pragma("unroll") for(int i=0;i<4;++i){ const int sidx=4*tid+i; if(sidx<n)bw[sidx]=-(pre+v4[i])*1.4426950408889634f; }
    __syncthreads(); }
  WAIT_BAR(3);
  qkt(pA0,pA1,Kbase,qr,negm,r32,hi);asm volatile("s_nop 15\n\ts_nop 7":"+v"(pA0),"+v"(pA1));BIAS(pA0,pA1,0);CMASK(pA0,pA1,0);
  START(pA0,pA1);
  _Pragma("unroll") for(int r=0;r<16;++r)pA1[r]=__builtin_amdgcn_exp2f(pA1[r]);
  WAIT_BAR(0);
  DMA_K(3,0);DMA_V(1,SLOTB);
  ROT();
  kload8(kf,kp0+sl_cur);
  WAIT_BAR(2);
  s16x4 vlo[8],vhi[8]; u32x4 pw0,pw1,pw2,pw3;
  #define PKW(P,B) cvtpk_s(P[B],P[B+1])
  #define PAF(k) __builtin_bit_cast(bf16x8,pw##k)
  #define VFR(i) (bf16x8){vlo[i][0],vlo[i][1],vlo[i][2],vlo[i][3],vhi[i][0],vhi[i][1],vhi[i][2],vhi[i][3]}
  #define PIN(x) asm volatile("":"+v"(x))
  #define MX3(a,b,c) __builtin_fmaxf(__builtin_fmaxf((a),(b)),(c))
  #define GAPA(MF,A0,A1,A2,A3,W0,W1,PW) do{ MF; sacc+=A0; sacc+=A1; sacc+=A2; sacc+=A3; PIN(sacc); W0; W1; PIN(PW); SBAR(); }while(0)
  #define EX(v) __builtin_amdgcn_exp2f(v)
  #define GAPB(MF,X,B) do{ MF; X[B]=EX(X[B]); X[B+1]=EX(X[B+1]); X[B+2]=EX(X[B+2]); X[B+3]=EX(X[B+3]); PIN(X); SBAR(); }while(0)
  #define VRD(i) do{ vlo[i]=vtr(vp_+(((i)>>2)*4096+((i)&3)*1024)); vhi[i]=vtr(vp_+(((i)>>2)*4096+((i)&3)*1024+512)); }while(0)
  #define KRD(G,j) do{ if(G){ kload2(kf,kp0+sl_next,j); SBAR(); } }while(0)
  #define STEP(C0,C1,P0,P1,t,GK,GV,GL) do{ SBAR(); \
    const lds_cptr vp_=vp0+sl_prev; \
    VRD(0); SBAR(); float sacc=(P0[0]+P0[1]); \
    GAPA(C0=__builtin_amdgcn_mfma_f32_32x32x16_bf16(kf[0],qr[0],negm,0,0,0), P0[2],P0[3],P0[4],P0[5],     pw0[0]=PKW(P0,0), pw0[1]=PKW(P0,2), pw0); \
    VRD(4); SBAR(); GAPA(C1=__builtin_amdgcn_mfma_f32_32x32x16_bf16(kf[1],qr[0],negm,0,0,0), P0[6],P0[7],P0[8],P0[9],     pw0[2]=PKW(P0,4), pw0[3]=PKW(P0,6), pw0); \
    VRD(1); SBAR(); GAPA(C0=__builtin_amdgcn_mfma_f32_32x32x16_bf16(kf[2],qr[1],C0,0,0,0),   P0[10],P0[11],P0[12],P0[13], pw1[0]=PKW(P0,8), pw1[1]=PKW(P0,10), pw1); \
    VRD(5); SBAR(); GAPA(C1=__builtin_amdgcn_mfma_f32_32x32x16_bf16(kf[3],qr[1],C1,0,0,0),   P0[14],P0[15],P1[0],P1[1],   pw1[2]=PKW(P0,12),pw1[3]=PKW(P0,14), pw1); \
    VRD(2); SBAR(); GAPA(C0=__builtin_amdgcn_mfma_f32_32x32x16_bf16(kf[4],qr[2],C0,0,0,0),   P1[2],P1[3],P1[4],P1[5],     pw2[0]=PKW(P1,0), pw2[1]=PKW(P1,2), pw2); \
    VRD(6); SBAR(); GAPA(C1=__builtin_amdgcn_mfma_f32_32x32x16_bf16(kf[5],qr[2],C1,0,0,0),   P1[6],P1[7],P1[8],P1[9],     pw2[2]=PKW(P1,4), pw2[3]=PKW(P1,6), pw2); \
    VRD(3); SBAR(); GAPA(C0=__builtin_amdgcn_mfma_f32_32x32x16_bf16(kf[6],qr[3],C0,0,0,0),   P1[10],P1[11],P1[12],P1[13], pw3[0]=PKW(P1,8), pw3[1]=PKW(P1,10), pw3); \
    VRD(7); SBAR(); GAPA(C1=__builtin_amdgcn_mfma_f32_32x32x16_bf16(kf[7],qr[3],C1,0,0,0),   P1[14],P1[15],0.f,0.f,       pw3[2]=PKW(P1,12),pw3[3]=PKW(P1,14), pw3); \
    l_reg+=sacc; \
    if(GK){DMA_K((t)+3,sl_cur);} if(GV){DMA_V((t)+1,sl_next);} \
    BIAS(C0,C1,t); CMASK(C0,C1,t); \
    { float a=MX3(C0[0],C0[1],C1[0]),b=MX3(C0[2],C0[3],C1[1]); a=MX3(a,C1[2],C1[3]); \
      _Pragma("unroll") for(int r=4;r<16;r+=4){a=MX3(a,C0[r],C0[r+1]);b=MX3(b,C0[r+2],C0[r+3]);a=MX3(a,C1[r],C1[r+1]);b=MX3(b,C1[r+2],C1[r+3]);} \
      float rm=__builtin_fmaxf(a,b); { auto rr=__builtin_amdgcn_permlane32_swap(__float_as_uint(rm),__float_as_uint(rm),false,false); rm=__builtin_fmaxf(__uint_as_float(rr[0]),__uint_as_float(rr[1])); } \
      resc=false; \
      if(__builtin_expect(__any(rm>(float)THRL),0)){ const float dl=__builtin_fmaxf(rm,0.f); mhat+=dl; \
        _Pragma("unroll") for(int r=0;r<16;++r){C0[r]-=dl;C1[r]-=dl;} \
        _Pragma("unroll") for(int r=0;r<16;++r)negm[r]=-mhat; asm volatile("":"+v"(negm)); \
        const float f=__builtin_amdgcn_exp2f(-dl); l_reg*=f; if(hi==0)wsf[r32]=f; resc=true; } } \
    SBAR(); \
    GAPB(o[0]=__builtin_amdgcn_mfma_f32_32x32x16_bf16(PAF(0),VFR(0),o[0],0,0,0), C0,0); \
    GAPB(o[1]=__builtin_amdgcn_mfma_f32_32x32x16_bf16(PAF(0),VFR(4),o[1],0,0,0), C0,4); \
    KRD(GL,0); GAPB(o[0]=__builtin_amdgcn_mfma_f32_32x32x16_bf16(PAF(1),VFR(1),o[0],0,0,0), C0,8); \
    KRD(GL,1); GAPB(o[1]=__builtin_amdgcn_mfma_f32_32x32x16_bf16(PAF(1),VFR(5),o[1],0,0,0), C0,12); \
    KRD(GL,2); GAPB(o[0]=__builtin_amdgcn_mfma_f32_32x32x16_bf16(PAF(2),VFR(2),o[0],0,0,0), C1,0); \
    KRD(GL,3); GAPB(o[1]=__builtin_amdgcn_mfma_f32_32x32x16_bf16(PAF(2),VFR(6),o[1],0,0,0), C1,4); \
    GAPB(o[0]=__builtin_amdgcn_mfma_f32_32x32x16_bf16(PAF(3),VFR(3),o[0],0,0,0), C1,8); \
    GAPB(o[1]=__builtin_amdgcn_mfma_f32_32x32x16_bf16(PAF(3),VFR(7),o[1],0,0,0), C1,12); \
    }while(0)
  int t=1;
  #undef CMASK
  #define CMASK(P0,P1,t) do{}while(0)
  for(;t+5<NT;t+=2){
    STEP(pB0,pB1,pA0,pA1,t,true,true,true);     WAIT_BAR(2); RESC(); ROT();
    STEP(pA0,pA1,pB0,pB1,t+1,true,true,true);   WAIT_BAR(2); RESC(); ROT();
  }
  #undef CMASK
  #define CMASK(P0,P1,t) do{int jb_=(t)-(NT-4); if(jb_>=0)cmask(P0,P1,jb_,qrel,hi);}while(0)
  #define ENDW(tt) do{ if((tt)+3<NT){WAIT_BAR(2);} else if((tt)+2<NT){WAIT_BAR(1);} else {WAIT_BAR(0);} }while(0)
  for(;t+1<NT;t+=2){
    STEP(pB0,pB1,pA0,pA1,t,(t+3<NT),(t+1<NT),(t+1<NT));       ENDW(t);   RESC(); ROT();
    STEP(pA0,pA1,pB0,pB1,t+1,(t+4<NT),(t+2<NT),(t+2<NT));     ENDW(t+1); RESC(); ROT();
  }
  STEP(pB0,pB1,pA0,pA1,NT-1,false,false,false); RESC();
  { float sacc=pB0[0]+pB0[1]; _Pragma("unroll") for(int r=2;r<16;++r)sacc+=pB0[r]; _Pragma("unroll") for(int r=0;r<16;++r)sacc+=pB1[r]; l_reg+=sacc;
    pw0=(u32x4){PKW(pB0,0),PKW(pB0,2),PKW(pB0,4),PKW(pB0,6)};pw1=(u32x4){PKW(pB0,8),PKW(pB0,10),PKW(pB0,12),PKW(pB0,14)};pw2=(u32x4){PKW(pB1,0),PKW(pB1,2),PKW(pB1,4),PKW(pB1,6)};pw3=(u32x4){PKW(pB1,8),PKW(pB1,10),PKW(pB1,12),PKW(pB1,14)};
    SBAR(); pv(o,vb0+sl_cur,PAF(0),PAF(1),PAF(2),PAF(3)); }
  #undef PKW
  #undef PAF
  #undef VFR
  #undef PIN
  #undef MX3
  #undef GAPA
  #undef GAPB
  #undef EX
  #undef VRD
  #undef KRD
  #undef STEP
  #undef ENDW
  {auto rr=__builtin_amdgcn_permlane32_swap(__float_as_uint(l_reg),__float_as_uint(l_reg),false,false);l_reg=__uint_as_float(rr[0])+__uint_as_float(rr[1]);}
  if(hi==0)wsf[32+r32]=l_reg;asm volatile("s_waitcnt lgkmcnt(0)":::"memory");
  float rli[16];
  #pragma unroll
  for(int r=0;r<16;++r)rli[r]=__builtin_amdgcn_rcpf(wsf[32+crow(r,hi)]);
  { hbf16*stg=(hbf16*)(shm+LDS_OST)+wid*2048;
    #pragma unroll
    for(int r=0;r<16;++r){const int orow=crow(r,hi);
      #pragma unroll
      for(int d0=0;d0<2;++d0)stg[orow*64+d0*32+r32]=__float2bfloat16(o[d0][r]*rli[r]);}
    asm volatile("s_waitcnt lgkmcnt(0)":::"memory");
    const long grow=rowbase+q0+wid*QBLK; float*ssq=(float*)(shm+LDS_SSQ)+wid*32;
    int lane_e=lane; asm volatile("":"+v"(lane_e));
    #pragma unroll
    for(int i=0;i<4;++i){const int row=i*8+(lane_e>>3),ch=lane_e&7; const u32x4 v=*(const u32x4*)(stg+row*64+ch*8);
      if(MODE==0){ *(u32x4*)(P.out+(grow+row)*(long)P.opitch+ch*8)=v; }
      else { bf16*sp=P.stash+(grow+row)*512+ch*8+(MODE==2?64:0); const u32x4 a=*(const u32x4*)sp; float of[8]; float ss=0.f;
        #pragma unroll
        for(int j=0;j<4;++j){ const float a0=__uint_as_float(a[j]<<16),a1=__uint_as_float(a[j]&0xffff0000u),c0=__uint_as_float(v[j]<<16),c1=__uint_as_float(v[j]&0xffff0000u);
          of[2*j]=a0-P.lam*c0; of[2*j+1]=a1-P.lam*c1; ss+=of[2*j]*of[2*j]+of[2*j+1]*of[2*j+1]; }
        ss+=__int_as_float(__builtin_amdgcn_ds_swizzle(__float_as_int(ss),0x041f)); ss+=__int_as_float(__builtin_amdgcn_ds_swizzle(__float_as_int(ss),0x081f)); ss+=__int_as_float(__builtin_amdgcn_ds_swizzle(__float_as_int(ss),0x101f));
        if(MODE==1){ if(ch==0)ssq[row]=ss; u32x4 w; _Pragma("unroll") for(int j=0;j<4;++j)w[j]=cvtpk_s(of[2*j],of[2*j+1]); *(u32x4*)sp=w; }
        else { const float rr_=rsqrtf((ss+ssq[row])*(1.0f/128.0f)+1e-6f)*P.nscale; bf16*yp=P.out+(grow+row)*(long)P.opitch+ch*8;
          const f32x4_t g0=*(const f32x4_t*)(P.gsub+64+ch*8), g1=*(const f32x4_t*)(P.gsub+64+ch*8+4), h0=*(const f32x4_t*)(P.gsub+ch*8), h1=*(const f32x4_t*)(P.gsub+ch*8+4);
          u32x4 w; w[0]=cvtpk_s(of[0]*rr_*g0[0],of[1]*rr_*g0[1]); w[1]=cvtpk_s(of[2]*rr_*g0[2],of[3]*rr_*g0[3]); w[2]=cvtpk_s(of[4]*rr_*g1[0],of[5]*rr_*g1[1]); w[3]=cvtpk_s(of[6]*rr_*g1[2],of[7]*rr_*g1[3]);
          *(u32x4*)(yp+64)=w;
          const u32x4 lo=*(const u32x4*)(sp-64); float lf[8];
          #pragma unroll
          for(int j=0;j<4;++j){ lf[2*j]=__uint_as_float(lo[j]<<16); lf[2*j+1]=__uint_as_float(lo[j]&0xffff0000u); }
          w[0]=cvtpk_s(lf[0]*rr_*h0[0],lf[1]*rr_*h0[1]); w[1]=cvtpk_s(lf[2]*rr_*h0[2],lf[3]*rr_*h0[3]); w[2]=cvtpk_s(lf[4]*rr_*h1[0],lf[5]*rr_*h1[1]); w[3]=cvtpk_s(lf[6]*rr_*h1[2],lf[7]*rr_*h1[3]);
          *(u32x4*)yp=w; } } } }
  asm volatile("s_waitcnt lgkmcnt(0)\n\ts_barrier":::"memory");
  #undef DMA_K
  #undef BIAS
  #undef DMA_V
  #undef CMASK
  #undef START
  #undef RESC
  #undef ROT
}
__device__ __forceinline__ void pv128(f32x16*o,int vb,bf16x8 pa0,bf16x8 pa1,bf16x8 pa2,bf16x8 pa3){
  #pragma unroll
  for(int d0=0;d0<4;++d0){s16x4 lo[4],hi[4];
    #pragma unroll
    for(int ks=0;ks<4;++ks){
      asm volatile("ds_read_b64_tr_b16 %0,%1 offset:%c2":"=&v"(lo[ks]):"v"(vb),"i"(d0*4096+ks*1024):"memory");
      asm volatile("ds_read_b64_tr_b16 %0,%1 offset:%c2":"=&v"(hi[ks]):"v"(vb),"i"(d0*4096+ks*1024+512):"memory");}
    asm volatile("s_waitcnt lgkmcnt(0)":::"memory");SBAR();
    #define PK(k) (bf16x8){lo[k][0],lo[k][1],lo[k][2],lo[k][3],hi[k][0],hi[k][1],hi[k][2],hi[k][3]}
    o[d0]=__builtin_amdgcn_mfma_f32_32x32x16_bf16(pa0,PK(0),o[d0],0,0,0);
    o[d0]=__builtin_amdgcn_mfma_f32_32x32x16_bf16(pa1,PK(1),o[d0],0,0,0);
    o[d0]=__builtin_amdgcn_mfma_f32_32x32x16_bf16(pa2,PK(2),o[d0],0,0,0);
    o[d0]=__builtin_amdgcn_mfma_f32_32x32x16_bf16(pa3,PK(3),o[d0],0,0,0);
    #undef PK
  }
}
template<int THRL> __device__ __forceinline__ void attn_unit128(const int tid_in,int b,int qb,const int MODE,const AttnP&P,char*shm){
  constexpr bool FOX=false; constexpr int LDS_V=24576, LDS_WS=73728, LDS_OST=75776, SLOTV=16384;
  int tid=tid_in; asm volatile("":"+v"(tid));
  const int lane=tid&63,r32=lane&31,hi=lane>>5; const int wid=__builtin_amdgcn_readfirstlane(tid>>6);
  const long rowbase=(long)b*SEQ; const int q0=qb*QB;
  const bf16*Qw=P.Q+(rowbase+q0+wid*QBLK)*DM;
  const bf16*Kh=P.K+rowbase*DM,*Vh=P.V+rowbase*DM;
  const unsigned lds0=(unsigned)(uintptr_t)shm;
  float*wsf=(float*)(shm+LDS_WS)+wid*64;
  const float*biasL=(const float*)(shm+LDS_BIAS);
  #define BIAS(P0,P1,t) do{ if(FOX){ const float*bb_=biasL+64*(t)+4*hi; _Pragma("unroll") for(int g_=0;g_<4;++g_){ const f32x4_t b0_=*(const f32x4_t*)(bb_+8*g_), b1_=*(const f32x4_t*)(bb_+32+8*g_); \
      _Pragma("unroll") for(int e_=0;e_<4;++e_){ P0[4*g_+e_]+=b0_[e_]; P1[4*g_+e_]+=b1_[e_]; } asm volatile("":::"memory"); } } }while(0)
  const bf16*ksrc=Kh+(long)lane*DM+wid*8;
  const bf16*vsrc=Vh+(long)(16*(wid&3)+(lane>>2))*DM+(wid>>2)*32+(lane&3)*8;
  const unsigned kdst=lds0+LDS_K+wid*1024, vdst=lds0+LDS_V+wid*1024;
  #define DMA_K(t,slot) glds16(ksrc+(long)(t)*KVBLK*DM,(unsigned)__builtin_amdgcn_readfirstlane(kdst+(slot)))
  #define DMA_V(t,slot) do{ glds16(vsrc+(long)(t)*KVBLK*DM,(unsigned)__builtin_amdgcn_readfirstlane(vdst+2*(slot))); glds16(vsrc+(long)(t)*KVBLK*DM+64,(unsigned)__builtin_amdgcn_readfirstlane(vdst+2*(slot)+8192)); }while(0)
  const int vb0=(int)(lds0+LDS_V)+((lane>>4)&1)*32+(lane&3)*8+(4*hi+((lane&15)>>2))*64;
  const char*Kbase=shm+LDS_K; bf16x8 kf[8];
  const lds_cptr shm3=(lds_cptr)shm; const lds_cptr kp0=shm3+LDS_K+hi*1024+r32*16; const lds_cptr vp0=shm3+LDS_V+((lane>>4)&1)*32+(lane&3)*8+(4*hi+((lane&15)>>2))*64;
  const int NT=(q0+QB)/KVBLK;
  DMA_K(0,0);DMA_V(0,0);DMA_K(1,SLOTB);
  bf16x8 qr[4];
  #pragma unroll
  for(int d0=0;d0<4;++d0)qr[d0]=*reinterpret_cast<const bf16x8*>(&Qw[(long)r32*DM+d0*16+hi*8]);
  float mhat=0.f,l_reg=0.f;f32x16 o[4];o[0]=f32x16{};o[1]=f32x16{};o[2]=f32x16{};o[3]=f32x16{};const f32x16 zero16=f32x16{};
  const int qrel=wid*QBLK+r32;
  #define CMASK(P0,P1,t) do{int jb_=(t)-(NT-4); if(jb_>=0)cmask(P0,P1,jb_,qrel,hi);}while(0)
  bool resc=false;
  #define START(P0,P1) do{ const float rm=rowmax(P0,P1); resc=false; \
    { const float dl=rm; mhat=fadd_s(mhat,dl); \
      _Pragma("unroll") for(int r=0;r<16;++r){P0[r]=fsub_s(P0[r],dl);P1[r]=fsub_s(P1[r],dl);} \
      } \
    _Pragma("unroll") for(int r=0;r<16;++r)P0[r]=__builtin_amdgcn_exp2f(P0[r]); }while(0)
  #define RESC() do{ if(resc){ asm volatile("s_waitcnt lgkmcnt(0)":::"memory"); \
      _Pragma("unroll") for(int d_=0;d_<4;++d_) _Pragma("unroll") for(int r=0;r<16;++r)o[d_][r]*=wsf[crow(r,hi)]; } }while(0)
  f32x16 pA0,pA1,pB0,pB1;
  int sl_prev=0,sl_cur=0,sl_next=SLOTB;
  #define ROT() do{sl_prev=sl_cur;sl_cur=sl_next;sl_next=(sl_next==(NSLOT-1)*SLOTB)?0:sl_next+SLOTB;}while(0)
  DMA_K(2,2*SLOTB);
  WAIT_BAR(4);
  qkt(pA0,pA1,Kbase,qr,zero16,r32,hi);asm volatile("s_nop 15\n\ts_nop 7":"+v"(pA0),"+v"(pA1));BIAS(pA0,pA1,0);CMASK(pA0,pA1,0);
  START(pA0,pA1);
  _Pragma("unroll") for(int r=0;r<16;++r)pA1[r]=__builtin_amdgcn_exp2f(pA1[r]);
  WAIT_BAR(0);
  DMA_K(3,0);DMA_V(1,SLOTB);
  ROT();
  kload8(kf,kp0+sl_cur);
  WAIT_BAR(3);
  s16x4 va_lo,va_hi,vb_lo,vb_hi; u32x4 pw0,pw1,pw2,pw3;
  #define PKW(P,B) cvtpk_s(P[B],P[B+1])
  #define PAF(k) __builtin_bit_cast(bf16x8,pw##k)
  #define VFA (bf16x8){va_lo[0],va_lo[1],va_lo[2],va_lo[3],va_hi[0],va_hi[1],va_hi[2],va_hi[3]}
  #define VFB (bf16x8){vb_lo[0],vb_lo[1],vb_lo[2],vb_lo[3],vb_hi[0],vb_hi[1],vb_hi[2],vb_hi[3]}
  #define PIN(x) asm volatile("":"+v"(x))
  #define MX3(a,b,c) __builtin_fmaxf(__builtin_fmaxf((a),(b)),(c))
  #define GAPA(MF,A0,A1,A2,A3,W0,W1,PW) do{ MF; sacc+=A0; sacc+=A1; sacc+=A2; sacc+=A3; PIN(sacc); W0; W1; PIN(PW); SBAR(); }while(0)
  #define EX(v) __builtin_amdgcn_exp2f((v)-mhat)
  #define VRDA(d0,ks) do{ va_lo=vtr(vp_+((d0)*4096+(ks)*1024)); va_hi=vtr(vp_+((d0)*4096+(ks)*1024+512)); }while(0)
  #define VRDB(d0,ks) do{ vb_lo=vtr(vp_+((d0)*4096+(ks)*1024)); vb_hi=vtr(vp_+((d0)*4096+(ks)*1024+512)); }while(0)
  #define KRD(G,j) do{ if(G){ kload2(kf,kp0+sl_next,j); } }while(0)
  #define GAPB(MF,RD,X,B) do{ MF; RD; X[B]=EX(X[B]); X[B+1]=EX(X[B+1]); PIN(X); SBAR(); }while(0)
  #define STEP(C0,C1,P0,P1,t,GK,GV,GL) do{ SBAR(); \
    const lds_cptr vp_=vp0+2*sl_prev; \
    float sacc=(P0[0]+P0[1]); \
    GAPA(C0=__builtin_amdgcn_mfma_f32_32x32x16_bf16(kf[0],qr[0],zero16,0,0,0), P0[2],P0[3],P0[4],P0[5],     pw0[0]=PKW(P0,0), pw0[1]=PKW(P0,2), pw0); \
    GAPA(C1=__builtin_amdgcn_mfma_f32_32x32x16_bf16(kf[1],qr[0],zero16,0,0,0), P0[6],P0[7],P0[8],P0[9],     pw0[2]=PKW(P0,4), pw0[3]=PKW(P0,6), pw0); \
    GAPA(C0=__builtin_amdgcn_mfma_f32_32x32x16_bf16(kf[2],qr[1],C0,0,0,0),   P0[10],P0[11],P0[12],P0[13], pw1[0]=PKW(P0,8), pw1[1]=PKW(P0,10), pw1); \
    GAPA(C1=__builtin_amdgcn_mfma_f32_32x32x16_bf16(kf[3],qr[1],C1,0,0,0),   P0[14],P0[15],P1[0],P1[1],   pw1[2]=PKW(P0,12),pw1[3]=PKW(P0,14), pw1); \
    GAPA(C0=__builtin_amdgcn_mfma_f32_32x32x16_bf16(kf[4],qr[2],C0,0,0,0),   P1[2],P1[3],P1[4],P1[5],     pw2[0]=PKW(P1,0), pw2[1]=PKW(P1,2), pw2); \
    GAPA(C1=__builtin_amdgcn_mfma_f32_32x32x16_bf16(kf[5],qr[2],C1,0,0,0),   P1[6],P1[7],P1[8],P1[9],     pw2[2]=PKW(P1,4), pw2[3]=PKW(P1,6), pw2); \
    VRDA(0,0); SBAR(); \
    GAPA(C0=__builtin_amdgcn_mfma_f32_32x32x16_bf16(kf[6],qr[3],C0,0,0,0),   P1[10],P1[11],P1[12],P1[13], pw3[0]=PKW(P1,8), pw3[1]=PKW(P1,10), pw3); \
    GAPA(C1=__builtin_amdgcn_mfma_f32_32x32x16_bf16(kf[7],qr[3],C1,0,0,0),   P1[14],P1[15],0.f,0.f,       pw3[2]=PKW(P1,12),pw3[3]=PKW(P1,14), pw3); \
    l_reg+=sacc; \
    if(GK){DMA_K((t)+3,sl_cur);} if(GV){DMA_V((t)+1,sl_next);} \
    CMASK(C0,C1,t); \
    { float a=MX3(C0[0],C0[1],C1[0]),b=MX3(C0[2],C0[3],C1[1]); a=MX3(a,C1[2],C1[3]); \
      _Pragma("unroll") for(int r=4;r<16;r+=4){a=MX3(a,C0[r],C0[r+1]);b=MX3(b,C0[r+2],C0[r+3]);a=MX3(a,C1[r],C1[r+1]);b=MX3(b,C1[r+2],C1[r+3]);} \
      float rm=__builtin_fmaxf(a,b); { auto rr=__builtin_amdgcn_permlane32_swap(__float_as_uint(rm),__float_as_uint(rm),false,false); rm=__builtin_fmaxf(__uint_as_float(rr[0]),__uint_as_float(rr[1])); } \
      rm-=mhat; resc=false; \
      if(__builtin_expect(__any(rm>(float)THRL),0)){ const float dl=__builtin_fmaxf(rm,0.f); mhat+=dl; \
        const float f=__builtin_amdgcn_exp2f(-dl); l_reg*=f; if(hi==0)wsf[r32]=f; resc=true; } } \
    SBAR(); \
    GAPB(o[0]=__builtin_amdgcn_mfma_f32_32x32x16_bf16(PAF(0),VFA,o[0],0,0,0), VRDB(1,0), C0,0); \
    GAPB(o[1]=__builtin_amdgcn_mfma_f32_32x32x16_bf16(PAF(0),VFB,o[1],0,0,0), VRDA(2,0), C0,2); \
    GAPB(o[2]=__builtin_amdgcn_mfma_f32_32x32x16_bf16(PAF(0),VFA,o[2],0,0,0), VRDB(3,0), C0,4); \
    GAPB(o[3]=__builtin_amdgcn_mfma_f32_32x32x16_bf16(PAF(0),VFB,o[3],0,0,0), VRDA(0,1), C0,6); \
    KRD(GL,0); GAPB(o[0]=__builtin_amdgcn_mfma_f32_32x32x16_bf16(PAF(1),VFA,o[0],0,0,0), VRDB(1,1), C0,8); \
    GAPB(o[1]=__builtin_amdgcn_mfma_f32_32x32x16_bf16(PAF(1),VFB,o[1],0,0,0), VRDA(2,1), C0,10); \
    KRD(GL,1); GAPB(o[2]=__builtin_amdgcn_mfma_f32_32x32x16_bf16(PAF(1),VFA,o[2],0,0,0), VRDB(3,1), C0,12); \
    GAPB(o[3]=__builtin_amdgcn_mfma_f32_32x32x16_bf16(PAF(1),VFB,o[3],0,0,0), VRDA(0,2), C0,14); \
    KRD(GL,2); GAPB(o[0]=__builtin_amdgcn_mfma_f32_32x32x16_bf16(PAF(2),VFA,o[0],0,0,0), VRDB(1,2), C1,0); \
    GAPB(o[1]=__builtin_amdgcn_mfma_f32_32x32x16_bf16(PAF(2),VFB,o[1],0,0,0), VRDA(2,2), C1,2); \
    KRD(GL,3); GAPB(o[2]=__builtin_amdgcn_mfma_f32_32x32x16_bf16(PAF(2),VFA,o[2],0,0,0), VRDB(3,2), C1,4); \
    GAPB(o[3]=__builtin_amdgcn_mfma_f32_32x32x16_bf16(PAF(2),VFB,o[3],0,0,0), VRDA(0,3), C1,6); \
    GAPB(o[0]=__builtin_amdgcn_mfma_f32_32x32x16_bf16(PAF(3),VFA,o[0],0,0,0), VRDB(1,3), C1,8); \
    GAPB(o[1]=__builtin_amdgcn_mfma_f32_32x32x16_bf16(PAF(3),VFB,o[1],0,0,0), VRDA(2,3), C1,10); \
    GAPB(o[2]=__builtin_amdgcn_mfma_f32_32x32x16_bf16(PAF(3),VFA,o[2],0,0,0), VRDB(3,3), C1,12); \
    GAPB(o[3]=__builtin_amdgcn_mfma_f32_32x32x16_bf16(PAF(3),VFB,o[3],0,0,0), (void)0, C1,14); \
    }while(0)
  int t=1;
  #undef CMASK
  #define CMASK(P0,P1,t) do{}while(0)
  for(;t+5<NT;t+=2){
    STEP(pB0,pB1,pA0,pA1,t,true,true,true);     WAIT_BAR(3); RESC(); ROT();
    STEP(pA0,pA1,pB0,pB1,t+1,true,true,true);   WAIT_BAR(3); RESC(); ROT();
  }
  #undef CMASK
  #define CMASK(P0,P1,t) do{int jb_=(t)-(NT-4); if(jb_>=0)cmask(P0,P1,jb_,qrel,hi);}while(0)
  #define ENDW(tt) do{ if((tt)+3<NT){WAIT_BAR(3);} else if((tt)+2<NT){WAIT_BAR(2);} else {WAIT_BAR(0);} }while(0)
  for(;t+1<NT;t+=2){
    STEP(pB0,pB1,pA0,pA1,t,(t+3<NT),(t+1<NT),(t+1<NT));       ENDW(t);   RESC(); ROT();
    STEP(pA0,pA1,pB0,pB1,t+1,(t+4<NT),(t+2<NT),(t+2<NT));     ENDW(t+1); RESC(); ROT();
  }
  STEP(pB0,pB1,pA0,pA1,NT-1,false,false,false); RESC();
  { float sacc=pB0[0]+pB0[1]; _Pragma("unroll") for(int r=2;r<16;++r)sacc+=pB0[r]; _Pragma("unroll") for(int r=0;r<16;++r)sacc+=pB1[r]; l_reg+=sacc;
    pw0=(u32x4){PKW(pB0,0),PKW(pB0,2),PKW(pB0,4),PKW(pB0,6)};pw1=(u32x4){PKW(pB0,8),PKW(pB0,10),PKW(pB0,12),PKW(pB0,14)};pw2=(u32x4){PKW(pB1,0),PKW(pB1,2),PKW(pB1,4),PKW(pB1,6)};pw3=(u32x4){PKW(pB1,8),PKW(pB1,10),PKW(pB1,12),PKW(pB1,14)};
    SBAR(); pv128(o,vb0+2*sl_cur,PAF(0),PAF(1),PAF(2),PAF(3)); }
  #undef PKW
  #undef PAF
  #undef VFA
  #undef VFB
  #undef VRDA
  #undef VRDB
  #undef PIN
  #undef MX3
  #undef GAPA
  #undef GAPB
  #undef EX
  #undef KRD
  #undef STEP
  #undef ENDW
  {auto rr=__builtin_amdgcn_permlane32_swap(__float_as_uint(l_reg),__float_as_uint(l_reg),false,false);l_reg=__uint_as_float(rr[0])+__uint_as_float(rr[1]);}
  if(hi==0)wsf[32+r32]=l_reg;asm volatile("s_waitcnt lgkmcnt(0)":::"memory");
  float rli[16];
  #pragma unroll
  for(int r=0;r<16;++r)rli[r]=__builtin_amdgcn_rcpf(wsf[32+crow(r,hi)]);
  { hbf16*stg=(hbf16*)(shm+LDS_OST)+wid*2048;
    const long grow=rowbase+q0+wid*QBLK;
    int lane_e=lane; asm volatile("":"+v"(lane_e));
    float of[2][4][8]; float ssr[4]={0.f,0.f,0.f,0.f};
    #pragma unroll
    for(int hf=0;hf<2;++hf){
      #pragma unroll
      for(int r=0;r<16;++r){const int orow=crow(r,hi);
        #pragma unroll
        for(int d0=0;d0<2;++d0)stg[orow*64+d0*32+r32]=__float2bfloat16(o[2*hf+d0][r]*rli[r]);}
      asm volatile("s_waitcnt lgkmcnt(0)":::"memory");
      #pragma unroll
      for(int i=0;i<4;++i){const int row=i*8+(lane_e>>3),ch=lane_e&7; const u32x4 v=*(const u32x4*)(stg+row*64+ch*8);
        if(MODE==0){ *(u32x4*)(P.out+(grow+row)*(long)P.opitch+hf*64+ch*8)=v; }
        else { const u32x4 a=*(const u32x4*)(P.stash+(grow+row)*512+hf*64+ch*8); float ss=0.f;
          #pragma unroll
          for(int j=0;j<4;++j){ const float a0=__uint_as_float(a[j]<<16),a1=__uint_as_float(a[j]&0xffff0000u),c0=__uint_as_float(v[j]<<16),c1=__uint_as_float(v[j]&0xffff0000u);
            of[hf][i][2*j]=a0-P.lam*c0; of[hf][i][2*j+1]=a1-P.lam*c1; ss+=of[hf][i][2*j]*of[hf][i][2*j]+of[hf][i][2*j+1]*of[hf][i][2*j+1]; }
          ssr[i]+=ss; } }
      asm volatile("s_waitcnt lgkmcnt(0)":::"memory");
    }
    if(MODE!=0){
      #pragma unroll
      for(int i=0;i<4;++i){const int row=i*8+(lane_e>>3),ch=lane_e&7; float ss=ssr[i];
        ss+=__int_as_float(__builtin_amdgcn_ds_swizzle(__float_as_int(ss),0x041f)); ss+=__int_as_float(__builtin_amdgcn_ds_swizzle(__float_as_int(ss),0x081f)); ss+=__int_as_float(__builtin_amdgcn_ds_swizzle(__float_as_int(ss),0x101f));
        const float rr_=rsqrtf(ss*(1.0f/128.0f)+1e-6f)*P.nscale; bf16*yp=P.out+(grow+row)*(long)P.opitch+ch*8;
        #pragma unroll
        for(int hf=0;hf<2;++hf){ const f32x4_t g0=*(const f32x4_t*)(P.gsub+hf*64+ch*8), g1=*(const f32x4_t*)(P.gsub+hf*64+ch*8+4); u32x4 w;
          w[0]=cvtpk_s(of[hf][i][0]*rr_*g0[0],of[hf][i][1]*rr_*g0[1]); w[1]=cvtpk_s(of[hf][i][2]*rr_*g0[2],of[hf][i][3]*rr_*g0[3]); w[2]=cvtpk_s(of[hf][i][4]*rr_*g1[0],of[hf][i][5]*rr_*g1[1]); w[3]=cvtpk_s(of[hf][i][6]*rr_*g1[2],of[hf][i][7]*rr_*g1[3]);
          *(u32x4*)(yp+hf*64)=w; } } } }
  asm volatile("s_waitcnt lgkmcnt(0)\n\ts_barrier":::"memory");
  #undef DMA_K
  #undef BIAS
  #undef DMA_V
  #undef CMASK
  #undef START
  #undef RESC
  #undef ROT
}
constexpr int ATTN_LDS_BYTES=LDS_BYTES;
#undef SBAR
#undef WAIT_BAR
}
#ifndef MK_MU8
#define MK_MU8 0
#endif
#ifndef MK_PLE8
#define MK_PLE8 0
#endif
#define GAS __attribute__((address_space(1)))
#define LAS __attribute__((address_space(3)))
typedef unsigned v4u __attribute__((ext_vector_type(4)));
typedef float f32x4 __attribute__((ext_vector_type(4)));
typedef GAS unsigned gu32;
#define RLX_AGENT __ATOMIC_RELAXED, __HIP_MEMORY_SCOPE_AGENT
#define LDS_WAIT() asm volatile("s_waitcnt lgkmcnt(0)" ::: "memory")
#define VM_WAIT() asm volatile("s_waitcnt vmcnt(0)" ::: "memory")
constexpr int NWAVES = 8;
constexpr size_t W_IN = 0;
constexpr size_t W_CAT = W_IN + (size_t)3840 * 1024 * 2;
constexpr size_t W_G8 = W_CAT;
constexpr size_t W_BR = W_CAT + (size_t)3 * 1024 * 1024;
constexpr float G8_SCALE = 128.0f;
constexpr size_t W_OUT = W_CAT + (size_t)3 * 1024 * 1536 * 2;
constexpr size_t W_GU = W_OUT + (size_t)1024 * 1024 * 2;
constexpr size_t W_D = W_GU + (size_t)16 * 512 * 1024 * 2;
constexpr size_t W_RH = W_D + (size_t)16 * 1024 * 256 * 2;
constexpr size_t W_RL = W_RH + 65536;
constexpr size_t W_ENDB = W_RL + 65536;
static_assert(WS_W + W_ENDB <= WS_SSB && WS_SSB + MiB <= WS_WPLE, "weight map");
constexpr size_t W_PG = 0, W_P = (size_t)1024 * 1024 * 2, WPLE_STRIDE = (size_t)5 * 512 * 1024;
constexpr size_t OUT_XB8 = 0, OUT_GATES = 16 * MiB;
constexpr size_t OV_PB = WS_PB;
constexpr size_t OV_PW = WS_PROJ + 8 * MiB;
constexpr size_t OV_ACT = WS_PROJ + 40 * MiB;
constexpr size_t OV_XB2 = WS_PROJ + 64 * MiB;
constexpr int RING_BYTES = 131072, MISC_OFF = RING_BYTES, LDS_BYTES = 147456;
constexpr int MI_N = 0, MI_BASE = 32, MI_U0 = 64, MI_TOT = 96, MI_Q = 100, MI_BAR = 104;

__device__ __forceinline__ unsigned pk2(float lo, float hi) { typedef float f2 __attribute__((ext_vector_type(2))); typedef __bf16 b2 __attribute__((ext_vector_type(2))); f2 v = {lo, hi}; b2 b = __builtin_convertvector(v, b2); return __builtin_bit_cast(unsigned, b); }
__device__ __forceinline__ float bflo(unsigned u) { return __uint_as_float(u << 16); }
__device__ __forceinline__ float bfhi(unsigned u) { return __uint_as_float(u & 0xffff0000u); }
__device__ __forceinline__ float sigm(float v) { return __builtin_amdgcn_rcpf(1.0f + __expf(-v)); }
__device__ __forceinline__ float sg2(float t) { return __builtin_amdgcn_rcpf(1.0f + __builtin_amdgcn_exp2f(t)); }
__device__ __forceinline__ float clamp8(float v) { return __builtin_amdgcn_fmed3f(v, -448.0f, 448.0f); }
__device__ __forceinline__ unsigned pk_fp8x4(float a, float b, float c, float d) {
    int w = __builtin_amdgcn_cvt_pk_fp8_f32(clamp8(a), clamp8(b), 0, false); w = __builtin_amdgcn_cvt_pk_fp8_f32(clamp8(c), clamp8(d), w, true); return (unsigned)w; }

#define XOR1(v) __int_as_float(__builtin_amdgcn_ds_swizzle(__float_as_int(v), 0x041f))
#define XOR2(v) __int_as_float(__builtin_amdgcn_ds_swizzle(__float_as_int(v), 0x081f))
#define XOR4(v) __int_as_float(__builtin_amdgcn_ds_swizzle(__float_as_int(v), 0x101f))
#define XOR8(v) __int_as_float(__builtin_amdgcn_ds_swizzle(__float_as_int(v), 0x201f))
#define XOR16(v) __int_as_float(__builtin_amdgcn_ds_swizzle(__float_as_int(v), 0x401f))
__device__ __forceinline__ float add_xor32(float v) { const auto r = __builtin_amdgcn_permlane32_swap(__float_as_uint(v), __float_as_uint(v), false, false); return __uint_as_float(r[0]) + __uint_as_float(r[1]); }
__device__ __forceinline__ float wave_sum64(float v) { v += XOR1(v); v += XOR2(v); v += XOR4(v); v += XOR8(v); v += XOR16(v); return add_xor32(v); }
__device__ __forceinline__ int mk_tid(int wave0) { int l; asm volatile("v_mbcnt_lo_u32_b32 %0, -1, 0\n\tv_mbcnt_hi_u32_b32 %0, -1, %0" : "=v"(l)); return wave0 * 64 + l; }

#define XB_TMO      128
#define XB_XCNT(j)  (256  + 64 * (j))
#define XB_XSUB(j)  (1280 + 64 * (j))
#define XB_XGEN(j)  (2304 + 64 * (j))
#define XB_TOP      3328
#define XB_TOPGEN   3392
#define XCD_BAR_WORDS 3456
#define XB_SPIN_CAP (1u << 18)
__device__ __forceinline__ unsigned xb_ld(unsigned* p)              { return __hip_atomic_load(p, __ATOMIC_RELAXED, __HIP_MEMORY_SCOPE_AGENT); }
__device__ __forceinline__ unsigned xb_add(unsigned* p, unsigned v) { return __hip_atomic_fetch_add(p, v, __ATOMIC_RELAXED, __HIP_MEMORY_SCOPE_AGENT); }
__device__ __forceinline__ unsigned xb_xcc_id() { return (unsigned)__builtin_amdgcn_s_getreg((3 << 11) | 20) & 0xFu; }
#define XB_SPIN(cond, bar) do { unsigned _sp = 0; while (cond) { __builtin_amdgcn_s_sleep(1); \
    if ((++_sp & 255u) == 0u) { if (xb_ld(&(bar)[XB_TMO])) break; if (_sp > XB_SPIN_CAP) { atomicAdd(&(bar)[XB_TMO], 1u); break; } } } } while (0)
struct XcdBarrier { unsigned* bar; unsigned x; volatile LAS unsigned* st; };
__device__ __forceinline__ XcdBarrier xcd_barrier_post(unsigned* bar, volatile LAS unsigned* st, int tid) {
    XcdBarrier b; b.bar = bar; b.x = xb_xcc_id(); b.st = st;
    if (tid == 0) (void)xb_add(&bar[XB_XCNT(b.x)], 1u);
    return b;
}
__device__ __forceinline__ void xcd_barrier_complete(unsigned* bar, unsigned x, unsigned& nloc, unsigned& nx) {
    const unsigned G = gridDim.x * gridDim.y * gridDim.z;
    unsigned sum, cnt, mine, sp = 0u;
    for (;;) {
        sum = 0u; cnt = 0u; mine = 0u;
#pragma unroll
        for (unsigned j = 0; j < 16; ++j) { const unsigned c = xb_ld(&bar[XB_XCNT(j)]); sum += c; cnt += (c > 0u) ? 1u : 0u; mine = (j == x) ? c : mine; }
        if (sum == G) break;
        __builtin_amdgcn_s_sleep(1);
        if ((++sp & 255u) == 0u) { if (xb_ld(&bar[XB_TMO])) break; if (sp > XB_SPIN_CAP) { atomicAdd(&bar[XB_TMO], 1u); break; } }
    }
    nloc = mine > 0u ? mine : 1u; nx = cnt > 0u ? cnt : 1u;
}
#ifndef MK_EARLYINV
#define MK_EARLYINV 1
#endif
#ifndef MK_SPLIT_SLEEP
#define MK_SPLIT_SLEEP 16
#endif
__device__ __forceinline__ void xcd_barrier(const XcdBarrier& b, int tid) {
    asm volatile("s_waitcnt vmcnt(0)" ::: "memory");
    __syncthreads();
    if (tid == 0) {
        unsigned* bar = b.bar;
        __builtin_amdgcn_s_waitcnt(0);
        unsigned nloc = b.st[0], nx = b.st[1];
        if (nloc == 0u) { xcd_barrier_complete(bar, b.x, nloc, nx); b.st[0] = nloc; b.st[1] = nx; }
        const unsigned old = xb_add(&bar[XB_XSUB(b.x)], 1u);
        const unsigned gen = old / nloc;
        if (old + 1u == (gen + 1u) * nloc) {
            __builtin_amdgcn_fence(__ATOMIC_RELEASE, "agent");
            asm volatile("s_waitcnt vmcnt(0)" ::: "memory");
            const unsigned og = xb_add(&bar[XB_TOP], 1u);
            unsigned tg = og / nx; asm volatile("" : "+v"(tg) :: "memory");
            if (og + 1u == (tg + 1u) * nx) { xb_add(&bar[XB_TOPGEN], 1u);
#if MK_EARLYINV
                xb_add(&bar[XB_XGEN(b.x)], 1u); asm volatile("buffer_inv sc1" ::: "memory");
#endif
            } else {
#if MK_EARLYINV
                asm volatile("buffer_inv sc1" ::: "memory");
#endif
                XB_SPIN(xb_ld(&bar[XB_TOPGEN]) == tg, bar);
#if MK_EARLYINV
                xb_add(&bar[XB_XGEN(b.x)], 1u);
#endif
            }
#if !MK_EARLYINV
            __builtin_amdgcn_fence(__ATOMIC_ACQUIRE, "agent");
            xb_add(&bar[XB_XGEN(b.x)], 1u);
#endif
            asm volatile("s_waitcnt vmcnt(0)" ::: "memory");
        } else {
#if MK_EARLYINV
            { unsigned g2 = gen; asm volatile("" : "+v"(g2) :: "memory"); asm volatile("buffer_inv sc1" ::: "memory");
              XB_SPIN(xb_ld(&bar[XB_XGEN(b.x)]) == g2, bar); }
#else
            XB_SPIN(xb_ld(&bar[XB_XGEN(b.x)]) == gen, bar);
            __builtin_amdgcn_fence(__ATOMIC_ACQUIRE, "agent");
#endif
            asm volatile("s_waitcnt vmcnt(0)" ::: "memory");
        }
    }
    __syncthreads();
}

__device__ __forceinline__ void split_arrive(unsigned* cnt, int tid) {
    asm volatile("s_waitcnt vmcnt(0)" ::: "memory"); __syncthreads();
    if (tid == 0) { __builtin_amdgcn_fence(__ATOMIC_RELEASE, "agent"); asm volatile("s_waitcnt vmcnt(0)" ::: "memory"); xb_add(cnt, 1u); }
}
__device__ __forceinline__ void split_arrive_x(const XcdBarrier& b, unsigned* cnt_top, unsigned* cnt_x, int tid) {
    asm volatile("s_waitcnt vmcnt(0)" ::: "memory"); __syncthreads();
    if (tid == 0) { const unsigned nloc = b.st[0]; const unsigned old = xb_add(cnt_x + 8u * b.x, 1u);
        if (old + 1u == nloc) { __builtin_amdgcn_fence(__ATOMIC_RELEASE, "agent"); asm volatile("s_waitcnt vmcnt(0)" ::: "memory"); xb_add(cnt_top, nloc); }
#if MK_EARLYINV
        asm volatile("buffer_inv sc1" ::: "memory");
#endif
    }
}
__device__ __forceinline__ void split_wait_leader(unsigned* cnt, unsigned target) {
    unsigned sp = 0; while (xb_ld(cnt) < target) { __builtin_amdgcn_s_sleep(MK_SPLIT_SLEEP); if (++sp > (1u << 22)) break; }
#if !MK_EARLYINV
    __builtin_amdgcn_fence(__ATOMIC_ACQUIRE, "agent");
#endif
    asm volatile("s_waitcnt vmcnt(0)" ::: "memory");
}

__device__ __forceinline__ void group4_sync(unsigned* gc, int tid) {
    asm volatile("s_waitcnt vmcnt(0)" ::: "memory"); __syncthreads();
    if (tid == 0) { const unsigned sh = 8u + 3u * xb_xcc_id();
        xb_add(gc, 1u + (1u << sh));
        asm volatile("buffer_inv sc1" ::: "memory");
        unsigned sp = 0, v = 0; for (;;) { v = xb_ld(gc); if ((v & 0xffu) >= 4u) break; __builtin_amdgcn_s_sleep(1); if (++sp > (1u << 22)) break; }
        if (((v >> sh) & 7u) != 4u) {
            __builtin_amdgcn_fence(__ATOMIC_RELEASE, "agent"); asm volatile("s_waitcnt vmcnt(0)" ::: "memory");
            xb_add(gc + 16, 1u); sp = 0; while (xb_ld(gc + 16) < 4u) { __builtin_amdgcn_s_sleep(1); if (++sp > (1u << 22)) break; }
            __builtin_amdgcn_fence(__ATOMIC_ACQUIRE, "agent"); }
        asm volatile("s_waitcnt vmcnt(0)" ::: "memory"); }
    __syncthreads();
}

struct Args { const void* in[27]; float* out; unsigned char* ws; int ph_lo, ph_hi, li, pad; };
struct LayerW {
    const float *g_attn, *w_in, *pool_w, *pool_scale, *dqn, *dkn, *dlam, *dsub, *fqn, *fkn, *ffb, *w_branch, *w_out, *g_ffn, *wrg, *brg, *wre, *bre, *wg, *wu, *wd, *g_ple, *wpg, *wple, *p;
};
__device__ __forceinline__ LayerW layer_view(const __attribute__((address_space(4))) Args* a, int l) {
    LayerW w; const float* in[27];
#pragma unroll
    for (int i = 0; i < 27; ++i) in[i] = (const float*)a->in[i];
    w.g_attn = in[3] + l * 1024; w.w_in = in[4] + (size_t)l * 1024 * INW; w.pool_w = in[5] + (size_t)l * 65536; w.pool_scale = in[6] + l * 512;
    w.dqn = in[7] + l * 64; w.dkn = in[8] + l * 64; w.dlam = in[9] + l * 256; w.dsub = in[10] + l * 128; w.fqn = in[11] + l * 64; w.fkn = in[12] + l * 64; w.ffb = in[13] + l * 8;
    w.w_branch = in[14] + (size_t)l * 3 * 512 * 1024; w.w_out = in[15] + (size_t)l * 1024 * 1024; w.g_ffn = in[16] + l * 1024; w.wrg = in[17] + (size_t)l * 4096; w.brg = in[18] + l * 4;
    w.wre = in[19] + (size_t)l * 16384; w.bre = in[20] + l * 16; w.wg = in[21] + (size_t)l * 16 * 262144; w.wu = in[22] + (size_t)l * 16 * 262144; w.wd = in[23] + (size_t)l * 16 * 262144;
    w.g_ple = in[24] + l * 1024; w.wpg = in[25] + (size_t)l * 1024 * 1024; w.wple = in[26] + (size_t)l * 256 * 1024; w.p = in[1] + (size_t)l * T * 256;
    return w;
}

__device__ __forceinline__ void tr_item(const float* __restrict__ src, int ldsrc, int c0, int nvalid, int k0, const float* __restrict__ gk, bf16* dst, int dpitch, int nrow0, int dk0, LAS float* scr, int lane, const bool f8 = false) {
    float vv[32];
#pragma unroll
    for (int i = 0; i < 32; ++i) { const int kk = 2 * i + (lane >> 5), c = lane & 31; vv[i] = (c < nvalid) ? src[(size_t)(k0 + kk) * ldsrc + c0 + c] : 0.f; }
    if (gk) {
#pragma unroll
        for (int i = 0; i < 32; ++i) vv[i] *= gk[k0 + 2 * i + (lane >> 5)]; }
#pragma unroll
    for (int i = 0; i < 32; ++i) scr[(2 * i + (lane >> 5)) * 33 + (lane & 31)] = vv[i];
    LDS_WAIT(); asm volatile("" ::: "memory");
    const int c8 = lane & 7;
#pragma unroll
    for (int j = 0; j < 4; ++j) { const int n = (lane >> 3) + 8 * j; const LAS float* s = scr + (8 * c8) * 33 + n;
        if (f8) { typedef unsigned v2u_ __attribute__((ext_vector_type(2))); v2u_ o;
            o.x = pk_fp8x4(s[0 * 33] * G8_SCALE, s[1 * 33] * G8_SCALE, s[2 * 33] * G8_SCALE, s[3 * 33] * G8_SCALE); o.y = pk_fp8x4(s[4 * 33] * G8_SCALE, s[5 * 33] * G8_SCALE, s[6 * 33] * G8_SCALE, s[7 * 33] * G8_SCALE);
            *(GAS v2u_*)((GAS char*)dst + (size_t)(nrow0 + n) * dpitch + dk0 + 8 * c8) = o; }
        else { v4u o; o.x = pk2(s[0 * 33], s[1 * 33]); o.y = pk2(s[2 * 33], s[3 * 33]); o.z = pk2(s[4 * 33], s[5 * 33]); o.w = pk2(s[6 * 33], s[7 * 33]);
            *(GAS v4u*)(dst + (size_t)(nrow0 + n) * dpitch + dk0 + 8 * c8) = o; } }
    LDS_WAIT(); asm volatile("" ::: "memory");
}
constexpr int CV_EARLY = 1536 + 128 + 1536 + 768, CV_NIT = CV_EARLY + 512 + 4096 + 2048 + 512 + 128, CV_LATE_BATCHES = (CV_NIT - CV_EARLY + 7) / 8, CV_RT_BATCHES = 64, CV_PB_BATCHES = 64;
__device__ __forceinline__ void conv_item(const LayerW& w, unsigned char* ws, int l, int it, LAS float* scr, int lane) {
    bf16* Wb = (bf16*)(ws + WS_W); bf16* WIN = (bf16*)(ws + WS_W + W_IN); bf16* WOUT = (bf16*)(ws + WS_W + W_OUT);
    bf16* WGU = (bf16*)(ws + WS_W + W_GU); bf16* WDN = (bf16*)(ws + WS_W + W_D); bf16* WPG = (bf16*)(ws + WS_WPLE + l * WPLE_STRIDE + W_PG); bf16* WP = (bf16*)(ws + WS_WPLE + l * WPLE_STRIDE + W_P);
    (void)Wb;
    constexpr int I_A = 1536, I_B = 128, I_D1 = 1536, I_D2 = 768, I_E = 512, I_F = 4096, I_G = 2048, I_H1 = 512, I_H2 = 128;
    constexpr int NIT = I_A + I_B + I_D1 + I_D2 + I_E + I_F + I_G + I_H1 + I_H2;
    int r = it;
        if (r < I_A) { const int kb = r / 96, nb = r % 96, p0 = 512 + 32 * nb, pn = p0 >> 8, q0 = p0 & 255;
            const bool head = (pn >= 2 && pn <= 5) || (pn >= 8 && pn <= 11);
            const int c0 = head ? (256 * pn + 64 * ((q0 >> 5) & 3) + 32 * (q0 >> 7)) : p0;
            tr_item(w.w_in, INW, c0, 32, 64 * kb, w.g_attn, WIN, 1024, p0, 64 * kb, scr, lane); return; } r -= I_A;
        if (r < I_B) { const int kb = r / 8, nb = r % 8; tr_item(w.w_in, INW, 3584, nb == 0 ? 8 : 0, 64 * kb, w.g_attn, WIN, 1024, 3584 + 32 * nb, 64 * kb, scr, lane); return; } r -= I_B;
        if (r < I_D1) { const int n = r / 512, r2 = r % 512, kb = r2 / 32, nb = r2 % 32;
            tr_item(w.w_in, INW, 3592 + n * 1024 + 32 * nb, 32, 64 * kb, w.g_attn, (bf16*)(ws + WS_W + W_G8 + (size_t)n * 1024 * 1024), 1024, 32 * nb, 64 * kb, scr, lane, true); return; } r -= I_D1;
        if (r < I_D2) { const int n = r / 256, r2 = r % 256, kb = r2 / 32, nb = r2 % 32;
            tr_item(w.w_branch + (size_t)n * 512 * 1024, 1024, 32 * nb, 32, 64 * kb, nullptr, (bf16*)(ws + WS_W + W_BR) + (size_t)n * 1024 * 512, 512, 32 * nb, 64 * kb, scr, lane); return; } r -= I_D2;
        if (r < I_E) { const int kb = r / 32, nb = r % 32; tr_item(w.w_out, 1024, 32 * nb, 32, 64 * kb, nullptr, WOUT, 1024, 32 * nb, 64 * kb, scr, lane); return; } r -= I_E;
        if (r < I_F) { const int e = r / 256, r1 = r % 256, hf = r1 / 128, r2 = r1 % 128, kb = r2 / 8, nb = r2 % 8, q0 = 32 * nb;
            const float* src = ((q0 >> 7) ? w.wu : w.wg) + (size_t)e * 262144;
            const bool f8 = MK_MU8 && l == NL - 1;
            tr_item(src, 256, 128 * hf + (q0 & 127), 32, 64 * kb, w.g_ffn, f8 ? (bf16*)((unsigned char*)WGU + (size_t)(e * 2 + hf) * 256 * 1024) : WGU + (size_t)(e * 2 + hf) * 256 * 1024, 1024, q0, 64 * kb, scr, lane, f8); return; } r -= I_F;
        if (r < I_G) { const int e = r / 128, r2 = r % 128, kb = r2 / 32, nb = r2 % 32;
            tr_item(w.wd + (size_t)e * 262144, 1024, 32 * nb, 32, 64 * kb, nullptr, WDN + (size_t)e * 262144, 256, 32 * nb, 64 * kb, scr, lane); return; } r -= I_G;
        if (r < I_H1) { const int kb = r / 32, nb = r % 32; tr_item(w.wpg, 1024, 32 * nb, 32, 64 * kb, w.g_ple, WPG, 1024, 32 * nb, 64 * kb, scr, lane, MK_PLE8 != 0); return; } r -= I_H1;
        { const int kb = r / 32, nb = r % 32; tr_item(w.wple, 1024, 32 * nb, 32, 64 * kb, nullptr, WP, 256, 32 * nb, 64 * kb, scr, lane); }
}
__device__ __forceinline__ void conv_late_batch(const LayerW& w, unsigned char* ws, int l, LAS unsigned char* lds, int batch, int tid) {
    const int lane = tid & 63, wave = __builtin_amdgcn_readfirstlane(tid >> 6);
    if (batch < CV_LATE_BATCHES) { const int it = CV_EARLY + batch * 8 + wave; if (it < CV_NIT) conv_item(w, ws, l, it, (LAS float*)(lds + wave * 16384), lane); }
    else if (batch >= CV_LATE_BATCHES + CV_RT_BATCHES) {
        const int i0 = (batch - CV_LATE_BATCHES - CV_RT_BATCHES) * 8192 + tid; GAS v4u* PB = (GAS v4u*)(ws + OV_PB);
#pragma clang loop unroll(disable)
        for (int q0 = 0; q0 < 16; q0 += 4) { f32x4 a[4], b[4];
#pragma unroll
            for (int q = 0; q < 4; ++q) { const GAS f32x4* s = (const GAS f32x4*)(w.p) + 2 * (size_t)(i0 + (q0 + q) * 512); a[q] = s[0]; b[q] = s[1]; }
#pragma unroll
            for (int q = 0; q < 4; ++q) { v4u o; o.x = pk2(a[q].x, a[q].y); o.y = pk2(a[q].z, a[q].w); o.z = pk2(b[q].x, b[q].y); o.w = pk2(b[q].z, b[q].w); PB[i0 + (q0 + q) * 512] = o; } } }
    else { const int idx = (batch - CV_LATE_BATCHES) * 512 + tid; const int e = idx >> 10, k = idx & 1023;
        const float v = w.g_ffn[k] * (e < 4 ? w.wrg[k * 4 + e] : (e < 20 ? w.wre[k * 16 + e - 4] : 0.f));
        const unsigned hi = pk2(v, 0.f) & 0xffffu; const unsigned lo = pk2(v - bflo(hi), 0.f) & 0xffffu;
        ((bf16*)(ws + WS_W + W_RH))[idx] = (bf16)hi; ((bf16*)(ws + WS_W + W_RL))[idx] = (bf16)lo; }
}
__device__ __forceinline__ void weff_job(const LayerW& w, unsigned char* ws, LAS unsigned char* lds, int job, int tid) {
    bf16* WIN = (bf16*)(ws + WS_W + W_IN);
    LAS float* Wt = (LAS float*)lds; LAS float* Pw = (LAS float*)(lds + 36864);
    const int kb = job >> 4, g = (job >> 2) & 3, nq = job & 3, k0 = 64 * kb;
    for (int e = tid; e < 64 * 128; e += 512) { const int kk = e >> 7, c = e & 127; Wt[kk * 132 + c] = w.w_in[(size_t)(k0 + kk) * INW + 128 * g + c]; }
    for (int e = tid; e < 128 * 32; e += 512) { const int c = e >> 5, n = e & 31; Pw[c * 32 + n] = w.pool_w[(size_t)g * 16384 + c * 128 + 32 * nq + n]; }
    __syncthreads();
    const int n = tid & 31, ks = tid >> 5; float a[4] = {0.f, 0.f, 0.f, 0.f};
#pragma unroll 2
    for (int c = 0; c < 128; c += 4) {
        const float p0 = Pw[c * 32 + n], p1 = Pw[(c + 1) * 32 + n], p2 = Pw[(c + 2) * 32 + n], p3 = Pw[(c + 3) * 32 + n];
#pragma unroll
        for (int i = 0; i < 4; ++i) { const f32x4 w4 = *(const LAS f32x4*)(Wt + (ks * 4 + i) * 132 + c); a[i] += (w4.x * p0 + w4.y * p1) + (w4.z * p2 + w4.w * p3); } }
    const float sc = w.pool_scale[128 * g + 32 * nq + n];
#pragma unroll
    for (int i = 0; i < 4; ++i) a[i] *= sc * w.g_attn[k0 + ks * 4 + i];
    *(GAS unsigned long long*)(WIN + (size_t)(128 * g + 32 * nq + n) * 1024 + k0 + ks * 4) = (unsigned long long)pk2(a[0], a[1]) | ((unsigned long long)pk2(a[2], a[3]) << 32);
    __syncthreads();
}
__device__ __forceinline__ void conv_layer(const LayerW& w, unsigned char* ws, int l, LAS unsigned char* lds, int vcu, int G, int tid) {
    const int lane = tid & 63, wave = __builtin_amdgcn_readfirstlane(tid >> 6);
    LAS float* scr = (LAS float*)(lds + wave * 16384);
    const int gw = vcu * NWAVES + wave, NGW = G * NWAVES;
    for (int it = gw; it < CV_EARLY; it += NGW) conv_item(w, ws, l, it, scr, lane);
    __syncthreads();
    for (int job = vcu; job < 256; job += G) weff_job(w, ws, lds, job, tid);
}
constexpr int CV_EARLY_BATCHES = CV_EARLY / 8 + 256;
__device__ __forceinline__ void conv_early_batch(const LayerW& w, unsigned char* ws, int l, LAS unsigned char* lds, int batch, int tid) {
    const int lane = tid & 63, wave = __builtin_amdgcn_readfirstlane(tid >> 6);
    if (batch < CV_EARLY / 8) { conv_item(w, ws, l, batch * 8 + wave, (LAS float*)(lds + wave * 16384), lane); __syncthreads(); }
    else weff_job(w, ws, lds, batch - CV_EARLY / 8, tid);
}
__device__ __forceinline__ void p0_x(const float* x, const int* positions, unsigned char* ws, unsigned char* x8, int vcu, int G, int tid) {
    const int lane = tid & 63, wave = __builtin_amdgcn_readfirstlane(tid >> 6);
    bf16* XY = (bf16*)(ws + WS_XY); float* SS = (float*)(ws + WS_SS); float* CS = (float*)(ws + WS_COSSIN);
    const int gw = vcu * NWAVES + wave, NGW = G * NWAVES;
    for (int t = gw; t < T; t += NGW) {
        const GAS f32x4* xr = (const GAS f32x4*)(x + (size_t)t * 1024) + lane; float s = 0.f;
        GAS unsigned long long* o8 = (GAS unsigned long long*)(XY + (size_t)t * XYP + 1536) + lane;
#pragma unroll
        for (int j = 0; j < 4; ++j) { const f32x4 v = xr[64 * j]; s += (v.x * v.x + v.y * v.y) + (v.z * v.z + v.w * v.w); o8[64 * j] = (unsigned long long)pk2(v.x, v.y) | ((unsigned long long)pk2(v.z, v.w) << 32);
            ((GAS unsigned*)(x8 + (size_t)t * 1024))[lane + 64 * j] = pk_fp8x4(v.x, v.y, v.z, v.w); }
        s = wave_sum64(s);
        if (lane < 16) SS[(size_t)t * 16 + lane] = lane == 0 ? s : 0.f;
    }
    for (int idx = vcu * 512 + tid; idx < T * 8; idx += G * 512) { const int t = idx >> 3, i = idx & 7;
        const float invf = powf(500000.0f, -(float)(2 * i) / 16.0f); const float ang = (float)positions[t] * invf;
        CS[(size_t)t * 16 + i] = cosf(ang); CS[(size_t)t * 16 + 8 + i] = sinf(ang); }
}

typedef pg8::f32x4 (&AccRef)[2][2][4][2];
#define LAUNDER3(a, b, c) asm volatile("" : "+v"(a), "+v"(b), "+v"(c))
__device__ __forceinline__ float rstd_at(const float* SS, unsigned row) {
    const GAS f32x4* p = (const GAS f32x4*)((const GAS char*)SS + row * 64u); const f32x4 a = p[0], b = p[1], c = p[2], d = p[3];
    const float s = ((a.x + a.y) + (a.z + a.w)) + ((b.x + b.y) + (b.z + b.w)) + ((c.x + c.y) + (c.z + c.w)) + ((d.x + d.y) + (d.z + d.w));
    return rsqrtf(s * (1.0f / 1024.0f) + RMS_EPS);
}
__device__ __forceinline__ void rstd8(const float* SS, unsigned row0, int fq, float (&rs)[8]) {
    f32x4 v[8];
#pragma unroll
    for (int i = 0; i < 8; ++i) v[i] = *(const GAS f32x4*)((const GAS char*)SS + ((row0 + (unsigned)((i >> 2) * 128 + (i & 3) * 16)) * 64u + (unsigned)fq * 16u));
#pragma unroll
    for (int i = 0; i < 8; ++i) { float s = (v[i].x + v[i].y) + (v[i].z + v[i].w); s += XOR16(s); s = add_xor32(s); rs[i] = rsqrtf(s * (1.0f / 1024.0f) + RMS_EPS); }
}
__device__ __forceinline__ float logsig(float z) { return fminf(z, 0.f) - log1pf(expf(-fabsf(z))); }
struct EpiG1 {
    const float* SS; bf16* PROJ; float* LOGF; const float* CS; const float* GT; const float* ffb; int dry;
    __device__ __forceinline__ void operator()(AccRef acc, const pg8::Step& st, int wr, int wc, int fr_, int fq_) const {
        if (dry) return;
        int fr = fr_, fq = fq_, zz = 0; LAUNDER3(fr, fq, zz);
        const int pn = st.pn; const unsigned row0 = (unsigned)(st.pm * 256 + wr * 64 + fr);
        const bool head = (pn >= 2 && pn <= 5) || (pn >= 8 && pn <= 11);
        if (head) {
            const float* gain = GT + 64 * (pn < 4 ? 0 : (pn < 6 ? 1 : (pn < 10 ? 2 : 3)));
            const bool rot = pn < 6; const float osc = (pn < 4 || (pn >= 8 && pn < 10)) ? C2 : 1.0f;
            f32x4 G[2][2];
#pragma unroll
            for (int bj = 0; bj < 2; ++bj)
#pragma unroll
                for (int n = 0; n < 2; ++n) G[bj][n] = *(const GAS f32x4*)((const GAS char*)gain + (unsigned)(32 * bj + 8 * fq + 4 * n) * 4u);
            const GAS char* pb = (const GAS char*)PROJ + (unsigned)(256 * pn + 64 * wc) * 2u;
            float rs8[8]; rstd8(SS, row0, fq, rs8);
            f32x4 cs[4];
#define G1_LOADCS(i_) do { if (rot && fq < 2) { const GAS f32x4* cp_ = (const GAS f32x4*)((const GAS char*)CS + (row0 + (unsigned)(((i_) >> 2) * 128 + ((i_) & 3) * 16)) * 64u); \
                _Pragma("unroll") for (int q_ = 0; q_ < 4; ++q_) cs[q_] = cp_[q_]; } } while (0)
            G1_LOADCS(0);
#pragma unroll
            for (int i = 0; i < 8; ++i) {
                v4u ov[2];
                {
                    const int ai = i >> 2, m = i & 3; const float rs = rs8[i];
                    f32x4 v[2][2]; float ss = 0.f;
#pragma unroll
                    for (int bj = 0; bj < 2; ++bj)
#pragma unroll
                        for (int n = 0; n < 2; ++n) { v[bj][n] = acc[ai][bj][m][n]; const f32x4 q = v[bj][n] * v[bj][n]; ss += (q.x + q.y) + (q.z + q.w); }
                    ss += XOR16(ss); ss = add_xor32(ss);
                    const float hn = rsqrtf(ss * (1.0f / 64.0f) + RMS_EPS * __builtin_amdgcn_rcpf(rs * rs)) * osc;
#pragma unroll
                    for (int bj = 0; bj < 2; ++bj)
#pragma unroll
                        for (int n = 0; n < 2; ++n) v[bj][n] = v[bj][n] * hn * G[bj][n];
                    if (rot) {
                        f32x4 ot[2];
#pragma unroll
                        for (int n = 0; n < 2; ++n) { ot[n].x = XOR16(v[0][n].x); ot[n].y = XOR16(v[0][n].y); ot[n].z = XOR16(v[0][n].z); ot[n].w = XOR16(v[0][n].w); }
                        if (fq < 2) {
#pragma unroll
                            for (int n = 0; n < 2; ++n) { const f32x4 c = cs[n], s = cs[2 + n]; v[0][n] = (fq == 0) ? (v[0][n] * c - ot[n] * s) : (v[0][n] * c + ot[n] * s); }
                        }
                    }
#pragma unroll
                    for (int bj = 0; bj < 2; ++bj) { ov[bj].x = pk2(v[bj][0].x, v[bj][0].y); ov[bj].y = pk2(v[bj][0].z, v[bj][0].w); ov[bj].z = pk2(v[bj][1].x, v[bj][1].y); ov[bj].w = pk2(v[bj][1].z, v[bj][1].w); }
                }
                if (i < 7) G1_LOADCS(i + 1);
                asm volatile("" ::: "memory");
                { const unsigned row = row0 + (unsigned)((i >> 2) * 128 + (i & 3) * 16);
#pragma unroll
                    for (int bj = 0; bj < 2; ++bj) *(GAS v4u*)(pb + (row * (unsigned)(PJP * 2) + (unsigned)(32 * bj + 8 * fq) * 2u)) = ov[bj]; }
                asm volatile("" ::: "memory");
            }
#undef G1_LOADCS
        } else if (pn == 14) {
            float rs14[8]; rstd8(SS, row0, fq, rs14);
            if (wc == 0 && fq == 0) {
                const f32x4 b0 = *(const GAS f32x4*)ffb, b1 = *(const GAS f32x4*)(ffb + 4);
#pragma unroll
                for (int ai = 0; ai < 2; ++ai)
#pragma unroll
                    for (int m = 0; m < 4; ++m) {
                        const unsigned row = row0 + ai * 128 + m * 16; const float rs = rs14[ai * 4 + m];
                        const f32x4 z0 = acc[ai][0][m][0] * rs + b0, z1 = acc[ai][0][m][1] * rs + b1; f32x4 o0, o1;
                        o0.x = logsig(z0.x); o0.y = logsig(z0.y); o0.z = logsig(z0.z); o0.w = logsig(z0.w); o1.x = logsig(z1.x); o1.y = logsig(z1.y); o1.z = logsig(z1.z); o1.w = logsig(z1.w);
                        GAS f32x4* d = (GAS f32x4*)((GAS char*)LOGF + row * 32u); d[0] = o0; d[1] = o1;
                    }
            }
        } else {
            const GAS char* pb = (const GAS char*)PROJ + (unsigned)(256 * pn + 32 * wc) * 2u;
            float rsp[8]; rstd8(SS, row0, fq, rsp);
#pragma unroll
            for (int ai = 0; ai < 2; ++ai)
#pragma unroll
                for (int m = 0; m < 4; ++m) {
                    const unsigned row = row0 + ai * 128 + m * 16; const float rs = rsp[ai * 4 + m];
#pragma unroll
                    for (int bj = 0; bj < 2; ++bj) { const f32x4 a = acc[ai][bj][m][0] * rs, b = acc[ai][bj][m][1] * rs; v4u o; o.x = pk2(a.x, a.y); o.y = pk2(a.z, a.w); o.z = pk2(b.x, b.y); o.w = pk2(b.z, b.w);
                        *(GAS v4u*)(pb + (row * (unsigned)(PJP * 2) + (unsigned)(128 * bj + 8 * fq) * 2u)) = o; }
                }
        }
    }
};
typedef unsigned v2u __attribute__((ext_vector_type(2)));
__device__ __forceinline__ unsigned pk8(float a, float b, float c, float d) {
    unsigned w = __builtin_amdgcn_cvt_pk_u8_f32(a * 256.0f - 0.5f, 0u, 0u); w = __builtin_amdgcn_cvt_pk_u8_f32(b * 256.0f - 0.5f, 1u, w); w = __builtin_amdgcn_cvt_pk_u8_f32(c * 256.0f - 0.5f, 2u, w); return __builtin_amdgcn_cvt_pk_u8_f32(d * 256.0f - 0.5f, 3u, w); }
__device__ __forceinline__ float g8(unsigned w, const int k) { return ((float)((w >> (8 * k)) & 0xffu) + 0.5f) * (1.0f / 256.0f); }
__device__ __forceinline__ float g8u(unsigned w, const int k) { return (float)((w >> (8 * k)) & 0xffu) + 0.5f; }
template <int PART>
struct EpiG2 {
    const float* SS; unsigned char* gs; bf16* MERGED;
    __device__ __forceinline__ void operator()(AccRef acc, const pg8::Step& st, int wr, int wc, int fr_, int fq_) const {
        int ln; asm volatile("v_mbcnt_lo_u32_b32 %0, -1, 0\n\tv_mbcnt_hi_u32_b32 %0, -1, %0" : "=v"(ln));
        int fr = ln & 15, fq = ln >> 4, tid = (wr * 4 + wc) * 64 + ln; LAUNDER3(fr, fq, tid); (void)fr_; (void)fq_;
        const int aux = st.aux; const unsigned row0 = (unsigned)(st.pm * 256 + wr * 64 + fr), toff = (unsigned)tid * 8u;
        const int n = aux < 3 ? aux : aux - 3; GAS char* gb = (GAS char*)gs + (size_t)n * 65536;
        GAS char* mb = (GAS char*)MERGED + (unsigned)(256 * st.pn + 32 * wc) * 2u;
        float rsg[8];
#pragma unroll
        for (int i = 0; i < 8; ++i) rsg[i] = 0.f;
        if (PART == 0) rstd8(SS, row0, fq, rsg);
#pragma unroll
        for (int ai = 0; ai < 2; ++ai) {
            v2u gn[4][2], gd[4][2];
#pragma unroll
            for (int m = 0; m < 4; ++m)
#pragma unroll
                for (int bj = 0; bj < 2; ++bj) { gn[m][bj] = (v2u){0u, 0u}; gd[m][bj] = (v2u){0u, 0u}; }
            if (PART == 1) {
#pragma unroll
                for (int m = 0; m < 4; ++m)
#pragma unroll
                    for (int bj = 0; bj < 2; ++bj) { const unsigned so = toff + (unsigned)(((ai * 4 + m) * 2 + bj) * 4096); gn[m][bj] = *(const GAS v2u*)(gb + so); if (aux < 5) gd[m][bj] = *(const GAS v2u*)(gb + 65536 + so); }
            }
            asm volatile("" ::: "memory");
#pragma unroll
            for (int m = 0; m < 4; ++m) {
                const float rs = rsg[ai * 4 + m] * (1.0f / G8_SCALE);
#pragma unroll
                for (int bj = 0; bj < 2; ++bj) {
                    const unsigned so = toff + (unsigned)(((ai * 4 + m) * 2 + bj) * 4096);
                    const f32x4 a = acc[ai][bj][m][0], b = acc[ai][bj][m][1]; const v2u n_ = gn[m][bj], d_ = gd[m][bj];
                    f32x4 fa = (f32x4){0.f, 0.f, 0.f, 0.f}, fb = fa;
                    if (PART == 0) { const float rsn = rs * -1.4426950408889634f; const f32x4 x = a * rsn, y = b * rsn; v2u o;
                        o.x = pk8(sg2(x.x), sg2(x.y), sg2(x.z), sg2(x.w)); o.y = pk8(sg2(y.x), sg2(y.y), sg2(y.z), sg2(y.w));
                        *(GAS v2u*)(gb + so) = o;
                    } else if (aux < 5) {
                        fa.x = g8u(n_.x, 0) * __builtin_amdgcn_rcpf(g8u(d_.x, 0)); fa.y = g8u(n_.x, 1) * __builtin_amdgcn_rcpf(g8u(d_.x, 1)); fa.z = g8u(n_.x, 2) * __builtin_amdgcn_rcpf(g8u(d_.x, 2)); fa.w = g8u(n_.x, 3) * __builtin_amdgcn_rcpf(g8u(d_.x, 3));
                        fb.x = g8u(n_.y, 0) * __builtin_amdgcn_rcpf(g8u(d_.y, 0)); fb.y = g8u(n_.y, 1) * __builtin_amdgcn_rcpf(g8u(d_.y, 1)); fb.z = g8u(n_.y, 2) * __builtin_amdgcn_rcpf(g8u(d_.y, 2)); fb.w = g8u(n_.y, 3) * __builtin_amdgcn_rcpf(g8u(d_.y, 3));
                    } else { v4u o;
                        o.x = pk2(a.x * g8(n_.x, 0), a.y * g8(n_.x, 1)); o.y = pk2(a.z * g8(n_.x, 2), a.w * g8(n_.x, 3)); o.z = pk2(b.x * g8(n_.y, 0), b.y * g8(n_.y, 1)); o.w = pk2(b.z * g8(n_.y, 2), b.w * g8(n_.y, 3));
                        *(GAS v4u*)(mb + ((row0 + ai * 128 + m * 16) * 2048u + (unsigned)(128 * bj + 8 * fq) * 2u)) = o;
                    }
                    acc[ai][bj][m][0] = a * fa; acc[ai][bj][m][1] = b * fb;
                    asm volatile("" : "+v"(acc[ai][bj][m][0]), "+v"(acc[ai][bj][m][1]));
                }
            }
            asm volatile("" ::: "memory");
        }
    }
};
#ifndef MK_X8
#define MK_X8 1
#endif
template <int KIND, bool SCATTER>
struct EpiRes {
    const bf16* xs; int ldxs; float* xo; bf16* xb; int ldxb; float* SSo; const float* SSi; const bf16* PW; int dry; unsigned char* x8;
    __device__ __forceinline__ void operator()(AccRef acc, const pg8::Step& st, int wr, int wc, int fr_, int fq_) const {
        if (SCATTER && st.aux == 0) return;
        int fr = fr_, fq = fq_, zz = 0; LAUNDER3(fr, fq, zz);
        const int pn = st.pn; const unsigned colb = (unsigned)(256 * pn + 32 * wc + 8 * fq);
        int rowi[8];
#pragma unroll
        for (int i = 0; i < 8; ++i) { const int r = (i >> 2) * 128 + wr * 64 + (i & 3) * 16 + fr; rowi[i] = SCATTER ? ((r < st.nvalid) ? st.rows[r] : -1) : (st.pm * 256 + r); }
        float rs8[8];
#pragma unroll
        for (int i = 0; i < 8; ++i) rs8[i] = 1.f;
        if (KIND == 1) { rstd8(SSi, (unsigned)(st.pm * 256 + wr * 64 + fr), fq, rs8);
            if (MK_PLE8) {
#pragma unroll
                for (int i = 0; i < 8; ++i) rs8[i] *= (1.0f / G8_SCALE); } }
        v4u xin[2][2][2]; v4u pwv[2][2][2];
#define RES_LOAD(p_, buf_) do { _Pragma("unroll") for (int u_ = 0; u_ < 2; ++u_) { const int i_ = 2 * (p_) + u_; const unsigned rw_ = rowi[i_] >= 0 ? (unsigned)rowi[i_] : 0u; \
            _Pragma("unroll") for (int bj_ = 0; bj_ < 2; ++bj_) { xin[buf_][u_][bj_] = *(const GAS v4u*)((const GAS char*)xs + (rw_ * (unsigned)ldxs + colb + 128u * bj_) * 2u); \
                if (KIND == 1) pwv[buf_][u_][bj_] = *(const GAS v4u*)((const GAS char*)PW + (rw_ * 1024u + colb + 128u * bj_) * 2u); } } } while (0)
        RES_LOAD(0, 0);
#pragma unroll
        for (int pr = 0; pr < 4; ++pr) {
            float ssp[2]; f32x4 xr[2][2][2];
#pragma unroll
            for (int u = 0; u < 2; ++u) {
                const int i = 2 * pr + u, ai = i >> 2, m = i & 3; const float rs = rs8[i]; float ss = 0.f;
#pragma unroll
                for (int bj = 0; bj < 2; ++bj) {
                    const v4u xv = xin[pr & 1][u][bj];
                    f32x4 x0 = (f32x4){bflo(xv.x), bfhi(xv.x), bflo(xv.y), bfhi(xv.y)}, x1 = (f32x4){bflo(xv.z), bfhi(xv.z), bflo(xv.w), bfhi(xv.w)};
                    f32x4 a = acc[ai][bj][m][0], b = acc[ai][bj][m][1];
                    if (KIND == 1) { const v4u pw = pwv[pr & 1][u][bj];
                        const float rsn = rs * -1.4426950408889634f;
                        a.x = sg2(a.x * rsn) * bflo(pw.x); a.y = sg2(a.y * rsn) * bfhi(pw.x); a.z = sg2(a.z * rsn) * bflo(pw.y); a.w = sg2(a.w * rsn) * bfhi(pw.y);
                        b.x = sg2(b.x * rsn) * bflo(pw.z); b.y = sg2(b.y * rsn) * bfhi(pw.z); b.z = sg2(b.z * rsn) * bflo(pw.w); b.w = sg2(b.w * rsn) * bfhi(pw.w); }
                    x0 += a; x1 += b;
                    { const f32x4 q0 = x0 * x0, q1 = x1 * x1; ss += ((q0.x + q0.y) + (q0.z + q0.w)) + ((q1.x + q1.y) + (q1.z + q1.w)); }
                    xr[u][bj][0] = x0; xr[u][bj][1] = x1;
                }
                ss += XOR16(ss); ss = add_xor32(ss); ssp[u] = ss;
            }
            if (pr < 3) RES_LOAD(pr + 1, (pr + 1) & 1);
            asm volatile("" ::: "memory");
#pragma unroll
            for (int u = 0; u < 2; ++u) {
                const int i = 2 * pr + u; const bool ok = rowi[i] >= 0 && !dry; const unsigned rw = rowi[i] >= 0 ? (unsigned)rowi[i] : 0u;
                if (ok) {
#pragma unroll
                    for (int bj = 0; bj < 2; ++bj) { const f32x4 x0 = xr[u][bj][0], x1 = xr[u][bj][1];
                        if (xo) { GAS f32x4* op = (GAS f32x4*)((GAS char*)xo + (rw * 1024u + colb + 128u * bj) * 4u); op[0] = x0; op[1] = x1; }
                        if (xb) { v4u o; o.x = pk2(x0.x, x0.y); o.y = pk2(x0.z, x0.w); o.z = pk2(x1.x, x1.y); o.w = pk2(x1.z, x1.w);
                            *(GAS v4u*)((GAS char*)xb + (rw * (unsigned)ldxb + colb + 128u * bj) * 2u) = o; }
                        if (MK_X8 && x8) { v2u o2; o2.x = pk_fp8x4(x0.x, x0.y, x0.z, x0.w); o2.y = pk_fp8x4(x1.x, x1.y, x1.z, x1.w); *(GAS v2u*)((GAS char*)x8 + (rw * 1024u + colb + 128u * bj)) = o2; } }
                    if (fq == 0 && xb) *(GAS float*)((GAS char*)SSo + (rw * 16u + (unsigned)(4 * pn + wc)) * 4u) = ssp[u];
                }
            }
            asm volatile("" ::: "memory");
        }
#undef RES_LOAD
    }
};
struct EpiPW {
    bf16* O;
    __device__ __forceinline__ void operator()(AccRef acc, const pg8::Step& st, int wr, int wc, int fr_, int fq_) const {
        int fr = fr_, fq = fq_, zz = 0; LAUNDER3(fr, fq, zz);
        GAS char* ob = (GAS char*)O + (unsigned)(256 * st.pn + 32 * wc) * 2u; const unsigned row0 = (unsigned)(st.pm * 256 + wr * 64 + fr);
#pragma unroll
        for (int ai = 0; ai < 2; ++ai)
#pragma unroll
            for (int m = 0; m < 4; ++m) {
#pragma unroll
                for (int bj = 0; bj < 2; ++bj) { const f32x4 a = acc[ai][bj][m][0], b = acc[ai][bj][m][1]; v4u o; o.x = pk2(a.x, a.y); o.y = pk2(a.z, a.w); o.z = pk2(b.x, b.y); o.w = pk2(b.z, b.w);
                    *(GAS v4u*)(ob + ((row0 + ai * 128 + m * 16) * 2048u + (unsigned)(128 * bj + 8 * fq) * 2u)) = o; }
                asm volatile("" ::: "memory"); }
    }
};
struct EpiMU {
    bf16* ACT; const float* TOKW; float sc;
    __device__ __forceinline__ void operator()(AccRef acc, const pg8::Step& st, int wr, int wc, int fr_, int fq_) const {
        int fr = fr_, fq = fq_, zz = 0; LAUNDER3(fr, fq, zz);
        const int j = st.pn; GAS char* ab = (GAS char*)ACT + (size_t)st.pm * 1024 + (unsigned)(128 * j + 32 * wc) * 2u;
        int tok[8]; f32x4 tw[8];
#pragma unroll
        for (int i = 0; i < 8; ++i) { const int r = (i >> 2) * 128 + wr * 64 + (i & 3) * 16 + fr; tok[i] = (r < st.nvalid) ? st.rows[r] : -1; }
#pragma unroll
        for (int i = 0; i < 8; ++i) { tw[i] = *(const GAS f32x4*)((const GAS char*)TOKW + (unsigned)(tok[i] >= 0 ? tok[i] : 0) * 16u); if (tok[i] < 0) tw[i] = (f32x4){0.f, 0.f, 0.f, 0.f}; }
        asm volatile("" ::: "memory");
#pragma unroll
        for (int i = 0; i < 8; ++i) {
            const int ai = i >> 2, m = i & 3, r = ai * 128 + wr * 64 + m * 16 + fr;
            const float rs = tw[i].z * sc, w = (j < 2) ? tw[i].x : tw[i].y;
            const f32x4 g0 = acc[ai][0][m][0] * rs, g1 = acc[ai][0][m][1] * rs, u0 = acc[ai][1][m][0] * rs, u1 = acc[ai][1][m][1] * rs; v4u o;
            o.x = pk2(g0.x * sigm(g0.x) * u0.x * w, g0.y * sigm(g0.y) * u0.y * w); o.y = pk2(g0.z * sigm(g0.z) * u0.z * w, g0.w * sigm(g0.w) * u0.w * w);
            o.z = pk2(g1.x * sigm(g1.x) * u1.x * w, g1.y * sigm(g1.y) * u1.y * w); o.w = pk2(g1.z * sigm(g1.z) * u1.z * w, g1.w * sigm(g1.w) * u1.w * w);
            *(GAS v4u*)(ab + ((unsigned)r * 1024u + (unsigned)(8 * fq) * 2u)) = o;
            asm volatile("" ::: "memory");
        }
    }
};

__device__ __forceinline__ bool tile_order(long L, int nM, int nN, int& pm, int& pn) {
    const int nwg = nM * nN; if (L >= nwg) return false;
    int wgid = (int)L; { const int q = nwg / 8, r = nwg % 8, xcd = wgid % 8, off = wgid / 8; wgid = (xcd < r ? xcd * (q + 1) : r * (q + 1) + (xcd - r) * q) + off; }
    const int nig = 8 * nN, gid = wgid / nig, fm = gid * 8, gsz = (nM - fm) < 8 ? (nM - fm) : 8;
    pm = fm + ((wgid % nig) % gsz); pn = (wgid % nig) / gsz; return true;
}
struct SchedPlain {
    const char* A; const char* B; size_t a_tile, b_tile; int nM, nN, nt, G, c, fixa, fixb;
    __device__ __forceinline__ bool next(int i, pg8::Step& s) const {
        int pm, pn; if (!tile_order((long)i * G + c, nM, nN, pm, pn)) return false;
        s.A = A + (size_t)(fixa ? 0 : pm) * a_tile; s.B = B + (size_t)(fixb ? 0 : pn) * b_tile; s.rows = nullptr; s.nt = nt; s.pm = pm; s.pn = pn; s.aux = 0; s.nvalid = 256; s.zero_after = 1; return true; }
};
template <int PART>
struct SchedG2 {
    const char* Ab; const char* Bb; int c;
    __device__ __forceinline__ bool next(int i, pg8::Step& s) const {
        if (i >= 3) return false; int pm, pn; tile_order(c, 64, 4, pm, pn);
        const int n = i;
        s.A = PART == 0 ? Ab + (size_t)pm * 256 * 1024 : Ab + (size_t)pm * 256 * (XYP * 2) + 512 * n * 2;
        s.B = Bb + ((size_t)n * 1024 + pn * 256) * 1024;
        s.rows = nullptr; s.nt = 8; s.pm = pm; s.pn = pn; s.aux = PART * 3 + i; s.nvalid = 256; s.zero_after = 0; return true; }
};
struct SchedMoE {
    volatile LAS unsigned* MISC; const int* LIST; const char* Ab; const char* Bb; int G, c, mode, f8;
    __device__ __forceinline__ bool next(int i, pg8::Step& s) const {
        const int NU = (int)MISC[MI_TOT]; const int u = c;
        if (u >= NU || i > (mode == 2 ? 1 : 0)) return false;
        const int down = mode == 2;
        int cls = 0;
#pragma unroll 1
        for (int k = 1; k < 24; ++k) if (u >= (int)MISC[MI_U0 + k]) cls = k;
        const int r = u - (int)MISC[MI_U0 + cls], k = r >> 2, j = r & 3, n_c = (int)MISC[MI_N + cls], arow = (int)MISC[MI_BASE + cls] + 256 * k;
        const int grp = cls / 6, pr = cls % 6; const int pa = pr < 3 ? 0 : (pr < 5 ? 1 : 2), pb = pr < 3 ? pr + 1 : (pr < 5 ? pr - 1 : 3);
        s.rows = LIST + (size_t)cls * T + 256 * k; s.nvalid = min(256, n_c - 256 * k); s.pm = arow; s.pn = j;
        if (!down) { const int e = grp * 4 + (j < 2 ? pa : pb), hf = j & 1;
            s.A = Ab; s.B = Bb + (size_t)(e * 2 + hf) * 256 * (f8 ? 1024 : 2048); s.nt = f8 ? 8 : 16; s.aux = cls; s.zero_after = 1; }
        else { const int sgm = i & 1; const int e = grp * 4 + (sgm ? pb : pa);
            s.A = Ab + (size_t)arow * 1024 + sgm * 512; s.B = Bb + ((size_t)e * 1024 + j * 256) * 512; s.nt = 4; s.aux = sgm; s.zero_after = sgm; }
        return true; }
};
__device__ __forceinline__ float wave_sum(float v) {
    return wave_sum64(v);
}
__device__ __forceinline__ void pool_unit(int u, const bf16* PROJ, bf16* XY, int tid_) {
    int tid = tid_; asm volatile("" : "+v"(tid));
    const int c8 = tid & 63, rg = tid >> 6, g = c8 >> 4, w = 2 << g, t0 = 256 * u + 32 * rg, s0 = t0 % S;
    const GAS char* zb = (const GAS char*)PROJ + (unsigned)c8 * 16u; GAS char* yb = (GAS char*)XY + (unsigned)c8 * 16u;
    float sum[8];
#pragma unroll
    for (int j = 0; j < 8; ++j) sum[j] = 0.f;
    { v4u pz[16];
#pragma unroll
      for (int k = 1; k <= 16; ++k) { const bool ok = k <= w && k <= s0; pz[k - 1] = *(const GAS v4u*)(zb + (unsigned)(ok ? t0 - k : t0) * (unsigned)(PJP * 2)); }
#pragma unroll
      for (int k = 1; k <= 16; ++k) { const bool ok = k <= w && k <= s0; const v4u z = pz[k - 1];
        if (ok) { sum[0] += bflo(z.x); sum[1] += bfhi(z.x); sum[2] += bflo(z.y); sum[3] += bfhi(z.y); sum[4] += bflo(z.z); sum[5] += bfhi(z.z); sum[6] += bflo(z.w); sum[7] += bfhi(z.w); } } }
#pragma clang loop unroll(disable)
    for (int r0 = 0; r0 < 32; r0 += 8) {
        v4u zz[8], qq[8];
#pragma unroll
        for (int j = 0; j < 8; ++j) { const int t = t0 + r0 + j, s = s0 + r0 + j;
            zz[j] = *(const GAS v4u*)(zb + (unsigned)t * (unsigned)(PJP * 2)); qq[j] = *(const GAS v4u*)(zb + (unsigned)(s >= w ? t - w : t) * (unsigned)(PJP * 2)); }
#pragma unroll
        for (int j = 0; j < 8; ++j) { const int t = t0 + r0 + j, s = s0 + r0 + j; const v4u z = zz[j], q = qq[j];
            float zf[8] = {bflo(z.x), bfhi(z.x), bflo(z.y), bfhi(z.y), bflo(z.z), bfhi(z.z), bflo(z.w), bfhi(z.w)};
#pragma unroll
            for (int i = 0; i < 8; ++i) sum[i] += zf[i];
            if (s >= w) { sum[0] -= bflo(q.x); sum[1] -= bfhi(q.x); sum[2] -= bflo(q.y); sum[3] -= bfhi(q.y); sum[4] -= bflo(q.z); sum[5] -= bfhi(q.z); sum[6] -= bflo(q.w); sum[7] -= bfhi(q.w); }
            const float ic = 1.0f / (float)min(s + 1, w); v4u o;
            o.x = pk2(sum[0] * ic - zf[0], sum[1] * ic - zf[1]); o.y = pk2(sum[2] * ic - zf[2], sum[3] * ic - zf[3]); o.z = pk2(sum[4] * ic - zf[4], sum[5] * ic - zf[5]); o.w = pk2(sum[6] * ic - zf[6], sum[7] * ic - zf[7]);
            *(GAS v4u*)(yb + (unsigned)t * (unsigned)(XYP * 2)) = o; }
    }
}
#ifndef MK_THRD
#define MK_THRD 32
#endif
#ifndef MK_THRF
#define MK_THRF 64
#endif
#ifndef MK_ATT_SKIP
#define MK_ATT_SKIP 0
#endif
__device__ __forceinline__ void attn_phase(const int wave0, const LayerW& w, int l, int rep, unsigned char* ws, char* lds, volatile LAS unsigned* MISC, gu32* ctl, const int dry) {
    using namespace attn_body;
    int tid = mk_tid(wave0); const int lane = tid & 63;
    bf16* PROJ = (bf16*)(ws + WS_PROJ); bf16* XY = (bf16*)(ws + WS_XY); bf16* STASH = (bf16*)(ws + WS_STASH); const float* LOGF = (const float*)(ws + WS_LOGF);
    const float lam_init = 0.8f - 0.6f * __expf(-0.3f * (float)l);
    float lam; { const float a = wave_sum(w.dlam[lane] * w.dlam[64 + lane]), c = wave_sum(w.dlam[128 + lane] * w.dlam[192 + lane]); lam = __expf(a) - __expf(c) + lam_init; lam = __int_as_float(__builtin_amdgcn_readfirstlane(__float_as_int(lam))); }
    unsigned* qhead = pg8::rflp((unsigned*)(ctl + CW_AQ) + rep); unsigned* fhead = pg8::rflp((unsigned*)(ctl + CW_AQ) + 64 + 16 * l);
    {
        unsigned* top = pg8::rflp((unsigned*)(ctl + CW_SPLIT3) + 64 * l);
#pragma clang loop unroll(disable)
        for (;;) {
            tid = mk_tid(wave0);
            if (tid == 0) { unsigned r = 0xffffffffu; if (xb_ld(top) < (unsigned)gridDim.x) { const unsigned f = atomicAdd(fhead, 1u); if (f < (unsigned)(CV_LATE_BATCHES + CV_RT_BATCHES + CV_PB_BATCHES)) r = f; } MISC[MI_Q] = r; }
            __syncthreads();
            const unsigned fb = MISC[MI_Q];
            __syncthreads();
            if (fb == 0xffffffffu) break;
            conv_late_batch(w, ws, l, (LAS unsigned char*)lds, (int)fb, tid); __syncthreads();
        }
        tid = mk_tid(wave0);
        if (tid == 0) split_wait_leader(top, (unsigned)gridDim.x);
        __syncthreads();
    }
    int first = 1;
    for (;;) {
        tid = mk_tid(wave0);
        if (tid == 0) { unsigned q = first ? (unsigned)blockIdx.x : (unsigned)gridDim.x + atomicAdd(qhead, 1u); if (q >= 832u) q = 832u + atomicAdd(fhead, 1u); MISC[MI_Q] = q; }
        first = 0;
        __syncthreads();
        const int idx = (int)MISC[MI_Q];
        __syncthreads();
        if (idx >= 832 + CV_LATE_BATCHES + CV_RT_BATCHES + CV_PB_BATCHES) break;
        if (idx >= 832) { if (MK_ATT_SKIP && dry && (MK_ATT_SKIP & 8)) continue; conv_late_batch(w, ws, l, (LAS unsigned char*)lds, idx - 832, tid); continue; }
        int kind, qb, bh;
        if (idx < 160) { kind = 0; qb = 7 - idx / 32; bh = idx % 32; }
        else if (idx < 224) { kind = 1; qb = 7; bh = idx - 160; }
        else if (idx < 256) { kind = 0; qb = 2; bh = idx - 224; }
        else if (idx < 384) { kind = 1; qb = 6 - (idx - 256) / 64; bh = (idx - 256) % 64; }
        else if (idx < 416) { kind = 0; qb = 1; bh = idx - 384; }
        else if (idx < 480) { kind = 1; qb = 4; bh = idx - 416; }
        else if (idx < 544) { kind = 2; qb = 0; bh = idx - 480; }
        else if (idx < 608) { kind = 1; qb = 3; bh = idx - 544; }
        else if (idx < 640) { kind = 0; qb = 0; bh = idx - 608; }
        else if (idx < 704) { kind = 1; qb = 2; bh = idx - 640; }
        else { kind = 1; qb = 1 - (idx - 704) / 64; bh = (idx - 704) % 64; }
        if (MK_ATT_SKIP && dry && ((MK_ATT_SKIP >> kind) & 1)) continue;
        if (kind == 2) { pool_unit(bh, PROJ, XY, tid); __syncthreads(); continue; }
        if (kind == 1) {
            const int b = bh >> 3, h = bh & 7;
            AttnP P; P.Q = PROJ + 2048 + h * 64; P.K = PROJ + 2560 + h * 64; P.V = PROJ + 3072 + h * 64; P.out = XY + 1024 + h * 64; P.stash = nullptr; P.gsub = nullptr; P.logf = LOGF + h; P.opitch = XYP; P.lam = 0.f; P.nscale = 0.f;
            attn_unit<MK_THRF, true>(tid, b, qb, 0, P, lds);
        } else {
            const int b = bh >> 2, h = bh & 3;
#pragma unroll 1
            for (int c = 0; c < 2; ++c) {
                AttnP P; P.Q = PROJ + 512 + (h * 2 + c) * 64; P.K = PROJ + 1024 + (h * 2 + c) * 64; P.V = PROJ + 1536 + h * 128;
                P.stash = STASH + h * 128; P.gsub = w.dsub; P.logf = nullptr; P.lam = lam; P.nscale = 1.0f - lam_init;
                if (c == 0) { P.out = STASH + h * 128; P.opitch = 512; } else { P.out = XY + 512 + h * 128; P.opitch = XYP; }
                attn_unit128<MK_THRD>(mk_tid(wave0), b, qb, c == 0 ? 0 : 4, P, lds); }
        }
    }
}
__device__ __forceinline__ void moe_tables(volatile LAS unsigned* MISC, const unsigned* cls_cnt, int tid) {
    __syncthreads();
    if (tid < 24) MISC[MI_N + tid] = cls_cnt[tid];
    __syncthreads();
    if (tid == 0) { unsigned base = 0, u0 = 0;
        for (int c = 0; c < 24; ++c) { const unsigned n = MISC[MI_N + c]; MISC[MI_BASE + c] = base; MISC[MI_U0 + c] = u0; const unsigned nch = (n + 255u) >> 8; base += nch * 256u; u0 += nch * 4u; }
        MISC[MI_TOT] = u0; }
    __syncthreads();
}

#ifndef MK_FIXA
#define MK_FIXA 0
#endif
#ifndef MK_FIXB
#define MK_FIXB 0
#endif
#ifndef MK_REPEAT
#define MK_REPEAT 0
#endif
constexpr int NPH = 18;
struct Prog { int p[40]; int n; };
constexpr Prog make_prog() {
    Prog g{}; int n = 0;
    for (int ph = 0; ph < NPH; ++ph) {
        const int kind = (ph == 0 || ph == 9) ? 8 : (ph >= 10 ? ph - 10 : ph - 1);
        g.p[n++] = ph; if ((MK_REPEAT >> kind) & 1) g.p[n++] = ph; }
    g.n = n; return g;
}
__constant__ const Prog PROG = make_prog();
constexpr int NPOS = make_prog().n;
template <unsigned KMASK>
__device__ __forceinline__ void mk_body() {
    typedef const __attribute__((address_space(4))) Args* KArgs;
    const KArgs args0p = (KArgs)__builtin_amdgcn_kernarg_segment_ptr();
    extern __shared__ __attribute__((aligned(16))) unsigned char lds_raw[];
    { LAS unsigned char* lds0 = (LAS unsigned char*)lds_raw;
      for (int u = threadIdx.x; u < (LDS_BYTES - MISC_OFF) / 4; u += NWAVES * 64) ((LAS unsigned*)(lds0 + MISC_OFF))[u] = 0u; }
    __syncthreads();
    const int wave0 = __builtin_amdgcn_readfirstlane(threadIdx.x >> 6);
    XcdBarrier bar = xcd_barrier_post((unsigned*)((gu32*)(args0p->ws + WS_CTL) + CW_BAR) + args0p->li * XCD_BAR_WORDS, (volatile LAS unsigned*)((LAS unsigned char*)lds_raw + MISC_OFF) + MI_BAR, threadIdx.x);
    const int ph_lo = args0p->ph_lo, ph_hi = args0p->ph_hi;
#pragma clang loop unroll(disable)
    for (int pos = ph_lo; pos < ph_hi; ++pos) {
        const int ph = __builtin_amdgcn_readfirstlane(PROG.p[pos]); const int rep = pos; const int dry = (MK_REPEAT != 0 && pos + 1 < ph_hi && __builtin_amdgcn_readfirstlane(PROG.p[pos + 1]) == ph) ? 1 : 0;
        KArgs ap = args0p; asm volatile("" : "+s"(ap));
#define args (*ap)
        LAS unsigned char* lds = (LAS unsigned char*)lds_raw;
        volatile LAS unsigned* MISC = (volatile LAS unsigned*)(lds + MISC_OFF);
        int G = gridDim.x, bx = blockIdx.x; asm volatile("" : "+s"(G), "+s"(bx)); const int vcu = (G % 8 == 0) ? (bx % 8) * (G / 8) + bx / 8 : bx;
        unsigned char* ws = args.ws; gu32* ctl = (gu32*)(ws + WS_CTL);
        float* XOUT = args.out; const float* x0 = (const float*)args.in[0];
        bf16* XY = (bf16*)(ws + WS_XY); bf16* PROJ = (bf16*)(ws + WS_PROJ);
        float* SSA = (float*)(ws + WS_SS); float* SSB = (float*)(ws + WS_SSB);
        if (ph == 0) { if constexpr (KMASK & 0x100u) { const int tid = mk_tid(wave0); const LayerW w = layer_view(ap, 0); conv_layer(w, ws, 0, lds, vcu, G, tid); p0_x(x0, (const int*)args.in[2], ws, (unsigned char*)XOUT + OUT_XB8, vcu, G, tid);
            if (tid == 0) ((unsigned*)(ctl + CW_XCC))[vcu] = xb_xcc_id() + 1u;
            if (bx == 0) { float* GT = (float*)(ctl + CW_GT); const int ll = tid >> 8, r = tid & 255, wch = r >> 6, d = r & 63;
                const float* gsrc = (const float*)(wch == 0 ? args.in[7] : (wch == 1 ? args.in[8] : (wch == 2 ? args.in[11] : args.in[12]))); GT[tid] = gsrc[ll * 64 + d]; } } }
        else if (ph == 9) { }
        else {
            const int l = __builtin_amdgcn_readfirstlane(ph >= 10 ? 1 : 0), k = __builtin_amdgcn_readfirstlane(ph - (l ? 10 : 1));
            const LayerW w = layer_view(ap, l);
            const float* SSin = l == 0 ? SSA : SSB; const float* xcur = l == 0 ? x0 : XOUT;
            if (k == 0) { if constexpr (KMASK & 1u) { const int tid = mk_tid(wave0);
                SchedPlain S{(const char*)(XY + 1536), (const char*)(ws + WS_W + W_IN), (size_t)256 * XYP * 2, (size_t)256 * 2048, 64, 15, 16, G, bx, dry & MK_FIXA, dry & MK_FIXB};
                EpiG1 E{SSin, PROJ, (float*)(ws + WS_LOGF), (const float*)(ws + WS_COSSIN), (const float*)(ctl + CW_GT) + 256 * l, w.ffb, dry};
                pg8::gemm_phase<SchedPlain, EpiG1, false, true>(tid, lds, XYP * 2, 2048, S, E);
                split_arrive_x(bar, (unsigned*)(ctl + CW_SPLIT3) + 64 * l, (unsigned*)(ctl + CW_SPLIT3) + 64 * l + 32 * 0 + 128, mk_tid(wave0));
            } } else if (k == 1) { if constexpr (KMASK & 2u) {
                attn_phase(wave0, w, l, rep, ws, (char*)lds_raw, MISC, ctl, dry);
                split_arrive_x(bar, (unsigned*)(ctl + CW_SPLIT + (2 * l) * 64), (unsigned*)(ctl + CW_SPLITX + (2 * l) * 64), mk_tid(wave0));
            } } else if (k == 2) { if constexpr (KMASK & 4u) { const int tid = mk_tid(wave0);
                unsigned char* gsc = (unsigned char*)XOUT + OUT_GATES + (size_t)bx * 196608;
                { SchedG2<0> S{(const char*)XOUT + OUT_XB8, (const char*)(ws + WS_W + W_G8), bx};
                  EpiG2<0> E{SSin, gsc, (bf16*)(ws + WS_MERGED)};
                  pg8::gemm_phase<SchedG2<0>, EpiG2<0>, false, true, true>(tid, lds, 1024, 1024, S, E); }
                { const int t2 = mk_tid(wave0); if (t2 == 0) split_wait_leader((unsigned*)(ctl + CW_SPLIT + (2 * l) * 64), (unsigned)G); __syncthreads(); }
                { SchedG2<1> S{(const char*)XY, (const char*)(ws + WS_W + W_BR), bx};
                  EpiG2<1> E{SSin, gsc, (bf16*)(ws + WS_MERGED)};
                  pg8::gemm_phase<SchedG2<1>, EpiG2<1>, false, true>(mk_tid(wave0), lds, XYP * 2, 1024, S, E); }
                { int pm_, pn_; tile_order(bx, 64, 4, pm_, pn_); group4_sync((unsigned*)(ctl + CW_G4 + ((2 * l) * 64 + pm_) * 32), mk_tid(wave0)); }
            } } else if (k == 3) { if constexpr (KMASK & 8u) { const int tid = mk_tid(wave0);
                SchedPlain S{(const char*)(ws + WS_MERGED), (const char*)(ws + WS_W + W_OUT), (size_t)256 * 2048, (size_t)256 * 2048, 64, 4, 16, G, bx, 0, 0};
                EpiRes<0, false> E{XY + 1536, XYP, nullptr, XY + 1536, XYP, SSA, nullptr, nullptr, dry, (MK_MU8 && l == NL - 1) ? (unsigned char*)XOUT + OUT_XB8 : nullptr};
                pg8::gemm_phase<SchedPlain, EpiRes<0, false>, false, true>(tid, lds, 2048, 2048, S, E);
                { int pm_, pn_; tile_order(bx, 64, 4, pm_, pn_); group4_sync((unsigned*)(ctl + CW_G4 + ((2 * l + 1) * 64 + pm_) * 32), mk_tid(wave0)); }
            } } else if (k == 4) { if constexpr (KMASK & 16u) { const int tid = mk_tid(wave0);
                {
                    typedef float f32x16r __attribute__((ext_vector_type(16))); typedef short bf16x8r __attribute__((ext_vector_type(8)));
                    const int lane_ = tid & 63, r32 = lane_ & 31, hh = lane_ >> 5, wv = __builtin_amdgcn_readfirstlane(tid >> 6); int pm_, pn_; tile_order(bx, 64, 4, pm_, pn_); const int t0 = pm_ * 256 + pn_ * 64;
                    unsigned* ccnt = (unsigned*)(ctl + CW_CLS + 32 * l + 64 * dry); int* LIST = (int*)(ws + WS_LIST);
                    const GAS char* wrh = (const GAS char*)(ws + WS_W + W_RH) + (unsigned)(r32 * 2048 + (128 * wv + 8 * hh) * 2);
                    const GAS char* xb_ = (const GAS char*)(XY + 1536) + (size_t)t0 * (XYP * 2) + (unsigned)(r32 * (XYP * 2) + (128 * wv + 8 * hh) * 2);
                    f32x16r acc0 = {}, acc1 = {};
#pragma unroll 2
                    for (int ks = 0; ks < 8; ++ks) {
                        const bf16x8r Bh = *(const GAS bf16x8r*)(wrh + ks * 32), Bl = *(const GAS bf16x8r*)(wrh + 65536 + ks * 32);
                        const bf16x8r A0 = *(const GAS bf16x8r*)(xb_ + ks * 32), A1 = *(const GAS bf16x8r*)(xb_ + 32 * (XYP * 2) + ks * 32);
                        acc0 = __builtin_amdgcn_mfma_f32_32x32x16_bf16(A0, Bh, acc0, 0, 0, 0); acc0 = __builtin_amdgcn_mfma_f32_32x32x16_bf16(A0, Bl, acc0, 0, 0, 0);
                        acc1 = __builtin_amdgcn_mfma_f32_32x32x16_bf16(A1, Bh, acc1, 0, 0, 0); acc1 = __builtin_amdgcn_mfma_f32_32x32x16_bf16(A1, Bl, acc1, 0, 0, 0);
                    }
                    LAS float* Pp = (LAS float*)lds;
                    LAS float* Lg = (LAS float*)(lds + 65536);
#pragma unroll
                    for (int r = 0; r < 16; ++r) { const int tk = (r & 3) + 8 * (r >> 2) + 4 * hh; Pp[(wv * 64 + tk) * 32 + r32] = acc0[r]; Pp[(wv * 64 + 32 + tk) * 32 + r32] = acc1[r]; }
                    __syncthreads();
                    { const int tk = tid >> 3, n4 = (tid & 7) * 4; f32x4 s = (f32x4){0.f, 0.f, 0.f, 0.f};
#pragma unroll
                      for (int w8 = 0; w8 < 8; ++w8) s += *(const LAS f32x4*)(Pp + (w8 * 64 + tk) * 32 + n4);
                      *(LAS f32x4*)(Lg + tk * 32 + n4) = s; }
                    __syncthreads();
                    if (tid < 64) { const int t = t0 + tid; float dg[4], de[16];
#pragma unroll
                        for (int e = 0; e < 4; ++e) dg[e] = Lg[tid * 32 + e];
#pragma unroll
                        for (int e = 0; e < 16; ++e) de[e] = Lg[tid * 32 + 4 + e];
                        const float rstd = rstd_at(SSA, (unsigned)t); float wa, wb; const int cls = route_decide(dg, de, rstd, w.brg, w.bre, wa, wb);
                        *(GAS f32x4*)((GAS char*)(ws + WS_TOKW) + (unsigned)t * 16u) = (f32x4){wa, wb, rstd, 0.f}; MISC[128 + tid] = (unsigned)cls; }
                    __syncthreads();
                    if (tid < 64) {
                        const unsigned mycls = MISC[128 + tid]; const unsigned long long ltm = (1ull << tid) - 1ull; unsigned cnt_c = 0, rank = 0;
#pragma unroll 4
                        for (unsigned c = 0; c < 24; ++c) { const unsigned long long m = __ballot(mycls == c); if ((unsigned)tid == c) cnt_c = (unsigned)__popcll(m); if (mycls == c) rank = (unsigned)__popcll(m & ltm); }
                        unsigned base = 0; if (tid < 24 && cnt_c) base = atomicAdd(ccnt + tid, cnt_c);
                        const unsigned mybase = (unsigned)__builtin_amdgcn_ds_bpermute((int)(mycls << 2), (int)base);
                        LIST[(size_t)mycls * T + mybase + rank] = t0 + tid; }
                    __syncthreads();
                }
                split_arrive_x(bar, (unsigned*)(ctl + CW_SPLIT + (2 * l + 1) * 64), (unsigned*)(ctl + CW_SPLITX + (2 * l + 1) * 64), mk_tid(wave0));
            } } else if (k == 5) { if constexpr (KMASK & 96u) { int tid = mk_tid(wave0);
                if (tid == 0) split_wait_leader((unsigned*)(ctl + CW_SPLIT + (2 * l + 1) * 64), (unsigned)G);
                __syncthreads();
                moe_tables(MISC, (const unsigned*)(ctl + CW_CLS + 32 * l), tid);
                const int NUm = (int)MISC[MI_TOT], KO = NUm > 256 ? (NUm - 256) >> 2 : 0;
                const int gid = vcu >> 2, m4 = vcu & 3, xg = gid >> 3, lg = gid & 7;
                const int k_o = lg * 8 + xg, k_p = (lg - 4) * 8 + xg;
                const bool is_o = lg < 4 && k_o < KO, is_p = lg >= 4 && k_p < KO;
                unsigned* cA = (unsigned*)(ctl + CW_MOE2 + 3584 * l); unsigned* cB = cA + 2048; unsigned* cO = cA + 3072;
#pragma clang loop unroll(disable)
                for (int r = 0; r < 2; ++r) {
                    const int u = r == 0 ? vcu : 256 + 4 * k_o + m4; if (r == 1 && !is_o) break;
                    tid = mk_tid(wave0);
                    { SchedMoE S{MISC, (const int*)(ws + WS_LIST), (const char*)(XY + 1536), (const char*)(ws + WS_W + W_GU), G, u, 0, 0};
                      EpiMU E{(bf16*)(ws + OV_ACT), (const float*)(ws + WS_TOKW), 1.0f};
                      pg8::gemm_phase<SchedMoE, EpiMU, true, true>(tid, lds, XYP * 2, 2048, S, E); }
                    if (r == 0 && is_o) {
                        asm volatile("s_waitcnt vmcnt(0)" ::: "memory"); __syncthreads();
                        tid = mk_tid(wave0);
                        if (tid == 0) { const unsigned me = xb_xcc_id() + 1u; bool same = true;
#pragma unroll
                            for (int i = 0; i < 4; ++i) same = same && (xb_ld((unsigned*)(ctl + CW_XCC) + (gid + 4) * 4 + i) == me);
                            if (!same) { __builtin_amdgcn_fence(__ATOMIC_RELEASE, "agent"); asm volatile("s_waitcnt vmcnt(0)" ::: "memory"); }
                            xb_add(cO + 16 * k_o, 1u); asm volatile("s_waitcnt vmcnt(0)" ::: "memory"); }
                        __syncthreads();
                    }
                }
                group4_sync(is_o ? cB + 32 * k_o : cA + 32 * gid, mk_tid(wave0));
#pragma clang loop unroll(disable)
                for (int r = 0; r < 2; ++r) {
                    const int u = r == 0 ? (is_o ? 256 + 4 * k_o + m4 : vcu) : 4 * (gid - 4) + m4; if (r == 1 && !is_p) break;
                    tid = mk_tid(wave0);
                    if (r == 1) {
                        if (tid == 0) { unsigned sp = 0; while (xb_ld(cO + 16 * k_p) < 4u) { __builtin_amdgcn_s_sleep(2); if (++sp > (1u << 22)) break; }
                            __builtin_amdgcn_fence(__ATOMIC_ACQUIRE, "agent"); asm volatile("s_waitcnt vmcnt(0)" ::: "memory"); }
                        __syncthreads();
                    }
                    SchedMoE S{MISC, (const int*)(ws + WS_LIST), (const char*)(ws + OV_ACT), (const char*)(ws + WS_W + W_D), G, u, 2, 0};
                    EpiRes<0, true> E{XY + 1536, XYP, nullptr, (bf16*)(ws + OV_XB2), 1024, SSA, nullptr, nullptr, dry, MK_PLE8 ? ws + WS_MERGED : nullptr};
                    pg8::gemm_phase<SchedMoE, EpiRes<0, true>, false, true>(tid, lds, 1024, 512, S, E);
                }
                { unsigned* fqh = pg8::rflp((unsigned*)(ctl + CW_FQ) + 64 * l); const int NF = 256 + (l + 1 < NL ? CV_EARLY_BATCHES : 0);
                  int arrived = 0;
                  for (;;) {
                    const int tq = mk_tid(wave0);
                    if (tq == 0) MISC[MI_Q] = atomicAdd(fqh, 1u);
                    __syncthreads();
                    const int idx = (int)MISC[MI_Q];
                    __syncthreads();
                    if (idx >= 256 && !arrived) { split_arrive_x(bar, (unsigned*)(ctl + CW_SPLIT3) + 256 + 64 * l, (unsigned*)(ctl + CW_SPLIT3) + 512 + 64 * l, mk_tid(wave0)); arrived = 1; }
                    if (idx >= NF) break;
                    if (idx < 256) {
                        SchedPlain S2{(const char*)(ws + OV_PB), (const char*)(ws + WS_WPLE + l * WPLE_STRIDE + W_P), (size_t)256 * 512, (size_t)256 * 512, 64, 4, 4, 1 << 20, idx, 0, 0};
                        EpiPW E2{(bf16*)(ws + OV_PW)};
                        pg8::gemm_phase<SchedPlain, EpiPW, false, true>(tq, lds, 512, 512, S2, E2);
                    } else { const LayerW w1 = layer_view(ap, 1); conv_early_batch(w1, ws, 1, lds, idx - 256, tq); }
                  } }
            } } else if (k == 6) { if constexpr (KMASK & 96u) {
            } } else { if constexpr (KMASK & 128u) { const int tid = mk_tid(wave0);
                if (tid == 0) split_wait_leader((unsigned*)(ctl + CW_SPLIT3) + 256 + 64 * l, (unsigned)G);
                __syncthreads();
                constexpr int P8 = MK_PLE8 ? 1 : 0;
                SchedPlain S{(const char*)(ws + (P8 ? WS_MERGED : OV_XB2)), (const char*)(ws + WS_WPLE + l * WPLE_STRIDE + W_PG), (size_t)256 * (P8 ? 1024 : 2048), (size_t)256 * (P8 ? 1024 : 2048), 64, 4, P8 ? 8 : 16, G, bx, 0, 0};
                EpiRes<1, false> E{(const bf16*)(ws + OV_XB2), 1024, l == NL - 1 ? XOUT : nullptr, l == NL - 1 ? nullptr : XY + 1536, XYP, SSB, SSA, (const bf16*)(ws + OV_PW), dry, l == NL - 1 ? nullptr : (unsigned char*)XOUT + OUT_XB8};
                pg8::gemm_phase<SchedPlain, EpiRes<1, false>, false, true, P8 != 0>(tid, lds, P8 ? 1024 : 2048, P8 ? 1024 : 2048, S, E);
            } }
        }
        const int kk_ = (ph == 0 || ph == 9) ? -1 : (ph >= 10 ? ph - 10 : ph - 1);
        if (pos + 1 < ph_hi && ph != 9 && (MK_REPEAT != 0 || kk_ > 6 || kk_ < 0)) { xcd_barrier(bar, mk_tid(wave0));
#ifdef MK_DOUBLE_BAR
            xcd_barrier(bar, mk_tid(wave0)); xcd_barrier(bar, mk_tid(wave0));
#endif
        }
#undef args
    }
}

#ifndef MK_KMASKS
#ifdef MK_SPLIT_TEST
#define MK_KMASKS 0x100u
#else
#define MK_KMASKS 0x1FFu
#endif
#endif
__global__ void __launch_bounds__(NWAVES * 64, 2) mk_fwd(Args args) { mk_body<MK_KMASKS>(); }
#ifdef MK_SPLIT_TEST
__global__ void __launch_bounds__(NWAVES * 64, 2) mk_t0(Args args) { mk_body<1u>(); }
__global__ void __launch_bounds__(NWAVES * 64, 2) mk_t1(Args args) { mk_body<2u>(); }
__global__ void __launch_bounds__(NWAVES * 64, 2) mk_t2(Args args) { mk_body<4u>(); }
__global__ void __launch_bounds__(NWAVES * 64, 2) mk_t3(Args args) { mk_body<8u>(); }
__global__ void __launch_bounds__(NWAVES * 64, 2) mk_t4(Args args) { mk_body<16u>(); }
__global__ void __launch_bounds__(NWAVES * 64, 2) mk_t5(Args args) { mk_body<32u>(); }
__global__ void __launch_bounds__(NWAVES * 64, 2) mk_t6(Args args) { mk_body<64u>(); }
__global__ void __launch_bounds__(NWAVES * 64, 2) mk_t7(Args args) { mk_body<128u>(); }
__global__ void __launch_bounds__(NWAVES * 64, 2) mk_t8(Args args) { mk_body<256u>(); }
#endif
#ifndef MK_ONE_LAUNCH
#define MK_ONE_LAUNCH 0
#endif
#ifndef MK_OPT_MASK
#define MK_OPT_MASK 0x3FFFF
#endif
static void ref_phase(int l, int k, void* const* d_in, float* XOUT, unsigned char* ws, hipStream_t st) {
    using namespace refp;
    const float* x0 = (const float*)d_in[0]; const float* p = (const float*)d_in[1]; const int* pos = (const int*)d_in[2];
    const float* g_attn = (const float*)d_in[3] + l * 1024; const float* w_in_l = (const float*)d_in[4] + (size_t)l * 1024 * INW;
    const float* pool_w = (const float*)d_in[5] + (size_t)l * 4 * 128 * 128; const float* pool_scale = (const float*)d_in[6] + l * 512;
    const float* dqn = (const float*)d_in[7] + l * 64; const float* dkn = (const float*)d_in[8] + l * 64; const float* dlam = (const float*)d_in[9] + l * 256;
    const float* dsub = (const float*)d_in[10] + l * 128; const float* fqn = (const float*)d_in[11] + l * 64; const float* fkn = (const float*)d_in[12] + l * 64;
    const float* ffb = (const float*)d_in[13] + l * 8; const float* w_branch_l = (const float*)d_in[14] + (size_t)l * 3 * 512 * 1024; const float* w_out_l = (const float*)d_in[15] + (size_t)l * 1024 * 1024;
    const float* g_ffn = (const float*)d_in[16] + l * 1024; const float* wrg = (const float*)d_in[17] + (size_t)l * 1024 * 4; const float* brg = (const float*)d_in[18] + l * 4;
    const float* wre = (const float*)d_in[19] + (size_t)l * 1024 * 16; const float* bre = (const float*)d_in[20] + l * 16;
    const float* wg_l = (const float*)d_in[21] + (size_t)l * 16 * 1024 * 256; const float* wu_l = (const float*)d_in[22] + (size_t)l * 16 * 1024 * 256; const float* wd_l = (const float*)d_in[23] + (size_t)l * 16 * 256 * 1024;
    const float* g_ple = (const float*)d_in[24] + l * 1024; const float* wpg_l = (const float*)d_in[25] + (size_t)l * 1024 * 1024; const float* wple_l = (const float*)d_in[26] + (size_t)l * 256 * 1024;
    const float* p_l = p + (size_t)l * T * 256;
    float* SSA = (float*)(ws + WS_SS); float* SSB = (float*)(ws + WS_SSB); float* RS = (float*)(ws + WS_RSTD); float* LOGF = (float*)(ws + WS_LOGF); float* FCUM = (float*)(ws + WS_FCUM); float* TOKW = (float*)(ws + WS_TOKW); int* LIST = (int*)(ws + WS_LIST);
    bf16* XY = (bf16*)(ws + WS_XY); bf16* PROJ = (bf16*)(ws + WS_PROJ); float* CH = (float*)(ws + WS_STASH); bf16* MERGED = (bf16*)(ws + WS_MERGED); float* TMP = (float*)(ws + WS_PROJ);
    unsigned* cls_cnt = (unsigned*)(ws + WS_CTL) + CW_CLS + 32 * l;
    const float* xcur = l == 0 ? x0 : XOUT; float* SSin = l == 0 ? SSA : SSB;
    const float lam_init = 0.8f - 0.6f * expf(-0.3f * (float)l);
    if (k == -1) { k_rowstats<<<T / 4, 256, 0, st>>>(x0, XY + 1536, XYP, SSA, RS, nullptr); return; }
    if (k == 0) {
        k_ref_rstd<<<T / 256, 256, 0, st>>>(SSin, RS);
        for (int cc = 0; cc < 14; ++cc) {
            k_ref_gemm<<<dim3(4, T / 64), 256, 0, st>>>(XnormLoader{xcur, RS, g_attn}, w_in_l + 256 * cc, INW, 256, 1024, EpiStoreF32{CH, 256, 0});
            int kind = 2; const float* gain = nullptr; int rot = 0; float osc = 1.f;
            if (cc < 2) kind = 0;
            else if (cc < 4) { kind = 1; gain = dqn; rot = 1; osc = C2; }
            else if (cc < 6) { kind = 1; gain = dkn; rot = 1; }
            else if (cc >= 8 && cc < 10) { kind = 1; gain = fqn; osc = C2; }
            else if (cc >= 10 && cc < 12) { kind = 1; gain = fkn; }
            k_ref_epi1<<<T, 256, 0, st>>>(CH, cc, kind, pool_w, pool_scale, gain, rot, osc, pos, PROJ);
        }
        k_ref_gemm<<<dim3(1, T / 64), 256, 0, st>>>(XnormLoader{xcur, RS, g_attn}, w_in_l + 3584, INW, 8, 1024, EpiStoreF32{CH, 8, 0});
        k_ref_logf<<<T * 8 / 256, 256, 0, st>>>(CH, ffb, LOGF);
    } else if (k == 1) {
        k_ref_fscan<<<1, 64, 0, st>>>(LOGF, FCUM);
        k_ref_fox<<<T * 8 / 4, 256, 0, st>>>(PROJ, FCUM, XY);
        k_ref_diff<<<T * 4 / 2, 128, 0, st>>>(PROJ, dlam, dsub, lam_init, XY);
        k_ref_pool<<<T * 512 / 256, 256, 0, st>>>(PROJ, XY);
    } else if (k == 2) {
        k_ref_rstd<<<T / 256, 256, 0, st>>>(SSin, RS);
        k_ref_gemm2<<<dim3(16, T / 64), 256, 0, st>>>(xcur, RS, g_attn, w_in_l, w_branch_l, XY, MERGED);
    } else if (k == 3) {
        k_ref_gemm<<<dim3(16, T / 64), 256, 0, st>>>(Bf16Loader{MERGED, 1024, 0}, w_out_l, 1024, 1024, 1024, EpiResid{xcur, XOUT});
        k_rowstats<<<T / 4, 256, 0, st>>>(XOUT, XY + 1536, XYP, SSA, RS, nullptr);
    } else if (k == 4) {
        k_route<<<T / 4, 256, 0, st>>>(XOUT, g_ffn, wrg, brg, wre, bre, cls_cnt, LIST, TOKW);
    } else if (k == 5) {
        k_ref_rstd<<<T / 256, 256, 0, st>>>(SSA, RS);
        k_ref_moe<<<dim3(T / 8, 24), 256, 0, st>>>(XOUT, RS, g_ffn, (const int*)cls_cnt, LIST, TOKW, wg_l, wu_l, wd_l);
        k_rowstats<<<T / 4, 256, 0, st>>>(XOUT, (bf16*)(ws + OV_XB2), 1024, SSA, RS, nullptr);
    } else if (k == 7) {
        k_ref_rstd<<<T / 256, 256, 0, st>>>(SSA, RS);
        k_ref_ple<<<dim3(16, T / 64), 256, 0, st>>>(XOUT, RS, g_ple, wpg_l, p_l, wple_l, TMP);
        k_rowstats<<<T / 4, 256, 0, st>>>(TMP, XY + 1536, XYP, SSB, RS, XOUT);
    }
}

extern "C" void kernel_launch(void* const* d_in, const int* in_sizes, int n_in, void* d_out, int out_size, void* d_ws, size_t ws_size, hipStream_t stream) {
    static int grid = 0;
    if (grid == 0) {
        if (n_in != 27 || out_size != T * DM || ws_size < WS_END) { fprintf(stderr, "kernel_launch: unexpected shapes (n_in %d out %d ws %zu)\n", n_in, out_size, ws_size); grid = -1; return; }
        int dev = 0, cus = 0;
        if (hipGetDevice(&dev) != hipSuccess || hipDeviceGetAttribute(&cus, hipDeviceAttributeMultiprocessorCount, dev) != hipSuccess) { grid = -1; return; }
        if (hipFuncSetAttribute((const void*)mk_fwd, hipFuncAttributeMaxDynamicSharedMemorySize, LDS_BYTES) != hipSuccess) { fprintf(stderr, "kernel_launch: hipFuncSetAttribute failed\n"); grid = -1; return; }
#if !MK_ONE_LAUNCH
        { const void* ks[9] = {(const void*)mk_t0, (const void*)mk_t1, (const void*)mk_t2, (const void*)mk_t3, (const void*)mk_t4, (const void*)mk_t5, (const void*)mk_t6, (const void*)mk_t7, (const void*)mk_t8};
          for (int i = 0; i < 9; ++i) (void)hipFuncSetAttribute(ks[i], hipFuncAttributeMaxDynamicSharedMemorySize, LDS_BYTES); }
#endif
        int per_cu = 0;
        if (hipOccupancyMaxActiveBlocksPerMultiprocessor(&per_cu, mk_fwd, NWAVES * 64, LDS_BYTES) != hipSuccess || per_cu < 1) { fprintf(stderr, "kernel_launch: occupancy query failed (%d)\n", per_cu); grid = -1; return; }
        (void)hipGetLastError();
        grid = cus;
    }
    if (grid < 0) return;
    (void)hipMemsetAsync((char*)d_ws + WS_CTL, 0, MK_ONE_LAUNCH ? (size_t)192 * 1024 : CTL_BYTES, stream);
    Args a{};
    for (int i = 0; i < 27; ++i) a.in[i] = d_in[i];
    a.out = (float*)d_out; a.ws = (unsigned char*)d_ws;
#if MK_ONE_LAUNCH
    a.ph_lo = 0; a.ph_hi = NPOS; a.li = 0;
    hipLaunchKernelGGL(mk_fwd, dim3(grid), dim3(NWAVES * 64), LDS_BYTES, stream, a);
#else
    const unsigned mask = MK_OPT_MASK; int li = 0;
    typedef void (*kern_t)(Args);
    const kern_t ks[9] = {mk_t0, mk_t1, mk_t2, mk_t3, mk_t4, mk_t5, mk_t6, mk_t7, mk_t8};
#define LAUNCH_PH(kk) hipLaunchKernelGGL(ks[kk], dim3(grid), dim3(NWAVES * 64), LDS_BYTES, stream, a)
    for (int ph = 0; ph < NPH; ++ph) {
        const bool opt = (mask >> ph) & 1u;
        const int l = ph >= 10 ? 1 : 0, k = ph == 0 ? -1 : (ph == 9 ? -2 : ph - (l ? 10 : 1));
        if (ph == 0) {
            a.ph_lo = 0; a.ph_hi = 1; a.li = li++; LAUNCH_PH(8);
            if (!opt) ref_phase(0, -1, d_in, (float*)d_out, (unsigned char*)d_ws, stream);
            continue; }
        if (ph == 9) { a.ph_lo = 9; a.ph_hi = 10; a.li = li++; LAUNCH_PH(8); continue; }
        if (opt) { a.ph_lo = ph; a.ph_hi = ph + 1; a.li = li++; LAUNCH_PH(k); }
        else if (k != 6) ref_phase(l, k, d_in, (float*)d_out, (unsigned char*)d_ws, stream);
    }
#endif
}
```

```cpp
#include <hip/hip_runtime.h>
#include <cstdio>
#include <cstdint>
#include <cmath>
typedef unsigned short bf16;
constexpr int T = 16384, DM = 1024, S = 2048, NB = 8, NL = 2, INW = 6664;
constexpr float RMS_EPS = 1e-6f;
constexpr float C2 = 0.125f * 1.4426950408889634f;
constexpr size_t MiB = 1u << 20;
constexpr size_t WS_CTL = 0, CTL_BYTES = 1 * MiB;
constexpr size_t WS_SS = 1 * MiB;
constexpr size_t WS_LOGF = 2 * MiB;
constexpr size_t WS_FCUM = 2 * MiB + 512 * 1024;
constexpr size_t WS_TOKW = 3 * MiB;
constexpr size_t WS_RSTD = 3 * MiB + 256 * 1024;
constexpr size_t WS_LIST = 3 * MiB + 512 * 1024;
constexpr size_t WS_COSSIN = 5 * MiB;
constexpr size_t WS_SSB = 49 * MiB;
constexpr size_t WS_W = 6 * MiB;
constexpr size_t WS_WPLE = 52 * MiB;
constexpr size_t WS_XY = 57 * MiB;
constexpr size_t WS_PROJ = 137 * MiB;
constexpr size_t WS_STASH = 249 * MiB;
constexpr size_t WS_MERGED = WS_PROJ + 96 * MiB;
constexpr size_t WS_PB = 265 * MiB;
constexpr size_t WS_END = 273 * MiB;
constexpr int XYP = 2560, PJP = 3584;
constexpr int CW_CLS = 64;
constexpr int CW_AQ = 256;
constexpr int CW_G4 = 16384;
constexpr int CW_SPLIT3 = 24576;
constexpr int CW_MOE2 = 32768;
constexpr int CW_XCC = 40960;
constexpr int CW_GT = 131072;
constexpr int CW_MOEG = 512;
constexpr int CW_SPLIT = 5632;
constexpr int CW_SPLITX = 5888;
constexpr int CW_FQ = 6144;
constexpr int CW_BAR = 8192;
#define MK_ONE_LAUNCH 1
namespace refp {

__device__ __forceinline__ float bf2f(bf16 v) { return __uint_as_float((unsigned)v << 16); }
__device__ __forceinline__ bf16 f2b(float f) { unsigned u = __float_as_uint(f); return (bf16)((u + 0x7fffu + ((u >> 16) & 1u)) >> 16); }
__device__ __forceinline__ float wsum(float v) {
#pragma unroll
    for (int o = 1; o < 64; o <<= 1) v += __shfl_xor(v, o);
    return v;
}
__device__ __forceinline__ float wmax(float v) {
#pragma unroll
    for (int o = 1; o < 64; o <<= 1) v = fmaxf(v, __shfl_xor(v, o));
    return v;
}
__device__ __forceinline__ float row_rstd(const float* SS, int t) {
    float s = 0.f;
#pragma unroll
    for (int i = 0; i < 16; ++i) s += SS[(size_t)t * 16 + i];
    return rsqrtf(s * (1.0f / 1024.0f) + RMS_EPS);
}

__global__ void __launch_bounds__(256) k_rowstats(const float* __restrict__ xsrc, bf16* XBdst, int ldxb, float* SS, float* RSTD, float* xcopy) {
    const int t = blockIdx.x * 4 + (threadIdx.x >> 6), lane = threadIdx.x & 63;
    const float* xr = xsrc + (size_t)t * 1024;
    float s = 0.f;
    for (int j = 0; j < 16; ++j) { const int k = lane + 64 * j; const float v = xr[k]; s += v * v; XBdst[(size_t)t * ldxb + k] = f2b(v); if (xcopy) xcopy[(size_t)t * 1024 + k] = v; }
    s = wsum(s);
    if (lane < 16) SS[(size_t)t * 16 + lane] = (lane == 0) ? s : 0.f;
    if (lane == 0) RSTD[t] = rsqrtf(s * (1.0f / 1024.0f) + RMS_EPS);
}
__global__ void k_ref_rstd(const float* __restrict__ SS, float* RSTD) { const int t = blockIdx.x * blockDim.x + threadIdx.x; if (t < T) RSTD[t] = row_rstd(SS, t); }

struct XnormLoader { const float* x; const float* RS; const float* g;
    __device__ __forceinline__ float operator()(int t, int k) const { return x[(size_t)t * 1024 + k] * RS[t] * g[k]; } };
struct Bf16Loader { const bf16* A; int lda; int pad;
    __device__ __forceinline__ float operator()(int t, int k) const { return bf2f(A[(size_t)t * lda + k]); } };
struct F32Loader { const float* A; int lda; int pad;
    __device__ __forceinline__ float operator()(int t, int k) const { return A[(size_t)t * lda + k]; } };

template <class AL, class EPI>
__global__ void __launch_bounds__(256) k_ref_gemm(AL al, const float* __restrict__ W, int ldw, int N, int K, EPI epi) {
    __shared__ float sA[16][65], sB[16][65];
    const int tx = threadIdx.x & 15, ty = threadIdx.x >> 4, t0 = blockIdx.y * 64, n0 = blockIdx.x * 64;
    float acc[4][4] = {};
    for (int k0 = 0; k0 < K; k0 += 16) {
        for (int e = threadIdx.x; e < 1024; e += 256) { const int r = e >> 4, kk = e & 15; sA[kk][r] = al(t0 + r, k0 + kk); }
        for (int e = threadIdx.x; e < 1024; e += 256) { const int kk = e >> 6, c = e & 63; sB[kk][c] = (n0 + c < N) ? W[(size_t)(k0 + kk) * ldw + n0 + c] : 0.f; }
        __syncthreads();
#pragma unroll
        for (int kk = 0; kk < 16; ++kk) {
            float a[4], b[4];
#pragma unroll
            for (int i = 0; i < 4; ++i) { a[i] = sA[kk][ty * 4 + i]; b[i] = sB[kk][tx * 4 + i]; }
#pragma unroll
            for (int i = 0; i < 4; ++i)
#pragma unroll
                for (int j = 0; j < 4; ++j) acc[i][j] += a[i] * b[j];
        }
        __syncthreads();
    }
#pragma unroll
    for (int i = 0; i < 4; ++i)
#pragma unroll
        for (int j = 0; j < 4; ++j) { const int n = n0 + tx * 4 + j; if (n < N) epi(t0 + ty * 4 + i, n, acc[i][j]); }
}
struct EpiStoreF32 { float* C; int ldc; int pad; __device__ __forceinline__ void operator()(int t, int n, float v) const { C[(size_t)t * ldc + n] = v; } };
struct EpiResid { const float* xs; float* xo; __device__ __forceinline__ void operator()(int t, int n, float v) const { xo[(size_t)t * 1024 + n] = xs[(size_t)t * 1024 + n] + v; } };

__global__ void __launch_bounds__(256) k_ref_epi1(const float* __restrict__ C, int cc, int kind, const float* pool_w, const float* pool_scale,
                                                  const float* gain, int rotary, float outscale, const int* positions, bf16* PROJ) {
    __shared__ float row[256];
    const int t = blockIdx.x, j = threadIdx.x;
    row[j] = C[(size_t)t * 256 + j];
    __syncthreads();
    float out;
    if (kind == 0) {
        const int g = 2 * cc + (j >> 7), d = j & 127; float s = 0.f;
        for (int c = 0; c < 128; ++c) s += row[(j & 128) + c] * pool_w[((size_t)g * 128 + c) * 128 + d];
        out = s * pool_scale[g * 128 + d];
    } else if (kind == 1) {
        const int dim = j & 63; float v = row[j];
        const float ss = wsum(v * v);
        v = v * rsqrtf(ss * (1.0f / 64.0f) + RMS_EPS) * gain[dim];
        if (rotary) {
            const float other = __shfl_xor(v, 8);
            if (dim < 16) {
                const int i = dim & 7; const float invf = powf(500000.0f, -(float)(2 * i) / 16.0f);
                const float ang = (float)positions[t] * invf; const float c = cosf(ang), s = sinf(ang);
                v = (dim < 8) ? (v * c - other * s) : (v * c + other * s);
            }
        }
        out = v * outscale;
    } else out = row[j];
    PROJ[(size_t)t * 3584 + 256 * cc + j] = f2b(out);
}
__global__ void k_ref_logf(const float* __restrict__ C8, const float* fb, float* LOGF) {
    const int i = blockIdx.x * blockDim.x + threadIdx.x; if (i >= T * 8) return;
    const float v = C8[i] + fb[i & 7];
    LOGF[i] = fminf(v, 0.f) - log1pf(expf(-fabsf(v)));
}
__global__ void k_ref_fscan(const float* __restrict__ LOGF, float* FCUM) {
    const int i = threadIdx.x; if (i >= 64) return; const int b = i >> 3, h = i & 7; float s = 0.f;
    for (int t = 0; t < S; ++t) { s += LOGF[((size_t)b * S + t) * 8 + h]; FCUM[((size_t)b * S + t) * 8 + h] = s; }
}
__global__ void __launch_bounds__(256) k_ref_fox(const bf16* __restrict__ PROJ, const float* __restrict__ FCUM, bf16* XY) {
    __shared__ float P[4][S];
    const int w = threadIdx.x >> 6, lane = threadIdx.x & 63; const int gw = blockIdx.x * 4 + w; const int t = gw >> 3, h = gw & 7; const int b = t / S, sq = t % S;
    float q[64];
#pragma unroll
    for (int d = 0; d < 64; ++d) q[d] = bf2f(PROJ[(size_t)t * 3584 + 2048 + h * 64 + d]);
    const float Ft = FCUM[(size_t)t * 8 + h];
    float m = -INFINITY;
    for (int j = lane; j <= sq; j += 64) { const bf16* kr = PROJ + ((size_t)b * S + j) * 3584 + 2560 + h * 64; float s = 0.f;
#pragma unroll
        for (int d = 0; d < 64; ++d) s += q[d] * bf2f(kr[d]);
        s += (Ft - FCUM[((size_t)b * S + j) * 8 + h]) * 1.4426950408889634f; P[w][j] = s; m = fmaxf(m, s); }
    m = wmax(m); float l = 0.f;
    for (int j = lane; j <= sq; j += 64) { const float p = exp2f(P[w][j] - m); P[w][j] = p; l += p; }
    l = wsum(l);
    __syncthreads();
    float o = 0.f;
    for (int j = 0; j <= sq; ++j) o += P[w][j] * bf2f(PROJ[((size_t)b * S + j) * 3584 + 3072 + h * 64 + lane]);
    XY[(size_t)t * 2560 + 1024 + h * 64 + lane] = f2b(o / l);
}
__global__ void __launch_bounds__(128) k_ref_diff(const bf16* __restrict__ PROJ, const float* __restrict__ lamp, const float* __restrict__ gsub, float lam_init, bf16* XY) {
    __shared__ float P[2][2][S];
    const int w = threadIdx.x >> 6, lane = threadIdx.x & 63; const int gw = blockIdx.x * 2 + w; const int t = gw >> 2, h = gw & 3; const int b = t / S, sq = t % S;
    float lam; { const float a = wsum(lamp[lane] * lamp[64 + lane]), c = wsum(lamp[128 + lane] * lamp[192 + lane]); lam = expf(a) - expf(c) + lam_init; }
    float linv[2];
    for (int c = 0; c < 2; ++c) {
        float q[64];
#pragma unroll
        for (int d = 0; d < 64; ++d) q[d] = bf2f(PROJ[(size_t)t * 3584 + 512 + (h * 2 + c) * 64 + d]);
        float m = -INFINITY;
        for (int j = lane; j <= sq; j += 64) { const bf16* kr = PROJ + ((size_t)b * S + j) * 3584 + 1024 + (h * 2 + c) * 64; float s = 0.f;
    #pragma unroll
        for (int d = 0; d < 64; ++d) s += q[d] * bf2f(kr[d]);
            P[w][c][j] = s; m = fmaxf(m, s); }
        m = wmax(m); float l = 0.f;
        for (int j = lane; j <= sq; j += 64) { const float p = exp2f(P[w][c][j] - m); P[w][c][j] = p; l += p; }
        linv[c] = 1.0f / wsum(l);
    }
    __syncthreads();
    float o0 = 0.f, o1 = 0.f;
    for (int j = 0; j <= sq; ++j) { const float a = P[w][0][j] * linv[0] - lam * P[w][1][j] * linv[1]; const bf16* vr = PROJ + ((size_t)b * S + j) * 3584 + 1536 + h * 128;
        o0 += a * bf2f(vr[lane]); o1 += a * bf2f(vr[64 + lane]); }
    const float ss = wsum(o0 * o0 + o1 * o1); const float r = rsqrtf(ss * (1.0f / 128.0f) + RMS_EPS) * (1.0f - lam_init);
    XY[(size_t)t * 2560 + 512 + h * 128 + lane] = f2b(o0 * r * gsub[lane]);
    XY[(size_t)t * 2560 + 512 + h * 128 + 64 + lane] = f2b(o1 * r * gsub[64 + lane]);
}
__global__ void k_ref_pool(const bf16* __restrict__ PROJ, bf16* XY) {
    const int i = blockIdx.x * blockDim.x + threadIdx.x; if (i >= T * 512) return; const int t = i >> 9, j = i & 511; const int g = j >> 7, w = 2 << g, s = t % S;
    const int cnt = min(s + 1, w); float a = 0.f;
    for (int k = 0; k < cnt; ++k) a += bf2f(PROJ[(size_t)(t - k) * 3584 + j]);
    XY[(size_t)t * 2560 + j] = f2b(a / (float)cnt - bf2f(PROJ[(size_t)t * 3584 + j]));
}
__global__ void __launch_bounds__(256) k_ref_gemm2(const float* __restrict__ x, const float* __restrict__ SS, const float* __restrict__ g, const float* __restrict__ w_in_l,
                                                   const float* __restrict__ w_branch_l, const bf16* __restrict__ XY, bf16* MERGED) {
    __shared__ float sA[16][65], sB[16][65];
    const int tx = threadIdx.x & 15, ty = threadIdx.x >> 4, t0 = blockIdx.y * 64, n0 = blockIdx.x * 64;
    float mg[4][4] = {};
    for (int n = 0; n < 3; ++n) {
        float ag[4][4] = {}, ab[4][4] = {};
        for (int pass = 0; pass < 2; ++pass) {
            const int K = pass == 0 ? 1024 : 512;
            for (int k0 = 0; k0 < K; k0 += 16) {
                for (int e = threadIdx.x; e < 1024; e += 256) { const int r = e >> 4, kk = e & 15; const int t = t0 + r, k = k0 + kk;
                    sA[kk][r] = pass == 0 ? x[(size_t)t * 1024 + k] * SS[t] * g[k] : bf2f(XY[(size_t)t * 2560 + 512 * n + k]); }
                for (int e = threadIdx.x; e < 1024; e += 256) { const int kk = e >> 6, c = e & 63; const int k = k0 + kk;
                    sB[kk][c] = pass == 0 ? w_in_l[(size_t)k * INW + 3592 + n * 1024 + n0 + c] : w_branch_l[((size_t)n * 512 + k) * 1024 + n0 + c]; }
                __syncthreads();
#pragma unroll
                for (int kk = 0; kk < 16; ++kk) {
                    float a[4], b[4];
#pragma unroll
                    for (int i = 0; i < 4; ++i) { a[i] = sA[kk][ty * 4 + i]; b[i] = sB[kk][tx * 4 + i]; }
#pragma unroll
                    for (int i = 0; i < 4; ++i)
#pragma unroll
                        for (int j = 0; j < 4; ++j) { if (pass == 0) ag[i][j] += a[i] * b[j]; else ab[i][j] += a[i] * b[j]; }
                }
                __syncthreads();
            }
        }
#pragma unroll
        for (int i = 0; i < 4; ++i)
#pragma unroll
            for (int j = 0; j < 4; ++j) mg[i][j] += ab[i][j] / (1.0f + expf(-ag[i][j]));
    }
#pragma unroll
    for (int i = 0; i < 4; ++i)
#pragma unroll
        for (int j = 0; j < 4; ++j) MERGED[(size_t)(t0 + ty * 4 + i) * 1024 + n0 + tx * 4 + j] = f2b(mg[i][j]);
}
__global__ void __launch_bounds__(256) k_ref_moe(float* X, const float* __restrict__ SS, const float* __restrict__ g, const int* __restrict__ cls_cnt, const int* __restrict__ LIST,
                                                 const float* __restrict__ TOKW, const float* __restrict__ wg_l, const float* __restrict__ wu_l, const float* __restrict__ wd_l) {
    __shared__ float h[8][1024]; __shared__ float act[8][512]; __shared__ int tok[8];
    const int cls = blockIdx.y, n_c = cls_cnt[cls], base = blockIdx.x * 8; if (base >= n_c) return;
    const int nt = min(8, n_c - base), tid = threadIdx.x;
    if (tid < 8) tok[tid] = tid < nt ? LIST[(size_t)cls * T + base + tid] : -1;
    __syncthreads();
    for (int e = tid; e < 8 * 1024; e += 256) { const int i = e >> 10, k = e & 1023; const int t = tok[i]; h[i][k] = t >= 0 ? X[(size_t)t * 1024 + k] * SS[t] * g[k] : 0.f; }
    __syncthreads();
    const int grp = cls / 6, pr = cls % 6; const int pa = pr < 3 ? 0 : (pr < 5 ? 1 : 2), pb = pr < 3 ? pr + 1 : (pr < 5 ? pr - 1 : 3); const int ea = grp * 4 + pa, eb = grp * 4 + pb;
    for (int s = 0; s < 2; ++s) { const int e = s ? eb : ea; float ga[8], ua[8];
#pragma unroll
        for (int i = 0; i < 8; ++i) { ga[i] = 0.f; ua[i] = 0.f; }
        const float* wg = wg_l + (size_t)e * 1024 * 256 + tid; const float* wu = wu_l + (size_t)e * 1024 * 256 + tid;
        for (int k = 0; k < 1024; ++k) { const float a = wg[(size_t)k * 256], u = wu[(size_t)k * 256];
#pragma unroll
            for (int i = 0; i < 8; ++i) { ga[i] += h[i][k] * a; ua[i] += h[i][k] * u; } }
#pragma unroll
        for (int i = 0; i < 8; ++i) { const int t = tok[i]; const float w = t >= 0 ? TOKW[(size_t)t * 4 + s] : 0.f; act[i][s * 256 + tid] = ga[i] / (1.0f + expf(-ga[i])) * ua[i] * w; } }
    __syncthreads();
    for (int j = 0; j < 4; ++j) { const int n = tid + 256 * j; float y[8];
#pragma unroll
        for (int i = 0; i < 8; ++i) y[i] = 0.f;
        for (int s = 0; s < 2; ++s) { const int e = s ? eb : ea; const float* wd = wd_l + (size_t)e * 256 * 1024 + n;
            for (int f = 0; f < 256; ++f) { const float w = wd[(size_t)f * 1024];
#pragma unroll
                for (int i = 0; i < 8; ++i) y[i] += act[i][s * 256 + f] * w; } }
#pragma unroll
        for (int i = 0; i < 8; ++i) { const int t = tok[i]; if (t >= 0) X[(size_t)t * 1024 + n] += y[i]; } }
}
__global__ void __launch_bounds__(256) k_ref_ple(const float* __restrict__ x, const float* __restrict__ SS, const float* __restrict__ g, const float* __restrict__ wgate_l,
                                                 const float* __restrict__ p_l, const float* __restrict__ wple_l, float* xo) {
    __shared__ float sA[16][65], sB[16][65];
    const int tx = threadIdx.x & 15, ty = threadIdx.x >> 4, t0 = blockIdx.y * 64, n0 = blockIdx.x * 64;
    float ag[4][4] = {}, ab[4][4] = {};
    for (int pass = 0; pass < 2; ++pass) {
        const int K = pass == 0 ? 1024 : 256;
        for (int k0 = 0; k0 < K; k0 += 16) {
            for (int e = threadIdx.x; e < 1024; e += 256) { const int r = e >> 4, kk = e & 15; const int t = t0 + r, k = k0 + kk;
                sA[kk][r] = pass == 0 ? x[(size_t)t * 1024 + k] * SS[t] * g[k] : p_l[(size_t)t * 256 + k]; }
            for (int e = threadIdx.x; e < 1024; e += 256) { const int kk = e >> 6, c = e & 63; const int k = k0 + kk;
                sB[kk][c] = pass == 0 ? wgate_l[(size_t)k * 1024 + n0 + c] : wple_l[(size_t)k * 1024 + n0 + c]; }
            __syncthreads();
#pragma unroll
            for (int kk = 0; kk < 16; ++kk) {
                float a[4], b[4];
#pragma unroll
                for (int i = 0; i < 4; ++i) { a[i] = sA[kk][ty * 4 + i]; b[i] = sB[kk][tx * 4 + i]; }
#pragma unroll
                for (int i = 0; i < 4; ++i)
#pragma unroll
                    for (int j = 0; j < 4; ++j) { if (pass == 0) ag[i][j] += a[i] * b[j]; else ab[i][j] += a[i] * b[j]; }
            }
            __syncthreads();
        }
    }
#pragma unroll
    for (int i = 0; i < 4; ++i)
#pragma unroll
        for (int j = 0; j < 4; ++j) { const size_t o = (size_t)(t0 + ty * 4 + i) * 1024 + n0 + tx * 4 + j; xo[o] = x[o] + ab[i][j] / (1.0f + expf(-ag[i][j])); }
}
}
__device__ __forceinline__ int route_decide(const float (&dg)[4], const float (&de)[16], const float rstd, const float* __restrict__ brg, const float* __restrict__ bre, float& wa, float& wb) {
    float lg[4]; int gi = 0; float lmax;
#pragma unroll
    for (int e = 0; e < 4; ++e) lg[e] = rstd * dg[e] + brg[e];
    lmax = lg[0];
#pragma unroll
    for (int e = 1; e < 4; ++e) if (lg[e] > lmax) { lmax = lg[e]; gi = e; }
    float den = 0.f;
#pragma unroll
    for (int e = 0; e < 4; ++e) den += expf(lg[e] - lmax);
    const float gp = 1.0f / den;
    float el[4] = {0.f, 0.f, 0.f, 0.f};
#pragma unroll
    for (int gg = 0; gg < 4; ++gg)
#pragma unroll
        for (int e = 0; e < 4; ++e) if (gg == gi) el[e] = rstd * de[gg * 4 + e] + bre[gg * 4 + e];
    int i1 = 0; float m1 = el[0];
#pragma unroll
    for (int e = 1; e < 4; ++e) if (el[e] > m1) { m1 = el[e]; i1 = e; }
    int i2 = -1; float m2 = -INFINITY;
#pragma unroll
    for (int e = 0; e < 4; ++e) if (e != i1 && el[e] > m2) { m2 = el[e]; i2 = e; }
    const float r2 = expf(m2 - m1); const float w1 = gp / (1.0f + r2), w2 = gp * r2 / (1.0f + r2);
    const int a = min(i1, i2), b = max(i1, i2); const int pr = (a == 0) ? (b - 1) : ((a == 1) ? (b + 1) : 5); const int cls = gi * 6 + pr;
    wa = i1 == a ? w1 : w2; wb = i1 == a ? w2 : w1;
    return cls;
}
__device__ __forceinline__ int route_core(int t, int lane, const float* __restrict__ X, const float* __restrict__ g, const float* __restrict__ wrg, const float* __restrict__ brg,
                                          const float* __restrict__ wre, const float* __restrict__ bre, float* TOKW) {
    float ss = 0.f, dg[4] = {0.f, 0.f, 0.f, 0.f}, de[16];
#pragma unroll
    for (int e = 0; e < 16; ++e) de[e] = 0.f;
#pragma unroll 4
    for (int i = 0; i < 16; ++i) { const int k = lane + 64 * i; const float xv = X[(size_t)t * 1024 + k]; ss += xv * xv; const float h = xv * g[k];
        const float4 a = *(const float4*)(wrg + (size_t)k * 4); dg[0] += h * a.x; dg[1] += h * a.y; dg[2] += h * a.z; dg[3] += h * a.w;
#pragma unroll
        for (int q = 0; q < 4; ++q) { const float4 b = *(const float4*)(wre + (size_t)k * 16 + 4 * q); de[4 * q] += h * b.x; de[4 * q + 1] += h * b.y; de[4 * q + 2] += h * b.z; de[4 * q + 3] += h * b.w; } }
    ss = refp::wsum(ss);
#pragma unroll
    for (int e = 0; e < 4; ++e) dg[e] = refp::wsum(dg[e]);
#pragma unroll
    for (int e = 0; e < 16; ++e) de[e] = refp::wsum(de[e]);
    const float rstd = rsqrtf(ss * (1.0f / 1024.0f) + RMS_EPS);
    float wa, wb; const int cls = route_decide(dg, de, rstd, brg, bre, wa, wb);
    if (lane == 0) *(float4*)(TOKW + (size_t)t * 4) = make_float4(wa, wb, rstd, 0.f);
    return cls;
}
__device__ __forceinline__ void route_token(int t, int lane, const float* __restrict__ X, const float* __restrict__ g, const float* __restrict__ wrg, const float* __restrict__ brg,
                                            const float* __restrict__ wre, const float* __restrict__ bre, unsigned* cls_cnt, int* LIST, float* TOKW) {
    const int cls = route_core(t, lane, X, g, wrg, brg, wre, bre, TOKW);
    if (lane == 0) { const unsigned pos = atomicAdd(cls_cnt + cls, 1u); LIST[(size_t)cls * T + pos] = t; }
}
__global__ void __launch_bounds__(256) k_route(const float* X, const float* g, const float* wrg, const float* brg, const float* wre, const float* bre, unsigned* cls_cnt, int* LIST, float* TOKW) {
    const int t = blockIdx.x * 4 + (threadIdx.x >> 6);
    route_token(t, threadIdx.x & 63, X, g, wrg, brg, wre, bre, cls_cnt, LIST, TOKW);
}

namespace pg8 {
#define PG8_LAS __attribute__((address_space(3)))
typedef short bf16x8 __attribute__((ext_vector_type(8)));
typedef float f32x4 __attribute__((ext_vector_type(4)));
typedef unsigned u32x4 __attribute__((ext_vector_type(4)));
typedef int i32x4 __attribute__((ext_vector_type(4)));
typedef int i32x8 __attribute__((ext_vector_type(8)));
__device__ __forceinline__ i32x8 cat8(bf16x8 lo, bf16x8 hi) { const i32x4 a = __builtin_bit_cast(i32x4, lo), b = __builtin_bit_cast(i32x4, hi); return __builtin_shufflevector(a, b, 0, 1, 2, 3, 4, 5, 6, 7); }
constexpr int BM = 256, BK = 64, HALF = 128, HTB = HALF * BK * 2, STAGE_BYTES = 8 * HTB;

__host__ __device__ __forceinline__ int lds_byte(int r, int c) { const int st = (r >> 4) * 2 + (c >> 5), rr = r & 15, cc = c & 31, ob = rr * 64 + cc * 2; return st * 1024 + (ob ^ (((ob >> 9) & 1) << 5)); }
__host__ __device__ __forceinline__ void stage_rc(int b, int& R, int& C) { const int st = b / 1024, sb = b % 1024, swz = sb ^ (((sb >> 9) & 1) << 5); R = (st >> 1) * 16 + swz / 64; C = (st & 1) * 32 + (swz % 64) / 2; }
__host__ __device__ __forceinline__ int perm32(int rho) { const int n = rho >> 4, i = rho & 15; return 8 * (i >> 2) + 4 * n + (i & 3); }

struct Step { const char* A; const char* B; const int* rows; int nt, pm, pn, aux, nvalid, zero_after; };
__device__ __forceinline__ int rfl(int v) { return __builtin_amdgcn_readfirstlane(v); }
template <class P> __device__ __forceinline__ P rflp(P p) { const unsigned long long u = (unsigned long long)p; const unsigned lo = (unsigned)__builtin_amdgcn_readfirstlane((int)(unsigned)u), hi = (unsigned)__builtin_amdgcn_readfirstlane((int)(unsigned)(u >> 32)); return (P)(((unsigned long long)hi << 32) | lo); }
__device__ __forceinline__ void step_uniform(Step& s, int& ok) {
    s.A = rflp(s.A); s.B = rflp(s.B); s.rows = rflp(s.rows); s.nt = rfl(s.nt); s.pm = rfl(s.pm); s.pn = rfl(s.pn); s.aux = rfl(s.aux); s.nvalid = rfl(s.nvalid); s.zero_after = rfl(s.zero_after); ok = rfl(ok);
    asm volatile("" : "+s"(ok), "+s"(s.A), "+s"(s.B), "+s"(s.nt), "+s"(s.aux));
}

template <class Sched, class Epi, bool GATHER, bool ALIGN_EPI, bool F8 = false>
__device__ __forceinline__ void gemm_phase(const int tid, PG8_LAS unsigned char* lds, const unsigned lda, const unsigned ldb, const Sched& S, const Epi& E) {
    const int wid = __builtin_amdgcn_readfirstlane(tid >> 6), lane = tid & 63, wr = wid >> 2, wc = wid & 3, fr = lane & 15, fq = lane >> 4;
    int Rr[2], Cc[2]; unsigned voffB[2], cOA[2][2], nOA[2][2];
#pragma unroll
    for (int i = 0; i < 2; ++i) { stage_rc(tid * 16 + i * 8192, Rr[i], Cc[i]); const int Rb = (Rr[i] & ~31) + perm32(Rr[i] & 31); voffB[i] = (unsigned)Rb * ldb + (unsigned)Cc[i] * 2u; }
    const size_t kstep = (size_t)(BK * 2);
    const size_t hstepB = (size_t)HALF * ldb;
    const unsigned ldsw = (unsigned)wid * 1024u;
    const int aoff = lds_byte(wr * 64 + fr, fq * 8), boff = lds_byte(wc * 32 + fr, fq * 8);
#define PG8_SA(b, h) (((b) * 2 + (h)) * HTB)
#define PG8_SB(b, h) ((4 + (b) * 2 + (h)) * HTB)
#define PG8_STAGE_B(bufoff, gbase) do { _Pragma("unroll") for (int _i = 0; _i < 2; ++_i) \
        __builtin_amdgcn_global_load_lds((const unsigned*)((const char*)(gbase) + voffB[_i]), (PG8_LAS unsigned*)(lds + (bufoff) + ldsw + _i * 8192), 16, 0, 0); } while (0)
#define PG8_STAGE_A(bufoff, gbase, o0, o1) do { \
        __builtin_amdgcn_global_load_lds((const unsigned*)((const char*)(gbase) + (o0)), (PG8_LAS unsigned*)(lds + (bufoff) + ldsw), 16, 0, 0); \
        __builtin_amdgcn_global_load_lds((const unsigned*)((const char*)(gbase) + (o1)), (PG8_LAS unsigned*)(lds + (bufoff) + ldsw + 8192), 16, 0, 0); } while (0)
#define PG8_LDA(dst, b, h) do { _Pragma("unroll") for (int m = 0; m < 4; ++m) _Pragma("unroll") for (int k = 0; k < 2; ++k) dst[m][k] = *(const PG8_LAS bf16x8*)(lds + PG8_SA(b, h) + aoff + m * 2048 + k * 1024); } while (0)
#define PG8_LDB(dst, b, h) do { _Pragma("unroll") for (int n = 0; n < 2; ++n) _Pragma("unroll") for (int k = 0; k < 2; ++k) dst[n][k] = *(const PG8_LAS bf16x8*)(lds + PG8_SB(b, h) + boff + n * 2048 + k * 1024); } while (0)
#define PG8_MMA(ai, bj, At, Bt) do { __builtin_amdgcn_s_setprio(1); \
        if constexpr (F8) { _Pragma("unroll") for (int m = 0; m < 4; ++m) _Pragma("unroll") for (int n = 0; n < 2; ++n) \
            asm volatile("v_mfma_scale_f32_16x16x128_f8f6f4 %0, %1, %2, %0, %3, %3 op_sel_hi:[0,0,0]" : "+v"(acc[ai][bj][m][n]) : "v"(cat8(Bt[n][0], Bt[n][1])), "v"(cat8(At[m][0], At[m][1])), "v"(f8scale)); } \
        else { _Pragma("unroll") for (int m = 0; m < 4; ++m) _Pragma("unroll") for (int n = 0; n < 2; ++n) _Pragma("unroll") for (int k = 0; k < 2; ++k) \
            acc[ai][bj][m][n] = __builtin_amdgcn_mfma_f32_16x16x32_bf16(Bt[n][k], At[m][k], acc[ai][bj][m][n], 0, 0, 0); } \
        __builtin_amdgcn_s_setprio(0); } while (0)
#define PG8_WAIT_V(n) asm volatile("s_waitcnt vmcnt(" #n ")" ::: "memory")
#define PG8_WAIT_L(n) asm volatile("s_waitcnt lgkmcnt(" #n ")" ::: "memory")
#define PG8_BAR __builtin_amdgcn_s_barrier()
#define PG8_SCHED __builtin_amdgcn_sched_barrier(0)
#define PG8_AOFFS(dst, st) do { _Pragma("unroll") for (int _h = 0; _h < 2; ++_h) _Pragma("unroll") for (int _i = 0; _i < 2; ++_i) { \
        int _row = Rr[_i] + 128 * _h; if (GATHER) { _row = (st).rows[_row]; _row = _row < 0 ? 0 : _row; } \
        dst[_h][_i] = (unsigned)_row * lda + (unsigned)Cc[_i] * 2u; } } while (0)
    int f8scale = 0x7F7F7F7F; if constexpr (F8) asm volatile("" : "+v"(f8scale));
    Step cur, nxt; int ui = 0;
    { int ok_ = S.next(0, cur) ? 1 : 0; step_uniform(cur, ok_); if (!ok_) return; }
    f32x4 acc[2][2][4][2];
#pragma unroll
    for (int a = 0; a < 2; ++a)
#pragma unroll
        for (int b = 0; b < 2; ++b)
#pragma unroll
            for (int m = 0; m < 4; ++m)
#pragma unroll
                for (int n = 0; n < 2; ++n) acc[a][b][m][n] = (f32x4){0.f, 0.f, 0.f, 0.f};
    bf16x8 At[4][2], B0[2][2], B1[2][2];
    PG8_AOFFS(cOA, cur);
    const char* cA = cur.A; const char* cB = cur.B;
    PG8_STAGE_B(PG8_SB(0, 0), cB); PG8_STAGE_B(PG8_SB(0, 1), cB + hstepB); PG8_STAGE_A(PG8_SA(0, 0), cA, cOA[0][0], cOA[0][1]); PG8_STAGE_A(PG8_SA(0, 1), cA, cOA[1][0], cOA[1][1]);
    if (wr == 1) PG8_BAR;
    PG8_WAIT_V(2); PG8_BAR;
    PG8_STAGE_B(PG8_SB(1, 0), cB + kstep); PG8_STAGE_A(PG8_SA(1, 0), cA + kstep, cOA[0][0], cOA[0][1]); PG8_STAGE_B(PG8_SB(1, 1), cB + hstepB + kstep);
    PG8_WAIT_V(6); PG8_BAR;
#pragma clang loop unroll(disable)
    for (;;) {
        bool has_next = S.next(ui + 1, nxt);
        { int hn_ = has_next ? 1 : 0; step_uniform(nxt, hn_); has_next = hn_ != 0; }
        asm volatile("" : "+v"(voffB[0]), "+v"(voffB[1]));
        const char* nA = has_next ? nxt.A : cA; const char* nB = has_next ? nxt.B : cB;
        if (GATHER) { if (has_next) { PG8_AOFFS(nOA, nxt); } else {
#pragma unroll
            for (int _h = 0; _h < 2; ++_h)
#pragma unroll
                for (int _i = 0; _i < 2; ++_i) nOA[_h][_i] = cOA[_h][_i]; } }
        const int nt = cur.nt;
#pragma clang loop unroll(disable)
        for (int t = 0; t < nt; t += 2) {
            const bool last = (t == nt - 2);
            const char* a1 = cA + (size_t)(t + 1) * kstep;
            const char* a2 = last ? nA : cA + (size_t)(t + 2) * kstep; const char* b2 = last ? nB : cB + (size_t)(t + 2) * kstep;
            const char* a3 = a2 + kstep; const char* b3 = b2 + kstep;
            unsigned o00, o01, o10, o11;
            if (GATHER) { o00 = last ? nOA[0][0] : cOA[0][0]; o01 = last ? nOA[0][1] : cOA[0][1]; o10 = last ? nOA[1][0] : cOA[1][0]; o11 = last ? nOA[1][1] : cOA[1][1]; }
            else { o00 = cOA[0][0]; o01 = cOA[0][1]; o10 = cOA[1][0]; o11 = cOA[1][1]; }
            PG8_LDB(B0, 0, 0); PG8_LDB(B1, 0, 1); PG8_SCHED; PG8_LDA(At, 0, 0); PG8_STAGE_A(PG8_SA(1, 1), a1, cOA[1][0], cOA[1][1]);
            PG8_WAIT_V(8); PG8_WAIT_L(0); PG8_BAR; PG8_MMA(0, 0, At, B0); PG8_MMA(0, 1, At, B1); PG8_BAR; PG8_SCHED;
            PG8_LDA(At, 0, 1); PG8_STAGE_B(PG8_SB(0, 0), b2); PG8_STAGE_B(PG8_SB(0, 1), b2 + hstepB); PG8_STAGE_A(PG8_SA(0, 0), a2, o00, o01);
            PG8_WAIT_V(8); PG8_WAIT_L(0); PG8_BAR; PG8_MMA(1, 0, At, B0); PG8_MMA(1, 1, At, B1); PG8_BAR; PG8_SCHED;
            PG8_LDB(B0, 1, 0); PG8_LDB(B1, 1, 1); PG8_SCHED; PG8_LDA(At, 1, 0); PG8_STAGE_A(PG8_SA(0, 1), a2, o10, o11);
            PG8_WAIT_V(8); PG8_WAIT_L(0); PG8_BAR; PG8_MMA(0, 0, At, B0); PG8_MMA(0, 1, At, B1); PG8_BAR; PG8_SCHED;
            PG8_LDA(At, 1, 1); PG8_STAGE_B(PG8_SB(1, 0), b3); PG8_STAGE_B(PG8_SB(1, 1), b3 + hstepB); PG8_STAGE_A(PG8_SA(1, 0), a3, o00, o01);
            PG8_WAIT_V(8); PG8_WAIT_L(0); PG8_BAR; PG8_MMA(1, 0, At, B0); PG8_MMA(1, 1, At, B1); PG8_BAR; PG8_SCHED;
        }
        if constexpr (F8) { asm volatile("s_nop 15\n\ts_nop 15" ::: "memory"); }
        if constexpr (ALIGN_EPI) { if (wr == 0) PG8_BAR; }
        { int ln_; asm volatile("v_mbcnt_lo_u32_b32 %0, -1, 0\n\tv_mbcnt_hi_u32_b32 %0, -1, %0" : "=v"(ln_));
          E(acc, cur, wr, wc, ln_ & 15, ln_ >> 4); }
        if (!has_next) break;
        if (cur.zero_after) {
#pragma unroll
            for (int a = 0; a < 2; ++a)
#pragma unroll
                for (int b = 0; b < 2; ++b)
#pragma unroll
                    for (int m = 0; m < 4; ++m)
#pragma unroll
                        for (int n = 0; n < 2; ++n) acc[a][b][m][n] = (f32x4){0.f, 0.f, 0.f, 0.f};
        }
        cur = nxt; cA = nA; cB = nB; ++ui;
        if (GATHER) {
#pragma unroll
            for (int _h = 0; _h < 2; ++_h)
#pragma unroll
                for (int _i = 0; _i < 2; ++_i) cOA[_h][_i] = nOA[_h][_i]; }
        if constexpr (ALIGN_EPI) { if (wr == 1) PG8_BAR; }
    }
    PG8_WAIT_V(0);
    if constexpr (!ALIGN_EPI) { if (wr == 0) PG8_BAR; }
    PG8_BAR;
#undef PG8_SA
#undef PG8_SB
#undef PG8_STAGE_A
#undef PG8_STAGE_B
#undef PG8_LDA
#undef PG8_LDB
#undef PG8_MMA
#undef PG8_WAIT_V
#undef PG8_WAIT_L
#undef PG8_BAR
#undef PG8_SCHED
#undef PG8_AOFFS
}
}
#include <hip/hip_bf16.h>
namespace attn_body {
using hbf16=__hip_bfloat16;
using bf16x8=__attribute__((ext_vector_type(8)))short;
using s16x4=__attribute__((ext_vector_type(4)))short;
using f32x16=__attribute__((ext_vector_type(16)))float;
using u32x4=__attribute__((ext_vector_type(4)))unsigned;
constexpr int SEQ=2048,D=64,DM=3584;
constexpr int NW=8,QBLK=32,QB=QBLK*NW,KVBLK=64,NQB=SEQ/QB;
__device__ __forceinline__ int crow(int r,int hi){return (r&3)+8*(r>>2)+4*hi;}
#define SBAR() __builtin_amdgcn_sched_barrier(0)
__device__ __forceinline__ void cmask(f32x16&p0,f32x16&p1,int jb,int qrel,int hi){
  const float NEG=-INFINITY; int kb=64*jb+4*hi;
  #pragma unroll
  for(int r=0;r<16;++r){int kv=kb+(r&3)+8*(r>>2); if(kv>qrel)p0[r]=NEG; if(kv+32>qrel)p1[r]=NEG;}
}

constexpr int NSLOT=3, SLOTB=8192;
constexpr int LDS_K=0, LDS_V=NSLOT*SLOTB, LDS_WS=2*NSLOT*SLOTB, LDS_OST=LDS_WS+NW*64*4, LDS_BIAS=LDS_OST+NW*4096, LDS_SSQ=LDS_BIAS+SEQ*4, LDS_BYTES=LDS_SSQ+NW*32*4;
constexpr float C2=0.125f*1.4426950408889634f;
__device__ __forceinline__ void glds16(const void*gsrc,unsigned lds_dst){unsigned keep;
  asm volatile("s_mov_b32 %0, m0\n\ts_mov_b32 m0, %2\n\ts_nop 0\n\tglobal_load_lds_dwordx4 %1, off\n\ts_mov_b32 m0, %0":"=&s"(keep):"v"(gsrc),"s"(lds_dst):"memory");}
__device__ __forceinline__ float max3f(float a,float b,float c){float r;asm("v_max3_f32 %0, %1, %2, %3":"=v"(r):"v"(a),"v"(b),"v"(c));return r;}
__device__ __forceinline__ float max2f(float a,float b){float r;asm("v_max_f32_e32 %0, %1, %2":"=v"(r):"v"(a),"v"(b));return r;}
__device__ __forceinline__ float fadd_s(float a,float b){float r;asm("v_add_f32_e32 %0, %1, %2":"=v"(r):"v"(a),"v"(b));return r;}
__device__ __forceinline__ float fsub_s(float a,float b){float r;asm("v_sub_f32_e32 %0, %1, %2":"=v"(r):"v"(a),"v"(b));return r;}
typedef float f32x2_t __attribute__((ext_vector_type(2))); typedef float f32x4_t __attribute__((ext_vector_type(4))); typedef __bf16 bf16x2_t __attribute__((ext_vector_type(2)));
__device__ __forceinline__ unsigned cvtpk_s(float lo,float hi){f32x2_t v={lo,hi};bf16x2_t b=__builtin_convertvector(v,bf16x2_t);return __builtin_bit_cast(unsigned,b);}
#define WAIT_BAR(N) asm volatile("s_waitcnt vmcnt(" #N ") lgkmcnt(0)\n\ts_barrier":::"memory")

__device__ __forceinline__ void qkt(f32x16&p0,f32x16&p1,const char*Kslot,const bf16x8*qr,const f32x16&negm,int r32,int hi){
  const char*kb=Kslot+hi*1024+r32*16;
  #pragma unroll
  for(int d0=0;d0<4;++d0){
    const bf16x8 b0=*reinterpret_cast<const bf16x8*>(kb+d0*2048);
    const bf16x8 b1=*reinterpret_cast<const bf16x8*>(kb+d0*2048+512);
    if(d0==0){p0=__builtin_amdgcn_mfma_f32_32x32x16_bf16(b0,qr[0],negm,0,0,0);p1=__builtin_amdgcn_mfma_f32_32x32x16_bf16(b1,qr[0],negm,0,0,0);}
    else{p0=__builtin_amdgcn_mfma_f32_32x32x16_bf16(b0,qr[d0],p0,0,0,0);p1=__builtin_amdgcn_mfma_f32_32x32x16_bf16(b1,qr[d0],p1,0,0,0);}}
}
typedef __attribute__((address_space(3))) const char* lds_cptr;
typedef short v4i16_t __attribute__((ext_vector_type(4)));
__device__ __forceinline__ void kload8(bf16x8*kf,lds_cptr kp){
  kf[0]=*(const __attribute__((address_space(3))) bf16x8*)(kp);      kf[1]=*(const __attribute__((address_space(3))) bf16x8*)(kp+512);
  kf[2]=*(const __attribute__((address_space(3))) bf16x8*)(kp+2048); kf[3]=*(const __attribute__((address_space(3))) bf16x8*)(kp+2560);
  kf[4]=*(const __attribute__((address_space(3))) bf16x8*)(kp+4096); kf[5]=*(const __attribute__((address_space(3))) bf16x8*)(kp+4608);
  kf[6]=*(const __attribute__((address_space(3))) bf16x8*)(kp+6144); kf[7]=*(const __attribute__((address_space(3))) bf16x8*)(kp+6656);
}
__device__ __forceinline__ void kload2(bf16x8*kf,lds_cptr kp,int j){ kf[2*j]=*(const __attribute__((address_space(3))) bf16x8*)(kp+j*2048); kf[2*j+1]=*(const __attribute__((address_space(3))) bf16x8*)(kp+j*2048+512); }
__device__ __forceinline__ s16x4 vtr(lds_cptr p){ return __builtin_bit_cast(s16x4,__builtin_amdgcn_ds_read_tr16_b64_v4i16((__attribute__((address_space(3))) v4i16_t*)p)); }
__device__ __forceinline__ float rowmax(const f32x16&p0,const f32x16&p1){
  float a=max3f(p0[0],p0[1],p1[0]),b=max3f(p0[2],p0[3],p1[1]);a=max3f(a,p1[2],p1[3]);
  #pragma unroll
  for(int r=4;r<16;r+=4){a=max3f(a,p0[r],p0[r+1]);b=max3f(b,p0[r+2],p0[r+3]);a=max3f(a,p1[r],p1[r+1]);b=max3f(b,p1[r+2],p1[r+3]);}
  const float m=max2f(a,b);
  auto rr=__builtin_amdgcn_permlane32_swap(__float_as_uint(m),__float_as_uint(m),false,false);
  return max2f(__uint_as_float(rr[0]),__uint_as_float(rr[1]));
}
__device__ __forceinline__ void pv(f32x16*o,int vb,bf16x8 pa0,bf16x8 pa1,bf16x8 pa2,bf16x8 pa3){
  #pragma unroll
  for(int d0=0;d0<2;++d0){s16x4 lo[4],hi[4];
    #pragma unroll
    for(int ks=0;ks<4;++ks){
      asm volatile("ds_read_b64_tr_b16 %0,%1 offset:%c2":"=&v"(lo[ks]):"v"(vb),"i"(d0*4096+ks*1024):"memory");
      asm volatile("ds_read_b64_tr_b16 %0,%1 offset:%c2":"=&v"(hi[ks]):"v"(vb),"i"(d0*4096+ks*1024+512):"memory");}
    asm volatile("s_waitcnt lgkmcnt(0)":::"memory");SBAR();
    #define PK(k) (bf16x8){lo[k][0],lo[k][1],lo[k][2],lo[k][3],hi[k][0],hi[k][1],hi[k][2],hi[k][3]}
    o[d0]=__builtin_amdgcn_mfma_f32_32x32x16_bf16(pa0,PK(0),o[d0],0,0,0);
    o[d0]=__builtin_amdgcn_mfma_f32_32x32x16_bf16(pa1,PK(1),o[d0],0,0,0);
    o[d0]=__builtin_amdgcn_mfma_f32_32x32x16_bf16(pa2,PK(2),o[d0],0,0,0);
    o[d0]=__builtin_amdgcn_mfma_f32_32x32x16_bf16(pa3,PK(3),o[d0],0,0,0);
    #undef PK
  }
}

#ifndef ATTN_STORE16
#define ATTN_STORE16(p,v) (*(u32x4*)(p)=(v))
#endif
struct AttnP { const bf16* Q; const bf16* K; const bf16* V; bf16* out; bf16* stash; const float* gsub; const float* logf; int opitch; float lam, nscale; };
template<int THRL,bool FOX> __device__ __forceinline__ void attn_unit(const int tid_in,int b,int qb,const int MODE,const AttnP&P,char*shm){
  int tid=tid_in; asm volatile("":"+v"(tid));
  const int lane=tid&63,r32=lane&31,hi=lane>>5; const int wid=__builtin_amdgcn_readfirstlane(tid>>6);
  const long rowbase=(long)b*SEQ; const int q0=qb*QB;
  const bf16*Qw=P.Q+(rowbase+q0+wid*QBLK)*DM;
  const bf16*Kh=P.K+rowbase*DM,*Vh=P.V+rowbase*DM;
  const unsigned lds0=(unsigned)(uintptr_t)shm;
  float*wsf=(float*)(shm+LDS_WS)+wid*64;
  const float*biasL=(const float*)(shm+LDS_BIAS);
  #define BIAS(P0,P1,t) do{ if(FOX){ const float*bb_=biasL+64*(t)+4*hi; _Pragma("unroll") for(int g_=0;g_<4;++g_){ const f32x4_t b0_=*(const f32x4_t*)(bb_+8*g_), b1_=*(const f32x4_t*)(bb_+32+8*g_); \
      _Pragma("unroll") for(int e_=0;e_<4;++e_){ P0[4*g_+e_]+=b0_[e_]; P1[4*g_+e_]+=b1_[e_]; } asm volatile("":::"memory"); } } }while(0)
  const bf16*ksrc=Kh+(long)lane*DM+wid*8;
  const bf16*vsrc=Vh+(long)(16*(wid&3)+(lane>>2))*DM+(wid>>2)*32+(lane&3)*8;
  const unsigned kdst=lds0+LDS_K+wid*1024, vdst=lds0+LDS_V+wid*1024;
  #define DMA_K(t,slot) glds16(ksrc+(long)(t)*KVBLK*DM,(unsigned)__builtin_amdgcn_readfirstlane(kdst+(slot)))
  #define DMA_V(t,slot) glds16(vsrc+(long)(t)*KVBLK*DM,(unsigned)__builtin_amdgcn_readfirstlane(vdst+(slot)))
  const int vb0=(int)(lds0+LDS_V)+((lane>>4)&1)*32+(lane&3)*8+(4*hi+((lane&15)>>2))*64;
  const char*Kbase=shm+LDS_K; bf16x8 kf[8];
  const lds_cptr shm3=(lds_cptr)shm; const lds_cptr kp0=shm3+LDS_K+hi*1024+r32*16; const lds_cptr vp0=shm3+LDS_V+((lane>>4)&1)*32+(lane&3)*8+(4*hi+((lane&15)>>2))*64;
  const int NT=(q0+QB)/KVBLK;
  DMA_K(0,0);DMA_V(0,0);DMA_K(1,SLOTB);
  bf16x8 qr[4];
  #pragma unroll
  for(int d0=0;d0<4;++d0)qr[d0]=*reinterpret_cast<const bf16x8*>(&Qw[(long)r32*DM+d0*16+hi*8]);
  float mhat=0.f,l_reg=0.f;f32x16 o[2];o[0]=f32x16{};o[1]=f32x16{};f32x16 negm=f32x16{};asm volatile("":"+v"(negm));
  const int qrel=wid*QBLK+r32;
  #define CMASK(P0,P1,t) do{int jb_=(t)-(NT-4); if(jb_>=0)cmask(P0,P1,jb_,qrel,hi);}while(0)
  bool resc=false;
  #define START(P0,P1) do{ const float rm=rowmax(P0,P1); resc=false; \
    { const float dl=rm; mhat=fadd_s(mhat,dl); \
      _Pragma("unroll") for(int r=0;r<16;++r){P0[r]=fsub_s(P0[r],dl);P1[r]=fsub_s(P1[r],dl);} \
      _Pragma("unroll") for(int r=0;r<16;++r)negm[r]=-mhat; asm volatile("":"+v"(negm)); } \
    _Pragma("unroll") for(int r=0;r<16;++r)P0[r]=__builtin_amdgcn_exp2f(P0[r]); }while(0)
  #define RESC() do{ if(resc){ asm volatile("s_waitcnt lgkmcnt(0)":::"memory"); \
      _Pragma("unroll") for(int d_=0;d_<2;++d_) _Pragma("unroll") for(int r=0;r<16;++r)o[d_][r]*=wsf[crow(r,hi)]; } }while(0)
  f32x16 pA0,pA1,pB0,pB1;
  int sl_prev=0,sl_cur=0,sl_next=SLOTB;
  #define ROT() do{sl_prev=sl_cur;sl_cur=sl_next;sl_next=(sl_next==(NSLOT-1)*SLOTB)?0:sl_next+SLOTB;}while(0)
  DMA_K(2,2*SLOTB);
  if(FOX){
    const int n=q0+QB; float v4[4]; float run=0.f;
    _Pragma("unroll") for(int i=0;i<4;++i){ const int sidx=4*tid+i; const float lv=(sidx<n)?P.logf[(rowbase+sidx)*8]:0.f; run+=lv; v4[i]=run; }
    float inc=run; _Pragma("unroll") for(int o_=1;o_<64;o_<<=1){ const float up=__int_as_float(__builtin_amdgcn_ds_bpermute((lane-o_)<<2,__float_as_int(inc))); if(lane>=o_)inc+=up; }
    float*wt=(float*)(shm+LDS_WS); if(lane==63)wt[wid]=inc; __syncthreads();
    float pre=inc-run; _Pragma("unroll") for(int w_=0;w_<NW;++w_){ if(w_<wid)pre+=wt[w_]; }
    float*bw=(float*)(shm+LDS_BIAS); _Pragma("unroll") for(int i=0;i<4;++i){ const int sidx=4*tid+i; if(sidx<n)bw[sidx]=-(pre+v4[i])*1.4426950408889634f; }
    __syncthreads(); }
  WAIT_BAR(3);
  qkt(pA0,pA1,Kbase,qr,negm,r32,hi);asm volatile("s_nop 15\n\ts_nop 7":"+v"(pA0),"+v"(pA1));BIAS(pA0,pA1,0);CMASK(pA0,pA1,0);
  START(pA0,pA1);
  _Pragma("unroll") for(int r=0;r<16;++r)pA1[r]=__builtin_amdgcn_exp2f(pA1[r]);
  WAIT_BAR(0);
  DMA_K(3,0);DMA_V(1,SLOTB);
  ROT();
  kload8(kf,kp0+sl_cur);
  WAIT_BAR(2);
  s16x4 vlo[8],vhi[8]; u32x4 pw0,pw1,pw2,pw3;
  #define PKW(P,B) cvtpk_s(P[B],P[B+1])
  #define PAF(k) __builtin_bit_cast(bf16x8,pw##k)
  #define VFR(i) (bf16x8){vlo[i][0],vlo[i][1],vlo[i][2],vlo[i][3],vhi[i][0],vhi[i][1],vhi[i][2],vhi[i][3]}
  #define PIN(x) asm volatile("":"+v"(x))
  #define MX3(a,b,c) __builtin_fmaxf(__builtin_fmaxf((a),(b)),(c))
  #define GAPA(MF,A0,A1,A2,A3,W0,W1,PW) do{ MF; sacc+=A0; sacc+=A1; sacc+=A2; sacc+=A3; PIN(sacc); W0; W1; PIN(PW); SBAR(); }while(0)
  #define EX(v) __builtin_amdgcn_exp2f(v)
  #define GAPB(MF,X,B) do{ MF; X[B]=EX(X[B]); X[B+1]=EX(X[B+1]); X[B+2]=EX(X[B+2]); X[B+3]=EX(X[B+3]); PIN(X); SBAR(); }while(0)
  #define VRD(i) do{ vlo[i]=vtr(vp_+(((i)>>2)*4096+((i)&3)*1024)); vhi[i]=vtr(vp_+(((i)>>2)*4096+((i)&3)*1024+512)); }while(0)
  #define KRD(G,j) do{ if(G){ kload2(kf,kp0+sl_next,j); SBAR(); } }while(0)
  #define STEP(C0,C1,P0,P1,t,GK,GV,GL) do{ SBAR(); \
    const lds_cptr vp_=vp0+sl_prev; \
    VRD(0); SBAR(); float sacc=(P0[0]+P0[1]); \
    GAPA(C0=__builtin_amdgcn_mfma_f32_32x32x16_bf16(kf[0],qr[0],negm,0,0,0), P0[2],P0[3],P0[4],P0[5],     pw0[0]=PKW(P0,0), pw0[1]=PKW(P0,2), pw0); \
    VRD(4); SBAR(); GAPA(C1=__builtin_amdgcn_mfma_f32_32x32x16_bf16(kf[1],qr[0],negm,0,0,0), P0[6],P0[7],P0[8],P0[9],     pw0[2]=PKW(P0,4), pw0[3]=PKW(P0,6), pw0); \
    VRD(1); SBAR(); GAPA(C0=__builtin_amdgcn_mfma_f32_32x32x16_bf16(kf[2],qr[1],C0,0,0,0),   P0[10],P0[11],P0[12],P0[13], pw1[0]=PKW(P0,8), pw1[1]=PKW(P0,10), pw1); \
    VRD(5); SBAR(); GAPA(C1=__builtin_amdgcn_mfma_f32_32x32x16_bf16(kf[3],qr[1],C1,0,0,0),   P0[14],P0[15],P1[0],P1[1],   pw1[2]=PKW(P0,12),pw1[3]=PKW(P0,14), pw1); \
    VRD(2); SBAR(); GAPA(C0=__builtin_amdgcn_mfma_f32_32x32x16_bf16(kf[4],qr[2],C0,0,0,0),   P1[2],P1[3],P1[4],P1[5],     pw2[0]=PKW(P1,0), pw2[1]=PKW(P1,2), pw2); \
    VRD(6); SBAR(); GAPA(C1=__builtin_amdgcn_mfma_f32_32x32x16_bf16(kf[5],qr[2],C1,0,0,0),   P1[6],P1[7],P1[8],P1[9],     pw2[2]=PKW(P1,4), pw2[3]=PKW(P1,6), pw2); \
    VRD(3); SBAR(); GAPA(C0=__builtin_amdgcn_mfma_f32_32x32x16_bf16(kf[6],qr[3],C0,0,0,0),   P1[10],P1[11],P1[12],P1[13], pw3[0]=PKW(P1,8), pw3[1]=PKW(P1,10), pw3); \
    VRD(7); SBAR(); GAPA(C1=__builtin_amdgcn_mfma_f32_32x32x16_bf16(kf[7],qr[3],C1,0,0,0),   P1[14],P1[15],0.f,0.f,       pw3[2]=PKW(P1,12),pw3[3]=PKW(P1,14), pw3); \
    l_reg+=sacc; \
    if(GK){DMA_K((t)+3,sl_cur);} if(GV){DMA_V((t)+1,sl_next);} \
    BIAS(C0,C1,t); CMASK(C0,C1,t); \
    { float a=MX3(C0[0],C0[1],C1[0]),b=MX3(C0[2],C0[3],C1[1]); a=MX3(a,C1[2],C1[3]); \
      _Pragma("unroll") for(int r=4;r<16;r+=4){a=MX3(a,C0[r],C0[r+1]);b=MX3(b,C0[r+2],C0[r+3]);a=MX3(a,C1[r],C1[r+1]);b=MX3(b,C1[r+2],C1[r+3]);} \
      float rm=__builtin_fmaxf(a,b); { auto rr=__builtin_amdgcn_permlane32_swap(__float_as_uint(rm),__float_as_uint(rm),false,false); rm=__builtin_fmaxf(__uint_as_float(rr[0]),__uint_as_float(rr[1])); } \
      resc=false; \
      if(__builtin_expect(__any(rm>(float)THRL),0)){ const float dl=__builtin_fmaxf(rm,0.f); mhat+=dl; \
        _Pragma("unroll") for(int r=0;r<16;++r){C0[r]-=dl;C1[r]-=dl;} \
        _Pragma("unroll") for(int r=0;r<16;++r)negm[r]=-mhat; asm volatile("":"+v"(negm)); \
        const float f=__builtin_amdgcn_exp2f(-dl); l_reg*=f; if(hi==0)wsf[r32]=f; resc=true; } } \
    SBAR(); \
    GAPB(o[0]=__builtin_amdgcn_mfma_f32_32x32x16_bf16(PAF(0),VFR(0),o[0],0,0,0), C0,0); \
    GAPB(o[1]=__builtin_amdgcn_mfma_f32_32x32x16_bf16(PAF(0),VFR(4),o[1],0,0,0), C0,4); \
    KRD(GL,0); GAPB(o[0]=__builtin_amdgcn_mfma_f32_32x32x16_bf16(PAF(1),VFR(1),o[0],0,0,0), C0,8); \
    KRD(GL,1); GAPB(o[1]=__builtin_amdgcn_mfma_f32_32x32x16_bf16(PAF(1),VFR(5),o[1],0,0,0), C0,12); \
    KRD(GL,2); GAPB(o[0]=__builtin_amdgcn_mfma_f32_32x32x16_bf16(PAF(2),VFR(2),o[0],0,0,0), C1,0); \
    KRD(GL,3); GAPB(o[1]=__builtin_amdgcn_mfma_f32_32x32x16_bf16(PAF(2),VFR(6),o[1],0,0,0), C1,4); \
    GAPB(o[0]=__builtin_amdgcn_mfma_f32_32x32x16_bf16(PAF(3),VFR(3),o[0],0,0,0), C1,8); \
    GAPB(o[1]=__builtin_amdgcn_mfma_f32_32x32x16_bf16(PAF(3),VFR(7),o[1],0,0,0), C1,12); \
    }while(0)
  int t=1;
  #undef CMASK
  #define CMASK(P0,P1,t) do{}while(0)
  for(;t+5<NT;t+=2){
    STEP(pB0,pB1,pA0,pA1,t,true,true,true);     WAIT_BAR(2); RESC(); ROT();
    STEP(pA0,pA1,pB0,pB1,t+1,true,true,true);   WAIT_BAR(2); RESC(); ROT();
  }
  #undef CMASK
  #define CMASK(P0,P1,t) do{int jb_=(t)-(NT-4); if(jb_>=0)cmask(P0,P1,jb_,qrel,hi);}while(0)
  #define ENDW(tt) do{ if((tt)+3<NT){WAIT_BAR(2);} else if((tt)+2<NT){WAIT_BAR(1);} else {WAIT_BAR(0);} }while(0)
  for(;t+1<NT;t+=2){
    STEP(pB0,pB1,pA0,pA1,t,(t+3<NT),(t+1<NT),(t+1<NT));       ENDW(t);   RESC(); ROT();
    STEP(pA0,pA1,pB0,pB1,t+1,(t+4<NT),(t+2<NT),(t+2<NT));     ENDW(t+1); RESC(); ROT();
  }
  STEP(pB0,pB1,pA0,pA1,NT-1,false,false,false); RESC();
  { float sacc=pB0[0]+pB0[1]; _Pragma("unroll") for(int r=2;r<16;++r)sacc+=pB0[r]; _Pragma("unroll") for(int r=0;r<16;++r)sacc+=pB1[r]; l_reg+=sacc;
    pw0=(u32x4){PKW(pB0,0),PKW(pB0,2),PKW(pB0,4),PKW(pB0,6)};pw1=(u32x4){PKW(pB0,8),PKW(pB0,10),PKW(pB0,12),PKW(pB0,14)};pw2=(u32x4){PKW(pB1,0),PKW(pB1,2),PKW(pB1,4),PKW(pB1,6)};pw3=(u32x4){PKW(pB1,8),PKW(pB1,10),PKW(pB1,12),PKW(pB1,14)};
    SBAR(); pv(o,vb0+sl_cur,PAF(0),PAF(1),PAF(2),PAF(3)); }
  #undef PKW
  #undef PAF
  #undef VFR
  #undef PIN
  #undef MX3
  #undef GAPA
  #undef GAPB
  #undef EX
  #undef VRD
  #undef KRD
  #undef STEP
  #undef ENDW
  {auto rr=__builtin_amdgcn_permlane32_swap(__float_as_uint(l_reg),__float_as_uint(l_reg),false,false);l_reg=__uint_as_float(rr[0])+__uint_as_float(rr[1]);}
  if(hi==0)wsf[32+r32]=l_reg;asm volatile("s_waitcnt lgkmcnt(0)":::"memory");
  float rli[16];
  #pragma unroll
  for(int r=0;r<16;++r)rli[r]=__builtin_amdgcn_rcpf(wsf[32+crow(r,hi)]);
  { hbf16*stg=(hbf16*)(shm+LDS_OST)+wid*2048;
    #pragma unroll
    for(int r=0;r<16;++r){const int orow=crow(r,hi);
      #pragma unroll
      for(int d0=0;d0<2;++d0)stg[orow*64+d0*32+r32]=__float2bfloat16(o[d0][r]*rli[r]);}
    asm volatile("s_waitcnt lgkmcnt(0)":::"memory");
    const long grow=rowbase+q0+wid*QBLK; float*ssq=(float*)(shm+LDS_SSQ)+wid*32;
    int lane_e=lane; asm volatile("":"+v"(lane_e));
    #pragma unroll
    for(int i=0;i<4;++i){const int row=i*8+(lane_e>>3),ch=lane_e&7; const u32x4 v=*(const u32x4*)(stg+row*64+ch*8);
      if(MODE==0){ *(u32x4*)(P.out+(grow+row)*(long)P.opitch+ch*8)=v; }
      else { bf16*sp=P.stash+(grow+row)*512+ch*8+(MODE==2?64:0); const u32x4 a=*(const u32x4*)sp; float of[8]; float ss=0.f;
        #pragma unroll
        for(int j=0;j<4;++j){ const float a0=__uint_as_float(a[j]<<16),a1=__uint_as_float(a[j]&0xffff0000u),c0=__uint_as_float(v[j]<<16),c1=__uint_as_float(v[j]&0xffff0000u);
          of[2*j]=a0-P.lam*c0; of[2*j+1]=a1-P.lam*c1; ss+=of[2*j]*of[2*j]+of[2*j+1]*of[2*j+1]; }
        ss+=__int_as_float(__builtin_amdgcn_ds_swizzle(__float_as_int(ss),0x041f)); ss+=__int_as_float(__builtin_amdgcn_ds_swizzle(__float_as_int(ss),0x081f)); ss+=__int_as_float(__builtin_amdgcn_ds_swizzle(__float_as_int(ss),0x101f));
        if(MODE==1){ if(ch==0)ssq[row]=ss; u32x4 w; _Pragma("unroll") for(int j=0;j<4;++j)w[j]=cvtpk_s(of[2*j],of[2*j+1]); *(u32x4*)sp=w; }
        else { const float rr_=rsqrtf((ss+ssq[row])*(1.0f/128.0f)+1e-6f)*P.nscale; bf16*yp=P.out+(grow+row)*(long)P.opitch+ch*8;
          const f32x4_t g0=*(const f32x4_t*)(P.gsub+64+ch*8), g1=*(const f32x4_t*)(P.gsub+64+ch*8+4), h0=*(const f32x4_t*)(P.gsub+ch*8), h1=*(const f32x4_t*)(P.gsub+ch*8+4);
          u32x4 w; w[0]=cvtpk_s(of[0]*rr_*g0[0],of[1]*rr_*g0[1]); w[1]=cvtpk_s(of[2]*rr_*g0[2],of[3]*rr_*g0[3]); w[2]=cvtpk_s(of[4]*rr_*g1[0],of[5]*rr_*g1[1]); w[3]=cvtpk_s(of[6]*rr_*g1[2],of[7]*rr_*g1[3]);
          *(u32x4*)(yp+64)=w;
          const u32x4 lo=*(const u32x4*)(sp-64); float lf[8];
          #pragma unroll
          for(int j=0;j<4;++j){ lf[2*j]=__uint_as_float(lo[j]<<16); lf[2*j+1]=__uint_as_float(lo[j]&0xffff0000u); }
          w[0]=cvtpk_s(lf[0]*rr_*h0[0],lf[1]*rr_*h0[1]); w[1]=cvtpk_s(lf[2]*rr_*h0[2],lf[3]*rr_*h0[3]); w[2]=cvtpk_s(lf[4]*rr_*h1[0],lf[5]*rr_*h1[1]); w[3]=cvtpk_s(lf[6]*rr_*h1[2],lf[7]*rr_*h1[3]);
          *(u32x4*)yp=w; } } } }
  asm volatile("s_waitcnt lgkmcnt(0)\n\ts_barrier":::"memory");
  #undef DMA_K
  #undef BIAS
  #undef DMA_V
  #undef CMASK
  #undef START
  #undef RESC
  #undef ROT
}
__device__ __forceinline__ void pv128(f32x16*o,int vb,bf16x8 pa0,bf16x8 pa1,bf16x8 pa2,bf16x8 pa3){
  #pragma unroll
  for(int d0=0;d0<4;++d0){s16x4 lo[4],hi[4];
    #pragma unroll
    for(int ks=0;ks<4;++ks){
      asm volatile("ds_read_b64_tr_b16 %0,%1 offset:%c2":"=&v"(lo[ks]):"v"(vb),"i"(d0*4096+ks*1024):"memory");
      asm volatile("ds_read_b64_tr_b16 %0,%1 offset:%c2":"=&v"(hi[ks]):"v"(vb),"i"(d0*4096+ks*1024+512):"memory");}
    asm volatile("s_waitcnt lgkmcnt(0)":::"memory");SBAR();
    #define PK(k) (bf16x8){lo[k][0],lo[k][1],lo[k][2],lo[k][3],hi[k][0],hi[k][1],hi[k][2],hi[k][3]}
    o[d0]=__builtin_amdgcn_mfma_f32_32x32x16_bf16(pa0,PK(0),o[d0],0,0,0);
    o[d0]=__builtin_amdgcn_mfma_f32_32x32x16_bf16(pa1,PK(1),o[d0],0,0,0);
    o[d0]=__builtin_amdgcn_mfma_f32_32x32x16_bf16(pa2,PK(2),o[d0],0,0,0);
    o[d0]=__builtin_amdgcn_mfma_f32_32x32x16_bf16(pa3,PK(3),o[d0],0,0,0);
    #undef PK
  }
}
template<int THRL> __device__ __forceinline__ void attn_unit128(const int tid_in,int b,int qb,const int MODE,const AttnP&P,char*shm){
  constexpr bool FOX=false; constexpr int LDS_V=24576, LDS_WS=73728, LDS_OST=75776, SLOTV=16384;
  int tid=tid_in; asm volatile("":"+v"(tid));
  const int lane=tid&63,r32=lane&31,hi=lane>>5; const int wid=__builtin_amdgcn_readfirstlane(tid>>6);
  const long rowbase=(long)b*SEQ; const int q0=qb*QB;
  const bf16*Qw=P.Q+(rowbase+q0+wid*QBLK)*DM;
  const bf16*Kh=P.K+rowbase*DM,*Vh=P.V+rowbase*DM;
  const unsigned lds0=(unsigned)(uintptr_t)shm;
  float*wsf=(float*)(shm+LDS_WS)+wid*64;
  const float*biasL=(const float*)(shm+LDS_BIAS);
  #define BIAS(P0,P1,t) do{ if(FOX){ const float*bb_=biasL+64*(t)+4*hi; _Pragma("unroll") for(int g_=0;g_<4;++g_){ const f32x4_t b0_=*(const f32x4_t*)(bb_+8*g_), b1_=*(const f32x4_t*)(bb_+32+8*g_); \
      _Pragma("unroll") for(int e_=0;e_<4;++e_){ P0[4*g_+e_]+=b0_[e_]; P1[4*g_+e_]+=b1_[e_]; } asm volatile("":::"memory"); } } }while(0)
  const bf16*ksrc=Kh+(long)lane*DM+wid*8;
  const bf16*vsrc=Vh+(long)(16*(wid&3)+(lane>>2))*DM+(wid>>2)*32+(lane&3)*8;
  const unsigned kdst=lds0+LDS_K+wid*1024, vdst=lds0+LDS_V+wid*1024;
  #define DMA_K(t,slot) glds16(ksrc+(long)(t)*KVBLK*DM,(unsigned)__builtin_amdgcn_readfirstlane(kdst+(slot)))
  #define DMA_V(t,slot) do{ glds16(vsrc+(long)(t)*KVBLK*DM,(unsigned)__builtin_amdgcn_readfirstlane(vdst+2*(slot))); glds16(vsrc+(long)(t)*KVBLK*DM+64,(unsigned)__builtin_amdgcn_readfirstlane(vdst+2*(slot)+8192)); }while(0)
  const int vb0=(int)(lds0+LDS_V)+((lane>>4)&1)*32+(lane&3)*8+(4*hi+((lane&15)>>2))*64;
  const char*Kbase=shm+LDS_K; bf16x8 kf[8];
  const lds_cptr shm3=(lds_cptr)shm; const lds_cptr kp0=shm3+LDS_K+hi*1024+r32*16; const lds_cptr vp0=shm3+LDS_V+((lane>>4)&1)*32+(lane&3)*8+(4*hi+((lane&15)>>2))*64;
  const int NT=(q0+QB)/KVBLK;
  DMA_K(0,0);DMA_V(0,0);DMA_K(1,SLOTB);
  bf16x8 qr[4];
  #pragma unroll
  for(int d0=0;d0<4;++d0)qr[d0]=*reinterpret_cast<const bf16x8*>(&Qw[(long)r32*DM+d0*16+hi*8]);
  float mhat=0.f,l_reg=0.f;f32x16 o[4];o[0]=f32x16{};o[1]=f32x16{};o[2]=f32x16{};o[3]=f32x16{};const f32x16 zero16=f32x16{};
  const int qrel=wid*QBLK+r32;
  #define CMASK(P0,P1,t) do{int jb_=(t)-(NT-4); if(jb_>=0)cmask(P0,P1,jb_,qrel,hi);}while(0)
  bool resc=false;
  #define START(P0,P1) do{ const float rm=rowmax(P0,P1); resc=false; \
    { const float dl=rm; mhat=fadd_s(mhat,dl); \
      _Pragma("unroll") for(int r=0;r<16;++r){P0[r]=fsub_s(P0[r],dl);P1[r]=fsub_s(P1[r],dl);} \
      } \
    _Pragma("unroll") for(int r=0;r<16;++r)P0[r]=__builtin_amdgcn_exp2f(P0[r]); }while(0)
  #define RESC() do{ if(resc){ asm volatile("s_waitcnt lgkmcnt(0)":::"memory"); \
      _Pragma("unroll") for(int d_=0;d_<4;++d_) _Pragma("unroll") for(int r=0;r<16;++r)o[d_][r]*=wsf[crow(r,hi)]; } }while(0)
  f32x16 pA0,pA1,pB0,pB1;
  int sl_prev=0,sl_cur=0,sl_next=SLOTB;
  #define ROT() do{sl_prev=sl_cur;sl_cur=sl_next;sl_next=(sl_next==(NSLOT-1)*SLOTB)?0:sl_next+SLOTB;}while(0)
  DMA_K(2,2*SLOTB);
  WAIT_BAR(4);
  qkt(pA0,pA1,Kbase,qr,zero16,r32,hi);asm volatile("s_nop 15\n\ts_nop 7":"+v"(pA0),"+v"(pA1));BIAS(pA0,pA1,0);CMASK(pA0,pA1,0);
  START(pA0,pA1);
  _Pragma("unroll") for(int r=0;r<16;++r)pA1[r]=__builtin_amdgcn_exp2f(pA1[r]);
  WAIT_BAR(0);
  DMA_K(3,0);DMA_V(1,SLOTB);
  ROT();
  kload8(kf,kp0+sl_cur);
  WAIT_BAR(3);
  s16x4 va_lo,va_hi,vb_lo,vb_hi; u32x4 pw0,pw1,pw2,pw3;
  #define PKW(P,B) cvtpk_s(P[B],P[B+1])
  #define PAF(k) __builtin_bit_cast(bf16x8,pw##k)
  #define VFA (bf16x8){va_lo[0],va_lo[1],va_lo[2],va_lo[3],va_hi[0],va_hi[1],va_hi[2],va_hi[3]}
  #define VFB (bf16x8){vb_lo[0],vb_lo[1],vb_lo[2],vb_lo[3],vb_hi[0],vb_hi[1],vb_hi[2],vb_hi[3]}
  #define PIN(x) asm volatile("":"+v"(x))
  #define MX3(a,b,c) __builtin_fmaxf(__builtin_fmaxf((a),(b)),(c))
  #define GAPA(MF,A0,A1,A2,A3,W0,W1,PW) do{ MF; sacc+=A0; sacc+=A1; sacc+=A2; sacc+=A3; PIN(sacc); W0; W1; PIN(PW); SBAR(); }while(0)
  #define EX(v) __builtin_amdgcn_exp2f((v)-mhat)
  #define VRDA(d0,ks) do{ va_lo=vtr(vp_+((d0)*4096+(ks)*1024)); va_hi=vtr(vp_+((d0)*4096+(ks)*1024+512)); }while(0)
  #define VRDB(d0,ks) do{ vb_lo=vtr(vp_+((d0)*4096+(ks)*1024)); vb_hi=vtr(vp_+((d0)*4096+(ks)*1024+512)); }while(0)
  #define KRD(G,j) do{ if(G){ kload2(kf,kp0+sl_next,j); } }while(0)
  #define GAPB(MF,RD,X,B) do{ MF; RD; X[B]=EX(X[B]); X[B+1]=EX(X[B+1]); PIN(X); SBAR(); }while(0)
  #define STEP(C0,C1,P0,P1,t,GK,GV,GL) do{ SBAR(); \
    const lds_cptr vp_=vp0+2*sl_prev; \
    float sacc=(P0[0]+P0[1]); \
    GAPA(C0=__builtin_amdgcn_mfma_f32_32x32x16_bf16(kf[0],qr[0],zero16,0,0,0), P0[2],P0[3],P0[4],P0[5],     pw0[0]=PKW(P0,0), pw0[1]=PKW(P0,2), pw0); \
    GAPA(C1=__builtin_amdgcn_mfma_f32_32x32x16_bf16(kf[1],qr[0],zero16,0,0,0), P0[6],P0[7],P0[8],P0[9],     pw0[2]=PKW(P0,4), pw0[3]=PKW(P0,6), pw0); \
    GAPA(C0=__builtin_amdgcn_mfma_f32_32x32x16_bf16(kf[2],qr[1],C0,0,0,0),   P0[10],P0[11],P0[12],P0[13], pw1[0]=PKW(P0,8), pw1[1]=PKW(P0,10), pw1); \
    GAPA(C1=__builtin_amdgcn_mfma_f32_32x32x16_bf16(kf[3],qr[1],C1,0,0,0),   P0[14],P0[15],P1[0],P1[1],   pw1[2]=PKW(P0,12),pw1[3]=PKW(P0,14), pw1); \
    GAPA(C0=__builtin_amdgcn_mfma_f32_32x32x16_bf16(kf[4],qr[2],C0,0,0,0),   P1[2],P1[3],P1[4],P1[5],     pw2[0]=PKW(P1,0), pw2[1]=PKW(P1,2), pw2); \
    GAPA(C1=__builtin_amdgcn_mfma_f32_32x32x16_bf16(kf[5],qr[2],C1,0,0,0),   P1[6],P1[7],P1[8],P1[9],     pw2[2]=PKW(P1,4), pw2[3]=PKW(P1,6), pw2); \
    VRDA(0,0); SBAR(); \
    GAPA(C0=__builtin_amdgcn_mfma_f32_32x32x16_bf16(kf[6],qr[3],C0,0,0,0),   P1[10],P1[11],P1[12],P1[13], pw3[0]=PKW(P1,8), pw3[1]=PKW(P1,10), pw3); \
    GAPA(C1=__builtin_amdgcn_mfma_f32_32x32x16_bf16(kf[7],qr[3],C1,0,0,0),   P1[14],P1[15],0.f,0.f,       pw3[2]=PKW(P1,12),pw3[3]=PKW(P1,14), pw3); \
    l_reg+=sacc; \
    if(GK){DMA_K((t)+3,sl_cur);} if(GV){DMA_V((t)+1,sl_next);} \
    CMASK(C0,C1,t); \
    { float a=MX3(C0[0],C0[1],C1[0]),b=MX3(C0[2],C0[3],C1[1]); a=MX3(a,C1[2],C1[3]); \
      _Pragma("unroll") for(int r=4;r<16;r+=4){a=MX3(a,C0[r],C0[r+1]);b=MX3(b,C0[r+2],C0[r+3]);a=MX3(a,C1[r],C1[r+1]);b=MX3(b,C1[r+2],C1[r+3]);} \
      float rm=__builtin_fmaxf(a,b); { auto rr=__builtin_amdgcn_permlane32_swap(__float_as_uint(rm),__float_as_uint(rm),false,false); rm=__builtin_fmaxf(__uint_as_float(rr[0]),__uint_as_float(rr[1])); } \
      rm-=mhat; resc=false; \
      if(__builtin_expect(__any(rm>(float)THRL),0)){ const float dl=__builtin_fmaxf(rm,0.f); mhat+=dl; \
        const float f=__builtin_amdgcn_exp2f(-dl); l_reg*=f; if(hi==0)wsf[r32]=f; resc=true; } } \
    SBAR(); \
    GAPB(o[0]=__builtin_amdgcn_mfma_f32_32x32x16_bf16(PAF(0),VFA,o[0],0,0,0), VRDB(1,0), C0,0); \
    GAPB(o[1]=__builtin_amdgcn_mfma_f32_32x32x16_bf16(PAF(0),VFB,o[1],0,0,0), VRDA(2,0), C0,2); \
    GAPB(o[2]=__builtin_amdgcn_mfma_f32_32x32x16_bf16(PAF(0),VFA,o[2],0,0,0), VRDB(3,0), C0,4); \
    GAPB(o[3]=__builtin_amdgcn_mfma_f32_32x32x16_bf16(PAF(0),VFB,o[3],0,0,0), VRDA(0,1), C0,6); \
    KRD(GL,0); GAPB(o[0]=__builtin_amdgcn_mfma_f32_32x32x16_bf16(PAF(1),VFA,o[0],0,0,0), VRDB(1,1), C0,8); \
    GAPB(o[1]=__builtin_amdgcn_mfma_f32_32x32x16_bf16(PAF(1),VFB,o[1],0,0,0), VRDA(2,1), C0,10); \
    KRD(GL,1); GAPB(o[2]=__builtin_amdgcn_mfma_f32_32x32x16_bf16(PAF(1),VFA,o[2],0,0,0), VRDB(3,1), C0,12); \
    GAPB(o[3]=__builtin_amdgcn_mfma_f32_32x32x16_bf16(PAF(1),VFB,o[3],0,0,0), VRDA(0,2), C0,14); \
    KRD(GL,2); GAPB(o[0]=__builtin_amdgcn_mfma_f32_32x32x16_bf16(PAF(2),VFA,o[0],0,0,0), VRDB(1,2), C1,0); \
    GAPB(o[1]=__builtin_amdgcn_mfma_f32_32x32x16_bf16(PAF(2),VFB,o[1],0,0,0), VRDA(2,2), C1,2); \
    KRD(GL,3); GAPB(o[2]=__builtin_amdgcn_mfma_f32_32x32x16_bf16(PAF(2),VFA,o[2],0,0,0), VRDB(3,2), C1,4); \
    GAPB(o[3]=__builtin_amdgcn_mfma_f32_32x32x16_bf16(PAF(2),VFB,o[3],0,0,0), VRDA(0,3), C1,6); \
    GAPB(o[0]=__builtin_amdgcn_mfma_f32_32x32x16_bf16(PAF(3),VFA,o[0],0,0,0), VRDB(1,3), C1,8); \
    GAPB(o[1]=__builtin_amdgcn_mfma_f32_32x32x16_bf16(PAF(3),VFB,o[1],0,0,0), VRDA(2,3), C1,10); \
    GAPB(o[2]=__builtin_amdgcn_mfma_f32_32x32x16_bf16(PAF(3),VFA,o[2],0,0,0), VRDB(3,3), C1,12); \
    GAPB(o[3]=__builtin_amdgcn_mfma_f32_32x32x16_bf16(PAF(3),VFB,o[3],0,0,0), (void)0, C1,14); \
    }while(0)
  int t=1;
  #undef CMASK
  #define CMASK(P0,P1,t) do{}while(0)
  for(;t+5<NT;t+=2){
    STEP(pB0,pB1,pA0,pA1,t,true,true,true);     WAIT_BAR(3); RESC(); ROT();
    STEP(pA0,pA1,pB0,pB1,t+1,true,true,true);   WAIT_BAR(3); RESC(); ROT();
  }
  #undef CMASK
  #define CMASK(P0,P1,t) do{int jb_=(t)-(NT-4); if(jb_>=0)cmask(P0,P1,jb_,qrel,hi);}while(0)
  #define ENDW(tt) do{ if((tt)+3<NT){WAIT_BAR(3);} else if((tt)+2<NT){WAIT_BAR(2);} else {WAIT_BAR(0);} }while(0)
  for(;t+1<NT;t+=2){
    STEP(pB0,pB1,pA0,pA1,t,(t+3<NT),(t+1<NT),(t+1<NT));       ENDW(t);   RESC(); ROT();
    STEP(pA0,pA1,pB0,pB1,t+1,(t+4<NT),(t+2<NT),(t+2<NT));     ENDW(t+1); RESC(); ROT();
  }
  STEP(pB0,pB1,pA0,pA1,NT-1,false,false,false); RESC();
  { float sacc=pB0[0]+pB0[1]; _Pragma("unroll") for(int r=2;r<16;++r)sacc+=pB0[r]; _Pragma("unroll") for(int r=0;r<16;++r)sacc+=pB1[r]; l_reg+=sacc;
    pw0=(u32x4){PKW(pB0,0),PKW(pB0,2),PKW(pB0,4),PKW(pB0,6)};pw1=(u32x4){PKW(pB0,8),PKW(pB0,10),PKW(pB0,12),PKW(pB0,14)};pw2=(u32x4){PKW(pB1,0),PKW(pB1,2),PKW(pB1,4),PKW(pB1,6)};pw3=(u32x4){PKW(pB1,8),PKW(pB1,10),PKW(pB1,12),PKW(pB1,14)};
    SBAR(); pv128(o,vb0+2*sl_cur,PAF(0),PAF(1),PAF(2),PAF(3)); }
  #undef PKW
  #undef PAF
  #undef VFA
  #undef VFB
  #undef VRDA
  #undef VRDB
  #undef PIN
  #undef MX3
  #undef GAPA
  #undef GAPB
  #undef EX
  #undef KRD
  #undef STEP
  #undef ENDW
  {auto rr=__builtin_amdgcn_permlane32_swap(__float_as_uint(l_reg),__float_as_uint(l_reg),false,false);l_reg=__uint_as_float(rr[0])+__uint_as_float(rr[1]);}
  if(hi==0)wsf[32+r32]=l_reg;asm volatile("s_waitcnt lgkmcnt(0)":::"memory");
  float rli[16];
  #pragma unroll
  for(int r=0;r<16;++r)rli[r]=__builtin_amdgcn_rcpf(wsf[32+crow(r,hi)]);
  { hbf16*stg=(hbf16*)(shm+LDS_OST)+wid*2048;
    const long grow=rowbase+q0+wid*QBLK;
    int lane_e=lane; asm volatile("":"+v"(lane_e));
    float of[2][4][8]; float ssr[4]={0.f,0.f,0.f,0.f};
    #pragma unroll
    for(int hf=0;hf<2;++hf){
      #pragma unroll
      for(int r=0;r<16;++r){const int orow=crow(r,hi);
        #pragma unroll
        for(int d0=0;d0<2;++d0)stg[orow*64+d0*32+r32]=__float2bfloat16(o[2*hf+d0][r]*rli[r]);}
      asm volatile("s_waitcnt lgkmcnt(0)":::"memory");
      #pragma unroll
      for(int i=0;i<4;++i){const int row=i*8+(lane_e>>3),ch=lane_e&7; const u32x4 v=*(const u32x4*)(stg+row*64+ch*8);
        if(MODE==0){ *(u32x4*)(P.out+(grow+row)*(long)P.opitch+hf*64+ch*8)=v; }
        else { const u32x4 a=*(const u32x4*)(P.stash+(grow+row)*512+hf*64+ch*8); float ss=0.f;
          #pragma unroll
          for(int j=0;j<4;++j){ const float a0=__uint_as_float(a[j]<<16),a1=__uint_as_float(a[j]&0xffff0000u),c0=__uint_as_float(v[j]<<16),c1=__uint_as_float(v[j]&0xffff0000u);
            of[hf][i][2*j]=a0-P.lam*c0; of[hf][i][2*j+1]=a1-P.lam*c1; ss+=of[hf][i][2*j]*of[hf][i][2*j]+of[hf][i][2*j+1]*of[hf][i][2*j+1]; }
          ssr[i]+=ss; } }
      asm volatile("s_waitcnt lgkmcnt(0)":::"memory");
    }
    if(MODE!=0){
      #pragma unroll
      for(int i=0;i<4;++i){const int row=i*8+(lane_e>>3),ch=lane_e&7; float ss=ssr[i];
        ss+=__int_as_float(__builtin_amdgcn_ds_swizzle(__float_as_int(ss),0x041f)); ss+=__int_as_float(__builtin_amdgcn_ds_swizzle(__float_as_int(ss),0x081f)); ss+=__int_as_float(__builtin_amdgcn_ds_swizzle(__float_as_int(ss),0x101f));
        const float rr_=rsqrtf(ss*(1.0f/128.0f)+1e-6f)*P.nscale; bf16*yp=P.out+(grow+row)*(long)P.opitch+ch*8;
        #pragma unroll
        for(int hf=0;hf<2;++hf){ const f32x4_t g0=*(const f32x4_t*)(P.gsub+hf*64+ch*8), g1=*(const f32x4_t*)(P.gsub+hf*64+ch*8+4); u32x4 w;
          w[0]=cvtpk_s(of[hf][i][0]*rr_*g0[0],of[hf][i][1]*rr_*g0[1]); w[1]=cvtpk_s(of[hf][i][2]*rr_*g0[2],of[hf][i][3]*rr_*g0[3]); w[2]=cvtpk_s(of[hf][i][4]*rr_*g1[0],of[hf][i][5]*rr_*g1[1]); w[3]=cvtpk_s(of[hf][i][6]*rr_*g1[2],of[hf][i][7]*rr_*g1[3]);
          *(u32x4*)(yp+hf*64)=w; } } } }
  asm volatile("s_waitcnt lgkmcnt(0)\n\ts_barrier":::"memory");
  #undef DMA_K
  #undef BIAS
  #undef DMA_V
  #undef CMASK
  #undef START
  #undef RESC
  #undef ROT
}
constexpr int ATTN_LDS_BYTES=LDS_BYTES;
#undef SBAR
#undef WAIT_BAR
}
#ifndef MK_MU8
#define MK_MU8 0
#endif
#ifndef MK_PLE8
#define MK_PLE8 0
#endif
#define GAS __attribute__((address_space(1)))
#define LAS __attribute__((address_space(3)))
typedef unsigned v4u __attribute__((ext_vector_type(4)));
typedef float f32x4 __attribute__((ext_vector_type(4)));
typedef GAS unsigned gu32;
#define RLX_AGENT __ATOMIC_RELAXED, __HIP_MEMORY_SCOPE_AGENT
#define LDS_WAIT() asm volatile("s_waitcnt lgkmcnt(0)" ::: "memory")
#define VM_WAIT() asm volatile("s_waitcnt vmcnt(0)" ::: "memory")
constexpr int NWAVES = 8;
constexpr size_t W_IN = 0;
constexpr size_t W_CAT = W_IN + (size_t)3840 * 1024 * 2;
constexpr size_t W_G8 = W_CAT;
constexpr size_t W_BR = W_CAT + (size_t)3 * 1024 * 1024;
constexpr float G8_SCALE = 128.0f;
constexpr size_t W_OUT = W_CAT + (size_t)3 * 1024 * 1536 * 2;
constexpr size_t W_GU = W_OUT + (size_t)1024 * 1024 * 2;
constexpr size_t W_D = W_GU + (size_t)16 * 512 * 1024 * 2;
constexpr size_t W_RH = W_D + (size_t)16 * 1024 * 256 * 2;
constexpr size_t W_RL = W_RH + 65536;
constexpr size_t W_ENDB = W_RL + 65536;
static_assert(WS_W + W_ENDB <= WS_SSB && WS_SSB + MiB <= WS_WPLE, "weight map");
constexpr size_t W_PG = 0, W_P = (size_t)1024 * 1024 * 2, WPLE_STRIDE = (size_t)5 * 512 * 1024;
constexpr size_t OUT_XB8 = 0, OUT_GATES = 16 * MiB;
constexpr size_t OV_PB = WS_PB;
constexpr size_t OV_PW = WS_PROJ + 8 * MiB;
constexpr size_t OV_ACT = WS_PROJ + 40 * MiB;
constexpr size_t OV_XB2 = WS_PROJ + 64 * MiB;
constexpr int RING_BYTES = 131072, MISC_OFF = RING_BYTES, LDS_BYTES = 147456;
constexpr int MI_N = 0, MI_BASE = 32, MI_U0 = 64, MI_TOT = 96, MI_Q = 100, MI_BAR = 104;

__device__ __forceinline__ unsigned pk2(float lo, float hi) { typedef float f2 __attribute__((ext_vector_type(2))); typedef __bf16 b2 __attribute__((ext_vector_type(2))); f2 v = {lo, hi}; b2 b = __builtin_convertvector(v, b2); return __builtin_bit_cast(unsigned, b); }
__device__ __forceinline__ float bflo(unsigned u) { return __uint_as_float(u << 16); }
__device__ __forceinline__ float bfhi(unsigned u) { return __uint_as_float(u & 0xffff0000u); }
__device__ __forceinline__ float sigm(float v) { return __builtin_amdgcn_rcpf(1.0f + __expf(-v)); }
__device__ __forceinline__ float sg2(float t) { return __builtin_amdgcn_rcpf(1.0f + __builtin_amdgcn_exp2f(t)); }
__device__ __forceinline__ float clamp8(float v) { return __builtin_amdgcn_fmed3f(v, -448.0f, 448.0f); }
__device__ __forceinline__ unsigned pk_fp8x4(float a, float b, float c, float d) {
    int w = __builtin_amdgcn_cvt_pk_fp8_f32(clamp8(a), clamp8(b), 0, false); w = __builtin_amdgcn_cvt_pk_fp8_f32(clamp8(c), clamp8(d), w, true); return (unsigned)w; }

#define XOR1(v) __int_as_float(__builtin_amdgcn_ds_swizzle(__float_as_int(v), 0x041f))
#define XOR2(v) __int_as_float(__builtin_amdgcn_ds_swizzle(__float_as_int(v), 0x081f))
#define XOR4(v) __int_as_float(__builtin_amdgcn_ds_swizzle(__float_as_int(v), 0x101f))
#define XOR8(v) __int_as_float(__builtin_amdgcn_ds_swizzle(__float_as_int(v), 0x201f))
#define XOR16(v) __int_as_float(__builtin_amdgcn_ds_swizzle(__float_as_int(v), 0x401f))
__device__ __forceinline__ float add_xor32(float v) { const auto r = __builtin_amdgcn_permlane32_swap(__float_as_uint(v), __float_as_uint(v), false, false); return __uint_as_float(r[0]) + __uint_as_float(r[1]); }
__device__ __forceinline__ float wave_sum64(float v) { v += XOR1(v); v += XOR2(v); v += XOR4(v); v += XOR8(v); v += XOR16(v); return add_xor32(v); }
__device__ __forceinline__ int mk_tid(int wave0) { int l; asm volatile("v_mbcnt_lo_u32_b32 %0, -1, 0\n\tv_mbcnt_hi_u32_b32 %0, -1, %0" : "=v"(l)); return wave0 * 64 + l; }

#define XB_TMO      128
#define XB_XCNT(j)  (256  + 64 * (j))
#define XB_XSUB(j)  (1280 + 64 * (j))
#define XB_XGEN(j)  (2304 + 64 * (j))
#define XB_TOP      3328
#define XB_TOPGEN   3392
#define XCD_BAR_WORDS 3456
#define XB_SPIN_CAP (1u << 18)
__device__ __forceinline__ unsigned xb_ld(unsigned* p)              { return __hip_atomic_load(p, __ATOMIC_RELAXED, __HIP_MEMORY_SCOPE_AGENT); }
__device__ __forceinline__ unsigned xb_add(unsigned* p, unsigned v) { return __hip_atomic_fetch_add(p, v, __ATOMIC_RELAXED, __HIP_MEMORY_SCOPE_AGENT); }
__device__ __forceinline__ unsigned xb_xcc_id() { return (unsigned)__builtin_amdgcn_s_getreg((3 << 11) | 20) & 0xFu; }
#define XB_SPIN(cond, bar) do { unsigned _sp = 0; while (cond) { __builtin_amdgcn_s_sleep(1); \
    if ((++_sp & 255u) == 0u) { if (xb_ld(&(bar)[XB_TMO])) break; if (_sp > XB_SPIN_CAP) { atomicAdd(&(bar)[XB_TMO], 1u); break; } } } } while (0)
struct XcdBarrier { unsigned* bar; unsigned x; volatile LAS unsigned* st; };
__device__ __forceinline__ XcdBarrier xcd_barrier_post(unsigned* bar, volatile LAS unsigned* st, int tid) {
    XcdBarrier b; b.bar = bar; b.x = xb_xcc_id(); b.st = st;
    if (tid == 0) (void)xb_add(&bar[XB_XCNT(b.x)], 1u);
    return b;
}
__device__ __forceinline__ void xcd_barrier_complete(unsigned* bar, unsigned x, unsigned& nloc, unsigned& nx) {
    const unsigned G = gridDim.x * gridDim.y * gridDim.z;
    unsigned sum, cnt, mine, sp = 0u;
    for (;;) {
        sum = 0u; cnt = 0u; mine = 0u;
#pragma unroll
        for (unsigned j = 0; j < 16; ++j) { const unsigned c = xb_ld(&bar[XB_XCNT(j)]); sum += c; cnt += (c > 0u) ? 1u : 0u; mine = (j == x) ? c : mine; }
        if (sum == G) break;
        __builtin_amdgcn_s_sleep(1);
        if ((++sp & 255u) == 0u) { if (xb_ld(&bar[XB_TMO])) break; if (sp > XB_SPIN_CAP) { atomicAdd(&bar[XB_TMO], 1u); break; } }
    }
    nloc = mine > 0u ? mine : 1u; nx = cnt > 0u ? cnt : 1u;
}
#ifndef MK_EARLYINV
#define MK_EARLYINV 1
#endif
#ifndef MK_SPLIT_SLEEP
#define MK_SPLIT_SLEEP 16
#endif
__device__ __forceinline__ void xcd_barrier(const XcdBarrier& b, int tid) {
    asm volatile("s_waitcnt vmcnt(0)" ::: "memory");
    __syncthreads();
    if (tid == 0) {
        unsigned* bar = b.bar;
        __builtin_amdgcn_s_waitcnt(0);
        unsigned nloc = b.st[0], nx = b.st[1];
        if (nloc == 0u) { xcd_barrier_complete(bar, b.x, nloc, nx); b.st[0] = nloc; b.st[1] = nx; }
        const unsigned old = xb_add(&bar[XB_XSUB(b.x)], 1u);
        const unsigned gen = old / nloc;
        if (old + 1u == (gen + 1u) * nloc) {
            __builtin_amdgcn_fence(__ATOMIC_RELEASE, "agent");
            asm volatile("s_waitcnt vmcnt(0)" ::: "memory");
            const unsigned og = xb_add(&bar[XB_TOP], 1u);
            unsigned tg = og / nx; asm volatile("" : "+v"(tg) :: "memory");
            if (og + 1u == (tg + 1u) * nx) { xb_add(&bar[XB_TOPGEN], 1u);
#if MK_EARLYINV
                xb_add(&bar[XB_XGEN(b.x)], 1u); asm volatile("buffer_inv sc1" ::: "memory");
#endif
            } else {
#if MK_EARLYINV
                asm volatile("buffer_inv sc1" ::: "memory");
#endif
                XB_SPIN(xb_ld(&bar[XB_TOPGEN]) == tg, bar);
#if MK_EARLYINV
                xb_add(&bar[XB_XGEN(b.x)], 1u);
#endif
            }
#if !MK_EARLYINV
            __builtin_amdgcn_fence(__ATOMIC_ACQUIRE, "agent");
            xb_add(&bar[XB_XGEN(b.x)], 1u);
#endif
            asm volatile("s_waitcnt vmcnt(0)" ::: "memory");
        } else {
#if MK_EARLYINV
            { unsigned g2 = gen; asm volatile("" : "+v"(g2) :: "memory"); asm volatile("buffer_inv sc1" ::: "memory");
              XB_SPIN(xb_ld(&bar[XB_XGEN(b.x)]) == g2, bar); }
#else
            XB_SPIN(xb_ld(&bar[XB_XGEN(b.x)]) == gen, bar);
            __builtin_amdgcn_fence(__ATOMIC_ACQUIRE, "agent");
#endif
            asm volatile("s_waitcnt vmcnt(0)" ::: "memory");
        }
    }
    __syncthreads();
}

__device__ __forceinline__ void split_arrive(unsigned* cnt, int tid) {
    asm volatile("s_waitcnt vmcnt(0)" ::: "memory"); __syncthreads();
    if (tid == 0) { __builtin_amdgcn_fence(__ATOMIC_RELEASE, "agent"); asm volatile("s_waitcnt vmcnt(0)" ::: "memory"); xb_add(cnt, 1u); }
}
__device__ __forceinline__ void split_arrive_x(const XcdBarrier& b, unsigned* cnt_top, unsigned* cnt_x, int tid) {
    asm volatile("s_waitcnt vmcnt(0)" ::: "memory"); __syncthreads();
    if (tid == 0) { const unsigned nloc = b.st[0]; const unsigned old = xb_add(cnt_x + 8u * b.x, 1u);
        if (old + 1u == nloc) { __builtin_amdgcn_fence(__ATOMIC_RELEASE, "agent"); asm volatile("s_waitcnt vmcnt(0)" ::: "memory"); xb_add(cnt_top, nloc); }
#if MK_EARLYINV
        asm volatile("buffer_inv sc1" ::: "memory");
#endif
    }
}
__device__ __forceinline__ void split_wait_leader(unsigned* cnt, unsigned target) {
    unsigned sp = 0; while (xb_ld(cnt) < target) { __builtin_amdgcn_s_sleep(MK_SPLIT_SLEEP); if (++sp > (1u << 22)) break; }
#if !MK_EARLYINV
    __builtin_amdgcn_fence(__ATOMIC_ACQUIRE, "agent");
#endif
    asm volatile("s_waitcnt vmcnt(0)" ::: "memory");
}

__device__ __forceinline__ void group4_sync(unsigned* gc, int tid) {
    asm volatile("s_waitcnt vmcnt(0)" ::: "memory"); __syncthreads();
    if (tid == 0) { const unsigned sh = 8u + 3u * xb_xcc_id();
        xb_add(gc, 1u + (1u << sh));
        asm volatile("buffer_inv sc1" ::: "memory");
        unsigned sp = 0, v = 0; for (;;) { v = xb_ld(gc); if ((v & 0xffu) >= 4u) break; __builtin_amdgcn_s_sleep(1); if (++sp > (1u << 22)) break; }
        if (((v >> sh) & 7u) != 4u) {
            __builtin_amdgcn_fence(__ATOMIC_RELEASE, "agent"); asm volatile("s_waitcnt vmcnt(0)" ::: "memory");
            xb_add(gc + 16, 1u); sp = 0; while (xb_ld(gc + 16) < 4u) { __builtin_amdgcn_s_sleep(1); if (++sp > (1u << 22)) break; }
            __builtin_amdgcn_fence(__ATOMIC_ACQUIRE, "agent"); }
        asm volatile("s_waitcnt vmcnt(0)" ::: "memory"); }
    __syncthreads();
}

struct Args { const void* in[27]; float* out; unsigned char* ws; int ph_lo, ph_hi, li, pad; };
struct LayerW {
    const float *g_attn, *w_in, *pool_w, *pool_scale, *dqn, *dkn, *dlam, *dsub, *fqn, *fkn, *ffb, *w_branch, *w_out, *g_ffn, *wrg, *brg, *wre, *bre, *wg, *wu, *wd, *g_ple, *wpg, *wple, *p;
};
__device__ __forceinline__ LayerW layer_view(const __attribute__((address_space(4))) Args* a, int l) {
    LayerW w; const float* in[27];
#pragma unroll
    for (int i = 0; i < 27; ++i) in[i] = (const float*)a->in[i];
    w.g_attn = in[3] + l * 1024; w.w_in = in[4] + (size_t)l * 1024 * INW; w.pool_w = in[5] + (size_t)l * 65536; w.pool_scale = in[6] + l * 512;
    w.dqn = in[7] + l * 64; w.dkn = in[8] + l * 64; w.dlam = in[9] + l * 256; w.dsub = in[10] + l * 128; w.fqn = in[11] + l * 64; w.fkn = in[12] + l * 64; w.ffb = in[13] + l * 8;
    w.w_branch = in[14] + (size_t)l * 3 * 512 * 1024; w.w_out = in[15] + (size_t)l * 1024 * 1024; w.g_ffn = in[16] + l * 1024; w.wrg = in[17] + (size_t)l * 4096; w.brg = in[18] + l * 4;
    w.wre = in[19] + (size_t)l * 16384; w.bre = in[20] + l * 16; w.wg = in[21] + (size_t)l * 16 * 262144; w.wu = in[22] + (size_t)l * 16 * 262144; w.wd = in[23] + (size_t)l * 16 * 262144;
    w.g_ple = in[24] + l * 1024; w.wpg = in[25] + (size_t)l * 1024 * 1024; w.wple = in[26] + (size_t)l * 256 * 1024; w.p = in[1] + (size_t)l * T * 256;
    return w;
}

__device__ __forceinline__ void tr_item(const float* __restrict__ src, int ldsrc, int c0, int nvalid, int k0, const float* __restrict__ gk, bf16* dst, int dpitch, int nrow0, int dk0, LAS float* scr, int lane, const bool f8 = false) {
    float vv[32];
#pragma unroll
    for (int i = 0; i < 32; ++i) { const int kk = 2 * i + (lane >> 5), c = lane & 31; vv[i] = (c < nvalid) ? src[(size_t)(k0 + kk) * ldsrc + c0 + c] : 0.f; }
    if (gk) {
#pragma unroll
        for (int i = 0; i < 32; ++i) vv[i] *= gk[k0 + 2 * i + (lane >> 5)]; }
#pragma unroll
    for (int i = 0; i < 32; ++i) scr[(2 * i + (lane >> 5)) * 33 + (lane & 31)] = vv[i];
    LDS_WAIT(); asm volatile("" ::: "memory");
    const int c8 = lane & 7;
#pragma unroll
    for (int j = 0; j < 4; ++j) { const int n = (lane >> 3) + 8 * j; const LAS float* s = scr + (8 * c8) * 33 + n;
        if (f8) { typedef unsigned v2u_ __attribute__((ext_vector_type(2))); v2u_ o;
            o.x = pk_fp8x4(s[0 * 33] * G8_SCALE, s[1 * 33] * G8_SCALE, s[2 * 33] * G8_SCALE, s[3 * 33] * G8_SCALE); o.y = pk_fp8x4(s[4 * 33] * G8_SCALE, s[5 * 33] * G8_SCALE, s[6 * 33] * G8_SCALE, s[7 * 33] * G8_SCALE);
            *(GAS v2u_*)((GAS char*)dst + (size_t)(nrow0 + n) * dpitch + dk0 + 8 * c8) = o; }
        else { v4u o; o.x = pk2(s[0 * 33], s[1 * 33]); o.y = pk2(s[2 * 33], s[3 * 33]); o.z = pk2(s[4 * 33], s[5 * 33]); o.w = pk2(s[6 * 33], s[7 * 33]);
            *(GAS v4u*)(dst + (size_t)(nrow0 + n) * dpitch + dk0 + 8 * c8) = o; } }
    LDS_WAIT(); asm volatile("" ::: "memory");
}
constexpr int CV_EARLY = 1536 + 128 + 1536 + 768, CV_NIT = CV_EARLY + 512 + 4096 + 2048 + 512 + 128, CV_LATE_BATCHES = (CV_NIT - CV_EARLY + 7) / 8, CV_RT_BATCHES = 64, CV_PB_BATCHES = 64;
__device__ __forceinline__ void conv_item(const LayerW& w, unsigned char* ws, int l, int it, LAS float* scr, int lane) {
    bf16* Wb = (bf16*)(ws + WS_W); bf16* WIN = (bf16*)(ws + WS_W + W_IN); bf16* WOUT = (bf16*)(ws + WS_W + W_OUT);
    bf16* WGU = (bf16*)(ws + WS_W + W_GU); bf16* WDN = (bf16*)(ws + WS_W + W_D); bf16* WPG = (bf16*)(ws + WS_WPLE + l * WPLE_STRIDE + W_PG); bf16* WP = (bf16*)(ws + WS_WPLE + l * WPLE_STRIDE + W_P);
    (void)Wb;
    constexpr int I_A = 1536, I_B = 128, I_D1 = 1536, I_D2 = 768, I_E = 512, I_F = 4096, I_G = 2048, I_H1 = 512, I_H2 = 128;
    constexpr int NIT = I_A + I_B + I_D1 + I_D2 + I_E + I_F + I_G + I_H1 + I_H2;
    int r = it;
        if (r < I_A) { const int kb = r / 96, nb = r % 96, p0 = 512 + 32 * nb, pn = p0 >> 8, q0 = p0 & 255;
            const bool head = (pn >= 2 && pn <= 5) || (pn >= 8 && pn <= 11);
            const int c0 = head ? (256 * pn + 64 * ((q0 >> 5) & 3) + 32 * (q0 >> 7)) : p0;
            tr_item(w.w_in, INW, c0, 32, 64 * kb, w.g_attn, WIN, 1024, p0, 64 * kb, scr, lane); return; } r -= I_A;
        if (r < I_B) { const int kb = r / 8, nb = r % 8; tr_item(w.w_in, INW, 3584, nb == 0 ? 8 : 0, 64 * kb, w.g_attn, WIN, 1024, 3584 + 32 * nb, 64 * kb, scr, lane); return; } r -= I_B;
        if (r < I_D1) { const int n = r / 512, r2 = r % 512, kb = r2 / 32, nb = r2 % 32;
            tr_item(w.w_in, INW, 3592 + n * 1024 + 32 * nb, 32, 64 * kb, w.g_attn, (bf16*)(ws + WS_W + W_G8 + (size_t)n * 1024 * 1024), 1024, 32 * nb, 64 * kb, scr, lane, true); return; } r -= I_D1;
        if (r < I_D2) { const int n = r / 256, r2 = r % 256, kb = r2 / 32, nb = r2 % 32;
            tr_item(w.w_branch + (size_t)n * 512 * 1024, 1024, 32 * nb, 32, 64 * kb, nullptr, (bf16*)(ws + WS_W + W_BR) + (size_t)n * 1024 * 512, 512, 32 * nb, 64 * kb, scr, lane); return; } r -= I_D2;
        if (r < I_E) { const int kb = r / 32, nb = r % 32; tr_item(w.w_out, 1024, 32 * nb, 32, 64 * kb, nullptr, WOUT, 1024, 32 * nb, 64 * kb, scr, lane); return; } r -= I_E;
        if (r < I_F) { const int e = r / 256, r1 = r % 256, hf = r1 / 128, r2 = r1 % 128, kb = r2 / 8, nb = r2 % 8, q0 = 32 * nb;
            const float* src = ((q0 >> 7) ? w.wu : w.wg) + (size_t)e * 262144;
            const bool f8 = MK_MU8 && l == NL - 1;
            tr_item(src, 256, 128 * hf + (q0 & 127), 32, 64 * kb, w.g_ffn, f8 ? (bf16*)((unsigned char*)WGU + (size_t)(e * 2 + hf) * 256 * 1024) : WGU + (size_t)(e * 2 + hf) * 256 * 1024, 1024, q0, 64 * kb, scr, lane, f8); return; } r -= I_F;
        if (r < I_G) { const int e = r / 128, r2 = r % 128, kb = r2 / 32, nb = r2 % 32;
            tr_item(w.wd + (size_t)e * 262144, 1024, 32 * nb, 32, 64 * kb, nullptr, WDN + (size_t)e * 262144, 256, 32 * nb, 64 * kb, scr, lane); return; } r -= I_G;
        if (r < I_H1) { const int kb = r / 32, nb = r % 32; tr_item(w.wpg, 1024, 32 * nb, 32, 64 * kb, w.g_ple, WPG, 1024, 32 * nb, 64 * kb, scr, lane, MK_PLE8 != 0); return; } r -= I_H1;
        { const int kb = r / 32, nb = r % 32; tr_item(w.wple, 1024, 32 * nb, 32, 64 * kb, nullptr, WP, 256, 32 * nb, 64 * kb, scr, lane); }
}
__device__ __forceinline__ void conv_late_batch(const LayerW& w, unsigned char* ws, int l, LAS unsigned char* lds, int batch, int tid) {
    const int lane = tid & 63, wave = __builtin_amdgcn_readfirstlane(tid >> 6);
    if (batch < CV_LATE_BATCHES) { const int it = CV_EARLY + batch * 8 + wave; if (it < CV_NIT) conv_item(w, ws, l, it, (LAS float*)(lds + wave * 16384), lane); }
    else if (batch >= CV_LATE_BATCHES + CV_RT_BATCHES) {
        const int i0 = (batch - CV_LATE_BATCHES - CV_RT_BATCHES) * 8192 + tid; GAS v4u* PB = (GAS v4u*)(ws + OV_PB);
#pragma clang loop unroll(disable)
        for (int q0 = 0; q0 < 16; q0 += 4) { f32x4 a[4], b[4];
#pragma unroll
            for (int q = 0; q < 4; ++q) { const GAS f32x4* s = (const GAS f32x4*)(w.p) + 2 * (size_t)(i0 + (q0 + q) * 512); a[q] = s[0]; b[q] = s[1]; }
#pragma unroll
            for (int q = 0; q < 4; ++q) { v4u o; o.x = pk2(a[q].x, a[q].y); o.y = pk2(a[q].z, a[q].w); o.z = pk2(b[q].x, b[q].y); o.w = pk2(b[q].z, b[q].w); PB[i0 + (q0 + q) * 512] = o; } } }
    else { const int idx = (batch - CV_LATE_BATCHES) * 512 + tid; const int e = idx >> 10, k = idx & 1023;
        const float v = w.g_ffn[k] * (e < 4 ? w.wrg[k * 4 + e] : (e < 20 ? w.wre[k * 16 + e - 4] : 0.f));
        const unsigned hi = pk2(v, 0.f) & 0xffffu; const unsigned lo = pk2(v - bflo(hi), 0.f) & 0xffffu;
        ((bf16*)(ws + WS_W + W_RH))[idx] = (bf16)hi; ((bf16*)(ws + WS_W + W_RL))[idx] = (bf16)lo; }
}
__device__ __forceinline__ void weff_job(const LayerW& w, unsigned char* ws, LAS unsigned char* lds, int job, int tid) {
    bf16* WIN = (bf16*)(ws + WS_W + W_IN);
    LAS float* Wt = (LAS float*)lds; LAS float* Pw = (LAS float*)(lds + 36864);
    const int kb = job >> 4, g = (job >> 2) & 3, nq = job & 3, k0 = 64 * kb;
    for (int e = tid; e < 64 * 128; e += 512) { const int kk = e >> 7, c = e & 127; Wt[kk * 132 + c] = w.w_in[(size_t)(k0 + kk) * INW + 128 * g + c]; }
    for (int e = tid; e < 128 * 32; e += 512) { const int c = e >> 5, n = e & 31; Pw[c * 32 + n] = w.pool_w[(size_t)g * 16384 + c * 128 + 32 * nq + n]; }
    __syncthreads();
    const int n = tid & 31, ks = tid >> 5; float a[4] = {0.f, 0.f, 0.f, 0.f};
#pragma unroll 2
    for (int c = 0; c < 128; c += 4) {
        const float p0 = Pw[c * 32 + n], p1 = Pw[(c + 1) * 32 + n], p2 = Pw[(c + 2) * 32 + n], p3 = Pw[(c + 3) * 32 + n];
#pragma unroll
        for (int i = 0; i < 4; ++i) { const f32x4 w4 = *(const LAS f32x4*)(Wt + (ks * 4 + i) * 132 + c); a[i] += (w4.x * p0 + w4.y * p1) + (w4.z * p2 + w4.w * p3); } }
    const float sc = w.pool_scale[128 * g + 32 * nq + n];
#pragma unroll
    for (int i = 0; i < 4; ++i) a[i] *= sc * w.g_attn[k0 + ks * 4 + i];
    *(GAS unsigned long long*)(WIN + (size_t)(128 * g + 32 * nq + n) * 1024 + k0 + ks * 4) = (unsigned long long)pk2(a[0], a[1]) | ((unsigned long long)pk2(a[2], a[3]) << 32);
    __syncthreads();
}
__device__ __forceinline__ void conv_layer(const LayerW& w, unsigned char* ws, int l, LAS unsigned char* lds, int vcu, int G, int tid) {
    const int lane = tid & 63, wave = __builtin_amdgcn_readfirstlane(tid >> 6);
    LAS float* scr = (LAS float*)(lds + wave * 16384);
    const int gw = vcu * NWAVES + wave, NGW = G * NWAVES;
    for (int it = gw; it < CV_EARLY; it += NGW) conv_item(w, ws, l, it, scr, lane);
    __syncthreads();
    for (int job = vcu; job < 256; job += G) weff_job(w, ws, lds, job, tid);
}
constexpr int CV_EARLY_BATCHES = CV_EARLY / 8 + 256;
__device__ __forceinline__ void conv_early_batch(const LayerW& w, unsigned char* ws, int l, LAS unsigned char* lds, int batch, int tid) {
    const int lane = tid & 63, wave = __builtin_amdgcn_readfirstlane(tid >> 6);
    if (batch < CV_EARLY / 8) { conv_item(w, ws, l, batch * 8 + wave, (LAS float*)(lds + wave * 16384), lane); __syncthreads(); }
    else weff_job(w, ws, lds, batch - CV_EARLY / 8, tid);
}
__device__ __forceinline__ void p0_x(const float* x, const int* positions, unsigned char* ws, unsigned char* x8, int vcu, int G, int tid) {
    const int lane = tid & 63, wave = __builtin_amdgcn_readfirstlane(tid >> 6);
    bf16* XY = (bf16*)(ws + WS_XY); float* SS = (float*)(ws + WS_SS); float* CS = (float*)(ws + WS_COSSIN);
    const int gw = vcu * NWAVES + wave, NGW = G * NWAVES;
    for (int t = gw; t < T; t += NGW) {
        const GAS f32x4* xr = (const GAS f32x4*)(x + (size_t)t * 1024) + lane; float s = 0.f;
        GAS unsigned long long* o8 = (GAS unsigned long long*)(XY + (size_t)t * XYP + 1536) + lane;
#pragma unroll
        for (int j = 0; j < 4; ++j) { const f32x4 v = xr[64 * j]; s += (v.x * v.x + v.y * v.y) + (v.z * v.z + v.w * v.w); o8[64 * j] = (unsigned long long)pk2(v.x, v.y) | ((unsigned long long)pk2(v.z, v.w) << 32);
            ((GAS unsigned*)(x8 + (size_t)t * 1024))[lane + 64 * j] = pk_fp8x4(v.x, v.y, v.z, v.w); }
        s = wave_sum64(s);
        if (lane < 16) SS[(size_t)t * 16 + lane] = lane == 0 ? s : 0.f;
    }
    for (int idx = vcu * 512 + tid; idx < T * 8; idx += G * 512) { const int t = idx >> 3, i = idx & 7;
        const float invf = powf(500000.0f, -(float)(2 * i) / 16.0f); const float ang = (float)positions[t] * invf;
        CS[(size_t)t * 16 + i] = cosf(ang); CS[(size_t)t * 16 + 8 + i] = sinf(ang); }
}

typedef pg8::f32x4 (&AccRef)[2][2][4][2];
#define LAUNDER3(a, b, c) asm volatile("" : "+v"(a), "+v"(b), "+v"(c))
__device__ __forceinline__ float rstd_at(const float* SS, unsigned row) {
    const GAS f32x4* p = (const GAS f32x4*)((const GAS char*)SS + row * 64u); const f32x4 a = p[0], b = p[1], c = p[2], d = p[3];
    const float s = ((a.x + a.y) + (a.z + a.w)) + ((b.x + b.y) + (b.z + b.w)) + ((c.x + c.y) + (c.z + c.w)) + ((d.x + d.y) + (d.z + d.w));
    return rsqrtf(s * (1.0f / 1024.0f) + RMS_EPS);
}
__device__ __forceinline__ void rstd8(const float* SS, unsigned row0, int fq, float (&rs)[8]) {
    f32x4 v[8];
#pragma unroll
    for (int i = 0; i < 8; ++i) v[i] = *(const GAS f32x4*)((const GAS char*)SS + ((row0 + (unsigned)((i >> 2) * 128 + (i & 3) * 16)) * 64u + (unsigned)fq * 16u));
#pragma unroll
    for (int i = 0; i < 8; ++i) { float s = (v[i].x + v[i].y) + (v[i].z + v[i].w); s += XOR16(s); s = add_xor32(s); rs[i] = rsqrtf(s * (1.0f / 1024.0f) + RMS_EPS); }
}
__device__ __forceinline__ float logsig(float z) { return fminf(z, 0.f) - log1pf(expf(-fabsf(z))); }
struct EpiG1 {
    const float* SS; bf16* PROJ; float* LOGF; const float* CS; const float* GT; const float* ffb; int dry; const LAS float* rsl;
    __device__ __forceinline__ void operator()(AccRef acc, const pg8::Step& st, int wr, int wc, int fr_, int fq_) const {
        if (dry) return;
        int fr = fr_, fq = fq_, zz = 0; LAUNDER3(fr, fq, zz);
        const int pn = st.pn; const unsigned row0 = (unsigned)(st.pm * 256 + wr * 64 + fr);
#define RSL8(dst_) do { _Pragma("unroll") for (int i_ = 0; i_ < 8; ++i_) dst_[i_] = rsl[st.aux * 256 + (i_ >> 2) * 128 + wr * 64 + (i_ & 3) * 16 + fr]; } while (0)
        const bool head = (pn >= 2 && pn <= 5) || (pn >= 8 && pn <= 11);
        if (head) {
            const float* gain = GT + 64 * (pn < 4 ? 0 : (pn < 6 ? 1 : (pn < 10 ? 2 : 3)));
            const bool rot = pn < 6; const float osc = (pn < 4 || (pn >= 8 && pn < 10)) ? C2 : 1.0f;
            f32x4 G[2][2];
#pragma unroll
            for (int bj = 0; bj < 2; ++bj)
#pragma unroll
                for (int n = 0; n < 2; ++n) G[bj][n] = *(const GAS f32x4*)((const GAS char*)gain + (unsigned)(32 * bj + 8 * fq + 4 * n) * 4u);
            const GAS char* pb = (const GAS char*)PROJ + (unsigned)(256 * pn + 64 * wc) * 2u;
            float rs8[8]; RSL8(rs8);
            f32x4 cs[4];
#define G1_LOADCS(i_) do { if (rot && fq < 2) { const GAS f32x4* cp_ = (const GAS f32x4*)((const GAS char*)CS + (row0 + (unsigned)(((i_) >> 2) * 128 + ((i_) & 3) * 16)) * 64u); \
                _Pragma("unroll") for (int q_ = 0; q_ < 4; ++q_) cs[q_] = cp_[q_]; } } while (0)
            G1_LOADCS(0);
#pragma unroll
            for (int i = 0; i < 8; ++i) {
                v4u ov[2];
                {
                    const int ai = i >> 2, m = i & 3; const float rs = rs8[i];
                    f32x4 v[2][2]; float ss = 0.f;
#pragma unroll
                    for (int bj = 0; bj < 2; ++bj)
#pragma unroll
                        for (int n = 0; n < 2; ++n) { v[bj][n] = acc[ai][bj][m][n] * rs; const f32x4 q = v[bj][n] * v[bj][n]; ss += (q.x + q.y) + (q.z + q.w); }
                    ss += XOR16(ss); ss = add_xor32(ss);
                    const float hn = rsqrtf(ss * (1.0f / 64.0f) + RMS_EPS) * osc;
#pragma unroll
                    for (int bj = 0; bj < 2; ++bj)
#pragma unroll
                        for (int n = 0; n < 2; ++n) v[bj][n] = v[bj][n] * hn * G[bj][n];
                    if (rot) {
                        f32x4 ot[2];
#pragma unroll
                        for (int n = 0; n < 2; ++n) { ot[n].x = XOR16(v[0][n].x); ot[n].y = XOR16(v[0][n].y); ot[n].z = XOR16(v[0][n].z); ot[n].w = XOR16(v[0][n].w); }
                        if (fq < 2) {
#pragma unroll
                            for (int n = 0; n < 2; ++n) { const f32x4 c = cs[n], s = cs[2 + n]; v[0][n] = (fq == 0) ? (v[0][n] * c - ot[n] * s) : (v[0][n] * c + ot[n] * s); }
                        }
                    }
#pragma unroll
                    for (int bj = 0; bj < 2; ++bj) { ov[bj].x = pk2(v[bj][0].x, v[bj][0].y); ov[bj].y = pk2(v[bj][0].z, v[bj][0].w); ov[bj].z = pk2(v[bj][1].x, v[bj][1].y); ov[bj].w = pk2(v[bj][1].z, v[bj][1].w); }
                }
                if (i < 7) G1_LOADCS(i + 1);
                asm volatile("" ::: "memory");
                { const unsigned row = row0 + (unsigned)((i >> 2) * 128 + (i & 3) * 16);
#pragma unroll
                    for (int bj = 0; bj < 2; ++bj) *(GAS v4u*)(pb + (row * (unsigned)(PJP * 2) + (unsigned)(32 * bj + 8 * fq) * 2u)) = ov[bj]; }
                asm volatile("" ::: "memory");
            }
#undef G1_LOADCS
        } else if (pn == 14) {
            float rs14[8]; RSL8(rs14);
            if (wc == 0 && fq == 0) {
                const f32x4 b0 = *(const GAS f32x4*)ffb, b1 = *(const GAS f32x4*)(ffb + 4);
#pragma unroll
                for (int ai = 0; ai < 2; ++ai)
#pragma unroll
                    for (int m = 0; m < 4; ++m) {
                        const unsigned row = row0 + ai * 128 + m * 16; const float rs = rs14[ai * 4 + m];
                        const f32x4 z0 = acc[ai][0][m][0] * rs + b0, z1 = acc[ai][0][m][1] * rs + b1; f32x4 o0, o1;
                        o0.x = logsig(z0.x); o0.y = logsig(z0.y); o0.z = logsig(z0.z); o0.w = logsig(z0.w); o1.x = logsig(z1.x); o1.y = logsig(z1.y); o1.z = logsig(z1.z); o1.w = logsig(z1.w);
                        GAS f32x4* d = (GAS f32x4*)((GAS char*)LOGF + row * 32u); d[0] = o0; d[1] = o1;
                    }
            }
        } else {
            const GAS char* pb = (const GAS char*)PROJ + (unsigned)(256 * pn + 32 * wc) * 2u;
            float rsp[8]; RSL8(rsp);
#pragma unroll
            for (int ai = 0; ai < 2; ++ai)
#pragma unroll
                for (int m = 0; m < 4; ++m) {
                    const unsigned row = row0 + ai * 128 + m * 16; const float rs = rsp[ai * 4 + m];
#pragma unroll
                    for (int bj = 0; bj < 2; ++bj) { const f32x4 a = acc[ai][bj][m][0] * rs, b = acc[ai][bj][m][1] * rs; v4u o; o.x = pk2(a.x, a.y); o.y = pk2(a.z, a.w); o.z = pk2(b.x, b.y); o.w = pk2(b.z, b.w);
                        *(GAS v4u*)(pb + (row * (unsigned)(PJP * 2) + (unsigned)(128 * bj + 8 * fq) * 2u)) = o; }
                }
        }
    }
};
typedef unsigned v2u __attribute__((ext_vector_type(2)));
__device__ __forceinline__ unsigned pk8(float a, float b, float c, float d) {
    unsigned w = __builtin_amdgcn_cvt_pk_u8_f32(a * 256.0f - 0.5f, 0u, 0u); w = __builtin_amdgcn_cvt_pk_u8_f32(b * 256.0f - 0.5f, 1u, w); w = __builtin_amdgcn_cvt_pk_u8_f32(c * 256.0f - 0.5f, 2u, w); return __builtin_amdgcn_cvt_pk_u8_f32(d * 256.0f - 0.5f, 3u, w); }
__device__ __forceinline__ float g8(unsigned w, const int k) { return ((float)((w >> (8 * k)) & 0xffu) + 0.5f) * (1.0f / 256.0f); }
#undef RSL8
template <int PART>
struct EpiG2 {
    const float* SS; unsigned char* gs; bf16* MERGED;
    __device__ __forceinline__ void operator()(AccRef acc, const pg8::Step& st, int wr, int wc, int fr_, int fq_) const {
        int ln; asm volatile("v_mbcnt_lo_u32_b32 %0, -1, 0\n\tv_mbcnt_hi_u32_b32 %0, -1, %0" : "=v"(ln));
        int fr = ln & 15, fq = ln >> 4, tid = (wr * 4 + wc) * 64 + ln; LAUNDER3(fr, fq, tid); (void)fr_; (void)fq_;
        const int aux = st.aux; const unsigned row0 = (unsigned)(st.pm * 256 + wr * 64 + fr), toff = (unsigned)tid * 8u;
        const int n = aux < 3 ? aux : aux - 3; GAS char* gb = (GAS char*)gs + (size_t)n * 65536;
        GAS char* mb = (GAS char*)MERGED + (unsigned)(256 * st.pn + 32 * wc) * 2u;
        float rsg[8];
#pragma unroll
        for (int i = 0; i < 8; ++i) rsg[i] = 0.f;
        if (PART == 0) rstd8(SS, row0, fq, rsg);
#pragma unroll
        for (int ai = 0; ai < 2; ++ai) {
            v2u gn[4][2], gd[4][2];
#pragma unroll
            for (int m = 0; m < 4; ++m)
#pragma unroll
                for (int bj = 0; bj < 2; ++bj) { gn[m][bj] = (v2u){0u, 0u}; gd[m][bj] = (v2u){0u, 0u}; }
            if (PART == 1) {
#pragma unroll
                for (int m = 0; m < 4; ++m)
#pragma unroll
                    for (int bj = 0; bj < 2; ++bj) { const unsigned so = toff + (unsigned)(((ai * 4 + m) * 2 + bj) * 4096); gn[m][bj] = *(const GAS v2u*)(gb + so); if (aux < 5) gd[m][bj] = *(const GAS v2u*)(gb + 65536 + so); }
            }
            asm volatile("" ::: "memory");
#pragma unroll
            for (int m = 0; m < 4; ++m) {
                const float rs = rsg[ai * 4 + m] * (1.0f / G8_SCALE);
#pragma unroll
                for (int bj = 0; bj < 2; ++bj) {
                    const unsigned so = toff + (unsigned)(((ai * 4 + m) * 2 + bj) * 4096);
                    const f32x4 a = acc[ai][bj][m][0], b = acc[ai][bj][m][1]; const v2u n_ = gn[m][bj], d_ = gd[m][bj];
                    f32x4 fa = (f32x4){0.f, 0.f, 0.f, 0.f}, fb = fa;
                    if (PART == 0) { const float rsn = rs * -1.4426950408889634f; const f32x4 x = a * rsn, y = b * rsn; v2u o;
                        o.x = pk8(sg2(x.x), sg2(x.y), sg2(x.z), sg2(x.w)); o.y = pk8(sg2(y.x), sg2(y.y), sg2(y.z), sg2(y.w));
                        *(GAS v2u*)(gb + so) = o;
                    } else if (aux < 5) {
                        fa.x = g8(n_.x, 0) * __builtin_amdgcn_rcpf(g8(d_.x, 0)); fa.y = g8(n_.x, 1) * __builtin_amdgcn_rcpf(g8(d_.x, 1)); fa.z = g8(n_.x, 2) * __builtin_amdgcn_rcpf(g8(d_.x, 2)); fa.w = g8(n_.x, 3) * __builtin_amdgcn_rcpf(g8(d_.x, 3));
                        fb.x = g8(n_.y, 0) * __builtin_amdgcn_rcpf(g8(d_.y, 0)); fb.y = g8(n_.y, 1) * __builtin_amdgcn_rcpf(g8(d_.y, 1)); fb.z = g8(n_.y, 2) * __builtin_amdgcn_rcpf(g8(d_.y, 2)); fb.w = g8(n_.y, 3) * __builtin_amdgcn_rcpf(g8(d_.y, 3));
                    } else { v4u o;
                        o.x = pk2(a.x * g8(n_.x, 0), a.y * g8(n_.x, 1)); o.y = pk2(a.z * g8(n_.x, 2), a.w * g8(n_.x, 3)); o.z = pk2(b.x * g8(n_.y, 0), b.y * g8(n_.y, 1)); o.w = pk2(b.z * g8(n_.y, 2), b.w * g8(n_.y, 3));
                        *(GAS v4u*)(mb + ((row0 + ai * 128 + m * 16) * 2048u + (unsigned)(128 * bj + 8 * fq) * 2u)) = o;
                    }
                    acc[ai][bj][m][0] = a * fa; acc[ai][bj][m][1] = b * fb;
                    asm volatile("" : "+v"(acc[ai][bj][m][0]), "+v"(acc[ai][bj][m][1]));
                }
            }
            asm volatile("" ::: "memory");
        }
    }
};
#ifndef MK_X8
#define MK_X8 1
#endif
template <int KIND, bool SCATTER>
struct EpiRes {
    const bf16* xs; int ldxs; float* xo; bf16* xb; int ldxb; float* SSo; const float* SSi; const bf16* PW; int dry; unsigned char* x8;
    __device__ __forceinline__ void operator()(AccRef acc, const pg8::Step& st, int wr, int wc, int fr_, int fq_) const {
        if (SCATTER && st.aux == 0) return;
        int fr = fr_, fq = fq_, zz = 0; LAUNDER3(fr, fq, zz);
        const int pn = st.pn; const unsigned colb = (unsigned)(256 * pn + 32 * wc + 8 * fq);
        int rowi[8];
#pragma unroll
        for (int i = 0; i < 8; ++i) { const int r = (i >> 2) * 128 + wr * 64 + (i & 3) * 16 + fr; rowi[i] = SCATTER ? ((r < st.nvalid) ? st.rows[r] : -1) : (st.pm * 256 + r); }
        float rs8[8];
#pragma unroll
        for (int i = 0; i < 8; ++i) rs8[i] = 1.f;
        if (KIND == 1) { rstd8(SSi, (unsigned)(st.pm * 256 + wr * 64 + fr), fq, rs8);
            if (MK_PLE8) {
#pragma unroll
                for (int i = 0; i < 8; ++i) rs8[i] *= (1.0f / G8_SCALE); } }
        v4u xin[2][2][2]; v4u pwv[2][2][2];
#define RES_LOAD(p_, buf_) do { _Pragma("unroll") for (int u_ = 0; u_ < 2; ++u_) { const int i_ = 2 * (p_) + u_; const unsigned rw_ = rowi[i_] >= 0 ? (unsigned)rowi[i_] : 0u; \
            _Pragma("unroll") for (int bj_ = 0; bj_ < 2; ++bj_) { xin[buf_][u_][bj_] = *(const GAS v4u*)((const GAS char*)xs + (rw_ * (unsigned)ldxs + colb + 128u * bj_) * 2u); \
                if (KIND == 1) pwv[buf_][u_][bj_] = *(const GAS v4u*)((const GAS char*)PW + (rw_ * 1024u + colb + 128u * bj_) * 2u); } } } while (0)
        RES_LOAD(0, 0);
#pragma unroll
        for (int pr = 0; pr < 4; ++pr) {
            float ssp[2]; f32x4 xr[2][2][2];
#pragma unroll
            for (int u = 0; u < 2; ++u) {
                const int i = 2 * pr + u, ai = i >> 2, m = i & 3; const float rs = rs8[i]; float ss = 0.f;
#pragma unroll
                for (int bj = 0; bj < 2; ++bj) {
                    const v4u xv = xin[pr & 1][u][bj];
                    f32x4 x0 = (f32x4){bflo(xv.x), bfhi(xv.x), bflo(xv.y), bfhi(xv.y)}, x1 = (f32x4){bflo(xv.z), bfhi(xv.z), bflo(xv.w), bfhi(xv.w)};
                    f32x4 a = acc[ai][bj][m][0], b = acc[ai][bj][m][1];
                    if (KIND == 1) { const v4u pw = pwv[pr & 1][u][bj];
                        a.x = sigm(a.x * rs) * bflo(pw.x); a.y = sigm(a.y * rs) * bfhi(pw.x); a.z = sigm(a.z * rs) * bflo(pw.y); a.w = sigm(a.w * rs) * bfhi(pw.y);
                        b.x = sigm(b.x * rs) * bflo(pw.z); b.y = sigm(b.y * rs) * bfhi(pw.z); b.z = sigm(b.z * rs) * bflo(pw.w); b.w = sigm(b.w * rs) * bfhi(pw.w); }
                    x0 += a; x1 += b;
                    { const f32x4 q0 = x0 * x0, q1 = x1 * x1; ss += ((q0.x + q0.y) + (q0.z + q0.w)) + ((q1.x + q1.y) + (q1.z + q1.w)); }
                    xr[u][bj][0] = x0; xr[u][bj][1] = x1;
                }
                ss += XOR16(ss); ss = add_xor32(ss); ssp[u] = ss;
            }
            if (pr < 3) RES_LOAD(pr + 1, (pr + 1) & 1);
            asm volatile("" ::: "memory");
#pragma unroll
            for (int u = 0; u < 2; ++u) {
                const int i = 2 * pr + u; const bool ok = rowi[i] >= 0 && !dry; const unsigned rw = rowi[i] >= 0 ? (unsigned)rowi[i] : 0u;
                if (ok) {
#pragma unroll
                    for (int bj = 0; bj < 2; ++bj) { const f32x4 x0 = xr[u][bj][0], x1 = xr[u][bj][1];
                        if (xo) { GAS f32x4* op = (GAS f32x4*)((GAS char*)xo + (rw * 1024u + colb + 128u * bj) * 4u); op[0] = x0; op[1] = x1; }
                        if (xb) { v4u o; o.x = pk2(x0.x, x0.y); o.y = pk2(x0.z, x0.w); o.z = pk2(x1.x, x1.y); o.w = pk2(x1.z, x1.w);
                            *(GAS v4u*)((GAS char*)xb + (rw * (unsigned)ldxb + colb + 128u * bj) * 2u) = o; }
                        if (MK_X8 && x8) { v2u o2; o2.x = pk_fp8x4(x0.x, x0.y, x0.z, x0.w); o2.y = pk_fp8x4(x1.x, x1.y, x1.z, x1.w); *(GAS v2u*)((GAS char*)x8 + (rw * 1024u + colb + 128u * bj)) = o2; } }
                    if (fq == 0 && xb) *(GAS float*)((GAS char*)SSo + (rw * 16u + (unsigned)(4 * pn + wc)) * 4u) = ssp[u];
                }
            }
            asm volatile("" ::: "memory");
        }
#undef RES_LOAD
    }
};
struct EpiPW {
    bf16* O;
    __device__ __forceinline__ void operator()(AccRef acc, const pg8::Step& st, int wr, int wc, int fr_, int fq_) const {
        int fr = fr_, fq = fq_, zz = 0; LAUNDER3(fr, fq, zz);
        GAS char* ob = (GAS char*)O + (unsigned)(256 * st.pn + 32 * wc) * 2u; const unsigned row0 = (unsigned)(st.pm * 256 + wr * 64 + fr);
#pragma unroll
        for (int ai = 0; ai < 2; ++ai)
#pragma unroll
            for (int m = 0; m < 4; ++m) {
#pragma unroll
                for (int bj = 0; bj < 2; ++bj) { const f32x4 a = acc[ai][bj][m][0], b = acc[ai][bj][m][1]; v4u o; o.x = pk2(a.x, a.y); o.y = pk2(a.z, a.w); o.z = pk2(b.x, b.y); o.w = pk2(b.z, b.w);
                    *(GAS v4u*)(ob + ((row0 + ai * 128 + m * 16) * 2048u + (unsigned)(128 * bj + 8 * fq) * 2u)) = o; }
                asm volatile("" ::: "memory"); }
    }
};
struct EpiMU {
    bf16* ACT; const float* TOKW; float sc;
    __device__ __forceinline__ void operator()(AccRef acc, const pg8::Step& st, int wr, int wc, int fr_, int fq_) const {
        int fr = fr_, fq = fq_, zz = 0; LAUNDER3(fr, fq, zz);
        const int j = st.pn; GAS char* ab = (GAS char*)ACT + (size_t)st.pm * 1024 + (unsigned)(128 * j + 32 * wc) * 2u;
        int tok[8]; f32x4 tw[8];
#pragma unroll
        for (int i = 0; i < 8; ++i) { const int r = (i >> 2) * 128 + wr * 64 + (i & 3) * 16 + fr; tok[i] = (r < st.nvalid) ? st.rows[r] : -1; }
#pragma unroll
        for (int i = 0; i < 8; ++i) { tw[i] = *(const GAS f32x4*)((const GAS char*)TOKW + (unsigned)(tok[i] >= 0 ? tok[i] : 0) * 16u); if (tok[i] < 0) tw[i] = (f32x4){0.f, 0.f, 0.f, 0.f}; }
        asm volatile("" ::: "memory");
#pragma unroll
        for (int i = 0; i < 8; ++i) {
            const int ai = i >> 2, m = i & 3, r = ai * 128 + wr * 64 + m * 16 + fr;
            const float rs = tw[i].z * sc, w = (j < 2) ? tw[i].x : tw[i].y;
            const f32x4 g0 = acc[ai][0][m][0] * rs, g1 = acc[ai][0][m][1] * rs, u0 = acc[ai][1][m][0] * rs, u1 = acc[ai][1][m][1] * rs; v4u o;
            o.x = pk2(g0.x * sigm(g0.x) * u0.x * w, g0.y * sigm(g0.y) * u0.y * w); o.y = pk2(g0.z * sigm(g0.z) * u0.z * w, g0.w * sigm(g0.w) * u0.w * w);
            o.z = pk2(g1.x * sigm(g1.x) * u1.x * w, g1.y * sigm(g1.y) * u1.y * w); o.w = pk2(g1.z * sigm(g1.z) * u1.z * w, g1.w * sigm(g1.w) * u1.w * w);
            *(GAS v4u*)(ab + ((unsigned)r * 1024u + (unsigned)(8 * fq) * 2u)) = o;
            asm volatile("" ::: "memory");
        }
    }
};

__device__ __forceinline__ bool tile_order(long L, int nM, int nN, int& pm, int& pn) {
    const int nwg = nM * nN; if (L >= nwg) return false;
    int wgid = (int)L; { const int q = nwg / 8, r = nwg % 8, xcd = wgid % 8, off = wgid / 8; wgid = (xcd < r ? xcd * (q + 1) : r * (q + 1) + (xcd - r) * q) + off; }
    const int nig = 8 * nN, gid = wgid / nig, fm = gid * 8, gsz = (nM - fm) < 8 ? (nM - fm) : 8;
    pm = fm + ((wgid % nig) % gsz); pn = (wgid % nig) / gsz; return true;
}
struct SchedPlain {
    const char* A; const char* B; size_t a_tile, b_tile; int nM, nN, nt, G, c, fixa, fixb;
    __device__ __forceinline__ bool next(int i, pg8::Step& s) const {
        int pm, pn; if (!tile_order((long)i * G + c, nM, nN, pm, pn)) return false;
        s.A = A + (size_t)(fixa ? 0 : pm) * a_tile; s.B = B + (size_t)(fixb ? 0 : pn) * b_tile; s.rows = nullptr; s.nt = nt; s.pm = pm; s.pn = pn; s.aux = i; s.nvalid = 256; s.zero_after = 1; return true; }
};
template <int PART>
struct SchedG2 {
    const char* Ab; const char* Bb; int c;
    __device__ __forceinline__ bool next(int i, pg8::Step& s) const {
        if (i >= 3) return false; int pm, pn; tile_order(c, 64, 4, pm, pn);
        const int n = i;
        s.A = PART == 0 ? Ab + (size_t)pm * 256 * 1024 : Ab + (size_t)pm * 256 * (XYP * 2) + 512 * n * 2;
        s.B = Bb + ((size_t)n * 1024 + pn * 256) * 1024;
        s.rows = nullptr; s.nt = 8; s.pm = pm; s.pn = pn; s.aux = PART * 3 + i; s.nvalid = 256; s.zero_after = 0; return true; }
};
struct SchedMoE {
    volatile LAS unsigned* MISC; const int* LIST; const char* Ab; const char* Bb; int G, c, mode, f8;
    __device__ __forceinline__ bool next(int i, pg8::Step& s) const {
        const int NU = (int)MISC[MI_TOT]; const int u = c;
        if (u >= NU || i > (mode == 2 ? 1 : 0)) return false;
        const int down = mode == 2;
        int cls = 0;
#pragma unroll 1
        for (int k = 1; k < 24; ++k) if (u >= (int)MISC[MI_U0 + k]) cls = k;
        const int r = u - (int)MISC[MI_U0 + cls], k = r >> 2, j = r & 3, n_c = (int)MISC[MI_N + cls], arow = (int)MISC[MI_BASE + cls] + 256 * k;
        const int grp = cls / 6, pr = cls % 6; const int pa = pr < 3 ? 0 : (pr < 5 ? 1 : 2), pb = pr < 3 ? pr + 1 : (pr < 5 ? pr - 1 : 3);
        s.rows = LIST + (size_t)cls * T + 256 * k; s.nvalid = min(256, n_c - 256 * k); s.pm = arow; s.pn = j;
        if (!down) { const int e = grp * 4 + (j < 2 ? pa : pb), hf = j & 1;
            s.A = Ab; s.B = Bb + (size_t)(e * 2 + hf) * 256 * (f8 ? 1024 : 2048); s.nt = f8 ? 8 : 16; s.aux = cls; s.zero_after = 1; }
        else { const int sgm = i & 1; const int e = grp * 4 + (sgm ? pb : pa);
            s.A = Ab + (size_t)arow * 1024 + sgm * 512; s.B = Bb + ((size_t)e * 1024 + j * 256) * 512; s.nt = 4; s.aux = sgm; s.zero_after = sgm; }
        return true; }
};
__device__ __forceinline__ float wave_sum(float v) {
    return wave_sum64(v);
}
__device__ __forceinline__ void pool_unit(int u, const bf16* PROJ, bf16* XY, int tid_) {
    int tid = tid_; asm volatile("" : "+v"(tid));
    const int c8 = tid & 63, rg = tid >> 6, g = c8 >> 4, w = 2 << g, t0 = 256 * u + 32 * rg, s0 = t0 % S;
    const GAS char* zb = (const GAS char*)PROJ + (unsigned)c8 * 16u; GAS char* yb = (GAS char*)XY + (unsigned)c8 * 16u;
    float sum[8];
#pragma unroll
    for (int j = 0; j < 8; ++j) sum[j] = 0.f;
    { v4u pz[16];
#pragma unroll
      for (int k = 1; k <= 16; ++k) { const bool ok = k <= w && k <= s0; pz[k - 1] = *(const GAS v4u*)(zb + (unsigned)(ok ? t0 - k : t0) * (unsigned)(PJP * 2)); }
#pragma unroll
      for (int k = 1; k <= 16; ++k) { const bool ok = k <= w && k <= s0; const v4u z = pz[k - 1];
        if (ok) { sum[0] += bflo(z.x); sum[1] += bfhi(z.x); sum[2] += bflo(z.y); sum[3] += bfhi(z.y); sum[4] += bflo(z.z); sum[5] += bfhi(z.z); sum[6] += bflo(z.w); sum[7] += bfhi(z.w); } } }
#pragma clang loop unroll(disable)
    for (int r0 = 0; r0 < 32; r0 += 8) {
        v4u zz[8], qq[8];
#pragma unroll
        for (int j = 0; j < 8; ++j) { const int t = t0 + r0 + j, s = s0 + r0 + j;
            zz[j] = *(const GAS v4u*)(zb + (unsigned)t * (unsigned)(PJP * 2)); qq[j] = *(const GAS v4u*)(zb + (unsigned)(s >= w ? t - w : t) * (unsigned)(PJP * 2)); }
#pragma unroll
        for (int j = 0; j < 8; ++j) { const int t = t0 + r0 + j, s = s0 + r0 + j; const v4u z = zz[j], q = qq[j];
            float zf[8] = {bflo(z.x), bfhi(z.x), bflo(z.y), bfhi(z.y), bflo(z.z), bfhi(z.z), bflo(z.w), bfhi(z.w)};
#pragma unroll
            for (int i = 0; i < 8; ++i) sum[i] += zf[i];
            if (s >= w) { sum[0] -= bflo(q.x); sum[1] -= bfhi(q.x); sum[2] -= bflo(q.y); sum[3] -= bfhi(q.y); sum[4] -= bflo(q.z); sum[5] -= bfhi(q.z); sum[6] -= bflo(q.w); sum[7] -= bfhi(q.w); }
            const float ic = 1.0f / (float)min(s + 1, w); v4u o;
            o.x = pk2(sum[0] * ic - zf[0], sum[1] * ic - zf[1]); o.y = pk2(sum[2] * ic - zf[2], sum[3] * ic - zf[3]); o.z = pk2(sum[4] * ic - zf[4], sum[5] * ic - zf[5]); o.w = pk2(sum[6] * ic - zf[6], sum[7] * ic - zf[7]);
            *(GAS v4u*)(yb + (unsigned)t * (unsigned)(XYP * 2)) = o; }
    }
}
#ifndef MK_THRD
#define MK_THRD 32
#endif
#ifndef MK_THRF
#define MK_THRF 64
#endif
#ifndef MK_ATT_SKIP
#define MK_ATT_SKIP 0
#endif
__device__ __forceinline__ void attn_phase(const int wave0, const LayerW& w, int l, int rep, unsigned char* ws, char* lds, volatile LAS unsigned* MISC, gu32* ctl, const int dry) {
    using namespace attn_body;
    int tid = mk_tid(wave0); const int lane = tid & 63;
    bf16* PROJ = (bf16*)(ws + WS_PROJ); bf16* XY = (bf16*)(ws + WS_XY); bf16* STASH = (bf16*)(ws + WS_STASH); const float* LOGF = (const float*)(ws + WS_LOGF);
    const float lam_init = 0.8f - 0.6f * __expf(-0.3f * (float)l);
    float lam; { const float a = wave_sum(w.dlam[lane] * w.dlam[64 + lane]), c = wave_sum(w.dlam[128 + lane] * w.dlam[192 + lane]); lam = __expf(a) - __expf(c) + lam_init; lam = __int_as_float(__builtin_amdgcn_readfirstlane(__float_as_int(lam))); }
    unsigned* qhead = pg8::rflp((unsigned*)(ctl + CW_AQ) + rep); unsigned* fhead = pg8::rflp((unsigned*)(ctl + CW_AQ) + 64 + 16 * l);
    {
        unsigned* top = pg8::rflp((unsigned*)(ctl + CW_SPLIT3) + 64 * l);
#pragma clang loop unroll(disable)
        for (;;) {
            tid = mk_tid(wave0);
            if (tid == 0) { unsigned r = 0xffffffffu; if (xb_ld(top) < (unsigned)gridDim.x) { const unsigned f = atomicAdd(fhead, 1u); if (f < (unsigned)(CV_LATE_BATCHES + CV_RT_BATCHES + CV_PB_BATCHES)) r = f; } MISC[MI_Q] = r; }
            __syncthreads();
            const unsigned fb = MISC[MI_Q];
            __syncthreads();
            if (fb == 0xffffffffu) break;
            conv_late_batch(w, ws, l, (LAS unsigned char*)lds, (int)fb, tid); __syncthreads();
        }
        tid = mk_tid(wave0);
        if (tid == 0) split_wait_leader(top, (unsigned)gridDim.x);
        __syncthreads();
    }
    int first = 1;
    for (;;) {
        tid = mk_tid(wave0);
        if (tid == 0) { unsigned q = first ? (unsigned)blockIdx.x : (unsigned)gridDim.x + atomicAdd(qhead, 1u); if (q >= 832u) q = 832u + atomicAdd(fhead, 1u); MISC[MI_Q] = q; }
        first = 0;
        __syncthreads();
        const int idx = (int)MISC[MI_Q];
        __syncthreads();
        if (idx >= 832 + CV_LATE_BATCHES + CV_RT_BATCHES + CV_PB_BATCHES) break;
        if (idx >= 832) { if (MK_ATT_SKIP && dry && (MK_ATT_SKIP & 8)) continue; conv_late_batch(w, ws, l, (LAS unsigned char*)lds, idx - 832, tid); continue; }
        int kind, qb, bh;
        if (idx < 160) { kind = 0; qb = 7 - idx / 32; bh = idx % 32; }
        else if (idx < 224) { kind = 1; qb = 7; bh = idx - 160; }
        else if (idx < 256) { kind = 0; qb = 2; bh = idx - 224; }
        else if (idx < 384) { kind = 1; qb = 6 - (idx - 256) / 64; bh = (idx - 256) % 64; }
        else if (idx < 416) { kind = 0; qb = 1; bh = idx - 384; }
        else if (idx < 480) { kind = 1; qb = 4; bh = idx - 416; }
        else if (idx < 544) { kind = 2; qb = 0; bh = idx - 480; }
        else if (idx < 608) { kind = 1; qb = 3; bh = idx - 544; }
        else if (idx < 640) { kind = 0; qb = 0; bh = idx - 608; }
        else if (idx < 704) { kind = 1; qb = 2; bh = idx - 640; }
        else { kind = 1; qb = 1 - (idx - 704) / 64; bh = (idx - 704) % 64; }
        if (MK_ATT_SKIP && dry && ((MK_ATT_SKIP >> kind) & 1)) continue;
        if (kind == 2) { pool_unit(bh, PROJ, XY, tid); __syncthreads(); continue; }
        if (kind == 1) {
            const int b = bh >> 3, h = bh & 7;
            AttnP P; P.Q = PROJ + 2048 + h * 64; P.K = PROJ + 2560 + h * 64; P.V = PROJ + 3072 + h * 64; P.out = XY + 1024 + h * 64; P.stash = nullptr; P.gsub = nullptr; P.logf = LOGF + h; P.opitch = XYP; P.lam = 0.f; P.nscale = 0.f;
            attn_unit<MK_THRF, true>(tid, b, qb, 0, P, lds);
        } else {
            const int b = bh >> 2, h = bh & 3;
#pragma unroll 1
            for (int c = 0; c < 2; ++c) {
                AttnP P; P.Q = PROJ + 512 + (h * 2 + c) * 64; P.K = PROJ + 1024 + (h * 2 + c) * 64; P.V = PROJ + 1536 + h * 128;
                P.stash = STASH + h * 128; P.gsub = w.dsub; P.logf = nullptr; P.lam = lam; P.nscale = 1.0f - lam_init;
                if (c == 0) { P.out = STASH + h * 128; P.opitch = 512; } else { P.out = XY + 512 + h * 128; P.opitch = XYP; }
                attn_unit128<MK_THRD>(mk_tid(wave0), b, qb, c == 0 ? 0 : 4, P, lds); }
        }
    }
}
__device__ __forceinline__ void moe_tables(volatile LAS unsigned* MISC, const unsigned* cls_cnt, int tid) {
    __syncthreads();
    if (tid < 24) MISC[MI_N + tid] = cls_cnt[tid];
    __syncthreads();
    if (tid == 0) { unsigned base = 0, u0 = 0;
        for (int c = 0; c < 24; ++c) { const unsigned n = MISC[MI_N + c]; MISC[MI_BASE + c] = base; MISC[MI_U0 + c] = u0; const unsigned nch = (n + 255u) >> 8; base += nch * 256u; u0 += nch * 4u; }
        MISC[MI_TOT] = u0; }
    __syncthreads();
}

#ifndef MK_FIXA
#define MK_FIXA 0
#endif
#ifndef MK_FIXB
#define MK_FIXB 0
#endif
#ifndef MK_REPEAT
#define MK_REPEAT 0
#endif
constexpr int NPH = 18;
struct Prog { int p[40]; int n; };
constexpr Prog make_prog() {
    Prog g{}; int n = 0;
    for (int ph = 0; ph < NPH; ++ph) {
        const int kind = (ph == 0 || ph == 9) ? 8 : (ph >= 10 ? ph - 10 : ph - 1);
        g.p[n++] = ph; if ((MK_REPEAT >> kind) & 1) g.p[n++] = ph; }
    g.n = n; return g;
}
__constant__ const Prog PROG = make_prog();
constexpr int NPOS = make_prog().n;
template <unsigned KMASK>
__device__ __forceinline__ void mk_body() {
    typedef const __attribute__((address_space(4))) Args* KArgs;
    const KArgs args0p = (KArgs)__builtin_amdgcn_kernarg_segment_ptr();
    extern __shared__ __attribute__((aligned(16))) unsigned char lds_raw[];
    { LAS unsigned char* lds0 = (LAS unsigned char*)lds_raw;
      for (int u = threadIdx.x; u < (LDS_BYTES - MISC_OFF) / 4; u += NWAVES * 64) ((LAS unsigned*)(lds0 + MISC_OFF))[u] = 0u; }
    __syncthreads();
    const int wave0 = __builtin_amdgcn_readfirstlane(threadIdx.x >> 6);
    XcdBarrier bar = xcd_barrier_post((unsigned*)((gu32*)(args0p->ws + WS_CTL) + CW_BAR) + args0p->li * XCD_BAR_WORDS, (volatile LAS unsigned*)((LAS unsigned char*)lds_raw + MISC_OFF) + MI_BAR, threadIdx.x);
    const int ph_lo = args0p->ph_lo, ph_hi = args0p->ph_hi;
#pragma clang loop unroll(disable)
    for (int pos = ph_lo; pos < ph_hi; ++pos) {
        const int ph = __builtin_amdgcn_readfirstlane(PROG.p[pos]); const int rep = pos; const int dry = (MK_REPEAT != 0 && pos + 1 < ph_hi && __builtin_amdgcn_readfirstlane(PROG.p[pos + 1]) == ph) ? 1 : 0;
        KArgs ap = args0p; asm volatile("" : "+s"(ap));
#define args (*ap)
        LAS unsigned char* lds = (LAS unsigned char*)lds_raw;
        volatile LAS unsigned* MISC = (volatile LAS unsigned*)(lds + MISC_OFF);
        int G = gridDim.x, bx = blockIdx.x; asm volatile("" : "+s"(G), "+s"(bx)); const int vcu = (G % 8 == 0) ? (bx % 8) * (G / 8) + bx / 8 : bx;
        unsigned char* ws = args.ws; gu32* ctl = (gu32*)(ws + WS_CTL);
        float* XOUT = args.out; const float* x0 = (const float*)args.in[0];
        bf16* XY = (bf16*)(ws + WS_XY); bf16* PROJ = (bf16*)(ws + WS_PROJ);
        float* SSA = (float*)(ws + WS_SS); float* SSB = (float*)(ws + WS_SSB);
        if (ph == 0) { if constexpr (KMASK & 0x100u) { const int tid = mk_tid(wave0); const LayerW w = layer_view(ap, 0); conv_layer(w, ws, 0, lds, vcu, G, tid); p0_x(x0, (const int*)args.in[2], ws, (unsigned char*)XOUT + OUT_XB8, vcu, G, tid);
            if (tid == 0) ((unsigned*)(ctl + CW_XCC))[vcu] = xb_xcc_id() + 1u;
            if (bx == 0) { float* GT = (float*)(ctl + CW_GT); const int ll = tid >> 8, r = tid & 255, wch = r >> 6, d = r & 63;
                const float* gsrc = (const float*)(wch == 0 ? args.in[7] : (wch == 1 ? args.in[8] : (wch == 2 ? args.in[11] : args.in[12]))); GT[tid] = gsrc[ll * 64 + d]; } } }
        else if (ph == 9) { }
        else {
            const int l = __builtin_amdgcn_readfirstlane(ph >= 10 ? 1 : 0), k = __builtin_amdgcn_readfirstlane(ph - (l ? 10 : 1));
            const LayerW w = layer_view(ap, l);
            const float* SSin = l == 0 ? SSA : SSB; const float* xcur = l == 0 ? x0 : XOUT;
            if (k == 0) { if constexpr (KMASK & 1u) { const int tid = mk_tid(wave0);
                SchedPlain S{(const char*)(XY + 1536), (const char*)(ws + WS_W + W_IN), (size_t)256 * XYP * 2, (size_t)256 * 2048, 64, 15, 16, G, bx, dry & MK_FIXA, dry & MK_FIXB};
                LAS float* RSL = (LAS float*)(lds + MISC_OFF) + 1024;
                if (tid < 4) { int pm_ = -1, pn_ = 0; if (!tile_order((long)tid * G + bx, 64, 15, pm_, pn_)) pm_ = -1; MISC[112 + tid] = (unsigned)pm_; }
                __syncthreads();
#pragma unroll 1
                for (int idx = tid; idx < 1024; idx += 512) { const int pm_ = (int)MISC[112 + (idx >> 8)]; if (pm_ >= 0) RSL[idx] = rstd_at(SSin, (unsigned)(pm_ * 256 + (idx & 255))); }
                __syncthreads();
                EpiG1 E{SSin, PROJ, (float*)(ws + WS_LOGF), (const float*)(ws + WS_COSSIN), (const float*)(ctl + CW_GT) + 256 * l, w.ffb, dry, RSL};
                pg8::gemm_phase<SchedPlain, EpiG1, false, true>(tid, lds, XYP * 2, 2048, S, E);
                split_arrive_x(bar, (unsigned*)(ctl + CW_SPLIT3) + 64 * l, (unsigned*)(ctl + CW_SPLIT3) + 64 * l + 32 * 0 + 128, mk_tid(wave0));
            } } else if (k == 1) { if constexpr (KMASK & 2u) {
                attn_phase(wave0, w, l, rep, ws, (char*)lds_raw, MISC, ctl, dry);
                split_arrive_x(bar, (unsigned*)(ctl + CW_SPLIT + (2 * l) * 64), (unsigned*)(ctl + CW_SPLITX + (2 * l) * 64), mk_tid(wave0));
            } } else if (k == 2) { if constexpr (KMASK & 4u) { const int tid = mk_tid(wave0);
                unsigned char* gsc = (unsigned char*)XOUT + OUT_GATES + (size_t)bx * 196608;
                { SchedG2<0> S{(const char*)XOUT + OUT_XB8, (const char*)(ws + WS_W + W_G8), bx};
                  EpiG2<0> E{SSin, gsc, (bf16*)(ws + WS_MERGED)};
                  pg8::gemm_phase<SchedG2<0>, EpiG2<0>, false, true, true>(tid, lds, 1024, 1024, S, E); }
                { const int t2 = mk_tid(wave0); if (t2 == 0) split_wait_leader((unsigned*)(ctl + CW_SPLIT + (2 * l) * 64), (unsigned)G); __syncthreads(); }
                { SchedG2<1> S{(const char*)XY, (const char*)(ws + WS_W + W_BR), bx};
                  EpiG2<1> E{SSin, gsc, (bf16*)(ws + WS_MERGED)};
                  pg8::gemm_phase<SchedG2<1>, EpiG2<1>, false, true>(mk_tid(wave0), lds, XYP * 2, 1024, S, E); }
                { int pm_, pn_; tile_order(bx, 64, 4, pm_, pn_); group4_sync((unsigned*)(ctl + CW_G4 + ((2 * l) * 64 + pm_) * 32), mk_tid(wave0)); }
            } } else if (k == 3) { if constexpr (KMASK & 8u) { const int tid = mk_tid(wave0);
                SchedPlain S{(const char*)(ws + WS_MERGED), (const char*)(ws + WS_W + W_OUT), (size_t)256 * 2048, (size_t)256 * 2048, 64, 4, 16, G, bx, 0, 0};
                EpiRes<0, false> E{XY + 1536, XYP, nullptr, XY + 1536, XYP, SSA, nullptr, nullptr, dry, (MK_MU8 && l == NL - 1) ? (unsigned char*)XOUT + OUT_XB8 : nullptr};
                pg8::gemm_phase<SchedPlain, EpiRes<0, false>, false, true>(tid, lds, 2048, 2048, S, E);
                { int pm_, pn_; tile_order(bx, 64, 4, pm_, pn_); group4_sync((unsigned*)(ctl + CW_G4 + ((2 * l + 1) * 64 + pm_) * 32), mk_tid(wave0)); }
            } } else if (k == 4) { if constexpr (KMASK & 16u) { const int tid = mk_tid(wave0);
                {
                    typedef float f32x16r __attribute__((ext_vector_type(16))); typedef short bf16x8r __attribute__((ext_vector_type(8)));
                    const int lane_ = tid & 63, r32 = lane_ & 31, hh = lane_ >> 5, wv = __builtin_amdgcn_readfirstlane(tid >> 6); int pm_, pn_; tile_order(bx, 64, 4, pm_, pn_); const int t0 = pm_ * 256 + pn_ * 64;
                    unsigned* ccnt = (unsigned*)(ctl + CW_CLS + 32 * l + 64 * dry); int* LIST = (int*)(ws + WS_LIST);
                    const GAS char* wrh = (const GAS char*)(ws + WS_W + W_RH) + (unsigned)(r32 * 2048 + (128 * wv + 8 * hh) * 2);
                    const GAS char* xb_ = (const GAS char*)(XY + 1536) + (size_t)t0 * (XYP * 2) + (unsigned)(r32 * (XYP * 2) + (128 * wv + 8 * hh) * 2);
                    f32x16r acc0 = {}, acc1 = {};
#pragma unroll 2
                    for (int ks = 0; ks < 8; ++ks) {
                        const bf16x8r Bh = *(const GAS bf16x8r*)(wrh + ks * 32), Bl = *(const GAS bf16x8r*)(wrh + 65536 + ks * 32);
                        const bf16x8r A0 = *(const GAS bf16x8r*)(xb_ + ks * 32), A1 = *(const GAS bf16x8r*)(xb_ + 32 * (XYP * 2) + ks * 32);
                        acc0 = __builtin_amdgcn_mfma_f32_32x32x16_bf16(A0, Bh, acc0, 0, 0, 0); acc0 = __builtin_amdgcn_mfma_f32_32x32x16_bf16(A0, Bl, acc0, 0, 0, 0);
                        acc1 = __builtin_amdgcn_mfma_f32_32x32x16_bf16(A1, Bh, acc1, 0, 0, 0); acc1 = __builtin_amdgcn_mfma_f32_32x32x16_bf16(A1, Bl, acc1, 0, 0, 0);
                    }
                    LAS float* Pp = (LAS float*)lds;
                    LAS float* Lg = (LAS float*)(lds + 65536);
#pragma unroll
                    for (int r = 0; r < 16; ++r) { const int tk = (r & 3) + 8 * (r >> 2) + 4 * hh; Pp[(wv * 64 + tk) * 32 + r32] = acc0[r]; Pp[(wv * 64 + 32 + tk) * 32 + r32] = acc1[r]; }
                    __syncthreads();
                    { const int tk = tid >> 3, n4 = (tid & 7) * 4; f32x4 s = (f32x4){0.f, 0.f, 0.f, 0.f};
#pragma unroll
                      for (int w8 = 0; w8 < 8; ++w8) s += *(const LAS f32x4*)(Pp + (w8 * 64 + tk) * 32 + n4);
                      *(LAS f32x4*)(Lg + tk * 32 + n4) = s; }
                    __syncthreads();
                    if (tid < 64) { const int t = t0 + tid; float dg[4], de[16];
#pragma unroll
                        for (int e = 0; e < 4; ++e) dg[e] = Lg[tid * 32 + e];
#pragma unroll
                        for (int e = 0; e < 16; ++e) de[e] = Lg[tid * 32 + 4 + e];
                        const float rstd = rstd_at(SSA, (unsigned)t); float wa, wb; const int cls = route_decide(dg, de, rstd, w.brg, w.bre, wa, wb);
                        *(GAS f32x4*)((GAS char*)(ws + WS_TOKW) + (unsigned)t * 16u) = (f32x4){wa, wb, rstd, 0.f}; MISC[128 + tid] = (unsigned)cls; }
                    __syncthreads();
                    if (tid < 64) {
                        const unsigned mycls = MISC[128 + tid]; const unsigned long long ltm = (1ull << tid) - 1ull; unsigned cnt_c = 0, rank = 0;
#pragma unroll 4
                        for (unsigned c = 0; c < 24; ++c) { const unsigned long long m = __ballot(mycls == c); if ((unsigned)tid == c) cnt_c = (unsigned)__popcll(m); if (mycls == c) rank = (unsigned)__popcll(m & ltm); }
                        unsigned base = 0; if (tid < 24 && cnt_c) base = atomicAdd(ccnt + tid, cnt_c);
                        const unsigned mybase = (unsigned)__builtin_amdgcn_ds_bpermute((int)(mycls << 2), (int)base);
                        LIST[(size_t)mycls * T + mybase + rank] = t0 + tid; }
                    __syncthreads();
                }
                split_arrive_x(bar, (unsigned*)(ctl + CW_SPLIT + (2 * l + 1) * 64), (unsigned*)(ctl + CW_SPLITX + (2 * l + 1) * 64), mk_tid(wave0));
            } } else if (k == 5) { if constexpr (KMASK & 96u) { int tid = mk_tid(wave0);
                if (tid == 0) split_wait_leader((unsigned*)(ctl + CW_SPLIT + (2 * l + 1) * 64), (unsigned)G);
                __syncthreads();
                moe_tables(MISC, (const unsigned*)(ctl + CW_CLS + 32 * l), tid);
                const int NUm = (int)MISC[MI_TOT], KO = NUm > 256 ? (NUm - 256) >> 2 : 0;
                const int gid = vcu >> 2, m4 = vcu & 3, xg = gid >> 3, lg = gid & 7;
                const int k_o = lg * 8 + xg, k_p = (lg - 4) * 8 + xg;
                const bool is_o = lg < 4 && k_o < KO, is_p = lg >= 4 && k_p < KO;
                unsigned* cA = (unsigned*)(ctl + CW_MOE2 + 3584 * l); unsigned* cB = cA + 2048; unsigned* cO = cA + 3072;
#pragma clang loop unroll(disable)
                for (int r = 0; r < 2; ++r) {
                    const int u = r == 0 ? vcu : 256 + 4 * k_o + m4; if (r == 1 && !is_o) break;
                    tid = mk_tid(wave0);
                    { SchedMoE S{MISC, (const int*)(ws + WS_LIST), (const char*)(XY + 1536), (const char*)(ws + WS_W + W_GU), G, u, 0, 0};
                      EpiMU E{(bf16*)(ws + OV_ACT), (const float*)(ws + WS_TOKW), 1.0f};
                      pg8::gemm_phase<SchedMoE, EpiMU, true, true>(tid, lds, XYP * 2, 2048, S, E); }
                    if (r == 0 && is_o) {
                        asm volatile("s_waitcnt vmcnt(0)" ::: "memory"); __syncthreads();
                        tid = mk_tid(wave0);
                        if (tid == 0) { const unsigned me = xb_xcc_id() + 1u; bool same = true;
#pragma unroll
                            for (int i = 0; i < 4; ++i) same = same && (xb_ld((unsigned*)(ctl + CW_XCC) + (gid + 4) * 4 + i) == me);
                            if (!same) { __builtin_amdgcn_fence(__ATOMIC_RELEASE, "agent"); asm volatile("s_waitcnt vmcnt(0)" ::: "memory"); }
                            xb_add(cO + 16 * k_o, 1u); asm volatile("s_waitcnt vmcnt(0)" ::: "memory"); }
                        __syncthreads();
                    }
                }
                group4_sync(is_o ? cB + 32 * k_o : cA + 32 * gid, mk_tid(wave0));
#pragma clang loop unroll(disable)
                for (int r = 0; r < 2; ++r) {
                    const int u = r == 0 ? (is_o ? 256 + 4 * k_o + m4 : vcu) : 4 * (gid - 4) + m4; if (r == 1 && !is_p) break;
                    tid = mk_tid(wave0);
                    if (r == 1) {
                        if (tid == 0) { unsigned sp = 0; while (xb_ld(cO + 16 * k_p) < 4u) { __builtin_amdgcn_s_sleep(2); if (++sp > (1u << 22)) break; }
                            __builtin_amdgcn_fence(__ATOMIC_ACQUIRE, "agent"); asm volatile("s_waitcnt vmcnt(0)" ::: "memory"); }
                        __syncthreads();
                    }
                    SchedMoE S{MISC, (const int*)(ws + WS_LIST), (const char*)(ws + OV_ACT), (const char*)(ws + WS_W + W_D), G, u, 2, 0};
                    EpiRes<0, true> E{XY + 1536, XYP, nullptr, (bf16*)(ws + OV_XB2), 1024, SSA, nullptr, nullptr, dry, MK_PLE8 ? ws + WS_MERGED : nullptr};
                    pg8::gemm_phase<SchedMoE, EpiRes<0, true>, false, true>(tid, lds, 1024, 512, S, E);
                }
                { unsigned* fqh = pg8::rflp((unsigned*)(ctl + CW_FQ) + 64 * l); const int NF = 256 + (l + 1 < NL ? CV_EARLY_BATCHES : 0);
                  int arrived = 0;
                  for (;;) {
                    const int tq = mk_tid(wave0);
                    if (tq == 0) MISC[MI_Q] = atomicAdd(fqh, 1u);
                    __syncthreads();
                    const int idx = (int)MISC[MI_Q];
                    __syncthreads();
                    if (idx >= 256 && !arrived) { split_arrive_x(bar, (unsigned*)(ctl + CW_SPLIT3) + 256 + 64 * l, (unsigned*)(ctl + CW_SPLIT3) + 512 + 64 * l, mk_tid(wave0)); arrived = 1; }
                    if (idx >= NF) break;
                    if (idx < 256) {
                        SchedPlain S2{(const char*)(ws + OV_PB), (const char*)(ws + WS_WPLE + l * WPLE_STRIDE + W_P), (size_t)256 * 512, (size_t)256 * 512, 64, 4, 4, 1 << 20, idx, 0, 0};
                        EpiPW E2{(bf16*)(ws + OV_PW)};
                        pg8::gemm_phase<SchedPlain, EpiPW, false, true>(tq, lds, 512, 512, S2, E2);
                    } else { const LayerW w1 = layer_view(ap, 1); conv_early_batch(w1, ws, 1, lds, idx - 256, tq); }
                  } }
            } } else if (k == 6) { if constexpr (KMASK & 96u) {
            } } else { if constexpr (KMASK & 128u) { const int tid = mk_tid(wave0);
                if (tid == 0) split_wait_leader((unsigned*)(ctl + CW_SPLIT3) + 256 + 64 * l, (unsigned)G);
                __syncthreads();
                constexpr int P8 = MK_PLE8 ? 1 : 0;
                SchedPlain S{(const char*)(ws + (P8 ? WS_MERGED : OV_XB2)), (const char*)(ws + WS_WPLE + l * WPLE_STRIDE + W_PG), (size_t)256 * (P8 ? 1024 : 2048), (size_t)256 * (P8 ? 1024 : 2048), 64, 4, P8 ? 8 : 16, G, bx, 0, 0};
                EpiRes<1, false> E{(const bf16*)(ws + OV_XB2), 1024, l == NL - 1 ? XOUT : nullptr, l == NL - 1 ? nullptr : XY + 1536, XYP, SSB, SSA, (const bf16*)(ws + OV_PW), dry, l == NL - 1 ? nullptr : (unsigned char*)XOUT + OUT_XB8};
                pg8::gemm_phase<SchedPlain, EpiRes<1, false>, false, true, P8 != 0>(tid, lds, P8 ? 1024 : 2048, P8 ? 1024 : 2048, S, E);
            } }
        }
        const int kk_ = (ph == 0 || ph == 9) ? -1 : (ph >= 10 ? ph - 10 : ph - 1);
        if (pos + 1 < ph_hi && ph != 9 && (MK_REPEAT != 0 || kk_ > 6 || kk_ < 0)) { xcd_barrier(bar, mk_tid(wave0));
#ifdef MK_DOUBLE_BAR
            xcd_barrier(bar, mk_tid(wave0)); xcd_barrier(bar, mk_tid(wave0));
#endif
        }
#undef args
    }
}

#ifndef MK_KMASKS
#ifdef MK_SPLIT_TEST
#define MK_KMASKS 0x100u
#else
#define MK_KMASKS 0x1FFu
#endif
#endif
__global__ void __launch_bounds__(NWAVES * 64, 2) mk_fwd(Args args) { mk_body<MK_KMASKS>(); }
#ifdef MK_SPLIT_TEST
__global__ void __launch_bounds__(NWAVES * 64, 2) mk_t0(Args args) { mk_body<1u>(); }
__global__ void __launch_bounds__(NWAVES * 64, 2) mk_t1(Args args) { mk_body<2u>(); }
__global__ void __launch_bounds__(NWAVES * 64, 2) mk_t2(Args args) { mk_body<4u>(); }
__global__ void __launch_bounds__(NWAVES * 64, 2) mk_t3(Args args) { mk_body<8u>(); }
__global__ void __launch_bounds__(NWAVES * 64, 2) mk_t4(Args args) { mk_body<16u>(); }
__global__ void __launch_bounds__(NWAVES * 64, 2) mk_t5(Args args) { mk_body<32u>(); }
__global__ void __launch_bounds__(NWAVES * 64, 2) mk_t6(Args args) { mk_body<64u>(); }
__global__ void __launch_bounds__(NWAVES * 64, 2) mk_t7(Args args) { mk_body<128u>(); }
__global__ void __launch_bounds__(NWAVES * 64, 2) mk_t8(Args args) { mk_body<256u>(); }
#endif
#ifndef MK_ONE_LAUNCH
#define MK_ONE_LAUNCH 0
#endif
#ifndef MK_OPT_MASK
#define MK_OPT_MASK 0x3FFFF
#endif
static void ref_phase(int l, int k, void* const* d_in, float* XOUT, unsigned char* ws, hipStream_t st) {
    using namespace refp;
    const float* x0 = (const float*)d_in[0]; const float* p = (const float*)d_in[1]; const int* pos = (const int*)d_in[2];
    const float* g_attn = (const float*)d_in[3] + l * 1024; const float* w_in_l = (const float*)d_in[4] + (size_t)l * 1024 * INW;
    const float* pool_w = (const float*)d_in[5] + (size_t)l * 4 * 128 * 128; const float* pool_scale = (const float*)d_in[6] + l * 512;
    const float* dqn = (const float*)d_in[7] + l * 64; const float* dkn = (const float*)d_in[8] + l * 64; const float* dlam = (const float*)d_in[9] + l * 256;
    const float* dsub = (const float*)d_in[10] + l * 128; const float* fqn = (const float*)d_in[11] + l * 64; const float* fkn = (const float*)d_in[12] + l * 64;
    const float* ffb = (const float*)d_in[13] + l * 8; const float* w_branch_l = (const float*)d_in[14] + (size_t)l * 3 * 512 * 1024; const float* w_out_l = (const float*)d_in[15] + (size_t)l * 1024 * 1024;
    const float* g_ffn = (const float*)d_in[16] + l * 1024; const float* wrg = (const float*)d_in[17] + (size_t)l * 1024 * 4; const float* brg = (const float*)d_in[18] + l * 4;
    const float* wre = (const float*)d_in[19] + (size_t)l * 1024 * 16; const float* bre = (const float*)d_in[20] + l * 16;
    const float* wg_l = (const float*)d_in[21] + (size_t)l * 16 * 1024 * 256; const float* wu_l = (const float*)d_in[22] + (size_t)l * 16 * 1024 * 256; const float* wd_l = (const float*)d_in[23] + (size_t)l * 16 * 256 * 1024;
    const float* g_ple = (const float*)d_in[24] + l * 1024; const float* wpg_l = (const float*)d_in[25] + (size_t)l * 1024 * 1024; const float* wple_l = (const float*)d_in[26] + (size_t)l * 256 * 1024;
    const float* p_l = p + (size_t)l * T * 256;
    float* SSA = (float*)(ws + WS_SS); float* SSB = (float*)(ws + WS_SSB); float* RS = (float*)(ws + WS_RSTD); float* LOGF = (float*)(ws + WS_LOGF); float* FCUM = (float*)(ws + WS_FCUM); float* TOKW = (float*)(ws + WS_TOKW); int* LIST = (int*)(ws + WS_LIST);
    bf16* XY = (bf16*)(ws + WS_XY); bf16* PROJ = (bf16*)(ws + WS_PROJ); float* CH = (float*)(ws + WS_STASH); bf16* MERGED = (bf16*)(ws + WS_MERGED); float* TMP = (float*)(ws + WS_PROJ);
    unsigned* cls_cnt = (unsigned*)(ws + WS_CTL) + CW_CLS + 32 * l;
    const float* xcur = l == 0 ? x0 : XOUT; float* SSin = l == 0 ? SSA : SSB;
    const float lam_init = 0.8f - 0.6f * expf(-0.3f * (float)l);
    if (k == -1) { k_rowstats<<<T / 4, 256, 0, st>>>(x0, XY + 1536, XYP, SSA, RS, nullptr); return; }
    if (k == 0) {
        k_ref_rstd<<<T / 256, 256, 0, st>>>(SSin, RS);
        for (int cc = 0; cc < 14; ++cc) {
            k_ref_gemm<<<dim3(4, T / 64), 256, 0, st>>>(XnormLoader{xcur, RS, g_attn}, w_in_l + 256 * cc, INW, 256, 1024, EpiStoreF32{CH, 256, 0});
            int kind = 2; const float* gain = nullptr; int rot = 0; float osc = 1.f;
            if (cc < 2) kind = 0;
            else if (cc < 4) { kind = 1; gain = dqn; rot = 1; osc = C2; }
            else if (cc < 6) { kind = 1; gain = dkn; rot = 1; }
            else if (cc >= 8 && cc < 10) { kind = 1; gain = fqn; osc = C2; }
            else if (cc >= 10 && cc < 12) { kind = 1; gain = fkn; }
            k_ref_epi1<<<T, 256, 0, st>>>(CH, cc, kind, pool_w, pool_scale, gain, rot, osc, pos, PROJ);
        }
        k_ref_gemm<<<dim3(1, T / 64), 256, 0, st>>>(XnormLoader{xcur, RS, g_attn}, w_in_l + 3584, INW, 8, 1024, EpiStoreF32{CH, 8, 0});
        k_ref_logf<<<T * 8 / 256, 256, 0, st>>>(CH, ffb, LOGF);
    } else if (k == 1) {
        k_ref_fscan<<<1, 64, 0, st>>>(LOGF, FCUM);
        k_ref_fox<<<T * 8 / 4, 256, 0, st>>>(PROJ, FCUM, XY);
        k_ref_diff<<<T * 4 / 2, 128, 0, st>>>(PROJ, dlam, dsub, lam_init, XY);
        k_ref_pool<<<T * 512 / 256, 256, 0, st>>>(PROJ, XY);
    } else if (k == 2) {
        k_ref_rstd<<<T / 256, 256, 0, st>>>(SSin, RS);
        k_ref_gemm2<<<dim3(16, T / 64), 256, 0, st>>>(xcur, RS, g_attn, w_in_l, w_branch_l, XY, MERGED);
    } else if (k == 3) {
        k_ref_gemm<<<dim3(16, T / 64), 256, 0, st>>>(Bf16Loader{MERGED, 1024, 0}, w_out_l, 1024, 1024, 1024, EpiResid{xcur, XOUT});
        k_rowstats<<<T / 4, 256, 0, st>>>(XOUT, XY + 1536, XYP, SSA, RS, nullptr);
    } else if (k == 4) {
        k_route<<<T / 4, 256, 0, st>>>(XOUT, g_ffn, wrg, brg, wre, bre, cls_cnt, LIST, TOKW);
    } else if (k == 5) {
        k_ref_rstd<<<T / 256, 256, 0, st>>>(SSA, RS);
        k_ref_moe<<<dim3(T / 8, 24), 256, 0, st>>>(XOUT, RS, g_ffn, (const int*)cls_cnt, LIST, TOKW, wg_l, wu_l, wd_l);
        k_rowstats<<<T / 4, 256, 0, st>>>(XOUT, (bf16*)(ws + OV_XB2), 1024, SSA, RS, nullptr);
    } else if (k == 7) {
        k_ref_rstd<<<T / 256, 256, 0, st>>>(SSA, RS);
        k_ref_ple<<<dim3(16, T / 64), 256, 0, st>>>(XOUT, RS, g_ple, wpg_l, p_l, wple_l, TMP);
        k_rowstats<<<T / 4, 256, 0, st>>>(TMP, XY + 1536, XYP, SSB, RS, XOUT);
    }
}

extern "C" void kernel_launch(void* const* d_in, const int* in_sizes, int n_in, void* d_out, int out_size, void* d_ws, size_t ws_size, hipStream_t stream) {
    static int grid = 0;
    if (grid == 0) {
        if (n_in != 27 || out_size != T * DM || ws_size < WS_END) { fprintf(stderr, "kernel_launch: unexpected shapes (n_in %d out %d ws %zu)\n", n_in, out_size, ws_size); grid = -1; return; }
        int dev = 0, cus = 0;
        if (hipGetDevice(&dev) != hipSuccess || hipDeviceGetAttribute(&cus, hipDeviceAttributeMultiprocessorCount, dev) != hipSuccess) { grid = -1; return; }
        if (hipFuncSetAttribute((const void*)mk_fwd, hipFuncAttributeMaxDynamicSharedMemorySize, LDS_BYTES) != hipSuccess) { fprintf(stderr, "kernel_launch: hipFuncSetAttribute failed\n"); grid = -1; return; }
#if !MK_ONE_LAUNCH
        { const void* ks[9] = {(const void*)mk_t0, (const void*)mk_t1, (const void*)mk_t2, (const void*)mk_t3, (const void*)mk_t4, (const void*)mk_t5, (const void*)mk_t6, (const void*)mk_t7, (const void*)mk_t8};
          for (int i = 0; i < 9; ++i) (void)hipFuncSetAttribute(ks[i], hipFuncAttributeMaxDynamicSharedMemorySize, LDS_BYTES); }
#endif
        int per_cu = 0;
        if (hipOccupancyMaxActiveBlocksPerMultiprocessor(&per_cu, mk_fwd, NWAVES * 64, LDS_BYTES) != hipSuccess || per_cu < 1) { fprintf(stderr, "kernel_launch: occupancy query failed (%d)\n", per_cu); grid = -1; return; }
        (void)hipGetLastError();
        grid = cus;
    }
    if (grid < 0) return;
    (void)hipMemsetAsync((char*)d_ws + WS_CTL, 0, MK_ONE_LAUNCH ? (size_t)192 * 1024 : CTL_BYTES, stream);
    Args a{};
    for (int i = 0; i < 27; ++i) a.in[i] = d_in[i];
    a.out = (float*)d_out; a.ws = (unsigned char*)d_ws;
#if MK_ONE_LAUNCH
    a.ph_lo = 0; a.ph_hi = NPOS; a.li = 0;
    hipLaunchKernelGGL(mk_fwd, dim3(grid), dim3(NWAVES * 64), LDS_BYTES, stream, a);
#else
    const unsigned mask = MK_OPT_MASK; int li = 0;
    typedef void (*kern_t)(Args);
    const kern_t ks[9] = {mk_t0, mk_t1, mk_t2, mk_t3, mk_t4, mk_t5, mk_t6, mk_t7, mk_t8};
#define LAUNCH_PH(kk) hipLaunchKernelGGL(ks[kk], dim3(grid), dim3(NWAVES * 64), LDS_BYTES, stream, a)
    for (int ph = 0; ph < NPH; ++ph) {
        const bool opt = (mask >> ph) & 1u;
        const int l = ph >= 10 ? 1 : 0, k = ph == 0 ? -1 : (ph == 9 ? -2 : ph - (l ? 10 : 1));
        if (ph == 0) {
            a.ph_lo = 0; a.ph_hi = 1; a.li = li++; LAUNCH_PH(8);
            if (!opt) ref_phase(0, -1, d_in, (float*)d_out, (unsigned char*)d_ws, stream);
            continue; }
        if (ph == 9) { a.ph_lo = 9; a.ph_hi = 10; a.li = li++; LAUNCH_PH(8); continue; }
        if (opt) { a.ph_lo = ph; a.ph_hi = ph + 1; a.li = li++; LAUNCH_PH(k); }
        else if (k != 6) ref_phase(l, k, d_in, (float*)d_out, (unsigned char*)d_ws, stream);
    }
#endif
}
```

```cpp
#include <hip/hip_runtime.h>
#include <cstdio>
#include <cstdint>
#include <cmath>
typedef unsigned short bf16;
constexpr int T = 16384, DM = 1024, S = 2048, NB = 8, NL = 2, INW = 6664;
constexpr float RMS_EPS = 1e-6f;
constexpr float C2 = 0.125f * 1.4426950408889634f;
constexpr size_t MiB = 1u << 20;
constexpr size_t WS_CTL = 0, CTL_BYTES = 1 * MiB;
constexpr size_t WS_SS = 1 * MiB;
constexpr size_t WS_LOGF = 2 * MiB;
constexpr size_t WS_FCUM = 2 * MiB + 512 * 1024;
constexpr size_t WS_TOKW = 3 * MiB;
constexpr size_t WS_RSTD = 3 * MiB + 256 * 1024;
constexpr size_t WS_LIST = 3 * MiB + 512 * 1024;
constexpr size_t WS_COSSIN = 5 * MiB;
constexpr size_t WS_SSB = 49 * MiB;
constexpr size_t WS_W = 6 * MiB;
constexpr size_t WS_WPLE = 52 * MiB;
constexpr size_t WS_XY = 57 * MiB;
constexpr size_t WS_PROJ = 137 * MiB;
constexpr size_t WS_STASH = 249 * MiB;
constexpr size_t WS_MERGED = WS_PROJ + 96 * MiB;
constexpr size_t WS_PB = 265 * MiB;
constexpr size_t WS_END = 273 * MiB;
constexpr int XYP = 2560, PJP = 3584;
constexpr int CW_CLS = 64;
constexpr int CW_AQ = 256;
constexpr int CW_G4 = 16384;
constexpr int CW_SPLIT3 = 24576;
constexpr int CW_MOE2 = 32768;
constexpr int CW_XCC = 40960;
constexpr int CW_GT = 131072;
constexpr int CW_MOEG = 512;
constexpr int CW_SPLIT = 5632;
constexpr int CW_SPLITX = 5888;
constexpr int CW_FQ = 6144;
constexpr int CW_BAR = 8192;
#define MK_ONE_LAUNCH 1
namespace refp {

__device__ __forceinline__ float bf2f(bf16 v) { return __uint_as_float((unsigned)v << 16); }
__device__ __forceinline__ bf16 f2b(float f) { unsigned u = __float_as_uint(f); return (bf16)((u + 0x7fffu + ((u >> 16) & 1u)) >> 16); }
__device__ __forceinline__ float wsum(float v) {
#pragma unroll
    for (int o = 1; o < 64; o <<= 1) v += __shfl_xor(v, o);
    return v;
}
__device__ __forceinline__ float wmax(float v) {
#pragma unroll
    for (int o = 1; o < 64; o <<= 1) v = fmaxf(v, __shfl_xor(v, o));
    return v;
}
__device__ __forceinline__ float row_rstd(const float* SS, int t) {
    float s = 0.f;
#pragma unroll
    for (int i = 0; i < 16; ++i) s += SS[(size_t)t * 16 + i];
    return rsqrtf(s * (1.0f / 1024.0f) + RMS_EPS);
}

__global__ void __launch_bounds__(256) k_rowstats(const float* __restrict__ xsrc, bf16* XBdst, int ldxb, float* SS, float* RSTD, float* xcopy) {
    const int t = blockIdx.x * 4 + (threadIdx.x >> 6), lane = threadIdx.x & 63;
    const float* xr = xsrc + (size_t)t * 1024;
    float s = 0.f;
    for (int j = 0; j < 16; ++j) { const int k = lane + 64 * j; const float v = xr[k]; s += v * v; XBdst[(size_t)t * ldxb + k] = f2b(v); if (xcopy) xcopy[(size_t)t * 1024 + k] = v; }
    s = wsum(s);
    if (lane < 16) SS[(size_t)t * 16 + lane] = (lane == 0) ? s : 0.f;
    if (lane == 0) RSTD[t] = rsqrtf(s * (1.0f / 1024.0f) + RMS_EPS);
}
__global__ void k_ref_rstd(const float* __restrict__ SS, float* RSTD) { const int t = blockIdx.x * blockDim.x + threadIdx.x; if (t < T) RSTD[t] = row_rstd(SS, t); }

struct XnormLoader { const float* x; const float* RS; const float* g;
    __device__ __forceinline__ float operator()(int t, int k) const { return x[(size_t)t * 1024 + k] * RS[t] * g[k]; } };
struct Bf16Loader { const bf16* A; int lda; int pad;
    __device__ __forceinline__ float operator()(int t, int k) const { return bf2f(A[(size_t)t * lda + k]); } };
struct F32Loader { const float* A; int lda; int pad;
    __device__ __forceinline__ float operator()(int t, int k) const { return A[(size_t)t * lda + k]; } };

template <class AL, class EPI>
__global__ void __launch_bounds__(256) k_ref_gemm(AL al, const float* __restrict__ W, int ldw, int N, int K, EPI epi) {
    __shared__ float sA[16][65], sB[16][65];
    const int tx = threadIdx.x & 15, ty = threadIdx.x >> 4, t0 = blockIdx.y * 64, n0 = blockIdx.x * 64;
    float acc[4][4] = {};
    for (int k0 = 0; k0 < K; k0 += 16) {
        for (int e = threadIdx.x; e < 1024; e += 256) { const int r = e >> 4, kk = e & 15; sA[kk][r] = al(t0 + r, k0 + kk); }
        for (int e = threadIdx.x; e < 1024; e += 256) { const int kk = e >> 6, c = e & 63; sB[kk][c] = (n0 + c < N) ? W[(size_t)(k0 + kk) * ldw + n0 + c] : 0.f; }
        __syncthreads();
#pragma unroll
        for (int kk = 0; kk < 16; ++kk) {
            float a[4], b[4];
#pragma unroll
            for (int i = 0; i < 4; ++i) { a[i] = sA[kk][ty * 4 + i]; b[i] = sB[kk][tx * 4 + i]; }
#pragma unroll
            for (int i = 0; i < 4; ++i)
#pragma unroll
                for (int j = 0; j < 4; ++j) acc[i][j] += a[i] * b[j];
        }
        __syncthreads();
    }
#pragma unroll
    for (int i = 0; i < 4; ++i)
#pragma unroll
        for (int j = 0; j < 4; ++j) { const int n = n0 + tx * 4 + j; if (n < N) epi(t0 + ty * 4 + i, n, acc[i][j]); }
}
struct EpiStoreF32 { float* C; int ldc; int pad; __device__ __forceinline__ void operator()(int t, int n, float v) const { C[(size_t)t * ldc + n] = v; } };
struct EpiResid { const float* xs; float* xo; __device__ __forceinline__ void operator()(int t, int n, float v) const { xo[(size_t)t * 1024 + n] = xs[(size_t)t * 1024 + n] + v; } };

__global__ void __launch_bounds__(256) k_ref_epi1(const float* __restrict__ C, int cc, int kind, const float* pool_w, const float* pool_scale,
                                                  const float* gain, int rotary, float outscale, const int* positions, bf16* PROJ) {
    __shared__ float row[256];
    const int t = blockIdx.x, j = threadIdx.x;
    row[j] = C[(size_t)t * 256 + j];
    __syncthreads();
    float out;
    if (kind == 0) {
        const int g = 2 * cc + (j >> 7), d = j & 127; float s = 0.f;
        for (int c = 0; c < 128; ++c) s += row[(j & 128) + c] * pool_w[((size_t)g * 128 + c) * 128 + d];
        out = s * pool_scale[g * 128 + d];
    } else if (kind == 1) {
        const int dim = j & 63; float v = row[j];
        const float ss = wsum(v * v);
        v = v * rsqrtf(ss * (1.0f / 64.0f) + RMS_EPS) * gain[dim];
        if (rotary) {
            const float other = __shfl_xor(v, 8);
            if (dim < 16) {
                const int i = dim & 7; const float invf = powf(500000.0f, -(float)(2 * i) / 16.0f);
                const float ang = (float)positions[t] * invf; const float c = cosf(ang), s = sinf(ang);
                v = (dim < 8) ? (v * c - other * s) : (v * c + other * s);
            }
        }
        out = v * outscale;
    } else out = row[j];
    PROJ[(size_t)t * 3584 + 256 * cc + j] = f2b(out);
}
__global__ void k_ref_logf(const float* __restrict__ C8, const float* fb, float* LOGF) {
    const int i = blockIdx.x * blockDim.x + threadIdx.x; if (i >= T * 8) return;
    const float v = C8[i] + fb[i & 7];
    LOGF[i] = fminf(v, 0.f) - log1pf(expf(-fabsf(v)));
}
__global__ void k_ref_fscan(const float* __restrict__ LOGF, float* FCUM) {
    const int i = threadIdx.x; if (i >= 64) return; const int b = i >> 3, h = i & 7; float s = 0.f;
    for (int t = 0; t < S; ++t) { s += LOGF[((size_t)b * S + t) * 8 + h]; FCUM[((size_t)b * S + t) * 8 + h] = s; }
}
__global__ void __launch_bounds__(256) k_ref_fox(const bf16* __restrict__ PROJ, const float* __restrict__ FCUM, bf16* XY) {
    __shared__ float P[4][S];
    const int w = threadIdx.x >> 6, lane = threadIdx.x & 63; const int gw = blockIdx.x * 4 + w; const int t = gw >> 3, h = gw & 7; const int b = t / S, sq = t % S;
    float q[64];
#pragma unroll
    for (int d = 0; d < 64; ++d) q[d] = bf2f(PROJ[(size_t)t * 3584 + 2048 + h * 64 + d]);
    const float Ft = FCUM[(size_t)t * 8 + h];
    float m = -INFINITY;
    for (int j = lane; j <= sq; j += 64) { const bf16* kr = PROJ + ((size_t)b * S + j) * 3584 + 2560 + h * 64; float s = 0.f;
#pragma unroll
        for (int d = 0; d < 64; ++d) s += q[d] * bf2f(kr[d]);
        s += (Ft - FCUM[((size_t)b * S + j) * 8 + h]) * 1.4426950408889634f; P[w][j] = s; m = fmaxf(m, s); }
    m = wmax(m); float l = 0.f;
    for (int j = lane; j <= sq; j += 64) { const float p = exp2f(P[w][j] - m); P[w][j] = p; l += p; }
    l = wsum(l);
    __syncthreads();
    float o = 0.f;
    for (int j = 0; j <= sq; ++j) o += P[w][j] * bf2f(PROJ[((size_t)b * S + j) * 3584 + 3072 + h * 64 + lane]);
    XY[(size_t)t * 2560 + 1024 + h * 64 + lane] = f2b(o / l);
}
__global__ void __launch_bounds__(128) k_ref_diff(const bf16* __restrict__ PROJ, const float* __restrict__ lamp, const float* __restrict__ gsub, float lam_init, bf16* XY) {
    __shared__ float P[2][2][S];
    const int w = threadIdx.x >> 6, lane = threadIdx.x & 63; const int gw = blockIdx.x * 2 + w; const int t = gw >> 2, h = gw & 3; const int b = t / S, sq = t % S;
    float lam; { const float a = wsum(lamp[lane] * lamp[64 + lane]), c = wsum(lamp[128 + lane] * lamp[192 + lane]); lam = expf(a) - expf(c) + lam_init; }
    float linv[2];
    for (int c = 0; c < 2; ++c) {
        float q[64];
#pragma unroll
        for (int d = 0; d < 64; ++d) q[d] = bf2f(PROJ[(size_t)t * 3584 + 512 + (h * 2 + c) * 64 + d]);
        float m = -INFINITY;
        for (int j = lane; j <= sq; j += 64) { const bf16* kr = PROJ + ((size_t)b * S + j) * 3584 + 1024 + (h * 2 + c) * 64; float s = 0.f;
    #pragma unroll
        for (int d = 0; d < 64; ++d) s += q[d] * bf2f(kr[d]);
            P[w][c][j] = s; m = fmaxf(m, s); }
        m = wmax(m); float l = 0.f;
        for (int j = lane; j <= sq; j += 64) { const float p = exp2f(P[w][c][j] - m); P[w][c][j] = p; l += p; }
        linv[c] = 1.0f / wsum(l);
    }
    __syncthreads();
    float o0 = 0.f, o1 = 0.f;
    for (int j = 0; j <= sq; ++j) { const float a = P[w][0][j] * linv[0] - lam * P[w][1][j] * linv[1]; const bf16* vr = PROJ + ((size_t)b * S + j) * 3584 + 1536 + h * 128;
        o0 += a * bf2f(vr[lane]); o1 += a * bf2f(vr[64 + lane]); }
    const float ss = wsum(o0 * o0 + o1 * o1); const float r = rsqrtf(ss * (1.0f / 128.0f) + RMS_EPS) * (1.0f - lam_init);
    XY[(size_t)t * 2560 + 512 + h * 128 + lane] = f2b(o0 * r * gsub[lane]);
    XY[(size_t)t * 2560 + 512 + h * 128 + 64 + lane] = f2b(o1 * r * gsub[64 + lane]);
}
__global__ void k_ref_pool(const bf16* __restrict__ PROJ, bf16* XY) {
    const int i = blockIdx.x * blockDim.x + threadIdx.x; if (i >= T * 512) return; const int t = i >> 9, j = i & 511; const int g = j >> 7, w = 2 << g, s = t % S;
    const int cnt = min(s + 1, w); float a = 0.f;
    for (int k = 0; k < cnt; ++k) a += bf2f(PROJ[(size_t)(t - k) * 3584 + j]);
    XY[(size_t)t * 2560 + j] = f2b(a / (float)cnt - bf2f(PROJ[(size_t)t * 3584 + j]));
}
__global__ void __launch_bounds__(256) k_ref_gemm2(const float* __restrict__ x, const float* __restrict__ SS, const float* __restrict__ g, const float* __restrict__ w_in_l,
                                                   const float* __restrict__ w_branch_l, const bf16* __restrict__ XY, bf16* MERGED) {
    __shared__ float sA[16][65], sB[16][65];
    const int tx = threadIdx.x & 15, ty = threadIdx.x >> 4, t0 = blockIdx.y * 64, n0 = blockIdx.x * 64;
    float mg[4][4] = {};
    for (int n = 0; n < 3; ++n) {
        float ag[4][4] = {}, ab[4][4] = {};
        for (int pass = 0; pass < 2; ++pass) {
            const int K = pass == 0 ? 1024 : 512;
            for (int k0 = 0; k0 < K; k0 += 16) {
                for (int e = threadIdx.x; e < 1024; e += 256) { const int r = e >> 4, kk = e & 15; const int t = t0 + r, k = k0 + kk;
                    sA[kk][r] = pass == 0 ? x[(size_t)t * 1024 + k] * SS[t] * g[k] : bf2f(XY[(size_t)t * 2560 + 512 * n + k]); }
                for (int e = threadIdx.x; e < 1024; e += 256) { const int kk = e >> 6, c = e & 63; const int k = k0 + kk;
                    sB[kk][c] = pass == 0 ? w_in_l[(size_t)k * INW + 3592 + n * 1024 + n0 + c] : w_branch_l[((size_t)n * 512 + k) * 1024 + n0 + c]; }
                __syncthreads();
#pragma unroll
                for (int kk = 0; kk < 16; ++kk) {
                    float a[4], b[4];
#pragma unroll
                    for (int i = 0; i < 4; ++i) { a[i] = sA[kk][ty * 4 + i]; b[i] = sB[kk][tx * 4 + i]; }
#pragma unroll
                    for (int i = 0; i < 4; ++i)
#pragma unroll
                        for (int j = 0; j < 4; ++j) { if (pass == 0) ag[i][j] += a[i] * b[j]; else ab[i][j] += a[i] * b[j]; }
                }
                __syncthreads();
            }
        }
#pragma unroll
        for (int i = 0; i < 4; ++i)
#pragma unroll
            for (int j = 0; j < 4; ++j) mg[i][j] += ab[i][j] / (1.0f + expf(-ag[i][j]));
    }
#pragma unroll
    for (int i = 0; i < 4; ++i)
#pragma unroll
        for (int j = 0; j < 4; ++j) MERGED[(size_t)(t0 + ty * 4 + i) * 1024 + n0 + tx * 4 + j] = f2b(mg[i][j]);
}
__global__ void __launch_bounds__(256) k_ref_moe(float* X, const float* __restrict__ SS, const float* __restrict__ g, const int* __restrict__ cls_cnt, const int* __restrict__ LIST,
                                                 const float* __restrict__ TOKW, const float* __restrict__ wg_l, const float* __restrict__ wu_l, const float* __restrict__ wd_l) {
    __shared__ float h[8][1024]; __shared__ float act[8][512]; __shared__ int tok[8];
    const int cls = blockIdx.y, n_c = cls_cnt[cls], base = blockIdx.x * 8; if (base >= n_c) return;
    const int nt = min(8, n_c - base), tid = threadIdx.x;
    if (tid < 8) tok[tid] = tid < nt ? LIST[(size_t)cls * T + base + tid] : -1;
    __syncthreads();
    for (int e = tid; e < 8 * 1024; e += 256) { const int i = e >> 10, k = e & 1023; const int t = tok[i]; h[i][k] = t >= 0 ? X[(size_t)t * 1024 + k] * SS[t] * g[k] : 0.f; }
    __syncthreads();
    const int grp = cls / 6, pr = cls % 6; const int pa = pr < 3 ? 0 : (pr < 5 ? 1 : 2), pb = pr < 3 ? pr + 1 : (pr < 5 ? pr - 1 : 3); const int ea = grp * 4 + pa, eb = grp * 4 + pb;
    for (int s = 0; s < 2; ++s) { const int e = s ? eb : ea; float ga[8], ua[8];
#pragma unroll
        for (int i = 0; i < 8; ++i) { ga[i] = 0.f; ua[i] = 0.f; }
        const float* wg = wg_l + (size_t)e * 1024 * 256 + tid; const float* wu = wu_l + (size_t)e * 1024 * 256 + tid;
        for (int k = 0; k < 1024; ++k) { const float a = wg[(size_t)k * 256], u = wu[(size_t)k * 256];
#pragma unroll
            for (int i = 0; i < 8; ++i) { ga[i] += h[i][k] * a; ua[i] += h[i][k] * u; } }
#pragma unroll
        for (int i = 0; i < 8; ++i) { const int t = tok[i]; const float w = t >= 0 ? TOKW[(size_t)t * 4 + s] : 0.f; act[i][s * 256 + tid] = ga[i] / (1.0f + expf(-ga[i])) * ua[i] * w; } }
    __syncthreads();
    for (int j = 0; j < 4; ++j) { const int n = tid + 256 * j; float y[8];
#pragma unroll
        for (int i = 0; i < 8; ++i) y[i] = 0.f;
        for (int s = 0; s < 2; ++s) { const int e = s ? eb : ea; const float* wd = wd_l + (size_t)e * 256 * 1024 + n;
            for (int f = 0; f < 256; ++f) { const float w = wd[(size_t)f * 1024];
#pragma unroll
                for (int i = 0; i < 8; ++i) y[i] += act[i][s * 256 + f] * w; } }
#pragma unroll
        for (int i = 0; i < 8; ++i) { const int t = tok[i]; if (t >= 0) X[(size_t)t * 1024 + n] += y[i]; } }
}
__global__ void __launch_bounds__(256) k_ref_ple(const float* __restrict__ x, const float* __restrict__ SS, const float* __restrict__ g, const float* __restrict__ wgate_l,
                                                 const float* __restrict__ p_l, const float* __restrict__ wple_l, float* xo) {
    __shared__ float sA[16][65], sB[16][65];
    const int tx = threadIdx.x & 15, ty = threadIdx.x >> 4, t0 = blockIdx.y * 64, n0 = blockIdx.x * 64;
    float ag[4][4] = {}, ab[4][4] = {};
    for (int pass = 0; pass < 2; ++pass) {
        const int K = pass == 0 ? 1024 : 256;
        for (int k0 = 0; k0 < K; k0 += 16) {
            for (int e = threadIdx.x; e < 1024; e += 256) { const int r = e >> 4, kk = e & 15; const int t = t0 + r, k = k0 + kk;
                sA[kk][r] = pass == 0 ? x[(size_t)t * 1024 + k] * SS[t] * g[k] : p_l[(size_t)t * 256 + k]; }
            for (int e = threadIdx.x; e < 1024; e += 256) { const int kk = e >> 6, c = e & 63; const int k = k0 + kk;
                sB[kk][c] = pass == 0 ? wgate_l[(size_t)k * 1024 + n0 + c] : wple_l[(size_t)k * 1024 + n0 + c]; }
            __syncthreads();
#pragma unroll
            for (int kk = 0; kk < 16; ++kk) {
                float a[4], b[4];
#pragma unroll
                for (int i = 0; i < 4; ++i) { a[i] = sA[kk][ty * 4 + i]; b[i] = sB[kk][tx * 4 + i]; }
#pragma unroll
                for (int i = 0; i < 4; ++i)
#pragma unroll
                    for (int j = 0; j < 4; ++j) { if (pass == 0) ag[i][j] += a[i] * b[j]; else ab[i][j] += a[i] * b[j]; }
            }
            __syncthreads();
        }
    }
#pragma unroll
    for (int i = 0; i < 4; ++i)
#pragma unroll
        for (int j = 0; j < 4; ++j) { const size_t o = (size_t)(t0 + ty * 4 + i) * 1024 + n0 + tx * 4 + j; xo[o] = x[o] + ab[i][j] / (1.0f + expf(-ag[i][j])); }
}
}
__device__ __forceinline__ int route_decide(const float (&dg)[4], const float (&de)[16], const float rstd, const float* __restrict__ brg, const float* __restrict__ bre, float& wa, float& wb) {
    float lg[4]; int gi = 0; float lmax;
#pragma unroll
    for (int e = 0; e < 4; ++e) lg[e] = rstd * dg[e] + brg[e];
    lmax = lg[0];
#pragma unroll
    for (int e = 1; e < 4; ++e) if (lg[e] > lmax) { lmax = lg[e]; gi = e; }
    float den = 0.f;
#pragma unroll
    for (int e = 0; e < 4; ++e) den += expf(lg[e] - lmax);
    const float gp = 1.0f / den;
    float el[4] = {0.f, 0.f, 0.f, 0.f};
#pragma unroll
    for (int gg = 0; gg < 4; ++gg)
#pragma unroll
        for (int e = 0; e < 4; ++e) if (gg == gi) el[e] = rstd * de[gg * 4 + e] + bre[gg * 4 + e];
    int i1 = 0; float m1 = el[0];
#pragma unroll
    for (int e = 1; e < 4; ++e) if (el[e] > m1) { m1 = el[e]; i1 = e; }
    int i2 = -1; float m2 = -INFINITY;
#pragma unroll
    for (int e = 0; e < 4; ++e) if (e != i1 && el[e] > m2) { m2 = el[e]; i2 = e; }
    const float r2 = expf(m2 - m1); const float w1 = gp / (1.0f + r2), w2 = gp * r2 / (1.0f + r2);
    const int a = min(i1, i2), b = max(i1, i2); const int pr = (a == 0) ? (b - 1) : ((a == 1) ? (b + 1) : 5); const int cls = gi * 6 + pr;
    wa = i1 == a ? w1 : w2; wb = i1 == a ? w2 : w1;
    return cls;
}
__device__ __forceinline__ int route_core(int t, int lane, const float* __restrict__ X, const float* __restrict__ g, const float* __restrict__ wrg, const float* __restrict__ brg,
                                          const float* __restrict__ wre, const float* __restrict__ bre, float* TOKW) {
    float ss = 0.f, dg[4] = {0.f, 0.f, 0.f, 0.f}, de[16];
#pragma unroll
    for (int e = 0; e < 16; ++e) de[e] = 0.f;
#pragma unroll 4
    for (int i = 0; i < 16; ++i) { const int k = lane + 64 * i; const float xv = X[(size_t)t * 1024 + k]; ss += xv * xv; const float h = xv * g[k];
        const float4 a = *(const float4*)(wrg + (size_t)k * 4); dg[0] += h * a.x; dg[1] += h * a.y; dg[2] += h * a.z; dg[3] += h * a.w;
#pragma unroll
        for (int q = 0; q < 4; ++q) { const float4 b = *(const float4*)(wre + (size_t)k * 16 + 4 * q); de[4 * q] += h * b.x; de[4 * q + 1] += h * b.y; de[4 * q + 2] += h * b.z; de[4 * q + 3] += h * b.w; } }
    ss = refp::wsum(ss);
#pragma unroll
    for (int e = 0; e < 4; ++e) dg[e] = refp::wsum(dg[e]);
#pragma unroll
    for (int e = 0; e < 16; ++e) de[e] = refp::wsum(de[e]);
    const float rstd = rsqrtf(ss * (1.0f / 1024.0f) + RMS_EPS);
    float wa, wb; const int cls = route_decide(dg, de, rstd, brg, bre, wa, wb);
    if (lane == 0) *(float4*)(TOKW + (size_t)t * 4) = make_float4(wa, wb, rstd, 0.f);
    return cls;
}
__device__ __forceinline__ void route_token(int t, int lane, const float* __restrict__ X, const float* __restrict__ g, const float* __restrict__ wrg, const float* __restrict__ brg,
                                            const float* __restrict__ wre, const float* __restrict__ bre, unsigned* cls_cnt, int* LIST, float* TOKW) {
    const int cls = route_core(t, lane, X, g, wrg, brg, wre, bre, TOKW);
    if (lane == 0) { const unsigned pos = atomicAdd(cls_cnt + cls, 1u); LIST[(size_t)cls * T + pos] = t; }
}
__global__ void __launch_bounds__(256) k_route(const float* X, const float* g, const float* wrg, const float* brg, const float* wre, const float* bre, unsigned* cls_cnt, int* LIST, float* TOKW) {
    const int t = blockIdx.x * 4 + (threadIdx.x >> 6);
    route_token(t, threadIdx.x & 63, X, g, wrg, brg, wre, bre, cls_cnt, LIST, TOKW);
}

namespace pg8 {
#define PG8_LAS __attribute__((address_space(3)))
typedef short bf16x8 __attribute__((ext_vector_type(8)));
typedef float f32x4 __attribute__((ext_vector_type(4)));
typedef unsigned u32x4 __attribute__((ext_vector_type(4)));
typedef int i32x4 __attribute__((ext_vector_type(4)));
typedef int i32x8 __attribute__((ext_vector_type(8)));
__device__ __forceinline__ i32x8 cat8(bf16x8 lo, bf16x8 hi) { const i32x4 a = __builtin_bit_cast(i32x4, lo), b = __builtin_bit_cast(i32x4, hi); return __builtin_shufflevector(a, b, 0, 1, 2, 3, 4, 5, 6, 7); }
constexpr int BM = 256, BK = 64, HALF = 128, HTB = HALF * BK * 2, STAGE_BYTES = 8 * HTB;

__host__ __device__ __forceinline__ int lds_byte(int r, int c) { const int st = (r >> 4) * 2 + (c >> 5), rr = r & 15, cc = c & 31, ob = rr * 64 + cc * 2; return st * 1024 + (ob ^ (((ob >> 9) & 1) << 5)); }
__host__ __device__ __forceinline__ void stage_rc(int b, int& R, int& C) { const int st = b / 1024, sb = b % 1024, swz = sb ^ (((sb >> 9) & 1) << 5); R = (st >> 1) * 16 + swz / 64; C = (st & 1) * 32 + (swz % 64) / 2; }
__host__ __device__ __forceinline__ int perm32(int rho) { const int n = rho >> 4, i = rho & 15; return 8 * (i >> 2) + 4 * n + (i & 3); }

struct Step { const char* A; const char* B; const int* rows; int nt, pm, pn, aux, nvalid, zero_after; };
__device__ __forceinline__ int rfl(int v) { return __builtin_amdgcn_readfirstlane(v); }
template <class P> __device__ __forceinline__ P rflp(P p) { const unsigned long long u = (unsigned long long)p; const unsigned lo = (unsigned)__builtin_amdgcn_readfirstlane((int)(unsigned)u), hi = (unsigned)__builtin_amdgcn_readfirstlane((int)(unsigned)(u >> 32)); return (P)(((unsigned long long)hi << 32) | lo); }
__device__ __forceinline__ void step_uniform(Step& s, int& ok) {
    s.A = rflp(s.A); s.B = rflp(s.B); s.rows = rflp(s.rows); s.nt = rfl(s.nt); s.pm = rfl(s.pm); s.pn = rfl(s.pn); s.aux = rfl(s.aux); s.nvalid = rfl(s.nvalid); s.zero_after = rfl(s.zero_after); ok = rfl(ok);
    asm volatile("" : "+s"(ok), "+s"(s.A), "+s"(s.B), "+s"(s.nt), "+s"(s.aux));
}

template <class Sched, class Epi, bool GATHER, bool ALIGN_EPI, bool F8 = false>
__device__ __forceinline__ void gemm_phase(const int tid, PG8_LAS unsigned char* lds, const unsigned lda, const unsigned ldb, const Sched& S, const Epi& E) {
    const int wid = __builtin_amdgcn_readfirstlane(tid >> 6), lane = tid & 63, wr = wid >> 2, wc = wid & 3, fr = lane & 15, fq = lane >> 4;
    int Rr[2], Cc[2]; unsigned voffB[2], cOA[2][2], nOA[2][2];
#pragma unroll
    for (int i = 0; i < 2; ++i) { stage_rc(tid * 16 + i * 8192, Rr[i], Cc[i]); const int Rb = (Rr[i] & ~31) + perm32(Rr[i] & 31); voffB[i] = (unsigned)Rb * ldb + (unsigned)Cc[i] * 2u; }
    const size_t kstep = (size_t)(BK * 2);
    const size_t hstepB = (size_t)HALF * ldb;
    const unsigned ldsw = (unsigned)wid * 1024u;
    const int aoff = lds_byte(wr * 64 + fr, fq * 8), boff = lds_byte(wc * 32 + fr, fq * 8);
#define PG8_SA(b, h) (((b) * 2 + (h)) * HTB)
#define PG8_SB(b, h) ((4 + (b) * 2 + (h)) * HTB)
#define PG8_STAGE_B(bufoff, gbase) do { _Pragma("unroll") for (int _i = 0; _i < 2; ++_i) \
        __builtin_amdgcn_global_load_lds((const unsigned*)((const char*)(gbase) + voffB[_i]), (PG8_LAS unsigned*)(lds + (bufoff) + ldsw + _i * 8192), 16, 0, 0); } while (0)
#define PG8_STAGE_A(bufoff, gbase, o0, o1) do { \
        __builtin_amdgcn_global_load_lds((const unsigned*)((const char*)(gbase) + (o0)), (PG8_LAS unsigned*)(lds + (bufoff) + ldsw), 16, 0, 0); \
        __builtin_amdgcn_global_load_lds((const unsigned*)((const char*)(gbase) + (o1)), (PG8_LAS unsigned*)(lds + (bufoff) + ldsw + 8192), 16, 0, 0); } while (0)
#define PG8_LDA(dst, b, h) do { _Pragma("unroll") for (int m = 0; m < 4; ++m) _Pragma("unroll") for (int k = 0; k < 2; ++k) dst[m][k] = *(const PG8_LAS bf16x8*)(lds + PG8_SA(b, h) + aoff + m * 2048 + k * 1024); } while (0)
#define PG8_LDB(dst, b, h) do { _Pragma("unroll") for (int n = 0; n < 2; ++n) _Pragma("unroll") for (int k = 0; k < 2; ++k) dst[n][k] = *(const PG8_LAS bf16x8*)(lds + PG8_SB(b, h) + boff + n * 2048 + k * 1024); } while (0)
#define PG8_MMA(ai, bj, At, Bt) do { __builtin_amdgcn_s_setprio(1); \
        if constexpr (F8) { _Pragma("unroll") for (int m = 0; m < 4; ++m) _Pragma("unroll") for (int n = 0; n < 2; ++n) \
            asm volatile("v_mfma_scale_f32_16x16x128_f8f6f4 %0, %1, %2, %0, %3, %3 op_sel_hi:[0,0,0]" : "+v"(acc[ai][bj][m][n]) : "v"(cat8(Bt[n][0], Bt[n][1])), "v"(cat8(At[m][0], At[m][1])), "v"(f8scale)); } \
        else { _Pragma("unroll") for (int m = 0; m < 4; ++m) _Pragma("unroll") for (int n = 0; n < 2; ++n) _Pragma("unroll") for (int k = 0; k < 2; ++k) \
            acc[ai][bj][m][n] = __builtin_amdgcn_mfma_f32_16x16x32_bf16(Bt[n][k], At[m][k], acc[ai][bj][m][n], 0, 0, 0); } \
        __builtin_amdgcn_s_setprio(0); } while (0)
#define PG8_WAIT_V(n) asm volatile("s_waitcnt vmcnt(" #n ")" ::: "memory")
#define PG8_WAIT_L(n) asm volatile("s_waitcnt lgkmcnt(" #n ")" ::: "memory")
#define PG8_BAR __builtin_amdgcn_s_barrier()
#define PG8_SCHED __builtin_amdgcn_sched_barrier(0)
#define PG8_AOFFS(dst, st) do { _Pragma("unroll") for (int _h = 0; _h < 2; ++_h) _Pragma("unroll") for (int _i = 0; _i < 2; ++_i) { \
        int _row = Rr[_i] + 128 * _h; if (GATHER) { _row = (st).rows[_row]; _row = _row < 0 ? 0 : _row; } \
        dst[_h][_i] = (unsigned)_row * lda + (unsigned)Cc[_i] * 2u; } } while (0)
    int f8scale = 0x7F7F7F7F; if constexpr (F8) asm volatile("" : "+v"(f8scale));
    Step cur, nxt; int ui = 0;
    { int ok_ = S.next(0, cur) ? 1 : 0; step_uniform(cur, ok_); if (!ok_) return; }
    f32x4 acc[2][2][4][2];
#pragma unroll
    for (int a = 0; a < 2; ++a)
#pragma unroll
        for (int b = 0; b < 2; ++b)
#pragma unroll
            for (int m = 0; m < 4; ++m)
#pragma unroll
                for (int n = 0; n < 2; ++n) acc[a][b][m][n] = (f32x4){0.f, 0.f, 0.f, 0.f};
    bf16x8 At[4][2], B0[2][2], B1[2][2];
    PG8_AOFFS(cOA, cur);
    const char* cA = cur.A; const char* cB = cur.B;
    PG8_STAGE_B(PG8_SB(0, 0), cB); PG8_STAGE_B(PG8_SB(0, 1), cB + hstepB); PG8_STAGE_A(PG8_SA(0, 0), cA, cOA[0][0], cOA[0][1]); PG8_STAGE_A(PG8_SA(0, 1), cA, cOA[1][0], cOA[1][1]);
    if (wr == 1) PG8_BAR;
    PG8_WAIT_V(2); PG8_BAR;
    PG8_STAGE_B(PG8_SB(1, 0), cB + kstep); PG8_STAGE_A(PG8_SA(1, 0), cA + kstep, cOA[0][0], cOA[0][1]); PG8_STAGE_B(PG8_SB(1, 1), cB + hstepB + kstep);
    PG8_WAIT_V(6); PG8_BAR;
#pragma clang loop unroll(disable)
    for (;;) {
        bool has_next = S.next(ui + 1, nxt);
        { int hn_ = has_next ? 1 : 0; step_uniform(nxt, hn_); has_next = hn_ != 0; }
        asm volatile("" : "+v"(voffB[0]), "+v"(voffB[1]));
        const char* nA = has_next ? nxt.A : cA; const char* nB = has_next ? nxt.B : cB;
        if (GATHER) { if (has_next) { PG8_AOFFS(nOA, nxt); } else {
#pragma unroll
            for (int _h = 0; _h < 2; ++_h)
#pragma unroll
                for (int _i = 0; _i < 2; ++_i) nOA[_h][_i] = cOA[_h][_i]; } }
        const int nt = cur.nt;
#pragma clang loop unroll(disable)
        for (int t = 0; t < nt; t += 2) {
            const bool last = (t == nt - 2);
            const char* a1 = cA + (size_t)(t + 1) * kstep;
            const char* a2 = last ? nA : cA + (size_t)(t + 2) * kstep; const char* b2 = last ? nB : cB + (size_t)(t + 2) * kstep;
            const char* a3 = a2 + kstep; const char* b3 = b2 + kstep;
            unsigned o00, o01, o10, o11;
            if (GATHER) { o00 = last ? nOA[0][0] : cOA[0][0]; o01 = last ? nOA[0][1] : cOA[0][1]; o10 = last ? nOA[1][0] : cOA[1][0]; o11 = last ? nOA[1][1] : cOA[1][1]; }
            else { o00 = cOA[0][0]; o01 = cOA[0][1]; o10 = cOA[1][0]; o11 = cOA[1][1]; }
            PG8_LDB(B0, 0, 0); PG8_LDB(B1, 0, 1); PG8_SCHED; PG8_LDA(At, 0, 0); PG8_STAGE_A(PG8_SA(1, 1), a1, cOA[1][0], cOA[1][1]);
            PG8_WAIT_V(8); PG8_WAIT_L(0); PG8_BAR; PG8_MMA(0, 0, At, B0); PG8_MMA(0, 1, At, B1); PG8_BAR; PG8_SCHED;
            PG8_LDA(At, 0, 1); PG8_STAGE_B(PG8_SB(0, 0), b2); PG8_STAGE_B(PG8_SB(0, 1), b2 + hstepB); PG8_STAGE_A(PG8_SA(0, 0), a2, o00, o01);
            PG8_WAIT_V(8); PG8_WAIT_L(0); PG8_BAR; PG8_MMA(1, 0, At, B0); PG8_MMA(1, 1, At, B1); PG8_BAR; PG8_SCHED;
            PG8_LDB(B0, 1, 0); PG8_LDB(B1, 1, 1); PG8_SCHED; PG8_LDA(At, 1, 0); PG8_STAGE_A(PG8_SA(0, 1), a2, o10, o11);
            PG8_WAIT_V(8); PG8_WAIT_L(0); PG8_BAR; PG8_MMA(0, 0, At, B0); PG8_MMA(0, 1, At, B1); PG8_BAR; PG8_SCHED;
            PG8_LDA(At, 1, 1); PG8_STAGE_B(PG8_SB(1, 0), b3); PG8_STAGE_B(PG8_SB(1, 1), b3 + hstepB); PG8_STAGE_A(PG8_SA(1, 0), a3, o00, o01);
            PG8_WAIT_V(8); PG8_WAIT_L(0); PG8_BAR; PG8_MMA(1, 0, At, B0); PG8_MMA(1, 1, At, B1); PG8_BAR; PG8_SCHED;
        }
        if constexpr (F8) { asm volatile("s_nop 15\n\ts_nop 15" ::: "memory"); }
        if constexpr (ALIGN_EPI) { if (wr == 0) PG8_BAR; }
        { int ln_; asm volatile("v_mbcnt_lo_u32_b32 %0, -1, 0\n\tv_mbcnt_hi_u32_b32 %0, -1, %0" : "=v"(ln_));
          E(acc, cur, wr, wc, ln_ & 15, ln_ >> 4); }
        if (!has_next) break;
        if (cur.zero_after) {
#pragma unroll
            for (int a = 0; a < 2; ++a)
#pragma unroll
                for (int b = 0; b < 2; ++b)
#pragma unroll
                    for (int m = 0; m < 4; ++m)
#pragma unroll
                        for (int n = 0; n < 2; ++n) acc[a][b][m][n] = (f32x4){0.f, 0.f, 0.f, 0.f};
        }
        cur = nxt; cA = nA; cB = nB; ++ui;
        if (GATHER) {
#pragma unroll
            for (int _h = 0; _h < 2; ++_h)
#pragma unroll
                for (int _i = 0; _i < 2; ++_i) cOA[_h][_i] = nOA[_h][_i]; }
        if constexpr (ALIGN_EPI) { if (wr == 1) PG8_BAR; }
    }
    PG8_WAIT_V(0);
    if constexpr (!ALIGN_EPI) { if (wr == 0) PG8_BAR; }
    PG8_BAR;
#undef PG8_SA
#undef PG8_SB
#undef PG8_STAGE_A
#undef PG8_STAGE_B
#undef PG8_LDA
#undef PG8_LDB
#undef PG8_MMA
#undef PG8_WAIT_V
#undef PG8_WAIT_L
#undef PG8_BAR
#undef PG8_SCHED
#undef PG8_AOFFS
}
}
#include <hip/hip_bf16.h>
namespace attn_body {
using hbf16=__hip_bfloat16;
using bf16x8=__attribute__((ext_vector_type(8)))short;
using s16x4=__attribute__((ext_vector_type(4)))short;
using f32x16=__attribute__((ext_vector_type(16)))float;
using u32x4=__attribute__((ext_vector_type(4)))unsigned;
constexpr int SEQ=2048,D=64,DM=3584;
constexpr int NW=8,QBLK=32,QB=QBLK*NW,KVBLK=64,NQB=SEQ/QB;
__device__ __forceinline__ int crow(int r,int hi){return (r&3)+8*(r>>2)+4*hi;}
#define SBAR() __builtin_amdgcn_sched_barrier(0)
__device__ __forceinline__ void cmask(f32x16&p0,f32x16&p1,int jb,int qrel,int hi){
  const float NEG=-INFINITY; int kb=64*jb+4*hi;
  #pragma unroll
  for(int r=0;r<16;++r){int kv=kb+(r&3)+8*(r>>2); if(kv>qrel)p0[r]=NEG; if(kv+32>qrel)p1[r]=NEG;}
}

constexpr int NSLOT=3, SLOTB=8192;
constexpr int LDS_K=0, LDS_V=NSLOT*SLOTB, LDS_WS=2*NSLOT*SLOTB, LDS_OST=LDS_WS+NW*64*4, LDS_BIAS=LDS_OST+NW*4096, LDS_SSQ=LDS_BIAS+SEQ*4, LDS_BYTES=LDS_SSQ+NW*32*4;
constexpr float C2=0.125f*1.4426950408889634f;
__device__ __forceinline__ void glds16(const void*gsrc,unsigned lds_dst){unsigned keep;
  asm volatile("s_mov_b32 %0, m0\n\ts_mov_b32 m0, %2\n\ts_nop 0\n\tglobal_load_lds_dwordx4 %1, off\n\ts_mov_b32 m0, %0":"=&s"(keep):"v"(gsrc),"s"(lds_dst):"memory");}
__device__ __forceinline__ float max3f(float a,float b,float c){float r;asm("v_max3_f32 %0, %1, %2, %3":"=v"(r):"v"(a),"v"(b),"v"(c));return r;}
__device__ __forceinline__ float max2f(float a,float b){float r;asm("v_max_f32_e32 %0, %1, %2":"=v"(r):"v"(a),"v"(b));return r;}
__device__ __forceinline__ float fadd_s(float a,float b){float r;asm("v_add_f32_e32 %0, %1, %2":"=v"(r):"v"(a),"v"(b));return r;}
__device__ __forceinline__ float fsub_s(float a,float b){float r;asm("v_sub_f32_e32 %0, %1, %2":"=v"(r):"v"(a),"v"(b));return r;}
typedef float f32x2_t __attribute__((ext_vector_type(2))); typedef float f32x4_t __attribute__((ext_vector_type(4))); typedef __bf16 bf16x2_t __attribute__((ext_vector_type(2)));
__device__ __forceinline__ unsigned cvtpk_s(float lo,float hi){f32x2_t v={lo,hi};bf16x2_t b=__builtin_convertvector(v,bf16x2_t);return __builtin_bit_cast(unsigned,b);}
#define WAIT_BAR(N) asm volatile("s_waitcnt vmcnt(" #N ") lgkmcnt(0)\n\ts_barrier":::"memory")

__device__ __forceinline__ void qkt(f32x16&p0,f32x16&p1,const char*Kslot,const bf16x8*qr,const f32x16&negm,int r32,int hi){
  const char*kb=Kslot+hi*1024+r32*16;
  #pragma unroll
  for(int d0=0;d0<4;++d0){
    const bf16x8 b0=*reinterpret_cast<const bf16x8*>(kb+d0*2048);
    const bf16x8 b1=*reinterpret_cast<const bf16x8*>(kb+d0*2048+512);
    if(d0==0){p0=__builtin_amdgcn_mfma_f32_32x32x16_bf16(b0,qr[0],negm,0,0,0);p1=__builtin_amdgcn_mfma_f32_32x32x16_bf16(b1,qr[0],negm,0,0,0);}
    else{p0=__builtin_amdgcn_mfma_f32_32x32x16_bf16(b0,qr[d0],p0,0,0,0);p1=__builtin_amdgcn_mfma_f32_32x32x16_bf16(b1,qr[d0],p1,0,0,0);}}
}
typedef __attribute__((address_space(3))) const char* lds_cptr;
typedef short v4i16_t __attribute__((ext_vector_type(4)));
__device__ __forceinline__ void kload8(bf16x8*kf,lds_cptr kp){
  kf[0]=*(const __attribute__((address_space(3))) bf16x8*)(kp);      kf[1]=*(const __attribute__((address_space(3))) bf16x8*)(kp+512);
  kf[2]=*(const __attribute__((address_space(3))) bf16x8*)(kp+2048); kf[3]=*(const __attribute__((address_space(3))) bf16x8*)(kp+2560);
  kf[4]=*(const __attribute__((address_space(3))) bf16x8*)(kp+4096); kf[5]=*(const __attribute__((address_space(3))) bf16x8*)(kp+4608);
  kf[6]=*(const __attribute__((address_space(3))) bf16x8*)(kp+6144); kf[7]=*(const __attribute__((address_space(3))) bf16x8*)(kp+6656);
}
__device__ __forceinline__ void kload2(bf16x8*kf,lds_cptr kp,int j){ kf[2*j]=*(const __attribute__((address_space(3))) bf16x8*)(kp+j*2048); kf[2*j+1]=*(const __attribute__((address_space(3))) bf16x8*)(kp+j*2048+512); }
__device__ __forceinline__ s16x4 vtr(lds_cptr p){ return __builtin_bit_cast(s16x4,__builtin_amdgcn_ds_read_tr16_b64_v4i16((__attribute__((address_space(3))) v4i16_t*)p)); }
__device__ __forceinline__ float rowmax(const f32x16&p0,const f32x16&p1){
  float a=max3f(p0[0],p0[1],p1[0]),b=max3f(p0[2],p0[3],p1[1]);a=max3f(a,p1[2],p1[3]);
  #pragma unroll
  for(int r=4;r<16;r+=4){a=max3f(a,p0[r],p0[r+1]);b=max3f(b,p0[r+2],p0[r+3]);a=max3f(a,p1[r],p1[r+1]);b=max3f(b,p1[r+2],p1[r+3]);}
  const float m=max2f(a,b);
  auto rr=__builtin_amdgcn_permlane32_swap(__float_as_uint(m),__float_as_uint(m),false,false);
  return max2f(__uint_as_float(rr[0]),__uint_as_float(rr[1]));
}
__device__ __forceinline__ void pv(f32x16*o,int vb,bf16x8 pa0,bf16x8 pa1,bf16x8 pa2,bf16x8 pa3){
  #pragma unroll
  for(int d0=0;d0<2;++d0){s16x4 lo[4],hi[4];
    #pragma unroll
    for(int ks=0;ks<4;++ks){
      asm volatile("ds_read_b64_tr_b16 %0,%1 offset:%c2":"=&v"(lo[ks]):"v"(vb),"i"(d0*4096+ks*1024):"memory");
      asm volatile("ds_read_b64_tr_b16 %0,%1 offset:%c2":"=&v"(hi[ks]):"v"(vb),"i"(d0*4096+ks*1024+512):"memory");}
    asm volatile("s_waitcnt lgkmcnt(0)":::"memory");SBAR();
    #define PK(k) (bf16x8){lo[k][0],lo[k][1],lo[k][2],lo[k][3],hi[k][0],hi[k][1],hi[k][2],hi[k][3]}
    o[d0]=__builtin_amdgcn_mfma_f32_32x32x16_bf16(pa0,PK(0),o[d0],0,0,0);
    o[d0]=__builtin_amdgcn_mfma_f32_32x32x16_bf16(pa1,PK(1),o[d0],0,0,0);
    o[d0]=__builtin_amdgcn_mfma_f32_32x32x16_bf16(pa2,PK(2),o[d0],0,0,0);
    o[d0]=__builtin_amdgcn_mfma_f32_32x32x16_bf16(pa3,PK(3),o[d0],0,0,0);
    #undef PK
  }
}

#ifndef ATTN_STORE16
#define ATTN_STORE16(p,v) (*(u32x4*)(p)=(v))
#endif
struct AttnP { const bf16* Q; const bf16* K; const bf16* V; bf16* out; bf16* stash; const float* gsub; const float* logf; int opitch; float lam, nscale; };
template<int THRL,bool FOX> __device__ __forceinline__ void attn_unit(const int tid_in,int b,int qb,const int MODE,const AttnP&P,char*shm){
  int tid=tid_in; asm volatile("":"+v"(tid));
  const int lane=tid&63,r32=lane&31,hi=lane>>5; const int wid=__builtin_amdgcn_readfirstlane(tid>>6);
  const long rowbase=(long)b*SEQ; const int q0=qb*QB;
  const bf16*Qw=P.Q+(rowbase+q0+wid*QBLK)*DM;
  const bf16*Kh=P.K+rowbase*DM,*Vh=P.V+rowbase*DM;
  const unsigned lds0=(unsigned)(uintptr_t)shm;
  float*wsf=(float*)(shm+LDS_WS)+wid*64;
  const float*biasL=(const float*)(shm+LDS_BIAS);
  #define BIAS(P0,P1,t) do{ if(FOX){ const float*bb_=biasL+64*(t)+4*hi; _Pragma("unroll") for(int g_=0;g_<4;++g_){ const f32x4_t b0_=*(const f32x4_t*)(bb_+8*g_), b1_=*(const f32x4_t*)(bb_+32+8*g_); \
      _Pragma("unroll") for(int e_=0;e_<4;++e_){ P0[4*g_+e_]+=b0_[e_]; P1[4*g_+e_]+=b1_[e_]; } asm volatile("":::"memory"); } } }while(0)
  const bf16*ksrc=Kh+(long)lane*DM+wid*8;
  const bf16*vsrc=Vh+(long)(16*(wid&3)+(lane>>2))*DM+(wid>>2)*32+(lane&3)*8;
  const unsigned kdst=lds0+LDS_K+wid*1024, vdst=lds0+LDS_V+wid*1024;
  #define DMA_K(t,slot) glds16(ksrc+(long)(t)*KVBLK*DM,(unsigned)__builtin_amdgcn_readfirstlane(kdst+(slot)))
  #define DMA_V(t,slot) glds16(vsrc+(long)(t)*KVBLK*DM,(unsigned)__builtin_amdgcn_readfirstlane(vdst+(slot)))
  const int vb0=(int)(lds0+LDS_V)+((lane>>4)&1)*32+(lane&3)*8+(4*hi+((lane&15)>>2))*64;
  const char*Kbase=shm+LDS_K; bf16x8 kf[8];
  const lds_cptr shm3=(lds_cptr)shm; const lds_cptr kp0=shm3+LDS_K+hi*1024+r32*16; const lds_cptr vp0=shm3+LDS_V+((lane>>4)&1)*32+(lane&3)*8+(4*hi+((lane&15)>>2))*64;
  const int NT=(q0+QB)/KVBLK;
  DMA_K(0,0);DMA_V(0,0);DMA_K(1,SLOTB);
  bf16x8 qr[4];
  #pragma unroll
  for(int d0=0;d0<4;++d0)qr[d0]=*reinterpret_cast<const bf16x8*>(&Qw[(long)r32*DM+d0*16+hi*8]);
  float mhat=0.f,l_reg=0.f;f32x16 o[2];o[0]=f32x16{};o[1]=f32x16{};f32x16 negm=f32x16{};asm volatile("":"+v"(negm));
  const int qrel=wid*QBLK+r32;
  #define CMASK(P0,P1,t) do{int jb_=(t)-(NT-4); if(jb_>=0)cmask(P0,P1,jb_,qrel,hi);}while(0)
  bool resc=false;
  #define START(P0,P1) do{ const float rm=rowmax(P0,P1); resc=false; \
    { const float dl=rm; mhat=fadd_s(mhat,dl); \
      _Pragma("unroll") for(int r=0;r<16;++r){P0[r]=fsub_s(P0[r],dl);P1[r]=fsub_s(P1[r],dl);} \
      _Pragma("unroll") for(int r=0;r<16;++r)negm[r]=-mhat; asm volatile("":"+v"(negm)); } \
    _Pragma("unroll") for(int r=0;r<16;++r)P0[r]=__builtin_amdgcn_exp2f(P0[r]); }while(0)
  #define RESC() do{ if(resc){ asm volatile("s_waitcnt lgkmcnt(0)":::"memory"); \
      _Pragma("unroll") for(int d_=0;d_<2;++d_) _Pragma("unroll") for(int r=0;r<16;++r)o[d_][r]*=wsf[crow(r,hi)]; } }while(0)
  f32x16 pA0,pA1,pB0,pB1;
  int sl_prev=0,sl_cur=0,sl_next=SLOTB;
  #define ROT() do{sl_prev=sl_cur;sl_cur=sl_next;sl_next=(sl_next==(NSLOT-1)*SLOTB)?0:sl_next+SLOTB;}while(0)
  DMA_K(2,2*SLOTB);
  if(FOX){
    const int n=q0+QB; float v4[4]; float run=0.f;
    _Pragma("unroll") for(int i=0;i<4;++i){ const int sidx=4*tid+i; const float lv=(sidx<n)?P.logf[(rowbase+sidx)*8]:0.f; run+=lv; v4[i]=run; }
    float inc=run; _Pragma("unroll") for(int o_=1;o_<64;o_<<=1){ const float up=__int_as_float(__builtin_amdgcn_ds_bpermute((lane-o_)<<2,__float_as_int(inc))); if(lane>=o_)inc+=up; }
    float*wt=(float*)(shm+LDS_WS); if(lane==63)wt[wid]=inc; __syncthreads();
    float pre=inc-run; _Pragma("unroll") for(int w_=0;w_<NW;++w_){ if(w_<wid)pre+=wt[w_]; }
    float*bw=(float*)(shm+LDS_BIAS); _Pragma("unroll") for(int i=0;i<4;++i){ const int sidx=4*tid+i; if(sidx<n)bw[sidx]=-(pre+v4[i])*1.4426950408889634f; }
    __syncthreads(); }
  WAIT_BAR(3);
  qkt(pA0,pA1,Kbase,qr,negm,r32,hi);asm volatile("s_nop 15\n\ts_nop 7":"+v"(pA0),"+v"(pA1));BIAS(pA0,pA1,0);CMASK(pA0,pA1,0);
  START(pA0,pA1);
  _Pragma("unroll") for(int r=0;r<16;++r)pA1[r]=__builtin_amdgcn_exp2f(pA1[r]);
  WAIT_BAR(0);
  DMA_K(3,0);DMA_V(1,SLOTB);
  ROT();
  kload8(kf,kp0+sl_cur);
  WAIT_BAR(2);
  s16x4 vlo[8],vhi[8]; u32x4 pw0,pw1,pw2,pw3;
  #define PKW(P,B) cvtpk_s(P[B],P[B+1])
  #define PAF(k) __builtin_bit_cast(bf16x8,pw##k)
  #define VFR(i) (bf16x8){vlo[i][0],vlo[i][1],vlo[i][2],vlo[i][3],vhi[i][0],vhi[i][1],vhi[i][2],vhi[i][3]}
  #define PIN(x) asm volatile("":"+v"(x))
  #define MX3(a,b,c) __builtin_fmaxf(__builtin_fmaxf((a),(b)),(c))
  #define GAPA(MF,A0,A1,A2,A3,W0,W1,PW) do{ MF; sacc+=A0; sacc+=A1; sacc+=A2; sacc+=A3; PIN(sacc); W0; W1; PIN(PW); SBAR(); }while(0)
  #define EX(v) __builtin_amdgcn_exp2f(v)
  #define GAPB(MF,X,B) do{ MF; X[B]=EX(X[B]); X[B+1]=EX(X[B+1]); X[B+2]=EX(X[B+2]); X[B+3]=EX(X[B+3]); PIN(X); SBAR(); }while(0)
  #define VRD(i) do{ vlo[i]=vtr(vp_+(((i)>>2)*4096+((i)&3)*1024)); vhi[i]=vtr(vp_+(((i)>>2)*4096+((i)&3)*1024+512)); }while(0)
  #define KRD(G,j) do{ if(G){ kload2(kf,kp0+sl_next,j); SBAR(); } }while(0)
  #define STEP(C0,C1,P0,P1,t,GK,GV,GL) do{ SBAR(); \
    const lds_cptr vp_=vp0+sl_prev; \
    VRD(0); SBAR(); float sacc=(P0[0]+P0[1]); \
    GAPA(C0=__builtin_amdgcn_mfma_f32_32x32x16_bf16(kf[0],qr[0],negm,0,0,0), P0[2],P0[3],P0[4],P0[5],     pw0[0]=PKW(P0,0), pw0[1]=PKW(P0,2), pw0); \
    VRD(4); SBAR(); GAPA(C1=__builtin_amdgcn_mfma_f32_32x32x16_bf16(kf[1],qr[0],negm,0,0,0), P0[6],P0[7],P0[8],P0[9],     pw0[2]=PKW(P0,4), pw0[3]=PKW(P0,6), pw0); \
    VRD(1); SBAR(); GAPA(C0=__builtin_amdgcn_mfma_f32_32x32x16_bf16(kf[2],qr[1],C0,0,0,0),   P0[10],P0[11],P0[12],P0[13], pw1[0]=PKW(P0,8), pw1[1]=PKW(P0,10), pw1); \
    VRD(5); SBAR(); GAPA(C1=__builtin_amdgcn_mfma_f32_32x32x16_bf16(kf[3],qr[1],C1,0,0,0),   P0[14],P0[15],P1[0],P1[1],   pw1[2]=PKW(P0,12),pw1[3]=PKW(P0,14), pw1); \
    VRD(2); SBAR(); GAPA(C0=__builtin_amdgcn_mfma_f32_32x32x16_bf16(kf[4],qr[2],C0,0,0,0),   P1[2],P1[3],P1[4],P1[5],     pw2[0]=PKW(P1,0), pw2[1]=PKW(P1,2), pw2); \
    VRD(6); SBAR(); GAPA(C1=__builtin_amdgcn_mfma_f32_32x32x16_bf16(kf[5],qr[2],C1,0,0,0),   P1[6],P1[7],P1[8],P1[9],     pw2[2]=PKW(P1,4), pw2[3]=PKW(P1,6), pw2); \
    VRD(3); SBAR(); GAPA(C0=__builtin_amdgcn_mfma_f32_32x32x16_bf16(kf[6],qr[3],C0,0,0,0),   P1[10],P1[11],P1[12],P1[13], pw3[0]=PKW(P1,8), pw3[1]=PKW(P1,10), pw3); \
    VRD(7); SBAR(); GAPA(C1=__builtin_amdgcn_mfma_f32_32x32x16_bf16(kf[7],qr[3],C1,0,0,0),   P1[14],P1[15],0.f,0.f,       pw3[2]=PKW(P1,12),pw3[3]=PKW(P1,14), pw3); \
    l_reg+=sacc; \
    if(GK){DMA_K((t)+3,sl_cur);} if(GV){DMA_V((t)+1,sl_next);} \
    BIAS(C0,C1,t); CMASK(C0,C1,t); \
    { float a=MX3(C0[0],C0[1],C1[0]),b=MX3(C0[2],C0[3],C1[1]); a=MX3(a,C1[2],C1[3]); \
      _Pragma("unroll") for(int r=4;r<16;r+=4){a=MX3(a,C0[r],C0[r+1]);b=MX3(b,C0[r+2],C0[r+3]);a=MX3(a,C1[r],C1[r+1]);b=MX3(b,C1[r+2],C1[r+3]);} \
      float rm=__builtin_fmaxf(a,b); { auto rr=__builtin_amdgcn_permlane32_swap(__float_as_uint(rm),__float_as_uint(rm),false,false); rm=__builtin_fmaxf(__uint_as_float(rr[0]),__uint_as_float(rr[1])); } \
      resc=false; \
      if(__builtin_expect(__any(rm>(float)THRL),0)){ const float dl=__builtin_fmaxf(rm,0.f); mhat+=dl; \
        _Pragma("unroll") for(int r=0;r<16;++r){C0[r]-=dl;C1[r]-=dl;} \
        _Pragma("unroll") for(int r=0;r<16;++r)negm[r]=-mhat; asm volatile("":"+v"(negm)); \
        const float f=__builtin_amdgcn_exp2f(-dl); l_reg*=f; if(hi==0)wsf[r32]=f; resc=true; } } \
    SBAR(); \
    GAPB(o[0]=__builtin_amdgcn_mfma_f32_32x32x16_bf16(PAF(0),VFR(0),o[0],0,0,0), C0,0); \
    GAPB(o[1]=__builtin_amdgcn_mfma_f32_32x32x16_bf16(PAF(0),VFR(4),o[1],0,0,0), C0,4); \
    KRD(GL,0); GAPB(o[0]=__builtin_amdgcn_mfma_f32_32x32x16_bf16(PAF(1),VFR(1),o[0],0,0,0), C0,8); \
    KRD(GL,1); GAPB(o[1]=__builtin_amdgcn_mfma_f32_32x32x16_bf16(PAF(1),VFR(5),o[1],0,0,0), C0,12); \
    KRD(GL,2); GAPB(o[0]=__builtin_amdgcn_mfma_f32_32x32x16_bf16(PAF(2),VFR(2),o[0],0,0,0), C1,0); \
    KRD(GL,3); GAPB(o[1]=__builtin_amdgcn_mfma_f32_32x32x16_bf16(PAF(2),VFR(6),o[1],0,0,0), C1,4); \
    GAPB(o[0]=__builtin_amdgcn_mfma_f32_32x32x16_bf16(PAF(3),VFR(3),o[0],0,0,0), C1,8); \
    GAPB(o[1]=__builtin_amdgcn_mfma_f32_32x32x16_bf16(PAF(3),VFR(7),o[1],0,0,0), C1,12); \
    }while(0)
  int t=1;
  #undef CMASK
  #define CMASK(P0,P1,t) do{}while(0)
  for(;t+5<NT;t+=2){
    STEP(pB0,pB1,pA0,pA1,t,true,true,true);     WAIT_BAR(2); RESC(); ROT();
    STEP(pA0,pA1,pB0,pB1,t+1,true,true,true);   WAIT_BAR(2); RESC(); ROT();
  }
  #undef CMASK
  #define CMASK(P0,P1,t) do{int jb_=(t)-(NT-4); if(jb_>=0)cmask(P0,P1,jb_,qrel,hi);}while(0)
  #define ENDW(tt) do{ if((tt)+3<NT){WAIT_BAR(2);} else if((tt)+2<NT){WAIT_BAR(1);} else {WAIT_BAR(0);} }while(0)
  for(;t+1<NT;t+=2){
    STEP(pB0,pB1,pA0,pA1,t,(t+3<NT),(t+1<NT),(t+1<NT));       ENDW(t);   RESC(); ROT();
    STEP(pA0,pA1,pB0,pB1,t+1,(t+4<NT),(t+2<NT),(t+2<NT));     ENDW(t+1); RESC(); ROT();
  }
  STEP(pB0,pB1,pA0,pA1,NT-1,false,false,false); RESC();
  { float sacc=pB0[0]+pB0[1]; _Pragma("unroll") for(int r=2;r<16;++r)sacc+=pB0[r]; _Pragma("unroll") for(int r=0;r<16;++r)sacc+=pB1[r]; l_reg+=sacc;
    pw0=(u32x4){PKW(pB0,0),PKW(pB0,2),PKW(pB0,4),PKW(pB0,6)};pw1=(u32x4){PKW(pB0,8),PKW(pB0,10),PKW(pB0,12),PKW(pB0,14)};pw2=(u32x4){PKW(pB1,0),PKW(pB1,2),PKW(pB1,4),PKW(pB1,6)};pw3=(u32x4){PKW(pB1,8),PKW(pB1,10),PKW(pB1,12),PKW(pB1,14)};
    SBAR(); pv(o,vb0+sl_cur,PAF(0),PAF(1),PAF(2),PAF(3)); }
  #undef PKW
  #undef PAF
  #undef VFR
  #undef PIN
  #undef MX3
  #undef GAPA
  #undef GAPB
  #undef EX
  #undef VRD
  #undef KRD
  #undef STEP
  #undef ENDW
  {auto rr=__builtin_amdgcn_permlane32_swap(__float_as_uint(l_reg),__float_as_uint(l_reg),false,false);l_reg=__uint_as_float(rr[0])+__uint_as_float(rr[1]);}
  if(hi==0)wsf[32+r32]=l_reg;asm volatile("s_waitcnt lgkmcnt(0)":::"memory");
  float rli[16];
  #pragma unroll
  for(int r=0;r<16;++r)rli[r]=__builtin_amdgcn_rcpf(wsf[32+crow(r,hi)]);
  { hbf16*stg=(hbf16*)(shm+LDS_OST)+wid*2048;
    #pragma unroll
    for(int r=0;r<16;++r){const int orow=crow(r,hi);
      #pragma unroll
      for(int d0=0;d0<2;++d0)stg[orow*64+d0*32+r32]=__float2bfloat16(o[d0][r]*rli[r]);}
    asm volatile("s_waitcnt lgkmcnt(0)":::"memory");
    const long grow=rowbase+q0+wid*QBLK; float*ssq=(float*)(shm+LDS_SSQ)+wid*32;
    int lane_e=lane; asm volatile("":"+v"(lane_e));
    #pragma unroll
    for(int i=0;i<4;++i){const int row=i*8+(lane_e>>3),ch=lane_e&7; const u32x4 v=*(const u32x4*)(stg+row*64+ch*8);
      if(MODE==0){ *(u32x4*)(P.out+(grow+row)*(long)P.opitch+ch*8)=v; }
      else { bf16*sp=P.stash+(grow+row)*512+ch*8+(MODE==2?64:0); const u32x4 a=*(const u32x4*)sp; float of[8]; float ss=0.f;
        #pragma unroll
        for(int j=0;j<4;++j){ const float a0=__uint_as_float(a[j]<<16),a1=__uint_as_float(a[j]&0xffff0000u),c0=__uint_as_float(v[j]<<16),c1=__uint_as_float(v[j]&0xffff0000u);
          of[2*j]=a0-P.lam*c0; of[2*j+1]=a1-P.lam*c1; ss+=of[2*j]*of[2*j]+of[2*j+1]*of[2*j+1]; }
        ss+=__int_as_float(__builtin_amdgcn_ds_swizzle(__float_as_int(ss),0x041f)); ss+=__int_as_float(__builtin_amdgcn_ds_swizzle(__float_as_int(ss),0x081f)); ss+=__int_as_float(__builtin_amdgcn_ds_swizzle(__float_as_int(ss),0x101f));
        if(MODE==1){ if(ch==0)ssq[row]=ss; u32x4 w; _Pragma("unroll") for(int j=0;j<4;++j)w[j]=cvtpk_s(of[2*j],of[2*j+1]); *(u32x4*)sp=w; }
        else { const float rr_=rsqrtf((ss+ssq[row])*(1.0f/128.0f)+1e-6f)*P.nscale; bf16*yp=P.out+(grow+row)*(long)P.opitch+ch*8;
          const f32x4_t g0=*(const f32x4_t*)(P.gsub+64+ch*8), g1=*(const f32x4_t*)(P.gsub+64+ch*8+4), h0=*(const f32x4_t*)(P.gsub+ch*8), h1=*(const f32x4_t*)(P.gsub+ch*8+4);
          u32x4 w; w[0]=cvtpk_s(of[0]*rr_*g0[0],of[1]*rr_*g0[1]); w[1]=cvtpk_s(of[2]*rr_*g0[2],of[3]*rr_*g0[3]); w[2]=cvtpk_s(of[4]*rr_*g1[0],of[5]*rr_*g1[1]); w[3]=cvtpk_s(of[6]*rr_*g1[2],of[7]*rr_*g1[3]);
          *(u32x4*)(yp+64)=w;
          const u32x4 lo=*(const u32x4*)(sp-64); float lf[8];
          #pragma unroll
          for(int j=0;j<4;++j){ lf[2*j]=__uint_as_float(lo[j]<<16); lf[2*j+1]=__uint_as_float(lo[j]&0xffff0000u); }
          w[0]=cvtpk_s(lf[0]*rr_*h0[0],lf[1]*rr_*h0[1]); w[1]=cvtpk_s(lf[2]*rr_*h0[2],lf[3]*rr_*h0[3]); w[2]=cvtpk_s(lf[4]*rr_*h1[0],lf[5]*rr_*h1[1]); w[3]=cvtpk_s(lf[6]*rr_*h1[2],lf[7]*rr_*h1[3]);
          *(u32x4*)yp=w; } } } }
  asm volatile("s_waitcnt lgkmcnt(0)\n\ts_barrier":::"memory");
  #undef DMA_K
  #undef BIAS
  #undef DMA_V
  #undef CMASK
  #undef START
  #undef RESC
  #undef ROT
}
__device__ __forceinline__ void pv128(f32x16*o,int vb,bf16x8 pa0,bf16x8 pa1,bf16x8 pa2,bf16x8 pa3){
  #pragma unroll
  for(int d0=0;d0<4;++d0){s16x4 lo[4],hi[4];
    #pragma unroll
    for(int ks=0;ks<4;++ks){
      asm volatile("ds_read_b64_tr_b16 %0,%1 offset:%c2":"=&v"(lo[ks]):"v"(vb),"i"(d0*4096+ks*1024):"memory");
      asm volatile("ds_read_b64_tr_b16 %0,%1 offset:%c2":"=&v"(hi[ks]):"v"(vb),"i"(d0*4096+ks*1024+512):"memory");}
    asm volatile("s_waitcnt lgkmcnt(0)":::"memory");SBAR();
    #define PK(k) (bf16x8){lo[k][0],lo[k][1],lo[k][2],lo[k][3],hi[k][0],hi[k][1],hi[k][2],hi[k][3]}
    o[d0]=__builtin_amdgcn_mfma_f32_32x32x16_bf16(pa0,PK(0),o[d0],0,0,0);
    o[d0]=__builtin_amdgcn_mfma_f32_32x32x16_bf16(pa1,PK(1),o[d0],0,0,0);
    o[d0]=__builtin_amdgcn_mfma_f32_32x32x16_bf16(pa2,PK(2),o[d0],0,0,0);
    o[d0]=__builtin_amdgcn_mfma_f32_32x32x16_bf16(pa3,PK(3),o[d0],0,0,0);
    #undef PK
  }
}
template<int THRL> __device__ __forceinline__ void attn_unit128(const int tid_in,int b,int qb,const int MODE,const AttnP&P,char*shm){
  constexpr bool FOX=false; constexpr int LDS_V=24576, LDS_WS=73728, LDS_OST=75776, SLOTV=16384;
  int tid=tid_in; asm volatile("":"+v"(tid));
  const int lane=tid&63,r32=lane&31,hi=lane>>5; const int wid=__builtin_amdgcn_readfirstlane(tid>>6);
  const long rowbase=(long)b*SEQ; const int q0=qb*QB;
  const bf16*Qw=P.Q+(rowbase+q0+wid*QBLK)*DM;
  const bf16*Kh=P.K+rowbase*DM,*Vh=P.V+rowbase*DM;
  const unsigned lds0=(unsigned)(uintptr_t)shm;
  float*wsf=(float*)(shm+LDS_WS)+wid*64;
  const float*biasL=(const float*)(shm+LDS_BIAS);
  #define BIAS(P0,P1,t) do{ if(FOX){ const float*bb_=biasL+64*(t)+4*hi; _Pragma("unroll") for(int g_=0;g_<4;++g_){ const f32x4_t b0_=*(const f32x4_t*)(bb_+8*g_), b1_=*(const f32x4_t*)(bb_+32+8*g_); \
      _Pragma("unroll") for(int e_=0;e_<4;++e_){ P0[4*g_+e_]+=b0_[e_]; P1[4*g_+e_]+=b1_[e_]; } asm volatile("":::"memory"); } } }while(0)
  const bf16*ksrc=Kh+(long)lane*DM+wid*8;
  const bf16*vsrc=Vh+(long)(16*(wid&3)+(lane>>2))*DM+(wid>>2)*32+(lane&3)*8;
  const unsigned kdst=lds0+LDS_K+wid*1024, vdst=lds0+LDS_V+wid*1024;
  #define DMA_K(t,slot) glds16(ksrc+(long)(t)*KVBLK*DM,(unsigned)__builtin_amdgcn_readfirstlane(kdst+(slot)))
  #define DMA_V(t,slot) do{ glds16(vsrc+(long)(t)*KVBLK*DM,(unsigned)__builtin_amdgcn_readfirstlane(vdst+2*(slot))); glds16(vsrc+(long)(t)*KVBLK*DM+64,(unsigned)__builtin_amdgcn_readfirstlane(vdst+2*(slot)+8192)); }while(0)
  const int vb0=(int)(lds0+LDS_V)+((lane>>4)&1)*32+(lane&3)*8+(4*hi+((lane&15)>>2))*64;
  const char*Kbase=shm+LDS_K; bf16x8 kf[8];
  const lds_cptr shm3=(lds_cptr)shm; const lds_cptr kp0=shm3+LDS_K+hi*1024+r32*16; const lds_cptr vp0=shm3+LDS_V+((lane>>4)&1)*32+(lane&3)*8+(4*hi+((lane&15)>>2))*64;
  const int NT=(q0+QB)/KVBLK;
  DMA_K(0,0);DMA_V(0,0);DMA_K(1,SLOTB);
  bf16x8 qr[4];
  #pragma unroll
  for(int d0=0;d0<4;++d0)qr[d0]=*reinterpret_cast<const bf16x8*>(&Qw[(long)r32*DM+d0*16+hi*8]);
  float mhat=0.f,l_reg=0.f;f32x16 o[4];o[0]=f32x16{};o[1]=f32x16{};o[2]=f32x16{};o[3]=f32x16{};const f32x16 zero16=f32x16{};
  const int qrel=wid*QBLK+r32;
  #define CMASK(P0,P1,t) do{int jb_=(t)-(NT-4); if(jb_>=0)cmask(P0,P1,jb_,qrel,hi);}while(0)
  bool resc=false;
  #define START(P0,P1) do{ const float rm=rowmax(P0,P1); resc=false; \
    { const float dl=rm; mhat=fadd_s(mhat,dl); \
      _Pragma("unroll") for(int r=0;r<16;++r){P0[r]=fsub_s(P0[r],dl);P1[r]=fsub_s(P1[r],dl);} \
      } \
    _Pragma("unroll") for(int r=0;r<16;++r)P0[r]=__builtin_amdgcn_exp2f(P0[r]); }while(0)
  #define RESC() do{ if(resc){ asm volatile("s_waitcnt lgkmcnt(0)":::"memory"); \
      _Pragma("unroll") for(int d_=0;d_<4;++d_) _Pragma("unroll") for(int r=0;r<16;++r)o[d_][r]*=wsf[crow(r,hi)]; } }while(0)
  f32x16 pA0,pA1,pB0,pB1;
  int sl_prev=0,sl_cur=0,sl_next=SLOTB;
  #define ROT() do{sl_prev=sl_cur;sl_cur=sl_next;sl_next=(sl_next==(NSLOT-1)*SLOTB)?0:sl_next+SLOTB;}while(0)
  DMA_K(2,2*SLOTB);
  WAIT_BAR(4);
  qkt(pA0,pA1,Kbase,qr,zero16,r32,hi);asm volatile("s_nop 15\n\ts_nop 7":"+v"(pA0),"+v"(pA1));BIAS(pA0,pA1,0);CMASK(pA0,pA1,0);
  START(pA0,pA1);
  _Pragma("unroll") for(int r=0;r<16;++r)pA1[r]=__builtin_amdgcn_exp2f(pA1[r]);
  WAIT_BAR(0);
  DMA_K(3,0);DMA_V(1,SLOTB);
  ROT();
  kload8(kf,kp0+sl_cur);
  WAIT_BAR(3);
  s16x4 va_lo,va_hi,vb_lo,vb_hi; u32x4 pw0,pw1,pw2,pw3;
  #define PKW(P,B) cvtpk_s(P[B],P[B+1])
  #define PAF(k) __builtin_bit_cast(bf16x8,pw##k)
  #define VFA (bf16x8){va_lo[0],va_lo[1],va_lo[2],va_lo[3],va_hi[0],va_hi[1],va_hi[2],va_hi[3]}
  #define VFB (bf16x8){vb_lo[0],vb_lo[1],vb_lo[2],vb_lo[3],vb_hi[0],vb_hi[1],vb_hi[2],vb_hi[3]}
  #define PIN(x) asm volatile("":"+v"(x))
  #define MX3(a,b,c) __builtin_fmaxf(__builtin_fmaxf((a),(b)),(c))
  #define GAPA(MF,A0,A1,A2,A3,W0,W1,PW) do{ MF; sacc+=A0; sacc+=A1; sacc+=A2; sacc+=A3; PIN(sacc); W0; W1; PIN(PW); SBAR(); }while(0)
  #define EX(v) __builtin_amdgcn_exp2f((v)-mhat)
  #define VRDA(d0,ks) do{ va_lo=vtr(vp_+((d0)*4096+(ks)*1024)); va_hi=vtr(vp_+((d0)*4096+(ks)*1024+512)); }while(0)
  #define VRDB(d0,ks) do{ vb_lo=vtr(vp_+((d0)*4096+(ks)*1024)); vb_hi=vtr(vp_+((d0)*4096+(ks)*1024+512)); }while(0)
  #define KRD(G,j) do{ if(G){ kload2(kf,kp0+sl_next,j); } }while(0)
  #define GAPB(MF,RD,X,B) do{ MF; RD; X[B]=EX(X[B]); X[B+1]=EX(X[B+1]); PIN(X); SBAR(); }while(0)
  #define STEP(C0,C1,P0,P1,t,GK,GV,GL) do{ SBAR(); \
    const lds_cptr vp_=vp0+2*sl_prev; \
    float sacc=(P0[0]+P0[1]); \
    GAPA(C0=__builtin_amdgcn_mfma_f32_32x32x16_bf16(kf[0],qr[0],zero16,0,0,0), P0[2],P0[3],P0[4],P0[5],     pw0[0]=PKW(P0,0), pw0[1]=PKW(P0,2), pw0); \
    GAPA(C1=__builtin_amdgcn_mfma_f32_32x32x16_bf16(kf[1],qr[0],zero16,0,0,0), P0[6],P0[7],P0[8],P0[9],     pw0[2]=PKW(P0,4), pw0[3]=PKW(P0,6), pw0); \
    GAPA(C0=__builtin_amdgcn_mfma_f32_32x32x16_bf16(kf[2],qr[1],C0,0,0,0),   P0[10],P0[11],P0[12],P0[13], pw1[0]=PKW(P0,8), pw1[1]=PKW(P0,10), pw1); \
    GAPA(C1=__builtin_amdgcn_mfma_f32_32x32x16_bf16(kf[3],qr[1],C1,0,0,0),   P0[14],P0[15],P1[0],P1[1],   pw1[2]=PKW(P0,12),pw1[3]=PKW(P0,14), pw1); \
    GAPA(C0=__builtin_amdgcn_mfma_f32_32x32x16_bf16(kf[4],qr[2],C0,0,0,0),   P1[2],P1[3],P1[4],P1[5],     pw2[0]=PKW(P1,0), pw2[1]=PKW(P1,2), pw2); \
    GAPA(C1=__builtin_amdgcn_mfma_f32_32x32x16_bf16(kf[5],qr[2],C1,0,0,0),   P1[6],P1[7],P1[8],P1[9],     pw2[2]=PKW(P1,4), pw2[3]=PKW(P1,6), pw2); \
    VRDA(0,0); SBAR(); \
    GAPA(C0=__builtin_amdgcn_mfma_f32_32x32x16_bf16(kf[6],qr[3],C0,0,0,0),   P1[10],P1[11],P1[12],P1[13], pw3[0]=PKW(P1,8), pw3[1]=PKW(P1,10), pw3); \
    GAPA(C1=__builtin_amdgcn_mfma_f32_32x32x16_bf16(kf[7],qr[3],C1,0,0,0),   P1[14],P1[15],0.f,0.f,       pw3[2]=PKW(P1,12),pw3[3]=PKW(P1,14), pw3); \
    l_reg+=sacc; \
    if(GK){DMA_K((t)+3,sl_cur);} if(GV){DMA_V((t)+1,sl_next);} \
    CMASK(C0,C1,t); \
    { float a=MX3(C0[0],C0[1],C1[0]),b=MX3(C0[2],C0[3],C1[1]); a=MX3(a,C1[2],C1[3]); \
      _Pragma("unroll") for(int r=4;r<16;r+=4){a=MX3(a,C0[r],C0[r+1]);b=MX3(b,C0[r+2],C0[r+3]);a=MX3(a,C1[r],C1[r+1]);b=MX3(b,C1[r+2],C1[r+3]);} \
      float rm=__builtin_fmaxf(a,b); { auto rr=__builtin_amdgcn_permlane32_swap(__float_as_uint(rm),__float_as_uint(rm),false,false); rm=__builtin_fmaxf(__uint_as_float(rr[0]),__uint_as_float(rr[1])); } \
      rm-=mhat; resc=false; \
      if(__builtin_expect(__any(rm>(float)THRL),0)){ const float dl=__builtin_fmaxf(rm,0.f); mhat+=dl; \
        const float f=__builtin_amdgcn_exp2f(-dl); l_reg*=f; if(hi==0)wsf[r32]=f; resc=true; } } \
    SBAR(); \
    GAPB(o[0]=__builtin_amdgcn_mfma_f32_32x32x16_bf16(PAF(0),VFA,o[0],0,0,0), VRDB(1,0), C0,0); \
    GAPB(o[1]=__builtin_amdgcn_mfma_f32_32x32x16_bf16(PAF(0),VFB,o[1],0,0,0), VRDA(2,0), C0,2); \
    GAPB(o[2]=__builtin_amdgcn_mfma_f32_32x32x16_bf16(PAF(0),VFA,o[2],0,0,0), VRDB(3,0), C0,4); \
    GAPB(o[3]=__builtin_amdgcn_mfma_f32_32x32x16_bf16(PAF(0),VFB,o[3],0,0,0), VRDA(0,1), C0,6); \
    KRD(GL,0); GAPB(o[0]=__builtin_amdgcn_mfma_f32_32x32x16_bf16(PAF(1),VFA,o[0],0,0,0), VRDB(1,1), C0,8); \
    GAPB(o[1]=__builtin_amdgcn_mfma_f32_32x32x16_bf16(PAF(1),VFB,o[1],0,0,0), VRDA(2,1), C0,10); \
    KRD(GL,1); GAPB(o[2]=__builtin_amdgcn_mfma_f32_32x32x16_bf16(PAF(1),VFA,o[2],0,0,0), VRDB(3,1), C0,12); \
    GAPB(o[3]=__builtin_amdgcn_mfma_f32_32x32x16_bf16(PAF(1),VFB,o[3],0,0,0), VRDA(0,2), C0,14); \
    KRD(GL,2); GAPB(o[0]=__builtin_amdgcn_mfma_f32_32x32x16_bf16(PAF(2),VFA,o[0],0,0,0), VRDB(1,2), C1,0); \
    GAPB(o[1]=__builtin_amdgcn_mfma_f32_32x32x16_bf16(PAF(2),VFB,o[1],0,0,0), VRDA(2,2), C1,2); \
    KRD(GL,3); GAPB(o[2]=__builtin_amdgcn_mfma_f32_32x32x16_bf16(PAF(2),VFA,o[2],0,0,0), VRDB(3,2), C1,4); \
    GAPB(o[3]=__builtin_amdgcn_mfma_f32_32x32x16_bf16(PAF(2),VFB,o[3],0,0,0), VRDA(0,3), C1,6); \
    GAPB(o[0]=__builtin_amdgcn_mfma_f32_32x32x16_bf16(PAF(3),VFA,o[0],0,0,0), VRDB(1,3), C1,8); \
    GAPB(o[1]=__builtin_amdgcn_mfma_f32_32x32x16_bf16(PAF(3),VFB,o[1],0,0,0), VRDA(2,3), C1,10); \
    GAPB(o[2]=__builtin_amdgcn_mfma_f32_32x32x16_bf16(PAF(3),VFA,o[2],0,0,0), VRDB(3,3), C1,12); \
    GAPB(o[3]=__builtin_amdgcn_mfma_f32_32x32x16_bf16(PAF(3),VFB,o[3],0,0,0), (void)0, C1,14); \
    }while(0)
  int t=1;
  #undef CMASK
  #define CMASK(P0,P1,t) do{}while(0)
  for(;t+5<NT;t+=2){
    STEP(pB0,pB1,pA0,pA1,t,true,true,true);     WAIT_BAR(3); RESC(); ROT();
    STEP(pA0,pA1,pB0,pB1,t+1,true,true,true);   WAIT_BAR(3); RESC(); ROT();
  }
  #undef CMASK
  #define CMASK(P0,P1,t) do{int jb_=(t)-(NT-4); if(jb_>=0)cmask(P0,P1,jb_,qrel,hi);}while(0)
  #define ENDW(tt) do{ if((tt)+3<NT){WAIT_BAR(3);} else if((tt)+2<NT){WAIT_BAR(2);} else {WAIT_BAR(0);} }while(0)
  for(;t+1<NT;t+=2){
    STEP(pB0,pB1,pA0,pA1,t,(t+3<NT),(t+1<NT),(t+1<NT));       ENDW(t);   RESC(); ROT();
    STEP(pA0,pA1,pB0,pB1,t+1,(t+4<NT),(t+2<NT),(t+2<NT));     ENDW(t+1); RESC(); ROT();
  }
  STEP(pB0,pB1,pA0,pA1,NT-1,false,false,false); RESC();
  { float sacc=pB0[0]+pB0[1]; _Pragma("unroll") for(int r=2;r<16;++r)sacc+=pB0[r]; _Pragma("unroll") for(int r=0;r<16;++r)sacc+=pB1[r]; l_reg+=sacc;
    pw0=(u32x4){PKW(pB0,0),PKW(pB0,2),PKW(pB0,4),PKW(pB0,6)};pw1=(u32x4){PKW(pB0,8),PKW(pB0,10),PKW(pB0,12),PKW(pB0,14)};pw2=(u32x4){PKW(pB1,0),PKW(pB1,2),PKW(pB1,4),PKW(pB1,6)};pw3=(u32x4){PKW(pB1,8),PKW(pB1,10),PKW(pB1,12),PKW(pB1,14)};
    SBAR(); pv128(o,vb0+2*sl_cur,PAF(0),PAF(1),PAF(2),PAF(3)); }
  #undef PKW
  #undef PAF
  #undef VFA
  #undef VFB
  #undef VRDA
  #undef VRDB
  #undef PIN
  #undef MX3
  #undef GAPA
  #undef GAPB
  #undef EX
  #undef KRD
  #undef STEP
  #undef ENDW
  {auto rr=__builtin_amdgcn_permlane32_swap(__float_as_uint(l_reg),__float_as_uint(l_reg),false,false);l_reg=__uint_as_float(rr[0])+__uint_as_float(rr[1]);}
  if(hi==0)wsf[32+r32]=l_reg;asm volatile("s_waitcnt lgkmcnt(0)":::"memory");
  float rli[16];
  #pragma unroll
  for(int r=0;r<16;++r)rli[r]=__builtin_amdgcn_rcpf(wsf[32+crow(r,hi)]);
  { hbf16*stg=(hbf16*)(shm+LDS_OST)+wid*2048;
    const long grow=rowbase+q0+wid*QBLK;
    int lane_e=lane; asm volatile("":"+v"(lane_e));
    float of[2][4][8]; float ssr[4]={0.f,0.f,0.f,0.f};
    #pragma unroll
    for(int hf=0;hf<2;++hf){
      #pragma unroll
      for(int r=0;r<16;++r){const int orow=crow(r,hi);
        #pragma unroll
        for(int d0=0;d0<2;++d0)stg[orow*64+d0*32+r32]=__float2bfloat16(o[2*hf+d0][r]*rli[r]);}
      asm volatile("s_waitcnt lgkmcnt(0)":::"memory");
      #pragma unroll
      for(int i=0;i<4;++i){const int row=i*8+(lane_e>>3),ch=lane_e&7; const u32x4 v=*(const u32x4*)(stg+row*64+ch*8);
        if(MODE==0){ *(u32x4*)(P.out+(grow+row)*(long)P.opitch+hf*64+ch*8)=v; }
        else { const u32x4 a=*(const u32x4*)(P.stash+(grow+row)*512+hf*64+ch*8); float ss=0.f;
          #pragma unroll
          for(int j=0;j<4;++j){ const float a0=__uint_as_float(a[j]<<16),a1=__uint_as_float(a[j]&0xffff0000u),c0=__uint_as_float(v[j]<<16),c1=__uint_as_float(v[j]&0xffff0000u);
            of[hf][i][2*j]=a0-P.lam*c0; of[hf][i][2*j+1]=a1-P.lam*c1; ss+=of[hf][i][2*j]*of[hf][i][2*j]+of[hf][i][2*j+1]*of[hf][i][2*j+1]; }
          ssr[i]+=ss; } }
      asm volatile("s_waitcnt lgkmcnt(0)":::"memory");
    }
    if(MODE!=0){
      #pragma unroll
      for(int i=0;i<4;++i){const int row=i*8+(lane_e>>3),ch=lane_e&7; float ss=ssr[i];
        ss+=__int_as_float(__builtin_amdgcn_ds_swizzle(__float_as_int(ss),0x041f)); ss+=__int_as_float(__builtin_amdgcn_ds_swizzle(__float_as_int(ss),0x081f)); ss+=__int_as_float(__builtin_amdgcn_ds_swizzle(__float_as_int(ss),0x101f));
        const float rr_=rsqrtf(ss*(1.0f/128.0f)+1e-6f)*P.nscale; bf16*yp=P.out+(grow+row)*(long)P.opitch+ch*8;
        #pragma unroll
        for(int hf=0;hf<2;++hf){ const f32x4_t g0=*(const f32x4_t*)(P.gsub+hf*64+ch*8), g1=*(const f32x4_t*)(P.gsub+hf*64+ch*8+4); u32x4 w;
          w[0]=cvtpk_s(of[hf][i][0]*rr_*g0[0],of[hf][i][1]*rr_*g0[1]); w[1]=cvtpk_s(of[hf][i][2]*rr_*g0[2],of[hf][i][3]*rr_*g0[3]); w[2]=cvtpk_s(of[hf][i][4]*rr_*g1[0],of[hf][i][5]*rr_*g1[1]); w[3]=cvtpk_s(of[hf][i][6]*rr_*g1[2],of[hf][i][7]*rr_*g1[3]);
          *(u32x4*)(yp+hf*64)=w; } } } }
  asm volatile("s_waitcnt lgkmcnt(0)\n\ts_barrier":::"memory");
  #undef DMA_K
  #undef BIAS
  #undef DMA_V
  #undef CMASK
  #undef START
  #undef RESC
  #undef ROT
}
constexpr int ATTN_LDS_BYTES=LDS_BYTES;
#undef SBAR
#undef WAIT_BAR
}
#ifndef MK_MU8
#define MK_MU8 0
#endif
#ifndef MK_PLE8
#define MK_PLE8 0
#endif
#define GAS __attribute__((address_space(1)))
#define LAS __attribute__((address_space(3)))
typedef unsigned v4u __attribute__((ext_vector_type(4)));
typedef float f32x4 __attribute__((ext_vector_type(4)));
typedef GAS unsigned gu32;
#define RLX_AGENT __ATOMIC_RELAXED, __HIP_MEMORY_SCOPE_AGENT
#define LDS_WAIT() asm volatile("s_waitcnt lgkmcnt(0)" ::: "memory")
#define VM_WAIT() asm volatile("s_waitcnt vmcnt(0)" ::: "memory")
constexpr int NWAVES = 8;
constexpr size_t W_IN = 0;
constexpr size_t W_CAT = W_IN + (size_t)3840 * 1024 * 2;
constexpr size_t W_G8 = W_CAT;
constexpr size_t W_BR = W_CAT + (size_t)3 * 1024 * 1024;
constexpr float G8_SCALE = 128.0f;
constexpr size_t W_OUT = W_CAT + (size_t)3 * 1024 * 1536 * 2;
constexpr size_t W_GU = W_OUT + (size_t)1024 * 1024 * 2;
constexpr size_t W_D = W_GU + (size_t)16 * 512 * 1024 * 2;
constexpr size_t W_RH = W_D + (size_t)16 * 1024 * 256 * 2;
constexpr size_t W_RL = W_RH + 65536;
constexpr size_t W_ENDB = W_RL + 65536;
static_assert(WS_W + W_ENDB <= WS_SSB && WS_SSB + MiB <= WS_WPLE, "weight map");
constexpr size_t W_PG = 0, W_P = (size_t)1024 * 1024 * 2, WPLE_STRIDE = (size_t)5 * 512 * 1024;
constexpr size_t OUT_XB8 = 0, OUT_GATES = 16 * MiB;
constexpr size_t OV_PB = WS_PB;
constexpr size_t OV_PW = WS_PROJ + 8 * MiB;
constexpr size_t OV_ACT = WS_PROJ + 40 * MiB;
constexpr size_t OV_XB2 = WS_PROJ + 64 * MiB;
constexpr int RING_BYTES = 131072, MISC_OFF = RING_BYTES, LDS_BYTES = 147456;
constexpr int MI_N = 0, MI_BASE = 32, MI_U0 = 64, MI_TOT = 96, MI_Q = 100, MI_BAR = 104;

__device__ __forceinline__ unsigned pk2(float lo, float hi) { typedef float f2 __attribute__((ext_vector_type(2))); typedef __bf16 b2 __attribute__((ext_vector_type(2))); f2 v = {lo, hi}; b2 b = __builtin_convertvector(v, b2); return __builtin_bit_cast(unsigned, b); }
__device__ __forceinline__ float bflo(unsigned u) { return __uint_as_float(u << 16); }
__device__ __forceinline__ float bfhi(unsigned u) { return __uint_as_float(u & 0xffff0000u); }
__device__ __forceinline__ float sigm(float v) { return __builtin_amdgcn_rcpf(1.0f + __expf(-v)); }
__device__ __forceinline__ float sg2(float t) { return __builtin_amdgcn_rcpf(1.0f + __builtin_amdgcn_exp2f(t)); }
__device__ __forceinline__ float clamp8(float v) { return __builtin_amdgcn_fmed3f(v, -448.0f, 448.0f); }
__device__ __forceinline__ unsigned pk_fp8x4(float a, float b, float c, float d) {
    int w = __builtin_amdgcn_cvt_pk_fp8_f32(clamp8(a), clamp8(b), 0, false); w = __builtin_amdgcn_cvt_pk_fp8_f32(clamp8(c), clamp8(d), w, true); return (unsigned)w; }

#define XOR1(v) __int_as_float(__builtin_amdgcn_ds_swizzle(__float_as_int(v), 0x041f))
#define XOR2(v) __int_as_float(__builtin_amdgcn_ds_swizzle(__float_as_int(v), 0x081f))
#define XOR4(v) __int_as_float(__builtin_amdgcn_ds_swizzle(__float_as_int(v), 0x101f))
#define XOR8(v) __int_as_float(__builtin_amdgcn_ds_swizzle(__float_as_int(v), 0x201f))
#define XOR16(v) __int_as_float(__builtin_amdgcn_ds_swizzle(__float_as_int(v), 0x401f))
__device__ __forceinline__ float add_xor32(float v) { const auto r = __builtin_amdgcn_permlane32_swap(__float_as_uint(v), __float_as_uint(v), false, false); return __uint_as_float(r[0]) + __uint_as_float(r[1]); }
__device__ __forceinline__ float wave_sum64(float v) { v += XOR1(v); v += XOR2(v); v += XOR4(v); v += XOR8(v); v += XOR16(v); return add_xor32(v); }
__device__ __forceinline__ int mk_tid(int wave0) { int l; asm volatile("v_mbcnt_lo_u32_b32 %0, -1, 0\n\tv_mbcnt_hi_u32_b32 %0, -1, %0" : "=v"(l)); return wave0 * 64 + l; }

#define XB_TMO      128
#define XB_XCNT(j)  (256  + 64 * (j))
#define XB_XSUB(j)  (1280 + 64 * (j))
#define XB_XGEN(j)  (2304 + 64 * (j))
#define XB_TOP      3328
#define XB_TOPGEN   3392
#define XCD_BAR_WORDS 3456
#define XB_SPIN_CAP (1u << 18)
__device__ __forceinline__ unsigned xb_ld(unsigned* p)              { return __hip_atomic_load(p, __ATOMIC_RELAXED, __HIP_MEMORY_SCOPE_AGENT); }
__device__ __forceinline__ unsigned xb_add(unsigned* p, unsigned v) { return __hip_atomic_fetch_add(p, v, __ATOMIC_RELAXED, __HIP_MEMORY_SCOPE_AGENT); }
__device__ __forceinline__ unsigned xb_xcc_id() { return (unsigned)__builtin_amdgcn_s_getreg((3 << 11) | 20) & 0xFu; }
#define XB_SPIN(cond, bar) do { unsigned _sp = 0; while (cond) { __builtin_amdgcn_s_sleep(1); \
    if ((++_sp & 255u) == 0u) { if (xb_ld(&(bar)[XB_TMO])) break; if (_sp > XB_SPIN_CAP) { atomicAdd(&(bar)[XB_TMO], 1u); break; } } } } while (0)
struct XcdBarrier { unsigned* bar; unsigned x; volatile LAS unsigned* st; };
__device__ __forceinline__ XcdBarrier xcd_barrier_post(unsigned* bar, volatile LAS unsigned* st, int tid) {
    XcdBarrier b; b.bar = bar; b.x = xb_xcc_id(); b.st = st;
    if (tid == 0) (void)xb_add(&bar[XB_XCNT(b.x)], 1u);
    return b;
}
__device__ __forceinline__ void xcd_barrier_complete(unsigned* bar, unsigned x, unsigned& nloc, unsigned& nx) {
    const unsigned G = gridDim.x * gridDim.y * gridDim.z;
    unsigned sum, cnt, mine, sp = 0u;
    for (;;) {
        sum = 0u; cnt = 0u; mine = 0u;
#pragma unroll
        for (unsigned j = 0; j < 16; ++j) { const unsigned c = xb_ld(&bar[XB_XCNT(j)]); sum += c; cnt += (c > 0u) ? 1u : 0u; mine = (j == x) ? c : mine; }
        if (sum == G) break;
        __builtin_amdgcn_s_sleep(1);
        if ((++sp & 255u) == 0u) { if (xb_ld(&bar[XB_TMO])) break; if (sp > XB_SPIN_CAP) { atomicAdd(&bar[XB_TMO], 1u); break; } }
    }
    nloc = mine > 0u ? mine : 1u; nx = cnt > 0u ? cnt : 1u;
}
#ifndef MK_EARLYINV
#define MK_EARLYINV 1
#endif
#ifndef MK_SPLIT_SLEEP
#define MK_SPLIT_SLEEP 16
#endif
__device__ __forceinline__ void xcd_barrier(const XcdBarrier& b, int tid) {
    asm volatile("s_waitcnt vmcnt(0)" ::: "memory");
    __syncthreads();
    if (tid == 0) {
        unsigned* bar = b.bar;
        __builtin_amdgcn_s_waitcnt(0);
        unsigned nloc = b.st[0], nx = b.st[1];
        if (nloc == 0u) { xcd_barrier_complete(bar, b.x, nloc, nx); b.st[0] = nloc; b.st[1] = nx; }
        const unsigned old = xb_add(&bar[XB_XSUB(b.x)], 1u);
        const unsigned gen = old / nloc;
        if (old + 1u == (gen + 1u) * nloc) {
            __builtin_amdgcn_fence(__ATOMIC_RELEASE, "agent");
            asm volatile("s_waitcnt vmcnt(0)" ::: "memory");
            const unsigned og = xb_add(&bar[XB_TOP], 1u);
            unsigned tg = og / nx; asm volatile("" : "+v"(tg) :: "memory");
            if (og + 1u == (tg + 1u) * nx) { xb_add(&bar[XB_TOPGEN], 1u);
#if MK_EARLYINV
                xb_add(&bar[XB_XGEN(b.x)], 1u); asm volatile("buffer_inv sc1" ::: "memory");
#endif
            } else {
#if MK_EARLYINV
                asm volatile("buffer_inv sc1" ::: "memory");
#endif
                XB_SPIN(xb_ld(&bar[XB_TOPGEN]) == tg, bar);
#if MK_EARLYINV
                xb_add(&bar[XB_XGEN(b.x)], 1u);
#endif
            }
#if !MK_EARLYINV
            __builtin_amdgcn_fence(__ATOMIC_ACQUIRE, "agent");
            xb_add(&bar[XB_XGEN(b.x)], 1u);
#endif
            asm volatile("s_waitcnt vmcnt(0)" ::: "memory");
        } else {
#if MK_EARLYINV
            { unsigned g2 = gen; asm volatile("" : "+v"(g2) :: "memory"); asm volatile("buffer_inv sc1" ::: "memory");
              XB_SPIN(xb_ld(&bar[XB_XGEN(b.x)]) == g2, bar); }
#else
            XB_SPIN(xb_ld(&bar[XB_XGEN(b.x)]) == gen, bar);
            __builtin_amdgcn_fence(__ATOMIC_ACQUIRE, "agent");
#endif
            asm volatile("s_waitcnt vmcnt(0)" ::: "memory");
        }
    }
    __syncthreads();
}

__device__ __forceinline__ void split_arrive(unsigned* cnt, int tid) {
    asm volatile("s_waitcnt vmcnt(0)" ::: "memory"); __syncthreads();
    if (tid == 0) { __builtin_amdgcn_fence(__ATOMIC_RELEASE, "agent"); asm volatile("s_waitcnt vmcnt(0)" ::: "memory"); xb_add(cnt, 1u); }
}
__device__ __forceinline__ void split_arrive_x(const XcdBarrier& b, unsigned* cnt_top, unsigned* cnt_x, int tid) {
    asm volatile("s_waitcnt vmcnt(0)" ::: "memory"); __syncthreads();
    if (tid == 0) { const unsigned nloc = b.st[0]; const unsigned old = xb_add(cnt_x + 8u * b.x, 1u);
        if (old + 1u == nloc) { __builtin_amdgcn_fence(__ATOMIC_RELEASE, "agent"); asm volatile("s_waitcnt vmcnt(0)" ::: "memory"); xb_add(cnt_top, nloc); }
#if MK_EARLYINV
        asm volatile("buffer_inv sc1" ::: "memory");
#endif
    }
}
__device__ __forceinline__ void split_wait_leader(unsigned* cnt, unsigned target) {
    unsigned sp = 0; while (xb_ld(cnt) < target) { __builtin_amdgcn_s_sleep(MK_SPLIT_SLEEP); if (++sp > (1u << 22)) break; }
#if !MK_EARLYINV
    __builtin_amdgcn_fence(__ATOMIC_ACQUIRE, "agent");
#endif
    asm volatile("s_waitcnt vmcnt(0)" ::: "memory");
}

__device__ __forceinline__ void group4_sync(unsigned* gc, int tid) {
    asm volatile("s_waitcnt vmcnt(0)" ::: "memory"); __syncthreads();
    if (tid == 0) { const unsigned sh = 8u + 3u * xb_xcc_id();
        xb_add(gc, 1u + (1u << sh));
        asm volatile("buffer_inv sc1" ::: "memory");
        unsigned sp = 0, v = 0; for (;;) { v = xb_ld(gc); if ((v & 0xffu) >= 4u) break; __builtin_amdgcn_s_sleep(1); if (++sp > (1u << 22)) break; }
        if (((v >> sh) & 7u) != 4u) {
            __builtin_amdgcn_fence(__ATOMIC_RELEASE, "agent"); asm volatile("s_waitcnt vmcnt(0)" ::: "memory");
            xb_add(gc + 16, 1u); sp = 0; while (xb_ld(gc + 16) < 4u) { __builtin_amdgcn_s_sleep(1); if (++sp > (1u << 22)) break; }
            __builtin_amdgcn_fence(__ATOMIC_ACQUIRE, "agent"); }
        asm volatile("s_waitcnt vmcnt(0)" ::: "memory"); }
    __syncthreads();
}

struct Args { const void* in[27]; float* out; unsigned char* ws; int ph_lo, ph_hi, li, pad; };
struct LayerW {
    const float *g_attn, *w_in, *pool_w, *pool_scale, *dqn, *dkn, *dlam, *dsub, *fqn, *fkn, *ffb, *w_branch, *w_out, *g_ffn, *wrg, *brg, *wre, *bre, *wg, *wu, *wd, *g_ple, *wpg, *wple, *p;
};
__device__ __forceinline__ LayerW layer_view(const __attribute__((address_space(4))) Args* a, int l) {
    LayerW w; const float* in[27];
#pragma unroll
    for (int i = 0; i < 27; ++i) in[i] = (const float*)a->in[i];
    w.g_attn = in[3] + l * 1024; w.w_in = in[4] + (size_t)l * 1024 * INW; w.pool_w = in[5] + (size_t)l * 65536; w.pool_scale = in[6] + l * 512;
    w.dqn = in[7] + l * 64; w.dkn = in[8] + l * 64; w.dlam = in[9] + l * 256; w.dsub = in[10] + l * 128; w.fqn = in[11] + l * 64; w.fkn = in[12] + l * 64; w.ffb = in[13] + l * 8;
    w.w_branch = in[14] + (size_t)l * 3 * 512 * 1024; w.w_out = in[15] + (size_t)l * 1024 * 1024; w.g_ffn = in[16] + l * 1024; w.wrg = in[17] + (size_t)l * 4096; w.brg = in[18] + l * 4;
    w.wre = in[19] + (size_t)l * 16384; w.bre = in[20] + l * 16; w.wg = in[21] + (size_t)l * 16 * 262144; w.wu = in[22] + (size_t)l * 16 * 262144; w.wd = in[23] + (size_t)l * 16 * 262144;
    w.g_ple = in[24] + l * 1024; w.wpg = in[25] + (size_t)l * 1024 * 1024; w.wple = in[26] + (size_t)l * 256 * 1024; w.p = in[1] + (size_t)l * T * 256;
    return w;
}

__device__ __forceinline__ void tr_item(const float* __restrict__ src, int ldsrc, int c0, int nvalid, int k0, const float* __restrict__ gk, bf16* dst, int dpitch, int nrow0, int dk0, LAS float* scr, int lane, const bool f8 = false) {
    float vv[32];
#pragma unroll
    for (int i = 0; i < 32; ++i) { const int kk = 2 * i + (lane >> 5), c = lane & 31; vv[i] = (c < nvalid) ? src[(size_t)(k0 + kk) * ldsrc + c0 + c] : 0.f; }
    if (gk) {
#pragma unroll
        for (int i = 0; i < 32; ++i) vv[i] *= gk[k0 + 2 * i + (lane >> 5)]; }
#pragma unroll
    for (int i = 0; i < 32; ++i) scr[(2 * i + (lane >> 5)) * 33 + (lane & 31)] = vv[i];
    LDS_WAIT(); asm volatile("" ::: "memory");
    const int c8 = lane & 7;
#pragma unroll
    for (int j = 0; j < 4; ++j) { const int n = (lane >> 3) + 8 * j; const LAS float* s = scr + (8 * c8) * 33 + n;
        if (f8) { typedef unsigned v2u_ __attribute__((ext_vector_type(2))); v2u_ o;
            o.x = pk_fp8x4(s[0 * 33] * G8_SCALE, s[1 * 33] * G8_SCALE, s[2 * 33] * G8_SCALE, s[3 * 33] * G8_SCALE); o.y = pk_fp8x4(s[4 * 33] * G8_SCALE, s[5 * 33] * G8_SCALE, s[6 * 33] * G8_SCALE, s[7 * 33] * G8_SCALE);
            *(GAS v2u_*)((GAS char*)dst + (size_t)(nrow0 + n) * dpitch + dk0 + 8 * c8) = o; }
        else { v4u o; o.x = pk2(s[0 * 33], s[1 * 33]); o.y = pk2(s[2 * 33], s[3 * 33]); o.z = pk2(s[4 * 33], s[5 * 33]); o.w = pk2(s[6 * 33], s[7 * 33]);
            *(GAS v4u*)(dst + (size_t)(nrow0 + n) * dpitch + dk0 + 8 * c8) = o; } }
    LDS_WAIT(); asm volatile("" ::: "memory");
}
constexpr int CV_EARLY = 1536 + 128 + 1536 + 768, CV_NIT = CV_EARLY + 512 + 4096 + 2048 + 512 + 128, CV_LATE_BATCHES = (CV_NIT - CV_EARLY + 7) / 8, CV_RT_BATCHES = 64, CV_PB_BATCHES = 64;
__device__ __forceinline__ void conv_item(const LayerW& w, unsigned char* ws, int l, int it, LAS float* scr, int lane) {
    bf16* Wb = (bf16*)(ws + WS_W); bf16* WIN = (bf16*)(ws + WS_W + W_IN); bf16* WOUT = (bf16*)(ws + WS_W + W_OUT);
    bf16* WGU = (bf16*)(ws + WS_W + W_GU); bf16* WDN = (bf16*)(ws + WS_W + W_D); bf16* WPG = (bf16*)(ws + WS_WPLE + l * WPLE_STRIDE + W_PG); bf16* WP = (bf16*)(ws + WS_WPLE + l * WPLE_STRIDE + W_P);
    (void)Wb;
    constexpr int I_A = 1536, I_B = 128, I_D1 = 1536, I_D2 = 768, I_E = 512, I_F = 4096, I_G = 2048, I_H1 = 512, I_H2 = 128;
    constexpr int NIT = I_A + I_B + I_D1 + I_D2 + I_E + I_F + I_G + I_H1 + I_H2;
    int r = it;
        if (r < I_A) { const int kb = r / 96, nb = r % 96, p0 = 512 + 32 * nb, pn = p0 >> 8, q0 = p0 & 255;
            const bool head = (pn >= 2 && pn <= 5) || (pn >= 8 && pn <= 11);
            const int c0 = head ? (256 * pn + 64 * ((q0 >> 5) & 3) + 32 * (q0 >> 7)) : p0;
            tr_item(w.w_in, INW, c0, 32, 64 * kb, w.g_attn, WIN, 1024, p0, 64 * kb, scr, lane); return; } r -= I_A;
        if (r < I_B) { const int kb = r / 8, nb = r % 8; tr_item(w.w_in, INW, 3584, nb == 0 ? 8 : 0, 64 * kb, w.g_attn, WIN, 1024, 3584 + 32 * nb, 64 * kb, scr, lane); return; } r -= I_B;
        if (r < I_D1) { const int n = r / 512, r2 = r % 512, kb = r2 / 32, nb = r2 % 32;
            tr_item(w.w_in, INW, 3592 + n * 1024 + 32 * nb, 32, 64 * kb, w.g_attn, (bf16*)(ws + WS_W + W_G8 + (size_t)n * 1024 * 1024), 1024, 32 * nb, 64 * kb, scr, lane, true); return; } r -= I_D1;
        if (r < I_D2) { const int n = r / 256, r2 = r % 256, kb = r2 / 32, nb = r2 % 32;
            tr_item(w.w_branch + (size_t)n * 512 * 1024, 1024, 32 * nb, 32, 64 * kb, nullptr, (bf16*)(ws + WS_W + W_BR) + (size_t)n * 1024 * 512, 512, 32 * nb, 64 * kb, scr, lane); return; } r -= I_D2;
        if (r < I_E) { const int kb = r / 32, nb = r % 32; tr_item(w.w_out, 1024, 32 * nb, 32, 64 * kb, nullptr, WOUT, 1024, 32 * nb, 64 * kb, scr, lane); return; } r -= I_E;
        if (r < I_F) { const int e = r / 256, r1 = r % 256, hf = r1 / 128, r2 = r1 % 128, kb = r2 / 8, nb = r2 % 8, q0 = 32 * nb;
            const float* src = ((q0 >> 7) ? w.wu : w.wg) + (size_t)e * 262144;
            const bool f8 = MK_MU8 && l == NL - 1;
            tr_item(src, 256, 128 * hf + (q0 & 127), 32, 64 * kb, w.g_ffn, f8 ? (bf16*)((unsigned char*)WGU + (size_t)(e * 2 + hf) * 256 * 1024) : WGU + (size_t)(e * 2 + hf) * 256 * 1024, 1024, q0, 64 * kb, scr, lane, f8); return; } r -= I_F;
        if (r < I_G) { const int e = r / 128, r2 = r % 128, kb = r2 / 32, nb = r2 % 32;
            tr_item(w.wd + (size_t)e * 262144, 1024, 32 * nb, 32, 64 * kb, nullptr, WDN + (size_t)e * 262144, 256, 32 * nb, 64 * kb, scr, lane); return; } r -= I_G;
        if (r < I_H1) { const int kb = r / 32, nb = r % 32; tr_item(w.wpg, 1024, 32 * nb, 32, 64 * kb, w.g_ple, WPG, 1024, 32 * nb, 64 * kb, scr, lane, MK_PLE8 != 0); return; } r -= I_H1;
        { const int kb = r / 32, nb = r % 32; tr_item(w.wple, 1024, 32 * nb, 32, 64 * kb, nullptr, WP, 256, 32 * nb, 64 * kb, scr, lane); }
}
__device__ __forceinline__ void conv_late_batch(const LayerW& w, unsigned char* ws, int l, LAS unsigned char* lds, int batch, int tid) {
    const int lane = tid & 63, wave = __builtin_amdgcn_readfirstlane(tid >> 6);
    if (batch < CV_LATE_BATCHES) { const int it = CV_EARLY + batch * 8 + wave; if (it < CV_NIT) conv_item(w, ws, l, it, (LAS float*)(lds + wave * 16384), lane); }
    else if (batch >= CV_LATE_BATCHES + CV_RT_BATCHES) {
        const int i0 = (batch - CV_LATE_BATCHES - CV_RT_BATCHES) * 8192 + tid; GAS v4u* PB = (GAS v4u*)(ws + OV_PB);
#pragma clang loop unroll(disable)
        for (int q0 = 0; q0 < 16; q0 += 4) { f32x4 a[4], b[4];
#pragma unroll
            for (int q = 0; q < 4; ++q) { const GAS f32x4* s = (const GAS f32x4*)(w.p) + 2 * (size_t)(i0 + (q0 + q) * 512); a[q] = s[0]; b[q] = s[1]; }
#pragma unroll
            for (int q = 0; q < 4; ++q) { v4u o; o.x = pk2(a[q].x, a[q].y); o.y = pk2(a[q].z, a[q].w); o.z = pk2(b[q].x, b[q].y); o.w = pk2(b[q].z, b[q].w); PB[i0 + (q0 + q) * 512] = o; } } }
    else { const int idx = (batch - CV_LATE_BATCHES) * 512 + tid; const int e = idx >> 10, k = idx & 1023;
        const float v = w.g_ffn[k] * (e < 4 ? w.wrg[k * 4 + e] : (e < 20 ? w.wre[k * 16 + e - 4] : 0.f));
        const unsigned hi = pk2(v, 0.f) & 0xffffu; const unsigned lo = pk2(v - bflo(hi), 0.f) & 0xffffu;
        ((bf16*)(ws + WS_W + W_RH))[idx] = (bf16)hi; ((bf16*)(ws + WS_W + W_RL))[idx] = (bf16)lo; }
}
__device__ __forceinline__ void weff_job(const LayerW& w, unsigned char* ws, LAS unsigned char* lds, int job, int tid) {
    bf16* WIN = (bf16*)(ws + WS_W + W_IN);
    LAS float* Wt = (LAS float*)lds; LAS float* Pw = (LAS float*)(lds + 36864);
    const int kb = job >> 4, g = (job >> 2) & 3, nq = job & 3, k0 = 64 * kb;
    for (int e = tid; e < 64 * 128; e += 512) { const int kk = e >> 7, c = e & 127; Wt[kk * 132 + c] = w.w_in[(size_t)(k0 + kk) * INW + 128 * g + c]; }
    for (int e = tid; e < 128 * 32; e += 512) { const int c = e >> 5, n = e & 31; Pw[c * 32 + n] = w.pool_w[(size_t)g * 16384 + c * 128 + 32 * nq + n]; }
    __syncthreads();
    const int n = tid & 31, ks = tid >> 5; float a[4] = {0.f, 0.f, 0.f, 0.f};
#pragma unroll 2
    for (int c = 0; c < 128; c += 4) {
        const float p0 = Pw[c * 32 + n], p1 = Pw[(c + 1) * 32 + n], p2 = Pw[(c + 2) * 32 + n], p3 = Pw[(c + 3) * 32 + n];
#pragma unroll
        for (int i = 0; i < 4; ++i) { const f32x4 w4 = *(const LAS f32x4*)(Wt + (ks * 4 + i) * 132 + c); a[i] += (w4.x * p0 + w4.y * p1) + (w4.z * p2 + w4.w * p3); } }
    const float sc = w.pool_scale[128 * g + 32 * nq + n];
#pragma unroll
    for (int i = 0; i < 4; ++i) a[i] *= sc * w.g_attn[k0 + ks * 4 + i];
    *(GAS unsigned long long*)(WIN + (size_t)(128 * g + 32 * nq + n) * 1024 + k0 + ks * 4) = (unsigned long long)pk2(a[0], a[1]) | ((unsigned long long)pk2(a[2], a[3]) << 32);
    __syncthreads();
}
__device__ __forceinline__ void conv_layer(const LayerW& w, unsigned char* ws, int l, LAS unsigned char* lds, int vcu, int G, int tid) {
    const int lane = tid & 63, wave = __builtin_amdgcn_readfirstlane(tid >> 6);
    LAS float* scr = (LAS float*)(lds + wave * 16384);
    const int gw = vcu * NWAVES + wave, NGW = G * NWAVES;
    for (int it = gw; it < CV_EARLY; it += NGW) conv_item(w, ws, l, it, scr, lane);
    __syncthreads();
    for (int job = vcu; job < 256; job += G) weff_job(w, ws, lds, job, tid);
}
constexpr int CV_EARLY_BATCHES = CV_EARLY / 8 + 256;
__device__ __forceinline__ void conv_early_batch(const LayerW& w, unsigned char* ws, int l, LAS unsigned char* lds, int batch, int tid) {
    const int lane = tid & 63, wave = __builtin_amdgcn_readfirstlane(tid >> 6);
    if (batch < CV_EARLY / 8) { conv_item(w, ws, l, batch * 8 + wave, (LAS float*)(lds + wave * 16384), lane); __syncthreads(); }
    else weff_job(w, ws, lds, batch - CV_EARLY / 8, tid);
}
__device__ __forceinline__ void p0_x(const float* x, const int* positions, unsigned char* ws, unsigned char* x8, int vcu, int G, int tid) {
    const int lane = tid & 63, wave = __builtin_amdgcn_readfirstlane(tid >> 6);
    bf16* XY = (bf16*)(ws + WS_XY); float* SS = (float*)(ws + WS_SS); float* CS = (float*)(ws + WS_COSSIN);
    const int gw = vcu * NWAVES + wave, NGW = G * NWAVES;
    for (int t = gw; t < T; t += NGW) {
        const GAS f32x4* xr = (const GAS f32x4*)(x + (size_t)t * 1024) + lane; float s = 0.f;
        GAS unsigned long long* o8 = (GAS unsigned long long*)(XY + (size_t)t * XYP + 1536) + lane;
#pragma unroll
        for (int j = 0; j < 4; ++j) { const f32x4 v = xr[64 * j]; s += (v.x * v.x + v.y * v.y) + (v.z * v.z + v.w * v.w); o8[64 * j] = (unsigned long long)pk2(v.x, v.y) | ((unsigned long long)pk2(v.z, v.w) << 32);
            ((GAS unsigned*)(x8 + (size_t)t * 1024))[lane + 64 * j] = pk_fp8x4(v.x, v.y, v.z, v.w); }
        s = wave_sum64(s);
        if (lane < 16) SS[(size_t)t * 16 + lane] = lane == 0 ? s : 0.f;
    }
    for (int idx = vcu * 512 + tid; idx < T * 8; idx += G * 512) { const int t = idx >> 3, i = idx & 7;
        const float invf = powf(500000.0f, -(float)(2 * i) / 16.0f); const float ang = (float)positions[t] * invf;
        CS[(size_t)t * 16 + i] = cosf(ang); CS[(size_t)t * 16 + 8 + i] = sinf(ang); }
}

typedef pg8::f32x4 (&AccRef)[2][2][4][2];
#define LAUNDER3(a, b, c) asm volatile("" : "+v"(a), "+v"(b), "+v"(c))
__device__ __forceinline__ float rstd_at(const float* SS, unsigned row) {
    const GAS f32x4* p = (const GAS f32x4*)((const GAS char*)SS + row * 64u); const f32x4 a = p[0], b = p[1], c = p[2], d = p[3];
    const float s = ((a.x + a.y) + (a.z + a.w)) + ((b.x + b.y) + (b.z + b.w)) + ((c.x + c.y) + (c.z + c.w)) + ((d.x + d.y) + (d.z + d.w));
    return rsqrtf(s * (1.0f / 1024.0f) + RMS_EPS);
}
__device__ __forceinline__ void rstd8(const float* SS, unsigned row0, int fq, float (&rs)[8]) {
    f32x4 v[8];
#pragma unroll
    for (int i = 0; i < 8; ++i) v[i] = *(const GAS f32x4*)((const GAS char*)SS + ((row0 + (unsigned)((i >> 2) * 128 + (i & 3) * 16)) * 64u + (unsigned)fq * 16u));
#pragma unroll
    for (int i = 0; i < 8; ++i) { float s = (v[i].x + v[i].y) + (v[i].z + v[i].w); s += XOR16(s); s = add_xor32(s); rs[i] = rsqrtf(s * (1.0f / 1024.0f) + RMS_EPS); }
}
__device__ __forceinline__ float logsig(float z) { return fminf(z, 0.f) - log1pf(expf(-fabsf(z))); }
struct EpiG1 {
    const float* SS; bf16* PROJ; float* LOGF; const float* CS; const float* GT; const float* ffb; int dry; const LAS float* rsl;
    __device__ __forceinline__ void operator()(AccRef acc, const pg8::Step& st, int wr, int wc, int fr_, int fq_) const {
        if (dry) return;
        int fr = fr_, fq = fq_, zz = 0; LAUNDER3(fr, fq, zz);
        const int pn = st.pn; const unsigned row0 = (unsigned)(st.pm * 256 + wr * 64 + fr);
#define RSL8(dst_) do { _Pragma("unroll") for (int i_ = 0; i_ < 8; ++i_) dst_[i_] = rsl[st.aux * 256 + (i_ >> 2) * 128 + wr * 64 + (i_ & 3) * 16 + fr]; } while (0)
        const bool head = (pn >= 2 && pn <= 5) || (pn >= 8 && pn <= 11);
        if (head) {
            const float* gain = GT + 64 * (pn < 4 ? 0 : (pn < 6 ? 1 : (pn < 10 ? 2 : 3)));
            const bool rot = pn < 6; const float osc = (pn < 4 || (pn >= 8 && pn < 10)) ? C2 : 1.0f;
            f32x4 G[2][2];
#pragma unroll
            for (int bj = 0; bj < 2; ++bj)
#pragma unroll
                for (int n = 0; n < 2; ++n) G[bj][n] = *(const GAS f32x4*)((const GAS char*)gain + (unsigned)(32 * bj + 8 * fq + 4 * n) * 4u);
            const GAS char* pb = (const GAS char*)PROJ + (unsigned)(256 * pn + 64 * wc) * 2u;
            float rs8[8]; RSL8(rs8);
            f32x4 cs[4];
#define G1_LOADCS(i_) do { if (rot && fq < 2) { const GAS f32x4* cp_ = (const GAS f32x4*)((const GAS char*)CS + (row0 + (unsigned)(((i_) >> 2) * 128 + ((i_) & 3) * 16)) * 64u); \
                _Pragma("unroll") for (int q_ = 0; q_ < 4; ++q_) cs[q_] = cp_[q_]; } } while (0)
            G1_LOADCS(0);
#pragma unroll
            for (int i = 0; i < 8; ++i) {
                v4u ov[2];
                {
                    const int ai = i >> 2, m = i & 3; const float rs = rs8[i];
                    f32x4 v[2][2]; float ss = 0.f;
#pragma unroll
                    for (int bj = 0; bj < 2; ++bj)
#pragma unroll
                        for (int n = 0; n < 2; ++n) { v[bj][n] = acc[ai][bj][m][n] * rs; const f32x4 q = v[bj][n] * v[bj][n]; ss += (q.x + q.y) + (q.z + q.w); }
                    ss += XOR16(ss); ss = add_xor32(ss);
                    const float hn = rsqrtf(ss * (1.0f / 64.0f) + RMS_EPS) * osc;
#pragma unroll
                    for (int bj = 0; bj < 2; ++bj)
#pragma unroll
                        for (int n = 0; n < 2; ++n) v[bj][n] = v[bj][n] * hn * G[bj][n];
                    if (rot) {
                        f32x4 ot[2];
#pragma unroll
                        for (int n = 0; n < 2; ++n) { ot[n].x = XOR16(v[0][n].x); ot[n].y = XOR16(v[0][n].y); ot[n].z = XOR16(v[0][n].z); ot[n].w = XOR16(v[0][n].w); }
                        if (fq < 2) {
#pragma unroll
                            for (int n = 0; n < 2; ++n) { const f32x4 c = cs[n], s = cs[2 + n]; v[0][n] = (fq == 0) ? (v[0][n] * c - ot[n] * s) : (v[0][n] * c + ot[n] * s); }
                        }
                    }
#pragma unroll
                    for (int bj = 0; bj < 2; ++bj) { ov[bj].x = pk2(v[bj][0].x, v[bj][0].y); ov[bj].y = pk2(v[bj][0].z, v[bj][0].w); ov[bj].z = pk2(v[bj][1].x, v[bj][1].y); ov[bj].w = pk2(v[bj][1].z, v[bj][1].w); }
                }
                if (i < 7) G1_LOADCS(i + 1);
                asm volatile("" ::: "memory");
                { const unsigned row = row0 + (unsigned)((i >> 2) * 128 + (i & 3) * 16);
#pragma unroll
                    for (int bj = 0; bj < 2; ++bj) *(GAS v4u*)(pb + (row * (unsigned)(PJP * 2) + (unsigned)(32 * bj + 8 * fq) * 2u)) = ov[bj]; }
                asm volatile("" ::: "memory");
            }
#undef G1_LOADCS
        } else if (pn == 14) {
            float rs14[8]; RSL8(rs14);
            if (wc == 0 && fq == 0) {
                const f32x4 b0 = *(const GAS f32x4*)ffb, b1 = *(const GAS f32x4*)(ffb + 4);
#pragma unroll
                for (int ai = 0; ai < 2; ++ai)
#pragma unroll
                    for (int m = 0; m < 4; ++m) {
                        const unsigned row = row0 + ai * 128 + m * 16; const float rs = rs14[ai * 4 + m];
                        const f32x4 z0 = acc[ai][0][m][0] * rs + b0, z1 = acc[ai][0][m][1] * rs + b1; f32x4 o0, o1;
                        o0.x = logsig(z0.x); o0.y = logsig(z0.y); o0.z = logsig(z0.z); o0.w = logsig(z0.w); o1.x = logsig(z1.x); o1.y = logsig(z1.y); o1.z = logsig(z1.z); o1.w = logsig(z1.w);
                        GAS f32x4* d = (GAS f32x4*)((GAS char*)LOGF + row * 32u); d[0] = o0; d[1] = o1;
                    }
            }
        } else {
            const GAS char* pb = (const GAS char*)PROJ + (unsigned)(256 * pn + 32 * wc) * 2u;
            float rsp[8]; RSL8(rsp);
#pragma unroll
            for (int ai = 0; ai < 2; ++ai)
#pragma unroll
                for (int m = 0; m < 4; ++m) {
                    const unsigned row = row0 + ai * 128 + m * 16; const float rs = rsp[ai * 4 + m];
#pragma unroll
                    for (int bj = 0; bj < 2; ++bj) { const f32x4 a = acc[ai][bj][m][0] * rs, b = acc[ai][bj][m][1] * rs; v4u o; o.x = pk2(a.x, a.y); o.y = pk2(a.z, a.w); o.z = pk2(b.x, b.y); o.w = pk2(b.z, b.w);
                        *(GAS v4u*)(pb + (row * (unsigned)(PJP * 2) + (unsigned)(128 * bj + 8 * fq) * 2u)) = o; }
                }
        }
    }
};
typedef unsigned v2u __attribute__((ext_vector_type(2)));
__device__ __forceinline__ unsigned pk8(float a, float b, float c, float d) {
    unsigned w = __builtin_amdgcn_cvt_pk_u8_f32(a * 256.0f - 0.5f, 0u, 0u); w = __builtin_amdgcn_cvt_pk_u8_f32(b * 256.0f - 0.5f, 1u, w); w = __builtin_amdgcn_cvt_pk_u8_f32(c * 256.0f - 0.5f, 2u, w); return __builtin_amdgcn_cvt_pk_u8_f32(d * 256.0f - 0.5f, 3u, w); }
__device__ __forceinline__ float g8(unsigned w, const int k) { return ((float)((w >> (8 * k)) & 0xffu) + 0.5f) * (1.0f / 256.0f); }
#undef RSL8
template <int PART>
struct EpiG2 {
    const float* SS; unsigned char* gs; bf16* MERGED; const LAS float* rsl;
    __device__ __forceinline__ void operator()(AccRef acc, const pg8::Step& st, int wr, int wc, int fr_, int fq_) const {
        int ln; asm volatile("v_mbcnt_lo_u32_b32 %0, -1, 0\n\tv_mbcnt_hi_u32_b32 %0, -1, %0" : "=v"(ln));
        int fr = ln & 15, fq = ln >> 4, tid = (wr * 4 + wc) * 64 + ln; LAUNDER3(fr, fq, tid); (void)fr_; (void)fq_;
        const int aux = st.aux; const unsigned row0 = (unsigned)(st.pm * 256 + wr * 64 + fr), toff = (unsigned)tid * 8u;
        const int n = aux < 3 ? aux : aux - 3; GAS char* gb = (GAS char*)gs + (size_t)n * 65536;
        GAS char* mb = (GAS char*)MERGED + (unsigned)(256 * st.pn + 32 * wc) * 2u;
        float rsg[8];
#pragma unroll
        for (int i = 0; i < 8; ++i) rsg[i] = 0.f;
        if (PART == 0) {
#pragma unroll
            for (int i = 0; i < 8; ++i) rsg[i] = rsl[(i >> 2) * 128 + wr * 64 + (i & 3) * 16 + fr]; }
#pragma unroll
        for (int ai = 0; ai < 2; ++ai) {
            v2u gn[4][2], gd[4][2];
#pragma unroll
            for (int m = 0; m < 4; ++m)
#pragma unroll
                for (int bj = 0; bj < 2; ++bj) { gn[m][bj] = (v2u){0u, 0u}; gd[m][bj] = (v2u){0u, 0u}; }
            if (PART == 1) {
#pragma unroll
                for (int m = 0; m < 4; ++m)
#pragma unroll
                    for (int bj = 0; bj < 2; ++bj) { const unsigned so = toff + (unsigned)(((ai * 4 + m) * 2 + bj) * 4096); gn[m][bj] = *(const GAS v2u*)(gb + so); if (aux < 5) gd[m][bj] = *(const GAS v2u*)(gb + 65536 + so); }
            }
            asm volatile("" ::: "memory");
#pragma unroll
            for (int m = 0; m < 4; ++m) {
                const float rs = rsg[ai * 4 + m] * (1.0f / G8_SCALE);
#pragma unroll
                for (int bj = 0; bj < 2; ++bj) {
                    const unsigned so = toff + (unsigned)(((ai * 4 + m) * 2 + bj) * 4096);
                    const f32x4 a = acc[ai][bj][m][0], b = acc[ai][bj][m][1]; const v2u n_ = gn[m][bj], d_ = gd[m][bj];
                    f32x4 fa = (f32x4){0.f, 0.f, 0.f, 0.f}, fb = fa;
                    if (PART == 0) { const float rsn = rs * -1.4426950408889634f; const f32x4 x = a * rsn, y = b * rsn; v2u o;
                        o.x = pk8(sg2(x.x), sg2(x.y), sg2(x.z), sg2(x.w)); o.y = pk8(sg2(y.x), sg2(y.y), sg2(y.z), sg2(y.w));
                        *(GAS v2u*)(gb + so) = o;
                    } else if (aux < 5) {
                        fa.x = g8(n_.x, 0) * __builtin_amdgcn_rcpf(g8(d_.x, 0)); fa.y = g8(n_.x, 1) * __builtin_amdgcn_rcpf(g8(d_.x, 1)); fa.z = g8(n_.x, 2) * __builtin_amdgcn_rcpf(g8(d_.x, 2)); fa.w = g8(n_.x, 3) * __builtin_amdgcn_rcpf(g8(d_.x, 3));
                        fb.x = g8(n_.y, 0) * __builtin_amdgcn_rcpf(g8(d_.y, 0)); fb.y = g8(n_.y, 1) * __builtin_amdgcn_rcpf(g8(d_.y, 1)); fb.z = g8(n_.y, 2) * __builtin_amdgcn_rcpf(g8(d_.y, 2)); fb.w = g8(n_.y, 3) * __builtin_amdgcn_rcpf(g8(d_.y, 3));
                    } else { v4u o;
                        o.x = pk2(a.x * g8(n_.x, 0), a.y * g8(n_.x, 1)); o.y = pk2(a.z * g8(n_.x, 2), a.w * g8(n_.x, 3)); o.z = pk2(b.x * g8(n_.y, 0), b.y * g8(n_.y, 1)); o.w = pk2(b.z * g8(n_.y, 2), b.w * g8(n_.y, 3));
                        *(GAS v4u*)(mb + ((row0 + ai * 128 + m * 16) * 2048u + (unsigned)(128 * bj + 8 * fq) * 2u)) = o;
                    }
                    acc[ai][bj][m][0] = a * fa; acc[ai][bj][m][1] = b * fb;
                    asm volatile("" : "+v"(acc[ai][bj][m][0]), "+v"(acc[ai][bj][m][1]));
                }
            }
            asm volatile("" ::: "memory");
        }
    }
};
#ifndef MK_X8
#define MK_X8 1
#endif
template <int KIND, bool SCATTER>
struct EpiRes {
    const bf16* xs; int ldxs; float* xo; bf16* xb; int ldxb; float* SSo; const float* SSi; const bf16* PW; int dry; unsigned char* x8;
    __device__ __forceinline__ void operator()(AccRef acc, const pg8::Step& st, int wr, int wc, int fr_, int fq_) const {
        if (SCATTER && st.aux == 0) return;
        int fr = fr_, fq = fq_, zz = 0; LAUNDER3(fr, fq, zz);
        const int pn = st.pn; const unsigned colb = (unsigned)(256 * pn + 32 * wc + 8 * fq);
        int rowi[8];
#pragma unroll
        for (int i = 0; i < 8; ++i) { const int r = (i >> 2) * 128 + wr * 64 + (i & 3) * 16 + fr; rowi[i] = SCATTER ? ((r < st.nvalid) ? st.rows[r] : -1) : (st.pm * 256 + r); }
        float rs8[8];
#pragma unroll
        for (int i = 0; i < 8; ++i) rs8[i] = 1.f;
        if (KIND == 1) { rstd8(SSi, (unsigned)(st.pm * 256 + wr * 64 + fr), fq, rs8);
            if (MK_PLE8) {
#pragma unroll
                for (int i = 0; i < 8; ++i) rs8[i] *= (1.0f / G8_SCALE); } }
        v4u xin[2][2][2]; v4u pwv[2][2][2];
#define RES_LOAD(p_, buf_) do { _Pragma("unroll") for (int u_ = 0; u_ < 2; ++u_) { const int i_ = 2 * (p_) + u_; const unsigned rw_ = rowi[i_] >= 0 ? (unsigned)rowi[i_] : 0u; \
            _Pragma("unroll") for (int bj_ = 0; bj_ < 2; ++bj_) { xin[buf_][u_][bj_] = *(const GAS v4u*)((const GAS char*)xs + (rw_ * (unsigned)ldxs + colb + 128u * bj_) * 2u); \
                if (KIND == 1) pwv[buf_][u_][bj_] = *(const GAS v4u*)((const GAS char*)PW + (rw_ * 1024u + colb + 128u * bj_) * 2u); } } } while (0)
        RES_LOAD(0, 0);
#pragma unroll
        for (int pr = 0; pr < 4; ++pr) {
            float ssp[2]; f32x4 xr[2][2][2];
#pragma unroll
            for (int u = 0; u < 2; ++u) {
                const int i = 2 * pr + u, ai = i >> 2, m = i & 3; const float rs = rs8[i]; float ss = 0.f;
#pragma unroll
                for (int bj = 0; bj < 2; ++bj) {
                    const v4u xv = xin[pr & 1][u][bj];
                    f32x4 x0 = (f32x4){bflo(xv.x), bfhi(xv.x), bflo(xv.y), bfhi(xv.y)}, x1 = (f32x4){bflo(xv.z), bfhi(xv.z), bflo(xv.w), bfhi(xv.w)};
                    f32x4 a = acc[ai][bj][m][0], b = acc[ai][bj][m][1];
                    if (KIND == 1) { const v4u pw = pwv[pr & 1][u][bj];
                        a.x = sigm(a.x * rs) * bflo(pw.x); a.y = sigm(a.y * rs) * bfhi(pw.x); a.z = sigm(a.z * rs) * bflo(pw.y); a.w = sigm(a.w * rs) * bfhi(pw.y);
                        b.x = sigm(b.x * rs) * bflo(pw.z); b.y = sigm(b.y * rs) * bfhi(pw.z); b.z = sigm(b.z * rs) * bflo(pw.w); b.w = sigm(b.w * rs) * bfhi(pw.w); }
                    x0 += a; x1 += b;
                    { const f32x4 q0 = x0 * x0, q1 = x1 * x1; ss += ((q0.x + q0.y) + (q0.z + q0.w)) + ((q1.x + q1.y) + (q1.z + q1.w)); }
                    xr[u][bj][0] = x0; xr[u][bj][1] = x1;
                }
                ss += XOR16(ss); ss = add_xor32(ss); ssp[u] = ss;
            }
            if (pr < 3) RES_LOAD(pr + 1, (pr + 1) & 1);
            asm volatile("" ::: "memory");
#pragma unroll
            for (int u = 0; u < 2; ++u) {
                const int i = 2 * pr + u; const bool ok = rowi[i] >= 0 && !dry; const unsigned rw = rowi[i] >= 0 ? (unsigned)rowi[i] : 0u;
                if (ok) {
#pragma unroll
                    for (int bj = 0; bj < 2; ++bj) { const f32x4 x0 = xr[u][bj][0], x1 = xr[u][bj][1];
                        if (xo) { GAS f32x4* op = (GAS f32x4*)((GAS char*)xo + (rw * 1024u + colb + 128u * bj) * 4u); op[0] = x0; op[1] = x1; }
                        if (xb) { v4u o; o.x = pk2(x0.x, x0.y); o.y = pk2(x0.z, x0.w); o.z = pk2(x1.x, x1.y); o.w = pk2(x1.z, x1.w);
                            *(GAS v4u*)((GAS char*)xb + (rw * (unsigned)ldxb + colb + 128u * bj) * 2u) = o; }
                        if (MK_X8 && x8) { v2u o2; o2.x = pk_fp8x4(x0.x, x0.y, x0.z, x0.w); o2.y = pk_fp8x4(x1.x, x1.y, x1.z, x1.w); *(GAS v2u*)((GAS char*)x8 + (rw * 1024u + colb + 128u * bj)) = o2; } }
                    if (fq == 0 && xb) *(GAS float*)((GAS char*)SSo + (rw * 16u + (unsigned)(4 * pn + wc)) * 4u) = ssp[u];
                }
            }
            asm volatile("" ::: "memory");
        }
#undef RES_LOAD
    }
};
struct EpiPW {
    bf16* O;
    __device__ __forceinline__ void operator()(AccRef acc, const pg8::Step& st, int wr, int wc, int fr_, int fq_) const {
        int fr = fr_, fq = fq_, zz = 0; LAUNDER3(fr, fq, zz);
        GAS char* ob = (GAS char*)O + (unsigned)(256 * st.pn + 32 * wc) * 2u; const unsigned row0 = (unsigned)(st.pm * 256 + wr * 64 + fr);
#pragma unroll
        for (int ai = 0; ai < 2; ++ai)
#pragma unroll
            for (int m = 0; m < 4; ++m) {
#pragma unroll
                for (int bj = 0; bj < 2; ++bj) { const f32x4 a = acc[ai][bj][m][0], b = acc[ai][bj][m][1]; v4u o; o.x = pk2(a.x, a.y); o.y = pk2(a.z, a.w); o.z = pk2(b.x, b.y); o.w = pk2(b.z, b.w);
                    *(GAS v4u*)(ob + ((row0 + ai * 128 + m * 16) * 2048u + (unsigned)(128 * bj + 8 * fq) * 2u)) = o; }
                asm volatile("" ::: "memory"); }
    }
};
struct EpiMU {
    bf16* ACT; const float* TOKW; float sc;
    __device__ __forceinline__ void operator()(AccRef acc, const pg8::Step& st, int wr, int wc, int fr_, int fq_) const {
        int fr = fr_, fq = fq_, zz = 0; LAUNDER3(fr, fq, zz);
        const int j = st.pn; GAS char* ab = (GAS char*)ACT + (size_t)st.pm * 1024 + (unsigned)(128 * j + 32 * wc) * 2u;
        int tok[8]; f32x4 tw[8];
#pragma unroll
        for (int i = 0; i < 8; ++i) { const int r = (i >> 2) * 128 + wr * 64 + (i & 3) * 16 + fr; tok[i] = (r < st.nvalid) ? st.rows[r] : -1; }
#pragma unroll
        for (int i = 0; i < 8; ++i) { tw[i] = *(const GAS f32x4*)((const GAS char*)TOKW + (unsigned)(tok[i] >= 0 ? tok[i] : 0) * 16u); if (tok[i] < 0) tw[i] = (f32x4){0.f, 0.f, 0.f, 0.f}; }
        asm volatile("" ::: "memory");
#pragma unroll
        for (int i = 0; i < 8; ++i) {
            const int ai = i >> 2, m = i & 3, r = ai * 128 + wr * 64 + m * 16 + fr;
            const float rs = tw[i].z * sc, w = (j < 2) ? tw[i].x : tw[i].y;
            const f32x4 g0 = acc[ai][0][m][0] * rs, g1 = acc[ai][0][m][1] * rs, u0 = acc[ai][1][m][0] * rs, u1 = acc[ai][1][m][1] * rs; v4u o;
            o.x = pk2(g0.x * sigm(g0.x) * u0.x * w, g0.y * sigm(g0.y) * u0.y * w); o.y = pk2(g0.z * sigm(g0.z) * u0.z * w, g0.w * sigm(g0.w) * u0.w * w);
            o.z = pk2(g1.x * sigm(g1.x) * u1.x * w, g1.y * sigm(g1.y) * u1.y * w); o.w = pk2(g1.z * sigm(g1.z) * u1.z * w, g1.w * sigm(g1.w) * u1.w * w);
            *(GAS v4u*)(ab + ((unsigned)r * 1024u + (unsigned)(8 * fq) * 2u)) = o;
            asm volatile("" ::: "memory");
        }
    }
};

__device__ __forceinline__ bool tile_order(long L, int nM, int nN, int& pm, int& pn) {
    const int nwg = nM * nN; if (L >= nwg) return false;
    int wgid = (int)L; { const int q = nwg / 8, r = nwg % 8, xcd = wgid % 8, off = wgid / 8; wgid = (xcd < r ? xcd * (q + 1) : r * (q + 1) + (xcd - r) * q) + off; }
    const int nig = 8 * nN, gid = wgid / nig, fm = gid * 8, gsz = (nM - fm) < 8 ? (nM - fm) : 8;
    pm = fm + ((wgid % nig) % gsz); pn = (wgid % nig) / gsz; return true;
}
struct SchedPlain {
    const char* A; const char* B; size_t a_tile, b_tile; int nM, nN, nt, G, c, fixa, fixb;
    __device__ __forceinline__ bool next(int i, pg8::Step& s) const {
        int pm, pn; if (!tile_order((long)i * G + c, nM, nN, pm, pn)) return false;
        s.A = A + (size_t)(fixa ? 0 : pm) * a_tile; s.B = B + (size_t)(fixb ? 0 : pn) * b_tile; s.rows = nullptr; s.nt = nt; s.pm = pm; s.pn = pn; s.aux = i; s.nvalid = 256; s.zero_after = 1; return true; }
};
template <int PART>
struct SchedG2 {
    const char* Ab; const char* Bb; int c;
    __device__ __forceinline__ bool next(int i, pg8::Step& s) const {
        if (i >= 3) return false; int pm, pn; tile_order(c, 64, 4, pm, pn);
        const int n = i;
        s.A = PART == 0 ? Ab + (size_t)pm * 256 * 1024 : Ab + (size_t)pm * 256 * (XYP * 2) + 512 * n * 2;
        s.B = Bb + ((size_t)n * 1024 + pn * 256) * 1024;
        s.rows = nullptr; s.nt = 8; s.pm = pm; s.pn = pn; s.aux = PART * 3 + i; s.nvalid = 256; s.zero_after = 0; return true; }
};
struct SchedMoE {
    volatile LAS unsigned* MISC; const int* LIST; const char* Ab; const char* Bb; int G, c, mode, f8;
    __device__ __forceinline__ bool next(int i, pg8::Step& s) const {
        const int NU = (int)MISC[MI_TOT]; const int u = c;
        if (u >= NU || i > (mode == 2 ? 1 : 0)) return false;
        const int down = mode == 2;
        int cls = 0;
#pragma unroll 1
        for (int k = 1; k < 24; ++k) if (u >= (int)MISC[MI_U0 + k]) cls = k;
        const int r = u - (int)MISC[MI_U0 + cls], k = r >> 2, j = r & 3, n_c = (int)MISC[MI_N + cls], arow = (int)MISC[MI_BASE + cls] + 256 * k;
        const int grp = cls / 6, pr = cls % 6; const int pa = pr < 3 ? 0 : (pr < 5 ? 1 : 2), pb = pr < 3 ? pr + 1 : (pr < 5 ? pr - 1 : 3);
        s.rows = LIST + (size_t)cls * T + 256 * k; s.nvalid = min(256, n_c - 256 * k); s.pm = arow; s.pn = j;
        if (!down) { const int e = grp * 4 + (j < 2 ? pa : pb), hf = j & 1;
            s.A = Ab; s.B = Bb + (size_t)(e * 2 + hf) * 256 * (f8 ? 1024 : 2048); s.nt = f8 ? 8 : 16; s.aux = cls; s.zero_after = 1; }
        else { const int sgm = i & 1; const int e = grp * 4 + (sgm ? pb : pa);
            s.A = Ab + (size_t)arow * 1024 + sgm * 512; s.B = Bb + ((size_t)e * 1024 + j * 256) * 512; s.nt = 4; s.aux = sgm; s.zero_after = sgm; }
        return true; }
};
__device__ __forceinline__ float wave_sum(float v) {
    return wave_sum64(v);
}
__device__ __forceinline__ void pool_unit(int u, const bf16* PROJ, bf16* XY, int tid_) {
    int tid = tid_; asm volatile("" : "+v"(tid));
    const int c8 = tid & 63, rg = tid >> 6, g = c8 >> 4, w = 2 << g, t0 = 256 * u + 32 * rg, s0 = t0 % S;
    const GAS char* zb = (const GAS char*)PROJ + (unsigned)c8 * 16u; GAS char* yb = (GAS char*)XY + (unsigned)c8 * 16u;
    float sum[8];
#pragma unroll
    for (int j = 0; j < 8; ++j) sum[j] = 0.f;
    { v4u pz[16];
#pragma unroll
      for (int k = 1; k <= 16; ++k) { const bool ok = k <= w && k <= s0; pz[k - 1] = *(const GAS v4u*)(zb + (unsigned)(ok ? t0 - k : t0) * (unsigned)(PJP * 2)); }
#pragma unroll
      for (int k = 1; k <= 16; ++k) { const bool ok = k <= w && k <= s0; const v4u z = pz[k - 1];
        if (ok) { sum[0] += bflo(z.x); sum[1] += bfhi(z.x); sum[2] += bflo(z.y); sum[3] += bfhi(z.y); sum[4] += bflo(z.z); sum[5] += bfhi(z.z); sum[6] += bflo(z.w); sum[7] += bfhi(z.w); } } }
#pragma clang loop unroll(disable)
    for (int r0 = 0; r0 < 32; r0 += 8) {
        v4u zz[8], qq[8];
#pragma unroll
        for (int j = 0; j < 8; ++j) { const int t = t0 + r0 + j, s = s0 + r0 + j;
            zz[j] = *(const GAS v4u*)(zb + (unsigned)t * (unsigned)(PJP * 2)); qq[j] = *(const GAS v4u*)(zb + (unsigned)(s >= w ? t - w : t) * (unsigned)(PJP * 2)); }
#pragma unroll
        for (int j = 0; j < 8; ++j) { const int t = t0 + r0 + j, s = s0 + r0 + j; const v4u z = zz[j], q = qq[j];
            float zf[8] = {bflo(z.x), bfhi(z.x), bflo(z.y), bfhi(z.y), bflo(z.z), bfhi(z.z), bflo(z.w), bfhi(z.w)};
#pragma unroll
            for (int i = 0; i < 8; ++i) sum[i] += zf[i];
            if (s >= w) { sum[0] -= bflo(q.x); sum[1] -= bfhi(q.x); sum[2] -= bflo(q.y); sum[3] -= bfhi(q.y); sum[4] -= bflo(q.z); sum[5] -= bfhi(q.z); sum[6] -= bflo(q.w); sum[7] -= bfhi(q.w); }
            const float ic = 1.0f / (float)min(s + 1, w); v4u o;
            o.x = pk2(sum[0] * ic - zf[0], sum[1] * ic - zf[1]); o.y = pk2(sum[2] * ic - zf[2], sum[3] * ic - zf[3]); o.z = pk2(sum[4] * ic - zf[4], sum[5] * ic - zf[5]); o.w = pk2(sum[6] * ic - zf[6], sum[7] * ic - zf[7]);
            *(GAS v4u*)(yb + (unsigned)t * (unsigned)(XYP * 2)) = o; }
    }
}
#ifndef MK_THRD
#define MK_THRD 32
#endif
#ifndef MK_THRF
#define MK_THRF 64
#endif
#ifndef MK_ATT_SKIP
#define MK_ATT_SKIP 0
#endif
__device__ __forceinline__ void attn_phase(const int wave0, const LayerW& w, int l, int rep, unsigned char* ws, char* lds, volatile LAS unsigned* MISC, gu32* ctl, const int dry) {
    using namespace attn_body;
    int tid = mk_tid(wave0); const int lane = tid & 63;
    bf16* PROJ = (bf16*)(ws + WS_PROJ); bf16* XY = (bf16*)(ws + WS_XY); bf16* STASH = (bf16*)(ws + WS_STASH); const float* LOGF = (const float*)(ws + WS_LOGF);
    const float lam_init = 0.8f - 0.6f * __expf(-0.3f * (float)l);
    float lam; { const float a = wave_sum(w.dlam[lane] * w.dlam[64 + lane]), c = wave_sum(w.dlam[128 + lane] * w.dlam[192 + lane]); lam = __expf(a) - __expf(c) + lam_init; lam = __int_as_float(__builtin_amdgcn_readfirstlane(__float_as_int(lam))); }
    unsigned* qhead = pg8::rflp((unsigned*)(ctl + CW_AQ) + rep); unsigned* fhead = pg8::rflp((unsigned*)(ctl + CW_AQ) + 64 + 16 * l);
    {
        unsigned* top = pg8::rflp((unsigned*)(ctl + CW_SPLIT3) + 64 * l);
#pragma clang loop unroll(disable)
        for (;;) {
            tid = mk_tid(wave0);
            if (tid == 0) { unsigned r = 0xffffffffu; if (xb_ld(top) < (unsigned)gridDim.x) { const unsigned f = atomicAdd(fhead, 1u); if (f < (unsigned)(CV_LATE_BATCHES + CV_RT_BATCHES + CV_PB_BATCHES)) r = f; } MISC[MI_Q] = r; }
            __syncthreads();
            const unsigned fb = MISC[MI_Q];
            __syncthreads();
            if (fb == 0xffffffffu) break;
            conv_late_batch(w, ws, l, (LAS unsigned char*)lds, (int)fb, tid); __syncthreads();
        }
        tid = mk_tid(wave0);
        if (tid == 0) split_wait_leader(top, (unsigned)gridDim.x);
        __syncthreads();
    }
    int first = 1;
    for (;;) {
        tid = mk_tid(wave0);
        if (tid == 0) { unsigned q = first ? (unsigned)blockIdx.x : (unsigned)gridDim.x + atomicAdd(qhead, 1u); if (q >= 832u) q = 832u + atomicAdd(fhead, 1u); MISC[MI_Q] = q; }
        first = 0;
        __syncthreads();
        const int idx = (int)MISC[MI_Q];
        __syncthreads();
        if (idx >= 832 + CV_LATE_BATCHES + CV_RT_BATCHES + CV_PB_BATCHES) break;
        if (idx >= 832) { if (MK_ATT_SKIP && dry && (MK_ATT_SKIP & 8)) continue; conv_late_batch(w, ws, l, (LAS unsigned char*)lds, idx - 832, tid); continue; }
        int kind, qb, bh;
        if (idx < 160) { kind = 0; qb = 7 - idx / 32; bh = idx % 32; }
        else if (idx < 224) { kind = 1; qb = 7; bh = idx - 160; }
        else if (idx < 256) { kind = 0; qb = 2; bh = idx - 224; }
        else if (idx < 384) { kind = 1; qb = 6 - (idx - 256) / 64; bh = (idx - 256) % 64; }
        else if (idx < 416) { kind = 0; qb = 1; bh = idx - 384; }
        else if (idx < 480) { kind = 1; qb = 4; bh = idx - 416; }
        else if (idx < 544) { kind = 2; qb = 0; bh = idx - 480; }
        else if (idx < 608) { kind = 1; qb = 3; bh = idx - 544; }
        else if (idx < 640) { kind = 0; qb = 0; bh = idx - 608; }
        else if (idx < 704) { kind = 1; qb = 2; bh = idx - 640; }
        else { kind = 1; qb = 1 - (idx - 704) / 64; bh = (idx - 704) % 64; }
        if (MK_ATT_SKIP && dry && ((MK_ATT_SKIP >> kind) & 1)) continue;
        if (kind == 2) { pool_unit(bh, PROJ, XY, tid); __syncthreads(); continue; }
        if (kind == 1) {
            const int b = bh >> 3, h = bh & 7;
            AttnP P; P.Q = PROJ + 2048 + h * 64; P.K = PROJ + 2560 + h * 64; P.V = PROJ + 3072 + h * 64; P.out = XY + 1024 + h * 64; P.stash = nullptr; P.gsub = nullptr; P.logf = LOGF + h; P.opitch = XYP; P.lam = 0.f; P.nscale = 0.f;
            attn_unit<MK_THRF, true>(tid, b, qb, 0, P, lds);
        } else {
            const int b = bh >> 2, h = bh & 3;
#pragma unroll 1
            for (int c = 0; c < 2; ++c) {
                AttnP P; P.Q = PROJ + 512 + (h * 2 + c) * 64; P.K = PROJ + 1024 + (h * 2 + c) * 64; P.V = PROJ + 1536 + h * 128;
                P.stash = STASH + h * 128; P.gsub = w.dsub; P.logf = nullptr; P.lam = lam; P.nscale = 1.0f - lam_init;
                if (c == 0) { P.out = STASH + h * 128; P.opitch = 512; } else { P.out = XY + 512 + h * 128; P.opitch = XYP; }
                attn_unit128<MK_THRD>(mk_tid(wave0), b, qb, c == 0 ? 0 : 4, P, lds); }
        }
    }
}
__device__ __forceinline__ void moe_tables(volatile LAS unsigned* MISC, const unsigned* cls_cnt, int tid) {
    __syncthreads();
    if (tid < 24) MISC[MI_N + tid] = cls_cnt[tid];
    __syncthreads();
    if (tid == 0) { unsigned base = 0, u0 = 0;
        for (int c = 0; c < 24; ++c) { const unsigned n = MISC[MI_N + c]; MISC[MI_BASE + c] = base; MISC[MI_U0 + c] = u0; const unsigned nch = (n + 255u) >> 8; base += nch * 256u; u0 += nch * 4u; }
        MISC[MI_TOT] = u0; }
    __syncthreads();
}

#ifndef MK_FIXA
#define MK_FIXA 0
#endif
#ifndef MK_FIXB
#define MK_FIXB 0
#endif
#ifndef MK_REPEAT
#define MK_REPEAT 0
#endif
constexpr int NPH = 18;
struct Prog { int p[40]; int n; };
constexpr Prog make_prog() {
    Prog g{}; int n = 0;
    for (int ph = 0; ph < NPH; ++ph) {
        const int kind = (ph == 0 || ph == 9) ? 8 : (ph >= 10 ? ph - 10 : ph - 1);
        g.p[n++] = ph; if ((MK_REPEAT >> kind) & 1) g.p[n++] = ph; }
    g.n = n; return g;
}
__constant__ const Prog PROG = make_prog();
constexpr int NPOS = make_prog().n;
template <unsigned KMASK>
__device__ __forceinline__ void mk_body() {
    typedef const __attribute__((address_space(4))) Args* KArgs;
    const KArgs args0p = (KArgs)__builtin_amdgcn_kernarg_segment_ptr();
    extern __shared__ __attribute__((aligned(16))) unsigned char lds_raw[];
    { LAS unsigned char* lds0 = (LAS unsigned char*)lds_raw;
      for (int u = threadIdx.x; u < (LDS_BYTES - MISC_OFF) / 4; u += NWAVES * 64) ((LAS unsigned*)(lds0 + MISC_OFF))[u] = 0u; }
    __syncthreads();
    const int wave0 = __builtin_amdgcn_readfirstlane(threadIdx.x >> 6);
    XcdBarrier bar = xcd_barrier_post((unsigned*)((gu32*)(args0p->ws + WS_CTL) + CW_BAR) + args0p->li * XCD_BAR_WORDS, (volatile LAS unsigned*)((LAS unsigned char*)lds_raw + MISC_OFF) + MI_BAR, threadIdx.x);
    const int ph_lo = args0p->ph_lo, ph_hi = args0p->ph_hi;
#pragma clang loop unroll(disable)
    for (int pos = ph_lo; pos < ph_hi; ++pos) {
        const int ph = __builtin_amdgcn_readfirstlane(PROG.p[pos]); const int rep = pos; const int dry = (MK_REPEAT != 0 && pos + 1 < ph_hi && __builtin_amdgcn_readfirstlane(PROG.p[pos + 1]) == ph) ? 1 : 0;
        KArgs ap = args0p; asm volatile("" : "+s"(ap));
#define args (*ap)
        LAS unsigned char* lds = (LAS unsigned char*)lds_raw;
        volatile LAS unsigned* MISC = (volatile LAS unsigned*)(lds + MISC_OFF);
        int G = gridDim.x, bx = blockIdx.x; asm volatile("" : "+s"(G), "+s"(bx)); const int vcu = (G % 8 == 0) ? (bx % 8) * (G / 8) + bx / 8 : bx;
        unsigned char* ws = args.ws; gu32* ctl = (gu32*)(ws + WS_CTL);
        float* XOUT = args.out; const float* x0 = (const float*)args.in[0];
        bf16* XY = (bf16*)(ws + WS_XY); bf16* PROJ = (bf16*)(ws + WS_PROJ);
        float* SSA = (float*)(ws + WS_SS); float* SSB = (float*)(ws + WS_SSB);
        if (ph == 0) { if constexpr (KMASK & 0x100u) { const int tid = mk_tid(wave0); const LayerW w = layer_view(ap, 0); conv_layer(w, ws, 0, lds, vcu, G, tid); p0_x(x0, (const int*)args.in[2], ws, (unsigned char*)XOUT + OUT_XB8, vcu, G, tid);
            if (tid == 0) ((unsigned*)(ctl + CW_XCC))[vcu] = xb_xcc_id() + 1u;
            if (bx == 0) { float* GT = (float*)(ctl + CW_GT); const int ll = tid >> 8, r = tid & 255, wch = r >> 6, d = r & 63;
                const float* gsrc = (const float*)(wch == 0 ? args.in[7] : (wch == 1 ? args.in[8] : (wch == 2 ? args.in[11] : args.in[12]))); GT[tid] = gsrc[ll * 64 + d]; } } }
        else if (ph == 9) { }
        else {
            const int l = __builtin_amdgcn_readfirstlane(ph >= 10 ? 1 : 0), k = __builtin_amdgcn_readfirstlane(ph - (l ? 10 : 1));
            const LayerW w = layer_view(ap, l);
            const float* SSin = l == 0 ? SSA : SSB; const float* xcur = l == 0 ? x0 : XOUT;
            if (k == 0) { if constexpr (KMASK & 1u) { const int tid = mk_tid(wave0);
                SchedPlain S{(const char*)(XY + 1536), (const char*)(ws + WS_W + W_IN), (size_t)256 * XYP * 2, (size_t)256 * 2048, 64, 15, 16, G, bx, dry & MK_FIXA, dry & MK_FIXB};
                LAS float* RSL = (LAS float*)(lds + MISC_OFF) + 1024;
                if (tid < 4) { int pm_ = -1, pn_ = 0; if (!tile_order((long)tid * G + bx, 64, 15, pm_, pn_)) pm_ = -1; MISC[112 + tid] = (unsigned)pm_; }
                __syncthreads();
#pragma unroll 1
                for (int idx = tid; idx < 1024; idx += 512) { const int pm_ = (int)MISC[112 + (idx >> 8)]; if (pm_ >= 0) RSL[idx] = rstd_at(SSin, (unsigned)(pm_ * 256 + (idx & 255))); }
                __syncthreads();
                EpiG1 E{SSin, PROJ, (float*)(ws + WS_LOGF), (const float*)(ws + WS_COSSIN), (const float*)(ctl + CW_GT) + 256 * l, w.ffb, dry, RSL};
                pg8::gemm_phase<SchedPlain, EpiG1, false, true>(tid, lds, XYP * 2, 2048, S, E);
                split_arrive_x(bar, (unsigned*)(ctl + CW_SPLIT3) + 64 * l, (unsigned*)(ctl + CW_SPLIT3) + 64 * l + 32 * 0 + 128, mk_tid(wave0));
            } } else if (k == 1) { if constexpr (KMASK & 2u) {
                attn_phase(wave0, w, l, rep, ws, (char*)lds_raw, MISC, ctl, dry);
                split_arrive_x(bar, (unsigned*)(ctl + CW_SPLIT + (2 * l) * 64), (unsigned*)(ctl + CW_SPLITX + (2 * l) * 64), mk_tid(wave0));
            } } else if (k == 2) { if constexpr (KMASK & 4u) { const int tid = mk_tid(wave0);
                unsigned char* gsc = (unsigned char*)XOUT + OUT_GATES + (size_t)bx * 196608;
                LAS float* RSL2 = (LAS float*)(lds + MISC_OFF) + 1024;
                { int pm_, pn_; tile_order(bx, 64, 4, pm_, pn_); if (tid < 256) RSL2[tid] = rstd_at(SSin, (unsigned)(pm_ * 256 + tid)); __syncthreads(); }
                { SchedG2<0> S{(const char*)XOUT + OUT_XB8, (const char*)(ws + WS_W + W_G8), bx};
                  EpiG2<0> E{SSin, gsc, (bf16*)(ws + WS_MERGED), RSL2};
                  pg8::gemm_phase<SchedG2<0>, EpiG2<0>, false, true, true>(tid, lds, 1024, 1024, S, E); }
                { const int t2 = mk_tid(wave0); if (t2 == 0) split_wait_leader((unsigned*)(ctl + CW_SPLIT + (2 * l) * 64), (unsigned)G); __syncthreads(); }
                { SchedG2<1> S{(const char*)XY, (const char*)(ws + WS_W + W_BR), bx};
                  EpiG2<1> E{SSin, gsc, (bf16*)(ws + WS_MERGED), RSL2};
                  pg8::gemm_phase<SchedG2<1>, EpiG2<1>, false, true>(mk_tid(wave0), lds, XYP * 2, 1024, S, E); }
                { int pm_, pn_; tile_order(bx, 64, 4, pm_, pn_); group4_sync((unsigned*)(ctl + CW_G4 + ((2 * l) * 64 + pm_) * 32), mk_tid(wave0)); }
            } } else if (k == 3) { if constexpr (KMASK & 8u) { const int tid = mk_tid(wave0);
                SchedPlain S{(const char*)(ws + WS_MERGED), (const char*)(ws + WS_W + W_OUT), (size_t)256 * 2048, (size_t)256 * 2048, 64, 4, 16, G, bx, 0, 0};
                EpiRes<0, false> E{XY + 1536, XYP, nullptr, XY + 1536, XYP, SSA, nullptr, nullptr, dry, (MK_MU8 && l == NL - 1) ? (unsigned char*)XOUT + OUT_XB8 : nullptr};
                pg8::gemm_phase<SchedPlain, EpiRes<0, false>, false, true>(tid, lds, 2048, 2048, S, E);
                { int pm_, pn_; tile_order(bx, 64, 4, pm_, pn_); group4_sync((unsigned*)(ctl + CW_G4 + ((2 * l + 1) * 64 + pm_) * 32), mk_tid(wave0)); }
            } } else if (k == 4) { if constexpr (KMASK & 16u) { const int tid = mk_tid(wave0);
                {
                    typedef float f32x16r __attribute__((ext_vector_type(16))); typedef short bf16x8r __attribute__((ext_vector_type(8)));
                    const int lane_ = tid & 63, r32 = lane_ & 31, hh = lane_ >> 5, wv = __builtin_amdgcn_readfirstlane(tid >> 6); int pm_, pn_; tile_order(bx, 64, 4, pm_, pn_); const int t0 = pm_ * 256 + pn_ * 64;
                    unsigned* ccnt = (unsigned*)(ctl + CW_CLS + 32 * l + 64 * dry); int* LIST = (int*)(ws + WS_LIST);
                    const GAS char* wrh = (const GAS char*)(ws + WS_W + W_RH) + (unsigned)(r32 * 2048 + (128 * wv + 8 * hh) * 2);
                    const GAS char* xb_ = (const GAS char*)(XY + 1536) + (size_t)t0 * (XYP * 2) + (unsigned)(r32 * (XYP * 2) + (128 * wv + 8 * hh) * 2);
                    f32x16r acc0 = {}, acc1 = {};
#pragma unroll 2
                    for (int ks = 0; ks < 8; ++ks) {
                        const bf16x8r Bh = *(const GAS bf16x8r*)(wrh + ks * 32), Bl = *(const GAS bf16x8r*)(wrh + 65536 + ks * 32);
                        const bf16x8r A0 = *(const GAS bf16x8r*)(xb_ + ks * 32), A1 = *(const GAS bf16x8r*)(xb_ + 32 * (XYP * 2) + ks * 32);
                        acc0 = __builtin_amdgcn_mfma_f32_32x32x16_bf16(A0, Bh, acc0, 0, 0, 0); acc0 = __builtin_amdgcn_mfma_f32_32x32x16_bf16(A0, Bl, acc0, 0, 0, 0);
                        acc1 = __builtin_amdgcn_mfma_f32_32x32x16_bf16(A1, Bh, acc1, 0, 0, 0); acc1 = __builtin_amdgcn_mfma_f32_32x32x16_bf16(A1, Bl, acc1, 0, 0, 0);
                    }
                    LAS float* Pp = (LAS float*)lds;
                    LAS float* Lg = (LAS float*)(lds + 65536);
#pragma unroll
                    for (int r = 0; r < 16; ++r) { const int tk = (r & 3) + 8 * (r >> 2) + 4 * hh; Pp[(wv * 64 + tk) * 32 + r32] = acc0[r]; Pp[(wv * 64 + 32 + tk) * 32 + r32] = acc1[r]; }
                    __syncthreads();
                    { const int tk = tid >> 3, n4 = (tid & 7) * 4; f32x4 s = (f32x4){0.f, 0.f, 0.f, 0.f};
#pragma unroll
                      for (int w8 = 0; w8 < 8; ++w8) s += *(const LAS f32x4*)(Pp + (w8 * 64 + tk) * 32 + n4);
                      *(LAS f32x4*)(Lg + tk * 32 + n4) = s; }
                    __syncthreads();
                    if (tid < 64) { const int t = t0 + tid; float dg[4], de[16];
#pragma unroll
                        for (int e = 0; e < 4; ++e) dg[e] = Lg[tid * 32 + e];
#pragma unroll
                        for (int e = 0; e < 16; ++e) de[e] = Lg[tid * 32 + 4 + e];
                        const float rstd = rstd_at(SSA, (unsigned)t); float wa, wb; const int cls = route_decide(dg, de, rstd, w.brg, w.bre, wa, wb);
                        *(GAS f32x4*)((GAS char*)(ws + WS_TOKW) + (unsigned)t * 16u) = (f32x4){wa, wb, rstd, 0.f}; MISC[128 + tid] = (unsigned)cls; }
                    __syncthreads();
                    if (tid < 64) {
                        const unsigned mycls = MISC[128 + tid]; const unsigned long long ltm = (1ull << tid) - 1ull; unsigned cnt_c = 0, rank = 0;
#pragma unroll 4
                        for (unsigned c = 0; c < 24; ++c) { const unsigned long long m = __ballot(mycls == c); if ((unsigned)tid == c) cnt_c = (unsigned)__popcll(m); if (mycls == c) rank = (unsigned)__popcll(m & ltm); }
                        unsigned base = 0; if (tid < 24 && cnt_c) base = atomicAdd(ccnt + tid, cnt_c);
                        const unsigned mybase = (unsigned)__builtin_amdgcn_ds_bpermute((int)(mycls << 2), (int)base);
                        LIST[(size_t)mycls * T + mybase + rank] = t0 + tid; }
                    __syncthreads();
                }
                split_arrive_x(bar, (unsigned*)(ctl + CW_SPLIT + (2 * l + 1) * 64), (unsigned*)(ctl + CW_SPLITX + (2 * l + 1) * 64), mk_tid(wave0));
            } } else if (k == 5) { if constexpr (KMASK & 96u) { int tid = mk_tid(wave0);
                if (tid == 0) split_wait_leader((unsigned*)(ctl + CW_SPLIT + (2 * l + 1) * 64), (unsigned)G);
                __syncthreads();
                moe_tables(MISC, (const unsigned*)(ctl + CW_CLS + 32 * l), tid);
                const int NUm = (int)MISC[MI_TOT], KO = NUm > 256 ? (NUm - 256) >> 2 : 0;
                const int gid = vcu >> 2, m4 = vcu & 3, xg = gid >> 3, lg = gid & 7;
                const int k_o = lg * 8 + xg, k_p = (lg - 4) * 8 + xg;
                const bool is_o = lg < 4 && k_o < KO, is_p = lg >= 4 && k_p < KO;
                unsigned* cA = (unsigned*)(ctl + CW_MOE2 + 3584 * l); unsigned* cB = cA + 2048; unsigned* cO = cA + 3072;
#pragma clang loop unroll(disable)
                for (int r = 0; r < 2; ++r) {
                    const int u = r == 0 ? vcu : 256 + 4 * k_o + m4; if (r == 1 && !is_o) break;
                    tid = mk_tid(wave0);
                    { SchedMoE S{MISC, (const int*)(ws + WS_LIST), (const char*)(XY + 1536), (const char*)(ws + WS_W + W_GU), G, u, 0, 0};
                      EpiMU E{(bf16*)(ws + OV_ACT), (const float*)(ws + WS_TOKW), 1.0f};
                      pg8::gemm_phase<SchedMoE, EpiMU, true, true>(tid, lds, XYP * 2, 2048, S, E); }
                    if (r == 0 && is_o) {
                        asm volatile("s_waitcnt vmcnt(0)" ::: "memory"); __syncthreads();
                        tid = mk_tid(wave0);
                        if (tid == 0) { const unsigned me = xb_xcc_id() + 1u; bool same = true;
#pragma unroll
                            for (int i = 0; i < 4; ++i) same = same && (xb_ld((unsigned*)(ctl + CW_XCC) + (gid + 4) * 4 + i) == me);
                            if (!same) { __builtin_amdgcn_fence(__ATOMIC_RELEASE, "agent"); asm volatile("s_waitcnt vmcnt(0)" ::: "memory"); }
                            xb_add(cO + 16 * k_o, 1u); asm volatile("s_waitcnt vmcnt(0)" ::: "memory"); }
                        __syncthreads();
                    }
                }
                group4_sync(is_o ? cB + 32 * k_o : cA + 32 * gid, mk_tid(wave0));
#pragma clang loop unroll(disable)
                for (int r = 0; r < 2; ++r) {
                    const int u = r == 0 ? (is_o ? 256 + 4 * k_o + m4 : vcu) : 4 * (gid - 4) + m4; if (r == 1 && !is_p) break;
                    tid = mk_tid(wave0);
                    if (r == 1) {
                        if (tid == 0) { unsigned sp = 0; while (xb_ld(cO + 16 * k_p) < 4u) { __builtin_amdgcn_s_sleep(2); if (++sp > (1u << 22)) break; }
                            __builtin_amdgcn_fence(__ATOMIC_ACQUIRE, "agent"); asm volatile("s_waitcnt vmcnt(0)" ::: "memory"); }
                        __syncthreads();
                    }
                    SchedMoE S{MISC, (const int*)(ws + WS_LIST), (const char*)(ws + OV_ACT), (const char*)(ws + WS_W + W_D), G, u, 2, 0};
                    EpiRes<0, true> E{XY + 1536, XYP, nullptr, (bf16*)(ws + OV_XB2), 1024, SSA, nullptr, nullptr, dry, MK_PLE8 ? ws + WS_MERGED : nullptr};
                    pg8::gemm_phase<SchedMoE, EpiRes<0, true>, false, true>(tid, lds, 1024, 512, S, E);
                }
                { unsigned* fqh = pg8::rflp((unsigned*)(ctl + CW_FQ) + 64 * l); const int NF = 256 + (l + 1 < NL ? CV_EARLY_BATCHES : 0);
                  int arrived = 0;
                  for (;;) {
                    const int tq = mk_tid(wave0);
                    if (tq == 0) MISC[MI_Q] = atomicAdd(fqh, 1u);
                    __syncthreads();
                    const int idx = (int)MISC[MI_Q];
                    __syncthreads();
                    if (idx >= 256 && !arrived) { split_arrive_x(bar, (unsigned*)(ctl + CW_SPLIT3) + 256 + 64 * l, (unsigned*)(ctl + CW_SPLIT3) + 512 + 64 * l, mk_tid(wave0)); arrived = 1; }
                    if (idx >= NF) break;
                    if (idx < 256) {
                        SchedPlain S2{(const char*)(ws + OV_PB), (const char*)(ws + WS_WPLE + l * WPLE_STRIDE + W_P), (size_t)256 * 512, (size_t)256 * 512, 64, 4, 4, 1 << 20, idx, 0, 0};
                        EpiPW E2{(bf16*)(ws + OV_PW)};
                        pg8::gemm_phase<SchedPlain, EpiPW, false, true>(tq, lds, 512, 512, S2, E2);
                    } else { const LayerW w1 = layer_view(ap, 1); conv_early_batch(w1, ws, 1, lds, idx - 256, tq); }
                  } }
            } } else if (k == 6) { if constexpr (KMASK & 96u) {
            } } else { if constexpr (KMASK & 128u) { const int tid = mk_tid(wave0);
                if (tid == 0) split_wait_leader((unsigned*)(ctl + CW_SPLIT3) + 256 + 64 * l, (unsigned)G);
                __syncthreads();
                constexpr int P8 = MK_PLE8 ? 1 : 0;
                SchedPlain S{(const char*)(ws + (P8 ? WS_MERGED : OV_XB2)), (const char*)(ws + WS_WPLE + l * WPLE_STRIDE + W_PG), (size_t)256 * (P8 ? 1024 : 2048), (size_t)256 * (P8 ? 1024 : 2048), 64, 4, P8 ? 8 : 16, G, bx, 0, 0};
                EpiRes<1, false> E{(const bf16*)(ws + OV_XB2), 1024, l == NL - 1 ? XOUT : nullptr, l == NL - 1 ? nullptr : XY + 1536, XYP, SSB, SSA, (const bf16*)(ws + OV_PW), dry, l == NL - 1 ? nullptr : (unsigned char*)XOUT + OUT_XB8};
                pg8::gemm_phase<SchedPlain, EpiRes<1, false>, false, true, P8 != 0>(tid, lds, P8 ? 1024 : 2048, P8 ? 1024 : 2048, S, E);
            } }
        }
        const int kk_ = (ph == 0 || ph == 9) ? -1 : (ph >= 10 ? ph - 10 : ph - 1);
        if (pos + 1 < ph_hi && ph != 9 && (MK_REPEAT != 0 || kk_ > 6 || kk_ < 0)) { xcd_barrier(bar, mk_tid(wave0));
#ifdef MK_DOUBLE_BAR
            xcd_barrier(bar, mk_tid(wave0)); xcd_barrier(bar, mk_tid(wave0));
#endif
        }
#undef args
    }
}

#ifndef MK_KMASKS
#ifdef MK_SPLIT_TEST
#define MK_KMASKS 0x100u
#else
#define MK_KMASKS 0x1FFu
#endif
#endif
__global__ void __launch_bounds__(NWAVES * 64, 2) mk_fwd(Args args) { mk_body<MK_KMASKS>(); }
#ifdef MK_SPLIT_TEST
__global__ void __launch_bounds__(NWAVES * 64, 2) mk_t0(Args args) { mk_body<1u>(); }
__global__ void __launch_bounds__(NWAVES * 64, 2) mk_t1(Args args) { mk_body<2u>(); }
__global__ void __launch_bounds__(NWAVES * 64, 2) mk_t2(Args args) { mk_body<4u>(); }
__global__ void __launch_bounds__(NWAVES * 64, 2) mk_t3(Args args) { mk_body<8u>(); }
__global__ void __launch_bounds__(NWAVES * 64, 2) mk_t4(Args args) { mk_body<16u>(); }
__global__ void __launch_bounds__(NWAVES * 64, 2) mk_t5(Args args) { mk_body<32u>(); }
__global__ void __launch_bounds__(NWAVES * 64, 2) mk_t6(Args args) { mk_body<64u>(); }
__global__ void __launch_bounds__(NWAVES * 64, 2) mk_t7(Args args) { mk_body<128u>(); }
__global__ void __launch_bounds__(NWAVES * 64, 2) mk_t8(Args args) { mk_body<256u>(); }
#endif
#ifndef MK_ONE_LAUNCH
#define MK_ONE_LAUNCH 0
#endif
#ifndef MK_OPT_MASK
#define MK_OPT_MASK 0x3FFFF
#endif
static void ref_phase(int l, int k, void* const* d_in, float* XOUT, unsigned char* ws, hipStream_t st) {
    using namespace refp;
    const float* x0 = (const float*)d_in[0]; const float* p = (const float*)d_in[1]; const int* pos = (const int*)d_in[2];
    const float* g_attn = (const float*)d_in[3] + l * 1024; const float* w_in_l = (const float*)d_in[4] + (size_t)l * 1024 * INW;
    const float* pool_w = (const float*)d_in[5] + (size_t)l * 4 * 128 * 128; const float* pool_scale = (const float*)d_in[6] + l * 512;
    const float* dqn = (const float*)d_in[7] + l * 64; const float* dkn = (const float*)d_in[8] + l * 64; const float* dlam = (const float*)d_in[9] + l * 256;
    const float* dsub = (const float*)d_in[10] + l * 128; const float* fqn = (const float*)d_in[11] + l * 64; const float* fkn = (const float*)d_in[12] + l * 64;
    const float* ffb = (const float*)d_in[13] + l * 8; const float* w_branch_l = (const float*)d_in[14] + (size_t)l * 3 * 512 * 1024; const float* w_out_l = (const float*)d_in[15] + (size_t)l * 1024 * 1024;
    const float* g_ffn = (const float*)d_in[16] + l * 1024; const float* wrg = (const float*)d_in[17] + (size_t)l * 1024 * 4; const float* brg = (const float*)d_in[18] + l * 4;
    const float* wre = (const float*)d_in[19] + (size_t)l * 1024 * 16; const float* bre = (const float*)d_in[20] + l * 16;
    const float* wg_l = (const float*)d_in[21] + (size_t)l * 16 * 1024 * 256; const float* wu_l = (const float*)d_in[22] + (size_t)l * 16 * 1024 * 256; const float* wd_l = (const float*)d_in[23] + (size_t)l * 16 * 256 * 1024;
    const float* g_ple = (const float*)d_in[24] + l * 1024; const float* wpg_l = (const float*)d_in[25] + (size_t)l * 1024 * 1024; const float* wple_l = (const float*)d_in[26] + (size_t)l * 256 * 1024;
    const float* p_l = p + (size_t)l * T * 256;
    float* SSA = (float*)(ws + WS_SS); float* SSB = (float*)(ws + WS_SSB); float* RS = (float*)(ws + WS_RSTD); float* LOGF = (float*)(ws + WS_LOGF); float* FCUM = (float*)(ws + WS_FCUM); float* TOKW = (float*)(ws + WS_TOKW); int* LIST = (int*)(ws + WS_LIST);
    bf16* XY = (bf16*)(ws + WS_XY); bf16* PROJ = (bf16*)(ws + WS_PROJ); float* CH = (float*)(ws + WS_STASH); bf16* MERGED = (bf16*)(ws + WS_MERGED); float* TMP = (float*)(ws + WS_PROJ);
    unsigned* cls_cnt = (unsigned*)(ws + WS_CTL) + CW_CLS + 32 * l;
    const float* xcur = l == 0 ? x0 : XOUT; float* SSin = l == 0 ? SSA : SSB;
    const float lam_init = 0.8f - 0.6f * expf(-0.3f * (float)l);
    if (k == -1) { k_rowstats<<<T / 4, 256, 0, st>>>(x0, XY + 1536, XYP, SSA, RS, nullptr); return; }
    if (k == 0) {
        k_ref_rstd<<<T / 256, 256, 0, st>>>(SSin, RS);
        for (int cc = 0; cc < 14; ++cc) {
            k_ref_gemm<<<dim3(4, T / 64), 256, 0, st>>>(XnormLoader{xcur, RS, g_attn}, w_in_l + 256 * cc, INW, 256, 1024, EpiStoreF32{CH, 256, 0});
            int kind = 2; const float* gain = nullptr; int rot = 0; float osc = 1.f;
            if (cc < 2) kind = 0;
            else if (cc < 4) { kind = 1; gain = dqn; rot = 1; osc = C2; }
            else if (cc < 6) { kind = 1; gain = dkn; rot = 1; }
            else if (cc >= 8 && cc < 10) { kind = 1; gain = fqn; osc = C2; }
            else if (cc >= 10 && cc < 12) { kind = 1; gain = fkn; }
            k_ref_epi1<<<T, 256, 0, st>>>(CH, cc, kind, pool_w, pool_scale, gain, rot, osc, pos, PROJ);
        }
        k_ref_gemm<<<dim3(1, T / 64), 256, 0, st>>>(XnormLoader{xcur, RS, g_attn}, w_in_l + 3584, INW, 8, 1024, EpiStoreF32{CH, 8, 0});
        k_ref_logf<<<T * 8 / 256, 256, 0, st>>>(CH, ffb, LOGF);
    } else if (k == 1) {
        k_ref_fscan<<<1, 64, 0, st>>>(LOGF, FCUM);
        k_ref_fox<<<T * 8 / 4, 256, 0, st>>>(PROJ, FCUM, XY);
        k_ref_diff<<<T * 4 / 2, 128, 0, st>>>(PROJ, dlam, dsub, lam_init, XY);
        k_ref_pool<<<T * 512 / 256, 256, 0, st>>>(PROJ, XY);
    } else if (k == 2) {
        k_ref_rstd<<<T / 256, 256, 0, st>>>(SSin, RS);
        k_ref_gemm2<<<dim3(16, T / 64), 256, 0, st>>>(xcur, RS, g_attn, w_in_l, w_branch_l, XY, MERGED);
    } else if (k == 3) {
        k_ref_gemm<<<dim3(16, T / 64), 256, 0, st>>>(Bf16Loader{MERGED, 1024, 0}, w_out_l, 1024, 1024, 1024, EpiResid{xcur, XOUT});
        k_rowstats<<<T / 4, 256, 0, st>>>(XOUT, XY + 1536, XYP, SSA, RS, nullptr);
    } else if (k == 4) {
        k_route<<<T / 4, 256, 0, st>>>(XOUT, g_ffn, wrg, brg, wre, bre, cls_cnt, LIST, TOKW);
    } else if (k == 5) {
        k_ref_rstd<<<T / 256, 256, 0, st>>>(SSA, RS);
        k_ref_moe<<<dim3(T / 8, 24), 256, 0, st>>>(XOUT, RS, g_ffn, (const int*)cls_cnt, LIST, TOKW, wg_l, wu_l, wd_l);
        k_rowstats<<<T / 4, 256, 0, st>>>(XOUT, (bf16*)(ws + OV_XB2), 1024, SSA, RS, nullptr);
    } else if (k == 7) {
        k_ref_rstd<<<T / 256, 256, 0, st>>>(SSA, RS);
        k_ref_ple<<<dim3(16, T / 64), 256, 0, st>>>(XOUT, RS, g_ple, wpg_l, p_l, wple_l, TMP);
        k_rowstats<<<T / 4, 256, 0, st>>>(TMP, XY + 1536, XYP, SSB, RS, XOUT);
    }
}

extern "C" void kernel_launch(void* const* d_in, const int* in_sizes, int n_in, void* d_out, int out_size, void* d_ws, size_t ws_size, hipStream_t stream) {
    static int grid = 0;
    if (grid == 0) {
        if (n_in != 27 || out_size != T * DM || ws_size < WS_END) { fprintf(stderr, "kernel_launch: unexpected shapes (n_in %d out %d ws %zu)\n", n_in, out_size, ws_size); grid = -1; return; }
        int dev = 0, cus = 0;
        if (hipGetDevice(&dev) != hipSuccess || hipDeviceGetAttribute(&cus, hipDeviceAttributeMultiprocessorCount, dev) != hipSuccess) { grid = -1; return; }
        if (hipFuncSetAttribute((const void*)mk_fwd, hipFuncAttributeMaxDynamicSharedMemorySize, LDS_BYTES) != hipSuccess) { fprintf(stderr, "kernel_launch: hipFuncSetAttribute failed\n"); grid = -1; return; }
#if !MK_ONE_LAUNCH
        { const void* ks[9] = {(const void*)mk_t0, (const void*)mk_t1, (const void*)mk_t2, (const void*)mk_t3, (const void*)mk_t4, (const void*)mk_t5, (const void*)mk_t6, (const void*)mk_t7, (const void*)mk_t8};
          for (int i = 0; i < 9; ++i) (void)hipFuncSetAttribute(ks[i], hipFuncAttributeMaxDynamicSharedMemorySize, LDS_BYTES); }
#endif
        int per_cu = 0;
        if (hipOccupancyMaxActiveBlocksPerMultiprocessor(&per_cu, mk_fwd, NWAVES * 64, LDS_BYTES) != hipSuccess || per_cu < 1) { fprintf(stderr, "kernel_launch: occupancy query failed (%d)\n", per_cu); grid = -1; return; }
        (void)hipGetLastError();
        grid = cus;
    }
    if (grid < 0) return;
    (void)hipMemsetAsync((char*)d_ws + WS_CTL, 0, MK_ONE_LAUNCH ? (size_t)192 * 1024 : CTL_BYTES, stream);
    Args a{};
    for (int i = 0; i < 27; ++i) a.in[i] = d_in[i];
    a.out = (float*)d_out; a.ws = (unsigned char*)d_ws;
#if MK_ONE_LAUNCH
    a.ph_lo = 0; a.ph_hi = NPOS; a.li = 0;
    hipLaunchKernelGGL(mk_fwd, dim3(grid), dim3(NWAVES * 64), LDS_BYTES, stream, a);
#else
    const unsigned mask = MK_OPT_MASK; int li = 0;
    typedef void (*kern_t)(Args);
    const kern_t ks[9] = {mk_t0, mk_t1, mk_t2, mk_t3, mk_t4, mk_t5, mk_t6, mk_t7, mk_t8};
#define LAUNCH_PH(kk) hipLaunchKernelGGL(ks[kk], dim3(grid), dim3(NWAVES * 64), LDS_BYTES, stream, a)
    for (int ph = 0; ph < NPH; ++ph) {
        const bool opt = (mask >> ph) & 1u;
        const int l = ph >= 10 ? 1 : 0, k = ph == 0 ? -1 : (ph == 9 ? -2 : ph - (l ? 10 : 1));
        if (ph == 0) {
            a.ph_lo = 0; a.ph_hi = 1; a.li = li++; LAUNCH_PH(8);
            if (!opt) ref_phase(0, -1, d_in, (float*)d_out, (unsigned char*)d_ws, stream);
            continue; }
        if (ph == 9) { a.ph_lo = 9; a.ph_hi = 10; a.li = li++; LAUNCH_PH(8); continue; }
        if (opt) { a.ph_lo = ph; a.ph_hi = ph + 1; a.li = li++; LAUNCH_PH(k); }
        else if (k != 6) ref_phase(l, k, d_in, (float*)d_out, (unsigned char*)d_ws, stream);
    }
#endif
}
```

```cpp
#include <hip/hip_runtime.h>
#include <cstdio>
#include <cstdint>
#include <cmath>
typedef unsigned short bf16;
constexpr int T = 16384, DM = 1024, S = 2048, NB = 8, NL = 2, INW = 6664;
constexpr float RMS_EPS = 1e-6f;
constexpr float C2 = 0.125f * 1.4426950408889634f;
constexpr size_t MiB = 1u << 20;
constexpr size_t WS_CTL = 0, CTL_BYTES = 1 * MiB;
constexpr size_t WS_SS = 1 * MiB;
constexpr size_t WS_LOGF = 2 * MiB;
constexpr size_t WS_FCUM = 2 * MiB + 512 * 1024;
constexpr size_t WS_TOKW = 3 * MiB;
constexpr size_t WS_RSTD = 3 * MiB + 256 * 1024;
constexpr size_t WS_LIST = 3 * MiB + 512 * 1024;
constexpr size_t WS_COSSIN = 5 * MiB;
constexpr size_t WS_SSB = 49 * MiB;
constexpr size_t WS_W = 6 * MiB;
constexpr size_t WS_WPLE = 52 * MiB;
constexpr size_t WS_XY = 57 * MiB;
constexpr size_t WS_PROJ = 137 * MiB;
constexpr size_t WS_STASH = 249 * MiB;
constexpr size_t WS_MERGED = WS_PROJ + 96 * MiB;
constexpr size_t WS_PB = 265 * MiB;
constexpr size_t WS_END = 273 * MiB;
constexpr int XYP = 2560, PJP = 3584;
constexpr int CW_CLS = 64;
constexpr int CW_AQ = 256;
constexpr int CW_G4 = 16384;
constexpr int CW_SPLIT3 = 24576;
constexpr int CW_MOE2 = 32768;
constexpr int CW_XCC = 40960;
constexpr int CW_GT = 131072;
constexpr int CW_MOEG = 512;
constexpr int CW_SPLIT = 5632;
constexpr int CW_SPLITX = 5888;
constexpr int CW_FQ = 6144;
constexpr int CW_BAR = 8192;
#define MK_ONE_LAUNCH 1
namespace refp {

__device__ __forceinline__ float bf2f(bf16 v) { return __uint_as_float((unsigned)v << 16); }
__device__ __forceinline__ bf16 f2b(float f) { unsigned u = __float_as_uint(f); return (bf16)((u + 0x7fffu + ((u >> 16) & 1u)) >> 16); }
__device__ __forceinline__ float wsum(float v) {
#pragma unroll
    for (int o = 1; o < 64; o <<= 1) v += __shfl_xor(v, o);
    return v;
}
__device__ __forceinline__ float wmax(float v) {
#pragma unroll
    for (int o = 1; o < 64; o <<= 1) v = fmaxf(v, __shfl_xor(v, o));
    return v;
}
__device__ __forceinline__ float row_rstd(const float* SS, int t) {
    float s = 0.f;
#pragma unroll
    for (int i = 0; i < 16; ++i) s += SS[(size_t)t * 16 + i];
    return rsqrtf(s * (1.0f / 1024.0f) + RMS_EPS);
}

__global__ void __launch_bounds__(256) k_rowstats(const float* __restrict__ xsrc, bf16* XBdst, int ldxb, float* SS, float* RSTD, float* xcopy) {
    const int t = blockIdx.x * 4 + (threadIdx.x >> 6), lane = threadIdx.x & 63;
    const float* xr = xsrc + (size_t)t * 1024;
    float s = 0.f;
    for (int j = 0; j < 16; ++j) { const int k = lane + 64 * j; const float v = xr[k]; s += v * v; XBdst[(size_t)t * ldxb + k] = f2b(v); if (xcopy) xcopy[(size_t)t * 1024 + k] = v; }
    s = wsum(s);
    if (lane < 16) SS[(size_t)t * 16 + lane] = (lane == 0) ? s : 0.f;
    if (lane == 0) RSTD[t] = rsqrtf(s * (1.0f / 1024.0f) + RMS_EPS);
}
__global__ void k_ref_rstd(const float* __restrict__ SS, float* RSTD) { const int t = blockIdx.x * blockDim.x + threadIdx.x; if (t < T) RSTD[t] = row_rstd(SS, t); }

struct XnormLoader { const float* x; const float* RS; const float* g;
    __device__ __forceinline__ float operator()(int t, int k) const { return x[(size_t)t * 1024 + k] * RS[t] * g[k]; } };
struct Bf16Loader { const bf16* A; int lda; int pad;
    __device__ __forceinline__ float operator()(int t, int k) const { return bf2f(A[(size_t)t * lda + k]); } };
struct F32Loader { const float* A; int lda; int pad;
    __device__ __forceinline__ float operator()(int t, int k) const { return A[(size_t)t * lda + k]; } };

template <class AL, class EPI>
__global__ void __launch_bounds__(256) k_ref_gemm(AL al, const float* __restrict__ W, int ldw, int N, int K, EPI epi) {
    __shared__ float sA[16][65], sB[16][65];
    const int tx = threadIdx.x & 15, ty = threadIdx.x >> 4, t0 = blockIdx.y * 64, n0 = blockIdx.x * 64;
    float acc[4][4] = {};
    for (int k0 = 0; k0 < K; k0 += 16) {
        for (int e = threadIdx.x; e < 1024; e += 256) { const int r = e >> 4, kk = e & 15; sA[kk][r] = al(t0 + r, k0 + kk); }
        for (int e = threadIdx.x; e < 1024; e += 256) { const int kk = e >> 6, c = e & 63; sB[kk][c] = (n0 + c < N) ? W[(size_t)(k0 + kk) * ldw + n0 + c] : 0.f; }
        __syncthreads();
#pragma unroll
        for (int kk = 0; kk < 16; ++kk) {
            float a[4], b[4];
#pragma unroll
            for (int i = 0; i < 4; ++i) { a[i] = sA[kk][ty * 4 + i]; b[i] = sB[kk][tx * 4 + i]; }
#pragma unroll
            for (int i = 0; i < 4; ++i)
#pragma unroll
                for (int j = 0; j < 4; ++j) acc[i][j] += a[i] * b[j];
        }
        __syncthreads();
    }
#pragma unroll
    for (int i = 0; i < 4; ++i)
#pragma unroll
        for (int j = 0; j < 4; ++j) { const int n = n0 + tx * 4 + j; if (n < N) epi(t0 + ty * 4 + i, n, acc[i][j]); }
}
struct EpiStoreF32 { float* C; int ldc; int pad; __device__ __forceinline__ void operator()(int t, int n, float v) const { C[(size_t)t * ldc + n] = v; } };
struct EpiResid { const float* xs; float* xo; __device__ __forceinline__ void operator()(int t, int n, float v) const { xo[(size_t)t * 1024 + n] = xs[(size_t)t * 1024 + n] + v; } };

__global__ void __launch_bounds__(256) k_ref_epi1(const float* __restrict__ C, int cc, int kind, const float* pool_w, const float* pool_scale,
                                                  const float* gain, int rotary, float outscale, const int* positions, bf16* PROJ) {
    __shared__ float row[256];
    const int t = blockIdx.x, j = threadIdx.x;
    row[j] = C[(size_t)t * 256 + j];
    __syncthreads();
    float out;
    if (kind == 0) {
        const int g = 2 * cc + (j >> 7), d = j & 127; float s = 0.f;
        for (int c = 0; c < 128; ++c) s += row[(j & 128) + c] * pool_w[((size_t)g * 128 + c) * 128 + d];
        out = s * pool_scale[g * 128 + d];
    } else if (kind == 1) {
        const int dim = j & 63; float v = row[j];
        const float ss = wsum(v * v);
        v = v * rsqrtf(ss * (1.0f / 64.0f) + RMS_EPS) * gain[dim];
        if (rotary) {
            const float other = __shfl_xor(v, 8);
            if (dim < 16) {
                const int i = dim & 7; const float invf = powf(500000.0f, -(float)(2 * i) / 16.0f);
                const float ang = (float)positions[t] * invf; const float c = cosf(ang), s = sinf(ang);
                v = (dim < 8) ? (v * c - other * s) : (v * c + other * s);
            }
        }
        out = v * outscale;
    } else out = row[j];
    PROJ[(size_t)t * 3584 + 256 * cc + j] = f2b(out);
}
__global__ void k_ref_logf(const float* __restrict__ C8, const float* fb, float* LOGF) {
    const int i = blockIdx.x * blockDim.x + threadIdx.x; if (i >= T * 8) return;
    const float v = C8[i] + fb[i & 7];
    LOGF[i] = fminf(v, 0.f) - log1pf(expf(-fabsf(v)));
}
__global__ void k_ref_fscan(const float* __restrict__ LOGF, float* FCUM) {
    const int i = threadIdx.x; if (i >= 64) return; const int b = i >> 3, h = i & 7; float s = 0.f;
    for (int t = 0; t < S; ++t) { s += LOGF[((size_t)b * S + t) * 8 + h]; FCUM[((size_t)b * S + t) * 8 + h] = s; }
}
__global__ void __launch_bounds__(256) k_ref_fox(const bf16* __restrict__ PROJ, const float* __restrict__ FCUM, bf16* XY) {
    __shared__ float P[4][S];
    const int w = threadIdx.x >> 6, lane = threadIdx.x & 63; const int gw = blockIdx.x * 4 + w; const int t = gw >> 3, h = gw & 7; const int b = t / S, sq = t % S;
    float q[64];
#pragma unroll
    for (int d = 0; d < 64; ++d) q[d] = bf2f(PROJ[(size_t)t * 3584 + 2048 + h * 64 + d]);
    const float Ft = FCUM[(size_t)t * 8 + h];
    float m = -INFINITY;
    for (int j = lane; j <= sq; j += 64) { const bf16* kr = PROJ + ((size_t)b * S + j) * 3584 + 2560 + h * 64; float s = 0.f;
#pragma unroll
        for (int d = 0; d < 64; ++d) s += q[d] * bf2f(kr[d]);
        s += (Ft - FCUM[((size_t)b * S + j) * 8 + h]) * 1.4426950408889634f; P[w][j] = s; m = fmaxf(m, s); }
    m = wmax(m); float l = 0.f;
    for (int j = lane; j <= sq; j += 64) { const float p = exp2f(P[w][j] - m); P[w][j] = p; l += p; }
    l = wsum(l);
    __syncthreads();
    float o = 0.f;
    for (int j = 0; j <= sq; ++j) o += P[w][j] * bf2f(PROJ[((size_t)b * S + j) * 3584 + 3072 + h * 64 + lane]);
    XY[(size_t)t * 2560 + 1024 + h * 64 + lane] = f2b(o / l);
}
__global__ void __launch_bounds__(128) k_ref_diff(const bf16* __restrict__ PROJ, const float* __restrict__ lamp, const float* __restrict__ gsub, float lam_init, bf16* XY) {
    __shared__ float P[2][2][S];
    const int w = threadIdx.x >> 6, lane = threadIdx.x & 63; const int gw = blockIdx.x * 2 + w; const int t = gw >> 2, h = gw & 3; const int b = t / S, sq = t % S;
    float lam; { const float a = wsum(lamp[lane] * lamp[64 + lane]), c = wsum(lamp[128 + lane] * lamp[192 + lane]); lam = expf(a) - expf(c) + lam_init; }
    float linv[2];
    for (int c = 0; c < 2; ++c) {
        float q[64];
#pragma unroll
        for (int d = 0; d < 64; ++d) q[d] = bf2f(PROJ[(size_t)t * 3584 + 512 + (h * 2 + c) * 64 + d]);
        float m = -INFINITY;
        for (int j = lane; j <= sq; j += 64) { const bf16* kr = PROJ + ((size_t)b * S + j) * 3584 + 1024 + (h * 2 + c) * 64; float s = 0.f;
    #pragma unroll
        for (int d = 0; d < 64; ++d) s += q[d] * bf2f(kr[d]);
            P[w][c][j] = s; m = fmaxf(m, s); }
        m = wmax(m); float l = 0.f;
        for (int j = lane; j <= sq; j += 64) { const float p = exp2f(P[w][c][j] - m); P[w][c][j] = p; l += p; }
        linv[c] = 1.0f / wsum(l);
    }
    __syncthreads();
    float o0 = 0.f, o1 = 0.f;
    for (int j = 0; j <= sq; ++j) { const float a = P[w][0][j] * linv[0] - lam * P[w][1][j] * linv[1]; const bf16* vr = PROJ + ((size_t)b * S + j) * 3584 + 1536 + h * 128;
        o0 += a * bf2f(vr[lane]); o1 += a * bf2f(vr[64 + lane]); }
    const float ss = wsum(o0 * o0 + o1 * o1); const float r = rsqrtf(ss * (1.0f / 128.0f) + RMS_EPS) * (1.0f - lam_init);
    XY[(size_t)t * 2560 + 512 + h * 128 + lane] = f2b(o0 * r * gsub[lane]);
    XY[(size_t)t * 2560 + 512 + h * 128 + 64 + lane] = f2b(o1 * r * gsub[64 + lane]);
}
__global__ void k_ref_pool(const bf16* __restrict__ PROJ, bf16* XY) {
    const int i = blockIdx.x * blockDim.x + threadIdx.x; if (i >= T * 512) return; const int t = i >> 9, j = i & 511; const int g = j >> 7, w = 2 << g, s = t % S;
    const int cnt = min(s + 1, w); float a = 0.f;
    for (int k = 0; k < cnt; ++k) a += bf2f(PROJ[(size_t)(t - k) * 3584 + j]);
    XY[(size_t)t * 2560 + j] = f2b(a / (float)cnt - bf2f(PROJ[(size_t)t * 3584 + j]));
}
__global__ void __launch_bounds__(256) k_ref_gemm2(const float* __restrict__ x, const float* __restrict__ SS, const float* __restrict__ g, const float* __restrict__ w_in_l,
                                                   const float* __restrict__ w_branch_l, const bf16* __restrict__ XY, bf16* MERGED) {
    __shared__ float sA[16][65], sB[16][65];
    const int tx = threadIdx.x & 15, ty = threadIdx.x >> 4, t0 = blockIdx.y * 64, n0 = blockIdx.x * 64;
    float mg[4][4] = {};
    for (int n = 0; n < 3; ++n) {
        float ag[4][4] = {}, ab[4][4] = {};
        for (int pass = 0; pass < 2; ++pass) {
            const int K = pass == 0 ? 1024 : 512;
            for (int k0 = 0; k0 < K; k0 += 16) {
                for (int e = threadIdx.x; e < 1024; e += 256) { const int r = e >> 4, kk = e & 15; const int t = t0 + r, k = k0 + kk;
                    sA[kk][r] = pass == 0 ? x[(size_t)t * 1024 + k] * SS[t] * g[k] : bf2f(XY[(size_t)t * 2560 + 512 * n + k]); }
                for (int e = threadIdx.x; e < 1024; e += 256) { const int kk = e >> 6, c = e & 63; const int k = k0 + kk;
                    sB[kk][c] = pass == 0 ? w_in_l[(size_t)k * INW + 3592 + n * 1024 + n0 + c] : w_branch_l[((size_t)n * 512 + k) * 1024 + n0 + c]; }
                __syncthreads();
#pragma unroll
                for (int kk = 0; kk < 16; ++kk) {
                    float a[4], b[4];
#pragma unroll
                    for (int i = 0; i < 4; ++i) { a[i] = sA[kk][ty * 4 + i]; b[i] = sB[kk][tx * 4 + i]; }
#pragma unroll
                    for (int i = 0; i < 4; ++i)
#pragma unroll
                        for (int j = 0; j < 4; ++j) { if (pass == 0) ag[i][j] += a[i] * b[j]; else ab[i][j] += a[i] * b[j]; }
                }
                __syncthreads();
            }
        }
#pragma unroll
        for (int i = 0; i < 4; ++i)
#pragma unroll
            for (int j = 0; j < 4; ++j) mg[i][j] += ab[i][j] / (1.0f + expf(-ag[i][j]));
    }
#pragma unroll
    for (int i = 0; i < 4; ++i)
#pragma unroll
        for (int j = 0; j < 4; ++j) MERGED[(size_t)(t0 + ty * 4 + i) * 1024 + n0 + tx * 4 + j] = f2b(mg[i][j]);
}
__global__ void __launch_bounds__(256) k_ref_moe(float* X, const float* __restrict__ SS, const float* __restrict__ g, const int* __restrict__ cls_cnt, const int* __restrict__ LIST,
                                                 const float* __restrict__ TOKW, const float* __restrict__ wg_l, const float* __restrict__ wu_l, const float* __restrict__ wd_l) {
    __shared__ float h[8][1024]; __shared__ float act[8][512]; __shared__ int tok[8];
    const int cls = blockIdx.y, n_c = cls_cnt[cls], base = blockIdx.x * 8; if (base >= n_c) return;
    const int nt = min(8, n_c - base), tid = threadIdx.x;
    if (tid < 8) tok[tid] = tid < nt ? LIST[(size_t)cls * T + base + tid] : -1;
    __syncthreads();
    for (int e = tid; e < 8 * 1024; e += 256) { const int i = e >> 10, k = e & 1023; const int t = tok[i]; h[i][k] = t >= 0 ? X[(size_t)t * 1024 + k] * SS[t] * g[k] : 0.f; }
    __syncthreads();
    const int grp = cls / 6, pr = cls % 6; const int pa = pr < 3 ? 0 : (pr < 5 ? 1 : 2), pb = pr < 3 ? pr + 1 : (pr < 5 ? pr - 1 : 3); const int ea = grp * 4 + pa, eb = grp * 4 + pb;
    for (int s = 0; s < 2; ++s) { const int e = s ? eb : ea; float ga[8], ua[8];
#pragma unroll
        for (int i = 0; i < 8; ++i) { ga[i] = 0.f; ua[i] = 0.f; }
        const float* wg = wg_l + (size_t)e * 1024 * 256 + tid; const float* wu = wu_l + (size_t)e * 1024 * 256 + tid;
        for (int k = 0; k < 1024; ++k) { const float a = wg[(size_t)k * 256], u = wu[(size_t)k * 256];
#pragma unroll
            for (int i = 0; i < 8; ++i) { ga[i] += h[i][k] * a; ua[i] += h[i][k] * u; } }
#pragma unroll
        for (int i = 0; i < 8; ++i) { const int t = tok[i]; const float w = t >= 0 ? TOKW[(size_t)t * 4 + s] : 0.f; act[i][s * 256 + tid] = ga[i] / (1.0f + expf(-ga[i])) * ua[i] * w; } }
    __syncthreads();
    for (int j = 0; j < 4; ++j) { const int n = tid + 256 * j; float y[8];
#pragma unroll
        for (int i = 0; i < 8; ++i) y[i] = 0.f;
        for (int s = 0; s < 2; ++s) { const int e = s ? eb : ea; const float* wd = wd_l + (size_t)e * 256 * 1024 + n;
            for (int f = 0; f < 256; ++f) { const float w = wd[(size_t)f * 1024];
#pragma unroll
                for (int i = 0; i < 8; ++i) y[i] += act[i][s * 256 + f] * w; } }
#pragma unroll
        for (int i = 0; i < 8; ++i) { const int t = tok[i]; if (t >= 0) X[(size_t)t * 1024 + n] += y[i]; } }
}
__global__ void __launch_bounds__(256) k_ref_ple(const float* __restrict__ x, const float* __restrict__ SS, const float* __restrict__ g, const float* __restrict__ wgate_l,
                                                 const float* __restrict__ p_l, const float* __restrict__ wple_l, float* xo) {
    __shared__ float sA[16][65], sB[16][65];
    const int tx = threadIdx.x & 15, ty = threadIdx.x >> 4, t0 = blockIdx.y * 64, n0 = blockIdx.x * 64;
    float ag[4][4] = {}, ab[4][4] = {};
    for (int pass = 0; pass < 2; ++pass) {
        const int K = pass == 0 ? 1024 : 256;
        for (int k0 = 0; k0 < K; k0 += 16) {
            for (int e = threadIdx.x; e < 1024; e += 256) { const int r = e >> 4, kk = e & 15; const int t = t0 + r, k = k0 + kk;
                sA[kk][r] = pass == 0 ? x[(size_t)t * 1024 + k] * SS[t] * g[k] : p_l[(size_t)t * 256 + k]; }
            for (int e = threadIdx.x; e < 1024; e += 256) { const int kk = e >> 6, c = e & 63; const int k = k0 + kk;
                sB[kk][c] = pass == 0 ? wgate_l[(size_t)k * 1024 + n0 + c] : wple_l[(size_t)k * 1024 + n0 + c]; }
            __syncthreads();
#pragma unroll
            for (int kk = 0; kk < 16; ++kk) {
                float a[4], b[4];
#pragma unroll
                for (int i = 0; i < 4; ++i) { a[i] = sA[kk][ty * 4 + i]; b[i] = sB[kk][tx * 4 + i]; }
#pragma unroll
                for (int i = 0; i < 4; ++i)
#pragma unroll
                    for (int j = 0; j < 4; ++j) { if (pass == 0) ag[i][j] += a[i] * b[j]; else ab[i][j] += a[i] * b[j]; }
            }
            __syncthreads();
        }
    }
#pragma unroll
    for (int i = 0; i < 4; ++i)
#pragma unroll
        for (int j = 0; j < 4; ++j) { const size_t o = (size_t)(t0 + ty * 4 + i) * 1024 + n0 + tx * 4 + j; xo[o] = x[o] + ab[i][j] / (1.0f + expf(-ag[i][j])); }
}
}
__device__ __forceinline__ int route_decide(const float (&dg)[4], const float (&de)[16], const float rstd, const float* __restrict__ brg, const float* __restrict__ bre, float& wa, float& wb) {
    float lg[4]; int gi = 0; float lmax;
#pragma unroll
    for (int e = 0; e < 4; ++e) lg[e] = rstd * dg[e] + brg[e];
    lmax = lg[0];
#pragma unroll
    for (int e = 1; e < 4; ++e) if (lg[e] > lmax) { lmax = lg[e]; gi = e; }
    float den = 0.f;
#pragma unroll
    for (int e = 0; e < 4; ++e) den += expf(lg[e] - lmax);
    const float gp = 1.0f / den;
    float el[4] = {0.f, 0.f, 0.f, 0.f};
#pragma unroll
    for (int gg = 0; gg < 4; ++gg)
#pragma unroll
        for (int e = 0; e < 4; ++e) if (gg == gi) el[e] = rstd * de[gg * 4 + e] + bre[gg * 4 + e];
    int i1 = 0; float m1 = el[0];
#pragma unroll
    for (int e = 1; e < 4; ++e) if (el[e] > m1) { m1 = el[e]; i1 = e; }
    int i2 = -1; float m2 = -INFINITY;
#pragma unroll
    for (int e = 0; e < 4; ++e) if (e != i1 && el[e] > m2) { m2 = el[e]; i2 = e; }
    const float r2 = expf(m2 - m1); const float w1 = gp / (1.0f + r2), w2 = gp * r2 / (1.0f + r2);
    const int a = min(i1, i2), b = max(i1, i2); const int pr = (a == 0) ? (b - 1) : ((a == 1) ? (b + 1) : 5); const int cls = gi * 6 + pr;
    wa = i1 == a ? w1 : w2; wb = i1 == a ? w2 : w1;
    return cls;
}
__device__ __forceinline__ int route_core(int t, int lane, const float* __restrict__ X, const float* __restrict__ g, const float* __restrict__ wrg, const float* __restrict__ brg,
                                          const float* __restrict__ wre, const float* __restrict__ bre, float* TOKW) {
    float ss = 0.f, dg[4] = {0.f, 0.f, 0.f, 0.f}, de[16];
#pragma unroll
    for (int e = 0; e < 16; ++e) de[e] = 0.f;
#pragma unroll 4
    for (int i = 0; i < 16; ++i) { const int k = lane + 64 * i; const float xv = X[(size_t)t * 1024 + k]; ss += xv * xv; const float h = xv * g[k];
        const float4 a = *(const float4*)(wrg + (size_t)k * 4); dg[0] += h * a.x; dg[1] += h * a.y; dg[2] += h * a.z; dg[3] += h * a.w;
#pragma unroll
        for (int q = 0; q < 4; ++q) { const float4 b = *(const float4*)(wre + (size_t)k * 16 + 4 * q); de[4 * q] += h * b.x; de[4 * q + 1] += h * b.y; de[4 * q + 2] += h * b.z; de[4 * q + 3] += h * b.w; } }
    ss = refp::wsum(ss);
#pragma unroll
    for (int e = 0; e < 4; ++e) dg[e] = refp::wsum(dg[e]);
#pragma unroll
    for (int e = 0; e < 16; ++e) de[e] = refp::wsum(de[e]);
    const float rstd = rsqrtf(ss * (1.0f / 1024.0f) + RMS_EPS);
    float wa, wb; const int cls = route_decide(dg, de, rstd, brg, bre, wa, wb);
    if (lane == 0) *(float4*)(TOKW + (size_t)t * 4) = make_float4(wa, wb, rstd, 0.f);
    return cls;
}
__device__ __forceinline__ void route_token(int t, int lane, const float* __restrict__ X, const float* __restrict__ g, const float* __restrict__ wrg, const float* __restrict__ brg,
                                            const float* __restrict__ wre, const float* __restrict__ bre, unsigned* cls_cnt, int* LIST, float* TOKW) {
    const int cls = route_core(t, lane, X, g, wrg, brg, wre, bre, TOKW);
    if (lane == 0) { const unsigned pos = atomicAdd(cls_cnt + cls, 1u); LIST[(size_t)cls * T + pos] = t; }
}
__global__ void __launch_bounds__(256) k_route(const float* X, const float* g, const float* wrg, const float* brg, const float* wre, const float* bre, unsigned* cls_cnt, int* LIST, float* TOKW) {
    const int t = blockIdx.x * 4 + (threadIdx.x >> 6);
    route_token(t, threadIdx.x & 63, X, g, wrg, brg, wre, bre, cls_cnt, LIST, TOKW);
}

namespace pg8 {
#define PG8_LAS __attribute__((address_space(3)))
typedef short bf16x8 __attribute__((ext_vector_type(8)));
typedef float f32x4 __attribute__((ext_vector_type(4)));
typedef unsigned u32x4 __attribute__((ext_vector_type(4)));
typedef int i32x4 __attribute__((ext_vector_type(4)));
typedef int i32x8 __attribute__((ext_vector_type(8)));
__device__ __forceinline__ i32x8 cat8(bf16x8 lo, bf16x8 hi) { const i32x4 a = __builtin_bit_cast(i32x4, lo), b = __builtin_bit_cast(i32x4, hi); return __builtin_shufflevector(a, b, 0, 1, 2, 3, 4, 5, 6, 7); }
constexpr int BM = 256, BK = 64, HALF = 128, HTB = HALF * BK * 2, STAGE_BYTES = 8 * HTB;

__host__ __device__ __forceinline__ int lds_byte(int r, int c) { const int st = (r >> 4) * 2 + (c >> 5), rr = r & 15, cc = c & 31, ob = rr * 64 + cc * 2; return st * 1024 + (ob ^ (((ob >> 9) & 1) << 5)); }
__host__ __device__ __forceinline__ void stage_rc(int b, int& R, int& C) { const int st = b / 1024, sb = b % 1024, swz = sb ^ (((sb >> 9) & 1) << 5); R = (st >> 1) * 16 + swz / 64; C = (st & 1) * 32 + (swz % 64) / 2; }
__host__ __device__ __forceinline__ int perm32(int rho) { const int n = rho >> 4, i = rho & 15; return 8 * (i >> 2) + 4 * n + (i & 3); }

struct Step { const char* A; const char* B; const int* rows; int nt, pm, pn, aux, nvalid, zero_after; };
__device__ __forceinline__ int rfl(int v) { return __builtin_amdgcn_readfirstlane(v); }
template <class P> __device__ __forceinline__ P rflp(P p) { const unsigned long long u = (unsigned long long)p; const unsigned lo = (unsigned)__builtin_amdgcn_readfirstlane((int)(unsigned)u), hi = (unsigned)__builtin_amdgcn_readfirstlane((int)(unsigned)(u >> 32)); return (P)(((unsigned long long)hi << 32) | lo); }
__device__ __forceinline__ void step_uniform(Step& s, int& ok) {
    s.A = rflp(s.A); s.B = rflp(s.B); s.rows = rflp(s.rows); s.nt = rfl(s.nt); s.pm = rfl(s.pm); s.pn = rfl(s.pn); s.aux = rfl(s.aux); s.nvalid = rfl(s.nvalid); s.zero_after = rfl(s.zero_after); ok = rfl(ok);
    asm volatile("" : "+s"(ok), "+s"(s.A), "+s"(s.B), "+s"(s.nt), "+s"(s.aux));
}

template <class Sched, class Epi, bool GATHER, bool ALIGN_EPI, bool F8 = false>
__device__ __forceinline__ void gemm_phase(const int tid, PG8_LAS unsigned char* lds, const unsigned lda, const unsigned ldb, const Sched& S, const Epi& E) {
    const int wid = __builtin_amdgcn_readfirstlane(tid >> 6), lane = tid & 63, wr = wid >> 2, wc = wid & 3, fr = lane & 15, fq = lane >> 4;
    int Rr[2], Cc[2]; unsigned voffB[2], cOA[2][2], nOA[2][2];
#pragma unroll
    for (int i = 0; i < 2; ++i) { stage_rc(tid * 16 + i * 8192, Rr[i], Cc[i]); const int Rb = (Rr[i] & ~31) + perm32(Rr[i] & 31); voffB[i] = (unsigned)Rb * ldb + (unsigned)Cc[i] * 2u; }
    const size_t kstep = (size_t)(BK * 2);
    const size_t hstepB = (size_t)HALF * ldb;
    const unsigned ldsw = (unsigned)wid * 1024u;
    const int aoff = lds_byte(wr * 64 + fr, fq * 8), boff = lds_byte(wc * 32 + fr, fq * 8);
#define PG8_SA(b, h) (((b) * 2 + (h)) * HTB)
#define PG8_SB(b, h) ((4 + (b) * 2 + (h)) * HTB)
#define PG8_STAGE_B(bufoff, gbase) do { _Pragma("unroll") for (int _i = 0; _i < 2; ++_i) \
        __builtin_amdgcn_global_load_lds((const unsigned*)((const char*)(gbase) + voffB[_i]), (PG8_LAS unsigned*)(lds + (bufoff) + ldsw + _i * 8192), 16, 0, 0); } while (0)
#define PG8_STAGE_A(bufoff, gbase, o0, o1) do { \
        __builtin_amdgcn_global_load_lds((const unsigned*)((const char*)(gbase) + (o0)), (PG8_LAS unsigned*)(lds + (bufoff) + ldsw), 16, 0, 0); \
        __builtin_amdgcn_global_load_lds((const unsigned*)((const char*)(gbase) + (o1)), (PG8_LAS unsigned*)(lds + (bufoff) + ldsw + 8192), 16, 0, 0); } while (0)
#define PG8_LDA(dst, b, h) do { _Pragma("unroll") for (int m = 0; m < 4; ++m) _Pragma("unroll") for (int k = 0; k < 2; ++k) dst[m][k] = *(const PG8_LAS bf16x8*)(lds + PG8_SA(b, h) + aoff + m * 2048 + k * 1024); } while (0)
#define PG8_LDB(dst, b, h) do { _Pragma("unroll") for (int n = 0; n < 2; ++n) _Pragma("unroll") for (int k = 0; k < 2; ++k) dst[n][k] = *(const PG8_LAS bf16x8*)(lds + PG8_SB(b, h) + boff + n * 2048 + k * 1024); } while (0)
#define PG8_MMA(ai, bj, At, Bt) do { __builtin_amdgcn_s_setprio(1); \
        if constexpr (F8) { _Pragma("unroll") for (int m = 0; m < 4; ++m) _Pragma("unroll") for (int n = 0; n < 2; ++n) \
            asm volatile("v_mfma_scale_f32_16x16x128_f8f6f4 %0, %1, %2, %0, %3, %3 op_sel_hi:[0,0,0]" : "+v"(acc[ai][bj][m][n]) : "v"(cat8(Bt[n][0], Bt[n][1])), "v"(cat8(At[m][0], At[m][1])), "v"(f8scale)); } \
        else { _Pragma("unroll") for (int m = 0; m < 4; ++m) _Pragma("unroll") for (int n = 0; n < 2; ++n) _Pragma("unroll") for (int k = 0; k < 2; ++k) \
            acc[ai][bj][m][n] = __builtin_amdgcn_mfma_f32_16x16x32_bf16(Bt[n][k], At[m][k], acc[ai][bj][m][n], 0, 0, 0); } \
        __builtin_amdgcn_s_setprio(0); } while (0)
#define PG8_WAIT_V(n) asm volatile("s_waitcnt vmcnt(" #n ")" ::: "memory")
#define PG8_WAIT_L(n) asm volatile("s_waitcnt lgkmcnt(" #n ")" ::: "memory")
#define PG8_BAR __builtin_amdgcn_s_barrier()
#define PG8_SCHED __builtin_amdgcn_sched_barrier(0)
#define PG8_AOFFS(dst, st) do { _Pragma("unroll") for (int _h = 0; _h < 2; ++_h) _Pragma("unroll") for (int _i = 0; _i < 2; ++_i) { \
        int _row = Rr[_i] + 128 * _h; if (GATHER) { _row = (st).rows[_row]; _row = _row < 0 ? 0 : _row; } \
        dst[_h][_i] = (unsigned)_row * lda + (unsigned)Cc[_i] * 2u; } } while (0)
    int f8scale = 0x7F7F7F7F; if constexpr (F8) asm volatile("" : "+v"(f8scale));
    Step cur, nxt; int ui = 0;
    { int ok_ = S.next(0, cur) ? 1 : 0; step_uniform(cur, ok_); if (!ok_) return; }
    f32x4 acc[2][2][4][2];
#pragma unroll
    for (int a = 0; a < 2; ++a)
#pragma unroll
        for (int b = 0; b < 2; ++b)
#pragma unroll
            for (int m = 0; m < 4; ++m)
#pragma unroll
                for (int n = 0; n < 2; ++n) acc[a][b][m][n] = (f32x4){0.f, 0.f, 0.f, 0.f};
    bf16x8 At[4][2], B0[2][2], B1[2][2];
    PG8_AOFFS(cOA, cur);
    const char* cA = cur.A; const char* cB = cur.B;
    PG8_STAGE_B(PG8_SB(0, 0), cB); PG8_STAGE_B(PG8_SB(0, 1), cB + hstepB); PG8_STAGE_A(PG8_SA(0, 0), cA, cOA[0][0], cOA[0][1]); PG8_STAGE_A(PG8_SA(0, 1), cA, cOA[1][0], cOA[1][1]);
    if (wr == 1) PG8_BAR;
    PG8_WAIT_V(2); PG8_BAR;
    PG8_STAGE_B(PG8_SB(1, 0), cB + kstep); PG8_STAGE_A(PG8_SA(1, 0), cA + kstep, cOA[0][0], cOA[0][1]); PG8_STAGE_B(PG8_SB(1, 1), cB + hstepB + kstep);
    PG8_WAIT_V(6); PG8_BAR;
#pragma clang loop unroll(disable)
    for (;;) {
        bool has_next = S.next(ui + 1, nxt);
        { int hn_ = has_next ? 1 : 0; step_uniform(nxt, hn_); has_next = hn_ != 0; }
        asm volatile("" : "+v"(voffB[0]), "+v"(voffB[1]));
        const char* nA = has_next ? nxt.A : cA; const char* nB = has_next ? nxt.B : cB;
        if (GATHER) { if (has_next) { PG8_AOFFS(nOA, nxt); } else {
#pragma unroll
            for (int _h = 0; _h < 2; ++_h)
#pragma unroll
                for (int _i = 0; _i < 2; ++_i) nOA[_h][_i] = cOA[_h][_i]; } }
        const int nt = cur.nt;
#pragma clang loop unroll(disable)
        for (int t = 0; t < nt; t += 2) {
            const bool last = (t == nt - 2);
            const char* a1 = cA + (size_t)(t + 1) * kstep;
            const char* a2 = last ? nA : cA + (size_t)(t + 2) * kstep; const char* b2 = last ? nB : cB + (size_t)(t + 2) * kstep;
            const char* a3 = a2 + kstep; const char* b3 = b2 + kstep;
            unsigned o00, o01, o10, o11;
            if (GATHER) { o00 = last ? nOA[0][0] : cOA[0][0]; o01 = last ? nOA[0][1] : cOA[0][1]; o10 = last ? nOA[1][0] : cOA[1][0]; o11 = last ? nOA[1][1] : cOA[1][1]; }
            else { o00 = cOA[0][0]; o01 = cOA[0][1]; o10 = cOA[1][0]; o11 = cOA[1][1]; }
            PG8_LDB(B0, 0, 0); PG8_LDB(B1, 0, 1); PG8_SCHED; PG8_LDA(At, 0, 0); PG8_STAGE_A(PG8_SA(1, 1), a1, cOA[1][0], cOA[1][1]);
            PG8_WAIT_V(8); PG8_WAIT_L(0); PG8_BAR; PG8_MMA(0, 0, At, B0); PG8_MMA(0, 1, At, B1); PG8_BAR; PG8_SCHED;
            PG8_LDA(At, 0, 1); PG8_STAGE_B(PG8_SB(0, 0), b2); PG8_STAGE_B(PG8_SB(0, 1), b2 + hstepB); PG8_STAGE_A(PG8_SA(0, 0), a2, o00, o01);
            PG8_WAIT_V(8); PG8_WAIT_L(0); PG8_BAR; PG8_MMA(1, 0, At, B0); PG8_MMA(1, 1, At, B1); PG8_BAR; PG8_SCHED;
            PG8_LDB(B0, 1, 0); PG8_LDB(B1, 1, 1); PG8_SCHED; PG8_LDA(At, 1, 0); PG8_STAGE_A(PG8_SA(0, 1), a2, o10, o11);
            PG8_WAIT_V(8); PG8_WAIT_L(0); PG8_BAR; PG8_MMA(0, 0, At, B0); PG8_MMA(0, 1, At, B1); PG8_BAR; PG8_SCHED;
            PG8_LDA(At, 1, 1); PG8_STAGE_B(PG8_SB(1, 0), b3); PG8_STAGE_B(PG8_SB(1, 1), b3 + hstepB); PG8_STAGE_A(PG8_SA(1, 0), a3, o00, o01);
            PG8_WAIT_V(8); PG8_WAIT_L(0); PG8_BAR; PG8_MMA(1, 0, At, B0); PG8_MMA(1, 1, At, B1); PG8_BAR; PG8_SCHED;
        }
        if constexpr (F8) { asm volatile("s_nop 15\n\ts_nop 15" ::: "memory"); }
        if constexpr (ALIGN_EPI) { if (wr == 0) PG8_BAR; }
        { int ln_; asm volatile("v_mbcnt_lo_u32_b32 %0, -1, 0\n\tv_mbcnt_hi_u32_b32 %0, -1, %0" : "=v"(ln_));
          E(acc, cur, wr, wc, ln_ & 15, ln_ >> 4); }
        if (!has_next) break;
        if (cur.zero_after) {
#pragma unroll
            for (int a = 0; a < 2; ++a)
#pragma unroll
                for (int b = 0; b < 2; ++b)
#pragma unroll
                    for (int m = 0; m < 4; ++m)
#pragma unroll
                        for (int n = 0; n < 2; ++n) acc[a][b][m][n] = (f32x4){0.f, 0.f, 0.f, 0.f};
        }
        cur = nxt; cA = nA; cB = nB; ++ui;
        if (GATHER) {
#pragma unroll
            for (int _h = 0; _h < 2; ++_h)
#pragma unroll
                for (int _i = 0; _i < 2; ++_i) cOA[_h][_i] = nOA[_h][_i]; }
        if constexpr (ALIGN_EPI) { if (wr == 1) PG8_BAR; }
    }
    PG8_WAIT_V(0);
    if constexpr (!ALIGN_EPI) { if (wr == 0) PG8_BAR; }
    PG8_BAR;
#undef PG8_SA
#undef PG8_SB
#undef PG8_STAGE_A
#undef PG8_STAGE_B
#undef PG8_LDA
#undef PG8_LDB
#undef PG8_MMA
#undef PG8_WAIT_V
#undef PG8_WAIT_L
#undef PG8_BAR
#undef PG8_SCHED
#undef PG8_AOFFS
}
}
#include <hip/hip_bf16.h>
namespace attn_body {
using hbf16=__hip_bfloat16;
using bf16x8=__attribute__((ext_vector_type(8)))short;
using s16x4=__attribute__((ext_vector_type(4)))short;
using f32x16=__attribute__((ext_vector_type(16)))float;
using u32x4=__attribute__((ext_vector_type(4)))unsigned;
constexpr int SEQ=2048,D=64,DM=3584;
constexpr int NW=8,QBLK=32,QB=QBLK*NW,KVBLK=64,NQB=SEQ/QB;
__device__ __forceinline__ int crow(int r,int hi){return (r&3)+8*(r>>2)+4*hi;}
#define SBAR() __builtin_amdgcn_sched_barrier(0)
__device__ __forceinline__ void cmask(f32x16&p0,f32x16&p1,int jb,int qrel,int hi){
  const float NEG=-INFINITY; int kb=64*jb+4*hi;
  #pragma unroll
  for(int r=0;r<16;++r){int kv=kb+(r&3)+8*(r>>2); if(kv>qrel)p0[r]=NEG; if(kv+32>qrel)p1[r]=NEG;}
}

constexpr int NSLOT=3, SLOTB=8192;
constexpr int LDS_K=0, LDS_V=NSLOT*SLOTB, LDS_WS=2*NSLOT*SLOTB, LDS_OST=LDS_WS+NW*64*4, LDS_BIAS=LDS_OST+NW*4096, LDS_SSQ=LDS_BIAS+SEQ*4, LDS_BYTES=LDS_SSQ+NW*32*4;
constexpr float C2=0.125f*1.4426950408889634f;
__device__ __forceinline__ void glds16(const void*gsrc,unsigned lds_dst){unsigned keep;
  asm volatile("s_mov_b32 %0, m0\n\ts_mov_b32 m0, %2\n\ts_nop 0\n\tglobal_load_lds_dwordx4 %1, off\n\ts_mov_b32 m0, %0":"=&s"(keep):"v"(gsrc),"s"(lds_dst):"memory");}
__device__ __forceinline__ float max3f(float a,float b,float c){float r;asm("v_max3_f32 %0, %1, %2, %3":"=v"(r):"v"(a),"v"(b),"v"(c));return r;}
__device__ __forceinline__ float max2f(float a,float b){float r;asm("v_max_f32_e32 %0, %1, %2":"=v"(r):"v"(a),"v"(b));return r;}
__device__ __forceinline__ float fadd_s(float a,float b){float r;asm("v_add_f32_e32 %0, %1, %2":"=v"(r):"v"(a),"v"(b));return r;}
__device__ __forceinline__ float fsub_s(float a,float b){float r;asm("v_sub_f32_e32 %0, %1, %2":"=v"(r):"v"(a),"v"(b));return r;}
typedef float f32x2_t __attribute__((ext_vector_type(2))); typedef float f32x4_t __attribute__((ext_vector_type(4))); typedef __bf16 bf16x2_t __attribute__((ext_vector_type(2)));
__device__ __forceinline__ unsigned cvtpk_s(float lo,float hi){f32x2_t v={lo,hi};bf16x2_t b=__builtin_convertvector(v,bf16x2_t);return __builtin_bit_cast(unsigned,b);}
#define WAIT_BAR(N) asm volatile("s_waitcnt vmcnt(" #N ") lgkmcnt(0)\n\ts_barrier":::"memory")

__device__ __forceinline__ void qkt(f32x16&p0,f32x16&p1,const char*Kslot,const bf16x8*qr,const f32x16&negm,int r32,int hi){
  const char*kb=Kslot+hi*1024+r32*16;
  #pragma unroll
  for(int d0=0;d0<4;++d0){
    const bf16x8 b0=*reinterpret_cast<const bf16x8*>(kb+d0*2048);
    const bf16x8 b1=*reinterpret_cast<const bf16x8*>(kb+d0*2048+512);
    if(d0==0){p0=__builtin_amdgcn_mfma_f32_32x32x16_bf16(b0,qr[0],negm,0,0,0);p1=__builtin_amdgcn_mfma_f32_32x32x16_bf16(b1,qr[0],negm,0,0,0);}
    else{p0=__builtin_amdgcn_mfma_f32_32x32x16_bf16(b0,qr[d0],p0,0,0,0);p1=__builtin_amdgcn_mfma_f32_32x32x16_bf16(b1,qr[d0],p1,0,0,0);}}
}
typedef __attribute__((address_space(3))) const char* lds_cptr;
typedef short v4i16_t __attribute__((ext_vector_type(4)));
__device__ __forceinline__ void kload8(bf16x8*kf,lds_cptr kp){
  kf[0]=*(const __attribute__((address_space(3))) bf16x8*)(kp);      kf[1]=*(const __attribute__((address_space(3))) bf16x8*)(kp+512);
  kf[2]=*(const __attribute__((address_space(3))) bf16x8*)(kp+2048); kf[3]=*(const __attribute__((address_space(3))) bf16x8*)(kp+2560);
  kf[4]=*(const __attribute__((address_space(3))) bf16x8*)(kp+4096); kf[5]=*(const __attribute__((address_space(3))) bf16x8*)(kp+4608);
  kf[6]=*(const __attribute__((address_space(3))) bf16x8*)(kp+6144); kf[7]=*(const __attribute__((address_space(3))) bf16x8*)(kp+6656);
}
__device__ __forceinline__ void kload2(bf16x8*kf,lds_cptr kp,int j){ kf[2*j]=*(const __attribute__((address_space(3))) bf16x8*)(kp+j*2048); kf[2*j+1]=*(const __attribute__((address_space(3))) bf16x8*)(kp+j*2048+512); }
__device__ __forceinline__ s16x4 vtr(lds_cptr p){ return __builtin_bit_cast(s16x4,__builtin_amdgcn_ds_read_tr16_b64_v4i16((__attribute__((address_space(3))) v4i16_t*)p)); }
__device__ __forceinline__ float rowmax(const f32x16&p0,const f32x16&p1){
  float a=max3f(p0[0],p0[1],p1[0]),b=max3f(p0[2],p0[3],p1[1]);a=max3f(a,p1[2],p1[3]);
  #pragma unroll
  for(int r=4;r<16;r+=4){a=max3f(a,p0[r],p0[r+1]);b=max3f(b,p0[r+2],p0[r+3]);a=max3f(a,p1[r],p1[r+1]);b=max3f(b,p1[r+2],p1[r+3]);}
  const float m=max2f(a,b);
  auto rr=__builtin_amdgcn_permlane32_swap(__float_as_uint(m),__float_as_uint(m),false,false);
  return max2f(__uint_as_float(rr[0]),__uint_as_float(rr[1]));
}
__device__ __forceinline__ void pv(f32x16*o,int vb,bf16x8 pa0,bf16x8 pa1,bf16x8 pa2,bf16x8 pa3){
  #pragma unroll
  for(int d0=0;d0<2;++d0){s16x4 lo[4],hi[4];
    #pragma unroll
    for(int ks=0;ks<4;++ks){
      asm volatile("ds_read_b64_tr_b16 %0,%1 offset:%c2":"=&v"(lo[ks]):"v"(vb),"i"(d0*4096+ks*1024):"memory");
      asm volatile("ds_read_b64_tr_b16 %0,%1 offset:%c2":"=&v"(hi[ks]):"v"(vb),"i"(d0*4096+ks*1024+512):"memory");}
    asm volatile("s_waitcnt lgkmcnt(0)":::"memory");SBAR();
    #define PK(k) (bf16x8){lo[k][0],lo[k][1],lo[k][2],lo[k][3],hi[k][0],hi[k][1],hi[k][2],hi[k][3]}
    o[d0]=__builtin_amdgcn_mfma_f32_32x32x16_bf16(pa0,PK(0),o[d0],0,0,0);
    o[d0]=__builtin_amdgcn_mfma_f32_32x32x16_bf16(pa1,PK(1),o[d0],0,0,0);
    o[d0]=__builtin_amdgcn_mfma_f32_32x32x16_bf16(pa2,PK(2),o[d0],0,0,0);
    o[d0]=__builtin_amdgcn_mfma_f32_32x32x16_bf16(pa3,PK(3),o[d0],0,0,0);
    #undef PK
  }
}

#ifndef ATTN_STORE16
#define ATTN_STORE16(p,v) (*(u32x4*)(p)=(v))
#endif
struct AttnP { const bf16* Q; const bf16* K; const bf16* V; bf16* out; bf16* stash; const float* gsub; const float* logf; int opitch; float lam, nscale; };
template<int THRL,bool FOX> __device__ __forceinline__ void attn_unit(const int tid_in,int b,int qb,const int MODE,const AttnP&P,char*shm){
  int tid=tid_in; asm volatile("":"+v"(tid));
  const int lane=tid&63,r32=lane&31,hi=lane>>5; const int wid=__builtin_amdgcn_readfirstlane(tid>>6);
  const long rowbase=(long)b*SEQ; const int q0=qb*QB;
  const bf16*Qw=P.Q+(rowbase+q0+wid*QBLK)*DM;
  const bf16*Kh=P.K+rowbase*DM,*Vh=P.V+rowbase*DM;
  const unsigned lds0=(unsigned)(uintptr_t)shm;
  float*wsf=(float*)(shm+LDS_WS)+wid*64;
  const float*biasL=(const float*)(shm+LDS_BIAS);
  #define BIAS(P0,P1,t) do{ if(FOX){ const float*bb_=biasL+64*(t)+4*hi; _Pragma("unroll") for(int g_=0;g_<4;++g_){ const f32x4_t b0_=*(const f32x4_t*)(bb_+8*g_), b1_=*(const f32x4_t*)(bb_+32+8*g_); \
      _Pragma("unroll") for(int e_=0;e_<4;++e_){ P0[4*g_+e_]+=b0_[e_]; P1[4*g_+e_]+=b1_[e_]; } asm volatile("":::"memory"); } } }while(0)
  const bf16*ksrc=Kh+(long)lane*DM+wid*8;
  const bf16*vsrc=Vh+(long)(16*(wid&3)+(lane>>2))*DM+(wid>>2)*32+(lane&3)*8;
  const unsigned kdst=lds0+LDS_K+wid*1024, vdst=lds0+LDS_V+wid*1024;
  #define DMA_K(t,slot) glds16(ksrc+(long)(t)*KVBLK*DM,(unsigned)__builtin_amdgcn_readfirstlane(kdst+(slot)))
  #define DMA_V(t,slot) glds16(vsrc+(long)(t)*KVBLK*DM,(unsigned)__builtin_amdgcn_readfirstlane(vdst+(slot)))
  const int vb0=(int)(lds0+LDS_V)+((lane>>4)&1)*32+(lane&3)*8+(4*hi+((lane&15)>>2))*64;
  const char*Kbase=shm+LDS_K; bf16x8 kf[8];
  const lds_cptr shm3=(lds_cptr)shm; const lds_cptr kp0=shm3+LDS_K+hi*1024+r32*16; const lds_cptr vp0=shm3+LDS_V+((lane>>4)&1)*32+(lane&3)*8+(4*hi+((lane&15)>>2))*64;
  const int NT=(q0+QB)/KVBLK;
  DMA_K(0,0);DMA_V(0,0);DMA_K(1,SLOTB);
  bf16x8 qr[4];
  #pragma unroll
  for(int d0=0;d0<4;++d0)qr[d0]=*reinterpret_cast<const bf16x8*>(&Qw[(long)r32*DM+d0*16+hi*8]);
  float mhat=0.f,l_reg=0.f;f32x16 o[2];o[0]=f32x16{};o[1]=f32x16{};f32x16 negm=f32x16{};asm volatile("":"+v"(negm));
  const int qrel=wid*QBLK+r32;
  #define CMASK(P0,P1,t) do{int jb_=(t)-(NT-4); if(jb_>=0)cmask(P0,P1,jb_,qrel,hi);}while(0)
  bool resc=false;
  #define START(P0,P1) do{ const float rm=rowmax(P0,P1); resc=false; \
    { const float dl=rm; mhat=fadd_s(mhat,dl); \
      _Pragma("unroll") for(int r=0;r<16;++r){P0[r]=fsub_s(P0[r],dl);P1[r]=fsub_s(P1[r],dl);} \
      _Pragma("unroll") for(int r=0;r<16;++r)negm[r]=-mhat; asm volatile("":"+v"(negm)); } \
    _Pragma("unroll") for(int r=0;r<16;++r)P0[r]=__builtin_amdgcn_exp2f(P0[r]); }while(0)
  #define RESC() do{ if(resc){ asm volatile("s_waitcnt lgkmcnt(0)":::"memory"); \
      _Pragma("unroll") for(int d_=0;d_<2;++d_) _Pragma("unroll") for(int r=0;r<16;++r)o[d_][r]*=wsf[crow(r,hi)]; } }while(0)
  f32x16 pA0,pA1,pB0,pB1;
  int sl_prev=0,sl_cur=0,sl_next=SLOTB;
  #define ROT() do{sl_prev=sl_cur;sl_cur=sl_next;sl_next=(sl_next==(NSLOT-1)*SLOTB)?0:sl_next+SLOTB;}while(0)
  DMA_K(2,2*SLOTB);
  if(FOX){
    const int n=q0+QB; float v4[4]; float run=0.f;
    _Pragma("unroll") for(int i=0;i<4;++i){ const int sidx=4*tid+i; const float lv=(sidx<n)?P.logf[(rowbase+sidx)*8]:0.f; run+=lv; v4[i]=run; }
    float inc=run; _Pragma("unroll") for(int o_=1;o_<64;o_<<=1){ const float up=__int_as_float(__builtin_amdgcn_ds_bpermute((lane-o_)<<2,__float_as_int(inc))); if(lane>=o_)inc+=up; }
    float*wt=(float*)(shm+LDS_WS); if(lane==63)wt[wid]=inc; __syncthreads();
    float pre=inc-run; _Pragma("unroll") for(int w_=0;w_<NW;++w_){ if(w_<wid)pre+=wt[w_]; }
    float*bw=(float*)(shm+LDS_BIAS); _Pragma("unroll") for(int i=0;i<4;++i){ const int sidx=4*tid+i; if(sidx<n)bw[sidx]=-(pre+v4[i])*1.4426950408889634f; }
    __syncthreads(); }
  WAIT_BAR(3);
  qkt(pA0,pA1,Kbase,qr,negm,r32,hi);asm volatile("s_nop 15\n\ts_nop 7":"+v"(pA0),"+v"(pA1));BIAS(pA0,pA1,0);CMASK(pA0,pA1,0);
  START(pA0,pA1);
  _Pragma("unroll") for(int r=0;r<16;++r)pA1[r]=__builtin_amdgcn_exp2f(pA1[r]);
  WAIT_BAR(0);
  DMA_K(3,0);DMA_V(1,SLOTB);
  ROT();
  kload8(kf,kp0+sl_cur);
  WAIT_BAR(2);
  s16x4 vlo[8],vhi[8]; u32x4 pw0,pw1,pw2,pw3;
  #define PKW(P,B) cvtpk_s(P[B],P[B+1])
  #define PAF(k) __builtin_bit_cast(bf16x8,pw##k)
  #define VFR(i) (bf16x8){vlo[i][0],vlo[i][1],vlo[i][2],vlo[i][3],vhi[i][0],vhi[i][1],vhi[i][2],vhi[i][3]}
  #define PIN(x) asm volatile("":"+v"(x))
  #define MX3(a,b,c) __builtin_fmaxf(__builtin_fmaxf((a),(b)),(c))
  #define GAPA(MF,A0,A1,A2,A3,W0,W1,PW) do{ MF; sacc+=A0; sacc+=A1; sacc+=A2; sacc+=A3; PIN(sacc); W0; W1; PIN(PW); SBAR(); }while(0)
  #define EX(v) __builtin_amdgcn_exp2f(v)
  #define GAPB(MF,X,B) do{ MF; X[B]=EX(X[B]); X[B+1]=EX(X[B+1]); X[B+2]=EX(X[B+2]); X[B+3]=EX(X[B+3]); PIN(X); SBAR(); }while(0)
  #define VRD(i) do{ vlo[i]=vtr(vp_+(((i)>>2)*4096+((i)&3)*1024)); vhi[i]=vtr(vp_+(((i)>>2)*4096+((i)&3)*1024+512)); }while(0)
  #define KRD(G,j) do{ if(G){ kload2(kf,kp0+sl_next,j); SBAR(); } }while(0)
  #define STEP(C0,C1,P0,P1,t,GK,GV,GL) do{ SBAR(); \
    const lds_cptr vp_=vp0+sl_prev; \
    VRD(0); SBAR(); float sacc=(P0[0]+P0[1]); \
    GAPA(C0=__builtin_amdgcn_mfma_f32_32x32x16_bf16(kf[0],qr[0],negm,0,0,0), P0[2],P0[3],P0[4],P0[5],     pw0[0]=PKW(P0,0), pw0[1]=PKW(P0,2), pw0); \
    VRD(4); SBAR(); GAPA(C1=__builtin_amdgcn_mfma_f32_32x32x16_bf16(kf[1],qr[0],negm,0,0,0), P0[6],P0[7],P0[8],P0[9],     pw0[2]=PKW(P0,4), pw0[3]=PKW(P0,6), pw0); \
    VRD(1); SBAR(); GAPA(C0=__builtin_amdgcn_mfma_f32_32x32x16_bf16(kf[2],qr[1],C0,0,0,0),   P0[10],P0[11],P0[12],P0[13], pw1[0]=PKW(P0,8), pw1[1]=PKW(P0,10), pw1); \
    VRD(5); SBAR(); GAPA(C1=__builtin_amdgcn_mfma_f32_32x32x16_bf16(kf[3],qr[1],C1,0,0,0),   P0[14],P0[15],P1[0],P1[1],   pw1[2]=PKW(P0,12),pw1[3]=PKW(P0,14), pw1); \
    VRD(2); SBAR(); GAPA(C0=__builtin_amdgcn_mfma_f32_32x32x16_bf16(kf[4],qr[2],C0,0,0,0),   P1[2],P1[3],P1[4],P1[5],     pw2[0]=PKW(P1,0), pw2[1]=PKW(P1,2), pw2); \
    VRD(6); SBAR(); GAPA(C1=__builtin_amdgcn_mfma_f32_32x32x16_bf16(kf[5],qr[2],C1,0,0,0),   P1[6],P1[7],P1[8],P1[9],     pw2[2]=PKW(P1,4), pw2[3]=PKW(P1,6), pw2); \
    VRD(3); SBAR(); GAPA(C0=__builtin_amdgcn_mfma_f32_32x32x16_bf16(kf[6],qr[3],C0,0,0,0),   P1[10],P1[11],P1[12],P1[13], pw3[0]=PKW(P1,8), pw3[1]=PKW(P1,10), pw3); \
    VRD(7); SBAR(); GAPA(C1=__builtin_amdgcn_mfma_f32_32x32x16_bf16(kf[7],qr[3],C1,0,0,0),   P1[14],P1[15],0.f,0.f,       pw3[2]=PKW(P1,12),pw3[3]=PKW(P1,14), pw3); \
    l_reg+=sacc; \
    if(GK){DMA_K((t)+3,sl_cur);} if(GV){DMA_V((t)+1,sl_next);} \
    BIAS(C0,C1,t); CMASK(C0,C1,t); \
    { float a=MX3(C0[0],C0[1],C1[0]),b=MX3(C0[2],C0[3],C1[1]); a=MX3(a,C1[2],C1[3]); \
      _Pragma("unroll") for(int r=4;r<16;r+=4){a=MX3(a,C0[r],C0[r+1]);b=MX3(b,C0[r+2],C0[r+3]);a=MX3(a,C1[r],C1[r+1]);b=MX3(b,C1[r+2],C1[r+3]);} \
      float rm=__builtin_fmaxf(a,b); { auto rr=__builtin_amdgcn_permlane32_swap(__float_as_uint(rm),__float_as_uint(rm),false,false); rm=__builtin_fmaxf(__uint_as_float(rr[0]),__uint_as_float(rr[1])); } \
      resc=false; \
      if(__builtin_expect(__any(rm>(float)THRL),0)){ const float dl=__builtin_fmaxf(rm,0.f); mhat+=dl; \
        _Pragma("unroll") for(int r=0;r<16;++r){C0[r]-=dl;C1[r]-=dl;} \
        _Pragma("unroll") for(int r=0;r<16;++r)negm[r]=-mhat; asm volatile("":"+v"(negm)); \
        const float f=__builtin_amdgcn_exp2f(-dl); l_reg*=f; if(hi==0)wsf[r32]=f; resc=true; } } \
    SBAR(); \
    GAPB(o[0]=__builtin_amdgcn_mfma_f32_32x32x16_bf16(PAF(0),VFR(0),o[0],0,0,0), C0,0); \
    GAPB(o[1]=__builtin_amdgcn_mfma_f32_32x32x16_bf16(PAF(0),VFR(4),o[1],0,0,0), C0,4); \
    KRD(GL,0); GAPB(o[0]=__builtin_amdgcn_mfma_f32_32x32x16_bf16(PAF(1),VFR(1),o[0],0,0,0), C0,8); \
    KRD(GL,1); GAPB(o[1]=__builtin_amdgcn_mfma_f32_32x32x16_bf16(PAF(1),VFR(5),o[1],0,0,0), C0,12); \
    KRD(GL,2); GAPB(o[0]=__builtin_amdgcn_mfma_f32_32x32x16_bf16(PAF(2),VFR(2),o[0],0,0,0), C1,0); \
    KRD(GL,3); GAPB(o[1]=__builtin_amdgcn_mfma_f32_32x32x16_bf16(PAF(2),VFR(6),o[1],0,0,0), C1,4); \
    GAPB(o[0]=__builtin_amdgcn_mfma_f32_32x32x16_bf16(PAF(3),VFR(3),o[0],0,0,0), C1,8); \
    GAPB(o[1]=__builtin_amdgcn_mfma_f32_32x32x16_bf16(PAF(3),VFR(7),o[1],0,0,0), C1,12); \
    }while(0)
  int t=1;
  #undef CMASK
  #define CMASK(P0,P1,t) do{}while(0)
  for(;t+5<NT;t+=2){
    STEP(pB0,pB1,pA0,pA1,t,true,true,true);     WAIT_BAR(2); RESC(); ROT();
    STEP(pA0,pA1,pB0,pB1,t+1,true,true,true);   WAIT_BAR(2); RESC(); ROT();
  }
  #undef CMASK
  #define CMASK(P0,P1,t) do{int jb_=(t)-(NT-4); if(jb_>=0)cmask(P0,P1,jb_,qrel,hi);}while(0)
  #define ENDW(tt) do{ if((tt)+3<NT){WAIT_BAR(2);} else if((tt)+2<NT){WAIT_BAR(1);} else {WAIT_BAR(0);} }while(0)
  for(;t+1<NT;t+=2){
    STEP(pB0,pB1,pA0,pA1,t,(t+3<NT),(t+1<NT),(t+1<NT));       ENDW(t);   RESC(); ROT();
    STEP(pA0,pA1,pB0,pB1,t+1,(t+4<NT),(t+2<NT),(t+2<NT));     ENDW(t+1); RESC(); ROT();
  }
  STEP(pB0,pB1,pA0,pA1,NT-1,false,false,false); RESC();
  { float sacc=pB0[0]+pB0[1]; _Pragma("unroll") for(int r=2;r<16;++r)sacc+=pB0[r]; _Pragma("unroll") for(int r=0;r<16;++r)sacc+=pB1[r]; l_reg+=sacc;
    pw0=(u32x4){PKW(pB0,0),PKW(pB0,2),PKW(pB0,4),PKW(pB0,6)};pw1=(u32x4){PKW(pB0,8),PKW(pB0,10),PKW(pB0,12),PKW(pB0,14)};pw2=(u32x4){PKW(pB1,0),PKW(pB1,2),PKW(pB1,4),PKW(pB1,6)};pw3=(u32x4){PKW(pB1,8),PKW(pB1,10),PKW(pB1,12),PKW(pB1,14)};
    SBAR(); pv(o,vb0+sl_cur,PAF(0),PAF(1),PAF(2),PAF(3)); }
  #undef PKW
  #undef PAF
  #undef VFR
  #undef PIN
  #undef MX3
  #undef GAPA
  #undef GAPB
  #undef EX
  #undef VRD
  #undef KRD
  #undef STEP
  #undef ENDW
  {auto rr=__builtin_amdgcn_permlane32_swap(__float_as_uint(l_reg),__float_as_uint(l_reg),false,false);l_reg=__uint_as_float(rr[0])+__uint_as_float(rr[1]);}
  if(hi==0)wsf[32+r32]=l_reg;asm volatile("s_waitcnt lgkmcnt(0)":::"memory");
  float rli[16];
  #pragma unroll
  for(int r=0;r<16;++r)rli[r]=__builtin_amdgcn_rcpf(wsf[32+crow(r,hi)]);
  { hbf16*stg=(hbf16*)(shm+LDS_OST)+wid*2048;
    #pragma unroll
    for(int r=0;r<16;++r){const int orow=crow(r,hi);
      #pragma unroll
      for(int d0=0;d0<2;++d0)stg[orow*64+d0*32+r32]=__float2bfloat16(o[d0][r]*rli[r]);}
    asm volatile("s_waitcnt lgkmcnt(0)":::"memory");
    const long grow=rowbase+q0+wid*QBLK; float*ssq=(float*)(shm+LDS_SSQ)+wid*32;
    int lane_e=lane; asm volatile("":"+v"(lane_e));
    #pragma unroll
    for(int i=0;i<4;++i){const int row=i*8+(lane_e>>3),ch=lane_e&7; const u32x4 v=*(const u32x4*)(stg+row*64+ch*8);
      if(MODE==0){ *(u32x4*)(P.out+(grow+row)*(long)P.opitch+ch*8)=v; }
      else { bf16*sp=P.stash+(grow+row)*512+ch*8+(MODE==2?64:0); const u32x4 a=*(const u32x4*)sp; float of[8]; float ss=0.f;
        #pragma unroll
        for(int j=0;j<4;++j){ const float a0=__uint_as_float(a[j]<<16),a1=__uint_as_float(a[j]&0xffff0000u),c0=__uint_as_float(v[j]<<16),c1=__uint_as_float(v[j]&0xffff0000u);
          of[2*j]=a0-P.lam*c0; of[2*j+1]=a1-P.lam*c1; ss+=of[2*j]*of[2*j]+of[2*j+1]*of[2*j+1]; }
        ss+=__int_as_float(__builtin_amdgcn_ds_swizzle(__float_as_int(ss),0x041f)); ss+=__int_as_float(__builtin_amdgcn_ds_swizzle(__float_as_int(ss),0x081f)); ss+=__int_as_float(__builtin_amdgcn_ds_swizzle(__float_as_int(ss),0x101f));
        if(MODE==1){ if(ch==0)ssq[row]=ss; u32x4 w; _Pragma("unroll") for(int j=0;j<4;++j)w[j]=cvtpk_s(of[2*j],of[2*j+1]); *(u32x4*)sp=w; }
        else { const float rr_=rsqrtf((ss+ssq[row])*(1.0f/128.0f)+1e-6f)*P.nscale; bf16*yp=P.out+(grow+row)*(long)P.opitch+ch*8;
          const f32x4_t g0=*(const f32x4_t*)(P.gsub+64+ch*8), g1=*(const f32x4_t*)(P.gsub+64+ch*8+4), h0=*(const f32x4_t*)(P.gsub+ch*8), h1=*(const f32x4_t*)(P.gsub+ch*8+4);
          u32x4 w; w[0]=cvtpk_s(of[0]*rr_*g0[0],of[1]*rr_*g0[1]); w[1]=cvtpk_s(of[2]*rr_*g0[2],of[3]*rr_*g0[3]); w[2]=cvtpk_s(of[4]*rr_*g1[0],of[5]*rr_*g1[1]); w[3]=cvtpk_s(of[6]*rr_*g1[2],of[7]*rr_*g1[3]);
          *(u32x4*)(yp+64)=w;
          const u32x4 lo=*(const u32x4*)(sp-64); float lf[8];
          #pragma unroll
          for(int j=0;j<4;++j){ lf[2*j]=__uint_as_float(lo[j]<<16); lf[2*j+1]=__uint_as_float(lo[j]&0xffff0000u); }
          w[0]=cvtpk_s(lf[0]*rr_*h0[0],lf[1]*rr_*h0[1]); w[1]=cvtpk_s(lf[2]*rr_*h0[2],lf[3]*rr_*h0[3]); w[2]=cvtpk_s(lf[4]*rr_*h1[0],lf[5]*rr_*h1[1]); w[3]=cvtpk_s(lf[6]*rr_*h1[2],lf[7]*rr_*h1[3]);
          *(u32x4*)yp=w; } } } }
  asm volatile("s_waitcnt lgkmcnt(0)\n\ts_barrier":::"memory");
  #undef DMA_K
  #undef BIAS
  #undef DMA_V
  #undef CMASK
  #undef START
  #undef RESC
  #undef ROT
}
__device__ __forceinline__ void pv128(f32x16*o,int vb,bf16x8 pa0,bf16x8 pa1,bf16x8 pa2,bf16x8 pa3){
  #pragma unroll
  for(int d0=0;d0<4;++d0){s16x4 lo[4],hi[4];
    #pragma unroll
    for(int ks=0;ks<4;++ks){
      asm volatile("ds_read_b64_tr_b16 %0,%1 offset:%c2":"=&v"(lo[ks]):"v"(vb),"i"(d0*4096+ks*1024):"memory");
      asm volatile("ds_read_b64_tr_b16 %0,%1 offset:%c2":"=&v"(hi[ks]):"v"(vb),"i"(d0*4096+ks*1024+512):"memory");}
    asm volatile("s_waitcnt lgkmcnt(0)":::"memory");SBAR();
    #define PK(k) (bf16x8){lo[k][0],lo[k][1],lo[k][2],lo[k][3],hi[k][0],hi[k][1],hi[k][2],hi[k][3]}
    o[d0]=__builtin_amdgcn_mfma_f32_32x32x16_bf16(pa0,PK(0),o[d0],0,0,0);
    o[d0]=__builtin_amdgcn_mfma_f32_32x32x16_bf16(pa1,PK(1),o[d0],0,0,0);
    o[d0]=__builtin_amdgcn_mfma_f32_32x32x16_bf16(pa2,PK(2),o[d0],0,0,0);
    o[d0]=__builtin_amdgcn_mfma_f32_32x32x16_bf16(pa3,PK(3),o[d0],0,0,0);
    #undef PK
  }
}
template<int THRL> __device__ __forceinline__ void attn_unit128(const int tid_in,int b,int qb,const int MODE,const AttnP&P,char*shm){
  constexpr bool FOX=false; constexpr int LDS_V=24576, LDS_WS=73728, LDS_OST=75776, SLOTV=16384;
  int tid=tid_in; asm volatile("":"+v"(tid));
  const int lane=tid&63,r32=lane&31,hi=lane>>5; const int wid=__builtin_amdgcn_readfirstlane(tid>>6);
  const long rowbase=(long)b*SEQ; const int q0=qb*QB;
  const bf16*Qw=P.Q+(rowbase+q0+wid*QBLK)*DM;
  const bf16*Kh=P.K+rowbase*DM,*Vh=P.V+rowbase*DM;
  const unsigned lds0=(unsigned)(uintptr_t)shm;
  float*wsf=(float*)(shm+LDS_WS)+wid*64;
  const float*biasL=(const float*)(shm+LDS_BIAS);
  #define BIAS(P0,P1,t) do{ if(FOX){ const float*bb_=biasL+64*(t)+4*hi; _Pragma("unroll") for(int g_=0;g_<4;++g_){ const f32x4_t b0_=*(const f32x4_t*)(bb_+8*g_), b1_=*(const f32x4_t*)(bb_+32+8*g_); \
      _Pragma("unroll") for(int e_=0;e_<4;++e_){ P0[4*g_+e_]+=b0_[e_]; P1[4*g_+e_]+=b1_[e_]; } asm volatile("":::"memory"); } } }while(0)
  const bf16*ksrc=Kh+(long)lane*DM+wid*8;
  const bf16*vsrc=Vh+(long)(16*(wid&3)+(lane>>2))*DM+(wid>>2)*32+(lane&3)*8;
  const unsigned kdst=lds0+LDS_K+wid*1024, vdst=lds0+LDS_V+wid*1024;
  #define DMA_K(t,slot) glds16(ksrc+(long)(t)*KVBLK*DM,(unsigned)__builtin_amdgcn_readfirstlane(kdst+(slot)))
  #define DMA_V(t,slot) do{ glds16(vsrc+(long)(t)*KVBLK*DM,(unsigned)__builtin_amdgcn_readfirstlane(vdst+2*(slot))); glds16(vsrc+(long)(t)*KVBLK*DM+64,(unsigned)__builtin_amdgcn_readfirstlane(vdst+2*(slot)+8192)); }while(0)
  const int vb0=(int)(lds0+LDS_V)+((lane>>4)&1)*32+(lane&3)*8+(4*hi+((lane&15)>>2))*64;
  const char*Kbase=shm+LDS_K; bf16x8 kf[8];
  const lds_cptr shm3=(lds_cptr)shm; const lds_cptr kp0=shm3+LDS_K+hi*1024+r32*16; const lds_cptr vp0=shm3+LDS_V+((lane>>4)&1)*32+(lane&3)*8+(4*hi+((lane&15)>>2))*64;
  const int NT=(q0+QB)/KVBLK;
  DMA_K(0,0);DMA_V(0,0);DMA_K(1,SLOTB);
  bf16x8 qr[4];
  #pragma unroll
  for(int d0=0;d0<4;++d0)qr[d0]=*reinterpret_cast<const bf16x8*>(&Qw[(long)r32*DM+d0*16+hi*8]);
  float mhat=0.f,l_reg=0.f;f32x16 o[4];o[0]=f32x16{};o[1]=f32x16{};o[2]=f32x16{};o[3]=f32x16{};const f32x16 zero16=f32x16{};
  const int qrel=wid*QBLK+r32;
  #define CMASK(P0,P1,t) do{int jb_=(t)-(NT-4); if(jb_>=0)cmask(P0,P1,jb_,qrel,hi);}while(0)
  bool resc=false;
  #define START(P0,P1) do{ const float rm=rowmax(P0,P1); resc=false; \
    { const float dl=rm; mhat=fadd_s(mhat,dl); \
      _Pragma("unroll") for(int r=0;r<16;++r){P0[r]=fsub_s(P0[r],dl);P1[r]=fsub_s(P1[r],dl);} \
      } \
    _Pragma("unroll") for(int r=0;r<16;++r)P0[r]=__builtin_amdgcn_exp2f(P0[r]); }while(0)
  #define RESC() do{ if(resc){ asm volatile("s_waitcnt lgkmcnt(0)":::"memory"); \
      _Pragma("unroll") for(int d_=0;d_<4;++d_) _Pragma("unroll") for(int r=0;r<16;++r)o[d_][r]*=wsf[crow(r,hi)]; } }while(0)
  f32x16 pA0,pA1,pB0,pB1;
  int sl_prev=0,sl_cur=0,sl_next=SLOTB;
  #define ROT() do{sl_prev=sl_cur;sl_cur=sl_next;sl_next=(sl_next==(NSLOT-1)*SLOTB)?0:sl_next+SLOTB;}while(0)
  DMA_K(2,2*SLOTB);
  WAIT_BAR(4);
  qkt(pA0,pA1,Kbase,qr,zero16,r32,hi);asm volatile("s_nop 15\n\ts_nop 7":"+v"(pA0),"+v"(pA1));BIAS(pA0,pA1,0);CMASK(pA0,pA1,0);
  START(pA0,pA1);
  _Pragma("unroll") for(int r=0;r<16;++r)pA1[r]=__builtin_amdgcn_exp2f(pA1[r]);
  WAIT_BAR(0);
  DMA_K(3,0);DMA_V(1,SLOTB);
  ROT();
  kload8(kf,kp0+sl_cur);
  WAIT_BAR(3);
  s16x4 va_lo,va_hi,vb_lo,vb_hi; u32x4 pw0,pw1,pw2,pw3;
  #define PKW(P,B) cvtpk_s(P[B],P[B+1])
  #define PAF(k) __builtin_bit_cast(bf16x8,pw##k)
  #define VFA (bf16x8){va_lo[0],va_lo[1],va_lo[2],va_lo[3],va_hi[0],va_hi[1],va_hi[2],va_hi[3]}
  #define VFB (bf16x8){vb_lo[0],vb_lo[1],vb_lo[2],vb_lo[3],vb_hi[0],vb_hi[1],vb_hi[2],vb_hi[3]}
  #define PIN(x) asm volatile("":"+v"(x))
  #define MX3(a,b,c) __builtin_fmaxf(__builtin_fmaxf((a),(b)),(c))
  #define GAPA(MF,A0,A1,A2,A3,W0,W1,PW) do{ MF; sacc+=A0; sacc+=A1; sacc+=A2; sacc+=A3; PIN(sacc); W0; W1; PIN(PW); SBAR(); }while(0)
  #define EX(v) __builtin_amdgcn_exp2f((v)-mhat)
  #define VRDA(d0,ks) do{ va_lo=vtr(vp_+((d0)*4096+(ks)*1024)); va_hi=vtr(vp_+((d0)*4096+(ks)*1024+512)); }while(0)
  #define VRDB(d0,ks) do{ vb_lo=vtr(vp_+((d0)*4096+(ks)*1024)); vb_hi=vtr(vp_+((d0)*4096+(ks)*1024+512)); }while(0)
  #define KRD(G,j) do{ if(G){ kload2(kf,kp0+sl_next,j); } }while(0)
  #define GAPB(MF,RD,X,B) do{ MF; RD; X[B]=EX(X[B]); X[B+1]=EX(X[B+1]); PIN(X); SBAR(); }while(0)
  #define STEP(C0,C1,P0,P1,t,GK,GV,GL) do{ SBAR(); \
    const lds_cptr vp_=vp0+2*sl_prev; \
    float sacc=(P0[0]+P0[1]); \
    GAPA(C0=__builtin_amdgcn_mfma_f32_32x32x16_bf16(kf[0],qr[0],zero16,0,0,0), P0[2],P0[3],P0[4],P0[5],     pw0[0]=PKW(P0,0), pw0[1]=PKW(P0,2), pw0); \
    GAPA(C1=__builtin_amdgcn_mfma_f32_32x32x16_bf16(kf[1],qr[0],zero16,0,0,0), P0[6],P0[7],P0[8],P0[9],     pw0[2]=PKW(P0,4), pw0[3]=PKW(P0,6), pw0); \
    GAPA(C0=__builtin_amdgcn_mfma_f32_32x32x16_bf16(kf[2],qr[1],C0,0,0,0),   P0[10],P0[11],P0[12],P0[13], pw1[0]=PKW(P0,8), pw1[1]=PKW(P0,10), pw1); \
    GAPA(C1=__builtin_amdgcn_mfma_f32_32x32x16_bf16(kf[3],qr[1],C1,0,0,0),   P0[14],P0[15],P1[0],P1[1],   pw1[2]=PKW(P0,12),pw1[3]=PKW(P0,14), pw1); \
    GAPA(C0=__builtin_amdgcn_mfma_f32_32x32x16_bf16(kf[4],qr[2],C0,0,0,0),   P1[2],P1[3],P1[4],P1[5],     pw2[0]=PKW(P1,0), pw2[1]=PKW(P1,2), pw2); \
    GAPA(C1=__builtin_amdgcn_mfma_f32_32x32x16_bf16(kf[5],qr[2],C1,0,0,0),   P1[6],P1[7],P1[8],P1[9],     pw2[2]=PKW(P1,4), pw2[3]=PKW(P1,6), pw2); \
    VRDA(0,0); SBAR(); \
    GAPA(C0=__builtin_amdgcn_mfma_f32_32x32x16_bf16(kf[6],qr[3],C0,0,0,0),   P1[10],P1[11],P1[12],P1[13], pw3[0]=PKW(P1,8), pw3[1]=PKW(P1,10), pw3); \
    GAPA(C1=__builtin_amdgcn_mfma_f32_32x32x16_bf16(kf[7],qr[3],C1,0,0,0),   P1[14],P1[15],0.f,0.f,       pw3[2]=PKW(P1,12),pw3[3]=PKW(P1,14), pw3); \
    l_reg+=sacc; \
    if(GK){DMA_K((t)+3,sl_cur);} if(GV){DMA_V((t)+1,sl_next);} \
    CMASK(C0,C1,t); \
    { float a=MX3(C0[0],C0[1],C1[0]),b=MX3(C0[2],C0[3],C1[1]); a=MX3(a,C1[2],C1[3]); \
      _Pragma("unroll") for(int r=4;r<16;r+=4){a=MX3(a,C0[r],C0[r+1]);b=MX3(b,C0[r+2],C0[r+3]);a=MX3(a,C1[r],C1[r+1]);b=MX3(b,C1[r+2],C1[r+3]);} \
      float rm=__builtin_fmaxf(a,b); { auto rr=__builtin_amdgcn_permlane32_swap(__float_as_uint(rm),__float_as_uint(rm),false,false); rm=__builtin_fmaxf(__uint_as_float(rr[0]),__uint_as_float(rr[1])); } \
      rm-=mhat; resc=false; \
      if(__builtin_expect(__any(rm>(float)THRL),0)){ const float dl=__builtin_fmaxf(rm,0.f); mhat+=dl; \
        const float f=__builtin_amdgcn_exp2f(-dl); l_reg*=f; if(hi==0)wsf[r32]=f; resc=true; } } \
    SBAR(); \
    GAPB(o[0]=__builtin_amdgcn_mfma_f32_32x32x16_bf16(PAF(0),VFA,o[0],0,0,0), VRDB(1,0), C0,0); \
    GAPB(o[1]=__builtin_amdgcn_mfma_f32_32x32x16_bf16(PAF(0),VFB,o[1],0,0,0), VRDA(2,0), C0,2); \
    GAPB(o[2]=__builtin_amdgcn_mfma_f32_32x32x16_bf16(PAF(0),VFA,o[2],0,0,0), VRDB(3,0), C0,4); \
    GAPB(o[3]=__builtin_amdgcn_mfma_f32_32x32x16_bf16(PAF(0),VFB,o[3],0,0,0), VRDA(0,1), C0,6); \
    KRD(GL,0); GAPB(o[0]=__builtin_amdgcn_mfma_f32_32x32x16_bf16(PAF(1),VFA,o[0],0,0,0), VRDB(1,1), C0,8); \
    GAPB(o[1]=__builtin_amdgcn_mfma_f32_32x32x16_bf16(PAF(1),VFB,o[1],0,0,0), VRDA(2,1), C0,10); \
    KRD(GL,1); GAPB(o[2]=__builtin_amdgcn_mfma_f32_32x32x16_bf16(PAF(1),VFA,o[2],0,0,0), VRDB(3,1), C0,12); \
    GAPB(o[3]=__builtin_amdgcn_mfma_f32_32x32x16_bf16(PAF(1),VFB,o[3],0,0,0), VRDA(0,2), C0,14); \
    KRD(GL,2); GAPB(o[0]=__builtin_amdgcn_mfma_f32_32x32x16_bf16(PAF(2),VFA,o[0],0,0,0), VRDB(1,2), C1,0); \
    GAPB(o[1]=__builtin_amdgcn_mfma_f32_32x32x16_bf16(PAF(2),VFB,o[1],0,0,0), VRDA(2,2), C1,2); \
    KRD(GL,3); GAPB(o[2]=__builtin_amdgcn_mfma_f32_32x32x16_bf16(PAF(2),VFA,o[2],0,0,0), VRDB(3,2), C1,4); \
    GAPB(o[3]=__builtin_amdgcn_mfma_f32_32x32x16_bf16(PAF(2),VFB,o[3],0,0,0), VRDA(0,3), C1,6); \
    GAPB(o[0]=__builtin_amdgcn_mfma_f32_32x32x16_bf16(PAF(3),VFA,o[0],0,0,0), VRDB(1,3), C1,8); \
    GAPB(o[1]=__builtin_amdgcn_mfma_f32_32x32x16_bf16(PAF(3),VFB,o[1],0,0,0), VRDA(2,3), C1,10); \
    GAPB(o[2]=__builtin_amdgcn_mfma_f32_32x32x16_bf16(PAF(3),VFA,o[2],0,0,0), VRDB(3,3), C1,12); \
    GAPB(o[3]=__builtin_amdgcn_mfma_f32_32x32x16_bf16(PAF(3),VFB,o[3],0,0,0), (void)0, C1,14); \
    }while(0)
  int t=1;
  #undef CMASK
  #define CMASK(P0,P1,t) do{}while(0)
  for(;t+5<NT;t+=2){
    STEP(pB0,pB1,pA0,pA1,t,true,true,true);     WAIT_BAR(3); RESC(); ROT();
    STEP(pA0,pA1,pB0,pB1,t+1,true,true,true);   WAIT_BAR(3); RESC(); ROT();
  }
  #undef CMASK
  #define CMASK(P0,P1,t) do{int jb_=(t)-(NT-4); if(jb_>=0)cmask(P0,P1,jb_,qrel,hi);}while(0)
  #define ENDW(tt) do{ if((tt)+3<NT){WAIT_BAR(3);} else if((tt)+2<NT){WAIT_BAR(2);} else {WAIT_BAR(0);} }while(0)
  for(;t+1<NT;t+=2){
    STEP(pB0,pB1,pA0,pA1,t,(t+3<NT),(t+1<NT),(t+1<NT));       ENDW(t);   RESC(); ROT();
    STEP(pA0,pA1,pB0,pB1,t+1,(t+4<NT),(t+2<NT),(t+2<NT));     ENDW(t+1); RESC(); ROT();
  }
  STEP(pB0,pB1,pA0,pA1,NT-1,false,false,false); RESC();
  { float sacc=pB0[0]+pB0[1]; _Pragma("unroll") for(int r=2;r<16;++r)sacc+=pB0[r]; _Pragma("unroll") for(int r=0;r<16;++r)sacc+=pB1[r]; l_reg+=sacc;
    pw0=(u32x4){PKW(pB0,0),PKW(pB0,2),PKW(pB0,4),PKW(pB0,6)};pw1=(u32x4){PKW(pB0,8),PKW(pB0,10),PKW(pB0,12),PKW(pB0,14)};pw2=(u32x4){PKW(pB1,0),PKW(pB1,2),PKW(pB1,4),PKW(pB1,6)};pw3=(u32x4){PKW(pB1,8),PKW(pB1,10),PKW(pB1,12),PKW(pB1,14)};
    SBAR(); pv128(o,vb0+2*sl_cur,PAF(0),PAF(1),PAF(2),PAF(3)); }
  #undef PKW
  #undef PAF
  #undef VFA
  #undef VFB
  #undef VRDA
  #undef VRDB
  #undef PIN
  #undef MX3
  #undef GAPA
  #undef GAPB
  #undef EX
  #undef KRD
  #undef STEP
  #undef ENDW
  {auto rr=__builtin_amdgcn_permlane32_swap(__float_as_uint(l_reg),__float_as_uint(l_reg),false,false);l_reg=__uint_as_float(rr[0])+__uint_as_float(rr[1]);}
  if(hi==0)wsf[32+r32]=l_reg;asm volatile("s_waitcnt lgkmcnt(0)":::"memory");
  float rli[16];
  #pragma unroll
  for(int r=0;r<16;++r)rli[r]=__builtin_amdgcn_rcpf(wsf[32+crow(r,hi)]);
  { hbf16*stg=(hbf16*)(shm+LDS_OST)+wid*2048;
    const long grow=rowbase+q0+wid*QBLK;
    int lane_e=lane; asm volatile("":"+v"(lane_e));
    float of[2][4][8]; float ssr[4]={0.f,0.f,0.f,0.f};
    #pragma unroll
    for(int hf=0;hf<2;++hf){
      #pragma unroll
      for(int r=0;r<16;++r){const int orow=crow(r,hi);
        #pragma unroll
        for(int d0=0;d0<2;++d0)stg[orow*64+d0*32+r32]=__float2bfloat16(o[2*hf+d0][r]*rli[r]);}
      asm volatile("s_waitcnt lgkmcnt(0)":::"memory");
      #pragma unroll
      for(int i=0;i<4;++i){const int row=i*8+(lane_e>>3),ch=lane_e&7; const u32x4 v=*(const u32x4*)(stg+row*64+ch*8);
        if(MODE==0){ *(u32x4*)(P.out+(grow+row)*(long)P.opitch+hf*64+ch*8)=v; }
        else { const u32x4 a=*(const u32x4*)(P.stash+(grow+row)*512+hf*64+ch*8); float ss=0.f;
          #pragma unroll
          for(int j=0;j<4;++j){ const float a0=__uint_as_float(a[j]<<16),a1=__uint_as_float(a[j]&0xffff0000u),c0=__uint_as_float(v[j]<<16),c1=__uint_as_float(v[j]&0xffff0000u);
            of[hf][i][2*j]=a0-P.lam*c0; of[hf][i][2*j+1]=a1-P.lam*c1; ss+=of[hf][i][2*j]*of[hf][i][2*j]+of[hf][i][2*j+1]*of[hf][i][2*j+1]; }
          ssr[i]+=ss; } }
      asm volatile("s_waitcnt lgkmcnt(0)":::"memory");
    }
    if(MODE!=0){
      #pragma unroll
      for(int i=0;i<4;++i){const int row=i*8+(lane_e>>3),ch=lane_e&7; float ss=ssr[i];
        ss+=__int_as_float(__builtin_amdgcn_ds_swizzle(__float_as_int(ss),0x041f)); ss+=__int_as_float(__builtin_amdgcn_ds_swizzle(__float_as_int(ss),0x081f)); ss+=__int_as_float(__builtin_amdgcn_ds_swizzle(__float_as_int(ss),0x101f));
        const float rr_=rsqrtf(ss*(1.0f/128.0f)+1e-6f)*P.nscale; bf16*yp=P.out+(grow+row)*(long)P.opitch+ch*8;
        #pragma unroll
        for(int hf=0;hf<2;++hf){ const f32x4_t g0=*(const f32x4_t*)(P.gsub+hf*64+ch*8), g1=*(const f32x4_t*)(P.gsub+hf*64+ch*8+4); u32x4 w;
          w[0]=cvtpk_s(of[hf][i][0]*rr_*g0[0],of[hf][i][1]*rr_*g0[1]); w[1]=cvtpk_s(of[hf][i][2]*rr_*g0[2],of[hf][i][3]*rr_*g0[3]); w[2]=cvtpk_s(of[hf][i][4]*rr_*g1[0],of[hf][i][5]*rr_*g1[1]); w[3]=cvtpk_s(of[hf][i][6]*rr_*g1[2],of[hf][i][7]*rr_*g1[3]);
          *(u32x4*)(yp+hf*64)=w; } } } }
  asm volatile("s_waitcnt lgkmcnt(0)\n\ts_barrier":::"memory");
  #undef DMA_K
  #undef BIAS
  #undef DMA_V
  #undef CMASK
  #undef START
  #undef RESC
  #undef ROT
}
constexpr int ATTN_LDS_BYTES=LDS_BYTES;
#undef SBAR
#undef WAIT_BAR
}
#ifndef MK_MU8
#define MK_MU8 0
#endif
#ifndef MK_PLE8
#define MK_PLE8 0
#endif
#define GAS __attribute__((address_space(1)))
#define LAS __attribute__((address_space(3)))
typedef unsigned v4u __attribute__((ext_vector_type(4)));
typedef float f32x4 __attribute__((ext_vector_type(4)));
typedef GAS unsigned gu32;
#define RLX_AGENT __ATOMIC_RELAXED, __HIP_MEMORY_SCOPE_AGENT
#define LDS_WAIT() asm volatile("s_waitcnt lgkmcnt(0)" ::: "memory")
#define VM_WAIT() asm volatile("s_waitcnt vmcnt(0)" ::: "memory")
constexpr int NWAVES = 8;
constexpr size_t W_IN = 0;
constexpr size_t W_CAT = W_IN + (size_t)3840 * 1024 * 2;
constexpr size_t W_G8 = W_CAT;
constexpr size_t W_BR = W_CAT + (size_t)3 * 1024 * 1024;
constexpr float G8_SCALE = 128.0f;
constexpr size_t W_OUT = W_CAT + (size_t)3 * 1024 * 1536 * 2;
constexpr size_t W_GU = W_OUT + (size_t)1024 * 1024 * 2;
constexpr size_t W_D = W_GU + (size_t)16 * 512 * 1024 * 2;
constexpr size_t W_RH = W_D + (size_t)16 * 1024 * 256 * 2;
constexpr size_t W_RL = W_RH + 65536;
constexpr size_t W_ENDB = W_RL + 65536;
static_assert(WS_W + W_ENDB <= WS_SSB && WS_SSB + MiB <= WS_WPLE, "weight map");
constexpr size_t W_PG = 0, W_P = (size_t)1024 * 1024 * 2, WPLE_STRIDE = (size_t)5 * 512 * 1024;
constexpr size_t OUT_XB8 = 0, OUT_GATES = 16 * MiB;
constexpr size_t OV_PB = WS_PB;
constexpr size_t OV_PW = WS_PROJ + 8 * MiB;
constexpr size_t OV_ACT = WS_PROJ + 40 * MiB;
constexpr size_t OV_XB2 = WS_PROJ + 64 * MiB;
constexpr int RING_BYTES = 131072, MISC_OFF = RING_BYTES, LDS_BYTES = 147456;
constexpr int MI_N = 0, MI_BASE = 32, MI_U0 = 64, MI_TOT = 96, MI_Q = 100, MI_BAR = 104;

__device__ __forceinline__ unsigned pk2(float lo, float hi) { typedef float f2 __attribute__((ext_vector_type(2))); typedef __bf16 b2 __attribute__((ext_vector_type(2))); f2 v = {lo, hi}; b2 b = __builtin_convertvector(v, b2); return __builtin_bit_cast(unsigned, b); }
__device__ __forceinline__ float bflo(unsigned u) { return __uint_as_float(u << 16); }
__device__ __forceinline__ float bfhi(unsigned u) { return __uint_as_float(u & 0xffff0000u); }
__device__ __forceinline__ float sigm(float v) { return __builtin_amdgcn_rcpf(1.0f + __expf(-v)); }
__device__ __forceinline__ float sg2(float t) { return __builtin_amdgcn_rcpf(1.0f + __builtin_amdgcn_exp2f(t)); }
__device__ __forceinline__ float clamp8(float v) { return __builtin_amdgcn_fmed3f(v, -448.0f, 448.0f); }
__device__ __forceinline__ unsigned pk_fp8x4(float a, float b, float c, float d) {
    int w = __builtin_amdgcn_cvt_pk_fp8_f32(clamp8(a), clamp8(b), 0, false); w = __builtin_amdgcn_cvt_pk_fp8_f32(clamp8(c), clamp8(d), w, true); return (unsigned)w; }

#define XOR1(v) __int_as_float(__builtin_amdgcn_ds_swizzle(__float_as_int(v), 0x041f))
#define XOR2(v) __int_as_float(__builtin_amdgcn_ds_swizzle(__float_as_int(v), 0x081f))
#define XOR4(v) __int_as_float(__builtin_amdgcn_ds_swizzle(__float_as_int(v), 0x101f))
#define XOR8(v) __int_as_float(__builtin_amdgcn_ds_swizzle(__float_as_int(v), 0x201f))
#define XOR16(v) __int_as_float(__builtin_amdgcn_ds_swizzle(__float_as_int(v), 0x401f))
__device__ __forceinline__ float add_xor32(float v) { const auto r = __builtin_amdgcn_permlane32_swap(__float_as_uint(v), __float_as_uint(v), false, false); return __uint_as_float(r[0]) + __uint_as_float(r[1]); }
__device__ __forceinline__ float wave_sum64(float v) { v += XOR1(v); v += XOR2(v); v += XOR4(v); v += XOR8(v); v += XOR16(v); return add_xor32(v); }
__device__ __forceinline__ int mk_tid(int wave0) { int l; asm volatile("v_mbcnt_lo_u32_b32 %0, -1, 0\n\tv_mbcnt_hi_u32_b32 %0, -1, %0" : "=v"(l)); return wave0 * 64 + l; }

#define XB_TMO      128
#define XB_XCNT(j)  (256  + 64 * (j))
#define XB_XSUB(j)  (1280 + 64 * (j))
#define XB_XGEN(j)  (2304 + 64 * (j))
#define XB_TOP      3328
#define XB_TOPGEN   3392
#define XCD_BAR_WORDS 3456
#define XB_SPIN_CAP (1u << 18)
__device__ __forceinline__ unsigned xb_ld(unsigned* p)              { return __hip_atomic_load(p, __ATOMIC_RELAXED, __HIP_MEMORY_SCOPE_AGENT); }
__device__ __forceinline__ unsigned xb_add(unsigned* p, unsigned v) { return __hip_atomic_fetch_add(p, v, __ATOMIC_RELAXED, __HIP_MEMORY_SCOPE_AGENT); }
__device__ __forceinline__ unsigned xb_xcc_id() { return (unsigned)__builtin_amdgcn_s_getreg((3 << 11) | 20) & 0xFu; }
#define XB_SPIN(cond, bar) do { unsigned _sp = 0; while (cond) { __builtin_amdgcn_s_sleep(1); \
    if ((++_sp & 255u) == 0u) { if (xb_ld(&(bar)[XB_TMO])) break; if (_sp > XB_SPIN_CAP) { atomicAdd(&(bar)[XB_TMO], 1u); break; } } } } while (0)
struct XcdBarrier { unsigned* bar; unsigned x; volatile LAS unsigned* st; };
__device__ __forceinline__ XcdBarrier xcd_barrier_post(unsigned* bar, volatile LAS unsigned* st, int tid) {
    XcdBarrier b; b.bar = bar; b.x = xb_xcc_id(); b.st = st;
    if (tid == 0) (void)xb_add(&bar[XB_XCNT(b.x)], 1u);
    return b;
}
__device__ __forceinline__ void xcd_barrier_complete(unsigned* bar, unsigned x, unsigned& nloc, unsigned& nx) {
    const unsigned G = gridDim.x * gridDim.y * gridDim.z;
    unsigned sum, cnt, mine, sp = 0u;
    for (;;) {
        sum = 0u; cnt = 0u; mine = 0u;
#pragma unroll
        for (unsigned j = 0; j < 16; ++j) { const unsigned c = xb_ld(&bar[XB_XCNT(j)]); sum += c; cnt += (c > 0u) ? 1u : 0u; mine = (j == x) ? c : mine; }
        if (sum == G) break;
        __builtin_amdgcn_s_sleep(1);
        if ((++sp & 255u) == 0u) { if (xb_ld(&bar[XB_TMO])) break; if (sp > XB_SPIN_CAP) { atomicAdd(&bar[XB_TMO], 1u); break; } }
    }
    nloc = mine > 0u ? mine : 1u; nx = cnt > 0u ? cnt : 1u;
}
#ifndef MK_EARLYINV
#define MK_EARLYINV 1
#endif
#ifndef MK_SPLIT_SLEEP
#define MK_SPLIT_SLEEP 16
#endif
__device__ __forceinline__ void xcd_barrier(const XcdBarrier& b, int tid) {
    asm volatile("s_waitcnt vmcnt(0)" ::: "memory");
    __syncthreads();
    if (tid == 0) {
        unsigned* bar = b.bar;
        __builtin_amdgcn_s_waitcnt(0);
        unsigned nloc = b.st[0], nx = b.st[1];
        if (nloc == 0u) { xcd_barrier_complete(bar, b.x, nloc, nx); b.st[0] = nloc; b.st[1] = nx; }
        const unsigned old = xb_add(&bar[XB_XSUB(b.x)], 1u);
        const unsigned gen = old / nloc;
        if (old + 1u == (gen + 1u) * nloc) {
            __builtin_amdgcn_fence(__ATOMIC_RELEASE, "agent");
            asm volatile("s_waitcnt vmcnt(0)" ::: "memory");
            const unsigned og = xb_add(&bar[XB_TOP], 1u);
            unsigned tg = og / nx; asm volatile("" : "+v"(tg) :: "memory");
            if (og + 1u == (tg + 1u) * nx) { xb_add(&bar[XB_TOPGEN], 1u);
#if MK_EARLYINV
                xb_add(&bar[XB_XGEN(b.x)], 1u); asm volatile("buffer_inv sc1" ::: "memory");
#endif
            } else {
#if MK_EARLYINV
                asm volatile("buffer_inv sc1" ::: "memory");
#endif
                XB_SPIN(xb_ld(&bar[XB_TOPGEN]) == tg, bar);
#if MK_EARLYINV
                xb_add(&bar[XB_XGEN(b.x)], 1u);
#endif
            }
#if !MK_EARLYINV
            __builtin_amdgcn_fence(__ATOMIC_ACQUIRE, "agent");
            xb_add(&bar[XB_XGEN(b.x)], 1u);
#endif
            asm volatile("s_waitcnt vmcnt(0)" ::: "memory");
        } else {
#if MK_EARLYINV
            { unsigned g2 = gen; asm volatile("" : "+v"(g2) :: "memory"); asm volatile("buffer_inv sc1" ::: "memory");
              XB_SPIN(xb_ld(&bar[XB_XGEN(b.x)]) == g2, bar); }
#else
            XB_SPIN(xb_ld(&bar[XB_XGEN(b.x)]) == gen, bar);
            __builtin_amdgcn_fence(__ATOMIC_ACQUIRE, "agent");
#endif
            asm volatile("s_waitcnt vmcnt(0)" ::: "memory");
        }
    }
    __syncthreads();
}

__device__ __forceinline__ void split_arrive(unsigned* cnt, int tid) {
    asm volatile("s_waitcnt vmcnt(0)" ::: "memory"); __syncthreads();
    if (tid == 0) { __builtin_amdgcn_fence(__ATOMIC_RELEASE, "agent"); asm volatile("s_waitcnt vmcnt(0)" ::: "memory"); xb_add(cnt, 1u); }
}
__device__ __forceinline__ void split_arrive_x(const XcdBarrier& b, unsigned* cnt_top, unsigned* cnt_x, int tid) {
    asm volatile("s_waitcnt vmcnt(0)" ::: "memory"); __syncthreads();
    if (tid == 0) { const unsigned nloc = b.st[0]; const unsigned old = xb_add(cnt_x + 8u * b.x, 1u);
        if (old + 1u == nloc) { __builtin_amdgcn_fence(__ATOMIC_RELEASE, "agent"); asm volatile("s_waitcnt vmcnt(0)" ::: "memory"); xb_add(cnt_top, nloc); }
#if MK_EARLYINV
        asm volatile("buffer_inv sc1" ::: "memory");
#endif
    }
}
__device__ __forceinline__ void split_wait_leader(unsigned* cnt, unsigned target) {
    unsigned sp = 0; while (xb_ld(cnt) < target) { __builtin_amdgcn_s_sleep(MK_SPLIT_SLEEP); if (++sp > (1u << 22)) break; }
#if !MK_EARLYINV
    __builtin_amdgcn_fence(__ATOMIC_ACQUIRE, "agent");
#endif
    asm volatile("s_waitcnt vmcnt(0)" ::: "memory");
}

__device__ __forceinline__ void group4_sync(unsigned* gc, int tid) {
    asm volatile("s_waitcnt vmcnt(0)" ::: "memory"); __syncthreads();
    if (tid == 0) { const unsigned sh = 8u + 3u * xb_xcc_id();
        xb_add(gc, 1u + (1u << sh));
        asm volatile("buffer_inv sc1" ::: "memory");
        unsigned sp = 0, v = 0; for (;;) { v = xb_ld(gc); if ((v & 0xffu) >= 4u) break; __builtin_amdgcn_s_sleep(1); if (++sp > (1u << 22)) break; }
        if (((v >> sh) & 7u) != 4u) {
            __builtin_amdgcn_fence(__ATOMIC_RELEASE, "agent"); asm volatile("s_waitcnt vmcnt(0)" ::: "memory");
            xb_add(gc + 16, 1u); sp = 0; while (xb_ld(gc + 16) < 4u) { __builtin_amdgcn_s_sleep(1); if (++sp > (1u << 22)) break; }
            __builtin_amdgcn_fence(__ATOMIC_ACQUIRE, "agent"); }
        asm volatile("s_waitcnt vmcnt(0)" ::: "memory"); }
    __syncthreads();
}

struct Args { const void* in[27]; float* out; unsigned char* ws; int ph_lo, ph_hi, li, pad; };
struct LayerW {
    const float *g_attn, *w_in, *pool_w, *pool_scale, *dqn, *dkn, *dlam, *dsub, *fqn, *fkn, *ffb, *w_branch, *w_out, *g_ffn, *wrg, *brg, *wre, *bre, *wg, *wu, *wd, *g_ple, *wpg, *wple, *p;
};
__device__ __forceinline__ LayerW layer_view(const __attribute__((address_space(4))) Args* a, int l) {
    LayerW w; const float* in[27];
#pragma unroll
    for (int i = 0; i < 27; ++i) in[i] = (const float*)a->in[i];
    w.g_attn = in[3] + l * 1024; w.w_in = in[4] + (size_t)l * 1024 * INW; w.pool_w = in[5] + (size_t)l * 65536; w.pool_scale = in[6] + l * 512;
    w.dqn = in[7] + l * 64; w.dkn = in[8] + l * 64; w.dlam = in[9] + l * 256; w.dsub = in[10] + l * 128; w.fqn = in[11] + l * 64; w.fkn = in[12] + l * 64; w.ffb = in[13] + l * 8;
    w.w_branch = in[14] + (size_t)l * 3 * 512 * 1024; w.w_out = in[15] + (size_t)l * 1024 * 1024; w.g_ffn = in[16] + l * 1024; w.wrg = in[17] + (size_t)l * 4096; w.brg = in[18] + l * 4;
    w.wre = in[19] + (size_t)l * 16384; w.bre = in[20] + l * 16; w.wg = in[21] + (size_t)l * 16 * 262144; w.wu = in[22] + (size_t)l * 16 * 262144; w.wd = in[23] + (size_t)l * 16 * 262144;
    w.g_ple = in[24] + l * 1024; w.wpg = in[25] + (size_t)l * 1024 * 1024; w.wple = in[26] + (size_t)l * 256 * 1024; w.p = in[1] + (size_t)l * T * 256;
    return w;
}

__device__ __forceinline__ void tr_item(const float* __restrict__ src, int ldsrc, int c0, int nvalid, int k0, const float* __restrict__ gk, bf16* dst, int dpitch, int nrow0, int dk0, LAS float* scr, int lane, const bool f8 = false) {
    float vv[32];
#pragma unroll
    for (int i = 0; i < 32; ++i) { const int kk = 2 * i + (lane >> 5), c = lane & 31; vv[i] = (c < nvalid) ? src[(size_t)(k0 + kk) * ldsrc + c0 + c] : 0.f; }
    if (gk) {
#pragma unroll
        for (int i = 0; i < 32; ++i) vv[i] *= gk[k0 + 2 * i + (lane >> 5)]; }
#pragma unroll
    for (int i = 0; i < 32; ++i) scr[(2 * i + (lane >> 5)) * 33 + (lane & 31)] = vv[i];
    LDS_WAIT(); asm volatile("" ::: "memory");
    const int c8 = lane & 7;
#pragma unroll
    for (int j = 0; j < 4; ++j) { const int n = (lane >> 3) + 8 * j; const LAS float* s = scr + (8 * c8) * 33 + n;
        if (f8) { typedef unsigned v2u_ __attribute__((ext_vector_type(2))); v2u_ o;
            o.x = pk_fp8x4(s[0 * 33] * G8_SCALE, s[1 * 33] * G8_SCALE, s[2 * 33] * G8_SCALE, s[3 * 33] * G8_SCALE); o.y = pk_fp8x4(s[4 * 33] * G8_SCALE, s[5 * 33] * G8_SCALE, s[6 * 33] * G8_SCALE, s[7 * 33] * G8_SCALE);
            *(GAS v2u_*)((GAS char*)dst + (size_t)(nrow0 + n) * dpitch + dk0 + 8 * c8) = o; }
        else { v4u o; o.x = pk2(s[0 * 33], s[1 * 33]); o.y = pk2(s[2 * 33], s[3 * 33]); o.z = pk2(s[4 * 33], s[5 * 33]); o.w = pk2(s[6 * 33], s[7 * 33]);
            *(GAS v4u*)(dst + (size_t)(nrow0 + n) * dpitch + dk0 + 8 * c8) = o; } }
    LDS_WAIT(); asm volatile("" ::: "memory");
}
constexpr int CV_EARLY = 1536 + 128 + 1536 + 768, CV_NIT = CV_EARLY + 512 + 4096 + 2048 + 512 + 128, CV_LATE_BATCHES = (CV_NIT - CV_EARLY + 7) / 8, CV_RT_BATCHES = 64, CV_PB_BATCHES = 64;
__device__ __forceinline__ void conv_item(const LayerW& w, unsigned char* ws, int l, int it, LAS float* scr, int lane) {
    bf16* Wb = (bf16*)(ws + WS_W); bf16* WIN = (bf16*)(ws + WS_W + W_IN); bf16* WOUT = (bf16*)(ws + WS_W + W_OUT);
    bf16* WGU = (bf16*)(ws + WS_W + W_GU); bf16* WDN = (bf16*)(ws + WS_W + W_D); bf16* WPG = (bf16*)(ws + WS_WPLE + l * WPLE_STRIDE + W_PG); bf16* WP = (bf16*)(ws + WS_WPLE + l * WPLE_STRIDE + W_P);
    (void)Wb;
    constexpr int I_A = 1536, I_B = 128, I_D1 = 1536, I_D2 = 768, I_E = 512, I_F = 4096, I_G = 2048, I_H1 = 512, I_H2 = 128;
    constexpr int NIT = I_A + I_B + I_D1 + I_D2 + I_E + I_F + I_G + I_H1 + I_H2;
    int r = it;
        if (r < I_A) { const int kb = r / 96, nb = r % 96, p0 = 512 + 32 * nb, pn = p0 >> 8, q0 = p0 & 255;
            const bool head = (pn >= 2 && pn <= 5) || (pn >= 8 && pn <= 11);
            const int c0 = head ? (256 * pn + 64 * ((q0 >> 5) & 3) + 32 * (q0 >> 7)) : p0;
            tr_item(w.w_in, INW, c0, 32, 64 * kb, w.g_attn, WIN, 1024, p0, 64 * kb, scr, lane); return; } r -= I_A;
        if (r < I_B) { const int kb = r / 8, nb = r % 8; tr_item(w.w_in, INW, 3584, nb == 0 ? 8 : 0, 64 * kb, w.g_attn, WIN, 1024, 3584 + 32 * nb, 64 * kb, scr, lane); return; } r -= I_B;
        if (r < I_D1) { const int n = r / 512, r2 = r % 512, kb = r2 / 32, nb = r2 % 32;
            tr_item(w.w_in, INW, 3592 + n * 1024 + 32 * nb, 32, 64 * kb, w.g_attn, (bf16*)(ws + WS_W + W_G8 + (size_t)n * 1024 * 1024), 1024, 32 * nb, 64 * kb, scr, lane, true); return; } r -= I_D1;
        if (r < I_D2) { const int n = r / 256, r2 = r % 256, kb = r2 / 32, nb = r2 % 32;
            tr_item(w.w_branch + (size_t)n * 512 * 1024, 1024, 32 * nb, 32, 64 * kb, nullptr, (bf16*)(ws + WS_W + W_BR) + (size_t)n * 1024 * 512, 512, 32 * nb, 64 * kb, scr, lane); return; } r -= I_D2;
        if (r < I_E) { const int kb = r / 32, nb = r % 32; tr_item(w.w_out, 1024, 32 * nb, 32, 64 * kb, nullptr, WOUT, 1024, 32 * nb, 64 * kb, scr, lane); return; } r -= I_E;
        if (r < I_F) { const int e = r / 256, r1 = r % 256, hf = r1 / 128, r2 = r1 % 128, kb = r2 / 8, nb = r2 % 8, q0 = 32 * nb;
            const float* src = ((q0 >> 7) ? w.wu : w.wg) + (size_t)e * 262144;
            const bool f8 = MK_MU8 && l == NL - 1;
            tr_item(src, 256, 128 * hf + (q0 & 127), 32, 64 * kb, w.g_ffn, f8 ? (bf16*)((unsigned char*)WGU + (size_t)(e * 2 + hf) * 256 * 1024) : WGU + (size_t)(e * 2 + hf) * 256 * 1024, 1024, q0, 64 * kb, scr, lane, f8); return; } r -= I_F;
        if (r < I_G) { const int e = r / 128, r2 = r % 128, kb = r2 / 32, nb = r2 % 32;
            tr_item(w.wd + (size_t)e * 262144, 1024, 32 * nb, 32, 64 * kb, nullptr, WDN + (size_t)e * 262144, 256, 32 * nb, 64 * kb, scr, lane); return; } r -= I_G;
        if (r < I_H1) { const int kb = r / 32, nb = r % 32; tr_item(w.wpg, 1024, 32 * nb, 32, 64 * kb, w.g_ple, WPG, 1024, 32 * nb, 64 * kb, scr, lane, MK_PLE8 != 0); return; } r -= I_H1;
        { const int kb = r / 32, nb = r % 32; tr_item(w.wple, 1024, 32 * nb, 32, 64 * kb, nullptr, WP, 256, 32 * nb, 64 * kb, scr, lane); }
}
__device__ __forceinline__ void conv_late_batch(const LayerW& w, unsigned char* ws, int l, LAS unsigned char* lds, int batch, int tid) {
    const int lane = tid & 63, wave = __builtin_amdgcn_readfirstlane(tid >> 6);
    if (batch < CV_LATE_BATCHES) { const int it = CV_EARLY + batch * 8 + wave; if (it < CV_NIT) conv_item(w, ws, l, it, (LAS float*)(lds + wave * 16384), lane); }
    else if (batch >= CV_LATE_BATCHES + CV_RT_BATCHES) {
        const int i0 = (batch - CV_LATE_BATCHES - CV_RT_BATCHES) * 8192 + tid; GAS v4u* PB = (GAS v4u*)(ws + OV_PB);
#pragma clang loop unroll(disable)
        for (int q0 = 0; q0 < 16; q0 += 4) { f32x4 a[4], b[4];
#pragma unroll
            for (int q = 0; q < 4; ++q) { const GAS f32x4* s = (const GAS f32x4*)(w.p) + 2 * (size_t)(i0 + (q0 + q) * 512); a[q] = s[0]; b[q] = s[1]; }
#pragma unroll
            for (int q = 0; q < 4; ++q) { v4u o; o.x = pk2(a[q].x, a[q].y); o.y = pk2(a[q].z, a[q].w); o.z = pk2(b[q].x, b[q].y); o.w = pk2(b[q].z, b[q].w); PB[i0 + (q0 + q) * 512] = o; } } }
    else { const int idx = (batch - CV_LATE_BATCHES) * 512 + tid; const int e = idx >> 10, k = idx & 1023;
        const float v = w.g_ffn[k] * (e < 4 ? w.wrg[k * 4 + e] : (e < 20 ? w.wre[k * 16 + e - 4] : 0.f));
        const unsigned hi = pk2(v, 0.f) & 0xffffu; const unsigned lo = pk2(v - bflo(hi), 0.f) & 0xffffu;
        ((bf16*)(ws + WS_W + W_RH))[idx] = (bf16)hi; ((bf16*)(ws + WS_W + W_RL))[idx] = (bf16)lo; }
}
__device__ __forceinline__ void weff_job(const LayerW& w, unsigned char* ws, LAS unsigned char* lds, int job, int tid) {
    bf16* WIN = (bf16*)(ws + WS_W + W_IN);
    LAS float* Wt = (LAS float*)lds; LAS float* Pw = (LAS float*)(lds + 36864);
    const int kb = job >> 4, g = (job >> 2) & 3, nq = job & 3, k0 = 64 * kb;
    for (int e = tid; e < 64 * 128; e += 512) { const int kk = e >> 7, c = e & 127; Wt[kk * 132 + c] = w.w_in[(size_t)(k0 + kk) * INW + 128 * g + c]; }
    for (int e = tid; e < 128 * 32; e += 512) { const int c = e >> 5, n = e & 31; Pw[c * 32 + n] = w.pool_w[(size_t)g * 16384 + c * 128 + 32 * nq + n]; }
    __syncthreads();
    const int n = tid & 31, ks = tid >> 5; float a[4] = {0.f, 0.f, 0.f, 0.f};
#pragma unroll 2
    for (int c = 0; c < 128; c += 4) {
        const float p0 = Pw[c * 32 + n], p1 = Pw[(c + 1) * 32 + n], p2 = Pw[(c + 2) * 32 + n], p3 = Pw[(c + 3) * 32 + n];
#pragma unroll
        for (int i = 0; i < 4; ++i) { const f32x4 w4 = *(const LAS f32x4*)(Wt + (ks * 4 + i) * 132 + c); a[i] += (w4.x * p0 + w4.y * p1) + (w4.z * p2 + w4.w * p3); } }
    const float sc = w.pool_scale[128 * g + 32 * nq + n];
#pragma unroll
    for (int i = 0; i < 4; ++i) a[i] *= sc * w.g_attn[k0 + ks * 4 + i];
    *(GAS unsigned long long*)(WIN + (size_t)(128 * g + 32 * nq + n) * 1024 + k0 + ks * 4) = (unsigned long long)pk2(a[0], a[1]) | ((unsigned long long)pk2(a[2], a[3]) << 32);
    __syncthreads();
}
__device__ __forceinline__ void conv_layer(const LayerW& w, unsigned char* ws, int l, LAS unsigned char* lds, int vcu, int G, int tid) {
    const int lane = tid & 63, wave = __builtin_amdgcn_readfirstlane(tid >> 6);
    LAS float* scr = (LAS float*)(lds + wave * 16384);
    const int gw = vcu * NWAVES + wave, NGW = G * NWAVES;
    for (int it = gw; it < CV_EARLY; it += NGW) conv_item(w, ws, l, it, scr, lane);
    __syncthreads();
    for (int job = vcu; job < 256; job += G) weff_job(w, ws, lds, job, tid);
}
constexpr int CV_EARLY_BATCHES = CV_EARLY / 8 + 256;
__device__ __forceinline__ void conv_early_batch(const LayerW& w, unsigned char* ws, int l, LAS unsigned char* lds, int batch, int tid) {
    const int lane = tid & 63, wave = __builtin_amdgcn_readfirstlane(tid >> 6);
    if (batch < CV_EARLY / 8) { conv_item(w, ws, l, batch * 8 + wave, (LAS float*)(lds + wave * 16384), lane); __syncthreads(); }
    else weff_job(w, ws, lds, batch - CV_EARLY / 8, tid);
}
__device__ __forceinline__ void p0_x(const float* x, const int* positions, unsigned char* ws, unsigned char* x8, int vcu, int G, int tid) {
    const int lane = tid & 63, wave = __builtin_amdgcn_readfirstlane(tid >> 6);
    bf16* XY = (bf16*)(ws + WS_XY); float* SS = (float*)(ws + WS_SS); float* CS = (float*)(ws + WS_COSSIN);
    const int gw = vcu * NWAVES + wave, NGW = G * NWAVES;
    for (int t = gw; t < T; t += NGW) {
        const GAS f32x4* xr = (const GAS f32x4*)(x + (size_t)t * 1024) + lane; float s = 0.f;
        GAS unsigned long long* o8 = (GAS unsigned long long*)(XY + (size_t)t * XYP + 1536) + lane;
#pragma unroll
        for (int j = 0; j < 4; ++j) { const f32x4 v = xr[64 * j]; s += (v.x * v.x + v.y * v.y) + (v.z * v.z + v.w * v.w); o8[64 * j] = (unsigned long long)pk2(v.x, v.y) | ((unsigned long long)pk2(v.z, v.w) << 32);
            ((GAS unsigned*)(x8 + (size_t)t * 1024))[lane + 64 * j] = pk_fp8x4(v.x, v.y, v.z, v.w); }
        s = wave_sum64(s);
        if (lane < 16) SS[(size_t)t * 16 + lane] = lane == 0 ? s : 0.f;
    }
    for (int idx = vcu * 512 + tid; idx < T * 8; idx += G * 512) { const int t = idx >> 3, i = idx & 7;
        const float invf = powf(500000.0f, -(float)(2 * i) / 16.0f); const float ang = (float)positions[t] * invf;
        CS[(size_t)t * 16 + i] = cosf(ang); CS[(size_t)t * 16 + 8 + i] = sinf(ang); }
}

typedef pg8::f32x4 (&AccRef)[2][2][4][2];
#define LAUNDER3(a, b, c) asm volatile("" : "+v"(a), "+v"(b), "+v"(c))
__device__ __forceinline__ float rstd_at(const float* SS, unsigned row) {
    const GAS f32x4* p = (const GAS f32x4*)((const GAS char*)SS + row * 64u); const f32x4 a = p[0], b = p[1], c = p[2], d = p[3];
    const float s = ((a.x + a.y) + (a.z + a.w)) + ((b.x + b.y) + (b.z + b.w)) + ((c.x + c.y) + (c.z + c.w)) + ((d.x + d.y) + (d.z + d.w));
    return rsqrtf(s * (1.0f / 1024.0f) + RMS_EPS);
}
__device__ __forceinline__ void rstd8(const float* SS, unsigned row0, int fq, float (&rs)[8]) {
    f32x4 v[8];
#pragma unroll
    for (int i = 0; i < 8; ++i) v[i] = *(const GAS f32x4*)((const GAS char*)SS + ((row0 + (unsigned)((i >> 2) * 128 + (i & 3) * 16)) * 64u + (unsigned)fq * 16u));
#pragma unroll
    for (int i = 0; i < 8; ++i) { float s = (v[i].x + v[i].y) + (v[i].z + v[i].w); s += XOR16(s); s = add_xor32(s); rs[i] = rsqrtf(s * (1.0f / 1024.0f) + RMS_EPS); }
}
__device__ __forceinline__ float logsig(float z) { return fminf(z, 0.f) - log1pf(expf(-fabsf(z))); }
struct EpiG1 {
    const float* SS; bf16* PROJ; float* LOGF; const float* CS; const float* GT; const float* ffb; int dry; const LAS float* rsl;
    __device__ __forceinline__ void operator()(AccRef acc, const pg8::Step& st, int wr, int wc, int fr_, int fq_) const {
        if (dry) return;
        int fr = fr_, fq = fq_, zz = 0; LAUNDER3(fr, fq, zz);
        const int pn = st.pn; const unsigned row0 = (unsigned)(st.pm * 256 + wr * 64 + fr);
#define RSL8(dst_) do { _Pragma("unroll") for (int i_ = 0; i_ < 8; ++i_) dst_[i_] = rsl[st.aux * 256 + (i_ >> 2) * 128 + wr * 64 + (i_ & 3) * 16 + fr]; } while (0)
        const bool head = (pn >= 2 && pn <= 5) || (pn >= 8 && pn <= 11);
        if (head) {
            const float* gain = GT + 64 * (pn < 4 ? 0 : (pn < 6 ? 1 : (pn < 10 ? 2 : 3)));
            const bool rot = pn < 6; const float osc = (pn < 4 || (pn >= 8 && pn < 10)) ? C2 : 1.0f;
            f32x4 G[2][2];
#pragma unroll
            for (int bj = 0; bj < 2; ++bj)
#pragma unroll
                for (int n = 0; n < 2; ++n) G[bj][n] = *(const GAS f32x4*)((const GAS char*)gain + (unsigned)(32 * bj + 8 * fq + 4 * n) * 4u);
            const GAS char* pb = (const GAS char*)PROJ + (unsigned)(256 * pn + 64 * wc) * 2u;
            float rs8[8]; RSL8(rs8);
            f32x4 cs[4];
#define G1_LOADCS(i_) do { if (rot && fq < 2) { const GAS f32x4* cp_ = (const GAS f32x4*)((const GAS char*)CS + (row0 + (unsigned)(((i_) >> 2) * 128 + ((i_) & 3) * 16)) * 64u); \
                _Pragma("unroll") for (int q_ = 0; q_ < 4; ++q_) cs[q_] = cp_[q_]; } } while (0)
            G1_LOADCS(0);
#pragma unroll
            for (int i = 0; i < 8; ++i) {
                v4u ov[2];
                {
                    const int ai = i >> 2, m = i & 3; const float rs = rs8[i];
                    f32x4 v[2][2]; float ss = 0.f;
#pragma unroll
                    for (int bj = 0; bj < 2; ++bj)
#pragma unroll
                        for (int n = 0; n < 2; ++n) { v[bj][n] = acc[ai][bj][m][n]; const f32x4 q = v[bj][n] * v[bj][n]; ss += (q.x + q.y) + (q.z + q.w); }
                    ss += XOR16(ss); ss = add_xor32(ss);
                    const float hn = rsqrtf(ss * (1.0f / 64.0f) + RMS_EPS * __builtin_amdgcn_rcpf(rs * rs)) * osc;
#pragma unroll
                    for (int bj = 0; bj < 2; ++bj)
#pragma unroll
                        for (int n = 0; n < 2; ++n) v[bj][n] = v[bj][n] * hn * G[bj][n];
                    if (rot) {
                        f32x4 ot[2];
#pragma unroll
                        for (int n = 0; n < 2; ++n) { ot[n].x = XOR16(v[0][n].x); ot[n].y = XOR16(v[0][n].y); ot[n].z = XOR16(v[0][n].z); ot[n].w = XOR16(v[0][n].w); }
                        if (fq < 2) {
#pragma unroll
                            for (int n = 0; n < 2; ++n) { const f32x4 c = cs[n], s = cs[2 + n]; v[0][n] = (fq == 0) ? (v[0][n] * c - ot[n] * s) : (v[0][n] * c + ot[n] * s); }
                        }
                    }
#pragma unroll
                    for (int bj = 0; bj < 2; ++bj) { ov[bj].x = pk2(v[bj][0].x, v[bj][0].y); ov[bj].y = pk2(v[bj][0].z, v[bj][0].w); ov[bj].z = pk2(v[bj][1].x, v[bj][1].y); ov[bj].w = pk2(v[bj][1].z, v[bj][1].w); }
                }
                if (i < 7) G1_LOADCS(i + 1);
                asm volatile("" ::: "memory");
                { const unsigned row = row0 + (unsigned)((i >> 2) * 128 + (i & 3) * 16);
#pragma unroll
                    for (int bj = 0; bj < 2; ++bj) *(GAS v4u*)(pb + (row * (unsigned)(PJP * 2) + (unsigned)(32 * bj + 8 * fq) * 2u)) = ov[bj]; }
                asm volatile("" ::: "memory");
            }
#undef G1_LOADCS
        } else if (pn == 14) {
            float rs14[8]; RSL8(rs14);
            if (wc == 0 && fq == 0) {
                const f32x4 b0 = *(const GAS f32x4*)ffb, b1 = *(const GAS f32x4*)(ffb + 4);
#pragma unroll
                for (int ai = 0; ai < 2; ++ai)
#pragma unroll
                    for (int m = 0; m < 4; ++m) {
                        const unsigned row = row0 + ai * 128 + m * 16; const float rs = rs14[ai * 4 + m];
                        const f32x4 z0 = acc[ai][0][m][0] * rs + b0, z1 = acc[ai][0][m][1] * rs + b1; f32x4 o0, o1;
                        o0.x = logsig(z0.x); o0.y = logsig(z0.y); o0.z = logsig(z0.z); o0.w = logsig(z0.w); o1.x = logsig(z1.x); o1.y = logsig(z1.y); o1.z = logsig(z1.z); o1.w = logsig(z1.w);
                        GAS f32x4* d = (GAS f32x4*)((GAS char*)LOGF + row * 32u); d[0] = o0; d[1] = o1;
                    }
            }
        } else {
            const GAS char* pb = (const GAS char*)PROJ + (unsigned)(256 * pn + 32 * wc) * 2u;
            float rsp[8]; RSL8(rsp);
#pragma unroll
            for (int ai = 0; ai < 2; ++ai)
#pragma unroll
                for (int m = 0; m < 4; ++m) {
                    const unsigned row = row0 + ai * 128 + m * 16; const float rs = rsp[ai * 4 + m];
#pragma unroll
                    for (int bj = 0; bj < 2; ++bj) { const f32x4 a = acc[ai][bj][m][0] * rs, b = acc[ai][bj][m][1] * rs; v4u o; o.x = pk2(a.x, a.y); o.y = pk2(a.z, a.w); o.z = pk2(b.x, b.y); o.w = pk2(b.z, b.w);
                        *(GAS v4u*)(pb + (row * (unsigned)(PJP * 2) + (unsigned)(128 * bj + 8 * fq) * 2u)) = o; }
                }
        }
    }
};
typedef unsigned v2u __attribute__((ext_vector_type(2)));
__device__ __forceinline__ unsigned pk8(float a, float b, float c, float d) {
    unsigned w = __builtin_amdgcn_cvt_pk_u8_f32(a * 256.0f - 0.5f, 0u, 0u); w = __builtin_amdgcn_cvt_pk_u8_f32(b * 256.0f - 0.5f, 1u, w); w = __builtin_amdgcn_cvt_pk_u8_f32(c * 256.0f - 0.5f, 2u, w); return __builtin_amdgcn_cvt_pk_u8_f32(d * 256.0f - 0.5f, 3u, w); }
__device__ __forceinline__ float g8(unsigned w, const int k) { return ((float)((w >> (8 * k)) & 0xffu) + 0.5f) * (1.0f / 256.0f); }
__device__ __forceinline__ float g8u(unsigned w, const int k) { return (float)((w >> (8 * k)) & 0xffu) + 0.5f; }
#undef RSL8
template <int PART>
struct EpiG2 {
    const float* SS; unsigned char* gs; bf16* MERGED; const LAS float* rsl;
    __device__ __forceinline__ void operator()(AccRef acc, const pg8::Step& st, int wr, int wc, int fr_, int fq_) const {
        int ln; asm volatile("v_mbcnt_lo_u32_b32 %0, -1, 0\n\tv_mbcnt_hi_u32_b32 %0, -1, %0" : "=v"(ln));
        int fr = ln & 15, fq = ln >> 4, tid = (wr * 4 + wc) * 64 + ln; LAUNDER3(fr, fq, tid); (void)fr_; (void)fq_;
        const int aux = st.aux; const unsigned row0 = (unsigned)(st.pm * 256 + wr * 64 + fr), toff = (unsigned)tid * 8u;
        const int n = aux < 3 ? aux : aux - 3; GAS char* gb = (GAS char*)gs + (size_t)n * 65536;
        GAS char* mb = (GAS char*)MERGED + (unsigned)(256 * st.pn + 32 * wc) * 2u;
        float rsg[8];
#pragma unroll
        for (int i = 0; i < 8; ++i) rsg[i] = 0.f;
        if (PART == 0) {
#pragma unroll
            for (int i = 0; i < 8; ++i) rsg[i] = rsl[(i >> 2) * 128 + wr * 64 + (i & 3) * 16 + fr]; }
#pragma unroll
        for (int ai = 0; ai < 2; ++ai) {
            v2u gn[4][2], gd[4][2];
#pragma unroll
            for (int m = 0; m < 4; ++m)
#pragma unroll
                for (int bj = 0; bj < 2; ++bj) { gn[m][bj] = (v2u){0u, 0u}; gd[m][bj] = (v2u){0u, 0u}; }
            if (PART == 1) {
#pragma unroll
                for (int m = 0; m < 4; ++m)
#pragma unroll
                    for (int bj = 0; bj < 2; ++bj) { const unsigned so = toff + (unsigned)(((ai * 4 + m) * 2 + bj) * 4096); gn[m][bj] = *(const GAS v2u*)(gb + so); if (aux < 5) gd[m][bj] = *(const GAS v2u*)(gb + 65536 + so); }
            }
            asm volatile("" ::: "memory");
#pragma unroll
            for (int m = 0; m < 4; ++m) {
                const float rs = rsg[ai * 4 + m] * (1.0f / G8_SCALE);
#pragma unroll
                for (int bj = 0; bj < 2; ++bj) {
                    const unsigned so = toff + (unsigned)(((ai * 4 + m) * 2 + bj) * 4096);
                    const f32x4 a = acc[ai][bj][m][0], b = acc[ai][bj][m][1]; const v2u n_ = gn[m][bj], d_ = gd[m][bj];
                    f32x4 fa = (f32x4){0.f, 0.f, 0.f, 0.f}, fb = fa;
                    if (PART == 0) { const float rsn = rs * -1.4426950408889634f; const f32x4 x = a * rsn, y = b * rsn; v2u o;
                        o.x = pk8(sg2(x.x), sg2(x.y), sg2(x.z), sg2(x.w)); o.y = pk8(sg2(y.x), sg2(y.y), sg2(y.z), sg2(y.w));
                        *(GAS v2u*)(gb + so) = o;
                    } else if (aux < 5) {
                        fa.x = g8u(n_.x, 0) * __builtin_amdgcn_rcpf(g8u(d_.x, 0)); fa.y = g8u(n_.x, 1) * __builtin_amdgcn_rcpf(g8u(d_.x, 1)); fa.z = g8u(n_.x, 2) * __builtin_amdgcn_rcpf(g8u(d_.x, 2)); fa.w = g8u(n_.x, 3) * __builtin_amdgcn_rcpf(g8u(d_.x, 3));
                        fb.x = g8u(n_.y, 0) * __builtin_amdgcn_rcpf(g8u(d_.y, 0)); fb.y = g8u(n_.y, 1) * __builtin_amdgcn_rcpf(g8u(d_.y, 1)); fb.z = g8u(n_.y, 2) * __builtin_amdgcn_rcpf(g8u(d_.y, 2)); fb.w = g8u(n_.y, 3) * __builtin_amdgcn_rcpf(g8u(d_.y, 3));
                    } else { v4u o;
                        o.x = pk2(a.x * g8(n_.x, 0), a.y * g8(n_.x, 1)); o.y = pk2(a.z * g8(n_.x, 2), a.w * g8(n_.x, 3)); o.z = pk2(b.x * g8(n_.y, 0), b.y * g8(n_.y, 1)); o.w = pk2(b.z * g8(n_.y, 2), b.w * g8(n_.y, 3));
                        *(GAS v4u*)(mb + ((row0 + ai * 128 + m * 16) * 2048u + (unsigned)(128 * bj + 8 * fq) * 2u)) = o;
                    }
                    acc[ai][bj][m][0] = a * fa; acc[ai][bj][m][1] = b * fb;
                    asm volatile("" : "+v"(acc[ai][bj][m][0]), "+v"(acc[ai][bj][m][1]));
                }
            }
            asm volatile("" ::: "memory");
        }
    }
};
#ifndef MK_X8
#define MK_X8 1
#endif
template <int KIND, bool SCATTER>
struct EpiRes {
    const bf16* xs; int ldxs; float* xo; bf16* xb; int ldxb; float* SSo; const float* SSi; const bf16* PW; int dry; unsigned char* x8;
    __device__ __forceinline__ void operator()(AccRef acc, const pg8::Step& st, int wr, int wc, int fr_, int fq_) const {
        if (SCATTER && st.aux == 0) return;
        int fr = fr_, fq = fq_, zz = 0; LAUNDER3(fr, fq, zz);
        const int pn = st.pn; const unsigned colb = (unsigned)(256 * pn + 32 * wc + 8 * fq);
        int rowi[8];
#pragma unroll
        for (int i = 0; i < 8; ++i) { const int r = (i >> 2) * 128 + wr * 64 + (i & 3) * 16 + fr; rowi[i] = SCATTER ? ((r < st.nvalid) ? st.rows[r] : -1) : (st.pm * 256 + r); }
        float rs8[8];
#pragma unroll
        for (int i = 0; i < 8; ++i) rs8[i] = 1.f;
        if (KIND == 1) { rstd8(SSi, (unsigned)(st.pm * 256 + wr * 64 + fr), fq, rs8);
            if (MK_PLE8) {
#pragma unroll
                for (int i = 0; i < 8; ++i) rs8[i] *= (1.0f / G8_SCALE); } }
        v4u xin[2][2][2]; v4u pwv[2][2][2];
#define RES_LOAD(p_, buf_) do { _Pragma("unroll") for (int u_ = 0; u_ < 2; ++u_) { const int i_ = 2 * (p_) + u_; const unsigned rw_ = rowi[i_] >= 0 ? (unsigned)rowi[i_] : 0u; \
            _Pragma("unroll") for (int bj_ = 0; bj_ < 2; ++bj_) { xin[buf_][u_][bj_] = *(const GAS v4u*)((const GAS char*)xs + (rw_ * (unsigned)ldxs + colb + 128u * bj_) * 2u); \
                if (KIND == 1) pwv[buf_][u_][bj_] = *(const GAS v4u*)((const GAS char*)PW + (rw_ * 1024u + colb + 128u * bj_) * 2u); } } } while (0)
        RES_LOAD(0, 0);
#pragma unroll
        for (int pr = 0; pr < 4; ++pr) {
            float ssp[2]; f32x4 xr[2][2][2];
#pragma unroll
            for (int u = 0; u < 2; ++u) {
                const int i = 2 * pr + u, ai = i >> 2, m = i & 3; const float rs = rs8[i]; float ss = 0.f;
#pragma unroll
                for (int bj = 0; bj < 2; ++bj) {
                    const v4u xv = xin[pr & 1][u][bj];
                    f32x4 x0 = (f32x4){bflo(xv.x), bfhi(xv.x), bflo(xv.y), bfhi(xv.y)}, x1 = (f32x4){bflo(xv.z), bfhi(xv.z), bflo(xv.w), bfhi(xv.w)};
                    f32x4 a = acc[ai][bj][m][0], b = acc[ai][bj][m][1];
                    if (KIND == 1) { const v4u pw = pwv[pr & 1][u][bj];
                        const float rsn = rs * -1.4426950408889634f;
                        a.x = sg2(a.x * rsn) * bflo(pw.x); a.y = sg2(a.y * rsn) * bfhi(pw.x); a.z = sg2(a.z * rsn) * bflo(pw.y); a.w = sg2(a.w * rsn) * bfhi(pw.y);
                        b.x = sg2(b.x * rsn) * bflo(pw.z); b.y = sg2(b.y * rsn) * bfhi(pw.z); b.z = sg2(b.z * rsn) * bflo(pw.w); b.w = sg2(b.w * rsn) * bfhi(pw.w); }
                    x0 += a; x1 += b;
                    { const f32x4 q0 = x0 * x0, q1 = x1 * x1; ss += ((q0.x + q0.y) + (q0.z + q0.w)) + ((q1.x + q1.y) + (q1.z + q1.w)); }
                    xr[u][bj][0] = x0; xr[u][bj][1] = x1;
                }
                ss += XOR16(ss); ss = add_xor32(ss); ssp[u] = ss;
            }
            if (pr < 3) RES_LOAD(pr + 1, (pr + 1) & 1);
            asm volatile("" ::: "memory");
#pragma unroll
            for (int u = 0; u < 2; ++u) {
                const int i = 2 * pr + u; const bool ok = rowi[i] >= 0 && !dry; const unsigned rw = rowi[i] >= 0 ? (unsigned)rowi[i] : 0u;
                if (ok) {
#pragma unroll
                    for (int bj = 0; bj < 2; ++bj) { const f32x4 x0 = xr[u][bj][0], x1 = xr[u][bj][1];
                        if (xo) { GAS f32x4* op = (GAS f32x4*)((GAS char*)xo + (rw * 1024u + colb + 128u * bj) * 4u); op[0] = x0; op[1] = x1; }
                        if (xb) { v4u o; o.x = pk2(x0.x, x0.y); o.y = pk2(x0.z, x0.w); o.z = pk2(x1.x, x1.y); o.w = pk2(x1.z, x1.w);
                            *(GAS v4u*)((GAS char*)xb + (rw * (unsigned)ldxb + colb + 128u * bj) * 2u) = o; }
                        if (MK_X8 && x8) { v2u o2; o2.x = pk_fp8x4(x0.x, x0.y, x0.z, x0.w); o2.y = pk_fp8x4(x1.x, x1.y, x1.z, x1.w); *(GAS v2u*)((GAS char*)x8 + (rw * 1024u + colb + 128u * bj)) = o2; } }
                    if (fq == 0 && xb) *(GAS float*)((GAS char*)SSo + (rw * 16u + (unsigned)(4 * pn + wc)) * 4u) = ssp[u];
                }
            }
            asm volatile("" ::: "memory");
        }
#undef RES_LOAD
    }
};
struct EpiPW {
    bf16* O;
    __device__ __forceinline__ void operator()(AccRef acc, const pg8::Step& st, int wr, int wc, int fr_, int fq_) const {
        int fr = fr_, fq = fq_, zz = 0; LAUNDER3(fr, fq, zz);
        GAS char* ob = (GAS char*)O + (unsigned)(256 * st.pn + 32 * wc) * 2u; const unsigned row0 = (unsigned)(st.pm * 256 + wr * 64 + fr);
#pragma unroll
        for (int ai = 0; ai < 2; ++ai)
#pragma unroll
            for (int m = 0; m < 4; ++m) {
#pragma unroll
                for (int bj = 0; bj < 2; ++bj) { const f32x4 a = acc[ai][bj][m][0], b = acc[ai][bj][m][1]; v4u o; o.x = pk2(a.x, a.y); o.y = pk2(a.z, a.w); o.z = pk2(b.x, b.y); o.w = pk2(b.z, b.w);
                    *(GAS v4u*)(ob + ((row0 + ai * 128 + m * 16) * 2048u + (unsigned)(128 * bj + 8 * fq) * 2u)) = o; }
                asm volatile("" ::: "memory"); }
    }
};
struct EpiMU {
    bf16* ACT; const float* TOKW; float sc;
    __device__ __forceinline__ void operator()(AccRef acc, const pg8::Step& st, int wr, int wc, int fr_, int fq_) const {
        int fr = fr_, fq = fq_, zz = 0; LAUNDER3(fr, fq, zz);
        const int j = st.pn; GAS char* ab = (GAS char*)ACT + (size_t)st.pm * 1024 + (unsigned)(128 * j + 32 * wc) * 2u;
        int tok[8]; f32x4 tw[8];
#pragma unroll
        for (int i = 0; i < 8; ++i) { const int r = (i >> 2) * 128 + wr * 64 + (i & 3) * 16 + fr; tok[i] = (r < st.nvalid) ? st.rows[r] : -1; }
#pragma unroll
        for (int i = 0; i < 8; ++i) { tw[i] = *(const GAS f32x4*)((const GAS char*)TOKW + (unsigned)(tok[i] >= 0 ? tok[i] : 0) * 16u); if (tok[i] < 0) tw[i] = (f32x4){0.f, 0.f, 0.f, 0.f}; }
        asm volatile("" ::: "memory");
#pragma unroll
        for (int i = 0; i < 8; ++i) {
            const int ai = i >> 2, m = i & 3, r = ai * 128 + wr * 64 + m * 16 + fr;
            const float rs = tw[i].z * sc, w = (j < 2) ? tw[i].x : tw[i].y;
            const f32x4 g0 = acc[ai][0][m][0] * rs, g1 = acc[ai][0][m][1] * rs, u0 = acc[ai][1][m][0] * rs, u1 = acc[ai][1][m][1] * rs; v4u o;
            o.x = pk2(g0.x * sigm(g0.x) * u0.x * w, g0.y * sigm(g0.y) * u0.y * w); o.y = pk2(g0.z * sigm(g0.z) * u0.z * w, g0.w * sigm(g0.w) * u0.w * w);
            o.z = pk2(g1.x * sigm(g1.x) * u1.x * w, g1.y * sigm(g1.y) * u1.y * w); o.w = pk2(g1.z * sigm(g1.z) * u1.z * w, g1.w * sigm(g1.w) * u1.w * w);
            *(GAS v4u*)(ab + ((unsigned)r * 1024u + (unsigned)(8 * fq) * 2u)) = o;
            asm volatile("" ::: "memory");
        }
    }
};

__device__ __forceinline__ bool tile_order(long L, int nM, int nN, int& pm, int& pn) {
    const int nwg = nM * nN; if (L >= nwg) return false;
    int wgid = (int)L; { const int q = nwg / 8, r = nwg % 8, xcd = wgid % 8, off = wgid / 8; wgid = (xcd < r ? xcd * (q + 1) : r * (q + 1) + (xcd - r) * q) + off; }
    const int nig = 8 * nN, gid = wgid / nig, fm = gid * 8, gsz = (nM - fm) < 8 ? (nM - fm) : 8;
    pm = fm + ((wgid % nig) % gsz); pn = (wgid % nig) / gsz; return true;
}
struct SchedPlain {
    const char* A; const char* B; size_t a_tile, b_tile; int nM, nN, nt, G, c, fixa, fixb;
    __device__ __forceinline__ bool next(int i, pg8::Step& s) const {
        int pm, pn; if (!tile_order((long)i * G + c, nM, nN, pm, pn)) return false;
        s.A = A + (size_t)(fixa ? 0 : pm) * a_tile; s.B = B + (size_t)(fixb ? 0 : pn) * b_tile; s.rows = nullptr; s.nt = nt; s.pm = pm; s.pn = pn; s.aux = i; s.nvalid = 256; s.zero_after = 1; return true; }
};
template <int PART>
struct SchedG2 {
    const char* Ab; const char* Bb; int c;
    __device__ __forceinline__ bool next(int i, pg8::Step& s) const {
        if (i >= 3) return false; int pm, pn; tile_order(c, 64, 4, pm, pn);
        const int n = i;
        s.A = PART == 0 ? Ab + (size_t)pm * 256 * 1024 : Ab + (size_t)pm * 256 * (XYP * 2) + 512 * n * 2;
        s.B = Bb + ((size_t)n * 1024 + pn * 256) * 1024;
        s.rows = nullptr; s.nt = 8; s.pm = pm; s.pn = pn; s.aux = PART * 3 + i; s.nvalid = 256; s.zero_after = 0; return true; }
};
struct SchedMoE {
    volatile LAS unsigned* MISC; const int* LIST; const char* Ab; const char* Bb; int G, c, mode, f8;
    __device__ __forceinline__ bool next(int i, pg8::Step& s) const {
        const int NU = (int)MISC[MI_TOT]; const int u = c;
        if (u >= NU || i > (mode == 2 ? 1 : 0)) return false;
        const int down = mode == 2;
        int cls = 0;
#pragma unroll 1
        for (int k = 1; k < 24; ++k) if (u >= (int)MISC[MI_U0 + k]) cls = k;
        const int r = u - (int)MISC[MI_U0 + cls], k = r >> 2, j = r & 3, n_c = (int)MISC[MI_N + cls], arow = (int)MISC[MI_BASE + cls] + 256 * k;
        const int grp = cls / 6, pr = cls % 6; const int pa = pr < 3 ? 0 : (pr < 5 ? 1 : 2), pb = pr < 3 ? pr + 1 : (pr < 5 ? pr - 1 : 3);
        s.rows = LIST + (size_t)cls * T + 256 * k; s.nvalid = min(256, n_c - 256 * k); s.pm = arow; s.pn = j;
        if (!down) { const int e = grp * 4 + (j < 2 ? pa : pb), hf = j & 1;
            s.A = Ab; s.B = Bb + (size_t)(e * 2 + hf) * 256 * (f8 ? 1024 : 2048); s.nt = f8 ? 8 : 16; s.aux = cls; s.zero_after = 1; }
        else { const int sgm = i & 1; const int e = grp * 4 + (sgm ? pb : pa);
            s.A = Ab + (size_t)arow * 1024 + sgm * 512; s.B = Bb + ((size_t)e * 1024 + j * 256) * 512; s.nt = 4; s.aux = sgm; s.zero_after = sgm; }
        return true; }
};
__device__ __forceinline__ float wave_sum(float v) {
    return wave_sum64(v);
}
__device__ __forceinline__ void pool_unit(int u, const bf16* PROJ, bf16* XY, int tid_) {
    int tid = tid_; asm volatile("" : "+v"(tid));
    const int c8 = tid & 63, rg = tid >> 6, g = c8 >> 4, w = 2 << g, t0 = 256 * u + 32 * rg, s0 = t0 % S;
    const GAS char* zb = (const GAS char*)PROJ + (unsigned)c8 * 16u; GAS char* yb = (GAS char*)XY + (unsigned)c8 * 16u;
    float sum[8];
#pragma unroll
    for (int j = 0; j < 8; ++j) sum[j] = 0.f;
    { v4u pz[16];
#pragma unroll
      for (int k = 1; k <= 16; ++k) { const bool ok = k <= w && k <= s0; pz[k - 1] = *(const GAS v4u*)(zb + (unsigned)(ok ? t0 - k : t0) * (unsigned)(PJP * 2)); }
#pragma unroll
      for (int k = 1; k <= 16; ++k) { const bool ok = k <= w && k <= s0; const v4u z = pz[k - 1];
        if (ok) { sum[0] += bflo(z.x); sum[1] += bfhi(z.x); sum[2] += bflo(z.y); sum[3] += bfhi(z.y); sum[4] += bflo(z.z); sum[5] += bfhi(z.z); sum[6] += bflo(z.w); sum[7] += bfhi(z.w); } } }
#pragma clang loop unroll(disable)
    for (int r0 = 0; r0 < 32; r0 += 8) {
        v4u zz[8], qq[8];
#pragma unroll
        for (int j = 0; j < 8; ++j) { const int t = t0 + r0 + j, s = s0 + r0 + j;
            zz[j] = *(const GAS v4u*)(zb + (unsigned)t * (unsigned)(PJP * 2)); qq[j] = *(const GAS v4u*)(zb + (unsigned)(s >= w ? t - w : t) * (unsigned)(PJP * 2)); }
#pragma unroll
        for (int j = 0; j < 8; ++j) { const int t = t0 + r0 + j, s = s0 + r0 + j; const v4u z = zz[j], q = qq[j];
            float zf[8] = {bflo(z.x), bfhi(z.x), bflo(z.y), bfhi(z.y), bflo(z.z), bfhi(z.z), bflo(z.w), bfhi(z.w)};
#pragma unroll
            for (int i = 0; i < 8; ++i) sum[i] += zf[i];
            if (s >= w) { sum[0] -= bflo(q.x); sum[1] -= bfhi(q.x); sum[2] -= bflo(q.y); sum[3] -= bfhi(q.y); sum[4] -= bflo(q.z); sum[5] -= bfhi(q.z); sum[6] -= bflo(q.w); sum[7] -= bfhi(q.w); }
            const float ic = 1.0f / (float)min(s + 1, w); v4u o;
            o.x = pk2(sum[0] * ic - zf[0], sum[1] * ic - zf[1]); o.y = pk2(sum[2] * ic - zf[2], sum[3] * ic - zf[3]); o.z = pk2(sum[4] * ic - zf[4], sum[5] * ic - zf[5]); o.w = pk2(sum[6] * ic - zf[6], sum[7] * ic - zf[7]);
            *(GAS v4u*)(yb + (unsigned)t * (unsigned)(XYP * 2)) = o; }
    }
}
#ifndef MK_THRD
#define MK_THRD 32
#endif
#ifndef MK_THRF
#define MK_THRF 64
#endif
#ifndef MK_ATT_SKIP
#define MK_ATT_SKIP 0
#endif
__device__ __forceinline__ void attn_phase(const int wave0, const LayerW& w, int l, int rep, unsigned char* ws, char* lds, volatile LAS unsigned* MISC, gu32* ctl, const int dry) {
    using namespace attn_body;
    int tid = mk_tid(wave0); const int lane = tid & 63;
    bf16* PROJ = (bf16*)(ws + WS_PROJ); bf16* XY = (bf16*)(ws + WS_XY); bf16* STASH = (bf16*)(ws + WS_STASH); const float* LOGF = (const float*)(ws + WS_LOGF);
    const float lam_init = 0.8f - 0.6f * __expf(-0.3f * (float)l);
    float lam; { const float a = wave_sum(w.dlam[lane] * w.dlam[64 + lane]), c = wave_sum(w.dlam[128 + lane] * w.dlam[192 + lane]); lam = __expf(a) - __expf(c) + lam_init; lam = __int_as_float(__builtin_amdgcn_readfirstlane(__float_as_int(lam))); }
    unsigned* qhead = pg8::rflp((unsigned*)(ctl + CW_AQ) + rep); unsigned* fhead = pg8::rflp((unsigned*)(ctl + CW_AQ) + 64 + 16 * l);
    {
        unsigned* top = pg8::rflp((unsigned*)(ctl + CW_SPLIT3) + 64 * l);
#pragma clang loop unroll(disable)
        for (;;) {
            tid = mk_tid(wave0);
            if (tid == 0) { unsigned r = 0xffffffffu; if (xb_ld(top) < (unsigned)gridDim.x) { const unsigned f = atomicAdd(fhead, 1u); if (f < (unsigned)(CV_LATE_BATCHES + CV_RT_BATCHES + CV_PB_BATCHES)) r = f; } MISC[MI_Q] = r; }
            __syncthreads();
            const unsigned fb = MISC[MI_Q];
            __syncthreads();
            if (fb == 0xffffffffu) break;
            conv_late_batch(w, ws, l, (LAS unsigned char*)lds, (int)fb, tid); __syncthreads();
        }
        tid = mk_tid(wave0);
        if (tid == 0) split_wait_leader(top, (unsigned)gridDim.x);
        __syncthreads();
    }
    int first = 1;
    for (;;) {
        tid = mk_tid(wave0);
        if (tid == 0) { unsigned q = first ? (unsigned)blockIdx.x : (unsigned)gridDim.x + atomicAdd(qhead, 1u); if (q >= 832u) q = 832u + atomicAdd(fhead, 1u); MISC[MI_Q] = q; }
        first = 0;
        __syncthreads();
        const int idx = (int)MISC[MI_Q];
        __syncthreads();
        if (idx >= 832 + CV_LATE_BATCHES + CV_RT_BATCHES + CV_PB_BATCHES) break;
        if (idx >= 832) { if (MK_ATT_SKIP && dry && (MK_ATT_SKIP & 8)) continue; conv_late_batch(w, ws, l, (LAS unsigned char*)lds, idx - 832, tid); continue; }
        int kind, qb, bh;
        if (idx < 160) { kind = 0; qb = 7 - idx / 32; bh = idx % 32; }
        else if (idx < 224) { kind = 1; qb = 7; bh = idx - 160; }
        else if (idx < 256) { kind = 0; qb = 2; bh = idx - 224; }
        else if (idx < 384) { kind = 1; qb = 6 - (idx - 256) / 64; bh = (idx - 256) % 64; }
        else if (idx < 416) { kind = 0; qb = 1; bh = idx - 384; }
        else if (idx < 480) { kind = 1; qb = 4; bh = idx - 416; }
        else if (idx < 544) { kind = 2; qb = 0; bh = idx - 480; }
        else if (idx < 608) { kind = 1; qb = 3; bh = idx - 544; }
        else if (idx < 640) { kind = 0; qb = 0; bh = idx - 608; }
        else if (idx < 704) { kind = 1; qb = 2; bh = idx - 640; }
        else { kind = 1; qb = 1 - (idx - 704) / 64; bh = (idx - 704) % 64; }
        if (MK_ATT_SKIP && dry && ((MK_ATT_SKIP >> kind) & 1)) continue;
        if (kind == 2) { pool_unit(bh, PROJ, XY, tid); __syncthreads(); continue; }
        if (kind == 1) {
            const int b = bh >> 3, h = bh & 7;
            AttnP P; P.Q = PROJ + 2048 + h * 64; P.K = PROJ + 2560 + h * 64; P.V = PROJ + 3072 + h * 64; P.out = XY + 1024 + h * 64; P.stash = nullptr; P.gsub = nullptr; P.logf = LOGF + h; P.opitch = XYP; P.lam = 0.f; P.nscale = 0.f;
            attn_unit<MK_THRF, true>(tid, b, qb, 0, P, lds);
        } else {
            const int b = bh >> 2, h = bh & 3;
#pragma unroll 1
            for (int c = 0; c < 2; ++c) {
                AttnP P; P.Q = PROJ + 512 + (h * 2 + c) * 64; P.K = PROJ + 1024 + (h * 2 + c) * 64; P.V = PROJ + 1536 + h * 128;
                P.stash = STASH + h * 128; P.gsub = w.dsub; P.logf = nullptr; P.lam = lam; P.nscale = 1.0f - lam_init;
                if (c == 0) { P.out = STASH + h * 128; P.opitch = 512; } else { P.out = XY + 512 + h * 128; P.opitch = XYP; }
                attn_unit128<MK_THRD>(mk_tid(wave0), b, qb, c == 0 ? 0 : 4, P, lds); }
        }
    }
}
__device__ __forceinline__ void moe_tables(volatile LAS unsigned* MISC, const unsigned* cls_cnt, int tid) {
    __syncthreads();
    if (tid < 24) MISC[MI_N + tid] = cls_cnt[tid];
    __syncthreads();
    if (tid == 0) { unsigned base = 0, u0 = 0;
        for (int c = 0; c < 24; ++c) { const unsigned n = MISC[MI_N + c]; MISC[MI_BASE + c] = base; MISC[MI_U0 + c] = u0; const unsigned nch = (n + 255u) >> 8; base += nch * 256u; u0 += nch * 4u; }
        MISC[MI_TOT] = u0; }
    __syncthreads();
}

#ifndef MK_FIXA
#define MK_FIXA 0
#endif
#ifndef MK_FIXB
#define MK_FIXB 0
#endif
#ifndef MK_REPEAT
#define MK_REPEAT 0
#endif
constexpr int NPH = 18;
struct Prog { int p[40]; int n; };
constexpr Prog make_prog() {
    Prog g{}; int n = 0;
    for (int ph = 0; ph < NPH; ++ph) {
        const int kind = (ph == 0 || ph == 9) ? 8 : (ph >= 10 ? ph - 10 : ph - 1);
        g.p[n++] = ph; if ((MK_REPEAT >> kind) & 1) g.p[n++] = ph; }
    g.n = n; return g;
}
__constant__ const Prog PROG = make_prog();
constexpr int NPOS = make_prog().n;
template <unsigned KMASK>
__device__ __forceinline__ void mk_body() {
    typedef const __attribute__((address_space(4))) Args* KArgs;
    const KArgs args0p = (KArgs)__builtin_amdgcn_kernarg_segment_ptr();
    extern __shared__ __attribute__((aligned(16))) unsigned char lds_raw[];
    { LAS unsigned char* lds0 = (LAS unsigned char*)lds_raw;
      for (int u = threadIdx.x; u < (LDS_BYTES - MISC_OFF) / 4; u += NWAVES * 64) ((LAS unsigned*)(lds0 + MISC_OFF))[u] = 0u; }
    __syncthreads();
    const int wave0 = __builtin_amdgcn_readfirstlane(threadIdx.x >> 6);
    XcdBarrier bar = xcd_barrier_post((unsigned*)((gu32*)(args0p->ws + WS_CTL) + CW_BAR) + args0p->li * XCD_BAR_WORDS, (volatile LAS unsigned*)((LAS unsigned char*)lds_raw + MISC_OFF) + MI_BAR, threadIdx.x);
    const int ph_lo = args0p->ph_lo, ph_hi = args0p->ph_hi;
#pragma clang loop unroll(disable)
    for (int pos = ph_lo; pos < ph_hi; ++pos) {
        const int ph = __builtin_amdgcn_readfirstlane(PROG.p[pos]); const int rep = pos; const int dry = (MK_REPEAT != 0 && pos + 1 < ph_hi && __builtin_amdgcn_readfirstlane(PROG.p[pos + 1]) == ph) ? 1 : 0;
        KArgs ap = args0p; asm volatile("" : "+s"(ap));
#define args (*ap)
        LAS unsigned char* lds = (LAS unsigned char*)lds_raw;
        volatile LAS unsigned* MISC = (volatile LAS unsigned*)(lds + MISC_OFF);
        int G = gridDim.x, bx = blockIdx.x; asm volatile("" : "+s"(G), "+s"(bx)); const int vcu = (G % 8 == 0) ? (bx % 8) * (G / 8) + bx / 8 : bx;
        unsigned char* ws = args.ws; gu32* ctl = (gu32*)(ws + WS_CTL);
        float* XOUT = args.out; const float* x0 = (const float*)args.in[0];
        bf16* XY = (bf16*)(ws + WS_XY); bf16* PROJ = (bf16*)(ws + WS_PROJ);
        float* SSA = (float*)(ws + WS_SS); float* SSB = (float*)(ws + WS_SSB);
        if (ph == 0) { if constexpr (KMASK & 0x100u) { const int tid = mk_tid(wave0); const LayerW w = layer_view(ap, 0); conv_layer(w, ws, 0, lds, vcu, G, tid); p0_x(x0, (const int*)args.in[2], ws, (unsigned char*)XOUT + OUT_XB8, vcu, G, tid);
            if (tid == 0) ((unsigned*)(ctl + CW_XCC))[vcu] = xb_xcc_id() + 1u;
            if (bx == 0) { float* GT = (float*)(ctl + CW_GT); const int ll = tid >> 8, r = tid & 255, wch = r >> 6, d = r & 63;
                const float* gsrc = (const float*)(wch == 0 ? args.in[7] : (wch == 1 ? args.in[8] : (wch == 2 ? args.in[11] : args.in[12]))); GT[tid] = gsrc[ll * 64 + d]; } } }
        else if (ph == 9) { }
        else {
            const int l = __builtin_amdgcn_readfirstlane(ph >= 10 ? 1 : 0), k = __builtin_amdgcn_readfirstlane(ph - (l ? 10 : 1));
            const LayerW w = layer_view(ap, l);
            const float* SSin = l == 0 ? SSA : SSB; const float* xcur = l == 0 ? x0 : XOUT;
            if (k == 0) { if constexpr (KMASK & 1u) { const int tid = mk_tid(wave0);
                SchedPlain S{(const char*)(XY + 1536), (const char*)(ws + WS_W + W_IN), (size_t)256 * XYP * 2, (size_t)256 * 2048, 64, 15, 16, G, bx, dry & MK_FIXA, dry & MK_FIXB};
                LAS float* RSL = (LAS float*)(lds + MISC_OFF) + 1024;
                if (tid < 4) { int pm_ = -1, pn_ = 0; if (!tile_order((long)tid * G + bx, 64, 15, pm_, pn_)) pm_ = -1; MISC[112 + tid] = (unsigned)pm_; }
                __syncthreads();
#pragma unroll 1
                for (int idx = tid; idx < 1024; idx += 512) { const int pm_ = (int)MISC[112 + (idx >> 8)]; if (pm_ >= 0) RSL[idx] = rstd_at(SSin, (unsigned)(pm_ * 256 + (idx & 255))); }
                __syncthreads();
                EpiG1 E{SSin, PROJ, (float*)(ws + WS_LOGF), (const float*)(ws + WS_COSSIN), (const float*)(ctl + CW_GT) + 256 * l, w.ffb, dry, RSL};
                pg8::gemm_phase<SchedPlain, EpiG1, false, true>(tid, lds, XYP * 2, 2048, S, E);
                split_arrive_x(bar, (unsigned*)(ctl + CW_SPLIT3) + 64 * l, (unsigned*)(ctl + CW_SPLIT3) + 64 * l + 32 * 0 + 128, mk_tid(wave0));
            } } else if (k == 1) { if constexpr (KMASK & 2u) {
                attn_phase(wave0, w, l, rep, ws, (char*)lds_raw, MISC, ctl, dry);
                split_arrive_x(bar, (unsigned*)(ctl + CW_SPLIT + (2 * l) * 64), (unsigned*)(ctl + CW_SPLITX + (2 * l) * 64), mk_tid(wave0));
            } } else if (k == 2) { if constexpr (KMASK & 4u) { const int tid = mk_tid(wave0);
                unsigned char* gsc = (unsigned char*)XOUT + OUT_GATES + (size_t)bx * 196608;
                LAS float* RSL2 = (LAS float*)(lds + MISC_OFF) + 1024;
                { int pm_, pn_; tile_order(bx, 64, 4, pm_, pn_); if (tid < 256) RSL2[tid] = rstd_at(SSin, (unsigned)(pm_ * 256 + tid)); __syncthreads(); }
                { SchedG2<0> S{(const char*)XOUT + OUT_XB8, (const char*)(ws + WS_W + W_G8), bx};
                  EpiG2<0> E{SSin, gsc, (bf16*)(ws + WS_MERGED), RSL2};
                  pg8::gemm_phase<SchedG2<0>, EpiG2<0>, false, true, true>(tid, lds, 1024, 1024, S, E); }
                { const int t2 = mk_tid(wave0); if (t2 == 0) split_wait_leader((unsigned*)(ctl + CW_SPLIT + (2 * l) * 64), (unsigned)G); __syncthreads(); }
                { SchedG2<1> S{(const char*)XY, (const char*)(ws + WS_W + W_BR), bx};
                  EpiG2<1> E{SSin, gsc, (bf16*)(ws + WS_MERGED), RSL2};
                  pg8::gemm_phase<SchedG2<1>, EpiG2<1>, false, true>(mk_tid(wave0), lds, XYP * 2, 1024, S, E); }
                { int pm_, pn_; tile_order(bx, 64, 4, pm_, pn_); group4_sync((unsigned*)(ctl + CW_G4 + ((2 * l) * 64 + pm_) * 32), mk_tid(wave0)); }
            } } else if (k == 3) { if constexpr (KMASK & 8u) { const int tid = mk_tid(wave0);
                SchedPlain S{(const char*)(ws + WS_MERGED), (const char*)(ws + WS_W + W_OUT), (size_t)256 * 2048, (size_t)256 * 2048, 64, 4, 16, G, bx, 0, 0};
                EpiRes<0, false> E{XY + 1536, XYP, nullptr, XY + 1536, XYP, SSA, nullptr, nullptr, dry, (MK_MU8 && l == NL - 1) ? (unsigned char*)XOUT + OUT_XB8 : nullptr};
                pg8::gemm_phase<SchedPlain, EpiRes<0, false>, false, true>(tid, lds, 2048, 2048, S, E);
                { int pm_, pn_; tile_order(bx, 64, 4, pm_, pn_); group4_sync((unsigned*)(ctl + CW_G4 + ((2 * l + 1) * 64 + pm_) * 32), mk_tid(wave0)); }
            } } else if (k == 4) { if constexpr (KMASK & 16u) { const int tid = mk_tid(wave0);
                {
                    typedef float f32x16r __attribute__((ext_vector_type(16))); typedef short bf16x8r __attribute__((ext_vector_type(8)));
                    const int lane_ = tid & 63, r32 = lane_ & 31, hh = lane_ >> 5, wv = __builtin_amdgcn_readfirstlane(tid >> 6); int pm_, pn_; tile_order(bx, 64, 4, pm_, pn_); const int t0 = pm_ * 256 + pn_ * 64;
                    unsigned* ccnt = (unsigned*)(ctl + CW_CLS + 32 * l + 64 * dry); int* LIST = (int*)(ws + WS_LIST);
                    const GAS char* wrh = (const GAS char*)(ws + WS_W + W_RH) + (unsigned)(r32 * 2048 + (128 * wv + 8 * hh) * 2);
                    const GAS char* xb_ = (const GAS char*)(XY + 1536) + (size_t)t0 * (XYP * 2) + (unsigned)(r32 * (XYP * 2) + (128 * wv + 8 * hh) * 2);
                    f32x16r acc0 = {}, acc1 = {};
#pragma unroll 2
                    for (int ks = 0; ks < 8; ++ks) {
                        const bf16x8r Bh = *(const GAS bf16x8r*)(wrh + ks * 32), Bl = *(const GAS bf16x8r*)(wrh + 65536 + ks * 32);
                        const bf16x8r A0 = *(const GAS bf16x8r*)(xb_ + ks * 32), A1 = *(const GAS bf16x8r*)(xb_ + 32 * (XYP * 2) + ks * 32);
                        acc0 = __builtin_amdgcn_mfma_f32_32x32x16_bf16(A0, Bh, acc0, 0, 0, 0); acc0 = __builtin_amdgcn_mfma_f32_32x32x16_bf16(A0, Bl, acc0, 0, 0, 0);
                        acc1 = __builtin_amdgcn_mfma_f32_32x32x16_bf16(A1, Bh, acc1, 0, 0, 0); acc1 = __builtin_amdgcn_mfma_f32_32x32x16_bf16(A1, Bl, acc1, 0, 0, 0);
                    }
                    LAS float* Pp = (LAS float*)lds;
                    LAS float* Lg = (LAS float*)(lds + 65536);
#pragma unroll
                    for (int r = 0; r < 16; ++r) { const int tk = (r & 3) + 8 * (r >> 2) + 4 * hh; Pp[(wv * 64 + tk) * 32 + r32] = acc0[r]; Pp[(wv * 64 + 32 + tk) * 32 + r32] = acc1[r]; }
                    __syncthreads();
                    { const int tk = tid >> 3, n4 = (tid & 7) * 4; f32x4 s = (f32x4){0.f, 0.f, 0.f, 0.f};
#pragma unroll
                      for (int w8 = 0; w8 < 8; ++w8) s += *(const LAS f32x4*)(Pp + (w8 * 64 + tk) * 32 + n4);
                      *(LAS f32x4*)(Lg + tk * 32 + n4) = s; }
                    __syncthreads();
                    if (tid < 64) { const int t = t0 + tid; float dg[4], de[16];
#pragma unroll
                        for (int e = 0; e < 4; ++e) dg[e] = Lg[tid * 32 + e];
#pragma unroll
                        for (int e = 0; e < 16; ++e) de[e] = Lg[tid * 32 + 4 + e];
                        const float rstd = rstd_at(SSA, (unsigned)t); float wa, wb; const int cls = route_decide(dg, de, rstd, w.brg, w.bre, wa, wb);
                        *(GAS f32x4*)((GAS char*)(ws + WS_TOKW) + (unsigned)t * 16u) = (f32x4){wa, wb, rstd, 0.f}; MISC[128 + tid] = (unsigned)cls; }
                    __syncthreads();
                    if (tid < 64) {
                        const unsigned mycls = MISC[128 + tid]; const unsigned long long ltm = (1ull << tid) - 1ull; unsigned cnt_c = 0, rank = 0;
#pragma unroll 4
                        for (unsigned c = 0; c < 24; ++c) { const unsigned long long m = __ballot(mycls == c); if ((unsigned)tid == c) cnt_c = (unsigned)__popcll(m); if (mycls == c) rank = (unsigned)__popcll(m & ltm); }
                        unsigned base = 0; if (tid < 24 && cnt_c) base = atomicAdd(ccnt + tid, cnt_c);
                        const unsigned mybase = (unsigned)__builtin_amdgcn_ds_bpermute((int)(mycls << 2), (int)base);
                        LIST[(size_t)mycls * T + mybase + rank] = t0 + tid; }
                    __syncthreads();
                }
                split_arrive_x(bar, (unsigned*)(ctl + CW_SPLIT + (2 * l + 1) * 64), (unsigned*)(ctl + CW_SPLITX + (2 * l + 1) * 64), mk_tid(wave0));
            } } else if (k == 5) { if constexpr (KMASK & 96u) { int tid = mk_tid(wave0);
                if (tid == 0) split_wait_leader((unsigned*)(ctl + CW_SPLIT + (2 * l + 1) * 64), (unsigned)G);
                __syncthreads();
                moe_tables(MISC, (const unsigned*)(ctl + CW_CLS + 32 * l), tid);
                const int NUm = (int)MISC[MI_TOT], KO = NUm > 256 ? (NUm - 256) >> 2 : 0;
                const int gid = vcu >> 2, m4 = vcu & 3, xg = gid >> 3, lg = gid & 7;
                const int k_o = lg * 8 + xg, k_p = (lg - 4) * 8 + xg;
                const bool is_o = lg < 4 && k_o < KO, is_p = lg >= 4 && k_p < KO;
                unsigned* cA = (unsigned*)(ctl + CW_MOE2 + 3584 * l); unsigned* cB = cA + 2048; unsigned* cO = cA + 3072;
#pragma clang loop unroll(disable)
                for (int r = 0; r < 2; ++r) {
                    const int u = r == 0 ? vcu : 256 + 4 * k_o + m4; if (r == 1 && !is_o) break;
                    tid = mk_tid(wave0);
                    { SchedMoE S{MISC, (const int*)(ws + WS_LIST), (const char*)(XY + 1536), (const char*)(ws + WS_W + W_GU), G, u, 0, 0};
                      EpiMU E{(bf16*)(ws + OV_ACT), (const float*)(ws + WS_TOKW), 1.0f};
                      pg8::gemm_phase<SchedMoE, EpiMU, true, true>(tid, lds, XYP * 2, 2048, S, E); }
                    if (r == 0 && is_o) {
                        asm volatile("s_waitcnt vmcnt(0)" ::: "memory"); __syncthreads();
                        tid = mk_tid(wave0);
                        if (tid == 0) { const unsigned me = xb_xcc_id() + 1u; bool same = true;
#pragma unroll
                            for (int i = 0; i < 4; ++i) same = same && (xb_ld((unsigned*)(ctl + CW_XCC) + (gid + 4) * 4 + i) == me);
                            if (!same) { __builtin_amdgcn_fence(__ATOMIC_RELEASE, "agent"); asm volatile("s_waitcnt vmcnt(0)" ::: "memory"); }
                            xb_add(cO + 16 * k_o, 1u); asm volatile("s_waitcnt vmcnt(0)" ::: "memory"); }
                        __syncthreads();
                    }
                }
                group4_sync(is_o ? cB + 32 * k_o : cA + 32 * gid, mk_tid(wave0));
#pragma clang loop unroll(disable)
                for (int r = 0; r < 2; ++r) {
                    const int u = r == 0 ? (is_o ? 256 + 4 * k_o + m4 : vcu) : 4 * (gid - 4) + m4; if (r == 1 && !is_p) break;
                    tid = mk_tid(wave0);
                    if (r == 1) {
                        if (tid == 0) { unsigned sp = 0; while (xb_ld(cO + 16 * k_p) < 4u) { __builtin_amdgcn_s_sleep(2); if (++sp > (1u << 22)) break; }
                            __builtin_amdgcn_fence(__ATOMIC_ACQUIRE, "agent"); asm volatile("s_waitcnt vmcnt(0)" ::: "memory"); }
                        __syncthreads();
                    }
                    SchedMoE S{MISC, (const int*)(ws + WS_LIST), (const char*)(ws + OV_ACT), (const char*)(ws + WS_W + W_D), G, u, 2, 0};
                    EpiRes<0, true> E{XY + 1536, XYP, nullptr, (bf16*)(ws + OV_XB2), 1024, SSA, nullptr, nullptr, dry, MK_PLE8 ? ws + WS_MERGED : nullptr};
                    pg8::gemm_phase<SchedMoE, EpiRes<0, true>, false, true>(tid, lds, 1024, 512, S, E);
                }
                { unsigned* fqh = pg8::rflp((unsigned*)(ctl + CW_FQ) + 64 * l); const int NF = 256 + (l + 1 < NL ? CV_EARLY_BATCHES : 0);
                  int arrived = 0;
                  for (;;) {
                    const int tq = mk_tid(wave0);
                    if (tq == 0) MISC[MI_Q] = atomicAdd(fqh, 1u);
                    __syncthreads();
                    const int idx = (int)MISC[MI_Q];
                    __syncthreads();
                    if (idx >= 256 && !arrived) { split_arrive_x(bar, (unsigned*)(ctl + CW_SPLIT3) + 256 + 64 * l, (unsigned*)(ctl + CW_SPLIT3) + 512 + 64 * l, mk_tid(wave0)); arrived = 1; }
                    if (idx >= NF) break;
                    if (idx < 256) {
                        SchedPlain S2{(const char*)(ws + OV_PB), (const char*)(ws + WS_WPLE + l * WPLE_STRIDE + W_P), (size_t)256 * 512, (size_t)256 * 512, 64, 4, 4, 1 << 20, idx, 0, 0};
                        EpiPW E2{(bf16*)(ws + OV_PW)};
                        pg8::gemm_phase<SchedPlain, EpiPW, false, true>(tq, lds, 512, 512, S2, E2);
                    } else { const LayerW w1 = layer_view(ap, 1); conv_early_batch(w1, ws, 1, lds, idx - 256, tq); }
                  } }
            } } else if (k == 6) { if constexpr (KMASK & 96u) {
            } } else { if constexpr (KMASK & 128u) { const int tid = mk_tid(wave0);
                if (tid == 0) split_wait_leader((unsigned*)(ctl + CW_SPLIT3) + 256 + 64 * l, (unsigned)G);
                __syncthreads();
                constexpr int P8 = MK_PLE8 ? 1 : 0;
                SchedPlain S{(const char*)(ws + (P8 ? WS_MERGED : OV_XB2)), (const char*)(ws + WS_WPLE + l * WPLE_STRIDE + W_PG), (size_t)256 * (P8 ? 1024 : 2048), (size_t)256 * (P8 ? 1024 : 2048), 64, 4, P8 ? 8 : 16, G, bx, 0, 0};
                EpiRes<1, false> E{(const bf16*)(ws + OV_XB2), 1024, l == NL - 1 ? XOUT : nullptr, l == NL - 1 ? nullptr : XY + 1536, XYP, SSB, SSA, (const bf16*)(ws + OV_PW), dry, l == NL - 1 ? nullptr : (unsigned char*)XOUT + OUT_XB8};
                pg8::gemm_phase<SchedPlain, EpiRes<1, false>, false, true, P8 != 0>(tid, lds, P8 ? 1024 : 2048, P8 ? 1024 : 2048, S, E);
            } }
        }
        const int kk_ = (ph == 0 || ph == 9) ? -1 : (ph >= 10 ? ph - 10 : ph - 1);
        if (pos + 1 < ph_hi && ph != 9 && (MK_REPEAT != 0 || kk_ > 6 || kk_ < 0)) { xcd_barrier(bar, mk_tid(wave0));
#ifdef MK_DOUBLE_BAR
            xcd_barrier(bar, mk_tid(wave0)); xcd_barrier(bar, mk_tid(wave0));
#endif
        }
#undef args
    }
}

#ifndef MK_KMASKS
#ifdef MK_SPLIT_TEST
#define MK_KMASKS 0x100u
#else
#define MK_KMASKS 0x1FFu
#endif
#endif
__global__ void __launch_bounds__(NWAVES * 64, 2) mk_fwd(Args args) { mk_body<MK_KMASKS>(); }
#ifdef MK_SPLIT_TEST
__global__ void __launch_bounds__(NWAVES * 64, 2) mk_t0(Args args) { mk_body<1u>(); }
__global__ void __launch_bounds__(NWAVES * 64, 2) mk_t1(Args args) { mk_body<2u>(); }
__global__ void __launch_bounds__(NWAVES * 64, 2) mk_t2(Args args) { mk_body<4u>(); }
__global__ void __launch_bounds__(NWAVES * 64, 2) mk_t3(Args args) { mk_body<8u>(); }
__global__ void __launch_bounds__(NWAVES * 64, 2) mk_t4(Args args) { mk_body<16u>(); }
__global__ void __launch_bounds__(NWAVES * 64, 2) mk_t5(Args args) { mk_body<32u>(); }
__global__ void __launch_bounds__(NWAVES * 64, 2) mk_t6(Args args) { mk_body<64u>(); }
__global__ void __launch_bounds__(NWAVES * 64, 2) mk_t7(Args args) { mk_body<128u>(); }
__global__ void __launch_bounds__(NWAVES * 64, 2) mk_t8(Args args) { mk_body<256u>(); }
#endif
#ifndef MK_ONE_LAUNCH
#define MK_ONE_LAUNCH 0
#endif
#ifndef MK_OPT_MASK
#define MK_OPT_MASK 0x3FFFF
#endif
static void ref_phase(int l, int k, void* const* d_in, float* XOUT, unsigned char* ws, hipStream_t st) {
    using namespace refp;
    const float* x0 = (const float*)d_in[0]; const float* p = (const float*)d_in[1]; const int* pos = (const int*)d_in[2];
    const float* g_attn = (const float*)d_in[3] + l * 1024; const float* w_in_l = (const float*)d_in[4] + (size_t)l * 1024 * INW;
    const float* pool_w = (const float*)d_in[5] + (size_t)l * 4 * 128 * 128; const float* pool_scale = (const float*)d_in[6] + l * 512;
    const float* dqn = (const float*)d_in[7] + l * 64; const float* dkn = (const float*)d_in[8] + l * 64; const float* dlam = (const float*)d_in[9] + l * 256;
    const float* dsub = (const float*)d_in[10] + l * 128; const float* fqn = (const float*)d_in[11] + l * 64; const float* fkn = (const float*)d_in[12] + l * 64;
    const float* ffb = (const float*)d_in[13] + l * 8; const float* w_branch_l = (const float*)d_in[14] + (size_t)l * 3 * 512 * 1024; const float* w_out_l = (const float*)d_in[15] + (size_t)l * 1024 * 1024;
    const float* g_ffn = (const float*)d_in[16] + l * 1024; const float* wrg = (const float*)d_in[17] + (size_t)l * 1024 * 4; const float* brg = (const float*)d_in[18] + l * 4;
    const float* wre = (const float*)d_in[19] + (size_t)l * 1024 * 16; const float* bre = (const float*)d_in[20] + l * 16;
    const float* wg_l = (const float*)d_in[21] + (size_t)l * 16 * 1024 * 256; const float* wu_l = (const float*)d_in[22] + (size_t)l * 16 * 1024 * 256; const float* wd_l = (const float*)d_in[23] + (size_t)l * 16 * 256 * 1024;
    const float* g_ple = (const float*)d_in[24] + l * 1024; const float* wpg_l = (const float*)d_in[25] + (size_t)l * 1024 * 1024; const float* wple_l = (const float*)d_in[26] + (size_t)l * 256 * 1024;
    const float* p_l = p + (size_t)l * T * 256;
    float* SSA = (float*)(ws + WS_SS); float* SSB = (float*)(ws + WS_SSB); float* RS = (float*)(ws + WS_RSTD); float* LOGF = (float*)(ws + WS_LOGF); float* FCUM = (float*)(ws + WS_FCUM); float* TOKW = (float*)(ws + WS_TOKW); int* LIST = (int*)(ws + WS_LIST);
    bf16* XY = (bf16*)(ws + WS_XY); bf16* PROJ = (bf16*)(ws + WS_PROJ); float* CH = (float*)(ws + WS_STASH); bf16* MERGED = (bf16*)(ws + WS_MERGED); float* TMP = (float*)(ws + WS_PROJ);
    unsigned* cls_cnt = (unsigned*)(ws + WS_CTL) + CW_CLS + 32 * l;
    const float* xcur = l == 0 ? x0 : XOUT; float* SSin = l == 0 ? SSA : SSB;
    const float lam_init = 0.8f - 0.6f * expf(-0.3f * (float)l);
    if (k == -1) { k_rowstats<<<T / 4, 256, 0, st>>>(x0, XY + 1536, XYP, SSA, RS, nullptr); return; }
    if (k == 0) {
        k_ref_rstd<<<T / 256, 256, 0, st>>>(SSin, RS);
        for (int cc = 0; cc < 14; ++cc) {
            k_ref_gemm<<<dim3(4, T / 64), 256, 0, st>>>(XnormLoader{xcur, RS, g_attn}, w_in_l + 256 * cc, INW, 256, 1024, EpiStoreF32{CH, 256, 0});
            int kind = 2; const float* gain = nullptr; int rot = 0; float osc = 1.f;
            if (cc < 2) kind = 0;
            else if (cc < 4) { kind = 1; gain = dqn; rot = 1; osc = C2; }
            else if (cc < 6) { kind = 1; gain = dkn; rot = 1; }
            else if (cc >= 8 && cc < 10) { kind = 1; gain = fqn; osc = C2; }
            else if (cc >= 10 && cc < 12) { kind = 1; gain = fkn; }
            k_ref_epi1<<<T, 256, 0, st>>>(CH, cc, kind, pool_w, pool_scale, gain, rot, osc, pos, PROJ);
        }
        k_ref_gemm<<<dim3(1, T / 64), 256, 0, st>>>(XnormLoader{xcur, RS, g_attn}, w_in_l + 3584, INW, 8, 1024, EpiStoreF32{CH, 8, 0});
        k_ref_logf<<<T * 8 / 256, 256, 0, st>>>(CH, ffb, LOGF);
    } else if (k == 1) {
        k_ref_fscan<<<1, 64, 0, st>>>(LOGF, FCUM);
        k_ref_fox<<<T * 8 / 4, 256, 0, st>>>(PROJ, FCUM, XY);
        k_ref_diff<<<T * 4 / 2, 128, 0, st>>>(PROJ, dlam, dsub, lam_init, XY);
        k_ref_pool<<<T * 512 / 256, 256, 0, st>>>(PROJ, XY);
    } else if (k == 2) {
        k_ref_rstd<<<T / 256, 256, 0, st>>>(SSin, RS);
        k_ref_gemm2<<<dim3(16, T / 64), 256, 0, st>>>(xcur, RS, g_attn, w_in_l, w_branch_l, XY, MERGED);
    } else if (k == 3) {
        k_ref_gemm<<<dim3(16, T / 64), 256, 0, st>>>(Bf16Loader{MERGED, 1024, 0}, w_out_l, 1024, 1024, 1024, EpiResid{xcur, XOUT});
        k_rowstats<<<T / 4, 256, 0, st>>>(XOUT, XY + 1536, XYP, SSA, RS, nullptr);
    } else if (k == 4) {
        k_route<<<T / 4, 256, 0, st>>>(XOUT, g_ffn, wrg, brg, wre, bre, cls_cnt, LIST, TOKW);
    } else if (k == 5) {
        k_ref_rstd<<<T / 256, 256, 0, st>>>(SSA, RS);
        k_ref_moe<<<dim3(T / 8, 24), 256, 0, st>>>(XOUT, RS, g_ffn, (const int*)cls_cnt, LIST, TOKW, wg_l, wu_l, wd_l);
        k_rowstats<<<T / 4, 256, 0, st>>>(XOUT, (bf16*)(ws + OV_XB2), 1024, SSA, RS, nullptr);
    } else if (k == 7) {
        k_ref_rstd<<<T / 256, 256, 0, st>>>(SSA, RS);
        k_ref_ple<<<dim3(16, T / 64), 256, 0, st>>>(XOUT, RS, g_ple, wpg_l, p_l, wple_l, TMP);
        k_rowstats<<<T / 4, 256, 0, st>>>(TMP, XY + 1536, XYP, SSB, RS, XOUT);
    }
}

extern "C" void kernel_launch(void* const* d_in, const int* in_sizes, int n_in, void* d_out, int out_size, void* d_ws, size_t ws_size, hipStream_t stream) {
    static int grid = 0;
    if (grid == 0) {
        if (n_in != 27 || out_size != T * DM || ws_size < WS_END) { fprintf(stderr, "kernel_launch: unexpected shapes (n_in %d out %d ws %zu)\n", n_in, out_size, ws_size); grid = -1; return; }
        int dev = 0, cus = 0;
        if (hipGetDevice(&dev) != hipSuccess || hipDeviceGetAttribute(&cus, hipDeviceAttributeMultiprocessorCount, dev) != hipSuccess) { grid = -1; return; }
        if (hipFuncSetAttribute((const void*)mk_fwd, hipFuncAttributeMaxDynamicSharedMemorySize, LDS_BYTES) != hipSuccess) { fprintf(stderr, "kernel_launch: hipFuncSetAttribute failed\n"); grid = -1; return; }
#if !MK_ONE_LAUNCH
        { const void* ks[9] = {(const void*)mk_t0, (const void*)mk_t1, (const void*)mk_t2, (const void*)mk_t3, (const void*)mk_t4, (const void*)mk_t5, (const void*)mk_t6, (const void*)mk_t7, (const void*)mk_t8};
          for (int i = 0; i < 9; ++i) (void)hipFuncSetAttribute(ks[i], hipFuncAttributeMaxDynamicSharedMemorySize, LDS_BYTES); }
#endif
        int per_cu = 0;
        if (hipOccupancyMaxActiveBlocksPerMultiprocessor(&per_cu, mk_fwd, NWAVES * 64, LDS_BYTES) != hipSuccess || per_cu < 1) { fprintf(stderr, "kernel_launch: occupancy query failed (%d)\n", per_cu); grid = -1; return; }
        (void)hipGetLastError();
        grid = cus;
    }
    if (grid < 0) return;
    (void)hipMemsetAsync((char*)d_ws + WS_CTL, 0, MK_ONE_LAUNCH ? (size_t)192 * 1024 : CTL_BYTES, stream);
    Args a{};
    for (int i = 0; i < 27; ++i) a.in[i] = d_in[i];
    a.out = (float*)d_out; a.ws = (unsigned char*)d_ws;
#if MK_ONE_LAUNCH
    a.ph_lo = 0; a.ph_hi = NPOS; a.li = 0;
    hipLaunchKernelGGL(mk_fwd, dim3(grid), dim3(NWAVES * 64), LDS_BYTES, stream, a);
#else
    const unsigned mask = MK_OPT_MASK; int li = 0;
    typedef void (*kern_t)(Args);
    const kern_t ks[9] = {mk_t0, mk_t1, mk_t2, mk_t3, mk_t4, mk_t5, mk_t6, mk_t7, mk_t8};
#define LAUNCH_PH(kk) hipLaunchKernelGGL(ks[kk], dim3(grid), dim3(NWAVES * 64), LDS_BYTES, stream, a)
    for (int ph = 0; ph < NPH; ++ph) {
        const bool opt = (mask >> ph) & 1u;
        const int l = ph >= 10 ? 1 : 0, k = ph == 0 ? -1 : (ph == 9 ? -2 : ph - (l ? 10 : 1));
        if (ph == 0) {
            a.ph_lo = 0; a.ph_hi = 1; a.li = li++; LAUNCH_PH(8);
            if (!opt) ref_phase(0, -1, d_in, (float*)d_out, (unsigned char*)d_ws, stream);
            continue; }
        if (ph == 9) { a.ph_lo = 9; a.ph_hi = 10; a.li = li++; LAUNCH_PH(8); continue; }
        if (opt) { a.ph_lo = ph; a.ph_hi = ph + 1; a.li = li++; LAUNCH_PH(k); }
        else if (k != 6) ref_phase(l, k, d_in, (float*)d_out, (unsigned char*)d_ws, stream);
    }
#endif
}
```

```cpp
#include <hip/hip_runtime.h>
#include <cstdio>
#include <cstdint>
#include <cmath>
typedef unsigned short bf16;
constexpr int T = 16384, DM = 1024, S = 2048, NB = 8, NL = 2, INW = 6664;
constexpr float RMS_EPS = 1e-6f;
constexpr float C2 = 0.125f * 1.4426950408889634f;
constexpr size_t MiB = 1u << 20;
constexpr size_t WS_CTL = 0, CTL_BYTES = 1 * MiB;
constexpr size_t WS_SS = 1 * MiB;
constexpr size_t WS_LOGF = 2 * MiB;
constexpr size_t WS_FCUM = 2 * MiB + 512 * 1024;
constexpr size_t WS_TOKW = 3 * MiB;
constexpr size_t WS_RSTD = 3 * MiB + 256 * 1024;
constexpr size_t WS_LIST = 3 * MiB + 512 * 1024;
constexpr size_t WS_COSSIN = 5 * MiB;
constexpr size_t WS_SSB = 49 * MiB;
constexpr size_t WS_W = 6 * MiB;
constexpr size_t WS_WPLE = 52 * MiB;
constexpr size_t WS_XY = 57 * MiB;
constexpr size_t WS_PROJ = 137 * MiB;
constexpr size_t WS_STASH = 249 * MiB;
constexpr size_t WS_MERGED = WS_PROJ + 96 * MiB;
constexpr size_t WS_PB = 265 * MiB;
constexpr size_t WS_END = 273 * MiB;
constexpr int XYP = 2560, PJP = 3584;
constexpr int CW_CLS = 64;
constexpr int CW_AQ = 256;
constexpr int CW_G4 = 16384;
constexpr int CW_SPLIT3 = 24576;
constexpr int CW_MOE2 = 32768;
constexpr int CW_XCC = 40960;
constexpr int CW_GT = 131072;
constexpr int CW_MOEG = 512;
constexpr int CW_SPLIT = 5632;
constexpr int CW_SPLITX = 5888;
constexpr int CW_FQ = 6144;
constexpr int CW_BAR = 8192;
#define MK_ONE_LAUNCH 1
namespace refp {

__device__ __forceinline__ float bf2f(bf16 v) { return __uint_as_float((unsigned)v << 16); }
__device__ __forceinline__ bf16 f2b(float f) { unsigned u = __float_as_uint(f); return (bf16)((u + 0x7fffu + ((u >> 16) & 1u)) >> 16); }
__device__ __forceinline__ float wsum(float v) {
#pragma unroll
    for (int o = 1; o < 64; o <<= 1) v += __shfl_xor(v, o);
    return v;
}
__device__ __forceinline__ float wmax(float v) {
#pragma unroll
    for (int o = 1; o < 64; o <<= 1) v = fmaxf(v, __shfl_xor(v, o));
    return v;
}
__device__ __forceinline__ float row_rstd(const float* SS, int t) {
    float s = 0.f;
#pragma unroll
    for (int i = 0; i < 16; ++i) s += SS[(size_t)t * 16 + i];
    return rsqrtf(s * (1.0f / 1024.0f) + RMS_EPS);
}

__global__ void __launch_bounds__(256) k_rowstats(const float* __restrict__ xsrc, bf16* XBdst, int ldxb, float* SS, float* RSTD, float* xcopy) {
    const int t = blockIdx.x * 4 + (threadIdx.x >> 6), lane = threadIdx.x & 63;
    const float* xr = xsrc + (size_t)t * 1024;
    float s = 0.f;
    for (int j = 0; j < 16; ++j) { const int k = lane + 64 * j; const float v = xr[k]; s += v * v; XBdst[(size_t)t * ldxb + k] = f2b(v); if (xcopy) xcopy[(size_t)t * 1024 + k] = v; }
    s = wsum(s);
    if (lane < 16) SS[(size_t)t * 16 + lane] = (lane == 0) ? s : 0.f;
    if (lane == 0) RSTD[t] = rsqrtf(s * (1.0f / 1024.0f) + RMS_EPS);
}
__global__ void k_ref_rstd(const float* __restrict__ SS, float* RSTD) { const int t = blockIdx.x * blockDim.x + threadIdx.x; if (t < T) RSTD[t] = row_rstd(SS, t); }

struct XnormLoader { const float* x; const float* RS; const float* g;
    __device__ __forceinline__ float operator()(int t, int k) const { return x[(size_t)t * 1024 + k] * RS[t] * g[k]; } };
struct Bf16Loader { const bf16* A; int lda; int pad;
    __device__ __forceinline__ float operator()(int t, int k) const { return bf2f(A[(size_t)t * lda + k]); } };
struct F32Loader { const float* A; int lda; int pad;
    __device__ __forceinline__ float operator()(int t, int k) const { return A[(size_t)t * lda + k]; } };

template <class AL, class EPI>
__global__ void __launch_bounds__(256) k_ref_gemm(AL al, const float* __restrict__ W, int ldw, int N, int K, EPI epi) {
    __shared__ float sA[16][65], sB[16][65];
    const int tx = threadIdx.x & 15, ty = threadIdx.x >> 4, t0 = blockIdx.y * 64, n0 = blockIdx.x * 64;
    float acc[4][4] = {};
    for (int k0 = 0; k0 < K; k0 += 16) {
        for (int e = threadIdx.x; e < 1024; e += 256) { const int r = e >> 4, kk = e & 15; sA[kk][r] = al(t0 + r, k0 + kk); }
        for (int e = threadIdx.x; e < 1024; e += 256) { const int kk = e >> 6, c = e & 63; sB[kk][c] = (n0 + c < N) ? W[(size_t)(k0 + kk) * ldw + n0 + c] : 0.f; }
        __syncthreads();
#pragma unroll
        for (int kk = 0; kk < 16; ++kk) {
            float a[4], b[4];
#pragma unroll
            for (int i = 0; i < 4; ++i) { a[i] = sA[kk][ty * 4 + i]; b[i] = sB[kk][tx * 4 + i]; }
#pragma unroll
            for (int i = 0; i < 4; ++i)
#pragma unroll
                for (int j = 0; j < 4; ++j) acc[i][j] += a[i] * b[j];
        }
        __syncthreads();
    }
#pragma unroll
    for (int i = 0; i < 4; ++i)
#pragma unroll
        for (int j = 0; j < 4; ++j) { const int n = n0 + tx * 4 + j; if (n < N) epi(t0 + ty * 4 + i, n, acc[i][j]); }
}
struct EpiStoreF32 { float* C; int ldc; int pad; __device__ __forceinline__ void operator()(int t, int n, float v) const { C[(size_t)t * ldc + n] = v; } };
struct EpiResid { const float* xs; float* xo; __device__ __forceinline__ void operator()(int t, int n, float v) const { xo[(size_t)t * 1024 + n] = xs[(size_t)t * 1024 + n] + v; } };

__global__ void __launch_bounds__(256) k_ref_epi1(const float* __restrict__ C, int cc, int kind, const float* pool_w, const float* pool_scale,
                                                  const float* gain, int rotary, float outscale, const int* positions, bf16* PROJ) {
    __shared__ float row[256];
    const int t = blockIdx.x, j = threadIdx.x;
    row[j] = C[(size_t)t * 256 + j];
    __syncthreads();
    float out;
    if (kind == 0) {
        const int g = 2 * cc + (j >> 7), d = j & 127; float s = 0.f;
        for (int c = 0; c < 128; ++c) s += row[(j & 128) + c] * pool_w[((size_t)g * 128 + c) * 128 + d];
        out = s * pool_scale[g * 128 + d];
    } else if (kind == 1) {
        const int dim = j & 63; float v = row[j];
        const float ss = wsum(v * v);
        v = v * rsqrtf(ss * (1.0f / 64.0f) + RMS_EPS) * gain[dim];
        if (rotary) {
            const float other = __shfl_xor(v, 8);
            if (dim < 16) {
                const int i = dim & 7; const float invf = powf(500000.0f, -(float)(2 * i) / 16.0f);
                const float ang = (float)positions[t] * invf; const float c = cosf(ang), s = sinf(ang);
                v = (dim < 8) ? (v * c - other * s) : (v * c + other * s);
            }
        }
        out = v * outscale;
    } else out = row[j];
    PROJ[(size_t)t * 3584 + 256 * cc + j] = f2b(out);
}
__global__ void k_ref_logf(const float* __restrict__ C8, const float* fb, float* LOGF) {
    const int i = blockIdx.x * blockDim.x + threadIdx.x; if (i >= T * 8) return;
    const float v = C8[i] + fb[i & 7];
    LOGF[i] = fminf(v, 0.f) - log1pf(expf(-fabsf(v)));
}
__global__ void k_ref_fscan(const float* __restrict__ LOGF, float* FCUM) {
    const int i = threadIdx.x; if (i >= 64) return; const int b = i >> 3, h = i & 7; float s = 0.f;
    for (int t = 0; t < S; ++t) { s += LOGF[((size_t)b * S + t) * 8 + h]; FCUM[((size_t)b * S + t) * 8 + h] = s; }
}
__global__ void __launch_bounds__(256) k_ref_fox(const bf16* __restrict__ PROJ, const float* __restrict__ FCUM, bf16* XY) {
    __shared__ float P[4][S];
    const int w = threadIdx.x >> 6, lane = threadIdx.x & 63; const int gw = blockIdx.x * 4 + w; const int t = gw >> 3, h = gw & 7; const int b = t / S, sq = t % S;
    float q[64];
#pragma unroll
    for (int d = 0; d < 64; ++d) q[d] = bf2f(PROJ[(size_t)t * 3584 + 2048 + h * 64 + d]);
    const float Ft = FCUM[(size_t)t * 8 + h];
    float m = -INFINITY;
    for (int j = lane; j <= sq; j += 64) { const bf16* kr = PROJ + ((size_t)b * S + j) * 3584 + 2560 + h * 64; float s = 0.f;
#pragma unroll
        for (int d = 0; d < 64; ++d) s += q[d] * bf2f(kr[d]);
        s += (Ft - FCUM[((size_t)b * S + j) * 8 + h]) * 1.4426950408889634f; P[w][j] = s; m = fmaxf(m, s); }
    m = wmax(m); float l = 0.f;
    for (int j = lane; j <= sq; j += 64) { const float p = exp2f(P[w][j] - m); P[w][j] = p; l += p; }
    l = wsum(l);
    __syncthreads();
    float o = 0.f;
    for (int j = 0; j <= sq; ++j) o += P[w][j] * bf2f(PROJ[((size_t)b * S + j) * 3584 + 3072 + h * 64 + lane]);
    XY[(size_t)t * 2560 + 1024 + h * 64 + lane] = f2b(o / l);
}
__global__ void __launch_bounds__(128) k_ref_diff(const bf16* __restrict__ PROJ, const float* __restrict__ lamp, const float* __restrict__ gsub, float lam_init, bf16* XY) {
    __shared__ float P[2][2][S];
    const int w = threadIdx.x >> 6, lane = threadIdx.x & 63; const int gw = blockIdx.x * 2 + w; const int t = gw >> 2, h = gw & 3; const int b = t / S, sq = t % S;
    float lam; { const float a = wsum(lamp[lane] * lamp[64 + lane]), c = wsum(lamp[128 + lane] * lamp[192 + lane]); lam = expf(a) - expf(c) + lam_init; }
    float linv[2];
    for (int c = 0; c < 2; ++c) {
        float q[64];
#pragma unroll
        for (int d = 0; d < 64; ++d) q[d] = bf2f(PROJ[(size_t)t * 3584 + 512 + (h * 2 + c) * 64 + d]);
        float m = -INFINITY;
        for (int j = lane; j <= sq; j += 64) { const bf16* kr = PROJ + ((size_t)b * S + j) * 3584 + 1024 + (h * 2 + c) * 64; float s = 0.f;
    #pragma unroll
        for (int d = 0; d < 64; ++d) s += q[d] * bf2f(kr[d]);
            P[w][c][j] = s; m = fmaxf(m, s); }
        m = wmax(m); float l = 0.f;
        for (int j = lane; j <= sq; j += 64) { const float p = exp2f(P[w][c][j] - m); P[w][c][j] = p; l += p; }
        linv[c] = 1.0f / wsum(l);
    }
    __syncthreads();
    float o0 = 0.f, o1 = 0.f;
    for (int j = 0; j <= sq; ++j) { const float a = P[w][0][j] * linv[0] - lam * P[w][1][j] * linv[1]; const bf16* vr = PROJ + ((size_t)b * S + j) * 3584 + 1536 + h * 128;
        o0 += a * bf2f(vr[lane]); o1 += a * bf2f(vr[64 + lane]); }
    const float ss = wsum(o0 * o0 + o1 * o1); const float r = rsqrtf(ss * (1.0f / 128.0f) + RMS_EPS) * (1.0f - lam_init);
    XY[(size_t)t * 2560 + 512 + h * 128 + lane] = f2b(o0 * r * gsub[lane]);
    XY[(size_t)t * 2560 + 512 + h * 128 + 64 + lane] = f2b(o1 * r * gsub[64 + lane]);
}
__global__ void k_ref_pool(const bf16* __restrict__ PROJ, bf16* XY) {
    const int i = blockIdx.x * blockDim.x + threadIdx.x; if (i >= T * 512) return; const int t = i >> 9, j = i & 511; const int g = j >> 7, w = 2 << g, s = t % S;
    const int cnt = min(s + 1, w); float a = 0.f;
    for (int k = 0; k < cnt; ++k) a += bf2f(PROJ[(size_t)(t - k) * 3584 + j]);
    XY[(size_t)t * 2560 + j] = f2b(a / (float)cnt - bf2f(PROJ[(size_t)t * 3584 + j]));
}
__global__ void __launch_bounds__(256) k_ref_gemm2(const float* __restrict__ x, const float* __restrict__ SS, const float* __restrict__ g, const float* __restrict__ w_in_l,
                                                   const float* __restrict__ w_branch_l, const bf16* __restrict__ XY, bf16* MERGED) {
    __shared__ float sA[16][65], sB[16][65];
    const int tx = threadIdx.x & 15, ty = threadIdx.x >> 4, t0 = blockIdx.y * 64, n0 = blockIdx.x * 64;
    float mg[4][4] = {};
    for (int n = 0; n < 3; ++n) {
        float ag[4][4] = {}, ab[4][4] = {};
        for (int pass = 0; pass < 2; ++pass) {
            const int K = pass == 0 ? 1024 : 512;
            for (int k0 = 0; k0 < K; k0 += 16) {
                for (int e = threadIdx.x; e < 1024; e += 256) { const int r = e >> 4, kk = e & 15; const int t = t0 + r, k = k0 + kk;
                    sA[kk][r] = pass == 0 ? x[(size_t)t * 1024 + k] * SS[t] * g[k] : bf2f(XY[(size_t)t * 2560 + 512 * n + k]); }
                for (int e = threadIdx.x; e < 1024; e += 256) { const int kk = e >> 6, c = e & 63; const int k = k0 + kk;
                    sB[kk][c] = pass == 0 ? w_in_l[(size_t)k * INW + 3592 + n * 1024 + n0 + c] : w_branch_l[((size_t)n * 512 + k) * 1024 + n0 + c]; }
                __syncthreads();
#pragma unroll
                for (int kk = 0; kk < 16; ++kk) {
                    float a[4], b[4];
#pragma unroll
                    for (int i = 0; i < 4; ++i) { a[i] = sA[kk][ty * 4 + i]; b[i] = sB[kk][tx * 4 + i]; }
#pragma unroll
                    for (int i = 0; i < 4; ++i)
#pragma unroll
                        for (int j = 0; j < 4; ++j) { if (pass == 0) ag[i][j] += a[i] * b[j]; else ab[i][j] += a[i] * b[j]; }
                }
                __syncthreads();
            }
        }
#pragma unroll
        for (int i = 0; i < 4; ++i)
#pragma unroll
            for (int j = 0; j < 4; ++j) mg[i][j] += ab[i][j] / (1.0f + expf(-ag[i][j]));
    }
#pragma unroll
    for (int i = 0; i < 4; ++i)
#pragma unroll
        for (int j = 0; j < 4; ++j) MERGED[(size_t)(t0 + ty * 4 + i) * 1024 + n0 + tx * 4 + j] = f2b(mg[i][j]);
}
__global__ void __launch_bounds__(256) k_ref_moe(float* X, const float* __restrict__ SS, const float* __restrict__ g, const int* __restrict__ cls_cnt, const int* __restrict__ LIST,
                                                 const float* __restrict__ TOKW, const float* __restrict__ wg_l, const float* __restrict__ wu_l, const float* __restrict__ wd_l) {
    __shared__ float h[8][1024]; __shared__ float act[8][512]; __shared__ int tok[8];
    const int cls = blockIdx.y, n_c = cls_cnt[cls], base = blockIdx.x * 8; if (base >= n_c) return;
    const int nt = min(8, n_c - base), tid = threadIdx.x;
    if (tid < 8) tok[tid] = tid < nt ? LIST[(size_t)cls * T + base + tid] : -1;
    __syncthreads();
    for (int e = tid; e < 8 * 1024; e += 256) { const int i = e >> 10, k = e & 1023; const int t = tok[i]; h[i][k] = t >= 0 ? X[(size_t)t * 1024 + k] * SS[t] * g[k] : 0.f; }
    __syncthreads();
    const int grp = cls / 6, pr = cls % 6; const int pa = pr < 3 ? 0 : (pr < 5 ? 1 : 2), pb = pr < 3 ? pr + 1 : (pr < 5 ? pr - 1 : 3); const int ea = grp * 4 + pa, eb = grp * 4 + pb;
    for (int s = 0; s < 2; ++s) { const int e = s ? eb : ea; float ga[8], ua[8];
#pragma unroll
        for (int i = 0; i < 8; ++i) { ga[i] = 0.f; ua[i] = 0.f; }
        const float* wg = wg_l + (size_t)e * 1024 * 256 + tid; const float* wu = wu_l + (size_t)e * 1024 * 256 + tid;
        for (int k = 0; k < 1024; ++k) { const float a = wg[(size_t)k * 256], u = wu[(size_t)k * 256];
#pragma unroll
            for (int i = 0; i < 8; ++i) { ga[i] += h[i][k] * a; ua[i] += h[i][k] * u; } }
#pragma unroll
        for (int i = 0; i < 8; ++i) { const int t = tok[i]; const float w = t >= 0 ? TOKW[(size_t)t * 4 + s] : 0.f; act[i][s * 256 + tid] = ga[i] / (1.0f + expf(-ga[i])) * ua[i] * w; } }
    __syncthreads();
    for (int j = 0; j < 4; ++j) { const int n = tid + 256 * j; float y[8];
#pragma unroll
        for (int i = 0; i < 8; ++i) y[i] = 0.f;
        for (int s = 0; s < 2; ++s) { const int e = s ? eb : ea; const float* wd = wd_l + (size_t)e * 256 * 1024 + n;
            for (int f = 0; f < 256; ++f) { const float w = wd[(size_t)f * 1024];
#pragma unroll
                for (int i = 0; i < 8; ++i) y[i] += act[i][s * 256 + f] * w; } }
#pragma unroll
        for (int i = 0; i < 8; ++i) { const int t = tok[i]; if (t >= 0) X[(size_t)t * 1024 + n] += y[i]; } }
}
__global__ void __launch_bounds__(256) k_ref_ple(const float* __restrict__ x, const float* __restrict__ SS, const float* __restrict__ g, const float* __restrict__ wgate_l,
                                                 const float* __restrict__ p_l, const float* __restrict__ wple_l, float* xo) {
    __shared__ float sA[16][65], sB[16][65];
    const int tx = threadIdx.x & 15, ty = threadIdx.x >> 4, t0 = blockIdx.y * 64, n0 = blockIdx.x * 64;
    float ag[4][4] = {}, ab[4][4] = {};
    for (int pass = 0; pass < 2; ++pass) {
        const int K = pass == 0 ? 1024 : 256;
        for (int k0 = 0; k0 < K; k0 += 16) {
            for (int e = threadIdx.x; e < 1024; e += 256) { const int r = e >> 4, kk = e & 15; const int t = t0 + r, k = k0 + kk;
                sA[kk][r] = pass == 0 ? x[(size_t)t * 1024 + k] * SS[t] * g[k] : p_l[(size_t)t * 256 + k]; }
            for (int e = threadIdx.x; e < 1024; e += 256) { const int kk = e >> 6, c = e & 63; const int k = k0 + kk;
                sB[kk][c] = pass == 0 ? wgate_l[(size_t)k * 1024 + n0 + c] : wple_l[(size_t)k * 1024 + n0 + c]; }
            __syncthreads();
#pragma unroll
            for (int kk = 0; kk < 16; ++kk) {
                float a[4], b[4];
#pragma unroll
                for (int i = 0; i < 4; ++i) { a[i] = sA[kk][ty * 4 + i]; b[i] = sB[kk][tx * 4 + i]; }
#pragma unroll
                for (int i = 0; i < 4; ++i)
#pragma unroll
                    for (int j = 0; j < 4; ++j) { if (pass == 0) ag[i][j] += a[i] * b[j]; else ab[i][j] += a[i] * b[j]; }
            }
            __syncthreads();
        }
    }
#pragma unroll
    for (int i = 0; i < 4; ++i)
#pragma unroll
        for (int j = 0; j < 4; ++j) { const size_t o = (size_t)(t0 + ty * 4 + i) * 1024 + n0 + tx * 4 + j; xo[o] = x[o] + ab[i][j] / (1.0f + expf(-ag[i][j])); }
}
}
__device__ __forceinline__ int route_decide(const float (&dg)[4], const float (&de)[16], const float rstd, const float* __restrict__ brg, const float* __restrict__ bre, float& wa, float& wb) {
    float lg[4]; int gi = 0; float lmax;
#pragma unroll
    for (int e = 0; e < 4; ++e) lg[e] = rstd * dg[e] + brg[e];
    lmax = lg[0];
#pragma unroll
    for (int e = 1; e < 4; ++e) if (lg[e] > lmax) { lmax = lg[e]; gi = e; }
    float den = 0.f;
#pragma unroll
    for (int e = 0; e < 4; ++e) den += expf(lg[e] - lmax);
    const float gp = 1.0f / den;
    float el[4] = {0.f, 0.f, 0.f, 0.f};
#pragma unroll
    for (int gg = 0; gg < 4; ++gg)
#pragma unroll
        for (int e = 0; e < 4; ++e) if (gg == gi) el[e] = rstd * de[gg * 4 + e] + bre[gg * 4 + e];
    int i1 = 0; float m1 = el[0];
#pragma unroll
    for (int e = 1; e < 4; ++e) if (el[e] > m1) { m1 = el[e]; i1 = e; }
    int i2 = -1; float m2 = -INFINITY;
#pragma unroll
    for (int e = 0; e < 4; ++e) if (e != i1 && el[e] > m2) { m2 = el[e]; i2 = e; }
    const float r2 = expf(m2 - m1); const float w1 = gp / (1.0f + r2), w2 = gp * r2 / (1.0f + r2);
    const int a = min(i1, i2), b = max(i1, i2); const int pr = (a == 0) ? (b - 1) : ((a == 1) ? (b + 1) : 5); const int cls = gi * 6 + pr;
    wa = i1 == a ? w1 : w2; wb = i1 == a ? w2 : w1;
    return cls;
}
__device__ __forceinline__ int route_core(int t, int lane, const float* __restrict__ X, const float* __restrict__ g, const float* __restrict__ wrg, const float* __restrict__ brg,
                                          const float* __restrict__ wre, const float* __restrict__ bre, float* TOKW) {
    float ss = 0.f, dg[4] = {0.f, 0.f, 0.f, 0.f}, de[16];
#pragma unroll
    for (int e = 0; e < 16; ++e) de[e] = 0.f;
#pragma unroll 4
    for (int i = 0; i < 16; ++i) { const int k = lane + 64 * i; const float xv = X[(size_t)t * 1024 + k]; ss += xv * xv; const float h = xv * g[k];
        const float4 a = *(const float4*)(wrg + (size_t)k * 4); dg[0] += h * a.x; dg[1] += h * a.y; dg[2] += h * a.z; dg[3] += h * a.w;
#pragma unroll
        for (int q = 0; q < 4; ++q) { const float4 b = *(const float4*)(wre + (size_t)k * 16 + 4 * q); de[4 * q] += h * b.x; de[4 * q + 1] += h * b.y; de[4 * q + 2] += h * b.z; de[4 * q + 3] += h * b.w; } }
    ss = refp::wsum(ss);
#pragma unroll
    for (int e = 0; e < 4; ++e) dg[e] = refp::wsum(dg[e]);
#pragma unroll
    for (int e = 0; e < 16; ++e) de[e] = refp::wsum(de[e]);
    const float rstd = rsqrtf(ss * (1.0f / 1024.0f) + RMS_EPS);
    float wa, wb; const int cls = route_decide(dg, de, rstd, brg, bre, wa, wb);
    if (lane == 0) *(float4*)(TOKW + (size_t)t * 4) = make_float4(wa, wb, rstd, 0.f);
    return cls;
}
__device__ __forceinline__ void route_token(int t, int lane, const float* __restrict__ X, const float* __restrict__ g, const float* __restrict__ wrg, const float* __restrict__ brg,
                                            const float* __restrict__ wre, const float* __restrict__ bre, unsigned* cls_cnt, int* LIST, float* TOKW) {
    const int cls = route_core(t, lane, X, g, wrg, brg, wre, bre, TOKW);
    if (lane == 0) { const unsigned pos = atomicAdd(cls_cnt + cls, 1u); LIST[(size_t)cls * T + pos] = t; }
}
__global__ void __launch_bounds__(256) k_route(const float* X, const float* g, const float* wrg, const float* brg, const float* wre, const float* bre, unsigned* cls_cnt, int* LIST, float* TOKW) {
    const int t = blockIdx.x * 4 + (threadIdx.x >> 6);
    route_token(t, threadIdx.x & 63, X, g, wrg, brg, wre, bre, cls_cnt, LIST, TOKW);
}

namespace pg8 {
#define PG8_LAS __attribute__((address_space(3)))
typedef short bf16x8 __attribute__((ext_vector_type(8)));
typedef float f32x4 __attribute__((ext_vector_type(4)));
typedef unsigned u32x4 __attribute__((ext_vector_type(4)));
typedef int i32x4 __attribute__((ext_vector_type(4)));
typedef int i32x8 __attribute__((ext_vector_type(8)));
__device__ __forceinline__ i32x8 cat8(bf16x8 lo, bf16x8 hi) { const i32x4 a = __builtin_bit_cast(i32x4, lo), b = __builtin_bit_cast(i32x4, hi); return __builtin_shufflevector(a, b, 0, 1, 2, 3, 4, 5, 6, 7); }
constexpr int BM = 256, BK = 64, HALF = 128, HTB = HALF * BK * 2, STAGE_BYTES = 8 * HTB;

__host__ __device__ __forceinline__ int lds_byte(int r, int c) { const int st = (r >> 4) * 2 + (c >> 5), rr = r & 15, cc = c & 31, ob = rr * 64 + cc * 2; return st * 1024 + (ob ^ (((ob >> 9) & 1) << 5)); }
__host__ __device__ __forceinline__ void stage_rc(int b, int& R, int& C) { const int st = b / 1024, sb = b % 1024, swz = sb ^ (((sb >> 9) & 1) << 5); R = (st >> 1) * 16 + swz / 64; C = (st & 1) * 32 + (swz % 64) / 2; }
__host__ __device__ __forceinline__ int perm32(int rho) { const int n = rho >> 4, i = rho & 15; return 8 * (i >> 2) + 4 * n + (i & 3); }

struct Step { const char* A; const char* B; const int* rows; int nt, pm, pn, aux, nvalid, zero_after; };
__device__ __forceinline__ int rfl(int v) { return __builtin_amdgcn_readfirstlane(v); }
template <class P> __device__ __forceinline__ P rflp(P p) { const unsigned long long u = (unsigned long long)p; const unsigned lo = (unsigned)__builtin_amdgcn_readfirstlane((int)(unsigned)u), hi = (unsigned)__builtin_amdgcn_readfirstlane((int)(unsigned)(u >> 32)); return (P)(((unsigned long long)hi << 32) | lo); }
__device__ __forceinline__ void step_uniform(Step& s, int& ok) {
    s.A = rflp(s.A); s.B = rflp(s.B); s.rows = rflp(s.rows); s.nt = rfl(s.nt); s.pm = rfl(s.pm); s.pn = rfl(s.pn); s.aux = rfl(s.aux); s.nvalid = rfl(s.nvalid); s.zero_after = rfl(s.zero_after); ok = rfl(ok);
    asm volatile("" : "+s"(ok), "+s"(s.A), "+s"(s.B), "+s"(s.nt), "+s"(s.aux));
}

template <class Sched, class Epi, bool GATHER, bool ALIGN_EPI, bool F8 = false>
__device__ __forceinline__ void gemm_phase(const int tid, PG8_LAS unsigned char* lds, const unsigned lda, const unsigned ldb, const Sched& S, const Epi& E) {
    const int wid = __builtin_amdgcn_readfirstlane(tid >> 6), lane = tid & 63, wr = wid >> 2, wc = wid & 3, fr = lane & 15, fq = lane >> 4;
    int Rr[2], Cc[2]; unsigned voffB[2], cOA[2][2], nOA[2][2];
#pragma unroll
    for (int i = 0; i < 2; ++i) { stage_rc(tid * 16 + i * 8192, Rr[i], Cc[i]); const int Rb = (Rr[i] & ~31) + perm32(Rr[i] & 31); voffB[i] = (unsigned)Rb * ldb + (unsigned)Cc[i] * 2u; }
    const size_t kstep = (size_t)(BK * 2);
    const size_t hstepB = (size_t)HALF * ldb;
    const unsigned ldsw = (unsigned)wid * 1024u;
    const int aoff = lds_byte(wr * 64 + fr, fq * 8), boff = lds_byte(wc * 32 + fr, fq * 8);
#define PG8_SA(b, h) (((b) * 2 + (h)) * HTB)
#define PG8_SB(b, h) ((4 + (b) * 2 + (h)) * HTB)
#define PG8_STAGE_B(bufoff, gbase) do { _Pragma("unroll") for (int _i = 0; _i < 2; ++_i) \
        __builtin_amdgcn_global_load_lds((const unsigned*)((const char*)(gbase) + voffB[_i]), (PG8_LAS unsigned*)(lds + (bufoff) + ldsw + _i * 8192), 16, 0, 0); } while (0)
#define PG8_STAGE_A(bufoff, gbase, o0, o1) do { \
        __builtin_amdgcn_global_load_lds((const unsigned*)((const char*)(gbase) + (o0)), (PG8_LAS unsigned*)(lds + (bufoff) + ldsw), 16, 0, 0); \
        __builtin_amdgcn_global_load_lds((const unsigned*)((const char*)(gbase) + (o1)), (PG8_LAS unsigned*)(lds + (bufoff) + ldsw + 8192), 16, 0, 0); } while (0)
#define PG8_LDA(dst, b, h) do { _Pragma("unroll") for (int m = 0; m < 4; ++m) _Pragma("unroll") for (int k = 0; k < 2; ++k) dst[m][k] = *(const PG8_LAS bf16x8*)(lds + PG8_SA(b, h) + aoff + m * 2048 + k * 1024); } while (0)
#define PG8_LDB(dst, b, h) do { _Pragma("unroll") for (int n = 0; n < 2; ++n) _Pragma("unroll") for (int k = 0; k < 2; ++k) dst[n][k] = *(const PG8_LAS bf16x8*)(lds + PG8_SB(b, h) + boff + n * 2048 + k * 1024); } while (0)
#define PG8_MMA(ai, bj, At, Bt) do { __builtin_amdgcn_s_setprio(1); \
        if constexpr (F8) { _Pragma("unroll") for (int m = 0; m < 4; ++m) _Pragma("unroll") for (int n = 0; n < 2; ++n) \
            asm volatile("v_mfma_scale_f32_16x16x128_f8f6f4 %0, %1, %2, %0, %3, %3 op_sel_hi:[0,0,0]" : "+v"(acc[ai][bj][m][n]) : "v"(cat8(Bt[n][0], Bt[n][1])), "v"(cat8(At[m][0], At[m][1])), "v"(f8scale)); } \
        else { _Pragma("unroll") for (int m = 0; m < 4; ++m) _Pragma("unroll") for (int n = 0; n < 2; ++n) _Pragma("unroll") for (int k = 0; k < 2; ++k) \
            acc[ai][bj][m][n] = __builtin_amdgcn_mfma_f32_16x16x32_bf16(Bt[n][k], At[m][k], acc[ai][bj][m][n], 0, 0, 0); } \
        __builtin_amdgcn_s_setprio(0); } while (0)
#define PG8_WAIT_V(n) asm volatile("s_waitcnt vmcnt(" #n ")" ::: "memory")
#define PG8_WAIT_L(n) asm volatile("s_waitcnt lgkmcnt(" #n ")" ::: "memory")
#define PG8_BAR __builtin_amdgcn_s_barrier()
#define PG8_SCHED __builtin_amdgcn_sched_barrier(0)
#define PG8_AOFFS(dst, st) do { _Pragma("unroll") for (int _h = 0; _h < 2; ++_h) _Pragma("unroll") for (int _i = 0; _i < 2; ++_i) { \
        int _row = Rr[_i] + 128 * _h; if (GATHER) { _row = (st).rows[_row]; _row = _row < 0 ? 0 : _row; } \
        dst[_h][_i] = (unsigned)_row * lda + (unsigned)Cc[_i] * 2u; } } while (0)
    int f8scale = 0x7F7F7F7F; if constexpr (F8) asm volatile("" : "+v"(f8scale));
    Step cur, nxt; int ui = 0;
    { int ok_ = S.next(0, cur) ? 1 : 0; step_uniform(cur, ok_); if (!ok_) return; }
    f32x4 acc[2][2][4][2];
#pragma unroll
    for (int a = 0; a < 2; ++a)
#pragma unroll
        for (int b = 0; b < 2; ++b)
#pragma unroll
            for (int m = 0; m < 4; ++m)
#pragma unroll
                for (int n = 0; n < 2; ++n) acc[a][b][m][n] = (f32x4){0.f, 0.f, 0.f, 0.f};
    bf16x8 At[4][2], B0[2][2], B1[2][2];
    PG8_AOFFS(cOA, cur);
    const char* cA = cur.A; const char* cB = cur.B;
    PG8_STAGE_B(PG8_SB(0, 0), cB); PG8_STAGE_B(PG8_SB(0, 1), cB + hstepB); PG8_STAGE_A(PG8_SA(0, 0), cA, cOA[0][0], cOA[0][1]); PG8_STAGE_A(PG8_SA(0, 1), cA, cOA[1][0], cOA[1][1]);
    if (wr == 1) PG8_BAR;
    PG8_WAIT_V(2); PG8_BAR;
    PG8_STAGE_B(PG8_SB(1, 0), cB + kstep); PG8_STAGE_A(PG8_SA(1, 0), cA + kstep, cOA[0][0], cOA[0][1]); PG8_STAGE_B(PG8_SB(1, 1), cB + hstepB + kstep);
    PG8_WAIT_V(6); PG8_BAR;
#pragma clang loop unroll(disable)
    for (;;) {
        bool has_next = S.next(ui + 1, nxt);
        { int hn_ = has_next ? 1 : 0; step_uniform(nxt, hn_); has_next = hn_ != 0; }
        asm volatile("" : "+v"(voffB[0]), "+v"(voffB[1]));
        const char* nA = has_next ? nxt.A : cA; const char* nB = has_next ? nxt.B : cB;
        if (GATHER) { if (has_next) { PG8_AOFFS(nOA, nxt); } else {
#pragma unroll
            for (int _h = 0; _h < 2; ++_h)
#pragma unroll
                for (int _i = 0; _i < 2; ++_i) nOA[_h][_i] = cOA[_h][_i]; } }
        const int nt = cur.nt;
#pragma clang loop unroll(disable)
        for (int t = 0; t < nt; t += 2) {
            const bool last = (t == nt - 2);
            const char* a1 = cA + (size_t)(t + 1) * kstep;
            const char* a2 = last ? nA : cA + (size_t)(t + 2) * kstep; const char* b2 = last ? nB : cB + (size_t)(t + 2) * kstep;
            const char* a3 = a2 + kstep; const char* b3 = b2 + kstep;
            unsigned o00, o01, o10, o11;
            if (GATHER) { o00 = last ? nOA[0][0] : cOA[0][0]; o01 = last ? nOA[0][1] : cOA[0][1]; o10 = last ? nOA[1][0] : cOA[1][0]; o11 = last ? nOA[1][1] : cOA[1][1]; }
            else { o00 = cOA[0][0]; o01 = cOA[0][1]; o10 = cOA[1][0]; o11 = cOA[1][1]; }
            PG8_LDB(B0, 0, 0); PG8_LDB(B1, 0, 1); PG8_SCHED; PG8_LDA(At, 0, 0); PG8_STAGE_A(PG8_SA(1, 1), a1, cOA[1][0], cOA[1][1]);
            PG8_WAIT_V(8); PG8_WAIT_L(0); PG8_BAR; PG8_MMA(0, 0, At, B0); PG8_MMA(0, 1, At, B1); PG8_BAR; PG8_SCHED;
            PG8_LDA(At, 0, 1); PG8_STAGE_B(PG8_SB(0, 0), b2); PG8_STAGE_B(PG8_SB(0, 1), b2 + hstepB); PG8_STAGE_A(PG8_SA(0, 0), a2, o00, o01);
            PG8_WAIT_V(8); PG8_WAIT_L(0); PG8_BAR; PG8_MMA(1, 0, At, B0); PG8_MMA(1, 1, At, B1); PG8_BAR; PG8_SCHED;
            PG8_LDB(B0, 1, 0); PG8_LDB(B1, 1, 1); PG8_SCHED; PG8_LDA(At, 1, 0); PG8_STAGE_A(PG8_SA(0, 1), a2, o10, o11);
            PG8_WAIT_V(8); PG8_WAIT_L(0); PG8_BAR; PG8_MMA(0, 0, At, B0); PG8_MMA(0, 1, At, B1); PG8_BAR; PG8_SCHED;
            PG8_LDA(At, 1, 1); PG8_STAGE_B(PG8_SB(1, 0), b3); PG8_STAGE_B(PG8_SB(1, 1), b3 + hstepB); PG8_STAGE_A(PG8_SA(1, 0), a3, o00, o01);
            PG8_WAIT_V(8); PG8_WAIT_L(0); PG8_BAR; PG8_MMA(1, 0, At, B0); PG8_MMA(1, 1, At, B1); PG8_BAR; PG8_SCHED;
        }
        if constexpr (F8) { asm volatile("s_nop 15\n\ts_nop 15" ::: "memory"); }
        if constexpr (ALIGN_EPI) { if (wr == 0) PG8_BAR; }
        { int ln_; asm volatile("v_mbcnt_lo_u32_b32 %0, -1, 0\n\tv_mbcnt_hi_u32_b32 %0, -1, %0" : "=v"(ln_));
          E(acc, cur, wr, wc, ln_ & 15, ln_ >> 4); }
        if (!has_next) break;
        if (cur.zero_after) {
#pragma unroll
            for (int a = 0; a < 2; ++a)
#pragma unroll
                for (int b = 0; b < 2; ++b)
#pragma unroll
                    for (int m = 0; m < 4; ++m)
#pragma unroll
                        for (int n = 0; n < 2; ++n) acc[a][b][m][n] = (f32x4){0.f, 0.f, 0.f, 0.f};
        }
        cur = nxt; cA = nA; cB = nB; ++ui;
        if (GATHER) {
#pragma unroll
            for (int _h = 0; _h < 2; ++_h)
#pragma unroll
                for (int _i = 0; _i < 2; ++_i) cOA[_h][_i] = nOA[_h][_i]; }
        if constexpr (ALIGN_EPI) { if (wr == 1) PG8_BAR; }
    }
    PG8_WAIT_V(0);
    if constexpr (!ALIGN_EPI) { if (wr == 0) PG8_BAR; }
    PG8_BAR;
#undef PG8_SA
#undef PG8_SB
#undef PG8_STAGE_A
#undef PG8_STAGE_B
#undef PG8_LDA
#undef PG8_LDB
#undef PG8_MMA
#undef PG8_WAIT_V
#undef PG8_WAIT_L
#undef PG8_BAR
#undef PG8_SCHED
#undef PG8_AOFFS
}
}
#include <hip/hip_bf16.h>
namespace attn_body {
using hbf16=__hip_bfloat16;
using bf16x8=__attribute__((ext_vector_type(8)))short;
using s16x4=__attribute__((ext_vector_type(4)))short;
using f32x16=__attribute__((ext_vector_type(16)))float;
using u32x4=__attribute__((ext_vector_type(4)))unsigned;
constexpr int SEQ=2048,D=64,DM=3584;
constexpr int NW=8,QBLK=32,QB=QBLK*NW,KVBLK=64,NQB=SEQ/QB;
__device__ __forceinline__ int crow(int r,int hi){return (r&3)+8*(r>>2)+4*hi;}
#define SBAR() __builtin_amdgcn_sched_barrier(0)
__device__ __forceinline__ void cmask(f32x16&p0,f32x16&p1,int jb,int qrel,int hi){
  const float NEG=-INFINITY; int kb=64*jb+4*hi;
  #pragma unroll
  for(int r=0;r<16;++r){int kv=kb+(r&3)+8*(r>>2); if(kv>qrel)p0[r]=NEG; if(kv+32>qrel)p1[r]=NEG;}
}

constexpr int NSLOT=3, SLOTB=8192;
constexpr int LDS_K=0, LDS_V=NSLOT*SLOTB, LDS_WS=2*NSLOT*SLOTB, LDS_OST=LDS_WS+NW*64*4, LDS_BIAS=LDS_OST+NW*4096, LDS_SSQ=LDS_BIAS+SEQ*4, LDS_BYTES=LDS_SSQ+NW*32*4;
constexpr float C2=0.125f*1.4426950408889634f;
__device__ __forceinline__ void glds16(const void*gsrc,unsigned lds_dst){unsigned keep;
  asm volatile("s_mov_b32 %0, m0\n\ts_mov_b32 m0, %2\n\ts_nop 0\n\tglobal_load_lds_dwordx4 %1, off\n\ts_mov_b32 m0, %0":"=&s"(keep):"v"(gsrc),"s"(lds_dst):"memory");}
__device__ __forceinline__ float max3f(float a,float b,float c){float r;asm("v_max3_f32 %0, %1, %2, %3":"=v"(r):"v"(a),"v"(b),"v"(c));return r;}
__device__ __forceinline__ float max2f(float a,float b){float r;asm("v_max_f32_e32 %0, %1, %2":"=v"(r):"v"(a),"v"(b));return r;}
__device__ __forceinline__ float fadd_s(float a,float b){float r;asm("v_add_f32_e32 %0, %1, %2":"=v"(r):"v"(a),"v"(b));return r;}
__device__ __forceinline__ float fsub_s(float a,float b){float r;asm("v_sub_f32_e32 %0, %1, %2":"=v"(r):"v"(a),"v"(b));return r;}
typedef float f32x2_t __attribute__((ext_vector_type(2))); typedef float f32x4_t __attribute__((ext_vector_type(4))); typedef __bf16 bf16x2_t __attribute__((ext_vector_type(2)));
__device__ __forceinline__ unsigned cvtpk_s(float lo,float hi){f32x2_t v={lo,hi};bf16x2_t b=__builtin_convertvector(v,bf16x2_t);return __builtin_bit_cast(unsigned,b);}
#define WAIT_BAR(N) asm volatile("s_waitcnt vmcnt(" #N ") lgkmcnt(0)\n\ts_barrier":::"memory")

__device__ __forceinline__ void qkt(f32x16&p0,f32x16&p1,const char*Kslot,const bf16x8*qr,const f32x16&negm,int r32,int hi){
  const char*kb=Kslot+hi*1024+r32*16;
  #pragma unroll
  for(int d0=0;d0<4;++d0){
    const bf16x8 b0=*reinterpret_cast<const bf16x8*>(kb+d0*2048);
    const bf16x8 b1=*reinterpret_cast<const bf16x8*>(kb+d0*2048+512);
    if(d0==0){p0=__builtin_amdgcn_mfma_f32_32x32x16_bf16(b0,qr[0],negm,0,0,0);p1=__builtin_amdgcn_mfma_f32_32x32x16_bf16(b1,qr[0],negm,0,0,0);}
    else{p0=__builtin_amdgcn_mfma_f32_32x32x16_bf16(b0,qr[d0],p0,0,0,0);p1=__builtin_amdgcn_mfma_f32_32x32x16_bf16(b1,qr[d0],p1,0,0,0);}}
}
typedef __attribute__((address_space(3))) const char* lds_cptr;
typedef short v4i16_t __attribute__((ext_vector_type(4)));
__device__ __forceinline__ void kload8(bf16x8*kf,lds_cptr kp){
  kf[0]=*(const __attribute__((address_space(3))) bf16x8*)(kp);      kf[1]=*(const __attribute__((address_space(3))) bf16x8*)(kp+512);
  kf[2]=*(const __attribute__((address_space(3))) bf16x8*)(kp+2048); kf[3]=*(const __attribute__((address_space(3))) bf16x8*)(kp+2560);
  kf[4]=*(const __attribute__((address_space(3))) bf16x8*)(kp+4096); kf[5]=*(const __attribute__((address_space(3))) bf16x8*)(kp+4608);
  kf[6]=*(const __attribute__((address_space(3))) bf16x8*)(kp+6144); kf[7]=*(const __attribute__((address_space(3))) bf16x8*)(kp+6656);
}
__device__ __forceinline__ void kload2(bf16x8*kf,lds_cptr kp,int j){ kf[2*j]=*(const __attribute__((address_space(3))) bf16x8*)(kp+j*2048); kf[2*j+1]=*(const __attribute__((address_space(3))) bf16x8*)(kp+j*2048+512); }
__device__ __forceinline__ s16x4 vtr(lds_cptr p){ return __builtin_bit_cast(s16x4,__builtin_amdgcn_ds_read_tr16_b64_v4i16((__attribute__((address_space(3))) v4i16_t*)p)); }
__device__ __forceinline__ float rowmax(const f32x16&p0,const f32x16&p1){
  float a=max3f(p0[0],p0[1],p1[0]),b=max3f(p0[2],p0[3],p1[1]);a=max3f(a,p1[2],p1[3]);
  #pragma unroll
  for(int r=4;r<16;r+=4){a=max3f(a,p0[r],p0[r+1]);b=max3f(b,p0[r+2],p0[r+3]);a=max3f(a,p1[r],p1[r+1]);b=max3f(b,p1[r+2],p1[r+3]);}
  const float m=max2f(a,b);
  auto rr=__builtin_amdgcn_permlane32_swap(__float_as_uint(m),__float_as_uint(m),false,false);
  return max2f(__uint_as_float(rr[0]),__uint_as_float(rr[1]));
}
__device__ __forceinline__ void pv(f32x16*o,int vb,bf16x8 pa0,bf16x8 pa1,bf16x8 pa2,bf16x8 pa3){
  #pragma unroll
  for(int d0=0;d0<2;++d0){s16x4 lo[4],hi[4];
    #pragma unroll
    for(int ks=0;ks<4;++ks){
      asm volatile("ds_read_b64_tr_b16 %0,%1 offset:%c2":"=&v"(lo[ks]):"v"(vb),"i"(d0*4096+ks*1024):"memory");
      asm volatile("ds_read_b64_tr_b16 %0,%1 offset:%c2":"=&v"(hi[ks]):"v"(vb),"i"(d0*4096+ks*1024+512):"memory");}
    asm volatile("s_waitcnt lgkmcnt(0)":::"memory");SBAR();
    #define PK(k) (bf16x8){lo[k][0],lo[k][1],lo[k][2],lo[k][3],hi[k][0],hi[k][1],hi[k][2],hi[k][3]}
    o[d0]=__builtin_amdgcn_mfma_f32_32x32x16_bf16(pa0,PK(0),o[d0],0,0,0);
    o[d0]=__builtin_amdgcn_mfma_f32_32x32x16_bf16(pa1,PK(1),o[d0],0,0,0);
    o[d0]=__builtin_amdgcn_mfma_f32_32x32x16_bf16(pa2,PK(2),o[d0],0,0,0);
    o[d0]=__builtin_amdgcn_mfma_f32_32x32x16_bf16(pa3,PK(3),o[d0],0,0,0);
    #undef PK
  }
}

#ifndef ATTN_STORE16
#define ATTN_STORE16(p,v) (*(u32x4*)(p)=(v))
#endif
struct AttnP { const bf16* Q; const bf16* K; const bf16* V; bf16* out; bf16* stash; const float* gsub; const float* logf; int opitch; float lam, nscale; };
template<int THRL,bool FOX> __device__ __forceinline__ void attn_unit(const int tid_in,int b,int qb,const int MODE,const AttnP&P,char*shm){
  int tid=tid_in; asm volatile("":"+v"(tid));
  const int lane=tid&63,r32=lane&31,hi=lane>>5; const int wid=__builtin_amdgcn_readfirstlane(tid>>6);
  const long rowbase=(long)b*SEQ; const int q0=qb*QB;
  const bf16*Qw=P.Q+(rowbase+q0+wid*QBLK)*DM;
  const bf16*Kh=P.K+rowbase*DM,*Vh=P.V+rowbase*DM;
  const unsigned lds0=(unsigned)(uintptr_t)shm;
  float*wsf=(float*)(shm+LDS_WS)+wid*64;
  const float*biasL=(const float*)(shm+LDS_BIAS);
  #define BIAS(P0,P1,t) do{ if(FOX){ const float*bb_=biasL+64*(t)+4*hi; _Pragma("unroll") for(int g_=0;g_<4;++g_){ const f32x4_t b0_=*(const f32x4_t*)(bb_+8*g_), b1_=*(const f32x4_t*)(bb_+32+8*g_); \
      _Pragma("unroll") for(int e_=0;e_<4;++e_){ P0[4*g_+e_]+=b0_[e_]; P1[4*g_+e_]+=b1_[e_]; } asm volatile("":::"memory"); } } }while(0)
  const bf16*ksrc=Kh+(long)lane*DM+wid*8;
  const bf16*vsrc=Vh+(long)(16*(wid&3)+(lane>>2))*DM+(wid>>2)*32+(lane&3)*8;
  const unsigned kdst=lds0+LDS_K+wid*1024, vdst=lds0+LDS_V+wid*1024;
  #define DMA_K(t,slot) glds16(ksrc+(long)(t)*KVBLK*DM,(unsigned)__builtin_amdgcn_readfirstlane(kdst+(slot)))
  #define DMA_V(t,slot) glds16(vsrc+(long)(t)*KVBLK*DM,(unsigned)__builtin_amdgcn_readfirstlane(vdst+(slot)))
  const int vb0=(int)(lds0+LDS_V)+((lane>>4)&1)*32+(lane&3)*8+(4*hi+((lane&15)>>2))*64;
  const char*Kbase=shm+LDS_K; bf16x8 kf[8];
  const lds_cptr shm3=(lds_cptr)shm; const lds_cptr kp0=shm3+LDS_K+hi*1024+r32*16; const lds_cptr vp0=shm3+LDS_V+((lane>>4)&1)*32+(lane&3)*8+(4*hi+((lane&15)>>2))*64;
  const int NT=(q0+QB)/KVBLK;
  DMA_K(0,0);DMA_V(0,0);DMA_K(1,SLOTB);
  bf16x8 qr[4];
  #pragma unroll
  for(int d0=0;d0<4;++d0)qr[d0]=*reinterpret_cast<const bf16x8*>(&Qw[(long)r32*DM+d0*16+hi*8]);
  float mhat=0.f,l_reg=0.f;f32x16 o[2];o[0]=f32x16{};o[1]=f32x16{};f32x16 negm=f32x16{};asm volatile("":"+v"(negm));
  const int qrel=wid*QBLK+r32;
  #define CMASK(P0,P1,t) do{int jb_=(t)-(NT-4); if(jb_>=0)cmask(P0,P1,jb_,qrel,hi);}while(0)
  bool resc=false;
  #define START(P0,P1) do{ const float rm=rowmax(P0,P1); resc=false; \
    { const float dl=rm; mhat=fadd_s(mhat,dl); \
      _Pragma("unroll") for(int r=0;r<16;++r){P0[r]=fsub_s(P0[r],dl);P1[r]=fsub_s(P1[r],dl);} \
      _Pragma("unroll") for(int r=0;r<16;++r)negm[r]=-mhat; asm volatile("":"+v"(negm)); } \
    _Pragma("unroll") for(int r=0;r<16;++r)P0[r]=__builtin_amdgcn_exp2f(P0[r]); }while(0)
  #define RESC() do{ if(resc){ asm volatile("s_waitcnt lgkmcnt(0)":::"memory"); \
      _Pragma("unroll") for(int d_=0;d_<2;++d_) _Pragma("unroll") for(int r=0;r<16;++r)o[d_][r]*=wsf[crow(r,hi)]; } }while(0)
  f32x16 pA0,pA1,pB0,pB1;
  int sl_prev=0,sl_cur=0,sl_next=SLOTB;
  #define ROT() do{sl_prev=sl_cur;sl_cur=sl_next;sl_next=(sl_next==(NSLOT-1)*SLOTB)?0:sl_next+SLOTB;}while(0)
  DMA_K(2,2*SLOTB);
  if(FOX){
    const int n=q0+QB; float v4[4]; float run=0.f;
    _Pragma("unroll") for(int i=0;i<4;++i){ const int sidx=4*tid+i; const float lv=(sidx<n)?P.logf[(rowbase+sidx)*8]:0.f; run+=lv; v4[i]=run; }
    float inc=run; _Pragma("unroll") for(int o_=1;o_<64;o_<<=1){ const float up=__int_as_float(__builtin_amdgcn_ds_bpermute((lane-o_)<<2,__float_as_int(inc))); if(lane>=o_)inc+=up; }
    float*wt=(float*)(shm+LDS_WS); if(lane==63)wt[wid]=inc; __syncthreads();
    float pre=inc-run; _Pragma("unroll") for(int w_=0;w_<NW;++w_){ if(w_<wid)pre+=wt[w_]; }
    float*bw=(float*)(shm+LDS_BIAS); _Pragma("unroll") for(int i=0;i<4;++i){ const int sidx=4*tid+i; if(sidx<n)bw[sidx]=-(pre+v4[i])*1.4426950408889634f; }
    __syncthreads(); }
  WAIT_BAR(3);
  qkt(pA0,pA1,Kbase,qr,negm,r32,hi);asm volatile("s_nop 15\n\ts_nop 7":"+v"(pA0),"+v"(pA1));BIAS(pA0,pA1,0);CMASK(pA0,pA1,0);
  START(pA0,pA1);
  _Pragma("unroll") for(int r=0;r<16;++r)pA1[r]=__builtin_amdgcn_exp2f(pA1[r]);
  WAIT_BAR(0);
  DMA_K(3,0);DMA_V(1,SLOTB);
  ROT();
  kload8(kf,kp0+sl_cur);
  WAIT_BAR(2);
  s16x4 vlo[8],vhi[8]; u32x4 pw0,pw1,pw2,pw3;
  #define PKW(P,B) cvtpk_s(P[B],P[B+1])
  #define PAF(k) __builtin_bit_cast(bf16x8,pw##k)
  #define VFR(i) (bf16x8){vlo[i][0],vlo[i][1],vlo[i][2],vlo[i][3],vhi[i][0],vhi[i][1],vhi[i][2],vhi[i][3]}
  #define PIN(x) asm volatile("":"+v"(x))
  #define MX3(a,b,c) __builtin_fmaxf(__builtin_fmaxf((a),(b)),(c))
  #define GAPA(MF,A0,A1,A2,A3,W0,W1,PW) do{ MF; sacc+=A0; sacc+=A1; sacc+=A2; sacc+=A3; PIN(sacc); W0; W1; PIN(PW); SBAR(); }while(0)
  #define EX(v) __builtin_amdgcn_exp2f(v)
  #define GAPB(MF,X,B) do{ MF; X[B]=EX(X[B]); X[B+1]=EX(X[B+1]); X[B+2]=EX(X[B+2]); X[B+3]=EX(X[B+3]); PIN(X); SBAR(); }while(0)
  #define VRD(i) do{ vlo[i]=vtr(vp_+(((i)>>2)*4096+((i)&3)*1024)); vhi[i]=vtr(vp_+(((i)>>2)*4096+((i)&3)*1024+512)); }while(0)
  #define KRD(G,j) do{ if(G){ kload2(kf,kp0+sl_next,j); SBAR(); } }while(0)
  #define STEP(C0,C1,P0,P1,t,GK,GV,GL) do{ SBAR(); \
    const lds_cptr vp_=vp0+sl_prev; \
    VRD(0); SBAR(); float sacc=(P0[0]+P0[1]); \
    GAPA(C0=__builtin_amdgcn_mfma_f32_32x32x16_bf16(kf[0],qr[0],negm,0,0,0), P0[2],P0[3],P0[4],P0[5],     pw0[0]=PKW(P0,0), pw0[1]=PKW(P0,2), pw0); \
    VRD(4); SBAR(); GAPA(C1=__builtin_amdgcn_mfma_f32_32x32x16_bf16(kf[1],qr[0],negm,0,0,0), P0[6],P0[7],P0[8],P0[9],     pw0[2]=PKW(P0,4), pw0[3]=PKW(P0,6), pw0); \
    VRD(1); SBAR(); GAPA(C0=__builtin_amdgcn_mfma_f32_32x32x16_bf16(kf[2],qr[1],C0,0,0,0),   P0[10],P0[11],P0[12],P0[13], pw1[0]=PKW(P0,8), pw1[1]=PKW(P0,10), pw1); \
    VRD(5); SBAR(); GAPA(C1=__builtin_amdgcn_mfma_f32_32x32x16_bf16(kf[3],qr[1],C1,0,0,0),   P0[14],P0[15],P1[0],P1[1],   pw1[2]=PKW(P0,12),pw1[3]=PKW(P0,14), pw1); \
    VRD(2); SBAR(); GAPA(C0=__builtin_amdgcn_mfma_f32_32x32x16_bf16(kf[4],qr[2],C0,0,0,0),   P1[2],P1[3],P1[4],P1[5],     pw2[0]=PKW(P1,0), pw2[1]=PKW(P1,2), pw2); \
    VRD(6); SBAR(); GAPA(C1=__builtin_amdgcn_mfma_f32_32x32x16_bf16(kf[5],qr[2],C1,0,0,0),   P1[6],P1[7],P1[8],P1[9],     pw2[2]=PKW(P1,4), pw2[3]=PKW(P1,6), pw2); \
    VRD(3); SBAR(); GAPA(C0=__builtin_amdgcn_mfma_f32_32x32x16_bf16(kf[6],qr[3],C0,0,0,0),   P1[10],P1[11],P1[12],P1[13], pw3[0]=PKW(P1,8), pw3[1]=PKW(P1,10), pw3); \
    VRD(7); SBAR(); GAPA(C1=__builtin_amdgcn_mfma_f32_32x32x16_bf16(kf[7],qr[3],C1,0,0,0),   P1[14],P1[15],0.f,0.f,       pw3[2]=PKW(P1,12),pw3[3]=PKW(P1,14), pw3); \
    l_reg+=sacc; \
    if(GK){DMA_K((t)+3,sl_cur);} if(GV){DMA_V((t)+1,sl_next);} \
    BIAS(C0,C1,t); CMASK(C0,C1,t); \
    { float a=MX3(C0[0],C0[1],C1[0]),b=MX3(C0[2],C0[3],C1[1]); a=MX3(a,C1[2],C1[3]); \
      _Pragma("unroll") for(int r=4;r<16;r+=4){a=MX3(a,C0[r],C0[r+1]);b=MX3(b,C0[r+2],C0[r+3]);a=MX3(a,C1[r],C1[r+1]);b=MX3(b,C1[r+2],C1[r+3]);} \
      float rm=__builtin_fmaxf(a,b); { auto rr=__builtin_amdgcn_permlane32_swap(__float_as_uint(rm),__float_as_uint(rm),false,false); rm=__builtin_fmaxf(__uint_as_float(rr[0]),__uint_as_float(rr[1])); } \
      resc=false; \
      if(__builtin_expect(__any(rm>(float)THRL),0)){ const float dl=__builtin_fmaxf(rm,0.f); mhat+=dl; \
        _Pragma("unroll") for(int r=0;r<16;++r){C0[r]-=dl;C1[r]-=dl;} \
        _Pragma("unroll") for(int r=0;r<16;++r)negm[r]=-mhat; asm volatile("":"+v"(negm)); \
        const float f=__builtin_amdgcn_exp2f(-dl); l_reg*=f; if(hi==0)wsf[r32]=f; resc=true; } } \
    SBAR(); \
    GAPB(o[0]=__builtin_amdgcn_mfma_f32_32x32x16_bf16(PAF(0),VFR(0),o[0],0,0,0), C0,0); \
    GAPB(o[1]=__builtin_amdgcn_mfma_f32_32x32x16_bf16(PAF(0),VFR(4),o[1],0,0,0), C0,4); \
    KRD(GL,0); GAPB(o[0]=__builtin_amdgcn_mfma_f32_32x32x16_bf16(PAF(1),VFR(1),o[0],0,0,0), C0,8); \
    KRD(GL,1); GAPB(o[1]=__builtin_amdgcn_mfma_f32_32x32x16_bf16(PAF(1),VFR(5),o[1],0,0,0), C0,12); \
    KRD(GL,2); GAPB(o[0]=__builtin_amdgcn_mfma_f32_32x32x16_bf16(PAF(2),VFR(2),o[0],0,0,0), C1,0); \
    KRD(GL,3); GAPB(o[1]=__builtin_amdgcn_mfma_f32_32x32x16_bf16(PAF(2),VFR(6),o[1],0,0,0), C1,4); \
    GAPB(o[0]=__builtin_amdgcn_mfma_f32_32x32x16_bf16(PAF(3),VFR(3),o[0],0,0,0), C1,8); \
    GAPB(o[1]=__builtin_amdgcn_mfma_f32_32x32x16_bf16(PAF(3),VFR(7),o[1],0,0,0), C1,12); \
    }while(0)
  int t=1;
  #undef CMASK
  #define CMASK(P0,P1,t) do{}while(0)
  for(;t+5<NT;t+=2){
    STEP(pB0,pB1,pA0,pA1,t,true,true,true);     WAIT_BAR(2); RESC(); ROT();
    STEP(pA0,pA1,pB0,pB1,t+1,true,true,true);   WAIT_BAR(2); RESC(); ROT();
  }
  #undef CMASK
  #define CMASK(P0,P1,t) do{int jb_=(t)-(NT-4); if(jb_>=0)cmask(P0,P1,jb_,qrel,hi);}while(0)
  #define ENDW(tt) do{ if((tt)+3<NT){WAIT_BAR(2);} else if((tt)+2<NT){WAIT_BAR(1);} else {WAIT_BAR(0);} }while(0)
  for(;t+1<NT;t+=2){
    STEP(pB0,pB1,pA0,pA1,t,(t+3<NT),(t+1<NT),(t+1<NT));       ENDW(t);   RESC(); ROT();
    STEP(pA0,pA1,pB0,pB1,t+1,(t+4<NT),(t+2<NT),(t+2<NT));     ENDW(t+1); RESC(); ROT();
  }
  STEP(pB0,pB1,pA0,pA1,NT-1,false,false,false); RESC();
  { float sacc=pB0[0]+pB0[1]; _Pragma("unroll") for(int r=2;r<16;++r)sacc+=pB0[r]; _Pragma("unroll") for(int r=0;r<16;++r)sacc+=pB1[r]; l_reg+=sacc;
    pw0=(u32x4){PKW(pB0,0),PKW(pB0,2),PKW(pB0,4),PKW(pB0,6)};pw1=(u32x4){PKW(pB0,8),PKW(pB0,10),PKW(pB0,12),PKW(pB0,14)};pw2=(u32x4){PKW(pB1,0),PKW(pB1,2),PKW(pB1,4),PKW(pB1,6)};pw3=(u32x4){PKW(pB1,8),PKW(pB1,10),PKW(pB1,12),PKW(pB1,14)};
    SBAR(); pv(o,vb0+sl_cur,PAF(0),PAF(1),PAF(2),PAF(3)); }
  #undef PKW
  #undef PAF
  #undef VFR
  #undef PIN
  #undef MX3
  #undef GAPA
  #undef GAPB
  #undef EX
  #undef VRD
  #undef KRD
  #undef STEP
  #undef ENDW
  {auto rr=__builtin_amdgcn_permlane32_swap(__float_as_uint(l_reg),__float_as_uint(l_reg),false,false);l_reg=__uint_as_float(rr[0])+__uint_as_float(rr[1]);}
  if(hi==0)wsf[32+r32]=l_reg;asm volatile("s_waitcnt lgkmcnt(0)":::"memory");
  float rli[16];
  #pragma unroll
  for(int r=0;r<16;++r)rli[r]=__builtin_amdgcn_rcpf(wsf[32+crow(r,hi)]);
  { hbf16*stg=(hbf16*)(shm+LDS_OST)+wid*2048;
    #pragma unroll
    for(int r=0;r<16;++r){const int orow=crow(r,hi);
      #pragma unroll
      for(int d0=0;d0<2;++d0)stg[orow*64+d0*32+r32]=__float2bfloat16(o[d0][r]*rli[r]);}
    asm volatile("s_waitcnt lgkmcnt(0)":::"memory");
    const long grow=rowbase+q0+wid*QBLK; float*ssq=(float*)(shm+LDS_SSQ)+wid*32;
    int lane_e=lane; asm volatile("":"+v"(lane_e));
    #pragma unroll
    for(int i=0;i<4;++i){const int row=i*8+(lane_e>>3),ch=lane_e&7; const u32x4 v=*(const u32x4*)(stg+row*64+ch*8);
      if(MODE==0){ *(u32x4*)(P.out+(grow+row)*(long)P.opitch+ch*8)=v; }
      else { bf16*sp=P.stash+(grow+row)*512+ch*8+(MODE==2?64:0); const u32x4 a=*(const u32x4*)sp; float of[8]; float ss=0.f;
        #pragma unroll
        for(int j=0;j<4;++j){ const float a0=__uint_as_float(a[j]<<16),a1=__uint_as_float(a[j]&0xffff0000u),c0=__uint_as_float(v[j]<<16),c1=__uint_as_float(v[j]&0xffff0000u);
          of[2*j]=a0-P.lam*c0; of[2*j+1]=a1-P.lam*c1; ss+=of[2*j]*of[2*j]+of[2*j+1]*of[2*j+1]; }
        ss+=__int_as_float(__builtin_amdgcn_ds_swizzle(__float_as_int(ss),0x041f)); ss+=__int_as_float(__builtin_amdgcn_ds_swizzle(__float_as_int(ss),0x081f)); ss+=__int_as_float(__builtin_amdgcn_ds_swizzle(__float_as_int(ss),0x101f));
        if(MODE==1){ if(ch==0)ssq[row]=ss; u32x4 w; _Pragma("unroll") for(int j=0;j<4;++j)w[j]=cvtpk_s(of[2*j],of[2*j+1]); *(u32x4*)sp=w; }
        else { const float rr_=rsqrtf((ss+ssq[row])*(1.0f/128.0f)+1e-6f)*P.nscale; bf16*yp=P.out+(grow+row)*(long)P.opitch+ch*8;
          const f32x4_t g0=*(const f32x4_t*)(P.gsub+64+ch*8), g1=*(const f32x4_t*)(P.gsub+64+ch*8+4), h0=*(const f32x4_t*)(P.gsub+ch*8), h1=*(const f32x4_t*)(P.gsub+ch*8+4);
          u32x4 w; w[0]=cvtpk_s(of[0]*rr_*g0[0],of[1]*rr_*g0[1]); w[1]=cvtpk_s(of[2]*rr_*g0[2],of[3]*rr_*g0[3]); w[2]=cvtpk_s(of[4]*rr_*g1[0],of[5]*rr_*g1[1]); w[3]=cvtpk_s(of[6]*rr_*g1[2],of[7]*rr_*g1[3]);
          *(u32x4*)(yp+64)=w;
          const u32x4 lo=*(const u32x4*)(sp-64); float lf[8];
          #pragma unroll
          for(int j=0;j<4;++j){ lf[2*j]=__uint_as_float(lo[j]<<16); lf[2*j+1]=__uint_as_float(lo[j]&0xffff0000u); }
          w[0]=cvtpk_s(lf[0]*rr_*h0[0],lf[1]*rr_*h0[1]); w[1]=cvtpk_s(lf[2]*rr_*h0[2],lf[3]*rr_*h0[3]); w[2]=cvtpk_s(lf[4]*rr_*h1[0],lf[5]*rr_*h1[1]); w[3]=cvtpk_s(lf[6]*rr_*h1[2],lf[7]*rr_*h1[3]);
          *(u32x4*)yp=w; } } } }
  asm volatile("s_waitcnt lgkmcnt(0)\n\ts_barrier":::"memory");
  #undef DMA_K
  #undef BIAS
  #undef DMA_V
  #undef CMASK
  #undef START
  #undef RESC
  #undef ROT
}
__device__ __forceinline__ void pv128(f32x16*o,int vb,bf16x8 pa0,bf16x8 pa1,bf16x8 pa2,bf16x8 pa3){
  #pragma unroll
  for(int d0=0;d0<4;++d0){s16x4 lo[4],hi[4];
    #pragma unroll
    for(int ks=0;ks<4;++ks){
      asm volatile("ds_read_b64_tr_b16 %0,%1 offset:%c2":"=&v"(lo[ks]):"v"(vb),"i"(d0*4096+ks*1024):"memory");
      asm volatile("ds_read_b64_tr_b16 %0,%1 offset:%c2":"=&v"(hi[ks]):"v"(vb),"i"(d0*4096+ks*1024+512):"memory");}
    asm volatile("s_waitcnt lgkmcnt(0)":::"memory");SBAR();
    #define PK(k) (bf16x8){lo[k][0],lo[k][1],lo[k][2],lo[k][3],hi[k][0],hi[k][1],hi[k][2],hi[k][3]}
    o[d0]=__builtin_amdgcn_mfma_f32_32x32x16_bf16(pa0,PK(0),o[d0],0,0,0);
    o[d0]=__builtin_amdgcn_mfma_f32_32x32x16_bf16(pa1,PK(1),o[d0],0,0,0);
    o[d0]=__builtin_amdgcn_mfma_f32_32x32x16_bf16(pa2,PK(2),o[d0],0,0,0);
    o[d0]=__builtin_amdgcn_mfma_f32_32x32x16_bf16(pa3,PK(3),o[d0],0,0,0);
    #undef PK
  }
}
template<int THRL> __device__ __forceinline__ void attn_unit128(const int tid_in,int b,int qb,const int MODE,const AttnP&P,char*shm){
  constexpr bool FOX=false; constexpr int LDS_V=24576, LDS_WS=73728, LDS_OST=75776, SLOTV=16384;
  int tid=tid_in; asm volatile("":"+v"(tid));
  const int lane=tid&63,r32=lane&31,hi=lane>>5; const int wid=__builtin_amdgcn_readfirstlane(tid>>6);
  const long rowbase=(long)b*SEQ; const int q0=qb*QB;
  const bf16*Qw=P.Q+(rowbase+q0+wid*QBLK)*DM;
  const bf16*Kh=P.K+rowbase*DM,*Vh=P.V+rowbase*DM;
  const unsigned lds0=(unsigned)(uintptr_t)shm;
  float*wsf=(float*)(shm+LDS_WS)+wid*64;
  const float*biasL=(const float*)(shm+LDS_BIAS);
  #define BIAS(P0,P1,t) do{ if(FOX){ const float*bb_=biasL+64*(t)+4*hi; _Pragma("unroll") for(int g_=0;g_<4;++g_){ const f32x4_t b0_=*(const f32x4_t*)(bb_+8*g_), b1_=*(const f32x4_t*)(bb_+32+8*g_); \
      _Pragma("unroll") for(int e_=0;e_<4;++e_){ P0[4*g_+e_]+=b0_[e_]; P1[4*g_+e_]+=b1_[e_]; } asm volatile("":::"memory"); } } }while(0)
  const bf16*ksrc=Kh+(long)lane*DM+wid*8;
  const bf16*vsrc=Vh+(long)(16*(wid&3)+(lane>>2))*DM+(wid>>2)*32+(lane&3)*8;
  const unsigned kdst=lds0+LDS_K+wid*1024, vdst=lds0+LDS_V+wid*1024;
  #define DMA_K(t,slot) glds16(ksrc+(long)(t)*KVBLK*DM,(unsigned)__builtin_amdgcn_readfirstlane(kdst+(slot)))
  #define DMA_V(t,slot) do{ glds16(vsrc+(long)(t)*KVBLK*DM,(unsigned)__builtin_amdgcn_readfirstlane(vdst+2*(slot))); glds16(vsrc+(long)(t)*KVBLK*DM+64,(unsigned)__builtin_amdgcn_readfirstlane(vdst+2*(slot)+8192)); }while(0)
  const int vb0=(int)(lds0+LDS_V)+((lane>>4)&1)*32+(lane&3)*8+(4*hi+((lane&15)>>2))*64;
  const char*Kbase=shm+LDS_K; bf16x8 kf[8];
  const lds_cptr shm3=(lds_cptr)shm; const lds_cptr kp0=shm3+LDS_K+hi*1024+r32*16; const lds_cptr vp0=shm3+LDS_V+((lane>>4)&1)*32+(lane&3)*8+(4*hi+((lane&15)>>2))*64;
  const int NT=(q0+QB)/KVBLK;
  DMA_K(0,0);DMA_V(0,0);DMA_K(1,SLOTB);
  bf16x8 qr[4];
  #pragma unroll
  for(int d0=0;d0<4;++d0)qr[d0]=*reinterpret_cast<const bf16x8*>(&Qw[(long)r32*DM+d0*16+hi*8]);
  float mhat=0.f,l_reg=0.f;f32x16 o[4];o[0]=f32x16{};o[1]=f32x16{};o[2]=f32x16{};o[3]=f32x16{};const f32x16 zero16=f32x16{};
  const int qrel=wid*QBLK+r32;
  #define CMASK(P0,P1,t) do{int jb_=(t)-(NT-4); if(jb_>=0)cmask(P0,P1,jb_,qrel,hi);}while(0)
  bool resc=false;
  #define START(P0,P1) do{ const float rm=rowmax(P0,P1); resc=false; \
    { const float dl=rm; mhat=fadd_s(mhat,dl); \
      _Pragma("unroll") for(int r=0;r<16;++r){P0[r]=fsub_s(P0[r],dl);P1[r]=fsub_s(P1[r],dl);} \
      } \
    _Pragma("unroll") for(int r=0;r<16;++r)P0[r]=__builtin_amdgcn_exp2f(P0[r]); }while(0)
  #define RESC() do{ if(resc){ asm volatile("s_waitcnt lgkmcnt(0)":::"memory"); \
      _Pragma("unroll") for(int d_=0;d_<4;++d_) _Pragma("unroll") for(int r=0;r<16;++r)o[d_][r]*=wsf[crow(r,hi)]; } }while(0)
  f32x16 pA0,pA1,pB0,pB1;
  int sl_prev=0,sl_cur=0,sl_next=SLOTB;
  #define ROT() do{sl_prev=sl_cur;sl_cur=sl_next;sl_next=(sl_next==(NSLOT-1)*SLOTB)?0:sl_next+SLOTB;}while(0)
  DMA_K(2,2*SLOTB);
  WAIT_BAR(4);
  qkt(pA0,pA1,Kbase,qr,zero16,r32,hi);asm volatile("s_nop 15\n\ts_nop 7":"+v"(pA0),"+v"(pA1));BIAS(pA0,pA1,0);CMASK(pA0,pA1,0);
  START(pA0,pA1);
  _Pragma("unroll") for(int r=0;r<16;++r)pA1[r]=__builtin_amdgcn_exp2f(pA1[r]);
  WAIT_BAR(0);
  DMA_K(3,0);DMA_V(1,SLOTB);
  ROT();
  kload8(kf,kp0+sl_cur);
  WAIT_BAR(3);
  s16x4 va_lo,va_hi,vb_lo,vb_hi; u32x4 pw0,pw1,pw2,pw3;
  #define PKW(P,B) cvtpk_s(P[B],P[B+1])
  #define PAF(k) __builtin_bit_cast(bf16x8,pw##k)
  #define VFA (bf16x8){va_lo[0],va_lo[1],va_lo[2],va_lo[3],va_hi[0],va_hi[1],va_hi[2],va_hi[3]}
  #define VFB (bf16x8){vb_lo[0],vb_lo[1],vb_lo[2],vb_lo[3],vb_hi[0],vb_hi[1],vb_hi[2],vb_hi[3]}
  #define PIN(x) asm volatile("":"+v"(x))
  #define MX3(a,b,c) __builtin_fmaxf(__builtin_fmaxf((a),(b)),(c))
  #define GAPA(MF,A0,A1,A2,A3,W0,W1,PW) do{ MF; sacc+=A0; sacc+=A1; sacc+=A2; sacc+=A3; PIN(sacc); W0; W1; PIN(PW); SBAR(); }while(0)
  #define EX(v) __builtin_amdgcn_exp2f((v)-mhat)
  #define VRDA(d0,ks) do{ va_lo=vtr(vp_+((d0)*4096+(ks)*1024)); va_hi=vtr(vp_+((d0)*4096+(ks)*1024+512)); }while(0)
  #define VRDB(d0,ks) do{ vb_lo=vtr(vp_+((d0)*4096+(ks)*1024)); vb_hi=vtr(vp_+((d0)*4096+(ks)*1024+512)); }while(0)
  #define KRD(G,j) do{ if(G){ kload2(kf,kp0+sl_next,j); } }while(0)
  #define GAPB(MF,RD,X,B) do{ MF; RD; X[B]=EX(X[B]); X[B+1]=EX(X[B+1]); PIN(X); SBAR(); }while(0)
  #define STEP(C0,C1,P0,P1,t,GK,GV,GL) do{ SBAR(); \
    const lds_cptr vp_=vp0+2*sl_prev; \
    float sacc=(P0[0]+P0[1]); \
    GAPA(C0=__builtin_amdgcn_mfma_f32_32x32x16_bf16(kf[0],qr[0],zero16,0,0,0), P0[2],P0[3],P0[4],P0[5],     pw0[0]=PKW(P0,0), pw0[1]=PKW(P0,2), pw0); \
    GAPA(C1=__builtin_amdgcn_mfma_f32_32x32x16_bf16(kf[1],qr[0],zero16,0,0,0), P0[6],P0[7],P0[8],P0[9],     pw0[2]=PKW(P0,4), pw0[3]=PKW(P0,6), pw0); \
    GAPA(C0=__builtin_amdgcn_mfma_f32_32x32x16_bf16(kf[2],qr[1],C0,0,0,0),   P0[10],P0[11],P0[12],P0[13], pw1[0]=PKW(P0,8), pw1[1]=PKW(P0,10), pw1); \
    GAPA(C1=__builtin_amdgcn_mfma_f32_32x32x16_bf16(kf[3],qr[1],C1,0,0,0),   P0[14],P0[15],P1[0],P1[1],   pw1[2]=PKW(P0,12),pw1[3]=PKW(P0,14), pw1); \
    GAPA(C0=__builtin_amdgcn_mfma_f32_32x32x16_bf16(kf[4],qr[2],C0,0,0,0),   P1[2],P1[3],P1[4],P1[5],     pw2[0]=PKW(P1,0), pw2[1]=PKW(P1,2), pw2); \
    GAPA(C1=__builtin_amdgcn_mfma_f32_32x32x16_bf16(kf[5],qr[2],C1,0,0,0),   P1[6],P1[7],P1[8],P1[9],     pw2[2]=PKW(P1,4), pw2[3]=PKW(P1,6), pw2); \
    VRDA(0,0); SBAR(); \
    GAPA(C0=__builtin_amdgcn_mfma_f32_32x32x16_bf16(kf[6],qr[3],C0,0,0,0),   P1[10],P1[11],P1[12],P1[13], pw3[0]=PKW(P1,8), pw3[1]=PKW(P1,10), pw3); \
    GAPA(C1=__builtin_amdgcn_mfma_f32_32x32x16_bf16(kf[7],qr[3],C1,0,0,0),   P1[14],P1[15],0.f,0.f,       pw3[2]=PKW(P1,12),pw3[3]=PKW(P1,14), pw3); \
    l_reg+=sacc; \
    if(GK){DMA_K((t)+3,sl_cur);} if(GV){DMA_V((t)+1,sl_next);} \
    CMASK(C0,C1,t); \
    { float a=MX3(C0[0],C0[1],C1[0]),b=MX3(C0[2],C0[3],C1[1]); a=MX3(a,C1[2],C1[3]); \
      _Pragma("unroll") for(int r=4;r<16;r+=4){a=MX3(a,C0[r],C0[r+1]);b=MX3(b,C0[r+2],C0[r+3]);a=MX3(a,C1[r],C1[r+1]);b=MX3(b,C1[r+2],C1[r+3]);} \
      float rm=__builtin_fmaxf(a,b); { auto rr=__builtin_amdgcn_permlane32_swap(__float_as_uint(rm),__float_as_uint(rm),false,false); rm=__builtin_fmaxf(__uint_as_float(rr[0]),__uint_as_float(rr[1])); } \
      rm-=mhat; resc=false; \
      if(__builtin_expect(__any(rm>(float)THRL),0)){ const float dl=__builtin_fmaxf(rm,0.f); mhat+=dl; \
        const float f=__builtin_amdgcn_exp2f(-dl); l_reg*=f; if(hi==0)wsf[r32]=f; resc=true; } } \
    SBAR(); \
    GAPB(o[0]=__builtin_amdgcn_mfma_f32_32x32x16_bf16(PAF(0),VFA,o[0],0,0,0), VRDB(1,0), C0,0); \
    GAPB(o[1]=__builtin_amdgcn_mfma_f32_32x32x16_bf16(PAF(0),VFB,o[1],0,0,0), VRDA(2,0), C0,2); \
    GAPB(o[2]=__builtin_amdgcn_mfma_f32_32x32x16_bf16(PAF(0),VFA,o[2],0,0,0), VRDB(3,0), C0,4); \
    GAPB(o[3]=__builtin_amdgcn_mfma_f32_32x32x16_bf16(PAF(0),VFB,o[3],0,0,0), VRDA(0,1), C0,6); \
    KRD(GL,0); GAPB(o[0]=__builtin_amdgcn_mfma_f32_32x32x16_bf16(PAF(1),VFA,o[0],0,0,0), VRDB(1,1), C0,8); \
    GAPB(o[1]=__builtin_amdgcn_mfma_f32_32x32x16_bf16(PAF(1),VFB,o[1],0,0,0), VRDA(2,1), C0,10); \
    KRD(GL,1); GAPB(o[2]=__builtin_amdgcn_mfma_f32_32x32x16_bf16(PAF(1),VFA,o[2],0,0,0), VRDB(3,1), C0,12); \
    GAPB(o[3]=__builtin_amdgcn_mfma_f32_32x32x16_bf16(PAF(1),VFB,o[3],0,0,0), VRDA(0,2), C0,14); \
    KRD(GL,2); GAPB(o[0]=__builtin_amdgcn_mfma_f32_32x32x16_bf16(PAF(2),VFA,o[0],0,0,0), VRDB(1,2), C1,0); \
    GAPB(o[1]=__builtin_amdgcn_mfma_f32_32x32x16_bf16(PAF(2),VFB,o[1],0,0,0), VRDA(2,2), C1,2); \
    KRD(GL,3); GAPB(o[2]=__builtin_amdgcn_mfma_f32_32x32x16_bf16(PAF(2),VFA,o[2],0,0,0), VRDB(3,2), C1,4); \
    GAPB(o[3]=__builtin_amdgcn_mfma_f32_32x32x16_bf16(PAF(2),VFB,o[3],0,0,0), VRDA(0,3), C1,6); \
    GAPB(o[0]=__builtin_amdgcn_mfma_f32_32x32x16_bf16(PAF(3),VFA,o[0],0,0,0), VRDB(1,3), C1,8); \
    GAPB(o[1]=__builtin_amdgcn_mfma_f32_32x32x16_bf16(PAF(3),VFB,o[1],0,0,0), VRDA(2,3), C1,10); \
    GAPB(o[2]=__builtin_amdgcn_mfma_f32_32x32x16_bf16(PAF(3),VFA,o[2],0,0,0), VRDB(3,3), C1,12); \
    GAPB(o[3]=__builtin_amdgcn_mfma_f32_32x32x16_bf16(PAF(3),VFB,o[3],0,0,0), (void)0, C1,14); \
    }while(0)
  int t=1;
  #undef CMASK
  #define CMASK(P0,P1,t) do{}while(0)
  for(;t+5<NT;t+=2){
    STEP(pB0,pB1,pA0,pA1,t,true,true,true);     WAIT_BAR(3); RESC(); ROT();
    STEP(pA0,pA1,pB0,pB1,t+1,true,true,true);   WAIT_BAR(3); RESC(); ROT();
  }
  #undef CMASK
  #define CMASK(P0,P1,t) do{int jb_=(t)-(NT-4); if(jb_>=0)cmask(P0,P1,jb_,qrel,hi);}while(0)
  #define ENDW(tt) do{ if((tt)+3<NT){WAIT_BAR(3);} else if((tt)+2<NT){WAIT_BAR(2);} else {WAIT_BAR(0);} }while(0)
  for(;t+1<NT;t+=2){
    STEP(pB0,pB1,pA0,pA1,t,(t+3<NT),(t+1<NT),(t+1<NT));       ENDW(t);   RESC(); ROT();
    STEP(pA0,pA1,pB0,pB1,t+1,(t+4<NT),(t+2<NT),(t+2<NT));     ENDW(t+1); RESC(); ROT();
  }
  STEP(pB0,pB1,pA0,pA1,NT-1,false,false,false); RESC();
  { float sacc=pB0[0]+pB0[1]; _Pragma("unroll") for(int r=2;r<16;++r)sacc+=pB0[r]; _Pragma("unroll") for(int r=0;r<16;++r)sacc+=pB1[r]; l_reg+=sacc;
    pw0=(u32x4){PKW(pB0,0),PKW(pB0,2),PKW(pB0,4),PKW(pB0,6)};pw1=(u32x4){PKW(pB0,8),PKW(pB0,10),PKW(pB0,12),PKW(pB0,14)};pw2=(u32x4){PKW(pB1,0),PKW(pB1,2),PKW(pB1,4),PKW(pB1,6)};pw3=(u32x4){PKW(pB1,8),PKW(pB1,10),PKW(pB1,12),PKW(pB1,14)};
    SBAR(); pv128(o,vb0+2*sl_cur,PAF(0),PAF(1),PAF(2),PAF(3)); }
  #undef PKW
  #undef PAF
  #undef VFA
  #undef VFB
  #undef VRDA
  #undef VRDB
  #undef PIN
  #undef MX3
  #undef GAPA
  #undef GAPB
  #undef EX
  #undef KRD
  #undef STEP
  #undef ENDW
  {auto rr=__builtin_amdgcn_permlane32_swap(__float_as_uint(l_reg),__float_as_uint(l_reg),false,false);l_reg=__uint_as_float(rr[0])+__uint_as_float(rr[1]);}
  if(hi==0)wsf[32+r32]=l_reg;asm volatile("s_waitcnt lgkmcnt(0)":::"memory");
  float rli[16];
  #pragma unroll
  for(int r=0;r<16;++r)rli[r]=__builtin_amdgcn_rcpf(wsf[32+crow(r,hi)]);
  { hbf16*stg=(hbf16*)(shm+LDS_OST)+wid*2048;
    const long grow=rowbase+q0+wid*QBLK;
    int lane_e=lane; asm volatile("":"+v"(lane_e));
    float of[2][4][8]; float ssr[4]={0.f,0.f,0.f,0.f};
    #pragma unroll
    for(int hf=0;hf<2;++hf){
      #pragma unroll
      for(int r=0;r<16;++r){const int orow=crow(r,hi);
        #pragma unroll
        for(int d0=0;d0<2;++d0)stg[orow*64+d0*32+r32]=__float2bfloat16(o[2*hf+d0][r]*rli[r]);}
      asm volatile("s_waitcnt lgkmcnt(0)":::"memory");
      #pragma unroll
      for(int i=0;i<4;++i){const int row=i*8+(lane_e>>3),ch=lane_e&7; const u32x4 v=*(const u32x4*)(stg+row*64+ch*8);
        if(MODE==0){ *(u32x4*)(P.out+(grow+row)*(long)P.opitch+hf*64+ch*8)=v; }
        else { const u32x4 a=*(const u32x4*)(P.stash+(grow+row)*512+hf*64+ch*8); float ss=0.f;
          #pragma unroll
          for(int j=0;j<4;++j){ const float a0=__uint_as_float(a[j]<<16),a1=__uint_as_float(a[j]&0xffff0000u),c0=__uint_as_float(v[j]<<16),c1=__uint_as_float(v[j]&0xffff0000u);
            of[hf][i][2*j]=a0-P.lam*c0; of[hf][i][2*j+1]=a1-P.lam*c1; ss+=of[hf][i][2*j]*of[hf][i][2*j]+of[hf][i][2*j+1]*of[hf][i][2*j+1]; }
          ssr[i]+=ss; } }
      asm volatile("s_waitcnt lgkmcnt(0)":::"memory");
    }
    if(MODE!=0){
      #pragma unroll
      for(int i=0;i<4;++i){const int row=i*8+(lane_e>>3),ch=lane_e&7; float ss=ssr[i];
        ss+=__int_as_float(__builtin_amdgcn_ds_swizzle(__float_as_int(ss),0x041f)); ss+=__int_as_float(__builtin_amdgcn_ds_swizzle(__float_as_int(ss),0x081f)); ss+=__int_as_float(__builtin_amdgcn_ds_swizzle(__float_as_int(ss),0x101f));
        const float rr_=rsqrtf(ss*(1.0f/128.0f)+1e-6f)*P.nscale; bf16*yp=P.out+(grow+row)*(long)P.opitch+ch*8;
        #pragma unroll
        for(int hf=0;hf<2;++hf){ const f32x4_t g0=*(const f32x4_t*)(P.gsub+hf*64+ch*8), g1=*(const f32x4_t*)(P.gsub+hf*64+ch*8+4); u32x4 w;
          w[0]=cvtpk_s(of[hf][i][0]*rr_*g0[0],of[hf][i][1]*rr_*g0[1]); w[1]=cvtpk_s(of[hf][i][2]*rr_*g0[2],of[hf][i][3]*rr_*g0[3]); w[2]=cvtpk_s(of[hf][i][4]*rr_*g1[0],of[hf][i][5]*rr_*g1[1]); w[3]=cvtpk_s(of[hf][i][6]*rr_*g1[2],of[hf][i][7]*rr_*g1[3]);
          *(u32x4*)(yp+hf*64)=w; } } } }
  asm volatile("s_waitcnt lgkmcnt(0)\n\ts_barrier":::"memory");
  #undef DMA_K
  #undef BIAS
  #undef DMA_V
  #undef CMASK
  #undef START
  #undef RESC
  #undef ROT
}
constexpr int ATTN_LDS_BYTES=LDS_BYTES;
#undef SBAR
#undef WAIT_BAR
}
#ifndef MK_MU8
#define MK_MU8 0
#endif
#ifndef MK_PLE8
#define MK_PLE8 0
#endif
#define GAS __attribute__((address_space(1)))
#define LAS __attribute__((address_space(3)))
typedef unsigned v4u __attribute__((ext_vector_type(4)));
typedef float f32x4 __attribute__((ext_vector_type(4)));
typedef GAS unsigned gu32;
#define RLX_AGENT __ATOMIC_RELAXED, __HIP_MEMORY_SCOPE_AGENT
#define LDS_WAIT() asm volatile("s_waitcnt lgkmcnt(0)" ::: "memory")
#define VM_WAIT() asm volatile("s_waitcnt vmcnt(0)" ::: "memory")
constexpr int NWAVES = 8;
constexpr size_t W_IN = 0;
constexpr size_t W_CAT = W_IN + (size_t)3840 * 1024 * 2;
constexpr size_t W_G8 = W_CAT;
constexpr size_t W_BR = W_CAT + (size_t)3 * 1024 * 1024;
constexpr float G8_SCALE = 128.0f;
constexpr size_t W_OUT = W_CAT + (size_t)3 * 1024 * 1536 * 2;
constexpr size_t W_GU = W_OUT + (size_t)1024 * 1024 * 2;
constexpr size_t W_D = W_GU + (size_t)16 * 512 * 1024 * 2;
constexpr size_t W_RH = W_D + (size_t)16 * 1024 * 256 * 2;
constexpr size_t W_RL = W_RH + 65536;
constexpr size_t W_ENDB = W_RL + 65536;
static_assert(WS_W + W_ENDB <= WS_SSB && WS_SSB + MiB <= WS_WPLE, "weight map");
constexpr size_t W_PG = 0, W_P = (size_t)1024 * 1024 * 2, WPLE_STRIDE = (size_t)5 * 512 * 1024;
constexpr size_t OUT_XB8 = 0, OUT_GATES = 16 * MiB;
constexpr size_t OV_PB = WS_PB;
constexpr size_t OV_PW = WS_PROJ + 8 * MiB;
constexpr size_t OV_ACT = WS_PROJ + 40 * MiB;
constexpr size_t OV_XB2 = WS_PROJ + 64 * MiB;
constexpr int RING_BYTES = 131072, MISC_OFF = RING_BYTES, LDS_BYTES = 147456;
constexpr int MI_N = 0, MI_BASE = 32, MI_U0 = 64, MI_TOT = 96, MI_Q = 100, MI_BAR = 104;

__device__ __forceinline__ unsigned pk2(float lo, float hi) { typedef float f2 __attribute__((ext_vector_type(2))); typedef __bf16 b2 __attribute__((ext_vector_type(2))); f2 v = {lo, hi}; b2 b = __builtin_convertvector(v, b2); return __builtin_bit_cast(unsigned, b); }
__device__ __forceinline__ float bflo(unsigned u) { return __uint_as_float(u << 16); }
__device__ __forceinline__ float bfhi(unsigned u) { return __uint_as_float(u & 0xffff0000u); }
__device__ __forceinline__ float sigm(float v) { return __builtin_amdgcn_rcpf(1.0f + __expf(-v)); }
__device__ __forceinline__ float sg2(float t) { return __builtin_amdgcn_rcpf(1.0f + __builtin_amdgcn_exp2f(t)); }
__device__ __forceinline__ float clamp8(float v) { return __builtin_amdgcn_fmed3f(v, -448.0f, 448.0f); }
__device__ __forceinline__ unsigned pk_fp8x4(float a, float b, float c, float d) {
    int w = __builtin_amdgcn_cvt_pk_fp8_f32(clamp8(a), clamp8(b), 0, false); w = __builtin_amdgcn_cvt_pk_fp8_f32(clamp8(c), clamp8(d), w, true); return (unsigned)w; }

#define XOR1(v) __int_as_float(__builtin_amdgcn_ds_swizzle(__float_as_int(v), 0x041f))
#define XOR2(v) __int_as_float(__builtin_amdgcn_ds_swizzle(__float_as_int(v), 0x081f))
#define XOR4(v) __int_as_float(__builtin_amdgcn_ds_swizzle(__float_as_int(v), 0x101f))
#define XOR8(v) __int_as_float(__builtin_amdgcn_ds_swizzle(__float_as_int(v), 0x201f))
#define XOR16(v) __int_as_float(__builtin_amdgcn_ds_swizzle(__float_as_int(v), 0x401f))
__device__ __forceinline__ float add_xor32(float v) { const auto r = __builtin_amdgcn_permlane32_swap(__float_as_uint(v), __float_as_uint(v), false, false); return __uint_as_float(r[0]) + __uint_as_float(r[1]); }
__device__ __forceinline__ float wave_sum64(float v) { v += XOR1(v); v += XOR2(v); v += XOR4(v); v += XOR8(v); v += XOR16(v); return add_xor32(v); }
__device__ __forceinline__ int mk_tid(int wave0) { int l; asm volatile("v_mbcnt_lo_u32_b32 %0, -1, 0\n\tv_mbcnt_hi_u32_b32 %0, -1, %0" : "=v"(l)); return wave0 * 64 + l; }

#define XB_TMO      128
#define XB_XCNT(j)  (256  + 64 * (j))
#define XB_XSUB(j)  (1280 + 64 * (j))
#define XB_XGEN(j)  (2304 + 64 * (j))
#define XB_TOP      3328
#define XB_TOPGEN   3392
#define XCD_BAR_WORDS 3456
#define XB_SPIN_CAP (1u << 18)
__device__ __forceinline__ unsigned xb_ld(unsigned* p)              { return __hip_atomic_load(p, __ATOMIC_RELAXED, __HIP_MEMORY_SCOPE_AGENT); }
__device__ __forceinline__ unsigned xb_add(unsigned* p, unsigned v) { return __hip_atomic_fetch_add(p, v, __ATOMIC_RELAXED, __HIP_MEMORY_SCOPE_AGENT); }
__device__ __forceinline__ unsigned xb_xcc_id() { return (unsigned)__builtin_amdgcn_s_getreg((3 << 11) | 20) & 0xFu; }
#define XB_SPIN(cond, bar) do { unsigned _sp = 0; while (cond) { __builtin_amdgcn_s_sleep(1); \
    if ((++_sp & 255u) == 0u) { if (xb_ld(&(bar)[XB_TMO])) break; if (_sp > XB_SPIN_CAP) { atomicAdd(&(bar)[XB_TMO], 1u); break; } } } } while (0)
struct XcdBarrier { unsigned* bar; unsigned x; volatile LAS unsigned* st; };
__device__ __forceinline__ XcdBarrier xcd_barrier_post(unsigned* bar, volatile LAS unsigned* st, int tid) {
    XcdBarrier b; b.bar = bar; b.x = xb_xcc_id(); b.st = st;
    if (tid == 0) (void)xb_add(&bar[XB_XCNT(b.x)], 1u);
    return b;
}
__device__ __forceinline__ void xcd_barrier_complete(unsigned* bar, unsigned x, unsigned& nloc, unsigned& nx) {
    const unsigned G = gridDim.x * gridDim.y * gridDim.z;
    unsigned sum, cnt, mine, sp = 0u;
    for (;;) {
        sum = 0u; cnt = 0u; mine = 0u;
#pragma unroll
        for (unsigned j = 0; j < 16; ++j) { const unsigned c = xb_ld(&bar[XB_XCNT(j)]); sum += c; cnt += (c > 0u) ? 1u : 0u; mine = (j == x) ? c : mine; }
        if (sum == G) break;
        __builtin_amdgcn_s_sleep(1);
        if ((++sp & 255u) == 0u) { if (xb_ld(&bar[XB_TMO])) break; if (sp > XB_SPIN_CAP) { atomicAdd(&bar[XB_TMO], 1u); break; } }
    }
    nloc = mine > 0u ? mine : 1u; nx = cnt > 0u ? cnt : 1u;
}
#ifndef MK_EARLYINV
#define MK_EARLYINV 1
#endif
#ifndef MK_SPLIT_SLEEP
#define MK_SPLIT_SLEEP 16
#endif
__device__ __forceinline__ void xcd_barrier(const XcdBarrier& b, int tid) {
    asm volatile("s_waitcnt vmcnt(0)" ::: "memory");
    __syncthreads();
    if (tid == 0) {
        unsigned* bar = b.bar;
        __builtin_amdgcn_s_waitcnt(0);
        unsigned nloc = b.st[0], nx = b.st[1];
        if (nloc == 0u) { xcd_barrier_complete(bar, b.x, nloc, nx); b.st[0] = nloc; b.st[1] = nx; }
        const unsigned old = xb_add(&bar[XB_XSUB(b.x)], 1u);
        const unsigned gen = old / nloc;
        if (old + 1u == (gen + 1u) * nloc) {
            __builtin_amdgcn_fence(__ATOMIC_RELEASE, "agent");
            asm volatile("s_waitcnt vmcnt(0)" ::: "memory");
            const unsigned og = xb_add(&bar[XB_TOP], 1u);
            unsigned tg = og / nx; asm volatile("" : "+v"(tg) :: "memory");
            if (og + 1u == (tg + 1u) * nx) { xb_add(&bar[XB_TOPGEN], 1u);
#if MK_EARLYINV
                xb_add(&bar[XB_XGEN(b.x)], 1u); asm volatile("buffer_inv sc1" ::: "memory");
#endif
            } else {
#if MK_EARLYINV
                asm volatile("buffer_inv sc1" ::: "memory");
#endif
                XB_SPIN(xb_ld(&bar[XB_TOPGEN]) == tg, bar);
#if MK_EARLYINV
                xb_add(&bar[XB_XGEN(b.x)], 1u);
#endif
            }
#if !MK_EARLYINV
            __builtin_amdgcn_fence(__ATOMIC_ACQUIRE, "agent");
            xb_add(&bar[XB_XGEN(b.x)], 1u);
#endif
            asm volatile("s_waitcnt vmcnt(0)" ::: "memory");
        } else {
#if MK_EARLYINV
            { unsigned g2 = gen; asm volatile("" : "+v"(g2) :: "memory"); asm volatile("buffer_inv sc1" ::: "memory");
              XB_SPIN(xb_ld(&bar[XB_XGEN(b.x)]) == g2, bar); }
#else
            XB_SPIN(xb_ld(&bar[XB_XGEN(b.x)]) == gen, bar);
            __builtin_amdgcn_fence(__ATOMIC_ACQUIRE, "agent");
#endif
            asm volatile("s_waitcnt vmcnt(0)" ::: "memory");
        }
    }
    __syncthreads();
}

__device__ __forceinline__ void split_arrive(unsigned* cnt, int tid) {
    asm volatile("s_waitcnt vmcnt(0)" ::: "memory"); __syncthreads();
    if (tid == 0) { __builtin_amdgcn_fence(__ATOMIC_RELEASE, "agent"); asm volatile("s_waitcnt vmcnt(0)" ::: "memory"); xb_add(cnt, 1u); }
}
__device__ __forceinline__ void split_arrive_x(const XcdBarrier& b, unsigned* cnt_top, unsigned* cnt_x, int tid) {
    asm volatile("s_waitcnt vmcnt(0)" ::: "memory"); __syncthreads();
    if (tid == 0) { const unsigned nloc = b.st[0]; const unsigned old = xb_add(cnt_x + 8u * b.x, 1u);
        if (old + 1u == nloc) { __builtin_amdgcn_fence(__ATOMIC_RELEASE, "agent"); asm volatile("s_waitcnt vmcnt(0)" ::: "memory"); xb_add(cnt_top, nloc); }
#if MK_EARLYINV
        asm volatile("buffer_inv sc1" ::: "memory");
#endif
    }
}
__device__ __forceinline__ void split_wait_leader(unsigned* cnt, unsigned target) {
    unsigned sp = 0; while (xb_ld(cnt) < target) { __builtin_amdgcn_s_sleep(MK_SPLIT_SLEEP); if (++sp > (1u << 22)) break; }
#if !MK_EARLYINV
    __builtin_amdgcn_fence(__ATOMIC_ACQUIRE, "agent");
#endif
    asm volatile("s_waitcnt vmcnt(0)" ::: "memory");
}

__device__ __forceinline__ void group4_sync(unsigned* gc, int tid) {
    asm volatile("s_waitcnt vmcnt(0)" ::: "memory"); __syncthreads();
    if (tid == 0) { const unsigned sh = 8u + 3u * xb_xcc_id();
        xb_add(gc, 1u + (1u << sh));
        asm volatile("buffer_inv sc1" ::: "memory");
        unsigned sp = 0, v = 0; for (;;) { v = xb_ld(gc); if ((v & 0xffu) >= 4u) break; __builtin_amdgcn_s_sleep(1); if (++sp > (1u << 22)) break; }
        if (((v >> sh) & 7u) != 4u) {
            __builtin_amdgcn_fence(__ATOMIC_RELEASE, "agent"); asm volatile("s_waitcnt vmcnt(0)" ::: "memory");
            xb_add(gc + 16, 1u); sp = 0; while (xb_ld(gc + 16) < 4u) { __builtin_amdgcn_s_sleep(1); if (++sp > (1u << 22)) break; }
            __builtin_amdgcn_fence(__ATOMIC_ACQUIRE, "agent"); }
        asm volatile("s_waitcnt vmcnt(0)" ::: "memory"); }
    __syncthreads();
}

struct Args { const void* in[27]; float* out; unsigned char* ws; int ph_lo, ph_hi, li, pad; };
struct LayerW {
    const float *g_attn, *w_in, *pool_w, *pool_scale, *dqn, *dkn, *dlam, *dsub, *fqn, *fkn, *ffb, *w_branch, *w_out, *g_ffn, *wrg, *brg, *wre, *bre, *wg, *wu, *wd, *g_ple, *wpg, *wple, *p;
};
__device__ __forceinline__ LayerW layer_view(const __attribute__((address_space(4))) Args* a, int l) {
    LayerW w; const float* in[27];
#pragma unroll
    for (int i = 0; i < 27; ++i) in[i] = (const float*)a->in[i];
    w.g_attn = in[3] + l * 1024; w.w_in = in[4] + (size_t)l * 1024 * INW; w.pool_w = in[5] + (size_t)l * 65536; w.pool_scale = in[6] + l * 512;
    w.dqn = in[7] + l * 64; w.dkn = in[8] + l * 64; w.dlam = in[9] + l * 256; w.dsub = in[10] + l * 128; w.fqn = in[11] + l * 64; w.fkn = in[12] + l * 64; w.ffb = in[13] + l * 8;
    w.w_branch = in[14] + (size_t)l * 3 * 512 * 1024; w.w_out = in[15] + (size_t)l * 1024 * 1024; w.g_ffn = in[16] + l * 1024; w.wrg = in[17] + (size_t)l * 4096; w.brg = in[18] + l * 4;
    w.wre = in[19] + (size_t)l * 16384; w.bre = in[20] + l * 16; w.wg = in[21] + (size_t)l * 16 * 262144; w.wu = in[22] + (size_t)l * 16 * 262144; w.wd = in[23] + (size_t)l * 16 * 262144;
    w.g_ple = in[24] + l * 1024; w.wpg = in[25] + (size_t)l * 1024 * 1024; w.wple = in[26] + (size_t)l * 256 * 1024; w.p = in[1] + (size_t)l * T * 256;
    return w;
}

__device__ __forceinline__ void tr_item(const float* __restrict__ src, int ldsrc, int c0, int nvalid, int k0, const float* __restrict__ gk, bf16* dst, int dpitch, int nrow0, int dk0, LAS float* scr, int lane, const bool f8 = false) {
    float vv[32];
#pragma unroll
    for (int i = 0; i < 32; ++i) { const int kk = 2 * i + (lane >> 5), c = lane & 31; vv[i] = (c < nvalid) ? src[(size_t)(k0 + kk) * ldsrc + c0 + c] : 0.f; }
    if (gk) {
#pragma unroll
        for (int i = 0; i < 32; ++i) vv[i] *= gk[k0 + 2 * i + (lane >> 5)]; }
#pragma unroll
    for (int i = 0; i < 32; ++i) scr[(2 * i + (lane >> 5)) * 33 + (lane & 31)] = vv[i];
    LDS_WAIT(); asm volatile("" ::: "memory");
    const int c8 = lane & 7;
#pragma unroll
    for (int j = 0; j < 4; ++j) { const int n = (lane >> 3) + 8 * j; const LAS float* s = scr + (8 * c8) * 33 + n;
        if (f8) { typedef unsigned v2u_ __attribute__((ext_vector_type(2))); v2u_ o;
            o.x = pk_fp8x4(s[0 * 33] * G8_SCALE, s[1 * 33] * G8_SCALE, s[2 * 33] * G8_SCALE, s[3 * 33] * G8_SCALE); o.y = pk_fp8x4(s[4 * 33] * G8_SCALE, s[5 * 33] * G8_SCALE, s[6 * 33] * G8_SCALE, s[7 * 33] * G8_SCALE);
            *(GAS v2u_*)((GAS char*)dst + (size_t)(nrow0 + n) * dpitch + dk0 + 8 * c8) = o; }
        else { v4u o; o.x = pk2(s[0 * 33], s[1 * 33]); o.y = pk2(s[2 * 33], s[3 * 33]); o.z = pk2(s[4 * 33], s[5 * 33]); o.w = pk2(s[6 * 33], s[7 * 33]);
            *(GAS v4u*)(dst + (size_t)(nrow0 + n) * dpitch + dk0 + 8 * c8) = o; } }
    LDS_WAIT(); asm volatile("" ::: "memory");
}
constexpr int CV_EARLY = 1536 + 128 + 1536 + 768, CV_NIT = CV_EARLY + 512 + 4096 + 2048 + 512 + 128, CV_LATE_BATCHES = (CV_NIT - CV_EARLY + 7) / 8, CV_RT_BATCHES = 64, CV_PB_BATCHES = 64;
__device__ __forceinline__ void conv_item(const LayerW& w, unsigned char* ws, int l, int it, LAS float* scr, int lane) {
    bf16* Wb = (bf16*)(ws + WS_W); bf16* WIN = (bf16*)(ws + WS_W + W_IN); bf16* WOUT = (bf16*)(ws + WS_W + W_OUT);
    bf16* WGU = (bf16*)(ws + WS_W + W_GU); bf16* WDN = (bf16*)(ws + WS_W + W_D); bf16* WPG = (bf16*)(ws + WS_WPLE + l * WPLE_STRIDE + W_PG); bf16* WP = (bf16*)(ws + WS_WPLE + l * WPLE_STRIDE + W_P);
    (void)Wb;
    constexpr int I_A = 1536, I_B = 128, I_D1 = 1536, I_D2 = 768, I_E = 512, I_F = 4096, I_G = 2048, I_H1 = 512, I_H2 = 128;
    constexpr int NIT = I_A + I_B + I_D1 + I_D2 + I_E + I_F + I_G + I_H1 + I_H2;
    int r = it;
        if (r < I_A) { const int kb = r / 96, nb = r % 96, p0 = 512 + 32 * nb, pn = p0 >> 8, q0 = p0 & 255;
            const bool head = (pn >= 2 && pn <= 5) || (pn >= 8 && pn <= 11);
            const int c0 = head ? (256 * pn + 64 * ((q0 >> 5) & 3) + 32 * (q0 >> 7)) : p0;
            tr_item(w.w_in, INW, c0, 32, 64 * kb, w.g_attn, WIN, 1024, p0, 64 * kb, scr, lane); return; } r -= I_A;
        if (r < I_B) { const int kb = r / 8, nb = r % 8; tr_item(w.w_in, INW, 3584, nb == 0 ? 8 : 0, 64 * kb, w.g_attn, WIN, 1024, 3584 + 32 * nb, 64 * kb, scr, lane); return; } r -= I_B;
        if (r < I_D1) { const int n = r / 512, r2 = r % 512, kb = r2 / 32, nb = r2 % 32;
            tr_item(w.w_in, INW, 3592 + n * 1024 + 32 * nb, 32, 64 * kb, w.g_attn, (bf16*)(ws + WS_W + W_G8 + (size_t)n * 1024 * 1024), 1024, 32 * nb, 64 * kb, scr, lane, true); return; } r -= I_D1;
        if (r < I_D2) { const int n = r / 256, r2 = r % 256, kb = r2 / 32, nb = r2 % 32;
            tr_item(w.w_branch + (size_t)n * 512 * 1024, 1024, 32 * nb, 32, 64 * kb, nullptr, (bf16*)(ws + WS_W + W_BR) + (size_t)n * 1024 * 512, 512, 32 * nb, 64 * kb, scr, lane); return; } r -= I_D2;
        if (r < I_E) { const int kb = r / 32, nb = r % 32; tr_item(w.w_out, 1024, 32 * nb, 32, 64 * kb, nullptr, WOUT, 1024, 32 * nb, 64 * kb, scr, lane); return; } r -= I_E;
        if (r < I_F) { const int e = r / 256, r1 = r % 256, hf = r1 / 128, r2 = r1 % 128, kb = r2 / 8, nb = r2 % 8, q0 = 32 * nb;
            const float* src = ((q0 >> 7) ? w.wu : w.wg) + (size_t)e * 262144;
            const bool f8 = MK_MU8 && l == NL - 1;
            tr_item(src, 256, 128 * hf + (q0 & 127), 32, 64 * kb, w.g_ffn, f8 ? (bf16*)((unsigned char*)WGU + (size_t)(e * 2 + hf) * 256 * 1024) : WGU + (size_t)(e * 2 + hf) * 256 * 1024, 1024, q0, 64 * kb, scr, lane, f8); return; } r -= I_F;
        if (r < I_G) { const int e = r / 128, r2 = r % 128, kb = r2 / 32, nb = r2 % 32;
            tr_item(w.wd + (size_t)e * 262144, 1024, 32 * nb, 32, 64 * kb, nullptr, WDN + (size_t)e * 262144, 256, 32 * nb, 64 * kb, scr, lane); return; } r -= I_G;
        if (r < I_H1) { const int kb = r / 32, nb = r % 32; tr_item(w.wpg, 1024, 32 * nb, 32, 64 * kb, w.g_ple, WPG, 1024, 32 * nb, 64 * kb, scr, lane, MK_PLE8 != 0); return; } r -= I_H1;
        { const int kb = r / 32, nb = r % 32; tr_item(w.wple, 1024, 32 * nb, 32, 64 * kb, nullptr, WP, 256, 32 * nb, 64 * kb, scr, lane); }
}
__device__ __forceinline__ void conv_late_batch(const LayerW& w, unsigned char* ws, int l, LAS unsigned char* lds, int batch, int tid) {
    const int lane = tid & 63, wave = __builtin_amdgcn_readfirstlane(tid >> 6);
    if (batch < CV_LATE_BATCHES) { const int it = CV_EARLY + batch * 8 + wave; if (it < CV_NIT) conv_item(w, ws, l, it, (LAS float*)(lds + wave * 16384), lane); }
    else if (batch >= CV_LATE_BATCHES + CV_RT_BATCHES) {
        const int i0 = (batch - CV_LATE_BATCHES - CV_RT_BATCHES) * 8192 + tid; GAS v4u* PB = (GAS v4u*)(ws + OV_PB);
#pragma clang loop unroll(disable)
        for (int q0 = 0; q0 < 16; q0 += 4) { f32x4 a[4], b[4];
#pragma unroll
            for (int q = 0; q < 4; ++q) { const GAS f32x4* s = (const GAS f32x4*)(w.p) + 2 * (size_t)(i0 + (q0 + q) * 512); a[q] = s[0]; b[q] = s[1]; }
#pragma unroll
            for (int q = 0; q < 4; ++q) { v4u o; o.x = pk2(a[q].x, a[q].y); o.y = pk2(a[q].z, a[q].w); o.z = pk2(b[q].x, b[q].y); o.w = pk2(b[q].z, b[q].w); PB[i0 + (q0 + q) * 512] = o; } } }
    else { const int idx = (batch - CV_LATE_BATCHES) * 512 + tid; const int e = idx >> 10, k = idx & 1023;
        const float v = w.g_ffn[k] * (e < 4 ? w.wrg[k * 4 + e] : (e < 20 ? w.wre[k * 16 + e - 4] : 0.f));
        const unsigned hi = pk2(v, 0.f) & 0xffffu; const unsigned lo = pk2(v - bflo(hi), 0.f) & 0xffffu;
        ((bf16*)(ws + WS_W + W_RH))[idx] = (bf16)hi; ((bf16*)(ws + WS_W + W_RL))[idx] = (bf16)lo; }
}
__device__ __forceinline__ void weff_job(const LayerW& w, unsigned char* ws, LAS unsigned char* lds, int job, int tid) {
    bf16* WIN = (bf16*)(ws + WS_W + W_IN);
    LAS float* Wt = (LAS float*)lds; LAS float* Pw = (LAS float*)(lds + 36864);
    const int kb = job >> 4, g = (job >> 2) & 3, nq = job & 3, k0 = 64 * kb;
    for (int e = tid; e < 64 * 128; e += 512) { const int kk = e >> 7, c = e & 127; Wt[kk * 132 + c] = w.w_in[(size_t)(k0 + kk) * INW + 128 * g + c]; }
    for (int e = tid; e < 128 * 32; e += 512) { const int c = e >> 5, n = e & 31; Pw[c * 32 + n] = w.pool_w[(size_t)g * 16384 + c * 128 + 32 * nq + n]; }
    __syncthreads();
    const int n = tid & 31, ks = tid >> 5; float a[4] = {0.f, 0.f, 0.f, 0.f};
#pragma unroll 2
    for (int c = 0; c < 128; c += 4) {
        const float p0 = Pw[c * 32 + n], p1 = Pw[(c + 1) * 32 + n], p2 = Pw[(c + 2) * 32 + n], p3 = Pw[(c + 3) * 32 + n];
#pragma unroll
        for (int i = 0; i < 4; ++i) { const f32x4 w4 = *(const LAS f32x4*)(Wt + (ks * 4 + i) * 132 + c); a[i] += (w4.x * p0 + w4.y * p1) + (w4.z * p2 + w4.w * p3); } }
    const float sc = w.pool_scale[128 * g + 32 * nq + n];
#pragma unroll
    for (int i = 0; i < 4; ++i) a[i] *= sc * w.g_attn[k0 + ks * 4 + i];
    *(GAS unsigned long long*)(WIN + (size_t)(128 * g + 32 * nq + n) * 1024 + k0 + ks * 4) = (unsigned long long)pk2(a[0], a[1]) | ((unsigned long long)pk2(a[2], a[3]) << 32);
    __syncthreads();
}
__device__ __forceinline__ void conv_layer(const LayerW& w, unsigned char* ws, int l, LAS unsigned char* lds, int vcu, int G, int tid) {
    const int lane = tid & 63, wave = __builtin_amdgcn_readfirstlane(tid >> 6);
    LAS float* scr = (LAS float*)(lds + wave * 16384);
    const int gw = vcu * NWAVES + wave, NGW = G * NWAVES;
    for (int it = gw; it < CV_EARLY; it += NGW) conv_item(w, ws, l, it, scr, lane);
    __syncthreads();
    for (int job = vcu; job < 256; job += G) weff_job(w, ws, lds, job, tid);
}
constexpr int CV_EARLY_BATCHES = CV_EARLY / 8 + 256;
__device__ __forceinline__ void conv_early_batch(const LayerW& w, unsigned char* ws, int l, LAS unsigned char* lds, int batch, int tid) {
    const int lane = tid & 63, wave = __builtin_amdgcn_readfirstlane(tid >> 6);
    if (batch < CV_EARLY / 8) { conv_item(w, ws, l, batch * 8 + wave, (LAS float*)(lds + wave * 16384), lane); __syncthreads(); }
    else weff_job(w, ws, lds, batch - CV_EARLY / 8, tid);
}
__device__ __forceinline__ void p0_x(const float* x, const int* positions, unsigned char* ws, unsigned char* x8, int vcu, int G, int tid) {
    const int lane = tid & 63, wave = __builtin_amdgcn_readfirstlane(tid >> 6);
    bf16* XY = (bf16*)(ws + WS_XY); float* SS = (float*)(ws + WS_SS); float* CS = (float*)(ws + WS_COSSIN);
    const int gw = vcu * NWAVES + wave, NGW = G * NWAVES;
    for (int t = gw; t < T; t += NGW) {
        const GAS f32x4* xr = (const GAS f32x4*)(x + (size_t)t * 1024) + lane; float s = 0.f;
        GAS unsigned long long* o8 = (GAS unsigned long long*)(XY + (size_t)t * XYP + 1536) + lane;
#pragma unroll
        for (int j = 0; j < 4; ++j) { const f32x4 v = xr[64 * j]; s += (v.x * v.x + v.y * v.y) + (v.z * v.z + v.w * v.w); o8[64 * j] = (unsigned long long)pk2(v.x, v.y) | ((unsigned long long)pk2(v.z, v.w) << 32);
            ((GAS unsigned*)(x8 + (size_t)t * 1024))[lane + 64 * j] = pk_fp8x4(v.x, v.y, v.z, v.w); }
        s = wave_sum64(s);
        if (lane < 16) SS[(size_t)t * 16 + lane] = lane == 0 ? s : 0.f;
    }
    for (int idx = vcu * 512 + tid; idx < T * 8; idx += G * 512) { const int t = idx >> 3, i = idx & 7;
        const float invf = powf(500000.0f, -(float)(2 * i) / 16.0f); const float ang = (float)positions[t] * invf;
        CS[(size_t)t * 16 + i] = cosf(ang); CS[(size_t)t * 16 + 8 + i] = sinf(ang); }
}

typedef pg8::f32x4 (&AccRef)[2][2][4][2];
#define LAUNDER3(a, b, c) asm volatile("" : "+v"(a), "+v"(b), "+v"(c))
__device__ __forceinline__ float rstd_at(const float* SS, unsigned row) {
    const GAS f32x4* p = (const GAS f32x4*)((const GAS char*)SS + row * 64u); const f32x4 a = p[0], b = p[1], c = p[2], d = p[3];
    const float s = ((a.x + a.y) + (a.z + a.w)) + ((b.x + b.y) + (b.z + b.w)) + ((c.x + c.y) + (c.z + c.w)) + ((d.x + d.y) + (d.z + d.w));
    return rsqrtf(s * (1.0f / 1024.0f) + RMS_EPS);
}
__device__ __forceinline__ void rstd8(const float* SS, unsigned row0, int fq, float (&rs)[8]) {
    f32x4 v[8];
#pragma unroll
    for (int i = 0; i < 8; ++i) v[i] = *(const GAS f32x4*)((const GAS char*)SS + ((row0 + (unsigned)((i >> 2) * 128 + (i & 3) * 16)) * 64u + (unsigned)fq * 16u));
#pragma unroll
    for (int i = 0; i < 8; ++i) { float s = (v[i].x + v[i].y) + (v[i].z + v[i].w); s += XOR16(s); s = add_xor32(s); rs[i] = rsqrtf(s * (1.0f / 1024.0f) + RMS_EPS); }
}
__device__ __forceinline__ float logsig(float z) { return fminf(z, 0.f) - log1pf(expf(-fabsf(z))); }
struct EpiG1 {
    const float* SS; bf16* PROJ; float* LOGF; const float* CS; const float* GT; const float* ffb; int dry; const LAS float* rsl;
    __device__ __forceinline__ void operator()(AccRef acc, const pg8::Step& st, int wr, int wc, int fr_, int fq_) const {
        if (dry) return;
        int fr = fr_, fq = fq_, zz = 0; LAUNDER3(fr, fq, zz);
        const int pn = st.pn; const unsigned row0 = (unsigned)(st.pm * 256 + wr * 64 + fr);
#define RSL8(dst_) do { _Pragma("unroll") for (int i_ = 0; i_ < 8; ++i_) dst_[i_] = rsl[st.aux * 256 + (i_ >> 2) * 128 + wr * 64 + (i_ & 3) * 16 + fr]; } while (0)
        const bool head = (pn >= 2 && pn <= 5) || (pn >= 8 && pn <= 11);
        if (head) {
            const float* gain = GT + 64 * (pn < 4 ? 0 : (pn < 6 ? 1 : (pn < 10 ? 2 : 3)));
            const bool rot = pn < 6; const float osc = (pn < 4 || (pn >= 8 && pn < 10)) ? C2 : 1.0f;
            f32x4 G[2][2];
#pragma unroll
            for (int bj = 0; bj < 2; ++bj)
#pragma unroll
                for (int n = 0; n < 2; ++n) G[bj][n] = *(const GAS f32x4*)((const GAS char*)gain + (unsigned)(32 * bj + 8 * fq + 4 * n) * 4u);
            const GAS char* pb = (const GAS char*)PROJ + (unsigned)(256 * pn + 64 * wc) * 2u;
            float rs8[8]; RSL8(rs8);
            f32x4 cs[4];
#define G1_LOADCS(i_) do { if (rot && fq < 2) { const GAS f32x4* cp_ = (const GAS f32x4*)((const GAS char*)CS + (row0 + (unsigned)(((i_) >> 2) * 128 + ((i_) & 3) * 16)) * 64u); \
                _Pragma("unroll") for (int q_ = 0; q_ < 4; ++q_) cs[q_] = cp_[q_]; } } while (0)
            G1_LOADCS(0);
#pragma unroll
            for (int i = 0; i < 8; ++i) {
                v4u ov[2];
                {
                    const int ai = i >> 2, m = i & 3; const float rs = rs8[i];
                    f32x4 v[2][2]; float ss = 0.f;
#pragma unroll
                    for (int bj = 0; bj < 2; ++bj)
#pragma unroll
                        for (int n = 0; n < 2; ++n) { v[bj][n] = acc[ai][bj][m][n]; const f32x4 q = v[bj][n] * v[bj][n]; ss += (q.x + q.y) + (q.z + q.w); }
                    ss += XOR16(ss); ss = add_xor32(ss);
                    const float hn = rsqrtf(ss * (1.0f / 64.0f) + RMS_EPS * __builtin_amdgcn_rcpf(rs * rs)) * osc;
#pragma unroll
                    for (int bj = 0; bj < 2; ++bj)
#pragma unroll
                        for (int n = 0; n < 2; ++n) v[bj][n] = v[bj][n] * hn * G[bj][n];
                    if (rot) {
                        f32x4 ot[2];
#pragma unroll
                        for (int n = 0; n < 2; ++n) { ot[n].x = XOR16(v[0][n].x); ot[n].y = XOR16(v[0][n].y); ot[n].z = XOR16(v[0][n].z); ot[n].w = XOR16(v[0][n].w); }
                        if (fq < 2) {
#pragma unroll
                            for (int n = 0; n < 2; ++n) { const f32x4 c = cs[n], s = cs[2 + n]; v[0][n] = (fq == 0) ? (v[0][n] * c - ot[n] * s) : (v[0][n] * c + ot[n] * s); }
                        }
                    }
#pragma unroll
                    for (int bj = 0; bj < 2; ++bj) { ov[bj].x = pk2(v[bj][0].x, v[bj][0].y); ov[bj].y = pk2(v[bj][0].z, v[bj][0].w); ov[bj].z = pk2(v[bj][1].x, v[bj][1].y); ov[bj].w = pk2(v[bj][1].z, v[bj][1].w); }
                }
                if (i < 7) G1_LOADCS(i + 1);
                asm volatile("" ::: "memory");
                { const unsigned row = row0 + (unsigned)((i >> 2) * 128 + (i & 3) * 16);
#pragma unroll
                    for (int bj = 0; bj < 2; ++bj) *(GAS v4u*)(pb + (row * (unsigned)(PJP * 2) + (unsigned)(32 * bj + 8 * fq) * 2u)) = ov[bj]; }
                asm volatile("" ::: "memory");
            }
#undef G1_LOADCS
        } else if (pn == 14) {
            float rs14[8]; RSL8(rs14);
            if (wc == 0 && fq == 0) {
                const f32x4 b0 = *(const GAS f32x4*)ffb, b1 = *(const GAS f32x4*)(ffb + 4);
#pragma unroll
                for (int ai = 0; ai < 2; ++ai)
#pragma unroll
                    for (int m = 0; m < 4; ++m) {
                        const unsigned row = row0 + ai * 128 + m * 16; const float rs = rs14[ai * 4 + m];
                        const f32x4 z0 = acc[ai][0][m][0] * rs + b0, z1 = acc[ai][0][m][1] * rs + b1; f32x4 o0, o1;
                        o0.x = logsig(z0.x); o0.y = logsig(z0.y); o0.z = logsig(z0.z); o0.w = logsig(z0.w); o1.x = logsig(z1.x); o1.y = logsig(z1.y); o1.z = logsig(z1.z); o1.w = logsig(z1.w);
                        GAS f32x4* d = (GAS f32x4*)((GAS char*)LOGF + row * 32u); d[0] = o0; d[1] = o1;
                    }
            }
        } else {
            const GAS char* pb = (const GAS char*)PROJ + (unsigned)(256 * pn + 32 * wc) * 2u;
            float rsp[8]; RSL8(rsp);
#pragma unroll
            for (int ai = 0; ai < 2; ++ai)
#pragma unroll
                for (int m = 0; m < 4; ++m) {
                    const unsigned row = row0 + ai * 128 + m * 16; const float rs = rsp[ai * 4 + m];
#pragma unroll
                    for (int bj = 0; bj < 2; ++bj) { const f32x4 a = acc[ai][bj][m][0] * rs, b = acc[ai][bj][m][1] * rs; v4u o; o.x = pk2(a.x, a.y); o.y = pk2(a.z, a.w); o.z = pk2(b.x, b.y); o.w = pk2(b.z, b.w);
                        *(GAS v4u*)(pb + (row * (unsigned)(PJP * 2) + (unsigned)(128 * bj + 8 * fq) * 2u)) = o; }
                }
        }
    }
};
typedef unsigned v2u __attribute__((ext_vector_type(2)));
__device__ __forceinline__ unsigned pk8(float a, float b, float c, float d) {
    unsigned w = __builtin_amdgcn_cvt_pk_u8_f32(a * 256.0f - 0.5f, 0u, 0u); w = __builtin_amdgcn_cvt_pk_u8_f32(b * 256.0f - 0.5f, 1u, w); w = __builtin_amdgcn_cvt_pk_u8_f32(c * 256.0f - 0.5f, 2u, w); return __builtin_amdgcn_cvt_pk_u8_f32(d * 256.0f - 0.5f, 3u, w); }
__device__ __forceinline__ float g8(unsigned w, const int k) { return ((float)((w >> (8 * k)) & 0xffu) + 0.5f) * (1.0f / 256.0f); }
__device__ __forceinline__ float g8u(unsigned w, const int k) { return (float)((w >> (8 * k)) & 0xffu) + 0.5f; }
#undef RSL8
template <int PART>
struct EpiG2 {
    const float* SS; unsigned char* gs; bf16* MERGED; const LAS float* rsl;
    __device__ __forceinline__ void operator()(AccRef acc, const pg8::Step& st, int wr, int wc, int fr_, int fq_) const {
        int ln; asm volatile("v_mbcnt_lo_u32_b32 %0, -1, 0\n\tv_mbcnt_hi_u32_b32 %0, -1, %0" : "=v"(ln));
        int fr = ln & 15, fq = ln >> 4, tid = (wr * 4 + wc) * 64 + ln; LAUNDER3(fr, fq, tid); (void)fr_; (void)fq_;
        const int aux = st.aux; const unsigned row0 = (unsigned)(st.pm * 256 + wr * 64 + fr), toff = (unsigned)tid * 8u;
        const int n = aux < 3 ? aux : aux - 3; GAS char* gb = (GAS char*)gs + (size_t)n * 65536;
        GAS char* mb = (GAS char*)MERGED + (unsigned)(256 * st.pn + 32 * wc) * 2u;
        float rsg[8];
#pragma unroll
        for (int i = 0; i < 8; ++i) rsg[i] = 0.f;
        if (PART == 0) {
#pragma unroll
            for (int i = 0; i < 8; ++i) rsg[i] = rsl[(i >> 2) * 128 + wr * 64 + (i & 3) * 16 + fr]; }
#pragma unroll
        for (int ai = 0; ai < 2; ++ai) {
            v2u gn[4][2], gd[4][2];
#pragma unroll
            for (int m = 0; m < 4; ++m)
#pragma unroll
                for (int bj = 0; bj < 2; ++bj) { gn[m][bj] = (v2u){0u, 0u}; gd[m][bj] = (v2u){0u, 0u}; }
            if (PART == 1) {
#pragma unroll
                for (int m = 0; m < 4; ++m)
#pragma unroll
                    for (int bj = 0; bj < 2; ++bj) { const unsigned so = toff + (unsigned)(((ai * 4 + m) * 2 + bj) * 4096); gn[m][bj] = *(const GAS v2u*)(gb + so); if (aux < 5) gd[m][bj] = *(const GAS v2u*)(gb + 65536 + so); }
            }
            asm volatile("" ::: "memory");
#pragma unroll
            for (int m = 0; m < 4; ++m) {
                const float rs = rsg[ai * 4 + m] * (1.0f / G8_SCALE);
#pragma unroll
                for (int bj = 0; bj < 2; ++bj) {
                    const unsigned so = toff + (unsigned)(((ai * 4 + m) * 2 + bj) * 4096);
                    const f32x4 a = acc[ai][bj][m][0], b = acc[ai][bj][m][1]; const v2u n_ = gn[m][bj], d_ = gd[m][bj];
                    f32x4 fa = (f32x4){0.f, 0.f, 0.f, 0.f}, fb = fa;
                    if (PART == 0) { const float rsn = rs * -1.4426950408889634f; const f32x4 x = a * rsn, y = b * rsn; v2u o;
                        o.x = pk8(sg2(x.x), sg2(x.y), sg2(x.z), sg2(x.w)); o.y = pk8(sg2(y.x), sg2(y.y), sg2(y.z), sg2(y.w));
                        *(GAS v2u*)(gb + so) = o;
                    } else if (aux < 5) {
                        fa.x = g8u(n_.x, 0) * __builtin_amdgcn_rcpf(g8u(d_.x, 0)); fa.y = g8u(n_.x, 1) * __builtin_amdgcn_rcpf(g8u(d_.x, 1)); fa.z = g8u(n_.x, 2) * __builtin_amdgcn_rcpf(g8u(d_.x, 2)); fa.w = g8u(n_.x, 3) * __builtin_amdgcn_rcpf(g8u(d_.x, 3));
                        fb.x = g8u(n_.y, 0) * __builtin_amdgcn_rcpf(g8u(d_.y, 0)); fb.y = g8u(n_.y, 1) * __builtin_amdgcn_rcpf(g8u(d_.y, 1)); fb.z = g8u(n_.y, 2) * __builtin_amdgcn_rcpf(g8u(d_.y, 2)); fb.w = g8u(n_.y, 3) * __builtin_amdgcn_rcpf(g8u(d_.y, 3));
                    } else { v4u o;
                        o.x = pk2(a.x * g8(n_.x, 0), a.y * g8(n_.x, 1)); o.y = pk2(a.z * g8(n_.x, 2), a.w * g8(n_.x, 3)); o.z = pk2(b.x * g8(n_.y, 0), b.y * g8(n_.y, 1)); o.w = pk2(b.z * g8(n_.y, 2), b.w * g8(n_.y, 3));
                        *(GAS v4u*)(mb + ((row0 + ai * 128 + m * 16) * 2048u + (unsigned)(128 * bj + 8 * fq) * 2u)) = o;
                    }
                    acc[ai][bj][m][0] = a * fa; acc[ai][bj][m][1] = b * fb;
                    asm volatile("" : "+v"(acc[ai][bj][m][0]), "+v"(acc[ai][bj][m][1]));
                }
            }
            asm volatile("" ::: "memory");
        }
    }
};
#ifndef MK_X8
#define MK_X8 1
#endif
template <int KIND, bool SCATTER>
struct EpiRes {
    const bf16* xs; int ldxs; float* xo; bf16* xb; int ldxb; float* SSo; const float* SSi; const bf16* PW; int dry; unsigned char* x8;
    __device__ __forceinline__ void operator()(AccRef acc, const pg8::Step& st, int wr, int wc, int fr_, int fq_) const {
        if (SCATTER && st.aux == 0) return;
        int fr = fr_, fq = fq_, zz = 0; LAUNDER3(fr, fq, zz);
        const int pn = st.pn; const unsigned colb = (unsigned)(256 * pn + 32 * wc + 8 * fq);
        int rowi[8];
#pragma unroll
        for (int i = 0; i < 8; ++i) { const int r = (i >> 2) * 128 + wr * 64 + (i & 3) * 16 + fr; rowi[i] = SCATTER ? ((r < st.nvalid) ? st.rows[r] : -1) : (st.pm * 256 + r); }
        float rs8[8];
#pragma unroll
        for (int i = 0; i < 8; ++i) rs8[i] = 1.f;
        if (KIND == 1) { rstd8(SSi, (unsigned)(st.pm * 256 + wr * 64 + fr), fq, rs8);
            if (MK_PLE8) {
#pragma unroll
                for (int i = 0; i < 8; ++i) rs8[i] *= (1.0f / G8_SCALE); } }
        v4u xin[2][2][2]; v4u pwv[2][2][2];
#define RES_LOAD(p_, buf_) do { _Pragma("unroll") for (int u_ = 0; u_ < 2; ++u_) { const int i_ = 2 * (p_) + u_; const unsigned rw_ = rowi[i_] >= 0 ? (unsigned)rowi[i_] : 0u; \
            _Pragma("unroll") for (int bj_ = 0; bj_ < 2; ++bj_) { xin[buf_][u_][bj_] = *(const GAS v4u*)((const GAS char*)xs + (rw_ * (unsigned)ldxs + colb + 128u * bj_) * 2u); \
                if (KIND == 1) pwv[buf_][u_][bj_] = *(const GAS v4u*)((const GAS char*)PW + (rw_ * 1024u + colb + 128u * bj_) * 2u); } } } while (0)
        RES_LOAD(0, 0);
#pragma unroll
        for (int pr = 0; pr < 4; ++pr) {
            float ssp[2]; f32x4 xr[2][2][2];
#pragma unroll
            for (int u = 0; u < 2; ++u) {
                const int i = 2 * pr + u, ai = i >> 2, m = i & 3; const float rs = rs8[i]; float ss = 0.f;
#pragma unroll
                for (int bj = 0; bj < 2; ++bj) {
                    const v4u xv = xin[pr & 1][u][bj];
                    f32x4 x0 = (f32x4){bflo(xv.x), bfhi(xv.x), bflo(xv.y), bfhi(xv.y)}, x1 = (f32x4){bflo(xv.z), bfhi(xv.z), bflo(xv.w), bfhi(xv.w)};
                    f32x4 a = acc[ai][bj][m][0], b = acc[ai][bj][m][1];
                    if (KIND == 1) { const v4u pw = pwv[pr & 1][u][bj];
                        const float rsn = rs * -1.4426950408889634f;
                        a.x = sg2(a.x * rsn) * bflo(pw.x); a.y = sg2(a.y * rsn) * bfhi(pw.x); a.z = sg2(a.z * rsn) * bflo(pw.y); a.w = sg2(a.w * rsn) * bfhi(pw.y);
                        b.x = sg2(b.x * rsn) * bflo(pw.z); b.y = sg2(b.y * rsn) * bfhi(pw.z); b.z = sg2(b.z * rsn) * bflo(pw.w); b.w = sg2(b.w * rsn) * bfhi(pw.w); }
                    x0 += a; x1 += b;
                    { const f32x4 q0 = x0 * x0, q1 = x1 * x1; ss += ((q0.x + q0.y) + (q0.z + q0.w)) + ((q1.x + q1.y) + (q1.z + q1.w)); }
                    xr[u][bj][0] = x0; xr[u][bj][1] = x1;
                }
                ss += XOR16(ss); ss = add_xor32(ss); ssp[u] = ss;
            }
            if (pr < 3) RES_LOAD(pr + 1, (pr + 1) & 1);
            asm volatile("" ::: "memory");
#pragma unroll
            for (int u = 0; u < 2; ++u) {
                const int i = 2 * pr + u; const bool ok = rowi[i] >= 0 && !dry; const unsigned rw = rowi[i] >= 0 ? (unsigned)rowi[i] : 0u;
                if (ok) {
#pragma unroll
                    for (int bj = 0; bj < 2; ++bj) { const f32x4 x0 = xr[u][bj][0], x1 = xr[u][bj][1];
                        if (xo) { GAS f32x4* op = (GAS f32x4*)((GAS char*)xo + (rw * 1024u + colb + 128u * bj) * 4u); op[0] = x0; op[1] = x1; }
                        if (xb) { v4u o; o.x = pk2(x0.x, x0.y); o.y = pk2(x0.z, x0.w); o.z = pk2(x1.x, x1.y); o.w = pk2(x1.z, x1.w);
                            *(GAS v4u*)((GAS char*)xb + (rw * (unsigned)ldxb + colb + 128u * bj) * 2u) = o; }
                        if (MK_X8 && x8) { v2u o2; o2.x = pk_fp8x4(x0.x, x0.y, x0.z, x0.w); o2.y = pk_fp8x4(x1.x, x1.y, x1.z, x1.w); *(GAS v2u*)((GAS char*)x8 + (rw * 1024u + colb + 128u * bj)) = o2; } }
                    if (fq == 0 && xb) *(GAS float*)((GAS char*)SSo + (rw * 16u + (unsigned)(4 * pn + wc)) * 4u) = ssp[u];
                }
            }
            asm volatile("" ::: "memory");
        }
#undef RES_LOAD
    }
};
struct EpiPW {
    bf16* O;
    __device__ __forceinline__ void operator()(AccRef acc, const pg8::Step& st, int wr, int wc, int fr_, int fq_) const {
        int fr = fr_, fq = fq_, zz = 0; LAUNDER3(fr, fq, zz);
        GAS char* ob = (GAS char*)O + (unsigned)(256 * st.pn + 32 * wc) * 2u; const unsigned row0 = (unsigned)(st.pm * 256 + wr * 64 + fr);
#pragma unroll
        for (int ai = 0; ai < 2; ++ai)
#pragma unroll
            for (int m = 0; m < 4; ++m) {
#pragma unroll
                for (int bj = 0; bj < 2; ++bj) { const f32x4 a = acc[ai][bj][m][0], b = acc[ai][bj][m][1]; v4u o; o.x = pk2(a.x, a.y); o.y = pk2(a.z, a.w); o.z = pk2(b.x, b.y); o.w = pk2(b.z, b.w);
                    *(GAS v4u*)(ob + ((row0 + ai * 128 + m * 16) * 2048u + (unsigned)(128 * bj + 8 * fq) * 2u)) = o; }
                asm volatile("" ::: "memory"); }
    }
};
struct EpiMU {
    bf16* ACT; const float* TOKW; float sc;
    __device__ __forceinline__ void operator()(AccRef acc, const pg8::Step& st, int wr, int wc, int fr_, int fq_) const {
        int fr = fr_, fq = fq_, zz = 0; LAUNDER3(fr, fq, zz);
        const int j = st.pn; GAS char* ab = (GAS char*)ACT + (size_t)st.pm * 1024 + (unsigned)(128 * j + 32 * wc) * 2u;
        int tok[8]; f32x4 tw[8];
#pragma unroll
        for (int i = 0; i < 8; ++i) { const int r = (i >> 2) * 128 + wr * 64 + (i & 3) * 16 + fr; tok[i] = (r < st.nvalid) ? st.rows[r] : -1; }
#pragma unroll
        for (int i = 0; i < 8; ++i) { tw[i] = *(const GAS f32x4*)((const GAS char*)TOKW + (unsigned)(tok[i] >= 0 ? tok[i] : 0) * 16u); if (tok[i] < 0) tw[i] = (f32x4){0.f, 0.f, 0.f, 0.f}; }
        asm volatile("" ::: "memory");
#pragma unroll
        for (int i = 0; i < 8; ++i) {
            const int ai = i >> 2, m = i & 3, r = ai * 128 + wr * 64 + m * 16 + fr;
            const float rs = tw[i].z * sc, w = (j < 2) ? tw[i].x : tw[i].y;
            const f32x4 g0 = acc[ai][0][m][0] * rs, g1 = acc[ai][0][m][1] * rs, u0 = acc[ai][1][m][0] * rs, u1 = acc[ai][1][m][1] * rs; v4u o;
            o.x = pk2(g0.x * sigm(g0.x) * u0.x * w, g0.y * sigm(g0.y) * u0.y * w); o.y = pk2(g0.z * sigm(g0.z) * u0.z * w, g0.w * sigm(g0.w) * u0.w * w);
            o.z = pk2(g1.x * sigm(g1.x) * u1.x * w, g1.y * sigm(g1.y) * u1.y * w); o.w = pk2(g1.z * sigm(g1.z) * u1.z * w, g1.w * sigm(g1.w) * u1.w * w);
            *(GAS v4u*)(ab + ((unsigned)r * 1024u + (unsigned)(8 * fq) * 2u)) = o;
            asm volatile("" ::: "memory");
        }
    }
};

__device__ __forceinline__ bool tile_order(long L, int nM, int nN, int& pm, int& pn) {
    const int nwg = nM * nN; if (L >= nwg) return false;
    int wgid = (int)L; { const int q = nwg / 8, r = nwg % 8, xcd = wgid % 8, off = wgid / 8; wgid = (xcd < r ? xcd * (q + 1) : r * (q + 1) + (xcd - r) * q) + off; }
    const int nig = 8 * nN, gid = wgid / nig, fm = gid * 8, gsz = (nM - fm) < 8 ? (nM - fm) : 8;
    pm = fm + ((wgid % nig) % gsz); pn = (wgid % nig) / gsz; return true;
}
struct SchedPlain {
    const char* A; const char* B; size_t a_tile, b_tile; int nM, nN, nt, G, c, fixa, fixb;
    __device__ __forceinline__ bool next(int i, pg8::Step& s) const {
        int pm, pn; if (!tile_order((long)i * G + c, nM, nN, pm, pn)) return false;
        s.A = A + (size_t)(fixa ? 0 : pm) * a_tile; s.B = B + (size_t)(fixb ? 0 : pn) * b_tile; s.rows = nullptr; s.nt = nt; s.pm = pm; s.pn = pn; s.aux = i; s.nvalid = 256; s.zero_after = 1; return true; }
};
template <int PART>
struct SchedG2 {
    const char* Ab; const char* Bb; int c;
    __device__ __forceinline__ bool next(int i, pg8::Step& s) const {
        if (i >= 3) return false; int pm, pn; tile_order(c, 64, 4, pm, pn);
        const int n = i;
        s.A = PART == 0 ? Ab + (size_t)pm * 256 * 1024 : Ab + (size_t)pm * 256 * (XYP * 2) + 512 * n * 2;
        s.B = Bb + ((size_t)n * 1024 + pn * 256) * 1024;
        s.rows = nullptr; s.nt = 8; s.pm = pm; s.pn = pn; s.aux = PART * 3 + i; s.nvalid = 256; s.zero_after = 0; return true; }
};
struct SchedMoE {
    volatile LAS unsigned* MISC; const int* LIST; const char* Ab; const char* Bb; int G, c, mode, f8;
    __device__ __forceinline__ bool next(int i, pg8::Step& s) const {
        const int NU = (int)MISC[MI_TOT]; const int u = c;
        if (u >= NU || i > (mode == 2 ? 1 : 0)) return false;
        const int down = mode == 2;
        int cls = 0;
#pragma unroll 1
        for (int k = 1; k < 24; ++k) if (u >= (int)MISC[MI_U0 + k]) cls = k;
        const int r = u - (int)MISC[MI_U0 + cls], k = r >> 2, j = r & 3, n_c = (int)MISC[MI_N + cls], arow = (int)MISC[MI_BASE + cls] + 256 * k;
        const int grp = cls / 6, pr = cls % 6; const int pa = pr < 3 ? 0 : (pr < 5 ? 1 : 2), pb = pr < 3 ? pr + 1 : (pr < 5 ? pr - 1 : 3);
        s.rows = LIST + (size_t)cls * T + 256 * k; s.nvalid = min(256, n_c - 256 * k); s.pm = arow; s.pn = j;
        if (!down) { const int e = grp * 4 + (j < 2 ? pa : pb), hf = j & 1;
            s.A = Ab; s.B = Bb + (size_t)(e * 2 + hf) * 256 * (f8 ? 1024 : 2048); s.nt = f8 ? 8 : 16; s.aux = cls; s.zero_after = 1; }
        else { const int sgm = i & 1; const int e = grp * 4 + (sgm ? pb : pa);
            s.A = Ab + (size_t)arow * 1024 + sgm * 512; s.B = Bb + ((size_t)e * 1024 + j * 256) * 512; s.nt = 4; s.aux = sgm; s.zero_after = sgm; }
        return true; }
};
__device__ __forceinline__ float wave_sum(float v) {
    return wave_sum64(v);
}
__device__ __forceinline__ void pool_unit(int u, const bf16* PROJ, bf16* XY, int tid_) {
    int tid = tid_; asm volatile("" : "+v"(tid));
    const int c8 = tid & 63, rg = tid >> 6, g = c8 >> 4, w = 2 << g, t0 = 256 * u + 32 * rg, s0 = t0 % S;
    const GAS char* zb = (const GAS char*)PROJ + (unsigned)c8 * 16u; GAS char* yb = (GAS char*)XY + (unsigned)c8 * 16u;
    float sum[8];
#pragma unroll
    for (int j = 0; j < 8; ++j) sum[j] = 0.f;
    { v4u pz[16];
#pragma unroll
      for (int k = 1; k <= 16; ++k) { const bool ok = k <= w && k <= s0; pz[k - 1] = *(const GAS v4u*)(zb + (unsigned)(ok ? t0 - k : t0) * (unsigned)(PJP * 2)); }
#pragma unroll
      for (int k = 1; k <= 16; ++k) { const bool ok = k <= w && k <= s0; const v4u z = pz[k - 1];
        if (ok) { sum[0] += bflo(z.x); sum[1] += bfhi(z.x); sum[2] += bflo(z.y); sum[3] += bfhi(z.y); sum[4] += bflo(z.z); sum[5] += bfhi(z.z); sum[6] += bflo(z.w); sum[7] += bfhi(z.w); } } }
#pragma clang loop unroll(disable)
    for (int r0 = 0; r0 < 32; r0 += 8) {
        v4u zz[8], qq[8];
#pragma unroll
        for (int j = 0; j < 8; ++j) { const int t = t0 + r0 + j, s = s0 + r0 + j;
            zz[j] = *(const GAS v4u*)(zb + (unsigned)t * (unsigned)(PJP * 2)); qq[j] = *(const GAS v4u*)(zb + (unsigned)(s >= w ? t - w : t) * (unsigned)(PJP * 2)); }
#pragma unroll
        for (int j = 0; j < 8; ++j) { const int t = t0 + r0 + j, s = s0 + r0 + j; const v4u z = zz[j], q = qq[j];
            float zf[8] = {bflo(z.x), bfhi(z.x), bflo(z.y), bfhi(z.y), bflo(z.z), bfhi(z.z), bflo(z.w), bfhi(z.w)};
#pragma unroll
            for (int i = 0; i < 8; ++i) sum[i] += zf[i];
            if (s >= w) { sum[0] -= bflo(q.x); sum[1] -= bfhi(q.x); sum[2] -= bflo(q.y); sum[3] -= bfhi(q.y); sum[4] -= bflo(q.z); sum[5] -= bfhi(q.z); sum[6] -= bflo(q.w); sum[7] -= bfhi(q.w); }
            const float ic = 1.0f / (float)min(s + 1, w); v4u o;
            o.x = pk2(sum[0] * ic - zf[0], sum[1] * ic - zf[1]); o.y = pk2(sum[2] * ic - zf[2], sum[3] * ic - zf[3]); o.z = pk2(sum[4] * ic - zf[4], sum[5] * ic - zf[5]); o.w = pk2(sum[6] * ic - zf[6], sum[7] * ic - zf[7]);
            *(GAS v4u*)(yb + (unsigned)t * (unsigned)(XYP * 2)) = o; }
    }
}
#ifndef MK_THRD
#define MK_THRD 32
#endif
#ifndef MK_THRF
#define MK_THRF 64
#endif
#ifndef MK_ATT_SKIP
#define MK_ATT_SKIP 0
#endif
__device__ __forceinline__ void attn_phase(const int wave0, const LayerW& w, int l, int rep, unsigned char* ws, char* lds, volatile LAS unsigned* MISC, gu32* ctl, const int dry) {
    using namespace attn_body;
    int tid = mk_tid(wave0); const int lane = tid & 63;
    bf16* PROJ = (bf16*)(ws + WS_PROJ); bf16* XY = (bf16*)(ws + WS_XY); bf16* STASH = (bf16*)(ws + WS_STASH); const float* LOGF = (const float*)(ws + WS_LOGF);
    const float lam_init = 0.8f - 0.6f * __expf(-0.3f * (float)l);
    float lam; { const float a = wave_sum(w.dlam[lane] * w.dlam[64 + lane]), c = wave_sum(w.dlam[128 + lane] * w.dlam[192 + lane]); lam = __expf(a) - __expf(c) + lam_init; lam = __int_as_float(__builtin_amdgcn_readfirstlane(__float_as_int(lam))); }
    unsigned* qhead = pg8::rflp((unsigned*)(ctl + CW_AQ) + rep); unsigned* fhead = pg8::rflp((unsigned*)(ctl + CW_AQ) + 64 + 16 * l);
    {
        unsigned* top = pg8::rflp((unsigned*)(ctl + CW_SPLIT3) + 64 * l);
#pragma clang loop unroll(disable)
        for (;;) {
            tid = mk_tid(wave0);
            if (tid == 0) { unsigned r = 0xffffffffu; if (xb_ld(top) < (unsigned)gridDim.x) { const unsigned f = atomicAdd(fhead, 1u); if (f < (unsigned)(CV_LATE_BATCHES + CV_RT_BATCHES + CV_PB_BATCHES)) r = f; } MISC[MI_Q] = r; }
            __syncthreads();
            const unsigned fb = MISC[MI_Q];
            __syncthreads();
            if (fb == 0xffffffffu) break;
            conv_late_batch(w, ws, l, (LAS unsigned char*)lds, (int)fb, tid); __syncthreads();
        }
        tid = mk_tid(wave0);
        if (tid == 0) split_wait_leader(top, (unsigned)gridDim.x);
        __syncthreads();
    }
    int first = 1;
    for (;;) {
        tid = mk_tid(wave0);
        if (tid == 0) { unsigned q = first ? (unsigned)blockIdx.x : (unsigned)gridDim.x + atomicAdd(qhead, 1u); if (q >= 832u) q = 832u + atomicAdd(fhead, 1u); MISC[MI_Q] = q; }
        first = 0;
        __syncthreads();
        const int idx = (int)MISC[MI_Q];
        __syncthreads();
        if (idx >= 832 + CV_LATE_BATCHES + CV_RT_BATCHES + CV_PB_BATCHES) break;
        if (idx >= 832) { if (MK_ATT_SKIP && dry && (MK_ATT_SKIP & 8)) continue; conv_late_batch(w, ws, l, (LAS unsigned char*)lds, idx - 832, tid); continue; }
        int kind, qb, bh;
        if (idx < 160) { kind = 0; qb = 7 - idx / 32; bh = idx % 32; }
        else if (idx < 224) { kind = 1; qb = 7; bh = idx - 160; }
        else if (idx < 256) { kind = 0; qb = 2; bh = idx - 224; }
        else if (idx < 384) { kind = 1; qb = 6 - (idx - 256) / 64; bh = (idx - 256) % 64; }
        else if (idx < 416) { kind = 0; qb = 1; bh = idx - 384; }
        else if (idx < 480) { kind = 1; qb = 4; bh = idx - 416; }
        else if (idx < 544) { kind = 2; qb = 0; bh = idx - 480; }
        else if (idx < 608) { kind = 1; qb = 3; bh = idx - 544; }
        else if (idx < 640) { kind = 0; qb = 0; bh = idx - 608; }
        else if (idx < 704) { kind = 1; qb = 2; bh = idx - 640; }
        else { kind = 1; qb = 1 - (idx - 704) / 64; bh = (idx - 704) % 64; }
        if (MK_ATT_SKIP && dry && ((MK_ATT_SKIP >> kind) & 1)) continue;
        if (kind == 2) { pool_unit(bh, PROJ, XY, tid); __syncthreads(); continue; }
        if (kind == 1) {
            const int b = bh >> 3, h = bh & 7;
            AttnP P; P.Q = PROJ + 2048 + h * 64; P.K = PROJ + 2560 + h * 64; P.V = PROJ + 3072 + h * 64; P.out = XY + 1024 + h * 64; P.stash = nullptr; P.gsub = nullptr; P.logf = LOGF + h; P.opitch = XYP; P.lam = 0.f; P.nscale = 0.f;
            attn_unit<MK_THRF, true>(tid, b, qb, 0, P, lds);
        } else {
            const int b = bh >> 2, h = bh & 3;
#pragma unroll 1
            for (int c = 0; c < 2; ++c) {
                AttnP P; P.Q = PROJ + 512 + (h * 2 + c) * 64; P.K = PROJ + 1024 + (h * 2 + c) * 64; P.V = PROJ + 1536 + h * 128;
                P.stash = STASH + h * 128; P.gsub = w.dsub; P.logf = nullptr; P.lam = lam; P.nscale = 1.0f - lam_init;
                if (c == 0) { P.out = STASH + h * 128; P.opitch = 512; } else { P.out = XY + 512 + h * 128; P.opitch = XYP; }
                attn_unit128<MK_THRD>(mk_tid(wave0), b, qb, c == 0 ? 0 : 4, P, lds); }
        }
    }
}
__device__ __forceinline__ void moe_tables(volatile LAS unsigned* MISC, const unsigned* cls_cnt, int tid) {
    __syncthreads();
    if (tid < 64) {
        const unsigned n = tid < 24 ? cls_cnt[tid] : 0u; const unsigned nch = (n + 255u) >> 8; unsigned inc = nch;
#pragma unroll
        for (int o = 1; o < 32; o <<= 1) { const unsigned up = (unsigned)__builtin_amdgcn_ds_bpermute((tid - o) << 2, (int)inc); if (tid >= o) inc += up; }
        if (tid < 24) { MISC[MI_N + tid] = n; MISC[MI_BASE + tid] = (inc - nch) * 256u; MISC[MI_U0 + tid] = (inc - nch) * 4u; }
        if (tid == 23) MISC[MI_TOT] = inc * 4u; }
    __syncthreads();
}

#ifndef MK_FIXA
#define MK_FIXA 0
#endif
#ifndef MK_FIXB
#define MK_FIXB 0
#endif
#ifndef MK_REPEAT
#define MK_REPEAT 0
#endif
constexpr int NPH = 18;
struct Prog { int p[40]; int n; };
constexpr Prog make_prog() {
    Prog g{}; int n = 0;
    for (int ph = 0; ph < NPH; ++ph) {
        const int kind = (ph == 0 || ph == 9) ? 8 : (ph >= 10 ? ph - 10 : ph - 1);
        g.p[n++] = ph; if ((MK_REPEAT >> kind) & 1) g.p[n++] = ph; }
    g.n = n; return g;
}
__constant__ const Prog PROG = make_prog();
constexpr int NPOS = make_prog().n;
template <unsigned KMASK>
__device__ __forceinline__ void mk_body() {
    typedef const __attribute__((address_space(4))) Args* KArgs;
    const KArgs args0p = (KArgs)__builtin_amdgcn_kernarg_segment_ptr();
    extern __shared__ __attribute__((aligned(16))) unsigned char lds_raw[];
    { LAS unsigned char* lds0 = (LAS unsigned char*)lds_raw;
      for (int u = threadIdx.x; u < (LDS_BYTES - MISC_OFF) / 4; u += NWAVES * 64) ((LAS unsigned*)(lds0 + MISC_OFF))[u] = 0u; }
    __syncthreads();
    const int wave0 = __builtin_amdgcn_readfirstlane(threadIdx.x >> 6);
    XcdBarrier bar = xcd_barrier_post((unsigned*)((gu32*)(args0p->ws + WS_CTL) + CW_BAR) + args0p->li * XCD_BAR_WORDS, (volatile LAS unsigned*)((LAS unsigned char*)lds_raw + MISC_OFF) + MI_BAR, threadIdx.x);
    const int ph_lo = args0p->ph_lo, ph_hi = args0p->ph_hi;
#pragma clang loop unroll(disable)
    for (int pos = ph_lo; pos < ph_hi; ++pos) {
        const int ph = __builtin_amdgcn_readfirstlane(PROG.p[pos]); const int rep = pos; const int dry = (MK_REPEAT != 0 && pos + 1 < ph_hi && __builtin_amdgcn_readfirstlane(PROG.p[pos + 1]) == ph) ? 1 : 0;
        KArgs ap = args0p; asm volatile("" : "+s"(ap));
#define args (*ap)
        LAS unsigned char* lds = (LAS unsigned char*)lds_raw;
        volatile LAS unsigned* MISC = (volatile LAS unsigned*)(lds + MISC_OFF);
        int G = gridDim.x, bx = blockIdx.x; asm volatile("" : "+s"(G), "+s"(bx)); const int vcu = (G % 8 == 0) ? (bx % 8) * (G / 8) + bx / 8 : bx;
        unsigned char* ws = args.ws; gu32* ctl = (gu32*)(ws + WS_CTL);
        float* XOUT = args.out; const float* x0 = (const float*)args.in[0];
        bf16* XY = (bf16*)(ws + WS_XY); bf16* PROJ = (bf16*)(ws + WS_PROJ);
        float* SSA = (float*)(ws + WS_SS); float* SSB = (float*)(ws + WS_SSB);
        if (ph == 0) { if constexpr (KMASK & 0x100u) { const int tid = mk_tid(wave0); const LayerW w = layer_view(ap, 0); conv_layer(w, ws, 0, lds, vcu, G, tid); p0_x(x0, (const int*)args.in[2], ws, (unsigned char*)XOUT + OUT_XB8, vcu, G, tid);
            if (tid == 0) ((unsigned*)(ctl + CW_XCC))[vcu] = xb_xcc_id() + 1u;
            if (bx == 0) { float* GT = (float*)(ctl + CW_GT); const int ll = tid >> 8, r = tid & 255, wch = r >> 6, d = r & 63;
                const float* gsrc = (const float*)(wch == 0 ? args.in[7] : (wch == 1 ? args.in[8] : (wch == 2 ? args.in[11] : args.in[12]))); GT[tid] = gsrc[ll * 64 + d]; } } }
        else if (ph == 9) { }
        else {
            const int l = __builtin_amdgcn_readfirstlane(ph >= 10 ? 1 : 0), k = __builtin_amdgcn_readfirstlane(ph - (l ? 10 : 1));
            const LayerW w = layer_view(ap, l);
            const float* SSin = l == 0 ? SSA : SSB; const float* xcur = l == 0 ? x0 : XOUT;
            if (k == 0) { if constexpr (KMASK & 1u) { const int tid = mk_tid(wave0);
                SchedPlain S{(const char*)(XY + 1536), (const char*)(ws + WS_W + W_IN), (size_t)256 * XYP * 2, (size_t)256 * 2048, 64, 15, 16, G, bx, dry & MK_FIXA, dry & MK_FIXB};
                LAS float* RSL = (LAS float*)(lds + MISC_OFF) + 1024;
                if (tid < 4) { int pm_ = -1, pn_ = 0; if (!tile_order((long)tid * G + bx, 64, 15, pm_, pn_)) pm_ = -1; MISC[112 + tid] = (unsigned)pm_; }
                __syncthreads();
#pragma unroll 1
                for (int idx = tid; idx < 1024; idx += 512) { const int pm_ = (int)MISC[112 + (idx >> 8)]; if (pm_ >= 0) RSL[idx] = rstd_at(SSin, (unsigned)(pm_ * 256 + (idx & 255))); }
                __syncthreads();
                EpiG1 E{SSin, PROJ, (float*)(ws + WS_LOGF), (const float*)(ws + WS_COSSIN), (const float*)(ctl + CW_GT) + 256 * l, w.ffb, dry, RSL};
                pg8::gemm_phase<SchedPlain, EpiG1, false, true>(tid, lds, XYP * 2, 2048, S, E);
                split_arrive_x(bar, (unsigned*)(ctl + CW_SPLIT3) + 64 * l, (unsigned*)(ctl + CW_SPLIT3) + 64 * l + 32 * 0 + 128, mk_tid(wave0));
            } } else if (k == 1) { if constexpr (KMASK & 2u) {
                attn_phase(wave0, w, l, rep, ws, (char*)lds_raw, MISC, ctl, dry);
                split_arrive_x(bar, (unsigned*)(ctl + CW_SPLIT + (2 * l) * 64), (unsigned*)(ctl + CW_SPLITX + (2 * l) * 64), mk_tid(wave0));
            } } else if (k == 2) { if constexpr (KMASK & 4u) { const int tid = mk_tid(wave0);
                unsigned char* gsc = (unsigned char*)XOUT + OUT_GATES + (size_t)bx * 196608;
                LAS float* RSL2 = (LAS float*)(lds + MISC_OFF) + 1024;
                { int pm_, pn_; tile_order(bx, 64, 4, pm_, pn_); if (tid < 256) RSL2[tid] = rstd_at(SSin, (unsigned)(pm_ * 256 + tid)); __syncthreads(); }
                { SchedG2<0> S{(const char*)XOUT + OUT_XB8, (const char*)(ws + WS_W + W_G8), bx};
                  EpiG2<0> E{SSin, gsc, (bf16*)(ws + WS_MERGED), RSL2};
                  pg8::gemm_phase<SchedG2<0>, EpiG2<0>, false, true, true>(tid, lds, 1024, 1024, S, E); }
                { const int t2 = mk_tid(wave0); if (t2 == 0) split_wait_leader((unsigned*)(ctl + CW_SPLIT + (2 * l) * 64), (unsigned)G); __syncthreads(); }
                { SchedG2<1> S{(const char*)XY, (const char*)(ws + WS_W + W_BR), bx};
                  EpiG2<1> E{SSin, gsc, (bf16*)(ws + WS_MERGED), RSL2};
                  pg8::gemm_phase<SchedG2<1>, EpiG2<1>, false, true>(mk_tid(wave0), lds, XYP * 2, 1024, S, E); }
                { int pm_, pn_; tile_order(bx, 64, 4, pm_, pn_); group4_sync((unsigned*)(ctl + CW_G4 + ((2 * l) * 64 + pm_) * 32), mk_tid(wave0)); }
            } } else if (k == 3) { if constexpr (KMASK & 8u) { const int tid = mk_tid(wave0);
                SchedPlain S{(const char*)(ws + WS_MERGED), (const char*)(ws + WS_W + W_OUT), (size_t)256 * 2048, (size_t)256 * 2048, 64, 4, 16, G, bx, 0, 0};
                EpiRes<0, false> E{XY + 1536, XYP, nullptr, XY + 1536, XYP, SSA, nullptr, nullptr, dry, (MK_MU8 && l == NL - 1) ? (unsigned char*)XOUT + OUT_XB8 : nullptr};
                pg8::gemm_phase<SchedPlain, EpiRes<0, false>, false, true>(tid, lds, 2048, 2048, S, E);
                { int pm_, pn_; tile_order(bx, 64, 4, pm_, pn_); group4_sync((unsigned*)(ctl + CW_G4 + ((2 * l + 1) * 64 + pm_) * 32), mk_tid(wave0)); }
            } } else if (k == 4) { if constexpr (KMASK & 16u) { const int tid = mk_tid(wave0);
                {
                    typedef float f32x16r __attribute__((ext_vector_type(16))); typedef short bf16x8r __attribute__((ext_vector_type(8)));
                    const int lane_ = tid & 63, r32 = lane_ & 31, hh = lane_ >> 5, wv = __builtin_amdgcn_readfirstlane(tid >> 6); int pm_, pn_; tile_order(bx, 64, 4, pm_, pn_); const int t0 = pm_ * 256 + pn_ * 64;
                    unsigned* ccnt = (unsigned*)(ctl + CW_CLS + 32 * l + 64 * dry); int* LIST = (int*)(ws + WS_LIST);
                    const GAS char* wrh = (const GAS char*)(ws + WS_W + W_RH) + (unsigned)(r32 * 2048 + (128 * wv + 8 * hh) * 2);
                    const GAS char* xb_ = (const GAS char*)(XY + 1536) + (size_t)t0 * (XYP * 2) + (unsigned)(r32 * (XYP * 2) + (128 * wv + 8 * hh) * 2);
                    f32x16r acc0 = {}, acc1 = {};
#pragma unroll 2
                    for (int ks = 0; ks < 8; ++ks) {
                        const bf16x8r Bh = *(const GAS bf16x8r*)(wrh + ks * 32), Bl = *(const GAS bf16x8r*)(wrh + 65536 + ks * 32);
                        const bf16x8r A0 = *(const GAS bf16x8r*)(xb_ + ks * 32), A1 = *(const GAS bf16x8r*)(xb_ + 32 * (XYP * 2) + ks * 32);
                        acc0 = __builtin_amdgcn_mfma_f32_32x32x16_bf16(A0, Bh, acc0, 0, 0, 0); acc0 = __builtin_amdgcn_mfma_f32_32x32x16_bf16(A0, Bl, acc0, 0, 0, 0);
                        acc1 = __builtin_amdgcn_mfma_f32_32x32x16_bf16(A1, Bh, acc1, 0, 0, 0); acc1 = __builtin_amdgcn_mfma_f32_32x32x16_bf16(A1, Bl, acc1, 0, 0, 0);
                    }
                    LAS float* Pp = (LAS float*)lds;
                    LAS float* Lg = (LAS float*)(lds + 65536);
#pragma unroll
                    for (int r = 0; r < 16; ++r) { const int tk = (r & 3) + 8 * (r >> 2) + 4 * hh; Pp[(wv * 64 + tk) * 32 + r32] = acc0[r]; Pp[(wv * 64 + 32 + tk) * 32 + r32] = acc1[r]; }
                    __syncthreads();
                    { const int tk = tid >> 3, n4 = (tid & 7) * 4; f32x4 s = (f32x4){0.f, 0.f, 0.f, 0.f};
#pragma unroll
                      for (int w8 = 0; w8 < 8; ++w8) s += *(const LAS f32x4*)(Pp + (w8 * 64 + tk) * 32 + n4);
                      *(LAS f32x4*)(Lg + tk * 32 + n4) = s; }
                    __syncthreads();
                    if (tid < 64) { const int t = t0 + tid; float dg[4], de[16];
#pragma unroll
                        for (int e = 0; e < 4; ++e) dg[e] = Lg[tid * 32 + e];
#pragma unroll
                        for (int e = 0; e < 16; ++e) de[e] = Lg[tid * 32 + 4 + e];
                        const float rstd = rstd_at(SSA, (unsigned)t); float wa, wb; const int cls = route_decide(dg, de, rstd, w.brg, w.bre, wa, wb);
                        *(GAS f32x4*)((GAS char*)(ws + WS_TOKW) + (unsigned)t * 16u) = (f32x4){wa, wb, rstd, 0.f}; MISC[128 + tid] = (unsigned)cls; }
                    __syncthreads();
                    if (tid < 64) {
                        const unsigned mycls = MISC[128 + tid]; const unsigned long long ltm = (1ull << tid) - 1ull; unsigned cnt_c = 0, rank = 0;
#pragma unroll 4
                        for (unsigned c = 0; c < 24; ++c) { const unsigned long long m = __ballot(mycls == c); if ((unsigned)tid == c) cnt_c = (unsigned)__popcll(m); if (mycls == c) rank = (unsigned)__popcll(m & ltm); }
                        unsigned base = 0; if (tid < 24 && cnt_c) base = atomicAdd(ccnt + tid, cnt_c);
                        const unsigned mybase = (unsigned)__builtin_amdgcn_ds_bpermute((int)(mycls << 2), (int)base);
                        LIST[(size_t)mycls * T + mybase + rank] = t0 + tid; }
                    __syncthreads();
                }
                split_arrive_x(bar, (unsigned*)(ctl + CW_SPLIT + (2 * l + 1) * 64), (unsigned*)(ctl + CW_SPLITX + (2 * l + 1) * 64), mk_tid(wave0));
            } } else if (k == 5) { if constexpr (KMASK & 96u) { int tid = mk_tid(wave0);
                if (tid == 0) split_wait_leader((unsigned*)(ctl + CW_SPLIT + (2 * l + 1) * 64), (unsigned)G);
                __syncthreads();
                moe_tables(MISC, (const unsigned*)(ctl + CW_CLS + 32 * l), tid);
                const int NUm = (int)MISC[MI_TOT], KO = NUm > 256 ? (NUm - 256) >> 2 : 0;
                const int gid = vcu >> 2, m4 = vcu & 3, xg = gid >> 3, lg = gid & 7;
                const int k_o = lg * 8 + xg, k_p = (lg - 4) * 8 + xg;
                const bool is_o = lg < 4 && k_o < KO, is_p = lg >= 4 && k_p < KO;
                unsigned* cA = (unsigned*)(ctl + CW_MOE2 + 3584 * l); unsigned* cB = cA + 2048; unsigned* cO = cA + 3072;
#pragma clang loop unroll(disable)
                for (int r = 0; r < 2; ++r) {
                    const int u = r == 0 ? vcu : 256 + 4 * k_o + m4; if (r == 1 && !is_o) break;
                    tid = mk_tid(wave0);
                    { SchedMoE S{MISC, (const int*)(ws + WS_LIST), (const char*)(XY + 1536), (const char*)(ws + WS_W + W_GU), G, u, 0, 0};
                      EpiMU E{(bf16*)(ws + OV_ACT), (const float*)(ws + WS_TOKW), 1.0f};
                      pg8::gemm_phase<SchedMoE, EpiMU, true, true>(tid, lds, XYP * 2, 2048, S, E); }
                    if (r == 0 && is_o) {
                        asm volatile("s_waitcnt vmcnt(0)" ::: "memory"); __syncthreads();
                        tid = mk_tid(wave0);
                        if (tid == 0) { const unsigned me = xb_xcc_id() + 1u; bool same = true;
#pragma unroll
                            for (int i = 0; i < 4; ++i) same = same && (xb_ld((unsigned*)(ctl + CW_XCC) + (gid + 4) * 4 + i) == me);
                            if (!same) { __builtin_amdgcn_fence(__ATOMIC_RELEASE, "agent"); asm volatile("s_waitcnt vmcnt(0)" ::: "memory"); }
                            xb_add(cO + 16 * k_o, 1u); asm volatile("s_waitcnt vmcnt(0)" ::: "memory"); }
                        __syncthreads();
                    }
                }
                group4_sync(is_o ? cB + 32 * k_o : cA + 32 * gid, mk_tid(wave0));
#pragma clang loop unroll(disable)
                for (int r = 0; r < 2; ++r) {
                    const int u = r == 0 ? (is_o ? 256 + 4 * k_o + m4 : vcu) : 4 * (gid - 4) + m4; if (r == 1 && !is_p) break;
                    tid = mk_tid(wave0);
                    if (r == 1) {
                        if (tid == 0) { unsigned sp = 0; while (xb_ld(cO + 16 * k_p) < 4u) { __builtin_amdgcn_s_sleep(2); if (++sp > (1u << 22)) break; }
                            __builtin_amdgcn_fence(__ATOMIC_ACQUIRE, "agent"); asm volatile("s_waitcnt vmcnt(0)" ::: "memory"); }
                        __syncthreads();
                    }
                    SchedMoE S{MISC, (const int*)(ws + WS_LIST), (const char*)(ws + OV_ACT), (const char*)(ws + WS_W + W_D), G, u, 2, 0};
                    EpiRes<0, true> E{XY + 1536, XYP, nullptr, (bf16*)(ws + OV_XB2), 1024, SSA, nullptr, nullptr, dry, MK_PLE8 ? ws + WS_MERGED : nullptr};
                    pg8::gemm_phase<SchedMoE, EpiRes<0, true>, false, true>(tid, lds, 1024, 512, S, E);
                }
                { unsigned* fqh = pg8::rflp((unsigned*)(ctl + CW_FQ) + 64 * l); const int NF = 256 + (l + 1 < NL ? CV_EARLY_BATCHES : 0);
                  int arrived = 0;
                  for (;;) {
                    const int tq = mk_tid(wave0);
                    if (tq == 0) MISC[MI_Q] = atomicAdd(fqh, 1u);
                    __syncthreads();
                    const int idx = (int)MISC[MI_Q];
                    __syncthreads();
                    if (idx >= 256 && !arrived) { split_arrive_x(bar, (unsigned*)(ctl + CW_SPLIT3) + 256 + 64 * l, (unsigned*)(ctl + CW_SPLIT3) + 512 + 64 * l, mk_tid(wave0)); arrived = 1; }
                    if (idx >= NF) break;
                    if (idx < 256) {
                        SchedPlain S2{(const char*)(ws + OV_PB), (const char*)(ws + WS_WPLE + l * WPLE_STRIDE + W_P), (size_t)256 * 512, (size_t)256 * 512, 64, 4, 4, 1 << 20, idx, 0, 0};
                        EpiPW E2{(bf16*)(ws + OV_PW)};
                        pg8::gemm_phase<SchedPlain, EpiPW, false, true>(tq, lds, 512, 512, S2, E2);
                    } else { const LayerW w1 = layer_view(ap, 1); conv_early_batch(w1, ws, 1, lds, idx - 256, tq); }
                  } }
            } } else if (k == 6) { if constexpr (KMASK & 96u) {
            } } else { if constexpr (KMASK & 128u) { const int tid = mk_tid(wave0);
                if (tid == 0) split_wait_leader((unsigned*)(ctl + CW_SPLIT3) + 256 + 64 * l, (unsigned)G);
                __syncthreads();
                constexpr int P8 = MK_PLE8 ? 1 : 0;
                SchedPlain S{(const char*)(ws + (P8 ? WS_MERGED : OV_XB2)), (const char*)(ws + WS_WPLE + l * WPLE_STRIDE + W_PG), (size_t)256 * (P8 ? 1024 : 2048), (size_t)256 * (P8 ? 1024 : 2048), 64, 4, P8 ? 8 : 16, G, bx, 0, 0};
                EpiRes<1, false> E{(const bf16*)(ws + OV_XB2), 1024, l == NL - 1 ? XOUT : nullptr, l == NL - 1 ? nullptr : XY + 1536, XYP, SSB, SSA, (const bf16*)(ws + OV_PW), dry, l == NL - 1 ? nullptr : (unsigned char*)XOUT + OUT_XB8};
                pg8::gemm_phase<SchedPlain, EpiRes<1, false>, false, true, P8 != 0>(tid, lds, P8 ? 1024 : 2048, P8 ? 1024 : 2048, S, E);
            } }
        }
        const int kk_ = (ph == 0 || ph == 9) ? -1 : (ph >= 10 ? ph - 10 : ph - 1);
        if (pos + 1 < ph_hi && ph != 9 && (MK_REPEAT != 0 || kk_ > 6 || kk_ < 0)) { xcd_barrier(bar, mk_tid(wave0));
#ifdef MK_DOUBLE_BAR
            xcd_barrier(bar, mk_tid(wave0)); xcd_barrier(bar, mk_tid(wave0));
#endif
        }
#undef args
    }
}

#ifndef MK_KMASKS
#ifdef MK_SPLIT_TEST
#define MK_KMASKS 0x100u
#else
#define MK_KMASKS 0x1FFu
#endif
#endif
__global__ void __launch_bounds__(NWAVES * 64, 2) mk_fwd(Args args) { mk_body<MK_KMASKS>(); }
#ifdef MK_SPLIT_TEST
__global__ void __launch_bounds__(NWAVES * 64, 2) mk_t0(Args args) { mk_body<1u>(); }
__global__ void __launch_bounds__(NWAVES * 64, 2) mk_t1(Args args) { mk_body<2u>(); }
__global__ void __launch_bounds__(NWAVES * 64, 2) mk_t2(Args args) { mk_body<4u>(); }
__global__ void __launch_bounds__(NWAVES * 64, 2) mk_t3(Args args) { mk_body<8u>(); }
__global__ void __launch_bounds__(NWAVES * 64, 2) mk_t4(Args args) { mk_body<16u>(); }
__global__ void __launch_bounds__(NWAVES * 64, 2) mk_t5(Args args) { mk_body<32u>(); }
__global__ void __launch_bounds__(NWAVES * 64, 2) mk_t6(Args args) { mk_body<64u>(); }
__global__ void __launch_bounds__(NWAVES * 64, 2) mk_t7(Args args) { mk_body<128u>(); }
__global__ void __launch_bounds__(NWAVES * 64, 2) mk_t8(Args args) { mk_body<256u>(); }
#endif
#ifndef MK_ONE_LAUNCH
#define MK_ONE_LAUNCH 0
#endif
#ifndef MK_OPT_MASK
#define MK_OPT_MASK 0x3FFFF
#endif
static void ref_phase(int l, int k, void* const* d_in, float* XOUT, unsigned char* ws, hipStream_t st) {
    using namespace refp;
    const float* x0 = (const float*)d_in[0]; const float* p = (const float*)d_in[1]; const int* pos = (const int*)d_in[2];
    const float* g_attn = (const float*)d_in[3] + l * 1024; const float* w_in_l = (const float*)d_in[4] + (size_t)l * 1024 * INW;
    const float* pool_w = (const float*)d_in[5] + (size_t)l * 4 * 128 * 128; const float* pool_scale = (const float*)d_in[6] + l * 512;
    const float* dqn = (const float*)d_in[7] + l * 64; const float* dkn = (const float*)d_in[8] + l * 64; const float* dlam = (const float*)d_in[9] + l * 256;
    const float* dsub = (const float*)d_in[10] + l * 128; const float* fqn = (const float*)d_in[11] + l * 64; const float* fkn = (const float*)d_in[12] + l * 64;
    const float* ffb = (const float*)d_in[13] + l * 8; const float* w_branch_l = (const float*)d_in[14] + (size_t)l * 3 * 512 * 1024; const float* w_out_l = (const float*)d_in[15] + (size_t)l * 1024 * 1024;
    const float* g_ffn = (const float*)d_in[16] + l * 1024; const float* wrg = (const float*)d_in[17] + (size_t)l * 1024 * 4; const float* brg = (const float*)d_in[18] + l * 4;
    const float* wre = (const float*)d_in[19] + (size_t)l * 1024 * 16; const float* bre = (const float*)d_in[20] + l * 16;
    const float* wg_l = (const float*)d_in[21] + (size_t)l * 16 * 1024 * 256; const float* wu_l = (const float*)d_in[22] + (size_t)l * 16 * 1024 * 256; const float* wd_l = (const float*)d_in[23] + (size_t)l * 16 * 256 * 1024;
    const float* g_ple = (const float*)d_in[24] + l * 1024; const float* wpg_l = (const float*)d_in[25] + (size_t)l * 1024 * 1024; const float* wple_l = (const float*)d_in[26] + (size_t)l * 256 * 1024;
    const float* p_l = p + (size_t)l * T * 256;
    float* SSA = (float*)(ws + WS_SS); float* SSB = (float*)(ws + WS_SSB); float* RS = (float*)(ws + WS_RSTD); float* LOGF = (float*)(ws + WS_LOGF); float* FCUM = (float*)(ws + WS_FCUM); float* TOKW = (float*)(ws + WS_TOKW); int* LIST = (int*)(ws + WS_LIST);
    bf16* XY = (bf16*)(ws + WS_XY); bf16* PROJ = (bf16*)(ws + WS_PROJ); float* CH = (float*)(ws + WS_STASH); bf16* MERGED = (bf16*)(ws + WS_MERGED); float* TMP = (float*)(ws + WS_PROJ);
    unsigned* cls_cnt = (unsigned*)(ws + WS_CTL) + CW_CLS + 32 * l;
    const float* xcur = l == 0 ? x0 : XOUT; float* SSin = l == 0 ? SSA : SSB;
    const float lam_init = 0.8f - 0.6f * expf(-0.3f * (float)l);
    if (k == -1) { k_rowstats<<<T / 4, 256, 0, st>>>(x0, XY + 1536, XYP, SSA, RS, nullptr); return; }
    if (k == 0) {
        k_ref_rstd<<<T / 256, 256, 0, st>>>(SSin, RS);
        for (int cc = 0; cc < 14; ++cc) {
            k_ref_gemm<<<dim3(4, T / 64), 256, 0, st>>>(XnormLoader{xcur, RS, g_attn}, w_in_l + 256 * cc, INW, 256, 1024, EpiStoreF32{CH, 256, 0});
            int kind = 2; const float* gain = nullptr; int rot = 0; float osc = 1.f;
            if (cc < 2) kind = 0;
            else if (cc < 4) { kind = 1; gain = dqn; rot = 1; osc = C2; }
            else if (cc < 6) { kind = 1; gain = dkn; rot = 1; }
            else if (cc >= 8 && cc < 10) { kind = 1; gain = fqn; osc = C2; }
            else if (cc >= 10 && cc < 12) { kind = 1; gain = fkn; }
            k_ref_epi1<<<T, 256, 0, st>>>(CH, cc, kind, pool_w, pool_scale, gain, rot, osc, pos, PROJ);
        }
        k_ref_gemm<<<dim3(1, T / 64), 256, 0, st>>>(XnormLoader{xcur, RS, g_attn}, w_in_l + 3584, INW, 8, 1024, EpiStoreF32{CH, 8, 0});
        k_ref_logf<<<T * 8 / 256, 256, 0, st>>>(CH, ffb, LOGF);
    } else if (k == 1) {
        k_ref_fscan<<<1, 64, 0, st>>>(LOGF, FCUM);
        k_ref_fox<<<T * 8 / 4, 256, 0, st>>>(PROJ, FCUM, XY);
        k_ref_diff<<<T * 4 / 2, 128, 0, st>>>(PROJ, dlam, dsub, lam_init, XY);
        k_ref_pool<<<T * 512 / 256, 256, 0, st>>>(PROJ, XY);
    } else if (k == 2) {
        k_ref_rstd<<<T / 256, 256, 0, st>>>(SSin, RS);
        k_ref_gemm2<<<dim3(16, T / 64), 256, 0, st>>>(xcur, RS, g_attn, w_in_l, w_branch_l, XY, MERGED);
    } else if (k == 3) {
        k_ref_gemm<<<dim3(16, T / 64), 256, 0, st>>>(Bf16Loader{MERGED, 1024, 0}, w_out_l, 1024, 1024, 1024, EpiResid{xcur, XOUT});
        k_rowstats<<<T / 4, 256, 0, st>>>(XOUT, XY + 1536, XYP, SSA, RS, nullptr);
    } else if (k == 4) {
        k_route<<<T / 4, 256, 0, st>>>(XOUT, g_ffn, wrg, brg, wre, bre, cls_cnt, LIST, TOKW);
    } else if (k == 5) {
        k_ref_rstd<<<T / 256, 256, 0, st>>>(SSA, RS);
        k_ref_moe<<<dim3(T / 8, 24), 256, 0, st>>>(XOUT, RS, g_ffn, (const int*)cls_cnt, LIST, TOKW, wg_l, wu_l, wd_l);
        k_rowstats<<<T / 4, 256, 0, st>>>(XOUT, (bf16*)(ws + OV_XB2), 1024, SSA, RS, nullptr);
    } else if (k == 7) {
        k_ref_rstd<<<T / 256, 256, 0, st>>>(SSA, RS);
        k_ref_ple<<<dim3(16, T / 64), 256, 0, st>>>(XOUT, RS, g_ple, wpg_l, p_l, wple_l, TMP);
        k_rowstats<<<T / 4, 256, 0, st>>>(TMP, XY + 1536, XYP, SSB, RS, XOUT);
    }
}

extern "C" void kernel_launch(void* const* d_in, const int* in_sizes, int n_in, void* d_out, int out_size, void* d_ws, size_t ws_size, hipStream_t stream) {
    static int grid = 0;
    if (grid == 0) {
        if (n_in != 27 || out_size != T * DM || ws_size < WS_END) { fprintf(stderr, "kernel_launch: unexpected shapes (n_in %d out %d ws %zu)\n", n_in, out_size, ws_size); grid = -1; return; }
        int dev = 0, cus = 0;
        if (hipGetDevice(&dev) != hipSuccess || hipDeviceGetAttribute(&cus, hipDeviceAttributeMultiprocessorCount, dev) != hipSuccess) { grid = -1; return; }
        if (hipFuncSetAttribute((const void*)mk_fwd, hipFuncAttributeMaxDynamicSharedMemorySize, LDS_BYTES) != hipSuccess) { fprintf(stderr, "kernel_launch: hipFuncSetAttribute failed\n"); grid = -1; return; }
#if !MK_ONE_LAUNCH
        { const void* ks[9] = {(const void*)mk_t0, (const void*)mk_t1, (const void*)mk_t2, (const void*)mk_t3, (const void*)mk_t4, (const void*)mk_t5, (const void*)mk_t6, (const void*)mk_t7, (const void*)mk_t8};
          for (int i = 0; i < 9; ++i) (void)hipFuncSetAttribute(ks[i], hipFuncAttributeMaxDynamicSharedMemorySize, LDS_BYTES); }
#endif
        int per_cu = 0;
        if (hipOccupancyMaxActiveBlocksPerMultiprocessor(&per_cu, mk_fwd, NWAVES * 64, LDS_BYTES) != hipSuccess || per_cu < 1) { fprintf(stderr, "kernel_launch: occupancy query failed (%d)\n", per_cu); grid = -1; return; }
        (void)hipGetLastError();
        grid = cus;
    }
    if (grid < 0) return;
    (void)hipMemsetAsync((char*)d_ws + WS_CTL, 0, MK_ONE_LAUNCH ? (size_t)192 * 1024 : CTL_BYTES, stream);
    Args a{};
    for (int i = 0; i < 27; ++i) a.in[i] = d_in[i];
    a.out = (float*)d_out; a.ws = (unsigned char*)d_ws;
#if MK_ONE_LAUNCH
    a.ph_lo = 0; a.ph_hi = NPOS; a.li = 0;
    hipLaunchKernelGGL(mk_fwd, dim3(grid), dim3(NWAVES * 64), LDS_BYTES, stream, a);
#else
    const unsigned mask = MK_OPT_MASK; int li = 0;
    typedef void (*kern_t)(Args);
    const kern_t ks[9] = {mk_t0, mk_t1, mk_t2, mk_t3, mk_t4, mk_t5, mk_t6, mk_t7, mk_t8};
#define LAUNCH_PH(kk) hipLaunchKernelGGL(ks[kk], dim3(grid), dim3(NWAVES * 64), LDS_BYTES, stream, a)
    for (int ph = 0; ph < NPH; ++ph) {
        const bool opt = (mask >> ph) & 1u;
        const int l = ph >= 10 ? 1 : 0, k = ph == 0 ? -1 : (ph == 9 ? -2 : ph - (l ? 10 : 1));
        if (ph == 0) {
            a.ph_lo = 0; a.ph_hi = 1; a.li = li++; LAUNCH_PH(8);
            if (!opt) ref_phase(0, -1, d_in, (float*)d_out, (unsigned char*)d_ws, stream);
            continue; }
        if (ph == 9) { a.ph_lo = 9; a.ph_hi = 10; a.li = li++; LAUNCH_PH(8); continue; }
        if (opt) { a.ph_lo = ph; a.ph_hi = ph + 1; a.li = li++; LAUNCH_PH(k); }
        else if (k != 6) ref_phase(l, k, d_in, (float*)d_out, (unsigned char*)d_ws, stream);
    }
#endif
}
```

```cpp
#include <hip/hip_runtime.h>
#include <cstdio>
#include <cstdint>
#include <cmath>
typedef unsigned short bf16;
constexpr int T = 16384, DM = 1024, S = 2048, NB = 8, NL = 2, INW = 6664;
constexpr float RMS_EPS = 1e-6f;
constexpr float C2 = 0.125f * 1.4426950408889634f;
constexpr size_t MiB = 1u << 20;
constexpr size_t WS_CTL = 0, CTL_BYTES = 1 * MiB;
constexpr size_t WS_SS = 1 * MiB;
constexpr size_t WS_LOGF = 2 * MiB;
constexpr size_t WS_FCUM = 2 * MiB + 512 * 1024;
constexpr size_t WS_TOKW = 3 * MiB;
constexpr size_t WS_RSTD = 3 * MiB + 256 * 1024;
constexpr size_t WS_LIST = 3 * MiB + 512 * 1024;
constexpr size_t WS_COSSIN = 5 * MiB;
constexpr size_t WS_SSB = 49 * MiB;
constexpr size_t WS_W = 6 * MiB;
constexpr size_t WS_WPLE = 52 * MiB;
constexpr size_t WS_XY = 57 * MiB;
constexpr size_t WS_PROJ = 137 * MiB;
constexpr size_t WS_STASH = 249 * MiB;
constexpr size_t WS_MERGED = WS_PROJ + 96 * MiB;
constexpr size_t WS_PB = 265 * MiB;
constexpr size_t WS_END = 273 * MiB;
constexpr int XYP = 2560, PJP = 3584;
constexpr int CW_CLS = 64;
constexpr int CW_AQ = 256;
constexpr int CW_G4 = 16384;
constexpr int CW_SPLIT3 = 24576;
constexpr int CW_MOE2 = 32768;
constexpr int CW_XCC = 40960;
constexpr int CW_GT = 131072;
constexpr int CW_MOEG = 512;
constexpr int CW_SPLIT = 5632;
constexpr int CW_SPLITX = 5888;
constexpr int CW_FQ = 6144;
constexpr int CW_BAR = 8192;
#define MK_ONE_LAUNCH 1
namespace refp {

__device__ __forceinline__ float bf2f(bf16 v) { return __uint_as_float((unsigned)v << 16); }
__device__ __forceinline__ bf16 f2b(float f) { unsigned u = __float_as_uint(f); return (bf16)((u + 0x7fffu + ((u >> 16) & 1u)) >> 16); }
__device__ __forceinline__ float wsum(float v) {
#pragma unroll
    for (int o = 1; o < 64; o <<= 1) v += __shfl_xor(v, o);
    return v;
}
__device__ __forceinline__ float wmax(float v) {
#pragma unroll
    for (int o = 1; o < 64; o <<= 1) v = fmaxf(v, __shfl_xor(v, o));
    return v;
}
__device__ __forceinline__ float row_rstd(const float* SS, int t) {
    float s = 0.f;
#pragma unroll
    for (int i = 0; i < 16; ++i) s += SS[(size_t)t * 16 + i];
    return rsqrtf(s * (1.0f / 1024.0f) + RMS_EPS);
}

__global__ void __launch_bounds__(256) k_rowstats(const float* __restrict__ xsrc, bf16* XBdst, int ldxb, float* SS, float* RSTD, float* xcopy) {
    const int t = blockIdx.x * 4 + (threadIdx.x >> 6), lane = threadIdx.x & 63;
    const float* xr = xsrc + (size_t)t * 1024;
    float s = 0.f;
    for (int j = 0; j < 16; ++j) { const int k = lane + 64 * j; const float v = xr[k]; s += v * v; XBdst[(size_t)t * ldxb + k] = f2b(v); if (xcopy) xcopy[(size_t)t * 1024 + k] = v; }
    s = wsum(s);
    if (lane < 16) SS[(size_t)t * 16 + lane] = (lane == 0) ? s : 0.f;
    if (lane == 0) RSTD[t] = rsqrtf(s * (1.0f / 1024.0f) + RMS_EPS);
}
__global__ void k_ref_rstd(const float* __restrict__ SS, float* RSTD) { const int t = blockIdx.x * blockDim.x + threadIdx.x; if (t < T) RSTD[t] = row_rstd(SS, t); }

struct XnormLoader { const float* x; const float* RS; const float* g;
    __device__ __forceinline__ float operator()(int t, int k) const { return x[(size_t)t * 1024 + k] * RS[t] * g[k]; } };
struct Bf16Loader { const bf16* A; int lda; int pad;
    __device__ __forceinline__ float operator()(int t, int k) const { return bf2f(A[(size_t)t * lda + k]); } };
struct F32Loader { const float* A; int lda; int pad;
    __device__ __forceinline__ float operator()(int t, int k) const { return A[(size_t)t * lda + k]; } };

template <class AL, class EPI>
__global__ void __launch_bounds__(256) k_ref_gemm(AL al, const float* __restrict__ W, int ldw, int N, int K, EPI epi) {
    __shared__ float sA[16][65], sB[16][65];
    const int tx = threadIdx.x & 15, ty = threadIdx.x >> 4, t0 = blockIdx.y * 64, n0 = blockIdx.x * 64;
    float acc[4][4] = {};
    for (int k0 = 0; k0 < K; k0 += 16) {
        for (int e = threadIdx.x; e < 1024; e += 256) { const int r = e >> 4, kk = e & 15; sA[kk][r] = al(t0 + r, k0 + kk); }
        for (int e = threadIdx.x; e < 1024; e += 256) { const int kk = e >> 6, c = e & 63; sB[kk][c] = (n0 + c < N) ? W[(size_t)(k0 + kk) * ldw + n0 + c] : 0.f; }
        __syncthreads();
#pragma unroll
        for (int kk = 0; kk < 16; ++kk) {
            float a[4], b[4];
#pragma unroll
            for (int i = 0; i < 4; ++i) { a[i] = sA[kk][ty * 4 + i]; b[i] = sB[kk][tx * 4 + i]; }
#pragma unroll
            for (int i = 0; i < 4; ++i)
#pragma unroll
                for (int j = 0; j < 4; ++j) acc[i][j] += a[i] * b[j];
        }
        __syncthreads();
    }
#pragma unroll
    for (int i = 0; i < 4; ++i)
#pragma unroll
        for (int j = 0; j < 4; ++j) { const int n = n0 + tx * 4 + j; if (n < N) epi(t0 + ty * 4 + i, n, acc[i][j]); }
}
struct EpiStoreF32 { float* C; int ldc; int pad; __device__ __forceinline__ void operator()(int t, int n, float v) const { C[(size_t)t * ldc + n] = v; } };
struct EpiResid { const float* xs; float* xo; __device__ __forceinline__ void operator()(int t, int n, float v) const { xo[(size_t)t * 1024 + n] = xs[(size_t)t * 1024 + n] + v; } };

__global__ void __launch_bounds__(256) k_ref_epi1(const float* __restrict__ C, int cc, int kind, const float* pool_w, const float* pool_scale,
                                                  const float* gain, int rotary, float outscale, const int* positions, bf16* PROJ) {
    __shared__ float row[256];
    const int t = blockIdx.x, j = threadIdx.x;
    row[j] = C[(size_t)t * 256 + j];
    __syncthreads();
    float out;
    if (kind == 0) {
        const int g = 2 * cc + (j >> 7), d = j & 127; float s = 0.f;
        for (int c = 0; c < 128; ++c) s += row[(j & 128) + c] * pool_w[((size_t)g * 128 + c) * 128 + d];
        out = s * pool_scale[g * 128 + d];
    } else if (kind == 1) {
        const int dim = j & 63; float v = row[j];
        const float ss = wsum(v * v);
        v = v * rsqrtf(ss * (1.0f / 64.0f) + RMS_EPS) * gain[dim];
        if (rotary) {
            const float other = __shfl_xor(v, 8);
            if (dim < 16) {
                const int i = dim & 7; const float invf = powf(500000.0f, -(float)(2 * i) / 16.0f);
                const float ang = (float)positions[t] * invf; const float c = cosf(ang), s = sinf(ang);
                v = (dim < 8) ? (v * c - other * s) : (v * c + other * s);
            }
        }
        out = v * outscale;
    } else out = row[j];
    PROJ[(size_t)t * 3584 + 256 * cc + j] = f2b(out);
}
__global__ void k_ref_logf(const float* __restrict__ C8, const float* fb, float* LOGF) {
    const int i = blockIdx.x * blockDim.x + threadIdx.x; if (i >= T * 8) return;
    const float v = C8[i] + fb[i & 7];
    LOGF[i] = fminf(v, 0.f) - log1pf(expf(-fabsf(v)));
}
__global__ void k_ref_fscan(const float* __restrict__ LOGF, float* FCUM) {
    const int i = threadIdx.x; if (i >= 64) return; const int b = i >> 3, h = i & 7; float s = 0.f;
    for (int t = 0; t < S; ++t) { s += LOGF[((size_t)b * S + t) * 8 + h]; FCUM[((size_t)b * S + t) * 8 + h] = s; }
}
__global__ void __launch_bounds__(256) k_ref_fox(const bf16* __restrict__ PROJ, const float* __restrict__ FCUM, bf16* XY) {
    __shared__ float P[4][S];
    const int w = threadIdx.x >> 6, lane = threadIdx.x & 63; const int gw = blockIdx.x * 4 + w; const int t = gw >> 3, h = gw & 7; const int b = t / S, sq = t % S;
    float q[64];
#pragma unroll
    for (int d = 0; d < 64; ++d) q[d] = bf2f(PROJ[(size_t)t * 3584 + 2048 + h * 64 + d]);
    const float Ft = FCUM[(size_t)t * 8 + h];
    float m = -INFINITY;
    for (int j = lane; j <= sq; j += 64) { const bf16* kr = PROJ + ((size_t)b * S + j) * 3584 + 2560 + h * 64; float s = 0.f;
#pragma unroll
        for (int d = 0; d < 64; ++d) s += q[d] * bf2f(kr[d]);
        s += (Ft - FCUM[((size_t)b * S + j) * 8 + h]) * 1.4426950408889634f; P[w][j] = s; m = fmaxf(m, s); }
    m = wmax(m); float l = 0.f;
    for (int j = lane; j <= sq; j += 64) { const float p = exp2f(P[w][j] - m); P[w][j] = p; l += p; }
    l = wsum(l);
    __syncthreads();
    float o = 0.f;
    for (int j = 0; j <= sq; ++j) o += P[w][j] * bf2f(PROJ[((size_t)b * S + j) * 3584 + 3072 + h * 64 + lane]);
    XY[(size_t)t * 2560 + 1024 + h * 64 + lane] = f2b(o / l);
}
__global__ void __launch_bounds__(128) k_ref_diff(const bf16* __restrict__ PROJ, const float* __restrict__ lamp, const float* __restrict__ gsub, float lam_init, bf16* XY) {
    __shared__ float P[2][2][S];
    const int w = threadIdx.x >> 6, lane = threadIdx.x & 63; const int gw = blockIdx.x * 2 + w; const int t = gw >> 2, h = gw & 3; const int b = t / S, sq = t % S;
    float lam; { const float a = wsum(lamp[lane] * lamp[64 + lane]), c = wsum(lamp[128 + lane] * lamp[192 + lane]); lam = expf(a) - expf(c) + lam_init; }
    float linv[2];
    for (int c = 0; c < 2; ++c) {
        float q[64];
#pragma unroll
        for (int d = 0; d < 64; ++d) q[d] = bf2f(PROJ[(size_t)t * 3584 + 512 + (h * 2 + c) * 64 + d]);
        float m = -INFINITY;
        for (int j = lane; j <= sq; j += 64) { const bf16* kr = PROJ + ((size_t)b * S + j) * 3584 + 1024 + (h * 2 + c) * 64; float s = 0.f;
    #pragma unroll
        for (int d = 0; d < 64; ++d) s += q[d] * bf2f(kr[d]);
            P[w][c][j] = s; m = fmaxf(m, s); }
        m = wmax(m); float l = 0.f;
        for (int j = lane; j <= sq; j += 64) { const float p = exp2f(P[w][c][j] - m); P[w][c][j] = p; l += p; }
        linv[c] = 1.0f / wsum(l);
    }
    __syncthreads();
    float o0 = 0.f, o1 = 0.f;
    for (int j = 0; j <= sq; ++j) { const float a = P[w][0][j] * linv[0] - lam * P[w][1][j] * linv[1]; const bf16* vr = PROJ + ((size_t)b * S + j) * 3584 + 1536 + h * 128;
        o0 += a * bf2f(vr[lane]); o1 += a * bf2f(vr[64 + lane]); }
    const float ss = wsum(o0 * o0 + o1 * o1); const float r = rsqrtf(ss * (1.0f / 128.0f) + RMS_EPS) * (1.0f - lam_init);
    XY[(size_t)t * 2560 + 512 + h * 128 + lane] = f2b(o0 * r * gsub[lane]);
    XY[(size_t)t * 2560 + 512 + h * 128 + 64 + lane] = f2b(o1 * r * gsub[64 + lane]);
}
__global__ void k_ref_pool(const bf16* __restrict__ PROJ, bf16* XY) {
    const int i = blockIdx.x * blockDim.x + threadIdx.x; if (i >= T * 512) return; const int t = i >> 9, j = i & 511; const int g = j >> 7, w = 2 << g, s = t % S;
    const int cnt = min(s + 1, w); float a = 0.f;
    for (int k = 0; k < cnt; ++k) a += bf2f(PROJ[(size_t)(t - k) * 3584 + j]);
    XY[(size_t)t * 2560 + j] = f2b(a / (float)cnt - bf2f(PROJ[(size_t)t * 3584 + j]));
}
__global__ void __launch_bounds__(256) k_ref_gemm2(const float* __restrict__ x, const float* __restrict__ SS, const float* __restrict__ g, const float* __restrict__ w_in_l,
                                                   const float* __restrict__ w_branch_l, const bf16* __restrict__ XY, bf16* MERGED) {
    __shared__ float sA[16][65], sB[16][65];
    const int tx = threadIdx.x & 15, ty = threadIdx.x >> 4, t0 = blockIdx.y * 64, n0 = blockIdx.x * 64;
    float mg[4][4] = {};
    for (int n = 0; n < 3; ++n) {
        float ag[4][4] = {}, ab[4][4] = {};
        for (int pass = 0; pass < 2; ++pass) {
            const int K = pass == 0 ? 1024 : 512;
            for (int k0 = 0; k0 < K; k0 += 16) {
                for (int e = threadIdx.x; e < 1024; e += 256) { const int r = e >> 4, kk = e & 15; const int t = t0 + r, k = k0 + kk;
                    sA[kk][r] = pass == 0 ? x[(size_t)t * 1024 + k] * SS[t] * g[k] : bf2f(XY[(size_t)t * 2560 + 512 * n + k]); }
                for (int e = threadIdx.x; e < 1024; e += 256) { const int kk = e >> 6, c = e & 63; const int k = k0 + kk;
                    sB[kk][c] = pass == 0 ? w_in_l[(size_t)k * INW + 3592 + n * 1024 + n0 + c] : w_branch_l[((size_t)n * 512 + k) * 1024 + n0 + c]; }
                __syncthreads();
#pragma unroll
                for (int kk = 0; kk < 16; ++kk) {
                    float a[4], b[4];
#pragma unroll
                    for (int i = 0; i < 4; ++i) { a[i] = sA[kk][ty * 4 + i]; b[i] = sB[kk][tx * 4 + i]; }
#pragma unroll
                    for (int i = 0; i < 4; ++i)
#pragma unroll
                        for (int j = 0; j < 4; ++j) { if (pass == 0) ag[i][j] += a[i] * b[j]; else ab[i][j] += a[i] * b[j]; }
                }
                __syncthreads();
            }
        }
#pragma unroll
        for (int i = 0; i < 4; ++i)
#pragma unroll
            for (int j = 0; j < 4; ++j) mg[i][j] += ab[i][j] / (1.0f + expf(-ag[i][j]));
    }
#pragma unroll
    for (int i = 0; i < 4; ++i)
#pragma unroll
        for (int j = 0; j < 4; ++j) MERGED[(size_t)(t0 + ty * 4 + i) * 1024 + n0 + tx * 4 + j] = f2b(mg[i][j]);
}
__global__ void __launch_bounds__(256) k_ref_moe(float* X, const float* __restrict__ SS, const float* __restrict__ g, const int* __restrict__ cls_cnt, const int* __restrict__ LIST,
                                                 const float* __restrict__ TOKW, const float* __restrict__ wg_l, const float* __restrict__ wu_l, const float* __restrict__ wd_l) {
    __shared__ float h[8][1024]; __shared__ float act[8][512]; __shared__ int tok[8];
    const int cls = blockIdx.y, n_c = cls_cnt[cls], base = blockIdx.x * 8; if (base >= n_c) return;
    const int nt = min(8, n_c - base), tid = threadIdx.x;
    if (tid < 8) tok[tid] = tid < nt ? LIST[(size_t)cls * T + base + tid] : -1;
    __syncthreads();
    for (int e = tid; e < 8 * 1024; e += 256) { const int i = e >> 10, k = e & 1023; const int t = tok[i]; h[i][k] = t >= 0 ? X[(size_t)t * 1024 + k] * SS[t] * g[k] : 0.f; }
    __syncthreads();
    const int grp = cls / 6, pr = cls % 6; const int pa = pr < 3 ? 0 : (pr < 5 ? 1 : 2), pb = pr < 3 ? pr + 1 : (pr < 5 ? pr - 1 : 3); const int ea = grp * 4 + pa, eb = grp * 4 + pb;
    for (int s = 0; s < 2; ++s) { const int e = s ? eb : ea; float ga[8], ua[8];
#pragma unroll
        for (int i = 0; i < 8; ++i) { ga[i] = 0.f; ua[i] = 0.f; }
        const float* wg = wg_l + (size_t)e * 1024 * 256 + tid; const float* wu = wu_l + (size_t)e * 1024 * 256 + tid;
        for (int k = 0; k < 1024; ++k) { const float a = wg[(size_t)k * 256], u = wu[(size_t)k * 256];
#pragma unroll
            for (int i = 0; i < 8; ++i) { ga[i] += h[i][k] * a; ua[i] += h[i][k] * u; } }
#pragma unroll
        for (int i = 0; i < 8; ++i) { const int t = tok[i]; const float w = t >= 0 ? TOKW[(size_t)t * 4 + s] : 0.f; act[i][s * 256 + tid] = ga[i] / (1.0f + expf(-ga[i])) * ua[i] * w; } }
    __syncthreads();
    for (int j = 0; j < 4; ++j) { const int n = tid + 256 * j; float y[8];
#pragma unroll
        for (int i = 0; i < 8; ++i) y[i] = 0.f;
        for (int s = 0; s < 2; ++s) { const int e = s ? eb : ea; const float* wd = wd_l + (size_t)e * 256 * 1024 + n;
            for (int f = 0; f < 256; ++f) { const float w = wd[(size_t)f * 1024];
#pragma unroll
                for (int i = 0; i < 8; ++i) y[i] += act[i][s * 256 + f] * w; } }
#pragma unroll
        for (int i = 0; i < 8; ++i) { const int t = tok[i]; if (t >= 0) X[(size_t)t * 1024 + n] += y[i]; } }
}
__global__ void __launch_bounds__(256) k_ref_ple(const float* __restrict__ x, const float* __restrict__ SS, const float* __restrict__ g, const float* __restrict__ wgate_l,
                                                 const float* __restrict__ p_l, const float* __restrict__ wple_l, float* xo) {
    __shared__ float sA[16][65], sB[16][65];
    const int tx = threadIdx.x & 15, ty = threadIdx.x >> 4, t0 = blockIdx.y * 64, n0 = blockIdx.x * 64;
    float ag[4][4] = {}, ab[4][4] = {};
    for (int pass = 0; pass < 2; ++pass) {
        const int K = pass == 0 ? 1024 : 256;
        for (int k0 = 0; k0 < K; k0 += 16) {
            for (int e = threadIdx.x; e < 1024; e += 256) { const int r = e >> 4, kk = e & 15; const int t = t0 + r, k = k0 + kk;
                sA[kk][r] = pass == 0 ? x[(size_t)t * 1024 + k] * SS[t] * g[k] : p_l[(size_t)t * 256 + k]; }
            for (int e = threadIdx.x; e < 1024; e += 256) { const int kk = e >> 6, c = e & 63; const int k = k0 + kk;
                sB[kk][c] = pass == 0 ? wgate_l[(size_t)k * 1024 + n0 + c] : wple_l[(size_t)k * 1024 + n0 + c]; }
            __syncthreads();
#pragma unroll
            for (int kk = 0; kk < 16; ++kk) {
                float a[4], b[4];
#pragma unroll
                for (int i = 0; i < 4; ++i) { a[i] = sA[kk][ty * 4 + i]; b[i] = sB[kk][tx * 4 + i]; }
#pragma unroll
                for (int i = 0; i < 4; ++i)
#pragma unroll
                    for (int j = 0; j < 4; ++j) { if (pass == 0) ag[i][j] += a[i] * b[j]; else ab[i][j] += a[i] * b[j]; }
            }
            __syncthreads();
        }
    }
#pragma unroll
    for (int i = 0; i < 4; ++i)
#pragma unroll
        for (int j = 0; j < 4; ++j) { const size_t o = (size_t)(t0 + ty * 4 + i) * 1024 + n0 + tx * 4 + j; xo[o] = x[o] + ab[i][j] / (1.0f + expf(-ag[i][j])); }
}
}
__device__ __forceinline__ int route_decide(const float (&dg)[4], const float (&de)[16], const float rstd, const float* __restrict__ brg, const float* __restrict__ bre, float& wa, float& wb) {
    float lg[4]; int gi = 0; float lmax;
#pragma unroll
    for (int e = 0; e < 4; ++e) lg[e] = rstd * dg[e] + brg[e];
    lmax = lg[0];
#pragma unroll
    for (int e = 1; e < 4; ++e) if (lg[e] > lmax) { lmax = lg[e]; gi = e; }
    float den = 0.f;
#pragma unroll
    for (int e = 0; e < 4; ++e) den += expf(lg[e] - lmax);
    const float gp = 1.0f / den;
    float el[4] = {0.f, 0.f, 0.f, 0.f};
#pragma unroll
    for (int gg = 0; gg < 4; ++gg)
#pragma unroll
        for (int e = 0; e < 4; ++e) if (gg == gi) el[e] = rstd * de[gg * 4 + e] + bre[gg * 4 + e];
    int i1 = 0; float m1 = el[0];
#pragma unroll
    for (int e = 1; e < 4; ++e) if (el[e] > m1) { m1 = el[e]; i1 = e; }
    int i2 = -1; float m2 = -INFINITY;
#pragma unroll
    for (int e = 0; e < 4; ++e) if (e != i1 && el[e] > m2) { m2 = el[e]; i2 = e; }
    const float r2 = expf(m2 - m1); const float w1 = gp / (1.0f + r2), w2 = gp * r2 / (1.0f + r2);
    const int a = min(i1, i2), b = max(i1, i2); const int pr = (a == 0) ? (b - 1) : ((a == 1) ? (b + 1) : 5); const int cls = gi * 6 + pr;
    wa = i1 == a ? w1 : w2; wb = i1 == a ? w2 : w1;
    return cls;
}
__device__ __forceinline__ int route_core(int t, int lane, const float* __restrict__ X, const float* __restrict__ g, const float* __restrict__ wrg, const float* __restrict__ brg,
                                          const float* __restrict__ wre, const float* __restrict__ bre, float* TOKW) {
    float ss = 0.f, dg[4] = {0.f, 0.f, 0.f, 0.f}, de[16];
#pragma unroll
    for (int e = 0; e < 16; ++e) de[e] = 0.f;
#pragma unroll 4
    for (int i = 0; i < 16; ++i) { const int k = lane + 64 * i; const float xv = X[(size_t)t * 1024 + k]; ss += xv * xv; const float h = xv * g[k];
        const float4 a = *(const float4*)(wrg + (size_t)k * 4); dg[0] += h * a.x; dg[1] += h * a.y; dg[2] += h * a.z; dg[3] += h * a.w;
#pragma unroll
        for (int q = 0; q < 4; ++q) { const float4 b = *(const float4*)(wre + (size_t)k * 16 + 4 * q); de[4 * q] += h * b.x; de[4 * q + 1] += h * b.y; de[4 * q + 2] += h * b.z; de[4 * q + 3] += h * b.w; } }
    ss = refp::wsum(ss);
#pragma unroll
    for (int e = 0; e < 4; ++e) dg[e] = refp::wsum(dg[e]);
#pragma unroll
    for (int e = 0; e < 16; ++e) de[e] = refp::wsum(de[e]);
    const float rstd = rsqrtf(ss * (1.0f / 1024.0f) + RMS_EPS);
    float wa, wb; const int cls = route_decide(dg, de, rstd, brg, bre, wa, wb);
    if (lane == 0) *(float4*)(TOKW + (size_t)t * 4) = make_float4(wa, wb, rstd, 0.f);
    return cls;
}
__device__ __forceinline__ void route_token(int t, int lane, const float* __restrict__ X, const float* __restrict__ g, const float* __restrict__ wrg, const float* __restrict__ brg,
                                            const float* __restrict__ wre, const float* __restrict__ bre, unsigned* cls_cnt, int* LIST, float* TOKW) {
    const int cls = route_core(t, lane, X, g, wrg, brg, wre, bre, TOKW);
    if (lane == 0) { const unsigned pos = atomicAdd(cls_cnt + cls, 1u); LIST[(size_t)cls * T + pos] = t; }
}
__global__ void __launch_bounds__(256) k_route(const float* X, const float* g, const float* wrg, const float* brg, const float* wre, const float* bre, unsigned* cls_cnt, int* LIST, float* TOKW) {
    const int t = blockIdx.x * 4 + (threadIdx.x >> 6);
    route_token(t, threadIdx.x & 63, X, g, wrg, brg, wre, bre, cls_cnt, LIST, TOKW);
}

namespace pg8 {
#define PG8_LAS __attribute__((address_space(3)))
typedef short bf16x8 __attribute__((ext_vector_type(8)));
typedef float f32x4 __attribute__((ext_vector_type(4)));
typedef unsigned u32x4 __attribute__((ext_vector_type(4)));
typedef int i32x4 __attribute__((ext_vector_type(4)));
typedef int i32x8 __attribute__((ext_vector_type(8)));
__device__ __forceinline__ i32x8 cat8(bf16x8 lo, bf16x8 hi) { const i32x4 a = __builtin_bit_cast(i32x4, lo), b = __builtin_bit_cast(i32x4, hi); return __builtin_shufflevector(a, b, 0, 1, 2, 3, 4, 5, 6, 7); }
constexpr int BM = 256, BK = 64, HALF = 128, HTB = HALF * BK * 2, STAGE_BYTES = 8 * HTB;

__host__ __device__ __forceinline__ int lds_byte(int r, int c) { const int st = (r >> 4) * 2 + (c >> 5), rr = r & 15, cc = c & 31, ob = rr * 64 + cc * 2; return st * 1024 + (ob ^ (((ob >> 9) & 1) << 5)); }
__host__ __device__ __forceinline__ void stage_rc(int b, int& R, int& C) { const int st = b / 1024, sb = b % 1024, swz = sb ^ (((sb >> 9) & 1) << 5); R = (st >> 1) * 16 + swz / 64; C = (st & 1) * 32 + (swz % 64) / 2; }
__host__ __device__ __forceinline__ int perm32(int rho) { const int n = rho >> 4, i = rho & 15; return 8 * (i >> 2) + 4 * n + (i & 3); }

struct Step { const char* A; const char* B; const int* rows; int nt, pm, pn, aux, nvalid, zero_after; };
__device__ __forceinline__ int rfl(int v) { return __builtin_amdgcn_readfirstlane(v); }
template <class P> __device__ __forceinline__ P rflp(P p) { const unsigned long long u = (unsigned long long)p; const unsigned lo = (unsigned)__builtin_amdgcn_readfirstlane((int)(unsigned)u), hi = (unsigned)__builtin_amdgcn_readfirstlane((int)(unsigned)(u >> 32)); return (P)(((unsigned long long)hi << 32) | lo); }
__device__ __forceinline__ void step_uniform(Step& s, int& ok) {
    s.A = rflp(s.A); s.B = rflp(s.B); s.rows = rflp(s.rows); s.nt = rfl(s.nt); s.pm = rfl(s.pm); s.pn = rfl(s.pn); s.aux = rfl(s.aux); s.nvalid = rfl(s.nvalid); s.zero_after = rfl(s.zero_after); ok = rfl(ok);
    asm volatile("" : "+s"(ok), "+s"(s.A), "+s"(s.B), "+s"(s.nt), "+s"(s.aux));
}

template <class Sched, class Epi, bool GATHER, bool ALIGN_EPI, bool F8 = false>
__device__ __forceinline__ void gemm_phase(const int tid, PG8_LAS unsigned char* lds, const unsigned lda, const unsigned ldb, const Sched& S, const Epi& E) {
    const int wid = __builtin_amdgcn_readfirstlane(tid >> 6), lane = tid & 63, wr = wid >> 2, wc = wid & 3, fr = lane & 15, fq = lane >> 4;
    int Rr[2], Cc[2]; unsigned voffB[2], cOA[2][2], nOA[2][2];
#pragma unroll
    for (int i = 0; i < 2; ++i) { stage_rc(tid * 16 + i * 8192, Rr[i], Cc[i]); const int Rb = (Rr[i] & ~31) + perm32(Rr[i] & 31); voffB[i] = (unsigned)Rb * ldb + (unsigned)Cc[i] * 2u; }
    const size_t kstep = (size_t)(BK * 2);
    const size_t hstepB = (size_t)HALF * ldb;
    const unsigned ldsw = (unsigned)wid * 1024u;
    const int aoff = lds_byte(wr * 64 + fr, fq * 8), boff = lds_byte(wc * 32 + fr, fq * 8);
#define PG8_SA(b, h) (((b) * 2 + (h)) * HTB)
#define PG8_SB(b, h) ((4 + (b) * 2 + (h)) * HTB)
#define PG8_STAGE_B(bufoff, gbase) do { _Pragma("unroll") for (int _i = 0; _i < 2; ++_i) \
        __builtin_amdgcn_global_load_lds((const unsigned*)((const char*)(gbase) + voffB[_i]), (PG8_LAS unsigned*)(lds + (bufoff) + ldsw + _i * 8192), 16, 0, 0); } while (0)
#define PG8_STAGE_A(bufoff, gbase, o0, o1) do { \
        __builtin_amdgcn_global_load_lds((const unsigned*)((const char*)(gbase) + (o0)), (PG8_LAS unsigned*)(lds + (bufoff) + ldsw), 16, 0, 0); \
        __builtin_amdgcn_global_load_lds((const unsigned*)((const char*)(gbase) + (o1)), (PG8_LAS unsigned*)(lds + (bufoff) + ldsw + 8192), 16, 0, 0); } while (0)
#define PG8_LDA(dst, b, h) do { _Pragma("unroll") for (int m = 0; m < 4; ++m) _Pragma("unroll") for (int k = 0; k < 2; ++k) dst[m][k] = *(const PG8_LAS bf16x8*)(lds + PG8_SA(b, h) + aoff + m * 2048 + k * 1024); } while (0)
#define PG8_LDB(dst, b, h) do { _Pragma("unroll") for (int n = 0; n < 2; ++n) _Pragma("unroll") for (int k = 0; k < 2; ++k) dst[n][k] = *(const PG8_LAS bf16x8*)(lds + PG8_SB(b, h) + boff + n * 2048 + k * 1024); } while (0)
#define PG8_MMA(ai, bj, At, Bt) do { __builtin_amdgcn_s_setprio(1); \
        if constexpr (F8) { _Pragma("unroll") for (int m = 0; m < 4; ++m) _Pragma("unroll") for (int n = 0; n < 2; ++n) \
            asm volatile("v_mfma_scale_f32_16x16x128_f8f6f4 %0, %1, %2, %0, %3, %3 op_sel_hi:[0,0,0]" : "+v"(acc[ai][bj][m][n]) : "v"(cat8(Bt[n][0], Bt[n][1])), "v"(cat8(At[m][0], At[m][1])), "v"(f8scale)); } \
        else { _Pragma("unroll") for (int m = 0; m < 4; ++m) _Pragma("unroll") for (int n = 0; n < 2; ++n) _Pragma("unroll") for (int k = 0; k < 2; ++k) \
            acc[ai][bj][m][n] = __builtin_amdgcn_mfma_f32_16x16x32_bf16(Bt[n][k], At[m][k], acc[ai][bj][m][n], 0, 0, 0); } \
        __builtin_amdgcn_s_setprio(0); } while (0)
#define PG8_WAIT_V(n) asm volatile("s_waitcnt vmcnt(" #n ")" ::: "memory")
#define PG8_WAIT_L(n) asm volatile("s_waitcnt lgkmcnt(" #n ")" ::: "memory")
#define PG8_BAR __builtin_amdgcn_s_barrier()
#define PG8_SCHED __builtin_amdgcn_sched_barrier(0)
#define PG8_AOFFS(dst, st) do { _Pragma("unroll") for (int _h = 0; _h < 2; ++_h) _Pragma("unroll") for (int _i = 0; _i < 2; ++_i) { \
        int _row = Rr[_i] + 128 * _h; if (GATHER) { _row = (st).rows[_row]; _row = _row < 0 ? 0 : _row; } \
        dst[_h][_i] = (unsigned)_row * lda + (unsigned)Cc[_i] * 2u; } } while (0)
    int f8scale = 0x7F7F7F7F; if constexpr (F8) asm volatile("" : "+v"(f8scale));
    Step cur, nxt; int ui = 0;
    { int ok_ = S.next(0, cur) ? 1 : 0; step_uniform(cur, ok_); if (!ok_) return; }
    f32x4 acc[2][2][4][2];
#pragma unroll
    for (int a = 0; a < 2; ++a)
#pragma unroll
        for (int b = 0; b < 2; ++b)
#pragma unroll
            for (int m = 0; m < 4; ++m)
#pragma unroll
                for (int n = 0; n < 2; ++n) acc[a][b][m][n] = (f32x4){0.f, 0.f, 0.f, 0.f};
    bf16x8 At[4][2], B0[2][2], B1[2][2];
    PG8_AOFFS(cOA, cur);
    const char* cA = cur.A; const char* cB = cur.B;
    PG8_STAGE_B(PG8_SB(0, 0), cB); PG8_STAGE_B(PG8_SB(0, 1), cB + hstepB); PG8_STAGE_A(PG8_SA(0, 0), cA, cOA[0][0], cOA[0][1]); PG8_STAGE_A(PG8_SA(0, 1), cA, cOA[1][0], cOA[1][1]);
    if (wr == 1) PG8_BAR;
    PG8_WAIT_V(2); PG8_BAR;
    PG8_STAGE_B(PG8_SB(1, 0), cB + kstep); PG8_STAGE_A(PG8_SA(1, 0), cA + kstep, cOA[0][0], cOA[0][1]); PG8_STAGE_B(PG8_SB(1, 1), cB + hstepB + kstep);
    PG8_WAIT_V(6); PG8_BAR;
#pragma clang loop unroll(disable)
    for (;;) {
        bool has_next = S.next(ui + 1, nxt);
        { int hn_ = has_next ? 1 : 0; step_uniform(nxt, hn_); has_next = hn_ != 0; }
        asm volatile("" : "+v"(voffB[0]), "+v"(voffB[1]));
        const char* nA = has_next ? nxt.A : cA; const char* nB = has_next ? nxt.B : cB;
        if (GATHER) { if (has_next) { PG8_AOFFS(nOA, nxt); } else {
#pragma unroll
            for (int _h = 0; _h < 2; ++_h)
#pragma unroll
                for (int _i = 0; _i < 2; ++_i) nOA[_h][_i] = cOA[_h][_i]; } }
        const int nt = cur.nt;
#pragma clang loop unroll(disable)
        for (int t = 0; t < nt; t += 2) {
            const bool last = (t == nt - 2);
            const char* a1 = cA + (size_t)(t + 1) * kstep;
            const char* a2 = last ? nA : cA + (size_t)(t + 2) * kstep; const char* b2 = last ? nB : cB + (size_t)(t + 2) * kstep;
            const char* a3 = a2 + kstep; const char* b3 = b2 + kstep;
            unsigned o00, o01, o10, o11;
            if (GATHER) { o00 = last ? nOA[0][0] : cOA[0][0]; o01 = last ? nOA[0][1] : cOA[0][1]; o10 = last ? nOA[1][0] : cOA[1][0]; o11 = last ? nOA[1][1] : cOA[1][1]; }
            else { o00 = cOA[0][0]; o01 = cOA[0][1]; o10 = cOA[1][0]; o11 = cOA[1][1]; }
            PG8_LDB(B0, 0, 0); PG8_LDB(B1, 0, 1); PG8_SCHED; PG8_LDA(At, 0, 0); PG8_STAGE_A(PG8_SA(1, 1), a1, cOA[1][0], cOA[1][1]);
            PG8_WAIT_V(8); PG8_WAIT_L(0); PG8_BAR; PG8_MMA(0, 0, At, B0); PG8_MMA(0, 1, At, B1); PG8_BAR; PG8_SCHED;
            PG8_LDA(At, 0, 1); PG8_STAGE_B(PG8_SB(0, 0), b2); PG8_STAGE_B(PG8_SB(0, 1), b2 + hstepB); PG8_STAGE_A(PG8_SA(0, 0), a2, o00, o01);
            PG8_WAIT_V(8); PG8_WAIT_L(0); PG8_BAR; PG8_MMA(1, 0, At, B0); PG8_MMA(1, 1, At, B1); PG8_BAR; PG8_SCHED;
            PG8_LDB(B0, 1, 0); PG8_LDB(B1, 1, 1); PG8_SCHED; PG8_LDA(At, 1, 0); PG8_STAGE_A(PG8_SA(0, 1), a2, o10, o11);
            PG8_WAIT_V(8); PG8_WAIT_L(0); PG8_BAR; PG8_MMA(0, 0, At, B0); PG8_MMA(0, 1, At, B1); PG8_BAR; PG8_SCHED;
            PG8_LDA(At, 1, 1); PG8_STAGE_B(PG8_SB(1, 0), b3); PG8_STAGE_B(PG8_SB(1, 1), b3 + hstepB); PG8_STAGE_A(PG8_SA(1, 0), a3, o00, o01);
            PG8_WAIT_V(8); PG8_WAIT_L(0); PG8_BAR; PG8_MMA(1, 0, At, B0); PG8_MMA(1, 1, At, B1); PG8_BAR; PG8_SCHED;
        }
        if constexpr (F8) { asm volatile("s_nop 15\n\ts_nop 15" ::: "memory"); }
        if constexpr (ALIGN_EPI) { if (wr == 0) PG8_BAR; }
        { int ln_; asm volatile("v_mbcnt_lo_u32_b32 %0, -1, 0\n\tv_mbcnt_hi_u32_b32 %0, -1, %0" : "=v"(ln_));
          E(acc, cur, wr, wc, ln_ & 15, ln_ >> 4); }
        if (!has_next) break;
        if (cur.zero_after) {
#pragma unroll
            for (int a = 0; a < 2; ++a)
#pragma unroll
                for (int b = 0; b < 2; ++b)
#pragma unroll
                    for (int m = 0; m < 4; ++m)
#pragma unroll
                        for (int n = 0; n < 2; ++n) acc[a][b][m][n] = (f32x4){0.f, 0.f, 0.f, 0.f};
        }
        cur = nxt; cA = nA; cB = nB; ++ui;
        if (GATHER) {
#pragma unroll
            for (int _h = 0; _h < 2; ++_h)
#pragma unroll
                for (int _i = 0; _i < 2; ++_i) cOA[_h][_i] = nOA[_h][_i]; }
        if constexpr (ALIGN_EPI) { if (wr == 1) PG8_BAR; }
    }
    PG8_WAIT_V(0);
    if constexpr (!ALIGN_EPI) { if (wr == 0) PG8_BAR; }
    PG8_BAR;
#undef PG8_SA
#undef PG8_SB
#undef PG8_STAGE_A
#undef PG8_STAGE_B
#undef PG8_LDA
#undef PG8_LDB
#undef PG8_MMA
#undef PG8_WAIT_V
#undef PG8_WAIT_L
#undef PG8_BAR
#undef PG8_SCHED
#undef PG8_AOFFS
}
}
#include <hip/hip_bf16.h>
namespace attn_body {
using hbf16=__hip_bfloat16;
using bf16x8=__attribute__((ext_vector_type(8)))short;
using s16x4=__attribute__((ext_vector_type(4)))short;
using f32x16=__attribute__((ext_vector_type(16)))float;
using u32x4=__attribute__((ext_vector_type(4)))unsigned;
constexpr int SEQ=2048,D=64,DM=3584;
constexpr int NW=8,QBLK=32,QB=QBLK*NW,KVBLK=64,NQB=SEQ/QB;
__device__ __forceinline__ int crow(int r,int hi){return (r&3)+8*(r>>2)+4*hi;}
#define SBAR() __builtin_amdgcn_sched_barrier(0)
__device__ __forceinline__ void cmask(f32x16&p0,f32x16&p1,int jb,int qrel,int hi){
  const float NEG=-INFINITY; int kb=64*jb+4*hi;
  #pragma unroll
  for(int r=0;r<16;++r){int kv=kb+(r&3)+8*(r>>2); if(kv>qrel)p0[r]=NEG; if(kv+32>qrel)p1[r]=NEG;}
}

constexpr int NSLOT=3, SLOTB=8192;
constexpr int LDS_K=0, LDS_V=NSLOT*SLOTB, LDS_WS=2*NSLOT*SLOTB, LDS_OST=LDS_WS+NW*64*4, LDS_BIAS=LDS_OST+NW*4096, LDS_SSQ=LDS_BIAS+SEQ*4, LDS_BYTES=LDS_SSQ+NW*32*4;
constexpr float C2=0.125f*1.4426950408889634f;
__device__ __forceinline__ void glds16(const void*gsrc,unsigned lds_dst){unsigned keep;
  asm volatile("s_mov_b32 %0, m0\n\ts_mov_b32 m0, %2\n\ts_nop 0\n\tglobal_load_lds_dwordx4 %1, off\n\ts_mov_b32 m0, %0":"=&s"(keep):"v"(gsrc),"s"(lds_dst):"memory");}
__device__ __forceinline__ float max3f(float a,float b,float c){float r;asm("v_max3_f32 %0, %1, %2, %3":"=v"(r):"v"(a),"v"(b),"v"(c));return r;}
__device__ __forceinline__ float max2f(float a,float b){float r;asm("v_max_f32_e32 %0, %1, %2":"=v"(r):"v"(a),"v"(b));return r;}
__device__ __forceinline__ float fadd_s(float a,float b){float r;asm("v_add_f32_e32 %0, %1, %2":"=v"(r):"v"(a),"v"(b));return r;}
__device__ __forceinline__ float fsub_s(float a,float b){float r;asm("v_sub_f32_e32 %0, %1, %2":"=v"(r):"v"(a),"v"(b));return r;}
typedef float f32x2_t __attribute__((ext_vector_type(2))); typedef float f32x4_t __attribute__((ext_vector_type(4))); typedef __bf16 bf16x2_t __attribute__((ext_vector_type(2)));
__device__ __forceinline__ unsigned cvtpk_s(float lo,float hi){f32x2_t v={lo,hi};bf16x2_t b=__builtin_convertvector(v,bf16x2_t);return __builtin_bit_cast(unsigned,b);}
#define WAIT_BAR(N) asm volatile("s_waitcnt vmcnt(" #N ") lgkmcnt(0)\n\ts_barrier":::"memory")

__device__ __forceinline__ void qkt(f32x16&p0,f32x16&p1,const char*Kslot,const bf16x8*qr,const f32x16&negm,int r32,int hi){
  const char*kb=Kslot+hi*1024+r32*16;
  #pragma unroll
  for(int d0=0;d0<4;++d0){
    const bf16x8 b0=*reinterpret_cast<const bf16x8*>(kb+d0*2048);
    const bf16x8 b1=*reinterpret_cast<const bf16x8*>(kb+d0*2048+512);
    if(d0==0){p0=__builtin_amdgcn_mfma_f32_32x32x16_bf16(b0,qr[0],negm,0,0,0);p1=__builtin_amdgcn_mfma_f32_32x32x16_bf16(b1,qr[0],negm,0,0,0);}
    else{p0=__builtin_amdgcn_mfma_f32_32x32x16_bf16(b0,qr[d0],p0,0,0,0);p1=__builtin_amdgcn_mfma_f32_32x32x16_bf16(b1,qr[d0],p1,0,0,0);}}
}
typedef __attribute__((address_space(3))) const char* lds_cptr;
typedef short v4i16_t __attribute__((ext_vector_type(4)));
__device__ __forceinline__ void kload8(bf16x8*kf,lds_cptr kp){
  kf[0]=*(const __attribute__((address_space(3))) bf16x8*)(kp);      kf[1]=*(const __attribute__((address_space(3))) bf16x8*)(kp+512);
  kf[2]=*(const __attribute__((address_space(3))) bf16x8*)(kp+2048); kf[3]=*(const __attribute__((address_space(3))) bf16x8*)(kp+2560);
  kf[4]=*(const __attribute__((address_space(3))) bf16x8*)(kp+4096); kf[5]=*(const __attribute__((address_space(3))) bf16x8*)(kp+4608);
  kf[6]=*(const __attribute__((address_space(3))) bf16x8*)(kp+6144); kf[7]=*(const __attribute__((address_space(3))) bf16x8*)(kp+6656);
}
__device__ __forceinline__ void kload2(bf16x8*kf,lds_cptr kp,int j){ kf[2*j]=*(const __attribute__((address_space(3))) bf16x8*)(kp+j*2048); kf[2*j+1]=*(const __attribute__((address_space(3))) bf16x8*)(kp+j*2048+512); }
__device__ __forceinline__ s16x4 vtr(lds_cptr p){ return __builtin_bit_cast(s16x4,__builtin_amdgcn_ds_read_tr16_b64_v4i16((__attribute__((address_space(3))) v4i16_t*)p)); }
__device__ __forceinline__ float rowmax(const f32x16&p0,const f32x16&p1){
  float a=max3f(p0[0],p0[1],p1[0]),b=max3f(p0[2],p0[3],p1[1]);a=max3f(a,p1[2],p1[3]);
  #pragma unroll
  for(int r=4;r<16;r+=4){a=max3f(a,p0[r],p0[r+1]);b=max3f(b,p0[r+2],p0[r+3]);a=max3f(a,p1[r],p1[r+1]);b=max3f(b,p1[r+2],p1[r+3]);}
  const float m=max2f(a,b);
  auto rr=__builtin_amdgcn_permlane32_swap(__float_as_uint(m),__float_as_uint(m),false,false);
  return max2f(__uint_as_float(rr[0]),__uint_as_float(rr[1]));
}
__device__ __forceinline__ void pv(f32x16*o,int vb,bf16x8 pa0,bf16x8 pa1,bf16x8 pa2,bf16x8 pa3){
  #pragma unroll
  for(int d0=0;d0<2;++d0){s16x4 lo[4],hi[4];
    #pragma unroll
    for(int ks=0;ks<4;++ks){
      asm volatile("ds_read_b64_tr_b16 %0,%1 offset:%c2":"=&v"(lo[ks]):"v"(vb),"i"(d0*4096+ks*1024):"memory");
      asm volatile("ds_read_b64_tr_b16 %0,%1 offset:%c2":"=&v"(hi[ks]):"v"(vb),"i"(d0*4096+ks*1024+512):"memory");}
    asm volatile("s_waitcnt lgkmcnt(0)":::"memory");SBAR();
    #define PK(k) (bf16x8){lo[k][0],lo[k][1],lo[k][2],lo[k][3],hi[k][0],hi[k][1],hi[k][2],hi[k][3]}
    o[d0]=__builtin_amdgcn_mfma_f32_32x32x16_bf16(pa0,PK(0),o[d0],0,0,0);
    o[d0]=__builtin_amdgcn_mfma_f32_32x32x16_bf16(pa1,PK(1),o[d0],0,0,0);
    o[d0]=__builtin_amdgcn_mfma_f32_32x32x16_bf16(pa2,PK(2),o[d0],0,0,0);
    o[d0]=__builtin_amdgcn_mfma_f32_32x32x16_bf16(pa3,PK(3),o[d0],0,0,0);
    #undef PK
  }
}

#ifndef ATTN_STORE16
#define ATTN_STORE16(p,v) (*(u32x4*)(p)=(v))
#endif
struct AttnP { const bf16* Q; const bf16* K; const bf16* V; bf16* out; bf16* stash; const float* gsub; const float* logf; int opitch; float lam, nscale; };
template<int THRL,bool FOX> __device__ __forceinline__ void attn_unit(const int tid_in,int b,int qb,const int MODE,const AttnP&P,char*shm){
  int tid=tid_in; asm volatile("":"+v"(tid));
  const int lane=tid&63,r32=lane&31,hi=lane>>5; const int wid=__builtin_amdgcn_readfirstlane(tid>>6);
  const long rowbase=(long)b*SEQ; const int q0=qb*QB;
  const bf16*Qw=P.Q+(rowbase+q0+wid*QBLK)*DM;
  const bf16*Kh=P.K+rowbase*DM,*Vh=P.V+rowbase*DM;
  const unsigned lds0=(unsigned)(uintptr_t)shm;
  float*wsf=(float*)(shm+LDS_WS)+wid*64;
  const float*biasL=(const float*)(shm+LDS_BIAS);
  #define BIAS(P0,P1,t) do{ if(FOX){ const float*bb_=biasL+64*(t)+4*hi; _Pragma("unroll") for(int g_=0;g_<4;++g_){ const f32x4_t b0_=*(const f32x4_t*)(bb_+8*g_), b1_=*(const f32x4_t*)(bb_+32+8*g_); \
      _Pragma("unroll") for(int e_=0;e_<4;++e_){ P0[4*g_+e_]+=b0_[e_]; P1[4*g_+e_]+=b1_[e_]; } asm volatile("":::"memory"); } } }while(0)
  const bf16*ksrc=Kh+(long)lane*DM+wid*8;
  const bf16*vsrc=Vh+(long)(16*(wid&3)+(lane>>2))*DM+(wid>>2)*32+(lane&3)*8;
  const unsigned kdst=lds0+LDS_K+wid*1024, vdst=lds0+LDS_V+wid*1024;
  #define DMA_K(t,slot) glds16(ksrc+(long)(t)*KVBLK*DM,(unsigned)__builtin_amdgcn_readfirstlane(kdst+(slot)))
  #define DMA_V(t,slot) glds16(vsrc+(long)(t)*KVBLK*DM,(unsigned)__builtin_amdgcn_readfirstlane(vdst+(slot)))
  const int vb0=(int)(lds0+LDS_V)+((lane>>4)&1)*32+(lane&3)*8+(4*hi+((lane&15)>>2))*64;
  const char*Kbase=shm+LDS_K; bf16x8 kf[8];
  const lds_cptr shm3=(lds_cptr)shm; const lds_cptr kp0=shm3+LDS_K+hi*1024+r32*16; const lds_cptr vp0=shm3+LDS_V+((lane>>4)&1)*32+(lane&3)*8+(4*hi+((lane&15)>>2))*64;
  const int NT=(q0+QB)/KVBLK;
  DMA_K(0,0);DMA_V(0,0);DMA_K(1,SLOTB);
  bf16x8 qr[4];
  #pragma unroll
  for(int d0=0;d0<4;++d0)qr[d0]=*reinterpret_cast<const bf16x8*>(&Qw[(long)r32*DM+d0*16+hi*8]);
  float mhat=0.f,l_reg=0.f;f32x16 o[2];o[0]=f32x16{};o[1]=f32x16{};f32x16 negm=f32x16{};asm volatile("":"+v"(negm));
  const int qrel=wid*QBLK+r32;
  #define CMASK(P0,P1,t) do{int jb_=(t)-(NT-4); if(jb_>=0)cmask(P0,P1,jb_,qrel,hi);}while(0)
  bool resc=false;
  #define START(P0,P1) do{ const float rm=rowmax(P0,P1); resc=false; \
    { const float dl=rm; mhat=fadd_s(mhat,dl); \
      _Pragma("unroll") for(int r=0;r<16;++r){P0[r]=fsub_s(P0[r],dl);P1[r]=fsub_s(P1[r],dl);} \
      _Pragma("unroll") for(int r=0;r<16;++r)negm[r]=-mhat; asm volatile("":"+v"(negm)); } \
    _Pragma("unroll") for(int r=0;r<16;++r)P0[r]=__builtin_amdgcn_exp2f(P0[r]); }while(0)
  #define RESC() do{ if(resc){ asm volatile("s_waitcnt lgkmcnt(0)":::"memory"); \
      _Pragma("unroll") for(int d_=0;d_<2;++d_) _Pragma("unroll") for(int r=0;r<16;++r)o[d_][r]*=wsf[crow(r,hi)]; } }while(0)
  f32x16 pA0,pA1,pB0,pB1;
  int sl_prev=0,sl_cur=0,sl_next=SLOTB;
  #define ROT() do{sl_prev=sl_cur;sl_cur=sl_next;sl_next=(sl_next==(NSLOT-1)*SLOTB)?0:sl_next+SLOTB;}while(0)
  DMA_K(2,2*SLOTB);
  if(FOX){
    const int n=q0+QB; float v4[4]; float run=0.f;
    _Pragma("unroll") for(int i=0;i<4;++i){ const int sidx=4*tid+i; const float lv=(sidx<n)?P.logf[(rowbase+sidx)*8]:0.f; run+=lv; v4[i]=run; }
    float inc=run; _Pragma("unroll") for(int o_=1;o_<64;o_<<=1){ const float up=__int_as_float(__builtin_amdgcn_ds_bpermute((lane-o_)<<2,__float_as_int(inc))); if(lane>=o_)inc+=up; }
    float*wt=(float*)(shm+LDS_WS); if(lane==63)wt[wid]=inc; __syncthreads();
    float pre=inc-run; _Pragma("unroll") for(int w_=0;w_<NW;++w_){ if(w_<wid)pre+=wt[w_]; }
    float*bw=(float*)(shm+LDS_BIAS); _Pragma("unroll") for(int i=0;i<4;++i){ const int sidx=4*tid+i; if(sidx<n)bw[sidx]=-(pre+v4[i])*1.4426950408889634f; }
    __syncthreads(); }
  WAIT_BAR(3);
  qkt(pA0,pA1,Kbase,qr,negm,r32,hi);asm volatile("s_nop 15\n\ts_nop 7":"+v"(pA0),"+v"(pA1));BIAS(pA0,pA1,0);CMASK(pA0,pA1,0);
  START(pA0,pA1);
  _Pragma("unroll") for(int r=0;r<16;++r)pA1[r]=__builtin_amdgcn_exp2f(pA1[r]);
  WAIT_BAR(0);
  DMA_K(3,0);DMA_V(1,SLOTB);
  ROT();
  kload8(kf,kp0+sl_cur);
  WAIT_BAR(2);
  s16x4 vlo[8],vhi[8]; u32x4 pw0,pw1,pw2,pw3;
  #define PKW(P,B) cvtpk_s(P[B],P[B+1])
  #define PAF(k) __builtin_bit_cast(bf16x8,pw##k)
  #define VFR(i) (bf16x8){vlo[i][0],vlo[i][1],vlo[i][2],vlo[i][3],vhi[i][0],vhi[i][1],vhi[i][2],vhi[i][3]}
  #define PIN(x) asm volatile("":"+v"(x))
  #define MX3(a,b,c) __builtin_fmaxf(__builtin_fmaxf((a),(b)),(c))
  #define GAPA(MF,A0,A1,A2,A3,W0,W1,PW) do{ MF; sacc+=A0; sacc+=A1; sacc+=A2; sacc+=A3; PIN(sacc); W0; W1; PIN(PW); SBAR(); }while(0)
  #define EX(v) __builtin_amdgcn_exp2f(v)
  #define GAPB(MF,X,B) do{ MF; X[B]=EX(X[B]); X[B+1]=EX(X[B+1]); X[B+2]=EX(X[B+2]); X[B+3]=EX(X[B+3]); PIN(X); SBAR(); }while(0)
  #define VRD(i) do{ vlo[i]=vtr(vp_+(((i)>>2)*4096+((i)&3)*1024)); vhi[i]=vtr(vp_+(((i)>>2)*4096+((i)&3)*1024+512)); }while(0)
  #define KRD(G,j) do{ if(G){ kload2(kf,kp0+sl_next,j); SBAR(); } }while(0)
  #define STEP(C0,C1,P0,P1,t,GK,GV,GL) do{ SBAR(); \
    const lds_cptr vp_=vp0+sl_prev; \
    VRD(0); SBAR(); float sacc=(P0[0]+P0[1]); \
    GAPA(C0=__builtin_amdgcn_mfma_f32_32x32x16_bf16(kf[0],qr[0],negm,0,0,0), P0[2],P0[3],P0[4],P0[5],     pw0[0]=PKW(P0,0), pw0[1]=PKW(P0,2), pw0); \
    VRD(4); SBAR(); GAPA(C1=__builtin_amdgcn_mfma_f32_32x32x16_bf16(kf[1],qr[0],negm,0,0,0), P0[6],P0[7],P0[8],P0[9],     pw0[2]=PKW(P0,4), pw0[3]=PKW(P0,6), pw0); \
    VRD(1); SBAR(); GAPA(C0=__builtin_amdgcn_mfma_f32_32x32x16_bf16(kf[2],qr[1],C0,0,0,0),   P0[10],P0[11],P0[12],P0[13], pw1[0]=PKW(P0,8), pw1[1]=PKW(P0,10), pw1); \
    VRD(5); SBAR(); GAPA(C1=__builtin_amdgcn_mfma_f32_32x32x16_bf16(kf[3],qr[1],C1,0,0,0),   P0[14],P0[15],P1[0],P1[1],   pw1[2]=PKW(P0,12),pw1[3]=PKW(P0,14), pw1); \
    VRD(2); SBAR(); GAPA(C0=__builtin_amdgcn_mfma_f32_32x32x16_bf16(kf[4],qr[2],C0,0,0,0),   P1[2],P1[3],P1[4],P1[5],     pw2[0]=PKW(P1,0), pw2[1]=PKW(P1,2), pw2); \
    VRD(6); SBAR(); GAPA(C1=__builtin_amdgcn_mfma_f32_32x32x16_bf16(kf[5],qr[2],C1,0,0,0),   P1[6],P1[7],P1[8],P1[9],     pw2[2]=PKW(P1,4), pw2[3]=PKW(P1,6), pw2); \
    VRD(3); SBAR(); GAPA(C0=__builtin_amdgcn_mfma_f32_32x32x16_bf16(kf[6],qr[3],C0,0,0,0),   P1[10],P1[11],P1[12],P1[13], pw3[0]=PKW(P1,8), pw3[1]=PKW(P1,10), pw3); \
    VRD(7); SBAR(); GAPA(C1=__builtin_amdgcn_mfma_f32_32x32x16_bf16(kf[7],qr[3],C1,0,0,0),   P1[14],P1[15],0.f,0.f,       pw3[2]=PKW(P1,12),pw3[3]=PKW(P1,14), pw3); \
    l_reg+=sacc; \
    if(GK){DMA_K((t)+3,sl_cur);} if(GV){DMA_V((t)+1,sl_next);} \
    BIAS(C0,C1,t); CMASK(C0,C1,t); \
    { float a=MX3(C0[0],C0[1],C1[0]),b=MX3(C0[2],C0[3],C1[1]); a=MX3(a,C1[2],C1[3]); \
      _Pragma("unroll") for(int r=4;r<16;r+=4){a=MX3(a,C0[r],C0[r+1]);b=MX3(b,C0[r+2],C0[r+3]);a=MX3(a,C1[r],C1[r+1]);b=MX3(b,C1[r+2],C1[r+3]);} \
      float rm=__builtin_fmaxf(a,b); { auto rr=__builtin_amdgcn_permlane32_swap(__float_as_uint(rm),__float_as_uint(rm),false,false); rm=__builtin_fmaxf(__uint_as_float(rr[0]),__uint_as_float(rr[1])); } \
      resc=false; \
      if(__builtin_expect(__any(rm>(float)THRL),0)){ const float dl=__builtin_fmaxf(rm,0.f); mhat+=dl; \
        _Pragma("unroll") for(int r=0;r<16;++r){C0[r]-=dl;C1[r]-=dl;} \
        _Pragma("unroll") for(int r=0;r<16;++r)negm[r]=-mhat; asm volatile("":"+v"(negm)); \
        const float f=__builtin_amdgcn_exp2f(-dl); l_reg*=f; if(hi==0)wsf[r32]=f; resc=true; } } \
    SBAR(); \
    GAPB(o[0]=__builtin_amdgcn_mfma_f32_32x32x16_bf16(PAF(0),VFR(0),o[0],0,0,0), C0,0); \
    GAPB(o[1]=__builtin_amdgcn_mfma_f32_32x32x16_bf16(PAF(0),VFR(4),o[1],0,0,0), C0,4); \
    KRD(GL,0); GAPB(o[0]=__builtin_amdgcn_mfma_f32_32x32x16_bf16(PAF(1),VFR(1),o[0],0,0,0), C0,8); \
    KRD(GL,1); GAPB(o[1]=__builtin_amdgcn_mfma_f32_32x32x16_bf16(PAF(1),VFR(5),o[1],0,0,0), C0,12); \
    KRD(GL,2); GAPB(o[0]=__builtin_amdgcn_mfma_f32_32x32x16_bf16(PAF(2),VFR(2),o[0],0,0,0), C1,0); \
    KRD(GL,3); GAPB(o[1]=__builtin_amdgcn_mfma_f32_32x32x16_bf16(PAF(2),VFR(6),o[1],0,0,0), C1,4); \
    GAPB(o[0]=__builtin_amdgcn_mfma_f32_32x32x16_bf16(PAF(3),VFR(3),o[0],0,0,0), C1,8); \
    GAPB(o[1]=__builtin_amdgcn_mfma_f32_32x32x16_bf16(PAF(3),VFR(7),o[1],0,0,0), C1,12); \
    }while(0)
  int t=1;
  #undef CMASK
  #define CMASK(P0,P1,t) do{}while(0)
  for(;t+5<NT;t+=2){
    STEP(pB0,pB1,pA0,pA1,t,true,true,true);     WAIT_BAR(2); RESC(); ROT();
    STEP(pA0,pA1,pB0,pB1,t+1,true,true,true);   WAIT_BAR(2); RESC(); ROT();
  }
  #undef CMASK
  #define CMASK(P0,P1,t) do{int jb_=(t)-(NT-4); if(jb_>=0)cmask(P0,P1,jb_,qrel,hi);}while(0)
  #define ENDW(tt) do{ if((tt)+3<NT){WAIT_BAR(2);} else if((tt)+2<NT){WAIT_BAR(1);} else {WAIT_BAR(0);} }while(0)
  for(;t+1<NT;t+=2){
    STEP(pB0,pB1,pA0,pA1,t,(t+3<NT),(t+1<NT),(t+1<NT));       ENDW(t);   RESC(); ROT();
    STEP(pA0,pA1,pB0,pB1,t+1,(t+4<NT),(t+2<NT),(t+2<NT));     ENDW(t+1); RESC(); ROT();
  }
  STEP(pB0,pB1,pA0,pA1,NT-1,false,false,false); RESC();
  { float sacc=pB0[0]+pB0[1]; _Pragma("unroll") for(int r=2;r<16;++r)sacc+=pB0[r]; _Pragma("unroll") for(int r=0;r<16;++r)sacc+=pB1[r]; l_reg+=sacc;
    pw0=(u32x4){PKW(pB0,0),PKW(pB0,2),PKW(pB0,4),PKW(pB0,6)};pw1=(u32x4){PKW(pB0,8),PKW(pB0,10),PKW(pB0,12),PKW(pB0,14)};pw2=(u32x4){PKW(pB1,0),PKW(pB1,2),PKW(pB1,4),PKW(pB1,6)};pw3=(u32x4){PKW(pB1,8),PKW(pB1,10),PKW(pB1,12),PKW(pB1,14)};
    SBAR(); pv(o,vb0+sl_cur,PAF(0),PAF(1),PAF(2),PAF(3)); }
  #undef PKW
  #undef PAF
  #undef VFR
  #undef PIN
  #undef MX3
  #undef GAPA
  #undef GAPB
  #undef EX
  #undef VRD
  #undef KRD
  #undef STEP
  #undef ENDW
  {auto rr=__builtin_amdgcn_permlane32_swap(__float_as_uint(l_reg),__float_as_uint(l_reg),false,false);l_reg=__uint_as_float(rr[0])+__uint_as_float(rr[1]);}
  if(hi==0)wsf[32+r32]=l_reg;asm volatile("s_waitcnt lgkmcnt(0)":::"memory");
  float rli[16];
  #pragma unroll
  for(int r=0;r<16;++r)rli[r]=__builtin_amdgcn_rcpf(wsf[32+crow(r,hi)]);
  { hbf16*stg=(hbf16*)(shm+LDS_OST)+wid*2048;
    #pragma unroll
    for(int r=0;r<16;++r){const int orow=crow(r,hi);
      #pragma unroll
      for(int d0=0;d0<2;++d0)stg[orow*64+d0*32+r32]=__float2bfloat16(o[d0][r]*rli[r]);}
    asm volatile("s_waitcnt lgkmcnt(0)":::"memory");
    const long grow=rowbase+q0+wid*QBLK; float*ssq=(float*)(shm+LDS_SSQ)+wid*32;
    int lane_e=lane; asm volatile("":"+v"(lane_e));
    #pragma unroll
    for(int i=0;i<4;++i){const int row=i*8+(lane_e>>3),ch=lane_e&7; const u32x4 v=*(const u32x4*)(stg+row*64+ch*8);
      if(MODE==0){ *(u32x4*)(P.out+(grow+row)*(long)P.opitch+ch*8)=v; }
      else { bf16*sp=P.stash+(grow+row)*512+ch*8+(MODE==2?64:0); const u32x4 a=*(const u32x4*)sp; float of[8]; float ss=0.f;
        #pragma unroll
        for(int j=0;j<4;++j){ const float a0=__uint_as_float(a[j]<<16),a1=__uint_as_float(a[j]&0xffff0000u),c0=__uint_as_float(v[j]<<16),c1=__uint_as_float(v[j]&0xffff0000u);
          of[2*j]=a0-P.lam*c0; of[2*j+1]=a1-P.lam*c1; ss+=of[2*j]*of[2*j]+of[2*j+1]*of[2*j+1]; }
        ss+=__int_as_float(__builtin_amdgcn_ds_swizzle(__float_as_int(ss),0x041f)); ss+=__int_as_float(__builtin_amdgcn_ds_swizzle(__float_as_int(ss),0x081f)); ss+=__int_as_float(__builtin_amdgcn_ds_swizzle(__float_as_int(ss),0x101f));
        if(MODE==1){ if(ch==0)ssq[row]=ss; u32x4 w; _Pragma("unroll") for(int j=0;j<4;++j)w[j]=cvtpk_s(of[2*j],of[2*j+1]); *(u32x4*)sp=w; }
        else { const float rr_=rsqrtf((ss+ssq[row])*(1.0f/128.0f)+1e-6f)*P.nscale; bf16*yp=P.out+(grow+row)*(long)P.opitch+ch*8;
          const f32x4_t g0=*(const f32x4_t*)(P.gsub+64+ch*8), g1=*(const f32x4_t*)(P.gsub+64+ch*8+4), h0=*(const f32x4_t*)(P.gsub+ch*8), h1=*(const f32x4_t*)(P.gsub+ch*8+4);
          u32x4 w; w[0]=cvtpk_s(of[0]*rr_*g0[0],of[1]*rr_*g0[1]); w[1]=cvtpk_s(of[2]*rr_*g0[2],of[3]*rr_*g0[3]); w[2]=cvtpk_s(of[4]*rr_*g1[0],of[5]*rr_*g1[1]); w[3]=cvtpk_s(of[6]*rr_*g1[2],of[7]*rr_*g1[3]);
          *(u32x4*)(yp+64)=w;
          const u32x4 lo=*(const u32x4*)(sp-64); float lf[8];
          #pragma unroll
          for(int j=0;j<4;++j){ lf[2*j]=__uint_as_float(lo[j]<<16); lf[2*j+1]=__uint_as_float(lo[j]&0xffff0000u); }
          w[0]=cvtpk_s(lf[0]*rr_*h0[0],lf[1]*rr_*h0[1]); w[1]=cvtpk_s(lf[2]*rr_*h0[2],lf[3]*rr_*h0[3]); w[2]=cvtpk_s(lf[4]*rr_*h1[0],lf[5]*rr_*h1[1]); w[3]=cvtpk_s(lf[6]*rr_*h1[2],lf[7]*rr_*h1[3]);
          *(u32x4*)yp=w; } } } }
  asm volatile("s_waitcnt lgkmcnt(0)\n\ts_barrier":::"memory");
  #undef DMA_K
  #undef BIAS
  #undef DMA_V
  #undef CMASK
  #undef START
  #undef RESC
  #undef ROT
}
__device__ __forceinline__ void pv128(f32x16*o,int vb,bf16x8 pa0,bf16x8 pa1,bf16x8 pa2,bf16x8 pa3){
  #pragma unroll
  for(int d0=0;d0<4;++d0){s16x4 lo[4],hi[4];
    #pragma unroll
    for(int ks=0;ks<4;++ks){
      asm volatile("ds_read_b64_tr_b16 %0,%1 offset:%c2":"=&v"(lo[ks]):"v"(vb),"i"(d0*4096+ks*1024):"memory");
      asm volatile("ds_read_b64_tr_b16 %0,%1 offset:%c2":"=&v"(hi[ks]):"v"(vb),"i"(d0*4096+ks*1024+512):"memory");}
    asm volatile("s_waitcnt lgkmcnt(0)":::"memory");SBAR();
    #define PK(k) (bf16x8){lo[k][0],lo[k][1],lo[k][2],lo[k][3],hi[k][0],hi[k][1],hi[k][2],hi[k][3]}
    o[d0]=__builtin_amdgcn_mfma_f32_32x32x16_bf16(pa0,PK(0),o[d0],0,0,0);
    o[d0]=__builtin_amdgcn_mfma_f32_32x32x16_bf16(pa1,PK(1),o[d0],0,0,0);
    o[d0]=__builtin_amdgcn_mfma_f32_32x32x16_bf16(pa2,PK(2),o[d0],0,0,0);
    o[d0]=__builtin_amdgcn_mfma_f32_32x32x16_bf16(pa3,PK(3),o[d0],0,0,0);
    #undef PK
  }
}
template<int THRL> __device__ __forceinline__ void attn_unit128(const int tid_in,int b,int qb,const int MODE,const AttnP&P,char*shm){
  constexpr bool FOX=false; constexpr int LDS_V=24576, LDS_WS=73728, LDS_OST=75776, SLOTV=16384;
  int tid=tid_in; asm volatile("":"+v"(tid));
  const int lane=tid&63,r32=lane&31,hi=lane>>5; const int wid=__builtin_amdgcn_readfirstlane(tid>>6);
  const long rowbase=(long)b*SEQ; const int q0=qb*QB;
  const bf16*Qw=P.Q+(rowbase+q0+wid*QBLK)*DM;
  const bf16*Kh=P.K+rowbase*DM,*Vh=P.V+rowbase*DM;
  const unsigned lds0=(unsigned)(uintptr_t)shm;
  float*wsf=(float*)(shm+LDS_WS)+wid*64;
  const float*biasL=(const float*)(shm+LDS_BIAS);
  #define BIAS(P0,P1,t) do{ if(FOX){ const float*bb_=biasL+64*(t)+4*hi; _Pragma("unroll") for(int g_=0;g_<4;++g_){ const f32x4_t b0_=*(const f32x4_t*)(bb_+8*g_), b1_=*(const f32x4_t*)(bb_+32+8*g_); \
      _Pragma("unroll") for(int e_=0;e_<4;++e_){ P0[4*g_+e_]+=b0_[e_]; P1[4*g_+e_]+=b1_[e_]; } asm volatile("":::"memory"); } } }while(0)
  const bf16*ksrc=Kh+(long)lane*DM+wid*8;
  const bf16*vsrc=Vh+(long)(16*(wid&3)+(lane>>2))*DM+(wid>>2)*32+(lane&3)*8;
  const unsigned kdst=lds0+LDS_K+wid*1024, vdst=lds0+LDS_V+wid*1024;
  #define DMA_K(t,slot) glds16(ksrc+(long)(t)*KVBLK*DM,(unsigned)__builtin_amdgcn_readfirstlane(kdst+(slot)))
  #define DMA_V(t,slot) do{ glds16(vsrc+(long)(t)*KVBLK*DM,(unsigned)__builtin_amdgcn_readfirstlane(vdst+2*(slot))); glds16(vsrc+(long)(t)*KVBLK*DM+64,(unsigned)__builtin_amdgcn_readfirstlane(vdst+2*(slot)+8192)); }while(0)
  const int vb0=(int)(lds0+LDS_V)+((lane>>4)&1)*32+(lane&3)*8+(4*hi+((lane&15)>>2))*64;
  const char*Kbase=shm+LDS_K; bf16x8 kf[8];
  const lds_cptr shm3=(lds_cptr)shm; const lds_cptr kp0=shm3+LDS_K+hi*1024+r32*16; const lds_cptr vp0=shm3+LDS_V+((lane>>4)&1)*32+(lane&3)*8+(4*hi+((lane&15)>>2))*64;
  const int NT=(q0+QB)/KVBLK;
  DMA_K(0,0);DMA_V(0,0);DMA_K(1,SLOTB);
  bf16x8 qr[4];
  #pragma unroll
  for(int d0=0;d0<4;++d0)qr[d0]=*reinterpret_cast<const bf16x8*>(&Qw[(long)r32*DM+d0*16+hi*8]);
  float mhat=0.f,l_reg=0.f;f32x16 o[4];o[0]=f32x16{};o[1]=f32x16{};o[2]=f32x16{};o[3]=f32x16{};const f32x16 zero16=f32x16{};
  const int qrel=wid*QBLK+r32;
  #define CMASK(P0,P1,t) do{int jb_=(t)-(NT-4); if(jb_>=0)cmask(P0,P1,jb_,qrel,hi);}while(0)
  bool resc=false;
  #define START(P0,P1) do{ const float rm=rowmax(P0,P1); resc=false; \
    { const float dl=rm; mhat=fadd_s(mhat,dl); \
      _Pragma("unroll") for(int r=0;r<16;++r){P0[r]=fsub_s(P0[r],dl);P1[r]=fsub_s(P1[r],dl);} \
      } \
    _Pragma("unroll") for(int r=0;r<16;++r)P0[r]=__builtin_amdgcn_exp2f(P0[r]); }while(0)
  #define RESC() do{ if(resc){ asm volatile("s_waitcnt lgkmcnt(0)":::"memory"); \
      _Pragma("unroll") for(int d_=0;d_<4;++d_) _Pragma("unroll") for(int r=0;r<16;++r)o[d_][r]*=wsf[crow(r,hi)]; } }while(0)
  f32x16 pA0,pA1,pB0,pB1;
  int sl_prev=0,sl_cur=0,sl_next=SLOTB;
  #define ROT() do{sl_prev=sl_cur;sl_cur=sl_next;sl_next=(sl_next==(NSLOT-1)*SLOTB)?0:sl_next+SLOTB;}while(0)
  DMA_K(2,2*SLOTB);
  WAIT_BAR(4);
  qkt(pA0,pA1,Kbase,qr,zero16,r32,hi);asm volatile("s_nop 15\n\ts_nop 7":"+v"(pA0),"+v"(pA1));BIAS(pA0,pA1,0);CMASK(pA0,pA1,0);
  START(pA0,pA1);
  _Pragma("unroll") for(int r=0;r<16;++r)pA1[r]=__builtin_amdgcn_exp2f(pA1[r]);
  WAIT_BAR(0);
  DMA_K(3,0);DMA_V(1,SLOTB);
  ROT();
  kload8(kf,kp0+sl_cur);
  WAIT_BAR(3);
  s16x4 va_lo,va_hi,vb_lo,vb_hi; u32x4 pw0,pw1,pw2,pw3;
  #define PKW(P,B) cvtpk_s(P[B],P[B+1])
  #define PAF(k) __builtin_bit_cast(bf16x8,pw##k)
  #define VFA (bf16x8){va_lo[0],va_lo[1],va_lo[2],va_lo[3],va_hi[0],va_hi[1],va_hi[2],va_hi[3]}
  #define VFB (bf16x8){vb_lo[0],vb_lo[1],vb_lo[2],vb_lo[3],vb_hi[0],vb_hi[1],vb_hi[2],vb_hi[3]}
  #define PIN(x) asm volatile("":"+v"(x))
  #define MX3(a,b,c) __builtin_fmaxf(__builtin_fmaxf((a),(b)),(c))
  #define GAPA(MF,A0,A1,A2,A3,W0,W1,PW) do{ MF; sacc+=A0; sacc+=A1; sacc+=A2; sacc+=A3; PIN(sacc); W0; W1; PIN(PW); SBAR(); }while(0)
  #define EX(v) __builtin_amdgcn_exp2f((v)-mhat)
  #define VRDA(d0,ks) do{ va_lo=vtr(vp_+((d0)*4096+(ks)*1024)); va_hi=vtr(vp_+((d0)*4096+(ks)*1024+512)); }while(0)
  #define VRDB(d0,ks) do{ vb_lo=vtr(vp_+((d0)*4096+(ks)*1024)); vb_hi=vtr(vp_+((d0)*4096+(ks)*1024+512)); }while(0)
  #define KRD(G,j) do{ if(G){ kload2(kf,kp0+sl_next,j); } }while(0)
  #define GAPB(MF,RD,X,B) do{ MF; RD; X[B]=EX(X[B]); X[B+1]=EX(X[B+1]); PIN(X); SBAR(); }while(0)
  #define STEP(C0,C1,P0,P1,t,GK,GV,GL) do{ SBAR(); \
    const lds_cptr vp_=vp0+2*sl_prev; \
    float sacc=(P0[0]+P0[1]); \
    GAPA(C0=__builtin_amdgcn_mfma_f32_32x32x16_bf16(kf[0],qr[0],zero16,0,0,0), P0[2],P0[3],P0[4],P0[5],     pw0[0]=PKW(P0,0), pw0[1]=PKW(P0,2), pw0); \
    GAPA(C1=__builtin_amdgcn_mfma_f32_32x32x16_bf16(kf[1],qr[0],zero16,0,0,0), P0[6],P0[7],P0[8],P0[9],     pw0[2]=PKW(P0,4), pw0[3]=PKW(P0,6), pw0); \
    GAPA(C0=__builtin_amdgcn_mfma_f32_32x32x16_bf16(kf[2],qr[1],C0,0,0,0),   P0[10],P0[11],P0[12],P0[13], pw1[0]=PKW(P0,8), pw1[1]=PKW(P0,10), pw1); \
    GAPA(C1=__builtin_amdgcn_mfma_f32_32x32x16_bf16(kf[3],qr[1],C1,0,0,0),   P0[14],P0[15],P1[0],P1[1],   pw1[2]=PKW(P0,12),pw1[3]=PKW(P0,14), pw1); \
    GAPA(C0=__builtin_amdgcn_mfma_f32_32x32x16_bf16(kf[4],qr[2],C0,0,0,0),   P1[2],P1[3],P1[4],P1[5],     pw2[0]=PKW(P1,0), pw2[1]=PKW(P1,2), pw2); \
    GAPA(C1=__builtin_amdgcn_mfma_f32_32x32x16_bf16(kf[5],qr[2],C1,0,0,0),   P1[6],P1[7],P1[8],P1[9],     pw2[2]=PKW(P1,4), pw2[3]=PKW(P1,6), pw2); \
    VRDA(0,0); SBAR(); \
    GAPA(C0=__builtin_amdgcn_mfma_f32_32x32x16_bf16(kf[6],qr[3],C0,0,0,0),   P1[10],P1[11],P1[12],P1[13], pw3[0]=PKW(P1,8), pw3[1]=PKW(P1,10), pw3); \
    GAPA(C1=__builtin_amdgcn_mfma_f32_32x32x16_bf16(kf[7],qr[3],C1,0,0,0),   P1[14],P1[15],0.f,0.f,       pw3[2]=PKW(P1,12),pw3[3]=PKW(P1,14), pw3); \
    l_reg+=sacc; \
    if(GK){DMA_K((t)+3,sl_cur);} if(GV){DMA_V((t)+1,sl_next);} \
    CMASK(C0,C1,t); \
    { float a=MX3(C0[0],C0[1],C1[0]),b=MX3(C0[2],C0[3],C1[1]); a=MX3(a,C1[2],C1[3]); \
      _Pragma("unroll") for(int r=4;r<16;r+=4){a=MX3(a,C0[r],C0[r+1]);b=MX3(b,C0[r+2],C0[r+3]);a=MX3(a,C1[r],C1[r+1]);b=MX3(b,C1[r+2],C1[r+3]);} \
      float rm=__builtin_fmaxf(a,b); { auto rr=__builtin_amdgcn_permlane32_swap(__float_as_uint(rm),__float_as_uint(rm),false,false); rm=__builtin_fmaxf(__uint_as_float(rr[0]),__uint_as_float(rr[1])); } \
      rm-=mhat; resc=false; \
      if(__builtin_expect(__any(rm>(float)THRL),0)){ const float dl=__builtin_fmaxf(rm,0.f); mhat+=dl; \
        const float f=__builtin_amdgcn_exp2f(-dl); l_reg*=f; if(hi==0)wsf[r32]=f; resc=true; } } \
    SBAR(); \
    GAPB(o[0]=__builtin_amdgcn_mfma_f32_32x32x16_bf16(PAF(0),VFA,o[0],0,0,0), VRDB(1,0), C0,0); \
    GAPB(o[1]=__builtin_amdgcn_mfma_f32_32x32x16_bf16(PAF(0),VFB,o[1],0,0,0), VRDA(2,0), C0,2); \
    GAPB(o[2]=__builtin_amdgcn_mfma_f32_32x32x16_bf16(PAF(0),VFA,o[2],0,0,0), VRDB(3,0), C0,4); \
    GAPB(o[3]=__builtin_amdgcn_mfma_f32_32x32x16_bf16(PAF(0),VFB,o[3],0,0,0), VRDA(0,1), C0,6); \
    KRD(GL,0); GAPB(o[0]=__builtin_amdgcn_mfma_f32_32x32x16_bf16(PAF(1),VFA,o[0],0,0,0), VRDB(1,1), C0,8); \
    GAPB(o[1]=__builtin_amdgcn_mfma_f32_32x32x16_bf16(PAF(1),VFB,o[1],0,0,0), VRDA(2,1), C0,10); \
    KRD(GL,1); GAPB(o[2]=__builtin_amdgcn_mfma_f32_32x32x16_bf16(PAF(1),VFA,o[2],0,0,0), VRDB(3,1), C0,12); \
    GAPB(o[3]=__builtin_amdgcn_mfma_f32_32x32x16_bf16(PAF(1),VFB,o[3],0,0,0), VRDA(0,2), C0,14); \
    KRD(GL,2); GAPB(o[0]=__builtin_amdgcn_mfma_f32_32x32x16_bf16(PAF(2),VFA,o[0],0,0,0), VRDB(1,2), C1,0); \
    GAPB(o[1]=__builtin_amdgcn_mfma_f32_32x32x16_bf16(PAF(2),VFB,o[1],0,0,0), VRDA(2,2), C1,2); \
    KRD(GL,3); GAPB(o[2]=__builtin_amdgcn_mfma_f32_32x32x16_bf16(PAF(2),VFA,o[2],0,0,0), VRDB(3,2), C1,4); \
    GAPB(o[3]=__builtin_amdgcn_mfma_f32_32x32x16_bf16(PAF(2),VFB,o[3],0,0,0), VRDA(0,3), C1,6); \
    GAPB(o[0]=__builtin_amdgcn_mfma_f32_32x32x16_bf16(PAF(3),VFA,o[0],0,0,0), VRDB(1,3), C1,8); \
    GAPB(o[1]=__builtin_amdgcn_mfma_f32_32x32x16_bf16(PAF(3),VFB,o[1],0,0,0), VRDA(2,3), C1,10); \
    GAPB(o[2]=__builtin_amdgcn_mfma_f32_32x32x16_bf16(PAF(3),VFA,o[2],0,0,0), VRDB(3,3), C1,12); \
    GAPB(o[3]=__builtin_amdgcn_mfma_f32_32x32x16_bf16(PAF(3),VFB,o[3],0,0,0), (void)0, C1,14); \
    }while(0)
  int t=1;
  #undef CMASK
  #define CMASK(P0,P1,t) do{}while(0)
  for(;t+5<NT;t+=2){
    STEP(pB0,pB1,pA0,pA1,t,true,true,true);     WAIT_BAR(3); RESC(); ROT();
    STEP(pA0,pA1,pB0,pB1,t+1,true,true,true);   WAIT_BAR(3); RESC(); ROT();
  }
  #undef CMASK
  #define CMASK(P0,P1,t) do{int jb_=(t)-(NT-4); if(jb_>=0)cmask(P0,P1,jb_,qrel,hi);}while(0)
  #define ENDW(tt) do{ if((tt)+3<NT){WAIT_BAR(3);} else if((tt)+2<NT){WAIT_BAR(2);} else {WAIT_BAR(0);} }while(0)
  for(;t+1<NT;t+=2){
    STEP(pB0,pB1,pA0,pA1,t,(t+3<NT),(t+1<NT),(t+1<NT));       ENDW(t);   RESC(); ROT();
    STEP(pA0,pA1,pB0,pB1,t+1,(t+4<NT),(t+2<NT),(t+2<NT));     ENDW(t+1); RESC(); ROT();
  }
  STEP(pB0,pB1,pA0,pA1,NT-1,false,false,false); RESC();
  { float sacc=pB0[0]+pB0[1]; _Pragma("unroll") for(int r=2;r<16;++r)sacc+=pB0[r]; _Pragma("unroll") for(int r=0;r<16;++r)sacc+=pB1[r]; l_reg+=sacc;
    pw0=(u32x4){PKW(pB0,0),PKW(pB0,2),PKW(pB0,4),PKW(pB0,6)};pw1=(u32x4){PKW(pB0,8),PKW(pB0,10),PKW(pB0,12),PKW(pB0,14)};pw2=(u32x4){PKW(pB1,0),PKW(pB1,2),PKW(pB1,4),PKW(pB1,6)};pw3=(u32x4){PKW(pB1,8),PKW(pB1,10),PKW(pB1,12),PKW(pB1,14)};
    SBAR(); pv128(o,vb0+2*sl_cur,PAF(0),PAF(1),PAF(2),PAF(3)); }
  #undef PKW
  #undef PAF
  #undef VFA
  #undef VFB
  #undef VRDA
  #undef VRDB
  #undef PIN
  #undef MX3
  #undef GAPA
  #undef GAPB
  #undef EX
  #undef KRD
  #undef STEP
  #undef ENDW
  {auto rr=__builtin_amdgcn_permlane32_swap(__float_as_uint(l_reg),__float_as_uint(l_reg),false,false);l_reg=__uint_as_float(rr[0])+__uint_as_float(rr[1]);}
  if(hi==0)wsf[32+r32]=l_reg;asm volatile("s_waitcnt lgkmcnt(0)":::"memory");
  float rli[16];
  #pragma unroll
  for(int r=0;r<16;++r)rli[r]=__builtin_amdgcn_rcpf(wsf[32+crow(r,hi)]);
  { hbf16*stg=(hbf16*)(shm+LDS_OST)+wid*2048;
    const long grow=rowbase+q0+wid*QBLK;
    int lane_e=lane; asm volatile("":"+v"(lane_e));
    float of[2][4][8]; float ssr[4]={0.f,0.f,0.f,0.f};
    #pragma unroll
    for(int hf=0;hf<2;++hf){
      #pragma unroll
      for(int r=0;r<16;++r){const int orow=crow(r,hi);
        #pragma unroll
        for(int d0=0;d0<2;++d0)stg[orow*64+d0*32+r32]=__float2bfloat16(o[2*hf+d0][r]*rli[r]);}
      asm volatile("s_waitcnt lgkmcnt(0)":::"memory");
      #pragma unroll
      for(int i=0;i<4;++i){const int row=i*8+(lane_e>>3),ch=lane_e&7; const u32x4 v=*(const u32x4*)(stg+row*64+ch*8);
        if(MODE==0){ *(u32x4*)(P.out+(grow+row)*(long)P.opitch+hf*64+ch*8)=v; }
        else { const u32x4 a=*(const u32x4*)(P.stash+(grow+row)*512+hf*64+ch*8); float ss=0.f;
          #pragma unroll
          for(int j=0;j<4;++j){ const float a0=__uint_as_float(a[j]<<16),a1=__uint_as_float(a[j]&0xffff0000u),c0=__uint_as_float(v[j]<<16),c1=__uint_as_float(v[j]&0xffff0000u);
            of[hf][i][2*j]=a0-P.lam*c0; of[hf][i][2*j+1]=a1-P.lam*c1; ss+=of[hf][i][2*j]*of[hf][i][2*j]+of[hf][i][2*j+1]*of[hf][i][2*j+1]; }
          ssr[i]+=ss; } }
      asm volatile("s_waitcnt lgkmcnt(0)":::"memory");
    }
    if(MODE!=0){
      #pragma unroll
      for(int i=0;i<4;++i){const int row=i*8+(lane_e>>3),ch=lane_e&7; float ss=ssr[i];
        ss+=__int_as_float(__builtin_amdgcn_ds_swizzle(__float_as_int(ss),0x041f)); ss+=__int_as_float(__builtin_amdgcn_ds_swizzle(__float_as_int(ss),0x081f)); ss+=__int_as_float(__builtin_amdgcn_ds_swizzle(__float_as_int(ss),0x101f));
        const float rr_=rsqrtf(ss*(1.0f/128.0f)+1e-6f)*P.nscale; bf16*yp=P.out+(grow+row)*(long)P.opitch+ch*8;
        #pragma unroll
        for(int hf=0;hf<2;++hf){ const f32x4_t g0=*(const f32x4_t*)(P.gsub+hf*64+ch*8), g1=*(const f32x4_t*)(P.gsub+hf*64+ch*8+4); u32x4 w;
          w[0]=cvtpk_s(of[hf][i][0]*rr_*g0[0],of[hf][i][1]*rr_*g0[1]); w[1]=cvtpk_s(of[hf][i][2]*rr_*g0[2],of[hf][i][3]*rr_*g0[3]); w[2]=cvtpk_s(of[hf][i][4]*rr_*g1[0],of[hf][i][5]*rr_*g1[1]); w[3]=cvtpk_s(of[hf][i][6]*rr_*g1[2],of[hf][i][7]*rr_*g1[3]);
          *(u32x4*)(yp+hf*64)=w; } } } }
  asm volatile("s_waitcnt lgkmcnt(0)\n\ts_barrier":::"memory");
  #undef DMA_K
  #undef BIAS
  #undef DMA_V
  #undef CMASK
  #undef START
  #undef RESC
  #undef ROT
}
constexpr int ATTN_LDS_BYTES=LDS_BYTES;
#undef SBAR
#undef WAIT_BAR
}
#ifndef MK_MU8
#define MK_MU8 0
#endif
#ifndef MK_PLE8
#define MK_PLE8 0
#endif
#define GAS __attribute__((address_space(1)))
#define LAS __attribute__((address_space(3)))
typedef unsigned v4u __attribute__((ext_vector_type(4)));
typedef float f32x4 __attribute__((ext_vector_type(4)));
typedef GAS unsigned gu32;
#define RLX_AGENT __ATOMIC_RELAXED, __HIP_MEMORY_SCOPE_AGENT
#define LDS_WAIT() asm volatile("s_waitcnt lgkmcnt(0)" ::: "memory")
#define VM_WAIT() asm volatile("s_waitcnt vmcnt(0)" ::: "memory")
constexpr int NWAVES = 8;
constexpr size_t W_IN = 0;
constexpr size_t W_CAT = W_IN + (size_t)3840 * 1024 * 2;
constexpr size_t W_G8 = W_CAT;
constexpr size_t W_BR = W_CAT + (size_t)3 * 1024 * 1024;
constexpr float G8_SCALE = 128.0f;
constexpr size_t W_OUT = W_CAT + (size_t)3 * 1024 * 1536 * 2;
constexpr size_t W_GU = W_OUT + (size_t)1024 * 1024 * 2;
constexpr size_t W_D = W_GU + (size_t)16 * 512 * 1024 * 2;
constexpr size_t W_RH = W_D + (size_t)16 * 1024 * 256 * 2;
constexpr size_t W_RL = W_RH + 65536;
constexpr size_t W_ENDB = W_RL + 65536;
static_assert(WS_W + W_ENDB <= WS_SSB && WS_SSB + MiB <= WS_WPLE, "weight map");
constexpr size_t W_PG = 0, W_P = (size_t)1024 * 1024 * 2, WPLE_STRIDE = (size_t)5 * 512 * 1024;
constexpr size_t OUT_XB8 = 0, OUT_GATES = 16 * MiB;
constexpr size_t OV_PB = WS_PB;
constexpr size_t OV_PW = WS_PROJ + 8 * MiB;
constexpr size_t OV_ACT = WS_PROJ + 40 * MiB;
constexpr size_t OV_XB2 = WS_PROJ + 64 * MiB;
constexpr int RING_BYTES = 131072, MISC_OFF = RING_BYTES, LDS_BYTES = 147456;
constexpr int MI_N = 0, MI_BASE = 32, MI_U0 = 64, MI_TOT = 96, MI_Q = 100, MI_BAR = 104;

__device__ __forceinline__ unsigned pk2(float lo, float hi) { typedef float f2 __attribute__((ext_vector_type(2))); typedef __bf16 b2 __attribute__((ext_vector_type(2))); f2 v = {lo, hi}; b2 b = __builtin_convertvector(v, b2); return __builtin_bit_cast(unsigned, b); }
__device__ __forceinline__ float bflo(unsigned u) { return __uint_as_float(u << 16); }
__device__ __forceinline__ float bfhi(unsigned u) { return __uint_as_float(u & 0xffff0000u); }
__device__ __forceinline__ float sigm(float v) { return __builtin_amdgcn_rcpf(1.0f + __expf(-v)); }
__device__ __forceinline__ float sg2(float t) { return __builtin_amdgcn_rcpf(1.0f + __builtin_amdgcn_exp2f(t)); }
__device__ __forceinline__ float clamp8(float v) { return __builtin_amdgcn_fmed3f(v, -448.0f, 448.0f); }
__device__ __forceinline__ unsigned pk_fp8x4(float a, float b, float c, float d) {
    int w = __builtin_amdgcn_cvt_pk_fp8_f32(clamp8(a), clamp8(b), 0, false); w = __builtin_amdgcn_cvt_pk_fp8_f32(clamp8(c), clamp8(d), w, true); return (unsigned)w; }

#define XOR1(v) __int_as_float(__builtin_amdgcn_ds_swizzle(__float_as_int(v), 0x041f))
#define XOR2(v) __int_as_float(__builtin_amdgcn_ds_swizzle(__float_as_int(v), 0x081f))
#define XOR4(v) __int_as_float(__builtin_amdgcn_ds_swizzle(__float_as_int(v), 0x101f))
#define XOR8(v) __int_as_float(__builtin_amdgcn_ds_swizzle(__float_as_int(v), 0x201f))
#define XOR16(v) __int_as_float(__builtin_amdgcn_ds_swizzle(__float_as_int(v), 0x401f))
__device__ __forceinline__ float add_xor32(float v) { const auto r = __builtin_amdgcn_permlane32_swap(__float_as_uint(v), __float_as_uint(v), false, false); return __uint_as_float(r[0]) + __uint_as_float(r[1]); }
__device__ __forceinline__ float wave_sum64(float v) { v += XOR1(v); v += XOR2(v); v += XOR4(v); v += XOR8(v); v += XOR16(v); return add_xor32(v); }
__device__ __forceinline__ int mk_tid(int wave0) { int l; asm volatile("v_mbcnt_lo_u32_b32 %0, -1, 0\n\tv_mbcnt_hi_u32_b32 %0, -1, %0" : "=v"(l)); return wave0 * 64 + l; }

#define XB_TMO      128
#define XB_XCNT(j)  (256  + 64 * (j))
#define XB_XSUB(j)  (1280 + 64 * (j))
#define XB_XGEN(j)  (2304 + 64 * (j))
#define XB_TOP      3328
#define XB_TOPGEN   3392
#define XCD_BAR_WORDS 3456
#define XB_SPIN_CAP (1u << 18)
__device__ __forceinline__ unsigned xb_ld(unsigned* p)              { return __hip_atomic_load(p, __ATOMIC_RELAXED, __HIP_MEMORY_SCOPE_AGENT); }
__device__ __forceinline__ unsigned xb_add(unsigned* p, unsigned v) { return __hip_atomic_fetch_add(p, v, __ATOMIC_RELAXED, __HIP_MEMORY_SCOPE_AGENT); }
__device__ __forceinline__ unsigned xb_xcc_id() { return (unsigned)__builtin_amdgcn_s_getreg((3 << 11) | 20) & 0xFu; }
#define XB_SPIN(cond, bar) do { unsigned _sp = 0; while (cond) { __builtin_amdgcn_s_sleep(1); \
    if ((++_sp & 255u) == 0u) { if (xb_ld(&(bar)[XB_TMO])) break; if (_sp > XB_SPIN_CAP) { atomicAdd(&(bar)[XB_TMO], 1u); break; } } } } while (0)
struct XcdBarrier { unsigned* bar; unsigned x; volatile LAS unsigned* st; };
__device__ __forceinline__ XcdBarrier xcd_barrier_post(unsigned* bar, volatile LAS unsigned* st, int tid) {
    XcdBarrier b; b.bar = bar; b.x = xb_xcc_id(); b.st = st;
    if (tid == 0) (void)xb_add(&bar[XB_XCNT(b.x)], 1u);
    return b;
}
__device__ __forceinline__ void xcd_barrier_complete(unsigned* bar, unsigned x, unsigned& nloc, unsigned& nx) {
    const unsigned G = gridDim.x * gridDim.y * gridDim.z;
    unsigned sum, cnt, mine, sp = 0u;
    for (;;) {
        sum = 0u; cnt = 0u; mine = 0u;
#pragma unroll
        for (unsigned j = 0; j < 16; ++j) { const unsigned c = xb_ld(&bar[XB_XCNT(j)]); sum += c; cnt += (c > 0u) ? 1u : 0u; mine = (j == x) ? c : mine; }
        if (sum == G) break;
        __builtin_amdgcn_s_sleep(1);
        if ((++sp & 255u) == 0u) { if (xb_ld(&bar[XB_TMO])) break; if (sp > XB_SPIN_CAP) { atomicAdd(&bar[XB_TMO], 1u); break; } }
    }
    nloc = mine > 0u ? mine : 1u; nx = cnt > 0u ? cnt : 1u;
}
#ifndef MK_EARLYINV
#define MK_EARLYINV 1
#endif
#ifndef MK_SPLIT_SLEEP
#define MK_SPLIT_SLEEP 16
#endif
__device__ __forceinline__ void xcd_barrier(const XcdBarrier& b, int tid) {
    asm volatile("s_waitcnt vmcnt(0)" ::: "memory");
    __syncthreads();
    if (tid == 0) {
        unsigned* bar = b.bar;
        __builtin_amdgcn_s_waitcnt(0);
        unsigned nloc = b.st[0], nx = b.st[1];
        if (nloc == 0u) { xcd_barrier_complete(bar, b.x, nloc, nx); b.st[0] = nloc; b.st[1] = nx; }
        const unsigned old = xb_add(&bar[XB_XSUB(b.x)], 1u);
        const unsigned gen = old / nloc;
        if (old + 1u == (gen + 1u) * nloc) {
            __builtin_amdgcn_fence(__ATOMIC_RELEASE, "agent");
            asm volatile("s_waitcnt vmcnt(0)" ::: "memory");
            const unsigned og = xb_add(&bar[XB_TOP], 1u);
            unsigned tg = og / nx; asm volatile("" : "+v"(tg) :: "memory");
            if (og + 1u == (tg + 1u) * nx) { xb_add(&bar[XB_TOPGEN], 1u);
#if MK_EARLYINV
                xb_add(&bar[XB_XGEN(b.x)], 1u); asm volatile("buffer_inv sc1" ::: "memory");
#endif
            } else {
#if MK_EARLYINV
                asm volatile("buffer_inv sc1" ::: "memory");
#endif
                XB_SPIN(xb_ld(&bar[XB_TOPGEN]) == tg, bar);
#if MK_EARLYINV
                xb_add(&bar[XB_XGEN(b.x)], 1u);
#endif
            }
#if !MK_EARLYINV
            __builtin_amdgcn_fence(__ATOMIC_ACQUIRE, "agent");
            xb_add(&bar[XB_XGEN(b.x)], 1u);
#endif
            asm volatile("s_waitcnt vmcnt(0)" ::: "memory");
        } else {
#if MK_EARLYINV
            { unsigned g2 = gen; asm volatile("" : "+v"(g2) :: "memory"); asm volatile("buffer_inv sc1" ::: "memory");
              XB_SPIN(xb_ld(&bar[XB_XGEN(b.x)]) == g2, bar); }
#else
            XB_SPIN(xb_ld(&bar[XB_XGEN(b.x)]) == gen, bar);
            __builtin_amdgcn_fence(__ATOMIC_ACQUIRE, "agent");
#endif
            asm volatile("s_waitcnt vmcnt(0)" ::: "memory");
        }
    }
    __syncthreads();
}

__device__ __forceinline__ void split_arrive(unsigned* cnt, int tid) {
    asm volatile("s_waitcnt vmcnt(0)" ::: "memory"); __syncthreads();
    if (tid == 0) { __builtin_amdgcn_fence(__ATOMIC_RELEASE, "agent"); asm volatile("s_waitcnt vmcnt(0)" ::: "memory"); xb_add(cnt, 1u); }
}
__device__ __forceinline__ void split_arrive_x(const XcdBarrier& b, unsigned* cnt_top, unsigned* cnt_x, int tid) {
    asm volatile("s_waitcnt vmcnt(0)" ::: "memory"); __syncthreads();
    if (tid == 0) { const unsigned nloc = b.st[0]; const unsigned old = xb_add(cnt_x + 8u * b.x, 1u);
        if (old + 1u == nloc) { __builtin_amdgcn_fence(__ATOMIC_RELEASE, "agent"); asm volatile("s_waitcnt vmcnt(0)" ::: "memory"); xb_add(cnt_top, nloc); }
#if MK_EARLYINV
        asm volatile("buffer_inv sc1" ::: "memory");
#endif
    }
}
__device__ __forceinline__ void split_wait_leader(unsigned* cnt, unsigned target) {
    unsigned sp = 0; while (xb_ld(cnt) < target) { __builtin_amdgcn_s_sleep(MK_SPLIT_SLEEP); if (++sp > (1u << 22)) break; }
#if !MK_EARLYINV
    __builtin_amdgcn_fence(__ATOMIC_ACQUIRE, "agent");
#endif
    asm volatile("s_waitcnt vmcnt(0)" ::: "memory");
}

__device__ __forceinline__ void group4_sync(unsigned* gc, int tid) {
    asm volatile("s_waitcnt vmcnt(0)" ::: "memory"); __syncthreads();
    if (tid == 0) { const unsigned sh = 8u + 3u * xb_xcc_id();
        xb_add(gc, 1u + (1u << sh));
        asm volatile("buffer_inv sc1" ::: "memory");
        unsigned sp = 0, v = 0; for (;;) { v = xb_ld(gc); if ((v & 0xffu) >= 4u) break; __builtin_amdgcn_s_sleep(1); if (++sp > (1u << 22)) break; }
        if (((v >> sh) & 7u) != 4u) {
            __builtin_amdgcn_fence(__ATOMIC_RELEASE, "agent"); asm volatile("s_waitcnt vmcnt(0)" ::: "memory");
            xb_add(gc + 16, 1u); sp = 0; while (xb_ld(gc + 16) < 4u) { __builtin_amdgcn_s_sleep(1); if (++sp > (1u << 22)) break; }
            __builtin_amdgcn_fence(__ATOMIC_ACQUIRE, "agent"); }
        asm volatile("s_waitcnt vmcnt(0)" ::: "memory"); }
    __syncthreads();
}

struct Args { const void* in[27]; float* out; unsigned char* ws; int ph_lo, ph_hi, li, pad; };
struct LayerW {
    const float *g_attn, *w_in, *pool_w, *pool_scale, *dqn, *dkn, *dlam, *dsub, *fqn, *fkn, *ffb, *w_branch, *w_out, *g_ffn, *wrg, *brg, *wre, *bre, *wg, *wu, *wd, *g_ple, *wpg, *wple, *p;
};
__device__ __forceinline__ LayerW layer_view(const __attribute__((address_space(4))) Args* a, int l) {
    LayerW w; const float* in[27];
#pragma unroll
    for (int i = 0; i < 27; ++i) in[i] = (const float*)a->in[i];
    w.g_attn = in[3] + l * 1024; w.w_in = in[4] + (size_t)l * 1024 * INW; w.pool_w = in[5] + (size_t)l * 65536; w.pool_scale = in[6] + l * 512;
    w.dqn = in[7] + l * 64; w.dkn = in[8] + l * 64; w.dlam = in[9] + l * 256; w.dsub = in[10] + l * 128; w.fqn = in[11] + l * 64; w.fkn = in[12] + l * 64; w.ffb = in[13] + l * 8;
    w.w_branch = in[14] + (size_t)l * 3 * 512 * 1024; w.w_out = in[15] + (size_t)l * 1024 * 1024; w.g_ffn = in[16] + l * 1024; w.wrg = in[17] + (size_t)l * 4096; w.brg = in[18] + l * 4;
    w.wre = in[19] + (size_t)l * 16384; w.bre = in[20] + l * 16; w.wg = in[21] + (size_t)l * 16 * 262144; w.wu = in[22] + (size_t)l * 16 * 262144; w.wd = in[23] + (size_t)l * 16 * 262144;
    w.g_ple = in[24] + l * 1024; w.wpg = in[25] + (size_t)l * 1024 * 1024; w.wple = in[26] + (size_t)l * 256 * 1024; w.p = in[1] + (size_t)l * T * 256;
    return w;
}

__device__ __forceinline__ void tr_item(const float* __restrict__ src, int ldsrc, int c0, int nvalid, int k0, const float* __restrict__ gk, bf16* dst, int dpitch, int nrow0, int dk0, LAS float* scr, int lane, const bool f8 = false) {
    float vv[32];
#pragma unroll
    for (int i = 0; i < 32; ++i) { const int kk = 2 * i + (lane >> 5), c = lane & 31; vv[i] = (c < nvalid) ? src[(size_t)(k0 + kk) * ldsrc + c0 + c] : 0.f; }
    if (gk) {
#pragma unroll
        for (int i = 0; i < 32; ++i) vv[i] *= gk[k0 + 2 * i + (lane >> 5)]; }
#pragma unroll
    for (int i = 0; i < 32; ++i) scr[(2 * i + (lane >> 5)) * 33 + (lane & 31)] = vv[i];
    LDS_WAIT(); asm volatile("" ::: "memory");
    const int c8 = lane & 7;
#pragma unroll
    for (int j = 0; j < 4; ++j) { const int n = (lane >> 3) + 8 * j; const LAS float* s = scr + (8 * c8) * 33 + n;
        if (f8) { typedef unsigned v2u_ __attribute__((ext_vector_type(2))); v2u_ o;
            o.x = pk_fp8x4(s[0 * 33] * G8_SCALE, s[1 * 33] * G8_SCALE, s[2 * 33] * G8_SCALE, s[3 * 33] * G8_SCALE); o.y = pk_fp8x4(s[4 * 33] * G8_SCALE, s[5 * 33] * G8_SCALE, s[6 * 33] * G8_SCALE, s[7 * 33] * G8_SCALE);
            *(GAS v2u_*)((GAS char*)dst + (size_t)(nrow0 + n) * dpitch + dk0 + 8 * c8) = o; }
        else { v4u o; o.x = pk2(s[0 * 33], s[1 * 33]); o.y = pk2(s[2 * 33], s[3 * 33]); o.z = pk2(s[4 * 33], s[5 * 33]); o.w = pk2(s[6 * 33], s[7 * 33]);
            *(GAS v4u*)(dst + (size_t)(nrow0 + n) * dpitch + dk0 + 8 * c8) = o; } }
    LDS_WAIT(); asm volatile("" ::: "memory");
}
constexpr int CV_EARLY = 1536 + 128 + 1536 + 768, CV_NIT = CV_EARLY + 512 + 4096 + 2048 + 512 + 128, CV_LATE_BATCHES = (CV_NIT - CV_EARLY + 7) / 8, CV_RT_BATCHES = 64, CV_PB_BATCHES = 64;
__device__ __forceinline__ void conv_item(const LayerW& w, unsigned char* ws, int l, int it, LAS float* scr, int lane) {
    bf16* Wb = (bf16*)(ws + WS_W); bf16* WIN = (bf16*)(ws + WS_W + W_IN); bf16* WOUT = (bf16*)(ws + WS_W + W_OUT);
    bf16* WGU = (bf16*)(ws + WS_W + W_GU); bf16* WDN = (bf16*)(ws + WS_W + W_D); bf16* WPG = (bf16*)(ws + WS_WPLE + l * WPLE_STRIDE + W_PG); bf16* WP = (bf16*)(ws + WS_WPLE + l * WPLE_STRIDE + W_P);
    (void)Wb;
    constexpr int I_A = 1536, I_B = 128, I_D1 = 1536, I_D2 = 768, I_E = 512, I_F = 4096, I_G = 2048, I_H1 = 512, I_H2 = 128;
    constexpr int NIT = I_A + I_B + I_D1 + I_D2 + I_E + I_F + I_G + I_H1 + I_H2;
    int r = it;
        if (r < I_A) { const int kb = r / 96, nb = r % 96, p0 = 512 + 32 * nb, pn = p0 >> 8, q0 = p0 & 255;
            const bool head = (pn >= 2 && pn <= 5) || (pn >= 8 && pn <= 11);
            const int c0 = head ? (256 * pn + 64 * ((q0 >> 5) & 3) + 32 * (q0 >> 7)) : p0;
            tr_item(w.w_in, INW, c0, 32, 64 * kb, w.g_attn, WIN, 1024, p0, 64 * kb, scr, lane); return; } r -= I_A;
        if (r < I_B) { const int kb = r / 8, nb = r % 8; tr_item(w.w_in, INW, 3584, nb == 0 ? 8 : 0, 64 * kb, w.g_attn, WIN, 1024, 3584 + 32 * nb, 64 * kb, scr, lane); return; } r -= I_B;
        if (r < I_D1) { const int n = r / 512, r2 = r % 512, kb = r2 / 32, nb = r2 % 32;
            tr_item(w.w_in, INW, 3592 + n * 1024 + 32 * nb, 32, 64 * kb, w.g_attn, (bf16*)(ws + WS_W + W_G8 + (size_t)n * 1024 * 1024), 1024, 32 * nb, 64 * kb, scr, lane, true); return; } r -= I_D1;
        if (r < I_D2) { const int n = r / 256, r2 = r % 256, kb = r2 / 32, nb = r2 % 32;
            tr_item(w.w_branch + (size_t)n * 512 * 1024, 1024, 32 * nb, 32, 64 * kb, nullptr, (bf16*)(ws + WS_W + W_BR) + (size_t)n * 1024 * 512, 512, 32 * nb, 64 * kb, scr, lane); return; } r -= I_D2;
        if (r < I_E) { const int kb = r / 32, nb = r % 32; tr_item(w.w_out, 1024, 32 * nb, 32, 64 * kb, nullptr, WOUT, 1024, 32 * nb, 64 * kb, scr, lane); return; } r -= I_E;
        if (r < I_F) { const int e = r / 256, r1 = r % 256, hf = r1 / 128, r2 = r1 % 128, kb = r2 / 8, nb = r2 % 8, q0 = 32 * nb;
            const float* src = ((q0 >> 7) ? w.wu : w.wg) + (size_t)e * 262144;
            const bool f8 = MK_MU8 && l == NL - 1;
            tr_item(src, 256, 128 * hf + (q0 & 127), 32, 64 * kb, w.g_ffn, f8 ? (bf16*)((unsigned char*)WGU + (size_t)(e * 2 + hf) * 256 * 1024) : WGU + (size_t)(e * 2 + hf) * 256 * 1024, 1024, q0, 64 * kb, scr, lane, f8); return; } r -= I_F;
        if (r < I_G) { const int e = r / 128, r2 = r % 128, kb = r2 / 32, nb = r2 % 32;
            tr_item(w.wd + (size_t)e * 262144, 1024, 32 * nb, 32, 64 * kb, nullptr, WDN + (size_t)e * 262144, 256, 32 * nb, 64 * kb, scr, lane); return; } r -= I_G;
        if (r < I_H1) { const int kb = r / 32, nb = r % 32; tr_item(w.wpg, 1024, 32 * nb, 32, 64 * kb, w.g_ple, WPG, 1024, 32 * nb, 64 * kb, scr, lane, MK_PLE8 != 0); return; } r -= I_H1;
        { const int kb = r / 32, nb = r % 32; tr_item(w.wple, 1024, 32 * nb, 32, 64 * kb, nullptr, WP, 256, 32 * nb, 64 * kb, scr, lane); }
}
__device__ __forceinline__ void conv_late_batch(const LayerW& w, unsigned char* ws, int l, LAS unsigned char* lds, int batch, int tid) {
    const int lane = tid & 63, wave = __builtin_amdgcn_readfirstlane(tid >> 6);
    if (batch < CV_LATE_BATCHES) { const int it = CV_EARLY + batch * 8 + wave; if (it < CV_NIT) conv_item(w, ws, l, it, (LAS float*)(lds + wave * 16384), lane); }
    else if (batch >= CV_LATE_BATCHES + CV_RT_BATCHES) {
        const int i0 = (batch - CV_LATE_BATCHES - CV_RT_BATCHES) * 8192 + tid; GAS v4u* PB = (GAS v4u*)(ws + OV_PB);
#pragma clang loop unroll(disable)
        for (int q0 = 0; q0 < 16; q0 += 4) { f32x4 a[4], b[4];
#pragma unroll
            for (int q = 0; q < 4; ++q) { const GAS f32x4* s = (const GAS f32x4*)(w.p) + 2 * (size_t)(i0 + (q0 + q) * 512); a[q] = s[0]; b[q] = s[1]; }
#pragma unroll
            for (int q = 0; q < 4; ++q) { v4u o; o.x = pk2(a[q].x, a[q].y); o.y = pk2(a[q].z, a[q].w); o.z = pk2(b[q].x, b[q].y); o.w = pk2(b[q].z, b[q].w); PB[i0 + (q0 + q) * 512] = o; } } }
    else { const int idx = (batch - CV_LATE_BATCHES) * 512 + tid; const int e = idx >> 10, k = idx & 1023;
        const float v = w.g_ffn[k] * (e < 4 ? w.wrg[k * 4 + e] : (e < 20 ? w.wre[k * 16 + e - 4] : 0.f));
        const unsigned hi = pk2(v, 0.f) & 0xffffu; const unsigned lo = pk2(v - bflo(hi), 0.f) & 0xffffu;
        ((bf16*)(ws + WS_W + W_RH))[idx] = (bf16)hi; ((bf16*)(ws + WS_W + W_RL))[idx] = (bf16)lo; }
}
__device__ __forceinline__ void weff_job(const LayerW& w, unsigned char* ws, LAS unsigned char* lds, int job, int tid) {
    bf16* WIN = (bf16*)(ws + WS_W + W_IN);
    LAS float* Wt = (LAS float*)lds; LAS float* Pw = (LAS float*)(lds + 36864);
    const int kb = job >> 4, g = (job >> 2) & 3, nq = job & 3, k0 = 64 * kb;
    for (int e = tid; e < 64 * 128; e += 512) { const int kk = e >> 7, c = e & 127; Wt[kk * 132 + c] = w.w_in[(size_t)(k0 + kk) * INW + 128 * g + c]; }
    for (int e = tid; e < 128 * 32; e += 512) { const int c = e >> 5, n = e & 31; Pw[c * 32 + n] = w.pool_w[(size_t)g * 16384 + c * 128 + 32 * nq + n]; }
    __syncthreads();
    const int n = tid & 31, ks = tid >> 5; float a[4] = {0.f, 0.f, 0.f, 0.f};
#pragma unroll 2
    for (int c = 0; c < 128; c += 4) {
        const float p0 = Pw[c * 32 + n], p1 = Pw[(c + 1) * 32 + n], p2 = Pw[(c + 2) * 32 + n], p3 = Pw[(c + 3) * 32 + n];
#pragma unroll
        for (int i = 0; i < 4; ++i) { const f32x4 w4 = *(const LAS f32x4*)(Wt + (ks * 4 + i) * 132 + c); a[i] += (w4.x * p0 + w4.y * p1) + (w4.z * p2 + w4.w * p3); } }
    const float sc = w.pool_scale[128 * g + 32 * nq + n];
#pragma unroll
    for (int i = 0; i < 4; ++i) a[i] *= sc * w.g_attn[k0 + ks * 4 + i];
    *(GAS unsigned long long*)(WIN + (size_t)(128 * g + 32 * nq + n) * 1024 + k0 + ks * 4) = (unsigned long long)pk2(a[0], a[1]) | ((unsigned long long)pk2(a[2], a[3]) << 32);
    __syncthreads();
}
__device__ __forceinline__ void conv_layer(const LayerW& w, unsigned char* ws, int l, LAS unsigned char* lds, int vcu, int G, int tid) {
    const int lane = tid & 63, wave = __builtin_amdgcn_readfirstlane(tid >> 6);
    LAS float* scr = (LAS float*)(lds + wave * 16384);
    const int gw = vcu * NWAVES + wave, NGW = G * NWAVES;
    for (int it = gw; it < CV_EARLY; it += NGW) conv_item(w, ws, l, it, scr, lane);
    __syncthreads();
    for (int job = vcu; job < 256; job += G) weff_job(w, ws, lds, job, tid);
}
constexpr int CV_EARLY_BATCHES = CV_EARLY / 8 + 256;
__device__ __forceinline__ void conv_early_batch(const LayerW& w, unsigned char* ws, int l, LAS unsigned char* lds, int batch, int tid) {
    const int lane = tid & 63, wave = __builtin_amdgcn_readfirstlane(tid >> 6);
    if (batch < CV_EARLY / 8) { conv_item(w, ws, l, batch * 8 + wave, (LAS float*)(lds + wave * 16384), lane); __syncthreads(); }
    else weff_job(w, ws, lds, batch - CV_EARLY / 8, tid);
}
__device__ __forceinline__ void p0_x(const float* x, const int* positions, unsigned char* ws, unsigned char* x8, int vcu, int G, int tid) {
    const int lane = tid & 63, wave = __builtin_amdgcn_readfirstlane(tid >> 6);
    bf16* XY = (bf16*)(ws + WS_XY); float* SS = (float*)(ws + WS_SS); float* CS = (float*)(ws + WS_COSSIN);
    const int gw = vcu * NWAVES + wave, NGW = G * NWAVES;
    for (int t = gw; t < T; t += NGW) {
        const GAS f32x4* xr = (const GAS f32x4*)(x + (size_t)t * 1024) + lane; float s = 0.f;
        GAS unsigned long long* o8 = (GAS unsigned long long*)(XY + (size_t)t * XYP + 1536) + lane;
#pragma unroll
        for (int j = 0; j < 4; ++j) { const f32x4 v = xr[64 * j]; s += (v.x * v.x + v.y * v.y) + (v.z * v.z + v.w * v.w); o8[64 * j] = (unsigned long long)pk2(v.x, v.y) | ((unsigned long long)pk2(v.z, v.w) << 32);
            ((GAS unsigned*)(x8 + (size_t)t * 1024))[lane + 64 * j] = pk_fp8x4(v.x, v.y, v.z, v.w); }
        s = wave_sum64(s);
        if (lane < 16) SS[(size_t)t * 16 + lane] = lane == 0 ? s : 0.f;
    }
    for (int idx = vcu * 512 + tid; idx < T * 8; idx += G * 512) { const int t = idx >> 3, i = idx & 7;
        const float invf = powf(500000.0f, -(float)(2 * i) / 16.0f); const float ang = (float)positions[t] * invf;
        CS[(size_t)t * 16 + i] = cosf(ang); CS[(size_t)t * 16 + 8 + i] = sinf(ang); }
}

typedef pg8::f32x4 (&AccRef)[2][2][4][2];
#define LAUNDER3(a, b, c) asm volatile("" : "+v"(a), "+v"(b), "+v"(c))
__device__ __forceinline__ float rstd_at(const float* SS, unsigned row) {
    const GAS f32x4* p = (const GAS f32x4*)((const GAS char*)SS + row * 64u); const f32x4 a = p[0], b = p[1], c = p[2], d = p[3];
    const float s = ((a.x + a.y) + (a.z + a.w)) + ((b.x + b.y) + (b.z + b.w)) + ((c.x + c.y) + (c.z + c.w)) + ((d.x + d.y) + (d.z + d.w));
    return rsqrtf(s * (1.0f / 1024.0f) + RMS_EPS);
}
__device__ __forceinline__ void rstd8(const float* SS, unsigned row0, int fq, float (&rs)[8]) {
    f32x4 v[8];
#pragma unroll
    for (int i = 0; i < 8; ++i) v[i] = *(const GAS f32x4*)((const GAS char*)SS + ((row0 + (unsigned)((i >> 2) * 128 + (i & 3) * 16)) * 64u + (unsigned)fq * 16u));
#pragma unroll
    for (int i = 0; i < 8; ++i) { float s = (v[i].x + v[i].y) + (v[i].z + v[i].w); s += XOR16(s); s = add_xor32(s); rs[i] = rsqrtf(s * (1.0f / 1024.0f) + RMS_EPS); }
}
__device__ __forceinline__ float logsig(float z) { return fminf(z, 0.f) - log1pf(expf(-fabsf(z))); }
struct EpiG1 {
    const float* SS; bf16* PROJ; float* LOGF; const float* CS; const float* GT; const float* ffb; int dry; const LAS float* rsl;
    __device__ __forceinline__ void operator()(AccRef acc, const pg8::Step& st, int wr, int wc, int fr_, int fq_) const {
        if (dry) return;
        int fr = fr_, fq = fq_, zz = 0; LAUNDER3(fr, fq, zz);
        const int pn = st.pn; const unsigned row0 = (unsigned)(st.pm * 256 + wr * 64 + fr);
#define RSL8(dst_) do { _Pragma("unroll") for (int i_ = 0; i_ < 8; ++i_) dst_[i_] = rsl[st.aux * 256 + (i_ >> 2) * 128 + wr * 64 + (i_ & 3) * 16 + fr]; } while (0)
        const bool head = (pn >= 2 && pn <= 5) || (pn >= 8 && pn <= 11);
        if (head) {
            const float* gain = GT + 64 * (pn < 4 ? 0 : (pn < 6 ? 1 : (pn < 10 ? 2 : 3)));
            const bool rot = pn < 6; const float osc = (pn < 4 || (pn >= 8 && pn < 10)) ? C2 : 1.0f;
            f32x4 G[2][2];
#pragma unroll
            for (int bj = 0; bj < 2; ++bj)
#pragma unroll
                for (int n = 0; n < 2; ++n) G[bj][n] = *(const GAS f32x4*)((const GAS char*)gain + (unsigned)(32 * bj + 8 * fq + 4 * n) * 4u);
            const GAS char* pb = (const GAS char*)PROJ + (unsigned)(256 * pn + 64 * wc) * 2u;
            float rs8[8]; RSL8(rs8);
            f32x4 cs[4];
#define G1_LOADCS(i_) do { if (rot && fq < 2) { const GAS f32x4* cp_ = (const GAS f32x4*)((const GAS char*)CS + (row0 + (unsigned)(((i_) >> 2) * 128 + ((i_) & 3) * 16)) * 64u); \
                _Pragma("unroll") for (int q_ = 0; q_ < 4; ++q_) cs[q_] = cp_[q_]; } } while (0)
            G1_LOADCS(0);
#pragma unroll
            for (int i = 0; i < 8; ++i) {
                v4u ov[2];
                {
                    const int ai = i >> 2, m = i & 3; const float rs = rs8[i];
                    f32x4 v[2][2]; float ss = 0.f;
#pragma unroll
                    for (int bj = 0; bj < 2; ++bj)
#pragma unroll
                        for (int n = 0; n < 2; ++n) { v[bj][n] = acc[ai][bj][m][n]; const f32x4 q = v[bj][n] * v[bj][n]; ss += (q.x + q.y) + (q.z + q.w); }
                    ss += XOR16(ss); ss = add_xor32(ss);
                    const float hn = rsqrtf(ss * (1.0f / 64.0f) + RMS_EPS * __builtin_amdgcn_rcpf(rs * rs)) * osc;
#pragma unroll
                    for (int bj = 0; bj < 2; ++bj)
#pragma unroll
                        for (int n = 0; n < 2; ++n) v[bj][n] = v[bj][n] * hn * G[bj][n];
                    if (rot) {
                        f32x4 ot[2];
#pragma unroll
                        for (int n = 0; n < 2; ++n) { ot[n].x = XOR16(v[0][n].x); ot[n].y = XOR16(v[0][n].y); ot[n].z = XOR16(v[0][n].z); ot[n].w = XOR16(v[0][n].w); }
                        if (fq < 2) {
#pragma unroll
                            for (int n = 0; n < 2; ++n) { const f32x4 c = cs[n], s = cs[2 + n]; v[0][n] = (fq == 0) ? (v[0][n] * c - ot[n] * s) : (v[0][n] * c + ot[n] * s); }
                        }
                    }
#pragma unroll
                    for (int bj = 0; bj < 2; ++bj) { ov[bj].x = pk2(v[bj][0].x, v[bj][0].y); ov[bj].y = pk2(v[bj][0].z, v[bj][0].w); ov[bj].z = pk2(v[bj][1].x, v[bj][1].y); ov[bj].w = pk2(v[bj][1].z, v[bj][1].w); }
                }
                if (i < 7) G1_LOADCS(i + 1);
                asm volatile("" ::: "memory");
                { const unsigned row = row0 + (unsigned)((i >> 2) * 128 + (i & 3) * 16);
#pragma unroll
                    for (int bj = 0; bj < 2; ++bj) *(GAS v4u*)(pb + (row * (unsigned)(PJP * 2) + (unsigned)(32 * bj + 8 * fq) * 2u)) = ov[bj]; }
                asm volatile("" ::: "memory");
            }
#undef G1_LOADCS
        } else if (pn == 14) {
            float rs14[8]; RSL8(rs14);
            if (wc == 0 && fq == 0) {
                const f32x4 b0 = *(const GAS f32x4*)ffb, b1 = *(const GAS f32x4*)(ffb + 4);
#pragma unroll
                for (int ai = 0; ai < 2; ++ai)
#pragma unroll
                    for (int m = 0; m < 4; ++m) {
                        const unsigned row = row0 + ai * 128 + m * 16; const float rs = rs14[ai * 4 + m];
                        const f32x4 z0 = acc[ai][0][m][0] * rs + b0, z1 = acc[ai][0][m][1] * rs + b1; f32x4 o0, o1;
                        o0.x = logsig(z0.x); o0.y = logsig(z0.y); o0.z = logsig(z0.z); o0.w = logsig(z0.w); o1.x = logsig(z1.x); o1.y = logsig(z1.y); o1.z = logsig(z1.z); o1.w = logsig(z1.w);
                        GAS f32x4* d = (GAS f32x4*)((GAS char*)LOGF + row * 32u); d[0] = o0; d[1] = o1;
                    }
            }
        } else {
            const GAS char* pb = (const GAS char*)PROJ + (unsigned)(256 * pn + 32 * wc) * 2u;
            float rsp[8]; RSL8(rsp);
#pragma unroll
            for (int ai = 0; ai < 2; ++ai)
#pragma unroll
                for (int m = 0; m < 4; ++m) {
                    const unsigned row = row0 + ai * 128 + m * 16; const float rs = rsp[ai * 4 + m];
#pragma unroll
                    for (int bj = 0; bj < 2; ++bj) { const f32x4 a = acc[ai][bj][m][0] * rs, b = acc[ai][bj][m][1] * rs; v4u o; o.x = pk2(a.x, a.y); o.y = pk2(a.z, a.w); o.z = pk2(b.x, b.y); o.w = pk2(b.z, b.w);
                        *(GAS v4u*)(pb + (row * (unsigned)(PJP * 2) + (unsigned)(128 * bj + 8 * fq) * 2u)) = o; }
                }
        }
    }
};
typedef unsigned v2u __attribute__((ext_vector_type(2)));
__device__ __forceinline__ unsigned pk8(float a, float b, float c, float d) {
    unsigned w = __builtin_amdgcn_cvt_pk_u8_f32(a * 256.0f - 0.5f, 0u, 0u); w = __builtin_amdgcn_cvt_pk_u8_f32(b * 256.0f - 0.5f, 1u, w); w = __builtin_amdgcn_cvt_pk_u8_f32(c * 256.0f - 0.5f, 2u, w); return __builtin_amdgcn_cvt_pk_u8_f32(d * 256.0f - 0.5f, 3u, w); }
__device__ __forceinline__ float g8(unsigned w, const int k) { return ((float)((w >> (8 * k)) & 0xffu) + 0.5f) * (1.0f / 256.0f); }
__device__ __forceinline__ float g8u(unsigned w, const int k) { return (float)((w >> (8 * k)) & 0xffu) + 0.5f; }
#undef RSL8
template <int PART>
struct EpiG2 {
    const float* SS; unsigned char* gs; bf16* MERGED; const LAS float* rsl;
    __device__ __forceinline__ void operator()(AccRef acc, const pg8::Step& st, int wr, int wc, int fr_, int fq_) const {
        int ln; asm volatile("v_mbcnt_lo_u32_b32 %0, -1, 0\n\tv_mbcnt_hi_u32_b32 %0, -1, %0" : "=v"(ln));
        int fr = ln & 15, fq = ln >> 4, tid = (wr * 4 + wc) * 64 + ln; LAUNDER3(fr, fq, tid); (void)fr_; (void)fq_;
        const int aux = st.aux; const unsigned row0 = (unsigned)(st.pm * 256 + wr * 64 + fr), toff = (unsigned)tid * 8u;
        const int n = aux < 3 ? aux : aux - 3; GAS char* gb = (GAS char*)gs + (size_t)n * 65536;
        GAS char* mb = (GAS char*)MERGED + (unsigned)(256 * st.pn + 32 * wc) * 2u;
        float rsg[8];
#pragma unroll
        for (int i = 0; i < 8; ++i) rsg[i] = 0.f;
        if (PART == 0) {
#pragma unroll
            for (int i = 0; i < 8; ++i) rsg[i] = rsl[(i >> 2) * 128 + wr * 64 + (i & 3) * 16 + fr]; }
#pragma unroll
        for (int ai = 0; ai < 2; ++ai) {
            v2u gn[4][2], gd[4][2];
#pragma unroll
            for (int m = 0; m < 4; ++m)
#pragma unroll
                for (int bj = 0; bj < 2; ++bj) { gn[m][bj] = (v2u){0u, 0u}; gd[m][bj] = (v2u){0u, 0u}; }
            if (PART == 1) {
#pragma unroll
                for (int m = 0; m < 4; ++m)
#pragma unroll
                    for (int bj = 0; bj < 2; ++bj) { const unsigned so = toff + (unsigned)(((ai * 4 + m) * 2 + bj) * 4096); gn[m][bj] = *(const GAS v2u*)(gb + so); if (aux < 5) gd[m][bj] = *(const GAS v2u*)(gb + 65536 + so); }
            }
            asm volatile("" ::: "memory");
#pragma unroll
            for (int m = 0; m < 4; ++m) {
                const float rs = rsg[ai * 4 + m] * (1.0f / G8_SCALE);
#pragma unroll
                for (int bj = 0; bj < 2; ++bj) {
                    const unsigned so = toff + (unsigned)(((ai * 4 + m) * 2 + bj) * 4096);
                    const f32x4 a = acc[ai][bj][m][0], b = acc[ai][bj][m][1]; const v2u n_ = gn[m][bj], d_ = gd[m][bj];
                    f32x4 fa = (f32x4){0.f, 0.f, 0.f, 0.f}, fb = fa;
                    if (PART == 0) { const float rsn = rs * -1.4426950408889634f; const f32x4 x = a * rsn, y = b * rsn; v2u o;
                        o.x = pk8(sg2(x.x), sg2(x.y), sg2(x.z), sg2(x.w)); o.y = pk8(sg2(y.x), sg2(y.y), sg2(y.z), sg2(y.w));
                        *(GAS v2u*)(gb + so) = o;
                    } else if (aux < 5) {
                        fa.x = g8u(n_.x, 0) * __builtin_amdgcn_rcpf(g8u(d_.x, 0)); fa.y = g8u(n_.x, 1) * __builtin_amdgcn_rcpf(g8u(d_.x, 1)); fa.z = g8u(n_.x, 2) * __builtin_amdgcn_rcpf(g8u(d_.x, 2)); fa.w = g8u(n_.x, 3) * __builtin_amdgcn_rcpf(g8u(d_.x, 3));
                        fb.x = g8u(n_.y, 0) * __builtin_amdgcn_rcpf(g8u(d_.y, 0)); fb.y = g8u(n_.y, 1) * __builtin_amdgcn_rcpf(g8u(d_.y, 1)); fb.z = g8u(n_.y, 2) * __builtin_amdgcn_rcpf(g8u(d_.y, 2)); fb.w = g8u(n_.y, 3) * __builtin_amdgcn_rcpf(g8u(d_.y, 3));
                    } else { v4u o;
                        o.x = pk2(a.x * g8(n_.x, 0), a.y * g8(n_.x, 1)); o.y = pk2(a.z * g8(n_.x, 2), a.w * g8(n_.x, 3)); o.z = pk2(b.x * g8(n_.y, 0), b.y * g8(n_.y, 1)); o.w = pk2(b.z * g8(n_.y, 2), b.w * g8(n_.y, 3));
                        *(GAS v4u*)(mb + ((row0 + ai * 128 + m * 16) * 2048u + (unsigned)(128 * bj + 8 * fq) * 2u)) = o;
                    }
                    acc[ai][bj][m][0] = a * fa; acc[ai][bj][m][1] = b * fb;
                    asm volatile("" : "+v"(acc[ai][bj][m][0]), "+v"(acc[ai][bj][m][1]));
                }
            }
            asm volatile("" ::: "memory");
        }
    }
};
#ifndef MK_X8
#define MK_X8 1
#endif
template <int KIND, bool SCATTER>
struct EpiRes {
    const bf16* xs; int ldxs; float* xo; bf16* xb; int ldxb; float* SSo; const float* SSi; const bf16* PW; int dry; unsigned char* x8;
    __device__ __forceinline__ void operator()(AccRef acc, const pg8::Step& st, int wr, int wc, int fr_, int fq_) const {
        if (SCATTER && st.aux == 0) return;
        int fr = fr_, fq = fq_, zz = 0; LAUNDER3(fr, fq, zz);
        const int pn = st.pn; const unsigned colb = (unsigned)(256 * pn + 32 * wc + 8 * fq);
        int rowi[8];
#pragma unroll
        for (int i = 0; i < 8; ++i) { const int r = (i >> 2) * 128 + wr * 64 + (i & 3) * 16 + fr; rowi[i] = SCATTER ? ((r < st.nvalid) ? st.rows[r] : -1) : (st.pm * 256 + r); }
        float rs8[8];
#pragma unroll
        for (int i = 0; i < 8; ++i) rs8[i] = 1.f;
        if (KIND == 1) { rstd8(SSi, (unsigned)(st.pm * 256 + wr * 64 + fr), fq, rs8);
            if (MK_PLE8) {
#pragma unroll
                for (int i = 0; i < 8; ++i) rs8[i] *= (1.0f / G8_SCALE); } }
        v4u xin[2][2][2]; v4u pwv[2][2][2];
#define RES_LOAD(p_, buf_) do { _Pragma("unroll") for (int u_ = 0; u_ < 2; ++u_) { const int i_ = 2 * (p_) + u_; const unsigned rw_ = rowi[i_] >= 0 ? (unsigned)rowi[i_] : 0u; \
            _Pragma("unroll") for (int bj_ = 0; bj_ < 2; ++bj_) { xin[buf_][u_][bj_] = *(const GAS v4u*)((const GAS char*)xs + (rw_ * (unsigned)ldxs + colb + 128u * bj_) * 2u); \
                if (KIND == 1) pwv[buf_][u_][bj_] = *(const GAS v4u*)((const GAS char*)PW + (rw_ * 1024u + colb + 128u * bj_) * 2u); } } } while (0)
        RES_LOAD(0, 0);
#pragma unroll
        for (int pr = 0; pr < 4; ++pr) {
            float ssp[2]; f32x4 xr[2][2][2];
#pragma unroll
            for (int u = 0; u < 2; ++u) {
                const int i = 2 * pr + u, ai = i >> 2, m = i & 3; const float rs = rs8[i]; float ss = 0.f;
#pragma unroll
                for (int bj = 0; bj < 2; ++bj) {
                    const v4u xv = xin[pr & 1][u][bj];
                    f32x4 x0 = (f32x4){bflo(xv.x), bfhi(xv.x), bflo(xv.y), bfhi(xv.y)}, x1 = (f32x4){bflo(xv.z), bfhi(xv.z), bflo(xv.w), bfhi(xv.w)};
                    f32x4 a = acc[ai][bj][m][0], b = acc[ai][bj][m][1];
                    if (KIND == 1) { const v4u pw = pwv[pr & 1][u][bj];
                        const float rsn = rs * -1.4426950408889634f;
                        a.x = sg2(a.x * rsn) * bflo(pw.x); a.y = sg2(a.y * rsn) * bfhi(pw.x); a.z = sg2(a.z * rsn) * bflo(pw.y); a.w = sg2(a.w * rsn) * bfhi(pw.y);
                        b.x = sg2(b.x * rsn) * bflo(pw.z); b.y = sg2(b.y * rsn) * bfhi(pw.z); b.z = sg2(b.z * rsn) * bflo(pw.w); b.w = sg2(b.w * rsn) * bfhi(pw.w); }
                    x0 += a; x1 += b;
                    { const f32x4 q0 = x0 * x0, q1 = x1 * x1; ss += ((q0.x + q0.y) + (q0.z + q0.w)) + ((q1.x + q1.y) + (q1.z + q1.w)); }
                    xr[u][bj][0] = x0; xr[u][bj][1] = x1;
                }
                ss += XOR16(ss); ss = add_xor32(ss); ssp[u] = ss;
            }
            if (pr < 3) RES_LOAD(pr + 1, (pr + 1) & 1);
            asm volatile("" ::: "memory");
#pragma unroll
            for (int u = 0; u < 2; ++u) {
                const int i = 2 * pr + u; const bool ok = rowi[i] >= 0 && !dry; const unsigned rw = rowi[i] >= 0 ? (unsigned)rowi[i] : 0u;
                if (ok) {
#pragma unroll
                    for (int bj = 0; bj < 2; ++bj) { const f32x4 x0 = xr[u][bj][0], x1 = xr[u][bj][1];
                        if (xo) { GAS f32x4* op = (GAS f32x4*)((GAS char*)xo + (rw * 1024u + colb + 128u * bj) * 4u); op[0] = x0; op[1] = x1; }
                        if (xb) { v4u o; o.x = pk2(x0.x, x0.y); o.y = pk2(x0.z, x0.w); o.z = pk2(x1.x, x1.y); o.w = pk2(x1.z, x1.w);
                            *(GAS v4u*)((GAS char*)xb + (rw * (unsigned)ldxb + colb + 128u * bj) * 2u) = o; }
                        if (MK_X8 && x8) { v2u o2; o2.x = pk_fp8x4(x0.x, x0.y, x0.z, x0.w); o2.y = pk_fp8x4(x1.x, x1.y, x1.z, x1.w); *(GAS v2u*)((GAS char*)x8 + (rw * 1024u + colb + 128u * bj)) = o2; } }
                    if (fq == 0 && xb) *(GAS float*)((GAS char*)SSo + (rw * 16u + (unsigned)(4 * pn + wc)) * 4u) = ssp[u];
                }
            }
            asm volatile("" ::: "memory");
        }
#undef RES_LOAD
    }
};
struct EpiPW {
    bf16* O;
    __device__ __forceinline__ void operator()(AccRef acc, const pg8::Step& st, int wr, int wc, int fr_, int fq_) const {
        int fr = fr_, fq = fq_, zz = 0; LAUNDER3(fr, fq, zz);
        GAS char* ob = (GAS char*)O + (unsigned)(256 * st.pn + 32 * wc) * 2u; const unsigned row0 = (unsigned)(st.pm * 256 + wr * 64 + fr);
#pragma unroll
        for (int ai = 0; ai < 2; ++ai)
#pragma unroll
            for (int m = 0; m < 4; ++m) {
#pragma unroll
                for (int bj = 0; bj < 2; ++bj) { const f32x4 a = acc[ai][bj][m][0], b = acc[ai][bj][m][1]; v4u o; o.x = pk2(a.x, a.y); o.y = pk2(a.z, a.w); o.z = pk2(b.x, b.y); o.w = pk2(b.z, b.w);
                    *(GAS v4u*)(ob + ((row0 + ai * 128 + m * 16) * 2048u + (unsigned)(128 * bj + 8 * fq) * 2u)) = o; }
                asm volatile("" ::: "memory"); }
    }
};
struct EpiMU {
    bf16* ACT; const float* TOKW; float sc;
    __device__ __forceinline__ void operator()(AccRef acc, const pg8::Step& st, int wr, int wc, int fr_, int fq_) const {
        int fr = fr_, fq = fq_, zz = 0; LAUNDER3(fr, fq, zz);
        const int j = st.pn; GAS char* ab = (GAS char*)ACT + (size_t)st.pm * 1024 + (unsigned)(128 * j + 32 * wc) * 2u;
        int tok[8]; f32x4 tw[8];
#pragma unroll
        for (int i = 0; i < 8; ++i) { const int r = (i >> 2) * 128 + wr * 64 + (i & 3) * 16 + fr; tok[i] = (r < st.nvalid) ? st.rows[r] : -1; }
#pragma unroll
        for (int i = 0; i < 8; ++i) { tw[i] = *(const GAS f32x4*)((const GAS char*)TOKW + (unsigned)(tok[i] >= 0 ? tok[i] : 0) * 16u); if (tok[i] < 0) tw[i] = (f32x4){0.f, 0.f, 0.f, 0.f}; }
        asm volatile("" ::: "memory");
#pragma unroll
        for (int i = 0; i < 8; ++i) {
            const int ai = i >> 2, m = i & 3, r = ai * 128 + wr * 64 + m * 16 + fr;
            const float rs = tw[i].z * sc, w = (j < 2) ? tw[i].x : tw[i].y;
            const f32x4 g0 = acc[ai][0][m][0] * rs, g1 = acc[ai][0][m][1] * rs, u0 = acc[ai][1][m][0] * rs, u1 = acc[ai][1][m][1] * rs; v4u o;
            o.x = pk2(g0.x * sigm(g0.x) * u0.x * w, g0.y * sigm(g0.y) * u0.y * w); o.y = pk2(g0.z * sigm(g0.z) * u0.z * w, g0.w * sigm(g0.w) * u0.w * w);
            o.z = pk2(g1.x * sigm(g1.x) * u1.x * w, g1.y * sigm(g1.y) * u1.y * w); o.w = pk2(g1.z * sigm(g1.z) * u1.z * w, g1.w * sigm(g1.w) * u1.w * w);
            *(GAS v4u*)(ab + ((unsigned)r * 1024u + (unsigned)(8 * fq) * 2u)) = o;
            asm volatile("" ::: "memory");
        }
    }
};

__device__ __forceinline__ bool tile_order(long L, int nM, int nN, int& pm, int& pn) {
    const int nwg = nM * nN; if (L >= nwg) return false;
    int wgid = (int)L; { const int q = nwg / 8, r = nwg % 8, xcd = wgid % 8, off = wgid / 8; wgid = (xcd < r ? xcd * (q + 1) : r * (q + 1) + (xcd - r) * q) + off; }
    const int nig = 8 * nN, gid = wgid / nig, fm = gid * 8, gsz = (nM - fm) < 8 ? (nM - fm) : 8;
    pm = fm + ((wgid % nig) % gsz); pn = (wgid % nig) / gsz; return true;
}
struct SchedPlain {
    const char* A; const char* B; size_t a_tile, b_tile; int nM, nN, nt, G, c, fixa, fixb;
    __device__ __forceinline__ bool next(int i, pg8::Step& s) const {
        int pm, pn; if (!tile_order((long)i * G + c, nM, nN, pm, pn)) return false;
        s.A = A + (size_t)(fixa ? 0 : pm) * a_tile; s.B = B + (size_t)(fixb ? 0 : pn) * b_tile; s.rows = nullptr; s.nt = nt; s.pm = pm; s.pn = pn; s.aux = i; s.nvalid = 256; s.zero_after = 1; return true; }
};
template <int PART>
struct SchedG2 {
    const char* Ab; const char* Bb; int c;
    __device__ __forceinline__ bool next(int i, pg8::Step& s) const {
        if (i >= 3) return false; int pm, pn; tile_order(c, 64, 4, pm, pn);
        const int n = i;
        s.A = PART == 0 ? Ab + (size_t)pm * 256 * 1024 : Ab + (size_t)pm * 256 * (XYP * 2) + 512 * n * 2;
        s.B = Bb + ((size_t)n * 1024 + pn * 256) * 1024;
        s.rows = nullptr; s.nt = 8; s.pm = pm; s.pn = pn; s.aux = PART * 3 + i; s.nvalid = 256; s.zero_after = 0; return true; }
};
struct SchedMoE {
    volatile LAS unsigned* MISC; const int* LIST; const char* Ab; const char* Bb; int G, c, mode, f8, cls;
    __device__ __forceinline__ bool next(int i, pg8::Step& s) const {
        const int NU = (int)MISC[MI_TOT]; const int u = c;
        if (u >= NU || i > (mode == 2 ? 1 : 0)) return false;
        const int down = mode == 2;
        const int r = u - (int)MISC[MI_U0 + cls], k = r >> 2, j = r & 3, n_c = (int)MISC[MI_N + cls], arow = (int)MISC[MI_BASE + cls] + 256 * k;
        const int grp = cls / 6, pr = cls % 6; const int pa = pr < 3 ? 0 : (pr < 5 ? 1 : 2), pb = pr < 3 ? pr + 1 : (pr < 5 ? pr - 1 : 3);
        s.rows = LIST + (size_t)cls * T + 256 * k; s.nvalid = min(256, n_c - 256 * k); s.pm = arow; s.pn = j;
        if (!down) { const int e = grp * 4 + (j < 2 ? pa : pb), hf = j & 1;
            s.A = Ab; s.B = Bb + (size_t)(e * 2 + hf) * 256 * (f8 ? 1024 : 2048); s.nt = f8 ? 8 : 16; s.aux = cls; s.zero_after = 1; }
        else { const int sgm = i & 1; const int e = grp * 4 + (sgm ? pb : pa);
            s.A = Ab + (size_t)arow * 1024 + sgm * 512; s.B = Bb + ((size_t)e * 1024 + j * 256) * 512; s.nt = 4; s.aux = sgm; s.zero_after = sgm; }
        return true; }
};
__device__ __forceinline__ float wave_sum(float v) {
    return wave_sum64(v);
}
__device__ __forceinline__ void pool_unit(int u, const bf16* PROJ, bf16* XY, int tid_) {
    int tid = tid_; asm volatile("" : "+v"(tid));
    const int c8 = tid & 63, rg = tid >> 6, g = c8 >> 4, w = 2 << g, t0 = 256 * u + 32 * rg, s0 = t0 % S;
    const GAS char* zb = (const GAS char*)PROJ + (unsigned)c8 * 16u; GAS char* yb = (GAS char*)XY + (unsigned)c8 * 16u;
    float sum[8];
#pragma unroll
    for (int j = 0; j < 8; ++j) sum[j] = 0.f;
    { v4u pz[16];
#pragma unroll
      for (int k = 1; k <= 16; ++k) { const bool ok = k <= w && k <= s0; pz[k - 1] = *(const GAS v4u*)(zb + (unsigned)(ok ? t0 - k : t0) * (unsigned)(PJP * 2)); }
#pragma unroll
      for (int k = 1; k <= 16; ++k) { const bool ok = k <= w && k <= s0; const v4u z = pz[k - 1];
        if (ok) { sum[0] += bflo(z.x); sum[1] += bfhi(z.x); sum[2] += bflo(z.y); sum[3] += bfhi(z.y); sum[4] += bflo(z.z); sum[5] += bfhi(z.z); sum[6] += bflo(z.w); sum[7] += bfhi(z.w); } } }
#pragma clang loop unroll(disable)
    for (int r0 = 0; r0 < 32; r0 += 8) {
        v4u zz[8], qq[8];
#pragma unroll
        for (int j = 0; j < 8; ++j) { const int t = t0 + r0 + j, s = s0 + r0 + j;
            zz[j] = *(const GAS v4u*)(zb + (unsigned)t * (unsigned)(PJP * 2)); qq[j] = *(const GAS v4u*)(zb + (unsigned)(s >= w ? t - w : t) * (unsigned)(PJP * 2)); }
#pragma unroll
        for (int j = 0; j < 8; ++j) { const int t = t0 + r0 + j, s = s0 + r0 + j; const v4u z = zz[j], q = qq[j];
            float zf[8] = {bflo(z.x), bfhi(z.x), bflo(z.y), bfhi(z.y), bflo(z.z), bfhi(z.z), bflo(z.w), bfhi(z.w)};
#pragma unroll
            for (int i = 0; i < 8; ++i) sum[i] += zf[i];
            if (s >= w) { sum[0] -= bflo(q.x); sum[1] -= bfhi(q.x); sum[2] -= bflo(q.y); sum[3] -= bfhi(q.y); sum[4] -= bflo(q.z); sum[5] -= bfhi(q.z); sum[6] -= bflo(q.w); sum[7] -= bfhi(q.w); }
            const float ic = 1.0f / (float)min(s + 1, w); v4u o;
            o.x = pk2(sum[0] * ic - zf[0], sum[1] * ic - zf[1]); o.y = pk2(sum[2] * ic - zf[2], sum[3] * ic - zf[3]); o.z = pk2(sum[4] * ic - zf[4], sum[5] * ic - zf[5]); o.w = pk2(sum[6] * ic - zf[6], sum[7] * ic - zf[7]);
            *(GAS v4u*)(yb + (unsigned)t * (unsigned)(XYP * 2)) = o; }
    }
}
#ifndef MK_THRD
#define MK_THRD 32
#endif
#ifndef MK_THRF
#define MK_THRF 64
#endif
#ifndef MK_ATT_SKIP
#define MK_ATT_SKIP 0
#endif
__device__ __forceinline__ void attn_phase(const int wave0, const LayerW& w, int l, int rep, unsigned char* ws, char* lds, volatile LAS unsigned* MISC, gu32* ctl, const int dry) {
    using namespace attn_body;
    int tid = mk_tid(wave0); const int lane = tid & 63;
    bf16* PROJ = (bf16*)(ws + WS_PROJ); bf16* XY = (bf16*)(ws + WS_XY); bf16* STASH = (bf16*)(ws + WS_STASH); const float* LOGF = (const float*)(ws + WS_LOGF);
    const float lam_init = 0.8f - 0.6f * __expf(-0.3f * (float)l);
    float lam; { const float a = wave_sum(w.dlam[lane] * w.dlam[64 + lane]), c = wave_sum(w.dlam[128 + lane] * w.dlam[192 + lane]); lam = __expf(a) - __expf(c) + lam_init; lam = __int_as_float(__builtin_amdgcn_readfirstlane(__float_as_int(lam))); }
    unsigned* qhead = pg8::rflp((unsigned*)(ctl + CW_AQ) + rep); unsigned* fhead = pg8::rflp((unsigned*)(ctl + CW_AQ) + 64 + 16 * l);
    {
        unsigned* top = pg8::rflp((unsigned*)(ctl + CW_SPLIT3) + 64 * l);
#pragma clang loop unroll(disable)
        for (;;) {
            tid = mk_tid(wave0);
            if (tid == 0) { unsigned r = 0xffffffffu; if (xb_ld(top) < (unsigned)gridDim.x) { const unsigned f = atomicAdd(fhead, 1u); if (f < (unsigned)(CV_LATE_BATCHES + CV_RT_BATCHES + CV_PB_BATCHES)) r = f; } MISC[MI_Q] = r; }
            __syncthreads();
            const unsigned fb = MISC[MI_Q];
            __syncthreads();
            if (fb == 0xffffffffu) break;
            conv_late_batch(w, ws, l, (LAS unsigned char*)lds, (int)fb, tid); __syncthreads();
        }
        tid = mk_tid(wave0);
        if (tid == 0) split_wait_leader(top, (unsigned)gridDim.x);
        __syncthreads();
    }
    int first = 1;
    for (;;) {
        tid = mk_tid(wave0);
        if (tid == 0) { unsigned q = first ? (unsigned)blockIdx.x : (unsigned)gridDim.x + atomicAdd(qhead, 1u); if (q >= 832u) q = 832u + atomicAdd(fhead, 1u); MISC[MI_Q] = q; }
        first = 0;
        __syncthreads();
        const int idx = (int)MISC[MI_Q];
        __syncthreads();
        if (idx >= 832 + CV_LATE_BATCHES + CV_RT_BATCHES + CV_PB_BATCHES) break;
        if (idx >= 832) { if (MK_ATT_SKIP && dry && (MK_ATT_SKIP & 8)) continue; conv_late_batch(w, ws, l, (LAS unsigned char*)lds, idx - 832, tid); continue; }
        int kind, qb, bh;
        if (idx < 160) { kind = 0; qb = 7 - idx / 32; bh = idx % 32; }
        else if (idx < 224) { kind = 1; qb = 7; bh = idx - 160; }
        else if (idx < 256) { kind = 0; qb = 2; bh = idx - 224; }
        else if (idx < 384) { kind = 1; qb = 6 - (idx - 256) / 64; bh = (idx - 256) % 64; }
        else if (idx < 416) { kind = 0; qb = 1; bh = idx - 384; }
        else if (idx < 480) { kind = 1; qb = 4; bh = idx - 416; }
        else if (idx < 544) { kind = 2; qb = 0; bh = idx - 480; }
        else if (idx < 608) { kind = 1; qb = 3; bh = idx - 544; }
        else if (idx < 640) { kind = 0; qb = 0; bh = idx - 608; }
        else if (idx < 704) { kind = 1; qb = 2; bh = idx - 640; }
        else { kind = 1; qb = 1 - (idx - 704) / 64; bh = (idx - 704) % 64; }
        if (MK_ATT_SKIP && dry && ((MK_ATT_SKIP >> kind) & 1)) continue;
        if (kind == 2) { pool_unit(bh, PROJ, XY, tid); __syncthreads(); continue; }
        if (kind == 1) {
            const int b = bh >> 3, h = bh & 7;
            AttnP P; P.Q = PROJ + 2048 + h * 64; P.K = PROJ + 2560 + h * 64; P.V = PROJ + 3072 + h * 64; P.out = XY + 1024 + h * 64; P.stash = nullptr; P.gsub = nullptr; P.logf = LOGF + h; P.opitch = XYP; P.lam = 0.f; P.nscale = 0.f;
            attn_unit<MK_THRF, true>(tid, b, qb, 0, P, lds);
        } else {
            const int b = bh >> 2, h = bh & 3;
#pragma unroll 1
            for (int c = 0; c < 2; ++c) {
                AttnP P; P.Q = PROJ + 512 + (h * 2 + c) * 64; P.K = PROJ + 1024 + (h * 2 + c) * 64; P.V = PROJ + 1536 + h * 128;
                P.stash = STASH + h * 128; P.gsub = w.dsub; P.logf = nullptr; P.lam = lam; P.nscale = 1.0f - lam_init;
                if (c == 0) { P.out = STASH + h * 128; P.opitch = 512; } else { P.out = XY + 512 + h * 128; P.opitch = XYP; }
                attn_unit128<MK_THRD>(mk_tid(wave0), b, qb, c == 0 ? 0 : 4, P, lds); }
        }
    }
}
__device__ __forceinline__ void moe_tables(volatile LAS unsigned* MISC, const unsigned* cls_cnt, int tid) {
    __syncthreads();
    if (tid < 64) {
        const unsigned n = tid < 24 ? cls_cnt[tid] : 0u; const unsigned nch = (n + 255u) >> 8; unsigned inc = nch;
#pragma unroll
        for (int o = 1; o < 32; o <<= 1) { const unsigned up = (unsigned)__builtin_amdgcn_ds_bpermute((tid - o) << 2, (int)inc); if (tid >= o) inc += up; }
        if (tid < 24) { MISC[MI_N + tid] = n; MISC[MI_BASE + tid] = (inc - nch) * 256u; MISC[MI_U0 + tid] = (inc - nch) * 4u; }
        if (tid == 23) MISC[MI_TOT] = inc * 4u; }
    __syncthreads();
}

__device__ __forceinline__ int moe_class(volatile LAS unsigned* MISC, int u, int tid) {
    const int k = tid & 63; const bool ge = k < 24 && u >= (int)MISC[MI_U0 + (k < 24 ? k : 0)];
    const int n = __popcll(__ballot(ge)); return __builtin_amdgcn_readfirstlane(n > 0 ? n - 1 : 0);
}
#ifndef MK_FIXA
#define MK_FIXA 0
#endif
#ifndef MK_FIXB
#define MK_FIXB 0
#endif
#ifndef MK_REPEAT
#define MK_REPEAT 0
#endif
constexpr int NPH = 18;
struct Prog { int p[40]; int n; };
constexpr Prog make_prog() {
    Prog g{}; int n = 0;
    for (int ph = 0; ph < NPH; ++ph) {
        const int kind = (ph == 0 || ph == 9) ? 8 : (ph >= 10 ? ph - 10 : ph - 1);
        g.p[n++] = ph; if ((MK_REPEAT >> kind) & 1) g.p[n++] = ph; }
    g.n = n; return g;
}
__constant__ const Prog PROG = make_prog();
constexpr int NPOS = make_prog().n;
template <unsigned KMASK>
__device__ __forceinline__ void mk_body() {
    typedef const __attribute__((address_space(4))) Args* KArgs;
    const KArgs args0p = (KArgs)__builtin_amdgcn_kernarg_segment_ptr();
    extern __shared__ __attribute__((aligned(16))) unsigned char lds_raw[];
    { LAS unsigned char* lds0 = (LAS unsigned char*)lds_raw;
      for (int u = threadIdx.x; u < (LDS_BYTES - MISC_OFF) / 4; u += NWAVES * 64) ((LAS unsigned*)(lds0 + MISC_OFF))[u] = 0u; }
    __syncthreads();
    const int wave0 = __builtin_amdgcn_readfirstlane(threadIdx.x >> 6);
    XcdBarrier bar = xcd_barrier_post((unsigned*)((gu32*)(args0p->ws + WS_CTL) + CW_BAR) + args0p->li * XCD_BAR_WORDS, (volatile LAS unsigned*)((LAS unsigned char*)lds_raw + MISC_OFF) + MI_BAR, threadIdx.x);
    const int ph_lo = args0p->ph_lo, ph_hi = args0p->ph_hi;
#pragma clang loop unroll(disable)
    for (int pos = ph_lo; pos < ph_hi; ++pos) {
        const int ph = __builtin_amdgcn_readfirstlane(PROG.p[pos]); const int rep = pos; const int dry = (MK_REPEAT != 0 && pos + 1 < ph_hi && __builtin_amdgcn_readfirstlane(PROG.p[pos + 1]) == ph) ? 1 : 0;
        KArgs ap = args0p; asm volatile("" : "+s"(ap));
#define args (*ap)
        LAS unsigned char* lds = (LAS unsigned char*)lds_raw;
        volatile LAS unsigned* MISC = (volatile LAS unsigned*)(lds + MISC_OFF);
        int G = gridDim.x, bx = blockIdx.x; asm volatile("" : "+s"(G), "+s"(bx)); const int vcu = (G % 8 == 0) ? (bx % 8) * (G / 8) + bx / 8 : bx;
        unsigned char* ws = args.ws; gu32* ctl = (gu32*)(ws + WS_CTL);
        float* XOUT = args.out; const float* x0 = (const float*)args.in[0];
        bf16* XY = (bf16*)(ws + WS_XY); bf16* PROJ = (bf16*)(ws + WS_PROJ);
        float* SSA = (float*)(ws + WS_SS); float* SSB = (float*)(ws + WS_SSB);
        if (ph == 0) { if constexpr (KMASK & 0x100u) { const int tid = mk_tid(wave0); const LayerW w = layer_view(ap, 0); conv_layer(w, ws, 0, lds, vcu, G, tid); p0_x(x0, (const int*)args.in[2], ws, (unsigned char*)XOUT + OUT_XB8, vcu, G, tid);
            if (tid == 0) ((unsigned*)(ctl + CW_XCC))[vcu] = xb_xcc_id() + 1u;
            if (bx == 0) { float* GT = (float*)(ctl + CW_GT); const int ll = tid >> 8, r = tid & 255, wch = r >> 6, d = r & 63;
                const float* gsrc = (const float*)(wch == 0 ? args.in[7] : (wch == 1 ? args.in[8] : (wch == 2 ? args.in[11] : args.in[12]))); GT[tid] = gsrc[ll * 64 + d]; } } }
        else if (ph == 9) { }
        else {
            const int l = __builtin_amdgcn_readfirstlane(ph >= 10 ? 1 : 0), k = __builtin_amdgcn_readfirstlane(ph - (l ? 10 : 1));
            const LayerW w = layer_view(ap, l);
            const float* SSin = l == 0 ? SSA : SSB; const float* xcur = l == 0 ? x0 : XOUT;
            if (k == 0) { if constexpr (KMASK & 1u) { const int tid = mk_tid(wave0);
                SchedPlain S{(const char*)(XY + 1536), (const char*)(ws + WS_W + W_IN), (size_t)256 * XYP * 2, (size_t)256 * 2048, 64, 15, 16, G, bx, dry & MK_FIXA, dry & MK_FIXB};
                LAS float* RSL = (LAS float*)(lds + MISC_OFF) + 1024;
                if (tid < 4) { int pm_ = -1, pn_ = 0; if (!tile_order((long)tid * G + bx, 64, 15, pm_, pn_)) pm_ = -1; MISC[112 + tid] = (unsigned)pm_; }
                __syncthreads();
#pragma unroll 1
                for (int idx = tid; idx < 1024; idx += 512) { const int pm_ = (int)MISC[112 + (idx >> 8)]; if (pm_ >= 0) RSL[idx] = rstd_at(SSin, (unsigned)(pm_ * 256 + (idx & 255))); }
                __syncthreads();
                EpiG1 E{SSin, PROJ, (float*)(ws + WS_LOGF), (const float*)(ws + WS_COSSIN), (const float*)(ctl + CW_GT) + 256 * l, w.ffb, dry, RSL};
                pg8::gemm_phase<SchedPlain, EpiG1, false, true>(tid, lds, XYP * 2, 2048, S, E);
                split_arrive_x(bar, (unsigned*)(ctl + CW_SPLIT3) + 64 * l, (unsigned*)(ctl + CW_SPLIT3) + 64 * l + 32 * 0 + 128, mk_tid(wave0));
            } } else if (k == 1) { if constexpr (KMASK & 2u) {
                attn_phase(wave0, w, l, rep, ws, (char*)lds_raw, MISC, ctl, dry);
                split_arrive_x(bar, (unsigned*)(ctl + CW_SPLIT + (2 * l) * 64), (unsigned*)(ctl + CW_SPLITX + (2 * l) * 64), mk_tid(wave0));
            } } else if (k == 2) { if constexpr (KMASK & 4u) { const int tid = mk_tid(wave0);
                unsigned char* gsc = (unsigned char*)XOUT + OUT_GATES + (size_t)bx * 196608;
                LAS float* RSL2 = (LAS float*)(lds + MISC_OFF) + 1024;
                { int pm_, pn_; tile_order(bx, 64, 4, pm_, pn_); if (tid < 256) RSL2[tid] = rstd_at(SSin, (unsigned)(pm_ * 256 + tid)); __syncthreads(); }
                { SchedG2<0> S{(const char*)XOUT + OUT_XB8, (const char*)(ws + WS_W + W_G8), bx};
                  EpiG2<0> E{SSin, gsc, (bf16*)(ws + WS_MERGED), RSL2};
                  pg8::gemm_phase<SchedG2<0>, EpiG2<0>, false, true, true>(tid, lds, 1024, 1024, S, E); }
                { const int t2 = mk_tid(wave0); if (t2 == 0) split_wait_leader((unsigned*)(ctl + CW_SPLIT + (2 * l) * 64), (unsigned)G); __syncthreads(); }
                { SchedG2<1> S{(const char*)XY, (const char*)(ws + WS_W + W_BR), bx};
                  EpiG2<1> E{SSin, gsc, (bf16*)(ws + WS_MERGED), RSL2};
                  pg8::gemm_phase<SchedG2<1>, EpiG2<1>, false, true>(mk_tid(wave0), lds, XYP * 2, 1024, S, E); }
                { int pm_, pn_; tile_order(bx, 64, 4, pm_, pn_); group4_sync((unsigned*)(ctl + CW_G4 + ((2 * l) * 64 + pm_) * 32), mk_tid(wave0)); }
            } } else if (k == 3) { if constexpr (KMASK & 8u) { const int tid = mk_tid(wave0);
                SchedPlain S{(const char*)(ws + WS_MERGED), (const char*)(ws + WS_W + W_OUT), (size_t)256 * 2048, (size_t)256 * 2048, 64, 4, 16, G, bx, 0, 0};
                EpiRes<0, false> E{XY + 1536, XYP, nullptr, XY + 1536, XYP, SSA, nullptr, nullptr, dry, (MK_MU8 && l == NL - 1) ? (unsigned char*)XOUT + OUT_XB8 : nullptr};
                pg8::gemm_phase<SchedPlain, EpiRes<0, false>, false, true>(tid, lds, 2048, 2048, S, E);
                { int pm_, pn_; tile_order(bx, 64, 4, pm_, pn_); group4_sync((unsigned*)(ctl + CW_G4 + ((2 * l + 1) * 64 + pm_) * 32), mk_tid(wave0)); }
            } } else if (k == 4) { if constexpr (KMASK & 16u) { const int tid = mk_tid(wave0);
                {
                    typedef float f32x16r __attribute__((ext_vector_type(16))); typedef short bf16x8r __attribute__((ext_vector_type(8)));
                    const int lane_ = tid & 63, r32 = lane_ & 31, hh = lane_ >> 5, wv = __builtin_amdgcn_readfirstlane(tid >> 6); int pm_, pn_; tile_order(bx, 64, 4, pm_, pn_); const int t0 = pm_ * 256 + pn_ * 64;
                    unsigned* ccnt = (unsigned*)(ctl + CW_CLS + 32 * l + 64 * dry); int* LIST = (int*)(ws + WS_LIST);
                    const GAS char* wrh = (const GAS char*)(ws + WS_W + W_RH) + (unsigned)(r32 * 2048 + (128 * wv + 8 * hh) * 2);
                    const GAS char* xb_ = (const GAS char*)(XY + 1536) + (size_t)t0 * (XYP * 2) + (unsigned)(r32 * (XYP * 2) + (128 * wv + 8 * hh) * 2);
                    f32x16r acc0 = {}, acc1 = {};
#pragma unroll 2
                    for (int ks = 0; ks < 8; ++ks) {
                        const bf16x8r Bh = *(const GAS bf16x8r*)(wrh + ks * 32), Bl = *(const GAS bf16x8r*)(wrh + 65536 + ks * 32);
                        const bf16x8r A0 = *(const GAS bf16x8r*)(xb_ + ks * 32), A1 = *(const GAS bf16x8r*)(xb_ + 32 * (XYP * 2) + ks * 32);
                        acc0 = __builtin_amdgcn_mfma_f32_32x32x16_bf16(A0, Bh, acc0, 0, 0, 0); acc0 = __builtin_amdgcn_mfma_f32_32x32x16_bf16(A0, Bl, acc0, 0, 0, 0);
                        acc1 = __builtin_amdgcn_mfma_f32_32x32x16_bf16(A1, Bh, acc1, 0, 0, 0); acc1 = __builtin_amdgcn_mfma_f32_32x32x16_bf16(A1, Bl, acc1, 0, 0, 0);
                    }
                    LAS float* Pp = (LAS float*)lds;
                    LAS float* Lg = (LAS float*)(lds + 65536);
#pragma unroll
                    for (int r = 0; r < 16; ++r) { const int tk = (r & 3) + 8 * (r >> 2) + 4 * hh; Pp[(wv * 64 + tk) * 32 + r32] = acc0[r]; Pp[(wv * 64 + 32 + tk) * 32 + r32] = acc1[r]; }
                    __syncthreads();
                    { const int tk = tid >> 3, n4 = (tid & 7) * 4; f32x4 s = (f32x4){0.f, 0.f, 0.f, 0.f};
#pragma unroll
                      for (int w8 = 0; w8 < 8; ++w8) s += *(const LAS f32x4*)(Pp + (w8 * 64 + tk) * 32 + n4);
                      *(LAS f32x4*)(Lg + tk * 32 + n4) = s; }
                    __syncthreads();
                    if (tid < 64) { const int t = t0 + tid; float dg[4], de[16];
#pragma unroll
                        for (int e = 0; e < 4; ++e) dg[e] = Lg[tid * 32 + e];
#pragma unroll
                        for (int e = 0; e < 16; ++e) de[e] = Lg[tid * 32 + 4 + e];
                        const float rstd = rstd_at(SSA, (unsigned)t); float wa, wb; const int cls = route_decide(dg, de, rstd, w.brg, w.bre, wa, wb);
                        *(GAS f32x4*)((GAS char*)(ws + WS_TOKW) + (unsigned)t * 16u) = (f32x4){wa, wb, rstd, 0.f}; MISC[128 + tid] = (unsigned)cls; }
                    __syncthreads();
                    if (tid < 64) {
                        const unsigned mycls = MISC[128 + tid]; const unsigned long long ltm = (1ull << tid) - 1ull; unsigned cnt_c = 0, rank = 0;
#pragma unroll 4
                        for (unsigned c = 0; c < 24; ++c) { const unsigned long long m = __ballot(mycls == c); if ((unsigned)tid == c) cnt_c = (unsigned)__popcll(m); if (mycls == c) rank = (unsigned)__popcll(m & ltm); }
                        unsigned base = 0; if (tid < 24 && cnt_c) base = atomicAdd(ccnt + tid, cnt_c);
                        const unsigned mybase = (unsigned)__builtin_amdgcn_ds_bpermute((int)(mycls << 2), (int)base);
                        LIST[(size_t)mycls * T + mybase + rank] = t0 + tid; }
                    __syncthreads();
                }
                split_arrive_x(bar, (unsigned*)(ctl + CW_SPLIT + (2 * l + 1) * 64), (unsigned*)(ctl + CW_SPLITX + (2 * l + 1) * 64), mk_tid(wave0));
            } } else if (k == 5) { if constexpr (KMASK & 96u) { int tid = mk_tid(wave0);
                if (tid == 0) split_wait_leader((unsigned*)(ctl + CW_SPLIT + (2 * l + 1) * 64), (unsigned)G);
                __syncthreads();
                moe_tables(MISC, (const unsigned*)(ctl + CW_CLS + 32 * l), tid);
                const int NUm = (int)MISC[MI_TOT], KO = NUm > 256 ? (NUm - 256) >> 2 : 0;
                const int gid = vcu >> 2, m4 = vcu & 3, xg = gid >> 3, lg = gid & 7;
                const int k_o = lg * 8 + xg, k_p = (lg - 4) * 8 + xg;
                const bool is_o = lg < 4 && k_o < KO, is_p = lg >= 4 && k_p < KO;
                unsigned* cA = (unsigned*)(ctl + CW_MOE2 + 3584 * l); unsigned* cB = cA + 2048; unsigned* cO = cA + 3072;
#pragma clang loop unroll(disable)
                for (int r = 0; r < 2; ++r) {
                    const int u = r == 0 ? vcu : 256 + 4 * k_o + m4; if (r == 1 && !is_o) break;
                    tid = mk_tid(wave0);
                    { const int ucls = moe_class(MISC, u, tid);
                      SchedMoE S{MISC, (const int*)(ws + WS_LIST), (const char*)(XY + 1536), (const char*)(ws + WS_W + W_GU), G, u, 0, 0, ucls};
                      EpiMU E{(bf16*)(ws + OV_ACT), (const float*)(ws + WS_TOKW), 1.0f};
                      pg8::gemm_phase<SchedMoE, EpiMU, true, true>(tid, lds, XYP * 2, 2048, S, E); }
                    if (r == 0 && is_o) {
                        asm volatile("s_waitcnt vmcnt(0)" ::: "memory"); __syncthreads();
                        tid = mk_tid(wave0);
                        if (tid == 0) { const unsigned me = xb_xcc_id() + 1u; bool same = true;
#pragma unroll
                            for (int i = 0; i < 4; ++i) same = same && (xb_ld((unsigned*)(ctl + CW_XCC) + (gid + 4) * 4 + i) == me);
                            if (!same) { __builtin_amdgcn_fence(__ATOMIC_RELEASE, "agent"); asm volatile("s_waitcnt vmcnt(0)" ::: "memory"); }
                            xb_add(cO + 16 * k_o, 1u); asm volatile("s_waitcnt vmcnt(0)" ::: "memory"); }
                        __syncthreads();
                    }
                }
                group4_sync(is_o ? cB + 32 * k_o : cA + 32 * gid, mk_tid(wave0));
#pragma clang loop unroll(disable)
                for (int r = 0; r < 2; ++r) {
                    const int u = r == 0 ? (is_o ? 256 + 4 * k_o + m4 : vcu) : 4 * (gid - 4) + m4; if (r == 1 && !is_p) break;
                    tid = mk_tid(wave0);
                    if (r == 1) {
                        if (tid == 0) { unsigned sp = 0; while (xb_ld(cO + 16 * k_p) < 4u) { __builtin_amdgcn_s_sleep(2); if (++sp > (1u << 22)) break; }
                            __builtin_amdgcn_fence(__ATOMIC_ACQUIRE, "agent"); asm volatile("s_waitcnt vmcnt(0)" ::: "memory"); }
                        __syncthreads();
                    }
                    const int ucls = moe_class(MISC, u, tid);
                    SchedMoE S{MISC, (const int*)(ws + WS_LIST), (const char*)(ws + OV_ACT), (const char*)(ws + WS_W + W_D), G, u, 2, 0, ucls};
                    EpiRes<0, true> E{XY + 1536, XYP, nullptr, (bf16*)(ws + OV_XB2), 1024, SSA, nullptr, nullptr, dry, MK_PLE8 ? ws + WS_MERGED : nullptr};
                    pg8::gemm_phase<SchedMoE, EpiRes<0, true>, false, true>(tid, lds, 1024, 512, S, E);
                }
                { unsigned* fqh = pg8::rflp((unsigned*)(ctl + CW_FQ) + 64 * l); const int NF = 256 + (l + 1 < NL ? CV_EARLY_BATCHES : 0);
                  int arrived = 0;
                  for (;;) {
                    const int tq = mk_tid(wave0);
                    if (tq == 0) MISC[MI_Q] = atomicAdd(fqh, 1u);
                    __syncthreads();
                    const int idx = (int)MISC[MI_Q];
                    __syncthreads();
                    if (idx >= 256 && !arrived) { split_arrive_x(bar, (unsigned*)(ctl + CW_SPLIT3) + 256 + 64 * l, (unsigned*)(ctl + CW_SPLIT3) + 512 + 64 * l, mk_tid(wave0)); arrived = 1; }
                    if (idx >= NF) break;
                    if (idx < 256) {
                        SchedPlain S2{(const char*)(ws + OV_PB), (const char*)(ws + WS_WPLE + l * WPLE_STRIDE + W_P), (size_t)256 * 512, (size_t)256 * 512, 64, 4, 4, 1 << 20, idx, 0, 0};
                        EpiPW E2{(bf16*)(ws + OV_PW)};
                        pg8::gemm_phase<SchedPlain, EpiPW, false, true>(tq, lds, 512, 512, S2, E2);
                    } else { const LayerW w1 = layer_view(ap, 1); conv_early_batch(w1, ws, 1, lds, idx - 256, tq); }
                  } }
            } } else if (k == 6) { if constexpr (KMASK & 96u) {
            } } else { if constexpr (KMASK & 128u) { const int tid = mk_tid(wave0);
                if (tid == 0) split_wait_leader((unsigned*)(ctl + CW_SPLIT3) + 256 + 64 * l, (unsigned)G);
                __syncthreads();
                constexpr int P8 = MK_PLE8 ? 1 : 0;
                SchedPlain S{(const char*)(ws + (P8 ? WS_MERGED : OV_XB2)), (const char*)(ws + WS_WPLE + l * WPLE_STRIDE + W_PG), (size_t)256 * (P8 ? 1024 : 2048), (size_t)256 * (P8 ? 1024 : 2048), 64, 4, P8 ? 8 : 16, G, bx, 0, 0};
                EpiRes<1, false> E{(const bf16*)(ws + OV_XB2), 1024, l == NL - 1 ? XOUT : nullptr, l == NL - 1 ? nullptr : XY + 1536, XYP, SSB, SSA, (const bf16*)(ws + OV_PW), dry, l == NL - 1 ? nullptr : (unsigned char*)XOUT + OUT_XB8};
                pg8::gemm_phase<SchedPlain, EpiRes<1, false>, false, true, P8 != 0>(tid, lds, P8 ? 1024 : 2048, P8 ? 1024 : 2048, S, E);
            } }
        }
        const int kk_ = (ph == 0 || ph == 9) ? -1 : (ph >= 10 ? ph - 10 : ph - 1);
        if (pos + 1 < ph_hi && ph != 9 && (MK_REPEAT != 0 || kk_ > 6 || kk_ < 0)) { xcd_barrier(bar, mk_tid(wave0));
#ifdef MK_DOUBLE_BAR
            xcd_barrier(bar, mk_tid(wave0)); xcd_barrier(bar, mk_tid(wave0));
#endif
        }
#undef args
    }
}

#ifndef MK_KMASKS
#ifdef MK_SPLIT_TEST
#define MK_KMASKS 0x100u
#else
#define MK_KMASKS 0x1FFu
#endif
#endif
__global__ void __launch_bounds__(NWAVES * 64, 2) mk_fwd(Args args) { mk_body<MK_KMASKS>(); }
#ifdef MK_SPLIT_TEST
__global__ void __launch_bounds__(NWAVES * 64, 2) mk_t0(Args args) { mk_body<1u>(); }
__global__ void __launch_bounds__(NWAVES * 64, 2) mk_t1(Args args) { mk_body<2u>(); }
__global__ void __launch_bounds__(NWAVES * 64, 2) mk_t2(Args args) { mk_body<4u>(); }
__global__ void __launch_bounds__(NWAVES * 64, 2) mk_t3(Args args) { mk_body<8u>(); }
__global__ void __launch_bounds__(NWAVES * 64, 2) mk_t4(Args args) { mk_body<16u>(); }
__global__ void __launch_bounds__(NWAVES * 64, 2) mk_t5(Args args) { mk_body<32u>(); }
__global__ void __launch_bounds__(NWAVES * 64, 2) mk_t6(Args args) { mk_body<64u>(); }
__global__ void __launch_bounds__(NWAVES * 64, 2) mk_t7(Args args) { mk_body<128u>(); }
__global__ void __launch_bounds__(NWAVES * 64, 2) mk_t8(Args args) { mk_body<256u>(); }
#endif
#ifndef MK_ONE_LAUNCH
#define MK_ONE_LAUNCH 0
#endif
#ifndef MK_OPT_MASK
#define MK_OPT_MASK 0x3FFFF
#endif
static void ref_phase(int l, int k, void* const* d_in, float* XOUT, unsigned char* ws, hipStream_t st) {
    using namespace refp;
    const float* x0 = (const float*)d_in[0]; const float* p = (const float*)d_in[1]; const int* pos = (const int*)d_in[2];
    const float* g_attn = (const float*)d_in[3] + l * 1024; const float* w_in_l = (const float*)d_in[4] + (size_t)l * 1024 * INW;
    const float* pool_w = (const float*)d_in[5] + (size_t)l * 4 * 128 * 128; const float* pool_scale = (const float*)d_in[6] + l * 512;
    const float* dqn = (const float*)d_in[7] + l * 64; const float* dkn = (const float*)d_in[8] + l * 64; const float* dlam = (const float*)d_in[9] + l * 256;
    const float* dsub = (const float*)d_in[10] + l * 128; const float* fqn = (const float*)d_in[11] + l * 64; const float* fkn = (const float*)d_in[12] + l * 64;
    const float* ffb = (const float*)d_in[13] + l * 8; const float* w_branch_l = (const float*)d_in[14] + (size_t)l * 3 * 512 * 1024; const float* w_out_l = (const float*)d_in[15] + (size_t)l * 1024 * 1024;
    const float* g_ffn = (const float*)d_in[16] + l * 1024; const float* wrg = (const float*)d_in[17] + (size_t)l * 1024 * 4; const float* brg = (const float*)d_in[18] + l * 4;
    const float* wre = (const float*)d_in[19] + (size_t)l * 1024 * 16; const float* bre = (const float*)d_in[20] + l * 16;
    const float* wg_l = (const float*)d_in[21] + (size_t)l * 16 * 1024 * 256; const float* wu_l = (const float*)d_in[22] + (size_t)l * 16 * 1024 * 256; const float* wd_l = (const float*)d_in[23] + (size_t)l * 16 * 256 * 1024;
    const float* g_ple = (const float*)d_in[24] + l * 1024; const float* wpg_l = (const float*)d_in[25] + (size_t)l * 1024 * 1024; const float* wple_l = (const float*)d_in[26] + (size_t)l * 256 * 1024;
    const float* p_l = p + (size_t)l * T * 256;
    float* SSA = (float*)(ws + WS_SS); float* SSB = (float*)(ws + WS_SSB); float* RS = (float*)(ws + WS_RSTD); float* LOGF = (float*)(ws + WS_LOGF); float* FCUM = (float*)(ws + WS_FCUM); float* TOKW = (float*)(ws + WS_TOKW); int* LIST = (int*)(ws + WS_LIST);
    bf16* XY = (bf16*)(ws + WS_XY); bf16* PROJ = (bf16*)(ws + WS_PROJ); float* CH = (float*)(ws + WS_STASH); bf16* MERGED = (bf16*)(ws + WS_MERGED); float* TMP = (float*)(ws + WS_PROJ);
    unsigned* cls_cnt = (unsigned*)(ws + WS_CTL) + CW_CLS + 32 * l;
    const float* xcur = l == 0 ? x0 : XOUT; float* SSin = l == 0 ? SSA : SSB;
    const float lam_init = 0.8f - 0.6f * expf(-0.3f * (float)l);
    if (k == -1) { k_rowstats<<<T / 4, 256, 0, st>>>(x0, XY + 1536, XYP, SSA, RS, nullptr); return; }
    if (k == 0) {
        k_ref_rstd<<<T / 256, 256, 0, st>>>(SSin, RS);
        for (int cc = 0; cc < 14; ++cc) {
            k_ref_gemm<<<dim3(4, T / 64), 256, 0, st>>>(XnormLoader{xcur, RS, g_attn}, w_in_l + 256 * cc, INW, 256, 1024, EpiStoreF32{CH, 256, 0});
            int kind = 2; const float* gain = nullptr; int rot = 0; float osc = 1.f;
            if (cc < 2) kind = 0;
            else if (cc < 4) { kind = 1; gain = dqn; rot = 1; osc = C2; }
            else if (cc < 6) { kind = 1; gain = dkn; rot = 1; }
            else if (cc >= 8 && cc < 10) { kind = 1; gain = fqn; osc = C2; }
            else if (cc >= 10 && cc < 12) { kind = 1; gain = fkn; }
            k_ref_epi1<<<T, 256, 0, st>>>(CH, cc, kind, pool_w, pool_scale, gain, rot, osc, pos, PROJ);
        }
        k_ref_gemm<<<dim3(1, T / 64), 256, 0, st>>>(XnormLoader{xcur, RS, g_attn}, w_in_l + 3584, INW, 8, 1024, EpiStoreF32{CH, 8, 0});
        k_ref_logf<<<T * 8 / 256, 256, 0, st>>>(CH, ffb, LOGF);
    } else if (k == 1) {
        k_ref_fscan<<<1, 64, 0, st>>>(LOGF, FCUM);
        k_ref_fox<<<T * 8 / 4, 256, 0, st>>>(PROJ, FCUM, XY);
        k_ref_diff<<<T * 4 / 2, 128, 0, st>>>(PROJ, dlam, dsub, lam_init, XY);
        k_ref_pool<<<T * 512 / 256, 256, 0, st>>>(PROJ, XY);
    } else if (k == 2) {
        k_ref_rstd<<<T / 256, 256, 0, st>>>(SSin, RS);
        k_ref_gemm2<<<dim3(16, T / 64), 256, 0, st>>>(xcur, RS, g_attn, w_in_l, w_branch_l, XY, MERGED);
    } else if (k == 3) {
        k_ref_gemm<<<dim3(16, T / 64), 256, 0, st>>>(Bf16Loader{MERGED, 1024, 0}, w_out_l, 1024, 1024, 1024, EpiResid{xcur, XOUT});
        k_rowstats<<<T / 4, 256, 0, st>>>(XOUT, XY + 1536, XYP, SSA, RS, nullptr);
    } else if (k == 4) {
        k_route<<<T / 4, 256, 0, st>>>(XOUT, g_ffn, wrg, brg, wre, bre, cls_cnt, LIST, TOKW);
    } else if (k == 5) {
        k_ref_rstd<<<T / 256, 256, 0, st>>>(SSA, RS);
        k_ref_moe<<<dim3(T / 8, 24), 256, 0, st>>>(XOUT, RS, g_ffn, (const int*)cls_cnt, LIST, TOKW, wg_l, wu_l, wd_l);
        k_rowstats<<<T / 4, 256, 0, st>>>(XOUT, (bf16*)(ws + OV_XB2), 1024, SSA, RS, nullptr);
    } else if (k == 7) {
        k_ref_rstd<<<T / 256, 256, 0, st>>>(SSA, RS);
        k_ref_ple<<<dim3(16, T / 64), 256, 0, st>>>(XOUT, RS, g_ple, wpg_l, p_l, wple_l, TMP);
        k_rowstats<<<T / 4, 256, 0, st>>>(TMP, XY + 1536, XYP, SSB, RS, XOUT);
    }
}

extern "C" void kernel_launch(void* const* d_in, const int* in_sizes, int n_in, void* d_out, int out_size, void* d_ws, size_t ws_size, hipStream_t stream) {
    static int grid = 0;
    if (grid == 0) {
        if (n_in != 27 || out_size != T * DM || ws_size < WS_END) { fprintf(stderr, "kernel_launch: unexpected shapes (n_in %d out %d ws %zu)\n", n_in, out_size, ws_size); grid = -1; return; }
        int dev = 0, cus = 0;
        if (hipGetDevice(&dev) != hipSuccess || hipDeviceGetAttribute(&cus, hipDeviceAttributeMultiprocessorCount, dev) != hipSuccess) { grid = -1; return; }
        if (hipFuncSetAttribute((const void*)mk_fwd, hipFuncAttributeMaxDynamicSharedMemorySize, LDS_BYTES) != hipSuccess) { fprintf(stderr, "kernel_launch: hipFuncSetAttribute failed\n"); grid = -1; return; }
#if !MK_ONE_LAUNCH
        { const void* ks[9] = {(const void*)mk_t0, (const void*)mk_t1, (const void*)mk_t2, (const void*)mk_t3, (const void*)mk_t4, (const void*)mk_t5, (const void*)mk_t6, (const void*)mk_t7, (const void*)mk_t8};
          for (int i = 0; i < 9; ++i) (void)hipFuncSetAttribute(ks[i], hipFuncAttributeMaxDynamicSharedMemorySize, LDS_BYTES); }
#endif
        int per_cu = 0;
        if (hipOccupancyMaxActiveBlocksPerMultiprocessor(&per_cu, mk_fwd, NWAVES * 64, LDS_BYTES) != hipSuccess || per_cu < 1) { fprintf(stderr, "kernel_launch: occupancy query failed (%d)\n", per_cu); grid = -1; return; }
        (void)hipGetLastError();
        grid = cus;
    }
    if (grid < 0) return;
    (void)hipMemsetAsync((char*)d_ws + WS_CTL, 0, MK_ONE_LAUNCH ? (size_t)192 * 1024 : CTL_BYTES, stream);
    Args a{};
    for (int i = 0; i < 27; ++i) a.in[i] = d_in[i];
    a.out = (float*)d_out; a.ws = (unsigned char*)d_ws;
#if MK_ONE_LAUNCH
    a.ph_lo = 0; a.ph_hi = NPOS; a.li = 0;
    hipLaunchKernelGGL(mk_fwd, dim3(grid), dim3(NWAVES * 64), LDS_BYTES, stream, a);
#else
    const unsigned mask = MK_OPT_MASK; int li = 0;
    typedef void (*kern_t)(Args);
    const kern_t ks[9] = {mk_t0, mk_t1, mk_t2, mk_t3, mk_t4, mk_t5, mk_t6, mk_t7, mk_t8};
#define LAUNCH_PH(kk) hipLaunchKernelGGL(ks[kk], dim3(grid), dim3(NWAVES * 64), LDS_BYTES, stream, a)
    for (int ph = 0; ph < NPH; ++ph) {
        const bool opt = (mask >> ph) & 1u;
        const int l = ph >= 10 ? 1 : 0, k = ph == 0 ? -1 : (ph == 9 ? -2 : ph - (l ? 10 : 1));
        if (ph == 0) {
            a.ph_lo = 0; a.ph_hi = 1; a.li = li++; LAUNCH_PH(8);
            if (!opt) ref_phase(0, -1, d_in, (float*)d_out, (unsigned char*)d_ws, stream);
            continue; }
        if (ph == 9) { a.ph_lo = 9; a.ph_hi = 10; a.li = li++; LAUNCH_PH(8); continue; }
        if (opt) { a.ph_lo = ph; a.ph_hi = ph + 1; a.li = li++; LAUNCH_PH(k); }
        else if (k != 6) ref_phase(l, k, d_in, (float*)d_out, (unsigned char*)d_ws, stream);
    }
#endif
}
```

```cpp
#include <hip/hip_runtime.h>
#include <cstdio>
#include <cstdint>
#include <cmath>
typedef unsigned short bf16;
constexpr int T = 16384, DM = 1024, S = 2048, NB = 8, NL = 2, INW = 6664;
constexpr float RMS_EPS = 1e-6f;
constexpr float C2 = 0.125f * 1.4426950408889634f;
constexpr size_t MiB = 1u << 20;
constexpr size_t WS_CTL = 0, CTL_BYTES = 1 * MiB;
constexpr size_t WS_SS = 1 * MiB;
constexpr size_t WS_LOGF = 2 * MiB;
constexpr size_t WS_FCUM = 2 * MiB + 512 * 1024;
constexpr size_t WS_TOKW = 3 * MiB;
constexpr size_t WS_RSTD = 3 * MiB + 256 * 1024;
constexpr size_t WS_LIST = 3 * MiB + 512 * 1024;
constexpr size_t WS_COSSIN = 5 * MiB;
constexpr size_t WS_SSB = 49 * MiB;
constexpr size_t WS_W = 6 * MiB;
constexpr size_t WS_WPLE = 52 * MiB;
constexpr size_t WS_XY = 57 * MiB;
constexpr size_t WS_PROJ = 137 * MiB;
constexpr size_t WS_STASH = 249 * MiB;
constexpr size_t WS_MERGED = WS_PROJ + 96 * MiB;
constexpr size_t WS_PB = 265 * MiB;
constexpr size_t WS_END = 273 * MiB;
constexpr int XYP = 2560, PJP = 3584;
constexpr int CW_CLS = 64;
constexpr int CW_AQ = 256;
constexpr int CW_G4 = 16384;
constexpr int CW_SPLIT3 = 24576;
constexpr int CW_MOE2 = 32768;
constexpr int CW_XCC = 40960;
constexpr int CW_GT = 131072;
constexpr int CW_MOEG = 512;
constexpr int CW_SPLIT = 5632;
constexpr int CW_SPLITX = 5888;
constexpr int CW_FQ = 6144;
constexpr int CW_BAR = 8192;
#define MK_ONE_LAUNCH 1
namespace refp {

__device__ __forceinline__ float bf2f(bf16 v) { return __uint_as_float((unsigned)v << 16); }
__device__ __forceinline__ bf16 f2b(float f) { unsigned u = __float_as_uint(f); return (bf16)((u + 0x7fffu + ((u >> 16) & 1u)) >> 16); }
__device__ __forceinline__ float wsum(float v) {
#pragma unroll
    for (int o = 1; o < 64; o <<= 1) v += __shfl_xor(v, o);
    return v;
}
__device__ __forceinline__ float wmax(float v) {
#pragma unroll
    for (int o = 1; o < 64; o <<= 1) v = fmaxf(v, __shfl_xor(v, o));
    return v;
}
__device__ __forceinline__ float row_rstd(const float* SS, int t) {
    float s = 0.f;
#pragma unroll
    for (int i = 0; i < 16; ++i) s += SS[(size_t)t * 16 + i];
    return rsqrtf(s * (1.0f / 1024.0f) + RMS_EPS);
}

__global__ void __launch_bounds__(256) k_rowstats(const float* __restrict__ xsrc, bf16* XBdst, int ldxb, float* SS, float* RSTD, float* xcopy) {
    const int t = blockIdx.x * 4 + (threadIdx.x >> 6), lane = threadIdx.x & 63;
    const float* xr = xsrc + (size_t)t * 1024;
    float s = 0.f;
    for (int j = 0; j < 16; ++j) { const int k = lane + 64 * j; const float v = xr[k]; s += v * v; XBdst[(size_t)t * ldxb + k] = f2b(v); if (xcopy) xcopy[(size_t)t * 1024 + k] = v; }
    s = wsum(s);
    if (lane < 16) SS[(size_t)t * 16 + lane] = (lane == 0) ? s : 0.f;
    if (lane == 0) RSTD[t] = rsqrtf(s * (1.0f / 1024.0f) + RMS_EPS);
}
__global__ void k_ref_rstd(const float* __restrict__ SS, float* RSTD) { const int t = blockIdx.x * blockDim.x + threadIdx.x; if (t < T) RSTD[t] = row_rstd(SS, t); }

struct XnormLoader { const float* x; const float* RS; const float* g;
    __device__ __forceinline__ float operator()(int t, int k) const { return x[(size_t)t * 1024 + k] * RS[t] * g[k]; } };
struct Bf16Loader { const bf16* A; int lda; int pad;
    __device__ __forceinline__ float operator()(int t, int k) const { return bf2f(A[(size_t)t * lda + k]); } };
struct F32Loader { const float* A; int lda; int pad;
    __device__ __forceinline__ float operator()(int t, int k) const { return A[(size_t)t * lda + k]; } };

template <class AL, class EPI>
__global__ void __launch_bounds__(256) k_ref_gemm(AL al, const float* __restrict__ W, int ldw, int N, int K, EPI epi) {
    __shared__ float sA[16][65], sB[16][65];
    const int tx = threadIdx.x & 15, ty = threadIdx.x >> 4, t0 = blockIdx.y * 64, n0 = blockIdx.x * 64;
    float acc[4][4] = {};
    for (int k0 = 0; k0 < K; k0 += 16) {
        for (int e = threadIdx.x; e < 1024; e += 256) { const int r = e >> 4, kk = e & 15; sA[kk][r] = al(t0 + r, k0 + kk); }
        for (int e = threadIdx.x; e < 1024; e += 256) { const int kk = e >> 6, c = e & 63; sB[kk][c] = (n0 + c < N) ? W[(size_t)(k0 + kk) * ldw + n0 + c] : 0.f; }
        __syncthreads();
#pragma unroll
        for (int kk = 0; kk < 16; ++kk) {
            float a[4], b[4];
#pragma unroll
            for (int i = 0; i < 4; ++i) { a[i] = sA[kk][ty * 4 + i]; b[i] = sB[kk][tx * 4 + i]; }
#pragma unroll
            for (int i = 0; i < 4; ++i)
#pragma unroll
                for (int j = 0; j < 4; ++j) acc[i][j] += a[i] * b[j];
        }
        __syncthreads();
    }
#pragma unroll
    for (int i = 0; i < 4; ++i)
#pragma unroll
        for (int j = 0; j < 4; ++j) { const int n = n0 + tx * 4 + j; if (n < N) epi(t0 + ty * 4 + i, n, acc[i][j]); }
}
struct EpiStoreF32 { float* C; int ldc; int pad; __device__ __forceinline__ void operator()(int t, int n, float v) const { C[(size_t)t * ldc + n] = v; } };
struct EpiResid { const float* xs; float* xo; __device__ __forceinline__ void operator()(int t, int n, float v) const { xo[(size_t)t * 1024 + n] = xs[(size_t)t * 1024 + n] + v; } };

__global__ void __launch_bounds__(256) k_ref_epi1(const float* __restrict__ C, int cc, int kind, const float* pool_w, const float* pool_scale,
                                                  const float* gain, int rotary, float outscale, const int* positions, bf16* PROJ) {
    __shared__ float row[256];
    const int t = blockIdx.x, j = threadIdx.x;
    row[j] = C[(size_t)t * 256 + j];
    __syncthreads();
    float out;
    if (kind == 0) {
        const int g = 2 * cc + (j >> 7), d = j & 127; float s = 0.f;
        for (int c = 0; c < 128; ++c) s += row[(j & 128) + c] * pool_w[((size_t)g * 128 + c) * 128 + d];
        out = s * pool_scale[g * 128 + d];
    } else if (kind == 1) {
        const int dim = j & 63; float v = row[j];
        const float ss = wsum(v * v);
        v = v * rsqrtf(ss * (1.0f / 64.0f) + RMS_EPS) * gain[dim];
        if (rotary) {
            const float other = __shfl_xor(v, 8);
            if (dim < 16) {
                const int i = dim & 7; const float invf = powf(500000.0f, -(float)(2 * i) / 16.0f);
                const float ang = (float)positions[t] * invf; const float c = cosf(ang), s = sinf(ang);
                v = (dim < 8) ? (v * c - other * s) : (v * c + other * s);
            }
        }
        out = v * outscale;
    } else out = row[j];
    PROJ[(size_t)t * 3584 + 256 * cc + j] = f2b(out);
}
__global__ void k_ref_logf(const float* __restrict__ C8, const float* fb, float* LOGF) {
    const int i = blockIdx.x * blockDim.x + threadIdx.x; if (i >= T * 8) return;
    const float v = C8[i] + fb[i & 7];
    LOGF[i] = fminf(v, 0.f) - log1pf(expf(-fabsf(v)));
}
__global__ void k_ref_fscan(const float* __restrict__ LOGF, float* FCUM) {
    const int i = threadIdx.x; if (i >= 64) return; const int b = i >> 3, h = i & 7; float s = 0.f;
    for (int t = 0; t < S; ++t) { s += LOGF[((size_t)b * S + t) * 8 + h]; FCUM[((size_t)b * S + t) * 8 + h] = s; }
}
__global__ void __launch_bounds__(256) k_ref_fox(const bf16* __restrict__ PROJ, const float* __restrict__ FCUM, bf16* XY) {
    __shared__ float P[4][S];
    const int w = threadIdx.x >> 6, lane = threadIdx.x & 63; const int gw = blockIdx.x * 4 + w; const int t = gw >> 3, h = gw & 7; const int b = t / S, sq = t % S;
    float q[64];
#pragma unroll
    for (int d = 0; d < 64; ++d) q[d] = bf2f(PROJ[(size_t)t * 3584 + 2048 + h * 64 + d]);
    const float Ft = FCUM[(size_t)t * 8 + h];
    float m = -INFINITY;
    for (int j = lane; j <= sq; j += 64) { const bf16* kr = PROJ + ((size_t)b * S + j) * 3584 + 2560 + h * 64; float s = 0.f;
#pragma unroll
        for (int d = 0; d < 64; ++d) s += q[d] * bf2f(kr[d]);
        s += (Ft - FCUM[((size_t)b * S + j) * 8 + h]) * 1.4426950408889634f; P[w][j] = s; m = fmaxf(m, s); }
    m = wmax(m); float l = 0.f;
    for (int j = lane; j <= sq; j += 64) { const float p = exp2f(P[w][j] - m); P[w][j] = p; l += p; }
    l = wsum(l);
    __syncthreads();
    float o = 0.f;
    for (int j = 0; j <= sq; ++j) o += P[w][j] * bf2f(PROJ[((size_t)b * S + j) * 3584 + 3072 + h * 64 + lane]);
    XY[(size_t)t * 2560 + 1024 + h * 64 + lane] = f2b(o / l);
}
__global__ void __launch_bounds__(128) k_ref_diff(const bf16* __restrict__ PROJ, const float* __restrict__ lamp, const float* __restrict__ gsub, float lam_init, bf16* XY) {
    __shared__ float P[2][2][S];
    const int w = threadIdx.x >> 6, lane = threadIdx.x & 63; const int gw = blockIdx.x * 2 + w; const int t = gw >> 2, h = gw & 3; const int b = t / S, sq = t % S;
    float lam; { const float a = wsum(lamp[lane] * lamp[64 + lane]), c = wsum(lamp[128 + lane] * lamp[192 + lane]); lam = expf(a) - expf(c) + lam_init; }
    float linv[2];
    for (int c = 0; c < 2; ++c) {
        float q[64];
#pragma unroll
        for (int d = 0; d < 64; ++d) q[d] = bf2f(PROJ[(size_t)t * 3584 + 512 + (h * 2 + c) * 64 + d]);
        float m = -INFINITY;
        for (int j = lane; j <= sq; j += 64) { const bf16* kr = PROJ + ((size_t)b * S + j) * 3584 + 1024 + (h * 2 + c) * 64; float s = 0.f;
    #pragma unroll
        for (int d = 0; d < 64; ++d) s += q[d] * bf2f(kr[d]);
            P[w][c][j] = s; m = fmaxf(m, s); }
        m = wmax(m); float l = 0.f;
        for (int j = lane; j <= sq; j += 64) { const float p = exp2f(P[w][c][j] - m); P[w][c][j] = p; l += p; }
        linv[c] = 1.0f / wsum(l);
    }
    __syncthreads();
    float o0 = 0.f, o1 = 0.f;
    for (int j = 0; j <= sq; ++j) { const float a = P[w][0][j] * linv[0] - lam * P[w][1][j] * linv[1]; const bf16* vr = PROJ + ((size_t)b * S + j) * 3584 + 1536 + h * 128;
        o0 += a * bf2f(vr[lane]); o1 += a * bf2f(vr[64 + lane]); }
    const float ss = wsum(o0 * o0 + o1 * o1); const float r = rsqrtf(ss * (1.0f / 128.0f) + RMS_EPS) * (1.0f - lam_init);
    XY[(size_t)t * 2560 + 512 + h * 128 + lane] = f2b(o0 * r * gsub[lane]);
    XY[(size_t)t * 2560 + 512 + h * 128 + 64 + lane] = f2b(o1 * r * gsub[64 + lane]);
}
__global__ void k_ref_pool(const bf16* __restrict__ PROJ, bf16* XY) {
    const int i = blockIdx.x * blockDim.x + threadIdx.x; if (i >= T * 512) return; const int t = i >> 9, j = i & 511; const int g = j >> 7, w = 2 << g, s = t % S;
    const int cnt = min(s + 1, w); float a = 0.f;
    for (int k = 0; k < cnt; ++k) a += bf2f(PROJ[(size_t)(t - k) * 3584 + j]);
    XY[(size_t)t * 2560 + j] = f2b(a / (float)cnt - bf2f(PROJ[(size_t)t * 3584 + j]));
}
__global__ void __launch_bounds__(256) k_ref_gemm2(const float* __restrict__ x, const float* __restrict__ SS, const float* __restrict__ g, const float* __restrict__ w_in_l,
                                                   const float* __restrict__ w_branch_l, const bf16* __restrict__ XY, bf16* MERGED) {
    __shared__ float sA[16][65], sB[16][65];
    const int tx = threadIdx.x & 15, ty = threadIdx.x >> 4, t0 = blockIdx.y * 64, n0 = blockIdx.x * 64;
    float mg[4][4] = {};
    for (int n = 0; n < 3; ++n) {
        float ag[4][4] = {}, ab[4][4] = {};
        for (int pass = 0; pass < 2; ++pass) {
            const int K = pass == 0 ? 1024 : 512;
            for (int k0 = 0; k0 < K; k0 += 16) {
                for (int e = threadIdx.x; e < 1024; e += 256) { const int r = e >> 4, kk = e & 15; const int t = t0 + r, k = k0 + kk;
                    sA[kk][r] = pass == 0 ? x[(size_t)t * 1024 + k] * SS[t] * g[k] : bf2f(XY[(size_t)t * 2560 + 512 * n + k]); }
                for (int e = threadIdx.x; e < 1024; e += 256) { const int kk = e >> 6, c = e & 63; const int k = k0 + kk;
                    sB[kk][c] = pass == 0 ? w_in_l[(size_t)k * INW + 3592 + n * 1024 + n0 + c] : w_branch_l[((size_t)n * 512 + k) * 1024 + n0 + c]; }
                __syncthreads();
#pragma unroll
                for (int kk = 0; kk < 16; ++kk) {
                    float a[4], b[4];
#pragma unroll
                    for (int i = 0; i < 4; ++i) { a[i] = sA[kk][ty * 4 + i]; b[i] = sB[kk][tx * 4 + i]; }
#pragma unroll
                    for (int i = 0; i < 4; ++i)
#pragma unroll
                        for (int j = 0; j < 4; ++j) { if (pass == 0) ag[i][j] += a[i] * b[j]; else ab[i][j] += a[i] * b[j]; }
                }
                __syncthreads();
            }
        }
#pragma unroll
        for (int i = 0; i < 4; ++i)
#pragma unroll
            for (int j = 0; j < 4; ++j) mg[i][j] += ab[i][j] / (1.0f + expf(-ag[i][j]));
    }
#pragma unroll
    for (int i = 0; i < 4; ++i)
#pragma unroll
        for (int j = 0; j < 4; ++j) MERGED[(size_t)(t0 + ty * 4 + i) * 1024 + n0 + tx * 4 + j] = f2b(mg[i][j]);
}
__global__ void __launch_bounds__(256) k_ref_moe(float* X, const float* __restrict__ SS, const float* __restrict__ g, const int* __restrict__ cls_cnt, const int* __restrict__ LIST,
                                                 const float* __restrict__ TOKW, const float* __restrict__ wg_l, const float* __restrict__ wu_l, const float* __restrict__ wd_l) {
    __shared__ float h[8][1024]; __shared__ float act[8][512]; __shared__ int tok[8];
    const int cls = blockIdx.y, n_c = cls_cnt[cls], base = blockIdx.x * 8; if (base >= n_c) return;
    const int nt = min(8, n_c - base), tid = threadIdx.x;
    if (tid < 8) tok[tid] = tid < nt ? LIST[(size_t)cls * T + base + tid] : -1;
    __syncthreads();
    for (int e = tid; e < 8 * 1024; e += 256) { const int i = e >> 10, k = e & 1023; const int t = tok[i]; h[i][k] = t >= 0 ? X[(size_t)t * 1024 + k] * SS[t] * g[k] : 0.f; }
    __syncthreads();
    const int grp = cls / 6, pr = cls % 6; const int pa = pr < 3 ? 0 : (pr < 5 ? 1 : 2), pb = pr < 3 ? pr + 1 : (pr < 5 ? pr - 1 : 3); const int ea = grp * 4 + pa, eb = grp * 4 + pb;
    for (int s = 0; s < 2; ++s) { const int e = s ? eb : ea; float ga[8], ua[8];
#pragma unroll
        for (int i = 0; i < 8; ++i) { ga[i] = 0.f; ua[i] = 0.f; }
        const float* wg = wg_l + (size_t)e * 1024 * 256 + tid; const float* wu = wu_l + (size_t)e * 1024 * 256 + tid;
        for (int k = 0; k < 1024; ++k) { const float a = wg[(size_t)k * 256], u = wu[(size_t)k * 256];
#pragma unroll
            for (int i = 0; i < 8; ++i) { ga[i] += h[i][k] * a; ua[i] += h[i][k] * u; } }
#pragma unroll
        for (int i = 0; i < 8; ++i) { const int t = tok[i]; const float w = t >= 0 ? TOKW[(size_t)t * 4 + s] : 0.f; act[i][s * 256 + tid] = ga[i] / (1.0f + expf(-ga[i])) * ua[i] * w; } }
    __syncthreads();
    for (int j = 0; j < 4; ++j) { const int n = tid + 256 * j; float y[8];
#pragma unroll
        for (int i = 0; i < 8; ++i) y[i] = 0.f;
        for (int s = 0; s < 2; ++s) { const int e = s ? eb : ea; const float* wd = wd_l + (size_t)e * 256 * 1024 + n;
            for (int f = 0; f < 256; ++f) { const float w = wd[(size_t)f * 1024];
#pragma unroll
                for (int i = 0; i < 8; ++i) y[i] += act[i][s * 256 + f] * w; } }
#pragma unroll
        for (int i = 0; i < 8; ++i) { const int t = tok[i]; if (t >= 0) X[(size_t)t * 1024 + n] += y[i]; } }
}
__global__ void __launch_bounds__(256) k_ref_ple(const float* __restrict__ x, const float* __restrict__ SS, const float* __restrict__ g, const float* __restrict__ wgate_l,
                                                 const float* __restrict__ p_l, const float* __restrict__ wple_l, float* xo) {
    __shared__ float sA[16][65], sB[16][65];
    const int tx = threadIdx.x & 15, ty = threadIdx.x >> 4, t0 = blockIdx.y * 64, n0 = blockIdx.x * 64;
    float ag[4][4] = {}, ab[4][4] = {};
    for (int pass = 0; pass < 2; ++pass) {
        const int K = pass == 0 ? 1024 : 256;
        for (int k0 = 0; k0 < K; k0 += 16) {
            for (int e = threadIdx.x; e < 1024; e += 256) { const int r = e >> 4, kk = e & 15; const int t = t0 + r, k = k0 + kk;
                sA[kk][r] = pass == 0 ? x[(size_t)t * 1024 + k] * SS[t] * g[k] : p_l[(size_t)t * 256 + k]; }
            for (int e = threadIdx.x; e < 1024; e += 256) { const int kk = e >> 6, c = e & 63; const int k = k0 + kk;
                sB[kk][c] = pass == 0 ? wgate_l[(size_t)k * 1024 + n0 + c] : wple_l[(size_t)k * 1024 + n0 + c]; }
            __syncthreads();
#pragma unroll
            for (int kk = 0; kk < 16; ++kk) {
                float a[4], b[4];
#pragma unroll
                for (int i = 0; i < 4; ++i) { a[i] = sA[kk][ty * 4 + i]; b[i] = sB[kk][tx * 4 + i]; }
#pragma unroll
                for (int i = 0; i < 4; ++i)
#pragma unroll
                    for (int j = 0; j < 4; ++j) { if (pass == 0) ag[i][j] += a[i] * b[j]; else ab[i][j] += a[i] * b[j]; }
            }
            __syncthreads();
        }
    }
#pragma unroll
    for (int i = 0; i < 4; ++i)
#pragma unroll
        for (int j = 0; j < 4; ++j) { const size_t o = (size_t)(t0 + ty * 4 + i) * 1024 + n0 + tx * 4 + j; xo[o] = x[o] + ab[i][j] / (1.0f + expf(-ag[i][j])); }
}
}
__device__ __forceinline__ int route_decide(const float (&dg)[4], const float (&de)[16], const float rstd, const float* __restrict__ brg, const float* __restrict__ bre, float& wa, float& wb) {
    float lg[4]; int gi = 0; float lmax;
#pragma unroll
    for (int e = 0; e < 4; ++e) lg[e] = rstd * dg[e] + brg[e];
    lmax = lg[0];
#pragma unroll
    for (int e = 1; e < 4; ++e) if (lg[e] > lmax) { lmax = lg[e]; gi = e; }
    float den = 0.f;
#pragma unroll
    for (int e = 0; e < 4; ++e) den += expf(lg[e] - lmax);
    const float gp = 1.0f / den;
    float el[4] = {0.f, 0.f, 0.f, 0.f};
#pragma unroll
    for (int gg = 0; gg < 4; ++gg)
#pragma unroll
        for (int e = 0; e < 4; ++e) if (gg == gi) el[e] = rstd * de[gg * 4 + e] + bre[gg * 4 + e];
    int i1 = 0; float m1 = el[0];
#pragma unroll
    for (int e = 1; e < 4; ++e) if (el[e] > m1) { m1 = el[e]; i1 = e; }
    int i2 = -1; float m2 = -INFINITY;
#pragma unroll
    for (int e = 0; e < 4; ++e) if (e != i1 && el[e] > m2) { m2 = el[e]; i2 = e; }
    const float r2 = expf(m2 - m1); const float w1 = gp / (1.0f + r2), w2 = gp * r2 / (1.0f + r2);
    const int a = min(i1, i2), b = max(i1, i2); const int pr = (a == 0) ? (b - 1) : ((a == 1) ? (b + 1) : 5); const int cls = gi * 6 + pr;
    wa = i1 == a ? w1 : w2; wb = i1 == a ? w2 : w1;
    return cls;
}
__device__ __forceinline__ int route_core(int t, int lane, const float* __restrict__ X, const float* __restrict__ g, const float* __restrict__ wrg, const float* __restrict__ brg,
                                          const float* __restrict__ wre, const float* __restrict__ bre, float* TOKW) {
    float ss = 0.f, dg[4] = {0.f, 0.f, 0.f, 0.f}, de[16];
#pragma unroll
    for (int e = 0; e < 16; ++e) de[e] = 0.f;
#pragma unroll 4
    for (int i = 0; i < 16; ++i) { const int k = lane + 64 * i; const float xv = X[(size_t)t * 1024 + k]; ss += xv * xv; const float h = xv * g[k];
        const float4 a = *(const float4*)(wrg + (size_t)k * 4); dg[0] += h * a.x; dg[1] += h * a.y; dg[2] += h * a.z; dg[3] += h * a.w;
#pragma unroll
        for (int q = 0; q < 4; ++q) { const float4 b = *(const float4*)(wre + (size_t)k * 16 + 4 * q); de[4 * q] += h * b.x; de[4 * q + 1] += h * b.y; de[4 * q + 2] += h * b.z; de[4 * q + 3] += h * b.w; } }
    ss = refp::wsum(ss);
#pragma unroll
    for (int e = 0; e < 4; ++e) dg[e] = refp::wsum(dg[e]);
#pragma unroll
    for (int e = 0; e < 16; ++e) de[e] = refp::wsum(de[e]);
    const float rstd = rsqrtf(ss * (1.0f / 1024.0f) + RMS_EPS);
    float wa, wb; const int cls = route_decide(dg, de, rstd, brg, bre, wa, wb);
    if (lane == 0) *(float4*)(TOKW + (size_t)t * 4) = make_float4(wa, wb, rstd, 0.f);
    return cls;
}
__device__ __forceinline__ void route_token(int t, int lane, const float* __restrict__ X, const float* __restrict__ g, const float* __restrict__ wrg, const float* __restrict__ brg,
                                            const float* __restrict__ wre, const float* __restrict__ bre, unsigned* cls_cnt, int* LIST, float* TOKW) {
    const int cls = route_core(t, lane, X, g, wrg, brg, wre, bre, TOKW);
    if (lane == 0) { const unsigned pos = atomicAdd(cls_cnt + cls, 1u); LIST[(size_t)cls * T + pos] = t; }
}
__global__ void __launch_bounds__(256) k_route(const float* X, const float* g, const float* wrg, const float* brg, const float* wre, const float* bre, unsigned* cls_cnt, int* LIST, float* TOKW) {
    const int t = blockIdx.x * 4 + (threadIdx.x >> 6);
    route_token(t, threadIdx.x & 63, X, g, wrg, brg, wre, bre, cls_cnt, LIST, TOKW);
}

namespace pg8 {
#define PG8_LAS __attribute__((address_space(3)))
typedef short bf16x8 __attribute__((ext_vector_type(8)));
typedef float f32x4 __attribute__((ext_vector_type(4)));
typedef unsigned u32x4 __attribute__((ext_vector_type(4)));
typedef int i32x4 __attribute__((ext_vector_type(4)));
typedef int i32x8 __attribute__((ext_vector_type(8)));
__device__ __forceinline__ i32x8 cat8(bf16x8 lo, bf16x8 hi) { const i32x4 a = __builtin_bit_cast(i32x4, lo), b = __builtin_bit_cast(i32x4, hi); return __builtin_shufflevector(a, b, 0, 1, 2, 3, 4, 5, 6, 7); }
constexpr int BM = 256, BK = 64, HALF = 128, HTB = HALF * BK * 2, STAGE_BYTES = 8 * HTB;

__host__ __device__ __forceinline__ int lds_byte(int r, int c) { const int st = (r >> 4) * 2 + (c >> 5), rr = r & 15, cc = c & 31, ob = rr * 64 + cc * 2; return st * 1024 + (ob ^ (((ob >> 9) & 1) << 5)); }
__host__ __device__ __forceinline__ void stage_rc(int b, int& R, int& C) { const int st = b / 1024, sb = b % 1024, swz = sb ^ (((sb >> 9) & 1) << 5); R = (st >> 1) * 16 + swz / 64; C = (st & 1) * 32 + (swz % 64) / 2; }
__host__ __device__ __forceinline__ int perm32(int rho) { const int n = rho >> 4, i = rho & 15; return 8 * (i >> 2) + 4 * n + (i & 3); }

struct Step { const char* A; const char* B; const int* rows; int nt, pm, pn, aux, nvalid, zero_after; };
__device__ __forceinline__ int rfl(int v) { return __builtin_amdgcn_readfirstlane(v); }
template <class P> __device__ __forceinline__ P rflp(P p) { const unsigned long long u = (unsigned long long)p; const unsigned lo = (unsigned)__builtin_amdgcn_readfirstlane((int)(unsigned)u), hi = (unsigned)__builtin_amdgcn_readfirstlane((int)(unsigned)(u >> 32)); return (P)(((unsigned long long)hi << 32) | lo); }
__device__ __forceinline__ void step_uniform(Step& s, int& ok) {
    s.A = rflp(s.A); s.B = rflp(s.B); s.rows = rflp(s.rows); s.nt = rfl(s.nt); s.pm = rfl(s.pm); s.pn = rfl(s.pn); s.aux = rfl(s.aux); s.nvalid = rfl(s.nvalid); s.zero_after = rfl(s.zero_after); ok = rfl(ok);
    asm volatile("" : "+s"(ok), "+s"(s.A), "+s"(s.B), "+s"(s.nt), "+s"(s.aux));
}

template <class Sched, class Epi, bool GATHER, bool ALIGN_EPI, bool F8 = false>
__device__ __forceinline__ void gemm_phase(const int tid, PG8_LAS unsigned char* lds, const unsigned lda, const unsigned ldb, const Sched& S, const Epi& E) {
    const int wid = __builtin_amdgcn_readfirstlane(tid >> 6), lane = tid & 63, wr = wid >> 2, wc = wid & 3, fr = lane & 15, fq = lane >> 4;
    int Rr[2], Cc[2]; unsigned voffB[2], cOA[2][2], nOA[2][2];
#pragma unroll
    for (int i = 0; i < 2; ++i) { stage_rc(tid * 16 + i * 8192, Rr[i], Cc[i]); const int Rb = (Rr[i] & ~31) + perm32(Rr[i] & 31); voffB[i] = (unsigned)Rb * ldb + (unsigned)Cc[i] * 2u; }
    const size_t kstep = (size_t)(BK * 2);
    const size_t hstepB = (size_t)HALF * ldb;
    const unsigned ldsw = (unsigned)wid * 1024u;
    const int aoff = lds_byte(wr * 64 + fr, fq * 8), boff = lds_byte(wc * 32 + fr, fq * 8);
#define PG8_SA(b, h) (((b) * 2 + (h)) * HTB)
#define PG8_SB(b, h) ((4 + (b) * 2 + (h)) * HTB)
#define PG8_STAGE_B(bufoff, gbase) do { _Pragma("unroll") for (int _i = 0; _i < 2; ++_i) \
        __builtin_amdgcn_global_load_lds((const unsigned*)((const char*)(gbase) + voffB[_i]), (PG8_LAS unsigned*)(lds + (bufoff) + ldsw + _i * 8192), 16, 0, 0); } while (0)
#define PG8_STAGE_A(bufoff, gbase, o0, o1) do { \
        __builtin_amdgcn_global_load_lds((const unsigned*)((const char*)(gbase) + (o0)), (PG8_LAS unsigned*)(lds + (bufoff) + ldsw), 16, 0, 0); \
        __builtin_amdgcn_global_load_lds((const unsigned*)((const char*)(gbase) + (o1)), (PG8_LAS unsigned*)(lds + (bufoff) + ldsw + 8192), 16, 0, 0); } while (0)
#define PG8_LDA(dst, b, h) do { _Pragma("unroll") for (int m = 0; m < 4; ++m) _Pragma("unroll") for (int k = 0; k < 2; ++k) dst[m][k] = *(const PG8_LAS bf16x8*)(lds + PG8_SA(b, h) + aoff + m * 2048 + k * 1024); } while (0)
#define PG8_LDB(dst, b, h) do { _Pragma("unroll") for (int n = 0; n < 2; ++n) _Pragma("unroll") for (int k = 0; k < 2; ++k) dst[n][k] = *(const PG8_LAS bf16x8*)(lds + PG8_SB(b, h) + boff + n * 2048 + k * 1024); } while (0)
#define PG8_MMA(ai, bj, At, Bt) do { __builtin_amdgcn_s_setprio(1); \
        if constexpr (F8) { _Pragma("unroll") for (int m = 0; m < 4; ++m) _Pragma("unroll") for (int n = 0; n < 2; ++n) \
            asm volatile("v_mfma_scale_f32_16x16x128_f8f6f4 %0, %1, %2, %0, %3, %3 op_sel_hi:[0,0,0]" : "+v"(acc[ai][bj][m][n]) : "v"(cat8(Bt[n][0], Bt[n][1])), "v"(cat8(At[m][0], At[m][1])), "v"(f8scale)); } \
        else { _Pragma("unroll") for (int m = 0; m < 4; ++m) _Pragma("unroll") for (int n = 0; n < 2; ++n) _Pragma("unroll") for (int k = 0; k < 2; ++k) \
            acc[ai][bj][m][n] = __builtin_amdgcn_mfma_f32_16x16x32_bf16(Bt[n][k], At[m][k], acc[ai][bj][m][n], 0, 0, 0); } \
        __builtin_amdgcn_s_setprio(0); } while (0)
#define PG8_WAIT_V(n) asm volatile("s_waitcnt vmcnt(" #n ")" ::: "memory")
#define PG8_WAIT_L(n) asm volatile("s_waitcnt lgkmcnt(" #n ")" ::: "memory")
#define PG8_BAR __builtin_amdgcn_s_barrier()
#define PG8_SCHED __builtin_amdgcn_sched_barrier(0)
#define PG8_AOFFS(dst, st) do { _Pragma("unroll") for (int _h = 0; _h < 2; ++_h) _Pragma("unroll") for (int _i = 0; _i < 2; ++_i) { \
        int _row = Rr[_i] + 128 * _h; if (GATHER) { _row = (st).rows[_row]; _row = _row < 0 ? 0 : _row; } \
        dst[_h][_i] = (unsigned)_row * lda + (unsigned)Cc[_i] * 2u; } } while (0)
    int f8scale = 0x7F7F7F7F; if constexpr (F8) asm volatile("" : "+v"(f8scale));
    Step cur, nxt; int ui = 0;
    { int ok_ = S.next(0, cur) ? 1 : 0; step_uniform(cur, ok_); if (!ok_) return; }
    f32x4 acc[2][2][4][2];
#pragma unroll
    for (int a = 0; a < 2; ++a)
#pragma unroll
        for (int b = 0; b < 2; ++b)
#pragma unroll
            for (int m = 0; m < 4; ++m)
#pragma unroll
                for (int n = 0; n < 2; ++n) acc[a][b][m][n] = (f32x4){0.f, 0.f, 0.f, 0.f};
    bf16x8 At[4][2], B0[2][2], B1[2][2];
    PG8_AOFFS(cOA, cur);
    const char* cA = cur.A; const char* cB = cur.B;
    PG8_STAGE_B(PG8_SB(0, 0), cB); PG8_STAGE_B(PG8_SB(0, 1), cB + hstepB); PG8_STAGE_A(PG8_SA(0, 0), cA, cOA[0][0], cOA[0][1]); PG8_STAGE_A(PG8_SA(0, 1), cA, cOA[1][0], cOA[1][1]);
    if (wr == 1) PG8_BAR;
    PG8_WAIT_V(2); PG8_BAR;
    PG8_STAGE_B(PG8_SB(1, 0), cB + kstep); PG8_STAGE_A(PG8_SA(1, 0), cA + kstep, cOA[0][0], cOA[0][1]); PG8_STAGE_B(PG8_SB(1, 1), cB + hstepB + kstep);
    PG8_WAIT_V(6); PG8_BAR;
#pragma clang loop unroll(disable)
    for (;;) {
        bool has_next = S.next(ui + 1, nxt);
        { int hn_ = has_next ? 1 : 0; step_uniform(nxt, hn_); has_next = hn_ != 0; }
        asm volatile("" : "+v"(voffB[0]), "+v"(voffB[1]));
        const char* nA = has_next ? nxt.A : cA; const char* nB = has_next ? nxt.B : cB;
        if (GATHER) { if (has_next) { PG8_AOFFS(nOA, nxt); } else {
#pragma unroll
            for (int _h = 0; _h < 2; ++_h)
#pragma unroll
                for (int _i = 0; _i < 2; ++_i) nOA[_h][_i] = cOA[_h][_i]; } }
        const int nt = cur.nt;
#pragma clang loop unroll(disable)
        for (int t = 0; t < nt; t += 2) {
            const bool last = (t == nt - 2);
            const char* a1 = cA + (size_t)(t + 1) * kstep;
            const char* a2 = last ? nA : cA + (size_t)(t + 2) * kstep; const char* b2 = last ? nB : cB + (size_t)(t + 2) * kstep;
            const char* a3 = a2 + kstep; const char* b3 = b2 + kstep;
            unsigned o00, o01, o10, o11;
            if (GATHER) { o00 = last ? nOA[0][0] : cOA[0][0]; o01 = last ? nOA[0][1] : cOA[0][1]; o10 = last ? nOA[1][0] : cOA[1][0]; o11 = last ? nOA[1][1] : cOA[1][1]; }
            else { o00 = cOA[0][0]; o01 = cOA[0][1]; o10 = cOA[1][0]; o11 = cOA[1][1]; }
            PG8_LDB(B0, 0, 0); PG8_LDB(B1, 0, 1); PG8_SCHED; PG8_LDA(At, 0, 0); PG8_STAGE_A(PG8_SA(1, 1), a1, cOA[1][0], cOA[1][1]);
            PG8_WAIT_V(8); PG8_WAIT_L(0); PG8_BAR; PG8_MMA(0, 0, At, B0); PG8_MMA(0, 1, At, B1); PG8_BAR; PG8_SCHED;
            PG8_LDA(At, 0, 1); PG8_STAGE_B(PG8_SB(0, 0), b2); PG8_STAGE_B(PG8_SB(0, 1), b2 + hstepB); PG8_STAGE_A(PG8_SA(0, 0), a2, o00, o01);
            PG8_WAIT_V(8); PG8_WAIT_L(0); PG8_BAR; PG8_MMA(1, 0, At, B0); PG8_MMA(1, 1, At, B1); PG8_BAR; PG8_SCHED;
            PG8_LDB(B0, 1, 0); PG8_LDB(B1, 1, 1); PG8_SCHED; PG8_LDA(At, 1, 0); PG8_STAGE_A(PG8_SA(0, 1), a2, o10, o11);
            PG8_WAIT_V(8); PG8_WAIT_L(0); PG8_BAR; PG8_MMA(0, 0, At, B0); PG8_MMA(0, 1, At, B1); PG8_BAR; PG8_SCHED;
            PG8_LDA(At, 1, 1); PG8_STAGE_B(PG8_SB(1, 0), b3); PG8_STAGE_B(PG8_SB(1, 1), b3 + hstepB); PG8_STAGE_A(PG8_SA(1, 0), a3, o00, o01);
            PG8_WAIT_V(8); PG8_WAIT_L(0); PG8_BAR; PG8_MMA(1, 0, At, B0); PG8_MMA(1, 1, At, B1); PG8_BAR; PG8_SCHED;
        }
        if constexpr (F8) { asm volatile("s_nop 15\n\ts_nop 15" ::: "memory"); }
        if constexpr (ALIGN_EPI) { if (wr == 0) PG8_BAR; }
        { int ln_; asm volatile("v_mbcnt_lo_u32_b32 %0, -1, 0\n\tv_mbcnt_hi_u32_b32 %0, -1, %0" : "=v"(ln_));
          E(acc, cur, wr, wc, ln_ & 15, ln_ >> 4); }
        if (!has_next) break;
        if (cur.zero_after) {
#pragma unroll
            for (int a = 0; a < 2; ++a)
#pragma unroll
                for (int b = 0; b < 2; ++b)
#pragma unroll
                    for (int m = 0; m < 4; ++m)
#pragma unroll
                        for (int n = 0; n < 2; ++n) acc[a][b][m][n] = (f32x4){0.f, 0.f, 0.f, 0.f};
        }
        cur = nxt; cA = nA; cB = nB; ++ui;
        if (GATHER) {
#pragma unroll
            for (int _h = 0; _h < 2; ++_h)
#pragma unroll
                for (int _i = 0; _i < 2; ++_i) cOA[_h][_i] = nOA[_h][_i]; }
        if constexpr (ALIGN_EPI) { if (wr == 1) PG8_BAR; }
    }
    PG8_WAIT_V(0);
    if constexpr (!ALIGN_EPI) { if (wr == 0) PG8_BAR; }
    PG8_BAR;
#undef PG8_SA
#undef PG8_SB
#undef PG8_STAGE_A
#undef PG8_STAGE_B
#undef PG8_LDA
#undef PG8_LDB
#undef PG8_MMA
#undef PG8_WAIT_V
#undef PG8_WAIT_L
#undef PG8_BAR
#undef PG8_SCHED
#undef PG8_AOFFS
}
}
#include <hip/hip_bf16.h>
namespace attn_body {
using hbf16=__hip_bfloat16;
using bf16x8=__attribute__((ext_vector_type(8)))short;
using s16x4=__attribute__((ext_vector_type(4)))short;
using f32x16=__attribute__((ext_vector_type(16)))float;
using u32x4=__attribute__((ext_vector_type(4)))unsigned;
constexpr int SEQ=2048,D=64,DM=3584;
constexpr int NW=8,QBLK=32,QB=QBLK*NW,KVBLK=64,NQB=SEQ/QB;
__device__ __forceinline__ int crow(int r,int hi){return (r&3)+8*(r>>2)+4*hi;}
#define SBAR() __builtin_amdgcn_sched_barrier(0)
__device__ __forceinline__ void cmask(f32x16&p0,f32x16&p1,int jb,int qrel,int hi){
  const float NEG=-INFINITY; int kb=64*jb+4*hi;
  #pragma unroll
  for(int r=0;r<16;++r){int kv=kb+(r&3)+8*(r>>2); if(kv>qrel)p0[r]=NEG; if(kv+32>qrel)p1[r]=NEG;}
}

constexpr int NSLOT=3, SLOTB=8192;
constexpr int LDS_K=0, LDS_V=NSLOT*SLOTB, LDS_WS=2*NSLOT*SLOTB, LDS_OST=LDS_WS+NW*64*4, LDS_BIAS=LDS_OST+NW*4096, LDS_SSQ=LDS_BIAS+SEQ*4, LDS_BYTES=LDS_SSQ+NW*32*4;
constexpr float C2=0.125f*1.4426950408889634f;
__device__ __forceinline__ void glds16(const void*gsrc,unsigned lds_dst){unsigned keep;
  asm volatile("s_mov_b32 %0, m0\n\ts_mov_b32 m0, %2\n\ts_nop 0\n\tglobal_load_lds_dwordx4 %1, off\n\ts_mov_b32 m0, %0":"=&s"(keep):"v"(gsrc),"s"(lds_dst):"memory");}
__device__ __forceinline__ float max3f(float a,float b,float c){float r;asm("v_max3_f32 %0, %1, %2, %3":"=v"(r):"v"(a),"v"(b),"v"(c));return r;}
__device__ __forceinline__ float max2f(float a,float b){float r;asm("v_max_f32_e32 %0, %1, %2":"=v"(r):"v"(a),"v"(b));return r;}
__device__ __forceinline__ float fadd_s(float a,float b){float r;asm("v_add_f32_e32 %0, %1, %2":"=v"(r):"v"(a),"v"(b));return r;}
__device__ __forceinline__ float fsub_s(float a,float b){float r;asm("v_sub_f32_e32 %0, %1, %2":"=v"(r):"v"(a),"v"(b));return r;}
typedef float f32x2_t __attribute__((ext_vector_type(2))); typedef float f32x4_t __attribute__((ext_vector_type(4))); typedef __bf16 bf16x2_t __attribute__((ext_vector_type(2)));
__device__ __forceinline__ unsigned cvtpk_s(float lo,float hi){f32x2_t v={lo,hi};bf16x2_t b=__builtin_convertvector(v,bf16x2_t);return __builtin_bit_cast(unsigned,b);}
#define WAIT_BAR(N) asm volatile("s_waitcnt vmcnt(" #N ") lgkmcnt(0)\n\ts_barrier":::"memory")

__device__ __forceinline__ void qkt(f32x16&p0,f32x16&p1,const char*Kslot,const bf16x8*qr,const f32x16&negm,int r32,int hi){
  const char*kb=Kslot+hi*1024+r32*16;
  #pragma unroll
  for(int d0=0;d0<4;++d0){
    const bf16x8 b0=*reinterpret_cast<const bf16x8*>(kb+d0*2048);
    const bf16x8 b1=*reinterpret_cast<const bf16x8*>(kb+d0*2048+512);
    if(d0==0){p0=__builtin_amdgcn_mfma_f32_32x32x16_bf16(b0,qr[0],negm,0,0,0);p1=__builtin_amdgcn_mfma_f32_32x32x16_bf16(b1,qr[0],negm,0,0,0);}
    else{p0=__builtin_amdgcn_mfma_f32_32x32x16_bf16(b0,qr[d0],p0,0,0,0);p1=__builtin_amdgcn_mfma_f32_32x32x16_bf16(b1,qr[d0],p1,0,0,0);}}
}
typedef __attribute__((address_space(3))) const char* lds_cptr;
typedef short v4i16_t __attribute__((ext_vector_type(4)));
__device__ __forceinline__ void kload8(bf16x8*kf,lds_cptr kp){
  kf[0]=*(const __attribute__((address_space(3))) bf16x8*)(kp);      kf[1]=*(const __attribute__((address_space(3))) bf16x8*)(kp+512);
  kf[2]=*(const __attribute__((address_space(3))) bf16x8*)(kp+2048); kf[3]=*(const __attribute__((address_space(3))) bf16x8*)(kp+2560);
  kf[4]=*(const __attribute__((address_space(3))) bf16x8*)(kp+4096); kf[5]=*(const __attribute__((address_space(3))) bf16x8*)(kp+4608);
  kf[6]=*(const __attribute__((address_space(3))) bf16x8*)(kp+6144); kf[7]=*(const __attribute__((address_space(3))) bf16x8*)(kp+6656);
}
__device__ __forceinline__ void kload2(bf16x8*kf,lds_cptr kp,int j){ kf[2*j]=*(const __attribute__((address_space(3))) bf16x8*)(kp+j*2048); kf[2*j+1]=*(const __attribute__((address_space(3))) bf16x8*)(kp+j*2048+512); }
__device__ __forceinline__ s16x4 vtr(lds_cptr p){ return __builtin_bit_cast(s16x4,__builtin_amdgcn_ds_read_tr16_b64_v4i16((__attribute__((address_space(3))) v4i16_t*)p)); }
__device__ __forceinline__ float rowmax(const f32x16&p0,const f32x16&p1){
  float a=max3f(p0[0],p0[1],p1[0]),b=max3f(p0[2],p0[3],p1[1]);a=max3f(a,p1[2],p1[3]);
  #pragma unroll
  for(int r=4;r<16;r+=4){a=max3f(a,p0[r],p0[r+1]);b=max3f(b,p0[r+2],p0[r+3]);a=max3f(a,p1[r],p1[r+1]);b=max3f(b,p1[r+2],p1[r+3]);}
  const float m=max2f(a,b);
  auto rr=__builtin_amdgcn_permlane32_swap(__float_as_uint(m),__float_as_uint(m),false,false);
  return max2f(__uint_as_float(rr[0]),__uint_as_float(rr[1]));
}
__device__ __forceinline__ void pv(f32x16*o,int vb,bf16x8 pa0,bf16x8 pa1,bf16x8 pa2,bf16x8 pa3){
  #pragma unroll
  for(int d0=0;d0<2;++d0){s16x4 lo[4],hi[4];
    #pragma unroll
    for(int ks=0;ks<4;++ks){
      asm volatile("ds_read_b64_tr_b16 %0,%1 offset:%c2":"=&v"(lo[ks]):"v"(vb),"i"(d0*4096+ks*1024):"memory");
      asm volatile("ds_read_b64_tr_b16 %0,%1 offset:%c2":"=&v"(hi[ks]):"v"(vb),"i"(d0*4096+ks*1024+512):"memory");}
    asm volatile("s_waitcnt lgkmcnt(0)":::"memory");SBAR();
    #define PK(k) (bf16x8){lo[k][0],lo[k][1],lo[k][2],lo[k][3],hi[k][0],hi[k][1],hi[k][2],hi[k][3]}
    o[d0]=__builtin_amdgcn_mfma_f32_32x32x16_bf16(pa0,PK(0),o[d0],0,0,0);
    o[d0]=__builtin_amdgcn_mfma_f32_32x32x16_bf16(pa1,PK(1),o[d0],0,0,0);
    o[d0]=__builtin_amdgcn_mfma_f32_32x32x16_bf16(pa2,PK(2),o[d0],0,0,0);
    o[d0]=__builtin_amdgcn_mfma_f32_32x32x16_bf16(pa3,PK(3),o[d0],0,0,0);
    #undef PK
  }
}

#ifndef ATTN_STORE16
#define ATTN_STORE16(p,v) (*(u32x4*)(p)=(v))
#endif
struct AttnP { const bf16* Q; const bf16* K; const bf16* V; bf16* out; bf16* stash; const float* gsub; const float* logf; int opitch; float lam, nscale; };
template<int THRL,bool FOX> __device__ __forceinline__ void attn_unit(const int tid_in,int b,int qb,const int MODE,const AttnP&P,char*shm){
  int tid=tid_in; asm volatile("":"+v"(tid));
  const int lane=tid&63,r32=lane&31,hi=lane>>5; const int wid=__builtin_amdgcn_readfirstlane(tid>>6);
  const long rowbase=(long)b*SEQ; const int q0=qb*QB;
  const bf16*Qw=P.Q+(rowbase+q0+wid*QBLK)*DM;
  const bf16*Kh=P.K+rowbase*DM,*Vh=P.V+rowbase*DM;
  const unsigned lds0=(unsigned)(uintptr_t)shm;
  float*wsf=(float*)(shm+LDS_WS)+wid*64;
  const float*biasL=(const float*)(shm+LDS_BIAS);
  #define BIAS(P0,P1,t) do{ if(FOX){ const float*bb_=biasL+64*(t)+4*hi; _Pragma("unroll") for(int g_=0;g_<4;++g_){ const f32x4_t b0_=*(const f32x4_t*)(bb_+8*g_), b1_=*(const f32x4_t*)(bb_+32+8*g_); \
      _Pragma("unroll") for(int e_=0;e_<4;++e_){ P0[4*g_+e_]+=b0_[e_]; P1[4*g_+e_]+=b1_[e_]; } asm volatile("":::"memory"); } } }while(0)
  const bf16*ksrc=Kh+(long)lane*DM+wid*8;
  const bf16*vsrc=Vh+(long)(16*(wid&3)+(lane>>2))*DM+(wid>>2)*32+(lane&3)*8;
  const unsigned kdst=lds0+LDS_K+wid*1024, vdst=lds0+LDS_V+wid*1024;
  #define DMA_K(t,slot) glds16(ksrc+(long)(t)*KVBLK*DM,(unsigned)__builtin_amdgcn_readfirstlane(kdst+(slot)))
  #define DMA_V(t,slot) glds16(vsrc+(long)(t)*KVBLK*DM,(unsigned)__builtin_amdgcn_readfirstlane(vdst+(slot)))
  const int vb0=(int)(lds0+LDS_V)+((lane>>4)&1)*32+(lane&3)*8+(4*hi+((lane&15)>>2))*64;
  const char*Kbase=shm+LDS_K; bf16x8 kf[8];
  const lds_cptr shm3=(lds_cptr)shm; const lds_cptr kp0=shm3+LDS_K+hi*1024+r32*16; const lds_cptr vp0=shm3+LDS_V+((lane>>4)&1)*32+(lane&3)*8+(4*hi+((lane&15)>>2))*64;
  const int NT=(q0+QB)/KVBLK;
  DMA_K(0,0);DMA_V(0,0);DMA_K(1,SLOTB);
  bf16x8 qr[4];
  #pragma unroll
  for(int d0=0;d0<4;++d0)qr[d0]=*reinterpret_cast<const bf16x8*>(&Qw[(long)r32*DM+d0*16+hi*8]);
  float mhat=0.f,l_reg=0.f;f32x16 o[2];o[0]=f32x16{};o[1]=f32x16{};f32x16 negm=f32x16{};asm volatile("":"+v"(negm));
  const int qrel=wid*QBLK+r32;
  #define CMASK(P0,P1,t) do{int jb_=(t)-(NT-4); if(jb_>=0)cmask(P0,P1,jb_,qrel,hi);}while(0)
  bool resc=false;
  #define START(P0,P1) do{ const float rm=rowmax(P0,P1); resc=false; \
    { const float dl=rm; mhat=fadd_s(mhat,dl); \
      _Pragma("unroll") for(int r=0;r<16;++r){P0[r]=fsub_s(P0[r],dl);P1[r]=fsub_s(P1[r],dl);} \
      _Pragma("unroll") for(int r=0;r<16;++r)negm[r]=-mhat; asm volatile("":"+v"(negm)); } \
    _Pragma("unroll") for(int r=0;r<16;++r)P0[r]=__builtin_amdgcn_exp2f(P0[r]); }while(0)
  #define RESC() do{ if(resc){ asm volatile("s_waitcnt lgkmcnt(0)":::"memory"); \
      _Pragma("unroll") for(int d_=0;d_<2;++d_) _Pragma("unroll") for(int r=0;r<16;++r)o[d_][r]*=wsf[crow(r,hi)]; } }while(0)
  f32x16 pA0,pA1,pB0,pB1;
  int sl_prev=0,sl_cur=0,sl_next=SLOTB;
  #define ROT() do{sl_prev=sl_cur;sl_cur=sl_next;sl_next=(sl_next==(NSLOT-1)*SLOTB)?0:sl_next+SLOTB;}while(0)
  DMA_K(2,2*SLOTB);
  if(FOX){
    const int n=q0+QB; float v4[4]; float run=0.f;
    _Pragma("unroll") for(int i=0;i<4;++i){ const int sidx=4*tid+i; const float lv=(sidx<n)?P.logf[(rowbase+sidx)*8]:0.f; run+=lv; v4[i]=run; }
    float inc=run; _Pragma("unroll") for(int o_=1;o_<64;o_<<=1){ const float up=__int_as_float(__builtin_amdgcn_ds_bpermute((lane-o_)<<2,__float_as_int(inc))); if(lane>=o_)inc+=up; }
    float*wt=(float*)(shm+LDS_WS); if(lane==63)wt[wid]=inc; __syncthreads();
    float pre=inc-run; _Pragma("unroll") for(int w_=0;w_<NW;++w_){ if(w_<wid)pre+=wt[w_]; }
    float*bw=(float*)(shm+LDS_BIAS); _Pragma("unroll") for(int i=0;i<4;++i){ const int sidx=4*tid+i; if(sidx<n)bw[sidx]=-(pre+v4[i])*1.4426950408889634f; }
    __syncthreads(); }
  WAIT_BAR(3);
  qkt(pA0,pA1,Kbase,qr,negm,r32,hi);asm volatile("s_nop 15\n\ts_nop 7":"+v"(pA0),"+v"(pA1));BIAS(pA0,pA1,0);CMASK(pA0,pA1,0);
  START(pA0,pA1);
  _Pragma("unroll") for(int r=0;r<16;++r)pA1[r]=__builtin_amdgcn_exp2f(pA1[r]);
  WAIT_BAR(0);
  DMA_K(3,0);DMA_V(1,SLOTB);
  ROT();
  kload8(kf,kp0+sl_cur);
  WAIT_BAR(2);
  s16x4 vlo[8],vhi[8]; u32x4 pw0,pw1,pw2,pw3;
  #define PKW(P,B) cvtpk_s(P[B],P[B+1])
  #define PAF(k) __builtin_bit_cast(bf16x8,pw##k)
  #define VFR(i) (bf16x8){vlo[i][0],vlo[i][1],vlo[i][2],vlo[i][3],vhi[i][0],vhi[i][1],vhi[i][2],vhi[i][3]}
  #define PIN(x) asm volatile("":"+v"(x))
  #define MX3(a,b,c) __builtin_fmaxf(__builtin_fmaxf((a),(b)),(c))
  #define GAPA(MF,A0,A1,A2,A3,W0,W1,PW) do{ MF; sacc+=A0; sacc+=A1; sacc+=A2; sacc+=A3; PIN(sacc); W0; W1; PIN(PW); SBAR(); }while(0)
  #define EX(v) __builtin_amdgcn_exp2f(v)
  #define GAPB(MF,X,B) do{ MF; X[B]=EX(X[B]); X[B+1]=EX(X[B+1]); X[B+2]=EX(X[B+2]); X[B+3]=EX(X[B+3]); PIN(X); SBAR(); }while(0)
  #define VRD(i) do{ vlo[i]=vtr(vp_+(((i)>>2)*4096+((i)&3)*1024)); vhi[i]=vtr(vp_+(((i)>>2)*4096+((i)&3)*1024+512)); }while(0)
  #define KRD(G,j) do{ if(G){ kload2(kf,kp0+sl_next,j); SBAR(); } }while(0)
  #define STEP(C0,C1,P0,P1,t,GK,GV,GL) do{ SBAR(); \
    const lds_cptr vp_=vp0+sl_prev; \
    VRD(0); SBAR(); float sacc=(P0[0]+P0[1]); \
    GAPA(C0=__builtin_amdgcn_mfma_f32_32x32x16_bf16(kf[0],qr[0],negm,0,0,0), P0[2],P0[3],P0[4],P0[5],     pw0[0]=PKW(P0,0), pw0[1]=PKW(P0,2), pw0); \
    VRD(4); SBAR(); GAPA(C1=__builtin_amdgcn_mfma_f32_32x32x16_bf16(kf[1],qr[0],negm,0,0,0), P0[6],P0[7],P0[8],P0[9],     pw0[2]=PKW(P0,4), pw0[3]=PKW(P0,6), pw0); \
    VRD(1); SBAR(); GAPA(C0=__builtin_amdgcn_mfma_f32_32x32x16_bf16(kf[2],qr[1],C0,0,0,0),   P0[10],P0[11],P0[12],P0[13], pw1[0]=PKW(P0,8), pw1[1]=PKW(P0,10), pw1); \
    VRD(5); SBAR(); GAPA(C1=__builtin_amdgcn_mfma_f32_32x32x16_bf16(kf[3],qr[1],C1,0,0,0),   P0[14],P0[15],P1[0],P1[1],   pw1[2]=PKW(P0,12),pw1[3]=PKW(P0,14), pw1); \
    VRD(2); SBAR(); GAPA(C0=__builtin_amdgcn_mfma_f32_32x32x16_bf16(kf[4],qr[2],C0,0,0,0),   P1[2],P1[3],P1[4],P1[5],     pw2[0]=PKW(P1,0), pw2[1]=PKW(P1,2), pw2); \
    VRD(6); SBAR(); GAPA(C1=__builtin_amdgcn_mfma_f32_32x32x16_bf16(kf[5],qr[2],C1,0,0,0),   P1[6],P1[7],P1[8],P1[9],     pw2[2]=PKW(P1,4), pw2[3]=PKW(P1,6), pw2); \
    VRD(3); SBAR(); GAPA(C0=__builtin_amdgcn_mfma_f32_32x32x16_bf16(kf[6],qr[3],C0,0,0,0),   P1[10],P1[11],P1[12],P1[13], pw3[0]=PKW(P1,8), pw3[1]=PKW(P1,10), pw3); \
    VRD(7); SBAR(); GAPA(C1=__builtin_amdgcn_mfma_f32_32x32x16_bf16(kf[7],qr[3],C1,0,0,0),   P1[14],P1[15],0.f,0.f,       pw3[2]=PKW(P1,12),pw3[3]=PKW(P1,14), pw3); \
    l_reg+=sacc; \
    if(GK){DMA_K((t)+3,sl_cur);} if(GV){DMA_V((t)+1,sl_next);} \
    BIAS(C0,C1,t); CMASK(C0,C1,t); \
    { float a=MX3(C0[0],C0[1],C1[0]),b=MX3(C0[2],C0[3],C1[1]); a=MX3(a,C1[2],C1[3]); \
      _Pragma("unroll") for(int r=4;r<16;r+=4){a=MX3(a,C0[r],C0[r+1]);b=MX3(b,C0[r+2],C0[r+3]);a=MX3(a,C1[r],C1[r+1]);b=MX3(b,C1[r+2],C1[r+3]);} \
      float rm=__builtin_fmaxf(a,b); { auto rr=__builtin_amdgcn_permlane32_swap(__float_as_uint(rm),__float_as_uint(rm),false,false); rm=__builtin_fmaxf(__uint_as_float(rr[0]),__uint_as_float(rr[1])); } \
      resc=false; \
      if(__builtin_expect(__any(rm>(float)THRL),0)){ const float dl=__builtin_fmaxf(rm,0.f); mhat+=dl; \
        _Pragma("unroll") for(int r=0;r<16;++r){C0[r]-=dl;C1[r]-=dl;} \
        _Pragma("unroll") for(int r=0;r<16;++r)negm[r]=-mhat; asm volatile("":"+v"(negm)); \
        const float f=__builtin_amdgcn_exp2f(-dl); l_reg*=f; if(hi==0)wsf[r32]=f; resc=true; } } \
    SBAR(); \
    GAPB(o[0]=__builtin_amdgcn_mfma_f32_32x32x16_bf16(PAF(0),VFR(0),o[0],0,0,0), C0,0); \
    GAPB(o[1]=__builtin_amdgcn_mfma_f32_32x32x16_bf16(PAF(0),VFR(4),o[1],0,0,0), C0,4); \
    KRD(GL,0); GAPB(o[0]=__builtin_amdgcn_mfma_f32_32x32x16_bf16(PAF(1),VFR(1),o[0],0,0,0), C0,8); \
    KRD(GL,1); GAPB(o[1]=__builtin_amdgcn_mfma_f32_32x32x16_bf16(PAF(1),VFR(5),o[1],0,0,0), C0,12); \
    KRD(GL,2); GAPB(o[0]=__builtin_amdgcn_mfma_f32_32x32x16_bf16(PAF(2),VFR(2),o[0],0,0,0), C1,0); \
    KRD(GL,3); GAPB(o[1]=__builtin_amdgcn_mfma_f32_32x32x16_bf16(PAF(2),VFR(6),o[1],0,0,0), C1,4); \
    GAPB(o[0]=__builtin_amdgcn_mfma_f32_32x32x16_bf16(PAF(3),VFR(3),o[0],0,0,0), C1,8); \
    GAPB(o[1]=__builtin_amdgcn_mfma_f32_32x32x16_bf16(PAF(3),VFR(7),o[1],0,0,0), C1,12); \
    }while(0)
  int t=1;
  #undef CMASK
  #define CMASK(P0,P1,t) do{}while(0)
  for(;t+5<NT;t+=2){
    STEP(pB0,pB1,pA0,pA1,t,true,true,true);     WAIT_BAR(2); RESC(); ROT();
    STEP(pA0,pA1,pB0,pB1,t+1,true,true,true);   WAIT_BAR(2); RESC(); ROT();
  }
  #undef CMASK
  #define CMASK(P0,P1,t) do{int jb_=(t)-(NT-4); if(jb_>=0)cmask(P0,P1,jb_,qrel,hi);}while(0)
  #define ENDW(tt) do{ if((tt)+3<NT){WAIT_BAR(2);} else if((tt)+2<NT){WAIT_BAR(1);} else {WAIT_BAR(0);} }while(0)
  for(;t+1<NT;t+=2){
    STEP(pB0,pB1,pA0,pA1,t,(t+3<NT),(t+1<NT),(t+1<NT));       ENDW(t);   RESC(); ROT();
    STEP(pA0,pA1,pB0,pB1,t+1,(t+4<NT),(t+2<NT),(t+2<NT));     ENDW(t+1); RESC(); ROT();
  }
  STEP(pB0,pB1,pA0,pA1,NT-1,false,false,false); RESC();
  { float sacc=pB0[0]+pB0[1]; _Pragma("unroll") for(int r=2;r<16;++r)sacc+=pB0[r]; _Pragma("unroll") for(int r=0;r<16;++r)sacc+=pB1[r]; l_reg+=sacc;
    pw0=(u32x4){PKW(pB0,0),PKW(pB0,2),PKW(pB0,4),PKW(pB0,6)};pw1=(u32x4){PKW(pB0,8),PKW(pB0,10),PKW(pB0,12),PKW(pB0,14)};pw2=(u32x4){PKW(pB1,0),PKW(pB1,2),PKW(pB1,4),PKW(pB1,6)};pw3=(u32x4){PKW(pB1,8),PKW(pB1,10),PKW(pB1,12),PKW(pB1,14)};
    SBAR(); pv(o,vb0+sl_cur,PAF(0),PAF(1),PAF(2),PAF(3)); }
  #undef PKW
  #undef PAF
  #undef VFR
  #undef PIN
  #undef MX3
  #undef GAPA
  #undef GAPB
  #undef EX
  #undef VRD
  #undef KRD
  #undef STEP
  #undef ENDW
  {auto rr=__builtin_amdgcn_permlane32_swap(__float_as_uint(l_reg),__float_as_uint(l_reg),false,false);l_reg=__uint_as_float(rr[0])+__uint_as_float(rr[1]);}
  if(hi==0)wsf[32+r32]=l_reg;asm volatile("s_waitcnt lgkmcnt(0)":::"memory");
  float rli[16];
  #pragma unroll
  for(int r=0;r<16;++r)rli[r]=__builtin_amdgcn_rcpf(wsf[32+crow(r,hi)]);
  { hbf16*stg=(hbf16*)(shm+LDS_OST)+wid*2048;
    #pragma unroll
    for(int r=0;r<16;++r){const int orow=crow(r,hi);
      #pragma unroll
      for(int d0=0;d0<2;++d0)stg[orow*64+d0*32+r32]=__float2bfloat16(o[d0][r]*rli[r]);}
    asm volatile("s_waitcnt lgkmcnt(0)":::"memory");
    const long grow=rowbase+q0+wid*QBLK; float*ssq=(float*)(shm+LDS_SSQ)+wid*32;
    int lane_e=lane; asm volatile("":"+v"(lane_e));
    #pragma unroll
    for(int i=0;i<4;++i){const int row=i*8+(lane_e>>3),ch=lane_e&7; const u32x4 v=*(const u32x4*)(stg+row*64+ch*8);
      if(MODE==0){ *(u32x4*)(P.out+(grow+row)*(long)P.opitch+ch*8)=v; }
      else { bf16*sp=P.stash+(grow+row)*512+ch*8+(MODE==2?64:0); const u32x4 a=*(const u32x4*)sp; float of[8]; float ss=0.f;
        #pragma unroll
        for(int j=0;j<4;++j){ const float a0=__uint_as_float(a[j]<<16),a1=__uint_as_float(a[j]&0xffff0000u),c0=__uint_as_float(v[j]<<16),c1=__uint_as_float(v[j]&0xffff0000u);
          of[2*j]=a0-P.lam*c0; of[2*j+1]=a1-P.lam*c1; ss+=of[2*j]*of[2*j]+of[2*j+1]*of[2*j+1]; }
        ss+=__int_as_float(__builtin_amdgcn_ds_swizzle(__float_as_int(ss),0x041f)); ss+=__int_as_float(__builtin_amdgcn_ds_swizzle(__float_as_int(ss),0x081f)); ss+=__int_as_float(__builtin_amdgcn_ds_swizzle(__float_as_int(ss),0x101f));
        if(MODE==1){ if(ch==0)ssq[row]=ss; u32x4 w; _Pragma("unroll") for(int j=0;j<4;++j)w[j]=cvtpk_s(of[2*j],of[2*j+1]); *(u32x4*)sp=w; }
        else { const float rr_=rsqrtf((ss+ssq[row])*(1.0f/128.0f)+1e-6f)*P.nscale; bf16*yp=P.out+(grow+row)*(long)P.opitch+ch*8;
          const f32x4_t g0=*(const f32x4_t*)(P.gsub+64+ch*8), g1=*(const f32x4_t*)(P.gsub+64+ch*8+4), h0=*(const f32x4_t*)(P.gsub+ch*8), h1=*(const f32x4_t*)(P.gsub+ch*8+4);
          u32x4 w; w[0]=cvtpk_s(of[0]*rr_*g0[0],of[1]*rr_*g0[1]); w[1]=cvtpk_s(of[2]*rr_*g0[2],of[3]*rr_*g0[3]); w[2]=cvtpk_s(of[4]*rr_*g1[0],of[5]*rr_*g1[1]); w[3]=cvtpk_s(of[6]*rr_*g1[2],of[7]*rr_*g1[3]);
          *(u32x4*)(yp+64)=w;
          const u32x4 lo=*(const u32x4*)(sp-64); float lf[8];
          #pragma unroll
          for(int j=0;j<4;++j){ lf[2*j]=__uint_as_float(lo[j]<<16); lf[2*j+1]=__uint_as_float(lo[j]&0xffff0000u); }
          w[0]=cvtpk_s(lf[0]*rr_*h0[0],lf[1]*rr_*h0[1]); w[1]=cvtpk_s(lf[2]*rr_*h0[2],lf[3]*rr_*h0[3]); w[2]=cvtpk_s(lf[4]*rr_*h1[0],lf[5]*rr_*h1[1]); w[3]=cvtpk_s(lf[6]*rr_*h1[2],lf[7]*rr_*h1[3]);
          *(u32x4*)yp=w; } } } }
  asm volatile("s_waitcnt lgkmcnt(0)\n\ts_barrier":::"memory");
  #undef DMA_K
  #undef BIAS
  #undef DMA_V
  #undef CMASK
  #undef START
  #undef RESC
  #undef ROT
}
__device__ __forceinline__ void pv128(f32x16*o,int vb,bf16x8 pa0,bf16x8 pa1,bf16x8 pa2,bf16x8 pa3){
  #pragma unroll
  for(int d0=0;d0<4;++d0){s16x4 lo[4],hi[4];
    #pragma unroll
    for(int ks=0;ks<4;++ks){
      asm volatile("ds_read_b64_tr_b16 %0,%1 offset:%c2":"=&v"(lo[ks]):"v"(vb),"i"(d0*4096+ks*1024):"memory");
      asm volatile("ds_read_b64_tr_b16 %0,%1 offset:%c2":"=&v"(hi[ks]):"v"(vb),"i"(d0*4096+ks*1024+512):"memory");}
    asm volatile("s_waitcnt lgkmcnt(0)":::"memory");SBAR();
    #define PK(k) (bf16x8){lo[k][0],lo[k][1],lo[k][2],lo[k][3],hi[k][0],hi[k][1],hi[k][2],hi[k][3]}
    o[d0]=__builtin_amdgcn_mfma_f32_32x32x16_bf16(pa0,PK(0),o[d0],0,0,0);
    o[d0]=__builtin_amdgcn_mfma_f32_32x32x16_bf16(pa1,PK(1),o[d0],0,0,0);
    o[d0]=__builtin_amdgcn_mfma_f32_32x32x16_bf16(pa2,PK(2),o[d0],0,0,0);
    o[d0]=__builtin_amdgcn_mfma_f32_32x32x16_bf16(pa3,PK(3),o[d0],0,0,0);
    #undef PK
  }
}
template<int THRL> __device__ __forceinline__ void attn_unit128(const int tid_in,int b,int qb,const int MODE,const AttnP&P,char*shm){
  constexpr bool FOX=false; constexpr int LDS_V=24576, LDS_WS=73728, LDS_OST=75776, SLOTV=16384;
  int tid=tid_in; asm volatile("":"+v"(tid));
  const int lane=tid&63,r32=lane&31,hi=lane>>5; const int wid=__builtin_amdgcn_readfirstlane(tid>>6);
  const long rowbase=(long)b*SEQ; const int q0=qb*QB;
  const bf16*Qw=P.Q+(rowbase+q0+wid*QBLK)*DM;
  const bf16*Kh=P.K+rowbase*DM,*Vh=P.V+rowbase*DM;
  const unsigned lds0=(unsigned)(uintptr_t)shm;
  float*wsf=(float*)(shm+LDS_WS)+wid*64;
  const float*biasL=(const float*)(shm+LDS_BIAS);
  #define BIAS(P0,P1,t) do{ if(FOX){ const float*bb_=biasL+64*(t)+4*hi; _Pragma("unroll") for(int g_=0;g_<4;++g_){ const f32x4_t b0_=*(const f32x4_t*)(bb_+8*g_), b1_=*(const f32x4_t*)(bb_+32+8*g_); \
      _Pragma("unroll") for(int e_=0;e_<4;++e_){ P0[4*g_+e_]+=b0_[e_]; P1[4*g_+e_]+=b1_[e_]; } asm volatile("":::"memory"); } } }while(0)
  const bf16*ksrc=Kh+(long)lane*DM+wid*8;
  const bf16*vsrc=Vh+(long)(16*(wid&3)+(lane>>2))*DM+(wid>>2)*32+(lane&3)*8;
  const unsigned kdst=lds0+LDS_K+wid*1024, vdst=lds0+LDS_V+wid*1024;
  #define DMA_K(t,slot) glds16(ksrc+(long)(t)*KVBLK*DM,(unsigned)__builtin_amdgcn_readfirstlane(kdst+(slot)))
  #define DMA_V(t,slot) do{ glds16(vsrc+(long)(t)*KVBLK*DM,(unsigned)__builtin_amdgcn_readfirstlane(vdst+2*(slot))); glds16(vsrc+(long)(t)*KVBLK*DM+64,(unsigned)__builtin_amdgcn_readfirstlane(vdst+2*(slot)+8192)); }while(0)
  const int vb0=(int)(lds0+LDS_V)+((lane>>4)&1)*32+(lane&3)*8+(4*hi+((lane&15)>>2))*64;
  const char*Kbase=shm+LDS_K; bf16x8 kf[8];
  const lds_cptr shm3=(lds_cptr)shm; const lds_cptr kp0=shm3+LDS_K+hi*1024+r32*16; const lds_cptr vp0=shm3+LDS_V+((lane>>4)&1)*32+(lane&3)*8+(4*hi+((lane&15)>>2))*64;
  const int NT=(q0+QB)/KVBLK;
  DMA_K(0,0);DMA_V(0,0);DMA_K(1,SLOTB);
  bf16x8 qr[4];
  #pragma unroll
  for(int d0=0;d0<4;++d0)qr[d0]=*reinterpret_cast<const bf16x8*>(&Qw[(long)r32*DM+d0*16+hi*8]);
  float mhat=0.f,l_reg=0.f;f32x16 o[4];o[0]=f32x16{};o[1]=f32x16{};o[2]=f32x16{};o[3]=f32x16{};const f32x16 zero16=f32x16{};
  const int qrel=wid*QBLK+r32;
  #define CMASK(P0,P1,t) do{int jb_=(t)-(NT-4); if(jb_>=0)cmask(P0,P1,jb_,qrel,hi);}while(0)
  bool resc=false;
  #define START(P0,P1) do{ const float rm=rowmax(P0,P1); resc=false; \
    { const float dl=rm; mhat=fadd_s(mhat,dl); \
      _Pragma("unroll") for(int r=0;r<16;++r){P0[r]=fsub_s(P0[r],dl);P1[r]=fsub_s(P1[r],dl);} \
      } \
    _Pragma("unroll") for(int r=0;r<16;++r)P0[r]=__builtin_amdgcn_exp2f(P0[r]); }while(0)
  #define RESC() do{ if(resc){ asm volatile("s_waitcnt lgkmcnt(0)":::"memory"); \
      _Pragma("unroll") for(int d_=0;d_<4;++d_) _Pragma("unroll") for(int r=0;r<16;++r)o[d_][r]*=wsf[crow(r,hi)]; } }while(0)
  f32x16 pA0,pA1,pB0,pB1;
  int sl_prev=0,sl_cur=0,sl_next=SLOTB;
  #define ROT() do{sl_prev=sl_cur;sl_cur=sl_next;sl_next=(sl_next==(NSLOT-1)*SLOTB)?0:sl_next+SLOTB;}while(0)
  DMA_K(2,2*SLOTB);
  WAIT_BAR(4);
  qkt(pA0,pA1,Kbase,qr,zero16,r32,hi);asm volatile("s_nop 15\n\ts_nop 7":"+v"(pA0),"+v"(pA1));BIAS(pA0,pA1,0);CMASK(pA0,pA1,0);
  START(pA0,pA1);
  _Pragma("unroll") for(int r=0;r<16;++r)pA1[r]=__builtin_amdgcn_exp2f(pA1[r]);
  WAIT_BAR(0);
  DMA_K(3,0);DMA_V(1,SLOTB);
  ROT();
  kload8(kf,kp0+sl_cur);
  WAIT_BAR(3);
  s16x4 va_lo,va_hi,vb_lo,vb_hi; u32x4 pw0,pw1,pw2,pw3;
  #define PKW(P,B) cvtpk_s(P[B],P[B+1])
  #define PAF(k) __builtin_bit_cast(bf16x8,pw##k)
  #define VFA (bf16x8){va_lo[0],va_lo[1],va_lo[2],va_lo[3],va_hi[0],va_hi[1],va_hi[2],va_hi[3]}
  #define VFB (bf16x8){vb_lo[0],vb_lo[1],vb_lo[2],vb_lo[3],vb_hi[0],vb_hi[1],vb_hi[2],vb_hi[3]}
  #define PIN(x) asm volatile("":"+v"(x))
  #define MX3(a,b,c) __builtin_fmaxf(__builtin_fmaxf((a),(b)),(c))
  #define GAPA(MF,A0,A1,A2,A3,W0,W1,PW) do{ MF; sacc+=A0; sacc+=A1; sacc+=A2; sacc+=A3; PIN(sacc); W0; W1; PIN(PW); SBAR(); }while(0)
  #define EX(v) __builtin_amdgcn_exp2f((v)-mhat)
  #define VRDA(d0,ks) do{ va_lo=vtr(vp_+((d0)*4096+(ks)*1024)); va_hi=vtr(vp_+((d0)*4096+(ks)*1024+512)); }while(0)
  #define VRDB(d0,ks) do{ vb_lo=vtr(vp_+((d0)*4096+(ks)*1024)); vb_hi=vtr(vp_+((d0)*4096+(ks)*1024+512)); }while(0)
  #define KRD(G,j) do{ if(G){ kload2(kf,kp0+sl_next,j); } }while(0)
  #define GAPB(MF,RD,X,B) do{ MF; RD; X[B]=EX(X[B]); X[B+1]=EX(X[B+1]); PIN(X); SBAR(); }while(0)
  #define STEP(C0,C1,P0,P1,t,GK,GV,GL) do{ SBAR(); \
    const lds_cptr vp_=vp0+2*sl_prev; \
    float sacc=(P0[0]+P0[1]); \
    GAPA(C0=__builtin_amdgcn_mfma_f32_32x32x16_bf16(kf[0],qr[0],zero16,0,0,0), P0[2],P0[3],P0[4],P0[5],     pw0[0]=PKW(P0,0), pw0[1]=PKW(P0,2), pw0); \
    GAPA(C1=__builtin_amdgcn_mfma_f32_32x32x16_bf16(kf[1],qr[0],zero16,0,0,0), P0[6],P0[7],P0[8],P0[9],     pw0[2]=PKW(P0,4), pw0[3]=PKW(P0,6), pw0); \
    GAPA(C0=__builtin_amdgcn_mfma_f32_32x32x16_bf16(kf[2],qr[1],C0,0,0,0),   P0[10],P0[11],P0[12],P0[13], pw1[0]=PKW(P0,8), pw1[1]=PKW(P0,10), pw1); \
    GAPA(C1=__builtin_amdgcn_mfma_f32_32x32x16_bf16(kf[3],qr[1],C1,0,0,0),   P0[14],P0[15],P1[0],P1[1],   pw1[2]=PKW(P0,12),pw1[3]=PKW(P0,14), pw1); \
    GAPA(C0=__builtin_amdgcn_mfma_f32_32x32x16_bf16(kf[4],qr[2],C0,0,0,0),   P1[2],P1[3],P1[4],P1[5],     pw2[0]=PKW(P1,0), pw2[1]=PKW(P1,2), pw2); \
    GAPA(C1=__builtin_amdgcn_mfma_f32_32x32x16_bf16(kf[5],qr[2],C1,0,0,0),   P1[6],P1[7],P1[8],P1[9],     pw2[2]=PKW(P1,4), pw2[3]=PKW(P1,6), pw2); \
    VRDA(0,0); SBAR(); \
    GAPA(C0=__builtin_amdgcn_mfma_f32_32x32x16_bf16(kf[6],qr[3],C0,0,0,0),   P1[10],P1[11],P1[12],P1[13], pw3[0]=PKW(P1,8), pw3[1]=PKW(P1,10), pw3); \
    GAPA(C1=__builtin_amdgcn_mfma_f32_32x32x16_bf16(kf[7],qr[3],C1,0,0,0),   P1[14],P1[15],0.f,0.f,       pw3[2]=PKW(P1,12),pw3[3]=PKW(P1,14), pw3); \
    l_reg+=sacc; \
    if(GK){DMA_K((t)+3,sl_cur);} if(GV){DMA_V((t)+1,sl_next);} \
    CMASK(C0,C1,t); \
    { float a=MX3(C0[0],C0[1],C1[0]),b=MX3(C0[2],C0[3],C1[1]); a=MX3(a,C1[2],C1[3]); \
      _Pragma("unroll") for(int r=4;r<16;r+=4){a=MX3(a,C0[r],C0[r+1]);b=MX3(b,C0[r+2],C0[r+3]);a=MX3(a,C1[r],C1[r+1]);b=MX3(b,C1[r+2],C1[r+3]);} \
      float rm=__builtin_fmaxf(a,b); { auto rr=__builtin_amdgcn_permlane32_swap(__float_as_uint(rm),__float_as_uint(rm),false,false); rm=__builtin_fmaxf(__uint_as_float(rr[0]),__uint_as_float(rr[1])); } \
      rm-=mhat; resc=false; \
      if(__builtin_expect(__any(rm>(float)THRL),0)){ const float dl=__builtin_fmaxf(rm,0.f); mhat+=dl; \
        const float f=__builtin_amdgcn_exp2f(-dl); l_reg*=f; if(hi==0)wsf[r32]=f; resc=true; } } \
    SBAR(); \
    GAPB(o[0]=__builtin_amdgcn_mfma_f32_32x32x16_bf16(PAF(0),VFA,o[0],0,0,0), VRDB(1,0), C0,0); \
    GAPB(o[1]=__builtin_amdgcn_mfma_f32_32x32x16_bf16(PAF(0),VFB,o[1],0,0,0), VRDA(2,0), C0,2); \
    GAPB(o[2]=__builtin_amdgcn_mfma_f32_32x32x16_bf16(PAF(0),VFA,o[2],0,0,0), VRDB(3,0), C0,4); \
    GAPB(o[3]=__builtin_amdgcn_mfma_f32_32x32x16_bf16(PAF(0),VFB,o[3],0,0,0), VRDA(0,1), C0,6); \
    KRD(GL,0); GAPB(o[0]=__builtin_amdgcn_mfma_f32_32x32x16_bf16(PAF(1),VFA,o[0],0,0,0), VRDB(1,1), C0,8); \
    GAPB(o[1]=__builtin_amdgcn_mfma_f32_32x32x16_bf16(PAF(1),VFB,o[1],0,0,0), VRDA(2,1), C0,10); \
    KRD(GL,1); GAPB(o[2]=__builtin_amdgcn_mfma_f32_32x32x16_bf16(PAF(1),VFA,o[2],0,0,0), VRDB(3,1), C0,12); \
    GAPB(o[3]=__builtin_amdgcn_mfma_f32_32x32x16_bf16(PAF(1),VFB,o[3],0,0,0), VRDA(0,2), C0,14); \
    KRD(GL,2); GAPB(o[0]=__builtin_amdgcn_mfma_f32_32x32x16_bf16(PAF(2),VFA,o[0],0,0,0), VRDB(1,2), C1,0); \
    GAPB(o[1]=__builtin_amdgcn_mfma_f32_32x32x16_bf16(PAF(2),VFB,o[1],0,0,0), VRDA(2,2), C1,2); \
    KRD(GL,3); GAPB(o[2]=__builtin_amdgcn_mfma_f32_32x32x16_bf16(PAF(2),VFA,o[2],0,0,0), VRDB(3,2), C1,4); \
    GAPB(o[3]=__builtin_amdgcn_mfma_f32_32x32x16_bf16(PAF(2),VFB,o[3],0,0,0), VRDA(0,3), C1,6); \
    GAPB(o[0]=__builtin_amdgcn_mfma_f32_32x32x16_bf16(PAF(3),VFA,o[0],0,0,0), VRDB(1,3), C1,8); \
    GAPB(o[1]=__builtin_amdgcn_mfma_f32_32x32x16_bf16(PAF(3),VFB,o[1],0,0,0), VRDA(2,3), C1,10); \
    GAPB(o[2]=__builtin_amdgcn_mfma_f32_32x32x16_bf16(PAF(3),VFA,o[2],0,0,0), VRDB(3,3), C1,12); \
    GAPB(o[3]=__builtin_amdgcn_mfma_f32_32x32x16_bf16(PAF(3),VFB,o[3],0,0,0), (void)0, C1,14); \
    }while(0)
  int t=1;
  #undef CMASK
  #define CMASK(P0,P1,t) do{}while(0)
  for(;t+5<NT;t+=2){
    STEP(pB0,pB1,pA0,pA1,t,true,true,true);     WAIT_BAR(3); RESC(); ROT();
    STEP(pA0,pA1,pB0,pB1,t+1,true,true,true);   WAIT_BAR(3); RESC(); ROT();
  }
  #undef CMASK
  #define CMASK(P0,P1,t) do{int jb_=(t)-(NT-4); if(jb_>=0)cmask(P0,P1,jb_,qrel,hi);}while(0)
  #define ENDW(tt) do{ if((tt)+3<NT){WAIT_BAR(3);} else if((tt)+2<NT){WAIT_BAR(2);} else {WAIT_BAR(0);} }while(0)
  for(;t+1<NT;t+=2){
    STEP(pB0,pB1,pA0,pA1,t,(t+3<NT),(t+1<NT),(t+1<NT));       ENDW(t);   RESC(); ROT();
    STEP(pA0,pA1,pB0,pB1,t+1,(t+4<NT),(t+2<NT),(t+2<NT));     ENDW(t+1); RESC(); ROT();
  }
  STEP(pB0,pB1,pA0,pA1,NT-1,false,false,false); RESC();
  { float sacc=pB0[0]+pB0[1]; _Pragma("unroll") for(int r=2;r<16;++r)sacc+=pB0[r]; _Pragma("unroll") for(int r=0;r<16;++r)sacc+=pB1[r]; l_reg+=sacc;
    pw0=(u32x4){PKW(pB0,0),PKW(pB0,2),PKW(pB0,4),PKW(pB0,6)};pw1=(u32x4){PKW(pB0,8),PKW(pB0,10),PKW(pB0,12),PKW(pB0,14)};pw2=(u32x4){PKW(pB1,0),PKW(pB1,2),PKW(pB1,4),PKW(pB1,6)};pw3=(u32x4){PKW(pB1,8),PKW(pB1,10),PKW(pB1,12),PKW(pB1,14)};
    SBAR(); pv128(o,vb0+2*sl_cur,PAF(0),PAF(1),PAF(2),PAF(3)); }
  #undef PKW
  #undef PAF
  #undef VFA
  #undef VFB
  #undef VRDA
  #undef VRDB
  #undef PIN
  #undef MX3
  #undef GAPA
  #undef GAPB
  #undef EX
  #undef KRD
  #undef STEP
  #undef ENDW
  {auto rr=__builtin_amdgcn_permlane32_swap(__float_as_uint(l_reg),__float_as_uint(l_reg),false,false);l_reg=__uint_as_float(rr[0])+__uint_as_float(rr[1]);}
  if(hi==0)wsf[32+r32]=l_reg;asm volatile("s_waitcnt lgkmcnt(0)":::"memory");
  float rli[16];
  #pragma unroll
  for(int r=0;r<16;++r)rli[r]=__builtin_amdgcn_rcpf(wsf[32+crow(r,hi)]);
  { hbf16*stg=(hbf16*)(shm+LDS_OST)+wid*2048;
    const long grow=rowbase+q0+wid*QBLK;
    int lane_e=lane; asm volatile("":"+v"(lane_e));
    float of[2][4][8]; float ssr[4]={0.f,0.f,0.f,0.f};
    #pragma unroll
    for(int hf=0;hf<2;++hf){
      #pragma unroll
      for(int r=0;r<16;++r){const int orow=crow(r,hi);
        #pragma unroll
        for(int d0=0;d0<2;++d0)stg[orow*64+d0*32+r32]=__float2bfloat16(o[2*hf+d0][r]*rli[r]);}
      asm volatile("s_waitcnt lgkmcnt(0)":::"memory");
      #pragma unroll
      for(int i=0;i<4;++i){const int row=i*8+(lane_e>>3),ch=lane_e&7; const u32x4 v=*(const u32x4*)(stg+row*64+ch*8);
        if(MODE==0){ *(u32x4*)(P.out+(grow+row)*(long)P.opitch+hf*64+ch*8)=v; }
        else { const u32x4 a=*(const u32x4*)(P.stash+(grow+row)*512+hf*64+ch*8); float ss=0.f;
          #pragma unroll
          for(int j=0;j<4;++j){ const float a0=__uint_as_float(a[j]<<16),a1=__uint_as_float(a[j]&0xffff0000u),c0=__uint_as_float(v[j]<<16),c1=__uint_as_float(v[j]&0xffff0000u);
            of[hf][i][2*j]=a0-P.lam*c0; of[hf][i][2*j+1]=a1-P.lam*c1; ss+=of[hf][i][2*j]*of[hf][i][2*j]+of[hf][i][2*j+1]*of[hf][i][2*j+1]; }
          ssr[i]+=ss; } }
      asm volatile("s_waitcnt lgkmcnt(0)":::"memory");
    }
    if(MODE!=0){
      #pragma unroll
      for(int i=0;i<4;++i){const int row=i*8+(lane_e>>3),ch=lane_e&7; float ss=ssr[i];
        ss+=__int_as_float(__builtin_amdgcn_ds_swizzle(__float_as_int(ss),0x041f)); ss+=__int_as_float(__builtin_amdgcn_ds_swizzle(__float_as_int(ss),0x081f)); ss+=__int_as_float(__builtin_amdgcn_ds_swizzle(__float_as_int(ss),0x101f));
        const float rr_=rsqrtf(ss*(1.0f/128.0f)+1e-6f)*P.nscale; bf16*yp=P.out+(grow+row)*(long)P.opitch+ch*8;
        #pragma unroll
        for(int hf=0;hf<2;++hf){ const f32x4_t g0=*(const f32x4_t*)(P.gsub+hf*64+ch*8), g1=*(const f32x4_t*)(P.gsub+hf*64+ch*8+4); u32x4 w;
          w[0]=cvtpk_s(of[hf][i][0]*rr_*g0[0],of[hf][i][1]*rr_*g0[1]); w[1]=cvtpk_s(of[hf][i][2]*rr_*g0[2],of[hf][i][3]*rr_*g0[3]); w[2]=cvtpk_s(of[hf][i][4]*rr_*g1[0],of[hf][i][5]*rr_*g1[1]); w[3]=cvtpk_s(of[hf][i][6]*rr_*g1[2],of[hf][i][7]*rr_*g1[3]);
          *(u32x4*)(yp+hf*64)=w; } } } }
  asm volatile("s_waitcnt lgkmcnt(0)\n\ts_barrier":::"memory");
  #undef DMA_K
  #undef BIAS
  #undef DMA_V
  #undef CMASK
  #undef START
  #undef RESC
  #undef ROT
}
constexpr int ATTN_LDS_BYTES=LDS_BYTES;
#undef SBAR
#undef WAIT_BAR
}
#ifndef MK_MU8
#define MK_MU8 0
#endif
#ifndef MK_PLE8
#define MK_PLE8 0
#endif
#define GAS __attribute__((address_space(1)))
#define LAS __attribute__((address_space(3)))
typedef unsigned v4u __attribute__((ext_vector_type(4)));
typedef float f32x4 __attribute__((ext_vector_type(4)));
typedef GAS unsigned gu32;
#define RLX_AGENT __ATOMIC_RELAXED, __HIP_MEMORY_SCOPE_AGENT
#define LDS_WAIT() asm volatile("s_waitcnt lgkmcnt(0)" ::: "memory")
#define VM_WAIT() asm volatile("s_waitcnt vmcnt(0)" ::: "memory")
constexpr int NWAVES = 8;
constexpr size_t W_IN = 0;
constexpr size_t W_CAT = W_IN + (size_t)3840 * 1024 * 2;
constexpr size_t W_G8 = W_CAT;
constexpr size_t W_BR = W_CAT + (size_t)3 * 1024 * 1024;
constexpr float G8_SCALE = 128.0f;
constexpr size_t W_OUT = W_CAT + (size_t)3 * 1024 * 1536 * 2;
constexpr size_t W_GU = W_OUT + (size_t)1024 * 1024 * 2;
constexpr size_t W_D = W_GU + (size_t)16 * 512 * 1024 * 2;
constexpr size_t W_RH = W_D + (size_t)16 * 1024 * 256 * 2;
constexpr size_t W_RL = W_RH + 65536;
constexpr size_t W_ENDB = W_RL + 65536;
static_assert(WS_W + W_ENDB <= WS_SSB && WS_SSB + MiB <= WS_WPLE, "weight map");
constexpr size_t W_PG = 0, W_P = (size_t)1024 * 1024 * 2, WPLE_STRIDE = (size_t)5 * 512 * 1024;
constexpr size_t OUT_XB8 = 0, OUT_GATES = 16 * MiB;
constexpr size_t OV_PB = WS_PB;
constexpr size_t OV_PW = WS_PROJ + 8 * MiB;
constexpr size_t OV_ACT = WS_PROJ + 40 * MiB;
constexpr size_t OV_XB2 = WS_PROJ + 64 * MiB;
constexpr int RING_BYTES = 131072, MISC_OFF = RING_BYTES, LDS_BYTES = 147456;
constexpr int MI_N = 0, MI_BASE = 32, MI_U0 = 64, MI_TOT = 96, MI_Q = 100, MI_BAR = 104;

__device__ __forceinline__ unsigned pk2(float lo, float hi) { typedef float f2 __attribute__((ext_vector_type(2))); typedef __bf16 b2 __attribute__((ext_vector_type(2))); f2 v = {lo, hi}; b2 b = __builtin_convertvector(v, b2); return __builtin_bit_cast(unsigned, b); }
__device__ __forceinline__ float bflo(unsigned u) { return __uint_as_float(u << 16); }
__device__ __forceinline__ float bfhi(unsigned u) { return __uint_as_float(u & 0xffff0000u); }
__device__ __forceinline__ float sigm(float v) { return __builtin_amdgcn_rcpf(1.0f + __expf(-v)); }
__device__ __forceinline__ float sg2(float t) { return __builtin_amdgcn_rcpf(1.0f + __builtin_amdgcn_exp2f(t)); }
__device__ __forceinline__ float clamp8(float v) { return __builtin_amdgcn_fmed3f(v, -448.0f, 448.0f); }
__device__ __forceinline__ unsigned pk_fp8x4(float a, float b, float c, float d) {
    int w = __builtin_amdgcn_cvt_pk_fp8_f32(clamp8(a), clamp8(b), 0, false); w = __builtin_amdgcn_cvt_pk_fp8_f32(clamp8(c), clamp8(d), w, true); return (unsigned)w; }

#define XOR1(v) __int_as_float(__builtin_amdgcn_ds_swizzle(__float_as_int(v), 0x041f))
#define XOR2(v) __int_as_float(__builtin_amdgcn_ds_swizzle(__float_as_int(v), 0x081f))
#define XOR4(v) __int_as_float(__builtin_amdgcn_ds_swizzle(__float_as_int(v), 0x101f))
#define XOR8(v) __int_as_float(__builtin_amdgcn_ds_swizzle(__float_as_int(v), 0x201f))
#define XOR16(v) __int_as_float(__builtin_amdgcn_ds_swizzle(__float_as_int(v), 0x401f))
__device__ __forceinline__ float add_xor32(float v) { const auto r = __builtin_amdgcn_permlane32_swap(__float_as_uint(v), __float_as_uint(v), false, false); return __uint_as_float(r[0]) + __uint_as_float(r[1]); }
__device__ __forceinline__ float wave_sum64(float v) { v += XOR1(v); v += XOR2(v); v += XOR4(v); v += XOR8(v); v += XOR16(v); return add_xor32(v); }
__device__ __forceinline__ int mk_tid(int wave0) { int l; asm volatile("v_mbcnt_lo_u32_b32 %0, -1, 0\n\tv_mbcnt_hi_u32_b32 %0, -1, %0" : "=v"(l)); return wave0 * 64 + l; }

#define XB_TMO      128
#define XB_XCNT(j)  (256  + 64 * (j))
#define XB_XSUB(j)  (1280 + 64 * (j))
#define XB_XGEN(j)  (2304 + 64 * (j))
#define XB_TOP      3328
#define XB_TOPGEN   3392
#define XCD_BAR_WORDS 3456
#define XB_SPIN_CAP (1u << 18)
__device__ __forceinline__ unsigned xb_ld(unsigned* p)              { return __hip_atomic_load(p, __ATOMIC_RELAXED, __HIP_MEMORY_SCOPE_AGENT); }
__device__ __forceinline__ unsigned xb_add(unsigned* p, unsigned v) { return __hip_atomic_fetch_add(p, v, __ATOMIC_RELAXED, __HIP_MEMORY_SCOPE_AGENT); }
__device__ __forceinline__ unsigned xb_xcc_id() { return (unsigned)__builtin_amdgcn_s_getreg((3 << 11) | 20) & 0xFu; }
#define XB_SPIN(cond, bar) do { unsigned _sp = 0; while (cond) { __builtin_amdgcn_s_sleep(1); \
    if ((++_sp & 255u) == 0u) { if (xb_ld(&(bar)[XB_TMO])) break; if (_sp > XB_SPIN_CAP) { atomicAdd(&(bar)[XB_TMO], 1u); break; } } } } while (0)
struct XcdBarrier { unsigned* bar; unsigned x; volatile LAS unsigned* st; };
__device__ __forceinline__ XcdBarrier xcd_barrier_post(unsigned* bar, volatile LAS unsigned* st, int tid) {
    XcdBarrier b; b.bar = bar; b.x = xb_xcc_id(); b.st = st;
    if (tid == 0) (void)xb_add(&bar[XB_XCNT(b.x)], 1u);
    return b;
}
__device__ __forceinline__ void xcd_barrier_complete(unsigned* bar, unsigned x, unsigned& nloc, unsigned& nx) {
    const unsigned G = gridDim.x * gridDim.y * gridDim.z;
    unsigned sum, cnt, mine, sp = 0u;
    for (;;) {
        sum = 0u; cnt = 0u; mine = 0u;
#pragma unroll
        for (unsigned j = 0; j < 16; ++j) { const unsigned c = xb_ld(&bar[XB_XCNT(j)]); sum += c; cnt += (c > 0u) ? 1u : 0u; mine = (j == x) ? c : mine; }
        if (sum == G) break;
        __builtin_amdgcn_s_sleep(1);
        if ((++sp & 255u) == 0u) { if (xb_ld(&bar[XB_TMO])) break; if (sp > XB_SPIN_CAP) { atomicAdd(&bar[XB_TMO], 1u); break; } }
    }
    nloc = mine > 0u ? mine : 1u; nx = cnt > 0u ? cnt : 1u;
}
#ifndef MK_EARLYINV
#define MK_EARLYINV 1
#endif
#ifndef MK_SPLIT_SLEEP
#define MK_SPLIT_SLEEP 16
#endif
__device__ __forceinline__ void xcd_barrier(const XcdBarrier& b, int tid) {
    asm volatile("s_waitcnt vmcnt(0)" ::: "memory");
    __syncthreads();
    if (tid == 0) {
        unsigned* bar = b.bar;
        __builtin_amdgcn_s_waitcnt(0);
        unsigned nloc = b.st[0], nx = b.st[1];
        if (nloc == 0u) { xcd_barrier_complete(bar, b.x, nloc, nx); b.st[0] = nloc; b.st[1] = nx; }
        const unsigned old = xb_add(&bar[XB_XSUB(b.x)], 1u);
        const unsigned gen = old / nloc;
        if (old + 1u == (gen + 1u) * nloc) {
            __builtin_amdgcn_fence(__ATOMIC_RELEASE, "agent");
            asm volatile("s_waitcnt vmcnt(0)" ::: "memory");
            const unsigned og = xb_add(&bar[XB_TOP], 1u);
            unsigned tg = og / nx; asm volatile("" : "+v"(tg) :: "memory");
            if (og + 1u == (tg + 1u) * nx) { xb_add(&bar[XB_TOPGEN], 1u);
#if MK_EARLYINV
                xb_add(&bar[XB_XGEN(b.x)], 1u); asm volatile("buffer_inv sc1" ::: "memory");
#endif
            } else {
#if MK_EARLYINV
                asm volatile("buffer_inv sc1" ::: "memory");
#endif
                XB_SPIN(xb_ld(&bar[XB_TOPGEN]) == tg, bar);
#if MK_EARLYINV
                xb_add(&bar[XB_XGEN(b.x)], 1u);
#endif
            }
#if !MK_EARLYINV
            __builtin_amdgcn_fence(__ATOMIC_ACQUIRE, "agent");
            xb_add(&bar[XB_XGEN(b.x)], 1u);
#endif
            asm volatile("s_waitcnt vmcnt(0)" ::: "memory");
        } else {
#if MK_EARLYINV
            { unsigned g2 = gen; asm volatile("" : "+v"(g2) :: "memory"); asm volatile("buffer_inv sc1" ::: "memory");
              XB_SPIN(xb_ld(&bar[XB_XGEN(b.x)]) == g2, bar); }
#else
            XB_SPIN(xb_ld(&bar[XB_XGEN(b.x)]) == gen, bar);
            __builtin_amdgcn_fence(__ATOMIC_ACQUIRE, "agent");
#endif
            asm volatile("s_waitcnt vmcnt(0)" ::: "memory");
        }
    }
    __syncthreads();
}

__device__ __forceinline__ void split_arrive(unsigned* cnt, int tid) {
    asm volatile("s_waitcnt vmcnt(0)" ::: "memory"); __syncthreads();
    if (tid == 0) { __builtin_amdgcn_fence(__ATOMIC_RELEASE, "agent"); asm volatile("s_waitcnt vmcnt(0)" ::: "memory"); xb_add(cnt, 1u); }
}
__device__ __forceinline__ void split_arrive_x(const XcdBarrier& b, unsigned* cnt_top, unsigned* cnt_x, int tid) {
    asm volatile("s_waitcnt vmcnt(0)" ::: "memory"); __syncthreads();
    if (tid == 0) { const unsigned nloc = b.st[0]; const unsigned old = xb_add(cnt_x + 8u * b.x, 1u);
        if (old + 1u == nloc) { __builtin_amdgcn_fence(__ATOMIC_RELEASE, "agent"); asm volatile("s_waitcnt vmcnt(0)" ::: "memory"); xb_add(cnt_top, nloc); }
#if MK_EARLYINV
        asm volatile("buffer_inv sc1" ::: "memory");
#endif
    }
}
__device__ __forceinline__ void split_wait_leader(unsigned* cnt, unsigned target) {
    unsigned sp = 0; while (xb_ld(cnt) < target) { __builtin_amdgcn_s_sleep(MK_SPLIT_SLEEP); if (++sp > (1u << 22)) break; }
#if !MK_EARLYINV
    __builtin_amdgcn_fence(__ATOMIC_ACQUIRE, "agent");
#endif
    asm volatile("s_waitcnt vmcnt(0)" ::: "memory");
}

__device__ __forceinline__ void group4_sync(unsigned* gc, int tid) {
    asm volatile("s_waitcnt vmcnt(0)" ::: "memory"); __syncthreads();
    if (tid == 0) { const unsigned sh = 8u + 3u * xb_xcc_id();
        xb_add(gc, 1u + (1u << sh));
        asm volatile("buffer_inv sc1" ::: "memory");
        unsigned sp = 0, v = 0; for (;;) { v = xb_ld(gc); if ((v & 0xffu) >= 4u) break; __builtin_amdgcn_s_sleep(1); if (++sp > (1u << 22)) break; }
        if (((v >> sh) & 7u) != 4u) {
            __builtin_amdgcn_fence(__ATOMIC_RELEASE, "agent"); asm volatile("s_waitcnt vmcnt(0)" ::: "memory");
            xb_add(gc + 16, 1u); sp = 0; while (xb_ld(gc + 16) < 4u) { __builtin_amdgcn_s_sleep(1); if (++sp > (1u << 22)) break; }
            __builtin_amdgcn_fence(__ATOMIC_ACQUIRE, "agent"); }
        asm volatile("s_waitcnt vmcnt(0)" ::: "memory"); }
    __syncthreads();
}

struct Args { const void* in[27]; float* out; unsigned char* ws; int ph_lo, ph_hi, li, pad; };
struct LayerW {
    const float *g_attn, *w_in, *pool_w, *pool_scale, *dqn, *dkn, *dlam, *dsub, *fqn, *fkn, *ffb, *w_branch, *w_out, *g_ffn, *wrg, *brg, *wre, *bre, *wg, *wu, *wd, *g_ple, *wpg, *wple, *p;
};
__device__ __forceinline__ LayerW layer_view(const __attribute__((address_space(4))) Args* a, int l) {
    LayerW w; const float* in[27];
#pragma unroll
    for (int i = 0; i < 27; ++i) in[i] = (const float*)a->in[i];
    w.g_attn = in[3] + l * 1024; w.w_in = in[4] + (size_t)l * 1024 * INW; w.pool_w = in[5] + (size_t)l * 65536; w.pool_scale = in[6] + l * 512;
    w.dqn = in[7] + l * 64; w.dkn = in[8] + l * 64; w.dlam = in[9] + l * 256; w.dsub = in[10] + l * 128; w.fqn = in[11] + l * 64; w.fkn = in[12] + l * 64; w.ffb = in[13] + l * 8;
    w.w_branch = in[14] + (size_t)l * 3 * 512 * 1024; w.w_out = in[15] + (size_t)l * 1024 * 1024; w.g_ffn = in[16] + l * 1024; w.wrg = in[17] + (size_t)l * 4096; w.brg = in[18] + l * 4;
    w.wre = in[19] + (size_t)l * 16384; w.bre = in[20] + l * 16; w.wg = in[21] + (size_t)l * 16 * 262144; w.wu = in[22] + (size_t)l * 16 * 262144; w.wd = in[23] + (size_t)l * 16 * 262144;
    w.g_ple = in[24] + l * 1024; w.wpg = in[25] + (size_t)l * 1024 * 1024; w.wple = in[26] + (size_t)l * 256 * 1024; w.p = in[1] + (size_t)l * T * 256;
    return w;
}

__device__ __forceinline__ void tr_item(const float* __restrict__ src, int ldsrc, int c0, int nvalid, int k0, const float* __restrict__ gk, bf16* dst, int dpitch, int nrow0, int dk0, LAS float* scr, int lane, const bool f8 = false) {
    float vv[32];
#pragma unroll
    for (int i = 0; i < 32; ++i) { const int kk = 2 * i + (lane >> 5), c = lane & 31; vv[i] = (c < nvalid) ? src[(size_t)(k0 + kk) * ldsrc + c0 + c] : 0.f; }
    if (gk) {
#pragma unroll
        for (int i = 0; i < 32; ++i) vv[i] *= gk[k0 + 2 * i + (lane >> 5)]; }
#pragma unroll
    for (int i = 0; i < 32; ++i) scr[(2 * i + (lane >> 5)) * 33 + (lane & 31)] = vv[i];
    LDS_WAIT(); asm volatile("" ::: "memory");
    const int c8 = lane & 7;
#pragma unroll
    for (int j = 0; j < 4; ++j) { const int n = (lane >> 3) + 8 * j; const LAS float* s = scr + (8 * c8) * 33 + n;
        if (f8) { typedef unsigned v2u_ __attribute__((ext_vector_type(2))); v2u_ o;
            o.x = pk_fp8x4(s[0 * 33] * G8_SCALE, s[1 * 33] * G8_SCALE, s[2 * 33] * G8_SCALE, s[3 * 33] * G8_SCALE); o.y = pk_fp8x4(s[4 * 33] * G8_SCALE, s[5 * 33] * G8_SCALE, s[6 * 33] * G8_SCALE, s[7 * 33] * G8_SCALE);
            *(GAS v2u_*)((GAS char*)dst + (size_t)(nrow0 + n) * dpitch + dk0 + 8 * c8) = o; }
        else { v4u o; o.x = pk2(s[0 * 33], s[1 * 33]); o.y = pk2(s[2 * 33], s[3 * 33]); o.z = pk2(s[4 * 33], s[5 * 33]); o.w = pk2(s[6 * 33], s[7 * 33]);
            *(GAS v4u*)(dst + (size_t)(nrow0 + n) * dpitch + dk0 + 8 * c8) = o; } }
    LDS_WAIT(); asm volatile("" ::: "memory");
}
constexpr int CV_EARLY = 1536 + 128 + 1536 + 768, CV_NIT = CV_EARLY + 512 + 4096 + 2048 + 512 + 128, CV_LATE_BATCHES = (CV_NIT - CV_EARLY + 7) / 8, CV_RT_BATCHES = 64, CV_PB_BATCHES = 64;
__device__ __forceinline__ void conv_item(const LayerW& w, unsigned char* ws, int l, int it, LAS float* scr, int lane) {
    bf16* Wb = (bf16*)(ws + WS_W); bf16* WIN = (bf16*)(ws + WS_W + W_IN); bf16* WOUT = (bf16*)(ws + WS_W + W_OUT);
    bf16* WGU = (bf16*)(ws + WS_W + W_GU); bf16* WDN = (bf16*)(ws + WS_W + W_D); bf16* WPG = (bf16*)(ws + WS_WPLE + l * WPLE_STRIDE + W_PG); bf16* WP = (bf16*)(ws + WS_WPLE + l * WPLE_STRIDE + W_P);
    (void)Wb;
    constexpr int I_A = 1536, I_B = 128, I_D1 = 1536, I_D2 = 768, I_E = 512, I_F = 4096, I_G = 2048, I_H1 = 512, I_H2 = 128;
    constexpr int NIT = I_A + I_B + I_D1 + I_D2 + I_E + I_F + I_G + I_H1 + I_H2;
    int r = it;
        if (r < I_A) { const int kb = r / 96, nb = r % 96, p0 = 512 + 32 * nb, pn = p0 >> 8, q0 = p0 & 255;
            const bool head = (pn >= 2 && pn <= 5) || (pn >= 8 && pn <= 11);
            const int c0 = head ? (256 * pn + 64 * ((q0 >> 5) & 3) + 32 * (q0 >> 7)) : p0;
            tr_item(w.w_in, INW, c0, 32, 64 * kb, w.g_attn, WIN, 1024, p0, 64 * kb, scr, lane); return; } r -= I_A;
        if (r < I_B) { const int kb = r / 8, nb = r % 8; tr_item(w.w_in, INW, 3584, nb == 0 ? 8 : 0, 64 * kb, w.g_attn, WIN, 1024, 3584 + 32 * nb, 64 * kb, scr, lane); return; } r -= I_B;
        if (r < I_D1) { const int n = r / 512, r2 = r % 512, kb = r2 / 32, nb = r2 % 32;
            tr_item(w.w_in, INW, 3592 + n * 1024 + 32 * nb, 32, 64 * kb, w.g_attn, (bf16*)(ws + WS_W + W_G8 + (size_t)n * 1024 * 1024), 1024, 32 * nb, 64 * kb, scr, lane, true); return; } r -= I_D1;
        if (r < I_D2) { const int n = r / 256, r2 = r % 256, kb = r2 / 32, nb = r2 % 32;
            tr_item(w.w_branch + (size_t)n * 512 * 1024, 1024, 32 * nb, 32, 64 * kb, nullptr, (bf16*)(ws + WS_W + W_BR) + (size_t)n * 1024 * 512, 512, 32 * nb, 64 * kb, scr, lane); return; } r -= I_D2;
        if (r < I_E) { const int kb = r / 32, nb = r % 32; tr_item(w.w_out, 1024, 32 * nb, 32, 64 * kb, nullptr, WOUT, 1024, 32 * nb, 64 * kb, scr, lane); return; } r -= I_E;
        if (r < I_F) { const int e = r / 256, r1 = r % 256, hf = r1 / 128, r2 = r1 % 128, kb = r2 / 8, nb = r2 % 8, q0 = 32 * nb;
            const float* src = ((q0 >> 7) ? w.wu : w.wg) + (size_t)e * 262144;
            const bool f8 = MK_MU8 && l == NL - 1;
            tr_item(src, 256, 128 * hf + (q0 & 127), 32, 64 * kb, w.g_ffn, f8 ? (bf16*)((unsigned char*)WGU + (size_t)(e * 2 + hf) * 256 * 1024) : WGU + (size_t)(e * 2 + hf) * 256 * 1024, 1024, q0, 64 * kb, scr, lane, f8); return; } r -= I_F;
        if (r < I_G) { const int e = r / 128, r2 = r % 128, kb = r2 / 32, nb = r2 % 32;
            tr_item(w.wd + (size_t)e * 262144, 1024, 32 * nb, 32, 64 * kb, nullptr, WDN + (size_t)e * 262144, 256, 32 * nb, 64 * kb, scr, lane); return; } r -= I_G;
        if (r < I_H1) { const int kb = r / 32, nb = r % 32; tr_item(w.wpg, 1024, 32 * nb, 32, 64 * kb, w.g_ple, WPG, 1024, 32 * nb, 64 * kb, scr, lane, MK_PLE8 != 0); return; } r -= I_H1;
        { const int kb = r / 32, nb = r % 32; tr_item(w.wple, 1024, 32 * nb, 32, 64 * kb, nullptr, WP, 256, 32 * nb, 64 * kb, scr, lane); }
}
__device__ __forceinline__ void conv_late_batch(const LayerW& w, unsigned char* ws, int l, LAS unsigned char* lds, int batch, int tid) {
    const int lane = tid & 63, wave = __builtin_amdgcn_readfirstlane(tid >> 6);
    if (batch < CV_LATE_BATCHES) { const int it = CV_EARLY + batch * 8 + wave; if (it < CV_NIT) conv_item(w, ws, l, it, (LAS float*)(lds + wave * 16384), lane); }
    else if (batch >= CV_LATE_BATCHES + CV_RT_BATCHES) {
        const int i0 = (batch - CV_LATE_BATCHES - CV_RT_BATCHES) * 8192 + tid; GAS v4u* PB = (GAS v4u*)(ws + OV_PB);
#pragma clang loop unroll(disable)
        for (int q0 = 0; q0 < 16; q0 += 4) { f32x4 a[4], b[4];
#pragma unroll
            for (int q = 0; q < 4; ++q) { const GAS f32x4* s = (const GAS f32x4*)(w.p) + 2 * (size_t)(i0 + (q0 + q) * 512); a[q] = s[0]; b[q] = s[1]; }
#pragma unroll
            for (int q = 0; q < 4; ++q) { v4u o; o.x = pk2(a[q].x, a[q].y); o.y = pk2(a[q].z, a[q].w); o.z = pk2(b[q].x, b[q].y); o.w = pk2(b[q].z, b[q].w); PB[i0 + (q0 + q) * 512] = o; } } }
    else { const int idx = (batch - CV_LATE_BATCHES) * 512 + tid; const int e = idx >> 10, k = idx & 1023;
        const float v = w.g_ffn[k] * (e < 4 ? w.wrg[k * 4 + e] : (e < 20 ? w.wre[k * 16 + e - 4] : 0.f));
        const unsigned hi = pk2(v, 0.f) & 0xffffu; const unsigned lo = pk2(v - bflo(hi), 0.f) & 0xffffu;
        ((bf16*)(ws + WS_W + W_RH))[idx] = (bf16)hi; ((bf16*)(ws + WS_W + W_RL))[idx] = (bf16)lo; }
}
__device__ __forceinline__ void weff_job(const LayerW& w, unsigned char* ws, LAS unsigned char* lds, int job, int tid) {
    bf16* WIN = (bf16*)(ws + WS_W + W_IN);
    LAS float* Wt = (LAS float*)lds; LAS float* Pw = (LAS float*)(lds + 36864);
    const int kb = job >> 4, g = (job >> 2) & 3, nq = job & 3, k0 = 64 * kb;
    for (int e = tid; e < 64 * 128; e += 512) { const int kk = e >> 7, c = e & 127; Wt[kk * 132 + c] = w.w_in[(size_t)(k0 + kk) * INW + 128 * g + c]; }
    for (int e = tid; e < 128 * 32; e += 512) { const int c = e >> 5, n = e & 31; Pw[c * 32 + n] = w.pool_w[(size_t)g * 16384 + c * 128 + 32 * nq + n]; }
    __syncthreads();
    const int n = tid & 31, ks = tid >> 5; float a[4] = {0.f, 0.f, 0.f, 0.f};
#pragma unroll 2
    for (int c = 0; c < 128; c += 4) {
        const float p0 = Pw[c * 32 + n], p1 = Pw[(c + 1) * 32 + n], p2 = Pw[(c + 2) * 32 + n], p3 = Pw[(c + 3) * 32 + n];
#pragma unroll
        for (int i = 0; i < 4; ++i) { const f32x4 w4 = *(const LAS f32x4*)(Wt + (ks * 4 + i) * 132 + c); a[i] += (w4.x * p0 + w4.y * p1) + (w4.z * p2 + w4.w * p3); } }
    const float sc = w.pool_scale[128 * g + 32 * nq + n];
#pragma unroll
    for (int i = 0; i < 4; ++i) a[i] *= sc * w.g_attn[k0 + ks * 4 + i];
    *(GAS unsigned long long*)(WIN + (size_t)(128 * g + 32 * nq + n) * 1024 + k0 + ks * 4) = (unsigned long long)pk2(a[0], a[1]) | ((unsigned long long)pk2(a[2], a[3]) << 32);
    __syncthreads();
}
__device__ __forceinline__ void conv_layer(const LayerW& w, unsigned char* ws, int l, LAS unsigned char* lds, int vcu, int G, int tid) {
    const int lane = tid & 63, wave = __builtin_amdgcn_readfirstlane(tid >> 6);
    LAS float* scr = (LAS float*)(lds + wave * 16384);
    const int gw = vcu * NWAVES + wave, NGW = G * NWAVES;
    for (int it = gw; it < CV_EARLY; it += NGW) conv_item(w, ws, l, it, scr, lane);
    __syncthreads();
    for (int job = vcu; job < 256; job += G) weff_job(w, ws, lds, job, tid);
}
constexpr int CV_EARLY_BATCHES = CV_EARLY / 8 + 256;
__device__ __forceinline__ void conv_early_batch(const LayerW& w, unsigned char* ws, int l, LAS unsigned char* lds, int batch, int tid) {
    const int lane = tid & 63, wave = __builtin_amdgcn_readfirstlane(tid >> 6);
    if (batch < CV_EARLY / 8) { conv_item(w, ws, l, batch * 8 + wave, (LAS float*)(lds + wave * 16384), lane); __syncthreads(); }
    else weff_job(w, ws, lds, batch - CV_EARLY / 8, tid);
}
__device__ __forceinline__ void p0_x(const float* x, const int* positions, unsigned char* ws, unsigned char* x8, int vcu, int G, int tid) {
    const int lane = tid & 63, wave = __builtin_amdgcn_readfirstlane(tid >> 6);
    bf16* XY = (bf16*)(ws + WS_XY); float* SS = (float*)(ws + WS_SS); float* CS = (float*)(ws + WS_COSSIN);
    const int gw = vcu * NWAVES + wave, NGW = G * NWAVES;
    for (int t = gw; t < T; t += NGW) {
        const GAS f32x4* xr = (const GAS f32x4*)(x + (size_t)t * 1024) + lane; float s = 0.f;
        GAS unsigned long long* o8 = (GAS unsigned long long*)(XY + (size_t)t * XYP + 1536) + lane;
#pragma unroll
        for (int j = 0; j < 4; ++j) { const f32x4 v = xr[64 * j]; s += (v.x * v.x + v.y * v.y) + (v.z * v.z + v.w * v.w); o8[64 * j] = (unsigned long long)pk2(v.x, v.y) | ((unsigned long long)pk2(v.z, v.w) << 32);
            ((GAS unsigned*)(x8 + (size_t)t * 1024))[lane + 64 * j] = pk_fp8x4(v.x, v.y, v.z, v.w); }
        s = wave_sum64(s);
        if (lane < 16) SS[(size_t)t * 16 + lane] = lane == 0 ? s : 0.f;
    }
    for (int idx = vcu * 512 + tid; idx < T * 8; idx += G * 512) { const int t = idx >> 3, i = idx & 7;
        const float invf = powf(500000.0f, -(float)(2 * i) / 16.0f); const float ang = (float)positions[t] * invf;
        CS[(size_t)t * 16 + i] = cosf(ang); CS[(size_t)t * 16 + 8 + i] = sinf(ang); }
}

typedef pg8::f32x4 (&AccRef)[2][2][4][2];
#define LAUNDER3(a, b, c) asm volatile("" : "+v"(a), "+v"(b), "+v"(c))
__device__ __forceinline__ float rstd_at(const float* SS, unsigned row) {
    const GAS f32x4* p = (const GAS f32x4*)((const GAS char*)SS + row * 64u); const f32x4 a = p[0], b = p[1], c = p[2], d = p[3];
    const float s = ((a.x + a.y) + (a.z + a.w)) + ((b.x + b.y) + (b.z + b.w)) + ((c.x + c.y) + (c.z + c.w)) + ((d.x + d.y) + (d.z + d.w));
    return rsqrtf(s * (1.0f / 1024.0f) + RMS_EPS);
}
__device__ __forceinline__ void rstd8(const float* SS, unsigned row0, int fq, float (&rs)[8]) {
    f32x4 v[8];
#pragma unroll
    for (int i = 0; i < 8; ++i) v[i] = *(const GAS f32x4*)((const GAS char*)SS + ((row0 + (unsigned)((i >> 2) * 128 + (i & 3) * 16)) * 64u + (unsigned)fq * 16u));
#pragma unroll
    for (int i = 0; i < 8; ++i) { float s = (v[i].x + v[i].y) + (v[i].z + v[i].w); s += XOR16(s); s = add_xor32(s); rs[i] = rsqrtf(s * (1.0f / 1024.0f) + RMS_EPS); }
}
__device__ __forceinline__ float logsig(float z) { return fminf(z, 0.f) - log1pf(expf(-fabsf(z))); }
struct EpiG1 {
    const float* SS; bf16* PROJ; float* LOGF; const float* CS; const float* GT; const float* ffb; int dry; const LAS float* rsl;
    __device__ __forceinline__ void operator()(AccRef acc, const pg8::Step& st, int wr, int wc, int fr_, int fq_) const {
        if (dry) return;
        int fr = fr_, fq = fq_, zz = 0; LAUNDER3(fr, fq, zz);
        const int pn = st.pn; const unsigned row0 = (unsigned)(st.pm * 256 + wr * 64 + fr);
#define RSL8(dst_) do { _Pragma("unroll") for (int i_ = 0; i_ < 8; ++i_) dst_[i_] = rsl[st.aux * 256 + (i_ >> 2) * 128 + wr * 64 + (i_ & 3) * 16 + fr]; } while (0)
        const bool head = (pn >= 2 && pn <= 5) || (pn >= 8 && pn <= 11);
        if (head) {
            const float* gain = GT + 64 * (pn < 4 ? 0 : (pn < 6 ? 1 : (pn < 10 ? 2 : 3)));
            const bool rot = pn < 6; const float osc = (pn < 4 || (pn >= 8 && pn < 10)) ? C2 : 1.0f;
            f32x4 G[2][2];
#pragma unroll
            for (int bj = 0; bj < 2; ++bj)
#pragma unroll
                for (int n = 0; n < 2; ++n) G[bj][n] = *(const GAS f32x4*)((const GAS char*)gain + (unsigned)(32 * bj + 8 * fq + 4 * n) * 4u);
            const GAS char* pb = (const GAS char*)PROJ + (unsigned)(256 * pn + 64 * wc) * 2u;
            float rs8[8]; RSL8(rs8);
            f32x4 cs[4];
#define G1_LOADCS(i_) do { if (rot && fq < 2) { const GAS f32x4* cp_ = (const GAS f32x4*)((const GAS char*)CS + (row0 + (unsigned)(((i_) >> 2) * 128 + ((i_) & 3) * 16)) * 64u); \
                _Pragma("unroll") for (int q_ = 0; q_ < 4; ++q_) cs[q_] = cp_[q_]; } } while (0)
            G1_LOADCS(0);
#pragma unroll
            for (int i = 0; i < 8; ++i) {
                v4u ov[2];
                {
                    const int ai = i >> 2, m = i & 3; const float rs = rs8[i];
                    f32x4 v[2][2]; float ss = 0.f;
#pragma unroll
                    for (int bj = 0; bj < 2; ++bj)
#pragma unroll
                        for (int n = 0; n < 2; ++n) { v[bj][n] = acc[ai][bj][m][n]; const f32x4 q = v[bj][n] * v[bj][n]; ss += (q.x + q.y) + (q.z + q.w); }
                    ss += XOR16(ss); ss = add_xor32(ss);
                    const float hn = rsqrtf(ss * (1.0f / 64.0f) + RMS_EPS * __builtin_amdgcn_rcpf(rs * rs)) * osc;
#pragma unroll
                    for (int bj = 0; bj < 2; ++bj)
#pragma unroll
                        for (int n = 0; n < 2; ++n) v[bj][n] = v[bj][n] * hn * G[bj][n];
                    if (rot) {
                        f32x4 ot[2];
#pragma unroll
                        for (int n = 0; n < 2; ++n) { ot[n].x = XOR16(v[0][n].x); ot[n].y = XOR16(v[0][n].y); ot[n].z = XOR16(v[0][n].z); ot[n].w = XOR16(v[0][n].w); }
                        if (fq < 2) {
#pragma unroll
                            for (int n = 0; n < 2; ++n) { const f32x4 c = cs[n], s = cs[2 + n]; v[0][n] = (fq == 0) ? (v[0][n] * c - ot[n] * s) : (v[0][n] * c + ot[n] * s); }
                        }
                    }
#pragma unroll
                    for (int bj = 0; bj < 2; ++bj) { ov[bj].x = pk2(v[bj][0].x, v[bj][0].y); ov[bj].y = pk2(v[bj][0].z, v[bj][0].w); ov[bj].z = pk2(v[bj][1].x, v[bj][1].y); ov[bj].w = pk2(v[bj][1].z, v[bj][1].w); }
                }
                if (i < 7) G1_LOADCS(i + 1);
                asm volatile("" ::: "memory");
                { const unsigned row = row0 + (unsigned)((i >> 2) * 128 + (i & 3) * 16);
#pragma unroll
                    for (int bj = 0; bj < 2; ++bj) *(GAS v4u*)(pb + (row * (unsigned)(PJP * 2) + (unsigned)(32 * bj + 8 * fq) * 2u)) = ov[bj]; }
                asm volatile("" ::: "memory");
            }
#undef G1_LOADCS
        } else if (pn == 14) {
            float rs14[8]; RSL8(rs14);
            if (wc == 0 && fq == 0) {
                const f32x4 b0 = *(const GAS f32x4*)ffb, b1 = *(const GAS f32x4*)(ffb + 4);
#pragma unroll
                for (int ai = 0; ai < 2; ++ai)
#pragma unroll
                    for (int m = 0; m < 4; ++m) {
                        const unsigned row = row0 + ai * 128 + m * 16; const float rs = rs14[ai * 4 + m];
                        const f32x4 z0 = acc[ai][0][m][0] * rs + b0, z1 = acc[ai][0][m][1] * rs + b1; f32x4 o0, o1;
                        o0.x = logsig(z0.x); o0.y = logsig(z0.y); o0.z = logsig(z0.z); o0.w = logsig(z0.w); o1.x = logsig(z1.x); o1.y = logsig(z1.y); o1.z = logsig(z1.z); o1.w = logsig(z1.w);
                        GAS f32x4* d = (GAS f32x4*)((GAS char*)LOGF + row * 32u); d[0] = o0; d[1] = o1;
                    }
            }
        } else {
            const GAS char* pb = (const GAS char*)PROJ + (unsigned)(256 * pn + 32 * wc) * 2u;
            float rsp[8]; RSL8(rsp);
#pragma unroll
            for (int ai = 0; ai < 2; ++ai)
#pragma unroll
                for (int m = 0; m < 4; ++m) {
                    const unsigned row = row0 + ai * 128 + m * 16; const float rs = rsp[ai * 4 + m];
#pragma unroll
                    for (int bj = 0; bj < 2; ++bj) { const f32x4 a = acc[ai][bj][m][0] * rs, b = acc[ai][bj][m][1] * rs; v4u o; o.x = pk2(a.x, a.y); o.y = pk2(a.z, a.w); o.z = pk2(b.x, b.y); o.w = pk2(b.z, b.w);
                        *(GAS v4u*)(pb + (row * (unsigned)(PJP * 2) + (unsigned)(128 * bj + 8 * fq) * 2u)) = o; }
                }
        }
    }
};
typedef unsigned v2u __attribute__((ext_vector_type(2)));
__device__ __forceinline__ unsigned pk8(float a, float b, float c, float d) {
    unsigned w = __builtin_amdgcn_cvt_pk_u8_f32(a * 256.0f - 0.5f, 0u, 0u); w = __builtin_amdgcn_cvt_pk_u8_f32(b * 256.0f - 0.5f, 1u, w); w = __builtin_amdgcn_cvt_pk_u8_f32(c * 256.0f - 0.5f, 2u, w); return __builtin_amdgcn_cvt_pk_u8_f32(d * 256.0f - 0.5f, 3u, w); }
__device__ __forceinline__ float g8(unsigned w, const int k) { return ((float)((w >> (8 * k)) & 0xffu) + 0.5f) * (1.0f / 256.0f); }
__device__ __forceinline__ float g8u(unsigned w, const int k) { return (float)((w >> (8 * k)) & 0xffu) + 0.5f; }
#undef RSL8
template <int PART>
struct EpiG2 {
    const float* SS; unsigned char* gs; bf16* MERGED; const LAS float* rsl;
    __device__ __forceinline__ void operator()(AccRef acc, const pg8::Step& st, int wr, int wc, int fr_, int fq_) const {
        int ln; asm volatile("v_mbcnt_lo_u32_b32 %0, -1, 0\n\tv_mbcnt_hi_u32_b32 %0, -1, %0" : "=v"(ln));
        int fr = ln & 15, fq = ln >> 4, tid = (wr * 4 + wc) * 64 + ln; LAUNDER3(fr, fq, tid); (void)fr_; (void)fq_;
        const int aux = st.aux; const unsigned row0 = (unsigned)(st.pm * 256 + wr * 64 + fr), toff = (unsigned)tid * 8u;
        const int n = aux < 3 ? aux : aux - 3; GAS char* gb = (GAS char*)gs + (size_t)n * 65536;
        GAS char* mb = (GAS char*)MERGED + (unsigned)(256 * st.pn + 32 * wc) * 2u;
        float rsg[8];
#pragma unroll
        for (int i = 0; i < 8; ++i) rsg[i] = 0.f;
        if (PART == 0) {
#pragma unroll
            for (int i = 0; i < 8; ++i) rsg[i] = rsl[(i >> 2) * 128 + wr * 64 + (i & 3) * 16 + fr]; }
#pragma unroll
        for (int ai = 0; ai < 2; ++ai) {
            v2u gn[4][2], gd[4][2];
#pragma unroll
            for (int m = 0; m < 4; ++m)
#pragma unroll
                for (int bj = 0; bj < 2; ++bj) { gn[m][bj] = (v2u){0u, 0u}; gd[m][bj] = (v2u){0u, 0u}; }
            if (PART == 1) {
#pragma unroll
                for (int m = 0; m < 4; ++m)
#pragma unroll
                    for (int bj = 0; bj < 2; ++bj) { const unsigned so = toff + (unsigned)(((ai * 4 + m) * 2 + bj) * 4096); gn[m][bj] = *(const GAS v2u*)(gb + so); if (aux < 5) gd[m][bj] = *(const GAS v2u*)(gb + 65536 + so); }
            }
            asm volatile("" ::: "memory");
#pragma unroll
            for (int m = 0; m < 4; ++m) {
                const float rs = rsg[ai * 4 + m] * (1.0f / G8_SCALE);
#pragma unroll
                for (int bj = 0; bj < 2; ++bj) {
                    const unsigned so = toff + (unsigned)(((ai * 4 + m) * 2 + bj) * 4096);
                    const f32x4 a = acc[ai][bj][m][0], b = acc[ai][bj][m][1]; const v2u n_ = gn[m][bj], d_ = gd[m][bj];
                    f32x4 fa = (f32x4){0.f, 0.f, 0.f, 0.f}, fb = fa;
                    if (PART == 0) { const float rsn = rs * -1.4426950408889634f; const f32x4 x = a * rsn, y = b * rsn; v2u o;
                        o.x = pk8(sg2(x.x), sg2(x.y), sg2(x.z), sg2(x.w)); o.y = pk8(sg2(y.x), sg2(y.y), sg2(y.z), sg2(y.w));
                        *(GAS v2u*)(gb + so) = o;
                    } else if (aux < 5) {
                        fa.x = g8u(n_.x, 0) * __builtin_amdgcn_rcpf(g8u(d_.x, 0)); fa.y = g8u(n_.x, 1) * __builtin_amdgcn_rcpf(g8u(d_.x, 1)); fa.z = g8u(n_.x, 2) * __builtin_amdgcn_rcpf(g8u(d_.x, 2)); fa.w = g8u(n_.x, 3) * __builtin_amdgcn_rcpf(g8u(d_.x, 3));
                        fb.x = g8u(n_.y, 0) * __builtin_amdgcn_rcpf(g8u(d_.y, 0)); fb.y = g8u(n_.y, 1) * __builtin_amdgcn_rcpf(g8u(d_.y, 1)); fb.z = g8u(n_.y, 2) * __builtin_amdgcn_rcpf(g8u(d_.y, 2)); fb.w = g8u(n_.y, 3) * __builtin_amdgcn_rcpf(g8u(d_.y, 3));
                    } else { v4u o;
                        o.x = pk2(a.x * g8(n_.x, 0), a.y * g8(n_.x, 1)); o.y = pk2(a.z * g8(n_.x, 2), a.w * g8(n_.x, 3)); o.z = pk2(b.x * g8(n_.y, 0), b.y * g8(n_.y, 1)); o.w = pk2(b.z * g8(n_.y, 2), b.w * g8(n_.y, 3));
                        *(GAS v4u*)(mb + ((row0 + ai * 128 + m * 16) * 2048u + (unsigned)(128 * bj + 8 * fq) * 2u)) = o;
                    }
                    acc[ai][bj][m][0] = a * fa; acc[ai][bj][m][1] = b * fb;
                    asm volatile("" : "+v"(acc[ai][bj][m][0]), "+v"(acc[ai][bj][m][1]));
                }
            }
            asm volatile("" ::: "memory");
        }
    }
};
#ifndef MK_X8
#define MK_X8 1
#endif
template <int KIND, bool SCATTER>
struct EpiRes {
    const bf16* xs; int ldxs; float* xo; bf16* xb; int ldxb; float* SSo; const float* SSi; const bf16* PW; int dry; unsigned char* x8;
    __device__ __forceinline__ void operator()(AccRef acc, const pg8::Step& st, int wr, int wc, int fr_, int fq_) const {
        if (SCATTER && st.aux == 0) return;
        int fr = fr_, fq = fq_, zz = 0; LAUNDER3(fr, fq, zz);
        const int pn = st.pn; const unsigned colb = (unsigned)(256 * pn + 32 * wc + 8 * fq);
        int rowi[8];
#pragma unroll
        for (int i = 0; i < 8; ++i) { const int r = (i >> 2) * 128 + wr * 64 + (i & 3) * 16 + fr; rowi[i] = SCATTER ? ((r < st.nvalid) ? st.rows[r] : -1) : (st.pm * 256 + r); }
        float rs8[8];
#pragma unroll
        for (int i = 0; i < 8; ++i) rs8[i] = 1.f;
        if (KIND == 1) { rstd8(SSi, (unsigned)(st.pm * 256 + wr * 64 + fr), fq, rs8);
            if (MK_PLE8) {
#pragma unroll
                for (int i = 0; i < 8; ++i) rs8[i] *= (1.0f / G8_SCALE); } }
        v4u xin[2][2][2]; v4u pwv[2][2][2];
#define RES_LOAD(p_, buf_) do { _Pragma("unroll") for (int u_ = 0; u_ < 2; ++u_) { const int i_ = 2 * (p_) + u_; const unsigned rw_ = rowi[i_] >= 0 ? (unsigned)rowi[i_] : 0u; \
            _Pragma("unroll") for (int bj_ = 0; bj_ < 2; ++bj_) { xin[buf_][u_][bj_] = *(const GAS v4u*)((const GAS char*)xs + (rw_ * (unsigned)ldxs + colb + 128u * bj_) * 2u); \
                if (KIND == 1) pwv[buf_][u_][bj_] = *(const GAS v4u*)((const GAS char*)PW + (rw_ * 1024u + colb + 128u * bj_) * 2u); } } } while (0)
        RES_LOAD(0, 0);
#pragma unroll
        for (int pr = 0; pr < 4; ++pr) {
            float ssp[2]; f32x4 xr[2][2][2];
#pragma unroll
            for (int u = 0; u < 2; ++u) {
                const int i = 2 * pr + u, ai = i >> 2, m = i & 3; const float rs = rs8[i]; float ss = 0.f;
#pragma unroll
                for (int bj = 0; bj < 2; ++bj) {
                    const v4u xv = xin[pr & 1][u][bj];
                    f32x4 x0 = (f32x4){bflo(xv.x), bfhi(xv.x), bflo(xv.y), bfhi(xv.y)}, x1 = (f32x4){bflo(xv.z), bfhi(xv.z), bflo(xv.w), bfhi(xv.w)};
                    f32x4 a = acc[ai][bj][m][0], b = acc[ai][bj][m][1];
                    if (KIND == 1) { const v4u pw = pwv[pr & 1][u][bj];
                        const float rsn = rs * -1.4426950408889634f;
                        a.x = sg2(a.x * rsn) * bflo(pw.x); a.y = sg2(a.y * rsn) * bfhi(pw.x); a.z = sg2(a.z * rsn) * bflo(pw.y); a.w = sg2(a.w * rsn) * bfhi(pw.y);
                        b.x = sg2(b.x * rsn) * bflo(pw.z); b.y = sg2(b.y * rsn) * bfhi(pw.z); b.z = sg2(b.z * rsn) * bflo(pw.w); b.w = sg2(b.w * rsn) * bfhi(pw.w); }
                    x0 += a; x1 += b;
                    { const f32x4 q0 = x0 * x0, q1 = x1 * x1; ss += ((q0.x + q0.y) + (q0.z + q0.w)) + ((q1.x + q1.y) + (q1.z + q1.w)); }
                    xr[u][bj][0] = x0; xr[u][bj][1] = x1;
                }
                ss += XOR16(ss); ss = add_xor32(ss); ssp[u] = ss;
            }
            if (pr < 3) RES_LOAD(pr + 1, (pr + 1) & 1);
            asm volatile("" ::: "memory");
#pragma unroll
            for (int u = 0; u < 2; ++u) {
                const int i = 2 * pr + u; const bool ok = rowi[i] >= 0 && !dry; const unsigned rw = rowi[i] >= 0 ? (unsigned)rowi[i] : 0u;
                if (ok) {
#pragma unroll
                    for (int bj = 0; bj < 2; ++bj) { const f32x4 x0 = xr[u][bj][0], x1 = xr[u][bj][1];
                        if (xo) { GAS f32x4* op = (GAS f32x4*)((GAS char*)xo + (rw * 1024u + colb + 128u * bj) * 4u); op[0] = x0; op[1] = x1; }
                        if (xb) { v4u o; o.x = pk2(x0.x, x0.y); o.y = pk2(x0.z, x0.w); o.z = pk2(x1.x, x1.y); o.w = pk2(x1.z, x1.w);
                            *(GAS v4u*)((GAS char*)xb + (rw * (unsigned)ldxb + colb + 128u * bj) * 2u) = o; }
                        if (MK_X8 && x8) { v2u o2; o2.x = pk_fp8x4(x0.x, x0.y, x0.z, x0.w); o2.y = pk_fp8x4(x1.x, x1.y, x1.z, x1.w); *(GAS v2u*)((GAS char*)x8 + (rw * 1024u + colb + 128u * bj)) = o2; } }
                    if (fq == 0 && xb) *(GAS float*)((GAS char*)SSo + (rw * 16u + (unsigned)(4 * pn + wc)) * 4u) = ssp[u];
                }
            }
            asm volatile("" ::: "memory");
        }
#undef RES_LOAD
    }
};
struct EpiPW {
    bf16* O;
    __device__ __forceinline__ void operator()(AccRef acc, const pg8::Step& st, int wr, int wc, int fr_, int fq_) const {
        int fr = fr_, fq = fq_, zz = 0; LAUNDER3(fr, fq, zz);
        GAS char* ob = (GAS char*)O + (unsigned)(256 * st.pn + 32 * wc) * 2u; const unsigned row0 = (unsigned)(st.pm * 256 + wr * 64 + fr);
#pragma unroll
        for (int ai = 0; ai < 2; ++ai)
#pragma unroll
            for (int m = 0; m < 4; ++m) {
#pragma unroll
                for (int bj = 0; bj < 2; ++bj) { const f32x4 a = acc[ai][bj][m][0], b = acc[ai][bj][m][1]; v4u o; o.x = pk2(a.x, a.y); o.y = pk2(a.z, a.w); o.z = pk2(b.x, b.y); o.w = pk2(b.z, b.w);
                    *(GAS v4u*)(ob + ((row0 + ai * 128 + m * 16) * 2048u + (unsigned)(128 * bj + 8 * fq) * 2u)) = o; }
                asm volatile("" ::: "memory"); }
    }
};
struct EpiMU {
    bf16* ACT; const float* TOKW; float sc;
    __device__ __forceinline__ void operator()(AccRef acc, const pg8::Step& st, int wr, int wc, int fr_, int fq_) const {
        int fr = fr_, fq = fq_, zz = 0; LAUNDER3(fr, fq, zz);
        const int j = st.pn; GAS char* ab = (GAS char*)ACT + (size_t)st.pm * 1024 + (unsigned)(128 * j + 32 * wc) * 2u;
        int tok[8]; f32x4 tw[8];
#pragma unroll
        for (int i = 0; i < 8; ++i) { const int r = (i >> 2) * 128 + wr * 64 + (i & 3) * 16 + fr; tok[i] = (r < st.nvalid) ? st.rows[r] : -1; }
#pragma unroll
        for (int i = 0; i < 8; ++i) { tw[i] = *(const GAS f32x4*)((const GAS char*)TOKW + (unsigned)(tok[i] >= 0 ? tok[i] : 0) * 16u); if (tok[i] < 0) tw[i] = (f32x4){0.f, 0.f, 0.f, 0.f}; }
        asm volatile("" ::: "memory");
#pragma unroll
        for (int i = 0; i < 8; ++i) {
            const int ai = i >> 2, m = i & 3, r = ai * 128 + wr * 64 + m * 16 + fr;
            const float rs = tw[i].z * sc, w = (j < 2) ? tw[i].x : tw[i].y;
            const f32x4 g0 = acc[ai][0][m][0] * rs, g1 = acc[ai][0][m][1] * rs, u0 = acc[ai][1][m][0] * rs, u1 = acc[ai][1][m][1] * rs; v4u o;
            o.x = pk2(g0.x * sigm(g0.x) * u0.x * w, g0.y * sigm(g0.y) * u0.y * w); o.y = pk2(g0.z * sigm(g0.z) * u0.z * w, g0.w * sigm(g0.w) * u0.w * w);
            o.z = pk2(g1.x * sigm(g1.x) * u1.x * w, g1.y * sigm(g1.y) * u1.y * w); o.w = pk2(g1.z * sigm(g1.z) * u1.z * w, g1.w * sigm(g1.w) * u1.w * w);
            *(GAS v4u*)(ab + ((unsigned)r * 1024u + (unsigned)(8 * fq) * 2u)) = o;
            asm volatile("" ::: "memory");
        }
    }
};

__device__ __forceinline__ bool tile_order(long L, int nM, int nN, int& pm, int& pn) {
    const int nwg = nM * nN; if (L >= nwg) return false;
    int wgid = (int)L; { const int q = nwg / 8, r = nwg % 8, xcd = wgid % 8, off = wgid / 8; wgid = (xcd < r ? xcd * (q + 1) : r * (q + 1) + (xcd - r) * q) + off; }
    const int nig = 8 * nN, gid = wgid / nig, fm = gid * 8, gsz = (nM - fm) < 8 ? (nM - fm) : 8;
    pm = fm + ((wgid % nig) % gsz); pn = (wgid % nig) / gsz; return true;
}
struct SchedPlain {
    const char* A; const char* B; size_t a_tile, b_tile; int nM, nN, nt, G, c, fixa, fixb;
    __device__ __forceinline__ bool next(int i, pg8::Step& s) const {
        int pm, pn; if (!tile_order((long)i * G + c, nM, nN, pm, pn)) return false;
        s.A = A + (size_t)(fixa ? 0 : pm) * a_tile; s.B = B + (size_t)(fixb ? 0 : pn) * b_tile; s.rows = nullptr; s.nt = nt; s.pm = pm; s.pn = pn; s.aux = i; s.nvalid = 256; s.zero_after = 1; return true; }
};
template <int PART>
struct SchedG2 {
    const char* Ab; const char* Bb; int c;
    __device__ __forceinline__ bool next(int i, pg8::Step& s) const {
        if (i >= 3) return false; int pm, pn; tile_order(c, 64, 4, pm, pn);
        const int n = i;
        s.A = PART == 0 ? Ab + (size_t)pm * 256 * 1024 : Ab + (size_t)pm * 256 * (XYP * 2) + 512 * n * 2;
        s.B = Bb + ((size_t)n * 1024 + pn * 256) * 1024;
        s.rows = nullptr; s.nt = 8; s.pm = pm; s.pn = pn; s.aux = PART * 3 + i; s.nvalid = 256; s.zero_after = 0; return true; }
};
struct SchedMoE {
    volatile LAS unsigned* MISC; const int* LIST; const char* Ab; const char* Bb; int G, c, mode, f8, cls;
    __device__ __forceinline__ bool next(int i, pg8::Step& s) const {
        const int NU = (int)MISC[MI_TOT]; const int u = c;
        if (u >= NU || i > (mode == 2 ? 1 : 0)) return false;
        const int down = mode == 2;
        const int r = u - (int)MISC[MI_U0 + cls], k = r >> 2, j = r & 3, n_c = (int)MISC[MI_N + cls], arow = (int)MISC[MI_BASE + cls] + 256 * k;
        const int grp = cls / 6, pr = cls % 6; const int pa = pr < 3 ? 0 : (pr < 5 ? 1 : 2), pb = pr < 3 ? pr + 1 : (pr < 5 ? pr - 1 : 3);
        s.rows = LIST + (size_t)cls * T + 256 * k; s.nvalid = min(256, n_c - 256 * k); s.pm = arow; s.pn = j;
        if (!down) { const int e = grp * 4 + (j < 2 ? pa : pb), hf = j & 1;
            s.A = Ab; s.B = Bb + (size_t)(e * 2 + hf) * 256 * (f8 ? 1024 : 2048); s.nt = f8 ? 8 : 16; s.aux = cls; s.zero_after = 1; }
        else { const int sgm = i & 1; const int e = grp * 4 + (sgm ? pb : pa);
            s.A = Ab + (size_t)arow * 1024 + sgm * 512; s.B = Bb + ((size_t)e * 1024 + j * 256) * 512; s.nt = 4; s.aux = sgm; s.zero_after = sgm; }
        return true; }
};
__device__ __forceinline__ float wave_sum(float v) {
    return wave_sum64(v);
}
__device__ __forceinline__ void pool_unit(int u, const bf16* PROJ, bf16* XY, int tid_) {
    int tid = tid_; asm volatile("" : "+v"(tid));
    const int c8 = tid & 63, rg = tid >> 6, g = c8 >> 4, w = 2 << g, t0 = 256 * u + 32 * rg, s0 = t0 % S;
    const GAS char* zb = (const GAS char*)PROJ + (unsigned)c8 * 16u; GAS char* yb = (GAS char*)XY + (unsigned)c8 * 16u;
    float sum[8];
#pragma unroll
    for (int j = 0; j < 8; ++j) sum[j] = 0.f;
    { v4u pz[16];
#pragma unroll
      for (int k = 1; k <= 16; ++k) { const bool ok = k <= w && k <= s0; pz[k - 1] = *(const GAS v4u*)(zb + (unsigned)(ok ? t0 - k : t0) * (unsigned)(PJP * 2)); }
#pragma unroll
      for (int k = 1; k <= 16; ++k) { const bool ok = k <= w && k <= s0; const v4u z = pz[k - 1];
        if (ok) { sum[0] += bflo(z.x); sum[1] += bfhi(z.x); sum[2] += bflo(z.y); sum[3] += bfhi(z.y); sum[4] += bflo(z.z); sum[5] += bfhi(z.z); sum[6] += bflo(z.w); sum[7] += bfhi(z.w); } } }
#pragma clang loop unroll(disable)
    for (int r0 = 0; r0 < 32; r0 += 8) {
        v4u zz[8], qq[8];
#pragma unroll
        for (int j = 0; j < 8; ++j) { const int t = t0 + r0 + j, s = s0 + r0 + j;
            zz[j] = *(const GAS v4u*)(zb + (unsigned)t * (unsigned)(PJP * 2)); qq[j] = *(const GAS v4u*)(zb + (unsigned)(s >= w ? t - w : t) * (unsigned)(PJP * 2)); }
#pragma unroll
        for (int j = 0; j < 8; ++j) { const int t = t0 + r0 + j, s = s0 + r0 + j; const v4u z = zz[j], q = qq[j];
            float zf[8] = {bflo(z.x), bfhi(z.x), bflo(z.y), bfhi(z.y), bflo(z.z), bfhi(z.z), bflo(z.w), bfhi(z.w)};
#pragma unroll
            for (int i = 0; i < 8; ++i) sum[i] += zf[i];
            if (s >= w) { sum[0] -= bflo(q.x); sum[1] -= bfhi(q.x); sum[2] -= bflo(q.y); sum[3] -= bfhi(q.y); sum[4] -= bflo(q.z); sum[5] -= bfhi(q.z); sum[6] -= bflo(q.w); sum[7] -= bfhi(q.w); }
            const float ic = 1.0f / (float)min(s + 1, w); v4u o;
            o.x = pk2(sum[0] * ic - zf[0], sum[1] * ic - zf[1]); o.y = pk2(sum[2] * ic - zf[2], sum[3] * ic - zf[3]); o.z = pk2(sum[4] * ic - zf[4], sum[5] * ic - zf[5]); o.w = pk2(sum[6] * ic - zf[6], sum[7] * ic - zf[7]);
            *(GAS v4u*)(yb + (unsigned)t * (unsigned)(XYP * 2)) = o; }
    }
}
#ifndef MK_THRD
#define MK_THRD 32
#endif
#ifndef MK_THRF
#define MK_THRF 64
#endif
#ifndef MK_ATT_SKIP
#define MK_ATT_SKIP 0
#endif
__device__ __forceinline__ void attn_phase(const int wave0, const LayerW& w, int l, int rep, unsigned char* ws, char* lds, volatile LAS unsigned* MISC, gu32* ctl, const int dry) {
    using namespace attn_body;
    int tid = mk_tid(wave0); const int lane = tid & 63;
    bf16* PROJ = (bf16*)(ws + WS_PROJ); bf16* XY = (bf16*)(ws + WS_XY); bf16* STASH = (bf16*)(ws + WS_STASH); const float* LOGF = (const float*)(ws + WS_LOGF);
    const float lam_init = 0.8f - 0.6f * __expf(-0.3f * (float)l);
    float lam; { const float a = wave_sum(w.dlam[lane] * w.dlam[64 + lane]), c = wave_sum(w.dlam[128 + lane] * w.dlam[192 + lane]); lam = __expf(a) - __expf(c) + lam_init; lam = __int_as_float(__builtin_amdgcn_readfirstlane(__float_as_int(lam))); }
    unsigned* qhead = pg8::rflp((unsigned*)(ctl + CW_AQ) + rep); unsigned* fhead = pg8::rflp((unsigned*)(ctl + CW_AQ) + 64 + 16 * l);
    {
        unsigned* top = pg8::rflp((unsigned*)(ctl + CW_SPLIT3) + 64 * l);
#pragma clang loop unroll(disable)
        for (;;) {
            tid = mk_tid(wave0);
            if (tid == 0) { unsigned r = 0xffffffffu; if (xb_ld(top) < (unsigned)gridDim.x) { const unsigned f = atomicAdd(fhead, 1u); if (f < (unsigned)(CV_LATE_BATCHES + CV_RT_BATCHES + CV_PB_BATCHES)) r = f; } MISC[MI_Q] = r; }
            __syncthreads();
            const unsigned fb = MISC[MI_Q];
            __syncthreads();
            if (fb == 0xffffffffu) break;
            conv_late_batch(w, ws, l, (LAS unsigned char*)lds, (int)fb, tid); __syncthreads();
        }
        tid = mk_tid(wave0);
        if (tid == 0) split_wait_leader(top, (unsigned)gridDim.x);
        __syncthreads();
    }
    int first = 1;
    for (;;) {
        tid = mk_tid(wave0);
        if (tid == 0) { unsigned q = first ? (unsigned)blockIdx.x : (unsigned)gridDim.x + atomicAdd(qhead, 1u); if (q >= 832u) q = 832u + atomicAdd(fhead, 1u); MISC[MI_Q] = q; }
        first = 0;
        __syncthreads();
        const int idx = (int)MISC[MI_Q];
        __syncthreads();
        if (idx >= 832 + CV_LATE_BATCHES + CV_RT_BATCHES + CV_PB_BATCHES) break;
        if (idx >= 832) { if (MK_ATT_SKIP && dry && (MK_ATT_SKIP & 8)) continue; conv_late_batch(w, ws, l, (LAS unsigned char*)lds, idx - 832, tid); continue; }
        int kind, qb, bh;
        if (idx < 160) { kind = 0; qb = 7 - idx / 32; bh = idx % 32; }
        else if (idx < 224) { kind = 1; qb = 7; bh = idx - 160; }
        else if (idx < 256) { kind = 0; qb = 2; bh = idx - 224; }
        else if (idx < 384) { kind = 1; qb = 6 - (idx - 256) / 64; bh = (idx - 256) % 64; }
        else if (idx < 416) { kind = 0; qb = 1; bh = idx - 384; }
        else if (idx < 480) { kind = 1; qb = 4; bh = idx - 416; }
        else if (idx < 544) { kind = 2; qb = 0; bh = idx - 480; }
        else if (idx < 608) { kind = 1; qb = 3; bh = idx - 544; }
        else if (idx < 640) { kind = 0; qb = 0; bh = idx - 608; }
        else if (idx < 704) { kind = 1; qb = 2; bh = idx - 640; }
        else { kind = 1; qb = 1 - (idx - 704) / 64; bh = (idx - 704) % 64; }
        if (MK_ATT_SKIP && dry && ((MK_ATT_SKIP >> kind) & 1)) continue;
        if (kind == 2) { pool_unit(bh, PROJ, XY, tid); __syncthreads(); continue; }
        if (kind == 1) {
            const int b = bh >> 3, h = bh & 7;
            AttnP P; P.Q = PROJ + 2048 + h * 64; P.K = PROJ + 2560 + h * 64; P.V = PROJ + 3072 + h * 64; P.out = XY + 1024 + h * 64; P.stash = nullptr; P.gsub = nullptr; P.logf = LOGF + h; P.opitch = XYP; P.lam = 0.f; P.nscale = 0.f;
            attn_unit<MK_THRF, true>(tid, b, qb, 0, P, lds);
        } else {
            const int b = bh >> 2, h = bh & 3;
#pragma unroll 1
            for (int c = 0; c < 2; ++c) {
                AttnP P; P.Q = PROJ + 512 + (h * 2 + c) * 64; P.K = PROJ + 1024 + (h * 2 + c) * 64; P.V = PROJ + 1536 + h * 128;
                P.stash = STASH + h * 128; P.gsub = w.dsub; P.logf = nullptr; P.lam = lam; P.nscale = 1.0f - lam_init;
                if (c == 0) { P.out = STASH + h * 128; P.opitch = 512; } else { P.out = XY + 512 + h * 128; P.opitch = XYP; }
                attn_unit128<MK_THRD>(mk_tid(wave0), b, qb, c == 0 ? 0 : 4, P, lds); }
        }
    }
}
__device__ __forceinline__ void moe_tables(volatile LAS unsigned* MISC, const unsigned* cls_cnt, int tid) {
    __syncthreads();
    if (tid < 64) {
        const unsigned n = tid < 24 ? cls_cnt[tid] : 0u; const unsigned nch = (n + 255u) >> 8; unsigned inc = nch;
#pragma unroll
        for (int o = 1; o < 32; o <<= 1) { const unsigned up = (unsigned)__builtin_amdgcn_ds_bpermute((tid - o) << 2, (int)inc); if (tid >= o) inc += up; }
        if (tid < 24) { MISC[MI_N + tid] = n; MISC[MI_BASE + tid] = (inc - nch) * 256u; MISC[MI_U0 + tid] = (inc - nch) * 4u; }
        if (tid == 23) MISC[MI_TOT] = inc * 4u; }
    __syncthreads();
}

__device__ __forceinline__ int moe_class(volatile LAS unsigned* MISC, int u, int tid) {
    const int k = tid & 63; const bool ge = k < 24 && u >= (int)MISC[MI_U0 + (k < 24 ? k : 0)];
    const int n = __popcll(__ballot(ge)); return __builtin_amdgcn_readfirstlane(n > 0 ? n - 1 : 0);
}
#ifndef MK_FIXA
#define MK_FIXA 0
#endif
#ifndef MK_FIXB
#define MK_FIXB 0
#endif
#ifndef MK_REPEAT
#define MK_REPEAT 0
#endif
constexpr int NPH = 18;
struct Prog { int p[40]; int n; };
constexpr Prog make_prog() {
    Prog g{}; int n = 0;
    for (int ph = 0; ph < NPH; ++ph) {
        const int kind = (ph == 0 || ph == 9) ? 8 : (ph >= 10 ? ph - 10 : ph - 1);
        g.p[n++] = ph; if ((MK_REPEAT >> kind) & 1) g.p[n++] = ph; }
    g.n = n; return g;
}
__constant__ const Prog PROG = make_prog();
constexpr int NPOS = make_prog().n;
template <unsigned KMASK>
__device__ __forceinline__ void mk_body() {
    typedef const __attribute__((address_space(4))) Args* KArgs;
    const KArgs args0p = (KArgs)__builtin_amdgcn_kernarg_segment_ptr();
    extern __shared__ __attribute__((aligned(16))) unsigned char lds_raw[];
    { LAS unsigned char* lds0 = (LAS unsigned char*)lds_raw;
      for (int u = threadIdx.x; u < (LDS_BYTES - MISC_OFF) / 4; u += NWAVES * 64) ((LAS unsigned*)(lds0 + MISC_OFF))[u] = 0u; }
    __syncthreads();
    const int wave0 = __builtin_amdgcn_readfirstlane(threadIdx.x >> 6);
    XcdBarrier bar = xcd_barrier_post((unsigned*)((gu32*)(args0p->ws + WS_CTL) + CW_BAR) + args0p->li * XCD_BAR_WORDS, (volatile LAS unsigned*)((LAS unsigned char*)lds_raw + MISC_OFF) + MI_BAR, threadIdx.x);
    const int ph_lo = args0p->ph_lo, ph_hi = args0p->ph_hi;
#pragma clang loop unroll(disable)
    for (int pos = ph_lo; pos < ph_hi; ++pos) {
        const int ph = __builtin_amdgcn_readfirstlane(PROG.p[pos]); const int rep = pos; const int dry = (MK_REPEAT != 0 && pos + 1 < ph_hi && __builtin_amdgcn_readfirstlane(PROG.p[pos + 1]) == ph) ? 1 : 0;
        KArgs ap = args0p; asm volatile("" : "+s"(ap));
#define args (*ap)
        LAS unsigned char* lds = (LAS unsigned char*)lds_raw;
        volatile LAS unsigned* MISC = (volatile LAS unsigned*)(lds + MISC_OFF);
        int G = gridDim.x, bx = blockIdx.x; asm volatile("" : "+s"(G), "+s"(bx)); const int vcu = (G % 8 == 0) ? (bx % 8) * (G / 8) + bx / 8 : bx;
        unsigned char* ws = args.ws; gu32* ctl = (gu32*)(ws + WS_CTL);
        float* XOUT = args.out; const float* x0 = (const float*)args.in[0];
        bf16* XY = (bf16*)(ws + WS_XY); bf16* PROJ = (bf16*)(ws + WS_PROJ);
        float* SSA = (float*)(ws + WS_SS); float* SSB = (float*)(ws + WS_SSB);
        if (ph == 0) { if constexpr (KMASK & 0x100u) { const int tid = mk_tid(wave0); const LayerW w = layer_view(ap, 0); conv_layer(w, ws, 0, lds, vcu, G, tid); p0_x(x0, (const int*)args.in[2], ws, (unsigned char*)XOUT + OUT_XB8, vcu, G, tid);
            if (tid == 0) ((unsigned*)(ctl + CW_XCC))[vcu] = xb_xcc_id() + 1u;
            if (bx == 0) { float* GT = (float*)(ctl + CW_GT); const int ll = tid >> 8, r = tid & 255, wch = r >> 6, d = r & 63;
                const float* gsrc = (const float*)(wch == 0 ? args.in[7] : (wch == 1 ? args.in[8] : (wch == 2 ? args.in[11] : args.in[12]))); GT[tid] = gsrc[ll * 64 + d]; } } }
        else if (ph == 9) { }
        else {
            const int l = __builtin_amdgcn_readfirstlane(ph >= 10 ? 1 : 0), k = __builtin_amdgcn_readfirstlane(ph - (l ? 10 : 1));
            const LayerW w = layer_view(ap, l);
            const float* SSin = l == 0 ? SSA : SSB; const float* xcur = l == 0 ? x0 : XOUT;
            if (k == 0) { if constexpr (KMASK & 1u) { const int tid = mk_tid(wave0);
                SchedPlain S{(const char*)(XY + 1536), (const char*)(ws + WS_W + W_IN), (size_t)256 * XYP * 2, (size_t)256 * 2048, 64, 15, 16, G, bx, dry & MK_FIXA, dry & MK_FIXB};
                LAS float* RSL = (LAS float*)(lds + MISC_OFF) + 1024;
                if (tid < 4) { int pm_ = -1, pn_ = 0; if (!tile_order((long)tid * G + bx, 64, 15, pm_, pn_)) pm_ = -1; MISC[112 + tid] = (unsigned)pm_; }
                __syncthreads();
                {
                    const int pm0 = (int)MISC[112 + (tid >> 8)], pm1 = (int)MISC[114 + (tid >> 8)];
                    const float r0 = rstd_at(SSin, (unsigned)((pm0 >= 0 ? pm0 : 0) * 256 + (tid & 255))), r1 = rstd_at(SSin, (unsigned)((pm1 >= 0 ? pm1 : 0) * 256 + (tid & 255)));
                    if (pm0 >= 0) RSL[tid] = r0; if (pm1 >= 0) RSL[512 + tid] = r1; }
                __syncthreads();
                EpiG1 E{SSin, PROJ, (float*)(ws + WS_LOGF), (const float*)(ws + WS_COSSIN), (const float*)(ctl + CW_GT) + 256 * l, w.ffb, dry, RSL};
                pg8::gemm_phase<SchedPlain, EpiG1, false, true>(tid, lds, XYP * 2, 2048, S, E);
                split_arrive_x(bar, (unsigned*)(ctl + CW_SPLIT3) + 64 * l, (unsigned*)(ctl + CW_SPLIT3) + 64 * l + 32 * 0 + 128, mk_tid(wave0));
            } } else if (k == 1) { if constexpr (KMASK & 2u) {
                attn_phase(wave0, w, l, rep, ws, (char*)lds_raw, MISC, ctl, dry);
                split_arrive_x(bar, (unsigned*)(ctl + CW_SPLIT + (2 * l) * 64), (unsigned*)(ctl + CW_SPLITX + (2 * l) * 64), mk_tid(wave0));
            } } else if (k == 2) { if constexpr (KMASK & 4u) { const int tid = mk_tid(wave0);
                unsigned char* gsc = (unsigned char*)XOUT + OUT_GATES + (size_t)bx * 196608;
                LAS float* RSL2 = (LAS float*)(lds + MISC_OFF) + 1024;
                { int pm_, pn_; tile_order(bx, 64, 4, pm_, pn_); if (tid < 256) RSL2[tid] = rstd_at(SSin, (unsigned)(pm_ * 256 + tid)); __syncthreads(); }
                { SchedG2<0> S{(const char*)XOUT + OUT_XB8, (const char*)(ws + WS_W + W_G8), bx};
                  EpiG2<0> E{SSin, gsc, (bf16*)(ws + WS_MERGED), RSL2};
                  pg8::gemm_phase<SchedG2<0>, EpiG2<0>, false, true, true>(tid, lds, 1024, 1024, S, E); }
                { const int t2 = mk_tid(wave0); if (t2 == 0) split_wait_leader((unsigned*)(ctl + CW_SPLIT + (2 * l) * 64), (unsigned)G); __syncthreads(); }
                { SchedG2<1> S{(const char*)XY, (const char*)(ws + WS_W + W_BR), bx};
                  EpiG2<1> E{SSin, gsc, (bf16*)(ws + WS_MERGED), RSL2};
                  pg8::gemm_phase<SchedG2<1>, EpiG2<1>, false, true>(mk_tid(wave0), lds, XYP * 2, 1024, S, E); }
                { int pm_, pn_; tile_order(bx, 64, 4, pm_, pn_); group4_sync((unsigned*)(ctl + CW_G4 + ((2 * l) * 64 + pm_) * 32), mk_tid(wave0)); }
            } } else if (k == 3) { if constexpr (KMASK & 8u) { const int tid = mk_tid(wave0);
                SchedPlain S{(const char*)(ws + WS_MERGED), (const char*)(ws + WS_W + W_OUT), (size_t)256 * 2048, (size_t)256 * 2048, 64, 4, 16, G, bx, 0, 0};
                EpiRes<0, false> E{XY + 1536, XYP, nullptr, XY + 1536, XYP, SSA, nullptr, nullptr, dry, (MK_MU8 && l == NL - 1) ? (unsigned char*)XOUT + OUT_XB8 : nullptr};
                pg8::gemm_phase<SchedPlain, EpiRes<0, false>, false, true>(tid, lds, 2048, 2048, S, E);
                { int pm_, pn_; tile_order(bx, 64, 4, pm_, pn_); group4_sync((unsigned*)(ctl + CW_G4 + ((2 * l + 1) * 64 + pm_) * 32), mk_tid(wave0)); }
            } } else if (k == 4) { if constexpr (KMASK & 16u) { const int tid = mk_tid(wave0);
                {
                    typedef float f32x16r __attribute__((ext_vector_type(16))); typedef short bf16x8r __attribute__((ext_vector_type(8)));
                    const int lane_ = tid & 63, r32 = lane_ & 31, hh = lane_ >> 5, wv = __builtin_amdgcn_readfirstlane(tid >> 6); int pm_, pn_; tile_order(bx, 64, 4, pm_, pn_); const int t0 = pm_ * 256 + pn_ * 64;
                    unsigned* ccnt = (unsigned*)(ctl + CW_CLS + 32 * l + 64 * dry); int* LIST = (int*)(ws + WS_LIST);
                    const GAS char* wrh = (const GAS char*)(ws + WS_W + W_RH) + (unsigned)(r32 * 2048 + (128 * wv + 8 * hh) * 2);
                    const GAS char* xb_ = (const GAS char*)(XY + 1536) + (size_t)t0 * (XYP * 2) + (unsigned)(r32 * (XYP * 2) + (128 * wv + 8 * hh) * 2);
                    f32x16r acc0 = {}, acc1 = {};
#pragma unroll 2
                    for (int ks = 0; ks < 8; ++ks) {
                        const bf16x8r Bh = *(const GAS bf16x8r*)(wrh + ks * 32), Bl = *(const GAS bf16x8r*)(wrh + 65536 + ks * 32);
                        const bf16x8r A0 = *(const GAS bf16x8r*)(xb_ + ks * 32), A1 = *(const GAS bf16x8r*)(xb_ + 32 * (XYP * 2) + ks * 32);
                        acc0 = __builtin_amdgcn_mfma_f32_32x32x16_bf16(A0, Bh, acc0, 0, 0, 0); acc0 = __builtin_amdgcn_mfma_f32_32x32x16_bf16(A0, Bl, acc0, 0, 0, 0);
                        acc1 = __builtin_amdgcn_mfma_f32_32x32x16_bf16(A1, Bh, acc1, 0, 0, 0); acc1 = __builtin_amdgcn_mfma_f32_32x32x16_bf16(A1, Bl, acc1, 0, 0, 0);
                    }
                    LAS float* Pp = (LAS float*)lds;
                    LAS float* Lg = (LAS float*)(lds + 65536);
#pragma unroll
                    for (int r = 0; r < 16; ++r) { const int tk = (r & 3) + 8 * (r >> 2) + 4 * hh; Pp[(wv * 64 + tk) * 32 + r32] = acc0[r]; Pp[(wv * 64 + 32 + tk) * 32 + r32] = acc1[r]; }
                    __syncthreads();
                    { const int tk = tid >> 3, n4 = (tid & 7) * 4; f32x4 s = (f32x4){0.f, 0.f, 0.f, 0.f};
#pragma unroll
                      for (int w8 = 0; w8 < 8; ++w8) s += *(const LAS f32x4*)(Pp + (w8 * 64 + tk) * 32 + n4);
                      *(LAS f32x4*)(Lg + tk * 32 + n4) = s; }
                    __syncthreads();
                    if (tid < 64) { const int t = t0 + tid; float dg[4], de[16];
#pragma unroll
                        for (int e = 0; e < 4; ++e) dg[e] = Lg[tid * 32 + e];
#pragma unroll
                        for (int e = 0; e < 16; ++e) de[e] = Lg[tid * 32 + 4 + e];
                        const float rstd = rstd_at(SSA, (unsigned)t); float wa, wb; const int cls = route_decide(dg, de, rstd, w.brg, w.bre, wa, wb);
                        *(GAS f32x4*)((GAS char*)(ws + WS_TOKW) + (unsigned)t * 16u) = (f32x4){wa, wb, rstd, 0.f}; MISC[128 + tid] = (unsigned)cls; }
                    __syncthreads();
                    if (tid < 64) {
                        const unsigned mycls = MISC[128 + tid]; const unsigned long long ltm = (1ull << tid) - 1ull; unsigned cnt_c = 0, rank = 0;
#pragma unroll 4
                        for (unsigned c = 0; c < 24; ++c) { const unsigned long long m = __ballot(mycls == c); if ((unsigned)tid == c) cnt_c = (unsigned)__popcll(m); if (mycls == c) rank = (unsigned)__popcll(m & ltm); }
                        unsigned base = 0; if (tid < 24 && cnt_c) base = atomicAdd(ccnt + tid, cnt_c);
                        const unsigned mybase = (unsigned)__builtin_amdgcn_ds_bpermute((int)(mycls << 2), (int)base);
                        LIST[(size_t)mycls * T + mybase + rank] = t0 + tid; }
                    __syncthreads();
                }
                split_arrive_x(bar, (unsigned*)(ctl + CW_SPLIT + (2 * l + 1) * 64), (unsigned*)(ctl + CW_SPLITX + (2 * l + 1) * 64), mk_tid(wave0));
            } } else if (k == 5) { if constexpr (KMASK & 96u) { int tid = mk_tid(wave0);
                if (tid == 0) split_wait_leader((unsigned*)(ctl + CW_SPLIT + (2 * l + 1) * 64), (unsigned)G);
                __syncthreads();
                moe_tables(MISC, (const unsigned*)(ctl + CW_CLS + 32 * l), tid);
                const int NUm = (int)MISC[MI_TOT], KO = NUm > 256 ? (NUm - 256) >> 2 : 0;
                const int gid = vcu >> 2, m4 = vcu & 3, xg = gid >> 3, lg = gid & 7;
                const int k_o = lg * 8 + xg, k_p = (lg - 4) * 8 + xg;
                const bool is_o = lg < 4 && k_o < KO, is_p = lg >= 4 && k_p < KO;
                unsigned* cA = (unsigned*)(ctl + CW_MOE2 + 3584 * l); unsigned* cB = cA + 2048; unsigned* cO = cA + 3072;
#pragma clang loop unroll(disable)
                for (int r = 0; r < 2; ++r) {
                    const int u = r == 0 ? vcu : 256 + 4 * k_o + m4; if (r == 1 && !is_o) break;
                    tid = mk_tid(wave0);
                    { const int ucls = moe_class(MISC, u, tid);
                      SchedMoE S{MISC, (const int*)(ws + WS_LIST), (const char*)(XY + 1536), (const char*)(ws + WS_W + W_GU), G, u, 0, 0, ucls};
                      EpiMU E{(bf16*)(ws + OV_ACT), (const float*)(ws + WS_TOKW), 1.0f};
                      pg8::gemm_phase<SchedMoE, EpiMU, true, true>(tid, lds, XYP * 2, 2048, S, E); }
                    if (r == 0 && is_o) {
                        asm volatile("s_waitcnt vmcnt(0)" ::: "memory"); __syncthreads();
                        tid = mk_tid(wave0);
                        if (tid == 0) { const unsigned me = xb_xcc_id() + 1u; bool same = true;
#pragma unroll
                            for (int i = 0; i < 4; ++i) same = same && (xb_ld((unsigned*)(ctl + CW_XCC) + (gid + 4) * 4 + i) == me);
                            if (!same) { __builtin_amdgcn_fence(__ATOMIC_RELEASE, "agent"); asm volatile("s_waitcnt vmcnt(0)" ::: "memory"); }
                            xb_add(cO + 16 * k_o, 1u); asm volatile("s_waitcnt vmcnt(0)" ::: "memory"); }
                        __syncthreads();
                    }
                }
                group4_sync(is_o ? cB + 32 * k_o : cA + 32 * gid, mk_tid(wave0));
#pragma clang loop unroll(disable)
                for (int r = 0; r < 2; ++r) {
                    const int u = r == 0 ? (is_o ? 256 + 4 * k_o + m4 : vcu) : 4 * (gid - 4) + m4; if (r == 1 && !is_p) break;
                    tid = mk_tid(wave0);
                    if (r == 1) {
                        if (tid == 0) { unsigned sp = 0; while (xb_ld(cO + 16 * k_p) < 4u) { __builtin_amdgcn_s_sleep(2); if (++sp > (1u << 22)) break; }
                            __builtin_amdgcn_fence(__ATOMIC_ACQUIRE, "agent"); asm volatile("s_waitcnt vmcnt(0)" ::: "memory"); }
                        __syncthreads();
                    }
                    const int ucls = moe_class(MISC, u, tid);
                    SchedMoE S{MISC, (const int*)(ws + WS_LIST), (const char*)(ws + OV_ACT), (const char*)(ws + WS_W + W_D), G, u, 2, 0, ucls};
                    EpiRes<0, true> E{XY + 1536, XYP, nullptr, (bf16*)(ws + OV_XB2), 1024, SSA, nullptr, nullptr, dry, MK_PLE8 ? ws + WS_MERGED : nullptr};
                    pg8::gemm_phase<SchedMoE, EpiRes<0, true>, false, true>(tid, lds, 1024, 512, S, E);
                }
                { unsigned* fqh = pg8::rflp((unsigned*)(ctl + CW_FQ) + 64 * l); const int NF = 256 + (l + 1 < NL ? CV_EARLY_BATCHES : 0);
                  int arrived = 0;
                  for (;;) {
                    const int tq = mk_tid(wave0);
                    if (tq == 0) MISC[MI_Q] = atomicAdd(fqh, 1u);
                    __syncthreads();
                    const int idx = (int)MISC[MI_Q];
                    __syncthreads();
                    if (idx >= 256 && !arrived) { split_arrive_x(bar, (unsigned*)(ctl + CW_SPLIT3) + 256 + 64 * l, (unsigned*)(ctl + CW_SPLIT3) + 512 + 64 * l, mk_tid(wave0)); arrived = 1; }
                    if (idx >= NF) break;
                    if (idx < 256) {
                        SchedPlain S2{(const char*)(ws + OV_PB), (const char*)(ws + WS_WPLE + l * WPLE_STRIDE + W_P), (size_t)256 * 512, (size_t)256 * 512, 64, 4, 4, 1 << 20, idx, 0, 0};
                        EpiPW E2{(bf16*)(ws + OV_PW)};
                        pg8::gemm_phase<SchedPlain, EpiPW, false, true>(tq, lds, 512, 512, S2, E2);
                    } else { const LayerW w1 = layer_view(ap, 1); conv_early_batch(w1, ws, 1, lds, idx - 256, tq); }
                  } }
            } } else if (k == 6) { if constexpr (KMASK & 96u) {
            } } else { if constexpr (KMASK & 128u) { const int tid = mk_tid(wave0);
                if (tid == 0) split_wait_leader((unsigned*)(ctl + CW_SPLIT3) + 256 + 64 * l, (unsigned)G);
                __syncthreads();
                constexpr int P8 = MK_PLE8 ? 1 : 0;
                SchedPlain S{(const char*)(ws + (P8 ? WS_MERGED : OV_XB2)), (const char*)(ws + WS_WPLE + l * WPLE_STRIDE + W_PG), (size_t)256 * (P8 ? 1024 : 2048), (size_t)256 * (P8 ? 1024 : 2048), 64, 4, P8 ? 8 : 16, G, bx, 0, 0};
                EpiRes<1, false> E{(const bf16*)(ws + OV_XB2), 1024, l == NL - 1 ? XOUT : nullptr, l == NL - 1 ? nullptr : XY + 1536, XYP, SSB, SSA, (const bf16*)(ws + OV_PW), dry, l == NL - 1 ? nullptr : (unsigned char*)XOUT + OUT_XB8};
                pg8::gemm_phase<SchedPlain, EpiRes<1, false>, false, true, P8 != 0>(tid, lds, P8 ? 1024 : 2048, P8 ? 1024 : 2048, S, E);
            } }
        }
        const int kk_ = (ph == 0 || ph == 9) ? -1 : (ph >= 10 ? ph - 10 : ph - 1);
        if (pos + 1 < ph_hi && ph != 9 && (MK_REPEAT != 0 || kk_ > 6 || kk_ < 0)) { xcd_barrier(bar, mk_tid(wave0));
#ifdef MK_DOUBLE_BAR
            xcd_barrier(bar, mk_tid(wave0)); xcd_barrier(bar, mk_tid(wave0));
#endif
        }
#undef args
    }
}

#ifndef MK_KMASKS
#ifdef MK_SPLIT_TEST
#define MK_KMASKS 0x100u
#else
#define MK_KMASKS 0x1FFu
#endif
#endif
__global__ void __launch_bounds__(NWAVES * 64, 2) mk_fwd(Args args) { mk_body<MK_KMASKS>(); }
#ifdef MK_SPLIT_TEST
__global__ void __launch_bounds__(NWAVES * 64, 2) mk_t0(Args args) { mk_body<1u>(); }
__global__ void __launch_bounds__(NWAVES * 64, 2) mk_t1(Args args) { mk_body<2u>(); }
__global__ void __launch_bounds__(NWAVES * 64, 2) mk_t2(Args args) { mk_body<4u>(); }
__global__ void __launch_bounds__(NWAVES * 64, 2) mk_t3(Args args) { mk_body<8u>(); }
__global__ void __launch_bounds__(NWAVES * 64, 2) mk_t4(Args args) { mk_body<16u>(); }
__global__ void __launch_bounds__(NWAVES * 64, 2) mk_t5(Args args) { mk_body<32u>(); }
__global__ void __launch_bounds__(NWAVES * 64, 2) mk_t6(Args args) { mk_body<64u>(); }
__global__ void __launch_bounds__(NWAVES * 64, 2) mk_t7(Args args) { mk_body<128u>(); }
__global__ void __launch_bounds__(NWAVES * 64, 2) mk_t8(Args args) { mk_body<256u>(); }
#endif
#ifndef MK_ONE_LAUNCH
#define MK_ONE_LAUNCH 0
#endif
#ifndef MK_OPT_MASK
#define MK_OPT_MASK 0x3FFFF
#endif
static void ref_phase(int l, int k, void* const* d_in, float* XOUT, unsigned char* ws, hipStream_t st) {
    using namespace refp;
    const float* x0 = (const float*)d_in[0]; const float* p = (const float*)d_in[1]; const int* pos = (const int*)d_in[2];
    const float* g_attn = (const float*)d_in[3] + l * 1024; const float* w_in_l = (const float*)d_in[4] + (size_t)l * 1024 * INW;
    const float* pool_w = (const float*)d_in[5] + (size_t)l * 4 * 128 * 128; const float* pool_scale = (const float*)d_in[6] + l * 512;
    const float* dqn = (const float*)d_in[7] + l * 64; const float* dkn = (const float*)d_in[8] + l * 64; const float* dlam = (const float*)d_in[9] + l * 256;
    const float* dsub = (const float*)d_in[10] + l * 128; const float* fqn = (const float*)d_in[11] + l * 64; const float* fkn = (const float*)d_in[12] + l * 64;
    const float* ffb = (const float*)d_in[13] + l * 8; const float* w_branch_l = (const float*)d_in[14] + (size_t)l * 3 * 512 * 1024; const float* w_out_l = (const float*)d_in[15] + (size_t)l * 1024 * 1024;
    const float* g_ffn = (const float*)d_in[16] + l * 1024; const float* wrg = (const float*)d_in[17] + (size_t)l * 1024 * 4; const float* brg = (const float*)d_in[18] + l * 4;
    const float* wre = (const float*)d_in[19] + (size_t)l * 1024 * 16; const float* bre = (const float*)d_in[20] + l * 16;
    const float* wg_l = (const float*)d_in[21] + (size_t)l * 16 * 1024 * 256; const float* wu_l = (const float*)d_in[22] + (size_t)l * 16 * 1024 * 256; const float* wd_l = (const float*)d_in[23] + (size_t)l * 16 * 256 * 1024;
    const float* g_ple = (const float*)d_in[24] + l * 1024; const float* wpg_l = (const float*)d_in[25] + (size_t)l * 1024 * 1024; const float* wple_l = (const float*)d_in[26] + (size_t)l * 256 * 1024;
    const float* p_l = p + (size_t)l * T * 256;
    float* SSA = (float*)(ws + WS_SS); float* SSB = (float*)(ws + WS_SSB); float* RS = (float*)(ws + WS_RSTD); float* LOGF = (float*)(ws + WS_LOGF); float* FCUM = (float*)(ws + WS_FCUM); float* TOKW = (float*)(ws + WS_TOKW); int* LIST = (int*)(ws + WS_LIST);
    bf16* XY = (bf16*)(ws + WS_XY); bf16* PROJ = (bf16*)(ws + WS_PROJ); float* CH = (float*)(ws + WS_STASH); bf16* MERGED = (bf16*)(ws + WS_MERGED); float* TMP = (float*)(ws + WS_PROJ);
    unsigned* cls_cnt = (unsigned*)(ws + WS_CTL) + CW_CLS + 32 * l;
    const float* xcur = l == 0 ? x0 : XOUT; float* SSin = l == 0 ? SSA : SSB;
    const float lam_init = 0.8f - 0.6f * expf(-0.3f * (float)l);
    if (k == -1) { k_rowstats<<<T / 4, 256, 0, st>>>(x0, XY + 1536, XYP, SSA, RS, nullptr); return; }
    if (k == 0) {
        k_ref_rstd<<<T / 256, 256, 0, st>>>(SSin, RS);
        for (int cc = 0; cc < 14; ++cc) {
            k_ref_gemm<<<dim3(4, T / 64), 256, 0, st>>>(XnormLoader{xcur, RS, g_attn}, w_in_l + 256 * cc, INW, 256, 1024, EpiStoreF32{CH, 256, 0});
            int kind = 2; const float* gain = nullptr; int rot = 0; float osc = 1.f;
            if (cc < 2) kind = 0;
            else if (cc < 4) { kind = 1; gain = dqn; rot = 1; osc = C2; }
            else if (cc < 6) { kind = 1; gain = dkn; rot = 1; }
            else if (cc >= 8 && cc < 10) { kind = 1; gain = fqn; osc = C2; }
            else if (cc >= 10 && cc < 12) { kind = 1; gain = fkn; }
            k_ref_epi1<<<T, 256, 0, st>>>(CH, cc, kind, pool_w, pool_scale, gain, rot, osc, pos, PROJ);
        }
        k_ref_gemm<<<dim3(1, T / 64), 256, 0, st>>>(XnormLoader{xcur, RS, g_attn}, w_in_l + 3584, INW, 8, 1024, EpiStoreF32{CH, 8, 0});
        k_ref_logf<<<T * 8 / 256, 256, 0, st>>>(CH, ffb, LOGF);
    } else if (k == 1) {
        k_ref_fscan<<<1, 64, 0, st>>>(LOGF, FCUM);
        k_ref_fox<<<T * 8 / 4, 256, 0, st>>>(PROJ, FCUM, XY);
        k_ref_diff<<<T * 4 / 2, 128, 0, st>>>(PROJ, dlam, dsub, lam_init, XY);
        k_ref_pool<<<T * 512 / 256, 256, 0, st>>>(PROJ, XY);
    } else if (k == 2) {
        k_ref_rstd<<<T / 256, 256, 0, st>>>(SSin, RS);
        k_ref_gemm2<<<dim3(16, T / 64), 256, 0, st>>>(xcur, RS, g_attn, w_in_l, w_branch_l, XY, MERGED);
    } else if (k == 3) {
        k_ref_gemm<<<dim3(16, T / 64), 256, 0, st>>>(Bf16Loader{MERGED, 1024, 0}, w_out_l, 1024, 1024, 1024, EpiResid{xcur, XOUT});
        k_rowstats<<<T / 4, 256, 0, st>>>(XOUT, XY + 1536, XYP, SSA, RS, nullptr);
    } else if (k == 4) {
        k_route<<<T / 4, 256, 0, st>>>(XOUT, g_ffn, wrg, brg, wre, bre, cls_cnt, LIST, TOKW);
    } else if (k == 5) {
        k_ref_rstd<<<T / 256, 256, 0, st>>>(SSA, RS);
        k_ref_moe<<<dim3(T / 8, 24), 256, 0, st>>>(XOUT, RS, g_ffn, (const int*)cls_cnt, LIST, TOKW, wg_l, wu_l, wd_l);
        k_rowstats<<<T / 4, 256, 0, st>>>(XOUT, (bf16*)(ws + OV_XB2), 1024, SSA, RS, nullptr);
    } else if (k == 7) {
        k_ref_rstd<<<T / 256, 256, 0, st>>>(SSA, RS);
        k_ref_ple<<<dim3(16, T / 64), 256, 0, st>>>(XOUT, RS, g_ple, wpg_l, p_l, wple_l, TMP);
        k_rowstats<<<T / 4, 256, 0, st>>>(TMP, XY + 1536, XYP, SSB, RS, XOUT);
    }
}

extern "C" void kernel_launch(void* const* d_in, const int* in_sizes, int n_in, void* d_out, int out_size, void* d_ws, size_t ws_size, hipStream_t stream) {
    static int grid = 0;
    if (grid == 0) {
        if (n_in != 27 || out_size != T * DM || ws_size < WS_END) { fprintf(stderr, "kernel_launch: unexpected shapes (n_in %d out %d ws %zu)\n", n_in, out_size, ws_size); grid = -1; return; }
        int dev = 0, cus = 0;
        if (hipGetDevice(&dev) != hipSuccess || hipDeviceGetAttribute(&cus, hipDeviceAttributeMultiprocessorCount, dev) != hipSuccess) { grid = -1; return; }
        if (hipFuncSetAttribute((const void*)mk_fwd, hipFuncAttributeMaxDynamicSharedMemorySize, LDS_BYTES) != hipSuccess) { fprintf(stderr, "kernel_launch: hipFuncSetAttribute failed\n"); grid = -1; return; }
#if !MK_ONE_LAUNCH
        { const void* ks[9] = {(const void*)mk_t0, (const void*)mk_t1, (const void*)mk_t2, (const void*)mk_t3, (const void*)mk_t4, (const void*)mk_t5, (const void*)mk_t6, (const void*)mk_t7, (const void*)mk_t8};
          for (int i = 0; i < 9; ++i) (void)hipFuncSetAttribute(ks[i], hipFuncAttributeMaxDynamicSharedMemorySize, LDS_BYTES); }
#endif
        int per_cu = 0;
        if (hipOccupancyMaxActiveBlocksPerMultiprocessor(&per_cu, mk_fwd, NWAVES * 64, LDS_BYTES) != hipSuccess || per_cu < 1) { fprintf(stderr, "kernel_launch: occupancy query failed (%d)\n", per_cu); grid = -1; return; }
        (void)hipGetLastError();
        grid = cus;
    }
    if (grid < 0) return;
    (void)hipMemsetAsync((char*)d_ws + WS_CTL, 0, MK_ONE_LAUNCH ? (size_t)192 * 1024 : CTL_BYTES, stream);
    Args a{};
    for (int i = 0; i < 27; ++i) a.in[i] = d_in[i];
    a.out = (float*)d_out; a.ws = (unsigned char*)d_ws;
#if MK_ONE_LAUNCH
    a.ph_lo = 0; a.ph_hi = NPOS; a.li = 0;
    hipLaunchKernelGGL(mk_fwd, dim3(grid), dim3(NWAVES * 64), LDS_BYTES, stream, a);
#else
    const unsigned mask = MK_OPT_MASK; int li = 0;
    typedef void (*kern_t)(Args);
    const kern_t ks[9] = {mk_t0, mk_t1, mk_t2, mk_t3, mk_t4, mk_t5, mk_t6, mk_t7, mk_t8};
#define LAUNCH_PH(kk) hipLaunchKernelGGL(ks[kk], dim3(grid), dim3(NWAVES * 64), LDS_BYTES, stream, a)
    for (int ph = 0; ph < NPH; ++ph) {
        const bool opt = (mask >> ph) & 1u;
        const int l = ph >= 10 ? 1 : 0, k = ph == 0 ? -1 : (ph == 9 ? -2 : ph - (l ? 10 : 1));
        if (ph == 0) {
            a.ph_lo = 0; a.ph_hi = 1; a.li = li++; LAUNCH_PH(8);
            if (!opt) ref_phase(0, -1, d_in, (float*)d_out, (unsigned char*)d_ws, stream);
            continue; }
        if (ph == 9) { a.ph_lo = 9; a.ph_hi = 10; a.li = li++; LAUNCH_PH(8); continue; }
        if (opt) { a.ph_lo = ph; a.ph_hi = ph + 1; a.li = li++; LAUNCH_PH(k); }
        else if (k != 6) ref_phase(l, k, d_in, (float*)d_out, (unsigned char*)d_ws, stream);
    }
#endif
}
```

```cpp
#include <hip/hip_runtime.h>
#include <cstdio>
#include <cstdint>
#include <cmath>
typedef unsigned short bf16;
constexpr int T = 16384, DM = 1024, S = 2048, NB = 8, NL = 2, INW = 6664;
constexpr float RMS_EPS = 1e-6f;
constexpr float C2 = 0.125f * 1.4426950408889634f;
constexpr size_t MiB = 1u << 20;
constexpr size_t WS_CTL = 0, CTL_BYTES = 1 * MiB;
constexpr size_t WS_SS = 1 * MiB;
constexpr size_t WS_LOGF = 2 * MiB;
constexpr size_t WS_FCUM = 2 * MiB + 512 * 1024;
constexpr size_t WS_TOKW = 3 * MiB;
constexpr size_t WS_RSTD = 3 * MiB + 256 * 1024;
constexpr size_t WS_LIST = 3 * MiB + 512 * 1024;
constexpr size_t WS_COSSIN = 5 * MiB;
constexpr size_t WS_SSB = 49 * MiB;
constexpr size_t WS_W = 6 * MiB;
constexpr size_t WS_WPLE = 52 * MiB;
constexpr size_t WS_XY = 57 * MiB;
constexpr size_t WS_PROJ = 137 * MiB;
constexpr size_t WS_STASH = 249 * MiB;
constexpr size_t WS_MERGED = WS_PROJ + 96 * MiB;
constexpr size_t WS_PB = 265 * MiB;
constexpr size_t WS_END = 273 * MiB;
constexpr int XYP = 2560, PJP = 3584;
constexpr int CW_CLS = 64;
constexpr int CW_AQ = 256;
constexpr int CW_G4 = 16384;
constexpr int CW_SPLIT3 = 24576;
constexpr int CW_MOE2 = 32768;
constexpr int CW_XCC = 40960;
constexpr int CW_GT = 131072;
constexpr int CW_MOEG = 512;
constexpr int CW_SPLIT = 5632;
constexpr int CW_SPLITX = 5888;
constexpr int CW_FQ = 6144;
constexpr int CW_BAR = 8192;
#define MK_ONE_LAUNCH 1
namespace refp {

__device__ __forceinline__ float bf2f(bf16 v) { return __uint_as_float((unsigned)v << 16); }
__device__ __forceinline__ bf16 f2b(float f) { unsigned u = __float_as_uint(f); return (bf16)((u + 0x7fffu + ((u >> 16) & 1u)) >> 16); }
__device__ __forceinline__ float wsum(float v) {
#pragma unroll
    for (int o = 1; o < 64; o <<= 1) v += __shfl_xor(v, o);
    return v;
}
__device__ __forceinline__ float wmax(float v) {
#pragma unroll
    for (int o = 1; o < 64; o <<= 1) v = fmaxf(v, __shfl_xor(v, o));
    return v;
}
__device__ __forceinline__ float row_rstd(const float* SS, int t) {
    float s = 0.f;
#pragma unroll
    for (int i = 0; i < 16; ++i) s += SS[(size_t)t * 16 + i];
    return rsqrtf(s * (1.0f / 1024.0f) + RMS_EPS);
}

__global__ void __launch_bounds__(256) k_rowstats(const float* __restrict__ xsrc, bf16* XBdst, int ldxb, float* SS, float* RSTD, float* xcopy) {
    const int t = blockIdx.x * 4 + (threadIdx.x >> 6), lane = threadIdx.x & 63;
    const float* xr = xsrc + (size_t)t * 1024;
    float s = 0.f;
    for (int j = 0; j < 16; ++j) { const int k = lane + 64 * j; const float v = xr[k]; s += v * v; XBdst[(size_t)t * ldxb + k] = f2b(v); if (xcopy) xcopy[(size_t)t * 1024 + k] = v; }
    s = wsum(s);
    if (lane < 16) SS[(size_t)t * 16 + lane] = (lane == 0) ? s : 0.f;
    if (lane == 0) RSTD[t] = rsqrtf(s * (1.0f / 1024.0f) + RMS_EPS);
}
__global__ void k_ref_rstd(const float* __restrict__ SS, float* RSTD) { const int t = blockIdx.x * blockDim.x + threadIdx.x; if (t < T) RSTD[t] = row_rstd(SS, t); }

struct XnormLoader { const float* x; const float* RS; const float* g;
    __device__ __forceinline__ float operator()(int t, int k) const { return x[(size_t)t * 1024 + k] * RS[t] * g[k]; } };
struct Bf16Loader { const bf16* A; int lda; int pad;
    __device__ __forceinline__ float operator()(int t, int k) const { return bf2f(A[(size_t)t * lda + k]); } };
struct F32Loader { const float* A; int lda; int pad;
    __device__ __forceinline__ float operator()(int t, int k) const { return A[(size_t)t * lda + k]; } };

template <class AL, class EPI>
__global__ void __launch_bounds__(256) k_ref_gemm(AL al, const float* __restrict__ W, int ldw, int N, int K, EPI epi) {
    __shared__ float sA[16][65], sB[16][65];
    const int tx = threadIdx.x & 15, ty = threadIdx.x >> 4, t0 = blockIdx.y * 64, n0 = blockIdx.x * 64;
    float acc[4][4] = {};
    for (int k0 = 0; k0 < K; k0 += 16) {
        for (int e = threadIdx.x; e < 1024; e += 256) { const int r = e >> 4, kk = e & 15; sA[kk][r] = al(t0 + r, k0 + kk); }
        for (int e = threadIdx.x; e < 1024; e += 256) { const int kk = e >> 6, c = e & 63; sB[kk][c] = (n0 + c < N) ? W[(size_t)(k0 + kk) * ldw + n0 + c] : 0.f; }
        __syncthreads();
#pragma unroll
        for (int kk = 0; kk < 16; ++kk) {
            float a[4], b[4];
#pragma unroll
            for (int i = 0; i < 4; ++i) { a[i] = sA[kk][ty * 4 + i]; b[i] = sB[kk][tx * 4 + i]; }
#pragma unroll
            for (int i = 0; i < 4; ++i)
#pragma unroll
                for (int j = 0; j < 4; ++j) acc[i][j] += a[i] * b[j];
        }
        __syncthreads();
    }
#pragma unroll
    for (int i = 0; i < 4; ++i)
#pragma unroll
        for (int j = 0; j < 4; ++j) { const int n = n0 + tx * 4 + j; if (n < N) epi(t0 + ty * 4 + i, n, acc[i][j]); }
}
struct EpiStoreF32 { float* C; int ldc; int pad; __device__ __forceinline__ void operator()(int t, int n, float v) const { C[(size_t)t * ldc + n] = v; } };
struct EpiResid { const float* xs; float* xo; __device__ __forceinline__ void operator()(int t, int n, float v) const { xo[(size_t)t * 1024 + n] = xs[(size_t)t * 1024 + n] + v; } };

__global__ void __launch_bounds__(256) k_ref_epi1(const float* __restrict__ C, int cc, int kind, const float* pool_w, const float* pool_scale,
                                                  const float* gain, int rotary, float outscale, const int* positions, bf16* PROJ) {
    __shared__ float row[256];
    const int t = blockIdx.x, j = threadIdx.x;
    row[j] = C[(size_t)t * 256 + j];
    __syncthreads();
    float out;
    if (kind == 0) {
        const int g = 2 * cc + (j >> 7), d = j & 127; float s = 0.f;
        for (int c = 0; c < 128; ++c) s += row[(j & 128) + c] * pool_w[((size_t)g * 128 + c) * 128 + d];
        out = s * pool_scale[g * 128 + d];
    } else if (kind == 1) {
        const int dim = j & 63; float v = row[j];
        const float ss = wsum(v * v);
        v = v * rsqrtf(ss * (1.0f / 64.0f) + RMS_EPS) * gain[dim];
        if (rotary) {
            const float other = __shfl_xor(v, 8);
            if (dim < 16) {
                const int i = dim & 7; const float invf = powf(500000.0f, -(float)(2 * i) / 16.0f);
                const float ang = (float)positions[t] * invf; const float c = cosf(ang), s = sinf(ang);
                v = (dim < 8) ? (v * c - other * s) : (v * c + other * s);
            }
        }
        out = v * outscale;
    } else out = row[j];
    PROJ[(size_t)t * 3584 + 256 * cc + j] = f2b(out);
}
__global__ void k_ref_logf(const float* __restrict__ C8, const float* fb, float* LOGF) {
    const int i = blockIdx.x * blockDim.x + threadIdx.x; if (i >= T * 8) return;
    const float v = C8[i] + fb[i & 7];
    LOGF[i] = fminf(v, 0.f) - log1pf(expf(-fabsf(v)));
}
__global__ void k_ref_fscan(const float* __restrict__ LOGF, float* FCUM) {
    const int i = threadIdx.x; if (i >= 64) return; const int b = i >> 3, h = i & 7; float s = 0.f;
    for (int t = 0; t < S; ++t) { s += LOGF[((size_t)b * S + t) * 8 + h]; FCUM[((size_t)b * S + t) * 8 + h] = s; }
}
__global__ void __launch_bounds__(256) k_ref_fox(const bf16* __restrict__ PROJ, const float* __restrict__ FCUM, bf16* XY) {
    __shared__ float P[4][S];
    const int w = threadIdx.x >> 6, lane = threadIdx.x & 63; const int gw = blockIdx.x * 4 + w; const int t = gw >> 3, h = gw & 7; const int b = t / S, sq = t % S;
    float q[64];
#pragma unroll
    for (int d = 0; d < 64; ++d) q[d] = bf2f(PROJ[(size_t)t * 3584 + 2048 + h * 64 + d]);
    const float Ft = FCUM[(size_t)t * 8 + h];
    float m = -INFINITY;
    for (int j = lane; j <= sq; j += 64) { const bf16* kr = PROJ + ((size_t)b * S + j) * 3584 + 2560 + h * 64; float s = 0.f;
#pragma unroll
        for (int d = 0; d < 64; ++d) s += q[d] * bf2f(kr[d]);
        s += (Ft - FCUM[((size_t)b * S + j) * 8 + h]) * 1.4426950408889634f; P[w][j] = s; m = fmaxf(m, s); }
    m = wmax(m); float l = 0.f;
    for (int j = lane; j <= sq; j += 64) { const float p = exp2f(P[w][j] - m); P[w][j] = p; l += p; }
    l = wsum(l);
    __syncthreads();
    float o = 0.f;
    for (int j = 0; j <= sq; ++j) o += P[w][j] * bf2f(PROJ[((size_t)b * S + j) * 3584 + 3072 + h * 64 + lane]);
    XY[(size_t)t * 2560 + 1024 + h * 64 + lane] = f2b(o / l);
}
__global__ void __launch_bounds__(128) k_ref_diff(const bf16* __restrict__ PROJ, const float* __restrict__ lamp, const float* __restrict__ gsub, float lam_init, bf16* XY) {
    __shared__ float P[2][2][S];
    const int w = threadIdx.x >> 6, lane = threadIdx.x & 63; const int gw = blockIdx.x * 2 + w; const int t = gw >> 2, h = gw & 3; const int b = t / S, sq = t % S;
    float lam; { const float a = wsum(lamp[lane] * lamp[64 + lane]), c = wsum(lamp[128 + lane] * lamp[192 + lane]); lam = expf(a) - expf(c) + lam_init; }
    float linv[2];
    for (int c = 0; c < 2; ++c) {
        float q[64];
#pragma unroll
        for (int d = 0; d < 64; ++d) q[d] = bf2f(PROJ[(size_t)t * 3584 + 512 + (h * 2 + c) * 64 + d]);
        float m = -INFINITY;
        for (int j = lane; j <= sq; j += 64) { const bf16* kr = PROJ + ((size_t)b * S + j) * 3584 + 1024 + (h * 2 + c) * 64; float s = 0.f;
    #pragma unroll
        for (int d = 0; d < 64; ++d) s += q[d] * bf2f(kr[d]);
            P[w][c][j] = s; m = fmaxf(m, s); }
        m = wmax(m); float l = 0.f;
        for (int j = lane; j <= sq; j += 64) { const float p = exp2f(P[w][c][j] - m); P[w][c][j] = p; l += p; }
        linv[c] = 1.0f / wsum(l);
    }
    __syncthreads();
    float o0 = 0.f, o1 = 0.f;
    for (int j = 0; j <= sq; ++j) { const float a = P[w][0][j] * linv[0] - lam * P[w][1][j] * linv[1]; const bf16* vr = PROJ + ((size_t)b * S + j) * 3584 + 1536 + h * 128;
        o0 += a * bf2f(vr[lane]); o1 += a * bf2f(vr[64 + lane]); }
    const float ss = wsum(o0 * o0 + o1 * o1); const float r = rsqrtf(ss * (1.0f / 128.0f) + RMS_EPS) * (1.0f - lam_init);
    XY[(size_t)t * 2560 + 512 + h * 128 + lane] = f2b(o0 * r * gsub[lane]);
    XY[(size_t)t * 2560 + 512 + h * 128 + 64 + lane] = f2b(o1 * r * gsub[64 + lane]);
}
__global__ void k_ref_pool(const bf16* __restrict__ PROJ, bf16* XY) {
    const int i = blockIdx.x * blockDim.x + threadIdx.x; if (i >= T * 512) return; const int t = i >> 9, j = i & 511; const int g = j >> 7, w = 2 << g, s = t % S;
    const int cnt = min(s + 1, w); float a = 0.f;
    for (int k = 0; k < cnt; ++k) a += bf2f(PROJ[(size_t)(t - k) * 3584 + j]);
    XY[(size_t)t * 2560 + j] = f2b(a / (float)cnt - bf2f(PROJ[(size_t)t * 3584 + j]));
}
__global__ void __launch_bounds__(256) k_ref_gemm2(const float* __restrict__ x, const float* __restrict__ SS, const float* __restrict__ g, const float* __restrict__ w_in_l,
                                                   const float* __restrict__ w_branch_l, const bf16* __restrict__ XY, bf16* MERGED) {
    __shared__ float sA[16][65], sB[16][65];
    const int tx = threadIdx.x & 15, ty = threadIdx.x >> 4, t0 = blockIdx.y * 64, n0 = blockIdx.x * 64;
    float mg[4][4] = {};
    for (int n = 0; n < 3; ++n) {
        float ag[4][4] = {}, ab[4][4] = {};
        for (int pass = 0; pass < 2; ++pass) {
            const int K = pass == 0 ? 1024 : 512;
            for (int k0 = 0; k0 < K; k0 += 16) {
                for (int e = threadIdx.x; e < 1024; e += 256) { const int r = e >> 4, kk = e & 15; const int t = t0 + r, k = k0 + kk;
                    sA[kk][r] = pass == 0 ? x[(size_t)t * 1024 + k] * SS[t] * g[k] : bf2f(XY[(size_t)t * 2560 + 512 * n + k]); }
                for (int e = threadIdx.x; e < 1024; e += 256) { const int kk = e >> 6, c = e & 63; const int k = k0 + kk;
                    sB[kk][c] = pass == 0 ? w_in_l[(size_t)k * INW + 3592 + n * 1024 + n0 + c] : w_branch_l[((size_t)n * 512 + k) * 1024 + n0 + c]; }
                __syncthreads();
#pragma unroll
                for (int kk = 0; kk < 16; ++kk) {
                    float a[4], b[4];
#pragma unroll
                    for (int i = 0; i < 4; ++i) { a[i] = sA[kk][ty * 4 + i]; b[i] = sB[kk][tx * 4 + i]; }
#pragma unroll
                    for (int i = 0; i < 4; ++i)
#pragma unroll
                        for (int j = 0; j < 4; ++j) { if (pass == 0) ag[i][j] += a[i] * b[j]; else ab[i][j] += a[i] * b[j]; }
                }
                __syncthreads();
            }
        }
#pragma unroll
        for (int i = 0; i < 4; ++i)
#pragma unroll
            for (int j = 0; j < 4; ++j) mg[i][j] += ab[i][j] / (1.0f + expf(-ag[i][j]));
    }
#pragma unroll
    for (int i = 0; i < 4; ++i)
#pragma unroll
        for (int j = 0; j < 4; ++j) MERGED[(size_t)(t0 + ty * 4 + i) * 1024 + n0 + tx * 4 + j] = f2b(mg[i][j]);
}
__global__ void __launch_bounds__(256) k_ref_moe(float* X, const float* __restrict__ SS, const float* __restrict__ g, const int* __restrict__ cls_cnt, const int* __restrict__ LIST,
                                                 const float* __restrict__ TOKW, const float* __restrict__ wg_l, const float* __restrict__ wu_l, const float* __restrict__ wd_l) {
    __shared__ float h[8][1024]; __shared__ float act[8][512]; __shared__ int tok[8];
    const int cls = blockIdx.y, n_c = cls_cnt[cls], base = blockIdx.x * 8; if (base >= n_c) return;
    const int nt = min(8, n_c - base), tid = threadIdx.x;
    if (tid < 8) tok[tid] = tid < nt ? LIST[(size_t)cls * T + base + tid] : -1;
    __syncthreads();
    for (int e = tid; e < 8 * 1024; e += 256) { const int i = e >> 10, k = e & 1023; const int t = tok[i]; h[i][k] = t >= 0 ? X[(size_t)t * 1024 + k] * SS[t] * g[k] : 0.f; }
    __syncthreads();
    const int grp = cls / 6, pr = cls % 6; const int pa = pr < 3 ? 0 : (pr < 5 ? 1 : 2), pb = pr < 3 ? pr + 1 : (pr < 5 ? pr - 1 : 3); const int ea = grp * 4 + pa, eb = grp * 4 + pb;
    for (int s = 0; s < 2; ++s) { const int e = s ? eb : ea; float ga[8], ua[8];
#pragma unroll
        for (int i = 0; i < 8; ++i) { ga[i] = 0.f; ua[i] = 0.f; }
        const float* wg = wg_l + (size_t)e * 1024 * 256 + tid; const float* wu = wu_l + (size_t)e * 1024 * 256 + tid;
        for (int k = 0; k < 1024; ++k) { const float a = wg[(size_t)k * 256], u = wu[(size_t)k * 256];
#pragma unroll
            for (int i = 0; i < 8; ++i) { ga[i] += h[i][k] * a; ua[i] += h[i][k] * u; } }
#pragma unroll
        for (int i = 0; i < 8; ++i) { const int t = tok[i]; const float w = t >= 0 ? TOKW[(size_t)t * 4 + s] : 0.f; act[i][s * 256 + tid] = ga[i] / (1.0f + expf(-ga[i])) * ua[i] * w; } }
    __syncthreads();
    for (int j = 0; j < 4; ++j) { const int n = tid + 256 * j; float y[8];
#pragma unroll
        for (int i = 0; i < 8; ++i) y[i] = 0.f;
        for (int s = 0; s < 2; ++s) { const int e = s ? eb : ea; const float* wd = wd_l + (size_t)e * 256 * 1024 + n;
            for (int f = 0; f < 256; ++f) { const float w = wd[(size_t)f * 1024];
#pragma unroll
                for (int i = 0; i < 8; ++i) y[i] += act[i][s * 256 + f] * w; } }
#pragma unroll
        for (int i = 0; i < 8; ++i) { const int t = tok[i]; if (t >= 0) X[(size_t)t * 1024 + n] += y[i]; } }
}
__global__ void __launch_bounds__(256) k_ref_ple(const float* __restrict__ x, const float* __restrict__ SS, const float* __restrict__ g, const float* __restrict__ wgate_l,
                                                 const float* __restrict__ p_l, const float* __restrict__ wple_l, float* xo) {
    __shared__ float sA[16][65], sB[16][65];
    const int tx = threadIdx.x & 15, ty = threadIdx.x >> 4, t0 = blockIdx.y * 64, n0 = blockIdx.x * 64;
    float ag[4][4] = {}, ab[4][4] = {};
    for (int pass = 0; pass < 2; ++pass) {
        const int K = pass == 0 ? 1024 : 256;
        for (int k0 = 0; k0 < K; k0 += 16) {
            for (int e = threadIdx.x; e < 1024; e += 256) { const int r = e >> 4, kk = e & 15; const int t = t0 + r, k = k0 + kk;
                sA[kk][r] = pass == 0 ? x[(size_t)t * 1024 + k] * SS[t] * g[k] : p_l[(size_t)t * 256 + k]; }
            for (int e = threadIdx.x; e < 1024; e += 256) { const int kk = e >> 6, c = e & 63; const int k = k0 + kk;
                sB[kk][c] = pass == 0 ? wgate_l[(size_t)k * 1024 + n0 + c] : wple_l[(size_t)k * 1024 + n0 + c]; }
            __syncthreads();
#pragma unroll
            for (int kk = 0; kk < 16; ++kk) {
                float a[4], b[4];
#pragma unroll
                for (int i = 0; i < 4; ++i) { a[i] = sA[kk][ty * 4 + i]; b[i] = sB[kk][tx * 4 + i]; }
#pragma unroll
                for (int i = 0; i < 4; ++i)
#pragma unroll
                    for (int j = 0; j < 4; ++j) { if (pass == 0) ag[i][j] += a[i] * b[j]; else ab[i][j] += a[i] * b[j]; }
            }
            __syncthreads();
        }
    }
#pragma unroll
    for (int i = 0; i < 4; ++i)
#pragma unroll
        for (int j = 0; j < 4; ++j) { const size_t o = (size_t)(t0 + ty * 4 + i) * 1024 + n0 + tx * 4 + j; xo[o] = x[o] + ab[i][j] / (1.0f + expf(-ag[i][j])); }
}
}
__device__ __forceinline__ int route_decide(const float (&dg)[4], const float (&de)[16], const float rstd, const float* __restrict__ brg, const float* __restrict__ bre, float& wa, float& wb) {
    float lg[4]; int gi = 0; float lmax;
#pragma unroll
    for (int e = 0; e < 4; ++e) lg[e] = rstd * dg[e] + brg[e];
    lmax = lg[0];
#pragma unroll
    for (int e = 1; e < 4; ++e) if (lg[e] > lmax) { lmax = lg[e]; gi = e; }
    float den = 0.f;
#pragma unroll
    for (int e = 0; e < 4; ++e) den += expf(lg[e] - lmax);
    const float gp = 1.0f / den;
    float el[4] = {0.f, 0.f, 0.f, 0.f};
#pragma unroll
    for (int gg = 0; gg < 4; ++gg)
#pragma unroll
        for (int e = 0; e < 4; ++e) if (gg == gi) el[e] = rstd * de[gg * 4 + e] + bre[gg * 4 + e];
    int i1 = 0; float m1 = el[0];
#pragma unroll
    for (int e = 1; e < 4; ++e) if (el[e] > m1) { m1 = el[e]; i1 = e; }
    int i2 = -1; float m2 = -INFINITY;
#pragma unroll
    for (int e = 0; e < 4; ++e) if (e != i1 && el[e] > m2) { m2 = el[e]; i2 = e; }
    const float r2 = expf(m2 - m1); const float w1 = gp / (1.0f + r2), w2 = gp * r2 / (1.0f + r2);
    const int a = min(i1, i2), b = max(i1, i2); const int pr = (a == 0) ? (b - 1) : ((a == 1) ? (b + 1) : 5); const int cls = gi * 6 + pr;
    wa = i1 == a ? w1 : w2; wb = i1 == a ? w2 : w1;
    return cls;
}
__device__ __forceinline__ int route_core(int t, int lane, const float* __restrict__ X, const float* __restrict__ g, const float* __restrict__ wrg, const float* __restrict__ brg,
                                          const float* __restrict__ wre, const float* __restrict__ bre, float* TOKW) {
    float ss = 0.f, dg[4] = {0.f, 0.f, 0.f, 0.f}, de[16];
#pragma unroll
    for (int e = 0; e < 16; ++e) de[e] = 0.f;
#pragma unroll 4
    for (int i = 0; i < 16; ++i) { const int k = lane + 64 * i; const float xv = X[(size_t)t * 1024 + k]; ss += xv * xv; const float h = xv * g[k];
        const float4 a = *(const float4*)(wrg + (size_t)k * 4); dg[0] += h * a.x; dg[1] += h * a.y; dg[2] += h * a.z; dg[3] += h * a.w;
#pragma unroll
        for (int q = 0; q < 4; ++q) { const float4 b = *(const float4*)(wre + (size_t)k * 16 + 4 * q); de[4 * q] += h * b.x; de[4 * q + 1] += h * b.y; de[4 * q + 2] += h * b.z; de[4 * q + 3] += h * b.w; } }
    ss = refp::wsum(ss);
#pragma unroll
    for (int e = 0; e < 4; ++e) dg[e] = refp::wsum(dg[e]);
#pragma unroll
    for (int e = 0; e < 16; ++e) de[e] = refp::wsum(de[e]);
    const float rstd = rsqrtf(ss * (1.0f / 1024.0f) + RMS_EPS);
    float wa, wb; const int cls = route_decide(dg, de, rstd, brg, bre, wa, wb);
    if (lane == 0) *(float4*)(TOKW + (size_t)t * 4) = make_float4(wa, wb, rstd, 0.f);
    return cls;
}
__device__ __forceinline__ void route_token(int t, int lane, const float* __restrict__ X, const float* __restrict__ g, const float* __restrict__ wrg, const float* __restrict__ brg,
                                            const float* __restrict__ wre, const float* __restrict__ bre, unsigned* cls_cnt, int* LIST, float* TOKW) {
    const int cls = route_core(t, lane, X, g, wrg, brg, wre, bre, TOKW);
    if (lane == 0) { const unsigned pos = atomicAdd(cls_cnt + cls, 1u); LIST[(size_t)cls * T + pos] = t; }
}
__global__ void __launch_bounds__(256) k_route(const float* X, const float* g, const float* wrg, const float* brg, const float* wre, const float* bre, unsigned* cls_cnt, int* LIST, float* TOKW) {
    const int t = blockIdx.x * 4 + (threadIdx.x >> 6);
    route_token(t, threadIdx.x & 63, X, g, wrg, brg, wre, bre, cls_cnt, LIST, TOKW);
}

namespace pg8 {
#define PG8_LAS __attribute__((address_space(3)))
typedef short bf16x8 __attribute__((ext_vector_type(8)));
typedef float f32x4 __attribute__((ext_vector_type(4)));
typedef unsigned u32x4 __attribute__((ext_vector_type(4)));
typedef int i32x4 __attribute__((ext_vector_type(4)));
typedef int i32x8 __attribute__((ext_vector_type(8)));
__device__ __forceinline__ i32x8 cat8(bf16x8 lo, bf16x8 hi) { const i32x4 a = __builtin_bit_cast(i32x4, lo), b = __builtin_bit_cast(i32x4, hi); return __builtin_shufflevector(a, b, 0, 1, 2, 3, 4, 5, 6, 7); }
constexpr int BM = 256, BK = 64, HALF = 128, HTB = HALF * BK * 2, STAGE_BYTES = 8 * HTB;

__host__ __device__ __forceinline__ int lds_byte(int r, int c) { const int st = (r >> 4) * 2 + (c >> 5), rr = r & 15, cc = c & 31, ob = rr * 64 + cc * 2; return st * 1024 + (ob ^ (((ob >> 9) & 1) << 5)); }
__host__ __device__ __forceinline__ void stage_rc(int b, int& R, int& C) { const int st = b / 1024, sb = b % 1024, swz = sb ^ (((sb >> 9) & 1) << 5); R = (st >> 1) * 16 + swz / 64; C = (st & 1) * 32 + (swz % 64) / 2; }
__host__ __device__ __forceinline__ int perm32(int rho) { const int n = rho >> 4, i = rho & 15; return 8 * (i >> 2) + 4 * n + (i & 3); }

struct Step { const char* A; const char* B; const int* rows; int nt, pm, pn, aux, nvalid, zero_after; };
__device__ __forceinline__ int rfl(int v) { return __builtin_amdgcn_readfirstlane(v); }
template <class P> __device__ __forceinline__ P rflp(P p) { const unsigned long long u = (unsigned long long)p; const unsigned lo = (unsigned)__builtin_amdgcn_readfirstlane((int)(unsigned)u), hi = (unsigned)__builtin_amdgcn_readfirstlane((int)(unsigned)(u >> 32)); return (P)(((unsigned long long)hi << 32) | lo); }
__device__ __forceinline__ void step_uniform(Step& s, int& ok) {
    s.A = rflp(s.A); s.B = rflp(s.B); s.rows = rflp(s.rows); s.nt = rfl(s.nt); s.pm = rfl(s.pm); s.pn = rfl(s.pn); s.aux = rfl(s.aux); s.nvalid = rfl(s.nvalid); s.zero_after = rfl(s.zero_after); ok = rfl(ok);
    asm volatile("" : "+s"(ok), "+s"(s.A), "+s"(s.B), "+s"(s.nt), "+s"(s.aux));
}

template <class E> __device__ __forceinline__ auto epi_prep(const E& e, const Step& s, int tid, int wid, int) -> decltype(e.prep(s, tid, wid), void()) { e.prep(s, tid, wid); }
template <class E> __device__ __forceinline__ void epi_prep(const E&, const Step&, int, int, long) {}
template <class Sched, class Epi, bool GATHER, bool ALIGN_EPI, bool F8 = false>
__device__ __forceinline__ void gemm_phase(const int tid, PG8_LAS unsigned char* lds, const unsigned lda, const unsigned ldb, const Sched& S, const Epi& E) {
    const int wid = __builtin_amdgcn_readfirstlane(tid >> 6), lane = tid & 63, wr = wid >> 2, wc = wid & 3, fr = lane & 15, fq = lane >> 4;
    int Rr[2], Cc[2]; unsigned voffB[2], cOA[2][2], nOA[2][2];
#pragma unroll
    for (int i = 0; i < 2; ++i) { stage_rc(tid * 16 + i * 8192, Rr[i], Cc[i]); const int Rb = (Rr[i] & ~31) + perm32(Rr[i] & 31); voffB[i] = (unsigned)Rb * ldb + (unsigned)Cc[i] * 2u; }
    const size_t kstep = (size_t)(BK * 2);
    const size_t hstepB = (size_t)HALF * ldb;
    const unsigned ldsw = (unsigned)wid * 1024u;
    const int aoff = lds_byte(wr * 64 + fr, fq * 8), boff = lds_byte(wc * 32 + fr, fq * 8);
#define PG8_SA(b, h) (((b) * 2 + (h)) * HTB)
#define PG8_SB(b, h) ((4 + (b) * 2 + (h)) * HTB)
#define PG8_STAGE_B(bufoff, gbase) do { _Pragma("unroll") for (int _i = 0; _i < 2; ++_i) \
        __builtin_amdgcn_global_load_lds((const unsigned*)((const char*)(gbase) + voffB[_i]), (PG8_LAS unsigned*)(lds + (bufoff) + ldsw + _i * 8192), 16, 0, 0); } while (0)
#define PG8_STAGE_A(bufoff, gbase, o0, o1) do { \
        __builtin_amdgcn_global_load_lds((const unsigned*)((const char*)(gbase) + (o0)), (PG8_LAS unsigned*)(lds + (bufoff) + ldsw), 16, 0, 0); \
        __builtin_amdgcn_global_load_lds((const unsigned*)((const char*)(gbase) + (o1)), (PG8_LAS unsigned*)(lds + (bufoff) + ldsw + 8192), 16, 0, 0); } while (0)
#define PG8_LDA(dst, b, h) do { _Pragma("unroll") for (int m = 0; m < 4; ++m) _Pragma("unroll") for (int k = 0; k < 2; ++k) dst[m][k] = *(const PG8_LAS bf16x8*)(lds + PG8_SA(b, h) + aoff + m * 2048 + k * 1024); } while (0)
#define PG8_LDB(dst, b, h) do { _Pragma("unroll") for (int n = 0; n < 2; ++n) _Pragma("unroll") for (int k = 0; k < 2; ++k) dst[n][k] = *(const PG8_LAS bf16x8*)(lds + PG8_SB(b, h) + boff + n * 2048 + k * 1024); } while (0)
#define PG8_MMA(ai, bj, At, Bt) do { __builtin_amdgcn_s_setprio(1); \
        if constexpr (F8) { _Pragma("unroll") for (int m = 0; m < 4; ++m) _Pragma("unroll") for (int n = 0; n < 2; ++n) \
            asm volatile("v_mfma_scale_f32_16x16x128_f8f6f4 %0, %1, %2, %0, %3, %3 op_sel_hi:[0,0,0]" : "+v"(acc[ai][bj][m][n]) : "v"(cat8(Bt[n][0], Bt[n][1])), "v"(cat8(At[m][0], At[m][1])), "v"(f8scale)); } \
        else { _Pragma("unroll") for (int m = 0; m < 4; ++m) _Pragma("unroll") for (int n = 0; n < 2; ++n) _Pragma("unroll") for (int k = 0; k < 2; ++k) \
            acc[ai][bj][m][n] = __builtin_amdgcn_mfma_f32_16x16x32_bf16(Bt[n][k], At[m][k], acc[ai][bj][m][n], 0, 0, 0); } \
        __builtin_amdgcn_s_setprio(0); } while (0)
#define PG8_WAIT_V(n) asm volatile("s_waitcnt vmcnt(" #n ")" ::: "memory")
#define PG8_WAIT_L(n) asm volatile("s_waitcnt lgkmcnt(" #n ")" ::: "memory")
#define PG8_BAR __builtin_amdgcn_s_barrier()
#define PG8_SCHED __builtin_amdgcn_sched_barrier(0)
#define PG8_AOFFS(dst, st) do { _Pragma("unroll") for (int _h = 0; _h < 2; ++_h) _Pragma("unroll") for (int _i = 0; _i < 2; ++_i) { \
        int _row = Rr[_i] + 128 * _h; if (GATHER) { _row = (st).rows[_row]; _row = _row < 0 ? 0 : _row; } \
        dst[_h][_i] = (unsigned)_row * lda + (unsigned)Cc[_i] * 2u; } } while (0)
    int f8scale = 0x7F7F7F7F; if constexpr (F8) asm volatile("" : "+v"(f8scale));
    Step cur, nxt; int ui = 0;
    { int ok_ = S.next(0, cur) ? 1 : 0; step_uniform(cur, ok_); if (!ok_) return; }
    f32x4 acc[2][2][4][2];
#pragma unroll
    for (int a = 0; a < 2; ++a)
#pragma unroll
        for (int b = 0; b < 2; ++b)
#pragma unroll
            for (int m = 0; m < 4; ++m)
#pragma unroll
                for (int n = 0; n < 2; ++n) acc[a][b][m][n] = (f32x4){0.f, 0.f, 0.f, 0.f};
    bf16x8 At[4][2], B0[2][2], B1[2][2];
    PG8_AOFFS(cOA, cur);
    epi_prep(E, cur, tid, wid, 0);
    const char* cA = cur.A; const char* cB = cur.B;
    PG8_STAGE_B(PG8_SB(0, 0), cB); PG8_STAGE_B(PG8_SB(0, 1), cB + hstepB); PG8_STAGE_A(PG8_SA(0, 0), cA, cOA[0][0], cOA[0][1]); PG8_STAGE_A(PG8_SA(0, 1), cA, cOA[1][0], cOA[1][1]);
    if (wr == 1) PG8_BAR;
    PG8_WAIT_V(2); PG8_BAR;
    PG8_STAGE_B(PG8_SB(1, 0), cB + kstep); PG8_STAGE_A(PG8_SA(1, 0), cA + kstep, cOA[0][0], cOA[0][1]); PG8_STAGE_B(PG8_SB(1, 1), cB + hstepB + kstep);
    PG8_WAIT_V(6); PG8_BAR;
#pragma clang loop unroll(disable)
    for (;;) {
        bool has_next = S.next(ui + 1, nxt);
        { int hn_ = has_next ? 1 : 0; step_uniform(nxt, hn_); has_next = hn_ != 0; }
        asm volatile("" : "+v"(voffB[0]), "+v"(voffB[1]));
        const char* nA = has_next ? nxt.A : cA; const char* nB = has_next ? nxt.B : cB;
        if (GATHER) { if (has_next) { PG8_AOFFS(nOA, nxt); } else {
#pragma unroll
            for (int _h = 0; _h < 2; ++_h)
#pragma unroll
                for (int _i = 0; _i < 2; ++_i) nOA[_h][_i] = cOA[_h][_i]; } }
        const int nt = cur.nt;
#pragma clang loop unroll(disable)
        for (int t = 0; t < nt; t += 2) {
            const bool last = (t == nt - 2);
            const char* a1 = cA + (size_t)(t + 1) * kstep;
            const char* a2 = last ? nA : cA + (size_t)(t + 2) * kstep; const char* b2 = last ? nB : cB + (size_t)(t + 2) * kstep;
            const char* a3 = a2 + kstep; const char* b3 = b2 + kstep;
            unsigned o00, o01, o10, o11;
            if (GATHER) { o00 = last ? nOA[0][0] : cOA[0][0]; o01 = last ? nOA[0][1] : cOA[0][1]; o10 = last ? nOA[1][0] : cOA[1][0]; o11 = last ? nOA[1][1] : cOA[1][1]; }
            else { o00 = cOA[0][0]; o01 = cOA[0][1]; o10 = cOA[1][0]; o11 = cOA[1][1]; }
            PG8_LDB(B0, 0, 0); PG8_LDB(B1, 0, 1); PG8_SCHED; PG8_LDA(At, 0, 0); PG8_STAGE_A(PG8_SA(1, 1), a1, cOA[1][0], cOA[1][1]);
            PG8_WAIT_V(8); PG8_WAIT_L(0); PG8_BAR; PG8_MMA(0, 0, At, B0); PG8_MMA(0, 1, At, B1); PG8_BAR; PG8_SCHED;
            PG8_LDA(At, 0, 1); PG8_STAGE_B(PG8_SB(0, 0), b2); PG8_STAGE_B(PG8_SB(0, 1), b2 + hstepB); PG8_STAGE_A(PG8_SA(0, 0), a2, o00, o01);
            PG8_WAIT_V(8); PG8_WAIT_L(0); PG8_BAR; PG8_MMA(1, 0, At, B0); PG8_MMA(1, 1, At, B1); PG8_BAR; PG8_SCHED;
            PG8_LDB(B0, 1, 0); PG8_LDB(B1, 1, 1); PG8_SCHED; PG8_LDA(At, 1, 0); PG8_STAGE_A(PG8_SA(0, 1), a2, o10, o11);
            PG8_WAIT_V(8); PG8_WAIT_L(0); PG8_BAR; PG8_MMA(0, 0, At, B0); PG8_MMA(0, 1, At, B1); PG8_BAR; PG8_SCHED;
            PG8_LDA(At, 1, 1); PG8_STAGE_B(PG8_SB(1, 0), b3); PG8_STAGE_B(PG8_SB(1, 1), b3 + hstepB); PG8_STAGE_A(PG8_SA(1, 0), a3, o00, o01);
            PG8_WAIT_V(8); PG8_WAIT_L(0); PG8_BAR; PG8_MMA(1, 0, At, B0); PG8_MMA(1, 1, At, B1); PG8_BAR; PG8_SCHED;
        }
        if constexpr (F8) { asm volatile("s_nop 15\n\ts_nop 15" ::: "memory"); }
        if constexpr (ALIGN_EPI) { if (wr == 0) PG8_BAR; }
        { int ln_; asm volatile("v_mbcnt_lo_u32_b32 %0, -1, 0\n\tv_mbcnt_hi_u32_b32 %0, -1, %0" : "=v"(ln_));
          E(acc, cur, wr, wc, ln_ & 15, ln_ >> 4); }
        if (!has_next) break;
        if (cur.zero_after) {
#pragma unroll
            for (int a = 0; a < 2; ++a)
#pragma unroll
                for (int b = 0; b < 2; ++b)
#pragma unroll
                    for (int m = 0; m < 4; ++m)
#pragma unroll
                        for (int n = 0; n < 2; ++n) acc[a][b][m][n] = (f32x4){0.f, 0.f, 0.f, 0.f};
        }
        cur = nxt; cA = nA; cB = nB; ++ui;
        if (GATHER) {
#pragma unroll
            for (int _h = 0; _h < 2; ++_h)
#pragma unroll
                for (int _i = 0; _i < 2; ++_i) cOA[_h][_i] = nOA[_h][_i]; }
        if constexpr (ALIGN_EPI) { if (wr == 1) PG8_BAR; }
    }
    PG8_WAIT_V(0);
    if constexpr (!ALIGN_EPI) { if (wr == 0) PG8_BAR; }
    PG8_BAR;
#undef PG8_SA
#undef PG8_SB
#undef PG8_STAGE_A
#undef PG8_STAGE_B
#undef PG8_LDA
#undef PG8_LDB
#undef PG8_MMA
#undef PG8_WAIT_V
#undef PG8_WAIT_L
#undef PG8_BAR
#undef PG8_SCHED
#undef PG8_AOFFS
}
}
#include <hip/hip_bf16.h>
namespace attn_body {
using hbf16=__hip_bfloat16;
using bf16x8=__attribute__((ext_vector_type(8)))short;
using s16x4=__attribute__((ext_vector_type(4)))short;
using f32x16=__attribute__((ext_vector_type(16)))float;
using u32x4=__attribute__((ext_vector_type(4)))unsigned;
constexpr int SEQ=2048,D=64,DM=3584;
constexpr int NW=8,QBLK=32,QB=QBLK*NW,KVBLK=64,NQB=SEQ/QB;
__device__ __forceinline__ int crow(int r,int hi){return (r&3)+8*(r>>2)+4*hi;}
#define SBAR() __builtin_amdgcn_sched_barrier(0)
__device__ __forceinline__ void cmask(f32x16&p0,f32x16&p1,int jb,int qrel,int hi){
  const float NEG=-INFINITY; int kb=64*jb+4*hi;
  #pragma unroll
  for(int r=0;r<16;++r){int kv=kb+(r&3)+8*(r>>2); if(kv>qrel)p0[r]=NEG; if(kv+32>qrel)p1[r]=NEG;}
}

constexpr int NSLOT=3, SLOTB=8192;
constexpr int LDS_K=0, LDS_V=NSLOT*SLOTB, LDS_WS=2*NSLOT*SLOTB, LDS_OST=LDS_WS+NW*64*4, LDS_BIAS=LDS_OST+NW*4096, LDS_SSQ=LDS_BIAS+SEQ*4, LDS_BYTES=LDS_SSQ+NW*32*4;
constexpr float C2=0.125f*1.4426950408889634f;
__device__ __forceinline__ void glds16(const void*gsrc,unsigned lds_dst){unsigned keep;
  asm volatile("s_mov_b32 %0, m0\n\ts_mov_b32 m0, %2\n\ts_nop 0\n\tglobal_load_lds_dwordx4 %1, off\n\ts_mov_b32 m0, %0":"=&s"(keep):"v"(gsrc),"s"(lds_dst):"memory");}
__device__ __forceinline__ float max3f(float a,float b,float c){float r;asm("v_max3_f32 %0, %1, %2, %3":"=v"(r):"v"(a),"v"(b),"v"(c));return r;}
__device__ __forceinline__ float max2f(float a,float b){float r;asm("v_max_f32_e32 %0, %1, %2":"=v"(r):"v"(a),"v"(b));return r;}
__device__ __forceinline__ float fadd_s(float a,float b){float r;asm("v_add_f32_e32 %0, %1, %2":"=v"(r):"v"(a),"v"(b));return r;}
__device__ __forceinline__ float fsub_s(float a,float b){float r;asm("v_sub_f32_e32 %0, %1, %2":"=v"(r):"v"(a),"v"(b));return r;}
typedef float f32x2_t __attribute__((ext_vector_type(2))); typedef float f32x4_t __attribute__((ext_vector_type(4))); typedef __bf16 bf16x2_t __attribute__((ext_vector_type(2)));
__device__ __forceinline__ unsigned cvtpk_s(float lo,float hi){f32x2_t v={lo,hi};bf16x2_t b=__builtin_convertvector(v,bf16x2_t);return __builtin_bit_cast(unsigned,b);}
#define WAIT_BAR(N) asm volatile("s_waitcnt vmcnt(" #N ") lgkmcnt(0)\n\ts_barrier":::"memory")

__device__ __forceinline__ void qkt(f32x16&p0,f32x16&p1,const char*Kslot,const bf16x8*qr,const f32x16&negm,int r32,int hi){
  const char*kb=Kslot+hi*1024+r32*16;
  #pragma unroll
  for(int d0=0;d0<4;++d0){
    const bf16x8 b0=*reinterpret_cast<const bf16x8*>(kb+d0*2048);
    const bf16x8 b1=*reinterpret_cast<const bf16x8*>(kb+d0*2048+512);
    if(d0==0){p0=__builtin_amdgcn_mfma_f32_32x32x16_bf16(b0,qr[0],negm,0,0,0);p1=__builtin_amdgcn_mfma_f32_32x32x16_bf16(b1,qr[0],negm,0,0,0);}
    else{p0=__builtin_amdgcn_mfma_f32_32x32x16_bf16(b0,qr[d0],p0,0,0,0);p1=__builtin_amdgcn_mfma_f32_32x32x16_bf16(b1,qr[d0],p1,0,0,0);}}
}
typedef __attribute__((address_space(3))) const char* lds_cptr;
typedef short v4i16_t __attribute__((ext_vector_type(4)));
__device__ __forceinline__ void kload8(bf16x8*kf,lds_cptr kp){
  kf[0]=*(const __attribute__((address_space(3))) bf16x8*)(kp);      kf[1]=*(const __attribute__((address_space(3))) bf16x8*)(kp+512);
  kf[2]=*(const __attribute__((address_space(3))) bf16x8*)(kp+2048); kf[3]=*(const __attribute__((address_space(3))) bf16x8*)(kp+2560);
  kf[4]=*(const __attribute__((address_space(3))) bf16x8*)(kp+4096); kf[5]=*(const __attribute__((address_space(3))) bf16x8*)(kp+4608);
  kf[6]=*(const __attribute__((address_space(3))) bf16x8*)(kp+6144); kf[7]=*(const __attribute__((address_space(3))) bf16x8*)(kp+6656);
}
__device__ __forceinline__ void kload2(bf16x8*kf,lds_cptr kp,int j){ kf[2*j]=*(const __attribute__((address_space(3))) bf16x8*)(kp+j*2048); kf[2*j+1]=*(const __attribute__((address_space(3))) bf16x8*)(kp+j*2048+512); }
__device__ __forceinline__ s16x4 vtr(lds_cptr p){ return __builtin_bit_cast(s16x4,__builtin_amdgcn_ds_read_tr16_b64_v4i16((__attribute__((address_space(3))) v4i16_t*)p)); }
__device__ __forceinline__ float rowmax(const f32x16&p0,const f32x16&p1){
  float a=max3f(p0[0],p0[1],p1[0]),b=max3f(p0[2],p0[3],p1[1]);a=max3f(a,p1[2],p1[3]);
  #pragma unroll
  for(int r=4;r<16;r+=4){a=max3f(a,p0[r],p0[r+1]);b=max3f(b,p0[r+2],p0[r+3]);a=max3f(a,p1[r],p1[r+1]);b=max3f(b,p1[r+2],p1[r+3]);}
  const float m=max2f(a,b);
  auto rr=__builtin_amdgcn_permlane32_swap(__float_as_uint(m),__float_as_uint(m),false,false);
  return max2f(__uint_as_float(rr[0]),__uint_as_float(rr[1]));
}
__device__ __forceinline__ void pv(f32x16*o,int vb,bf16x8 pa0,bf16x8 pa1,bf16x8 pa2,bf16x8 pa3){
  #pragma unroll
  for(int d0=0;d0<2;++d0){s16x4 lo[4],hi[4];
    #pragma unroll
    for(int ks=0;ks<4;++ks){
      asm volatile("ds_read_b64_tr_b16 %0,%1 offset:%c2":"=&v"(lo[ks]):"v"(vb),"i"(d0*4096+ks*1024):"memory");
      asm volatile("ds_read_b64_tr_b16 %0,%1 offset:%c2":"=&v"(hi[ks]):"v"(vb),"i"(d0*4096+ks*1024+512):"memory");}
    asm volatile("s_waitcnt lgkmcnt(0)":::"memory");SBAR();
    #define PK(k) (bf16x8){lo[k][0],lo[k][1],lo[k][2],lo[k][3],hi[k][0],hi[k][1],hi[k][2],hi[k][3]}
    o[d0]=__builtin_amdgcn_mfma_f32_32x32x16_bf16(pa0,PK(0),o[d0],0,0,0);
    o[d0]=__builtin_amdgcn_mfma_f32_32x32x16_bf16(pa1,PK(1),o[d0],0,0,0);
    o[d0]=__builtin_amdgcn_mfma_f32_32x32x16_bf16(pa2,PK(2),o[d0],0,0,0);
    o[d0]=__builtin_amdgcn_mfma_f32_32x32x16_bf16(pa3,PK(3),o[d0],0,0,0);
    #undef PK
  }
}

#ifndef ATTN_STORE16
#define ATTN_STORE16(p,v) (*(u32x4*)(p)=(v))
#endif
struct AttnP { const bf16* Q; const bf16* K; const bf16* V; bf16* out; bf16* stash; const float* gsub; const float* logf; int opitch; float lam, nscale; };
template<int THRL,bool FOX> __device__ __forceinline__ void attn_unit(const int tid_in,int b,int qb,const int MODE,const AttnP&P,char*shm){
  int tid=tid_in; asm volatile("":"+v"(tid));
  const int lane=tid&63,r32=lane&31,hi=lane>>5; const int wid=__builtin_amdgcn_readfirstlane(tid>>6);
  const long rowbase=(long)b*SEQ; const int q0=qb*QB;
  const bf16*Qw=P.Q+(rowbase+q0+wid*QBLK)*DM;
  const bf16*Kh=P.K+rowbase*DM,*Vh=P.V+rowbase*DM;
  const unsigned lds0=(unsigned)(uintptr_t)shm;
  float*wsf=(float*)(shm+LDS_WS)+wid*64;
  const float*biasL=(const float*)(shm+LDS_BIAS);
  #define BIAS(P0,P1,t) do{ if(FOX){ const float*bb_=biasL+64*(t)+4*hi; _Pragma("unroll") for(int g_=0;g_<4;++g_){ const f32x4_t b0_=*(const f32x4_t*)(bb_+8*g_), b1_=*(const f32x4_t*)(bb_+32+8*g_); \
      _Pragma("unroll") for(int e_=0;e_<4;++e_){ P0[4*g_+e_]+=b0_[e_]; P1[4*g_+e_]+=b1_[e_]; } asm volatile("":::"memory"); } } }while(0)
  const bf16*ksrc=Kh+(long)lane*DM+wid*8;
  const bf16*vsrc=Vh+(long)(16*(wid&3)+(lane>>2))*DM+(wid>>2)*32+(lane&3)*8;
  const unsigned kdst=lds0+LDS_K+wid*1024, vdst=lds0+LDS_V+wid*1024;
  #define DMA_K(t,slot) glds16(ksrc+(long)(t)*KVBLK*DM,(unsigned)__builtin_amdgcn_readfirstlane(kdst+(slot)))
  #define DMA_V(t,slot) glds16(vsrc+(long)(t)*KVBLK*DM,(unsigned)__builtin_amdgcn_readfirstlane(vdst+(slot)))
  const int vb0=(int)(lds0+LDS_V)+((lane>>4)&1)*32+(lane&3)*8+(4*hi+((lane&15)>>2))*64;
  const char*Kbase=shm+LDS_K; bf16x8 kf[8];
  const lds_cptr shm3=(lds_cptr)shm; const lds_cptr kp0=shm3+LDS_K+hi*1024+r32*16; const lds_cptr vp0=shm3+LDS_V+((lane>>4)&1)*32+(lane&3)*8+(4*hi+((lane&15)>>2))*64;
  const int NT=(q0+QB)/KVBLK;
  DMA_K(0,0);DMA_V(0,0);DMA_K(1,SLOTB);
  bf16x8 qr[4];
  #pragma unroll
  for(int d0=0;d0<4;++d0)qr[d0]=*reinterpret_cast<const bf16x8*>(&Qw[(long)r32*DM+d0*16+hi*8]);
  float mhat=0.f,l_reg=0.f;f32x16 o[2];o[0]=f32x16{};o[1]=f32x16{};f32x16 negm=f32x16{};asm volatile("":"+v"(negm));
  const int qrel=wid*QBLK+r32;
  #define CMASK(P0,P1,t) do{int jb_=(t)-(NT-4); if(jb_>=0)cmask(P0,P1,jb_,qrel,hi);}while(0)
  bool resc=false;
  #define START(P0,P1) do{ const float rm=rowmax(P0,P1); resc=false; \
    { const float dl=rm; mhat=fadd_s(mhat,dl); \
      _Pragma("unroll") for(int r=0;r<16;++r){P0[r]=fsub_s(P0[r],dl);P1[r]=fsub_s(P1[r],dl);} \
      _Pragma("unroll") for(int r=0;r<16;++r)negm[r]=-mhat; asm volatile("":"+v"(negm)); } \
    _Pragma("unroll") for(int r=0;r<16;++r)P0[r]=__builtin_amdgcn_exp2f(P0[r]); }while(0)
  #define RESC() do{ if(resc){ asm volatile("s_waitcnt lgkmcnt(0)":::"memory"); \
      _Pragma("unroll") for(int d_=0;d_<2;++d_) _Pragma("unroll") for(int r=0;r<16;++r)o[d_][r]*=wsf[crow(r,hi)]; } }while(0)
  f32x16 pA0,pA1,pB0,pB1;
  int sl_prev=0,sl_cur=0,sl_next=SLOTB;
  #define ROT() do{sl_prev=sl_cur;sl_cur=sl_next;sl_next=(sl_next==(NSLOT-1)*SLOTB)?0:sl_next+SLOTB;}while(0)
  DMA_K(2,2*SLOTB);
  if(FOX){
    const int n=q0+QB; float v4[4]; float run=0.f;
    _Pragma("unroll") for(int i=0;i<4;++i){ const int sidx=4*tid+i; const float lv=(sidx<n)?P.logf[(rowbase+sidx)*8]:0.f; run+=lv; v4[i]=run; }
    float inc=run; _Pragma("unroll") for(int o_=1;o_<64;o_<<=1){ const float up=__int_as_float(__builtin_amdgcn_ds_bpermute((lane-o_)<<2,__float_as_int(inc))); if(lane>=o_)inc+=up; }
    float*wt=(float*)(shm+LDS_WS); if(lane==63)wt[wid]=inc; __syncthreads();
    float pre=inc-run; _Pragma("unroll") for(int w_=0;w_<NW;++w_){ if(w_<wid)pre+=wt[w_]; }
    float*bw=(float*)(shm+LDS_BIAS); _Pragma("unroll") for(int i=0;i<4;++i){ const int sidx=4*tid+i; if(sidx<n)bw[sidx]=-(pre+v4[i])*1.4426950408889634f; }
    __syncthreads(); }
  WAIT_BAR(3);
  qkt(pA0,pA1,Kbase,qr,negm,r32,hi);asm volatile("s_nop 15\n\ts_nop 7":"+v"(pA0),"+v"(pA1));BIAS(pA0,pA1,0);CMASK(pA0,pA1,0);
  START(pA0,pA1);
  _Pragma("unroll") for(int r=0;r<16;++r)pA1[r]=__builtin_amdgcn_exp2f(pA1[r]);
  WAIT_BAR(0);
  DMA_K(3,0);DMA_V(1,SLOTB);
  ROT();
  kload8(kf,kp0+sl_cur);
  WAIT_BAR(2);
  s16x4 vlo[8],vhi[8]; u32x4 pw0,pw1,pw2,pw3;
  #define PKW(P,B) cvtpk_s(P[B],P[B+1])
  #define PAF(k) __builtin_bit_cast(bf16x8,pw##k)
  #define VFR(i) (bf16x8){vlo[i][0],vlo[i][1],vlo[i][2],vlo[i][3],vhi[i][0],vhi[i][1],vhi[i][2],vhi[i][3]}
  #define PIN(x) asm volatile("":"+v"(x))
  #define MX3(a,b,c) __builtin_fmaxf(__builtin_fmaxf((a),(b)),(c))
  #define GAPA(MF,A0,A1,A2,A3,W0,W1,PW) do{ MF; sacc+=A0; sacc+=A1; sacc+=A2; sacc+=A3; PIN(sacc); W0; W1; PIN(PW); SBAR(); }while(0)
  #define EX(v) __builtin_amdgcn_exp2f(v)
  #define GAPB(MF,X,B) do{ MF; X[B]=EX(X[B]); X[B+1]=EX(X[B+1]); X[B+2]=EX(X[B+2]); X[B+3]=EX(X[B+3]); PIN(X); SBAR(); }while(0)
  #define VRD(i) do{ vlo[i]=vtr(vp_+(((i)>>2)*4096+((i)&3)*1024)); vhi[i]=vtr(vp_+(((i)>>2)*4096+((i)&3)*1024+512)); }while(0)
  #define KRD(G,j) do{ if(G){ kload2(kf,kp0+sl_next,j); SBAR(); } }while(0)
  #define STEP(C0,C1,P0,P1,t,GK,GV,GL) do{ SBAR(); \
    const lds_cptr vp_=vp0+sl_prev; \
    VRD(0); SBAR(); float sacc=(P0[0]+P0[1]); \
    GAPA(C0=__builtin_amdgcn_mfma_f32_32x32x16_bf16(kf[0],qr[0],negm,0,0,0), P0[2],P0[3],P0[4],P0[5],     pw0[0]=PKW(P0,0), pw0[1]=PKW(P0,2), pw0); \
    VRD(4); SBAR(); GAPA(C1=__builtin_amdgcn_mfma_f32_32x32x16_bf16(kf[1],qr[0],negm,0,0,0), P0[6],P0[7],P0[8],P0[9],     pw0[2]=PKW(P0,4), pw0[3]=PKW(P0,6), pw0); \
    VRD(1); SBAR(); GAPA(C0=__builtin_amdgcn_mfma_f32_32x32x16_bf16(kf[2],qr[1],C0,0,0,0),   P0[10],P0[11],P0[12],P0[13], pw1[0]=PKW(P0,8), pw1[1]=PKW(P0,10), pw1); \
    VRD(5); SBAR(); GAPA(C1=__builtin_amdgcn_mfma_f32_32x32x16_bf16(kf[3],qr[1],C1,0,0,0),   P0[14],P0[15],P1[0],P1[1],   pw1[2]=PKW(P0,12),pw1[3]=PKW(P0,14), pw1); \
    VRD(2); SBAR(); GAPA(C0=__builtin_amdgcn_mfma_f32_32x32x16_bf16(kf[4],qr[2],C0,0,0,0),   P1[2],P1[3],P1[4],P1[5],     pw2[0]=PKW(P1,0), pw2[1]=PKW(P1,2), pw2); \
    VRD(6); SBAR(); GAPA(C1=__builtin_amdgcn_mfma_f32_32x32x16_bf16(kf[5],qr[2],C1,0,0,0),   P1[6],P1[7],P1[8],P1[9],     pw2[2]=PKW(P1,4), pw2[3]=PKW(P1,6), pw2); \
    VRD(3); SBAR(); GAPA(C0=__builtin_amdgcn_mfma_f32_32x32x16_bf16(kf[6],qr[3],C0,0,0,0),   P1[10],P1[11],P1[12],P1[13], pw3[0]=PKW(P1,8), pw3[1]=PKW(P1,10), pw3); \
    VRD(7); SBAR(); GAPA(C1=__builtin_amdgcn_mfma_f32_32x32x16_bf16(kf[7],qr[3],C1,0,0,0),   P1[14],P1[15],0.f,0.f,       pw3[2]=PKW(P1,12),pw3[3]=PKW(P1,14), pw3); \
    l_reg+=sacc; \
    if(GK){DMA_K((t)+3,sl_cur);} if(GV){DMA_V((t)+1,sl_next);} \
    BIAS(C0,C1,t); CMASK(C0,C1,t); \
    { float a=MX3(C0[0],C0[1],C1[0]),b=MX3(C0[2],C0[3],C1[1]); a=MX3(a,C1[2],C1[3]); \
      _Pragma("unroll") for(int r=4;r<16;r+=4){a=MX3(a,C0[r],C0[r+1]);b=MX3(b,C0[r+2],C0[r+3]);a=MX3(a,C1[r],C1[r+1]);b=MX3(b,C1[r+2],C1[r+3]);} \
      float rm=__builtin_fmaxf(a,b); { auto rr=__builtin_amdgcn_permlane32_swap(__float_as_uint(rm),__float_as_uint(rm),false,false); rm=__builtin_fmaxf(__uint_as_float(rr[0]),__uint_as_float(rr[1])); } \
      resc=false; \
      if(__builtin_expect(__any(rm>(float)THRL),0)){ const float dl=__builtin_fmaxf(rm,0.f); mhat+=dl; \
        _Pragma("unroll") for(int r=0;r<16;++r){C0[r]-=dl;C1[r]-=dl;} \
        _Pragma("unroll") for(int r=0;r<16;++r)negm[r]=-mhat; asm volatile("":"+v"(negm)); \
        const float f=__builtin_amdgcn_exp2f(-dl); l_reg*=f; if(hi==0)wsf[r32]=f; resc=true; } } \
    SBAR(); \
    GAPB(o[0]=__builtin_amdgcn_mfma_f32_32x32x16_bf16(PAF(0),VFR(0),o[0],0,0,0), C0,0); \
    GAPB(o[1]=__builtin_amdgcn_mfma_f32_32x32x16_bf16(PAF(0),VFR(4),o[1],0,0,0), C0,4); \
    KRD(GL,0); GAPB(o[0]=__builtin_amdgcn_mfma_f32_32x32x16_bf16(PAF(1),VFR(1),o[0],0,0,0), C0,8); \
    KRD(GL,1); GAPB(o[1]=__builtin_amdgcn_mfma_f32_32x32x16_bf16(PAF(1),VFR(5),o[1],0,0,0), C0,12); \
    KRD(GL,2); GAPB(o[0]=__builtin_amdgcn_mfma_f32_32x32x16_bf16(PAF(2),VFR(2),o[0],0,0,0), C1,0); \
    KRD(GL,3); GAPB(o[1]=__builtin_amdgcn_mfma_f32_32x32x16_bf16(PAF(2),VFR(6),o[1],0,0,0), C1,4); \
    GAPB(o[0]=__builtin_amdgcn_mfma_f32_32x32x16_bf16(PAF(3),VFR(3),o[0],0,0,0), C1,8); \
    GAPB(o[1]=__builtin_amdgcn_mfma_f32_32x32x16_bf16(PAF(3),VFR(7),o[1],0,0,0), C1,12); \
    }while(0)
  int t=1;
  #undef CMASK
  #define CMASK(P0,P1,t) do{}while(0)
  for(;t+5<NT;t+=2){
    STEP(pB0,pB1,pA0,pA1,t,true,true,true);     WAIT_BAR(2); RESC(); ROT();
    STEP(pA0,pA1,pB0,pB1,t+1,true,true,true);   WAIT_BAR(2); RESC(); ROT();
  }
  #undef CMASK
  #define CMASK(P0,P1,t) do{int jb_=(t)-(NT-4); if(jb_>=0)cmask(P0,P1,jb_,qrel,hi);}while(0)
  #define ENDW(tt) do{ if((tt)+3<NT){WAIT_BAR(2);} else if((tt)+2<NT){WAIT_BAR(1);} else {WAIT_BAR(0);} }while(0)
  for(;t+1<NT;t+=2){
    STEP(pB0,pB1,pA0,pA1,t,(t+3<NT),(t+1<NT),(t+1<NT));       ENDW(t);   RESC(); ROT();
    STEP(pA0,pA1,pB0,pB1,t+1,(t+4<NT),(t+2<NT),(t+2<NT));     ENDW(t+1); RESC(); ROT();
  }
  STEP(pB0,pB1,pA0,pA1,NT-1,false,false,false); RESC();
  { float sacc=pB0[0]+pB0[1]; _Pragma("unroll") for(int r=2;r<16;++r)sacc+=pB0[r]; _Pragma("unroll") for(int r=0;r<16;++r)sacc+=pB1[r]; l_reg+=sacc;
    pw0=(u32x4){PKW(pB0,0),PKW(pB0,2),PKW(pB0,4),PKW(pB0,6)};pw1=(u32x4){PKW(pB0,8),PKW(pB0,10),PKW(pB0,12),PKW(pB0,14)};pw2=(u32x4){PKW(pB1,0),PKW(pB1,2),PKW(pB1,4),PKW(pB1,6)};pw3=(u32x4){PKW(pB1,8),PKW(pB1,10),PKW(pB1,12),PKW(pB1,14)};
    SBAR(); pv(o,vb0+sl_cur,PAF(0),PAF(1),PAF(2),PAF(3)); }
  #undef PKW
  #undef PAF
  #undef VFR
  #undef PIN
  #undef MX3
  #undef GAPA
  #undef GAPB
  #undef EX
  #undef VRD
  #undef KRD
  #undef STEP
  #undef ENDW
  {auto rr=__builtin_amdgcn_permlane32_swap(__float_as_uint(l_reg),__float_as_uint(l_reg),false,false);l_reg=__uint_as_float(rr[0])+__uint_as_float(rr[1]);}
  if(hi==0)wsf[32+r32]=l_reg;asm volatile("s_waitcnt lgkmcnt(0)":::"memory");
  float rli[16];
  #pragma unroll
  for(int r=0;r<16;++r)rli[r]=__builtin_amdgcn_rcpf(wsf[32+crow(r,hi)]);
  { hbf16*stg=(hbf16*)(shm+LDS_OST)+wid*2048;
    #pragma unroll
    for(int r=0;r<16;++r){const int orow=crow(r,hi);
      #pragma unroll
      for(int d0=0;d0<2;++d0)stg[orow*64+d0*32+r32]=__float2bfloat16(o[d0][r]*rli[r]);}
    asm volatile("s_waitcnt lgkmcnt(0)":::"memory");
    const long grow=rowbase+q0+wid*QBLK; float*ssq=(float*)(shm+LDS_SSQ)+wid*32;
    int lane_e=lane; asm volatile("":"+v"(lane_e));
    #pragma unroll
    for(int i=0;i<4;++i){const int row=i*8+(lane_e>>3),ch=lane_e&7; const u32x4 v=*(const u32x4*)(stg+row*64+ch*8);
      if(MODE==0){ *(u32x4*)(P.out+(grow+row)*(long)P.opitch+ch*8)=v; }
      else { bf16*sp=P.stash+(grow+row)*512+ch*8+(MODE==2?64:0); const u32x4 a=*(const u32x4*)sp; float of[8]; float ss=0.f;
        #pragma unroll
        for(int j=0;j<4;++j){ const float a0=__uint_as_float(a[j]<<16),a1=__uint_as_float(a[j]&0xffff0000u),c0=__uint_as_float(v[j]<<16),c1=__uint_as_float(v[j]&0xffff0000u);
          of[2*j]=a0-P.lam*c0; of[2*j+1]=a1-P.lam*c1; ss+=of[2*j]*of[2*j]+of[2*j+1]*of[2*j+1]; }
        ss+=__int_as_float(__builtin_amdgcn_ds_swizzle(__float_as_int(ss),0x041f)); ss+=__int_as_float(__builtin_amdgcn_ds_swizzle(__float_as_int(ss),0x081f)); ss+=__int_as_float(__builtin_amdgcn_ds_swizzle(__float_as_int(ss),0x101f));
        if(MODE==1){ if(ch==0)ssq[row]=ss; u32x4 w; _Pragma("unroll") for(int j=0;j<4;++j)w[j]=cvtpk_s(of[2*j],of[2*j+1]); *(u32x4*)sp=w; }
        else { const float rr_=rsqrtf((ss+ssq[row])*(1.0f/128.0f)+1e-6f)*P.nscale; bf16*yp=P.out+(grow+row)*(long)P.opitch+ch*8;
          const f32x4_t g0=*(const f32x4_t*)(P.gsub+64+ch*8), g1=*(const f32x4_t*)(P.gsub+64+ch*8+4), h0=*(const f32x4_t*)(P.gsub+ch*8), h1=*(const f32x4_t*)(P.gsub+ch*8+4);
          u32x4 w; w[0]=cvtpk_s(of[0]*rr_*g0[0],of[1]*rr_*g0[1]); w[1]=cvtpk_s(of[2]*rr_*g0[2],of[3]*rr_*g0[3]); w[2]=cvtpk_s(of[4]*rr_*g1[0],of[5]*rr_*g1[1]); w[3]=cvtpk_s(of[6]*rr_*g1[2],of[7]*rr_*g1[3]);
          *(u32x4*)(yp+64)=w;
          const u32x4 lo=*(const u32x4*)(sp-64); float lf[8];
          #pragma unroll
          for(int j=0;j<4;++j){ lf[2*j]=__uint_as_float(lo[j]<<16); lf[2*j+1]=__uint_as_float(lo[j]&0xffff0000u); }
          w[0]=cvtpk_s(lf[0]*rr_*h0[0],lf[1]*rr_*h0[1]); w[1]=cvtpk_s(lf[2]*rr_*h0[2],lf[3]*rr_*h0[3]); w[2]=cvtpk_s(lf[4]*rr_*h1[0],lf[5]*rr_*h1[1]); w[3]=cvtpk_s(lf[6]*rr_*h1[2],lf[7]*rr_*h1[3]);
          *(u32x4*)yp=w; } } } }
  asm volatile("s_waitcnt lgkmcnt(0)\n\ts_barrier":::"memory");
  #undef DMA_K
  #undef BIAS
  #undef DMA_V
  #undef CMASK
  #undef START
  #undef RESC
  #undef ROT
}
__device__ __forceinline__ void pv128(f32x16*o,int vb,bf16x8 pa0,bf16x8 pa1,bf16x8 pa2,bf16x8 pa3){
  #pragma unroll
  for(int d0=0;d0<4;++d0){s16x4 lo[4],hi[4];
    #pragma unroll
    for(int ks=0;ks<4;++ks){
      asm volatile("ds_read_b64_tr_b16 %0,%1 offset:%c2":"=&v"(lo[ks]):"v"(vb),"i"(d0*4096+ks*1024):"memory");
      asm volatile("ds_read_b64_tr_b16 %0,%1 offset:%c2":"=&v"(hi[ks]):"v"(vb),"i"(d0*4096+ks*1024+512):"memory");}
    asm volatile("s_waitcnt lgkmcnt(0)":::"memory");SBAR();
    #define PK(k) (bf16x8){lo[k][0],lo[k][1],lo[k][2],lo[k][3],hi[k][0],hi[k][1],hi[k][2],hi[k][3]}
    o[d0]=__builtin_amdgcn_mfma_f32_32x32x16_bf16(pa0,PK(0),o[d0],0,0,0);
    o[d0]=__builtin_amdgcn_mfma_f32_32x32x16_bf16(pa1,PK(1),o[d0],0,0,0);
    o[d0]=__builtin_amdgcn_mfma_f32_32x32x16_bf16(pa2,PK(2),o[d0],0,0,0);
    o[d0]=__builtin_amdgcn_mfma_f32_32x32x16_bf16(pa3,PK(3),o[d0],0,0,0);
    #undef PK
  }
}
template<int THRL> __device__ __forceinline__ void attn_unit128(const int tid_in,int b,int qb,const int MODE,const AttnP&P,char*shm){
  constexpr bool FOX=false; constexpr int LDS_V=24576, LDS_WS=73728, LDS_OST=75776, SLOTV=16384;
  int tid=tid_in; asm volatile("":"+v"(tid));
  const int lane=tid&63,r32=lane&31,hi=lane>>5; const int wid=__builtin_amdgcn_readfirstlane(tid>>6);
  const long rowbase=(long)b*SEQ; const int q0=qb*QB;
  const bf16*Qw=P.Q+(rowbase+q0+wid*QBLK)*DM;
  const bf16*Kh=P.K+rowbase*DM,*Vh=P.V+rowbase*DM;
  const unsigned lds0=(unsigned)(uintptr_t)shm;
  float*wsf=(float*)(shm+LDS_WS)+wid*64;
  const float*biasL=(const float*)(shm+LDS_BIAS);
  #define BIAS(P0,P1,t) do{ if(FOX){ const float*bb_=biasL+64*(t)+4*hi; _Pragma("unroll") for(int g_=0;g_<4;++g_){ const f32x4_t b0_=*(const f32x4_t*)(bb_+8*g_), b1_=*(const f32x4_t*)(bb_+32+8*g_); \
      _Pragma("unroll") for(int e_=0;e_<4;++e_){ P0[4*g_+e_]+=b0_[e_]; P1[4*g_+e_]+=b1_[e_]; } asm volatile("":::"memory"); } } }while(0)
  const bf16*ksrc=Kh+(long)lane*DM+wid*8;
  const bf16*vsrc=Vh+(long)(16*(wid&3)+(lane>>2))*DM+(wid>>2)*32+(lane&3)*8;
  const unsigned kdst=lds0+LDS_K+wid*1024, vdst=lds0+LDS_V+wid*1024;
  #define DMA_K(t,slot) glds16(ksrc+(long)(t)*KVBLK*DM,(unsigned)__builtin_amdgcn_readfirstlane(kdst+(slot)))
  #define DMA_V(t,slot) do{ glds16(vsrc+(long)(t)*KVBLK*DM,(unsigned)__builtin_amdgcn_readfirstlane(vdst+2*(slot))); glds16(vsrc+(long)(t)*KVBLK*DM+64,(unsigned)__builtin_amdgcn_readfirstlane(vdst+2*(slot)+8192)); }while(0)
  const int vb0=(int)(lds0+LDS_V)+((lane>>4)&1)*32+(lane&3)*8+(4*hi+((lane&15)>>2))*64;
  const char*Kbase=shm+LDS_K; bf16x8 kf[8];
  const lds_cptr shm3=(lds_cptr)shm; const lds_cptr kp0=shm3+LDS_K+hi*1024+r32*16; const lds_cptr vp0=shm3+LDS_V+((lane>>4)&1)*32+(lane&3)*8+(4*hi+((lane&15)>>2))*64;
  const int NT=(q0+QB)/KVBLK;
  DMA_K(0,0);DMA_V(0,0);DMA_K(1,SLOTB);
  bf16x8 qr[4];
  #pragma unroll
  for(int d0=0;d0<4;++d0)qr[d0]=*reinterpret_cast<const bf16x8*>(&Qw[(long)r32*DM+d0*16+hi*8]);
  float mhat=0.f,l_reg=0.f;f32x16 o[4];o[0]=f32x16{};o[1]=f32x16{};o[2]=f32x16{};o[3]=f32x16{};const f32x16 zero16=f32x16{};
  const int qrel=wid*QBLK+r32;
  #define CMASK(P0,P1,t) do{int jb_=(t)-(NT-4); if(jb_>=0)cmask(P0,P1,jb_,qrel,hi);}while(0)
  bool resc=false;
  #define START(P0,P1) do{ const float rm=rowmax(P0,P1); resc=false; \
    { const float dl=rm; mhat=fadd_s(mhat,dl); \
      _Pragma("unroll") for(int r=0;r<16;++r){P0[r]=fsub_s(P0[r],dl);P1[r]=fsub_s(P1[r],dl);} \
      } \
    _Pragma("unroll") for(int r=0;r<16;++r)P0[r]=__builtin_amdgcn_exp2f(P0[r]); }while(0)
  #define RESC() do{ if(resc){ asm volatile("s_waitcnt lgkmcnt(0)":::"memory"); \
      _Pragma("unroll") for(int d_=0;d_<4;++d_) _Pragma("unroll") for(int r=0;r<16;++r)o[d_][r]*=wsf[crow(r,hi)]; } }while(0)
  f32x16 pA0,pA1,pB0,pB1;
  int sl_prev=0,sl_cur=0,sl_next=SLOTB;
  #define ROT() do{sl_prev=sl_cur;sl_cur=sl_next;sl_next=(sl_next==(NSLOT-1)*SLOTB)?0:sl_next+SLOTB;}while(0)
  DMA_K(2,2*SLOTB);
  WAIT_BAR(4);
  qkt(pA0,pA1,Kbase,qr,zero16,r32,hi);asm volatile("s_nop 15\n\ts_nop 7":"+v"(pA0),"+v"(pA1));BIAS(pA0,pA1,0);CMASK(pA0,pA1,0);
  START(pA0,pA1);
  _Pragma("unroll") for(int r=0;r<16;++r)pA1[r]=__builtin_amdgcn_exp2f(pA1[r]);
  WAIT_BAR(0);
  DMA_K(3,0);DMA_V(1,SLOTB);
  ROT();
  kload8(kf,kp0+sl_cur);
  WAIT_BAR(3);
  s16x4 va_lo,va_hi,vb_lo,vb_hi; u32x4 pw0,pw1,pw2,pw3;
  #define PKW(P,B) cvtpk_s(P[B],P[B+1])
  #define PAF(k) __builtin_bit_cast(bf16x8,pw##k)
  #define VFA (bf16x8){va_lo[0],va_lo[1],va_lo[2],va_lo[3],va_hi[0],va_hi[1],va_hi[2],va_hi[3]}
  #define VFB (bf16x8){vb_lo[0],vb_lo[1],vb_lo[2],vb_lo[3],vb_hi[0],vb_hi[1],vb_hi[2],vb_hi[3]}
  #define PIN(x) asm volatile("":"+v"(x))
  #define MX3(a,b,c) __builtin_fmaxf(__builtin_fmaxf((a),(b)),(c))
  #define GAPA(MF,A0,A1,A2,A3,W0,W1,PW) do{ MF; sacc+=A0; sacc+=A1; sacc+=A2; sacc+=A3; PIN(sacc); W0; W1; PIN(PW); SBAR(); }while(0)
  #define EX(v) __builtin_amdgcn_exp2f((v)-mhat)
  #define VRDA(d0,ks) do{ va_lo=vtr(vp_+((d0)*4096+(ks)*1024)); va_hi=vtr(vp_+((d0)*4096+(ks)*1024+512)); }while(0)
  #define VRDB(d0,ks) do{ vb_lo=vtr(vp_+((d0)*4096+(ks)*1024)); vb_hi=vtr(vp_+((d0)*4096+(ks)*1024+512)); }while(0)
  #define KRD(G,j) do{ if(G){ kload2(kf,kp0+sl_next,j); } }while(0)
  #define GAPB(MF,RD,X,B) do{ MF; RD; X[B]=EX(X[B]); X[B+1]=EX(X[B+1]); PIN(X); SBAR(); }while(0)
  #define STEP(C0,C1,P0,P1,t,GK,GV,GL) do{ SBAR(); \
    const lds_cptr vp_=vp0+2*sl_prev; \
    float sacc=(P0[0]+P0[1]); \
    GAPA(C0=__builtin_amdgcn_mfma_f32_32x32x16_bf16(kf[0],qr[0],zero16,0,0,0), P0[2],P0[3],P0[4],P0[5],     pw0[0]=PKW(P0,0), pw0[1]=PKW(P0,2), pw0); \
    GAPA(C1=__builtin_amdgcn_mfma_f32_32x32x16_bf16(kf[1],qr[0],zero16,0,0,0), P0[6],P0[7],P0[8],P0[9],     pw0[2]=PKW(P0,4), pw0[3]=PKW(P0,6), pw0); \
    GAPA(C0=__builtin_amdgcn_mfma_f32_32x32x16_bf16(kf[2],qr[1],C0,0,0,0),   P0[10],P0[11],P0[12],P0[13], pw1[0]=PKW(P0,8), pw1[1]=PKW(P0,10), pw1); \
    GAPA(C1=__builtin_amdgcn_mfma_f32_32x32x16_bf16(kf[3],qr[1],C1,0,0,0),   P0[14],P0[15],P1[0],P1[1],   pw1[2]=PKW(P0,12),pw1[3]=PKW(P0,14), pw1); \
    GAPA(C0=__builtin_amdgcn_mfma_f32_32x32x16_bf16(kf[4],qr[2],C0,0,0,0),   P1[2],P1[3],P1[4],P1[5],     pw2[0]=PKW(P1,0), pw2[1]=PKW(P1,2), pw2); \
    GAPA(C1=__builtin_amdgcn_mfma_f32_32x32x16_bf16(kf[5],qr[2],C1,0,0,0),   P1[6],P1[7],P1[8],P1[9],     pw2[2]=PKW(P1,4), pw2[3]=PKW(P1,6), pw2); \
    VRDA(0,0); SBAR(); \
    GAPA(C0=__builtin_amdgcn_mfma_f32_32x32x16_bf16(kf[6],qr[3],C0,0,0,0),   P1[10],P1[11],P1[12],P1[13], pw3[0]=PKW(P1,8), pw3[1]=PKW(P1,10), pw3); \
    GAPA(C1=__builtin_amdgcn_mfma_f32_32x32x16_bf16(kf[7],qr[3],C1,0,0,0),   P1[14],P1[15],0.f,0.f,       pw3[2]=PKW(P1,12),pw3[3]=PKW(P1,14), pw3); \
    l_reg+=sacc; \
    if(GK){DMA_K((t)+3,sl_cur);} if(GV){DMA_V((t)+1,sl_next);} \
    CMASK(C0,C1,t); \
    { float a=MX3(C0[0],C0[1],C1[0]),b=MX3(C0[2],C0[3],C1[1]); a=MX3(a,C1[2],C1[3]); \
      _Pragma("unroll") for(int r=4;r<16;r+=4){a=MX3(a,C0[r],C0[r+1]);b=MX3(b,C0[r+2],C0[r+3]);a=MX3(a,C1[r],C1[r+1]);b=MX3(b,C1[r+2],C1[r+3]);} \
      float rm=__builtin_fmaxf(a,b); { auto rr=__builtin_amdgcn_permlane32_swap(__float_as_uint(rm),__float_as_uint(rm),false,false); rm=__builtin_fmaxf(__uint_as_float(rr[0]),__uint_as_float(rr[1])); } \
      rm-=mhat; resc=false; \
      if(__builtin_expect(__any(rm>(float)THRL),0)){ const float dl=__builtin_fmaxf(rm,0.f); mhat+=dl; \
        const float f=__builtin_amdgcn_exp2f(-dl); l_reg*=f; if(hi==0)wsf[r32]=f; resc=true; } } \
    SBAR(); \
    GAPB(o[0]=__builtin_amdgcn_mfma_f32_32x32x16_bf16(PAF(0),VFA,o[0],0,0,0), VRDB(1,0), C0,0); \
    GAPB(o[1]=__builtin_amdgcn_mfma_f32_32x32x16_bf16(PAF(0),VFB,o[1],0,0,0), VRDA(2,0), C0,2); \
    GAPB(o[2]=__builtin_amdgcn_mfma_f32_32x32x16_bf16(PAF(0),VFA,o[2],0,0,0), VRDB(3,0), C0,4); \
    GAPB(o[3]=__builtin_amdgcn_mfma_f32_32x32x16_bf16(PAF(0),VFB,o[3],0,0,0), VRDA(0,1), C0,6); \
    KRD(GL,0); GAPB(o[0]=__builtin_amdgcn_mfma_f32_32x32x16_bf16(PAF(1),VFA,o[0],0,0,0), VRDB(1,1), C0,8); \
    GAPB(o[1]=__builtin_amdgcn_mfma_f32_32x32x16_bf16(PAF(1),VFB,o[1],0,0,0), VRDA(2,1), C0,10); \
    KRD(GL,1); GAPB(o[2]=__builtin_amdgcn_mfma_f32_32x32x16_bf16(PAF(1),VFA,o[2],0,0,0), VRDB(3,1), C0,12); \
    GAPB(o[3]=__builtin_amdgcn_mfma_f32_32x32x16_bf16(PAF(1),VFB,o[3],0,0,0), VRDA(0,2), C0,14); \
    KRD(GL,2); GAPB(o[0]=__builtin_amdgcn_mfma_f32_32x32x16_bf16(PAF(2),VFA,o[0],0,0,0), VRDB(1,2), C1,0); \
    GAPB(o[1]=__builtin_amdgcn_mfma_f32_32x32x16_bf16(PAF(2),VFB,o[1],0,0,0), VRDA(2,2), C1,2); \
    KRD(GL,3); GAPB(o[2]=__builtin_amdgcn_mfma_f32_32x32x16_bf16(PAF(2),VFA,o[2],0,0,0), VRDB(3,2), C1,4); \
    GAPB(o[3]=__builtin_amdgcn_mfma_f32_32x32x16_bf16(PAF(2),VFB,o[3],0,0,0), VRDA(0,3), C1,6); \
    GAPB(o[0]=__builtin_amdgcn_mfma_f32_32x32x16_bf16(PAF(3),VFA,o[0],0,0,0), VRDB(1,3), C1,8); \
    GAPB(o[1]=__builtin_amdgcn_mfma_f32_32x32x16_bf16(PAF(3),VFB,o[1],0,0,0), VRDA(2,3), C1,10); \
    GAPB(o[2]=__builtin_amdgcn_mfma_f32_32x32x16_bf16(PAF(3),VFA,o[2],0,0,0), VRDB(3,3), C1,12); \
    GAPB(o[3]=__builtin_amdgcn_mfma_f32_32x32x16_bf16(PAF(3),VFB,o[3],0,0,0), (void)0, C1,14); \
    }while(0)
  int t=1;
  #undef CMASK
  #define CMASK(P0,P1,t) do{}while(0)
  for(;t+5<NT;t+=2){
    STEP(pB0,pB1,pA0,pA1,t,true,true,true);     WAIT_BAR(3); RESC(); ROT();
    STEP(pA0,pA1,pB0,pB1,t+1,true,true,true);   WAIT_BAR(3); RESC(); ROT();
  }
  #undef CMASK
  #define CMASK(P0,P1,t) do{int jb_=(t)-(NT-4); if(jb_>=0)cmask(P0,P1,jb_,qrel,hi);}while(0)
  #define ENDW(tt) do{ if((tt)+3<NT){WAIT_BAR(3);} else if((tt)+2<NT){WAIT_BAR(2);} else {WAIT_BAR(0);} }while(0)
  for(;t+1<NT;t+=2){
    STEP(pB0,pB1,pA0,pA1,t,(t+3<NT),(t+1<NT),(t+1<NT));       ENDW(t);   RESC(); ROT();
    STEP(pA0,pA1,pB0,pB1,t+1,(t+4<NT),(t+2<NT),(t+2<NT));     ENDW(t+1); RESC(); ROT();
  }
  STEP(pB0,pB1,pA0,pA1,NT-1,false,false,false); RESC();
  { float sacc=pB0[0]+pB0[1]; _Pragma("unroll") for(int r=2;r<16;++r)sacc+=pB0[r]; _Pragma("unroll") for(int r=0;r<16;++r)sacc+=pB1[r]; l_reg+=sacc;
    pw0=(u32x4){PKW(pB0,0),PKW(pB0,2),PKW(pB0,4),PKW(pB0,6)};pw1=(u32x4){PKW(pB0,8),PKW(pB0,10),PKW(pB0,12),PKW(pB0,14)};pw2=(u32x4){PKW(pB1,0),PKW(pB1,2),PKW(pB1,4),PKW(pB1,6)};pw3=(u32x4){PKW(pB1,8),PKW(pB1,10),PKW(pB1,12),PKW(pB1,14)};
    SBAR(); pv128(o,vb0+2*sl_cur,PAF(0),PAF(1),PAF(2),PAF(3)); }
  #undef PKW
  #undef PAF
  #undef VFA
  #undef VFB
  #undef VRDA
  #undef VRDB
  #undef PIN
  #undef MX3
  #undef GAPA
  #undef GAPB
  #undef EX
  #undef KRD
  #undef STEP
  #undef ENDW
  {auto rr=__builtin_amdgcn_permlane32_swap(__float_as_uint(l_reg),__float_as_uint(l_reg),false,false);l_reg=__uint_as_float(rr[0])+__uint_as_float(rr[1]);}
  if(hi==0)wsf[32+r32]=l_reg;asm volatile("s_waitcnt lgkmcnt(0)":::"memory");
  float rli[16];
  #pragma unroll
  for(int r=0;r<16;++r)rli[r]=__builtin_amdgcn_rcpf(wsf[32+crow(r,hi)]);
  { hbf16*stg=(hbf16*)(shm+LDS_OST)+wid*2048;
    const long grow=rowbase+q0+wid*QBLK;
    int lane_e=lane; asm volatile("":"+v"(lane_e));
    float of[2][4][8]; float ssr[4]={0.f,0.f,0.f,0.f};
    #pragma unroll
    for(int hf=0;hf<2;++hf){
      #pragma unroll
      for(int r=0;r<16;++r){const int orow=crow(r,hi);
        #pragma unroll
        for(int d0=0;d0<2;++d0)stg[orow*64+d0*32+r32]=__float2bfloat16(o[2*hf+d0][r]*rli[r]);}
      asm volatile("s_waitcnt lgkmcnt(0)":::"memory");
      #pragma unroll
      for(int i=0;i<4;++i){const int row=i*8+(lane_e>>3),ch=lane_e&7; const u32x4 v=*(const u32x4*)(stg+row*64+ch*8);
        if(MODE==0){ *(u32x4*)(P.out+(grow+row)*(long)P.opitch+hf*64+ch*8)=v; }
        else { const u32x4 a=*(const u32x4*)(P.stash+(grow+row)*512+hf*64+ch*8); float ss=0.f;
          #pragma unroll
          for(int j=0;j<4;++j){ const float a0=__uint_as_float(a[j]<<16),a1=__uint_as_float(a[j]&0xffff0000u),c0=__uint_as_float(v[j]<<16),c1=__uint_as_float(v[j]&0xffff0000u);
            of[hf][i][2*j]=a0-P.lam*c0; of[hf][i][2*j+1]=a1-P.lam*c1; ss+=of[hf][i][2*j]*of[hf][i][2*j]+of[hf][i][2*j+1]*of[hf][i][2*j+1]; }
          ssr[i]+=ss; } }
      asm volatile("s_waitcnt lgkmcnt(0)":::"memory");
    }
    if(MODE!=0){
      #pragma unroll
      for(int i=0;i<4;++i){const int row=i*8+(lane_e>>3),ch=lane_e&7; float ss=ssr[i];
        ss+=__int_as_float(__builtin_amdgcn_ds_swizzle(__float_as_int(ss),0x041f)); ss+=__int_as_float(__builtin_amdgcn_ds_swizzle(__float_as_int(ss),0x081f)); ss+=__int_as_float(__builtin_amdgcn_ds_swizzle(__float_as_int(ss),0x101f));
        const float rr_=rsqrtf(ss*(1.0f/128.0f)+1e-6f)*P.nscale; bf16*yp=P.out+(grow+row)*(long)P.opitch+ch*8;
        #pragma unroll
        for(int hf=0;hf<2;++hf){ const f32x4_t g0=*(const f32x4_t*)(P.gsub+hf*64+ch*8), g1=*(const f32x4_t*)(P.gsub+hf*64+ch*8+4); u32x4 w;
          w[0]=cvtpk_s(of[hf][i][0]*rr_*g0[0],of[hf][i][1]*rr_*g0[1]); w[1]=cvtpk_s(of[hf][i][2]*rr_*g0[2],of[hf][i][3]*rr_*g0[3]); w[2]=cvtpk_s(of[hf][i][4]*rr_*g1[0],of[hf][i][5]*rr_*g1[1]); w[3]=cvtpk_s(of[hf][i][6]*rr_*g1[2],of[hf][i][7]*rr_*g1[3]);
          *(u32x4*)(yp+hf*64)=w; } } } }
  asm volatile("s_waitcnt lgkmcnt(0)\n\ts_barrier":::"memory");
  #undef DMA_K
  #undef BIAS
  #undef DMA_V
  #undef CMASK
  #undef START
  #undef RESC
  #undef ROT
}
constexpr int ATTN_LDS_BYTES=LDS_BYTES;
#undef SBAR
#undef WAIT_BAR
}
#ifndef MK_MU8
#define MK_MU8 0
#endif
#ifndef MK_PLE8
#define MK_PLE8 0
#endif
#define GAS __attribute__((address_space(1)))
#define LAS __attribute__((address_space(3)))
typedef unsigned v4u __attribute__((ext_vector_type(4)));
typedef float f32x4 __attribute__((ext_vector_type(4)));
typedef GAS unsigned gu32;
#define RLX_AGENT __ATOMIC_RELAXED, __HIP_MEMORY_SCOPE_AGENT
#define LDS_WAIT() asm volatile("s_waitcnt lgkmcnt(0)" ::: "memory")
#define VM_WAIT() asm volatile("s_waitcnt vmcnt(0)" ::: "memory")
constexpr int NWAVES = 8;
constexpr size_t W_IN = 0;
constexpr size_t W_CAT = W_IN + (size_t)3840 * 1024 * 2;
constexpr size_t W_G8 = W_CAT;
constexpr size_t W_BR = W_CAT + (size_t)3 * 1024 * 1024;
constexpr float G8_SCALE = 128.0f;
constexpr size_t W_OUT = W_CAT + (size_t)3 * 1024 * 1536 * 2;
constexpr size_t W_GU = W_OUT + (size_t)1024 * 1024 * 2;
constexpr size_t W_D = W_GU + (size_t)16 * 512 * 1024 * 2;
constexpr size_t W_RH = W_D + (size_t)16 * 1024 * 256 * 2;
constexpr size_t W_RL = W_RH + 65536;
constexpr size_t W_ENDB = W_RL + 65536;
static_assert(WS_W + W_ENDB <= WS_SSB && WS_SSB + MiB <= WS_WPLE, "weight map");
constexpr size_t W_PG = 0, W_P = (size_t)1024 * 1024 * 2, WPLE_STRIDE = (size_t)5 * 512 * 1024;
constexpr size_t OUT_XB8 = 0, OUT_GATES = 16 * MiB;
constexpr size_t OV_PB = WS_PB;
constexpr size_t OV_PW = WS_PROJ + 8 * MiB;
constexpr size_t OV_ACT = WS_PROJ + 40 * MiB;
constexpr size_t OV_XB2 = WS_PROJ + 64 * MiB;
constexpr int RING_BYTES = 131072, MISC_OFF = RING_BYTES, LDS_BYTES = 147456;
constexpr int MI_N = 0, MI_BASE = 32, MI_U0 = 64, MI_TOT = 96, MI_Q = 100, MI_BAR = 104;

__device__ __forceinline__ unsigned pk2(float lo, float hi) { typedef float f2 __attribute__((ext_vector_type(2))); typedef __bf16 b2 __attribute__((ext_vector_type(2))); f2 v = {lo, hi}; b2 b = __builtin_convertvector(v, b2); return __builtin_bit_cast(unsigned, b); }
__device__ __forceinline__ float bflo(unsigned u) { return __uint_as_float(u << 16); }
__device__ __forceinline__ float bfhi(unsigned u) { return __uint_as_float(u & 0xffff0000u); }
__device__ __forceinline__ float sigm(float v) { return __builtin_amdgcn_rcpf(1.0f + __expf(-v)); }
__device__ __forceinline__ float sg2(float t) { return __builtin_amdgcn_rcpf(1.0f + __builtin_amdgcn_exp2f(t)); }
__device__ __forceinline__ float clamp8(float v) { return __builtin_amdgcn_fmed3f(v, -448.0f, 448.0f); }
__device__ __forceinline__ unsigned pk_fp8x4(float a, float b, float c, float d) {
    int w = __builtin_amdgcn_cvt_pk_fp8_f32(clamp8(a), clamp8(b), 0, false); w = __builtin_amdgcn_cvt_pk_fp8_f32(clamp8(c), clamp8(d), w, true); return (unsigned)w; }

#define XOR1(v) __int_as_float(__builtin_amdgcn_ds_swizzle(__float_as_int(v), 0x041f))
#define XOR2(v) __int_as_float(__builtin_amdgcn_ds_swizzle(__float_as_int(v), 0x081f))
#define XOR4(v) __int_as_float(__builtin_amdgcn_ds_swizzle(__float_as_int(v), 0x101f))
#define XOR8(v) __int_as_float(__builtin_amdgcn_ds_swizzle(__float_as_int(v), 0x201f))
#define XOR16(v) __int_as_float(__builtin_amdgcn_ds_swizzle(__float_as_int(v), 0x401f))
__device__ __forceinline__ float add_xor32(float v) { const auto r = __builtin_amdgcn_permlane32_swap(__float_as_uint(v), __float_as_uint(v), false, false); return __uint_as_float(r[0]) + __uint_as_float(r[1]); }
__device__ __forceinline__ float wave_sum64(float v) { v += XOR1(v); v += XOR2(v); v += XOR4(v); v += XOR8(v); v += XOR16(v); return add_xor32(v); }
__device__ __forceinline__ int mk_tid(int wave0) { int l; asm volatile("v_mbcnt_lo_u32_b32 %0, -1, 0\n\tv_mbcnt_hi_u32_b32 %0, -1, %0" : "=v"(l)); return wave0 * 64 + l; }

#define XB_TMO      128
#define XB_XCNT(j)  (256  + 64 * (j))
#define XB_XSUB(j)  (1280 + 64 * (j))
#define XB_XGEN(j)  (2304 + 64 * (j))
#define XB_TOP      3328
#define XB_TOPGEN   3392
#define XCD_BAR_WORDS 3456
#define XB_SPIN_CAP (1u << 18)
__device__ __forceinline__ unsigned xb_ld(unsigned* p)              { return __hip_atomic_load(p, __ATOMIC_RELAXED, __HIP_MEMORY_SCOPE_AGENT); }
__device__ __forceinline__ unsigned xb_add(unsigned* p, unsigned v) { return __hip_atomic_fetch_add(p, v, __ATOMIC_RELAXED, __HIP_MEMORY_SCOPE_AGENT); }
__device__ __forceinline__ unsigned xb_xcc_id() { return (unsigned)__builtin_amdgcn_s_getreg((3 << 11) | 20) & 0xFu; }
#define XB_SPIN(cond, bar) do { unsigned _sp = 0; while (cond) { __builtin_amdgcn_s_sleep(1); \
    if ((++_sp & 255u) == 0u) { if (xb_ld(&(bar)[XB_TMO])) break; if (_sp > XB_SPIN_CAP) { atomicAdd(&(bar)[XB_TMO], 1u); break; } } } } while (0)
struct XcdBarrier { unsigned* bar; unsigned x; volatile LAS unsigned* st; };
__device__ __forceinline__ XcdBarrier xcd_barrier_post(unsigned* bar, volatile LAS unsigned* st, int tid) {
    XcdBarrier b; b.bar = bar; b.x = xb_xcc_id(); b.st = st;
    if (tid == 0) (void)xb_add(&bar[XB_XCNT(b.x)], 1u);
    return b;
}
__device__ __forceinline__ void xcd_barrier_complete(unsigned* bar, unsigned x, unsigned& nloc, unsigned& nx) {
    const unsigned G = gridDim.x * gridDim.y * gridDim.z;
    unsigned sum, cnt, mine, sp = 0u;
    for (;;) {
        sum = 0u; cnt = 0u; mine = 0u;
#pragma unroll
        for (unsigned j = 0; j < 16; ++j) { const unsigned c = xb_ld(&bar[XB_XCNT(j)]); sum += c; cnt += (c > 0u) ? 1u : 0u; mine = (j == x) ? c : mine; }
        if (sum == G) break;
        __builtin_amdgcn_s_sleep(1);
        if ((++sp & 255u) == 0u) { if (xb_ld(&bar[XB_TMO])) break; if (sp > XB_SPIN_CAP) { atomicAdd(&bar[XB_TMO], 1u); break; } }
    }
    nloc = mine > 0u ? mine : 1u; nx = cnt > 0u ? cnt : 1u;
}
#ifndef MK_EARLYINV
#define MK_EARLYINV 1
#endif
#ifndef MK_SPLIT_SLEEP
#define MK_SPLIT_SLEEP 16
#endif
__device__ __forceinline__ void xcd_barrier(const XcdBarrier& b, int tid) {
    asm volatile("s_waitcnt vmcnt(0)" ::: "memory");
    __syncthreads();
    if (tid == 0) {
        unsigned* bar = b.bar;
        __builtin_amdgcn_s_waitcnt(0);
        unsigned nloc = b.st[0], nx = b.st[1];
        if (nloc == 0u) { xcd_barrier_complete(bar, b.x, nloc, nx); b.st[0] = nloc; b.st[1] = nx; }
        const unsigned old = xb_add(&bar[XB_XSUB(b.x)], 1u);
        const unsigned gen = old / nloc;
        if (old + 1u == (gen + 1u) * nloc) {
            __builtin_amdgcn_fence(__ATOMIC_RELEASE, "agent");
            asm volatile("s_waitcnt vmcnt(0)" ::: "memory");
            const unsigned og = xb_add(&bar[XB_TOP], 1u);
            unsigned tg = og / nx; asm volatile("" : "+v"(tg) :: "memory");
            if (og + 1u == (tg + 1u) * nx) { xb_add(&bar[XB_TOPGEN], 1u);
#if MK_EARLYINV
                xb_add(&bar[XB_XGEN(b.x)], 1u); asm volatile("buffer_inv sc1" ::: "memory");
#endif
            } else {
#if MK_EARLYINV
                asm volatile("buffer_inv sc1" ::: "memory");
#endif
                XB_SPIN(xb_ld(&bar[XB_TOPGEN]) == tg, bar);
#if MK_EARLYINV
                xb_add(&bar[XB_XGEN(b.x)], 1u);
#endif
            }
#if !MK_EARLYINV
            __builtin_amdgcn_fence(__ATOMIC_ACQUIRE, "agent");
            xb_add(&bar[XB_XGEN(b.x)], 1u);
#endif
            asm volatile("s_waitcnt vmcnt(0)" ::: "memory");
        } else {
#if MK_EARLYINV
            { unsigned g2 = gen; asm volatile("" : "+v"(g2) :: "memory"); asm volatile("buffer_inv sc1" ::: "memory");
              XB_SPIN(xb_ld(&bar[XB_XGEN(b.x)]) == g2, bar); }
#else
            XB_SPIN(xb_ld(&bar[XB_XGEN(b.x)]) == gen, bar);
            __builtin_amdgcn_fence(__ATOMIC_ACQUIRE, "agent");
#endif
            asm volatile("s_waitcnt vmcnt(0)" ::: "memory");
        }
    }
    __syncthreads();
}

__device__ __forceinline__ void split_arrive(unsigned* cnt, int tid) {
    asm volatile("s_waitcnt vmcnt(0)" ::: "memory"); __syncthreads();
    if (tid == 0) { __builtin_amdgcn_fence(__ATOMIC_RELEASE, "agent"); asm volatile("s_waitcnt vmcnt(0)" ::: "memory"); xb_add(cnt, 1u); }
}
__device__ __forceinline__ void split_arrive_x(const XcdBarrier& b, unsigned* cnt_top, unsigned* cnt_x, int tid) {
    asm volatile("s_waitcnt vmcnt(0)" ::: "memory"); __syncthreads();
    if (tid == 0) { const unsigned nloc = b.st[0]; const unsigned old = xb_add(cnt_x + 8u * b.x, 1u);
        if (old + 1u == nloc) { __builtin_amdgcn_fence(__ATOMIC_RELEASE, "agent"); asm volatile("s_waitcnt vmcnt(0)" ::: "memory"); xb_add(cnt_top, nloc); }
#if MK_EARLYINV
        asm volatile("buffer_inv sc1" ::: "memory");
#endif
    }
}
__device__ __forceinline__ void split_wait_leader(unsigned* cnt, unsigned target) {
    unsigned sp = 0; while (xb_ld(cnt) < target) { __builtin_amdgcn_s_sleep(MK_SPLIT_SLEEP); if (++sp > (1u << 22)) break; }
#if !MK_EARLYINV
    __builtin_amdgcn_fence(__ATOMIC_ACQUIRE, "agent");
#endif
    asm volatile("s_waitcnt vmcnt(0)" ::: "memory");
}

__device__ __forceinline__ void group4_sync(unsigned* gc, int tid) {
    asm volatile("s_waitcnt vmcnt(0)" ::: "memory"); __syncthreads();
    if (tid == 0) { const unsigned sh = 8u + 3u * xb_xcc_id();
        xb_add(gc, 1u + (1u << sh));
        asm volatile("buffer_inv sc1" ::: "memory");
        unsigned sp = 0, v = 0; for (;;) { v = xb_ld(gc); if ((v & 0xffu) >= 4u) break; __builtin_amdgcn_s_sleep(1); if (++sp > (1u << 22)) break; }
        if (((v >> sh) & 7u) != 4u) {
            __builtin_amdgcn_fence(__ATOMIC_RELEASE, "agent"); asm volatile("s_waitcnt vmcnt(0)" ::: "memory");
            xb_add(gc + 16, 1u); sp = 0; while (xb_ld(gc + 16) < 4u) { __builtin_amdgcn_s_sleep(1); if (++sp > (1u << 22)) break; }
            __builtin_amdgcn_fence(__ATOMIC_ACQUIRE, "agent"); }
        asm volatile("s_waitcnt vmcnt(0)" ::: "memory"); }
    __syncthreads();
}

struct Args { const void* in[27]; float* out; unsigned char* ws; int ph_lo, ph_hi, li, pad; };
struct LayerW {
    const float *g_attn, *w_in, *pool_w, *pool_scale, *dqn, *dkn, *dlam, *dsub, *fqn, *fkn, *ffb, *w_branch, *w_out, *g_ffn, *wrg, *brg, *wre, *bre, *wg, *wu, *wd, *g_ple, *wpg, *wple, *p;
};
__device__ __forceinline__ LayerW layer_view(const __attribute__((address_space(4))) Args* a, int l) {
    LayerW w; const float* in[27];
#pragma unroll
    for (int i = 0; i < 27; ++i) in[i] = (const float*)a->in[i];
    w.g_attn = in[3] + l * 1024; w.w_in = in[4] + (size_t)l * 1024 * INW; w.pool_w = in[5] + (size_t)l * 65536; w.pool_scale = in[6] + l * 512;
    w.dqn = in[7] + l * 64; w.dkn = in[8] + l * 64; w.dlam = in[9] + l * 256; w.dsub = in[10] + l * 128; w.fqn = in[11] + l * 64; w.fkn = in[12] + l * 64; w.ffb = in[13] + l * 8;
    w.w_branch = in[14] + (size_t)l * 3 * 512 * 1024; w.w_out = in[15] + (size_t)l * 1024 * 1024; w.g_ffn = in[16] + l * 1024; w.wrg = in[17] + (size_t)l * 4096; w.brg = in[18] + l * 4;
    w.wre = in[19] + (size_t)l * 16384; w.bre = in[20] + l * 16; w.wg = in[21] + (size_t)l * 16 * 262144; w.wu = in[22] + (size_t)l * 16 * 262144; w.wd = in[23] + (size_t)l * 16 * 262144;
    w.g_ple = in[24] + l * 1024; w.wpg = in[25] + (size_t)l * 1024 * 1024; w.wple = in[26] + (size_t)l * 256 * 1024; w.p = in[1] + (size_t)l * T * 256;
    return w;
}

__device__ __forceinline__ void tr_item(const float* __restrict__ src, int ldsrc, int c0, int nvalid, int k0, const float* __restrict__ gk, bf16* dst, int dpitch, int nrow0, int dk0, LAS float* scr, int lane, const bool f8 = false) {
    float vv[32];
#pragma unroll
    for (int i = 0; i < 32; ++i) { const int kk = 2 * i + (lane >> 5), c = lane & 31; vv[i] = (c < nvalid) ? src[(size_t)(k0 + kk) * ldsrc + c0 + c] : 0.f; }
    if (gk) {
#pragma unroll
        for (int i = 0; i < 32; ++i) vv[i] *= gk[k0 + 2 * i + (lane >> 5)]; }
#pragma unroll
    for (int i = 0; i < 32; ++i) scr[(2 * i + (lane >> 5)) * 33 + (lane & 31)] = vv[i];
    LDS_WAIT(); asm volatile("" ::: "memory");
    const int c8 = lane & 7;
#pragma unroll
    for (int j = 0; j < 4; ++j) { const int n = (lane >> 3) + 8 * j; const LAS float* s = scr + (8 * c8) * 33 + n;
        if (f8) { typedef unsigned v2u_ __attribute__((ext_vector_type(2))); v2u_ o;
            o.x = pk_fp8x4(s[0 * 33] * G8_SCALE, s[1 * 33] * G8_SCALE, s[2 * 33] * G8_SCALE, s[3 * 33] * G8_SCALE); o.y = pk_fp8x4(s[4 * 33] * G8_SCALE, s[5 * 33] * G8_SCALE, s[6 * 33] * G8_SCALE, s[7 * 33] * G8_SCALE);
            *(GAS v2u_*)((GAS char*)dst + (size_t)(nrow0 + n) * dpitch + dk0 + 8 * c8) = o; }
        else { v4u o; o.x = pk2(s[0 * 33], s[1 * 33]); o.y = pk2(s[2 * 33], s[3 * 33]); o.z = pk2(s[4 * 33], s[5 * 33]); o.w = pk2(s[6 * 33], s[7 * 33]);
            *(GAS v4u*)(dst + (size_t)(nrow0 + n) * dpitch + dk0 + 8 * c8) = o; } }
    LDS_WAIT(); asm volatile("" ::: "memory");
}
constexpr int CV_EARLY = 1536 + 128 + 1536 + 768, CV_NIT = CV_EARLY + 512 + 4096 + 2048 + 512 + 128, CV_LATE_BATCHES = (CV_NIT - CV_EARLY + 7) / 8, CV_RT_BATCHES = 64, CV_PB_BATCHES = 64;
__device__ __forceinline__ void conv_item(const LayerW& w, unsigned char* ws, int l, int it, LAS float* scr, int lane) {
    bf16* Wb = (bf16*)(ws + WS_W); bf16* WIN = (bf16*)(ws + WS_W + W_IN); bf16* WOUT = (bf16*)(ws + WS_W + W_OUT);
    bf16* WGU = (bf16*)(ws + WS_W + W_GU); bf16* WDN = (bf16*)(ws + WS_W + W_D); bf16* WPG = (bf16*)(ws + WS_WPLE + l * WPLE_STRIDE + W_PG); bf16* WP = (bf16*)(ws + WS_WPLE + l * WPLE_STRIDE + W_P);
    (void)Wb;
    constexpr int I_A = 1536, I_B = 128, I_D1 = 1536, I_D2 = 768, I_E = 512, I_F = 4096, I_G = 2048, I_H1 = 512, I_H2 = 128;
    constexpr int NIT = I_A + I_B + I_D1 + I_D2 + I_E + I_F + I_G + I_H1 + I_H2;
    int r = it;
        if (r < I_A) { const int kb = r / 96, nb = r % 96, p0 = 512 + 32 * nb, pn = p0 >> 8, q0 = p0 & 255;
            const bool head = (pn >= 2 && pn <= 5) || (pn >= 8 && pn <= 11);
            const int c0 = head ? (256 * pn + 64 * ((q0 >> 5) & 3) + 32 * (q0 >> 7)) : p0;
            tr_item(w.w_in, INW, c0, 32, 64 * kb, w.g_attn, WIN, 1024, p0, 64 * kb, scr, lane); return; } r -= I_A;
        if (r < I_B) { const int kb = r / 8, nb = r % 8; tr_item(w.w_in, INW, 3584, nb == 0 ? 8 : 0, 64 * kb, w.g_attn, WIN, 1024, 3584 + 32 * nb, 64 * kb, scr, lane); return; } r -= I_B;
        if (r < I_D1) { const int n = r / 512, r2 = r % 512, kb = r2 / 32, nb = r2 % 32;
            tr_item(w.w_in, INW, 3592 + n * 1024 + 32 * nb, 32, 64 * kb, w.g_attn, (bf16*)(ws + WS_W + W_G8 + (size_t)n * 1024 * 1024), 1024, 32 * nb, 64 * kb, scr, lane, true); return; } r -= I_D1;
        if (r < I_D2) { const int n = r / 256, r2 = r % 256, kb = r2 / 32, nb = r2 % 32;
            tr_item(w.w_branch + (size_t)n * 512 * 1024, 1024, 32 * nb, 32, 64 * kb, nullptr, (bf16*)(ws + WS_W + W_BR) + (size_t)n * 1024 * 512, 512, 32 * nb, 64 * kb, scr, lane); return; } r -= I_D2;
        if (r < I_E) { const int kb = r / 32, nb = r % 32; tr_item(w.w_out, 1024, 32 * nb, 32, 64 * kb, nullptr, WOUT, 1024, 32 * nb, 64 * kb, scr, lane); return; } r -= I_E;
        if (r < I_F) { const int e = r / 256, r1 = r % 256, hf = r1 / 128, r2 = r1 % 128, kb = r2 / 8, nb = r2 % 8, q0 = 32 * nb;
            const float* src = ((q0 >> 7) ? w.wu : w.wg) + (size_t)e * 262144;
            const bool f8 = MK_MU8 && l == NL - 1;
            tr_item(src, 256, 128 * hf + (q0 & 127), 32, 64 * kb, w.g_ffn, f8 ? (bf16*)((unsigned char*)WGU + (size_t)(e * 2 + hf) * 256 * 1024) : WGU + (size_t)(e * 2 + hf) * 256 * 1024, 1024, q0, 64 * kb, scr, lane, f8); return; } r -= I_F;
        if (r < I_G) { const int e = r / 128, r2 = r % 128, kb = r2 / 32, nb = r2 % 32;
            tr_item(w.wd + (size_t)e * 262144, 1024, 32 * nb, 32, 64 * kb, nullptr, WDN + (size_t)e * 262144, 256, 32 * nb, 64 * kb, scr, lane); return; } r -= I_G;
        if (r < I_H1) { const int kb = r / 32, nb = r % 32; tr_item(w.wpg, 1024, 32 * nb, 32, 64 * kb, w.g_ple, WPG, 1024, 32 * nb, 64 * kb, scr, lane, MK_PLE8 != 0); return; } r -= I_H1;
        { const int kb = r / 32, nb = r % 32; tr_item(w.wple, 1024, 32 * nb, 32, 64 * kb, nullptr, WP, 256, 32 * nb, 64 * kb, scr, lane); }
}
__device__ __forceinline__ void conv_late_batch(const LayerW& w, unsigned char* ws, int l, LAS unsigned char* lds, int batch, int tid) {
    const int lane = tid & 63, wave = __builtin_amdgcn_readfirstlane(tid >> 6);
    if (batch < CV_LATE_BATCHES) { const int it = CV_EARLY + batch * 8 + wave; if (it < CV_NIT) conv_item(w, ws, l, it, (LAS float*)(lds + wave * 16384), lane); }
    else if (batch >= CV_LATE_BATCHES + CV_RT_BATCHES) {
        const int i0 = (batch - CV_LATE_BATCHES - CV_RT_BATCHES) * 8192 + tid; GAS v4u* PB = (GAS v4u*)(ws + OV_PB);
#pragma clang loop unroll(disable)
        for (int q0 = 0; q0 < 16; q0 += 4) { f32x4 a[4], b[4];
#pragma unroll
            for (int q = 0; q < 4; ++q) { const GAS f32x4* s = (const GAS f32x4*)(w.p) + 2 * (size_t)(i0 + (q0 + q) * 512); a[q] = s[0]; b[q] = s[1]; }
#pragma unroll
            for (int q = 0; q < 4; ++q) { v4u o; o.x = pk2(a[q].x, a[q].y); o.y = pk2(a[q].z, a[q].w); o.z = pk2(b[q].x, b[q].y); o.w = pk2(b[q].z, b[q].w); PB[i0 + (q0 + q) * 512] = o; } } }
    else { const int idx = (batch - CV_LATE_BATCHES) * 512 + tid; const int e = idx >> 10, k = idx & 1023;
        const float v = w.g_ffn[k] * (e < 4 ? w.wrg[k * 4 + e] : (e < 20 ? w.wre[k * 16 + e - 4] : 0.f));
        const unsigned hi = pk2(v, 0.f) & 0xffffu; const unsigned lo = pk2(v - bflo(hi), 0.f) & 0xffffu;
        ((bf16*)(ws + WS_W + W_RH))[idx] = (bf16)hi; ((bf16*)(ws + WS_W + W_RL))[idx] = (bf16)lo; }
}
__device__ __forceinline__ void weff_job(const LayerW& w, unsigned char* ws, LAS unsigned char* lds, int job, int tid) {
    bf16* WIN = (bf16*)(ws + WS_W + W_IN);
    LAS float* Wt = (LAS float*)lds; LAS float* Pw = (LAS float*)(lds + 36864);
    const int kb = job >> 4, g = (job >> 2) & 3, nq = job & 3, k0 = 64 * kb;
    for (int e = tid; e < 64 * 128; e += 512) { const int kk = e >> 7, c = e & 127; Wt[kk * 132 + c] = w.w_in[(size_t)(k0 + kk) * INW + 128 * g + c]; }
    for (int e = tid; e < 128 * 32; e += 512) { const int c = e >> 5, n = e & 31; Pw[c * 32 + n] = w.pool_w[(size_t)g * 16384 + c * 128 + 32 * nq + n]; }
    __syncthreads();
    const int n = tid & 31, ks = tid >> 5; float a[4] = {0.f, 0.f, 0.f, 0.f};
#pragma unroll 2
    for (int c = 0; c < 128; c += 4) {
        const float p0 = Pw[c * 32 + n], p1 = Pw[(c + 1) * 32 + n], p2 = Pw[(c + 2) * 32 + n], p3 = Pw[(c + 3) * 32 + n];
#pragma unroll
        for (int i = 0; i < 4; ++i) { const f32x4 w4 = *(const LAS f32x4*)(Wt + (ks * 4 + i) * 132 + c); a[i] += (w4.x * p0 + w4.y * p1) + (w4.z * p2 + w4.w * p3); } }
    const float sc = w.pool_scale[128 * g + 32 * nq + n];
#pragma unroll
    for (int i = 0; i < 4; ++i) a[i] *= sc * w.g_attn[k0 + ks * 4 + i];
    *(GAS unsigned long long*)(WIN + (size_t)(128 * g + 32 * nq + n) * 1024 + k0 + ks * 4) = (unsigned long long)pk2(a[0], a[1]) | ((unsigned long long)pk2(a[2], a[3]) << 32);
    __syncthreads();
}
__device__ __forceinline__ void conv_layer(const LayerW& w, unsigned char* ws, int l, LAS unsigned char* lds, int vcu, int G, int tid) {
    const int lane = tid & 63, wave = __builtin_amdgcn_readfirstlane(tid >> 6);
    LAS float* scr = (LAS float*)(lds + wave * 16384);
    const int gw = vcu * NWAVES + wave, NGW = G * NWAVES;
    for (int it = gw; it < CV_EARLY; it += NGW) conv_item(w, ws, l, it, scr, lane);
    __syncthreads();
    for (int job = vcu; job < 256; job += G) weff_job(w, ws, lds, job, tid);
}
constexpr int CV_EARLY_BATCHES = CV_EARLY / 8 + 256;
__device__ __forceinline__ void conv_early_batch(const LayerW& w, unsigned char* ws, int l, LAS unsigned char* lds, int batch, int tid) {
    const int lane = tid & 63, wave = __builtin_amdgcn_readfirstlane(tid >> 6);
    if (batch < CV_EARLY / 8) { conv_item(w, ws, l, batch * 8 + wave, (LAS float*)(lds + wave * 16384), lane); __syncthreads(); }
    else weff_job(w, ws, lds, batch - CV_EARLY / 8, tid);
}
__device__ __forceinline__ void p0_x(const float* x, const int* positions, unsigned char* ws, unsigned char* x8, int vcu, int G, int tid) {
    const int lane = tid & 63, wave = __builtin_amdgcn_readfirstlane(tid >> 6);
    bf16* XY = (bf16*)(ws + WS_XY); float* SS = (float*)(ws + WS_SS); float* CS = (float*)(ws + WS_COSSIN);
    const int gw = vcu * NWAVES + wave, NGW = G * NWAVES;
    for (int t = gw; t < T; t += NGW) {
        const GAS f32x4* xr = (const GAS f32x4*)(x + (size_t)t * 1024) + lane; float s = 0.f;
        GAS unsigned long long* o8 = (GAS unsigned long long*)(XY + (size_t)t * XYP + 1536) + lane;
#pragma unroll
        for (int j = 0; j < 4; ++j) { const f32x4 v = xr[64 * j]; s += (v.x * v.x + v.y * v.y) + (v.z * v.z + v.w * v.w); o8[64 * j] = (unsigned long long)pk2(v.x, v.y) | ((unsigned long long)pk2(v.z, v.w) << 32);
            ((GAS unsigned*)(x8 + (size_t)t * 1024))[lane + 64 * j] = pk_fp8x4(v.x, v.y, v.z, v.w); }
        s = wave_sum64(s);
        if (lane < 16) SS[(size_t)t * 16 + lane] = lane == 0 ? s : 0.f;
    }
    for (int idx = vcu * 512 + tid; idx < T * 8; idx += G * 512) { const int t = idx >> 3, i = idx & 7;
        const float invf = powf(500000.0f, -(float)(2 * i) / 16.0f); const float ang = (float)positions[t] * invf;
        CS[(size_t)t * 16 + i] = cosf(ang); CS[(size_t)t * 16 + 8 + i] = sinf(ang); }
}

typedef pg8::f32x4 (&AccRef)[2][2][4][2];
#define LAUNDER3(a, b, c) asm volatile("" : "+v"(a), "+v"(b), "+v"(c))
__device__ __forceinline__ float rstd_at(const float* SS, unsigned row) {
    const GAS f32x4* p = (const GAS f32x4*)((const GAS char*)SS + row * 64u); const f32x4 a = p[0], b = p[1], c = p[2], d = p[3];
    const float s = ((a.x + a.y) + (a.z + a.w)) + ((b.x + b.y) + (b.z + b.w)) + ((c.x + c.y) + (c.z + c.w)) + ((d.x + d.y) + (d.z + d.w));
    return rsqrtf(s * (1.0f / 1024.0f) + RMS_EPS);
}
__device__ __forceinline__ void rstd8(const float* SS, unsigned row0, int fq, float (&rs)[8]) {
    f32x4 v[8];
#pragma unroll
    for (int i = 0; i < 8; ++i) v[i] = *(const GAS f32x4*)((const GAS char*)SS + ((row0 + (unsigned)((i >> 2) * 128 + (i & 3) * 16)) * 64u + (unsigned)fq * 16u));
#pragma unroll
    for (int i = 0; i < 8; ++i) { float s = (v[i].x + v[i].y) + (v[i].z + v[i].w); s += XOR16(s); s = add_xor32(s); rs[i] = rsqrtf(s * (1.0f / 1024.0f) + RMS_EPS); }
}
__device__ __forceinline__ float logsig(float z) { return fminf(z, 0.f) - log1pf(expf(-fabsf(z))); }
struct EpiG1 {
    const float* SS; bf16* PROJ; float* LOGF; const float* CS; const float* GT; const float* ffb; int dry; const LAS float* rsl;
    __device__ __forceinline__ void operator()(AccRef acc, const pg8::Step& st, int wr, int wc, int fr_, int fq_) const {
        if (dry) return;
        int fr = fr_, fq = fq_, zz = 0; LAUNDER3(fr, fq, zz);
        const int pn = st.pn; const unsigned row0 = (unsigned)(st.pm * 256 + wr * 64 + fr);
#define RSL8(dst_) do { _Pragma("unroll") for (int i_ = 0; i_ < 8; ++i_) dst_[i_] = rsl[st.aux * 256 + (i_ >> 2) * 128 + wr * 64 + (i_ & 3) * 16 + fr]; } while (0)
        const bool head = (pn >= 2 && pn <= 5) || (pn >= 8 && pn <= 11);
        if (head) {
            const float* gain = GT + 64 * (pn < 4 ? 0 : (pn < 6 ? 1 : (pn < 10 ? 2 : 3)));
            const bool rot = pn < 6; const float osc = (pn < 4 || (pn >= 8 && pn < 10)) ? C2 : 1.0f;
            f32x4 G[2][2];
#pragma unroll
            for (int bj = 0; bj < 2; ++bj)
#pragma unroll
                for (int n = 0; n < 2; ++n) G[bj][n] = *(const GAS f32x4*)((const GAS char*)gain + (unsigned)(32 * bj + 8 * fq + 4 * n) * 4u);
            const GAS char* pb = (const GAS char*)PROJ + (unsigned)(256 * pn + 64 * wc) * 2u;
            float rs8[8]; RSL8(rs8);
            f32x4 cs[4];
#define G1_LOADCS(i_) do { if (rot && fq < 2) { const GAS f32x4* cp_ = (const GAS f32x4*)((const GAS char*)CS + (row0 + (unsigned)(((i_) >> 2) * 128 + ((i_) & 3) * 16)) * 64u); \
                _Pragma("unroll") for (int q_ = 0; q_ < 4; ++q_) cs[q_] = cp_[q_]; } } while (0)
            G1_LOADCS(0);
#pragma unroll
            for (int i = 0; i < 8; ++i) {
                v4u ov[2];
                {
                    const int ai = i >> 2, m = i & 3; const float rs = rs8[i];
                    f32x4 v[2][2]; float ss = 0.f;
#pragma unroll
                    for (int bj = 0; bj < 2; ++bj)
#pragma unroll
                        for (int n = 0; n < 2; ++n) { v[bj][n] = acc[ai][bj][m][n]; const f32x4 q = v[bj][n] * v[bj][n]; ss += (q.x + q.y) + (q.z + q.w); }
                    ss += XOR16(ss); ss = add_xor32(ss);
                    const float hn = rsqrtf(ss * (1.0f / 64.0f) + RMS_EPS * __builtin_amdgcn_rcpf(rs * rs)) * osc;
#pragma unroll
                    for (int bj = 0; bj < 2; ++bj)
#pragma unroll
                        for (int n = 0; n < 2; ++n) v[bj][n] = v[bj][n] * hn * G[bj][n];
                    if (rot) {
                        f32x4 ot[2];
#pragma unroll
                        for (int n = 0; n < 2; ++n) { ot[n].x = XOR16(v[0][n].x); ot[n].y = XOR16(v[0][n].y); ot[n].z = XOR16(v[0][n].z); ot[n].w = XOR16(v[0][n].w); }
                        if (fq < 2) {
#pragma unroll
                            for (int n = 0; n < 2; ++n) { const f32x4 c = cs[n], s = cs[2 + n]; v[0][n] = (fq == 0) ? (v[0][n] * c - ot[n] * s) : (v[0][n] * c + ot[n] * s); }
                        }
                    }
#pragma unroll
                    for (int bj = 0; bj < 2; ++bj) { ov[bj].x = pk2(v[bj][0].x, v[bj][0].y); ov[bj].y = pk2(v[bj][0].z, v[bj][0].w); ov[bj].z = pk2(v[bj][1].x, v[bj][1].y); ov[bj].w = pk2(v[bj][1].z, v[bj][1].w); }
                }
                if (i < 7) G1_LOADCS(i + 1);
                asm volatile("" ::: "memory");
                { const unsigned row = row0 + (unsigned)((i >> 2) * 128 + (i & 3) * 16);
#pragma unroll
                    for (int bj = 0; bj < 2; ++bj) *(GAS v4u*)(pb + (row * (unsigned)(PJP * 2) + (unsigned)(32 * bj + 8 * fq) * 2u)) = ov[bj]; }
                asm volatile("" ::: "memory");
            }
#undef G1_LOADCS
        } else if (pn == 14) {
            float rs14[8]; RSL8(rs14);
            if (wc == 0 && fq == 0) {
                const f32x4 b0 = *(const GAS f32x4*)ffb, b1 = *(const GAS f32x4*)(ffb + 4);
#pragma unroll
                for (int ai = 0; ai < 2; ++ai)
#pragma unroll
                    for (int m = 0; m < 4; ++m) {
                        const unsigned row = row0 + ai * 128 + m * 16; const float rs = rs14[ai * 4 + m];
                        const f32x4 z0 = acc[ai][0][m][0] * rs + b0, z1 = acc[ai][0][m][1] * rs + b1; f32x4 o0, o1;
                        o0.x = logsig(z0.x); o0.y = logsig(z0.y); o0.z = logsig(z0.z); o0.w = logsig(z0.w); o1.x = logsig(z1.x); o1.y = logsig(z1.y); o1.z = logsig(z1.z); o1.w = logsig(z1.w);
                        GAS f32x4* d = (GAS f32x4*)((GAS char*)LOGF + row * 32u); d[0] = o0; d[1] = o1;
                    }
            }
        } else {
            const GAS char* pb = (const GAS char*)PROJ + (unsigned)(256 * pn + 32 * wc) * 2u;
            float rsp[8]; RSL8(rsp);
#pragma unroll
            for (int ai = 0; ai < 2; ++ai)
#pragma unroll
                for (int m = 0; m < 4; ++m) {
                    const unsigned row = row0 + ai * 128 + m * 16; const float rs = rsp[ai * 4 + m];
#pragma unroll
                    for (int bj = 0; bj < 2; ++bj) { const f32x4 a = acc[ai][bj][m][0] * rs, b = acc[ai][bj][m][1] * rs; v4u o; o.x = pk2(a.x, a.y); o.y = pk2(a.z, a.w); o.z = pk2(b.x, b.y); o.w = pk2(b.z, b.w);
                        *(GAS v4u*)(pb + (row * (unsigned)(PJP * 2) + (unsigned)(128 * bj + 8 * fq) * 2u)) = o; }
                }
        }
    }
};
typedef unsigned v2u __attribute__((ext_vector_type(2)));
__device__ __forceinline__ unsigned pk8(float a, float b, float c, float d) {
    unsigned w = __builtin_amdgcn_cvt_pk_u8_f32(a * 256.0f - 0.5f, 0u, 0u); w = __builtin_amdgcn_cvt_pk_u8_f32(b * 256.0f - 0.5f, 1u, w); w = __builtin_amdgcn_cvt_pk_u8_f32(c * 256.0f - 0.5f, 2u, w); return __builtin_amdgcn_cvt_pk_u8_f32(d * 256.0f - 0.5f, 3u, w); }
__device__ __forceinline__ float g8(unsigned w, const int k) { return ((float)((w >> (8 * k)) & 0xffu) + 0.5f) * (1.0f / 256.0f); }
__device__ __forceinline__ float g8u(unsigned w, const int k) { return (float)((w >> (8 * k)) & 0xffu) + 0.5f; }
#undef RSL8
template <int PART>
struct EpiG2 {
    const float* SS; unsigned char* gs; bf16* MERGED; const LAS float* rsl;
    __device__ __forceinline__ void operator()(AccRef acc, const pg8::Step& st, int wr, int wc, int fr_, int fq_) const {
        int ln; asm volatile("v_mbcnt_lo_u32_b32 %0, -1, 0\n\tv_mbcnt_hi_u32_b32 %0, -1, %0" : "=v"(ln));
        int fr = ln & 15, fq = ln >> 4, tid = (wr * 4 + wc) * 64 + ln; LAUNDER3(fr, fq, tid); (void)fr_; (void)fq_;
        const int aux = st.aux; const unsigned row0 = (unsigned)(st.pm * 256 + wr * 64 + fr), toff = (unsigned)tid * 8u;
        const int n = aux < 3 ? aux : aux - 3; GAS char* gb = (GAS char*)gs + (size_t)n * 65536;
        GAS char* mb = (GAS char*)MERGED + (unsigned)(256 * st.pn + 32 * wc) * 2u;
        float rsg[8];
#pragma unroll
        for (int i = 0; i < 8; ++i) rsg[i] = 0.f;
        if (PART == 0) {
#pragma unroll
            for (int i = 0; i < 8; ++i) rsg[i] = rsl[(i >> 2) * 128 + wr * 64 + (i & 3) * 16 + fr]; }
#pragma unroll
        for (int ai = 0; ai < 2; ++ai) {
            v2u gn[4][2], gd[4][2];
#pragma unroll
            for (int m = 0; m < 4; ++m)
#pragma unroll
                for (int bj = 0; bj < 2; ++bj) { gn[m][bj] = (v2u){0u, 0u}; gd[m][bj] = (v2u){0u, 0u}; }
            if (PART == 1) {
#pragma unroll
                for (int m = 0; m < 4; ++m)
#pragma unroll
                    for (int bj = 0; bj < 2; ++bj) { const unsigned so = toff + (unsigned)(((ai * 4 + m) * 2 + bj) * 4096); gn[m][bj] = *(const GAS v2u*)(gb + so); if (aux < 5) gd[m][bj] = *(const GAS v2u*)(gb + 65536 + so); }
            }
            asm volatile("" ::: "memory");
#pragma unroll
            for (int m = 0; m < 4; ++m) {
                const float rs = rsg[ai * 4 + m] * (1.0f / G8_SCALE);
#pragma unroll
                for (int bj = 0; bj < 2; ++bj) {
                    const unsigned so = toff + (unsigned)(((ai * 4 + m) * 2 + bj) * 4096);
                    const f32x4 a = acc[ai][bj][m][0], b = acc[ai][bj][m][1]; const v2u n_ = gn[m][bj], d_ = gd[m][bj];
                    f32x4 fa = (f32x4){0.f, 0.f, 0.f, 0.f}, fb = fa;
                    if (PART == 0) { const float rsn = rs * -1.4426950408889634f; const f32x4 x = a * rsn, y = b * rsn; v2u o;
                        o.x = pk8(sg2(x.x), sg2(x.y), sg2(x.z), sg2(x.w)); o.y = pk8(sg2(y.x), sg2(y.y), sg2(y.z), sg2(y.w));
                        *(GAS v2u*)(gb + so) = o;
                    } else if (aux < 5) {
                        fa.x = g8u(n_.x, 0) * __builtin_amdgcn_rcpf(g8u(d_.x, 0)); fa.y = g8u(n_.x, 1) * __builtin_amdgcn_rcpf(g8u(d_.x, 1)); fa.z = g8u(n_.x, 2) * __builtin_amdgcn_rcpf(g8u(d_.x, 2)); fa.w = g8u(n_.x, 3) * __builtin_amdgcn_rcpf(g8u(d_.x, 3));
                        fb.x = g8u(n_.y, 0) * __builtin_amdgcn_rcpf(g8u(d_.y, 0)); fb.y = g8u(n_.y, 1) * __builtin_amdgcn_rcpf(g8u(d_.y, 1)); fb.z = g8u(n_.y, 2) * __builtin_amdgcn_rcpf(g8u(d_.y, 2)); fb.w = g8u(n_.y, 3) * __builtin_amdgcn_rcpf(g8u(d_.y, 3));
                    } else { v4u o;
                        o.x = pk2(a.x * g8(n_.x, 0), a.y * g8(n_.x, 1)); o.y = pk2(a.z * g8(n_.x, 2), a.w * g8(n_.x, 3)); o.z = pk2(b.x * g8(n_.y, 0), b.y * g8(n_.y, 1)); o.w = pk2(b.z * g8(n_.y, 2), b.w * g8(n_.y, 3));
                        *(GAS v4u*)(mb + ((row0 + ai * 128 + m * 16) * 2048u + (unsigned)(128 * bj + 8 * fq) * 2u)) = o;
                    }
                    acc[ai][bj][m][0] = a * fa; acc[ai][bj][m][1] = b * fb;
                    asm volatile("" : "+v"(acc[ai][bj][m][0]), "+v"(acc[ai][bj][m][1]));
                }
            }
            asm volatile("" ::: "memory");
        }
    }
};
#ifndef MK_X8
#define MK_X8 1
#endif
template <int KIND, bool SCATTER>
struct EpiRes {
    const bf16* xs; int ldxs; float* xo; bf16* xb; int ldxb; float* SSo; const float* SSi; const bf16* PW; int dry; unsigned char* x8;
    __device__ __forceinline__ void operator()(AccRef acc, const pg8::Step& st, int wr, int wc, int fr_, int fq_) const {
        if (SCATTER && st.aux == 0) return;
        int fr = fr_, fq = fq_, zz = 0; LAUNDER3(fr, fq, zz);
        const int pn = st.pn; const unsigned colb = (unsigned)(256 * pn + 32 * wc + 8 * fq);
        int rowi[8];
#pragma unroll
        for (int i = 0; i < 8; ++i) { const int r = (i >> 2) * 128 + wr * 64 + (i & 3) * 16 + fr; rowi[i] = SCATTER ? ((r < st.nvalid) ? st.rows[r] : -1) : (st.pm * 256 + r); }
        float rs8[8];
#pragma unroll
        for (int i = 0; i < 8; ++i) rs8[i] = 1.f;
        if (KIND == 1) { rstd8(SSi, (unsigned)(st.pm * 256 + wr * 64 + fr), fq, rs8);
            if (MK_PLE8) {
#pragma unroll
                for (int i = 0; i < 8; ++i) rs8[i] *= (1.0f / G8_SCALE); } }
        v4u xin[2][2][2]; v4u pwv[2][2][2];
#define RES_LOAD(p_, buf_) do { _Pragma("unroll") for (int u_ = 0; u_ < 2; ++u_) { const int i_ = 2 * (p_) + u_; const unsigned rw_ = rowi[i_] >= 0 ? (unsigned)rowi[i_] : 0u; \
            _Pragma("unroll") for (int bj_ = 0; bj_ < 2; ++bj_) { xin[buf_][u_][bj_] = *(const GAS v4u*)((const GAS char*)xs + (rw_ * (unsigned)ldxs + colb + 128u * bj_) * 2u); \
                if (KIND == 1) pwv[buf_][u_][bj_] = *(const GAS v4u*)((const GAS char*)PW + (rw_ * 1024u + colb + 128u * bj_) * 2u); } } } while (0)
        RES_LOAD(0, 0);
#pragma unroll
        for (int pr = 0; pr < 4; ++pr) {
            float ssp[2]; f32x4 xr[2][2][2];
#pragma unroll
            for (int u = 0; u < 2; ++u) {
                const int i = 2 * pr + u, ai = i >> 2, m = i & 3; const float rs = rs8[i]; float ss = 0.f;
#pragma unroll
                for (int bj = 0; bj < 2; ++bj) {
                    const v4u xv = xin[pr & 1][u][bj];
                    f32x4 x0 = (f32x4){bflo(xv.x), bfhi(xv.x), bflo(xv.y), bfhi(xv.y)}, x1 = (f32x4){bflo(xv.z), bfhi(xv.z), bflo(xv.w), bfhi(xv.w)};
                    f32x4 a = acc[ai][bj][m][0], b = acc[ai][bj][m][1];
                    if (KIND == 1) { const v4u pw = pwv[pr & 1][u][bj];
                        const float rsn = rs * -1.4426950408889634f;
                        a.x = sg2(a.x * rsn) * bflo(pw.x); a.y = sg2(a.y * rsn) * bfhi(pw.x); a.z = sg2(a.z * rsn) * bflo(pw.y); a.w = sg2(a.w * rsn) * bfhi(pw.y);
                        b.x = sg2(b.x * rsn) * bflo(pw.z); b.y = sg2(b.y * rsn) * bfhi(pw.z); b.z = sg2(b.z * rsn) * bflo(pw.w); b.w = sg2(b.w * rsn) * bfhi(pw.w); }
                    x0 += a; x1 += b;
                    { const f32x4 q0 = x0 * x0, q1 = x1 * x1; ss += ((q0.x + q0.y) + (q0.z + q0.w)) + ((q1.x + q1.y) + (q1.z + q1.w)); }
                    xr[u][bj][0] = x0; xr[u][bj][1] = x1;
                }
                ss += XOR16(ss); ss = add_xor32(ss); ssp[u] = ss;
            }
            if (pr < 3) RES_LOAD(pr + 1, (pr + 1) & 1);
            asm volatile("" ::: "memory");
#pragma unroll
            for (int u = 0; u < 2; ++u) {
                const int i = 2 * pr + u; const bool ok = rowi[i] >= 0 && !dry; const unsigned rw = rowi[i] >= 0 ? (unsigned)rowi[i] : 0u;
                if (ok) {
#pragma unroll
                    for (int bj = 0; bj < 2; ++bj) { const f32x4 x0 = xr[u][bj][0], x1 = xr[u][bj][1];
                        if (xo) { GAS f32x4* op = (GAS f32x4*)((GAS char*)xo + (rw * 1024u + colb + 128u * bj) * 4u); op[0] = x0; op[1] = x1; }
                        if (xb) { v4u o; o.x = pk2(x0.x, x0.y); o.y = pk2(x0.z, x0.w); o.z = pk2(x1.x, x1.y); o.w = pk2(x1.z, x1.w);
                            *(GAS v4u*)((GAS char*)xb + (rw * (unsigned)ldxb + colb + 128u * bj) * 2u) = o; }
                        if (MK_X8 && x8) { v2u o2; o2.x = pk_fp8x4(x0.x, x0.y, x0.z, x0.w); o2.y = pk_fp8x4(x1.x, x1.y, x1.z, x1.w); *(GAS v2u*)((GAS char*)x8 + (rw * 1024u + colb + 128u * bj)) = o2; } }
                    if (fq == 0 && xb) *(GAS float*)((GAS char*)SSo + (rw * 16u + (unsigned)(4 * pn + wc)) * 4u) = ssp[u];
                }
            }
            asm volatile("" ::: "memory");
        }
#undef RES_LOAD
    }
};
struct EpiPW {
    bf16* O;
    __device__ __forceinline__ void operator()(AccRef acc, const pg8::Step& st, int wr, int wc, int fr_, int fq_) const {
        int fr = fr_, fq = fq_, zz = 0; LAUNDER3(fr, fq, zz);
        GAS char* ob = (GAS char*)O + (unsigned)(256 * st.pn + 32 * wc) * 2u; const unsigned row0 = (unsigned)(st.pm * 256 + wr * 64 + fr);
#pragma unroll
        for (int ai = 0; ai < 2; ++ai)
#pragma unroll
            for (int m = 0; m < 4; ++m) {
#pragma unroll
                for (int bj = 0; bj < 2; ++bj) { const f32x4 a = acc[ai][bj][m][0], b = acc[ai][bj][m][1]; v4u o; o.x = pk2(a.x, a.y); o.y = pk2(a.z, a.w); o.z = pk2(b.x, b.y); o.w = pk2(b.z, b.w);
                    *(GAS v4u*)(ob + ((row0 + ai * 128 + m * 16) * 2048u + (unsigned)(128 * bj + 8 * fq) * 2u)) = o; }
                asm volatile("" ::: "memory"); }
    }
};
struct EpiMU {
    bf16* ACT; const float* TOKW; float sc; LAS f32x4* twl;
    __device__ __forceinline__ void prep(const pg8::Step& st, int tid, int wid) const {
        if (wid < 4) { const int tk = (tid < st.nvalid) ? st.rows[tid] : 0;
            __builtin_amdgcn_global_load_lds((const unsigned*)((const char*)TOKW + (unsigned)tk * 16u), (LAS unsigned*)((LAS char*)twl + wid * 1024), 16, 0, 0); } }
    __device__ __forceinline__ void operator()(AccRef acc, const pg8::Step& st, int wr, int wc, int fr_, int fq_) const {
        int fr = fr_, fq = fq_, zz = 0; LAUNDER3(fr, fq, zz);
        const int j = st.pn; GAS char* ab = (GAS char*)ACT + (size_t)st.pm * 1024 + (unsigned)(128 * j + 32 * wc) * 2u;
        f32x4 tw[8];
#pragma unroll
        for (int i = 0; i < 8; ++i) { const int r = (i >> 2) * 128 + wr * 64 + (i & 3) * 16 + fr; tw[i] = twl[r]; if (r >= st.nvalid) tw[i] = (f32x4){0.f, 0.f, 0.f, 0.f}; }
        asm volatile("" ::: "memory");
#pragma unroll
        for (int i = 0; i < 8; ++i) {
            const int ai = i >> 2, m = i & 3, r = ai * 128 + wr * 64 + m * 16 + fr;
            const float rs = tw[i].z * sc, w = (j < 2) ? tw[i].x : tw[i].y;
            const f32x4 g0 = acc[ai][0][m][0] * rs, g1 = acc[ai][0][m][1] * rs, u0 = acc[ai][1][m][0] * rs, u1 = acc[ai][1][m][1] * rs; v4u o;
            o.x = pk2(g0.x * sigm(g0.x) * u0.x * w, g0.y * sigm(g0.y) * u0.y * w); o.y = pk2(g0.z * sigm(g0.z) * u0.z * w, g0.w * sigm(g0.w) * u0.w * w);
            o.z = pk2(g1.x * sigm(g1.x) * u1.x * w, g1.y * sigm(g1.y) * u1.y * w); o.w = pk2(g1.z * sigm(g1.z) * u1.z * w, g1.w * sigm(g1.w) * u1.w * w);
            *(GAS v4u*)(ab + ((unsigned)r * 1024u + (unsigned)(8 * fq) * 2u)) = o;
            asm volatile("" ::: "memory");
        }
    }
};

__device__ __forceinline__ bool tile_order(long L, int nM, int nN, int& pm, int& pn) {
    const int nwg = nM * nN; if (L >= nwg) return false;
    int wgid = (int)L; { const int q = nwg / 8, r = nwg % 8, xcd = wgid % 8, off = wgid / 8; wgid = (xcd < r ? xcd * (q + 1) : r * (q + 1) + (xcd - r) * q) + off; }
    const int nig = 8 * nN, gid = wgid / nig, fm = gid * 8, gsz = (nM - fm) < 8 ? (nM - fm) : 8;
    pm = fm + ((wgid % nig) % gsz); pn = (wgid % nig) / gsz; return true;
}
struct SchedPlain {
    const char* A; const char* B; size_t a_tile, b_tile; int nM, nN, nt, G, c, fixa, fixb;
    __device__ __forceinline__ bool next(int i, pg8::Step& s) const {
        int pm, pn; if (!tile_order((long)i * G + c, nM, nN, pm, pn)) return false;
        s.A = A + (size_t)(fixa ? 0 : pm) * a_tile; s.B = B + (size_t)(fixb ? 0 : pn) * b_tile; s.rows = nullptr; s.nt = nt; s.pm = pm; s.pn = pn; s.aux = i; s.nvalid = 256; s.zero_after = 1; return true; }
};
template <int PART>
struct SchedG2 {
    const char* Ab; const char* Bb; int c;
    __device__ __forceinline__ bool next(int i, pg8::Step& s) const {
        if (i >= 3) return false; int pm, pn; tile_order(c, 64, 4, pm, pn);
        const int n = i;
        s.A = PART == 0 ? Ab + (size_t)pm * 256 * 1024 : Ab + (size_t)pm * 256 * (XYP * 2) + 512 * n * 2;
        s.B = Bb + ((size_t)n * 1024 + pn * 256) * 1024;
        s.rows = nullptr; s.nt = 8; s.pm = pm; s.pn = pn; s.aux = PART * 3 + i; s.nvalid = 256; s.zero_after = 0; return true; }
};
struct SchedMoE {
    volatile LAS unsigned* MISC; const int* LIST; const char* Ab; const char* Bb; int G, c, mode, f8, cls;
    __device__ __forceinline__ bool next(int i, pg8::Step& s) const {
        const int NU = (int)MISC[MI_TOT]; const int u = c;
        if (u >= NU || i > (mode == 2 ? 1 : 0)) return false;
        const int down = mode == 2;
        const int r = u - (int)MISC[MI_U0 + cls], k = r >> 2, j = r & 3, n_c = (int)MISC[MI_N + cls], arow = (int)MISC[MI_BASE + cls] + 256 * k;
        const int grp = cls / 6, pr = cls % 6; const int pa = pr < 3 ? 0 : (pr < 5 ? 1 : 2), pb = pr < 3 ? pr + 1 : (pr < 5 ? pr - 1 : 3);
        s.rows = LIST + (size_t)cls * T + 256 * k; s.nvalid = min(256, n_c - 256 * k); s.pm = arow; s.pn = j;
        if (!down) { const int e = grp * 4 + (j < 2 ? pa : pb), hf = j & 1;
            s.A = Ab; s.B = Bb + (size_t)(e * 2 + hf) * 256 * (f8 ? 1024 : 2048); s.nt = f8 ? 8 : 16; s.aux = cls; s.zero_after = 1; }
        else { const int sgm = i & 1; const int e = grp * 4 + (sgm ? pb : pa);
            s.A = Ab + (size_t)arow * 1024 + sgm * 512; s.B = Bb + ((size_t)e * 1024 + j * 256) * 512; s.nt = 4; s.aux = sgm; s.zero_after = sgm; }
        return true; }
};
__device__ __forceinline__ float wave_sum(float v) {
    return wave_sum64(v);
}
__device__ __forceinline__ void pool_unit(int u, const bf16* PROJ, bf16* XY, int tid_) {
    int tid = tid_; asm volatile("" : "+v"(tid));
    const int c8 = tid & 63, rg = tid >> 6, g = c8 >> 4, w = 2 << g, t0 = 256 * u + 32 * rg, s0 = t0 % S;
    const GAS char* zb = (const GAS char*)PROJ + (unsigned)c8 * 16u; GAS char* yb = (GAS char*)XY + (unsigned)c8 * 16u;
    float sum[8];
#pragma unroll
    for (int j = 0; j < 8; ++j) sum[j] = 0.f;
    { v4u pz[16];
#pragma unroll
      for (int k = 1; k <= 16; ++k) { const bool ok = k <= w && k <= s0; pz[k - 1] = *(const GAS v4u*)(zb + (unsigned)(ok ? t0 - k : t0) * (unsigned)(PJP * 2)); }
#pragma unroll
      for (int k = 1; k <= 16; ++k) { const bool ok = k <= w && k <= s0; const v4u z = pz[k - 1];
        if (ok) { sum[0] += bflo(z.x); sum[1] += bfhi(z.x); sum[2] += bflo(z.y); sum[3] += bfhi(z.y); sum[4] += bflo(z.z); sum[5] += bfhi(z.z); sum[6] += bflo(z.w); sum[7] += bfhi(z.w); } } }
#pragma clang loop unroll(disable)
    for (int r0 = 0; r0 < 32; r0 += 8) {
        v4u zz[8], qq[8];
#pragma unroll
        for (int j = 0; j < 8; ++j) { const int t = t0 + r0 + j, s = s0 + r0 + j;
            zz[j] = *(const GAS v4u*)(zb + (unsigned)t * (unsigned)(PJP * 2)); qq[j] = *(const GAS v4u*)(zb + (unsigned)(s >= w ? t - w : t) * (unsigned)(PJP * 2)); }
#pragma unroll
        for (int j = 0; j < 8; ++j) { const int t = t0 + r0 + j, s = s0 + r0 + j; const v4u z = zz[j], q = qq[j];
            float zf[8] = {bflo(z.x), bfhi(z.x), bflo(z.y), bfhi(z.y), bflo(z.z), bfhi(z.z), bflo(z.w), bfhi(z.w)};
#pragma unroll
            for (int i = 0; i < 8; ++i) sum[i] += zf[i];
            if (s >= w) { sum[0] -= bflo(q.x); sum[1] -= bfhi(q.x); sum[2] -= bflo(q.y); sum[3] -= bfhi(q.y); sum[4] -= bflo(q.z); sum[5] -= bfhi(q.z); sum[6] -= bflo(q.w); sum[7] -= bfhi(q.w); }
            const float ic = 1.0f / (float)min(s + 1, w); v4u o;
            o.x = pk2(sum[0] * ic - zf[0], sum[1] * ic - zf[1]); o.y = pk2(sum[2] * ic - zf[2], sum[3] * ic - zf[3]); o.z = pk2(sum[4] * ic - zf[4], sum[5] * ic - zf[5]); o.w = pk2(sum[6] * ic - zf[6], sum[7] * ic - zf[7]);
            *(GAS v4u*)(yb + (unsigned)t * (unsigned)(XYP * 2)) = o; }
    }
}
#ifndef MK_THRD
#define MK_THRD 32
#endif
#ifndef MK_THRF
#define MK_THRF 64
#endif
#ifndef MK_ATT_SKIP
#define MK_ATT_SKIP 0
#endif
__device__ __forceinline__ void attn_phase(const int wave0, const LayerW& w, int l, int rep, unsigned char* ws, char* lds, volatile LAS unsigned* MISC, gu32* ctl, const int dry) {
    using namespace attn_body;
    int tid = mk_tid(wave0); const int lane = tid & 63;
    bf16* PROJ = (bf16*)(ws + WS_PROJ); bf16* XY = (bf16*)(ws + WS_XY); bf16* STASH = (bf16*)(ws + WS_STASH); const float* LOGF = (const float*)(ws + WS_LOGF);
    const float lam_init = 0.8f - 0.6f * __expf(-0.3f * (float)l);
    float lam; { const float a = wave_sum(w.dlam[lane] * w.dlam[64 + lane]), c = wave_sum(w.dlam[128 + lane] * w.dlam[192 + lane]); lam = __expf(a) - __expf(c) + lam_init; lam = __int_as_float(__builtin_amdgcn_readfirstlane(__float_as_int(lam))); }
    unsigned* qhead = pg8::rflp((unsigned*)(ctl + CW_AQ) + rep); unsigned* fhead = pg8::rflp((unsigned*)(ctl + CW_AQ) + 64 + 16 * l);
    {
        unsigned* top = pg8::rflp((unsigned*)(ctl + CW_SPLIT3) + 64 * l);
#pragma clang loop unroll(disable)
        for (;;) {
            tid = mk_tid(wave0);
            if (tid == 0) { unsigned r = 0xffffffffu; if (xb_ld(top) < (unsigned)gridDim.x) { const unsigned f = atomicAdd(fhead, 1u); if (f < (unsigned)(CV_LATE_BATCHES + CV_RT_BATCHES + CV_PB_BATCHES)) r = f; } MISC[MI_Q] = r; }
            __syncthreads();
            const unsigned fb = MISC[MI_Q];
            __syncthreads();
            if (fb == 0xffffffffu) break;
            conv_late_batch(w, ws, l, (LAS unsigned char*)lds, (int)fb, tid); __syncthreads();
        }
        tid = mk_tid(wave0);
        if (tid == 0) split_wait_leader(top, (unsigned)gridDim.x);
        __syncthreads();
    }
    int first = 1;
    for (;;) {
        tid = mk_tid(wave0);
        if (tid == 0) { unsigned q = first ? (unsigned)blockIdx.x : (unsigned)gridDim.x + atomicAdd(qhead, 1u); if (q >= 832u) q = 832u + atomicAdd(fhead, 1u); MISC[MI_Q] = q; }
        first = 0;
        __syncthreads();
        const int idx = (int)MISC[MI_Q];
        __syncthreads();
        if (idx >= 832 + CV_LATE_BATCHES + CV_RT_BATCHES + CV_PB_BATCHES) break;
        if (idx >= 832) { if (MK_ATT_SKIP && dry && (MK_ATT_SKIP & 8)) continue; conv_late_batch(w, ws, l, (LAS unsigned char*)lds, idx - 832, tid); continue; }
        int kind, qb, bh;
        if (idx < 160) { kind = 0; qb = 7 - idx / 32; bh = idx % 32; }
        else if (idx < 224) { kind = 1; qb = 7; bh = idx - 160; }
        else if (idx < 256) { kind = 0; qb = 2; bh = idx - 224; }
        else if (idx < 384) { kind = 1; qb = 6 - (idx - 256) / 64; bh = (idx - 256) % 64; }
        else if (idx < 416) { kind = 0; qb = 1; bh = idx - 384; }
        else if (idx < 480) { kind = 1; qb = 4; bh = idx - 416; }
        else if (idx < 544) { kind = 2; qb = 0; bh = idx - 480; }
        else if (idx < 608) { kind = 1; qb = 3; bh = idx - 544; }
        else if (idx < 640) { kind = 0; qb = 0; bh = idx - 608; }
        else if (idx < 704) { kind = 1; qb = 2; bh = idx - 640; }
        else { kind = 1; qb = 1 - (idx - 704) / 64; bh = (idx - 704) % 64; }
        if (MK_ATT_SKIP && dry && ((MK_ATT_SKIP >> kind) & 1)) continue;
        if (kind == 2) { pool_unit(bh, PROJ, XY, tid); __syncthreads(); continue; }
        if (kind == 1) {
            const int b = bh >> 3, h = bh & 7;
            AttnP P; P.Q = PROJ + 2048 + h * 64; P.K = PROJ + 2560 + h * 64; P.V = PROJ + 3072 + h * 64; P.out = XY + 1024 + h * 64; P.stash = nullptr; P.gsub = nullptr; P.logf = LOGF + h; P.opitch = XYP; P.lam = 0.f; P.nscale = 0.f;
            attn_unit<MK_THRF, true>(tid, b, qb, 0, P, lds);
        } else {
            const int b = bh >> 2, h = bh & 3;
#pragma unroll 1
            for (int c = 0; c < 2; ++c) {
                AttnP P; P.Q = PROJ + 512 + (h * 2 + c) * 64; P.K = PROJ + 1024 + (h * 2 + c) * 64; P.V = PROJ + 1536 + h * 128;
                P.stash = STASH + h * 128; P.gsub = w.dsub; P.logf = nullptr; P.lam = lam; P.nscale = 1.0f - lam_init;
                if (c == 0) { P.out = STASH + h * 128; P.opitch = 512; } else { P.out = XY + 512 + h * 128; P.opitch = XYP; }
                attn_unit128<MK_THRD>(mk_tid(wave0), b, qb, c == 0 ? 0 : 4, P, lds); }
        }
    }
}
__device__ __forceinline__ void moe_tables(volatile LAS unsigned* MISC, const unsigned* cls_cnt, int tid) {
    __syncthreads();
    if (tid < 64) {
        const unsigned n = tid < 24 ? cls_cnt[tid] : 0u; const unsigned nch = (n + 255u) >> 8; unsigned inc = nch;
#pragma unroll
        for (int o = 1; o < 32; o <<= 1) { const unsigned up = (unsigned)__builtin_amdgcn_ds_bpermute((tid - o) << 2, (int)inc); if (tid >= o) inc += up; }
        if (tid < 24) { MISC[MI_N + tid] = n; MISC[MI_BASE + tid] = (inc - nch) * 256u; MISC[MI_U0 + tid] = (inc - nch) * 4u; }
        if (tid == 23) MISC[MI_TOT] = inc * 4u; }
    __syncthreads();
}

__device__ __forceinline__ int moe_class(volatile LAS unsigned* MISC, int u, int tid) {
    const int k = tid & 63; const bool ge = k < 24 && u >= (int)MISC[MI_U0 + (k < 24 ? k : 0)];
    const int n = __popcll(__ballot(ge)); return __builtin_amdgcn_readfirstlane(n > 0 ? n - 1 : 0);
}
#ifndef MK_FIXA
#define MK_FIXA 0
#endif
#ifndef MK_FIXB
#define MK_FIXB 0
#endif
#ifndef MK_REPEAT
#define MK_REPEAT 0
#endif
constexpr int NPH = 18;
struct Prog { int p[40]; int n; };
constexpr Prog make_prog() {
    Prog g{}; int n = 0;
    for (int ph = 0; ph < NPH; ++ph) {
        const int kind = (ph == 0 || ph == 9) ? 8 : (ph >= 10 ? ph - 10 : ph - 1);
        g.p[n++] = ph; if ((MK_REPEAT >> kind) & 1) g.p[n++] = ph; }
    g.n = n; return g;
}
__constant__ const Prog PROG = make_prog();
constexpr int NPOS = make_prog().n;
template <unsigned KMASK>
__device__ __forceinline__ void mk_body() {
    typedef const __attribute__((address_space(4))) Args* KArgs;
    const KArgs args0p = (KArgs)__builtin_amdgcn_kernarg_segment_ptr();
    extern __shared__ __attribute__((aligned(16))) unsigned char lds_raw[];
    { LAS unsigned char* lds0 = (LAS unsigned char*)lds_raw;
      for (int u = threadIdx.x; u < (LDS_BYTES - MISC_OFF) / 4; u += NWAVES * 64) ((LAS unsigned*)(lds0 + MISC_OFF))[u] = 0u; }
    __syncthreads();
    const int wave0 = __builtin_amdgcn_readfirstlane(threadIdx.x >> 6);
    XcdBarrier bar = xcd_barrier_post((unsigned*)((gu32*)(args0p->ws + WS_CTL) + CW_BAR) + args0p->li * XCD_BAR_WORDS, (volatile LAS unsigned*)((LAS unsigned char*)lds_raw + MISC_OFF) + MI_BAR, threadIdx.x);
    const int ph_lo = args0p->ph_lo, ph_hi = args0p->ph_hi;
#pragma clang loop unroll(disable)
    for (int pos = ph_lo; pos < ph_hi; ++pos) {
        const int ph = __builtin_amdgcn_readfirstlane(PROG.p[pos]); const int rep = pos; const int dry = (MK_REPEAT != 0 && pos + 1 < ph_hi && __builtin_amdgcn_readfirstlane(PROG.p[pos + 1]) == ph) ? 1 : 0;
        KArgs ap = args0p; asm volatile("" : "+s"(ap));
#define args (*ap)
        LAS unsigned char* lds = (LAS unsigned char*)lds_raw;
        volatile LAS unsigned* MISC = (volatile LAS unsigned*)(lds + MISC_OFF);
        int G = gridDim.x, bx = blockIdx.x; asm volatile("" : "+s"(G), "+s"(bx)); const int vcu = (G % 8 == 0) ? (bx % 8) * (G / 8) + bx / 8 : bx;
        unsigned char* ws = args.ws; gu32* ctl = (gu32*)(ws + WS_CTL);
        float* XOUT = args.out; const float* x0 = (const float*)args.in[0];
        bf16* XY = (bf16*)(ws + WS_XY); bf16* PROJ = (bf16*)(ws + WS_PROJ);
        float* SSA = (float*)(ws + WS_SS); float* SSB = (float*)(ws + WS_SSB);
        if (ph == 0) { if constexpr (KMASK & 0x100u) { const int tid = mk_tid(wave0); const LayerW w = layer_view(ap, 0); conv_layer(w, ws, 0, lds, vcu, G, tid); p0_x(x0, (const int*)args.in[2], ws, (unsigned char*)XOUT + OUT_XB8, vcu, G, tid);
            if (tid == 0) ((unsigned*)(ctl + CW_XCC))[vcu] = xb_xcc_id() + 1u;
            if (bx == 0) { float* GT = (float*)(ctl + CW_GT); const int ll = tid >> 8, r = tid & 255, wch = r >> 6, d = r & 63;
                const float* gsrc = (const float*)(wch == 0 ? args.in[7] : (wch == 1 ? args.in[8] : (wch == 2 ? args.in[11] : args.in[12]))); GT[tid] = gsrc[ll * 64 + d]; } } }
        else if (ph == 9) { }
        else {
            const int l = __builtin_amdgcn_readfirstlane(ph >= 10 ? 1 : 0), k = __builtin_amdgcn_readfirstlane(ph - (l ? 10 : 1));
            const LayerW w = layer_view(ap, l);
            const float* SSin = l == 0 ? SSA : SSB; const float* xcur = l == 0 ? x0 : XOUT;
            if (k == 0) { if constexpr (KMASK & 1u) { const int tid = mk_tid(wave0);
                SchedPlain S{(const char*)(XY + 1536), (const char*)(ws + WS_W + W_IN), (size_t)256 * XYP * 2, (size_t)256 * 2048, 64, 15, 16, G, bx, dry & MK_FIXA, dry & MK_FIXB};
                LAS float* RSL = (LAS float*)(lds + MISC_OFF) + 1024;
                if (tid < 4) { int pm_ = -1, pn_ = 0; if (!tile_order((long)tid * G + bx, 64, 15, pm_, pn_)) pm_ = -1; MISC[112 + tid] = (unsigned)pm_; }
                __syncthreads();
                {
                    const int pm0 = (int)MISC[112 + (tid >> 8)], pm1 = (int)MISC[114 + (tid >> 8)];
                    const float r0 = rstd_at(SSin, (unsigned)((pm0 >= 0 ? pm0 : 0) * 256 + (tid & 255))), r1 = rstd_at(SSin, (unsigned)((pm1 >= 0 ? pm1 : 0) * 256 + (tid & 255)));
                    if (pm0 >= 0) RSL[tid] = r0; if (pm1 >= 0) RSL[512 + tid] = r1; }
                __syncthreads();
                EpiG1 E{SSin, PROJ, (float*)(ws + WS_LOGF), (const float*)(ws + WS_COSSIN), (const float*)(ctl + CW_GT) + 256 * l, w.ffb, dry, RSL};
                pg8::gemm_phase<SchedPlain, EpiG1, false, true>(tid, lds, XYP * 2, 2048, S, E);
                split_arrive_x(bar, (unsigned*)(ctl + CW_SPLIT3) + 64 * l, (unsigned*)(ctl + CW_SPLIT3) + 64 * l + 32 * 0 + 128, mk_tid(wave0));
            } } else if (k == 1) { if constexpr (KMASK & 2u) {
                attn_phase(wave0, w, l, rep, ws, (char*)lds_raw, MISC, ctl, dry);
                split_arrive_x(bar, (unsigned*)(ctl + CW_SPLIT + (2 * l) * 64), (unsigned*)(ctl + CW_SPLITX + (2 * l) * 64), mk_tid(wave0));
            } } else if (k == 2) { if constexpr (KMASK & 4u) { const int tid = mk_tid(wave0);
                unsigned char* gsc = (unsigned char*)XOUT + OUT_GATES + (size_t)bx * 196608;
                LAS float* RSL2 = (LAS float*)(lds + MISC_OFF) + 1024;
                { int pm_, pn_; tile_order(bx, 64, 4, pm_, pn_); if (tid < 256) RSL2[tid] = rstd_at(SSin, (unsigned)(pm_ * 256 + tid)); __syncthreads(); }
                { SchedG2<0> S{(const char*)XOUT + OUT_XB8, (const char*)(ws + WS_W + W_G8), bx};
                  EpiG2<0> E{SSin, gsc, (bf16*)(ws + WS_MERGED), RSL2};
                  pg8::gemm_phase<SchedG2<0>, EpiG2<0>, false, true, true>(tid, lds, 1024, 1024, S, E); }
                { const int t2 = mk_tid(wave0); if (t2 == 0) split_wait_leader((unsigned*)(ctl + CW_SPLIT + (2 * l) * 64), (unsigned)G); __syncthreads(); }
                { SchedG2<1> S{(const char*)XY, (const char*)(ws + WS_W + W_BR), bx};
                  EpiG2<1> E{SSin, gsc, (bf16*)(ws + WS_MERGED), RSL2};
                  pg8::gemm_phase<SchedG2<1>, EpiG2<1>, false, true>(mk_tid(wave0), lds, XYP * 2, 1024, S, E); }
                { int pm_, pn_; tile_order(bx, 64, 4, pm_, pn_); group4_sync((unsigned*)(ctl + CW_G4 + ((2 * l) * 64 + pm_) * 32), mk_tid(wave0)); }
            } } else if (k == 3) { if constexpr (KMASK & 8u) { const int tid = mk_tid(wave0);
                SchedPlain S{(const char*)(ws + WS_MERGED), (const char*)(ws + WS_W + W_OUT), (size_t)256 * 2048, (size_t)256 * 2048, 64, 4, 16, G, bx, 0, 0};
                EpiRes<0, false> E{XY + 1536, XYP, nullptr, XY + 1536, XYP, SSA, nullptr, nullptr, dry, (MK_MU8 && l == NL - 1) ? (unsigned char*)XOUT + OUT_XB8 : nullptr};
                pg8::gemm_phase<SchedPlain, EpiRes<0, false>, false, true>(tid, lds, 2048, 2048, S, E);
                { int pm_, pn_; tile_order(bx, 64, 4, pm_, pn_); group4_sync((unsigned*)(ctl + CW_G4 + ((2 * l + 1) * 64 + pm_) * 32), mk_tid(wave0)); }
            } } else if (k == 4) { if constexpr (KMASK & 16u) { const int tid = mk_tid(wave0);
                {
                    typedef float f32x16r __attribute__((ext_vector_type(16))); typedef short bf16x8r __attribute__((ext_vector_type(8)));
                    const int lane_ = tid & 63, r32 = lane_ & 31, hh = lane_ >> 5, wv = __builtin_amdgcn_readfirstlane(tid >> 6); int pm_, pn_; tile_order(bx, 64, 4, pm_, pn_); const int t0 = pm_ * 256 + pn_ * 64;
                    unsigned* ccnt = (unsigned*)(ctl + CW_CLS + 32 * l + 64 * dry); int* LIST = (int*)(ws + WS_LIST);
                    const GAS char* wrh = (const GAS char*)(ws + WS_W + W_RH) + (unsigned)(r32 * 2048 + (128 * wv + 8 * hh) * 2);
                    const GAS char* xb_ = (const GAS char*)(XY + 1536) + (size_t)t0 * (XYP * 2) + (unsigned)(r32 * (XYP * 2) + (128 * wv + 8 * hh) * 2);
                    f32x16r acc0 = {}, acc1 = {};
#pragma unroll 2
                    for (int ks = 0; ks < 8; ++ks) {
                        const bf16x8r Bh = *(const GAS bf16x8r*)(wrh + ks * 32), Bl = *(const GAS bf16x8r*)(wrh + 65536 + ks * 32);
                        const bf16x8r A0 = *(const GAS bf16x8r*)(xb_ + ks * 32), A1 = *(const GAS bf16x8r*)(xb_ + 32 * (XYP * 2) + ks * 32);
                        acc0 = __builtin_amdgcn_mfma_f32_32x32x16_bf16(A0, Bh, acc0, 0, 0, 0); acc0 = __builtin_amdgcn_mfma_f32_32x32x16_bf16(A0, Bl, acc0, 0, 0, 0);
                        acc1 = __builtin_amdgcn_mfma_f32_32x32x16_bf16(A1, Bh, acc1, 0, 0, 0); acc1 = __builtin_amdgcn_mfma_f32_32x32x16_bf16(A1, Bl, acc1, 0, 0, 0);
                    }
                    LAS float* Pp = (LAS float*)lds;
                    LAS float* Lg = (LAS float*)(lds + 65536);
#pragma unroll
                    for (int r = 0; r < 16; ++r) { const int tk = (r & 3) + 8 * (r >> 2) + 4 * hh; Pp[(wv * 64 + tk) * 32 + r32] = acc0[r]; Pp[(wv * 64 + 32 + tk) * 32 + r32] = acc1[r]; }
                    __syncthreads();
                    { const int tk = tid >> 3, n4 = (tid & 7) * 4; f32x4 s = (f32x4){0.f, 0.f, 0.f, 0.f};
#pragma unroll
                      for (int w8 = 0; w8 < 8; ++w8) s += *(const LAS f32x4*)(Pp + (w8 * 64 + tk) * 32 + n4);
                      *(LAS f32x4*)(Lg + tk * 32 + n4) = s; }
                    __syncthreads();
                    if (tid < 64) { const int t = t0 + tid; float dg[4], de[16];
#pragma unroll
                        for (int e = 0; e < 4; ++e) dg[e] = Lg[tid * 32 + e];
#pragma unroll
                        for (int e = 0; e < 16; ++e) de[e] = Lg[tid * 32 + 4 + e];
                        const float rstd = rstd_at(SSA, (unsigned)t); float wa, wb; const int cls = route_decide(dg, de, rstd, w.brg, w.bre, wa, wb);
                        *(GAS f32x4*)((GAS char*)(ws + WS_TOKW) + (unsigned)t * 16u) = (f32x4){wa, wb, rstd, 0.f}; MISC[128 + tid] = (unsigned)cls; }
                    __syncthreads();
                    if (tid < 64) {
                        const unsigned mycls = MISC[128 + tid]; const unsigned long long ltm = (1ull << tid) - 1ull; unsigned cnt_c = 0, rank = 0;
#pragma unroll 4
                        for (unsigned c = 0; c < 24; ++c) { const unsigned long long m = __ballot(mycls == c); if ((unsigned)tid == c) cnt_c = (unsigned)__popcll(m); if (mycls == c) rank = (unsigned)__popcll(m & ltm); }
                        unsigned base = 0; if (tid < 24 && cnt_c) base = atomicAdd(ccnt + tid, cnt_c);
                        const unsigned mybase = (unsigned)__builtin_amdgcn_ds_bpermute((int)(mycls << 2), (int)base);
                        LIST[(size_t)mycls * T + mybase + rank] = t0 + tid; }
                    __syncthreads();
                }
                split_arrive_x(bar, (unsigned*)(ctl + CW_SPLIT + (2 * l + 1) * 64), (unsigned*)(ctl + CW_SPLITX + (2 * l + 1) * 64), mk_tid(wave0));
            } } else if (k == 5) { if constexpr (KMASK & 96u) { int tid = mk_tid(wave0);
                if (tid == 0) split_wait_leader((unsigned*)(ctl + CW_SPLIT + (2 * l + 1) * 64), (unsigned)G);
                __syncthreads();
                moe_tables(MISC, (const unsigned*)(ctl + CW_CLS + 32 * l), tid);
                const int NUm = (int)MISC[MI_TOT], KO = NUm > 256 ? (NUm - 256) >> 2 : 0;
                const int gid = vcu >> 2, m4 = vcu & 3, xg = gid >> 3, lg = gid & 7;
                const int k_o = lg * 8 + xg, k_p = (lg - 4) * 8 + xg;
                const bool is_o = lg < 4 && k_o < KO, is_p = lg >= 4 && k_p < KO;
                unsigned* cA = (unsigned*)(ctl + CW_MOE2 + 3584 * l); unsigned* cB = cA + 2048; unsigned* cO = cA + 3072;
#pragma clang loop unroll(disable)
                for (int r = 0; r < 2; ++r) {
                    const int u = r == 0 ? vcu : 256 + 4 * k_o + m4; if (r == 1 && !is_o) break;
                    tid = mk_tid(wave0);
                    { const int ucls = moe_class(MISC, u, tid);
                      SchedMoE S{MISC, (const int*)(ws + WS_LIST), (const char*)(XY + 1536), (const char*)(ws + WS_W + W_GU), G, u, 0, 0, ucls};
                      EpiMU E{(bf16*)(ws + OV_ACT), (const float*)(ws + WS_TOKW), 1.0f, (LAS f32x4*)(lds + MISC_OFF + 4096)};
                      pg8::gemm_phase<SchedMoE, EpiMU, true, true>(tid, lds, XYP * 2, 2048, S, E); }
                    if (r == 0 && is_o) {
                        asm volatile("s_waitcnt vmcnt(0)" ::: "memory"); __syncthreads();
                        tid = mk_tid(wave0);
                        if (tid == 0) { const unsigned me = xb_xcc_id() + 1u; bool same = true;
#pragma unroll
                            for (int i = 0; i < 4; ++i) same = same && (xb_ld((unsigned*)(ctl + CW_XCC) + (gid + 4) * 4 + i) == me);
                            if (!same) { __builtin_amdgcn_fence(__ATOMIC_RELEASE, "agent"); asm volatile("s_waitcnt vmcnt(0)" ::: "memory"); }
                            xb_add(cO + 16 * k_o, 1u); asm volatile("s_waitcnt vmcnt(0)" ::: "memory"); }
                        __syncthreads();
                    }
                }
                group4_sync(is_o ? cB + 32 * k_o : cA + 32 * gid, mk_tid(wave0));
#pragma clang loop unroll(disable)
                for (int r = 0; r < 2; ++r) {
                    const int u = r == 0 ? (is_o ? 256 + 4 * k_o + m4 : vcu) : 4 * (gid - 4) + m4; if (r == 1 && !is_p) break;
                    tid = mk_tid(wave0);
                    if (r == 1) {
                        if (tid == 0) { unsigned sp = 0; while (xb_ld(cO + 16 * k_p) < 4u) { __builtin_amdgcn_s_sleep(2); if (++sp > (1u << 22)) break; }
                            __builtin_amdgcn_fence(__ATOMIC_ACQUIRE, "agent"); asm volatile("s_waitcnt vmcnt(0)" ::: "memory"); }
                        __syncthreads();
                    }
                    const int ucls = moe_class(MISC, u, tid);
                    SchedMoE S{MISC, (const int*)(ws + WS_LIST), (const char*)(ws + OV_ACT), (const char*)(ws + WS_W + W_D), G, u, 2, 0, ucls};
                    EpiRes<0, true> E{XY + 1536, XYP, nullptr, (bf16*)(ws + OV_XB2), 1024, SSA, nullptr, nullptr, dry, MK_PLE8 ? ws + WS_MERGED : nullptr};
                    pg8::gemm_phase<SchedMoE, EpiRes<0, true>, false, true>(tid, lds, 1024, 512, S, E);
                }
                { unsigned* fqh = pg8::rflp((unsigned*)(ctl + CW_FQ) + 64 * l); const int NF = 256 + (l + 1 < NL ? CV_EARLY_BATCHES : 0);
                  int arrived = 0;
                  for (;;) {
                    const int tq = mk_tid(wave0);
                    if (tq == 0) MISC[MI_Q] = atomicAdd(fqh, 1u);
                    __syncthreads();
                    const int idx = (int)MISC[MI_Q];
                    __syncthreads();
                    if (idx >= 256 && !arrived) { split_arrive_x(bar, (unsigned*)(ctl + CW_SPLIT3) + 256 + 64 * l, (unsigned*)(ctl + CW_SPLIT3) + 512 + 64 * l, mk_tid(wave0)); arrived = 1; }
                    if (idx >= NF) break;
                    if (idx < 256) {
                        SchedPlain S2{(const char*)(ws + OV_PB), (const char*)(ws + WS_WPLE + l * WPLE_STRIDE + W_P), (size_t)256 * 512, (size_t)256 * 512, 64, 4, 4, 1 << 20, idx, 0, 0};
                        EpiPW E2{(bf16*)(ws + OV_PW)};
                        pg8::gemm_phase<SchedPlain, EpiPW, false, true>(tq, lds, 512, 512, S2, E2);
                    } else { const LayerW w1 = layer_view(ap, 1); conv_early_batch(w1, ws, 1, lds, idx - 256, tq); }
                  } }
            } } else if (k == 6) { if constexpr (KMASK & 96u) {
            } } else { if constexpr (KMASK & 128u) { const int tid = mk_tid(wave0);
                if (tid == 0) split_wait_leader((unsigned*)(ctl + CW_SPLIT3) + 256 + 64 * l, (unsigned)G);
                __syncthreads();
                constexpr int P8 = MK_PLE8 ? 1 : 0;
                SchedPlain S{(const char*)(ws + (P8 ? WS_MERGED : OV_XB2)), (const char*)(ws + WS_WPLE + l * WPLE_STRIDE + W_PG), (size_t)256 * (P8 ? 1024 : 2048), (size_t)256 * (P8 ? 1024 : 2048), 64, 4, P8 ? 8 : 16, G, bx, 0, 0};
                EpiRes<1, false> E{(const bf16*)(ws + OV_XB2), 1024, l == NL - 1 ? XOUT : nullptr, l == NL - 1 ? nullptr : XY + 1536, XYP, SSB, SSA, (const bf16*)(ws + OV_PW), dry, l == NL - 1 ? nullptr : (unsigned char*)XOUT + OUT_XB8};
                pg8::gemm_phase<SchedPlain, EpiRes<1, false>, false, true, P8 != 0>(tid, lds, P8 ? 1024 : 2048, P8 ? 1024 : 2048, S, E);
            } }
        }
        const int kk_ = (ph == 0 || ph == 9) ? -1 : (ph >= 10 ? ph - 10 : ph - 1);
        if (pos + 1 < ph_hi && ph != 9 && (MK_REPEAT != 0 || kk_ > 6 || kk_ < 0)) { xcd_barrier(bar, mk_tid(wave0));
#ifdef MK_DOUBLE_BAR
            xcd_barrier(bar, mk_tid(wave0)); xcd_barrier(bar, mk_tid(wave0));
#endif
        }
#undef args
    }
}

#ifndef MK_KMASKS
#ifdef MK_SPLIT_TEST
#define MK_KMASKS 0x100u
#else
#define MK_KMASKS 0x1FFu
#endif
#endif
__global__ void __launch_bounds__(NWAVES * 64, 2) mk_fwd(Args args) { mk_body<MK_KMASKS>(); }
#ifdef MK_SPLIT_TEST
__global__ void __launch_bounds__(NWAVES * 64, 2) mk_t0(Args args) { mk_body<1u>(); }
__global__ void __launch_bounds__(NWAVES * 64, 2) mk_t1(Args args) { mk_body<2u>(); }
__global__ void __launch_bounds__(NWAVES * 64, 2) mk_t2(Args args) { mk_body<4u>(); }
__global__ void __launch_bounds__(NWAVES * 64, 2) mk_t3(Args args) { mk_body<8u>(); }
__global__ void __launch_bounds__(NWAVES * 64, 2) mk_t4(Args args) { mk_body<16u>(); }
__global__ void __launch_bounds__(NWAVES * 64, 2) mk_t5(Args args) { mk_body<32u>(); }
__global__ void __launch_bounds__(NWAVES * 64, 2) mk_t6(Args args) { mk_body<64u>(); }
__global__ void __launch_bounds__(NWAVES * 64, 2) mk_t7(Args args) { mk_body<128u>(); }
__global__ void __launch_bounds__(NWAVES * 64, 2) mk_t8(Args args) { mk_body<256u>(); }
#endif
#ifndef MK_ONE_LAUNCH
#define MK_ONE_LAUNCH 0
#endif
#ifndef MK_OPT_MASK
#define MK_OPT_MASK 0x3FFFF
#endif
static void ref_phase(int l, int k, void* const* d_in, float* XOUT, unsigned char* ws, hipStream_t st) {
    using namespace refp;
    const float* x0 = (const float*)d_in[0]; const float* p = (const float*)d_in[1]; const int* pos = (const int*)d_in[2];
    const float* g_attn = (const float*)d_in[3] + l * 1024; const float* w_in_l = (const float*)d_in[4] + (size_t)l * 1024 * INW;
    const float* pool_w = (const float*)d_in[5] + (size_t)l * 4 * 128 * 128; const float* pool_scale = (const float*)d_in[6] + l * 512;
    const float* dqn = (const float*)d_in[7] + l * 64; const float* dkn = (const float*)d_in[8] + l * 64; const float* dlam = (const float*)d_in[9] + l * 256;
    const float* dsub = (const float*)d_in[10] + l * 128; const float* fqn = (const float*)d_in[11] + l * 64; const float* fkn = (const float*)d_in[12] + l * 64;
    const float* ffb = (const float*)d_in[13] + l * 8; const float* w_branch_l = (const float*)d_in[14] + (size_t)l * 3 * 512 * 1024; const float* w_out_l = (const float*)d_in[15] + (size_t)l * 1024 * 1024;
    const float* g_ffn = (const float*)d_in[16] + l * 1024; const float* wrg = (const float*)d_in[17] + (size_t)l * 1024 * 4; const float* brg = (const float*)d_in[18] + l * 4;
    const float* wre = (const float*)d_in[19] + (size_t)l * 1024 * 16; const float* bre = (const float*)d_in[20] + l * 16;
    const float* wg_l = (const float*)d_in[21] + (size_t)l * 16 * 1024 * 256; const float* wu_l = (const float*)d_in[22] + (size_t)l * 16 * 1024 * 256; const float* wd_l = (const float*)d_in[23] + (size_t)l * 16 * 256 * 1024;
    const float* g_ple = (const float*)d_in[24] + l * 1024; const float* wpg_l = (const float*)d_in[25] + (size_t)l * 1024 * 1024; const float* wple_l = (const float*)d_in[26] + (size_t)l * 256 * 1024;
    const float* p_l = p + (size_t)l * T * 256;
    float* SSA = (float*)(ws + WS_SS); float* SSB = (float*)(ws + WS_SSB); float* RS = (float*)(ws + WS_RSTD); float* LOGF = (float*)(ws + WS_LOGF); float* FCUM = (float*)(ws + WS_FCUM); float* TOKW = (float*)(ws + WS_TOKW); int* LIST = (int*)(ws + WS_LIST);
    bf16* XY = (bf16*)(ws + WS_XY); bf16* PROJ = (bf16*)(ws + WS_PROJ); float* CH = (float*)(ws + WS_STASH); bf16* MERGED = (bf16*)(ws + WS_MERGED); float* TMP = (float*)(ws + WS_PROJ);
    unsigned* cls_cnt = (unsigned*)(ws + WS_CTL) + CW_CLS + 32 * l;
    const float* xcur = l == 0 ? x0 : XOUT; float* SSin = l == 0 ? SSA : SSB;
    const float lam_init = 0.8f - 0.6f * expf(-0.3f * (float)l);
    if (k == -1) { k_rowstats<<<T / 4, 256, 0, st>>>(x0, XY + 1536, XYP, SSA, RS, nullptr); return; }
    if (k == 0) {
        k_ref_rstd<<<T / 256, 256, 0, st>>>(SSin, RS);
        for (int cc = 0; cc < 14; ++cc) {
            k_ref_gemm<<<dim3(4, T / 64), 256, 0, st>>>(XnormLoader{xcur, RS, g_attn}, w_in_l + 256 * cc, INW, 256, 1024, EpiStoreF32{CH, 256, 0});
            int kind = 2; const float* gain = nullptr; int rot = 0; float osc = 1.f;
            if (cc < 2) kind = 0;
            else if (cc < 4) { kind = 1; gain = dqn; rot = 1; osc = C2; }
            else if (cc < 6) { kind = 1; gain = dkn; rot = 1; }
            else if (cc >= 8 && cc < 10) { kind = 1; gain = fqn; osc = C2; }
            else if (cc >= 10 && cc < 12) { kind = 1; gain = fkn; }
            k_ref_epi1<<<T, 256, 0, st>>>(CH, cc, kind, pool_w, pool_scale, gain, rot, osc, pos, PROJ);
        }
        k_ref_gemm<<<dim3(1, T / 64), 256, 0, st>>>(XnormLoader{xcur, RS, g_attn}, w_in_l + 3584, INW, 8, 1024, EpiStoreF32{CH, 8, 0});
        k_ref_logf<<<T * 8 / 256, 256, 0, st>>>(CH, ffb, LOGF);
    } else if (k == 1) {
        k_ref_fscan<<<1, 64, 0, st>>>(LOGF, FCUM);
        k_ref_fox<<<T * 8 / 4, 256, 0, st>>>(PROJ, FCUM, XY);
        k_ref_diff<<<T * 4 / 2, 128, 0, st>>>(PROJ, dlam, dsub, lam_init, XY);
        k_ref_pool<<<T * 512 / 256, 256, 0, st>>>(PROJ, XY);
    } else if (k == 2) {
        k_ref_rstd<<<T / 256, 256, 0, st>>>(SSin, RS);
        k_ref_gemm2<<<dim3(16, T / 64), 256, 0, st>>>(xcur, RS, g_attn, w_in_l, w_branch_l, XY, MERGED);
    } else if (k == 3) {
        k_ref_gemm<<<dim3(16, T / 64), 256, 0, st>>>(Bf16Loader{MERGED, 1024, 0}, w_out_l, 1024, 1024, 1024, EpiResid{xcur, XOUT});
        k_rowstats<<<T / 4, 256, 0, st>>>(XOUT, XY + 1536, XYP, SSA, RS, nullptr);
    } else if (k == 4) {
        k_route<<<T / 4, 256, 0, st>>>(XOUT, g_ffn, wrg, brg, wre, bre, cls_cnt, LIST, TOKW);
    } else if (k == 5) {
        k_ref_rstd<<<T / 256, 256, 0, st>>>(SSA, RS);
        k_ref_moe<<<dim3(T / 8, 24), 256, 0, st>>>(XOUT, RS, g_ffn, (const int*)cls_cnt, LIST, TOKW, wg_l, wu_l, wd_l);
        k_rowstats<<<T / 4, 256, 0, st>>>(XOUT, (bf16*)(ws + OV_XB2), 1024, SSA, RS, nullptr);
    } else if (k == 7) {
        k_ref_rstd<<<T / 256, 256, 0, st>>>(SSA, RS);
        k_ref_ple<<<dim3(16, T / 64), 256, 0, st>>>(XOUT, RS, g_ple, wpg_l, p_l, wple_l, TMP);
        k_rowstats<<<T / 4, 256, 0, st>>>(TMP, XY + 1536, XYP, SSB, RS, XOUT);
    }
}

extern "C" void kernel_launch(void* const* d_in, const int* in_sizes, int n_in, void* d_out, int out_size, void* d_ws, size_t ws_size, hipStream_t stream) {
    static int grid = 0;
    if (grid == 0) {
        if (n_in != 27 || out_size != T * DM || ws_size < WS_END) { fprintf(stderr, "kernel_launch: unexpected shapes (n_in %d out %d ws %zu)\n", n_in, out_size, ws_size); grid = -1; return; }
        int dev = 0, cus = 0;
        if (hipGetDevice(&dev) != hipSuccess || hipDeviceGetAttribute(&cus, hipDeviceAttributeMultiprocessorCount, dev) != hipSuccess) { grid = -1; return; }
        if (hipFuncSetAttribute((const void*)mk_fwd, hipFuncAttributeMaxDynamicSharedMemorySize, LDS_BYTES) != hipSuccess) { fprintf(stderr, "kernel_launch: hipFuncSetAttribute failed\n"); grid = -1; return; }
#if !MK_ONE_LAUNCH
        { const void* ks[9] = {(const void*)mk_t0, (const void*)mk_t1, (const void*)mk_t2, (const void*)mk_t3, (const void*)mk_t4, (const void*)mk_t5, (const void*)mk_t6, (const void*)mk_t7, (const void*)mk_t8};
          for (int i = 0; i < 9; ++i) (void)hipFuncSetAttribute(ks[i], hipFuncAttributeMaxDynamicSharedMemorySize, LDS_BYTES); }
#endif
        int per_cu = 0;
        if (hipOccupancyMaxActiveBlocksPerMultiprocessor(&per_cu, mk_fwd, NWAVES * 64, LDS_BYTES) != hipSuccess || per_cu < 1) { fprintf(stderr, "kernel_launch: occupancy query failed (%d)\n", per_cu); grid = -1; return; }
        (void)hipGetLastError();
        grid = cus;
    }
    if (grid < 0) return;
    (void)hipMemsetAsync((char*)d_ws + WS_CTL, 0, MK_ONE_LAUNCH ? (size_t)192 * 1024 : CTL_BYTES, stream);
    Args a{};
    for (int i = 0; i < 27; ++i) a.in[i] = d_in[i];
    a.out = (float*)d_out; a.ws = (unsigned char*)d_ws;
#if MK_ONE_LAUNCH
    a.ph_lo = 0; a.ph_hi = NPOS; a.li = 0;
    hipLaunchKernelGGL(mk_fwd, dim3(grid), dim3(NWAVES * 64), LDS_BYTES, stream, a);
#else
    const unsigned mask = MK_OPT_MASK; int li = 0;
    typedef void (*kern_t)(Args);
    const kern_t ks[9] = {mk_t0, mk_t1, mk_t2, mk_t3, mk_t4, mk_t5, mk_t6, mk_t7, mk_t8};
#define LAUNCH_PH(kk) hipLaunchKernelGGL(ks[kk], dim3(grid), dim3(NWAVES * 64), LDS_BYTES, stream, a)
    for (int ph = 0; ph < NPH; ++ph) {
        const bool opt = (mask >> ph) & 1u;
        const int l = ph >= 10 ? 1 : 0, k = ph == 0 ? -1 : (ph == 9 ? -2 : ph - (l ? 10 : 1));
        if (ph == 0) {
            a.ph_lo = 0; a.ph_hi = 1; a.li = li++; LAUNCH_PH(8);
            if (!opt) ref_phase(0, -1, d_in, (float*)d_out, (unsigned char*)d_ws, stream);
            continue; }
        if (ph == 9) { a.ph_lo = 9; a.ph_hi = 10; a.li = li++; LAUNCH_PH(8); continue; }
        if (opt) { a.ph_lo = ph; a.ph_hi = ph + 1; a.li = li++; LAUNCH_PH(k); }
        else if (k != 6) ref_phase(l, k, d_in, (float*)d_out, (unsigned char*)d_ws, stream);
    }
#endif
}
```

```cpp
#include <hip/hip_runtime.h>
#include <cstdio>
#include <cstdint>
#include <cmath>
typedef unsigned short bf16;
constexpr int T = 16384, DM = 1024, S = 2048, NB = 8, NL = 2, INW = 6664;
constexpr float RMS_EPS = 1e-6f;
constexpr float C2 = 0.125f * 1.4426950408889634f;
constexpr size_t MiB = 1u << 20;
constexpr size_t WS_CTL = 0, CTL_BYTES = 1 * MiB;
constexpr size_t WS_SS = 1 * MiB;
constexpr size_t WS_LOGF = 2 * MiB;
constexpr size_t WS_FCUM = 2 * MiB + 512 * 1024;
constexpr size_t WS_TOKW = 3 * MiB;
constexpr size_t WS_RSTD = 3 * MiB + 256 * 1024;
constexpr size_t WS_LIST = 3 * MiB + 512 * 1024;
constexpr size_t WS_COSSIN = 5 * MiB;
constexpr size_t WS_SSB = 49 * MiB;
constexpr size_t WS_W = 6 * MiB;
constexpr size_t WS_WPLE = 52 * MiB;
constexpr size_t WS_XY = 57 * MiB;
constexpr size_t WS_PROJ = 137 * MiB;
constexpr size_t WS_STASH = 249 * MiB;
constexpr size_t WS_MERGED = WS_PROJ + 96 * MiB;
constexpr size_t WS_PB = 265 * MiB;
constexpr size_t WS_END = 273 * MiB;
constexpr int XYP = 2560, PJP = 3584;
constexpr int CW_CLS = 64;
constexpr int CW_AQ = 256;
constexpr int CW_G4 = 16384;
constexpr int CW_SPLIT3 = 24576;
constexpr int CW_MOE2 = 32768;
constexpr int CW_XCC = 40960;
constexpr int CW_GT = 131072;
constexpr int CW_MOEG = 512;
constexpr int CW_SPLIT = 5632;
constexpr int CW_SPLITX = 5888;
constexpr int CW_FQ = 6144;
constexpr int CW_BAR = 8192;
#define MK_ONE_LAUNCH 1
namespace refp {

__device__ __forceinline__ float bf2f(bf16 v) { return __uint_as_float((unsigned)v << 16); }
__device__ __forceinline__ bf16 f2b(float f) { unsigned u = __float_as_uint(f); return (bf16)((u + 0x7fffu + ((u >> 16) & 1u)) >> 16); }
__device__ __forceinline__ float wsum(float v) {
#pragma unroll
    for (int o = 1; o < 64; o <<= 1) v += __shfl_xor(v, o);
    return v;
}
__device__ __forceinline__ float wmax(float v) {
#pragma unroll
    for (int o = 1; o < 64; o <<= 1) v = fmaxf(v, __shfl_xor(v, o));
    return v;
}
__device__ __forceinline__ float row_rstd(const float* SS, int t) {
    float s = 0.f;
#pragma unroll
    for (int i = 0; i < 16; ++i) s += SS[(size_t)t * 16 + i];
    return rsqrtf(s * (1.0f / 1024.0f) + RMS_EPS);
}

__global__ void __launch_bounds__(256) k_rowstats(const float* __restrict__ xsrc, bf16* XBdst, int ldxb, float* SS, float* RSTD, float* xcopy) {
    const int t = blockIdx.x * 4 + (threadIdx.x >> 6), lane = threadIdx.x & 63;
    const float* xr = xsrc + (size_t)t * 1024;
    float s = 0.f;
    for (int j = 0; j < 16; ++j) { const int k = lane + 64 * j; const float v = xr[k]; s += v * v; XBdst[(size_t)t * ldxb + k] = f2b(v); if (xcopy) xcopy[(size_t)t * 1024 + k] = v; }
    s = wsum(s);
    if (lane < 16) SS[(size_t)t * 16 + lane] = (lane == 0) ? s : 0.f;
    if (lane == 0) RSTD[t] = rsqrtf(s * (1.0f / 1024.0f) + RMS_EPS);
}
__global__ void k_ref_rstd(const float* __restrict__ SS, float* RSTD) { const int t = blockIdx.x * blockDim.x + threadIdx.x; if (t < T) RSTD[t] = row_rstd(SS, t); }

struct XnormLoader { const float* x; const float* RS; const float* g;
    __device__ __forceinline__ float operator()(int t, int k) const { return x[(size_t)t * 1024 + k] * RS[t] * g[k]; } };
struct Bf16Loader { const bf16* A; int lda; int pad;
    __device__ __forceinline__ float operator()(int t, int k) const { return bf2f(A[(size_t)t * lda + k]); } };
struct F32Loader { const float* A; int lda; int pad;
    __device__ __forceinline__ float operator()(int t, int k) const { return A[(size_t)t * lda + k]; } };

template <class AL, class EPI>
__global__ void __launch_bounds__(256) k_ref_gemm(AL al, const float* __restrict__ W, int ldw, int N, int K, EPI epi) {
    __shared__ float sA[16][65], sB[16][65];
    const int tx = threadIdx.x & 15, ty = threadIdx.x >> 4, t0 = blockIdx.y * 64, n0 = blockIdx.x * 64;
    float acc[4][4] = {};
    for (int k0 = 0; k0 < K; k0 += 16) {
        for (int e = threadIdx.x; e < 1024; e += 256) { const int r = e >> 4, kk = e & 15; sA[kk][r] = al(t0 + r, k0 + kk); }
        for (int e = threadIdx.x; e < 1024; e += 256) { const int kk = e >> 6, c = e & 63; sB[kk][c] = (n0 + c < N) ? W[(size_t)(k0 + kk) * ldw + n0 + c] : 0.f; }
        __syncthreads();
#pragma unroll
        for (int kk = 0; kk < 16; ++kk) {
            float a[4], b[4];
#pragma unroll
            for (int i = 0; i < 4; ++i) { a[i] = sA[kk][ty * 4 + i]; b[i] = sB[kk][tx * 4 + i]; }
#pragma unroll
            for (int i = 0; i < 4; ++i)
#pragma unroll
                for (int j = 0; j < 4; ++j) acc[i][j] += a[i] * b[j];
        }
        __syncthreads();
    }
#pragma unroll
    for (int i = 0; i < 4; ++i)
#pragma unroll
        for (int j = 0; j < 4; ++j) { const int n = n0 + tx * 4 + j; if (n < N) epi(t0 + ty * 4 + i, n, acc[i][j]); }
}
struct EpiStoreF32 { float* C; int ldc; int pad; __device__ __forceinline__ void operator()(int t, int n, float v) const { C[(size_t)t * ldc + n] = v; } };
struct EpiResid { const float* xs; float* xo; __device__ __forceinline__ void operator()(int t, int n, float v) const { xo[(size_t)t * 1024 + n] = xs[(size_t)t * 1024 + n] + v; } };

__global__ void __launch_bounds__(256) k_ref_epi1(const float* __restrict__ C, int cc, int kind, const float* pool_w, const float* pool_scale,
                                                  const float* gain, int rotary, float outscale, const int* positions, bf16* PROJ) {
    __shared__ float row[256];
    const int t = blockIdx.x, j = threadIdx.x;
    row[j] = C[(size_t)t * 256 + j];
    __syncthreads();
    float out;
    if (kind == 0) {
        const int g = 2 * cc + (j >> 7), d = j & 127; float s = 0.f;
        for (int c = 0; c < 128; ++c) s += row[(j & 128) + c] * pool_w[((size_t)g * 128 + c) * 128 + d];
        out = s * pool_scale[g * 128 + d];
    } else if (kind == 1) {
        const int dim = j & 63; float v = row[j];
        const float ss = wsum(v * v);
        v = v * rsqrtf(ss * (1.0f / 64.0f) + RMS_EPS) * gain[dim];
        if (rotary) {
            const float other = __shfl_xor(v, 8);
            if (dim < 16) {
                const int i = dim & 7; const float invf = powf(500000.0f, -(float)(2 * i) / 16.0f);
                const float ang = (float)positions[t] * invf; const float c = cosf(ang), s = sinf(ang);
                v = (dim < 8) ? (v * c - other * s) : (v * c + other * s);
            }
        }
        out = v * outscale;
    } else out = row[j];
    PROJ[(size_t)t * 3584 + 256 * cc + j] = f2b(out);
}
__global__ void k_ref_logf(const float* __restrict__ C8, const float* fb, float* LOGF) {
    const int i = blockIdx.x * blockDim.x + threadIdx.x; if (i >= T * 8) return;
    const float v = C8[i] + fb[i & 7];
    LOGF[i] = fminf(v, 0.f) - log1pf(expf(-fabsf(v)));
}
__global__ void k_ref_fscan(const float* __restrict__ LOGF, float* FCUM) {
    const int i = threadIdx.x; if (i >= 64) return; const int b = i >> 3, h = i & 7; float s = 0.f;
    for (int t = 0; t < S; ++t) { s += LOGF[((size_t)b * S + t) * 8 + h]; FCUM[((size_t)b * S + t) * 8 + h] = s; }
}
__global__ void __launch_bounds__(256) k_ref_fox(const bf16* __restrict__ PROJ, const float* __restrict__ FCUM, bf16* XY) {
    __shared__ float P[4][S];
    const int w = threadIdx.x >> 6, lane = threadIdx.x & 63; const int gw = blockIdx.x * 4 + w; const int t = gw >> 3, h = gw & 7; const int b = t / S, sq = t % S;
    float q[64];
#pragma unroll
    for (int d = 0; d < 64; ++d) q[d] = bf2f(PROJ[(size_t)t * 3584 + 2048 + h * 64 + d]);
    const float Ft = FCUM[(size_t)t * 8 + h];
    float m = -INFINITY;
    for (int j = lane; j <= sq; j += 64) { const bf16* kr = PROJ + ((size_t)b * S + j) * 3584 + 2560 + h * 64; float s = 0.f;
#pragma unroll
        for (int d = 0; d < 64; ++d) s += q[d] * bf2f(kr[d]);
        s += (Ft - FCUM[((size_t)b * S + j) * 8 + h]) * 1.4426950408889634f; P[w][j] = s; m = fmaxf(m, s); }
    m = wmax(m); float l = 0.f;
    for (int j = lane; j <= sq; j += 64) { const float p = exp2f(P[w][j] - m); P[w][j] = p; l += p; }
    l = wsum(l);
    __syncthreads();
    float o = 0.f;
    for (int j = 0; j <= sq; ++j) o += P[w][j] * bf2f(PROJ[((size_t)b * S + j) * 3584 + 3072 + h * 64 + lane]);
    XY[(size_t)t * 2560 + 1024 + h * 64 + lane] = f2b(o / l);
}
__global__ void __launch_bounds__(128) k_ref_diff(const bf16* __restrict__ PROJ, const float* __restrict__ lamp, const float* __restrict__ gsub, float lam_init, bf16* XY) {
    __shared__ float P[2][2][S];
    const int w = threadIdx.x >> 6, lane = threadIdx.x & 63; const int gw = blockIdx.x * 2 + w; const int t = gw >> 2, h = gw & 3; const int b = t / S, sq = t % S;
    float lam; { const float a = wsum(lamp[lane] * lamp[64 + lane]), c = wsum(lamp[128 + lane] * lamp[192 + lane]); lam = expf(a) - expf(c) + lam_init; }
    float linv[2];
    for (int c = 0; c < 2; ++c) {
        float q[64];
#pragma unroll
        for (int d = 0; d < 64; ++d) q[d] = bf2f(PROJ[(size_t)t * 3584 + 512 + (h * 2 + c) * 64 + d]);
        float m = -INFINITY;
        for (int j = lane; j <= sq; j += 64) { const bf16* kr = PROJ + ((size_t)b * S + j) * 3584 + 1024 + (h * 2 + c) * 64; float s = 0.f;
    #pragma unroll
        for (int d = 0; d < 64; ++d) s += q[d] * bf2f(kr[d]);
            P[w][c][j] = s; m = fmaxf(m, s); }
        m = wmax(m); float l = 0.f;
        for (int j = lane; j <= sq; j += 64) { const float p = exp2f(P[w][c][j] - m); P[w][c][j] = p; l += p; }
        linv[c] = 1.0f / wsum(l);
    }
    __syncthreads();
    float o0 = 0.f, o1 = 0.f;
    for (int j = 0; j <= sq; ++j) { const float a = P[w][0][j] * linv[0] - lam * P[w][1][j] * linv[1]; const bf16* vr = PROJ + ((size_t)b * S + j) * 3584 + 1536 + h * 128;
        o0 += a * bf2f(vr[lane]); o1 += a * bf2f(vr[64 + lane]); }
    const float ss = wsum(o0 * o0 + o1 * o1); const float r = rsqrtf(ss * (1.0f / 128.0f) + RMS_EPS) * (1.0f - lam_init);
    XY[(size_t)t * 2560 + 512 + h * 128 + lane] = f2b(o0 * r * gsub[lane]);
    XY[(size_t)t * 2560 + 512 + h * 128 + 64 + lane] = f2b(o1 * r * gsub[64 + lane]);
}
__global__ void k_ref_pool(const bf16* __restrict__ PROJ, bf16* XY) {
    const int i = blockIdx.x * blockDim.x + threadIdx.x; if (i >= T * 512) return; const int t = i >> 9, j = i & 511; const int g = j >> 7, w = 2 << g, s = t % S;
    const int cnt = min(s + 1, w); float a = 0.f;
    for (int k = 0; k < cnt; ++k) a += bf2f(PROJ[(size_t)(t - k) * 3584 + j]);
    XY[(size_t)t * 2560 + j] = f2b(a / (float)cnt - bf2f(PROJ[(size_t)t * 3584 + j]));
}
__global__ void __launch_bounds__(256) k_ref_gemm2(const float* __restrict__ x, const float* __restrict__ SS, const float* __restrict__ g, const float* __restrict__ w_in_l,
                                                   const float* __restrict__ w_branch_l, const bf16* __restrict__ XY, bf16* MERGED) {
    __shared__ float sA[16][65], sB[16][65];
    const int tx = threadIdx.x & 15, ty = threadIdx.x >> 4, t0 = blockIdx.y * 64, n0 = blockIdx.x * 64;
    float mg[4][4] = {};
    for (int n = 0; n < 3; ++n) {
        float ag[4][4] = {}, ab[4][4] = {};
        for (int pass = 0; pass < 2; ++pass) {
            const int K = pass == 0 ? 1024 : 512;
            for (int k0 = 0; k0 < K; k0 += 16) {
                for (int e = threadIdx.x; e < 1024; e += 256) { const int r = e >> 4, kk = e & 15; const int t = t0 + r, k = k0 + kk;
                    sA[kk][r] = pass == 0 ? x[(size_t)t * 1024 + k] * SS[t] * g[k] : bf2f(XY[(size_t)t * 2560 + 512 * n + k]); }
                for (int e = threadIdx.x; e < 1024; e += 256) { const int kk = e >> 6, c = e & 63; const int k = k0 + kk;
                    sB[kk][c] = pass == 0 ? w_in_l[(size_t)k * INW + 3592 + n * 1024 + n0 + c] : w_branch_l[((size_t)n * 512 + k) * 1024 + n0 + c]; }
                __syncthreads();
#pragma unroll
                for (int kk = 0; kk < 16; ++kk) {
                    float a[4], b[4];
#pragma unroll
                    for (int i = 0; i < 4; ++i) { a[i] = sA[kk][ty * 4 + i]; b[i] = sB[kk][tx * 4 + i]; }
#pragma unroll
                    for (int i = 0; i < 4; ++i)
#pragma unroll
                        for (int j = 0; j < 4; ++j) { if (pass == 0) ag[i][j] += a[i] * b[j]; else ab[i][j] += a[i] * b[j]; }
                }
                __syncthreads();
            }
        }
#pragma unroll
        for (int i = 0; i < 4; ++i)
#pragma unroll
            for (int j = 0; j < 4; ++j) mg[i][j] += ab[i][j] / (1.0f + expf(-ag[i][j]));
    }
#pragma unroll
    for (int i = 0; i < 4; ++i)
#pragma unroll
        for (int j = 0; j < 4; ++j) MERGED[(size_t)(t0 + ty * 4 + i) * 1024 + n0 + tx * 4 + j] = f2b(mg[i][j]);
}
__global__ void __launch_bounds__(256) k_ref_moe(float* X, const float* __restrict__ SS, const float* __restrict__ g, const int* __restrict__ cls_cnt, const int* __restrict__ LIST,
                                                 const float* __restrict__ TOKW, const float* __restrict__ wg_l, const float* __restrict__ wu_l, const float* __restrict__ wd_l) {
    __shared__ float h[8][1024]; __shared__ float act[8][512]; __shared__ int tok[8];
    const int cls = blockIdx.y, n_c = cls_cnt[cls], base = blockIdx.x * 8; if (base >= n_c) return;
    const int nt = min(8, n_c - base), tid = threadIdx.x;
    if (tid < 8) tok[tid] = tid < nt ? LIST[(size_t)cls * T + base + tid] : -1;
    __syncthreads();
    for (int e = tid; e < 8 * 1024; e += 256) { const int i = e >> 10, k = e & 1023; const int t = tok[i]; h[i][k] = t >= 0 ? X[(size_t)t * 1024 + k] * SS[t] * g[k] : 0.f; }
    __syncthreads();
    const int grp = cls / 6, pr = cls % 6; const int pa = pr < 3 ? 0 : (pr < 5 ? 1 : 2), pb = pr < 3 ? pr + 1 : (pr < 5 ? pr - 1 : 3); const int ea = grp * 4 + pa, eb = grp * 4 + pb;
    for (int s = 0; s < 2; ++s) { const int e = s ? eb : ea; float ga[8], ua[8];
#pragma unroll
        for (int i = 0; i < 8; ++i) { ga[i] = 0.f; ua[i] = 0.f; }
        const float* wg = wg_l + (size_t)e * 1024 * 256 + tid; const float* wu = wu_l + (size_t)e * 1024 * 256 + tid;
        for (int k = 0; k < 1024; ++k) { const float a = wg[(size_t)k * 256], u = wu[(size_t)k * 256];
#pragma unroll
            for (int i = 0; i < 8; ++i) { ga[i] += h[i][k] * a; ua[i] += h[i][k] * u; } }
#pragma unroll
        for (int i = 0; i < 8; ++i) { const int t = tok[i]; const float w = t >= 0 ? TOKW[(size_t)t * 4 + s] : 0.f; act[i][s * 256 + tid] = ga[i] / (1.0f + expf(-ga[i])) * ua[i] * w; } }
    __syncthreads();
    for (int j = 0; j < 4; ++j) { const int n = tid + 256 * j; float y[8];
#pragma unroll
        for (int i = 0; i < 8; ++i) y[i] = 0.f;
        for (int s = 0; s < 2; ++s) { const int e = s ? eb : ea; const float* wd = wd_l + (size_t)e * 256 * 1024 + n;
            for (int f = 0; f < 256; ++f) { const float w = wd[(size_t)f * 1024];
#pragma unroll
                for (int i = 0; i < 8; ++i) y[i] += act[i][s * 256 + f] * w; } }
#pragma unroll
        for (int i = 0; i < 8; ++i) { const int t = tok[i]; if (t >= 0) X[(size_t)t * 1024 + n] += y[i]; } }
}
__global__ void __launch_bounds__(256) k_ref_ple(const float* __restrict__ x, const float* __restrict__ SS, const float* __restrict__ g, const float* __restrict__ wgate_l,
                                                 const float* __restrict__ p_l, const float* __restrict__ wple_l, float* xo) {
    __shared__ float sA[16][65], sB[16][65];
    const int tx = threadIdx.x & 15, ty = threadIdx.x >> 4, t0 = blockIdx.y * 64, n0 = blockIdx.x * 64;
    float ag[4][4] = {}, ab[4][4] = {};
    for (int pass = 0; pass < 2; ++pass) {
        const int K = pass == 0 ? 1024 : 256;
        for (int k0 = 0; k0 < K; k0 += 16) {
            for (int e = threadIdx.x; e < 1024; e += 256) { const int r = e >> 4, kk = e & 15; const int t = t0 + r, k = k0 + kk;
                sA[kk][r] = pass == 0 ? x[(size_t)t * 1024 + k] * SS[t] * g[k] : p_l[(size_t)t * 256 + k]; }
            for (int e = threadIdx.x; e < 1024; e += 256) { const int kk = e >> 6, c = e & 63; const int k = k0 + kk;
                sB[kk][c] = pass == 0 ? wgate_l[(size_t)k * 1024 + n0 + c] : wple_l[(size_t)k * 1024 + n0 + c]; }
            __syncthreads();
#pragma unroll
            for (int kk = 0; kk < 16; ++kk) {
                float a[4], b[4];
#pragma unroll
                for (int i = 0; i < 4; ++i) { a[i] = sA[kk][ty * 4 + i]; b[i] = sB[kk][tx * 4 + i]; }
#pragma unroll
                for (int i = 0; i < 4; ++i)
#pragma unroll
                    for (int j = 0; j < 4; ++j) { if (pass == 0) ag[i][j] += a[i] * b[j]; else ab[i][j] += a[i] * b[j]; }
            }
            __syncthreads();
        }
    }
#pragma unroll
    for (int i = 0; i < 4; ++i)
#pragma unroll
        for (int j = 0; j < 4; ++j) { const size_t o = (size_t)(t0 + ty * 4 + i) * 1024 + n0 + tx * 4 + j; xo[o] = x[o] + ab[i][j] / (1.0f + expf(-ag[i][j])); }
}
}
template <class BG, class BE>
__device__ __forceinline__ int route_decide(const float (&dg)[4], const float (&de)[16], const float rstd, const BG& brg, const BE& bre, float& wa, float& wb) {
    float lg[4]; int gi = 0; float lmax;
#pragma unroll
    for (int e = 0; e < 4; ++e) lg[e] = rstd * dg[e] + brg[e];
    lmax = lg[0];
#pragma unroll
    for (int e = 1; e < 4; ++e) if (lg[e] > lmax) { lmax = lg[e]; gi = e; }
    float den = 0.f;
#pragma unroll
    for (int e = 0; e < 4; ++e) den += expf(lg[e] - lmax);
    const float gp = 1.0f / den;
    float el[4] = {0.f, 0.f, 0.f, 0.f};
#pragma unroll
    for (int gg = 0; gg < 4; ++gg)
#pragma unroll
        for (int e = 0; e < 4; ++e) if (gg == gi) el[e] = rstd * de[gg * 4 + e] + bre[gg * 4 + e];
    int i1 = 0; float m1 = el[0];
#pragma unroll
    for (int e = 1; e < 4; ++e) if (el[e] > m1) { m1 = el[e]; i1 = e; }
    int i2 = -1; float m2 = -INFINITY;
#pragma unroll
    for (int e = 0; e < 4; ++e) if (e != i1 && el[e] > m2) { m2 = el[e]; i2 = e; }
    const float r2 = expf(m2 - m1); const float w1 = gp / (1.0f + r2), w2 = gp * r2 / (1.0f + r2);
    const int a = min(i1, i2), b = max(i1, i2); const int pr = (a == 0) ? (b - 1) : ((a == 1) ? (b + 1) : 5); const int cls = gi * 6 + pr;
    wa = i1 == a ? w1 : w2; wb = i1 == a ? w2 : w1;
    return cls;
}
__device__ __forceinline__ int route_core(int t, int lane, const float* __restrict__ X, const float* __restrict__ g, const float* __restrict__ wrg, const float* __restrict__ brg,
                                          const float* __restrict__ wre, const float* __restrict__ bre, float* TOKW) {
    float ss = 0.f, dg[4] = {0.f, 0.f, 0.f, 0.f}, de[16];
#pragma unroll
    for (int e = 0; e < 16; ++e) de[e] = 0.f;
#pragma unroll 4
    for (int i = 0; i < 16; ++i) { const int k = lane + 64 * i; const float xv = X[(size_t)t * 1024 + k]; ss += xv * xv; const float h = xv * g[k];
        const float4 a = *(const float4*)(wrg + (size_t)k * 4); dg[0] += h * a.x; dg[1] += h * a.y; dg[2] += h * a.z; dg[3] += h * a.w;
#pragma unroll
        for (int q = 0; q < 4; ++q) { const float4 b = *(const float4*)(wre + (size_t)k * 16 + 4 * q); de[4 * q] += h * b.x; de[4 * q + 1] += h * b.y; de[4 * q + 2] += h * b.z; de[4 * q + 3] += h * b.w; } }
    ss = refp::wsum(ss);
#pragma unroll
    for (int e = 0; e < 4; ++e) dg[e] = refp::wsum(dg[e]);
#pragma unroll
    for (int e = 0; e < 16; ++e) de[e] = refp::wsum(de[e]);
    const float rstd = rsqrtf(ss * (1.0f / 1024.0f) + RMS_EPS);
    float wa, wb; const int cls = route_decide(dg, de, rstd, brg, bre, wa, wb);
    if (lane == 0) *(float4*)(TOKW + (size_t)t * 4) = make_float4(wa, wb, rstd, 0.f);
    return cls;
}
__device__ __forceinline__ void route_token(int t, int lane, const float* __restrict__ X, const float* __restrict__ g, const float* __restrict__ wrg, const float* __restrict__ brg,
                                            const float* __restrict__ wre, const float* __restrict__ bre, unsigned* cls_cnt, int* LIST, float* TOKW) {
    const int cls = route_core(t, lane, X, g, wrg, brg, wre, bre, TOKW);
    if (lane == 0) { const unsigned pos = atomicAdd(cls_cnt + cls, 1u); LIST[(size_t)cls * T + pos] = t; }
}
__global__ void __launch_bounds__(256) k_route(const float* X, const float* g, const float* wrg, const float* brg, const float* wre, const float* bre, unsigned* cls_cnt, int* LIST, float* TOKW) {
    const int t = blockIdx.x * 4 + (threadIdx.x >> 6);
    route_token(t, threadIdx.x & 63, X, g, wrg, brg, wre, bre, cls_cnt, LIST, TOKW);
}

namespace pg8 {
#define PG8_LAS __attribute__((address_space(3)))
typedef short bf16x8 __attribute__((ext_vector_type(8)));
typedef float f32x4 __attribute__((ext_vector_type(4)));
typedef unsigned u32x4 __attribute__((ext_vector_type(4)));
typedef int i32x4 __attribute__((ext_vector_type(4)));
typedef int i32x8 __attribute__((ext_vector_type(8)));
__device__ __forceinline__ i32x8 cat8(bf16x8 lo, bf16x8 hi) { const i32x4 a = __builtin_bit_cast(i32x4, lo), b = __builtin_bit_cast(i32x4, hi); return __builtin_shufflevector(a, b, 0, 1, 2, 3, 4, 5, 6, 7); }
constexpr int BM = 256, BK = 64, HALF = 128, HTB = HALF * BK * 2, STAGE_BYTES = 8 * HTB;

__host__ __device__ __forceinline__ int lds_byte(int r, int c) { const int st = (r >> 4) * 2 + (c >> 5), rr = r & 15, cc = c & 31, ob = rr * 64 + cc * 2; return st * 1024 + (ob ^ (((ob >> 9) & 1) << 5)); }
__host__ __device__ __forceinline__ void stage_rc(int b, int& R, int& C) { const int st = b / 1024, sb = b % 1024, swz = sb ^ (((sb >> 9) & 1) << 5); R = (st >> 1) * 16 + swz / 64; C = (st & 1) * 32 + (swz % 64) / 2; }
__host__ __device__ __forceinline__ int perm32(int rho) { const int n = rho >> 4, i = rho & 15; return 8 * (i >> 2) + 4 * n + (i & 3); }

struct Step { const char* A; const char* B; const int* rows; int nt, pm, pn, aux, nvalid, zero_after; };
__device__ __forceinline__ int rfl(int v) { return __builtin_amdgcn_readfirstlane(v); }
template <class P> __device__ __forceinline__ P rflp(P p) { const unsigned long long u = (unsigned long long)p; const unsigned lo = (unsigned)__builtin_amdgcn_readfirstlane((int)(unsigned)u), hi = (unsigned)__builtin_amdgcn_readfirstlane((int)(unsigned)(u >> 32)); return (P)(((unsigned long long)hi << 32) | lo); }
__device__ __forceinline__ void step_uniform(Step& s, int& ok) {
    s.A = rflp(s.A); s.B = rflp(s.B); s.rows = rflp(s.rows); s.nt = rfl(s.nt); s.pm = rfl(s.pm); s.pn = rfl(s.pn); s.aux = rfl(s.aux); s.nvalid = rfl(s.nvalid); s.zero_after = rfl(s.zero_after); ok = rfl(ok);
    asm volatile("" : "+s"(ok), "+s"(s.A), "+s"(s.B), "+s"(s.nt), "+s"(s.aux));
}

template <class E> __device__ __forceinline__ auto epi_prep(const E& e, const Step& s, int tid, int wid, int) -> decltype(e.prep(s, tid, wid), void()) { e.prep(s, tid, wid); }
template <class E> __device__ __forceinline__ void epi_prep(const E&, const Step&, int, int, long) {}
template <class Sched, class Epi, bool GATHER, bool ALIGN_EPI, bool F8 = false>
__device__ __forceinline__ void gemm_phase(const int tid, PG8_LAS unsigned char* lds, const unsigned lda, const unsigned ldb, const Sched& S, const Epi& E) {
    const int wid = __builtin_amdgcn_readfirstlane(tid >> 6), lane = tid & 63, wr = wid >> 2, wc = wid & 3, fr = lane & 15, fq = lane >> 4;
    int Rr[2], Cc[2]; unsigned voffB[2], cOA[2][2], nOA[2][2];
#pragma unroll
    for (int i = 0; i < 2; ++i) { stage_rc(tid * 16 + i * 8192, Rr[i], Cc[i]); const int Rb = (Rr[i] & ~31) + perm32(Rr[i] & 31); voffB[i] = (unsigned)Rb * ldb + (unsigned)Cc[i] * 2u; }
    const size_t kstep = (size_t)(BK * 2);
    const size_t hstepB = (size_t)HALF * ldb;
    const unsigned ldsw = (unsigned)wid * 1024u;
    const int aoff = lds_byte(wr * 64 + fr, fq * 8), boff = lds_byte(wc * 32 + fr, fq * 8);
#define PG8_SA(b, h) (((b) * 2 + (h)) * HTB)
#define PG8_SB(b, h) ((4 + (b) * 2 + (h)) * HTB)
#define PG8_STAGE_B(bufoff, gbase) do { _Pragma("unroll") for (int _i = 0; _i < 2; ++_i) \
        __builtin_amdgcn_global_load_lds((const unsigned*)((const char*)(gbase) + voffB[_i]), (PG8_LAS unsigned*)(lds + (bufoff) + ldsw + _i * 8192), 16, 0, 0); } while (0)
#define PG8_STAGE_A(bufoff, gbase, o0, o1) do { \
        __builtin_amdgcn_global_load_lds((const unsigned*)((const char*)(gbase) + (o0)), (PG8_LAS unsigned*)(lds + (bufoff) + ldsw), 16, 0, 0); \
        __builtin_amdgcn_global_load_lds((const unsigned*)((const char*)(gbase) + (o1)), (PG8_LAS unsigned*)(lds + (bufoff) + ldsw + 8192), 16, 0, 0); } while (0)
#define PG8_LDA(dst, b, h) do { _Pragma("unroll") for (int m = 0; m < 4; ++m) _Pragma("unroll") for (int k = 0; k < 2; ++k) dst[m][k] = *(const PG8_LAS bf16x8*)(lds + PG8_SA(b, h) + aoff + m * 2048 + k * 1024); } while (0)
#define PG8_LDB(dst, b, h) do { _Pragma("unroll") for (int n = 0; n < 2; ++n) _Pragma("unroll") for (int k = 0; k < 2; ++k) dst[n][k] = *(const PG8_LAS bf16x8*)(lds + PG8_SB(b, h) + boff + n * 2048 + k * 1024); } while (0)
#define PG8_MMA(ai, bj, At, Bt) do { __builtin_amdgcn_s_setprio(1); \
        if constexpr (F8) { _Pragma("unroll") for (int m = 0; m < 4; ++m) _Pragma("unroll") for (int n = 0; n < 2; ++n) \
            asm volatile("v_mfma_scale_f32_16x16x128_f8f6f4 %0, %1, %2, %0, %3, %3 op_sel_hi:[0,0,0]" : "+v"(acc[ai][bj][m][n]) : "v"(cat8(Bt[n][0], Bt[n][1])), "v"(cat8(At[m][0], At[m][1])), "v"(f8scale)); } \
        else { _Pragma("unroll") for (int m = 0; m < 4; ++m) _Pragma("unroll") for (int n = 0; n < 2; ++n) _Pragma("unroll") for (int k = 0; k < 2; ++k) \
            acc[ai][bj][m][n] = __builtin_amdgcn_mfma_f32_16x16x32_bf16(Bt[n][k], At[m][k], acc[ai][bj][m][n], 0, 0, 0); } \
        __builtin_amdgcn_s_setprio(0); } while (0)
#define PG8_WAIT_V(n) asm volatile("s_waitcnt vmcnt(" #n ")" ::: "memory")
#define PG8_WAIT_L(n) asm volatile("s_waitcnt lgkmcnt(" #n ")" ::: "memory")
#define PG8_BAR __builtin_amdgcn_s_barrier()
#define PG8_SCHED __builtin_amdgcn_sched_barrier(0)
#define PG8_AOFFS(dst, st) do { _Pragma("unroll") for (int _h = 0; _h < 2; ++_h) _Pragma("unroll") for (int _i = 0; _i < 2; ++_i) { \
        int _row = Rr[_i] + 128 * _h; if (GATHER) { _row = (st).rows[_row]; _row = _row < 0 ? 0 : _row; } \
        dst[_h][_i] = (unsigned)_row * lda + (unsigned)Cc[_i] * 2u; } } while (0)
    int f8scale = 0x7F7F7F7F; if constexpr (F8) asm volatile("" : "+v"(f8scale));
    Step cur, nxt; int ui = 0;
    { int ok_ = S.next(0, cur) ? 1 : 0; step_uniform(cur, ok_); if (!ok_) return; }
    f32x4 acc[2][2][4][2];
#pragma unroll
    for (int a = 0; a < 2; ++a)
#pragma unroll
        for (int b = 0; b < 2; ++b)
#pragma unroll
            for (int m = 0; m < 4; ++m)
#pragma unroll
                for (int n = 0; n < 2; ++n) acc[a][b][m][n] = (f32x4){0.f, 0.f, 0.f, 0.f};
    bf16x8 At[4][2], B0[2][2], B1[2][2];
    PG8_AOFFS(cOA, cur);
    epi_prep(E, cur, tid, wid, 0);
    const char* cA = cur.A; const char* cB = cur.B;
    PG8_STAGE_B(PG8_SB(0, 0), cB); PG8_STAGE_B(PG8_SB(0, 1), cB + hstepB); PG8_STAGE_A(PG8_SA(0, 0), cA, cOA[0][0], cOA[0][1]); PG8_STAGE_A(PG8_SA(0, 1), cA, cOA[1][0], cOA[1][1]);
    if (wr == 1) PG8_BAR;
    PG8_WAIT_V(2); PG8_BAR;
    PG8_STAGE_B(PG8_SB(1, 0), cB + kstep); PG8_STAGE_A(PG8_SA(1, 0), cA + kstep, cOA[0][0], cOA[0][1]); PG8_STAGE_B(PG8_SB(1, 1), cB + hstepB + kstep);
    PG8_WAIT_V(6); PG8_BAR;
#pragma clang loop unroll(disable)
    for (;;) {
        bool has_next = S.next(ui + 1, nxt);
        { int hn_ = has_next ? 1 : 0; step_uniform(nxt, hn_); has_next = hn_ != 0; }
        asm volatile("" : "+v"(voffB[0]), "+v"(voffB[1]));
        const char* nA = has_next ? nxt.A : cA; const char* nB = has_next ? nxt.B : cB;
        if (GATHER) { if (has_next) { PG8_AOFFS(nOA, nxt); } else {
#pragma unroll
            for (int _h = 0; _h < 2; ++_h)
#pragma unroll
                for (int _i = 0; _i < 2; ++_i) nOA[_h][_i] = cOA[_h][_i]; } }
        const int nt = cur.nt;
#pragma clang loop unroll(disable)
        for (int t = 0; t < nt; t += 2) {
            const bool last = (t == nt - 2);
            const char* a1 = cA + (size_t)(t + 1) * kstep;
            const char* a2 = last ? nA : cA + (size_t)(t + 2) * kstep; const char* b2 = last ? nB : cB + (size_t)(t + 2) * kstep;
            const char* a3 = a2 + kstep; const char* b3 = b2 + kstep;
            unsigned o00, o01, o10, o11;
            if (GATHER) { o00 = last ? nOA[0][0] : cOA[0][0]; o01 = last ? nOA[0][1] : cOA[0][1]; o10 = last ? nOA[1][0] : cOA[1][0]; o11 = last ? nOA[1][1] : cOA[1][1]; }
            else { o00 = cOA[0][0]; o01 = cOA[0][1]; o10 = cOA[1][0]; o11 = cOA[1][1]; }
            PG8_LDB(B0, 0, 0); PG8_LDB(B1, 0, 1); PG8_SCHED; PG8_LDA(At, 0, 0); PG8_STAGE_A(PG8_SA(1, 1), a1, cOA[1][0], cOA[1][1]);
            PG8_WAIT_V(8); PG8_WAIT_L(0); PG8_BAR; PG8_MMA(0, 0, At, B0); PG8_MMA(0, 1, At, B1); PG8_BAR; PG8_SCHED;
            PG8_LDA(At, 0, 1); PG8_STAGE_B(PG8_SB(0, 0), b2); PG8_STAGE_B(PG8_SB(0, 1), b2 + hstepB); PG8_STAGE_A(PG8_SA(0, 0), a2, o00, o01);
            PG8_WAIT_V(8); PG8_WAIT_L(0); PG8_BAR; PG8_MMA(1, 0, At, B0); PG8_MMA(1, 1, At, B1); PG8_BAR; PG8_SCHED;
            PG8_LDB(B0, 1, 0); PG8_LDB(B1, 1, 1); PG8_SCHED; PG8_LDA(At, 1, 0); PG8_STAGE_A(PG8_SA(0, 1), a2, o10, o11);
            PG8_WAIT_V(8); PG8_WAIT_L(0); PG8_BAR; PG8_MMA(0, 0, At, B0); PG8_MMA(0, 1, At, B1); PG8_BAR; PG8_SCHED;
            PG8_LDA(At, 1, 1); PG8_STAGE_B(PG8_SB(1, 0), b3); PG8_STAGE_B(PG8_SB(1, 1), b3 + hstepB); PG8_STAGE_A(PG8_SA(1, 0), a3, o00, o01);
            PG8_WAIT_V(8); PG8_WAIT_L(0); PG8_BAR; PG8_MMA(1, 0, At, B0); PG8_MMA(1, 1, At, B1); PG8_BAR; PG8_SCHED;
        }
        if constexpr (F8) { asm volatile("s_nop 15\n\ts_nop 15" ::: "memory"); }
        if constexpr (ALIGN_EPI) { if (wr == 0) PG8_BAR; }
        { int ln_; asm volatile("v_mbcnt_lo_u32_b32 %0, -1, 0\n\tv_mbcnt_hi_u32_b32 %0, -1, %0" : "=v"(ln_));
          E(acc, cur, wr, wc, ln_ & 15, ln_ >> 4); }
        if (!has_next) break;
        if (cur.zero_after) {
#pragma unroll
            for (int a = 0; a < 2; ++a)
#pragma unroll
                for (int b = 0; b < 2; ++b)
#pragma unroll
                    for (int m = 0; m < 4; ++m)
#pragma unroll
                        for (int n = 0; n < 2; ++n) acc[a][b][m][n] = (f32x4){0.f, 0.f, 0.f, 0.f};
        }
        cur = nxt; cA = nA; cB = nB; ++ui;
        if (GATHER) {
#pragma unroll
            for (int _h = 0; _h < 2; ++_h)
#pragma unroll
                for (int _i = 0; _i < 2; ++_i) cOA[_h][_i] = nOA[_h][_i]; }
        if constexpr (ALIGN_EPI) { if (wr == 1) PG8_BAR; }
    }
    PG8_WAIT_V(0);
    if constexpr (!ALIGN_EPI) { if (wr == 0) PG8_BAR; }
    PG8_BAR;
#undef PG8_SA
#undef PG8_SB
#undef PG8_STAGE_A
#undef PG8_STAGE_B
#undef PG8_LDA
#undef PG8_LDB
#undef PG8_MMA
#undef PG8_WAIT_V
#undef PG8_WAIT_L
#undef PG8_BAR
#undef PG8_SCHED
#undef PG8_AOFFS
}
}
#include <hip/hip_bf16.h>
namespace attn_body {
using hbf16=__hip_bfloat16;
using bf16x8=__attribute__((ext_vector_type(8)))short;
using s16x4=__attribute__((ext_vector_type(4)))short;
using f32x16=__attribute__((ext_vector_type(16)))float;
using u32x4=__attribute__((ext_vector_type(4)))unsigned;
constexpr int SEQ=2048,D=64,DM=3584;
constexpr int NW=8,QBLK=32,QB=QBLK*NW,KVBLK=64,NQB=SEQ/QB;
__device__ __forceinline__ int crow(int r,int hi){return (r&3)+8*(r>>2)+4*hi;}
#define SBAR() __builtin_amdgcn_sched_barrier(0)
__device__ __forceinline__ void cmask(f32x16&p0,f32x16&p1,int jb,int qrel,int hi){
  const float NEG=-INFINITY; int kb=64*jb+4*hi;
  #pragma unroll
  for(int r=0;r<16;++r){int kv=kb+(r&3)+8*(r>>2); if(kv>qrel)p0[r]=NEG; if(kv+32>qrel)p1[r]=NEG;}
}

constexpr int NSLOT=3, SLOTB=8192;
constexpr int LDS_K=0, LDS_V=NSLOT*SLOTB, LDS_WS=2*NSLOT*SLOTB, LDS_OST=LDS_WS+NW*64*4, LDS_BIAS=LDS_OST+NW*4096, LDS_SSQ=LDS_BIAS+SEQ*4, LDS_BYTES=LDS_SSQ+NW*32*4;
constexpr float C2=0.125f*1.4426950408889634f;
__device__ __forceinline__ void glds16(const void*gsrc,unsigned lds_dst){unsigned keep;
  asm volatile("s_mov_b32 %0, m0\n\ts_mov_b32 m0, %2\n\ts_nop 0\n\tglobal_load_lds_dwordx4 %1, off\n\ts_mov_b32 m0, %0":"=&s"(keep):"v"(gsrc),"s"(lds_dst):"memory");}
__device__ __forceinline__ float max3f(float a,float b,float c){float r;asm("v_max3_f32 %0, %1, %2, %3":"=v"(r):"v"(a),"v"(b),"v"(c));return r;}
__device__ __forceinline__ float max2f(float a,float b){float r;asm("v_max_f32_e32 %0, %1, %2":"=v"(r):"v"(a),"v"(b));return r;}
__device__ __forceinline__ float fadd_s(float a,float b){float r;asm("v_add_f32_e32 %0, %1, %2":"=v"(r):"v"(a),"v"(b));return r;}
__device__ __forceinline__ float fsub_s(float a,float b){float r;asm("v_sub_f32_e32 %0, %1, %2":"=v"(r):"v"(a),"v"(b));return r;}
typedef float f32x2_t __attribute__((ext_vector_type(2))); typedef float f32x4_t __attribute__((ext_vector_type(4))); typedef __bf16 bf16x2_t __attribute__((ext_vector_type(2)));
__device__ __forceinline__ unsigned cvtpk_s(float lo,float hi){f32x2_t v={lo,hi};bf16x2_t b=__builtin_convertvector(v,bf16x2_t);return __builtin_bit_cast(unsigned,b);}
#define WAIT_BAR(N) asm volatile("s_waitcnt vmcnt(" #N ") lgkmcnt(0)\n\ts_barrier":::"memory")

__device__ __forceinline__ void qkt(f32x16&p0,f32x16&p1,const char*Kslot,const bf16x8*qr,const f32x16&negm,int r32,int hi){
  const char*kb=Kslot+hi*1024+r32*16;
  #pragma unroll
  for(int d0=0;d0<4;++d0){
    const bf16x8 b0=*reinterpret_cast<const bf16x8*>(kb+d0*2048);
    const bf16x8 b1=*reinterpret_cast<const bf16x8*>(kb+d0*2048+512);
    if(d0==0){p0=__builtin_amdgcn_mfma_f32_32x32x16_bf16(b0,qr[0],negm,0,0,0);p1=__builtin_amdgcn_mfma_f32_32x32x16_bf16(b1,qr[0],negm,0,0,0);}
    else{p0=__builtin_amdgcn_mfma_f32_32x32x16_bf16(b0,qr[d0],p0,0,0,0);p1=__builtin_amdgcn_mfma_f32_32x32x16_bf16(b1,qr[d0],p1,0,0,0);}}
}
typedef __attribute__((address_space(3))) const char* lds_cptr;
typedef short v4i16_t __attribute__((ext_vector_type(4)));
__device__ __forceinline__ void kload8(bf16x8*kf,lds_cptr kp){
  kf[0]=*(const __attribute__((address_space(3))) bf16x8*)(kp);      kf[1]=*(const __attribute__((address_space(3))) bf16x8*)(kp+512);
  kf[2]=*(const __attribute__((address_space(3))) bf16x8*)(kp+2048); kf[3]=*(const __attribute__((address_space(3))) bf16x8*)(kp+2560);
  kf[4]=*(const __attribute__((address_space(3))) bf16x8*)(kp+4096); kf[5]=*(const __attribute__((address_space(3))) bf16x8*)(kp+4608);
  kf[6]=*(const __attribute__((address_space(3))) bf16x8*)(kp+6144); kf[7]=*(const __attribute__((address_space(3))) bf16x8*)(kp+6656);
}
__device__ __forceinline__ void kload2(bf16x8*kf,lds_cptr kp,int j){ kf[2*j]=*(const __attribute__((address_space(3))) bf16x8*)(kp+j*2048); kf[2*j+1]=*(const __attribute__((address_space(3))) bf16x8*)(kp+j*2048+512); }
__device__ __forceinline__ s16x4 vtr(lds_cptr p){ return __builtin_bit_cast(s16x4,__builtin_amdgcn_ds_read_tr16_b64_v4i16((__attribute__((address_space(3))) v4i16_t*)p)); }
__device__ __forceinline__ float rowmax(const f32x16&p0,const f32x16&p1){
  float a=max3f(p0[0],p0[1],p1[0]),b=max3f(p0[2],p0[3],p1[1]);a=max3f(a,p1[2],p1[3]);
  #pragma unroll
  for(int r=4;r<16;r+=4){a=max3f(a,p0[r],p0[r+1]);b=max3f(b,p0[r+2],p0[r+3]);a=max3f(a,p1[r],p1[r+1]);b=max3f(b,p1[r+2],p1[r+3]);}
  const float m=max2f(a,b);
  auto rr=__builtin_amdgcn_permlane32_swap(__float_as_uint(m),__float_as_uint(m),false,false);
  return max2f(__uint_as_float(rr[0]),__uint_as_float(rr[1]));
}
__device__ __forceinline__ void pv(f32x16*o,int vb,bf16x8 pa0,bf16x8 pa1,bf16x8 pa2,bf16x8 pa3){
  #pragma unroll
  for(int d0=0;d0<2;++d0){s16x4 lo[4],hi[4];
    #pragma unroll
    for(int ks=0;ks<4;++ks){
      asm volatile("ds_read_b64_tr_b16 %0,%1 offset:%c2":"=&v"(lo[ks]):"v"(vb),"i"(d0*4096+ks*1024):"memory");
      asm volatile("ds_read_b64_tr_b16 %0,%1 offset:%c2":"=&v"(hi[ks]):"v"(vb),"i"(d0*4096+ks*1024+512):"memory");}
    asm volatile("s_waitcnt lgkmcnt(0)":::"memory");SBAR();
    #define PK(k) (bf16x8){lo[k][0],lo[k][1],lo[k][2],lo[k][3],hi[k][0],hi[k][1],hi[k][2],hi[k][3]}
    o[d0]=__builtin_amdgcn_mfma_f32_32x32x16_bf16(pa0,PK(0),o[d0],0,0,0);
    o[d0]=__builtin_amdgcn_mfma_f32_32x32x16_bf16(pa1,PK(1),o[d0],0,0,0);
    o[d0]=__builtin_amdgcn_mfma_f32_32x32x16_bf16(pa2,PK(2),o[d0],0,0,0);
    o[d0]=__builtin_amdgcn_mfma_f32_32x32x16_bf16(pa3,PK(3),o[d0],0,0,0);
    #undef PK
  }
}

#ifndef ATTN_STORE16
#define ATTN_STORE16(p,v) (*(u32x4*)(p)=(v))
#endif
struct AttnP { const bf16* Q; const bf16* K; const bf16* V; bf16* out; bf16* stash; const float* gsub; const float* logf; int opitch; float lam, nscale; };
template<int THRL,bool FOX> __device__ __forceinline__ void attn_unit(const int tid_in,int b,int qb,const int MODE,const AttnP&P,char*shm){
  int tid=tid_in; asm volatile("":"+v"(tid));
  const int lane=tid&63,r32=lane&31,hi=lane>>5; const int wid=__builtin_amdgcn_readfirstlane(tid>>6);
  const long rowbase=(long)b*SEQ; const int q0=qb*QB;
  const bf16*Qw=P.Q+(rowbase+q0+wid*QBLK)*DM;
  const bf16*Kh=P.K+rowbase*DM,*Vh=P.V+rowbase*DM;
  const unsigned lds0=(unsigned)(uintptr_t)shm;
  float*wsf=(float*)(shm+LDS_WS)+wid*64;
  const float*biasL=(const float*)(shm+LDS_BIAS);
  #define BIAS(P0,P1,t) do{ if(FOX){ const float*bb_=biasL+64*(t)+4*hi; _Pragma("unroll") for(int g_=0;g_<4;++g_){ const f32x4_t b0_=*(const f32x4_t*)(bb_+8*g_), b1_=*(const f32x4_t*)(bb_+32+8*g_); \
      _Pragma("unroll") for(int e_=0;e_<4;++e_){ P0[4*g_+e_]+=b0_[e_]; P1[4*g_+e_]+=b1_[e_]; } asm volatile("":::"memory"); } } }while(0)
  const bf16*ksrc=Kh+(long)lane*DM+wid*8;
  const bf16*vsrc=Vh+(long)(16*(wid&3)+(lane>>2))*DM+(wid>>2)*32+(lane&3)*8;
  const unsigned kdst=lds0+LDS_K+wid*1024, vdst=lds0+LDS_V+wid*1024;
  #define DMA_K(t,slot) glds16(ksrc+(long)(t)*KVBLK*DM,(unsigned)__builtin_amdgcn_readfirstlane(kdst+(slot)))
  #define DMA_V(t,slot) glds16(vsrc+(long)(t)*KVBLK*DM,(unsigned)__builtin_amdgcn_readfirstlane(vdst+(slot)))
  const int vb0=(int)(lds0+LDS_V)+((lane>>4)&1)*32+(lane&3)*8+(4*hi+((lane&15)>>2))*64;
  const char*Kbase=shm+LDS_K; bf16x8 kf[8];
  const lds_cptr shm3=(lds_cptr)shm; const lds_cptr kp0=shm3+LDS_K+hi*1024+r32*16; const lds_cptr vp0=shm3+LDS_V+((lane>>4)&1)*32+(lane&3)*8+(4*hi+((lane&15)>>2))*64;
  const int NT=(q0+QB)/KVBLK;
  DMA_K(0,0);DMA_V(0,0);DMA_K(1,SLOTB);
  bf16x8 qr[4];
  #pragma unroll
  for(int d0=0;d0<4;++d0)qr[d0]=*reinterpret_cast<const bf16x8*>(&Qw[(long)r32*DM+d0*16+hi*8]);
  float mhat=0.f,l_reg=0.f;f32x16 o[2];o[0]=f32x16{};o[1]=f32x16{};f32x16 negm=f32x16{};asm volatile("":"+v"(negm));
  const int qrel=wid*QBLK+r32;
  #define CMASK(P0,P1,t) do{int jb_=(t)-(NT-4); if(jb_>=0)cmask(P0,P1,jb_,qrel,hi);}while(0)
  bool resc=false;
  #define START(P0,P1) do{ const float rm=rowmax(P0,P1); resc=false; \
    { const float dl=rm; mhat=fadd_s(mhat,dl); \
      _Pragma("unroll") for(int r=0;r<16;++r){P0[r]=fsub_s(P0[r],dl);P1[r]=fsub_s(P1[r],dl);} \
      _Pragma("unroll") for(int r=0;r<16;++r)negm[r]=-mhat; asm volatile("":"+v"(negm)); } \
    _Pragma("unroll") for(int r=0;r<16;++r)P0[r]=__builtin_amdgcn_exp2f(P0[r]); }while(0)
  #define RESC() do{ if(resc){ asm volatile("s_waitcnt lgkmcnt(0)":::"memory"); \
      _Pragma("unroll") for(int d_=0;d_<2;++d_) _Pragma("unroll") for(int r=0;r<16;++r)o[d_][r]*=wsf[crow(r,hi)]; } }while(0)
  f32x16 pA0,pA1,pB0,pB1;
  int sl_prev=0,sl_cur=0,sl_next=SLOTB;
  #define ROT() do{sl_prev=sl_cur;sl_cur=sl_next;sl_next=(sl_next==(NSLOT-1)*SLOTB)?0:sl_next+SLOTB;}while(0)
  DMA_K(2,2*SLOTB);
  if(FOX){
    const int n=q0+QB; float v4[4]; float run=0.f;
    _Pragma("unroll") for(int i=0;i<4;++i){ const int sidx=4*tid+i; const float lv=(sidx<n)?P.logf[(rowbase+sidx)*8]:0.f; run+=lv; v4[i]=run; }
    float inc=run; _Pragma("unroll") for(int o_=1;o_<64;o_<<=1){ const float up=__int_as_float(__builtin_amdgcn_ds_bpermute((lane-o_)<<2,__float_as_int(inc))); if(lane>=o_)inc+=up; }
    float*wt=(float*)(shm+LDS_WS); if(lane==63)wt[wid]=inc; __syncthreads();
    float pre=inc-run; _Pragma("unroll") for(int w_=0;w_<NW;++w_){ if(w_<wid)pre+=wt[w_]; }
    float*bw=(float*)(shm+LDS_BIAS); _Pragma("unroll") for(int i=0;i<4;++i){ const int sidx=4*tid+i; if(sidx<n)bw[sidx]=-(pre+v4[i])*1.4426950408889634f; }
    __syncthreads(); }
  WAIT_BAR(3);
  qkt(pA0,pA1,Kbase,qr,negm,r32,hi);asm volatile("s_nop 15\n\ts_nop 7":"+v"(pA0),"+v"(pA1));BIAS(pA0,pA1,0);CMASK(pA0,pA1,0);
  START(pA0,pA1);
  _Pragma("unroll") for(int r=0;r<16;++r)pA1[r]=__builtin_amdgcn_exp2f(pA1[r]);
  WAIT_BAR(0);
  DMA_K(3,0);DMA_V(1,SLOTB);
  ROT();
  kload8(kf,kp0+sl_cur);
  WAIT_BAR(2);
  s16x4 vlo[8],vhi[8]; u32x4 pw0,pw1,pw2,pw3;
  #define PKW(P,B) cvtpk_s(P[B],P[B+1])
  #define PAF(k) __builtin_bit_cast(bf16x8,pw##k)
  #define VFR(i) (bf16x8){vlo[i][0],vlo[i][1],vlo[i][2],vlo[i][3],vhi[i][0],vhi[i][1],vhi[i][2],vhi[i][3]}
  #define PIN(x) asm volatile("":"+v"(x))
  #define MX3(a,b,c) __builtin_fmaxf(__builtin_fmaxf((a),(b)),(c))
  #define GAPA(MF,A0,A1,A2,A3,W0,W1,PW) do{ MF; sacc+=A0; sacc+=A1; sacc+=A2; sacc+=A3; PIN(sacc); W0; W1; PIN(PW); SBAR(); }while(0)
  #define EX(v) __builtin_amdgcn_exp2f(v)
  #define GAPB(MF,X,B) do{ MF; X[B]=EX(X[B]); X[B+1]=EX(X[B+1]); X[B+2]=EX(X[B+2]); X[B+3]=EX(X[B+3]); PIN(X); SBAR(); }while(0)
  #define VRD(i) do{ vlo[i]=vtr(vp_+(((i)>>2)*4096+((i)&3)*1024)); vhi[i]=vtr(vp_+(((i)>>2)*4096+((i)&3)*1024+512)); }while(0)
  #define KRD(G,j) do{ if(G){ kload2(kf,kp0+sl_next,j); SBAR(); } }while(0)
  #define STEP(C0,C1,P0,P1,t,GK,GV,GL) do{ SBAR(); \
    const lds_cptr vp_=vp0+sl_prev; \
    VRD(0); SBAR(); float sacc=(P0[0]+P0[1]); \
    GAPA(C0=__builtin_amdgcn_mfma_f32_32x32x16_bf16(kf[0],qr[0],negm,0,0,0), P0[2],P0[3],P0[4],P0[5],     pw0[0]=PKW(P0,0), pw0[1]=PKW(P0,2), pw0); \
    VRD(4); SBAR(); GAPA(C1=__builtin_amdgcn_mfma_f32_32x32x16_bf16(kf[1],qr[0],negm,0,0,0), P0[6],P0[7],P0[8],P0[9],     pw0[2]=PKW(P0,4), pw0[3]=PKW(P0,6), pw0); \
    VRD(1); SBAR(); GAPA(C0=__builtin_amdgcn_mfma_f32_32x32x16_bf16(kf[2],qr[1],C0,0,0,0),   P0[10],P0[11],P0[12],P0[13], pw1[0]=PKW(P0,8), pw1[1]=PKW(P0,10), pw1); \
    VRD(5); SBAR(); GAPA(C1=__builtin_amdgcn_mfma_f32_32x32x16_bf16(kf[3],qr[1],C1,0,0,0),   P0[14],P0[15],P1[0],P1[1],   pw1[2]=PKW(P0,12),pw1[3]=PKW(P0,14), pw1); \
    VRD(2); SBAR(); GAPA(C0=__builtin_amdgcn_mfma_f32_32x32x16_bf16(kf[4],qr[2],C0,0,0,0),   P1[2],P1[3],P1[4],P1[5],     pw2[0]=PKW(P1,0), pw2[1]=PKW(P1,2), pw2); \
    VRD(6); SBAR(); GAPA(C1=__builtin_amdgcn_mfma_f32_32x32x16_bf16(kf[5],qr[2],C1,0,0,0),   P1[6],P1[7],P1[8],P1[9],     pw2[2]=PKW(P1,4), pw2[3]=PKW(P1,6), pw2); \
    VRD(3); SBAR(); GAPA(C0=__builtin_amdgcn_mfma_f32_32x32x16_bf16(kf[6],qr[3],C0,0,0,0),   P1[10],P1[11],P1[12],P1[13], pw3[0]=PKW(P1,8), pw3[1]=PKW(P1,10), pw3); \
    VRD(7); SBAR(); GAPA(C1=__builtin_amdgcn_mfma_f32_32x32x16_bf16(kf[7],qr[3],C1,0,0,0),   P1[14],P1[15],0.f,0.f,       pw3[2]=PKW(P1,12),pw3[3]=PKW(P1,14), pw3); \
    l_reg+=sacc; \
    if(GK){DMA_K((t)+3,sl_cur);} if(GV){DMA_V((t)+1,sl_next);} \
    BIAS(C0,C1,t); CMASK(C0,C1,t); \
    { float a=MX3(C0[0],C0[1],C1[0]),b=MX3(C0[2],C0[3],C1[1]); a=MX3(a,C1[2],C1[3]); \
      _Pragma("unroll") for(int r=4;r<16;r+=4){a=MX3(a,C0[r],C0[r+1]);b=MX3(b,C0[r+2],C0[r+3]);a=MX3(a,C1[r],C1[r+1]);b=MX3(b,C1[r+2],C1[r+3]);} \
      float rm=__builtin_fmaxf(a,b); { auto rr=__builtin_amdgcn_permlane32_swap(__float_as_uint(rm),__float_as_uint(rm),false,false); rm=__builtin_fmaxf(__uint_as_float(rr[0]),__uint_as_float(rr[1])); } \
      resc=false; \
      if(__builtin_expect(__any(rm>(float)THRL),0)){ const float dl=__builtin_fmaxf(rm,0.f); mhat+=dl; \
        _Pragma("unroll") for(int r=0;r<16;++r){C0[r]-=dl;C1[r]-=dl;} \
        _Pragma("unroll") for(int r=0;r<16;++r)negm[r]=-mhat; asm volatile("":"+v"(negm)); \
        const float f=__builtin_amdgcn_exp2f(-dl); l_reg*=f; if(hi==0)wsf[r32]=f; resc=true; } } \
    SBAR(); \
    GAPB(o[0]=__builtin_amdgcn_mfma_f32_32x32x16_bf16(PAF(0),VFR(0),o[0],0,0,0), C0,0); \
    GAPB(o[1]=__builtin_amdgcn_mfma_f32_32x32x16_bf16(PAF(0),VFR(4),o[1],0,0,0), C0,4); \
    KRD(GL,0); GAPB(o[0]=__builtin_amdgcn_mfma_f32_32x32x16_bf16(PAF(1),VFR(1),o[0],0,0,0), C0,8); \
    KRD(GL,1); GAPB(o[1]=__builtin_amdgcn_mfma_f32_32x32x16_bf16(PAF(1),VFR(5),o[1],0,0,0), C0,12); \
    KRD(GL,2); GAPB(o[0]=__builtin_amdgcn_mfma_f32_32x32x16_bf16(PAF(2),VFR(2),o[0],0,0,0), C1,0); \
    KRD(GL,3); GAPB(o[1]=__builtin_amdgcn_mfma_f32_32x32x16_bf16(PAF(2),VFR(6),o[1],0,0,0), C1,4); \
    GAPB(o[0]=__builtin_amdgcn_mfma_f32_32x32x16_bf16(PAF(3),VFR(3),o[0],0,0,0), C1,8); \
    GAPB(o[1]=__builtin_amdgcn_mfma_f32_32x32x16_bf16(PAF(3),VFR(7),o[1],0,0,0), C1,12); \
    }while(0)
  int t=1;
  #undef CMASK
  #define CMASK(P0,P1,t) do{}while(0)
  for(;t+5<NT;t+=2){
    STEP(pB0,pB1,pA0,pA1,t,true,true,true);     WAIT_BAR(2); RESC(); ROT();
    STEP(pA0,pA1,pB0,pB1,t+1,true,true,true);   WAIT_BAR(2); RESC(); ROT();
  }
  #undef CMASK
  #define CMASK(P0,P1,t) do{int jb_=(t)-(NT-4); if(jb_>=0)cmask(P0,P1,jb_,qrel,hi);}while(0)
  #define ENDW(tt) do{ if((tt)+3<NT){WAIT_BAR(2);} else if((tt)+2<NT){WAIT_BAR(1);} else {WAIT_BAR(0);} }while(0)
  for(;t+1<NT;t+=2){
    STEP(pB0,pB1,pA0,pA1,t,(t+3<NT),(t+1<NT),(t+1<NT));       ENDW(t);   RESC(); ROT();
    STEP(pA0,pA1,pB0,pB1,t+1,(t+4<NT),(t+2<NT),(t+2<NT));     ENDW(t+1); RESC(); ROT();
  }
  STEP(pB0,pB1,pA0,pA1,NT-1,false,false,false); RESC();
  { float sacc=pB0[0]+pB0[1]; _Pragma("unroll") for(int r=2;r<16;++r)sacc+=pB0[r]; _Pragma("unroll") for(int r=0;r<16;++r)sacc+=pB1[r]; l_reg+=sacc;
    pw0=(u32x4){PKW(pB0,0),PKW(pB0,2),PKW(pB0,4),PKW(pB0,6)};pw1=(u32x4){PKW(pB0,8),PKW(pB0,10),PKW(pB0,12),PKW(pB0,14)};pw2=(u32x4){PKW(pB1,0),PKW(pB1,2),PKW(pB1,4),PKW(pB1,6)};pw3=(u32x4){PKW(pB1,8),PKW(pB1,10),PKW(pB1,12),PKW(pB1,14)};
    SBAR(); pv(o,vb0+sl_cur,PAF(0),PAF(1),PAF(2),PAF(3)); }
  #undef PKW
  #undef PAF
  #undef VFR
  #undef PIN
  #undef MX3
  #undef GAPA
  #undef GAPB
  #undef EX
  #undef VRD
  #undef KRD
  #undef STEP
  #undef ENDW
  {auto rr=__builtin_amdgcn_permlane32_swap(__float_as_uint(l_reg),__float_as_uint(l_reg),false,false);l_reg=__uint_as_float(rr[0])+__uint_as_float(rr[1]);}
  if(hi==0)wsf[32+r32]=l_reg;asm volatile("s_waitcnt lgkmcnt(0)":::"memory");
  float rli[16];
  #pragma unroll
  for(int r=0;r<16;++r)rli[r]=__builtin_amdgcn_rcpf(wsf[32+crow(r,hi)]);
  { hbf16*stg=(hbf16*)(shm+LDS_OST)+wid*2048;
    #pragma unroll
    for(int r=0;r<16;++r){const int orow=crow(r,hi);
      #pragma unroll
      for(int d0=0;d0<2;++d0)stg[orow*64+d0*32+r32]=__float2bfloat16(o[d0][r]*rli[r]);}
    asm volatile("s_waitcnt lgkmcnt(0)":::"memory");
    const long grow=rowbase+q0+wid*QBLK; float*ssq=(float*)(shm+LDS_SSQ)+wid*32;
    int lane_e=lane; asm volatile("":"+v"(lane_e));
    #pragma unroll
    for(int i=0;i<4;++i){const int row=i*8+(lane_e>>3),ch=lane_e&7; const u32x4 v=*(const u32x4*)(stg+row*64+ch*8);
      if(MODE==0){ *(u32x4*)(P.out+(grow+row)*(long)P.opitch+ch*8)=v; }
      else { bf16*sp=P.stash+(grow+row)*512+ch*8+(MODE==2?64:0); const u32x4 a=*(const u32x4*)sp; float of[8]; float ss=0.f;
        #pragma unroll
        for(int j=0;j<4;++j){ const float a0=__uint_as_float(a[j]<<16),a1=__uint_as_float(a[j]&0xffff0000u),c0=__uint_as_float(v[j]<<16),c1=__uint_as_float(v[j]&0xffff0000u);
          of[2*j]=a0-P.lam*c0; of[2*j+1]=a1-P.lam*c1; ss+=of[2*j]*of[2*j]+of[2*j+1]*of[2*j+1]; }
        ss+=__int_as_float(__builtin_amdgcn_ds_swizzle(__float_as_int(ss),0x041f)); ss+=__int_as_float(__builtin_amdgcn_ds_swizzle(__float_as_int(ss),0x081f)); ss+=__int_as_float(__builtin_amdgcn_ds_swizzle(__float_as_int(ss),0x101f));
        if(MODE==1){ if(ch==0)ssq[row]=ss; u32x4 w; _Pragma("unroll") for(int j=0;j<4;++j)w[j]=cvtpk_s(of[2*j],of[2*j+1]); *(u32x4*)sp=w; }
        else { const float rr_=rsqrtf((ss+ssq[row])*(1.0f/128.0f)+1e-6f)*P.nscale; bf16*yp=P.out+(grow+row)*(long)P.opitch+ch*8;
          const f32x4_t g0=*(const f32x4_t*)(P.gsub+64+ch*8), g1=*(const f32x4_t*)(P.gsub+64+ch*8+4), h0=*(const f32x4_t*)(P.gsub+ch*8), h1=*(const f32x4_t*)(P.gsub+ch*8+4);
          u32x4 w; w[0]=cvtpk_s(of[0]*rr_*g0[0],of[1]*rr_*g0[1]); w[1]=cvtpk_s(of[2]*rr_*g0[2],of[3]*rr_*g0[3]); w[2]=cvtpk_s(of[4]*rr_*g1[0],of[5]*rr_*g1[1]); w[3]=cvtpk_s(of[6]*rr_*g1[2],of[7]*rr_*g1[3]);
          *(u32x4*)(yp+64)=w;
          const u32x4 lo=*(const u32x4*)(sp-64); float lf[8];
          #pragma unroll
          for(int j=0;j<4;++j){ lf[2*j]=__uint_as_float(lo[j]<<16); lf[2*j+1]=__uint_as_float(lo[j]&0xffff0000u); }
          w[0]=cvtpk_s(lf[0]*rr_*h0[0],lf[1]*rr_*h0[1]); w[1]=cvtpk_s(lf[2]*rr_*h0[2],lf[3]*rr_*h0[3]); w[2]=cvtpk_s(lf[4]*rr_*h1[0],lf[5]*rr_*h1[1]); w[3]=cvtpk_s(lf[6]*rr_*h1[2],lf[7]*rr_*h1[3]);
          *(u32x4*)yp=w; } } } }
  asm volatile("s_waitcnt lgkmcnt(0)\n\ts_barrier":::"memory");
  #undef DMA_K
  #undef BIAS
  #undef DMA_V
  #undef CMASK
  #undef START
  #undef RESC
  #undef ROT
}
__device__ __forceinline__ void pv128(f32x16*o,int vb,bf16x8 pa0,bf16x8 pa1,bf16x8 pa2,bf16x8 pa3){
  #pragma unroll
  for(int d0=0;d0<4;++d0){s16x4 lo[4],hi[4];
    #pragma unroll
    for(int ks=0;ks<4;++ks){
      asm volatile("ds_read_b64_tr_b16 %0,%1 offset:%c2":"=&v"(lo[ks]):"v"(vb),"i"(d0*4096+ks*1024):"memory");
      asm volatile("ds_read_b64_tr_b16 %0,%1 offset:%c2":"=&v"(hi[ks]):"v"(vb),"i"(d0*4096+ks*1024+512):"memory");}
    asm volatile("s_waitcnt lgkmcnt(0)":::"memory");SBAR();
    #define PK(k) (bf16x8){lo[k][0],lo[k][1],lo[k][2],lo[k][3],hi[k][0],hi[k][1],hi[k][2],hi[k][3]}
    o[d0]=__builtin_amdgcn_mfma_f32_32x32x16_bf16(pa0,PK(0),o[d0],0,0,0);
    o[d0]=__builtin_amdgcn_mfma_f32_32x32x16_bf16(pa1,PK(1),o[d0],0,0,0);
    o[d0]=__builtin_amdgcn_mfma_f32_32x32x16_bf16(pa2,PK(2),o[d0],0,0,0);
    o[d0]=__builtin_amdgcn_mfma_f32_32x32x16_bf16(pa3,PK(3),o[d0],0,0,0);
    #undef PK
  }
}
template<int THRL> __device__ __forceinline__ void attn_unit128(const int tid_in,int b,int qb,const int MODE,const AttnP&P,char*shm){
  constexpr bool FOX=false; constexpr int LDS_V=24576, LDS_WS=73728, LDS_OST=75776, SLOTV=16384;
  int tid=tid_in; asm volatile("":"+v"(tid));
  const int lane=tid&63,r32=lane&31,hi=lane>>5; const int wid=__builtin_amdgcn_readfirstlane(tid>>6);
  const long rowbase=(long)b*SEQ; const int q0=qb*QB;
  const bf16*Qw=P.Q+(rowbase+q0+wid*QBLK)*DM;
  const bf16*Kh=P.K+rowbase*DM,*Vh=P.V+rowbase*DM;
  const unsigned lds0=(unsigned)(uintptr_t)shm;
  float*wsf=(float*)(shm+LDS_WS)+wid*64;
  const float*biasL=(const float*)(shm+LDS_BIAS);
  #define BIAS(P0,P1,t) do{ if(FOX){ const float*bb_=biasL+64*(t)+4*hi; _Pragma("unroll") for(int g_=0;g_<4;++g_){ const f32x4_t b0_=*(const f32x4_t*)(bb_+8*g_), b1_=*(const f32x4_t*)(bb_+32+8*g_); \
      _Pragma("unroll") for(int e_=0;e_<4;++e_){ P0[4*g_+e_]+=b0_[e_]; P1[4*g_+e_]+=b1_[e_]; } asm volatile("":::"memory"); } } }while(0)
  const bf16*ksrc=Kh+(long)lane*DM+wid*8;
  const bf16*vsrc=Vh+(long)(16*(wid&3)+(lane>>2))*DM+(wid>>2)*32+(lane&3)*8;
  const unsigned kdst=lds0+LDS_K+wid*1024, vdst=lds0+LDS_V+wid*1024;
  #define DMA_K(t,slot) glds16(ksrc+(long)(t)*KVBLK*DM,(unsigned)__builtin_amdgcn_readfirstlane(kdst+(slot)))
  #define DMA_V(t,slot) do{ glds16(vsrc+(long)(t)*KVBLK*DM,(unsigned)__builtin_amdgcn_readfirstlane(vdst+2*(slot))); glds16(vsrc+(long)(t)*KVBLK*DM+64,(unsigned)__builtin_amdgcn_readfirstlane(vdst+2*(slot)+8192)); }while(0)
  const int vb0=(int)(lds0+LDS_V)+((lane>>4)&1)*32+(lane&3)*8+(4*hi+((lane&15)>>2))*64;
  const char*Kbase=shm+LDS_K; bf16x8 kf[8];
  const lds_cptr shm3=(lds_cptr)shm; const lds_cptr kp0=shm3+LDS_K+hi*1024+r32*16; const lds_cptr vp0=shm3+LDS_V+((lane>>4)&1)*32+(lane&3)*8+(4*hi+((lane&15)>>2))*64;
  const int NT=(q0+QB)/KVBLK;
  DMA_K(0,0);DMA_V(0,0);DMA_K(1,SLOTB);
  bf16x8 qr[4];
  #pragma unroll
  for(int d0=0;d0<4;++d0)qr[d0]=*reinterpret_cast<const bf16x8*>(&Qw[(long)r32*DM+d0*16+hi*8]);
  float mhat=0.f,l_reg=0.f;f32x16 o[4];o[0]=f32x16{};o[1]=f32x16{};o[2]=f32x16{};o[3]=f32x16{};const f32x16 zero16=f32x16{};
  const int qrel=wid*QBLK+r32;
  #define CMASK(P0,P1,t) do{int jb_=(t)-(NT-4); if(jb_>=0)cmask(P0,P1,jb_,qrel,hi);}while(0)
  bool resc=false;
  #define START(P0,P1) do{ const float rm=rowmax(P0,P1); resc=false; \
    { const float dl=rm; mhat=fadd_s(mhat,dl); \
      _Pragma("unroll") for(int r=0;r<16;++r){P0[r]=fsub_s(P0[r],dl);P1[r]=fsub_s(P1[r],dl);} \
      } \
    _Pragma("unroll") for(int r=0;r<16;++r)P0[r]=__builtin_amdgcn_exp2f(P0[r]); }while(0)
  #define RESC() do{ if(resc){ asm volatile("s_waitcnt lgkmcnt(0)":::"memory"); \
      _Pragma("unroll") for(int d_=0;d_<4;++d_) _Pragma("unroll") for(int r=0;r<16;++r)o[d_][r]*=wsf[crow(r,hi)]; } }while(0)
  f32x16 pA0,pA1,pB0,pB1;
  int sl_prev=0,sl_cur=0,sl_next=SLOTB;
  #define ROT() do{sl_prev=sl_cur;sl_cur=sl_next;sl_next=(sl_next==(NSLOT-1)*SLOTB)?0:sl_next+SLOTB;}while(0)
  DMA_K(2,2*SLOTB);
  WAIT_BAR(4);
  qkt(pA0,pA1,Kbase,qr,zero16,r32,hi);asm volatile("s_nop 15\n\ts_nop 7":"+v"(pA0),"+v"(pA1));BIAS(pA0,pA1,0);CMASK(pA0,pA1,0);
  START(pA0,pA1);
  _Pragma("unroll") for(int r=0;r<16;++r)pA1[r]=__builtin_amdgcn_exp2f(pA1[r]);
  WAIT_BAR(0);
  DMA_K(3,0);DMA_V(1,SLOTB);
  ROT();
  kload8(kf,kp0+sl_cur);
  WAIT_BAR(3);
  s16x4 va_lo,va_hi,vb_lo,vb_hi; u32x4 pw0,pw1,pw2,pw3;
  #define PKW(P,B) cvtpk_s(P[B],P[B+1])
  #define PAF(k) __builtin_bit_cast(bf16x8,pw##k)
  #define VFA (bf16x8){va_lo[0],va_lo[1],va_lo[2],va_lo[3],va_hi[0],va_hi[1],va_hi[2],va_hi[3]}
  #define VFB (bf16x8){vb_lo[0],vb_lo[1],vb_lo[2],vb_lo[3],vb_hi[0],vb_hi[1],vb_hi[2],vb_hi[3]}
  #define PIN(x) asm volatile("":"+v"(x))
  #define MX3(a,b,c) __builtin_fmaxf(__builtin_fmaxf((a),(b)),(c))
  #define GAPA(MF,A0,A1,A2,A3,W0,W1,PW) do{ MF; sacc+=A0; sacc+=A1; sacc+=A2; sacc+=A3; PIN(sacc); W0; W1; PIN(PW); SBAR(); }while(0)
  #define EX(v) __builtin_amdgcn_exp2f((v)-mhat)
  #define VRDA(d0,ks) do{ va_lo=vtr(vp_+((d0)*4096+(ks)*1024)); va_hi=vtr(vp_+((d0)*4096+(ks)*1024+512)); }while(0)
  #define VRDB(d0,ks) do{ vb_lo=vtr(vp_+((d0)*4096+(ks)*1024)); vb_hi=vtr(vp_+((d0)*4096+(ks)*1024+512)); }while(0)
  #define KRD(G,j) do{ if(G){ kload2(kf,kp0+sl_next,j); } }while(0)
  #define GAPB(MF,RD,X,B) do{ MF; RD; X[B]=EX(X[B]); X[B+1]=EX(X[B+1]); PIN(X); SBAR(); }while(0)
  #define STEP(C0,C1,P0,P1,t,GK,GV,GL) do{ SBAR(); \
    const lds_cptr vp_=vp0+2*sl_prev; \
    float sacc=(P0[0]+P0[1]); \
    GAPA(C0=__builtin_amdgcn_mfma_f32_32x32x16_bf16(kf[0],qr[0],zero16,0,0,0), P0[2],P0[3],P0[4],P0[5],     pw0[0]=PKW(P0,0), pw0[1]=PKW(P0,2), pw0); \
    GAPA(C1=__builtin_amdgcn_mfma_f32_32x32x16_bf16(kf[1],qr[0],zero16,0,0,0), P0[6],P0[7],P0[8],P0[9],     pw0[2]=PKW(P0,4), pw0[3]=PKW(P0,6), pw0); \
    GAPA(C0=__builtin_amdgcn_mfma_f32_32x32x16_bf16(kf[2],qr[1],C0,0,0,0),   P0[10],P0[11],P0[12],P0[13], pw1[0]=PKW(P0,8), pw1[1]=PKW(P0,10), pw1); \
    GAPA(C1=__builtin_amdgcn_mfma_f32_32x32x16_bf16(kf[3],qr[1],C1,0,0,0),   P0[14],P0[15],P1[0],P1[1],   pw1[2]=PKW(P0,12),pw1[3]=PKW(P0,14), pw1); \
    GAPA(C0=__builtin_amdgcn_mfma_f32_32x32x16_bf16(kf[4],qr[2],C0,0,0,0),   P1[2],P1[3],P1[4],P1[5],     pw2[0]=PKW(P1,0), pw2[1]=PKW(P1,2), pw2); \
    GAPA(C1=__builtin_amdgcn_mfma_f32_32x32x16_bf16(kf[5],qr[2],C1,0,0,0),   P1[6],P1[7],P1[8],P1[9],     pw2[2]=PKW(P1,4), pw2[3]=PKW(P1,6), pw2); \
    VRDA(0,0); SBAR(); \
    GAPA(C0=__builtin_amdgcn_mfma_f32_32x32x16_bf16(kf[6],qr[3],C0,0,0,0),   P1[10],P1[11],P1[12],P1[13], pw3[0]=PKW(P1,8), pw3[1]=PKW(P1,10), pw3); \
    GAPA(C1=__builtin_amdgcn_mfma_f32_32x32x16_bf16(kf[7],qr[3],C1,0,0,0),   P1[14],P1[15],0.f,0.f,       pw3[2]=PKW(P1,12),pw3[3]=PKW(P1,14), pw3); \
    l_reg+=sacc; \
    if(GK){DMA_K((t)+3,sl_cur);} if(GV){DMA_V((t)+1,sl_next);} \
    CMASK(C0,C1,t); \
    { float a=MX3(C0[0],C0[1],C1[0]),b=MX3(C0[2],C0[3],C1[1]); a=MX3(a,C1[2],C1[3]); \
      _Pragma("unroll") for(int r=4;r<16;r+=4){a=MX3(a,C0[r],C0[r+1]);b=MX3(b,C0[r+2],C0[r+3]);a=MX3(a,C1[r],C1[r+1]);b=MX3(b,C1[r+2],C1[r+3]);} \
      float rm=__builtin_fmaxf(a,b); { auto rr=__builtin_amdgcn_permlane32_swap(__float_as_uint(rm),__float_as_uint(rm),false,false); rm=__builtin_fmaxf(__uint_as_float(rr[0]),__uint_as_float(rr[1])); } \
      rm-=mhat; resc=false; \
      if(__builtin_expect(__any(rm>(float)THRL),0)){ const float dl=__builtin_fmaxf(rm,0.f); mhat+=dl; \
        const float f=__builtin_amdgcn_exp2f(-dl); l_reg*=f; if(hi==0)wsf[r32]=f; resc=true; } } \
    SBAR(); \
    GAPB(o[0]=__builtin_amdgcn_mfma_f32_32x32x16_bf16(PAF(0),VFA,o[0],0,0,0), VRDB(1,0), C0,0); \
    GAPB(o[1]=__builtin_amdgcn_mfma_f32_32x32x16_bf16(PAF(0),VFB,o[1],0,0,0), VRDA(2,0), C0,2); \
    GAPB(o[2]=__builtin_amdgcn_mfma_f32_32x32x16_bf16(PAF(0),VFA,o[2],0,0,0), VRDB(3,0), C0,4); \
    GAPB(o[3]=__builtin_amdgcn_mfma_f32_32x32x16_bf16(PAF(0),VFB,o[3],0,0,0), VRDA(0,1), C0,6); \
    KRD(GL,0); GAPB(o[0]=__builtin_amdgcn_mfma_f32_32x32x16_bf16(PAF(1),VFA,o[0],0,0,0), VRDB(1,1), C0,8); \
    GAPB(o[1]=__builtin_amdgcn_mfma_f32_32x32x16_bf16(PAF(1),VFB,o[1],0,0,0), VRDA(2,1), C0,10); \
    KRD(GL,1); GAPB(o[2]=__builtin_amdgcn_mfma_f32_32x32x16_bf16(PAF(1),VFA,o[2],0,0,0), VRDB(3,1), C0,12); \
    GAPB(o[3]=__builtin_amdgcn_mfma_f32_32x32x16_bf16(PAF(1),VFB,o[3],0,0,0), VRDA(0,2), C0,14); \
    KRD(GL,2); GAPB(o[0]=__builtin_amdgcn_mfma_f32_32x32x16_bf16(PAF(2),VFA,o[0],0,0,0), VRDB(1,2), C1,0); \
    GAPB(o[1]=__builtin_amdgcn_mfma_f32_32x32x16_bf16(PAF(2),VFB,o[1],0,0,0), VRDA(2,2), C1,2); \
    KRD(GL,3); GAPB(o[2]=__builtin_amdgcn_mfma_f32_32x32x16_bf16(PAF(2),VFA,o[2],0,0,0), VRDB(3,2), C1,4); \
    GAPB(o[3]=__builtin_amdgcn_mfma_f32_32x32x16_bf16(PAF(2),VFB,o[3],0,0,0), VRDA(0,3), C1,6); \
    GAPB(o[0]=__builtin_amdgcn_mfma_f32_32x32x16_bf16(PAF(3),VFA,o[0],0,0,0), VRDB(1,3), C1,8); \
    GAPB(o[1]=__builtin_amdgcn_mfma_f32_32x32x16_bf16(PAF(3),VFB,o[1],0,0,0), VRDA(2,3), C1,10); \
    GAPB(o[2]=__builtin_amdgcn_mfma_f32_32x32x16_bf16(PAF(3),VFA,o[2],0,0,0), VRDB(3,3), C1,12); \
    GAPB(o[3]=__builtin_amdgcn_mfma_f32_32x32x16_bf16(PAF(3),VFB,o[3],0,0,0), (void)0, C1,14); \
    }while(0)
  int t=1;
  #undef CMASK
  #define CMASK(P0,P1,t) do{}while(0)
  for(;t+5<NT;t+=2){
    STEP(pB0,pB1,pA0,pA1,t,true,true,true);     WAIT_BAR(3); RESC(); ROT();
    STEP(pA0,pA1,pB0,pB1,t+1,true,true,true);   WAIT_BAR(3); RESC(); ROT();
  }
  #undef CMASK
  #define CMASK(P0,P1,t) do{int jb_=(t)-(NT-4); if(jb_>=0)cmask(P0,P1,jb_,qrel,hi);}while(0)
  #define ENDW(tt) do{ if((tt)+3<NT){WAIT_BAR(3);} else if((tt)+2<NT){WAIT_BAR(2);} else {WAIT_BAR(0);} }while(0)
  for(;t+1<NT;t+=2){
    STEP(pB0,pB1,pA0,pA1,t,(t+3<NT),(t+1<NT),(t+1<NT));       ENDW(t);   RESC(); ROT();
    STEP(pA0,pA1,pB0,pB1,t+1,(t+4<NT),(t+2<NT),(t+2<NT));     ENDW(t+1); RESC(); ROT();
  }
  STEP(pB0,pB1,pA0,pA1,NT-1,false,false,false); RESC();
  { float sacc=pB0[0]+pB0[1]; _Pragma("unroll") for(int r=2;r<16;++r)sacc+=pB0[r]; _Pragma("unroll") for(int r=0;r<16;++r)sacc+=pB1[r]; l_reg+=sacc;
    pw0=(u32x4){PKW(pB0,0),PKW(pB0,2),PKW(pB0,4),PKW(pB0,6)};pw1=(u32x4){PKW(pB0,8),PKW(pB0,10),PKW(pB0,12),PKW(pB0,14)};pw2=(u32x4){PKW(pB1,0),PKW(pB1,2),PKW(pB1,4),PKW(pB1,6)};pw3=(u32x4){PKW(pB1,8),PKW(pB1,10),PKW(pB1,12),PKW(pB1,14)};
    SBAR(); pv128(o,vb0+2*sl_cur,PAF(0),PAF(1),PAF(2),PAF(3)); }
  #undef PKW
  #undef PAF
  #undef VFA
  #undef VFB
  #undef VRDA
  #undef VRDB
  #undef PIN
  #undef MX3
  #undef GAPA
  #undef GAPB
  #undef EX
  #undef KRD
  #undef STEP
  #undef ENDW
  {auto rr=__builtin_amdgcn_permlane32_swap(__float_as_uint(l_reg),__float_as_uint(l_reg),false,false);l_reg=__uint_as_float(rr[0])+__uint_as_float(rr[1]);}
  if(hi==0)wsf[32+r32]=l_reg;asm volatile("s_waitcnt lgkmcnt(0)":::"memory");
  float rli[16];
  #pragma unroll
  for(int r=0;r<16;++r)rli[r]=__builtin_amdgcn_rcpf(wsf[32+crow(r,hi)]);
  { hbf16*stg=(hbf16*)(shm+LDS_OST)+wid*2048;
    const long grow=rowbase+q0+wid*QBLK;
    int lane_e=lane; asm volatile("":"+v"(lane_e));
    float of[2][4][8]; float ssr[4]={0.f,0.f,0.f,0.f};
    u32x4 av[2][4];
    if(MODE!=0){
      #pragma unroll
      for(int hf=0;hf<2;++hf)
        #pragma unroll
        for(int i=0;i<4;++i){const int row=i*8+(lane_e>>3),ch=lane_e&7; av[hf][i]=*(const u32x4*)(P.stash+(grow+row)*512+hf*64+ch*8);} }
    #pragma unroll
    for(int hf=0;hf<2;++hf){
      #pragma unroll
      for(int r=0;r<16;++r){const int orow=crow(r,hi);
        #pragma unroll
        for(int d0=0;d0<2;++d0)stg[orow*64+d0*32+r32]=__float2bfloat16(o[2*hf+d0][r]*rli[r]);}
      asm volatile("s_waitcnt lgkmcnt(0)":::"memory");
      #pragma unroll
      for(int i=0;i<4;++i){const int row=i*8+(lane_e>>3),ch=lane_e&7; const u32x4 v=*(const u32x4*)(stg+row*64+ch*8);
        if(MODE==0){ *(u32x4*)(P.out+(grow+row)*(long)P.opitch+hf*64+ch*8)=v; }
        else { const u32x4 a=av[hf][i]; float ss=0.f;
          #pragma unroll
          for(int j=0;j<4;++j){ const float a0=__uint_as_float(a[j]<<16),a1=__uint_as_float(a[j]&0xffff0000u),c0=__uint_as_float(v[j]<<16),c1=__uint_as_float(v[j]&0xffff0000u);
            of[hf][i][2*j]=a0-P.lam*c0; of[hf][i][2*j+1]=a1-P.lam*c1; ss+=of[hf][i][2*j]*of[hf][i][2*j]+of[hf][i][2*j+1]*of[hf][i][2*j+1]; }
          ssr[i]+=ss; } }
      asm volatile("s_waitcnt lgkmcnt(0)":::"memory");
    }
    if(MODE!=0){
      f32x4_t gs[2][2];
      #pragma unroll
      for(int hf=0;hf<2;++hf){ gs[hf][0]=*(const f32x4_t*)(P.gsub+hf*64+(lane_e&7)*8); gs[hf][1]=*(const f32x4_t*)(P.gsub+hf*64+(lane_e&7)*8+4); }
      #pragma unroll
      for(int i=0;i<4;++i){const int row=i*8+(lane_e>>3),ch=lane_e&7; float ss=ssr[i];
        ss+=__int_as_float(__builtin_amdgcn_ds_swizzle(__float_as_int(ss),0x041f)); ss+=__int_as_float(__builtin_amdgcn_ds_swizzle(__float_as_int(ss),0x081f)); ss+=__int_as_float(__builtin_amdgcn_ds_swizzle(__float_as_int(ss),0x101f));
        const float rr_=rsqrtf(ss*(1.0f/128.0f)+1e-6f)*P.nscale; bf16*yp=P.out+(grow+row)*(long)P.opitch+ch*8;
        #pragma unroll
        for(int hf=0;hf<2;++hf){ const f32x4_t g0=gs[hf][0], g1=gs[hf][1]; u32x4 w;
          w[0]=cvtpk_s(of[hf][i][0]*rr_*g0[0],of[hf][i][1]*rr_*g0[1]); w[1]=cvtpk_s(of[hf][i][2]*rr_*g0[2],of[hf][i][3]*rr_*g0[3]); w[2]=cvtpk_s(of[hf][i][4]*rr_*g1[0],of[hf][i][5]*rr_*g1[1]); w[3]=cvtpk_s(of[hf][i][6]*rr_*g1[2],of[hf][i][7]*rr_*g1[3]);
          *(u32x4*)(yp+hf*64)=w; } } } }
  asm volatile("s_waitcnt lgkmcnt(0)\n\ts_barrier":::"memory");
  #undef DMA_K
  #undef BIAS
  #undef DMA_V
  #undef CMASK
  #undef START
  #undef RESC
  #undef ROT
}
constexpr int ATTN_LDS_BYTES=LDS_BYTES;
#undef SBAR
#undef WAIT_BAR
}
#ifndef MK_MU8
#define MK_MU8 0
#endif
#ifndef MK_PLE8
#define MK_PLE8 0
#endif
#define GAS __attribute__((address_space(1)))
#define LAS __attribute__((address_space(3)))
typedef unsigned v4u __attribute__((ext_vector_type(4)));
typedef float f32x4 __attribute__((ext_vector_type(4)));
typedef GAS unsigned gu32;
#define RLX_AGENT __ATOMIC_RELAXED, __HIP_MEMORY_SCOPE_AGENT
#define LDS_WAIT() asm volatile("s_waitcnt lgkmcnt(0)" ::: "memory")
#define VM_WAIT() asm volatile("s_waitcnt vmcnt(0)" ::: "memory")
constexpr int NWAVES = 8;
constexpr size_t W_IN = 0;
constexpr size_t W_CAT = W_IN + (size_t)3840 * 1024 * 2;
constexpr size_t W_G8 = W_CAT;
constexpr size_t W_BR = W_CAT + (size_t)3 * 1024 * 1024;
constexpr float G8_SCALE = 128.0f;
constexpr size_t W_OUT = W_CAT + (size_t)3 * 1024 * 1536 * 2;
constexpr size_t W_GU = W_OUT + (size_t)1024 * 1024 * 2;
constexpr size_t W_D = W_GU + (size_t)16 * 512 * 1024 * 2;
constexpr size_t W_RH = W_D + (size_t)16 * 1024 * 256 * 2;
constexpr size_t W_RL = W_RH + 65536;
constexpr size_t W_ENDB = W_RL + 65536;
static_assert(WS_W + W_ENDB <= WS_SSB && WS_SSB + MiB <= WS_WPLE, "weight map");
constexpr size_t W_PG = 0, W_P = (size_t)1024 * 1024 * 2, WPLE_STRIDE = (size_t)5 * 512 * 1024;
constexpr size_t OUT_XB8 = 0, OUT_GATES = 16 * MiB;
constexpr size_t OV_PB = WS_PB;
constexpr size_t OV_PW = WS_PROJ + 8 * MiB;
constexpr size_t OV_ACT = WS_PROJ + 40 * MiB;
constexpr size_t OV_XB2 = WS_PROJ + 64 * MiB;
constexpr int RING_BYTES = 131072, MISC_OFF = RING_BYTES, LDS_BYTES = 147456;
constexpr int MI_N = 0, MI_BASE = 32, MI_U0 = 64, MI_TOT = 96, MI_Q = 100, MI_BAR = 104;

__device__ __forceinline__ unsigned pk2(float lo, float hi) { typedef float f2 __attribute__((ext_vector_type(2))); typedef __bf16 b2 __attribute__((ext_vector_type(2))); f2 v = {lo, hi}; b2 b = __builtin_convertvector(v, b2); return __builtin_bit_cast(unsigned, b); }
__device__ __forceinline__ float bflo(unsigned u) { return __uint_as_float(u << 16); }
__device__ __forceinline__ float bfhi(unsigned u) { return __uint_as_float(u & 0xffff0000u); }
__device__ __forceinline__ float sigm(float v) { return __builtin_amdgcn_rcpf(1.0f + __expf(-v)); }
__device__ __forceinline__ float sg2(float t) { return __builtin_amdgcn_rcpf(1.0f + __builtin_amdgcn_exp2f(t)); }
__device__ __forceinline__ float clamp8(float v) { return __builtin_amdgcn_fmed3f(v, -448.0f, 448.0f); }
__device__ __forceinline__ unsigned pk_fp8x4(float a, float b, float c, float d) {
    int w = __builtin_amdgcn_cvt_pk_fp8_f32(clamp8(a), clamp8(b), 0, false); w = __builtin_amdgcn_cvt_pk_fp8_f32(clamp8(c), clamp8(d), w, true); return (unsigned)w; }

#define XOR1(v) __int_as_float(__builtin_amdgcn_ds_swizzle(__float_as_int(v), 0x041f))
#define XOR2(v) __int_as_float(__builtin_amdgcn_ds_swizzle(__float_as_int(v), 0x081f))
#define XOR4(v) __int_as_float(__builtin_amdgcn_ds_swizzle(__float_as_int(v), 0x101f))
#define XOR8(v) __int_as_float(__builtin_amdgcn_ds_swizzle(__float_as_int(v), 0x201f))
#define XOR16(v) __int_as_float(__builtin_amdgcn_ds_swizzle(__float_as_int(v), 0x401f))
__device__ __forceinline__ float add_xor32(float v) { const auto r = __builtin_amdgcn_permlane32_swap(__float_as_uint(v), __float_as_uint(v), false, false); return __uint_as_float(r[0]) + __uint_as_float(r[1]); }
__device__ __forceinline__ float wave_sum64(float v) { v += XOR1(v); v += XOR2(v); v += XOR4(v); v += XOR8(v); v += XOR16(v); return add_xor32(v); }
__device__ __forceinline__ int mk_tid(int wave0) { int l; asm volatile("v_mbcnt_lo_u32_b32 %0, -1, 0\n\tv_mbcnt_hi_u32_b32 %0, -1, %0" : "=v"(l)); return wave0 * 64 + l; }

#define XB_TMO      128
#define XB_XCNT(j)  (256  + 64 * (j))
#define XB_XSUB(j)  (1280 + 64 * (j))
#define XB_XGEN(j)  (2304 + 64 * (j))
#define XB_TOP      3328
#define XB_TOPGEN   3392
#define XCD_BAR_WORDS 3456
#define XB_SPIN_CAP (1u << 18)
__device__ __forceinline__ unsigned xb_ld(unsigned* p)              { return __hip_atomic_load(p, __ATOMIC_RELAXED, __HIP_MEMORY_SCOPE_AGENT); }
__device__ __forceinline__ unsigned xb_add(unsigned* p, unsigned v) { return __hip_atomic_fetch_add(p, v, __ATOMIC_RELAXED, __HIP_MEMORY_SCOPE_AGENT); }
__device__ __forceinline__ unsigned xb_xcc_id() { return (unsigned)__builtin_amdgcn_s_getreg((3 << 11) | 20) & 0xFu; }
#define XB_SPIN(cond, bar) do { unsigned _sp = 0; while (cond) { __builtin_amdgcn_s_sleep(1); \
    if ((++_sp & 255u) == 0u) { if (xb_ld(&(bar)[XB_TMO])) break; if (_sp > XB_SPIN_CAP) { atomicAdd(&(bar)[XB_TMO], 1u); break; } } } } while (0)
struct XcdBarrier { unsigned* bar; unsigned x; volatile LAS unsigned* st; };
__device__ __forceinline__ XcdBarrier xcd_barrier_post(unsigned* bar, volatile LAS unsigned* st, int tid) {
    XcdBarrier b; b.bar = bar; b.x = xb_xcc_id(); b.st = st;
    if (tid == 0) (void)xb_add(&bar[XB_XCNT(b.x)], 1u);
    return b;
}
__device__ __forceinline__ void xcd_barrier_complete(unsigned* bar, unsigned x, unsigned& nloc, unsigned& nx) {
    const unsigned G = gridDim.x * gridDim.y * gridDim.z;
    unsigned sum, cnt, mine, sp = 0u;
    for (;;) {
        sum = 0u; cnt = 0u; mine = 0u;
#pragma unroll
        for (unsigned j = 0; j < 16; ++j) { const unsigned c = xb_ld(&bar[XB_XCNT(j)]); sum += c; cnt += (c > 0u) ? 1u : 0u; mine = (j == x) ? c : mine; }
        if (sum == G) break;
        __builtin_amdgcn_s_sleep(1);
        if ((++sp & 255u) == 0u) { if (xb_ld(&bar[XB_TMO])) break; if (sp > XB_SPIN_CAP) { atomicAdd(&bar[XB_TMO], 1u); break; } }
    }
    nloc = mine > 0u ? mine : 1u; nx = cnt > 0u ? cnt : 1u;
}
#ifndef MK_EARLYINV
#define MK_EARLYINV 1
#endif
#ifndef MK_SPLIT_SLEEP
#define MK_SPLIT_SLEEP 16
#endif
__device__ __forceinline__ void xcd_barrier(const XcdBarrier& b, int tid) {
    asm volatile("s_waitcnt vmcnt(0)" ::: "memory");
    __syncthreads();
    if (tid == 0) {
        unsigned* bar = b.bar;
        __builtin_amdgcn_s_waitcnt(0);
        unsigned nloc = b.st[0], nx = b.st[1];
        if (nloc == 0u) { xcd_barrier_complete(bar, b.x, nloc, nx); b.st[0] = nloc; b.st[1] = nx; }
        const unsigned old = xb_add(&bar[XB_XSUB(b.x)], 1u);
        const unsigned gen = old / nloc;
        if (old + 1u == (gen + 1u) * nloc) {
            __builtin_amdgcn_fence(__ATOMIC_RELEASE, "agent");
            asm volatile("s_waitcnt vmcnt(0)" ::: "memory");
            const unsigned og = xb_add(&bar[XB_TOP], 1u);
            unsigned tg = og / nx; asm volatile("" : "+v"(tg) :: "memory");
            if (og + 1u == (tg + 1u) * nx) { xb_add(&bar[XB_TOPGEN], 1u);
#if MK_EARLYINV
                xb_add(&bar[XB_XGEN(b.x)], 1u); asm volatile("buffer_inv sc1" ::: "memory");
#endif
            } else {
#if MK_EARLYINV
                asm volatile("buffer_inv sc1" ::: "memory");
#endif
                XB_SPIN(xb_ld(&bar[XB_TOPGEN]) == tg, bar);
#if MK_EARLYINV
                xb_add(&bar[XB_XGEN(b.x)], 1u);
#endif
            }
#if !MK_EARLYINV
            __builtin_amdgcn_fence(__ATOMIC_ACQUIRE, "agent");
            xb_add(&bar[XB_XGEN(b.x)], 1u);
#endif
            asm volatile("s_waitcnt vmcnt(0)" ::: "memory");
        } else {
#if MK_EARLYINV
            { unsigned g2 = gen; asm volatile("" : "+v"(g2) :: "memory"); asm volatile("buffer_inv sc1" ::: "memory");
              XB_SPIN(xb_ld(&bar[XB_XGEN(b.x)]) == g2, bar); }
#else
            XB_SPIN(xb_ld(&bar[XB_XGEN(b.x)]) == gen, bar);
            __builtin_amdgcn_fence(__ATOMIC_ACQUIRE, "agent");
#endif
            asm volatile("s_waitcnt vmcnt(0)" ::: "memory");
        }
    }
    __syncthreads();
}

__device__ __forceinline__ void split_arrive(unsigned* cnt, int tid) {
    asm volatile("s_waitcnt vmcnt(0)" ::: "memory"); __syncthreads();
    if (tid == 0) { __builtin_amdgcn_fence(__ATOMIC_RELEASE, "agent"); asm volatile("s_waitcnt vmcnt(0)" ::: "memory"); xb_add(cnt, 1u); }
}
__device__ __forceinline__ void split_arrive_x(const XcdBarrier& b, unsigned* cnt_top, unsigned* cnt_x, int tid) {
    asm volatile("s_waitcnt vmcnt(0)" ::: "memory"); __syncthreads();
    if (tid == 0) { const unsigned nloc = b.st[0]; const unsigned old = xb_add(cnt_x + 8u * b.x, 1u);
        if (old + 1u == nloc) { __builtin_amdgcn_fence(__ATOMIC_RELEASE, "agent"); asm volatile("s_waitcnt vmcnt(0)" ::: "memory"); xb_add(cnt_top, nloc); }
#if MK_EARLYINV
        asm volatile("buffer_inv sc1" ::: "memory");
#endif
    }
}
__device__ __forceinline__ void split_wait_leader(unsigned* cnt, unsigned target) {
    unsigned sp = 0; while (xb_ld(cnt) < target) { __builtin_amdgcn_s_sleep(MK_SPLIT_SLEEP); if (++sp > (1u << 22)) break; }
#if !MK_EARLYINV
    __builtin_amdgcn_fence(__ATOMIC_ACQUIRE, "agent");
#endif
    asm volatile("s_waitcnt vmcnt(0)" ::: "memory");
}

__device__ __forceinline__ void group4_sync(unsigned* gc, int tid) {
    asm volatile("s_waitcnt vmcnt(0)" ::: "memory"); __syncthreads();
    if (tid == 0) { const unsigned sh = 8u + 3u * xb_xcc_id();
        xb_add(gc, 1u + (1u << sh));
        asm volatile("buffer_inv sc1" ::: "memory");
        unsigned sp = 0, v = 0; for (;;) { v = xb_ld(gc); if ((v & 0xffu) >= 4u) break; __builtin_amdgcn_s_sleep(1); if (++sp > (1u << 22)) break; }
        if (((v >> sh) & 7u) != 4u) {
            __builtin_amdgcn_fence(__ATOMIC_RELEASE, "agent"); asm volatile("s_waitcnt vmcnt(0)" ::: "memory");
            xb_add(gc + 16, 1u); sp = 0; while (xb_ld(gc + 16) < 4u) { __builtin_amdgcn_s_sleep(1); if (++sp > (1u << 22)) break; }
            __builtin_amdgcn_fence(__ATOMIC_ACQUIRE, "agent"); }
        asm volatile("s_waitcnt vmcnt(0)" ::: "memory"); }
    __syncthreads();
}

struct Args { const void* in[27]; float* out; unsigned char* ws; int ph_lo, ph_hi, li, pad; };
struct LayerW {
    const float *g_attn, *w_in, *pool_w, *pool_scale, *dqn, *dkn, *dlam, *dsub, *fqn, *fkn, *ffb, *w_branch, *w_out, *g_ffn, *wrg, *brg, *wre, *bre, *wg, *wu, *wd, *g_ple, *wpg, *wple, *p;
};
__device__ __forceinline__ LayerW layer_view(const __attribute__((address_space(4))) Args* a, int l) {
    LayerW w; const float* in[27];
#pragma unroll
    for (int i = 0; i < 27; ++i) in[i] = (const float*)a->in[i];
    w.g_attn = in[3] + l * 1024; w.w_in = in[4] + (size_t)l * 1024 * INW; w.pool_w = in[5] + (size_t)l * 65536; w.pool_scale = in[6] + l * 512;
    w.dqn = in[7] + l * 64; w.dkn = in[8] + l * 64; w.dlam = in[9] + l * 256; w.dsub = in[10] + l * 128; w.fqn = in[11] + l * 64; w.fkn = in[12] + l * 64; w.ffb = in[13] + l * 8;
    w.w_branch = in[14] + (size_t)l * 3 * 512 * 1024; w.w_out = in[15] + (size_t)l * 1024 * 1024; w.g_ffn = in[16] + l * 1024; w.wrg = in[17] + (size_t)l * 4096; w.brg = in[18] + l * 4;
    w.wre = in[19] + (size_t)l * 16384; w.bre = in[20] + l * 16; w.wg = in[21] + (size_t)l * 16 * 262144; w.wu = in[22] + (size_t)l * 16 * 262144; w.wd = in[23] + (size_t)l * 16 * 262144;
    w.g_ple = in[24] + l * 1024; w.wpg = in[25] + (size_t)l * 1024 * 1024; w.wple = in[26] + (size_t)l * 256 * 1024; w.p = in[1] + (size_t)l * T * 256;
    return w;
}

__device__ __forceinline__ void tr_item(const float* __restrict__ src, int ldsrc, int c0, int nvalid, int k0, const float* __restrict__ gk, bf16* dst, int dpitch, int nrow0, int dk0, LAS float* scr, int lane, const bool f8 = false) {
    float vv[32];
#pragma unroll
    for (int i = 0; i < 32; ++i) { const int kk = 2 * i + (lane >> 5), c = lane & 31; vv[i] = (c < nvalid) ? src[(size_t)(k0 + kk) * ldsrc + c0 + c] : 0.f; }
    const int c8 = lane & 7;
    f32x4 gA = (f32x4){1.f, 1.f, 1.f, 1.f}, gB = gA;
    if (gk) { const GAS f32x4* gp = (const GAS f32x4*)(gk + k0 + 8 * c8); gA = gp[0]; gB = gp[1]; }
#pragma unroll
    for (int i = 0; i < 32; ++i) scr[(2 * i + (lane >> 5)) * 33 + (lane & 31)] = vv[i];
    LDS_WAIT(); asm volatile("" ::: "memory");
#pragma unroll
    for (int j = 0; j < 4; ++j) { const int n = (lane >> 3) + 8 * j; const LAS float* sp = scr + (8 * c8) * 33 + n;
        const float s0 = sp[0 * 33] * gA.x, s1 = sp[1 * 33] * gA.y, s2 = sp[2 * 33] * gA.z, s3 = sp[3 * 33] * gA.w, s4 = sp[4 * 33] * gB.x, s5 = sp[5 * 33] * gB.y, s6 = sp[6 * 33] * gB.z, s7 = sp[7 * 33] * gB.w;
        if (f8) { typedef unsigned v2u_ __attribute__((ext_vector_type(2))); v2u_ o;
            o.x = pk_fp8x4(s0 * G8_SCALE, s1 * G8_SCALE, s2 * G8_SCALE, s3 * G8_SCALE); o.y = pk_fp8x4(s4 * G8_SCALE, s5 * G8_SCALE, s6 * G8_SCALE, s7 * G8_SCALE);
            *(GAS v2u_*)((GAS char*)dst + (size_t)(nrow0 + n) * dpitch + dk0 + 8 * c8) = o; }
        else { v4u o; o.x = pk2(s0, s1); o.y = pk2(s2, s3); o.z = pk2(s4, s5); o.w = pk2(s6, s7);
            *(GAS v4u*)(dst + (size_t)(nrow0 + n) * dpitch + dk0 + 8 * c8) = o; } }
    LDS_WAIT(); asm volatile("" ::: "memory");
}
constexpr int CV_EARLY = 1536 + 128 + 1536 + 768, CV_NIT = CV_EARLY + 512 + 4096 + 2048 + 512 + 128, CV_LATE_BATCHES = (CV_NIT - CV_EARLY + 7) / 8, CV_RT_BATCHES = 64, CV_PB_BATCHES = 64;
__device__ __forceinline__ void conv_item(const LayerW& w, unsigned char* ws, int l, int it, LAS float* scr, int lane) {
    bf16* Wb = (bf16*)(ws + WS_W); bf16* WIN = (bf16*)(ws + WS_W + W_IN); bf16* WOUT = (bf16*)(ws + WS_W + W_OUT);
    bf16* WGU = (bf16*)(ws + WS_W + W_GU); bf16* WDN = (bf16*)(ws + WS_W + W_D); bf16* WPG = (bf16*)(ws + WS_WPLE + l * WPLE_STRIDE + W_PG); bf16* WP = (bf16*)(ws + WS_WPLE + l * WPLE_STRIDE + W_P);
    (void)Wb;
    constexpr int I_A = 1536, I_B = 128, I_D1 = 1536, I_D2 = 768, I_E = 512, I_F = 4096, I_G = 2048, I_H1 = 512, I_H2 = 128;
    constexpr int NIT = I_A + I_B + I_D1 + I_D2 + I_E + I_F + I_G + I_H1 + I_H2;
    int r = it;
        if (r < I_A) { const int kb = r / 96, nb = r % 96, p0 = 512 + 32 * nb, pn = p0 >> 8, q0 = p0 & 255;
            const bool head = (pn >= 2 && pn <= 5) || (pn >= 8 && pn <= 11);
            const int c0 = head ? (256 * pn + 64 * ((q0 >> 5) & 3) + 32 * (q0 >> 7)) : p0;
            tr_item(w.w_in, INW, c0, 32, 64 * kb, w.g_attn, WIN, 1024, p0, 64 * kb, scr, lane); return; } r -= I_A;
        if (r < I_B) { const int kb = r / 8, nb = r % 8; tr_item(w.w_in, INW, 3584, nb == 0 ? 8 : 0, 64 * kb, w.g_attn, WIN, 1024, 3584 + 32 * nb, 64 * kb, scr, lane); return; } r -= I_B;
        if (r < I_D1) { const int n = r / 512, r2 = r % 512, kb = r2 / 32, nb = r2 % 32;
            tr_item(w.w_in, INW, 3592 + n * 1024 + 32 * nb, 32, 64 * kb, w.g_attn, (bf16*)(ws + WS_W + W_G8 + (size_t)n * 1024 * 1024), 1024, 32 * nb, 64 * kb, scr, lane, true); return; } r -= I_D1;
        if (r < I_D2) { const int n = r / 256, r2 = r % 256, kb = r2 / 32, nb = r2 % 32;
            tr_item(w.w_branch + (size_t)n * 512 * 1024, 1024, 32 * nb, 32, 64 * kb, nullptr, (bf16*)(ws + WS_W + W_BR) + (size_t)n * 1024 * 512, 512, 32 * nb, 64 * kb, scr, lane); return; } r -= I_D2;
        if (r < I_E) { const int kb = r / 32, nb = r % 32; tr_item(w.w_out, 1024, 32 * nb, 32, 64 * kb, nullptr, WOUT, 1024, 32 * nb, 64 * kb, scr, lane); return; } r -= I_E;
        if (r < I_F) { const int e = r / 256, r1 = r % 256, hf = r1 / 128, r2 = r1 % 128, kb = r2 / 8, nb = r2 % 8, q0 = 32 * nb;
            const float* src = ((q0 >> 7) ? w.wu : w.wg) + (size_t)e * 262144;
            const bool f8 = MK_MU8 && l == NL - 1;
            tr_item(src, 256, 128 * hf + (q0 & 127), 32, 64 * kb, w.g_ffn, f8 ? (bf16*)((unsigned char*)WGU + (size_t)(e * 2 + hf) * 256 * 1024) : WGU + (size_t)(e * 2 + hf) * 256 * 1024, 1024, q0, 64 * kb, scr, lane, f8); return; } r -= I_F;
        if (r < I_G) { const int e = r / 128, r2 = r % 128, kb = r2 / 32, nb = r2 % 32;
            tr_item(w.wd + (size_t)e * 262144, 1024, 32 * nb, 32, 64 * kb, nullptr, WDN + (size_t)e * 262144, 256, 32 * nb, 64 * kb, scr, lane); return; } r -= I_G;
        if (r < I_H1) { const int kb = r / 32, nb = r % 32; tr_item(w.wpg, 1024, 32 * nb, 32, 64 * kb, w.g_ple, WPG, 1024, 32 * nb, 64 * kb, scr, lane, MK_PLE8 != 0); return; } r -= I_H1;
        { const int kb = r / 32, nb = r % 32; tr_item(w.wple, 1024, 32 * nb, 32, 64 * kb, nullptr, WP, 256, 32 * nb, 64 * kb, scr, lane); }
}
__device__ __forceinline__ void conv_late_batch(const LayerW& w, unsigned char* ws, int l, LAS unsigned char* lds, int batch, int tid) {
    const int lane = tid & 63, wave = __builtin_amdgcn_readfirstlane(tid >> 6);
    if (batch < CV_LATE_BATCHES) { const int it = CV_EARLY + batch * 8 + wave; if (it < CV_NIT) conv_item(w, ws, l, it, (LAS float*)(lds + wave * 16384), lane); }
    else if (batch >= CV_LATE_BATCHES + CV_RT_BATCHES) {
        const int i0 = (batch - CV_LATE_BATCHES - CV_RT_BATCHES) * 8192 + tid; GAS v4u* PB = (GAS v4u*)(ws + OV_PB);
#pragma clang loop unroll(disable)
        for (int q0 = 0; q0 < 16; q0 += 4) { f32x4 a[4], b[4];
#pragma unroll
            for (int q = 0; q < 4; ++q) { const GAS f32x4* s = (const GAS f32x4*)(w.p) + 2 * (size_t)(i0 + (q0 + q) * 512); a[q] = s[0]; b[q] = s[1]; }
#pragma unroll
            for (int q = 0; q < 4; ++q) { v4u o; o.x = pk2(a[q].x, a[q].y); o.y = pk2(a[q].z, a[q].w); o.z = pk2(b[q].x, b[q].y); o.w = pk2(b[q].z, b[q].w); PB[i0 + (q0 + q) * 512] = o; } } }
    else { const int idx = (batch - CV_LATE_BATCHES) * 512 + tid; const int e = idx >> 10, k = idx & 1023;
        const float v = w.g_ffn[k] * (e < 4 ? w.wrg[k * 4 + e] : (e < 20 ? w.wre[k * 16 + e - 4] : 0.f));
        const unsigned hi = pk2(v, 0.f) & 0xffffu; const unsigned lo = pk2(v - bflo(hi), 0.f) & 0xffffu;
        ((bf16*)(ws + WS_W + W_RH))[idx] = (bf16)hi; ((bf16*)(ws + WS_W + W_RL))[idx] = (bf16)lo; }
}
__device__ __forceinline__ void weff_job(const LayerW& w, unsigned char* ws, LAS unsigned char* lds, int job, int tid) {
    bf16* WIN = (bf16*)(ws + WS_W + W_IN);
    LAS float* Wt = (LAS float*)lds; LAS float* Pw = (LAS float*)(lds + 36864);
    const int kb = job >> 4, g = (job >> 2) & 3, nq = job & 3, k0 = 64 * kb;
    {
        float wv_[16], pv_[8];
#pragma unroll
        for (int i = 0; i < 16; ++i) { const int e = tid + 512 * i, kk = e >> 7, c = e & 127; wv_[i] = w.w_in[(size_t)(k0 + kk) * INW + 128 * g + c]; }
#pragma unroll
        for (int i = 0; i < 8; ++i) { const int e = tid + 512 * i, c = e >> 5, n_ = e & 31; pv_[i] = w.pool_w[(size_t)g * 16384 + c * 128 + 32 * nq + n_]; }
#pragma unroll
        for (int i = 0; i < 16; ++i) { const int e = tid + 512 * i; Wt[(e >> 7) * 132 + (e & 127)] = wv_[i]; }
#pragma unroll
        for (int i = 0; i < 8; ++i) { const int e = tid + 512 * i; Pw[(e >> 5) * 32 + (e & 31)] = pv_[i]; }
    }
    __syncthreads();
    const int n = tid & 31, ks = tid >> 5; float a[4] = {0.f, 0.f, 0.f, 0.f};
#pragma unroll 2
    for (int c = 0; c < 128; c += 4) {
        const float p0 = Pw[c * 32 + n], p1 = Pw[(c + 1) * 32 + n], p2 = Pw[(c + 2) * 32 + n], p3 = Pw[(c + 3) * 32 + n];
#pragma unroll
        for (int i = 0; i < 4; ++i) { const f32x4 w4 = *(const LAS f32x4*)(Wt + (ks * 4 + i) * 132 + c); a[i] += (w4.x * p0 + w4.y * p1) + (w4.z * p2 + w4.w * p3); } }
    const float sc = w.pool_scale[128 * g + 32 * nq + n];
#pragma unroll
    for (int i = 0; i < 4; ++i) a[i] *= sc * w.g_attn[k0 + ks * 4 + i];
    *(GAS unsigned long long*)(WIN + (size_t)(128 * g + 32 * nq + n) * 1024 + k0 + ks * 4) = (unsigned long long)pk2(a[0], a[1]) | ((unsigned long long)pk2(a[2], a[3]) << 32);
    __syncthreads();
}
__device__ __forceinline__ void conv_layer(const LayerW& w, unsigned char* ws, int l, LAS unsigned char* lds, int vcu, int G, int tid) {
    const int lane = tid & 63, wave = __builtin_amdgcn_readfirstlane(tid >> 6);
    LAS float* scr = (LAS float*)(lds + wave * 16384);
    const int gw = vcu * NWAVES + wave, NGW = G * NWAVES;
    for (int it = gw; it < CV_EARLY; it += NGW) conv_item(w, ws, l, it, scr, lane);
    __syncthreads();
    for (int job = vcu; job < 256; job += G) weff_job(w, ws, lds, job, tid);
}
constexpr int CV_EARLY_BATCHES = CV_EARLY / 8 + 256;
__device__ __forceinline__ void conv_early_batch(const LayerW& w, unsigned char* ws, int l, LAS unsigned char* lds, int batch, int tid) {
    const int lane = tid & 63, wave = __builtin_amdgcn_readfirstlane(tid >> 6);
    if (batch < CV_EARLY / 8) { conv_item(w, ws, l, batch * 8 + wave, (LAS float*)(lds + wave * 16384), lane); __syncthreads(); }
    else weff_job(w, ws, lds, batch - CV_EARLY / 8, tid);
}
__device__ __forceinline__ void p0_x(const float* x, const int* positions, unsigned char* ws, unsigned char* x8, int vcu, int G, int tid) {
    const int lane = tid & 63, wave = __builtin_amdgcn_readfirstlane(tid >> 6);
    bf16* XY = (bf16*)(ws + WS_XY); float* SS = (float*)(ws + WS_SS); float* CS = (float*)(ws + WS_COSSIN);
    const int gw = vcu * NWAVES + wave, NGW = G * NWAVES;
    for (int t = gw; t < T; t += NGW) {
        const GAS f32x4* xr = (const GAS f32x4*)(x + (size_t)t * 1024) + lane; float s = 0.f;
        GAS unsigned long long* o8 = (GAS unsigned long long*)(XY + (size_t)t * XYP + 1536) + lane;
#pragma unroll
        for (int j = 0; j < 4; ++j) { const f32x4 v = xr[64 * j]; s += (v.x * v.x + v.y * v.y) + (v.z * v.z + v.w * v.w); o8[64 * j] = (unsigned long long)pk2(v.x, v.y) | ((unsigned long long)pk2(v.z, v.w) << 32);
            ((GAS unsigned*)(x8 + (size_t)t * 1024))[lane + 64 * j] = pk_fp8x4(v.x, v.y, v.z, v.w); }
        s = wave_sum64(s);
        if (lane < 16) SS[(size_t)t * 16 + lane] = lane == 0 ? s : 0.f;
    }
    for (int idx = vcu * 512 + tid; idx < T * 8; idx += G * 512) { const int t = idx >> 3, i = idx & 7;
        const float invf = powf(500000.0f, -(float)(2 * i) / 16.0f); const float ang = (float)positions[t] * invf;
        CS[(size_t)t * 16 + i] = cosf(ang); CS[(size_t)t * 16 + 8 + i] = sinf(ang); }
}

typedef pg8::f32x4 (&AccRef)[2][2][4][2];
#define LAUNDER3(a, b, c) asm volatile("" : "+v"(a), "+v"(b), "+v"(c))
__device__ __forceinline__ float rstd_at(const float* SS, unsigned row) {
    const GAS f32x4* p = (const GAS f32x4*)((const GAS char*)SS + row * 64u); const f32x4 a = p[0], b = p[1], c = p[2], d = p[3];
    const float s = ((a.x + a.y) + (a.z + a.w)) + ((b.x + b.y) + (b.z + b.w)) + ((c.x + c.y) + (c.z + c.w)) + ((d.x + d.y) + (d.z + d.w));
    return rsqrtf(s * (1.0f / 1024.0f) + RMS_EPS);
}
__device__ __forceinline__ void rstd8(const float* SS, unsigned row0, int fq, float (&rs)[8]) {
    f32x4 v[8];
#pragma unroll
    for (int i = 0; i < 8; ++i) v[i] = *(const GAS f32x4*)((const GAS char*)SS + ((row0 + (unsigned)((i >> 2) * 128 + (i & 3) * 16)) * 64u + (unsigned)fq * 16u));
#pragma unroll
    for (int i = 0; i < 8; ++i) { float s = (v[i].x + v[i].y) + (v[i].z + v[i].w); s += XOR16(s); s = add_xor32(s); rs[i] = rsqrtf(s * (1.0f / 1024.0f) + RMS_EPS); }
}
__device__ __forceinline__ float logsig(float z) { return fminf(z, 0.f) - log1pf(expf(-fabsf(z))); }
struct EpiG1 {
    const float* SS; bf16* PROJ; float* LOGF; const float* CS; const float* GT; const float* ffb; int dry; const LAS float* rsl;
    __device__ __forceinline__ void operator()(AccRef acc, const pg8::Step& st, int wr, int wc, int fr_, int fq_) const {
        if (dry) return;
        int fr = fr_, fq = fq_, zz = 0; LAUNDER3(fr, fq, zz);
        const int pn = st.pn; const unsigned row0 = (unsigned)(st.pm * 256 + wr * 64 + fr);
#define RSL8(dst_) do { _Pragma("unroll") for (int i_ = 0; i_ < 8; ++i_) dst_[i_] = rsl[st.aux * 256 + (i_ >> 2) * 128 + wr * 64 + (i_ & 3) * 16 + fr]; } while (0)
        const bool head = (pn >= 2 && pn <= 5) || (pn >= 8 && pn <= 11);
        if (head) {
            const float* gain = GT + 64 * (pn < 4 ? 0 : (pn < 6 ? 1 : (pn < 10 ? 2 : 3)));
            const bool rot = pn < 6; const float osc = (pn < 4 || (pn >= 8 && pn < 10)) ? C2 : 1.0f;
            f32x4 G[2][2];
#pragma unroll
            for (int bj = 0; bj < 2; ++bj)
#pragma unroll
                for (int n = 0; n < 2; ++n) G[bj][n] = *(const GAS f32x4*)((const GAS char*)gain + (unsigned)(32 * bj + 8 * fq + 4 * n) * 4u);
            const GAS char* pb = (const GAS char*)PROJ + (unsigned)(256 * pn + 64 * wc) * 2u;
            float rs8[8]; RSL8(rs8);
            f32x4 cs[4];
#define G1_LOADCS(i_) do { if (rot && fq < 2) { const GAS f32x4* cp_ = (const GAS f32x4*)((const GAS char*)CS + (row0 + (unsigned)(((i_) >> 2) * 128 + ((i_) & 3) * 16)) * 64u); \
                _Pragma("unroll") for (int q_ = 0; q_ < 4; ++q_) cs[q_] = cp_[q_]; } } while (0)
            G1_LOADCS(0);
#pragma unroll
            for (int i = 0; i < 8; ++i) {
                v4u ov[2];
                {
                    const int ai = i >> 2, m = i & 3; const float rs = rs8[i];
                    f32x4 v[2][2]; float ss = 0.f;
#pragma unroll
                    for (int bj = 0; bj < 2; ++bj)
#pragma unroll
                        for (int n = 0; n < 2; ++n) { v[bj][n] = acc[ai][bj][m][n]; const f32x4 q = v[bj][n] * v[bj][n]; ss += (q.x + q.y) + (q.z + q.w); }
                    ss += XOR16(ss); ss = add_xor32(ss);
                    const float hn = rsqrtf(ss * (1.0f / 64.0f) + RMS_EPS * __builtin_amdgcn_rcpf(rs * rs)) * osc;
#pragma unroll
                    for (int bj = 0; bj < 2; ++bj)
#pragma unroll
                        for (int n = 0; n < 2; ++n) v[bj][n] = v[bj][n] * hn * G[bj][n];
                    if (rot) {
                        f32x4 ot[2];
#pragma unroll
                        for (int n = 0; n < 2; ++n) { ot[n].x = XOR16(v[0][n].x); ot[n].y = XOR16(v[0][n].y); ot[n].z = XOR16(v[0][n].z); ot[n].w = XOR16(v[0][n].w); }
                        if (fq < 2) {
#pragma unroll
                            for (int n = 0; n < 2; ++n) { const f32x4 c = cs[n], s = cs[2 + n]; v[0][n] = (fq == 0) ? (v[0][n] * c - ot[n] * s) : (v[0][n] * c + ot[n] * s); }
                        }
                    }
#pragma unroll
                    for (int bj = 0; bj < 2; ++bj) { ov[bj].x = pk2(v[bj][0].x, v[bj][0].y); ov[bj].y = pk2(v[bj][0].z, v[bj][0].w); ov[bj].z = pk2(v[bj][1].x, v[bj][1].y); ov[bj].w = pk2(v[bj][1].z, v[bj][1].w); }
                }
                if (i < 7) G1_LOADCS(i + 1);
                asm volatile("" ::: "memory");
                { const unsigned row = row0 + (unsigned)((i >> 2) * 128 + (i & 3) * 16);
#pragma unroll
                    for (int bj = 0; bj < 2; ++bj) *(GAS v4u*)(pb + (row * (unsigned)(PJP * 2) + (unsigned)(32 * bj + 8 * fq) * 2u)) = ov[bj]; }
                asm volatile("" ::: "memory");
            }
#undef G1_LOADCS
        } else if (pn == 14) {
            float rs14[8]; RSL8(rs14);
            if (wc == 0 && fq == 0) {
                const f32x4 b0 = *(const GAS f32x4*)ffb, b1 = *(const GAS f32x4*)(ffb + 4);
#pragma unroll
                for (int ai = 0; ai < 2; ++ai)
#pragma unroll
                    for (int m = 0; m < 4; ++m) {
                        const unsigned row = row0 + ai * 128 + m * 16; const float rs = rs14[ai * 4 + m];
                        const f32x4 z0 = acc[ai][0][m][0] * rs + b0, z1 = acc[ai][0][m][1] * rs + b1; f32x4 o0, o1;
                        o0.x = logsig(z0.x); o0.y = logsig(z0.y); o0.z = logsig(z0.z); o0.w = logsig(z0.w); o1.x = logsig(z1.x); o1.y = logsig(z1.y); o1.z = logsig(z1.z); o1.w = logsig(z1.w);
                        GAS f32x4* d = (GAS f32x4*)((GAS char*)LOGF + row * 32u); d[0] = o0; d[1] = o1;
                    }
            }
        } else {
            const GAS char* pb = (const GAS char*)PROJ + (unsigned)(256 * pn + 32 * wc) * 2u;
            float rsp[8]; RSL8(rsp);
#pragma unroll
            for (int ai = 0; ai < 2; ++ai)
#pragma unroll
                for (int m = 0; m < 4; ++m) {
                    const unsigned row = row0 + ai * 128 + m * 16; const float rs = rsp[ai * 4 + m];
#pragma unroll
                    for (int bj = 0; bj < 2; ++bj) { const f32x4 a = acc[ai][bj][m][0] * rs, b = acc[ai][bj][m][1] * rs; v4u o; o.x = pk2(a.x, a.y); o.y = pk2(a.z, a.w); o.z = pk2(b.x, b.y); o.w = pk2(b.z, b.w);
                        *(GAS v4u*)(pb + (row * (unsigned)(PJP * 2) + (unsigned)(128 * bj + 8 * fq) * 2u)) = o; }
                }
        }
    }
};
typedef unsigned v2u __attribute__((ext_vector_type(2)));
__device__ __forceinline__ unsigned pk8(float a, float b, float c, float d) {
    unsigned w = __builtin_amdgcn_cvt_pk_u8_f32(a * 256.0f - 0.5f, 0u, 0u); w = __builtin_amdgcn_cvt_pk_u8_f32(b * 256.0f - 0.5f, 1u, w); w = __builtin_amdgcn_cvt_pk_u8_f32(c * 256.0f - 0.5f, 2u, w); return __builtin_amdgcn_cvt_pk_u8_f32(d * 256.0f - 0.5f, 3u, w); }
__device__ __forceinline__ float g8(unsigned w, const int k) { return ((float)((w >> (8 * k)) & 0xffu) + 0.5f) * (1.0f / 256.0f); }
__device__ __forceinline__ float g8u(unsigned w, const int k) { return (float)((w >> (8 * k)) & 0xffu) + 0.5f; }
#undef RSL8
template <int PART>
struct EpiG2 {
    const float* SS; unsigned char* gs; bf16* MERGED; const LAS float* rsl;
    __device__ __forceinline__ void operator()(AccRef acc, const pg8::Step& st, int wr, int wc, int fr_, int fq_) const {
        int ln; asm volatile("v_mbcnt_lo_u32_b32 %0, -1, 0\n\tv_mbcnt_hi_u32_b32 %0, -1, %0" : "=v"(ln));
        int fr = ln & 15, fq = ln >> 4, tid = (wr * 4 + wc) * 64 + ln; LAUNDER3(fr, fq, tid); (void)fr_; (void)fq_;
        const int aux = st.aux; const unsigned row0 = (unsigned)(st.pm * 256 + wr * 64 + fr), toff = (unsigned)tid * 8u;
        const int n = aux < 3 ? aux : aux - 3; GAS char* gb = (GAS char*)gs + (size_t)n * 65536;
        GAS char* mb = (GAS char*)MERGED + (unsigned)(256 * st.pn + 32 * wc) * 2u;
        float rsg[8];
#pragma unroll
        for (int i = 0; i < 8; ++i) rsg[i] = 0.f;
        if (PART == 0) {
#pragma unroll
            for (int i = 0; i < 8; ++i) rsg[i] = rsl[(i >> 2) * 128 + wr * 64 + (i & 3) * 16 + fr]; }
#pragma unroll
        for (int ai = 0; ai < 2; ++ai) {
            v2u gn[4][2], gd[4][2];
#pragma unroll
            for (int m = 0; m < 4; ++m)
#pragma unroll
                for (int bj = 0; bj < 2; ++bj) { gn[m][bj] = (v2u){0u, 0u}; gd[m][bj] = (v2u){0u, 0u}; }
            if (PART == 1) {
#pragma unroll
                for (int m = 0; m < 4; ++m)
#pragma unroll
                    for (int bj = 0; bj < 2; ++bj) { const unsigned so = toff + (unsigned)(((ai * 4 + m) * 2 + bj) * 4096); gn[m][bj] = *(const GAS v2u*)(gb + so); if (aux < 5) gd[m][bj] = *(const GAS v2u*)(gb + 65536 + so); }
            }
            asm volatile("" ::: "memory");
#pragma unroll
            for (int m = 0; m < 4; ++m) {
                const float rs = rsg[ai * 4 + m] * (1.0f / G8_SCALE);
#pragma unroll
                for (int bj = 0; bj < 2; ++bj) {
                    const unsigned so = toff + (unsigned)(((ai * 4 + m) * 2 + bj) * 4096);
                    const f32x4 a = acc[ai][bj][m][0], b = acc[ai][bj][m][1]; const v2u n_ = gn[m][bj], d_ = gd[m][bj];
                    f32x4 fa = (f32x4){0.f, 0.f, 0.f, 0.f}, fb = fa;
                    if (PART == 0) { const float rsn = rs * -1.4426950408889634f; const f32x4 x = a * rsn, y = b * rsn; v2u o;
                        o.x = pk8(sg2(x.x), sg2(x.y), sg2(x.z), sg2(x.w)); o.y = pk8(sg2(y.x), sg2(y.y), sg2(y.z), sg2(y.w));
                        *(GAS v2u*)(gb + so) = o;
                    } else if (aux < 5) {
                        fa.x = g8u(n_.x, 0) * __builtin_amdgcn_rcpf(g8u(d_.x, 0)); fa.y = g8u(n_.x, 1) * __builtin_amdgcn_rcpf(g8u(d_.x, 1)); fa.z = g8u(n_.x, 2) * __builtin_amdgcn_rcpf(g8u(d_.x, 2)); fa.w = g8u(n_.x, 3) * __builtin_amdgcn_rcpf(g8u(d_.x, 3));
                        fb.x = g8u(n_.y, 0) * __builtin_amdgcn_rcpf(g8u(d_.y, 0)); fb.y = g8u(n_.y, 1) * __builtin_amdgcn_rcpf(g8u(d_.y, 1)); fb.z = g8u(n_.y, 2) * __builtin_amdgcn_rcpf(g8u(d_.y, 2)); fb.w = g8u(n_.y, 3) * __builtin_amdgcn_rcpf(g8u(d_.y, 3));
                    } else { v4u o;
                        o.x = pk2(a.x * g8(n_.x, 0), a.y * g8(n_.x, 1)); o.y = pk2(a.z * g8(n_.x, 2), a.w * g8(n_.x, 3)); o.z = pk2(b.x * g8(n_.y, 0), b.y * g8(n_.y, 1)); o.w = pk2(b.z * g8(n_.y, 2), b.w * g8(n_.y, 3));
                        *(GAS v4u*)(mb + ((row0 + ai * 128 + m * 16) * 2048u + (unsigned)(128 * bj + 8 * fq) * 2u)) = o;
                    }
                    acc[ai][bj][m][0] = a * fa; acc[ai][bj][m][1] = b * fb;
                    asm volatile("" : "+v"(acc[ai][bj][m][0]), "+v"(acc[ai][bj][m][1]));
                }
            }
            asm volatile("" ::: "memory");
        }
    }
};
#ifndef MK_X8
#define MK_X8 1
#endif
template <int KIND, bool SCATTER>
struct EpiRes {
    const bf16* xs; int ldxs; float* xo; bf16* xb; int ldxb; float* SSo; const float* SSi; const bf16* PW; int dry; unsigned char* x8;
    __device__ __forceinline__ void operator()(AccRef acc, const pg8::Step& st, int wr, int wc, int fr_, int fq_) const {
        if (SCATTER && st.aux == 0) return;
        int fr = fr_, fq = fq_, zz = 0; LAUNDER3(fr, fq, zz);
        const int pn = st.pn; const unsigned colb = (unsigned)(256 * pn + 32 * wc + 8 * fq);
        int rowi[8];
#pragma unroll
        for (int i = 0; i < 8; ++i) { const int r = (i >> 2) * 128 + wr * 64 + (i & 3) * 16 + fr; rowi[i] = SCATTER ? ((r < st.nvalid) ? st.rows[r] : -1) : (st.pm * 256 + r); }
        float rs8[8];
#pragma unroll
        for (int i = 0; i < 8; ++i) rs8[i] = 1.f;
        if (KIND == 1) { rstd8(SSi, (unsigned)(st.pm * 256 + wr * 64 + fr), fq, rs8);
            if (MK_PLE8) {
#pragma unroll
                for (int i = 0; i < 8; ++i) rs8[i] *= (1.0f / G8_SCALE); } }
        v4u xin[2][2][2]; v4u pwv[2][2][2];
#define RES_LOAD(p_, buf_) do { _Pragma("unroll") for (int u_ = 0; u_ < 2; ++u_) { const int i_ = 2 * (p_) + u_; const unsigned rw_ = rowi[i_] >= 0 ? (unsigned)rowi[i_] : 0u; \
            _Pragma("unroll") for (int bj_ = 0; bj_ < 2; ++bj_) { xin[buf_][u_][bj_] = *(const GAS v4u*)((const GAS char*)xs + (rw_ * (unsigned)ldxs + colb + 128u * bj_) * 2u); \
                if (KIND == 1) pwv[buf_][u_][bj_] = *(const GAS v4u*)((const GAS char*)PW + (rw_ * 1024u + colb + 128u * bj_) * 2u); } } } while (0)
        RES_LOAD(0, 0);
#pragma unroll
        for (int pr = 0; pr < 4; ++pr) {
            float ssp[2]; f32x4 xr[2][2][2];
#pragma unroll
            for (int u = 0; u < 2; ++u) {
                const int i = 2 * pr + u, ai = i >> 2, m = i & 3; const float rs = rs8[i]; float ss = 0.f;
#pragma unroll
                for (int bj = 0; bj < 2; ++bj) {
                    const v4u xv = xin[pr & 1][u][bj];
                    f32x4 x0 = (f32x4){bflo(xv.x), bfhi(xv.x), bflo(xv.y), bfhi(xv.y)}, x1 = (f32x4){bflo(xv.z), bfhi(xv.z), bflo(xv.w), bfhi(xv.w)};
                    f32x4 a = acc[ai][bj][m][0], b = acc[ai][bj][m][1];
                    if (KIND == 1) { const v4u pw = pwv[pr & 1][u][bj];
                        const float rsn = rs * -1.4426950408889634f;
                        a.x = sg2(a.x * rsn) * bflo(pw.x); a.y = sg2(a.y * rsn) * bfhi(pw.x); a.z = sg2(a.z * rsn) * bflo(pw.y); a.w = sg2(a.w * rsn) * bfhi(pw.y);
                        b.x = sg2(b.x * rsn) * bflo(pw.z); b.y = sg2(b.y * rsn) * bfhi(pw.z); b.z = sg2(b.z * rsn) * bflo(pw.w); b.w = sg2(b.w * rsn) * bfhi(pw.w); }
                    x0 += a; x1 += b;
                    { const f32x4 q0 = x0 * x0, q1 = x1 * x1; ss += ((q0.x + q0.y) + (q0.z + q0.w)) + ((q1.x + q1.y) + (q1.z + q1.w)); }
                    xr[u][bj][0] = x0; xr[u][bj][1] = x1;
                }
                ss += XOR16(ss); ss = add_xor32(ss); ssp[u] = ss;
            }
            if (pr < 3) RES_LOAD(pr + 1, (pr + 1) & 1);
            asm volatile("" ::: "memory");
#pragma unroll
            for (int u = 0; u < 2; ++u) {
                const int i = 2 * pr + u; const bool ok = rowi[i] >= 0 && !dry; const unsigned rw = rowi[i] >= 0 ? (unsigned)rowi[i] : 0u;
                if (ok) {
#pragma unroll
                    for (int bj = 0; bj < 2; ++bj) { const f32x4 x0 = xr[u][bj][0], x1 = xr[u][bj][1];
                        if (xo) { GAS f32x4* op = (GAS f32x4*)((GAS char*)xo + (rw * 1024u + colb + 128u * bj) * 4u); op[0] = x0; op[1] = x1; }
                        if (xb) { v4u o; o.x = pk2(x0.x, x0.y); o.y = pk2(x0.z, x0.w); o.z = pk2(x1.x, x1.y); o.w = pk2(x1.z, x1.w);
                            *(GAS v4u*)((GAS char*)xb + (rw * (unsigned)ldxb + colb + 128u * bj) * 2u) = o; }
                        if (MK_X8 && x8) { v2u o2; o2.x = pk_fp8x4(x0.x, x0.y, x0.z, x0.w); o2.y = pk_fp8x4(x1.x, x1.y, x1.z, x1.w); *(GAS v2u*)((GAS char*)x8 + (rw * 1024u + colb + 128u * bj)) = o2; } }
                    if (fq == 0 && xb) *(GAS float*)((GAS char*)SSo + (rw * 16u + (unsigned)(4 * pn + wc)) * 4u) = ssp[u];
                }
            }
            asm volatile("" ::: "memory");
        }
#undef RES_LOAD
    }
};
struct EpiPW {
    bf16* O;
    __device__ __forceinline__ void operator()(AccRef acc, const pg8::Step& st, int wr, int wc, int fr_, int fq_) const {
        int fr = fr_, fq = fq_, zz = 0; LAUNDER3(fr, fq, zz);
        GAS char* ob = (GAS char*)O + (unsigned)(256 * st.pn + 32 * wc) * 2u; const unsigned row0 = (unsigned)(st.pm * 256 + wr * 64 + fr);
#pragma unroll
        for (int ai = 0; ai < 2; ++ai)
#pragma unroll
            for (int m = 0; m < 4; ++m) {
#pragma unroll
                for (int bj = 0; bj < 2; ++bj) { const f32x4 a = acc[ai][bj][m][0], b = acc[ai][bj][m][1]; v4u o; o.x = pk2(a.x, a.y); o.y = pk2(a.z, a.w); o.z = pk2(b.x, b.y); o.w = pk2(b.z, b.w);
                    *(GAS v4u*)(ob + ((row0 + ai * 128 + m * 16) * 2048u + (unsigned)(128 * bj + 8 * fq) * 2u)) = o; }
                asm volatile("" ::: "memory"); }
    }
};
struct EpiMU {
    bf16* ACT; const float* TOKW; float sc; LAS f32x4* twl;
    __device__ __forceinline__ void prep(const pg8::Step& st, int tid, int wid) const {
        if (wid < 4) { const int tk = (tid < st.nvalid) ? st.rows[tid] : 0;
            __builtin_amdgcn_global_load_lds((const unsigned*)((const char*)TOKW + (unsigned)tk * 16u), (LAS unsigned*)((LAS char*)twl + wid * 1024), 16, 0, 0); } }
    __device__ __forceinline__ void operator()(AccRef acc, const pg8::Step& st, int wr, int wc, int fr_, int fq_) const {
        int fr = fr_, fq = fq_, zz = 0; LAUNDER3(fr, fq, zz);
        const int j = st.pn; GAS char* ab = (GAS char*)ACT + (size_t)st.pm * 1024 + (unsigned)(128 * j + 32 * wc) * 2u;
        f32x4 tw[8];
#pragma unroll
        for (int i = 0; i < 8; ++i) { const int r = (i >> 2) * 128 + wr * 64 + (i & 3) * 16 + fr; tw[i] = twl[r]; if (r >= st.nvalid) tw[i] = (f32x4){0.f, 0.f, 0.f, 0.f}; }
        asm volatile("" ::: "memory");
#pragma unroll
        for (int i = 0; i < 8; ++i) {
            const int ai = i >> 2, m = i & 3, r = ai * 128 + wr * 64 + m * 16 + fr;
            const float rs = tw[i].z * sc, w = (j < 2) ? tw[i].x : tw[i].y;
            const f32x4 g0 = acc[ai][0][m][0] * rs, g1 = acc[ai][0][m][1] * rs, u0 = acc[ai][1][m][0] * rs, u1 = acc[ai][1][m][1] * rs; v4u o;
            o.x = pk2(g0.x * sigm(g0.x) * u0.x * w, g0.y * sigm(g0.y) * u0.y * w); o.y = pk2(g0.z * sigm(g0.z) * u0.z * w, g0.w * sigm(g0.w) * u0.w * w);
            o.z = pk2(g1.x * sigm(g1.x) * u1.x * w, g1.y * sigm(g1.y) * u1.y * w); o.w = pk2(g1.z * sigm(g1.z) * u1.z * w, g1.w * sigm(g1.w) * u1.w * w);
            *(GAS v4u*)(ab + ((unsigned)r * 1024u + (unsigned)(8 * fq) * 2u)) = o;
            asm volatile("" ::: "memory");
        }
    }
};

__device__ __forceinline__ bool tile_order(long L, int nM, int nN, int& pm, int& pn) {
    const int nwg = nM * nN; if (L >= nwg) return false;
    int wgid = (int)L; { const int q = nwg / 8, r = nwg % 8, xcd = wgid % 8, off = wgid / 8; wgid = (xcd < r ? xcd * (q + 1) : r * (q + 1) + (xcd - r) * q) + off; }
    const int nig = 8 * nN, gid = wgid / nig, fm = gid * 8, gsz = (nM - fm) < 8 ? (nM - fm) : 8;
    pm = fm + ((wgid % nig) % gsz); pn = (wgid % nig) / gsz; return true;
}
struct SchedPlain {
    const char* A; const char* B; size_t a_tile, b_tile; int nM, nN, nt, G, c, fixa, fixb;
    __device__ __forceinline__ bool next(int i, pg8::Step& s) const {
        int pm, pn; if (!tile_order((long)i * G + c, nM, nN, pm, pn)) return false;
        s.A = A + (size_t)(fixa ? 0 : pm) * a_tile; s.B = B + (size_t)(fixb ? 0 : pn) * b_tile; s.rows = nullptr; s.nt = nt; s.pm = pm; s.pn = pn; s.aux = i; s.nvalid = 256; s.zero_after = 1; return true; }
};
template <int PART>
struct SchedG2 {
    const char* Ab; const char* Bb; int c;
    __device__ __forceinline__ bool next(int i, pg8::Step& s) const {
        if (i >= 3) return false; int pm, pn; tile_order(c, 64, 4, pm, pn);
        const int n = i;
        s.A = PART == 0 ? Ab + (size_t)pm * 256 * 1024 : Ab + (size_t)pm * 256 * (XYP * 2) + 512 * n * 2;
        s.B = Bb + ((size_t)n * 1024 + pn * 256) * 1024;
        s.rows = nullptr; s.nt = 8; s.pm = pm; s.pn = pn; s.aux = PART * 3 + i; s.nvalid = 256; s.zero_after = 0; return true; }
};
struct SchedMoE {
    volatile LAS unsigned* MISC; const int* LIST; const char* Ab; const char* Bb; int G, c, mode, f8, cls;
    __device__ __forceinline__ bool next(int i, pg8::Step& s) const {
        const int NU = (int)MISC[MI_TOT]; const int u = c;
        if (u >= NU || i > (mode == 2 ? 1 : 0)) return false;
        const int down = mode == 2;
        const int r = u - (int)MISC[MI_U0 + cls], k = r >> 2, j = r & 3, n_c = (int)MISC[MI_N + cls], arow = (int)MISC[MI_BASE + cls] + 256 * k;
        const int grp = cls / 6, pr = cls % 6; const int pa = pr < 3 ? 0 : (pr < 5 ? 1 : 2), pb = pr < 3 ? pr + 1 : (pr < 5 ? pr - 1 : 3);
        s.rows = LIST + (size_t)cls * T + 256 * k; s.nvalid = min(256, n_c - 256 * k); s.pm = arow; s.pn = j;
        if (!down) { const int e = grp * 4 + (j < 2 ? pa : pb), hf = j & 1;
            s.A = Ab; s.B = Bb + (size_t)(e * 2 + hf) * 256 * (f8 ? 1024 : 2048); s.nt = f8 ? 8 : 16; s.aux = cls; s.zero_after = 1; }
        else { const int sgm = i & 1; const int e = grp * 4 + (sgm ? pb : pa);
            s.A = Ab + (size_t)arow * 1024 + sgm * 512; s.B = Bb + ((size_t)e * 1024 + j * 256) * 512; s.nt = 4; s.aux = sgm; s.zero_after = sgm; }
        return true; }
};
__device__ __forceinline__ float wave_sum(float v) {
    return wave_sum64(v);
}
__device__ __forceinline__ void pool_unit(int u, const bf16* PROJ, bf16* XY, int tid_) {
    int tid = tid_; asm volatile("" : "+v"(tid));
    const int c8 = tid & 63, rg = tid >> 6, g = c8 >> 4, w = 2 << g, t0 = 256 * u + 32 * rg, s0 = t0 % S;
    const GAS char* zb = (const GAS char*)PROJ + (unsigned)c8 * 16u; GAS char* yb = (GAS char*)XY + (unsigned)c8 * 16u;
    float sum[8];
#pragma unroll
    for (int j = 0; j < 8; ++j) sum[j] = 0.f;
    { v4u pz[16];
#pragma unroll
      for (int k = 1; k <= 16; ++k) { const bool ok = k <= w && k <= s0; pz[k - 1] = *(const GAS v4u*)(zb + (unsigned)(ok ? t0 - k : t0) * (unsigned)(PJP * 2)); }
#pragma unroll
      for (int k = 1; k <= 16; ++k) { const bool ok = k <= w && k <= s0; const v4u z = pz[k - 1];
        if (ok) { sum[0] += bflo(z.x); sum[1] += bfhi(z.x); sum[2] += bflo(z.y); sum[3] += bfhi(z.y); sum[4] += bflo(z.z); sum[5] += bfhi(z.z); sum[6] += bflo(z.w); sum[7] += bfhi(z.w); } } }
#pragma clang loop unroll(disable)
    for (int r0 = 0; r0 < 32; r0 += 8) {
        v4u zz[8], qq[8];
#pragma unroll
        for (int j = 0; j < 8; ++j) { const int t = t0 + r0 + j, s = s0 + r0 + j;
            zz[j] = *(const GAS v4u*)(zb + (unsigned)t * (unsigned)(PJP * 2)); qq[j] = *(const GAS v4u*)(zb + (unsigned)(s >= w ? t - w : t) * (unsigned)(PJP * 2)); }
#pragma unroll
        for (int j = 0; j < 8; ++j) { const int t = t0 + r0 + j, s = s0 + r0 + j; const v4u z = zz[j], q = qq[j];
            float zf[8] = {bflo(z.x), bfhi(z.x), bflo(z.y), bfhi(z.y), bflo(z.z), bfhi(z.z), bflo(z.w), bfhi(z.w)};
#pragma unroll
            for (int i = 0; i < 8; ++i) sum[i] += zf[i];
            if (s >= w) { sum[0] -= bflo(q.x); sum[1] -= bfhi(q.x); sum[2] -= bflo(q.y); sum[3] -= bfhi(q.y); sum[4] -= bflo(q.z); sum[5] -= bfhi(q.z); sum[6] -= bflo(q.w); sum[7] -= bfhi(q.w); }
            const float ic = 1.0f / (float)min(s + 1, w); v4u o;
            o.x = pk2(sum[0] * ic - zf[0], sum[1] * ic - zf[1]); o.y = pk2(sum[2] * ic - zf[2], sum[3] * ic - zf[3]); o.z = pk2(sum[4] * ic - zf[4], sum[5] * ic - zf[5]); o.w = pk2(sum[6] * ic - zf[6], sum[7] * ic - zf[7]);
            *(GAS v4u*)(yb + (unsigned)t * (unsigned)(XYP * 2)) = o; }
    }
}
#ifndef MK_THRD
#define MK_THRD 32
#endif
#ifndef MK_THRF
#define MK_THRF 64
#endif
#ifndef MK_ATT_SKIP
#define MK_ATT_SKIP 0
#endif
__device__ __forceinline__ void attn_phase(const int wave0, const LayerW& w, int l, int rep, unsigned char* ws, char* lds, volatile LAS unsigned* MISC, gu32* ctl, const int dry) {
    using namespace attn_body;
    int tid = mk_tid(wave0); const int lane = tid & 63;
    bf16* PROJ = (bf16*)(ws + WS_PROJ); bf16* XY = (bf16*)(ws + WS_XY); bf16* STASH = (bf16*)(ws + WS_STASH); const float* LOGF = (const float*)(ws + WS_LOGF);
    const float lam_init = 0.8f - 0.6f * __expf(-0.3f * (float)l);
    float lam; { const float a = wave_sum(w.dlam[lane] * w.dlam[64 + lane]), c = wave_sum(w.dlam[128 + lane] * w.dlam[192 + lane]); lam = __expf(a) - __expf(c) + lam_init; lam = __int_as_float(__builtin_amdgcn_readfirstlane(__float_as_int(lam))); }
    unsigned* qhead = pg8::rflp((unsigned*)(ctl + CW_AQ) + rep); unsigned* fhead = pg8::rflp((unsigned*)(ctl + CW_AQ) + 64 + 16 * l);
    {
        unsigned* top = pg8::rflp((unsigned*)(ctl + CW_SPLIT3) + 64 * l);
#pragma clang loop unroll(disable)
        for (;;) {
            tid = mk_tid(wave0);
            if (tid == 0) { unsigned r = 0xffffffffu; if (xb_ld(top) < (unsigned)gridDim.x) { const unsigned f = atomicAdd(fhead, 1u); if (f < (unsigned)(CV_LATE_BATCHES + CV_RT_BATCHES + CV_PB_BATCHES)) r = f; } MISC[MI_Q] = r; }
            __syncthreads();
            const unsigned fb = MISC[MI_Q];
            __syncthreads();
            if (fb == 0xffffffffu) break;
            conv_late_batch(w, ws, l, (LAS unsigned char*)lds, (int)fb, tid); __syncthreads();
        }
        tid = mk_tid(wave0);
        if (tid == 0) split_wait_leader(top, (unsigned)gridDim.x);
        __syncthreads();
    }
    int first = 1;
    for (;;) {
        tid = mk_tid(wave0);
        if (tid == 0) { unsigned q = first ? (unsigned)blockIdx.x : (unsigned)gridDim.x + atomicAdd(qhead, 1u); if (q >= 832u) q = 832u + atomicAdd(fhead, 1u); MISC[MI_Q] = q; }
        first = 0;
        __syncthreads();
        const int idx = (int)MISC[MI_Q];
        __syncthreads();
        if (idx >= 832 + CV_LATE_BATCHES + CV_RT_BATCHES + CV_PB_BATCHES) break;
        if (idx >= 832) { if (MK_ATT_SKIP && dry && (MK_ATT_SKIP & 8)) continue; conv_late_batch(w, ws, l, (LAS unsigned char*)lds, idx - 832, tid); continue; }
        int kind, qb, bh;
        if (idx < 160) { kind = 0; qb = 7 - idx / 32; bh = idx % 32; }
        else if (idx < 224) { kind = 1; qb = 7; bh = idx - 160; }
        else if (idx < 256) { kind = 0; qb = 2; bh = idx - 224; }
        else if (idx < 384) { kind = 1; qb = 6 - (idx - 256) / 64; bh = (idx - 256) % 64; }
        else if (idx < 416) { kind = 0; qb = 1; bh = idx - 384; }
        else if (idx < 480) { kind = 1; qb = 4; bh = idx - 416; }
        else if (idx < 544) { kind = 2; qb = 0; bh = idx - 480; }
        else if (idx < 608) { kind = 1; qb = 3; bh = idx - 544; }
        else if (idx < 640) { kind = 0; qb = 0; bh = idx - 608; }
        else if (idx < 704) { kind = 1; qb = 2; bh = idx - 640; }
        else { kind = 1; qb = 1 - (idx - 704) / 64; bh = (idx - 704) % 64; }
        if (MK_ATT_SKIP && dry && ((MK_ATT_SKIP >> kind) & 1)) continue;
        if (kind == 2) { pool_unit(bh, PROJ, XY, tid); __syncthreads(); continue; }
        if (kind == 1) {
            const int b = bh >> 3, h = bh & 7;
            AttnP P; P.Q = PROJ + 2048 + h * 64; P.K = PROJ + 2560 + h * 64; P.V = PROJ + 3072 + h * 64; P.out = XY + 1024 + h * 64; P.stash = nullptr; P.gsub = nullptr; P.logf = LOGF + h; P.opitch = XYP; P.lam = 0.f; P.nscale = 0.f;
            attn_unit<MK_THRF, true>(tid, b, qb, 0, P, lds);
        } else {
            const int b = bh >> 2, h = bh & 3;
#pragma unroll 1
            for (int c = 0; c < 2; ++c) {
                AttnP P; P.Q = PROJ + 512 + (h * 2 + c) * 64; P.K = PROJ + 1024 + (h * 2 + c) * 64; P.V = PROJ + 1536 + h * 128;
                P.stash = STASH + h * 128; P.gsub = w.dsub; P.logf = nullptr; P.lam = lam; P.nscale = 1.0f - lam_init;
                if (c == 0) { P.out = STASH + h * 128; P.opitch = 512; } else { P.out = XY + 512 + h * 128; P.opitch = XYP; }
                attn_unit128<MK_THRD>(mk_tid(wave0), b, qb, c == 0 ? 0 : 4, P, lds); }
        }
    }
}
__device__ __forceinline__ void moe_tables(volatile LAS unsigned* MISC, const unsigned* cls_cnt, int tid) {
    __syncthreads();
    if (tid < 64) {
        const unsigned n = tid < 24 ? cls_cnt[tid] : 0u; const unsigned nch = (n + 255u) >> 8; unsigned inc = nch;
#pragma unroll
        for (int o = 1; o < 32; o <<= 1) { const unsigned up = (unsigned)__builtin_amdgcn_ds_bpermute((tid - o) << 2, (int)inc); if (tid >= o) inc += up; }
        if (tid < 24) { MISC[MI_N + tid] = n; MISC[MI_BASE + tid] = (inc - nch) * 256u; MISC[MI_U0 + tid] = (inc - nch) * 4u; }
        if (tid == 23) MISC[MI_TOT] = inc * 4u; }
    __syncthreads();
}

__device__ __forceinline__ int moe_class(volatile LAS unsigned* MISC, int u, int tid) {
    const int k = tid & 63; const bool ge = k < 24 && u >= (int)MISC[MI_U0 + (k < 24 ? k : 0)];
    const int n = __popcll(__ballot(ge)); return __builtin_amdgcn_readfirstlane(n > 0 ? n - 1 : 0);
}
#ifndef MK_FIXA
#define MK_FIXA 0
#endif
#ifndef MK_FIXB
#define MK_FIXB 0
#endif
#ifndef MK_REPEAT
#define MK_REPEAT 0
#endif
constexpr int NPH = 18;
struct Prog { int p[40]; int n; };
constexpr Prog make_prog() {
    Prog g{}; int n = 0;
    for (int ph = 0; ph < NPH; ++ph) {
        const int kind = (ph == 0 || ph == 9) ? 8 : (ph >= 10 ? ph - 10 : ph - 1);
        g.p[n++] = ph; if ((MK_REPEAT >> kind) & 1) g.p[n++] = ph; }
    g.n = n; return g;
}
__constant__ const Prog PROG = make_prog();
constexpr int NPOS = make_prog().n;
template <unsigned KMASK>
__device__ __forceinline__ void mk_body() {
    typedef const __attribute__((address_space(4))) Args* KArgs;
    const KArgs args0p = (KArgs)__builtin_amdgcn_kernarg_segment_ptr();
    extern __shared__ __attribute__((aligned(16))) unsigned char lds_raw[];
    { LAS unsigned char* lds0 = (LAS unsigned char*)lds_raw;
      for (int u = threadIdx.x; u < (LDS_BYTES - MISC_OFF) / 4; u += NWAVES * 64) ((LAS unsigned*)(lds0 + MISC_OFF))[u] = 0u; }
    __syncthreads();
    const int wave0 = __builtin_amdgcn_readfirstlane(threadIdx.x >> 6);
    XcdBarrier bar = xcd_barrier_post((unsigned*)((gu32*)(args0p->ws + WS_CTL) + CW_BAR) + args0p->li * XCD_BAR_WORDS, (volatile LAS unsigned*)((LAS unsigned char*)lds_raw + MISC_OFF) + MI_BAR, threadIdx.x);
    const int ph_lo = args0p->ph_lo, ph_hi = args0p->ph_hi;
#pragma clang loop unroll(disable)
    for (int pos = ph_lo; pos < ph_hi; ++pos) {
        const int ph = __builtin_amdgcn_readfirstlane(PROG.p[pos]); const int rep = pos; const int dry = (MK_REPEAT != 0 && pos + 1 < ph_hi && __builtin_amdgcn_readfirstlane(PROG.p[pos + 1]) == ph) ? 1 : 0;
        KArgs ap = args0p; asm volatile("" : "+s"(ap));
#define args (*ap)
        LAS unsigned char* lds = (LAS unsigned char*)lds_raw;
        volatile LAS unsigned* MISC = (volatile LAS unsigned*)(lds + MISC_OFF);
        int G = gridDim.x, bx = blockIdx.x; asm volatile("" : "+s"(G), "+s"(bx)); const int vcu = (G % 8 == 0) ? (bx % 8) * (G / 8) + bx / 8 : bx;
        unsigned char* ws = args.ws; gu32* ctl = (gu32*)(ws + WS_CTL);
        float* XOUT = args.out; const float* x0 = (const float*)args.in[0];
        bf16* XY = (bf16*)(ws + WS_XY); bf16* PROJ = (bf16*)(ws + WS_PROJ);
        float* SSA = (float*)(ws + WS_SS); float* SSB = (float*)(ws + WS_SSB);
        if (ph == 0) { if constexpr (KMASK & 0x100u) { const int tid = mk_tid(wave0); const LayerW w = layer_view(ap, 0); conv_layer(w, ws, 0, lds, vcu, G, tid); p0_x(x0, (const int*)args.in[2], ws, (unsigned char*)XOUT + OUT_XB8, vcu, G, tid);
            if (tid == 0) ((unsigned*)(ctl + CW_XCC))[vcu] = xb_xcc_id() + 1u;
            if (bx == 0) { float* GT = (float*)(ctl + CW_GT); const int ll = tid >> 8, r = tid & 255, wch = r >> 6, d = r & 63;
                const float* gsrc = (const float*)(wch == 0 ? args.in[7] : (wch == 1 ? args.in[8] : (wch == 2 ? args.in[11] : args.in[12]))); GT[tid] = gsrc[ll * 64 + d]; } } }
        else if (ph == 9) { }
        else {
            const int l = __builtin_amdgcn_readfirstlane(ph >= 10 ? 1 : 0), k = __builtin_amdgcn_readfirstlane(ph - (l ? 10 : 1));
            const LayerW w = layer_view(ap, l);
            const float* SSin = l == 0 ? SSA : SSB; const float* xcur = l == 0 ? x0 : XOUT;
            if (k == 0) { if constexpr (KMASK & 1u) { const int tid = mk_tid(wave0);
                SchedPlain S{(const char*)(XY + 1536), (const char*)(ws + WS_W + W_IN), (size_t)256 * XYP * 2, (size_t)256 * 2048, 64, 15, 16, G, bx, dry & MK_FIXA, dry & MK_FIXB};
                LAS float* RSL = (LAS float*)(lds + MISC_OFF) + 1024;
                if (tid < 4) { int pm_ = -1, pn_ = 0; if (!tile_order((long)tid * G + bx, 64, 15, pm_, pn_)) pm_ = -1; MISC[112 + tid] = (unsigned)pm_; }
                __syncthreads();
                {
                    const int pm0 = (int)MISC[112 + (tid >> 8)], pm1 = (int)MISC[114 + (tid >> 8)];
                    const float r0 = rstd_at(SSin, (unsigned)((pm0 >= 0 ? pm0 : 0) * 256 + (tid & 255))), r1 = rstd_at(SSin, (unsigned)((pm1 >= 0 ? pm1 : 0) * 256 + (tid & 255)));
                    if (pm0 >= 0) RSL[tid] = r0; if (pm1 >= 0) RSL[512 + tid] = r1; }
                __syncthreads();
                EpiG1 E{SSin, PROJ, (float*)(ws + WS_LOGF), (const float*)(ws + WS_COSSIN), (const float*)(ctl + CW_GT) + 256 * l, w.ffb, dry, RSL};
                pg8::gemm_phase<SchedPlain, EpiG1, false, true>(tid, lds, XYP * 2, 2048, S, E);
                split_arrive_x(bar, (unsigned*)(ctl + CW_SPLIT3) + 64 * l, (unsigned*)(ctl + CW_SPLIT3) + 64 * l + 32 * 0 + 128, mk_tid(wave0));
            } } else if (k == 1) { if constexpr (KMASK & 2u) {
                attn_phase(wave0, w, l, rep, ws, (char*)lds_raw, MISC, ctl, dry);
                split_arrive_x(bar, (unsigned*)(ctl + CW_SPLIT + (2 * l) * 64), (unsigned*)(ctl + CW_SPLITX + (2 * l) * 64), mk_tid(wave0));
            } } else if (k == 2) { if constexpr (KMASK & 4u) { const int tid = mk_tid(wave0);
                unsigned char* gsc = (unsigned char*)XOUT + OUT_GATES + (size_t)bx * 196608;
                LAS float* RSL2 = (LAS float*)(lds + MISC_OFF) + 1024;
                { int pm_, pn_; tile_order(bx, 64, 4, pm_, pn_); if (tid < 256) RSL2[tid] = rstd_at(SSin, (unsigned)(pm_ * 256 + tid)); __syncthreads(); }
                { SchedG2<0> S{(const char*)XOUT + OUT_XB8, (const char*)(ws + WS_W + W_G8), bx};
                  EpiG2<0> E{SSin, gsc, (bf16*)(ws + WS_MERGED), RSL2};
                  pg8::gemm_phase<SchedG2<0>, EpiG2<0>, false, true, true>(tid, lds, 1024, 1024, S, E); }
                { const int t2 = mk_tid(wave0); if (t2 == 0) split_wait_leader((unsigned*)(ctl + CW_SPLIT + (2 * l) * 64), (unsigned)G); __syncthreads(); }
                { SchedG2<1> S{(const char*)XY, (const char*)(ws + WS_W + W_BR), bx};
                  EpiG2<1> E{SSin, gsc, (bf16*)(ws + WS_MERGED), RSL2};
                  pg8::gemm_phase<SchedG2<1>, EpiG2<1>, false, true>(mk_tid(wave0), lds, XYP * 2, 1024, S, E); }
                { int pm_, pn_; tile_order(bx, 64, 4, pm_, pn_); group4_sync((unsigned*)(ctl + CW_G4 + ((2 * l) * 64 + pm_) * 32), mk_tid(wave0)); }
            } } else if (k == 3) { if constexpr (KMASK & 8u) { const int tid = mk_tid(wave0);
                SchedPlain S{(const char*)(ws + WS_MERGED), (const char*)(ws + WS_W + W_OUT), (size_t)256 * 2048, (size_t)256 * 2048, 64, 4, 16, G, bx, 0, 0};
                EpiRes<0, false> E{XY + 1536, XYP, nullptr, XY + 1536, XYP, SSA, nullptr, nullptr, dry, (MK_MU8 && l == NL - 1) ? (unsigned char*)XOUT + OUT_XB8 : nullptr};
                pg8::gemm_phase<SchedPlain, EpiRes<0, false>, false, true>(tid, lds, 2048, 2048, S, E);
                { int pm_, pn_; tile_order(bx, 64, 4, pm_, pn_); group4_sync((unsigned*)(ctl + CW_G4 + ((2 * l + 1) * 64 + pm_) * 32), mk_tid(wave0)); }
            } } else if (k == 4) { if constexpr (KMASK & 16u) { const int tid = mk_tid(wave0);
                {
                    typedef float f32x16r __attribute__((ext_vector_type(16))); typedef short bf16x8r __attribute__((ext_vector_type(8)));
                    const int lane_ = tid & 63, r32 = lane_ & 31, hh = lane_ >> 5, wv = __builtin_amdgcn_readfirstlane(tid >> 6); int pm_, pn_; tile_order(bx, 64, 4, pm_, pn_); const int t0 = pm_ * 256 + pn_ * 64;
                    unsigned* ccnt = (unsigned*)(ctl + CW_CLS + 32 * l + 64 * dry); int* LIST = (int*)(ws + WS_LIST);
                    const GAS char* wrh = (const GAS char*)(ws + WS_W + W_RH) + (unsigned)(r32 * 2048 + (128 * wv + 8 * hh) * 2);
                    const GAS char* xb_ = (const GAS char*)(XY + 1536) + (size_t)t0 * (XYP * 2) + (unsigned)(r32 * (XYP * 2) + (128 * wv + 8 * hh) * 2);
                    f32x16r acc0 = {}, acc1 = {};
                    bf16x8r Bh[8], Bl[8], A0[8], A1[8];
#pragma unroll
                    for (int ks = 0; ks < 8; ++ks) { Bh[ks] = *(const GAS bf16x8r*)(wrh + ks * 32); Bl[ks] = *(const GAS bf16x8r*)(wrh + 65536 + ks * 32);
                        A0[ks] = *(const GAS bf16x8r*)(xb_ + ks * 32); A1[ks] = *(const GAS bf16x8r*)(xb_ + 32 * (XYP * 2) + ks * 32); }
                    const float rstd_pre = rstd_at(SSA, (unsigned)(t0 + (tid & 63)));
#pragma unroll
                    for (int ks = 0; ks < 8; ++ks) asm volatile("" : "+v"(Bh[ks]), "+v"(Bl[ks]), "+v"(A0[ks]), "+v"(A1[ks]));
                    float brgv[4], brev[16];
#pragma unroll
                    for (int e = 0; e < 4; ++e) brgv[e] = w.brg[e];
#pragma unroll
                    for (int e = 0; e < 16; ++e) brev[e] = w.bre[e];
#pragma unroll
                    for (int ks = 0; ks < 8; ++ks) {
                        acc0 = __builtin_amdgcn_mfma_f32_32x32x16_bf16(A0[ks], Bh[ks], acc0, 0, 0, 0); acc0 = __builtin_amdgcn_mfma_f32_32x32x16_bf16(A0[ks], Bl[ks], acc0, 0, 0, 0);
                        acc1 = __builtin_amdgcn_mfma_f32_32x32x16_bf16(A1[ks], Bh[ks], acc1, 0, 0, 0); acc1 = __builtin_amdgcn_mfma_f32_32x32x16_bf16(A1[ks], Bl[ks], acc1, 0, 0, 0);
                    }
                    LAS float* Pp = (LAS float*)lds;
                    LAS float* Lg = (LAS float*)(lds + 65536);
#pragma unroll
                    for (int r = 0; r < 16; ++r) { const int tk = (r & 3) + 8 * (r >> 2) + 4 * hh; Pp[(wv * 64 + tk) * 32 + r32] = acc0[r]; Pp[(wv * 64 + 32 + tk) * 32 + r32] = acc1[r]; }
                    __syncthreads();
                    { const int tk = tid >> 3, n4 = (tid & 7) * 4; f32x4 s = (f32x4){0.f, 0.f, 0.f, 0.f};
#pragma unroll
                      for (int w8 = 0; w8 < 8; ++w8) s += *(const LAS f32x4*)(Pp + (w8 * 64 + tk) * 32 + n4);
                      *(LAS f32x4*)(Lg + tk * 32 + n4) = s; }
                    __syncthreads();
                    if (tid < 64) { const int t = t0 + tid; float dg[4], de[16];
#pragma unroll
                        for (int e = 0; e < 4; ++e) dg[e] = Lg[tid * 32 + e];
#pragma unroll
                        for (int e = 0; e < 16; ++e) de[e] = Lg[tid * 32 + 4 + e];
                        const float rstd = rstd_pre; float wa, wb; const int cls = route_decide(dg, de, rstd, brgv, brev, wa, wb);
                        *(GAS f32x4*)((GAS char*)(ws + WS_TOKW) + (unsigned)t * 16u) = (f32x4){wa, wb, rstd, 0.f}; MISC[128 + tid] = (unsigned)cls; }
                    __syncthreads();
                    if (tid < 64) {
                        const unsigned mycls = MISC[128 + tid]; const unsigned long long ltm = (1ull << tid) - 1ull; unsigned cnt_c = 0, rank = 0;
#pragma unroll 4
                        for (unsigned c = 0; c < 24; ++c) { const unsigned long long m = __ballot(mycls == c); if ((unsigned)tid == c) cnt_c = (unsigned)__popcll(m); if (mycls == c) rank = (unsigned)__popcll(m & ltm); }
                        unsigned base = 0; if (tid < 24 && cnt_c) base = atomicAdd(ccnt + tid, cnt_c);
                        const unsigned mybase = (unsigned)__builtin_amdgcn_ds_bpermute((int)(mycls << 2), (int)base);
                        LIST[(size_t)mycls * T + mybase + rank] = t0 + tid; }
                    __syncthreads();
                }
                split_arrive_x(bar, (unsigned*)(ctl + CW_SPLIT + (2 * l + 1) * 64), (unsigned*)(ctl + CW_SPLITX + (2 * l + 1) * 64), mk_tid(wave0));
            } } else if (k == 5) { if constexpr (KMASK & 96u) { int tid = mk_tid(wave0);
                if (tid == 0) split_wait_leader((unsigned*)(ctl + CW_SPLIT + (2 * l + 1) * 64), (unsigned)G);
                __syncthreads();
                moe_tables(MISC, (const unsigned*)(ctl + CW_CLS + 32 * l), tid);
                const int NUm = (int)MISC[MI_TOT], KO = NUm > 256 ? (NUm - 256) >> 2 : 0;
                const int gid = vcu >> 2, m4 = vcu & 3, xg = gid >> 3, lg = gid & 7;
                const int k_o = lg * 8 + xg, k_p = (lg - 4) * 8 + xg;
                const bool is_o = lg < 4 && k_o < KO, is_p = lg >= 4 && k_p < KO;
                unsigned* cA = (unsigned*)(ctl + CW_MOE2 + 3584 * l); unsigned* cB = cA + 2048; unsigned* cO = cA + 3072;
#pragma clang loop unroll(disable)
                for (int r = 0; r < 2; ++r) {
                    const int u = r == 0 ? vcu : 256 + 4 * k_o + m4; if (r == 1 && !is_o) break;
                    tid = mk_tid(wave0);
                    { const int ucls = moe_class(MISC, u, tid);
                      SchedMoE S{MISC, (const int*)(ws + WS_LIST), (const char*)(XY + 1536), (const char*)(ws + WS_W + W_GU), G, u, 0, 0, ucls};
                      EpiMU E{(bf16*)(ws + OV_ACT), (const float*)(ws + WS_TOKW), 1.0f, (LAS f32x4*)(lds + MISC_OFF + 4096)};
                      pg8::gemm_phase<SchedMoE, EpiMU, true, true>(tid, lds, XYP * 2, 2048, S, E); }
                    if (r == 0 && is_o) {
                        asm volatile("s_waitcnt vmcnt(0)" ::: "memory"); __syncthreads();
                        tid = mk_tid(wave0);
                        if (tid == 0) { const unsigned me = xb_xcc_id() + 1u; bool same = true;
#pragma unroll
                            for (int i = 0; i < 4; ++i) same = same && (xb_ld((unsigned*)(ctl + CW_XCC) + (gid + 4) * 4 + i) == me);
                            if (!same) { __builtin_amdgcn_fence(__ATOMIC_RELEASE, "agent"); asm volatile("s_waitcnt vmcnt(0)" ::: "memory"); }
                            xb_add(cO + 16 * k_o, 1u); asm volatile("s_waitcnt vmcnt(0)" ::: "memory"); }
                        __syncthreads();
                    }
                }
                group4_sync(is_o ? cB + 32 * k_o : cA + 32 * gid, mk_tid(wave0));
#pragma clang loop unroll(disable)
                for (int r = 0; r < 2; ++r) {
                    const int u = r == 0 ? (is_o ? 256 + 4 * k_o + m4 : vcu) : 4 * (gid - 4) + m4; if (r == 1 && !is_p) break;
                    tid = mk_tid(wave0);
                    if (r == 1) {
                        if (tid == 0) { unsigned sp = 0; while (xb_ld(cO + 16 * k_p) < 4u) { __builtin_amdgcn_s_sleep(2); if (++sp > (1u << 22)) break; }
                            __builtin_amdgcn_fence(__ATOMIC_ACQUIRE, "agent"); asm volatile("s_waitcnt vmcnt(0)" ::: "memory"); }
                        __syncthreads();
                    }
                    const int ucls = moe_class(MISC, u, tid);
                    SchedMoE S{MISC, (const int*)(ws + WS_LIST), (const char*)(ws + OV_ACT), (const char*)(ws + WS_W + W_D), G, u, 2, 0, ucls};
                    EpiRes<0, true> E{XY + 1536, XYP, nullptr, (bf16*)(ws + OV_XB2), 1024, SSA, nullptr, nullptr, dry, MK_PLE8 ? ws + WS_MERGED : nullptr};
                    pg8::gemm_phase<SchedMoE, EpiRes<0, true>, false, true>(tid, lds, 1024, 512, S, E);
                }
                { unsigned* fqh = pg8::rflp((unsigned*)(ctl + CW_FQ) + 64 * l); const int NF = 256 + (l + 1 < NL ? CV_EARLY_BATCHES : 0);
                  int arrived = 0;
                  for (;;) {
                    const int tq = mk_tid(wave0);
                    if (tq == 0) MISC[MI_Q] = atomicAdd(fqh, 1u);
                    __syncthreads();
                    const int idx = (int)MISC[MI_Q];
                    __syncthreads();
                    if (idx >= 256 && !arrived) { split_arrive_x(bar, (unsigned*)(ctl + CW_SPLIT3) + 256 + 64 * l, (unsigned*)(ctl + CW_SPLIT3) + 512 + 64 * l, mk_tid(wave0)); arrived = 1; }
                    if (idx >= NF) break;
                    if (idx < 256) {
                        SchedPlain S2{(const char*)(ws + OV_PB), (const char*)(ws + WS_WPLE + l * WPLE_STRIDE + W_P), (size_t)256 * 512, (size_t)256 * 512, 64, 4, 4, 1 << 20, idx, 0, 0};
                        EpiPW E2{(bf16*)(ws + OV_PW)};
                        pg8::gemm_phase<SchedPlain, EpiPW, false, true>(tq, lds, 512, 512, S2, E2);
                    } else { const LayerW w1 = layer_view(ap, 1); conv_early_batch(w1, ws, 1, lds, idx - 256, tq); }
                  } }
            } } else if (k == 6) { if constexpr (KMASK & 96u) {
            } } else { if constexpr (KMASK & 128u) { const int tid = mk_tid(wave0);
                if (tid == 0) split_wait_leader((unsigned*)(ctl + CW_SPLIT3) + 256 + 64 * l, (unsigned)G);
                __syncthreads();
                constexpr int P8 = MK_PLE8 ? 1 : 0;
                SchedPlain S{(const char*)(ws + (P8 ? WS_MERGED : OV_XB2)), (const char*)(ws + WS_WPLE + l * WPLE_STRIDE + W_PG), (size_t)256 * (P8 ? 1024 : 2048), (size_t)256 * (P8 ? 1024 : 2048), 64, 4, P8 ? 8 : 16, G, bx, 0, 0};
                EpiRes<1, false> E{(const bf16*)(ws + OV_XB2), 1024, l == NL - 1 ? XOUT : nullptr, l == NL - 1 ? nullptr : XY + 1536, XYP, SSB, SSA, (const bf16*)(ws + OV_PW), dry, l == NL - 1 ? nullptr : (unsigned char*)XOUT + OUT_XB8};
                pg8::gemm_phase<SchedPlain, EpiRes<1, false>, false, true, P8 != 0>(tid, lds, P8 ? 1024 : 2048, P8 ? 1024 : 2048, S, E);
            } }
        }
        const int kk_ = (ph == 0 || ph == 9) ? -1 : (ph >= 10 ? ph - 10 : ph - 1);
        if (pos + 1 < ph_hi && ph != 9 && (MK_REPEAT != 0 || kk_ > 6 || kk_ < 0)) { xcd_barrier(bar, mk_tid(wave0));
#ifdef MK_DOUBLE_BAR
            xcd_barrier(bar, mk_tid(wave0)); xcd_barrier(bar, mk_tid(wave0));
#endif
        }
#undef args
    }
}

#ifndef MK_KMASKS
#ifdef MK_SPLIT_TEST
#define MK_KMASKS 0x100u
#else
#define MK_KMASKS 0x1FFu
#endif
#endif
__global__ void __launch_bounds__(NWAVES * 64, 2) mk_fwd(Args args) { mk_body<MK_KMASKS>(); }
#ifdef MK_SPLIT_TEST
__global__ void __launch_bounds__(NWAVES * 64, 2) mk_t0(Args args) { mk_body<1u>(); }
__global__ void __launch_bounds__(NWAVES * 64, 2) mk_t1(Args args) { mk_body<2u>(); }
__global__ void __launch_bounds__(NWAVES * 64, 2) mk_t2(Args args) { mk_body<4u>(); }
__global__ void __launch_bounds__(NWAVES * 64, 2) mk_t3(Args args) { mk_body<8u>(); }
__global__ void __launch_bounds__(NWAVES * 64, 2) mk_t4(Args args) { mk_body<16u>(); }
__global__ void __launch_bounds__(NWAVES * 64, 2) mk_t5(Args args) { mk_body<32u>(); }
__global__ void __launch_bounds__(NWAVES * 64, 2) mk_t6(Args args) { mk_body<64u>(); }
__global__ void __launch_bounds__(NWAVES * 64, 2) mk_t7(Args args) { mk_body<128u>(); }
__global__ void __launch_bounds__(NWAVES * 64, 2) mk_t8(Args args) { mk_body<256u>(); }
#endif
#ifndef MK_ONE_LAUNCH
#define MK_ONE_LAUNCH 0
#endif
#ifndef MK_OPT_MASK
#define MK_OPT_MASK 0x3FFFF
#endif
static void ref_phase(int l, int k, void* const* d_in, float* XOUT, unsigned char* ws, hipStream_t st) {
    using namespace refp;
    const float* x0 = (const float*)d_in[0]; const float* p = (const float*)d_in[1]; const int* pos = (const int*)d_in[2];
    const float* g_attn = (const float*)d_in[3] + l * 1024; const float* w_in_l = (const float*)d_in[4] + (size_t)l * 1024 * INW;
    const float* pool_w = (const float*)d_in[5] + (size_t)l * 4 * 128 * 128; const float* pool_scale = (const float*)d_in[6] + l * 512;
    const float* dqn = (const float*)d_in[7] + l * 64; const float* dkn = (const float*)d_in[8] + l * 64; const float* dlam = (const float*)d_in[9] + l * 256;
    const float* dsub = (const float*)d_in[10] + l * 128; const float* fqn = (const float*)d_in[11] + l * 64; const float* fkn = (const float*)d_in[12] + l * 64;
    const float* ffb = (const float*)d_in[13] + l * 8; const float* w_branch_l = (const float*)d_in[14] + (size_t)l * 3 * 512 * 1024; const float* w_out_l = (const float*)d_in[15] + (size_t)l * 1024 * 1024;
    const float* g_ffn = (const float*)d_in[16] + l * 1024; const float* wrg = (const float*)d_in[17] + (size_t)l * 1024 * 4; const float* brg = (const float*)d_in[18] + l * 4;
    const float* wre = (const float*)d_in[19] + (size_t)l * 1024 * 16; const float* bre = (const float*)d_in[20] + l * 16;
    const float* wg_l = (const float*)d_in[21] + (size_t)l * 16 * 1024 * 256; const float* wu_l = (const float*)d_in[22] + (size_t)l * 16 * 1024 * 256; const float* wd_l = (const float*)d_in[23] + (size_t)l * 16 * 256 * 1024;
    const float* g_ple = (const float*)d_in[24] + l * 1024; const float* wpg_l = (const float*)d_in[25] + (size_t)l * 1024 * 1024; const float* wple_l = (const float*)d_in[26] + (size_t)l * 256 * 1024;
    const float* p_l = p + (size_t)l * T * 256;
    float* SSA = (float*)(ws + WS_SS); float* SSB = (float*)(ws + WS_SSB); float* RS = (float*)(ws + WS_RSTD); float* LOGF = (float*)(ws + WS_LOGF); float* FCUM = (float*)(ws + WS_FCUM); float* TOKW = (float*)(ws + WS_TOKW); int* LIST = (int*)(ws + WS_LIST);
    bf16* XY = (bf16*)(ws + WS_XY); bf16* PROJ = (bf16*)(ws + WS_PROJ); float* CH = (float*)(ws + WS_STASH); bf16* MERGED = (bf16*)(ws + WS_MERGED); float* TMP = (float*)(ws + WS_PROJ);
    unsigned* cls_cnt = (unsigned*)(ws + WS_CTL) + CW_CLS + 32 * l;
    const float* xcur = l == 0 ? x0 : XOUT; float* SSin = l == 0 ? SSA : SSB;
    const float lam_init = 0.8f - 0.6f * expf(-0.3f * (float)l);
    if (k == -1) { k_rowstats<<<T / 4, 256, 0, st>>>(x0, XY + 1536, XYP, SSA, RS, nullptr); return; }
    if (k == 0) {
        k_ref_rstd<<<T / 256, 256, 0, st>>>(SSin, RS);
        for (int cc = 0; cc < 14; ++cc) {
            k_ref_gemm<<<dim3(4, T / 64), 256, 0, st>>>(XnormLoader{xcur, RS, g_attn}, w_in_l + 256 * cc, INW, 256, 1024, EpiStoreF32{CH, 256, 0});
            int kind = 2; const float* gain = nullptr; int rot = 0; float osc = 1.f;
            if (cc < 2) kind = 0;
            else if (cc < 4) { kind = 1; gain = dqn; rot = 1; osc = C2; }
            else if (cc < 6) { kind = 1; gain = dkn; rot = 1; }
            else if (cc >= 8 && cc < 10) { kind = 1; gain = fqn; osc = C2; }
            else if (cc >= 10 && cc < 12) { kind = 1; gain = fkn; }
            k_ref_epi1<<<T, 256, 0, st>>>(CH, cc, kind, pool_w, pool_scale, gain, rot, osc, pos, PROJ);
        }
        k_ref_gemm<<<dim3(1, T / 64), 256, 0, st>>>(XnormLoader{xcur, RS, g_attn}, w_in_l + 3584, INW, 8, 1024, EpiStoreF32{CH, 8, 0});
        k_ref_logf<<<T * 8 / 256, 256, 0, st>>>(CH, ffb, LOGF);
    } else if (k == 1) {
        k_ref_fscan<<<1, 64, 0, st>>>(LOGF, FCUM);
        k_ref_fox<<<T * 8 / 4, 256, 0, st>>>(PROJ, FCUM, XY);
        k_ref_diff<<<T * 4 / 2, 128, 0, st>>>(PROJ, dlam, dsub, lam_init, XY);
        k_ref_pool<<<T * 512 / 256, 256, 0, st>>>(PROJ, XY);
    } else if (k == 2) {
        k_ref_rstd<<<T / 256, 256, 0, st>>>(SSin, RS);
        k_ref_gemm2<<<dim3(16, T / 64), 256, 0, st>>>(xcur, RS, g_attn, w_in_l, w_branch_l, XY, MERGED);
    } else if (k == 3) {
        k_ref_gemm<<<dim3(16, T / 64), 256, 0, st>>>(Bf16Loader{MERGED, 1024, 0}, w_out_l, 1024, 1024, 1024, EpiResid{xcur, XOUT});
        k_rowstats<<<T / 4, 256, 0, st>>>(XOUT, XY + 1536, XYP, SSA, RS, nullptr);
    } else if (k == 4) {
        k_route<<<T / 4, 256, 0, st>>>(XOUT, g_ffn, wrg, brg, wre, bre, cls_cnt, LIST, TOKW);
    } else if (k == 5) {
        k_ref_rstd<<<T / 256, 256, 0, st>>>(SSA, RS);
        k_ref_moe<<<dim3(T / 8, 24), 256, 0, st>>>(XOUT, RS, g_ffn, (const int*)cls_cnt, LIST, TOKW, wg_l, wu_l, wd_l);
        k_rowstats<<<T / 4, 256, 0, st>>>(XOUT, (bf16*)(ws + OV_XB2), 1024, SSA, RS, nullptr);
    } else if (k == 7) {
        k_ref_rstd<<<T / 256, 256, 0, st>>>(SSA, RS);
        k_ref_ple<<<dim3(16, T / 64), 256, 0, st>>>(XOUT, RS, g_ple, wpg_l, p_l, wple_l, TMP);
        k_rowstats<<<T / 4, 256, 0, st>>>(TMP, XY + 1536, XYP, SSB, RS, XOUT);
    }
}

extern "C" void kernel_launch(void* const* d_in, const int* in_sizes, int n_in, void* d_out, int out_size, void* d_ws, size_t ws_size, hipStream_t stream) {
    static int grid = 0;
    if (grid == 0) {
        if (n_in != 27 || out_size != T * DM || ws_size < WS_END) { fprintf(stderr, "kernel_launch: unexpected shapes (n_in %d out %d ws %zu)\n", n_in, out_size, ws_size); grid = -1; return; }
        int dev = 0, cus = 0;
        if (hipGetDevice(&dev) != hipSuccess || hipDeviceGetAttribute(&cus, hipDeviceAttributeMultiprocessorCount, dev) != hipSuccess) { grid = -1; return; }
        if (hipFuncSetAttribute((const void*)mk_fwd, hipFuncAttributeMaxDynamicSharedMemorySize, LDS_BYTES) != hipSuccess) { fprintf(stderr, "kernel_launch: hipFuncSetAttribute failed\n"); grid = -1; return; }
#if !MK_ONE_LAUNCH
        { const void* ks[9] = {(const void*)mk_t0, (const void*)mk_t1, (const void*)mk_t2, (const void*)mk_t3, (const void*)mk_t4, (const void*)mk_t5, (const void*)mk_t6, (const void*)mk_t7, (const void*)mk_t8};
          for (int i = 0; i < 9; ++i) (void)hipFuncSetAttribute(ks[i], hipFuncAttributeMaxDynamicSharedMemorySize, LDS_BYTES); }
#endif
        int per_cu = 0;
        if (hipOccupancyMaxActiveBlocksPerMultiprocessor(&per_cu, mk_fwd, NWAVES * 64, LDS_BYTES) != hipSuccess || per_cu < 1) { fprintf(stderr, "kernel_launch: occupancy query failed (%d)\n", per_cu); grid = -1; return; }
        (void)hipGetLastError();
        grid = cus;
    }
    if (grid < 0) return;
    (void)hipMemsetAsync((char*)d_ws + WS_CTL, 0, MK_ONE_LAUNCH ? (size_t)192 * 1024 : CTL_BYTES, stream);
    Args a{};
    for (int i = 0; i < 27; ++i) a.in[i] = d_in[i];
    a.out = (float*)d_out; a.ws = (unsigned char*)d_ws;
#if MK_ONE_LAUNCH
    a.ph_lo = 0; a.ph_hi = NPOS; a.li = 0;
    hipLaunchKernelGGL(mk_fwd, dim3(grid), dim3(NWAVES * 64), LDS_BYTES, stream, a);
#else
    const unsigned mask = MK_OPT_MASK; int li = 0;
    typedef void (*kern_t)(Args);
    const kern_t ks[9] = {mk_t0, mk_t1, mk_t2, mk_t3, mk_t4, mk_t5, mk_t6, mk_t7, mk_t8};
#define LAUNCH_PH(kk) hipLaunchKernelGGL(ks[kk], dim3(grid), dim3(NWAVES * 64), LDS_BYTES, stream, a)
    for (int ph = 0; ph < NPH; ++ph) {
        const bool opt = (mask >> ph) & 1u;
        const int l = ph >= 10 ? 1 : 0, k = ph == 0 ? -1 : (ph == 9 ? -2 : ph - (l ? 10 : 1));
        if (ph == 0) {
            a.ph_lo = 0; a.ph_hi = 1; a.li = li++; LAUNCH_PH(8);
            if (!opt) ref_phase(0, -1, d_in, (float*)d_out, (unsigned char*)d_ws, stream);
            continue; }
        if (ph == 9) { a.ph_lo = 9; a.ph_hi = 10; a.li = li++; LAUNCH_PH(8); continue; }
        if (opt) { a.ph_lo = ph; a.ph_hi = ph + 1; a.li = li++; LAUNCH_PH(k); }
        else if (k != 6) ref_phase(l, k, d_in, (float*)d_out, (unsigned char*)d_ws, stream);
    }
#endif
}
```
